# Optimizing an MI355X kernel written in HIP

```python
import math
import jax, jax.numpy as jnp
from jax import lax
import numpy as np

D_MODEL = 1024
BATCH = 8
SEQ = 4096
DEPTH = 4

N_MIXERS = 3
D_FF = 2816
EPS = 1e-6
GDN_HEADS = 8
GDN_DK = 128
GDN_DV = 128
GDN_CONV = 4
GDN_CHUNK = 64
SC_WIDTH = 3
NSA_HEADS = 16
NSA_KV_HEADS = 4
NSA_GROUP = NSA_HEADS // NSA_KV_HEADS
NSA_DH = 64
CMP_BLOCK = 32
CMP_STRIDE = 16
CMP_HIDDEN = 256
SLC_BLOCK = 64
SLC_TOPK = 16
N_LOCAL = 2
WINDOW = 512
NSA_Q_BLOCK = 32
ROPE_THETA = 10000.0
NEG = -1e30
FORCE = 1e9
N_GDN = (DEPTH + 2) // 3
N_SC = (DEPTH + 1) // 3
N_NSA = DEPTH // 3

kernel_name = "hybrid_gdn_shortconv_nsa_macaron"


def rmsnorm(x, w):
    xf = x.astype(jnp.float32)
    y = xf * lax.rsqrt(jnp.mean(xf * xf, -1, keepdims=True) + EPS)
    return (y * w.astype(jnp.float32)).astype(x.dtype)


def l2norm(x):
    xf = x.astype(jnp.float32)
    return xf * lax.rsqrt(jnp.sum(xf * xf, -1, keepdims=True) + EPS)


def causal_depthwise_conv(x, w):
    width = w.shape[0]
    S = x.shape[1]
    xp = jnp.pad(x, ((0, 0), (width - 1, 0), (0, 0)))
    y = xp[:, 0:S] * w[0]
    for j in range(1, width):
        y = y + xp[:, j:j + S] * w[j]
    return y


def swiglu(h, w_gate_up, w_down):
    g, u = jnp.split(h @ w_gate_up, 2, axis=-1)
    return (jax.nn.silu(g) * u) @ w_down


def rope_tables(positions, dim):
    inv = 1.0 / (ROPE_THETA ** (jnp.arange(0, dim, 2, dtype=jnp.float32) / dim))
    ang = positions.astype(jnp.float32)[..., None] * inv
    ang = jnp.concatenate([ang, ang], axis=-1)[:, :, None, :]
    return jnp.cos(ang), jnp.sin(ang)


def apply_rope(x, cos, sin):
    x1, x2 = jnp.split(x, 2, axis=-1)
    rot = jnp.concatenate([-x2, x1], axis=-1)
    return (x * cos + rot * sin).astype(x.dtype)


def gated_delta_rule_chunked(q, k, v, g, beta):
    B, S, H, dk = q.shape
    dv = v.shape[-1]
    C = GDN_CHUNK
    N = S // C

    def to_chunks(t):
        return jnp.moveaxis(t.reshape((B, N, C, H) + t.shape[3:]), 3, 1)

    q = to_chunks(q) * (dk ** -0.5)
    k = to_chunks(k)
    v = to_chunks(v)
    g = to_chunks(g)
    beta = to_chunks(beta)
    gc = jnp.cumsum(g, axis=-1)
    causal = jnp.tril(jnp.ones((C, C), bool))
    strict = jnp.tril(jnp.ones((C, C), bool), -1)
    decay = jnp.exp(jnp.where(causal, gc[..., :, None] - gc[..., None, :], -jnp.inf))
    k_beta = k * beta[..., None]
    A = jnp.where(strict, jnp.einsum('bhncd,bhned->bhnce', k_beta, k) * decay, 0.0)
    eye = jnp.eye(C, dtype=jnp.float32)
    u = lax.linalg.triangular_solve(eye + A, v * beta[..., None], left_side=True,
                                    lower=True, unit_diagonal=True)
    w = lax.linalg.triangular_solve(eye + A, k_beta * jnp.exp(gc)[..., None], left_side=True,
                                    lower=True, unit_diagonal=True)
    attn_intra = jnp.where(causal, jnp.einsum('bhncd,bhned->bhnce', q, k) * decay, 0.0)
    q_dec = q * jnp.exp(gc)[..., None]
    k_dec = k * jnp.exp(gc[..., -1:] - gc)[..., None]
    g_last = jnp.exp(gc[..., -1])
    xs = tuple(jnp.moveaxis(t, 2, 0) for t in (q_dec, k_dec, u, w, attn_intra, g_last))

    def step(state, inp):
        qd, kd, u_c, w_c, a_c, gl = inp
        v_new = u_c - jnp.einsum('bhcd,bhde->bhce', w_c, state)
        o = jnp.einsum('bhcd,bhde->bhce', qd, state) + jnp.einsum('bhce,bhef->bhcf', a_c, v_new)
        state = state * gl[..., None, None] + jnp.einsum('bhcd,bhce->bhde', kd, v_new)
        return state, o

    s0 = jnp.zeros((B, H, dk, dv), jnp.float32)
    _, o = lax.scan(step, s0, xs)
    return jnp.transpose(o, (1, 0, 3, 2, 4)).reshape(B, S, H, dv)


def gdn_mixer(h, w_in, conv_w, A_log, dt_bias, out_norm, w_out):
    B, S, _ = h.shape
    H, dk, dv = GDN_HEADS, GDN_DK, GDN_DV
    n_qkv = 2 * H * dk + H * dv
    proj = h @ w_in
    qkv, gate, a, b = jnp.split(proj, [n_qkv, n_qkv + H * dv, n_qkv + H * dv + H], axis=-1)
    qkv = jax.nn.silu(causal_depthwise_conv(qkv, conv_w))
    q, k, v = jnp.split(qkv, [H * dk, 2 * H * dk], axis=-1)
    q = l2norm(q.reshape(B, S, H, dk))
    k = l2norm(k.reshape(B, S, H, dk))
    v = v.reshape(B, S, H, dv).astype(jnp.float32)
    beta = jax.nn.sigmoid(b.astype(jnp.float32))
    g = -jnp.exp(A_log.astype(jnp.float32)) * jax.nn.softplus(
        a.astype(jnp.float32) + dt_bias.astype(jnp.float32))
    o = gated_delta_rule_chunked(q, k, v, g, beta)
    o = rmsnorm(o, out_norm) * jax.nn.silu(gate.reshape(B, S, H, dv).astype(jnp.float32))
    return o.reshape(B, S, H * dv).astype(h.dtype) @ w_out


def short_conv_mixer(h, w_in, conv_w, w_out):
    b_gate, c_gate, xin = jnp.split(h @ w_in, 3, axis=-1)
    y = causal_depthwise_conv(c_gate * xin, conv_w)
    return (b_gate * y) @ w_out


def nsa_mixer(h, cos, sin, w_in, q_norm, k_norm, cmp_pe, cmp_w1, cmp_b1, cmp_w2, cmp_b2, w_out):
    B, S, _ = h.shape
    H, Hk, G, dh = NSA_HEADS, NSA_KV_HEADS, NSA_GROUP, NSA_DH
    kvw = Hk * dh
    sizes = [H * dh] + [kvw] * 6
    splits = [int(s) for s in np.cumsum(sizes)]
    q, kc, vc, ks, vs, kw, vw, gates = jnp.split(h @ w_in, splits, axis=-1)
    q = rmsnorm(q.reshape(B, S, H, dh), q_norm)
    q_rot = apply_rope(q, cos, sin)
    ks = apply_rope(rmsnorm(ks.reshape(B, S, Hk, dh), k_norm[1]), cos, sin)
    kw = apply_rope(rmsnorm(kw.reshape(B, S, Hk, dh), k_norm[2]), cos, sin)
    vs = vs.reshape(B, S, Hk, dh)
    vw = vw.reshape(B, S, Hk, dh)
    gates = jax.nn.sigmoid(gates.reshape(B, S, H, 3).astype(jnp.float32))

    r = CMP_BLOCK // CMP_STRIDE
    n_chunks = S // CMP_STRIDE
    Nc = n_chunks - r + 1

    def compress(t, i):
        c = t.reshape(B, n_chunks, CMP_STRIDE, Hk, dh)
        blocks = jnp.concatenate([c[:, j:j + Nc] for j in range(r)], axis=2)
        blocks = blocks + cmp_pe[i][:, None, :]
        blocks = jnp.moveaxis(blocks, 3, 2).reshape(B, Nc, Hk, CMP_BLOCK * dh)
        hid = jax.nn.gelu(blocks @ cmp_w1[i] + cmp_b1[i])
        return hid @ cmp_w2[i] + cmp_b2[i]

    kc = rmsnorm(compress(kc.reshape(B, S, Hk, dh), 0), k_norm[0])
    vc = compress(vc.reshape(B, S, Hk, dh), 1)

    qn_t = q.reshape(B, S, Hk, G, dh).transpose(0, 2, 3, 1, 4)
    qr_t = q_rot.reshape(B, S, Hk, G, dh).transpose(0, 2, 3, 1, 4)
    kc_t = kc.transpose(0, 2, 1, 3)
    vc_t = vc.transpose(0, 2, 1, 3)
    Ns = S // SLC_BLOCK
    n_sel = min(SLC_TOPK, Ns)
    ks_blk = ks.transpose(0, 2, 1, 3).reshape(B, Hk, Ns, SLC_BLOCK, dh)
    vs_blk = vs.transpose(0, 2, 1, 3).reshape(B, Hk, Ns, SLC_BLOCK, dh)
    pad = ((0, 0), (0, 0), (WINDOW, 0), (0, 0))
    kw_pad = jnp.pad(kw.transpose(0, 2, 1, 3), pad)
    vw_pad = jnp.pad(vw.transpose(0, 2, 1, 3), pad)

    cmp_end = jnp.arange(Nc) * CMP_STRIDE + CMP_BLOCK - 1
    ci = jnp.arange(Nc)[:, None]
    sj = jnp.arange(Ns)[None, :]
    overlap = jnp.clip(jnp.minimum(ci * CMP_STRIDE + CMP_BLOCK, (sj + 1) * SLC_BLOCK)
                       - jnp.maximum(ci * CMP_STRIDE, sj * SLC_BLOCK), 0, None)
    overlap = overlap.astype(jnp.float32) / CMP_BLOCK
    blk_ids = jnp.arange(Ns)
    b_idx = jnp.arange(B)[:, None, None, None]
    h_idx = jnp.arange(Hk)[None, :, None, None]
    scale = dh ** -0.5
    QB = NSA_Q_BLOCK

    def block(i):
        s0 = i * QB
        tpos = s0 + jnp.arange(QB)
        qn = lax.dynamic_slice_in_dim(qn_t, s0, QB, axis=3).astype(jnp.float32)
        qr = lax.dynamic_slice_in_dim(qr_t, s0, QB, axis=3).astype(jnp.float32)
        sc = jnp.einsum('bhgqd,bhkd->bhgqk', qn, kc_t) * scale
        cmask = cmp_end[None, :] <= tpos[:, None]
        p_c = jax.nn.softmax(jnp.where(cmask, sc, NEG), axis=-1)
        p_c = jnp.where(cmask.any(-1)[:, None], p_c, 0.0)
        o_c = jnp.einsum('bhgqk,bhkd->bhgqd', p_c, vc_t)
        imp = jnp.einsum('bhgqc,cs->bhqs', p_c, overlap)
        svalid = (blk_ids * SLC_BLOCK)[None, :] <= tpos[:, None]
        dist = (tpos // SLC_BLOCK)[:, None] - blk_ids[None, :]
        forced = (blk_ids == 0)[None, :] | ((dist >= 0) & (dist < N_LOCAL))
        score = jnp.where(svalid & forced, FORCE, jnp.where(svalid, imp, -1.0))
        top_score, idx = lax.top_k(score, n_sel)
        sel_valid = top_score >= 0.0
        kb = ks_blk[b_idx, h_idx, idx]
        vb = vs_blk[b_idx, h_idx, idx]
        ss = jnp.einsum('bhgqd,bhqnkd->bhgqnk', qr, kb) * scale
        kpos = idx[..., None] * SLC_BLOCK + jnp.arange(SLC_BLOCK)
        smask = sel_valid[..., None] & (kpos <= tpos[:, None, None])
        ss = jnp.where(smask[:, :, None], ss, NEG)
        p_s = jax.nn.softmax(ss.reshape(B, Hk, G, QB, n_sel * SLC_BLOCK), axis=-1)
        p_s = p_s.reshape(B, Hk, G, QB, n_sel, SLC_BLOCK)
        o_s = jnp.einsum('bhgqnk,bhqnkd->bhgqd', p_s, vb)
        kwin = lax.dynamic_slice_in_dim(kw_pad, s0, WINDOW + QB, axis=2)
        vwin = lax.dynamic_slice_in_dim(vw_pad, s0, WINDOW + QB, axis=2)
        wpos = s0 - WINDOW + jnp.arange(WINDOW + QB)
        wmask = ((wpos[None, :] <= tpos[:, None]) & (wpos[None, :] > tpos[:, None] - WINDOW)
                 & (wpos[None, :] >= 0))
        sw = jnp.einsum('bhgqd,bhkd->bhgqk', qr, kwin) * scale
        p_w = jax.nn.softmax(jnp.where(wmask, sw, NEG), axis=-1)
        o_w = jnp.einsum('bhgqk,bhkd->bhgqd', p_w, vwin)
        return o_c, o_s, o_w

    o_c, o_s, o_w = lax.map(block, jnp.arange(S // QB))

    def to_bshd(o):
        return jnp.transpose(o, (1, 0, 4, 2, 3, 5)).reshape(B, S, H, dh)

    o = (gates[..., 0:1] * to_bshd(o_c) + gates[..., 1:2] * to_bshd(o_s)
         + gates[..., 2:3] * to_bshd(o_w))
    return o.reshape(B, S, H * dh).astype(h.dtype) @ w_out


def setup_inputs(seed: int = 0) -> dict:
    key = jax.random.key(seed)
    ks = jax.random.split(key, 26)
    f32 = jnp.float32
    D, F = D_MODEL, D_FF

    def nrm(k, shape, scale):
        return jax.random.normal(k, shape, f32) * scale

    def gain(k, shape):
        return 1.0 + 0.02 * jax.random.normal(k, shape, f32)

    gdn_in = 2 * GDN_HEADS * GDN_DK + 2 * GDN_HEADS * GDN_DV + 2 * GDN_HEADS
    nsa_in = NSA_HEADS * NSA_DH + 6 * NSA_KV_HEADS * NSA_DH + 3 * NSA_HEADS
    n_conv = 2 * GDN_HEADS * GDN_DK + GDN_HEADS * GDN_DV
    dt = jnp.exp(jax.random.uniform(ks[7], (N_GDN, GDN_HEADS), f32,
                                    minval=math.log(1e-3), maxval=math.log(1e-1)))
    return {
        "x": jax.random.normal(ks[0], (BATCH, SEQ, D), f32),
        "positions": jnp.broadcast_to(jnp.arange(SEQ, dtype=jnp.int32), (BATCH, SEQ)),
        "ffn_norm": gain(ks[1], (DEPTH, 2, D)),
        "ffn_w_gate_up": nrm(ks[2], (DEPTH, 2, D, 2 * F), D ** -0.5),
        "ffn_w_down": nrm(ks[3], (DEPTH, 2, F, D), F ** -0.5),
        "mixer_norm": gain(ks[4], (DEPTH, D)),
        "gdn_w_in": nrm(ks[5], (N_GDN, D, gdn_in), D ** -0.5),
        "gdn_conv_w": nrm(ks[6], (N_GDN, GDN_CONV, n_conv), GDN_CONV ** -0.5),
        "gdn_A_log": jnp.log(jax.random.uniform(ks[8], (N_GDN, GDN_HEADS), f32, minval=1.0, maxval=16.0)),
        "gdn_dt_bias": dt + jnp.log(-jnp.expm1(-dt)),
        "gdn_out_norm": gain(ks[9], (N_GDN, GDN_DV)),
        "gdn_w_out": nrm(ks[10], (N_GDN, GDN_HEADS * GDN_DV, D), (GDN_HEADS * GDN_DV) ** -0.5),
        "sc_w_in": nrm(ks[11], (N_SC, D, 3 * D), D ** -0.5),
        "sc_conv_w": nrm(ks[12], (N_SC, SC_WIDTH, D), SC_WIDTH ** -0.5),
        "sc_w_out": nrm(ks[13], (N_SC, D, D), D ** -0.5),
        "nsa_w_in": nrm(ks[14], (N_NSA, D, nsa_in), D ** -0.5),
        "nsa_q_norm": gain(ks[15], (N_NSA, NSA_DH)),
        "nsa_k_norm": gain(ks[16], (N_NSA, 3, NSA_DH)),
        "nsa_cmp_pe": nrm(ks[17], (N_NSA, 2, CMP_BLOCK, NSA_DH), 0.02),
        "nsa_cmp_w1": nrm(ks[18], (N_NSA, 2, CMP_BLOCK * NSA_DH, CMP_HIDDEN), (CMP_BLOCK * NSA_DH) ** -0.5),
        "nsa_cmp_b1": nrm(ks[19], (N_NSA, 2, CMP_HIDDEN), 0.01),
        "nsa_cmp_w2": nrm(ks[20], (N_NSA, 2, CMP_HIDDEN, NSA_DH), CMP_HIDDEN ** -0.5),
        "nsa_cmp_b2": nrm(ks[21], (N_NSA, 2, NSA_DH), 0.01),
        "nsa_w_out": nrm(ks[22], (N_NSA, NSA_HEADS * NSA_DH, D), (NSA_HEADS * NSA_DH) ** -0.5),
    }


def reference(x, positions, ffn_norm, ffn_w_gate_up, ffn_w_down, mixer_norm,
              gdn_w_in, gdn_conv_w, gdn_A_log, gdn_dt_bias, gdn_out_norm, gdn_w_out,
              sc_w_in, sc_conv_w, sc_w_out,
              nsa_w_in, nsa_q_norm, nsa_k_norm, nsa_cmp_pe, nsa_cmp_w1, nsa_cmp_b1,
              nsa_cmp_w2, nsa_cmp_b2, nsa_w_out):
    cos, sin = rope_tables(positions, NSA_DH)
    h = x
    for layer in range(DEPTH):
        h = h + 0.5 * swiglu(rmsnorm(h, ffn_norm[layer, 0]), ffn_w_gate_up[layer, 0], ffn_w_down[layer, 0])
        hn = rmsnorm(h, mixer_norm[layer])
        kind = layer % N_MIXERS
        j = layer // N_MIXERS
        if kind == 0:
            mix = gdn_mixer(hn, gdn_w_in[j], gdn_conv_w[j], gdn_A_log[j], gdn_dt_bias[j],
                            gdn_out_norm[j], gdn_w_out[j])
        elif kind == 1:
            mix = short_conv_mixer(hn, sc_w_in[j], sc_conv_w[j], sc_w_out[j])
        else:
            mix = nsa_mixer(hn, cos, sin, nsa_w_in[j], nsa_q_norm[j], nsa_k_norm[j], nsa_cmp_pe[j],
                            nsa_cmp_w1[j], nsa_cmp_b1[j], nsa_cmp_w2[j], nsa_cmp_b2[j], nsa_w_out[j])
        h = h + mix
        h = h + 0.5 * swiglu(rmsnorm(h, ffn_norm[layer, 1]), ffn_w_gate_up[layer, 1], ffn_w_down[layer, 1])
    return h
```

```cpp
#include <hip/hip_runtime.h>
#include <hip/hip_cooperative_groups.h>
#include <cstdio>
#include <cstdint>
namespace cg = cooperative_groups;
namespace pg8 {
#define PG8_LAS __attribute__((address_space(3)))
typedef unsigned short bf16_t;
typedef short bf16x8 __attribute__((ext_vector_type(8)));
typedef float f32x4 __attribute__((ext_vector_type(4)));
typedef unsigned u32x4 __attribute__((ext_vector_type(4)));
constexpr int BM = 256, BK = 64, HALF = 128, HTB = HALF * BK * 2  , STAGE_BYTES = 8 * HTB, NXCD = 8, WGM = 8;

__host__ __device__ __forceinline__ int lds_byte(int r, int c) { const int st = (r >> 4) * 2 + (c >> 5), rr = r & 15, cc = c & 31, ob = rr * 64 + cc * 2; return st * 1024 + (ob ^ (((ob >> 9) & 1) << 5)); }
__host__ __device__ __forceinline__ void stage_rc(int b, int& R, int& C) { const int st = b / 1024, sb = b % 1024, swz = sb ^ (((sb >> 9) & 1) << 5); R = (st >> 1) * 16 + swz / 64; C = (st & 1) * 32 + (swz % 64) / 2; }
__host__ __device__ __forceinline__ int perm32(int rho) { const int n = rho >> 4, i = rho & 15; return 8 * (i >> 2) + 4 * n + (i & 3); }

struct Unit { int pm, pn; };
struct Gemm { const bf16_t* A; const bf16_t* Bt; int M, N, K; };

struct StaticOrder {
    int nM, nN, nwg, G, c;
    __host__ __device__ void init(int M, int N, int G_, int c_) { nM = M / BM; nN = N / BM; nwg = nM * nN; G = G_; c = c_; }
    __host__ __device__ bool next(int i, Unit& u) const {
        const long L = (long)i * G + c; if (L >= nwg) return false;
        int wgid = (int)L; { const int q = nwg / NXCD, r = nwg % NXCD, xcd = wgid % NXCD, off = wgid / NXCD; wgid = (xcd < r ? xcd * (q + 1) : r * (q + 1) + (xcd - r) * q) + off; }
        const int nig = WGM * nN, gid = wgid / nig, fm = gid * WGM, gsz = (nM - fm) < WGM ? (nM - fm) : WGM;
        u.pm = fm + ((wgid % nig) % gsz); u.pn = (wgid % nig) / gsz; return true;
    }
    __device__ __forceinline__ void a_ready(const Unit&) const {}
    __device__ __forceinline__ void done(const Unit&) const {}
};
__device__ __forceinline__ unsigned cvt_pk_bf16(float lo, float hi) { unsigned r; asm volatile("v_cvt_pk_bf16_f32 %0, %1, %2" : "=v"(r) : "v"(lo), "v"(hi)); return r; }
template <class Epi, class Sched, bool ALIGN_EPI = false, bool SP2 = false>
__device__ __forceinline__ void gemm_phase(PG8_LAS unsigned char* lds, const Gemm g, const Sched& S, const Epi& E) {
    const int tid = threadIdx.x, wid = __builtin_amdgcn_readfirstlane(tid >> 6), lane = tid & 63, wr = wid >> 2, wc = wid & 3, fr = lane & 15, fq = lane >> 4;
    const int K = g.K, nt = K / BK;
    unsigned voffA[2], voffB[2];
#pragma unroll
    for (int i = 0; i < 2; ++i) { int R, C; stage_rc(tid * 16 + i * 8192, R, C); const int Rb = Epi::PERM ? ((R & ~31) + perm32(R & 31)) : R;
        voffA[i] = (unsigned)(R * K + C) * 2u; voffB[i] = (unsigned)(Rb * K + C) * 2u; }
    const size_t kstep = (size_t)(BK * 2);
    const size_t hstep = (size_t)HALF * K * 2;
    const size_t tstep = 2 * hstep;
    const unsigned ldsw = (unsigned)wid * 1024u;
    const int aoff = lds_byte(wr * 64 + fr, fq * 8), boff = lds_byte(wc * 32 + fr, fq * 8);
#define PG8_SA(b, h) (((b) * 2 + (h)) * HTB)
#define PG8_SB(b, h) ((4 + (b) * 2 + (h)) * HTB)
#define PG8_STAGE(bufoff, gbase, voff) do { _Pragma("unroll") for (int _i = 0; _i < 2; ++_i) \
        __builtin_amdgcn_global_load_lds((const unsigned*)((const char*)(gbase) + (voff)[_i]), (PG8_LAS unsigned*)(lds + (bufoff) + ldsw + _i * 8192), 16, 0, 0); } while (0)
#define PG8_LDA(dst, b, h) do { _Pragma("unroll") for (int m = 0; m < 4; ++m) _Pragma("unroll") for (int k = 0; k < 2; ++k) dst[m][k] = *(const PG8_LAS bf16x8*)(lds + PG8_SA(b, h) + aoff + m * 2048 + k * 1024); } while (0)
#define PG8_LDB(dst, b, h) do { _Pragma("unroll") for (int n = 0; n < 2; ++n) _Pragma("unroll") for (int k = 0; k < 2; ++k) dst[n][k] = *(const PG8_LAS bf16x8*)(lds + PG8_SB(b, h) + boff + n * 2048 + k * 1024); } while (0)
#define PG8_MMA(ai, bj, At, Bt) do { __builtin_amdgcn_s_setprio(1); _Pragma("unroll") for (int m = 0; m < 4; ++m) _Pragma("unroll") for (int n = 0; n < 2; ++n) _Pragma("unroll") for (int k = 0; k < 2; ++k) \
        acc[ai][bj][m][n] = __builtin_amdgcn_mfma_f32_16x16x32_bf16(Bt[n][k], At[m][k], acc[ai][bj][m][n], 0, 0, 0); __builtin_amdgcn_s_setprio(0); } while (0)
#define PG8_WAIT_V(n) asm volatile("s_waitcnt vmcnt(" #n ")" ::: "memory")
#define PG8_WAIT_L(n) asm volatile("s_waitcnt lgkmcnt(" #n ")" ::: "memory")
#define PG8_BAR __builtin_amdgcn_s_barrier()
#define PG8_SCHED __builtin_amdgcn_sched_barrier(0)
    Unit cur, nxt; int ui = 0;
    if (!S.next(0, cur)) return;
    f32x4 acc[2][2][4][2];
#pragma unroll
    for (int a = 0; a < 2; ++a)
#pragma unroll
        for (int b = 0; b < 2; ++b)
#pragma unroll
            for (int m = 0; m < 4; ++m)
#pragma unroll
                for (int n = 0; n < 2; ++n) acc[a][b][m][n] = (f32x4){0.f, 0.f, 0.f, 0.f};
    bf16x8 At[4][2], B0[2][2], B1[2][2];
    const char* cA = (const char*)g.A + (size_t)cur.pm * tstep; const char* cB = (const char*)g.Bt + (size_t)cur.pn * tstep;
    S.a_ready(cur);
    if constexpr (SP2) {
        PG8_STAGE(PG8_SB(0, 0), cB, voffB); PG8_STAGE(PG8_SB(0, 1), cB + hstep, voffB); PG8_STAGE(PG8_SA(0, 0), cA, voffA); PG8_STAGE(PG8_SA(0, 1), cA + hstep, voffA);
        if (wr == 1) PG8_BAR;
        PG8_WAIT_V(2); PG8_BAR;
        PG8_STAGE(PG8_SB(1, 0), cB + kstep, voffB); PG8_STAGE(PG8_SA(1, 0), cA + kstep, voffA); PG8_STAGE(PG8_SB(1, 1), cB + hstep + kstep, voffB);
        PG8_WAIT_V(6); PG8_BAR;
    } else {
        PG8_STAGE(PG8_SB(0, 0), cB, voffB); PG8_STAGE(PG8_SA(0, 0), cA, voffA); PG8_STAGE(PG8_SB(0, 1), cB + hstep, voffB); PG8_STAGE(PG8_SA(0, 1), cA + hstep, voffA);
        if (wr == 1) PG8_BAR;
        PG8_WAIT_V(4); PG8_BAR;
        PG8_STAGE(PG8_SB(1, 0), cB + kstep, voffB); PG8_STAGE(PG8_SA(1, 0), cA + kstep, voffA); PG8_STAGE(PG8_SB(1, 1), cB + hstep + kstep, voffB);
        PG8_WAIT_V(6); PG8_BAR;
    }
    for (;;) {
        const bool has_next = S.next(ui + 1, nxt);
        const char* nA = has_next ? (const char*)g.A + (size_t)nxt.pm * tstep : cA; const char* nB = has_next ? (const char*)g.Bt + (size_t)nxt.pn * tstep : cB;
        for (int t = 0; t < nt; t += 2) {
            const bool last = (t == nt - 2);
            const char* a1 = cA + (size_t)(t + 1) * kstep;
            const char* a2 = last ? nA : cA + (size_t)(t + 2) * kstep; const char* b2 = last ? nB : cB + (size_t)(t + 2) * kstep;
            const char* a3 = a2 + kstep; const char* b3 = b2 + kstep;
            if (last && has_next) S.a_ready(nxt);
            if constexpr (SP2) {
            PG8_LDB(B0, 0, 0); PG8_LDB(B1, 0, 1); PG8_SCHED; PG8_LDA(At, 0, 0); PG8_STAGE(PG8_SA(1, 1), a1 + hstep, voffA);
            PG8_WAIT_V(8); PG8_WAIT_L(0); PG8_BAR; PG8_MMA(0, 0, At, B0); PG8_MMA(0, 1, At, B1); PG8_BAR; PG8_SCHED;
            PG8_LDA(At, 0, 1); PG8_STAGE(PG8_SB(0, 0), b2, voffB); PG8_STAGE(PG8_SB(0, 1), b2 + hstep, voffB); PG8_STAGE(PG8_SA(0, 0), a2, voffA);
            PG8_WAIT_V(8); PG8_WAIT_L(0); PG8_BAR; PG8_MMA(1, 0, At, B0); PG8_MMA(1, 1, At, B1); PG8_BAR; PG8_SCHED;
            PG8_LDB(B0, 1, 0); PG8_LDB(B1, 1, 1); PG8_SCHED; PG8_LDA(At, 1, 0); PG8_STAGE(PG8_SA(0, 1), a2 + hstep, voffA);
            PG8_WAIT_V(8); PG8_WAIT_L(0); PG8_BAR; PG8_MMA(0, 0, At, B0); PG8_MMA(0, 1, At, B1); PG8_BAR; PG8_SCHED;
            PG8_LDA(At, 1, 1); PG8_STAGE(PG8_SB(1, 0), b3, voffB); PG8_STAGE(PG8_SB(1, 1), b3 + hstep, voffB); PG8_STAGE(PG8_SA(1, 0), a3, voffA);
            PG8_WAIT_V(8); PG8_WAIT_L(0); PG8_BAR; PG8_MMA(1, 0, At, B0); PG8_MMA(1, 1, At, B1); PG8_BAR; PG8_SCHED;
            } else {
            PG8_LDB(B0, 0, 0); PG8_SCHED; PG8_LDA(At, 0, 0); PG8_STAGE(PG8_SA(1, 1), a1 + hstep, voffA);
            PG8_WAIT_L(8); PG8_BAR; PG8_WAIT_L(0); PG8_MMA(0, 0, At, B0); PG8_BAR; PG8_SCHED;
            PG8_LDB(B1, 0, 1); PG8_STAGE(PG8_SB(0, 0), b2, voffB);
            PG8_BAR; PG8_WAIT_L(0); PG8_MMA(0, 1, At, B1); PG8_BAR;
            PG8_LDA(At, 0, 1); PG8_STAGE(PG8_SA(0, 0), a2, voffA);
            PG8_BAR; PG8_WAIT_L(0); PG8_MMA(1, 0, At, B0); PG8_BAR; PG8_SCHED;
            PG8_STAGE(PG8_SB(0, 1), b2 + hstep, voffB);
            PG8_WAIT_V(6); PG8_BAR; PG8_MMA(1, 1, At, B1); PG8_BAR;
            PG8_LDB(B0, 1, 0); PG8_SCHED; PG8_LDA(At, 1, 0); PG8_STAGE(PG8_SA(0, 1), a2 + hstep, voffA);
            PG8_WAIT_L(8); PG8_BAR; PG8_WAIT_L(0); PG8_MMA(0, 0, At, B0); PG8_BAR; PG8_SCHED;
            PG8_LDB(B1, 1, 1); PG8_STAGE(PG8_SB(1, 0), b3, voffB);
            PG8_BAR; PG8_WAIT_L(0); PG8_MMA(0, 1, At, B1); PG8_BAR;
            PG8_LDA(At, 1, 1); PG8_STAGE(PG8_SA(1, 0), a3, voffA);
            PG8_BAR; PG8_WAIT_L(0); PG8_MMA(1, 0, At, B0); PG8_BAR; PG8_SCHED;
            PG8_STAGE(PG8_SB(1, 1), b3 + hstep, voffB);
            PG8_WAIT_V(6); PG8_BAR; PG8_MMA(1, 1, At, B1); PG8_BAR;
            }
        }
        if constexpr (ALIGN_EPI) { if (wr == 0) PG8_BAR; }
        if constexpr (!Epi::AFTER_DRAIN) { E(acc, cur, wr, wc, fr, fq); S.done(cur); }
        if (!has_next) break;
#pragma unroll
        for (int a = 0; a < 2; ++a)
#pragma unroll
            for (int b = 0; b < 2; ++b)
#pragma unroll
                for (int m = 0; m < 4; ++m)
#pragma unroll
                    for (int n = 0; n < 2; ++n) acc[a][b][m][n] = (f32x4){0.f, 0.f, 0.f, 0.f};
        cur = nxt; cA = nA; cB = nB; ++ui;
        if constexpr (ALIGN_EPI) { if (wr == 1) PG8_BAR; }
    }
    PG8_WAIT_V(0);
    if constexpr (!ALIGN_EPI) { if (wr == 0) PG8_BAR; }
    PG8_BAR;
    if constexpr (Epi::AFTER_DRAIN) { E.fused(acc, cur, wr, wc, fr, fq, lds, wid, lane); S.done(cur); }
#undef PG8_SA
#undef PG8_SB
#undef PG8_STAGE
#undef PG8_LDA
#undef PG8_LDB
#undef PG8_MMA
#undef PG8_WAIT_V
#undef PG8_WAIT_L
#undef PG8_BAR
#undef PG8_SCHED
}
}

typedef unsigned short bf16;
typedef float f32x4 __attribute__((ext_vector_type(4)));
typedef float f32x2 __attribute__((ext_vector_type(2)));
typedef unsigned u32x4 __attribute__((ext_vector_type(4)));
typedef unsigned u32x2 __attribute__((ext_vector_type(2)));

#ifndef MK_MULTI
#define MK_MULTI 1
#endif

constexpr int Bn = 8, S = 4096, T = Bn * S, D = 1024, FF = 2816, DEPTH = 4;
constexpr float EPS = 1e-6f;
constexpr int GDN_NPAD = 4352, NSA_NPAD = 2816;
constexpr int LDS_BYTES = 147456;
constexpr size_t MiB = 1u << 20;
constexpr size_t WS_WGU = 1 * MiB;
constexpr size_t WS_WDN = WS_WGU + 88 * MiB;
constexpr size_t WS_WGI = WS_WDN + 44 * MiB;
constexpr size_t WS_WGO = WS_WGI + 17 * MiB;
constexpr size_t WS_WSI = WS_WGO + 4 * MiB;
constexpr size_t WS_WSO = WS_WSI + 6 * MiB;
constexpr size_t WS_WNI = WS_WSO + 2 * MiB;
constexpr size_t WS_WNO = WS_WNI + 6 * MiB;
constexpr size_t WS_WC1 = WS_WNO + 2 * MiB;
constexpr size_t WS_TAB = WS_WC1 + 2 * MiB;
constexpr size_t WS_HN  = 184 * MiB;
constexpr size_t WS_R   = WS_HN + 64 * MiB;
constexpr size_t WS_O32 = WS_R + 256 * MiB;
constexpr size_t WS_SM  = WS_O32 + 128 * MiB;
constexpr size_t WS_AB  = WS_SM;
constexpr size_t WS_GT  = WS_SM + 2 * MiB;
constexpr size_t WS_BP  = WS_SM + 8 * MiB;
constexpr size_t WS_END = WS_SM + 9 * MiB;
static_assert(WS_TAB + 8 * MiB <= WS_HN, "ws map");

__device__ __forceinline__ float bf2f(unsigned v) { return __uint_as_float(v << 16); }
__device__ __forceinline__ unsigned f2bf(float f) { unsigned u = __float_as_uint(f); return (u + 0x7fffu + ((u >> 16) & 1u)) >> 16; }
__device__ __forceinline__ unsigned pk2(float lo, float hi) { return f2bf(lo) | (f2bf(hi) << 16); }
__device__ __forceinline__ float wave_sum(float v) {
#pragma unroll
    for (int o = 1; o < 64; o <<= 1) v += __shfl_xor(v, o);
    return v;
}
__device__ __forceinline__ float wave_max(float v) {
#pragma unroll
    for (int o = 1; o < 64; o <<= 1) v = fmaxf(v, __shfl_xor(v, o));
    return v;
}
__device__ __forceinline__ float row_sum16(float v) {
#pragma unroll
    for (int o = 1; o < 16; o <<= 1) v += __shfl_xor(v, o);
    return v;
}
__device__ __forceinline__ float sigmoidf_(float x) { return 1.f / (1.f + __expf(-x)); }
__device__ __forceinline__ float siluf_(float x) { return x / (1.f + __expf(-x)); }
#define WAVE_SYNC() do { asm volatile("s_waitcnt lgkmcnt(0)" ::: "memory"); __builtin_amdgcn_wave_barrier(); } while (0)

namespace pg8 {
struct EpiSwiGLU {
    static constexpr bool PERM = true, AFTER_DRAIN = false;
    bf16_t* O;
    __device__ __forceinline__ void operator()(const f32x4 (&acc)[2][2][4][2], const Unit& u, int wr, int wc, int fr, int fq) const {
        const int row0 = u.pm * BM + wr * 64 + fr, col0 = u.pn * HALF + wc * 32 + 8 * fq;
#pragma unroll
        for (int ai = 0; ai < 2; ++ai)
#pragma unroll
            for (int m = 0; m < 4; ++m) {
                bf16_t* rowp = O + (size_t)(row0 + ai * HALF + m * 16) * FF + col0;
                float v[8];
#pragma unroll
                for (int n = 0; n < 2; ++n)
#pragma unroll
                    for (int j = 0; j < 4; ++j) { const float g = acc[ai][0][m][n][j], uu = acc[ai][1][m][n][j]; v[n * 4 + j] = g * __builtin_amdgcn_rcpf(1.f + __expf(-g)) * uu; }
                u32x4 w; w.x = cvt_pk_bf16(v[0], v[1]); w.y = cvt_pk_bf16(v[2], v[3]); w.z = cvt_pk_bf16(v[4], v[5]); w.w = cvt_pk_bf16(v[6], v[7]);
                *(u32x4*)rowp = w;
            }
    }
};
struct EpiResid {
    static constexpr bool PERM = false, AFTER_DRAIN = false;
    const float* base; float* out; float scale;
    __device__ __forceinline__ void operator()(const f32x4 (&acc)[2][2][4][2], const Unit& u, int wr, int wc, int fr, int fq) const {
        const int row0 = u.pm * BM + wr * 64 + fr, col0 = u.pn * BM + wc * 32 + 4 * fq;
#pragma unroll
        for (int ai = 0; ai < 2; ++ai)
#pragma unroll
            for (int m = 0; m < 4; ++m) {
                const size_t off = (size_t)(row0 + ai * HALF + m * 16) * D + col0;
#pragma unroll
                for (int bj = 0; bj < 2; ++bj)
#pragma unroll
                    for (int n = 0; n < 2; ++n) { const f32x4 bs = *(const f32x4*)(base + off + bj * HALF + n * 16); *(f32x4*)(out + off + bj * HALF + n * 16) = bs + acc[ai][bj][m][n] * scale; }
                asm volatile("" ::: "memory");
            }
    }
};
struct EpiProj {
    static constexpr bool PERM = true, AFTER_DRAIN = false;
    bf16_t* O; int ldc; int nmain; float* tail; int ldt; int nvalid;
    __device__ __forceinline__ void operator()(const f32x4 (&acc)[2][2][4][2], const Unit& u, int wr, int wc, int fr, int fq) const {
        const int row0 = u.pm * BM + wr * 64 + fr, colt = u.pn * BM, col0 = colt + wc * 32 + 8 * fq;
        if (colt + BM <= nmain) {
#pragma unroll
            for (int ai = 0; ai < 2; ++ai)
#pragma unroll
                for (int m = 0; m < 4; ++m) {
                    bf16_t* rowp = O + (size_t)(row0 + ai * HALF + m * 16) * ldc + col0;
#pragma unroll
                    for (int bj = 0; bj < 2; ++bj) { const f32x4 v0 = acc[ai][bj][m][0], v1 = acc[ai][bj][m][1];
                        u32x4 w; w.x = cvt_pk_bf16(v0[0], v0[1]); w.y = cvt_pk_bf16(v0[2], v0[3]); w.z = cvt_pk_bf16(v1[0], v1[1]); w.w = cvt_pk_bf16(v1[2], v1[3]);
                        *(u32x4*)(rowp + bj * HALF) = w; }
                }
        } else {
#pragma unroll
            for (int ai = 0; ai < 2; ++ai)
#pragma unroll
                for (int m = 0; m < 4; ++m) {
                    const size_t row = (size_t)(row0 + ai * HALF + m * 16);
#pragma unroll
                    for (int bj = 0; bj < 2; ++bj)
#pragma unroll
                        for (int n = 0; n < 2; ++n)
#pragma unroll
                            for (int j = 0; j < 4; ++j) { const int col = col0 + bj * HALF + 4 * n + j; if (col >= nmain && col < nvalid) tail[row * ldt + (col - nmain)] = acc[ai][bj][m][n][j]; }
                }
        }
    }
};
struct EpiF32 {
    static constexpr bool PERM = false, AFTER_DRAIN = false;
    float* C; int ldc;
    __device__ __forceinline__ void operator()(const f32x4 (&acc)[2][2][4][2], const Unit& u, int wr, int wc, int fr, int fq) const {
        const int row0 = u.pm * BM + wr * 64 + fr, col0 = u.pn * BM + wc * 32 + 4 * fq;
#pragma unroll
        for (int ai = 0; ai < 2; ++ai)
#pragma unroll
            for (int m = 0; m < 4; ++m) {
                float* rowp = C + (size_t)(row0 + ai * HALF + m * 16) * ldc + col0;
#pragma unroll
                for (int bj = 0; bj < 2; ++bj)
#pragma unroll
                    for (int n = 0; n < 2; ++n) *(f32x4*)(rowp + bj * HALF + n * 16) = acc[ai][bj][m][n];
            }
    }
};
}

__device__ __forceinline__ void xpose_item(const float* W, int K, int N, bf16* WT, int rowbase, float* scr, int k0, int n0, int lane) {
#pragma unroll 8
    for (int i = 0; i < 32; ++i) { const int kk = 2 * i + (lane >> 5), n = n0 + (lane & 31); scr[kk * 33 + (lane & 31)] = n < N ? W[(size_t)(k0 + kk) * N + n] : 0.f; }
    WAVE_SYNC();
    const int c = lane & 7;
#pragma unroll
    for (int j = 0; j < 4; ++j) { const int n = (lane >> 3) + 8 * j; const float* s = scr + (8 * c) * 33 + n;
        u32x4 o; o.x = pk2(s[0 * 33], s[1 * 33]); o.y = pk2(s[2 * 33], s[3 * 33]); o.z = pk2(s[4 * 33], s[5 * 33]); o.w = pk2(s[6 * 33], s[7 * 33]);
        *(u32x4*)(WT + (size_t)(rowbase + n) * K + k0 + 8 * c) = o; }
    WAVE_SYNC();
}
__device__ __forceinline__ void xpose_matrix(const float* W, int K, int N, int Npad, bf16* WT, int mode, float* scr, int gw, int NGW, int lane) {
    const int nblk = Npad / 32, nitems = (K / 64) * nblk;
    for (int it = gw; it < nitems; it += NGW) {
        const int kb = it / nblk, nb = it - kb * nblk, n0 = nb * 32;
        int rb = n0;
        if (mode == 1) rb = (n0 < FF) ? ((n0 >> 7) * 256 + (n0 & 127)) : ((((n0 - FF) >> 7) * 256) + 128 + ((n0 - FF) & 127));
        xpose_item(W, K, N, WT, rb, scr, kb * 64, n0, lane);
    }
}

__device__ __forceinline__ void phase_norm(const float* h, const float* w, bf16* out, int gw, int NGW, int lane) {
    f32x4 wv[4];
#pragma unroll
    for (int j = 0; j < 4; ++j) wv[j] = ((const f32x4*)w)[64 * j + lane];
    for (int m = gw; m < T; m += NGW) {
        const f32x4* xr = (const f32x4*)(h + (size_t)m * D) + lane;
        f32x4 v[4]; float s = 0.f;
#pragma unroll
        for (int j = 0; j < 4; ++j) { v[j] = xr[64 * j]; s += (v[j].x * v[j].x + v[j].y * v[j].y) + (v[j].z * v[j].z + v[j].w * v[j].w); }
        const float rstd = 1.f / sqrtf(wave_sum(s) * (1.f / D) + EPS);
        u32x2* o8 = (u32x2*)(out + (size_t)m * D) + lane;
#pragma unroll
        for (int j = 0; j < 4; ++j) { u32x2 o; o.x = pk2(v[j].x * rstd * wv[j].x, v[j].y * rstd * wv[j].y); o.y = pk2(v[j].z * rstd * wv[j].z, v[j].w * rstd * wv[j].w); o8[64 * j] = o; }
    }
}

__device__ __forceinline__ void phase_gdn_scan(unsigned char* lds, const bf16* proj, const float* ab, const float* convw, const float* A_log, const float* dt_bias,
                                               float* o32, int vblk, int nblk, int tid, int wid, int lane) {
    float* qs = (float*)lds;
    float* ks = qs + 64 * 128;
    float* vs = ks + 64 * 128;
    float* al = vs + 64 * 32;
    float* be = al + 64;
    float* os = be + 64;
    const int e = tid >> 4, dl = tid & 15;
    for (int item = vblk; item < 256; item += nblk) {
        const int bh = (item & 7) + 8 * (item >> 5), es = (item >> 3) & 3, b = bh >> 3, h = bh & 7;
        const float Ah = __expf(A_log[h]), dtb = dt_bias[h];
        float St[8];
#pragma unroll
        for (int i = 0; i < 8; ++i) St[i] = 0.f;
        for (int chunk = 0; chunk < S / 64; ++chunk) {
            const int t0 = chunk * 64;
            __syncthreads();
            for (int idx = tid; idx < 64 * 36; idx += 512) {
                const int tok = idx / 36, cgp = idx - tok * 36;
                int col; float* dst;
                if (cgp < 16) { col = h * 128 + cgp * 8; dst = qs + tok * 128 + cgp * 8; }
                else if (cgp < 32) { col = 1024 + h * 128 + (cgp - 16) * 8; dst = ks + tok * 128 + (cgp - 16) * 8; }
                else { col = 2048 + h * 128 + es * 32 + (cgp - 32) * 8; dst = vs + tok * 32 + (cgp - 32) * 8; }
                float a8[8];
#pragma unroll
                for (int i = 0; i < 8; ++i) a8[i] = 0.f;
#pragma unroll
                for (int j = 0; j < 4; ++j) {
                    const int ts = t0 + tok - 3 + j;
                    if (ts >= 0) {
                        const u32x4 xv = *(const u32x4*)(proj + (size_t)(b * S + ts) * 4096 + col);
                        const f32x4 w0 = *(const f32x4*)(convw + j * 3072 + col), w1 = *(const f32x4*)(convw + j * 3072 + col + 4);
                        a8[0] += bf2f(xv.x & 0xffffu) * w0.x; a8[1] += bf2f(xv.x >> 16) * w0.y; a8[2] += bf2f(xv.y & 0xffffu) * w0.z; a8[3] += bf2f(xv.y >> 16) * w0.w;
                        a8[4] += bf2f(xv.z & 0xffffu) * w1.x; a8[5] += bf2f(xv.z >> 16) * w1.y; a8[6] += bf2f(xv.w & 0xffffu) * w1.z; a8[7] += bf2f(xv.w >> 16) * w1.w;
                    }
                }
#pragma unroll
                for (int i = 0; i < 8; ++i) dst[i] = siluf_(a8[i]);
            }
            if (tid < 64) {
                const size_t tg = (size_t)(b * S + t0 + tid);
                const float a = ab[tg * 16 + h] + dtb, bb = ab[tg * 16 + 8 + h];
                const float sp = a > 20.f ? a : log1pf(__expf(a));
                al[tid] = __expf(-Ah * sp); be[tid] = sigmoidf_(bb);
            }
            __syncthreads();
#pragma unroll 4
            for (int r = 0; r < 16; ++r) {
                const int row = wid * 16 + r;
                float* p = row < 64 ? qs + row * 128 : ks + (row - 64) * 128;
                const float x0 = p[lane], x1 = p[lane + 64];
                const float ss = wave_sum(x0 * x0 + x1 * x1);
                const float sc = (1.f / sqrtf(ss + EPS)) * (row < 64 ? 0.08838834764831845f : 1.f);
                p[lane] = x0 * sc; p[lane + 64] = x1 * sc;
            }
            __syncthreads();
            for (int tt = 0; tt < 64; ++tt) {
                const f32x4 k0 = *(const f32x4*)(ks + tt * 128 + dl * 8), k1 = *(const f32x4*)(ks + tt * 128 + dl * 8 + 4);
                const f32x4 q0 = *(const f32x4*)(qs + tt * 128 + dl * 8), q1 = *(const f32x4*)(qs + tt * 128 + dl * 8 + 4);
                const float v = vs[tt * 32 + e], a = al[tt], bt = be[tt];
                float p = (k0.x * St[0] + k0.y * St[1]) + (k0.z * St[2] + k0.w * St[3]) + (k1.x * St[4] + k1.y * St[5]) + (k1.z * St[6] + k1.w * St[7]);
                p = row_sum16(p);
                const float vn = bt * (v - a * p);
                St[0] = a * St[0] + k0.x * vn; St[1] = a * St[1] + k0.y * vn; St[2] = a * St[2] + k0.z * vn; St[3] = a * St[3] + k0.w * vn;
                St[4] = a * St[4] + k1.x * vn; St[5] = a * St[5] + k1.y * vn; St[6] = a * St[6] + k1.z * vn; St[7] = a * St[7] + k1.w * vn;
                float o = (q0.x * St[0] + q0.y * St[1]) + (q0.z * St[2] + q0.w * St[3]) + (q1.x * St[4] + q1.y * St[5]) + (q1.z * St[6] + q1.w * St[7]);
                o = row_sum16(o);
                if (dl == 0) os[tt * 32 + e] = o;
            }
            __syncthreads();
            { const int tok = tid >> 3, c4 = tid & 7;
              *(f32x4*)(o32 + (size_t)(b * S + t0 + tok) * D + h * 128 + es * 32 + c4 * 4) = *(const f32x4*)(os + tok * 32 + c4 * 4); }
        }
    }
}
__device__ __forceinline__ void phase_gdn_post(const float* o32, const bf16* proj, const float* onorm, bf16* hn, int gw, int NGW, int lane) {
    const f32x4 wv = *(const f32x4*)(onorm + ((4 * lane) & 127));
    for (int m = gw; m < T; m += NGW) {
        const f32x4* xr = (const f32x4*)(o32 + (size_t)m * D) + lane;
        const u32x2* gr = (const u32x2*)(proj + (size_t)m * 4096 + 3072) + lane;
        u32x2* o8 = (u32x2*)(hn + (size_t)m * D) + lane;
#pragma unroll
        for (int j = 0; j < 4; ++j) {
            const f32x4 v = xr[64 * j]; const u32x2 g = gr[64 * j];
            float s = (v.x * v.x + v.y * v.y) + (v.z * v.z + v.w * v.w);
#pragma unroll
            for (int o = 1; o < 32; o <<= 1) s += __shfl_xor(s, o);
            const float rstd = 1.f / sqrtf(s * (1.f / 128.f) + EPS);
            u32x2 o; o.x = pk2(v.x * rstd * wv.x * siluf_(bf2f(g.x & 0xffffu)), v.y * rstd * wv.y * siluf_(bf2f(g.x >> 16)));
            o.y = pk2(v.z * rstd * wv.z * siluf_(bf2f(g.y & 0xffffu)), v.w * rstd * wv.w * siluf_(bf2f(g.y >> 16)));
            o8[64 * j] = o;
        }
    }
}
__device__ __forceinline__ void phase_sc_post(const bf16* proj, const float* cw, bf16* hn, int gtid, int NT) {
    for (int idx = gtid; idx < T * 128; idx += NT) {
        const int m = idx >> 7, c8 = (idx & 127) * 8, s = m & (S - 1);
        float y[8];
#pragma unroll
        for (int i = 0; i < 8; ++i) y[i] = 0.f;
#pragma unroll
        for (int j = 0; j < 3; ++j) {
            if (s - 2 + j >= 0) {
                const bf16* pr = proj + (size_t)(m - 2 + j) * 3072;
                const u32x4 cv = *(const u32x4*)(pr + 1024 + c8), xv = *(const u32x4*)(pr + 2048 + c8);
                const f32x4 w0 = *(const f32x4*)(cw + j * 1024 + c8), w1 = *(const f32x4*)(cw + j * 1024 + c8 + 4);
                y[0] += w0.x * bf2f(cv.x & 0xffffu) * bf2f(xv.x & 0xffffu); y[1] += w0.y * bf2f(cv.x >> 16) * bf2f(xv.x >> 16);
                y[2] += w0.z * bf2f(cv.y & 0xffffu) * bf2f(xv.y & 0xffffu); y[3] += w0.w * bf2f(cv.y >> 16) * bf2f(xv.y >> 16);
                y[4] += w1.x * bf2f(cv.z & 0xffffu) * bf2f(xv.z & 0xffffu); y[5] += w1.y * bf2f(cv.z >> 16) * bf2f(xv.z >> 16);
                y[6] += w1.z * bf2f(cv.w & 0xffffu) * bf2f(xv.w & 0xffffu); y[7] += w1.w * bf2f(cv.w >> 16) * bf2f(xv.w >> 16);
            }
        }
        const u32x4 bv = *(const u32x4*)(proj + (size_t)m * 3072 + c8);
        u32x4 o;
        o.x = pk2(y[0] * bf2f(bv.x & 0xffffu), y[1] * bf2f(bv.x >> 16)); o.y = pk2(y[2] * bf2f(bv.y & 0xffffu), y[3] * bf2f(bv.y >> 16));
        o.z = pk2(y[4] * bf2f(bv.z & 0xffffu), y[5] * bf2f(bv.z >> 16)); o.w = pk2(y[6] * bf2f(bv.w & 0xffffu), y[7] * bf2f(bv.w >> 16));
        *(u32x4*)(hn + (size_t)m * D + c8) = o;
    }
}
__device__ __forceinline__ void phase_nsa_post(const bf16* proj, const float* qnorm, const float* knorm, const f32x2* tab,
                                               bf16* QN, bf16* KS, bf16* KW, bf16* KCH, bf16* VCH, int gw, int NGW, int lane) {
    const float qw = qnorm[lane], kw1 = knorm[64 + lane], kw2 = knorm[128 + lane];
    for (int m = gw; m < T; m += NGW) {
        const int b = m >> 12, s = m & (S - 1);
        const bf16* pr = proj + (size_t)m * 2560;
        const f32x2 cs = tab[(size_t)m * 32 + (lane & 31)];
#pragma unroll 4
        for (int hh = 0; hh < 16; ++hh) {
            const float x = bf2f(pr[hh * 64 + lane]);
            const float ss = wave_sum(x * x);
            QN[((size_t)(b * 16 + hh) * S + s) * 64 + lane] = (bf16)f2bf(x * (1.f / sqrtf(ss * (1.f / 64.f) + EPS)) * qw);
        }
#pragma unroll
        for (int hk = 0; hk < 4; ++hk) {
            const size_t o = ((size_t)(b * 4 + hk) * S + s) * 64 + lane;
            { const float x = bf2f(pr[1536 + hk * 64 + lane]); const float ss = wave_sum(x * x);
              const float y = x * (1.f / sqrtf(ss * (1.f / 64.f) + EPS)) * kw1; const float yp = __shfl_xor(y, 32);
              KS[o] = (bf16)f2bf(y * cs.x + (lane < 32 ? -yp : yp) * cs.y); }
            { const float x = bf2f(pr[2048 + hk * 64 + lane]); const float ss = wave_sum(x * x);
              const float y = x * (1.f / sqrtf(ss * (1.f / 64.f) + EPS)) * kw2; const float yp = __shfl_xor(y, 32);
              KW[o] = (bf16)f2bf(y * cs.x + (lane < 32 ? -yp : yp) * cs.y); }
            KCH[o] = pr[1024 + hk * 64 + lane];
            VCH[o] = pr[1280 + hk * 64 + lane];
        }
    }
}
__device__ __forceinline__ void phase_cmp2(unsigned char* lds, const float* Pk, const float* Pv, const float* biasp, const float* w2, const float* b2, const float* knorm0,
                                           float* KC, float* VC, int gw, int NGW, int wid, int lane) {
    float* hs = (float*)lds + wid * 256;
    for (int item = gw; item < 2 * 32 * 256; item += NGW) {
        const int i = item & 255, bh = (item >> 8) & 31, kind = item >> 13;
        float* outp = (kind ? VC : KC) + ((size_t)bh * 256 + i) * 64 + lane;
        if (i == 255) { *outp = 0.f; continue; }
        const float* P = kind ? Pv : Pk;
        const float* r0 = P + ((size_t)bh * 256 + i) * 512; const float* r1 = r0 + 512 + 256;
#pragma unroll
        for (int j = 0; j < 4; ++j) { const int n = lane + 64 * j; const float x = r0[n] + r1[n] + biasp[kind * 256 + n];
            const float uu = 0.7978845608028654f * (x + 0.044715f * x * x * x);
            const float th = 1.f - 2.f / (1.f + __expf(2.f * uu));
            hs[n] = 0.5f * x * (1.f + th); }
        WAVE_SYNC();
        float acc = b2[kind * 64 + lane];
        const float* w = w2 + (size_t)kind * 256 * 64 + lane;
#pragma unroll 8
        for (int n = 0; n < 256; ++n) acc += hs[n] * w[n * 64];
        if (kind == 0) { const float ss = wave_sum(acc * acc); acc = acc * (1.f / sqrtf(ss * (1.f / 64.f) + EPS)) * knorm0[lane]; }
        *outp = acc;
        WAVE_SYNC();
    }
}
__device__ __forceinline__ void attend_chunk(const bf16* Krow, bool valid, const bf16* Vb, int vstride, int nk, const float* q_s, float* p_s,
                                             float (&m)[4], float (&l)[4], float (&o)[4], int lane) {
    float s[4] = {0.f, 0.f, 0.f, 0.f};
    const u32x4* kr = (const u32x4*)Krow;
#pragma unroll
    for (int c = 0; c < 8; ++c) {
        const u32x4 kk = kr[c];
        const float k0 = bf2f(kk.x & 0xffffu), k1 = bf2f(kk.x >> 16), k2 = bf2f(kk.y & 0xffffu), k3 = bf2f(kk.y >> 16), k4 = bf2f(kk.z & 0xffffu), k5 = bf2f(kk.z >> 16), k6 = bf2f(kk.w & 0xffffu), k7 = bf2f(kk.w >> 16);
#pragma unroll
        for (int g = 0; g < 4; ++g) { const f32x4 qa = *(const f32x4*)(q_s + g * 64 + c * 8), qb = *(const f32x4*)(q_s + g * 64 + c * 8 + 4);
            s[g] += (k0 * qa.x + k1 * qa.y) + (k2 * qa.z + k3 * qa.w) + (k4 * qb.x + k5 * qb.y) + (k6 * qb.z + k7 * qb.w); }
    }
#pragma unroll
    for (int g = 0; g < 4; ++g) {
        const float sg = valid ? s[g] : -1e30f;
        const float mn = fmaxf(m[g], wave_max(sg));
        const float corr = __expf(m[g] - mn);
        const float p = valid ? __expf(sg - mn) : 0.f;
        l[g] = l[g] * corr + wave_sum(p); m[g] = mn; o[g] *= corr;
        p_s[g * 64 + lane] = p;
    }
    WAVE_SYNC();
    for (int k = 0; k < nk; ++k) {
        const float v = bf2f(Vb[(size_t)k * vstride]);
        o[0] += p_s[k] * v; o[1] += p_s[64 + k] * v; o[2] += p_s[128 + k] * v; o[3] += p_s[192 + k] * v;
    }
    WAVE_SYNC();
}
__device__ __forceinline__ void phase_nsa_attn(unsigned char* lds, const bf16* proj, const bf16* QN, const bf16* KS, const bf16* KW, const float* KC, const float* VC,
                                               const float* gates, const f32x2* tab, bf16* hn, int gw, int NGW, int wid, int lane) {
    float* wl = (float*)(lds + wid * 6144);
    float* qn_s = wl; float* qr_s = wl + 256; float* p_s = wl + 512;
    for (int item = gw; item < Bn * 4 * S; item += NGW) {
        const int t = item & (S - 1), hk = (item >> 12) & 3, b = item >> 14;
        const size_t tok = (size_t)b * S + t;
        const f32x2 cs = tab[tok * 32 + (lane & 31)];
#pragma unroll
        for (int g = 0; g < 4; ++g) {
            const float x = bf2f(QN[((size_t)(b * 16 + hk * 4 + g) * S + t) * 64 + lane]) * 0.125f;
            const float xp = __shfl_xor(x, 32);
            qn_s[g * 64 + lane] = x; qr_s[g * 64 + lane] = x * cs.x + (lane < 32 ? -xp : xp) * cs.y;
        }
        WAVE_SYNC();
        float oc[4] = {0.f, 0.f, 0.f, 0.f}; float imp = 0.f;
        const int nv = t >= 31 ? ((t - 31) >> 4) + 1 : 0;
        if (nv > 0) {
            const float* kcb = KC + (size_t)(b * 4 + hk) * 256 * 64;
            float sc[4][4];
#pragma unroll
            for (int kk = 0; kk < 4; ++kk)
#pragma unroll
                for (int g = 0; g < 4; ++g) sc[kk][g] = -1e30f;
            const int nkk = (nv + 63) >> 6;
#pragma unroll
            for (int kk = 0; kk < 4; ++kk) {
                if (kk < nkk) {
                    const int i = lane + 64 * kk, ii = i < nv ? i : nv - 1;
                    const f32x4* kr = (const f32x4*)(kcb + (size_t)ii * 64);
                    float a0 = 0.f, a1 = 0.f, a2 = 0.f, a3 = 0.f;
#pragma unroll 4
                    for (int dc = 0; dc < 16; ++dc) {
                        const f32x4 kv = kr[dc];
                        const f32x4 q0 = *(const f32x4*)(qn_s + dc * 4), q1 = *(const f32x4*)(qn_s + 64 + dc * 4), q2 = *(const f32x4*)(qn_s + 128 + dc * 4), q3 = *(const f32x4*)(qn_s + 192 + dc * 4);
                        a0 += (kv.x * q0.x + kv.y * q0.y) + (kv.z * q0.z + kv.w * q0.w);
                        a1 += (kv.x * q1.x + kv.y * q1.y) + (kv.z * q1.z + kv.w * q1.w);
                        a2 += (kv.x * q2.x + kv.y * q2.y) + (kv.z * q2.z + kv.w * q2.w);
                        a3 += (kv.x * q3.x + kv.y * q3.y) + (kv.z * q3.z + kv.w * q3.w);
                    }
                    if (i < nv) { sc[kk][0] = a0; sc[kk][1] = a1; sc[kk][2] = a2; sc[kk][3] = a3; }
                }
            }
#pragma unroll
            for (int g = 0; g < 4; ++g) {
                float mx = fmaxf(fmaxf(sc[0][g], sc[1][g]), fmaxf(sc[2][g], sc[3][g]));
                mx = wave_max(mx);
                float sum = 0.f;
#pragma unroll
                for (int kk = 0; kk < 4; ++kk) { const float p = (lane + 64 * kk < nv) ? __expf(sc[kk][g] - mx) : 0.f; sc[kk][g] = p; sum += p; }
                sum = wave_sum(sum);
                const float inv = 1.f / sum;
#pragma unroll
                for (int kk = 0; kk < 4; ++kk) p_s[g * 256 + lane + 64 * kk] = sc[kk][g] * inv;
            }
            WAVE_SYNC();
            const float* vcb = VC + (size_t)(b * 4 + hk) * 256 * 64 + lane;
            for (int i = 0; i < nv; ++i) {
                const float v = vcb[(size_t)i * 64];
                oc[0] += p_s[i] * v; oc[1] += p_s[256 + i] * v; oc[2] += p_s[512 + i] * v; oc[3] += p_s[768 + i] * v;
            }
#pragma unroll
            for (int g = 0; g < 4; ++g) {
                const f32x4 pv = *(const f32x4*)(p_s + g * 256 + 4 * lane);
                const float pm1 = lane > 0 ? p_s[g * 256 + 4 * lane - 1] : 0.f;
                imp += pv.x + pv.y + pv.z + 0.5f * pv.w + 0.5f * pm1;
            }
            WAVE_SYNC();
        }
        const int cur = t >> 6;
        const bool sv = lane <= cur, forced = (lane == 0) || (lane == cur) || (lane + 1 == cur);
        const float score = sv ? (forced ? 1e9f : imp) : -1.f;
        int rank = 0;
#pragma unroll
        for (int i = 0; i < 64; ++i) { const float si = __uint_as_float(__builtin_amdgcn_readlane(__float_as_uint(score), i)); rank += (si > score || (si == score && i < lane)) ? 1 : 0; }
        const bool sel = (rank < 16) && (score >= 0.f);
        unsigned long long mask = __ballot(sel);
        float m1[4] = {-1e30f, -1e30f, -1e30f, -1e30f}, l1[4] = {0.f, 0.f, 0.f, 0.f}, o1[4] = {0.f, 0.f, 0.f, 0.f};
        while (mask) {
            const int j = __builtin_ctzll(mask); mask &= mask - 1;
            const int key = 64 * j + lane, keyc = key <= t ? key : t;
            const int nk = (t - 64 * j + 1) < 64 ? (t - 64 * j + 1) : 64;
            attend_chunk(KS + ((size_t)(b * 4 + hk) * S + keyc) * 64, key <= t, proj + ((size_t)b * S + 64 * j) * 2560 + 1792 + hk * 64 + lane, 2560, nk, qr_s, p_s, m1, l1, o1, lane);
        }
        float m2[4] = {-1e30f, -1e30f, -1e30f, -1e30f}, l2[4] = {0.f, 0.f, 0.f, 0.f}, o2[4] = {0.f, 0.f, 0.f, 0.f};
        for (int k0 = (t - 511 > 0 ? t - 511 : 0); k0 <= t; k0 += 64) {
            const int key = k0 + lane, keyc = key <= t ? key : t;
            const int nk = (t - k0 + 1) < 64 ? (t - k0 + 1) : 64;
            attend_chunk(KW + ((size_t)(b * 4 + hk) * S + keyc) * 64, key <= t, proj + ((size_t)b * S + k0) * 2560 + 2304 + hk * 64 + lane, 2560, nk, qr_s, p_s, m2, l2, o2, lane);
        }
#pragma unroll
        for (int g = 0; g < 4; ++g) {
            const float* gp = gates + tok * 48 + (hk * 4 + g) * 3;
            const float r = sigmoidf_(gp[0]) * oc[g] + sigmoidf_(gp[1]) * (o1[g] / l1[g]) + sigmoidf_(gp[2]) * (o2[g] / l2[g]);
            hn[tok * D + (hk * 4 + g) * 64 + lane] = (bf16)f2bf(r);
        }
    }
}

struct Args { const void* in[24]; float* out; unsigned char* ws; int lo, hi; };

__host__ __device__ constexpr int mixer_inner_phases(int kind) { return kind == 0 ? 2 : (kind == 1 ? 1 : 4); }
__host__ __device__ constexpr int total_phases() { int n = 1; for (int L = 0; L < DEPTH; ++L) n += 6 + 3 + mixer_inner_phases(L % 3); return n; }

__global__ void __launch_bounds__(512, 2) mega(Args args) {
    extern __shared__ __attribute__((aligned(16))) unsigned char lds[];
    cg::grid_group grid = cg::this_grid();
    for (int ph = args.lo; ph < args.hi; ++ph) {
        int type = 0, s = 0, L = 0;
        if (ph > 0) {
            int p = ph - 1;
            for (L = 0; L < DEPTH; ++L) { const int n = 9 + mixer_inner_phases(L % 3); if (p < n) break; p -= n; }
            const int inner = mixer_inner_phases(L % 3), kind = L % 3;
            if (p < 3) { type = 1 + p; s = 2 * L; }
            else if (p == 3) type = 4;
            else if (p == 4) type = 5;
            else if (p < 5 + inner) { const int q = p - 5; type = kind == 0 ? 6 + q : (kind == 1 ? 8 : 9 + q); }
            else if (p == 5 + inner) type = 13;
            else { type = 1 + (p - 6 - inner); s = 2 * L + 1; }
        }
        int tid_ = threadIdx.x; asm volatile("" : "+v"(tid_));
        int G_ = gridDim.x, bx_ = blockIdx.x; asm volatile("" : "+s"(G_), "+s"(bx_));
        const int tid = tid_, lane = tid & 63, wid = __builtin_amdgcn_readfirstlane(tid >> 6);
        const int G = G_, bx = bx_;
        const int vcu = (G % 8 == 0) ? (bx % 8) * (G / 8) + bx / 8 : bx;
        const int gw = vcu * 8 + wid, NGW = G * 8;
        unsigned char* ws = args.ws; asm volatile("" : "+s"(ws));
        PG8_LAS unsigned char* ldsl = (PG8_LAS unsigned char*)lds;
        float* hout = args.out; asm volatile("" : "+s"(hout));
        bf16* HN = (bf16*)(ws + WS_HN);
        bf16* RB = (bf16*)(ws + WS_R);
        f32x2* tab = (f32x2*)(ws + WS_TAB);
        const int kind = L % 3, jj = L / 3;
        bf16* QN = RB + (size_t)T * 2560;
        bf16* KSb = QN + (size_t)T * 1024;
        bf16* KWb = KSb + (size_t)T * 256;
        bf16* KCH = (bf16*)(ws + WS_O32);
        bf16* VCH = KCH + (size_t)T * 256;
        float* Pk = (float*)(ws + WS_O32 + 32 * MiB);
        float* Pv = Pk + (size_t)8192 * 512;
        float* KC = (float*)(ws + WS_O32 + 64 * MiB);
        float* VC = KC + (size_t)32 * 256 * 64;
        switch (type) {
        case 0: {
            float* scr = (float*)lds + wid * (64 * 33);
            for (int mi = 0; mi < 28; ++mi) {
                const float* W; int K, N, Npad, mode = 0; bf16* WT;
                if (mi < 8)       { W = (const float*)args.in[3] + (size_t)mi * D * 2 * FF; K = D; N = 2 * FF; Npad = N; mode = 1; WT = (bf16*)(ws + WS_WGU) + (size_t)mi * 2 * FF * D; }
                else if (mi < 16) { const int i = mi - 8; W = (const float*)args.in[4] + (size_t)i * FF * D; K = FF; N = D; Npad = N; WT = (bf16*)(ws + WS_WDN) + (size_t)i * D * FF; }
                else if (mi < 18) { const int i = mi - 16; W = (const float*)args.in[6] + (size_t)i * D * 4112; K = D; N = 4112; Npad = GDN_NPAD; WT = (bf16*)(ws + WS_WGI) + (size_t)i * GDN_NPAD * D; }
                else if (mi < 20) { const int i = mi - 18; W = (const float*)args.in[11] + (size_t)i * D * D; K = D; N = D; Npad = N; WT = (bf16*)(ws + WS_WGO) + (size_t)i * D * D; }
                else if (mi == 20) { W = (const float*)args.in[12]; K = D; N = 3072; Npad = N; WT = (bf16*)(ws + WS_WSI); }
                else if (mi == 21) { W = (const float*)args.in[14]; K = D; N = D; Npad = N; WT = (bf16*)(ws + WS_WSO); }
                else if (mi == 22) { W = (const float*)args.in[15]; K = D; N = 2608; Npad = NSA_NPAD; WT = (bf16*)(ws + WS_WNI); }
                else if (mi == 23) { W = (const float*)args.in[23]; K = D; N = D; Npad = N; WT = (bf16*)(ws + WS_WNO); }
                else { const int i = mi - 24, kd = i >> 1, hf = i & 1;
                    W = (const float*)args.in[19] + (size_t)kd * 2048 * 256 + (size_t)hf * 1024 * 256; K = 1024; N = 256; Npad = 256; WT = (bf16*)(ws + WS_WC1) + (size_t)kd * 512 * 1024 + (size_t)hf * 256 * 1024; }
                xpose_matrix(W, K, N, Npad, WT, mode, scr, gw, NGW, lane);
            }
            const int* positions = (const int*)args.in[1];
            for (int idx = bx * 512 + tid; idx < T * 32; idx += G * 512) {
                const int tk = idx >> 5, i = idx & 31;
                const float inv = 1.0f / exp2f((float)(2 * i) * (13.287712379549449f / 64.f));
                const float ang = (float)positions[tk] * inv;
                const double rev = (double)ang * 0.15915494309189535;
                const float fr = (float)(rev - rint(rev));
                f32x2 v; v.x = __builtin_amdgcn_cosf(fr); v.y = __builtin_amdgcn_sinf(fr);
                tab[idx] = v;
            }
            if (bx < 2 && tid < 256) {
                const float* pe = (const float*)args.in[18] + (size_t)bx * 2048;
                const float* w1 = (const float*)args.in[19] + (size_t)bx * 2048 * 256 + tid;
                float acc = ((const float*)args.in[20])[bx * 256 + tid];
                for (int k = 0; k < 2048; ++k) acc += pe[k] * w1[(size_t)k * 256];
                ((float*)(ws + WS_BP))[bx * 256 + tid] = acc;
            }
        } break;
        case 1: phase_norm(s == 0 ? (const float*)args.in[0] : hout, (const float*)args.in[2] + (size_t)s * D, HN, gw, NGW, lane); break;
        case 2: {
            pg8::Gemm g{HN, (const bf16*)(ws + WS_WGU) + (size_t)s * 2 * FF * D, T, 2 * FF, D}; pg8::StaticOrder SO; SO.init(T, 2 * FF, G, bx);
            pg8::EpiSwiGLU E{RB};
            pg8::gemm_phase<pg8::EpiSwiGLU, pg8::StaticOrder, true, true>(ldsl, g, SO, E); } break;
        case 3: {
            pg8::Gemm g{RB, (const bf16*)(ws + WS_WDN) + (size_t)s * D * FF, T, D, FF}; pg8::StaticOrder SO; SO.init(T, D, G, bx);
            pg8::EpiResid E{s == 0 ? (const float*)args.in[0] : hout, hout, 0.5f};
            pg8::gemm_phase<pg8::EpiResid, pg8::StaticOrder, true, true>(ldsl, g, SO, E); } break;
        case 4: phase_norm(hout, (const float*)args.in[5] + (size_t)L * D, HN, gw, NGW, lane); break;
        case 5: {
            const bf16* Wt; int Np, ldc, nmain, ldt, nvalid; float* tail;
            if (kind == 0) { Wt = (const bf16*)(ws + WS_WGI) + (size_t)jj * GDN_NPAD * D; Np = GDN_NPAD; ldc = 4096; nmain = 4096; tail = (float*)(ws + WS_AB); ldt = 16; nvalid = 4112; }
            else if (kind == 1) { Wt = (const bf16*)(ws + WS_WSI); Np = 3072; ldc = 3072; nmain = 3072; tail = (float*)(ws + WS_AB); ldt = 16; nvalid = 3072; }
            else { Wt = (const bf16*)(ws + WS_WNI); Np = NSA_NPAD; ldc = 2560; nmain = 2560; tail = (float*)(ws + WS_GT); ldt = 48; nvalid = 2608; }
            pg8::Gemm g{HN, Wt, T, Np, D}; pg8::StaticOrder SO; SO.init(T, Np, G, bx);
            pg8::EpiProj E{RB, ldc, nmain, tail, ldt, nvalid};
            pg8::gemm_phase<pg8::EpiProj, pg8::StaticOrder, true, true>(ldsl, g, SO, E); } break;
        case 6:
#ifndef DIS_SCAN
            phase_gdn_scan(lds, RB, (const float*)(ws + WS_AB), (const float*)args.in[7] + (size_t)jj * 4 * 3072, (const float*)args.in[8] + jj * 8, (const float*)args.in[9] + jj * 8,
                           (float*)(ws + WS_O32), bx, G, tid, wid, lane);
#endif
            break;
        case 7:
#ifndef DIS_GPOST
            phase_gdn_post((const float*)(ws + WS_O32), RB, (const float*)args.in[10] + jj * 128, HN, gw, NGW, lane);
#endif
            break;
        case 8:
#ifndef DIS_SPOST
            phase_sc_post(RB, (const float*)args.in[13], HN, vcu * 512 + tid, G * 512);
#endif
            break;
        case 9:
#ifndef DIS_NPOST
            phase_nsa_post(RB, (const float*)args.in[16], (const float*)args.in[17], tab, QN, KSb, KWb, KCH, VCH, gw, NGW, lane);
#endif
            break;
        case 10: {
            pg8::Gemm g{KCH, (const bf16*)(ws + WS_WC1), 8192, 512, 1024}; pg8::StaticOrder SO; SO.init(8192, 512, G, bx);
            pg8::Gemm g2{VCH, (const bf16*)(ws + WS_WC1) + (size_t)512 * 1024, 8192, 512, 1024};
            pg8::EpiF32 E{Pk, 512};
            if (bx >= G / 2) { g = g2; SO.init(8192, 512, G, bx - G / 2); E.C = Pv; }
            pg8::gemm_phase<pg8::EpiF32, pg8::StaticOrder, true, true>(ldsl, g, SO, E); } break;
        case 11:
#ifndef DIS_CMP2
            phase_cmp2(lds, Pk, Pv, (const float*)(ws + WS_BP), (const float*)args.in[21], (const float*)args.in[22], (const float*)args.in[17], KC, VC, gw, NGW, wid, lane);
#endif
            break;
        case 12:
#ifndef DIS_ATTN
            phase_nsa_attn(lds, RB, QN, KSb, KWb, KC, VC, (const float*)(ws + WS_GT), tab, HN, gw, NGW, wid, lane);
#endif
            break;
        default: {
            const bf16* Wout = kind == 0 ? (const bf16*)(ws + WS_WGO) + (size_t)jj * D * D : (kind == 1 ? (const bf16*)(ws + WS_WSO) : (const bf16*)(ws + WS_WNO));
            pg8::Gemm g{HN, Wout, T, D, D}; pg8::StaticOrder SO; SO.init(T, D, G, bx);
            pg8::EpiResid E{hout, hout, 1.0f};
            pg8::gemm_phase<pg8::EpiResid, pg8::StaticOrder, true, true>(ldsl, g, SO, E); } break;
        }
        if (ph + 1 < args.hi) grid.sync();
    }
}

extern "C" void kernel_launch(void* const* d_in, const int* in_sizes, int n_in, void* d_out, int out_size, void* d_ws, size_t ws_size, hipStream_t stream) {
    static int grid = 0;
    if (grid == 0) {
        if (n_in != 24 || out_size != T * D || ws_size < WS_END) { fprintf(stderr, "kernel_launch: unexpected shapes n_in %d out %d ws %zu (need %zu)\n", n_in, out_size, ws_size, (size_t)WS_END); grid = -1; return; }
        int dev = 0, cus = 0, per_cu = 0;
        hipGetDevice(&dev); hipDeviceGetAttribute(&cus, hipDeviceAttributeMultiprocessorCount, dev);
        if (hipFuncSetAttribute((const void*)mega, hipFuncAttributeMaxDynamicSharedMemorySize, LDS_BYTES) != hipSuccess) { fprintf(stderr, "kernel_launch: hipFuncSetAttribute failed\n"); grid = -1; return; }
        if (hipOccupancyMaxActiveBlocksPerMultiprocessor(&per_cu, (const void*)mega, 512, LDS_BYTES) != hipSuccess || per_cu < 1) { fprintf(stderr, "kernel_launch: occupancy query says %d\n", per_cu); per_cu = 1; }
        (void)hipGetLastError();
        grid = cus;
    }
    if (grid < 0) return;
    Args a{};
    for (int i = 0; i < 24; ++i) a.in[i] = d_in[i];
    a.out = (float*)d_out; a.ws = (unsigned char*)d_ws;
    constexpr int NPH = total_phases();
#if MK_MULTI
    for (int p = 0; p < NPH; ++p) { a.lo = p; a.hi = p + 1; hipLaunchKernelGGL(mega, dim3(grid), dim3(512), LDS_BYTES, stream, a); }
#else
    a.lo = 0; a.hi = NPH;
    void* kargs[] = {&a};
    hipError_t e = hipLaunchCooperativeKernel((const void*)mega, dim3(grid), dim3(512), kargs, LDS_BYTES, stream);
    if (e != hipSuccess) fprintf(stderr, "cooperative launch failed: %s (grid %d)\n", hipGetErrorString(e), grid);
#endif
}
```

```cpp
#include <hip/hip_runtime.h>
#include <hip/hip_cooperative_groups.h>
#include <cstdio>
#include <cstdint>
namespace cg = cooperative_groups;
namespace pg8 {
#define PG8_LAS __attribute__((address_space(3)))
typedef unsigned short bf16_t;
typedef short bf16x8 __attribute__((ext_vector_type(8)));
typedef float f32x4 __attribute__((ext_vector_type(4)));
typedef unsigned u32x4 __attribute__((ext_vector_type(4)));
constexpr int BM = 256, BK = 64, HALF = 128, HTB = HALF * BK * 2  , STAGE_BYTES = 8 * HTB, NXCD = 8, WGM = 8;

__host__ __device__ __forceinline__ int lds_byte(int r, int c) { const int st = (r >> 4) * 2 + (c >> 5), rr = r & 15, cc = c & 31, ob = rr * 64 + cc * 2; return st * 1024 + (ob ^ (((ob >> 9) & 1) << 5)); }
__host__ __device__ __forceinline__ void stage_rc(int b, int& R, int& C) { const int st = b / 1024, sb = b % 1024, swz = sb ^ (((sb >> 9) & 1) << 5); R = (st >> 1) * 16 + swz / 64; C = (st & 1) * 32 + (swz % 64) / 2; }
__host__ __device__ __forceinline__ int perm32(int rho) { const int n = rho >> 4, i = rho & 15; return 8 * (i >> 2) + 4 * n + (i & 3); }

struct Unit { int pm, pn; };
struct Gemm { const bf16_t* A; const bf16_t* Bt; int M, N, K; };

struct StaticOrder {
    int nM, nN, nwg, G, c;
    __host__ __device__ void init(int M, int N, int G_, int c_) { nM = M / BM; nN = N / BM; nwg = nM * nN; G = G_; c = c_; }
    __host__ __device__ bool next(int i, Unit& u) const {
        const long L = (long)i * G + c; if (L >= nwg) return false;
        int wgid = (int)L; { const int q = nwg / NXCD, r = nwg % NXCD, xcd = wgid % NXCD, off = wgid / NXCD; wgid = (xcd < r ? xcd * (q + 1) : r * (q + 1) + (xcd - r) * q) + off; }
        const int nig = WGM * nN, gid = wgid / nig, fm = gid * WGM, gsz = (nM - fm) < WGM ? (nM - fm) : WGM;
        u.pm = fm + ((wgid % nig) % gsz); u.pn = (wgid % nig) / gsz; return true;
    }
    __device__ __forceinline__ void a_ready(const Unit&) const {}
    __device__ __forceinline__ void done(const Unit&) const {}
};
__device__ __forceinline__ unsigned cvt_pk_bf16(float lo, float hi) { unsigned r; asm volatile("v_cvt_pk_bf16_f32 %0, %1, %2" : "=v"(r) : "v"(lo), "v"(hi)); return r; }
template <class Epi, class Sched, bool ALIGN_EPI = false, bool SP2 = false>
__device__ __forceinline__ void gemm_phase(PG8_LAS unsigned char* lds, const Gemm g, const Sched& S, const Epi& E) {
    const int tid = threadIdx.x, wid = __builtin_amdgcn_readfirstlane(tid >> 6), lane = tid & 63, wr = wid >> 2, wc = wid & 3, fr = lane & 15, fq = lane >> 4;
    const int K = g.K, nt = K / BK;
    unsigned voffA[2], voffB[2];
#pragma unroll
    for (int i = 0; i < 2; ++i) { int R, C; stage_rc(tid * 16 + i * 8192, R, C); const int Rb = Epi::PERM ? ((R & ~31) + perm32(R & 31)) : R;
        voffA[i] = (unsigned)(R * K + C) * 2u; voffB[i] = (unsigned)(Rb * K + C) * 2u; }
    const size_t kstep = (size_t)(BK * 2);
    const size_t hstep = (size_t)HALF * K * 2;
    const size_t tstep = 2 * hstep;
    const unsigned ldsw = (unsigned)wid * 1024u;
    const int aoff = lds_byte(wr * 64 + fr, fq * 8), boff = lds_byte(wc * 32 + fr, fq * 8);
#define PG8_SA(b, h) (((b) * 2 + (h)) * HTB)
#define PG8_SB(b, h) ((4 + (b) * 2 + (h)) * HTB)
#define PG8_STAGE(bufoff, gbase, voff) do { _Pragma("unroll") for (int _i = 0; _i < 2; ++_i) \
        __builtin_amdgcn_global_load_lds((const unsigned*)((const char*)(gbase) + (voff)[_i]), (PG8_LAS unsigned*)(lds + (bufoff) + ldsw + _i * 8192), 16, 0, 0); } while (0)
#define PG8_LDA(dst, b, h) do { _Pragma("unroll") for (int m = 0; m < 4; ++m) _Pragma("unroll") for (int k = 0; k < 2; ++k) dst[m][k] = *(const PG8_LAS bf16x8*)(lds + PG8_SA(b, h) + aoff + m * 2048 + k * 1024); } while (0)
#define PG8_LDB(dst, b, h) do { _Pragma("unroll") for (int n = 0; n < 2; ++n) _Pragma("unroll") for (int k = 0; k < 2; ++k) dst[n][k] = *(const PG8_LAS bf16x8*)(lds + PG8_SB(b, h) + boff + n * 2048 + k * 1024); } while (0)
#define PG8_MMA(ai, bj, At, Bt) do { __builtin_amdgcn_s_setprio(1); _Pragma("unroll") for (int m = 0; m < 4; ++m) _Pragma("unroll") for (int n = 0; n < 2; ++n) _Pragma("unroll") for (int k = 0; k < 2; ++k) \
        acc[ai][bj][m][n] = __builtin_amdgcn_mfma_f32_16x16x32_bf16(Bt[n][k], At[m][k], acc[ai][bj][m][n], 0, 0, 0); __builtin_amdgcn_s_setprio(0); } while (0)
#define PG8_WAIT_V(n) asm volatile("s_waitcnt vmcnt(" #n ")" ::: "memory")
#define PG8_WAIT_L(n) asm volatile("s_waitcnt lgkmcnt(" #n ")" ::: "memory")
#define PG8_BAR __builtin_amdgcn_s_barrier()
#define PG8_SCHED __builtin_amdgcn_sched_barrier(0)
    Unit cur, nxt; int ui = 0;
    if (!S.next(0, cur)) return;
    f32x4 acc[2][2][4][2];
#pragma unroll
    for (int a = 0; a < 2; ++a)
#pragma unroll
        for (int b = 0; b < 2; ++b)
#pragma unroll
            for (int m = 0; m < 4; ++m)
#pragma unroll
                for (int n = 0; n < 2; ++n) acc[a][b][m][n] = (f32x4){0.f, 0.f, 0.f, 0.f};
    bf16x8 At[4][2], B0[2][2], B1[2][2];
    const char* cA = (const char*)g.A + (size_t)cur.pm * tstep; const char* cB = (const char*)g.Bt + (size_t)cur.pn * tstep;
    S.a_ready(cur);
    if constexpr (SP2) {
        PG8_STAGE(PG8_SB(0, 0), cB, voffB); PG8_STAGE(PG8_SB(0, 1), cB + hstep, voffB); PG8_STAGE(PG8_SA(0, 0), cA, voffA); PG8_STAGE(PG8_SA(0, 1), cA + hstep, voffA);
        if (wr == 1) PG8_BAR;
        PG8_WAIT_V(2); PG8_BAR;
        PG8_STAGE(PG8_SB(1, 0), cB + kstep, voffB); PG8_STAGE(PG8_SA(1, 0), cA + kstep, voffA); PG8_STAGE(PG8_SB(1, 1), cB + hstep + kstep, voffB);
        PG8_WAIT_V(6); PG8_BAR;
    } else {
        PG8_STAGE(PG8_SB(0, 0), cB, voffB); PG8_STAGE(PG8_SA(0, 0), cA, voffA); PG8_STAGE(PG8_SB(0, 1), cB + hstep, voffB); PG8_STAGE(PG8_SA(0, 1), cA + hstep, voffA);
        if (wr == 1) PG8_BAR;
        PG8_WAIT_V(4); PG8_BAR;
        PG8_STAGE(PG8_SB(1, 0), cB + kstep, voffB); PG8_STAGE(PG8_SA(1, 0), cA + kstep, voffA); PG8_STAGE(PG8_SB(1, 1), cB + hstep + kstep, voffB);
        PG8_WAIT_V(6); PG8_BAR;
    }
    for (;;) {
        const bool has_next = S.next(ui + 1, nxt);
        const char* nA = has_next ? (const char*)g.A + (size_t)nxt.pm * tstep : cA; const char* nB = has_next ? (const char*)g.Bt + (size_t)nxt.pn * tstep : cB;
        for (int t = 0; t < nt; t += 2) {
            const bool last = (t == nt - 2);
            const char* a1 = cA + (size_t)(t + 1) * kstep;
            const char* a2 = last ? nA : cA + (size_t)(t + 2) * kstep; const char* b2 = last ? nB : cB + (size_t)(t + 2) * kstep;
            const char* a3 = a2 + kstep; const char* b3 = b2 + kstep;
            if (last && has_next) S.a_ready(nxt);
            if constexpr (SP2) {
            PG8_LDB(B0, 0, 0); PG8_LDB(B1, 0, 1); PG8_SCHED; PG8_LDA(At, 0, 0); PG8_STAGE(PG8_SA(1, 1), a1 + hstep, voffA);
            PG8_WAIT_V(8); PG8_WAIT_L(0); PG8_BAR; PG8_MMA(0, 0, At, B0); PG8_MMA(0, 1, At, B1); PG8_BAR; PG8_SCHED;
            PG8_LDA(At, 0, 1); PG8_STAGE(PG8_SB(0, 0), b2, voffB); PG8_STAGE(PG8_SB(0, 1), b2 + hstep, voffB); PG8_STAGE(PG8_SA(0, 0), a2, voffA);
            PG8_WAIT_V(8); PG8_WAIT_L(0); PG8_BAR; PG8_MMA(1, 0, At, B0); PG8_MMA(1, 1, At, B1); PG8_BAR; PG8_SCHED;
            PG8_LDB(B0, 1, 0); PG8_LDB(B1, 1, 1); PG8_SCHED; PG8_LDA(At, 1, 0); PG8_STAGE(PG8_SA(0, 1), a2 + hstep, voffA);
            PG8_WAIT_V(8); PG8_WAIT_L(0); PG8_BAR; PG8_MMA(0, 0, At, B0); PG8_MMA(0, 1, At, B1); PG8_BAR; PG8_SCHED;
            PG8_LDA(At, 1, 1); PG8_STAGE(PG8_SB(1, 0), b3, voffB); PG8_STAGE(PG8_SB(1, 1), b3 + hstep, voffB); PG8_STAGE(PG8_SA(1, 0), a3, voffA);
            PG8_WAIT_V(8); PG8_WAIT_L(0); PG8_BAR; PG8_MMA(1, 0, At, B0); PG8_MMA(1, 1, At, B1); PG8_BAR; PG8_SCHED;
            } else {
            PG8_LDB(B0, 0, 0); PG8_SCHED; PG8_LDA(At, 0, 0); PG8_STAGE(PG8_SA(1, 1), a1 + hstep, voffA);
            PG8_WAIT_L(8); PG8_BAR; PG8_WAIT_L(0); PG8_MMA(0, 0, At, B0); PG8_BAR; PG8_SCHED;
            PG8_LDB(B1, 0, 1); PG8_STAGE(PG8_SB(0, 0), b2, voffB);
            PG8_BAR; PG8_WAIT_L(0); PG8_MMA(0, 1, At, B1); PG8_BAR;
            PG8_LDA(At, 0, 1); PG8_STAGE(PG8_SA(0, 0), a2, voffA);
            PG8_BAR; PG8_WAIT_L(0); PG8_MMA(1, 0, At, B0); PG8_BAR; PG8_SCHED;
            PG8_STAGE(PG8_SB(0, 1), b2 + hstep, voffB);
            PG8_WAIT_V(6); PG8_BAR; PG8_MMA(1, 1, At, B1); PG8_BAR;
            PG8_LDB(B0, 1, 0); PG8_SCHED; PG8_LDA(At, 1, 0); PG8_STAGE(PG8_SA(0, 1), a2 + hstep, voffA);
            PG8_WAIT_L(8); PG8_BAR; PG8_WAIT_L(0); PG8_MMA(0, 0, At, B0); PG8_BAR; PG8_SCHED;
            PG8_LDB(B1, 1, 1); PG8_STAGE(PG8_SB(1, 0), b3, voffB);
            PG8_BAR; PG8_WAIT_L(0); PG8_MMA(0, 1, At, B1); PG8_BAR;
            PG8_LDA(At, 1, 1); PG8_STAGE(PG8_SA(1, 0), a3, voffA);
            PG8_BAR; PG8_WAIT_L(0); PG8_MMA(1, 0, At, B0); PG8_BAR; PG8_SCHED;
            PG8_STAGE(PG8_SB(1, 1), b3 + hstep, voffB);
            PG8_WAIT_V(6); PG8_BAR; PG8_MMA(1, 1, At, B1); PG8_BAR;
            }
        }
        if constexpr (ALIGN_EPI) { if (wr == 0) PG8_BAR; }
        if constexpr (!Epi::AFTER_DRAIN) { E(acc, cur, wr, wc, fr, fq); S.done(cur); }
        if (!has_next) break;
#pragma unroll
        for (int a = 0; a < 2; ++a)
#pragma unroll
            for (int b = 0; b < 2; ++b)
#pragma unroll
                for (int m = 0; m < 4; ++m)
#pragma unroll
                    for (int n = 0; n < 2; ++n) acc[a][b][m][n] = (f32x4){0.f, 0.f, 0.f, 0.f};
        cur = nxt; cA = nA; cB = nB; ++ui;
        if constexpr (ALIGN_EPI) { if (wr == 1) PG8_BAR; }
    }
    PG8_WAIT_V(0);
    if constexpr (!ALIGN_EPI) { if (wr == 0) PG8_BAR; }
    PG8_BAR;
    if constexpr (Epi::AFTER_DRAIN) { E.fused(acc, cur, wr, wc, fr, fq, lds, wid, lane); S.done(cur); }
#undef PG8_SA
#undef PG8_SB
#undef PG8_STAGE
#undef PG8_LDA
#undef PG8_LDB
#undef PG8_MMA
#undef PG8_WAIT_V
#undef PG8_WAIT_L
#undef PG8_BAR
#undef PG8_SCHED
}
}

typedef unsigned short bf16;
typedef float f32x4 __attribute__((ext_vector_type(4)));
typedef float f32x2 __attribute__((ext_vector_type(2)));
typedef unsigned u32x4 __attribute__((ext_vector_type(4)));
typedef unsigned u32x2 __attribute__((ext_vector_type(2)));

#ifndef MK_MULTI
#define MK_MULTI 0
#endif

constexpr int Bn = 8, S = 4096, T = Bn * S, D = 1024, FF = 2816, DEPTH = 4;
constexpr float EPS = 1e-6f;
constexpr int GDN_NPAD = 4352, NSA_NPAD = 2816;
constexpr int LDS_BYTES = 147456;
constexpr size_t MiB = 1u << 20;
constexpr size_t WS_WGU = 1 * MiB;
constexpr size_t WS_WDN = WS_WGU + 88 * MiB;
constexpr size_t WS_WGI = WS_WDN + 44 * MiB;
constexpr size_t WS_WGO = WS_WGI + 17 * MiB;
constexpr size_t WS_WSI = WS_WGO + 4 * MiB;
constexpr size_t WS_WSO = WS_WSI + 6 * MiB;
constexpr size_t WS_WNI = WS_WSO + 2 * MiB;
constexpr size_t WS_WNO = WS_WNI + 6 * MiB;
constexpr size_t WS_WC1 = WS_WNO + 2 * MiB;
constexpr size_t WS_TAB = WS_WC1 + 2 * MiB;
constexpr size_t WS_HN  = 184 * MiB;
constexpr size_t WS_R   = WS_HN + 64 * MiB;
constexpr size_t WS_O32 = WS_R + 256 * MiB;
constexpr size_t WS_SM  = WS_O32 + 128 * MiB;
constexpr size_t WS_AB  = WS_SM;
constexpr size_t WS_GT  = WS_SM + 2 * MiB;
constexpr size_t WS_BP  = WS_SM + 8 * MiB;
constexpr size_t WS_END = WS_SM + 9 * MiB;
static_assert(WS_TAB + 8 * MiB <= WS_HN, "ws map");

__device__ __forceinline__ float bf2f(unsigned v) { return __uint_as_float(v << 16); }
__device__ __forceinline__ unsigned f2bf(float f) { unsigned u = __float_as_uint(f); return (u + 0x7fffu + ((u >> 16) & 1u)) >> 16; }
__device__ __forceinline__ unsigned pk2(float lo, float hi) { return f2bf(lo) | (f2bf(hi) << 16); }
__device__ __forceinline__ float wave_sum(float v) {
#pragma unroll
    for (int o = 1; o < 64; o <<= 1) v += __shfl_xor(v, o);
    return v;
}
__device__ __forceinline__ float wave_max(float v) {
#pragma unroll
    for (int o = 1; o < 64; o <<= 1) v = fmaxf(v, __shfl_xor(v, o));
    return v;
}
__device__ __forceinline__ float row_sum16(float v) {
#pragma unroll
    for (int o = 1; o < 16; o <<= 1) v += __shfl_xor(v, o);
    return v;
}
__device__ __forceinline__ float sigmoidf_(float x) { return 1.f / (1.f + __expf(-x)); }
__device__ __forceinline__ float siluf_(float x) { return x / (1.f + __expf(-x)); }
#define WAVE_SYNC() do { asm volatile("s_waitcnt lgkmcnt(0)" ::: "memory"); __builtin_amdgcn_wave_barrier(); } while (0)

namespace pg8 {
struct EpiSwiGLU {
    static constexpr bool PERM = true, AFTER_DRAIN = false;
    bf16_t* O;
    __device__ __forceinline__ void operator()(const f32x4 (&acc)[2][2][4][2], const Unit& u, int wr, int wc, int fr, int fq) const {
        const int row0 = u.pm * BM + wr * 64 + fr, col0 = u.pn * HALF + wc * 32 + 8 * fq;
#pragma unroll
        for (int ai = 0; ai < 2; ++ai)
#pragma unroll
            for (int m = 0; m < 4; ++m) {
                bf16_t* rowp = O + (size_t)(row0 + ai * HALF + m * 16) * FF + col0;
                float v[8];
#pragma unroll
                for (int n = 0; n < 2; ++n)
#pragma unroll
                    for (int j = 0; j < 4; ++j) { const float g = acc[ai][0][m][n][j], uu = acc[ai][1][m][n][j]; v[n * 4 + j] = g * __builtin_amdgcn_rcpf(1.f + __expf(-g)) * uu; }
                u32x4 w; w.x = cvt_pk_bf16(v[0], v[1]); w.y = cvt_pk_bf16(v[2], v[3]); w.z = cvt_pk_bf16(v[4], v[5]); w.w = cvt_pk_bf16(v[6], v[7]);
                *(u32x4*)rowp = w;
            }
    }
};
struct EpiResid {
    static constexpr bool PERM = false, AFTER_DRAIN = false;
    const float* base; float* out; float scale;
    __device__ __forceinline__ void operator()(const f32x4 (&acc)[2][2][4][2], const Unit& u, int wr, int wc, int fr, int fq) const {
        const int row0 = u.pm * BM + wr * 64 + fr, col0 = u.pn * BM + wc * 32 + 4 * fq;
#pragma unroll
        for (int ai = 0; ai < 2; ++ai)
#pragma unroll
            for (int m = 0; m < 4; ++m) {
                const size_t off = (size_t)(row0 + ai * HALF + m * 16) * D + col0;
#pragma unroll
                for (int bj = 0; bj < 2; ++bj)
#pragma unroll
                    for (int n = 0; n < 2; ++n) { const f32x4 bs = *(const f32x4*)(base + off + bj * HALF + n * 16); *(f32x4*)(out + off + bj * HALF + n * 16) = bs + acc[ai][bj][m][n] * scale; }
                asm volatile("" ::: "memory");
            }
    }
};
struct EpiProj {
    static constexpr bool PERM = true, AFTER_DRAIN = false;
    bf16_t* O; int ldc; int nmain; float* tail; int ldt; int nvalid;
    __device__ __forceinline__ void operator()(const f32x4 (&acc)[2][2][4][2], const Unit& u, int wr, int wc, int fr, int fq) const {
        const int row0 = u.pm * BM + wr * 64 + fr, colt = u.pn * BM, col0 = colt + wc * 32 + 8 * fq;
        if (colt + BM <= nmain) {
#pragma unroll
            for (int ai = 0; ai < 2; ++ai)
#pragma unroll
                for (int m = 0; m < 4; ++m) {
                    bf16_t* rowp = O + (size_t)(row0 + ai * HALF + m * 16) * ldc + col0;
#pragma unroll
                    for (int bj = 0; bj < 2; ++bj) { const f32x4 v0 = acc[ai][bj][m][0], v1 = acc[ai][bj][m][1];
                        u32x4 w; w.x = cvt_pk_bf16(v0[0], v0[1]); w.y = cvt_pk_bf16(v0[2], v0[3]); w.z = cvt_pk_bf16(v1[0], v1[1]); w.w = cvt_pk_bf16(v1[2], v1[3]);
                        *(u32x4*)(rowp + bj * HALF) = w; }
                }
        } else {
#pragma unroll
            for (int ai = 0; ai < 2; ++ai)
#pragma unroll
                for (int m = 0; m < 4; ++m) {
                    const size_t row = (size_t)(row0 + ai * HALF + m * 16);
#pragma unroll
                    for (int bj = 0; bj < 2; ++bj)
#pragma unroll
                        for (int n = 0; n < 2; ++n)
#pragma unroll
                            for (int j = 0; j < 4; ++j) { const int col = col0 + bj * HALF + 4 * n + j; if (col >= nmain && col < nvalid) tail[row * ldt + (col - nmain)] = acc[ai][bj][m][n][j]; }
                }
        }
    }
};
struct EpiF32 {
    static constexpr bool PERM = false, AFTER_DRAIN = false;
    float* C; int ldc;
    __device__ __forceinline__ void operator()(const f32x4 (&acc)[2][2][4][2], const Unit& u, int wr, int wc, int fr, int fq) const {
        const int row0 = u.pm * BM + wr * 64 + fr, col0 = u.pn * BM + wc * 32 + 4 * fq;
#pragma unroll
        for (int ai = 0; ai < 2; ++ai)
#pragma unroll
            for (int m = 0; m < 4; ++m) {
                float* rowp = C + (size_t)(row0 + ai * HALF + m * 16) * ldc + col0;
#pragma unroll
                for (int bj = 0; bj < 2; ++bj)
#pragma unroll
                    for (int n = 0; n < 2; ++n) *(f32x4*)(rowp + bj * HALF + n * 16) = acc[ai][bj][m][n];
            }
    }
};
}

__device__ __forceinline__ void xpose_item(const float* W, int K, int N, bf16* WT, int rowbase, float* scr, int k0, int n0, int lane) {
#pragma unroll 8
    for (int i = 0; i < 32; ++i) { const int kk = 2 * i + (lane >> 5), n = n0 + (lane & 31); scr[kk * 33 + (lane & 31)] = n < N ? W[(size_t)(k0 + kk) * N + n] : 0.f; }
    WAVE_SYNC();
    const int c = lane & 7;
#pragma unroll
    for (int j = 0; j < 4; ++j) { const int n = (lane >> 3) + 8 * j; const float* s = scr + (8 * c) * 33 + n;
        u32x4 o; o.x = pk2(s[0 * 33], s[1 * 33]); o.y = pk2(s[2 * 33], s[3 * 33]); o.z = pk2(s[4 * 33], s[5 * 33]); o.w = pk2(s[6 * 33], s[7 * 33]);
        *(u32x4*)(WT + (size_t)(rowbase + n) * K + k0 + 8 * c) = o; }
    WAVE_SYNC();
}
__device__ __forceinline__ void xpose_matrix(const float* W, int K, int N, int Npad, bf16* WT, int mode, float* scr, int gw, int NGW, int lane) {
    const int nblk = Npad / 32, nitems = (K / 64) * nblk;
    for (int it = gw; it < nitems; it += NGW) {
        const int kb = it / nblk, nb = it - kb * nblk, n0 = nb * 32;
        int rb = n0;
        if (mode == 1) rb = (n0 < FF) ? ((n0 >> 7) * 256 + (n0 & 127)) : ((((n0 - FF) >> 7) * 256) + 128 + ((n0 - FF) & 127));
        xpose_item(W, K, N, WT, rb, scr, kb * 64, n0, lane);
    }
}

__device__ __forceinline__ void phase_norm(const float* h, const float* w, bf16* out, int gw, int NGW, int lane) {
    f32x4 wv[4];
#pragma unroll
    for (int j = 0; j < 4; ++j) wv[j] = ((const f32x4*)w)[64 * j + lane];
    for (int m = gw; m < T; m += NGW) {
        const f32x4* xr = (const f32x4*)(h + (size_t)m * D) + lane;
        f32x4 v[4]; float s = 0.f;
#pragma unroll
        for (int j = 0; j < 4; ++j) { v[j] = xr[64 * j]; s += (v[j].x * v[j].x + v[j].y * v[j].y) + (v[j].z * v[j].z + v[j].w * v[j].w); }
        const float rstd = 1.f / sqrtf(wave_sum(s) * (1.f / D) + EPS);
        u32x2* o8 = (u32x2*)(out + (size_t)m * D) + lane;
#pragma unroll
        for (int j = 0; j < 4; ++j) { u32x2 o; o.x = pk2(v[j].x * rstd * wv[j].x, v[j].y * rstd * wv[j].y); o.y = pk2(v[j].z * rstd * wv[j].z, v[j].w * rstd * wv[j].w); o8[64 * j] = o; }
    }
}

__device__ __forceinline__ void phase_gdn_scan(unsigned char* lds, const bf16* proj, const float* ab, const float* convw, const float* A_log, const float* dt_bias,
                                               float* o32, int vblk, int nblk, int tid, int wid, int lane) {
    float* qs = (float*)lds;
    float* ks = qs + 64 * 128;
    float* vs = ks + 64 * 128;
    float* al = vs + 64 * 32;
    float* be = al + 64;
    float* os = be + 64;
    const int e = tid >> 4, dl = tid & 15;
    for (int item = vblk; item < 256; item += nblk) {
        const int bh = (item & 7) + 8 * (item >> 5), es = (item >> 3) & 3, b = bh >> 3, h = bh & 7;
        const float Ah = __expf(A_log[h]), dtb = dt_bias[h];
        float St[8];
#pragma unroll
        for (int i = 0; i < 8; ++i) St[i] = 0.f;
        for (int chunk = 0; chunk < S / 64; ++chunk) {
            const int t0 = chunk * 64;
            __syncthreads();
            for (int idx = tid; idx < 64 * 36; idx += 512) {
                const int tok = idx / 36, cgp = idx - tok * 36;
                int col; float* dst;
                if (cgp < 16) { col = h * 128 + cgp * 8; dst = qs + tok * 128 + cgp * 8; }
                else if (cgp < 32) { col = 1024 + h * 128 + (cgp - 16) * 8; dst = ks + tok * 128 + (cgp - 16) * 8; }
                else { col = 2048 + h * 128 + es * 32 + (cgp - 32) * 8; dst = vs + tok * 32 + (cgp - 32) * 8; }
                float a8[8];
#pragma unroll
                for (int i = 0; i < 8; ++i) a8[i] = 0.f;
#pragma unroll
                for (int j = 0; j < 4; ++j) {
                    const int ts = t0 + tok - 3 + j;
                    if (ts >= 0) {
                        const u32x4 xv = *(const u32x4*)(proj + (size_t)(b * S + ts) * 4096 + col);
                        const f32x4 w0 = *(const f32x4*)(convw + j * 3072 + col), w1 = *(const f32x4*)(convw + j * 3072 + col + 4);
                        a8[0] += bf2f(xv.x & 0xffffu) * w0.x; a8[1] += bf2f(xv.x >> 16) * w0.y; a8[2] += bf2f(xv.y & 0xffffu) * w0.z; a8[3] += bf2f(xv.y >> 16) * w0.w;
                        a8[4] += bf2f(xv.z & 0xffffu) * w1.x; a8[5] += bf2f(xv.z >> 16) * w1.y; a8[6] += bf2f(xv.w & 0xffffu) * w1.z; a8[7] += bf2f(xv.w >> 16) * w1.w;
                    }
                }
#pragma unroll
                for (int i = 0; i < 8; ++i) dst[i] = siluf_(a8[i]);
            }
            if (tid < 64) {
                const size_t tg = (size_t)(b * S + t0 + tid);
                const float a = ab[tg * 16 + h] + dtb, bb = ab[tg * 16 + 8 + h];
                const float sp = a > 20.f ? a : log1pf(__expf(a));
                al[tid] = __expf(-Ah * sp); be[tid] = sigmoidf_(bb);
            }
            __syncthreads();
#pragma unroll 4
            for (int r = 0; r < 16; ++r) {
                const int row = wid * 16 + r;
                float* p = row < 64 ? qs + row * 128 : ks + (row - 64) * 128;
                const float x0 = p[lane], x1 = p[lane + 64];
                const float ss = wave_sum(x0 * x0 + x1 * x1);
                const float sc = (1.f / sqrtf(ss + EPS)) * (row < 64 ? 0.08838834764831845f : 1.f);
                p[lane] = x0 * sc; p[lane + 64] = x1 * sc;
            }
            __syncthreads();
            for (int tt = 0; tt < 64; ++tt) {
                const f32x4 k0 = *(const f32x4*)(ks + tt * 128 + dl * 8), k1 = *(const f32x4*)(ks + tt * 128 + dl * 8 + 4);
                const f32x4 q0 = *(const f32x4*)(qs + tt * 128 + dl * 8), q1 = *(const f32x4*)(qs + tt * 128 + dl * 8 + 4);
                const float v = vs[tt * 32 + e], a = al[tt], bt = be[tt];
                float p = (k0.x * St[0] + k0.y * St[1]) + (k0.z * St[2] + k0.w * St[3]) + (k1.x * St[4] + k1.y * St[5]) + (k1.z * St[6] + k1.w * St[7]);
                p = row_sum16(p);
                const float vn = bt * (v - a * p);
                St[0] = a * St[0] + k0.x * vn; St[1] = a * St[1] + k0.y * vn; St[2] = a * St[2] + k0.z * vn; St[3] = a * St[3] + k0.w * vn;
                St[4] = a * St[4] + k1.x * vn; St[5] = a * St[5] + k1.y * vn; St[6] = a * St[6] + k1.z * vn; St[7] = a * St[7] + k1.w * vn;
                float o = (q0.x * St[0] + q0.y * St[1]) + (q0.z * St[2] + q0.w * St[3]) + (q1.x * St[4] + q1.y * St[5]) + (q1.z * St[6] + q1.w * St[7]);
                o = row_sum16(o);
                if (dl == 0) os[tt * 32 + e] = o;
            }
            __syncthreads();
            { const int tok = tid >> 3, c4 = tid & 7;
              *(f32x4*)(o32 + (size_t)(b * S + t0 + tok) * D + h * 128 + es * 32 + c4 * 4) = *(const f32x4*)(os + tok * 32 + c4 * 4); }
        }
    }
}
__device__ __forceinline__ void phase_gdn_post(const float* o32, const bf16* proj, const float* onorm, bf16* hn, int gw, int NGW, int lane) {
    const f32x4 wv = *(const f32x4*)(onorm + ((4 * lane) & 127));
    for (int m = gw; m < T; m += NGW) {
        const f32x4* xr = (const f32x4*)(o32 + (size_t)m * D) + lane;
        const u32x2* gr = (const u32x2*)(proj + (size_t)m * 4096 + 3072) + lane;
        u32x2* o8 = (u32x2*)(hn + (size_t)m * D) + lane;
#pragma unroll
        for (int j = 0; j < 4; ++j) {
            const f32x4 v = xr[64 * j]; const u32x2 g = gr[64 * j];
            float s = (v.x * v.x + v.y * v.y) + (v.z * v.z + v.w * v.w);
#pragma unroll
            for (int o = 1; o < 32; o <<= 1) s += __shfl_xor(s, o);
            const float rstd = 1.f / sqrtf(s * (1.f / 128.f) + EPS);
            u32x2 o; o.x = pk2(v.x * rstd * wv.x * siluf_(bf2f(g.x & 0xffffu)), v.y * rstd * wv.y * siluf_(bf2f(g.x >> 16)));
            o.y = pk2(v.z * rstd * wv.z * siluf_(bf2f(g.y & 0xffffu)), v.w * rstd * wv.w * siluf_(bf2f(g.y >> 16)));
            o8[64 * j] = o;
        }
    }
}
__device__ __forceinline__ void phase_sc_post(const bf16* proj, const float* cw, bf16* hn, int gtid, int NT) {
    for (int idx = gtid; idx < T * 128; idx += NT) {
        const int m = idx >> 7, c8 = (idx & 127) * 8, s = m & (S - 1);
        float y[8];
#pragma unroll
        for (int i = 0; i < 8; ++i) y[i] = 0.f;
#pragma unroll
        for (int j = 0; j < 3; ++j) {
            if (s - 2 + j >= 0) {
                const bf16* pr = proj + (size_t)(m - 2 + j) * 3072;
                const u32x4 cv = *(const u32x4*)(pr + 1024 + c8), xv = *(const u32x4*)(pr + 2048 + c8);
                const f32x4 w0 = *(const f32x4*)(cw + j * 1024 + c8), w1 = *(const f32x4*)(cw + j * 1024 + c8 + 4);
                y[0] += w0.x * bf2f(cv.x & 0xffffu) * bf2f(xv.x & 0xffffu); y[1] += w0.y * bf2f(cv.x >> 16) * bf2f(xv.x >> 16);
                y[2] += w0.z * bf2f(cv.y & 0xffffu) * bf2f(xv.y & 0xffffu); y[3] += w0.w * bf2f(cv.y >> 16) * bf2f(xv.y >> 16);
                y[4] += w1.x * bf2f(cv.z & 0xffffu) * bf2f(xv.z & 0xffffu); y[5] += w1.y * bf2f(cv.z >> 16) * bf2f(xv.z >> 16);
                y[6] += w1.z * bf2f(cv.w & 0xffffu) * bf2f(xv.w & 0xffffu); y[7] += w1.w * bf2f(cv.w >> 16) * bf2f(xv.w >> 16);
            }
        }
        const u32x4 bv = *(const u32x4*)(proj + (size_t)m * 3072 + c8);
        u32x4 o;
        o.x = pk2(y[0] * bf2f(bv.x & 0xffffu), y[1] * bf2f(bv.x >> 16)); o.y = pk2(y[2] * bf2f(bv.y & 0xffffu), y[3] * bf2f(bv.y >> 16));
        o.z = pk2(y[4] * bf2f(bv.z & 0xffffu), y[5] * bf2f(bv.z >> 16)); o.w = pk2(y[6] * bf2f(bv.w & 0xffffu), y[7] * bf2f(bv.w >> 16));
        *(u32x4*)(hn + (size_t)m * D + c8) = o;
    }
}
__device__ __forceinline__ void phase_nsa_post(const bf16* proj, const float* qnorm, const float* knorm, const f32x2* tab,
                                               bf16* QN, bf16* KS, bf16* KW, bf16* KCH, bf16* VCH, int gw, int NGW, int lane) {
    const float qw = qnorm[lane], kw1 = knorm[64 + lane], kw2 = knorm[128 + lane];
    for (int m = gw; m < T; m += NGW) {
        const int b = m >> 12, s = m & (S - 1);
        const bf16* pr = proj + (size_t)m * 2560;
        const f32x2 cs = tab[(size_t)m * 32 + (lane & 31)];
#pragma unroll 4
        for (int hh = 0; hh < 16; ++hh) {
            const float x = bf2f(pr[hh * 64 + lane]);
            const float ss = wave_sum(x * x);
            QN[((size_t)(b * 16 + hh) * S + s) * 64 + lane] = (bf16)f2bf(x * (1.f / sqrtf(ss * (1.f / 64.f) + EPS)) * qw);
        }
#pragma unroll
        for (int hk = 0; hk < 4; ++hk) {
            const size_t o = ((size_t)(b * 4 + hk) * S + s) * 64 + lane;
            { const float x = bf2f(pr[1536 + hk * 64 + lane]); const float ss = wave_sum(x * x);
              const float y = x * (1.f / sqrtf(ss * (1.f / 64.f) + EPS)) * kw1; const float yp = __shfl_xor(y, 32);
              KS[o] = (bf16)f2bf(y * cs.x + (lane < 32 ? -yp : yp) * cs.y); }
            { const float x = bf2f(pr[2048 + hk * 64 + lane]); const float ss = wave_sum(x * x);
              const float y = x * (1.f / sqrtf(ss * (1.f / 64.f) + EPS)) * kw2; const float yp = __shfl_xor(y, 32);
              KW[o] = (bf16)f2bf(y * cs.x + (lane < 32 ? -yp : yp) * cs.y); }
            KCH[o] = pr[1024 + hk * 64 + lane];
            VCH[o] = pr[1280 + hk * 64 + lane];
        }
    }
}
__device__ __forceinline__ void phase_cmp2(unsigned char* lds, const float* Pk, const float* Pv, const float* biasp, const float* w2, const float* b2, const float* knorm0,
                                           float* KC, float* VC, int gw, int NGW, int wid, int lane) {
    float* hs = (float*)lds + wid * 256;
    for (int item = gw; item < 2 * 32 * 256; item += NGW) {
        const int i = item & 255, bh = (item >> 8) & 31, kind = item >> 13;
        float* outp = (kind ? VC : KC) + ((size_t)bh * 256 + i) * 64 + lane;
        if (i == 255) { *outp = 0.f; continue; }
        const float* P = kind ? Pv : Pk;
        const float* r0 = P + ((size_t)bh * 256 + i) * 512; const float* r1 = r0 + 512 + 256;
#pragma unroll
        for (int j = 0; j < 4; ++j) { const int n = lane + 64 * j; const float x = r0[n] + r1[n] + biasp[kind * 256 + n];
            const float uu = 0.7978845608028654f * (x + 0.044715f * x * x * x);
            const float th = 1.f - 2.f / (1.f + __expf(2.f * uu));
            hs[n] = 0.5f * x * (1.f + th); }
        WAVE_SYNC();
        float acc = b2[kind * 64 + lane];
        const float* w = w2 + (size_t)kind * 256 * 64 + lane;
#pragma unroll 8
        for (int n = 0; n < 256; ++n) acc += hs[n] * w[n * 64];
        if (kind == 0) { const float ss = wave_sum(acc * acc); acc = acc * (1.f / sqrtf(ss * (1.f / 64.f) + EPS)) * knorm0[lane]; }
        *outp = acc;
        WAVE_SYNC();
    }
}
__device__ __forceinline__ void attend_chunk(const bf16* Krow, bool valid, const bf16* Vb, int vstride, int nk, const float* q_s, float* p_s,
                                             float (&m)[4], float (&l)[4], float (&o)[4], int lane) {
    float s[4] = {0.f, 0.f, 0.f, 0.f};
    const u32x4* kr = (const u32x4*)Krow;
#pragma unroll
    for (int c = 0; c < 8; ++c) {
        const u32x4 kk = kr[c];
        const float k0 = bf2f(kk.x & 0xffffu), k1 = bf2f(kk.x >> 16), k2 = bf2f(kk.y & 0xffffu), k3 = bf2f(kk.y >> 16), k4 = bf2f(kk.z & 0xffffu), k5 = bf2f(kk.z >> 16), k6 = bf2f(kk.w & 0xffffu), k7 = bf2f(kk.w >> 16);
#pragma unroll
        for (int g = 0; g < 4; ++g) { const f32x4 qa = *(const f32x4*)(q_s + g * 64 + c * 8), qb = *(const f32x4*)(q_s + g * 64 + c * 8 + 4);
            s[g] += (k0 * qa.x + k1 * qa.y) + (k2 * qa.z + k3 * qa.w) + (k4 * qb.x + k5 * qb.y) + (k6 * qb.z + k7 * qb.w); }
    }
#pragma unroll
    for (int g = 0; g < 4; ++g) {
        const float sg = valid ? s[g] : -1e30f;
        const float mn = fmaxf(m[g], wave_max(sg));
        const float corr = __expf(m[g] - mn);
        const float p = valid ? __expf(sg - mn) : 0.f;
        l[g] = l[g] * corr + wave_sum(p); m[g] = mn; o[g] *= corr;
        p_s[g * 64 + lane] = p;
    }
    WAVE_SYNC();
    for (int k = 0; k < nk; ++k) {
        const float v = bf2f(Vb[(size_t)k * vstride]);
        o[0] += p_s[k] * v; o[1] += p_s[64 + k] * v; o[2] += p_s[128 + k] * v; o[3] += p_s[192 + k] * v;
    }
    WAVE_SYNC();
}
__device__ __forceinline__ void phase_nsa_attn(unsigned char* lds, const bf16* proj, const bf16* QN, const bf16* KS, const bf16* KW, const float* KC, const float* VC,
                                               const float* gates, const f32x2* tab, bf16* hn, int gw, int NGW, int wid, int lane) {
    float* wl = (float*)(lds + wid * 6144);
    float* qn_s = wl; float* qr_s = wl + 256; float* p_s = wl + 512;
    for (int item = gw; item < Bn * 4 * S; item += NGW) {
        const int t = item & (S - 1), hk = (item >> 12) & 3, b = item >> 14;
        const size_t tok = (size_t)b * S + t;
        const f32x2 cs = tab[tok * 32 + (lane & 31)];
#pragma unroll
        for (int g = 0; g < 4; ++g) {
            const float x = bf2f(QN[((size_t)(b * 16 + hk * 4 + g) * S + t) * 64 + lane]) * 0.125f;
            const float xp = __shfl_xor(x, 32);
            qn_s[g * 64 + lane] = x; qr_s[g * 64 + lane] = x * cs.x + (lane < 32 ? -xp : xp) * cs.y;
        }
        WAVE_SYNC();
        float oc[4] = {0.f, 0.f, 0.f, 0.f}; float imp = 0.f;
        const int nv = t >= 31 ? ((t - 31) >> 4) + 1 : 0;
        if (nv > 0) {
            const float* kcb = KC + (size_t)(b * 4 + hk) * 256 * 64;
            float sc[4][4];
#pragma unroll
            for (int kk = 0; kk < 4; ++kk)
#pragma unroll
                for (int g = 0; g < 4; ++g) sc[kk][g] = -1e30f;
            const int nkk = (nv + 63) >> 6;
#pragma unroll
            for (int kk = 0; kk < 4; ++kk) {
                if (kk < nkk) {
                    const int i = lane + 64 * kk, ii = i < nv ? i : nv - 1;
                    const f32x4* kr = (const f32x4*)(kcb + (size_t)ii * 64);
                    float a0 = 0.f, a1 = 0.f, a2 = 0.f, a3 = 0.f;
#pragma unroll 4
                    for (int dc = 0; dc < 16; ++dc) {
                        const f32x4 kv = kr[dc];
                        const f32x4 q0 = *(const f32x4*)(qn_s + dc * 4), q1 = *(const f32x4*)(qn_s + 64 + dc * 4), q2 = *(const f32x4*)(qn_s + 128 + dc * 4), q3 = *(const f32x4*)(qn_s + 192 + dc * 4);
                        a0 += (kv.x * q0.x + kv.y * q0.y) + (kv.z * q0.z + kv.w * q0.w);
                        a1 += (kv.x * q1.x + kv.y * q1.y) + (kv.z * q1.z + kv.w * q1.w);
                        a2 += (kv.x * q2.x + kv.y * q2.y) + (kv.z * q2.z + kv.w * q2.w);
                        a3 += (kv.x * q3.x + kv.y * q3.y) + (kv.z * q3.z + kv.w * q3.w);
                    }
                    if (i < nv) { sc[kk][0] = a0; sc[kk][1] = a1; sc[kk][2] = a2; sc[kk][3] = a3; }
                }
            }
#pragma unroll
            for (int g = 0; g < 4; ++g) {
                float mx = fmaxf(fmaxf(sc[0][g], sc[1][g]), fmaxf(sc[2][g], sc[3][g]));
                mx = wave_max(mx);
                float sum = 0.f;
#pragma unroll
                for (int kk = 0; kk < 4; ++kk) { const float p = (lane + 64 * kk < nv) ? __expf(sc[kk][g] - mx) : 0.f; sc[kk][g] = p; sum += p; }
                sum = wave_sum(sum);
                const float inv = 1.f / sum;
#pragma unroll
                for (int kk = 0; kk < 4; ++kk) p_s[g * 256 + lane + 64 * kk] = sc[kk][g] * inv;
            }
            WAVE_SYNC();
            const float* vcb = VC + (size_t)(b * 4 + hk) * 256 * 64 + lane;
            for (int i = 0; i < nv; ++i) {
                const float v = vcb[(size_t)i * 64];
                oc[0] += p_s[i] * v; oc[1] += p_s[256 + i] * v; oc[2] += p_s[512 + i] * v; oc[3] += p_s[768 + i] * v;
            }
#pragma unroll
            for (int g = 0; g < 4; ++g) {
                const f32x4 pv = *(const f32x4*)(p_s + g * 256 + 4 * lane);
                const float pm1 = lane > 0 ? p_s[g * 256 + 4 * lane - 1] : 0.f;
                imp += pv.x + pv.y + pv.z + 0.5f * pv.w + 0.5f * pm1;
            }
            WAVE_SYNC();
        }
        const int cur = t >> 6;
        const bool sv = lane <= cur, forced = (lane == 0) || (lane == cur) || (lane + 1 == cur);
        const float score = sv ? (forced ? 1e9f : imp) : -1.f;
        int rank = 0;
#pragma unroll
        for (int i = 0; i < 64; ++i) { const float si = __uint_as_float(__builtin_amdgcn_readlane(__float_as_uint(score), i)); rank += (si > score || (si == score && i < lane)) ? 1 : 0; }
        const bool sel = (rank < 16) && (score >= 0.f);
        unsigned long long mask = __ballot(sel);
        float m1[4] = {-1e30f, -1e30f, -1e30f, -1e30f}, l1[4] = {0.f, 0.f, 0.f, 0.f}, o1[4] = {0.f, 0.f, 0.f, 0.f};
        while (mask) {
            const int j = __builtin_ctzll(mask); mask &= mask - 1;
            const int key = 64 * j + lane, keyc = key <= t ? key : t;
            const int nk = (t - 64 * j + 1) < 64 ? (t - 64 * j + 1) : 64;
            attend_chunk(KS + ((size_t)(b * 4 + hk) * S + keyc) * 64, key <= t, proj + ((size_t)b * S + 64 * j) * 2560 + 1792 + hk * 64 + lane, 2560, nk, qr_s, p_s, m1, l1, o1, lane);
        }
        float m2[4] = {-1e30f, -1e30f, -1e30f, -1e30f}, l2[4] = {0.f, 0.f, 0.f, 0.f}, o2[4] = {0.f, 0.f, 0.f, 0.f};
        for (int k0 = (t - 511 > 0 ? t - 511 : 0); k0 <= t; k0 += 64) {
            const int key = k0 + lane, keyc = key <= t ? key : t;
            const int nk = (t - k0 + 1) < 64 ? (t - k0 + 1) : 64;
            attend_chunk(KW + ((size_t)(b * 4 + hk) * S + keyc) * 64, key <= t, proj + ((size_t)b * S + k0) * 2560 + 2304 + hk * 64 + lane, 2560, nk, qr_s, p_s, m2, l2, o2, lane);
        }
#pragma unroll
        for (int g = 0; g < 4; ++g) {
            const float* gp = gates + tok * 48 + (hk * 4 + g) * 3;
            const float r = sigmoidf_(gp[0]) * oc[g] + sigmoidf_(gp[1]) * (o1[g] / l1[g]) + sigmoidf_(gp[2]) * (o2[g] / l2[g]);
            hn[tok * D + (hk * 4 + g) * 64 + lane] = (bf16)f2bf(r);
        }
    }
}

struct Args { const void* in[24]; float* out; unsigned char* ws; int lo, hi; };

__host__ __device__ constexpr int mixer_inner_phases(int kind) { return kind == 0 ? 2 : (kind == 1 ? 1 : 4); }
__host__ __device__ constexpr int total_phases() { int n = 1; for (int L = 0; L < DEPTH; ++L) n += 6 + 3 + mixer_inner_phases(L % 3); return n; }

__global__ void __launch_bounds__(512, 2) mega(Args args) {
    extern __shared__ __attribute__((aligned(16))) unsigned char lds[];
    cg::grid_group grid = cg::this_grid();
    for (int ph = args.lo; ph < args.hi; ++ph) {
        int type = 0, s = 0, L = 0;
        if (ph > 0) {
            int p = ph - 1;
            for (L = 0; L < DEPTH; ++L) { const int n = 9 + mixer_inner_phases(L % 3); if (p < n) break; p -= n; }
            const int inner = mixer_inner_phases(L % 3), kind = L % 3;
            if (p < 3) { type = 1 + p; s = 2 * L; }
            else if (p == 3) type = 4;
            else if (p == 4) type = 5;
            else if (p < 5 + inner) { const int q = p - 5; type = kind == 0 ? 6 + q : (kind == 1 ? 8 : 9 + q); }
            else if (p == 5 + inner) type = 13;
            else { type = 1 + (p - 6 - inner); s = 2 * L + 1; }
        }
        int tid_ = threadIdx.x; asm volatile("" : "+v"(tid_));
        int G_ = gridDim.x, bx_ = blockIdx.x; asm volatile("" : "+s"(G_), "+s"(bx_));
        const int tid = tid_, lane = tid & 63, wid = __builtin_amdgcn_readfirstlane(tid >> 6);
        const int G = G_, bx = bx_;
        const int vcu = (G % 8 == 0) ? (bx % 8) * (G / 8) + bx / 8 : bx;
        const int gw = vcu * 8 + wid, NGW = G * 8;
        unsigned char* ws = args.ws; asm volatile("" : "+s"(ws));
        PG8_LAS unsigned char* ldsl = (PG8_LAS unsigned char*)lds;
        float* hout = args.out; asm volatile("" : "+s"(hout));
        bf16* HN = (bf16*)(ws + WS_HN);
        bf16* RB = (bf16*)(ws + WS_R);
        f32x2* tab = (f32x2*)(ws + WS_TAB);
        const int kind = L % 3, jj = L / 3;
        bf16* QN = RB + (size_t)T * 2560;
        bf16* KSb = QN + (size_t)T * 1024;
        bf16* KWb = KSb + (size_t)T * 256;
        bf16* KCH = (bf16*)(ws + WS_O32);
        bf16* VCH = KCH + (size_t)T * 256;
        float* Pk = (float*)(ws + WS_O32 + 32 * MiB);
        float* Pv = Pk + (size_t)8192 * 512;
        float* KC = (float*)(ws + WS_O32 + 64 * MiB);
        float* VC = KC + (size_t)32 * 256 * 64;
        switch (type) {
        case 0: {
            float* scr = (float*)lds + wid * (64 * 33);
            for (int mi = 0; mi < 28; ++mi) {
                const float* W; int K, N, Npad, mode = 0; bf16* WT;
                if (mi < 8)       { W = (const float*)args.in[3] + (size_t)mi * D * 2 * FF; K = D; N = 2 * FF; Npad = N; mode = 1; WT = (bf16*)(ws + WS_WGU) + (size_t)mi * 2 * FF * D; }
                else if (mi < 16) { const int i = mi - 8; W = (const float*)args.in[4] + (size_t)i * FF * D; K = FF; N = D; Npad = N; WT = (bf16*)(ws + WS_WDN) + (size_t)i * D * FF; }
                else if (mi < 18) { const int i = mi - 16; W = (const float*)args.in[6] + (size_t)i * D * 4112; K = D; N = 4112; Npad = GDN_NPAD; WT = (bf16*)(ws + WS_WGI) + (size_t)i * GDN_NPAD * D; }
                else if (mi < 20) { const int i = mi - 18; W = (const float*)args.in[11] + (size_t)i * D * D; K = D; N = D; Npad = N; WT = (bf16*)(ws + WS_WGO) + (size_t)i * D * D; }
                else if (mi == 20) { W = (const float*)args.in[12]; K = D; N = 3072; Npad = N; WT = (bf16*)(ws + WS_WSI); }
                else if (mi == 21) { W = (const float*)args.in[14]; K = D; N = D; Npad = N; WT = (bf16*)(ws + WS_WSO); }
                else if (mi == 22) { W = (const float*)args.in[15]; K = D; N = 2608; Npad = NSA_NPAD; WT = (bf16*)(ws + WS_WNI); }
                else if (mi == 23) { W = (const float*)args.in[23]; K = D; N = D; Npad = N; WT = (bf16*)(ws + WS_WNO); }
                else { const int i = mi - 24, kd = i >> 1, hf = i & 1;
                    W = (const float*)args.in[19] + (size_t)kd * 2048 * 256 + (size_t)hf * 1024 * 256; K = 1024; N = 256; Npad = 256; WT = (bf16*)(ws + WS_WC1) + (size_t)kd * 512 * 1024 + (size_t)hf * 256 * 1024; }
                xpose_matrix(W, K, N, Npad, WT, mode, scr, gw, NGW, lane);
            }
            const int* positions = (const int*)args.in[1];
            for (int idx = bx * 512 + tid; idx < T * 32; idx += G * 512) {
                const int tk = idx >> 5, i = idx & 31;
                const float inv = 1.0f / exp2f((float)(2 * i) * (13.287712379549449f / 64.f));
                const float ang = (float)positions[tk] * inv;
                const double rev = (double)ang * 0.15915494309189535;
                const float fr = (float)(rev - rint(rev));
                f32x2 v; v.x = __builtin_amdgcn_cosf(fr); v.y = __builtin_amdgcn_sinf(fr);
                tab[idx] = v;
            }
            if (bx < 2 && tid < 256) {
                const float* pe = (const float*)args.in[18] + (size_t)bx * 2048;
                const float* w1 = (const float*)args.in[19] + (size_t)bx * 2048 * 256 + tid;
                float acc = ((const float*)args.in[20])[bx * 256 + tid];
                for (int k = 0; k < 2048; ++k) acc += pe[k] * w1[(size_t)k * 256];
                ((float*)(ws + WS_BP))[bx * 256 + tid] = acc;
            }
        } break;
        case 1: phase_norm(s == 0 ? (const float*)args.in[0] : hout, (const float*)args.in[2] + (size_t)s * D, HN, gw, NGW, lane); break;
        case 2: {
            pg8::Gemm g{HN, (const bf16*)(ws + WS_WGU) + (size_t)s * 2 * FF * D, T, 2 * FF, D}; pg8::StaticOrder SO; SO.init(T, 2 * FF, G, bx);
            pg8::EpiSwiGLU E{RB};
            pg8::gemm_phase<pg8::EpiSwiGLU, pg8::StaticOrder, true, true>(ldsl, g, SO, E); } break;
        case 3: {
            pg8::Gemm g{RB, (const bf16*)(ws + WS_WDN) + (size_t)s * D * FF, T, D, FF}; pg8::StaticOrder SO; SO.init(T, D, G, bx);
            pg8::EpiResid E{s == 0 ? (const float*)args.in[0] : hout, hout, 0.5f};
            pg8::gemm_phase<pg8::EpiResid, pg8::StaticOrder, true, true>(ldsl, g, SO, E); } break;
        case 4: phase_norm(hout, (const float*)args.in[5] + (size_t)L * D, HN, gw, NGW, lane); break;
        case 5: {
            const bf16* Wt; int Np, ldc, nmain, ldt, nvalid; float* tail;
            if (kind == 0) { Wt = (const bf16*)(ws + WS_WGI) + (size_t)jj * GDN_NPAD * D; Np = GDN_NPAD; ldc = 4096; nmain = 4096; tail = (float*)(ws + WS_AB); ldt = 16; nvalid = 4112; }
            else if (kind == 1) { Wt = (const bf16*)(ws + WS_WSI); Np = 3072; ldc = 3072; nmain = 3072; tail = (float*)(ws + WS_AB); ldt = 16; nvalid = 3072; }
            else { Wt = (const bf16*)(ws + WS_WNI); Np = NSA_NPAD; ldc = 2560; nmain = 2560; tail = (float*)(ws + WS_GT); ldt = 48; nvalid = 2608; }
            pg8::Gemm g{HN, Wt, T, Np, D}; pg8::StaticOrder SO; SO.init(T, Np, G, bx);
            pg8::EpiProj E{RB, ldc, nmain, tail, ldt, nvalid};
            pg8::gemm_phase<pg8::EpiProj, pg8::StaticOrder, true, true>(ldsl, g, SO, E); } break;
        case 6:
#ifndef DIS_SCAN
            phase_gdn_scan(lds, RB, (const float*)(ws + WS_AB), (const float*)args.in[7] + (size_t)jj * 4 * 3072, (const float*)args.in[8] + jj * 8, (const float*)args.in[9] + jj * 8,
                           (float*)(ws + WS_O32), bx, G, tid, wid, lane);
#endif
            break;
        case 7:
#ifndef DIS_GPOST
            phase_gdn_post((const float*)(ws + WS_O32), RB, (const float*)args.in[10] + jj * 128, HN, gw, NGW, lane);
#endif
            break;
        case 8:
#ifndef DIS_SPOST
            phase_sc_post(RB, (const float*)args.in[13], HN, vcu * 512 + tid, G * 512);
#endif
            break;
        case 9:
#ifndef DIS_NPOST
            phase_nsa_post(RB, (const float*)args.in[16], (const float*)args.in[17], tab, QN, KSb, KWb, KCH, VCH, gw, NGW, lane);
#endif
            break;
        case 10: {
            pg8::Gemm g{KCH, (const bf16*)(ws + WS_WC1), 8192, 512, 1024}; pg8::StaticOrder SO; SO.init(8192, 512, G, bx);
            pg8::Gemm g2{VCH, (const bf16*)(ws + WS_WC1) + (size_t)512 * 1024, 8192, 512, 1024};
            pg8::EpiF32 E{Pk, 512};
            if (bx >= G / 2) { g = g2; SO.init(8192, 512, G, bx - G / 2); E.C = Pv; }
            pg8::gemm_phase<pg8::EpiF32, pg8::StaticOrder, true, true>(ldsl, g, SO, E); } break;
        case 11:
#ifndef DIS_CMP2
            phase_cmp2(lds, Pk, Pv, (const float*)(ws + WS_BP), (const float*)args.in[21], (const float*)args.in[22], (const float*)args.in[17], KC, VC, gw, NGW, wid, lane);
#endif
            break;
        case 12:
#ifndef DIS_ATTN
            phase_nsa_attn(lds, RB, QN, KSb, KWb, KC, VC, (const float*)(ws + WS_GT), tab, HN, gw, NGW, wid, lane);
#endif
            break;
        default: {
            const bf16* Wout = kind == 0 ? (const bf16*)(ws + WS_WGO) + (size_t)jj * D * D : (kind == 1 ? (const bf16*)(ws + WS_WSO) : (const bf16*)(ws + WS_WNO));
            pg8::Gemm g{HN, Wout, T, D, D}; pg8::StaticOrder SO; SO.init(T, D, G, bx);
            pg8::EpiResid E{hout, hout, 1.0f};
            pg8::gemm_phase<pg8::EpiResid, pg8::StaticOrder, true, true>(ldsl, g, SO, E); } break;
        }
        if (ph + 1 < args.hi) grid.sync();
    }
}

extern "C" void kernel_launch(void* const* d_in, const int* in_sizes, int n_in, void* d_out, int out_size, void* d_ws, size_t ws_size, hipStream_t stream) {
    static int grid = 0;
    if (grid == 0) {
        if (n_in != 24 || out_size != T * D || ws_size < WS_END) { fprintf(stderr, "kernel_launch: unexpected shapes n_in %d out %d ws %zu (need %zu)\n", n_in, out_size, ws_size, (size_t)WS_END); grid = -1; return; }
        int dev = 0, cus = 0, per_cu = 0;
        hipGetDevice(&dev); hipDeviceGetAttribute(&cus, hipDeviceAttributeMultiprocessorCount, dev);
        if (hipFuncSetAttribute((const void*)mega, hipFuncAttributeMaxDynamicSharedMemorySize, LDS_BYTES) != hipSuccess) { fprintf(stderr, "kernel_launch: hipFuncSetAttribute failed\n"); grid = -1; return; }
        if (hipOccupancyMaxActiveBlocksPerMultiprocessor(&per_cu, (const void*)mega, 512, LDS_BYTES) != hipSuccess || per_cu < 1) { fprintf(stderr, "kernel_launch: occupancy query says %d\n", per_cu); per_cu = 1; }
        (void)hipGetLastError();
        grid = cus;
    }
    if (grid < 0) return;
    Args a{};
    for (int i = 0; i < 24; ++i) a.in[i] = d_in[i];
    a.out = (float*)d_out; a.ws = (unsigned char*)d_ws;
    constexpr int NPH = total_phases();
#if MK_MULTI
    for (int p = 0; p < NPH; ++p) { a.lo = p; a.hi = p + 1; hipLaunchKernelGGL(mega, dim3(grid), dim3(512), LDS_BYTES, stream, a); }
#else
    a.lo = 0; a.hi = NPH;
    void* kargs[] = {&a};
    hipError_t e = hipLaunchCooperativeKernel((const void*)mega, dim3(grid), dim3(512), kargs, LDS_BYTES, stream);
    if (e != hipSuccess) fprintf(stderr, "cooperative launch failed: %s (grid %d)\n", hipGetErrorString(e), grid);
#endif
}
```

```cpp
#include <hip/hip_runtime.h>
#include <hip/hip_cooperative_groups.h>
#include <cstdio>
#include <cstdint>
namespace cg = cooperative_groups;
namespace pg8 {
#define PG8_LAS __attribute__((address_space(3)))
typedef unsigned short bf16_t;
typedef short bf16x8 __attribute__((ext_vector_type(8)));
typedef float f32x4 __attribute__((ext_vector_type(4)));
typedef unsigned u32x4 __attribute__((ext_vector_type(4)));
constexpr int BM = 256, BK = 64, HALF = 128, HTB = HALF * BK * 2  , STAGE_BYTES = 8 * HTB, NXCD = 8, WGM = 8;

__host__ __device__ __forceinline__ int lds_byte(int r, int c) { const int st = (r >> 4) * 2 + (c >> 5), rr = r & 15, cc = c & 31, ob = rr * 64 + cc * 2; return st * 1024 + (ob ^ (((ob >> 9) & 1) << 5)); }
__host__ __device__ __forceinline__ void stage_rc(int b, int& R, int& C) { const int st = b / 1024, sb = b % 1024, swz = sb ^ (((sb >> 9) & 1) << 5); R = (st >> 1) * 16 + swz / 64; C = (st & 1) * 32 + (swz % 64) / 2; }
__host__ __device__ __forceinline__ int perm32(int rho) { const int n = rho >> 4, i = rho & 15; return 8 * (i >> 2) + 4 * n + (i & 3); }

struct Unit { int pm, pn; };
struct Gemm { const bf16_t* A; const bf16_t* Bt; int M, N, K; };

struct StaticOrder {
    int nM, nN, nwg, G, c;
    __host__ __device__ void init(int M, int N, int G_, int c_) { nM = M / BM; nN = N / BM; nwg = nM * nN; G = G_; c = c_; }
    __host__ __device__ bool next(int i, Unit& u) const {
        const long L = (long)i * G + c; if (L >= nwg) return false;
        int wgid = (int)L; { const int q = nwg / NXCD, r = nwg % NXCD, xcd = wgid % NXCD, off = wgid / NXCD; wgid = (xcd < r ? xcd * (q + 1) : r * (q + 1) + (xcd - r) * q) + off; }
        const int nig = WGM * nN, gid = wgid / nig, fm = gid * WGM, gsz = (nM - fm) < WGM ? (nM - fm) : WGM;
        u.pm = fm + ((wgid % nig) % gsz); u.pn = (wgid % nig) / gsz; return true;
    }
    __device__ __forceinline__ void a_ready(const Unit&) const {}
    __device__ __forceinline__ void done(const Unit&) const {}
};
__device__ __forceinline__ unsigned cvt_pk_bf16(float lo, float hi) { unsigned r; asm volatile("v_cvt_pk_bf16_f32 %0, %1, %2" : "=v"(r) : "v"(lo), "v"(hi)); return r; }
template <class Epi, class Sched, bool ALIGN_EPI = false, bool SP2 = false>
__device__ __forceinline__ void gemm_phase(PG8_LAS unsigned char* lds, const Gemm g, const Sched& S, const Epi& E, const int tid) {
    const int wid = __builtin_amdgcn_readfirstlane(tid >> 6), lane = tid & 63, wr = wid >> 2, wc = wid & 3, fr = lane & 15, fq = lane >> 4;
    const int K = g.K, nt = K / BK;
    unsigned voffA[2], voffB[2];
#pragma unroll
    for (int i = 0; i < 2; ++i) { int R, C; stage_rc(tid * 16 + i * 8192, R, C); const int Rb = Epi::PERM ? ((R & ~31) + perm32(R & 31)) : R;
        voffA[i] = (unsigned)(R * K + C) * 2u; voffB[i] = (unsigned)(Rb * K + C) * 2u; }
    const size_t kstep = (size_t)(BK * 2);
    const size_t hstep = (size_t)HALF * K * 2;
    const size_t tstep = 2 * hstep;
    const unsigned ldsw = (unsigned)wid * 1024u;
    const int aoff = lds_byte(wr * 64 + fr, fq * 8), boff = lds_byte(wc * 32 + fr, fq * 8);
#define PG8_SA(b, h) (((b) * 2 + (h)) * HTB)
#define PG8_SB(b, h) ((4 + (b) * 2 + (h)) * HTB)
#define PG8_STAGE(bufoff, gbase, voff) do { _Pragma("unroll") for (int _i = 0; _i < 2; ++_i) \
        __builtin_amdgcn_global_load_lds((const unsigned*)((const char*)(gbase) + (voff)[_i]), (PG8_LAS unsigned*)(lds + (bufoff) + ldsw + _i * 8192), 16, 0, 0); } while (0)
#define PG8_LDA(dst, b, h) do { _Pragma("unroll") for (int m = 0; m < 4; ++m) _Pragma("unroll") for (int k = 0; k < 2; ++k) dst[m][k] = *(const PG8_LAS bf16x8*)(lds + PG8_SA(b, h) + aoff + m * 2048 + k * 1024); } while (0)
#define PG8_LDB(dst, b, h) do { _Pragma("unroll") for (int n = 0; n < 2; ++n) _Pragma("unroll") for (int k = 0; k < 2; ++k) dst[n][k] = *(const PG8_LAS bf16x8*)(lds + PG8_SB(b, h) + boff + n * 2048 + k * 1024); } while (0)
#define PG8_MMA(ai, bj, At, Bt) do { __builtin_amdgcn_s_setprio(1); _Pragma("unroll") for (int m = 0; m < 4; ++m) _Pragma("unroll") for (int n = 0; n < 2; ++n) _Pragma("unroll") for (int k = 0; k < 2; ++k) \
        acc[ai][bj][m][n] = __builtin_amdgcn_mfma_f32_16x16x32_bf16(Bt[n][k], At[m][k], acc[ai][bj][m][n], 0, 0, 0); __builtin_amdgcn_s_setprio(0); } while (0)
#define PG8_WAIT_V(n) asm volatile("s_waitcnt vmcnt(" #n ")" ::: "memory")
#define PG8_WAIT_L(n) asm volatile("s_waitcnt lgkmcnt(" #n ")" ::: "memory")
#define PG8_BAR __builtin_amdgcn_s_barrier()
#define PG8_SCHED __builtin_amdgcn_sched_barrier(0)
    Unit cur, nxt; int ui = 0;
    if (!S.next(0, cur)) return;
    f32x4 acc[2][2][4][2];
#pragma unroll
    for (int a = 0; a < 2; ++a)
#pragma unroll
        for (int b = 0; b < 2; ++b)
#pragma unroll
            for (int m = 0; m < 4; ++m)
#pragma unroll
                for (int n = 0; n < 2; ++n) acc[a][b][m][n] = (f32x4){0.f, 0.f, 0.f, 0.f};
    bf16x8 At[4][2], B0[2][2], B1[2][2];
    const char* cA = (const char*)g.A + (size_t)cur.pm * tstep; const char* cB = (const char*)g.Bt + (size_t)cur.pn * tstep;
    S.a_ready(cur);
    if constexpr (SP2) {
        PG8_STAGE(PG8_SB(0, 0), cB, voffB); PG8_STAGE(PG8_SB(0, 1), cB + hstep, voffB); PG8_STAGE(PG8_SA(0, 0), cA, voffA); PG8_STAGE(PG8_SA(0, 1), cA + hstep, voffA);
        if (wr == 1) PG8_BAR;
        PG8_WAIT_V(2); PG8_BAR;
        PG8_STAGE(PG8_SB(1, 0), cB + kstep, voffB); PG8_STAGE(PG8_SA(1, 0), cA + kstep, voffA); PG8_STAGE(PG8_SB(1, 1), cB + hstep + kstep, voffB);
        PG8_WAIT_V(6); PG8_BAR;
    } else {
        PG8_STAGE(PG8_SB(0, 0), cB, voffB); PG8_STAGE(PG8_SA(0, 0), cA, voffA); PG8_STAGE(PG8_SB(0, 1), cB + hstep, voffB); PG8_STAGE(PG8_SA(0, 1), cA + hstep, voffA);
        if (wr == 1) PG8_BAR;
        PG8_WAIT_V(4); PG8_BAR;
        PG8_STAGE(PG8_SB(1, 0), cB + kstep, voffB); PG8_STAGE(PG8_SA(1, 0), cA + kstep, voffA); PG8_STAGE(PG8_SB(1, 1), cB + hstep + kstep, voffB);
        PG8_WAIT_V(6); PG8_BAR;
    }
    for (;;) {
        const bool has_next = S.next(ui + 1, nxt);
        const char* nA = has_next ? (const char*)g.A + (size_t)nxt.pm * tstep : cA; const char* nB = has_next ? (const char*)g.Bt + (size_t)nxt.pn * tstep : cB;
        for (int t = 0; t < nt; t += 2) {
            const bool last = (t == nt - 2);
            const char* a1 = cA + (size_t)(t + 1) * kstep;
            const char* a2 = last ? nA : cA + (size_t)(t + 2) * kstep; const char* b2 = last ? nB : cB + (size_t)(t + 2) * kstep;
            const char* a3 = a2 + kstep; const char* b3 = b2 + kstep;
            if (last && has_next) S.a_ready(nxt);
            if constexpr (SP2) {
            PG8_LDB(B0, 0, 0); PG8_LDB(B1, 0, 1); PG8_SCHED; PG8_LDA(At, 0, 0); PG8_STAGE(PG8_SA(1, 1), a1 + hstep, voffA);
            PG8_WAIT_V(8); PG8_WAIT_L(0); PG8_BAR; PG8_MMA(0, 0, At, B0); PG8_MMA(0, 1, At, B1); PG8_BAR; PG8_SCHED;
            PG8_LDA(At, 0, 1); PG8_STAGE(PG8_SB(0, 0), b2, voffB); PG8_STAGE(PG8_SB(0, 1), b2 + hstep, voffB); PG8_STAGE(PG8_SA(0, 0), a2, voffA);
            PG8_WAIT_V(8); PG8_WAIT_L(0); PG8_BAR; PG8_MMA(1, 0, At, B0); PG8_MMA(1, 1, At, B1); PG8_BAR; PG8_SCHED;
            PG8_LDB(B0, 1, 0); PG8_LDB(B1, 1, 1); PG8_SCHED; PG8_LDA(At, 1, 0); PG8_STAGE(PG8_SA(0, 1), a2 + hstep, voffA);
            PG8_WAIT_V(8); PG8_WAIT_L(0); PG8_BAR; PG8_MMA(0, 0, At, B0); PG8_MMA(0, 1, At, B1); PG8_BAR; PG8_SCHED;
            PG8_LDA(At, 1, 1); PG8_STAGE(PG8_SB(1, 0), b3, voffB); PG8_STAGE(PG8_SB(1, 1), b3 + hstep, voffB); PG8_STAGE(PG8_SA(1, 0), a3, voffA);
            PG8_WAIT_V(8); PG8_WAIT_L(0); PG8_BAR; PG8_MMA(1, 0, At, B0); PG8_MMA(1, 1, At, B1); PG8_BAR; PG8_SCHED;
            } else {
            PG8_LDB(B0, 0, 0); PG8_SCHED; PG8_LDA(At, 0, 0); PG8_STAGE(PG8_SA(1, 1), a1 + hstep, voffA);
            PG8_WAIT_L(8); PG8_BAR; PG8_WAIT_L(0); PG8_MMA(0, 0, At, B0); PG8_BAR; PG8_SCHED;
            PG8_LDB(B1, 0, 1); PG8_STAGE(PG8_SB(0, 0), b2, voffB);
            PG8_BAR; PG8_WAIT_L(0); PG8_MMA(0, 1, At, B1); PG8_BAR;
            PG8_LDA(At, 0, 1); PG8_STAGE(PG8_SA(0, 0), a2, voffA);
            PG8_BAR; PG8_WAIT_L(0); PG8_MMA(1, 0, At, B0); PG8_BAR; PG8_SCHED;
            PG8_STAGE(PG8_SB(0, 1), b2 + hstep, voffB);
            PG8_WAIT_V(6); PG8_BAR; PG8_MMA(1, 1, At, B1); PG8_BAR;
            PG8_LDB(B0, 1, 0); PG8_SCHED; PG8_LDA(At, 1, 0); PG8_STAGE(PG8_SA(0, 1), a2 + hstep, voffA);
            PG8_WAIT_L(8); PG8_BAR; PG8_WAIT_L(0); PG8_MMA(0, 0, At, B0); PG8_BAR; PG8_SCHED;
            PG8_LDB(B1, 1, 1); PG8_STAGE(PG8_SB(1, 0), b3, voffB);
            PG8_BAR; PG8_WAIT_L(0); PG8_MMA(0, 1, At, B1); PG8_BAR;
            PG8_LDA(At, 1, 1); PG8_STAGE(PG8_SA(1, 0), a3, voffA);
            PG8_BAR; PG8_WAIT_L(0); PG8_MMA(1, 0, At, B0); PG8_BAR; PG8_SCHED;
            PG8_STAGE(PG8_SB(1, 1), b3 + hstep, voffB);
            PG8_WAIT_V(6); PG8_BAR; PG8_MMA(1, 1, At, B1); PG8_BAR;
            }
        }
        if constexpr (ALIGN_EPI) { if (wr == 0) PG8_BAR; }
        if constexpr (!Epi::AFTER_DRAIN) { E(acc, cur, wr, wc, fr, fq); S.done(cur); }
        if (!has_next) break;
#pragma unroll
        for (int a = 0; a < 2; ++a)
#pragma unroll
            for (int b = 0; b < 2; ++b)
#pragma unroll
                for (int m = 0; m < 4; ++m)
#pragma unroll
                    for (int n = 0; n < 2; ++n) acc[a][b][m][n] = (f32x4){0.f, 0.f, 0.f, 0.f};
        cur = nxt; cA = nA; cB = nB; ++ui;
        if constexpr (ALIGN_EPI) { if (wr == 1) PG8_BAR; }
    }
    PG8_WAIT_V(0);
    if constexpr (!ALIGN_EPI) { if (wr == 0) PG8_BAR; }
    PG8_BAR;
    if constexpr (Epi::AFTER_DRAIN) { E.fused(acc, cur, wr, wc, fr, fq, lds, wid, lane); S.done(cur); }
#undef PG8_SA
#undef PG8_SB
#undef PG8_STAGE
#undef PG8_LDA
#undef PG8_LDB
#undef PG8_MMA
#undef PG8_WAIT_V
#undef PG8_WAIT_L
#undef PG8_BAR
#undef PG8_SCHED
}
}

typedef unsigned short bf16;
typedef float f32x4 __attribute__((ext_vector_type(4)));
typedef float f32x2 __attribute__((ext_vector_type(2)));
typedef unsigned u32x4 __attribute__((ext_vector_type(4)));
typedef unsigned u32x2 __attribute__((ext_vector_type(2)));

#ifndef MK_MULTI
#define MK_MULTI 0
#endif

constexpr int Bn = 8, S = 4096, T = Bn * S, D = 1024, FF = 2816, DEPTH = 4;
constexpr float EPS = 1e-6f;
constexpr int GDN_NPAD = 4352, NSA_NPAD = 2816;
constexpr int LDS_BYTES = 147456;
constexpr size_t MiB = 1u << 20;
constexpr size_t WS_WGU = 1 * MiB;
constexpr size_t WS_WDN = WS_WGU + 88 * MiB;
constexpr size_t WS_WGI = WS_WDN + 44 * MiB;
constexpr size_t WS_WGO = WS_WGI + 17 * MiB;
constexpr size_t WS_WSI = WS_WGO + 4 * MiB;
constexpr size_t WS_WSO = WS_WSI + 6 * MiB;
constexpr size_t WS_WNI = WS_WSO + 2 * MiB;
constexpr size_t WS_WNO = WS_WNI + 6 * MiB;
constexpr size_t WS_WC1 = WS_WNO + 2 * MiB;
constexpr size_t WS_TAB = WS_WC1 + 2 * MiB;
constexpr size_t WS_HN  = 184 * MiB;
constexpr size_t WS_R   = WS_HN + 64 * MiB;
constexpr size_t WS_O32 = WS_R + 256 * MiB;
constexpr size_t WS_SM  = WS_O32 + 128 * MiB;
constexpr size_t WS_AB  = WS_SM;
constexpr size_t WS_GT  = WS_SM + 2 * MiB;
constexpr size_t WS_BP  = WS_SM + 8 * MiB;
constexpr size_t WS_END = WS_SM + 9 * MiB;
static_assert(WS_TAB + 8 * MiB <= WS_HN, "ws map");

__device__ __forceinline__ float bf2f(unsigned v) { return __uint_as_float(v << 16); }
__device__ __forceinline__ unsigned f2bf(float f) { unsigned u = __float_as_uint(f); return (u + 0x7fffu + ((u >> 16) & 1u)) >> 16; }
__device__ __forceinline__ unsigned pk2(float lo, float hi) { return f2bf(lo) | (f2bf(hi) << 16); }
__device__ __forceinline__ float wave_sum(float v) {
#pragma unroll
    for (int o = 1; o < 64; o <<= 1) v += __shfl_xor(v, o);
    return v;
}
__device__ __forceinline__ float wave_max(float v) {
#pragma unroll
    for (int o = 1; o < 64; o <<= 1) v = fmaxf(v, __shfl_xor(v, o));
    return v;
}
__device__ __forceinline__ float row_sum16(float v) {
#pragma unroll
    for (int o = 1; o < 16; o <<= 1) v += __shfl_xor(v, o);
    return v;
}
__device__ __forceinline__ float sigmoidf_(float x) { return 1.f / (1.f + __expf(-x)); }
__device__ __forceinline__ float siluf_(float x) { return x / (1.f + __expf(-x)); }
#define WAVE_SYNC() do { asm volatile("s_waitcnt lgkmcnt(0)" ::: "memory"); __builtin_amdgcn_wave_barrier(); } while (0)

namespace pg8 {
struct EpiSwiGLU {
    static constexpr bool PERM = true, AFTER_DRAIN = false;
    bf16_t* O;
    __device__ __forceinline__ void operator()(const f32x4 (&acc)[2][2][4][2], const Unit& u, int wr, int wc, int fr, int fq) const {
        const int row0 = u.pm * BM + wr * 64 + fr, col0 = u.pn * HALF + wc * 32 + 8 * fq;
#pragma unroll
        for (int ai = 0; ai < 2; ++ai)
#pragma unroll
            for (int m = 0; m < 4; ++m) {
                bf16_t* rowp = O + (size_t)(row0 + ai * HALF + m * 16) * FF + col0;
                float v[8];
#pragma unroll
                for (int n = 0; n < 2; ++n)
#pragma unroll
                    for (int j = 0; j < 4; ++j) { const float g = acc[ai][0][m][n][j], uu = acc[ai][1][m][n][j]; v[n * 4 + j] = g * __builtin_amdgcn_rcpf(1.f + __expf(-g)) * uu; }
                u32x4 w; w.x = cvt_pk_bf16(v[0], v[1]); w.y = cvt_pk_bf16(v[2], v[3]); w.z = cvt_pk_bf16(v[4], v[5]); w.w = cvt_pk_bf16(v[6], v[7]);
                *(u32x4*)rowp = w;
            }
    }
};
struct EpiResid {
    static constexpr bool PERM = false, AFTER_DRAIN = false;
    const float* base; float* out; float scale;
    __device__ __forceinline__ void operator()(const f32x4 (&acc)[2][2][4][2], const Unit& u, int wr, int wc, int fr, int fq) const {
        const int row0 = u.pm * BM + wr * 64 + fr, col0 = u.pn * BM + wc * 32 + 4 * fq;
#pragma unroll
        for (int ai = 0; ai < 2; ++ai)
#pragma unroll
            for (int m = 0; m < 4; ++m) {
                const size_t off = (size_t)(row0 + ai * HALF + m * 16) * D + col0;
#pragma unroll
                for (int bj = 0; bj < 2; ++bj)
#pragma unroll
                    for (int n = 0; n < 2; ++n) { const f32x4 bs = *(const f32x4*)(base + off + bj * HALF + n * 16); *(f32x4*)(out + off + bj * HALF + n * 16) = bs + acc[ai][bj][m][n] * scale; }
                asm volatile("" ::: "memory");
            }
    }
};
struct EpiProj {
    static constexpr bool PERM = true, AFTER_DRAIN = false;
    bf16_t* O; int ldc; int nmain; float* tail; int ldt; int nvalid;
    __device__ __forceinline__ void operator()(const f32x4 (&acc)[2][2][4][2], const Unit& u, int wr, int wc, int fr, int fq) const {
        const int row0 = u.pm * BM + wr * 64 + fr, colt = u.pn * BM, col0 = colt + wc * 32 + 8 * fq;
        if (colt + BM <= nmain) {
#pragma unroll
            for (int ai = 0; ai < 2; ++ai)
#pragma unroll
                for (int m = 0; m < 4; ++m) {
                    bf16_t* rowp = O + (size_t)(row0 + ai * HALF + m * 16) * ldc + col0;
#pragma unroll
                    for (int bj = 0; bj < 2; ++bj) { const f32x4 v0 = acc[ai][bj][m][0], v1 = acc[ai][bj][m][1];
                        u32x4 w; w.x = cvt_pk_bf16(v0[0], v0[1]); w.y = cvt_pk_bf16(v0[2], v0[3]); w.z = cvt_pk_bf16(v1[0], v1[1]); w.w = cvt_pk_bf16(v1[2], v1[3]);
                        *(u32x4*)(rowp + bj * HALF) = w; }
                }
        } else {
#pragma unroll
            for (int ai = 0; ai < 2; ++ai)
#pragma unroll
                for (int m = 0; m < 4; ++m) {
                    const size_t row = (size_t)(row0 + ai * HALF + m * 16);
#pragma unroll
                    for (int bj = 0; bj < 2; ++bj)
#pragma unroll
                        for (int n = 0; n < 2; ++n)
#pragma unroll
                            for (int j = 0; j < 4; ++j) { const int col = col0 + bj * HALF + 4 * n + j; if (col >= nmain && col < nvalid) tail[row * ldt + (col - nmain)] = acc[ai][bj][m][n][j]; }
                }
        }
    }
};
struct EpiF32 {
    static constexpr bool PERM = false, AFTER_DRAIN = false;
    float* C; int ldc;
    __device__ __forceinline__ void operator()(const f32x4 (&acc)[2][2][4][2], const Unit& u, int wr, int wc, int fr, int fq) const {
        const int row0 = u.pm * BM + wr * 64 + fr, col0 = u.pn * BM + wc * 32 + 4 * fq;
#pragma unroll
        for (int ai = 0; ai < 2; ++ai)
#pragma unroll
            for (int m = 0; m < 4; ++m) {
                float* rowp = C + (size_t)(row0 + ai * HALF + m * 16) * ldc + col0;
#pragma unroll
                for (int bj = 0; bj < 2; ++bj)
#pragma unroll
                    for (int n = 0; n < 2; ++n) *(f32x4*)(rowp + bj * HALF + n * 16) = acc[ai][bj][m][n];
            }
    }
};
}

__device__ __forceinline__ void xpose_item(const float* W, int K, int N, bf16* WT, int rowbase, float* scr, int k0, int n0, int lane) {
#pragma unroll 8
    for (int i = 0; i < 32; ++i) { const int kk = 2 * i + (lane >> 5), n = n0 + (lane & 31); scr[kk * 33 + (lane & 31)] = n < N ? W[(size_t)(k0 + kk) * N + n] : 0.f; }
    WAVE_SYNC();
    const int c = lane & 7;
#pragma unroll
    for (int j = 0; j < 4; ++j) { const int n = (lane >> 3) + 8 * j; const float* s = scr + (8 * c) * 33 + n;
        u32x4 o; o.x = pk2(s[0 * 33], s[1 * 33]); o.y = pk2(s[2 * 33], s[3 * 33]); o.z = pk2(s[4 * 33], s[5 * 33]); o.w = pk2(s[6 * 33], s[7 * 33]);
        *(u32x4*)(WT + (size_t)(rowbase + n) * K + k0 + 8 * c) = o; }
    WAVE_SYNC();
}
__device__ __forceinline__ void xpose_matrix(const float* W, int K, int N, int Npad, bf16* WT, int mode, float* scr, int gw, int NGW, int lane) {
    const int nblk = Npad / 32, nitems = (K / 64) * nblk;
    for (int it = gw; it < nitems; it += NGW) {
        const int kb = it / nblk, nb = it - kb * nblk, n0 = nb * 32;
        int rb = n0;
        if (mode == 1) rb = (n0 < FF) ? ((n0 >> 7) * 256 + (n0 & 127)) : ((((n0 - FF) >> 7) * 256) + 128 + ((n0 - FF) & 127));
        xpose_item(W, K, N, WT, rb, scr, kb * 64, n0, lane);
    }
}

__device__ __forceinline__ void phase_norm(const float* h, const float* w, bf16* out, int gw, int NGW, int lane) {
    f32x4 wv[4];
#pragma unroll
    for (int j = 0; j < 4; ++j) wv[j] = ((const f32x4*)w)[64 * j + lane];
    for (int m = gw; m < T; m += NGW) {
        const f32x4* xr = (const f32x4*)(h + (size_t)m * D) + lane;
        f32x4 v[4]; float s = 0.f;
#pragma unroll
        for (int j = 0; j < 4; ++j) { v[j] = xr[64 * j]; s += (v[j].x * v[j].x + v[j].y * v[j].y) + (v[j].z * v[j].z + v[j].w * v[j].w); }
        const float rstd = 1.f / sqrtf(wave_sum(s) * (1.f / D) + EPS);
        u32x2* o8 = (u32x2*)(out + (size_t)m * D) + lane;
#pragma unroll
        for (int j = 0; j < 4; ++j) { u32x2 o; o.x = pk2(v[j].x * rstd * wv[j].x, v[j].y * rstd * wv[j].y); o.y = pk2(v[j].z * rstd * wv[j].z, v[j].w * rstd * wv[j].w); o8[64 * j] = o; }
    }
}

__device__ __forceinline__ void phase_gdn_scan(unsigned char* lds, const bf16* proj, const float* ab, const float* convw, const float* A_log, const float* dt_bias,
                                               float* o32, int vblk, int nblk, int tid, int wid, int lane) {
    float* qs = (float*)lds;
    float* ks = qs + 64 * 128;
    float* vs = ks + 64 * 128;
    float* al = vs + 64 * 32;
    float* be = al + 64;
    float* os = be + 64;
    const int e = tid >> 4, dl = tid & 15;
    for (int item = vblk; item < 256; item += nblk) {
        const int bh = (item & 7) + 8 * (item >> 5), es = (item >> 3) & 3, b = bh >> 3, h = bh & 7;
        const float Ah = __expf(A_log[h]), dtb = dt_bias[h];
        float St[8];
#pragma unroll
        for (int i = 0; i < 8; ++i) St[i] = 0.f;
        for (int chunk = 0; chunk < S / 64; ++chunk) {
            const int t0 = chunk * 64;
            __syncthreads();
            for (int idx = tid; idx < 64 * 36; idx += 512) {
                const int tok = idx / 36, cgp = idx - tok * 36;
                int col; float* dst;
                if (cgp < 16) { col = h * 128 + cgp * 8; dst = qs + tok * 128 + cgp * 8; }
                else if (cgp < 32) { col = 1024 + h * 128 + (cgp - 16) * 8; dst = ks + tok * 128 + (cgp - 16) * 8; }
                else { col = 2048 + h * 128 + es * 32 + (cgp - 32) * 8; dst = vs + tok * 32 + (cgp - 32) * 8; }
                float a8[8];
#pragma unroll
                for (int i = 0; i < 8; ++i) a8[i] = 0.f;
#pragma unroll
                for (int j = 0; j < 4; ++j) {
                    const int ts = t0 + tok - 3 + j;
                    if (ts >= 0) {
                        const u32x4 xv = *(const u32x4*)(proj + (size_t)(b * S + ts) * 4096 + col);
                        const f32x4 w0 = *(const f32x4*)(convw + j * 3072 + col), w1 = *(const f32x4*)(convw + j * 3072 + col + 4);
                        a8[0] += bf2f(xv.x & 0xffffu) * w0.x; a8[1] += bf2f(xv.x >> 16) * w0.y; a8[2] += bf2f(xv.y & 0xffffu) * w0.z; a8[3] += bf2f(xv.y >> 16) * w0.w;
                        a8[4] += bf2f(xv.z & 0xffffu) * w1.x; a8[5] += bf2f(xv.z >> 16) * w1.y; a8[6] += bf2f(xv.w & 0xffffu) * w1.z; a8[7] += bf2f(xv.w >> 16) * w1.w;
                    }
                }
#pragma unroll
                for (int i = 0; i < 8; ++i) dst[i] = siluf_(a8[i]);
            }
            if (tid < 64) {
                const size_t tg = (size_t)(b * S + t0 + tid);
                const float a = ab[tg * 16 + h] + dtb, bb = ab[tg * 16 + 8 + h];
                const float sp = a > 20.f ? a : log1pf(__expf(a));
                al[tid] = __expf(-Ah * sp); be[tid] = sigmoidf_(bb);
            }
            __syncthreads();
#pragma unroll 4
            for (int r = 0; r < 16; ++r) {
                const int row = wid * 16 + r;
                float* p = row < 64 ? qs + row * 128 : ks + (row - 64) * 128;
                const float x0 = p[lane], x1 = p[lane + 64];
                const float ss = wave_sum(x0 * x0 + x1 * x1);
                const float sc = (1.f / sqrtf(ss + EPS)) * (row < 64 ? 0.08838834764831845f : 1.f);
                p[lane] = x0 * sc; p[lane + 64] = x1 * sc;
            }
            __syncthreads();
            for (int tt = 0; tt < 64; ++tt) {
                const f32x4 k0 = *(const f32x4*)(ks + tt * 128 + dl * 8), k1 = *(const f32x4*)(ks + tt * 128 + dl * 8 + 4);
                const f32x4 q0 = *(const f32x4*)(qs + tt * 128 + dl * 8), q1 = *(const f32x4*)(qs + tt * 128 + dl * 8 + 4);
                const float v = vs[tt * 32 + e], a = al[tt], bt = be[tt];
                float p = (k0.x * St[0] + k0.y * St[1]) + (k0.z * St[2] + k0.w * St[3]) + (k1.x * St[4] + k1.y * St[5]) + (k1.z * St[6] + k1.w * St[7]);
                p = row_sum16(p);
                const float vn = bt * (v - a * p);
                St[0] = a * St[0] + k0.x * vn; St[1] = a * St[1] + k0.y * vn; St[2] = a * St[2] + k0.z * vn; St[3] = a * St[3] + k0.w * vn;
                St[4] = a * St[4] + k1.x * vn; St[5] = a * St[5] + k1.y * vn; St[6] = a * St[6] + k1.z * vn; St[7] = a * St[7] + k1.w * vn;
                float o = (q0.x * St[0] + q0.y * St[1]) + (q0.z * St[2] + q0.w * St[3]) + (q1.x * St[4] + q1.y * St[5]) + (q1.z * St[6] + q1.w * St[7]);
                o = row_sum16(o);
                if (dl == 0) os[tt * 32 + e] = o;
            }
            __syncthreads();
            { const int tok = tid >> 3, c4 = tid & 7;
              *(f32x4*)(o32 + (size_t)(b * S + t0 + tok) * D + h * 128 + es * 32 + c4 * 4) = *(const f32x4*)(os + tok * 32 + c4 * 4); }
        }
    }
}
__device__ __forceinline__ void phase_gdn_post(const float* o32, const bf16* proj, const float* onorm, bf16* hn, int gw, int NGW, int lane) {
    const f32x4 wv = *(const f32x4*)(onorm + ((4 * lane) & 127));
    for (int m = gw; m < T; m += NGW) {
        const f32x4* xr = (const f32x4*)(o32 + (size_t)m * D) + lane;
        const u32x2* gr = (const u32x2*)(proj + (size_t)m * 4096 + 3072) + lane;
        u32x2* o8 = (u32x2*)(hn + (size_t)m * D) + lane;
#pragma unroll
        for (int j = 0; j < 4; ++j) {
            const f32x4 v = xr[64 * j]; const u32x2 g = gr[64 * j];
            float s = (v.x * v.x + v.y * v.y) + (v.z * v.z + v.w * v.w);
#pragma unroll
            for (int o = 1; o < 32; o <<= 1) s += __shfl_xor(s, o);
            const float rstd = 1.f / sqrtf(s * (1.f / 128.f) + EPS);
            u32x2 o; o.x = pk2(v.x * rstd * wv.x * siluf_(bf2f(g.x & 0xffffu)), v.y * rstd * wv.y * siluf_(bf2f(g.x >> 16)));
            o.y = pk2(v.z * rstd * wv.z * siluf_(bf2f(g.y & 0xffffu)), v.w * rstd * wv.w * siluf_(bf2f(g.y >> 16)));
            o8[64 * j] = o;
        }
    }
}
__device__ __forceinline__ void phase_sc_post(const bf16* proj, const float* cw, bf16* hn, int gtid, int NT) {
    for (int idx = gtid; idx < T * 128; idx += NT) {
        const int m = idx >> 7, c8 = (idx & 127) * 8, s = m & (S - 1);
        float y[8];
#pragma unroll
        for (int i = 0; i < 8; ++i) y[i] = 0.f;
#pragma unroll
        for (int j = 0; j < 3; ++j) {
            if (s - 2 + j >= 0) {
                const bf16* pr = proj + (size_t)(m - 2 + j) * 3072;
                const u32x4 cv = *(const u32x4*)(pr + 1024 + c8), xv = *(const u32x4*)(pr + 2048 + c8);
                const f32x4 w0 = *(const f32x4*)(cw + j * 1024 + c8), w1 = *(const f32x4*)(cw + j * 1024 + c8 + 4);
                y[0] += w0.x * bf2f(cv.x & 0xffffu) * bf2f(xv.x & 0xffffu); y[1] += w0.y * bf2f(cv.x >> 16) * bf2f(xv.x >> 16);
                y[2] += w0.z * bf2f(cv.y & 0xffffu) * bf2f(xv.y & 0xffffu); y[3] += w0.w * bf2f(cv.y >> 16) * bf2f(xv.y >> 16);
                y[4] += w1.x * bf2f(cv.z & 0xffffu) * bf2f(xv.z & 0xffffu); y[5] += w1.y * bf2f(cv.z >> 16) * bf2f(xv.z >> 16);
                y[6] += w1.z * bf2f(cv.w & 0xffffu) * bf2f(xv.w & 0xffffu); y[7] += w1.w * bf2f(cv.w >> 16) * bf2f(xv.w >> 16);
            }
        }
        const u32x4 bv = *(const u32x4*)(proj + (size_t)m * 3072 + c8);
        u32x4 o;
        o.x = pk2(y[0] * bf2f(bv.x & 0xffffu), y[1] * bf2f(bv.x >> 16)); o.y = pk2(y[2] * bf2f(bv.y & 0xffffu), y[3] * bf2f(bv.y >> 16));
        o.z = pk2(y[4] * bf2f(bv.z & 0xffffu), y[5] * bf2f(bv.z >> 16)); o.w = pk2(y[6] * bf2f(bv.w & 0xffffu), y[7] * bf2f(bv.w >> 16));
        *(u32x4*)(hn + (size_t)m * D + c8) = o;
    }
}
__device__ __forceinline__ void phase_nsa_post(unsigned char* lds, const bf16* proj, const float* qnorm, const float* knorm, const f32x2* tab,
                                               bf16* QN, bf16* KS, bf16* KW, bf16* KCH, bf16* VCH, bf16* VST, bf16* VWT, int gw, int NGW, int wid, int lane) {
    {
        bf16* tile = (bf16*)lds + wid * (64 * 66);
        for (int item = gw; item < 2 * 32 * 64; item += NGW) {
            const int st = item & 63, bh = (item >> 6) & 31, which = item >> 11, b = bh >> 2, hk = bh & 3;
            const bf16* src = proj + ((size_t)b * S + st * 64) * 2560 + (which ? 2304 : 1792) + hk * 64 + lane;
#pragma unroll 8
            for (int i = 0; i < 64; ++i) tile[i * 66 + lane] = src[(size_t)i * 2560];
            WAVE_SYNC();
            bf16* dst = (which ? VWT : VST) + (size_t)bh * 64 * S + st * 64 + lane;
#pragma unroll 8
            for (int d = 0; d < 64; ++d) dst[(size_t)d * S] = tile[lane * 66 + d];
            WAVE_SYNC();
        }
    }
    const float qw = qnorm[lane], kw1 = knorm[64 + lane], kw2 = knorm[128 + lane];
    for (int m = gw; m < T; m += NGW) {
        const int b = m >> 12, s = m & (S - 1);
        const bf16* pr = proj + (size_t)m * 2560;
        const f32x2 cs = tab[(size_t)m * 32 + (lane & 31)];
#pragma unroll 4
        for (int hh = 0; hh < 16; ++hh) {
            const float x = bf2f(pr[hh * 64 + lane]);
            const float ss = wave_sum(x * x);
            QN[((size_t)(b * 16 + hh) * S + s) * 64 + lane] = (bf16)f2bf(x * (1.f / sqrtf(ss * (1.f / 64.f) + EPS)) * qw);
        }
#pragma unroll
        for (int hk = 0; hk < 4; ++hk) {
            const size_t o = ((size_t)(b * 4 + hk) * S + s) * 64 + lane;
            { const float x = bf2f(pr[1536 + hk * 64 + lane]); const float ss = wave_sum(x * x);
              const float y = x * (1.f / sqrtf(ss * (1.f / 64.f) + EPS)) * kw1; const float yp = __shfl_xor(y, 32);
              KS[o] = (bf16)f2bf(y * cs.x + (lane < 32 ? -yp : yp) * cs.y); }
            { const float x = bf2f(pr[2048 + hk * 64 + lane]); const float ss = wave_sum(x * x);
              const float y = x * (1.f / sqrtf(ss * (1.f / 64.f) + EPS)) * kw2; const float yp = __shfl_xor(y, 32);
              KW[o] = (bf16)f2bf(y * cs.x + (lane < 32 ? -yp : yp) * cs.y); }
            KCH[o] = pr[1024 + hk * 64 + lane];
            VCH[o] = pr[1280 + hk * 64 + lane];
        }
    }
}
__device__ __forceinline__ void phase_cmp2(unsigned char* lds, const float* Pk, const float* Pv, const float* biasp, const float* w2, const float* b2, const float* knorm0,
                                           bf16* KC, bf16* VC, int gw, int NGW, int wid, int lane) {
    float* hs = (float*)lds + wid * 256;
    for (int item = gw; item < 2 * 32 * 256; item += NGW) {
        const int i = item & 255, bh = (item >> 8) & 31, kind = item >> 13;
        bf16* outp = kind ? VC + ((size_t)bh * 64 + lane) * 256 + i : KC + ((size_t)bh * 256 + i) * 64 + lane;
        if (i == 255) { *outp = 0; continue; }
        const float* P = kind ? Pv : Pk;
        const float* r0 = P + ((size_t)bh * 256 + i) * 512; const float* r1 = r0 + 512 + 256;
#pragma unroll
        for (int j = 0; j < 4; ++j) { const int n = lane + 64 * j; const float x = r0[n] + r1[n] + biasp[kind * 256 + n];
            const float uu = 0.7978845608028654f * (x + 0.044715f * x * x * x);
            const float th = 1.f - 2.f / (1.f + __expf(2.f * uu));
            hs[n] = 0.5f * x * (1.f + th); }
        WAVE_SYNC();
        float acc = b2[kind * 64 + lane];
        const float* w = w2 + (size_t)kind * 256 * 64 + lane;
#pragma unroll 8
        for (int n = 0; n < 256; ++n) acc += hs[n] * w[n * 64];
        if (kind == 0) { const float ss = wave_sum(acc * acc); acc = acc * (1.f / sqrtf(ss * (1.f / 64.f) + EPS)) * knorm0[lane]; }
        *outp = (bf16)f2bf(acc);
        WAVE_SYNC();
    }
}
#define MFMA32(a, b, c) __builtin_amdgcn_mfma_f32_32x32x16_bf16((a), (b), (c), 0, 0, 0)
typedef short bf16x8v __attribute__((ext_vector_type(8)));
typedef float f32x16 __attribute__((ext_vector_type(16)));
typedef __bf16 bf16v2 __attribute__((ext_vector_type(2)));
constexpr int KV_STRIDE = 144;
constexpr int KV_BUF = 2 * 64 * KV_STRIDE;
constexpr int ATT_IMP_OFF = 2 * KV_BUF;
constexpr int ATT_MSK_OFF = ATT_IMP_OFF + 8 * 2048;
__device__ __forceinline__ unsigned pkbf(float a, float b) { f32x2 v = {a, b}; return __builtin_bit_cast(unsigned, __builtin_convertvector(v, bf16v2)); }

template <bool IMP>
__device__ __forceinline__ void attn_tile(const unsigned char* buf, int tt, int key0, int lo, int hi, const bf16x8v (&qf)[4],
                                          f32x16 (&O)[2], f32x16 (&IM)[2], float& m, float& l, const bf16* ovt, int r, int h, int pr) {
    f32x16 sacc;
#pragma unroll
    for (int i = 0; i < 16; ++i) sacc[i] = 0.f;
    const unsigned char* kb = buf + (32 * tt + pr) * KV_STRIDE + h * 16;
#pragma unroll
    for (int ks = 0; ks < 4; ++ks) { const bf16x8v a = *(const bf16x8v*)(kb + ks * 32); sacc = MFMA32(a, qf[ks], sacc); }
    const int kb0 = key0 + 8 * h;
    float mx = -1e30f;
#pragma unroll
    for (int i = 0; i < 16; ++i) { const int key = kb0 + 16 * (i >> 3) + (i & 7); const bool ok = (key >= lo) && (key <= hi);
        const float sv = ok ? sacc[i] * 0.18033688011112042f : -1e30f; sacc[i] = sv; mx = fmaxf(mx, sv); }
    mx = fmaxf(mx, __shfl_xor(mx, 32));
    const float mnew = fmaxf(m, mx), corr = __builtin_amdgcn_exp2f(m - mnew);
    m = mnew;
    float psum = 0.f;
#pragma unroll
    for (int i = 0; i < 16; ++i) { const float p = sacc[i] > -1e29f ? __builtin_amdgcn_exp2f(sacc[i] - mnew) : 0.f; psum += p; sacc[i] = p; }
    l = l * corr + psum;
    if (__any(corr != 1.f)) {
#pragma unroll
        for (int i = 0; i < 16; ++i) { O[0][i] *= corr; O[1][i] *= corr; }
        if (IMP) {
#pragma unroll
            for (int i = 0; i < 16; ++i) { IM[0][i] *= corr; IM[1][i] *= corr; }
        }
    }
    bf16x8v pf[2];
#pragma unroll
    for (int sx = 0; sx < 2; ++sx) { u32x4 w; w.x = pkbf(sacc[8 * sx], sacc[8 * sx + 1]); w.y = pkbf(sacc[8 * sx + 2], sacc[8 * sx + 3]); w.z = pkbf(sacc[8 * sx + 4], sacc[8 * sx + 5]); w.w = pkbf(sacc[8 * sx + 6], sacc[8 * sx + 7]);
        pf[sx] = __builtin_bit_cast(bf16x8v, w); }
    const unsigned char* vb = buf + 64 * KV_STRIDE + r * KV_STRIDE + (32 * tt + 8 * h) * 2;
#pragma unroll
    for (int dt = 0; dt < 2; ++dt)
#pragma unroll
        for (int sx = 0; sx < 2; ++sx) { const bf16x8v a = *(const bf16x8v*)(vb + dt * 32 * KV_STRIDE + sx * 32); O[dt] = MFMA32(a, pf[sx], O[dt]); }
    if (IMP) {
#pragma unroll
        for (int st = 0; st < 2; ++st)
#pragma unroll
            for (int sx = 0; sx < 2; ++sx) { const bf16x8v a = *(const bf16x8v*)(ovt + (32 * st + r) * 256 + key0 + 16 * sx + 8 * h); IM[st] = MFMA32(a, pf[sx], IM[st]); }
    }
}

template <int MODE>
__device__ __forceinline__ void attn_branch(unsigned char* kvbuf, const bf16* Kg0, const bf16* VTg0, int vts, unsigned long long blkmask, int t, int nv, unsigned long long selm,
                                            int wlo, int whi, const bf16x8v (&qf)[4], f32x16 (&O)[2], f32x16 (&IM)[2], float& l, const bf16* ovt, int tid, int r, int h, int pr) {
    float m = -1e30f;
    l = 0.f;
#pragma unroll
    for (int i = 0; i < 16; ++i) { O[0][i] = 0.f; O[1][i] = 0.f; IM[0][i] = 0.f; IM[1][i] = 0.f; }
    const int srow = tid >> 3, sch = tid & 7;
    int j = __builtin_ctzll(blkmask);
    unsigned long long rest = blkmask & (blkmask - 1);
    u32x4 kr = *(const u32x4*)(Kg0 + (size_t)(64 * j + srow) * 64 + sch * 8);
    u32x4 vr = *(const u32x4*)(VTg0 + (size_t)srow * vts + 64 * j + sch * 8);
    *(u32x4*)(kvbuf + srow * KV_STRIDE + sch * 16) = kr;
    *(u32x4*)(kvbuf + 64 * KV_STRIDE + srow * KV_STRIDE + sch * 16) = vr;
    int cur = 0;
    for (;;) {
        __syncthreads();
        const bool more = rest != 0ull;
        int jn = 0;
        if (more) { jn = __builtin_ctzll(rest); rest &= rest - 1;
            kr = *(const u32x4*)(Kg0 + (size_t)(64 * jn + srow) * 64 + sch * 8);
            vr = *(const u32x4*)(VTg0 + (size_t)srow * vts + 64 * jn + sch * 8); }
        const unsigned char* buf = kvbuf + cur * KV_BUF;
        int lo, hi;
        if (MODE == 0) { lo = 0; hi = nv - 1; }
        else if (MODE == 1) { lo = 0; hi = ((selm >> j) & 1ull) ? t : -1; }
        else { lo = t - 511; hi = t; }
#pragma unroll
        for (int tt = 0; tt < 2; ++tt) {
            const int key0 = 64 * j + 32 * tt;
            if (key0 > whi || key0 + 31 < wlo) continue;
            attn_tile<MODE == 0>(buf, tt, key0, lo, hi, qf, O, IM, m, l, ovt, r, h, pr);
        }
        if (!more) break;
        *(u32x4*)(kvbuf + (cur ^ 1) * KV_BUF + srow * KV_STRIDE + sch * 16) = kr;
        *(u32x4*)(kvbuf + (cur ^ 1) * KV_BUF + 64 * KV_STRIDE + srow * KV_STRIDE + sch * 16) = vr;
        cur ^= 1; j = jn;
    }
    __syncthreads();
}

__device__ __forceinline__ void phase_nsa_attn(unsigned char* lds, const bf16* QN, const bf16* KS, const bf16* KW, const bf16* VST, const bf16* VWT, const bf16* KCb, const bf16* VCT,
                                               const bf16* ovt, const float* gates, const f32x2* tab, bf16* hn, int vblk, int nblk, int tid, int wid, int lane) {
    const int r = lane & 31, h = lane >> 5, pr = (r & ~12) | ((r & 4) << 1) | ((r & 8) >> 1);
    float* imp_s = (float*)(lds + ATT_IMP_OFF + wid * 2048);
    unsigned long long* msk_s = (unsigned long long*)(lds + ATT_MSK_OFF);
    unsigned* uni_s = (unsigned*)(lds + ATT_MSK_OFF + 512);
    for (int item = vblk; item < Bn * 4 * 64; item += nblk) {
        const int rnd = item / nblk, wv = item - rnd * nblk;
        const int bh = wv & 31, sub = wv >> 5, per = nblk >> 5;
        int qb = rnd * per + ((rnd & 1) ? (per - 1 - sub) : sub);
        if (nblk != 256) { qb = item >> 5; }
        const int bhh = (nblk != 256) ? (item & 31) : bh;
        const int b = bhh >> 2, hk = bhh & 3;
        const int t0 = qb * 64, tw0 = t0 + 8 * wid, t = tw0 + (r & 7), g = r >> 3;
        const size_t tok = (size_t)b * S + t;
        if (tid == 0) { unsigned z = 0u; asm volatile("" : "+v"(z)); uni_s[0] = z; uni_s[1] = z; }
        bf16x8v qn[4], qr[4];
        {
            const bf16* qp = QN + ((size_t)(b * 16 + hk * 4 + g) * S + t) * 64 + 8 * h;
#pragma unroll
            for (int ks = 0; ks < 4; ++ks) qn[ks] = *(const bf16x8v*)(qp + 16 * ks);
            const f32x2* cp = tab + tok * 32 + 8 * h;
#pragma unroll
            for (int kl = 0; kl < 2; ++kl) {
                u32x4 wlo_, whi_;
                const u32x4 a = __builtin_bit_cast(u32x4, qn[kl]), c = __builtin_bit_cast(u32x4, qn[kl + 2]);
#pragma unroll
                for (int jj = 0; jj < 4; ++jj) {
                    const f32x2 cs0 = cp[16 * kl + 2 * jj], cs1 = cp[16 * kl + 2 * jj + 1];
                    const float x0 = bf2f(a[jj] & 0xffffu), x1 = bf2f(a[jj] >> 16), y0 = bf2f(c[jj] & 0xffffu), y1 = bf2f(c[jj] >> 16);
                    wlo_[jj] = pkbf(x0 * cs0.x - y0 * cs0.y, x1 * cs1.x - y1 * cs1.y);
                    whi_[jj] = pkbf(y0 * cs0.x + x0 * cs0.y, y1 * cs1.x + x1 * cs1.y);
                }
                qr[kl] = __builtin_bit_cast(bf16x8v, wlo_); qr[kl + 2] = __builtin_bit_cast(bf16x8v, whi_);
            }
        }
        const float* gp = gates + tok * 48 + (hk * 4 + g) * 3;
        const float g0 = sigmoidf_(gp[0]), g1 = sigmoidf_(gp[1]), g2 = sigmoidf_(gp[2]);
        f32x16 acc[2], O[2], IM[2];
        float l;
        const int nv = t >= 31 ? ((t - 31) >> 4) + 1 : 0;
        const int nvw = ((tw0 + 7 - 31) >> 4) + 1;
        const int nvmax = 4 * qb + 3;
        {
            const int ncb = (nvmax + 63) >> 6;
            const unsigned long long bm = ncb >= 64 ? ~0ull : ((1ull << ncb) - 1ull);
            attn_branch<0>(lds, KCb + (size_t)bhh * 256 * 64, VCT + (size_t)bhh * 64 * 256, 256, bm, t, nv, 0ull, 0, (tw0 + 7 >= 31 ? nvw - 1 : -1), qn, O, IM, l, ovt, tid, r, h, pr);
        }
        {
            const float lt = l + __shfl_xor(l, 32), inv = lt > 0.f ? 1.f / lt : 0.f, sc = inv * g0;
#pragma unroll
            for (int i = 0; i < 16; ++i) { acc[0][i] = O[0][i] * sc; acc[1][i] = O[1][i] * sc; }
#pragma unroll
            for (int st = 0; st < 2; ++st)
#pragma unroll
                for (int i = 0; i < 16; ++i) { float v = IM[st][i] * inv; v += __shfl_xor(v, 8); v += __shfl_xor(v, 16);
                    if (r < 8) imp_s[r * 64 + 32 * st + (i & 3) + 8 * (i >> 2) + 4 * h] = v; }
        }
        WAVE_SYNC();
        {
            unsigned long long um = 0ull;
            for (int tk = 0; tk < 8; ++tk) {
                const float imp = imp_s[tk * 64 + lane];
                const bool sv = lane <= qb, forced = (lane == 0) || (lane == qb) || (lane + 1 == qb);
                const float score = sv ? (forced ? 1e9f : imp) : -1.f;
                int rank = 0;
#pragma unroll 4
                for (int i = 0; i < 64; ++i) { const float si = __uint_as_float(__builtin_amdgcn_readlane(__float_as_uint(score), i)); rank += (si > score || (si == score && i < lane)) ? 1 : 0; }
                const unsigned long long mk = __ballot((rank < 16) && (score >= 0.f));
                um |= mk;
                if (lane == 0) msk_s[wid * 8 + tk] = mk;
            }
            if (lane == 0) { atomicOr(&uni_s[0], (unsigned)um); atomicOr(&uni_s[1], (unsigned)(um >> 32)); }
        }
        __syncthreads();
        const unsigned long long selm = msk_s[wid * 8 + (r & 7)];
        const unsigned long long uni = (unsigned long long)uni_s[0] | ((unsigned long long)uni_s[1] << 32);
        attn_branch<1>(lds, KS + (size_t)bhh * S * 64, VST + (size_t)bhh * 64 * S, S, uni, t, 0, selm, 0, tw0 + 7, qr, O, IM, l, ovt, tid, r, h, pr);
        {
            const float lt = l + __shfl_xor(l, 32), sc = g1 / lt;
#pragma unroll
            for (int i = 0; i < 16; ++i) { acc[0][i] += O[0][i] * sc; acc[1][i] += O[1][i] * sc; }
        }
        {
            const int jlo = qb >= 8 ? qb - 8 : 0;
            const unsigned long long bm = (qb >= 63 ? ~0ull : ((1ull << (qb + 1)) - 1ull)) & ~((1ull << jlo) - 1ull);
            attn_branch<2>(lds, KW + (size_t)bhh * S * 64, VWT + (size_t)bhh * 64 * S, S, bm, t, 0, 0ull, tw0 - 511, tw0 + 7, qr, O, IM, l, ovt, tid, r, h, pr);
        }
        {
            const float lt = l + __shfl_xor(l, 32), sc = g2 / lt;
            bf16* op = hn + tok * D + (hk * 4 + g) * 64 + 4 * h;
#pragma unroll
            for (int dt = 0; dt < 2; ++dt)
#pragma unroll
                for (int q4 = 0; q4 < 4; ++q4) {
                    u32x2 w; w.x = pkbf(acc[dt][4 * q4] + O[dt][4 * q4] * sc, acc[dt][4 * q4 + 1] + O[dt][4 * q4 + 1] * sc);
                    w.y = pkbf(acc[dt][4 * q4 + 2] + O[dt][4 * q4 + 2] * sc, acc[dt][4 * q4 + 3] + O[dt][4 * q4 + 3] * sc);
                    *(u32x2*)(op + 32 * dt + 8 * q4) = w;
                }
        }
    }
}

struct Args { const void* in[24]; float* out; unsigned char* ws; int lo, hi; };

__host__ __device__ constexpr int mixer_inner_phases(int kind) { return kind == 0 ? 2 : (kind == 1 ? 1 : 4); }
__host__ __device__ constexpr int total_phases() { int n = 1; for (int L = 0; L < DEPTH; ++L) n += 6 + 3 + mixer_inner_phases(L % 3); return n; }

__global__ void __launch_bounds__(512, 2) mega(Args args) {
    extern __shared__ __attribute__((aligned(16))) unsigned char lds[];
    cg::grid_group grid = cg::this_grid();
    bool again = false;
    for (int ph = args.lo; ph < args.hi; ++ph) {
        int type = 0, s = 0, L = 0;
        if (ph > 0) {
            int p = ph - 1;
            for (L = 0; L < DEPTH; ++L) { const int n = 9 + mixer_inner_phases(L % 3); if (p < n) break; p -= n; }
            const int inner = mixer_inner_phases(L % 3), kind = L % 3;
            if (p < 3) { type = 1 + p; s = 2 * L; }
            else if (p == 3) type = 4;
            else if (p == 4) type = 5;
            else if (p < 5 + inner) { const int q = p - 5; type = kind == 0 ? 6 + q : (kind == 1 ? 8 : 9 + q); }
            else if (p == 5 + inner) type = 13;
            else { type = 1 + (p - 6 - inner); s = 2 * L + 1; }
        }
        int tid_ = threadIdx.x; asm volatile("" : "+v"(tid_));
        int G_ = gridDim.x, bx_ = blockIdx.x; asm volatile("" : "+s"(G_), "+s"(bx_));
        const int tid = tid_, lane = tid & 63, wid = __builtin_amdgcn_readfirstlane(tid >> 6);
        const int G = G_, bx = bx_;
        const int vcu = (G % 8 == 0) ? (bx % 8) * (G / 8) + bx / 8 : bx;
        const int gw = vcu * 8 + wid, NGW = G * 8;
        unsigned char* ws = args.ws; asm volatile("" : "+s"(ws));
        PG8_LAS unsigned char* ldsl = (PG8_LAS unsigned char*)lds;
        float* hout = args.out; asm volatile("" : "+s"(hout));
        bf16* HN = (bf16*)(ws + WS_HN);
        bf16* RB = (bf16*)(ws + WS_R);
        f32x2* tab = (f32x2*)(ws + WS_TAB);
        const int kind = L % 3, jj = L / 3;
        bf16* QN = RB + (size_t)T * 2560;
        bf16* KSb = QN + (size_t)T * 1024;
        bf16* KWb = KSb + (size_t)T * 256;
        bf16* KCH = (bf16*)(ws + WS_O32);
        bf16* VCH = KCH + (size_t)T * 256;
        float* Pk = (float*)(ws + WS_O32 + 32 * MiB);
        float* Pv = Pk + (size_t)8192 * 512;
        bf16* KC = (bf16*)(ws + WS_O32 + 64 * MiB);
        bf16* VC = (bf16*)(ws + WS_O32 + 65 * MiB);
        bf16* OVT = (bf16*)(ws + WS_BP + 65536);
        bf16* VST = (bf16*)(ws + WS_O32 + 68 * MiB);
        bf16* VWT = (bf16*)(ws + WS_O32 + 84 * MiB);
        switch (type) {
        case 0: {
            float* scr = (float*)lds + wid * (64 * 33);
            for (int mi = 0; mi < 28; ++mi) {
                const float* W; int K, N, Npad, mode = 0; bf16* WT;
                if (mi < 8)       { W = (const float*)args.in[3] + (size_t)mi * D * 2 * FF; K = D; N = 2 * FF; Npad = N; mode = 1; WT = (bf16*)(ws + WS_WGU) + (size_t)mi * 2 * FF * D; }
                else if (mi < 16) { const int i = mi - 8; W = (const float*)args.in[4] + (size_t)i * FF * D; K = FF; N = D; Npad = N; WT = (bf16*)(ws + WS_WDN) + (size_t)i * D * FF; }
                else if (mi < 18) { const int i = mi - 16; W = (const float*)args.in[6] + (size_t)i * D * 4112; K = D; N = 4112; Npad = GDN_NPAD; WT = (bf16*)(ws + WS_WGI) + (size_t)i * GDN_NPAD * D; }
                else if (mi < 20) { const int i = mi - 18; W = (const float*)args.in[11] + (size_t)i * D * D; K = D; N = D; Npad = N; WT = (bf16*)(ws + WS_WGO) + (size_t)i * D * D; }
                else if (mi == 20) { W = (const float*)args.in[12]; K = D; N = 3072; Npad = N; WT = (bf16*)(ws + WS_WSI); }
                else if (mi == 21) { W = (const float*)args.in[14]; K = D; N = D; Npad = N; WT = (bf16*)(ws + WS_WSO); }
                else if (mi == 22) { W = (const float*)args.in[15]; K = D; N = 2608; Npad = NSA_NPAD; WT = (bf16*)(ws + WS_WNI); }
                else if (mi == 23) { W = (const float*)args.in[23]; K = D; N = D; Npad = N; WT = (bf16*)(ws + WS_WNO); }
                else { const int i = mi - 24, kd = i >> 1, hf = i & 1;
                    W = (const float*)args.in[19] + (size_t)kd * 2048 * 256 + (size_t)hf * 1024 * 256; K = 1024; N = 256; Npad = 256; WT = (bf16*)(ws + WS_WC1) + (size_t)kd * 512 * 1024 + (size_t)hf * 256 * 1024; }
                xpose_matrix(W, K, N, Npad, WT, mode, scr, gw, NGW, lane);
            }
            const int* positions = (const int*)args.in[1];
            for (int idx = bx * 512 + tid; idx < T * 32; idx += G * 512) {
                const int tk = idx >> 5, i = idx & 31;
                const float inv = 1.0f / exp2f((float)(2 * i) * (13.287712379549449f / 64.f));
                const float ang = (float)positions[tk] * inv;
                const double rev = (double)ang * 0.15915494309189535;
                const float fr = (float)(rev - rint(rev));
                f32x2 v; v.x = __builtin_amdgcn_cosf(fr); v.y = __builtin_amdgcn_sinf(fr);
                tab[idx] = v;
            }
            for (int idx = bx * 512 + tid; idx < 64 * 256; idx += G * 512) {
                const int sj = idx >> 8, i = idx & 255, q = i >> 2, rem = i & 3;
                OVT[idx] = (bf16)(rem < 3 ? (q == sj ? 0x3F80 : 0) : ((q == sj || q + 1 == sj) ? 0x3F00 : 0));
            }
            if (bx < 2 && tid < 256) {
                const float* pe = (const float*)args.in[18] + (size_t)bx * 2048;
                const float* w1 = (const float*)args.in[19] + (size_t)bx * 2048 * 256 + tid;
                float acc = ((const float*)args.in[20])[bx * 256 + tid];
                for (int k = 0; k < 2048; ++k) acc += pe[k] * w1[(size_t)k * 256];
                ((float*)(ws + WS_BP))[bx * 256 + tid] = acc;
            }
        } break;
        case 1: phase_norm(s == 0 ? (const float*)args.in[0] : hout, (const float*)args.in[2] + (size_t)s * D, HN, gw, NGW, lane); break;
        case 2: {
            pg8::Gemm g{HN, (const bf16*)(ws + WS_WGU) + (size_t)s * 2 * FF * D, T, 2 * FF, D}; pg8::StaticOrder SO; SO.init(T, 2 * FF, G, bx);
            pg8::EpiSwiGLU E{RB};
            pg8::gemm_phase<pg8::EpiSwiGLU, pg8::StaticOrder, true, true>(ldsl, g, SO, E, tid); } break;
        case 3: {
            pg8::Gemm g{RB, (const bf16*)(ws + WS_WDN) + (size_t)s * D * FF, T, D, FF}; pg8::StaticOrder SO; SO.init(T, D, G, bx);
            pg8::EpiResid E{s == 0 ? (const float*)args.in[0] : hout, hout, 0.5f};
            pg8::gemm_phase<pg8::EpiResid, pg8::StaticOrder, true, true>(ldsl, g, SO, E, tid); } break;
        case 4: phase_norm(hout, (const float*)args.in[5] + (size_t)L * D, HN, gw, NGW, lane); break;
        case 5: {
            const bf16* Wt; int Np, ldc, nmain, ldt, nvalid; float* tail;
            if (kind == 0) { Wt = (const bf16*)(ws + WS_WGI) + (size_t)jj * GDN_NPAD * D; Np = GDN_NPAD; ldc = 4096; nmain = 4096; tail = (float*)(ws + WS_AB); ldt = 16; nvalid = 4112; }
            else if (kind == 1) { Wt = (const bf16*)(ws + WS_WSI); Np = 3072; ldc = 3072; nmain = 3072; tail = (float*)(ws + WS_AB); ldt = 16; nvalid = 3072; }
            else { Wt = (const bf16*)(ws + WS_WNI); Np = NSA_NPAD; ldc = 2560; nmain = 2560; tail = (float*)(ws + WS_GT); ldt = 48; nvalid = 2608; }
            pg8::Gemm g{HN, Wt, T, Np, D}; pg8::StaticOrder SO; SO.init(T, Np, G, bx);
            pg8::EpiProj E{RB, ldc, nmain, tail, ldt, nvalid};
            pg8::gemm_phase<pg8::EpiProj, pg8::StaticOrder, true, true>(ldsl, g, SO, E, tid); } break;
        case 6:
#ifndef DIS_SCAN
            phase_gdn_scan(lds, RB, (const float*)(ws + WS_AB), (const float*)args.in[7] + (size_t)jj * 4 * 3072, (const float*)args.in[8] + jj * 8, (const float*)args.in[9] + jj * 8,
                           (float*)(ws + WS_O32), bx, G, tid, wid, lane);
#endif
            break;
        case 7:
#ifndef DIS_GPOST
            phase_gdn_post((const float*)(ws + WS_O32), RB, (const float*)args.in[10] + jj * 128, HN, gw, NGW, lane);
#endif
            break;
        case 8:
#ifndef DIS_SPOST
            phase_sc_post(RB, (const float*)args.in[13], HN, vcu * 512 + tid, G * 512);
#endif
            break;
        case 9:
#ifndef DIS_NPOST
            phase_nsa_post(lds, RB, (const float*)args.in[16], (const float*)args.in[17], tab, QN, KSb, KWb, KCH, VCH, VST, VWT, gw, NGW, wid, lane);
#endif
            break;
        case 10: {
            pg8::Gemm g{KCH, (const bf16*)(ws + WS_WC1), 8192, 512, 1024}; pg8::StaticOrder SO; SO.init(8192, 512, G, bx);
            pg8::Gemm g2{VCH, (const bf16*)(ws + WS_WC1) + (size_t)512 * 1024, 8192, 512, 1024};
            pg8::EpiF32 E{Pk, 512};
            if (bx >= G / 2) { g = g2; SO.init(8192, 512, G, bx - G / 2); E.C = Pv; }
            pg8::gemm_phase<pg8::EpiF32, pg8::StaticOrder, true, true>(ldsl, g, SO, E, tid); } break;
        case 11:
#ifndef DIS_CMP2
            phase_cmp2(lds, Pk, Pv, (const float*)(ws + WS_BP), (const float*)args.in[21], (const float*)args.in[22], (const float*)args.in[17], KC, VC, gw, NGW, wid, lane);
#endif
            break;
        case 12:
#ifndef DIS_ATTN
            phase_nsa_attn(lds, QN, KSb, KWb, VST, VWT, KC, VC, OVT, (const float*)(ws + WS_GT), tab, HN, bx, G, tid, wid, lane);
#endif
            break;
        default: {
            const bf16* Wout = kind == 0 ? (const bf16*)(ws + WS_WGO) + (size_t)jj * D * D : (kind == 1 ? (const bf16*)(ws + WS_WSO) : (const bf16*)(ws + WS_WNO));
            pg8::Gemm g{HN, Wout, T, D, D}; pg8::StaticOrder SO; SO.init(T, D, G, bx);
            pg8::EpiResid E{hout, hout, 1.0f};
            pg8::gemm_phase<pg8::EpiResid, pg8::StaticOrder, true, true>(ldsl, g, SO, E, tid); } break;
        }
#ifdef REP_TYPE
        if (type == REP_TYPE && !again) { again = true; grid.sync(); --ph; continue; }
        again = false;
#endif
        if (ph + 1 < args.hi) grid.sync();
    }
}

extern "C" void kernel_launch(void* const* d_in, const int* in_sizes, int n_in, void* d_out, int out_size, void* d_ws, size_t ws_size, hipStream_t stream) {
    static int grid = 0;
    if (grid == 0) {
        if (n_in != 24 || out_size != T * D || ws_size < WS_END) { fprintf(stderr, "kernel_launch: unexpected shapes n_in %d out %d ws %zu (need %zu)\n", n_in, out_size, ws_size, (size_t)WS_END); grid = -1; return; }
        int dev = 0, cus = 0, per_cu = 0;
        hipGetDevice(&dev); hipDeviceGetAttribute(&cus, hipDeviceAttributeMultiprocessorCount, dev);
        if (hipFuncSetAttribute((const void*)mega, hipFuncAttributeMaxDynamicSharedMemorySize, LDS_BYTES) != hipSuccess) { fprintf(stderr, "kernel_launch: hipFuncSetAttribute failed\n"); grid = -1; return; }
        if (hipOccupancyMaxActiveBlocksPerMultiprocessor(&per_cu, (const void*)mega, 512, LDS_BYTES) != hipSuccess || per_cu < 1) { fprintf(stderr, "kernel_launch: occupancy query says %d\n", per_cu); per_cu = 1; }
        (void)hipGetLastError();
        grid = cus;
    }
    if (grid < 0) return;
    Args a{};
    for (int i = 0; i < 24; ++i) a.in[i] = d_in[i];
    a.out = (float*)d_out; a.ws = (unsigned char*)d_ws;
    constexpr int NPH = total_phases();
#if MK_MULTI
    for (int p = 0; p < NPH; ++p) { a.lo = p; a.hi = p + 1; hipLaunchKernelGGL(mega, dim3(grid), dim3(512), LDS_BYTES, stream, a); }
#else
    a.lo = 0; a.hi = NPH;
    void* kargs[] = {&a};
    hipError_t e = hipLaunchCooperativeKernel((const void*)mega, dim3(grid), dim3(512), kargs, LDS_BYTES, stream);
    if (e != hipSuccess) fprintf(stderr, "cooperative launch failed: %s (grid %d)\n", hipGetErrorString(e), grid);
#endif
}
```

```cpp
#include <hip/hip_runtime.h>
#include <hip/hip_cooperative_groups.h>
#include <cstdio>
#include <cstdint>
namespace cg = cooperative_groups;
namespace pg8 {
#define PG8_LAS __attribute__((address_space(3)))
typedef unsigned short bf16_t;
typedef short bf16x8 __attribute__((ext_vector_type(8)));
typedef float f32x4 __attribute__((ext_vector_type(4)));
typedef unsigned u32x4 __attribute__((ext_vector_type(4)));
constexpr int BM = 256, BK = 64, HALF = 128, HTB = HALF * BK * 2  , STAGE_BYTES = 8 * HTB, NXCD = 8, WGM = 8;

__host__ __device__ __forceinline__ int lds_byte(int r, int c) { const int st = (r >> 4) * 2 + (c >> 5), rr = r & 15, cc = c & 31, ob = rr * 64 + cc * 2; return st * 1024 + (ob ^ (((ob >> 9) & 1) << 5)); }
__host__ __device__ __forceinline__ void stage_rc(int b, int& R, int& C) { const int st = b / 1024, sb = b % 1024, swz = sb ^ (((sb >> 9) & 1) << 5); R = (st >> 1) * 16 + swz / 64; C = (st & 1) * 32 + (swz % 64) / 2; }
__host__ __device__ __forceinline__ int perm32(int rho) { const int n = rho >> 4, i = rho & 15; return 8 * (i >> 2) + 4 * n + (i & 3); }

struct Unit { int pm, pn; };
struct Gemm { const bf16_t* A; const bf16_t* Bt; int M, N, K; };

struct StaticOrder {
    int nM, nN, nwg, G, c;
    __host__ __device__ void init(int M, int N, int G_, int c_) { nM = M / BM; nN = N / BM; nwg = nM * nN; G = G_; c = c_; }
    __host__ __device__ bool next(int i, Unit& u) const {
        const long L = (long)i * G + c; if (L >= nwg) return false;
        int wgid = (int)L; { const int q = nwg / NXCD, r = nwg % NXCD, xcd = wgid % NXCD, off = wgid / NXCD; wgid = (xcd < r ? xcd * (q + 1) : r * (q + 1) + (xcd - r) * q) + off; }
        const int nig = WGM * nN, gid = wgid / nig, fm = gid * WGM, gsz = (nM - fm) < WGM ? (nM - fm) : WGM;
        u.pm = fm + ((wgid % nig) % gsz); u.pn = (wgid % nig) / gsz; return true;
    }
    __device__ __forceinline__ void a_ready(const Unit&) const {}
    __device__ __forceinline__ void done(const Unit&) const {}
};
__device__ __forceinline__ unsigned cvt_pk_bf16(float lo, float hi) { unsigned r; asm volatile("v_cvt_pk_bf16_f32 %0, %1, %2" : "=v"(r) : "v"(lo), "v"(hi)); return r; }
template <class Epi, class Sched, bool ALIGN_EPI = false, bool SP2 = false>
__device__ __forceinline__ void gemm_phase(PG8_LAS unsigned char* lds, const Gemm g, const Sched& S, const Epi& E, const int tid) {
    const int wid = __builtin_amdgcn_readfirstlane(tid >> 6), lane = tid & 63, wr = wid >> 2, wc = wid & 3, fr = lane & 15, fq = lane >> 4;
    const int K = g.K, nt = K / BK;
    unsigned voffA[2], voffB[2];
#pragma unroll
    for (int i = 0; i < 2; ++i) { int R, C; stage_rc(tid * 16 + i * 8192, R, C); const int Rb = Epi::PERM ? ((R & ~31) + perm32(R & 31)) : R;
        voffA[i] = (unsigned)(R * K + C) * 2u; voffB[i] = (unsigned)(Rb * K + C) * 2u; }
    const size_t kstep = (size_t)(BK * 2);
    const size_t hstep = (size_t)HALF * K * 2;
    const size_t tstep = 2 * hstep;
    const unsigned ldsw = (unsigned)wid * 1024u;
    const int aoff = lds_byte(wr * 64 + fr, fq * 8), boff = lds_byte(wc * 32 + fr, fq * 8);
#define PG8_SA(b, h) (((b) * 2 + (h)) * HTB)
#define PG8_SB(b, h) ((4 + (b) * 2 + (h)) * HTB)
#define PG8_STAGE(bufoff, gbase, voff) do { _Pragma("unroll") for (int _i = 0; _i < 2; ++_i) \
        __builtin_amdgcn_global_load_lds((const unsigned*)((const char*)(gbase) + (voff)[_i]), (PG8_LAS unsigned*)(lds + (bufoff) + ldsw + _i * 8192), 16, 0, 0); } while (0)
#define PG8_LDA(dst, b, h) do { _Pragma("unroll") for (int m = 0; m < 4; ++m) _Pragma("unroll") for (int k = 0; k < 2; ++k) dst[m][k] = *(const PG8_LAS bf16x8*)(lds + PG8_SA(b, h) + aoff + m * 2048 + k * 1024); } while (0)
#define PG8_LDB(dst, b, h) do { _Pragma("unroll") for (int n = 0; n < 2; ++n) _Pragma("unroll") for (int k = 0; k < 2; ++k) dst[n][k] = *(const PG8_LAS bf16x8*)(lds + PG8_SB(b, h) + boff + n * 2048 + k * 1024); } while (0)
#define PG8_MMA(ai, bj, At, Bt) do { __builtin_amdgcn_s_setprio(1); _Pragma("unroll") for (int m = 0; m < 4; ++m) _Pragma("unroll") for (int n = 0; n < 2; ++n) _Pragma("unroll") for (int k = 0; k < 2; ++k) \
        acc[ai][bj][m][n] = __builtin_amdgcn_mfma_f32_16x16x32_bf16(Bt[n][k], At[m][k], acc[ai][bj][m][n], 0, 0, 0); __builtin_amdgcn_s_setprio(0); } while (0)
#define PG8_WAIT_V(n) asm volatile("s_waitcnt vmcnt(" #n ")" ::: "memory")
#define PG8_WAIT_L(n) asm volatile("s_waitcnt lgkmcnt(" #n ")" ::: "memory")
#define PG8_BAR __builtin_amdgcn_s_barrier()
#define PG8_SCHED __builtin_amdgcn_sched_barrier(0)
    Unit cur, nxt; int ui = 0;
    if (!S.next(0, cur)) return;
    f32x4 acc[2][2][4][2];
#pragma unroll
    for (int a = 0; a < 2; ++a)
#pragma unroll
        for (int b = 0; b < 2; ++b)
#pragma unroll
            for (int m = 0; m < 4; ++m)
#pragma unroll
                for (int n = 0; n < 2; ++n) acc[a][b][m][n] = (f32x4){0.f, 0.f, 0.f, 0.f};
    bf16x8 At[4][2], B0[2][2], B1[2][2];
    const char* cA = (const char*)g.A + (size_t)cur.pm * tstep; const char* cB = (const char*)g.Bt + (size_t)cur.pn * tstep;
    S.a_ready(cur);
    if constexpr (SP2) {
        PG8_STAGE(PG8_SB(0, 0), cB, voffB); PG8_STAGE(PG8_SB(0, 1), cB + hstep, voffB); PG8_STAGE(PG8_SA(0, 0), cA, voffA); PG8_STAGE(PG8_SA(0, 1), cA + hstep, voffA);
        if (wr == 1) PG8_BAR;
        PG8_WAIT_V(2); PG8_BAR;
        PG8_STAGE(PG8_SB(1, 0), cB + kstep, voffB); PG8_STAGE(PG8_SA(1, 0), cA + kstep, voffA); PG8_STAGE(PG8_SB(1, 1), cB + hstep + kstep, voffB);
        PG8_WAIT_V(6); PG8_BAR;
    } else {
        PG8_STAGE(PG8_SB(0, 0), cB, voffB); PG8_STAGE(PG8_SA(0, 0), cA, voffA); PG8_STAGE(PG8_SB(0, 1), cB + hstep, voffB); PG8_STAGE(PG8_SA(0, 1), cA + hstep, voffA);
        if (wr == 1) PG8_BAR;
        PG8_WAIT_V(4); PG8_BAR;
        PG8_STAGE(PG8_SB(1, 0), cB + kstep, voffB); PG8_STAGE(PG8_SA(1, 0), cA + kstep, voffA); PG8_STAGE(PG8_SB(1, 1), cB + hstep + kstep, voffB);
        PG8_WAIT_V(6); PG8_BAR;
    }
    for (;;) {
        const bool has_next = S.next(ui + 1, nxt);
        const char* nA = has_next ? (const char*)g.A + (size_t)nxt.pm * tstep : cA; const char* nB = has_next ? (const char*)g.Bt + (size_t)nxt.pn * tstep : cB;
        for (int t = 0; t < nt; t += 2) {
            const bool last = (t == nt - 2);
            const char* a1 = cA + (size_t)(t + 1) * kstep;
            const char* a2 = last ? nA : cA + (size_t)(t + 2) * kstep; const char* b2 = last ? nB : cB + (size_t)(t + 2) * kstep;
            const char* a3 = a2 + kstep; const char* b3 = b2 + kstep;
            if (last && has_next) S.a_ready(nxt);
            if constexpr (SP2) {
            PG8_LDB(B0, 0, 0); PG8_LDB(B1, 0, 1); PG8_SCHED; PG8_LDA(At, 0, 0); PG8_STAGE(PG8_SA(1, 1), a1 + hstep, voffA);
            PG8_WAIT_V(8); PG8_WAIT_L(0); PG8_BAR; PG8_MMA(0, 0, At, B0); PG8_MMA(0, 1, At, B1); PG8_BAR; PG8_SCHED;
            PG8_LDA(At, 0, 1); PG8_STAGE(PG8_SB(0, 0), b2, voffB); PG8_STAGE(PG8_SB(0, 1), b2 + hstep, voffB); PG8_STAGE(PG8_SA(0, 0), a2, voffA);
            PG8_WAIT_V(8); PG8_WAIT_L(0); PG8_BAR; PG8_MMA(1, 0, At, B0); PG8_MMA(1, 1, At, B1); PG8_BAR; PG8_SCHED;
            PG8_LDB(B0, 1, 0); PG8_LDB(B1, 1, 1); PG8_SCHED; PG8_LDA(At, 1, 0); PG8_STAGE(PG8_SA(0, 1), a2 + hstep, voffA);
            PG8_WAIT_V(8); PG8_WAIT_L(0); PG8_BAR; PG8_MMA(0, 0, At, B0); PG8_MMA(0, 1, At, B1); PG8_BAR; PG8_SCHED;
            PG8_LDA(At, 1, 1); PG8_STAGE(PG8_SB(1, 0), b3, voffB); PG8_STAGE(PG8_SB(1, 1), b3 + hstep, voffB); PG8_STAGE(PG8_SA(1, 0), a3, voffA);
            PG8_WAIT_V(8); PG8_WAIT_L(0); PG8_BAR; PG8_MMA(1, 0, At, B0); PG8_MMA(1, 1, At, B1); PG8_BAR; PG8_SCHED;
            } else {
            PG8_LDB(B0, 0, 0); PG8_SCHED; PG8_LDA(At, 0, 0); PG8_STAGE(PG8_SA(1, 1), a1 + hstep, voffA);
            PG8_WAIT_L(8); PG8_BAR; PG8_WAIT_L(0); PG8_MMA(0, 0, At, B0); PG8_BAR; PG8_SCHED;
            PG8_LDB(B1, 0, 1); PG8_STAGE(PG8_SB(0, 0), b2, voffB);
            PG8_BAR; PG8_WAIT_L(0); PG8_MMA(0, 1, At, B1); PG8_BAR;
            PG8_LDA(At, 0, 1); PG8_STAGE(PG8_SA(0, 0), a2, voffA);
            PG8_BAR; PG8_WAIT_L(0); PG8_MMA(1, 0, At, B0); PG8_BAR; PG8_SCHED;
            PG8_STAGE(PG8_SB(0, 1), b2 + hstep, voffB);
            PG8_WAIT_V(6); PG8_BAR; PG8_MMA(1, 1, At, B1); PG8_BAR;
            PG8_LDB(B0, 1, 0); PG8_SCHED; PG8_LDA(At, 1, 0); PG8_STAGE(PG8_SA(0, 1), a2 + hstep, voffA);
            PG8_WAIT_L(8); PG8_BAR; PG8_WAIT_L(0); PG8_MMA(0, 0, At, B0); PG8_BAR; PG8_SCHED;
            PG8_LDB(B1, 1, 1); PG8_STAGE(PG8_SB(1, 0), b3, voffB);
            PG8_BAR; PG8_WAIT_L(0); PG8_MMA(0, 1, At, B1); PG8_BAR;
            PG8_LDA(At, 1, 1); PG8_STAGE(PG8_SA(1, 0), a3, voffA);
            PG8_BAR; PG8_WAIT_L(0); PG8_MMA(1, 0, At, B0); PG8_BAR; PG8_SCHED;
            PG8_STAGE(PG8_SB(1, 1), b3 + hstep, voffB);
            PG8_WAIT_V(6); PG8_BAR; PG8_MMA(1, 1, At, B1); PG8_BAR;
            }
        }
        if constexpr (ALIGN_EPI) { if (wr == 0) PG8_BAR; }
        if constexpr (!Epi::AFTER_DRAIN) { E(acc, cur, wr, wc, fr, fq); S.done(cur); }
        if (!has_next) break;
#pragma unroll
        for (int a = 0; a < 2; ++a)
#pragma unroll
            for (int b = 0; b < 2; ++b)
#pragma unroll
                for (int m = 0; m < 4; ++m)
#pragma unroll
                    for (int n = 0; n < 2; ++n) acc[a][b][m][n] = (f32x4){0.f, 0.f, 0.f, 0.f};
        cur = nxt; cA = nA; cB = nB; ++ui;
        if constexpr (ALIGN_EPI) { if (wr == 1) PG8_BAR; }
    }
    PG8_WAIT_V(0);
    if constexpr (!ALIGN_EPI) { if (wr == 0) PG8_BAR; }
    PG8_BAR;
    if constexpr (Epi::AFTER_DRAIN) { E.fused(acc, cur, wr, wc, fr, fq, lds, wid, lane); S.done(cur); }
#undef PG8_SA
#undef PG8_SB
#undef PG8_STAGE
#undef PG8_LDA
#undef PG8_LDB
#undef PG8_MMA
#undef PG8_WAIT_V
#undef PG8_WAIT_L
#undef PG8_BAR
#undef PG8_SCHED
}
}

typedef unsigned short bf16;
typedef float f32x4 __attribute__((ext_vector_type(4)));
typedef float f32x2 __attribute__((ext_vector_type(2)));
typedef unsigned u32x4 __attribute__((ext_vector_type(4)));
typedef unsigned u32x2 __attribute__((ext_vector_type(2)));

#ifndef MK_MULTI
#define MK_MULTI 0
#endif

constexpr int Bn = 8, S = 4096, T = Bn * S, D = 1024, FF = 2816, DEPTH = 4;
constexpr float EPS = 1e-6f;
constexpr int GDN_NPAD = 4352, NSA_NPAD = 2816;
constexpr int LDS_BYTES = 147456;
constexpr size_t MiB = 1u << 20;
constexpr size_t WS_WGU = 1 * MiB;
constexpr size_t WS_WDN = WS_WGU + 88 * MiB;
constexpr size_t WS_WGI = WS_WDN + 44 * MiB;
constexpr size_t WS_WGO = WS_WGI + 17 * MiB;
constexpr size_t WS_WSI = WS_WGO + 4 * MiB;
constexpr size_t WS_WSO = WS_WSI + 6 * MiB;
constexpr size_t WS_WNI = WS_WSO + 2 * MiB;
constexpr size_t WS_WNO = WS_WNI + 6 * MiB;
constexpr size_t WS_WC1 = WS_WNO + 2 * MiB;
constexpr size_t WS_TAB = WS_WC1 + 2 * MiB;
constexpr size_t WS_HN  = 184 * MiB;
constexpr size_t WS_R   = WS_HN + 64 * MiB;
constexpr size_t WS_O32 = WS_R + 256 * MiB;
constexpr size_t WS_SM  = WS_O32 + 128 * MiB;
constexpr size_t WS_AB  = WS_SM;
constexpr size_t WS_GT  = WS_SM + 2 * MiB;
constexpr size_t WS_BP  = WS_SM + 8 * MiB;
constexpr size_t WS_END = WS_SM + 9 * MiB;
static_assert(WS_TAB + 8 * MiB <= WS_HN, "ws map");

__device__ __forceinline__ float bf2f(unsigned v) { return __uint_as_float(v << 16); }
__device__ __forceinline__ unsigned f2bf(float f) { unsigned u = __float_as_uint(f); return (u + 0x7fffu + ((u >> 16) & 1u)) >> 16; }
__device__ __forceinline__ unsigned pk2(float lo, float hi) { return f2bf(lo) | (f2bf(hi) << 16); }
__device__ __forceinline__ float wave_sum(float v) {
#pragma unroll
    for (int o = 1; o < 64; o <<= 1) v += __shfl_xor(v, o);
    return v;
}
__device__ __forceinline__ float wave_max(float v) {
#pragma unroll
    for (int o = 1; o < 64; o <<= 1) v = fmaxf(v, __shfl_xor(v, o));
    return v;
}
__device__ __forceinline__ float row_sum16(float v) {
    v += __uint_as_float((unsigned)__builtin_amdgcn_update_dpp(0, (int)__float_as_uint(v), 0x128, 0xf, 0xf, false));
    v += __uint_as_float((unsigned)__builtin_amdgcn_update_dpp(0, (int)__float_as_uint(v), 0x124, 0xf, 0xf, false));
    v += __uint_as_float((unsigned)__builtin_amdgcn_update_dpp(0, (int)__float_as_uint(v), 0x122, 0xf, 0xf, false));
    v += __uint_as_float((unsigned)__builtin_amdgcn_update_dpp(0, (int)__float_as_uint(v), 0x121, 0xf, 0xf, false));
    return v;
}
__device__ __forceinline__ float sigmoidf_(float x) { return 1.f / (1.f + __expf(-x)); }
__device__ __forceinline__ float siluf_(float x) { return x / (1.f + __expf(-x)); }
#define WAVE_SYNC() do { asm volatile("s_waitcnt lgkmcnt(0)" ::: "memory"); __builtin_amdgcn_wave_barrier(); } while (0)

namespace pg8 {
struct EpiSwiGLU {
    static constexpr bool PERM = true, AFTER_DRAIN = false;
    bf16_t* O;
    __device__ __forceinline__ void operator()(const f32x4 (&acc)[2][2][4][2], const Unit& u, int wr, int wc, int fr, int fq) const {
        const int row0 = u.pm * BM + wr * 64 + fr, col0 = u.pn * HALF + wc * 32 + 8 * fq;
#pragma unroll
        for (int ai = 0; ai < 2; ++ai)
#pragma unroll
            for (int m = 0; m < 4; ++m) {
                bf16_t* rowp = O + (size_t)(row0 + ai * HALF + m * 16) * FF + col0;
                float v[8];
#pragma unroll
                for (int n = 0; n < 2; ++n)
#pragma unroll
                    for (int j = 0; j < 4; ++j) { const float g = acc[ai][0][m][n][j], uu = acc[ai][1][m][n][j]; v[n * 4 + j] = g * __builtin_amdgcn_rcpf(1.f + __expf(-g)) * uu; }
                u32x4 w; w.x = cvt_pk_bf16(v[0], v[1]); w.y = cvt_pk_bf16(v[2], v[3]); w.z = cvt_pk_bf16(v[4], v[5]); w.w = cvt_pk_bf16(v[6], v[7]);
                *(u32x4*)rowp = w;
            }
    }
};
struct EpiResid {
    static constexpr bool PERM = false, AFTER_DRAIN = false;
    const float* base; float* out; float scale;
    __device__ __forceinline__ void operator()(const f32x4 (&acc)[2][2][4][2], const Unit& u, int wr, int wc, int fr, int fq) const {
        const int row0 = u.pm * BM + wr * 64 + fr, col0 = u.pn * BM + wc * 32 + 4 * fq;
#pragma unroll
        for (int ai = 0; ai < 2; ++ai)
#pragma unroll
            for (int m = 0; m < 4; ++m) {
                const size_t off = (size_t)(row0 + ai * HALF + m * 16) * D + col0;
#pragma unroll
                for (int bj = 0; bj < 2; ++bj)
#pragma unroll
                    for (int n = 0; n < 2; ++n) { const f32x4 bs = *(const f32x4*)(base + off + bj * HALF + n * 16); *(f32x4*)(out + off + bj * HALF + n * 16) = bs + acc[ai][bj][m][n] * scale; }
                asm volatile("" ::: "memory");
            }
    }
};
struct EpiProj {
    static constexpr bool PERM = true, AFTER_DRAIN = false;
    bf16_t* O; int ldc; int nmain; float* tail; int ldt; int nvalid;
    __device__ __forceinline__ void operator()(const f32x4 (&acc)[2][2][4][2], const Unit& u, int wr, int wc, int fr, int fq) const {
        const int row0 = u.pm * BM + wr * 64 + fr, colt = u.pn * BM, col0 = colt + wc * 32 + 8 * fq;
        if (colt + BM <= nmain) {
#pragma unroll
            for (int ai = 0; ai < 2; ++ai)
#pragma unroll
                for (int m = 0; m < 4; ++m) {
                    bf16_t* rowp = O + (size_t)(row0 + ai * HALF + m * 16) * ldc + col0;
#pragma unroll
                    for (int bj = 0; bj < 2; ++bj) { const f32x4 v0 = acc[ai][bj][m][0], v1 = acc[ai][bj][m][1];
                        u32x4 w; w.x = cvt_pk_bf16(v0[0], v0[1]); w.y = cvt_pk_bf16(v0[2], v0[3]); w.z = cvt_pk_bf16(v1[0], v1[1]); w.w = cvt_pk_bf16(v1[2], v1[3]);
                        *(u32x4*)(rowp + bj * HALF) = w; }
                }
        } else {
#pragma unroll
            for (int ai = 0; ai < 2; ++ai)
#pragma unroll
                for (int m = 0; m < 4; ++m) {
                    const size_t row = (size_t)(row0 + ai * HALF + m * 16);
#pragma unroll
                    for (int bj = 0; bj < 2; ++bj)
#pragma unroll
                        for (int n = 0; n < 2; ++n)
#pragma unroll
                            for (int j = 0; j < 4; ++j) { const int col = col0 + bj * HALF + 4 * n + j; if (col >= nmain && col < nvalid) tail[row * ldt + (col - nmain)] = acc[ai][bj][m][n][j]; }
                }
        }
    }
};
struct EpiF32 {
    static constexpr bool PERM = false, AFTER_DRAIN = false;
    float* C; int ldc;
    __device__ __forceinline__ void operator()(const f32x4 (&acc)[2][2][4][2], const Unit& u, int wr, int wc, int fr, int fq) const {
        const int row0 = u.pm * BM + wr * 64 + fr, col0 = u.pn * BM + wc * 32 + 4 * fq;
#pragma unroll
        for (int ai = 0; ai < 2; ++ai)
#pragma unroll
            for (int m = 0; m < 4; ++m) {
                float* rowp = C + (size_t)(row0 + ai * HALF + m * 16) * ldc + col0;
#pragma unroll
                for (int bj = 0; bj < 2; ++bj)
#pragma unroll
                    for (int n = 0; n < 2; ++n) *(f32x4*)(rowp + bj * HALF + n * 16) = acc[ai][bj][m][n];
            }
    }
};
}

__device__ __forceinline__ void xpose_item(const float* W, int K, int N, bf16* WT, int rowbase, float* scr, int k0, int n0, int lane) {
#pragma unroll 8
    for (int i = 0; i < 32; ++i) { const int kk = 2 * i + (lane >> 5), n = n0 + (lane & 31); scr[kk * 33 + (lane & 31)] = n < N ? W[(size_t)(k0 + kk) * N + n] : 0.f; }
    WAVE_SYNC();
    const int c = lane & 7;
#pragma unroll
    for (int j = 0; j < 4; ++j) { const int n = (lane >> 3) + 8 * j; const float* s = scr + (8 * c) * 33 + n;
        u32x4 o; o.x = pk2(s[0 * 33], s[1 * 33]); o.y = pk2(s[2 * 33], s[3 * 33]); o.z = pk2(s[4 * 33], s[5 * 33]); o.w = pk2(s[6 * 33], s[7 * 33]);
        *(u32x4*)(WT + (size_t)(rowbase + n) * K + k0 + 8 * c) = o; }
    WAVE_SYNC();
}
__device__ __forceinline__ void xpose_matrix(const float* W, int K, int N, int Npad, bf16* WT, int mode, float* scr, int gw, int NGW, int lane) {
    const int nblk = Npad / 32, nitems = (K / 64) * nblk;
    for (int it = gw; it < nitems; it += NGW) {
        const int kb = it / nblk, nb = it - kb * nblk, n0 = nb * 32;
        int rb = n0;
        if (mode == 1) rb = (n0 < FF) ? ((n0 >> 7) * 256 + (n0 & 127)) : ((((n0 - FF) >> 7) * 256) + 128 + ((n0 - FF) & 127));
        xpose_item(W, K, N, WT, rb, scr, kb * 64, n0, lane);
    }
}

__device__ __forceinline__ void phase_norm(const float* h, const float* w, bf16* out, int gw, int NGW, int lane) {
    f32x4 wv[4];
#pragma unroll
    for (int j = 0; j < 4; ++j) wv[j] = ((const f32x4*)w)[64 * j + lane];
    for (int m = gw; m < T; m += NGW) {
        const f32x4* xr = (const f32x4*)(h + (size_t)m * D) + lane;
        f32x4 v[4]; float s = 0.f;
#pragma unroll
        for (int j = 0; j < 4; ++j) { v[j] = xr[64 * j]; s += (v[j].x * v[j].x + v[j].y * v[j].y) + (v[j].z * v[j].z + v[j].w * v[j].w); }
        const float rstd = 1.f / sqrtf(wave_sum(s) * (1.f / D) + EPS);
        u32x2* o8 = (u32x2*)(out + (size_t)m * D) + lane;
#pragma unroll
        for (int j = 0; j < 4; ++j) { u32x2 o; o.x = pk2(v[j].x * rstd * wv[j].x, v[j].y * rstd * wv[j].y); o.y = pk2(v[j].z * rstd * wv[j].z, v[j].w * rstd * wv[j].w); o8[64 * j] = o; }
    }
}

__device__ __forceinline__ void phase_gdn_scan(unsigned char* lds, const bf16* proj, const float* ab, const float* convw, const float* A_log, const float* dt_bias,
                                               float* o32, int vblk, int nblk, int tid, int wid, int lane) {
    float* qs = (float*)lds;
    float* ks = qs + 64 * 128;
    float* vs = ks + 64 * 128;
    float* al = vs + 64 * 32;
    float* be = al + 64;
    float* os = be + 64;
    bf16* raw = (bf16*)(os + 64 * 32);
    const int e = tid >> 4, dl = tid & 15;
    for (int item = vblk; item < 256; item += nblk) {
        const int bh = (item & 7) + 8 * (item >> 5), es = (item >> 3) & 3, b = bh >> 3, h = bh & 7;
        const float Ah = __expf(A_log[h]), dtb = dt_bias[h];
        const int isk = (tid >> 4) & 1, cg = tid & 15, cv = tid & 3;
        const int colqk = isk * 1024 + h * 128 + cg * 8, colv = 2048 + h * 128 + es * 32 + cv * 8;
        f32x4 wq[4][2], wv[4][2];
#pragma unroll
        for (int j = 0; j < 4; ++j) { wq[j][0] = *(const f32x4*)(convw + j * 3072 + colqk); wq[j][1] = *(const f32x4*)(convw + j * 3072 + colqk + 4);
                                      wv[j][0] = *(const f32x4*)(convw + j * 3072 + colv);  wv[j][1] = *(const f32x4*)(convw + j * 3072 + colv + 4); }
        float St[8];
#pragma unroll
        for (int i = 0; i < 8; ++i) St[i] = 0.f;
        u32x4 pre[5];
#define GDN_PREFETCH(T0) do { _Pragma("unroll") for (int k_ = 0; k_ < 5; ++k_) { const int idx_ = tid + 512 * k_; const int row_ = idx_ / 36, c_ = idx_ - row_ * 36; const int ts_ = (T0) - 3 + row_; \
            const int col_ = c_ < 16 ? h * 128 + c_ * 8 : (c_ < 32 ? 1024 + h * 128 + (c_ - 16) * 8 : 2048 + h * 128 + es * 32 + (c_ - 32) * 8); \
            pre[k_] = (u32x4){0u, 0u, 0u, 0u}; if (idx_ < 67 * 36 && ts_ >= 0) pre[k_] = *(const u32x4*)(proj + (size_t)(b * S + ts_) * 4096 + col_); } } while (0)
#define GDN_PARK() do { _Pragma("unroll") for (int k_ = 0; k_ < 5; ++k_) { const int idx_ = tid + 512 * k_; if (idx_ < 67 * 36) *(u32x4*)(raw + idx_ * 8) = pre[k_]; } } while (0)
#define GDN_CONV8(ROW0, C8, W, OUT) do { _Pragma("unroll") for (int i_ = 0; i_ < 8; ++i_) OUT[i_] = 0.f; _Pragma("unroll") for (int j_ = 0; j_ < 4; ++j_) { const u32x4 xv_ = *(const u32x4*)(raw + ((ROW0) + j_) * 288 + (C8) * 8); \
            OUT[0] += bf2f(xv_.x & 0xffffu) * W[j_][0].x; OUT[1] += bf2f(xv_.x >> 16) * W[j_][0].y; OUT[2] += bf2f(xv_.y & 0xffffu) * W[j_][0].z; OUT[3] += bf2f(xv_.y >> 16) * W[j_][0].w; \
            OUT[4] += bf2f(xv_.z & 0xffffu) * W[j_][1].x; OUT[5] += bf2f(xv_.z >> 16) * W[j_][1].y; OUT[6] += bf2f(xv_.w & 0xffffu) * W[j_][1].z; OUT[7] += bf2f(xv_.w >> 16) * W[j_][1].w; } \
            _Pragma("unroll") for (int i_ = 0; i_ < 8; ++i_) OUT[i_] = siluf_(OUT[i_]); } while (0)
#define GDN_CONVNORM(T0) do { \
            _Pragma("unroll") for (int it_ = 0; it_ < 4; ++it_) { const int tok_ = it_ * 16 + (tid >> 5); float y_[8]; GDN_CONV8(tok_, isk * 16 + cg, wq, y_); \
                float ss_ = (y_[0] * y_[0] + y_[1] * y_[1]) + (y_[2] * y_[2] + y_[3] * y_[3]) + (y_[4] * y_[4] + y_[5] * y_[5]) + (y_[6] * y_[6] + y_[7] * y_[7]); \
                ss_ = row_sum16(ss_); const float sc_ = (1.f / sqrtf(ss_ + EPS)) * (isk ? 1.f : 0.08838834764831845f); \
                float* d_ = (isk ? ks : qs) + tok_ * 128 + cg * 8; \
                *(f32x4*)d_ = (f32x4){y_[0] * sc_, y_[1] * sc_, y_[2] * sc_, y_[3] * sc_}; *(f32x4*)(d_ + 4) = (f32x4){y_[4] * sc_, y_[5] * sc_, y_[6] * sc_, y_[7] * sc_}; } \
            if (tid < 256) { const int tok_ = tid >> 2; float y_[8]; GDN_CONV8(tok_, 32 + cv, wv, y_); float* d_ = vs + tok_ * 32 + cv * 8; \
                *(f32x4*)d_ = (f32x4){y_[0], y_[1], y_[2], y_[3]}; *(f32x4*)(d_ + 4) = (f32x4){y_[4], y_[5], y_[6], y_[7]}; } \
            if (tid < 64) { const size_t tg_ = (size_t)(b * S + (T0) + tid); const float a_ = ab[tg_ * 16 + h] + dtb, bb_ = ab[tg_ * 16 + 8 + h]; \
                const float sp_ = a_ > 20.f ? a_ : log1pf(__expf(a_)); al[tid] = __expf(-Ah * sp_); be[tid] = sigmoidf_(bb_); } } while (0)
        __syncthreads();
        GDN_PREFETCH(0); GDN_PARK();
        __syncthreads();
        GDN_CONVNORM(0);
        __syncthreads();
        for (int chunk = 0; chunk < S / 64; ++chunk) {
            const int t0 = chunk * 64;
            const bool more = chunk + 1 < S / 64;
            if (more) GDN_PREFETCH(t0 + 64);
            for (int t16 = 0; t16 < 4; ++t16) {
                float ok = 0.f;
#pragma unroll 4
                for (int i = 0; i < 16; ++i) {
                    const int tt = t16 * 16 + i;
                    const f32x4 k0 = *(const f32x4*)(ks + tt * 128 + dl * 8), k1 = *(const f32x4*)(ks + tt * 128 + dl * 8 + 4);
                    const f32x4 q0 = *(const f32x4*)(qs + tt * 128 + dl * 8), q1 = *(const f32x4*)(qs + tt * 128 + dl * 8 + 4);
                    const float v = vs[tt * 32 + e], a = al[tt], bt = be[tt];
                    float p = (k0.x * St[0] + k0.y * St[1]) + (k0.z * St[2] + k0.w * St[3]) + (k1.x * St[4] + k1.y * St[5]) + (k1.z * St[6] + k1.w * St[7]);
                    p = row_sum16(p);
                    const float vn = bt * (v - a * p);
                    St[0] = a * St[0] + k0.x * vn; St[1] = a * St[1] + k0.y * vn; St[2] = a * St[2] + k0.z * vn; St[3] = a * St[3] + k0.w * vn;
                    St[4] = a * St[4] + k1.x * vn; St[5] = a * St[5] + k1.y * vn; St[6] = a * St[6] + k1.z * vn; St[7] = a * St[7] + k1.w * vn;
                    float o = (q0.x * St[0] + q0.y * St[1]) + (q0.z * St[2] + q0.w * St[3]) + (q1.x * St[4] + q1.y * St[5]) + (q1.z * St[6] + q1.w * St[7]);
                    o = row_sum16(o);
                    ok = (i == dl) ? o : ok;
                }
                os[(t16 * 16 + dl) * 32 + e] = ok;
            }
            __syncthreads();
            { const int tok = tid >> 3, c4 = tid & 7;
              *(f32x4*)(o32 + (size_t)(b * S + t0 + tok) * D + h * 128 + es * 32 + c4 * 4) = *(const f32x4*)(os + tok * 32 + c4 * 4); }
            if (more) {
                GDN_PARK();
                __syncthreads();
                GDN_CONVNORM(t0 + 64);
            }
            __syncthreads();
        }
#undef GDN_PREFETCH
#undef GDN_PARK
#undef GDN_CONV8
#undef GDN_CONVNORM
    }
}
__device__ __forceinline__ void phase_gdn_post(const float* o32, const bf16* proj, const float* onorm, bf16* hn, int gw, int NGW, int lane) {
    const f32x4 wv = *(const f32x4*)(onorm + ((4 * lane) & 127));
    for (int m = gw; m < T; m += NGW) {
        const f32x4* xr = (const f32x4*)(o32 + (size_t)m * D) + lane;
        const u32x2* gr = (const u32x2*)(proj + (size_t)m * 4096 + 3072) + lane;
        u32x2* o8 = (u32x2*)(hn + (size_t)m * D) + lane;
#pragma unroll
        for (int j = 0; j < 4; ++j) {
            const f32x4 v = xr[64 * j]; const u32x2 g = gr[64 * j];
            float s = (v.x * v.x + v.y * v.y) + (v.z * v.z + v.w * v.w);
#pragma unroll
            for (int o = 1; o < 32; o <<= 1) s += __shfl_xor(s, o);
            const float rstd = 1.f / sqrtf(s * (1.f / 128.f) + EPS);
            u32x2 o; o.x = pk2(v.x * rstd * wv.x * siluf_(bf2f(g.x & 0xffffu)), v.y * rstd * wv.y * siluf_(bf2f(g.x >> 16)));
            o.y = pk2(v.z * rstd * wv.z * siluf_(bf2f(g.y & 0xffffu)), v.w * rstd * wv.w * siluf_(bf2f(g.y >> 16)));
            o8[64 * j] = o;
        }
    }
}
__device__ __forceinline__ void phase_sc_post(const bf16* proj, const float* cw, bf16* hn, int gtid, int NT) {
    for (int idx = gtid; idx < T * 128; idx += NT) {
        const int m = idx >> 7, c8 = (idx & 127) * 8, s = m & (S - 1);
        float y[8];
#pragma unroll
        for (int i = 0; i < 8; ++i) y[i] = 0.f;
#pragma unroll
        for (int j = 0; j < 3; ++j) {
            if (s - 2 + j >= 0) {
                const bf16* pr = proj + (size_t)(m - 2 + j) * 3072;
                const u32x4 cv = *(const u32x4*)(pr + 1024 + c8), xv = *(const u32x4*)(pr + 2048 + c8);
                const f32x4 w0 = *(const f32x4*)(cw + j * 1024 + c8), w1 = *(const f32x4*)(cw + j * 1024 + c8 + 4);
                y[0] += w0.x * bf2f(cv.x & 0xffffu) * bf2f(xv.x & 0xffffu); y[1] += w0.y * bf2f(cv.x >> 16) * bf2f(xv.x >> 16);
                y[2] += w0.z * bf2f(cv.y & 0xffffu) * bf2f(xv.y & 0xffffu); y[3] += w0.w * bf2f(cv.y >> 16) * bf2f(xv.y >> 16);
                y[4] += w1.x * bf2f(cv.z & 0xffffu) * bf2f(xv.z & 0xffffu); y[5] += w1.y * bf2f(cv.z >> 16) * bf2f(xv.z >> 16);
                y[6] += w1.z * bf2f(cv.w & 0xffffu) * bf2f(xv.w & 0xffffu); y[7] += w1.w * bf2f(cv.w >> 16) * bf2f(xv.w >> 16);
            }
        }
        const u32x4 bv = *(const u32x4*)(proj + (size_t)m * 3072 + c8);
        u32x4 o;
        o.x = pk2(y[0] * bf2f(bv.x & 0xffffu), y[1] * bf2f(bv.x >> 16)); o.y = pk2(y[2] * bf2f(bv.y & 0xffffu), y[3] * bf2f(bv.y >> 16));
        o.z = pk2(y[4] * bf2f(bv.z & 0xffffu), y[5] * bf2f(bv.z >> 16)); o.w = pk2(y[6] * bf2f(bv.w & 0xffffu), y[7] * bf2f(bv.w >> 16));
        *(u32x4*)(hn + (size_t)m * D + c8) = o;
    }
}
__device__ __forceinline__ void phase_nsa_post(unsigned char* lds, const bf16* proj, const float* qnorm, const float* knorm, const f32x2* tab,
                                               bf16* QN, bf16* KS, bf16* KW, bf16* KCH, bf16* VCH, bf16* VST, bf16* VWT, int gw, int NGW, int wid, int lane) {
    {
        bf16* tile = (bf16*)lds + wid * (64 * 66);
        for (int item = gw; item < 2 * 32 * 64; item += NGW) {
            const int st = item & 63, bh = (item >> 6) & 31, which = item >> 11, b = bh >> 2, hk = bh & 3;
            const bf16* src = proj + ((size_t)b * S + st * 64) * 2560 + (which ? 2304 : 1792) + hk * 64 + lane;
#pragma unroll 8
            for (int i = 0; i < 64; ++i) tile[i * 66 + lane] = src[(size_t)i * 2560];
            WAVE_SYNC();
            bf16* dst = (which ? VWT : VST) + (size_t)bh * 64 * S + st * 64 + lane;
#pragma unroll 8
            for (int d = 0; d < 64; ++d) dst[(size_t)d * S] = tile[lane * 66 + d];
            WAVE_SYNC();
        }
    }
    const float qw = qnorm[lane], kw1 = knorm[64 + lane], kw2 = knorm[128 + lane];
    for (int m = gw; m < T; m += NGW) {
        const int b = m >> 12, s = m & (S - 1);
        const bf16* pr = proj + (size_t)m * 2560;
        const f32x2 cs = tab[(size_t)m * 32 + (lane & 31)];
#pragma unroll 4
        for (int hh = 0; hh < 16; ++hh) {
            const float x = bf2f(pr[hh * 64 + lane]);
            const float ss = wave_sum(x * x);
            QN[((size_t)(b * 16 + hh) * S + s) * 64 + lane] = (bf16)f2bf(x * (1.f / sqrtf(ss * (1.f / 64.f) + EPS)) * qw);
        }
#pragma unroll
        for (int hk = 0; hk < 4; ++hk) {
            const size_t o = ((size_t)(b * 4 + hk) * S + s) * 64 + lane;
            { const float x = bf2f(pr[1536 + hk * 64 + lane]); const float ss = wave_sum(x * x);
              const float y = x * (1.f / sqrtf(ss * (1.f / 64.f) + EPS)) * kw1; const float yp = __shfl_xor(y, 32);
              KS[o] = (bf16)f2bf(y * cs.x + (lane < 32 ? -yp : yp) * cs.y); }
            { const float x = bf2f(pr[2048 + hk * 64 + lane]); const float ss = wave_sum(x * x);
              const float y = x * (1.f / sqrtf(ss * (1.f / 64.f) + EPS)) * kw2; const float yp = __shfl_xor(y, 32);
              KW[o] = (bf16)f2bf(y * cs.x + (lane < 32 ? -yp : yp) * cs.y); }
            KCH[o] = pr[1024 + hk * 64 + lane];
            VCH[o] = pr[1280 + hk * 64 + lane];
        }
    }
}
__device__ __forceinline__ void phase_cmp2(unsigned char* lds, const float* Pk, const float* Pv, const float* biasp, const float* w2, const float* b2, const float* knorm0,
                                           bf16* KC, bf16* VC, int gw, int NGW, int wid, int lane) {
    float* hs = (float*)lds + wid * 256;
    for (int item = gw; item < 2 * 32 * 256; item += NGW) {
        const int i = item & 255, bh = (item >> 8) & 31, kind = item >> 13;
        bf16* outp = kind ? VC + ((size_t)bh * 64 + lane) * 256 + i : KC + ((size_t)bh * 256 + i) * 64 + lane;
        if (i == 255) { *outp = 0; continue; }
        const float* P = kind ? Pv : Pk;
        const float* r0 = P + ((size_t)bh * 256 + i) * 512; const float* r1 = r0 + 512 + 256;
#pragma unroll
        for (int j = 0; j < 4; ++j) { const int n = lane + 64 * j; const float x = r0[n] + r1[n] + biasp[kind * 256 + n];
            const float uu = 0.7978845608028654f * (x + 0.044715f * x * x * x);
            const float th = 1.f - 2.f / (1.f + __expf(2.f * uu));
            hs[n] = 0.5f * x * (1.f + th); }
        WAVE_SYNC();
        float acc = b2[kind * 64 + lane];
        const float* w = w2 + (size_t)kind * 256 * 64 + lane;
#pragma unroll 8
        for (int n = 0; n < 256; ++n) acc += hs[n] * w[n * 64];
        if (kind == 0) { const float ss = wave_sum(acc * acc); acc = acc * (1.f / sqrtf(ss * (1.f / 64.f) + EPS)) * knorm0[lane]; }
        *outp = (bf16)f2bf(acc);
        WAVE_SYNC();
    }
}
#define MFMA32(a, b, c) __builtin_amdgcn_mfma_f32_32x32x16_bf16((a), (b), (c), 0, 0, 0)
typedef short bf16x8v __attribute__((ext_vector_type(8)));
typedef float f32x16 __attribute__((ext_vector_type(16)));
typedef __bf16 bf16v2 __attribute__((ext_vector_type(2)));
constexpr int KV_STRIDE = 144;
constexpr int KV_BUF = 2 * 64 * KV_STRIDE;
constexpr int ATT_IMP_OFF = 2 * KV_BUF;
constexpr int ATT_MSK_OFF = ATT_IMP_OFF + 8 * 2048;
__device__ __forceinline__ unsigned pkbf(float a, float b) { f32x2 v = {a, b}; return __builtin_bit_cast(unsigned, __builtin_convertvector(v, bf16v2)); }

template <bool IMP>
__device__ __forceinline__ void attn_tile(const unsigned char* buf, int tt, int key0, int lo, int hi, const bf16x8v (&qf)[4],
                                          f32x16 (&O)[2], f32x16 (&IM)[2], float& m, float& l, const bf16* ovt, int r, int h, int pr) {
    f32x16 sacc;
#pragma unroll
    for (int i = 0; i < 16; ++i) sacc[i] = 0.f;
    const unsigned char* kb = buf + (32 * tt + pr) * KV_STRIDE + h * 16;
#pragma unroll
    for (int ks = 0; ks < 4; ++ks) { const bf16x8v a = *(const bf16x8v*)(kb + ks * 32); sacc = MFMA32(a, qf[ks], sacc); }
    const int kb0 = key0 + 8 * h;
    float mx = -1e30f;
#pragma unroll
    for (int i = 0; i < 16; ++i) { const int key = kb0 + 16 * (i >> 3) + (i & 7); const bool ok = (key >= lo) && (key <= hi);
        const float sv = ok ? sacc[i] * 0.18033688011112042f : -1e30f; sacc[i] = sv; mx = fmaxf(mx, sv); }
    mx = fmaxf(mx, __shfl_xor(mx, 32));
    const float mnew = fmaxf(m, mx), corr = __builtin_amdgcn_exp2f(m - mnew);
    m = mnew;
    float psum = 0.f;
#pragma unroll
    for (int i = 0; i < 16; ++i) { const float p = sacc[i] > -1e29f ? __builtin_amdgcn_exp2f(sacc[i] - mnew) : 0.f; psum += p; sacc[i] = p; }
    l = l * corr + psum;
    if (__any(corr != 1.f)) {
#pragma unroll
        for (int i = 0; i < 16; ++i) { O[0][i] *= corr; O[1][i] *= corr; }
        if (IMP) {
#pragma unroll
            for (int i = 0; i < 16; ++i) { IM[0][i] *= corr; IM[1][i] *= corr; }
        }
    }
    bf16x8v pf[2];
#pragma unroll
    for (int sx = 0; sx < 2; ++sx) { u32x4 w; w.x = pkbf(sacc[8 * sx], sacc[8 * sx + 1]); w.y = pkbf(sacc[8 * sx + 2], sacc[8 * sx + 3]); w.z = pkbf(sacc[8 * sx + 4], sacc[8 * sx + 5]); w.w = pkbf(sacc[8 * sx + 6], sacc[8 * sx + 7]);
        pf[sx] = __builtin_bit_cast(bf16x8v, w); }
    const unsigned char* vb = buf + 64 * KV_STRIDE + r * KV_STRIDE + (32 * tt + 8 * h) * 2;
#pragma unroll
    for (int dt = 0; dt < 2; ++dt)
#pragma unroll
        for (int sx = 0; sx < 2; ++sx) { const bf16x8v a = *(const bf16x8v*)(vb + dt * 32 * KV_STRIDE + sx * 32); O[dt] = MFMA32(a, pf[sx], O[dt]); }
    if (IMP) {
#pragma unroll
        for (int st = 0; st < 2; ++st)
#pragma unroll
            for (int sx = 0; sx < 2; ++sx) { const bf16x8v a = *(const bf16x8v*)(ovt + (32 * st + r) * 256 + key0 + 16 * sx + 8 * h); IM[st] = MFMA32(a, pf[sx], IM[st]); }
    }
}

template <int MODE>
__device__ __forceinline__ void attn_branch(unsigned char* kvbuf, const bf16* Kg0, const bf16* VTg0, int vts, unsigned long long blkmask, int t, int nv, unsigned long long selm,
                                            int wlo, int whi, const bf16x8v (&qf)[4], f32x16 (&O)[2], f32x16 (&IM)[2], float& l, const bf16* ovt, int tid, int r, int h, int pr) {
    float m = -1e30f;
    l = 0.f;
#pragma unroll
    for (int i = 0; i < 16; ++i) { O[0][i] = 0.f; O[1][i] = 0.f; IM[0][i] = 0.f; IM[1][i] = 0.f; }
    const int srow = tid >> 3, sch = tid & 7;
    int j = __builtin_ctzll(blkmask);
    unsigned long long rest = blkmask & (blkmask - 1);
    u32x4 kr = *(const u32x4*)(Kg0 + (size_t)(64 * j + srow) * 64 + sch * 8);
    u32x4 vr = *(const u32x4*)(VTg0 + (size_t)srow * vts + 64 * j + sch * 8);
    *(u32x4*)(kvbuf + srow * KV_STRIDE + sch * 16) = kr;
    *(u32x4*)(kvbuf + 64 * KV_STRIDE + srow * KV_STRIDE + sch * 16) = vr;
    int cur = 0;
    for (;;) {
        __syncthreads();
        const bool more = rest != 0ull;
        int jn = 0;
        if (more) { jn = __builtin_ctzll(rest); rest &= rest - 1;
            kr = *(const u32x4*)(Kg0 + (size_t)(64 * jn + srow) * 64 + sch * 8);
            vr = *(const u32x4*)(VTg0 + (size_t)srow * vts + 64 * jn + sch * 8); }
        const unsigned char* buf = kvbuf + cur * KV_BUF;
        int lo, hi;
        if (MODE == 0) { lo = 0; hi = nv - 1; }
        else if (MODE == 1) { lo = 0; hi = ((selm >> j) & 1ull) ? t : -1; }
        else { lo = t - 511; hi = t; }
#pragma unroll
        for (int tt = 0; tt < 2; ++tt) {
            const int key0 = 64 * j + 32 * tt;
            if (key0 > whi || key0 + 31 < wlo) continue;
            attn_tile<MODE == 0>(buf, tt, key0, lo, hi, qf, O, IM, m, l, ovt, r, h, pr);
        }
        if (!more) break;
        *(u32x4*)(kvbuf + (cur ^ 1) * KV_BUF + srow * KV_STRIDE + sch * 16) = kr;
        *(u32x4*)(kvbuf + (cur ^ 1) * KV_BUF + 64 * KV_STRIDE + srow * KV_STRIDE + sch * 16) = vr;
        cur ^= 1; j = jn;
    }
    __syncthreads();
}

__device__ __forceinline__ void phase_nsa_attn(unsigned char* lds, const bf16* QN, const bf16* KS, const bf16* KW, const bf16* VST, const bf16* VWT, const bf16* KCb, const bf16* VCT,
                                               const bf16* ovt, const float* gates, const f32x2* tab, bf16* hn, int vblk, int nblk, int tid, int wid, int lane) {
    const int r = lane & 31, h = lane >> 5, pr = (r & ~12) | ((r & 4) << 1) | ((r & 8) >> 1);
    float* imp_s = (float*)(lds + ATT_IMP_OFF + wid * 2048);
    unsigned long long* msk_s = (unsigned long long*)(lds + ATT_MSK_OFF);
    unsigned* uni_s = (unsigned*)(lds + ATT_MSK_OFF + 512);
    for (int item = vblk; item < Bn * 4 * 64; item += nblk) {
        const int rnd = item / nblk, wv = item - rnd * nblk;
        const int bh = wv & 31, sub = wv >> 5, per = nblk >> 5;
        int qb = rnd * per + ((rnd & 1) ? (per - 1 - sub) : sub);
        if (nblk != 256) { qb = item >> 5; }
        const int bhh = (nblk != 256) ? (item & 31) : bh;
        const int b = bhh >> 2, hk = bhh & 3;
        const int t0 = qb * 64, tw0 = t0 + 8 * wid, t = tw0 + (r & 7), g = r >> 3;
        const size_t tok = (size_t)b * S + t;
        if (tid == 0) { unsigned z = 0u; asm volatile("" : "+v"(z)); uni_s[0] = z; uni_s[1] = z; }
        bf16x8v qn[4], qr[4];
        {
            const bf16* qp = QN + ((size_t)(b * 16 + hk * 4 + g) * S + t) * 64 + 8 * h;
#pragma unroll
            for (int ks = 0; ks < 4; ++ks) qn[ks] = *(const bf16x8v*)(qp + 16 * ks);
            const f32x2* cp = tab + tok * 32 + 8 * h;
#pragma unroll
            for (int kl = 0; kl < 2; ++kl) {
                u32x4 wlo_, whi_;
                const u32x4 a = __builtin_bit_cast(u32x4, qn[kl]), c = __builtin_bit_cast(u32x4, qn[kl + 2]);
#pragma unroll
                for (int jj = 0; jj < 4; ++jj) {
                    const f32x2 cs0 = cp[16 * kl + 2 * jj], cs1 = cp[16 * kl + 2 * jj + 1];
                    const float x0 = bf2f(a[jj] & 0xffffu), x1 = bf2f(a[jj] >> 16), y0 = bf2f(c[jj] & 0xffffu), y1 = bf2f(c[jj] >> 16);
                    wlo_[jj] = pkbf(x0 * cs0.x - y0 * cs0.y, x1 * cs1.x - y1 * cs1.y);
                    whi_[jj] = pkbf(y0 * cs0.x + x0 * cs0.y, y1 * cs1.x + x1 * cs1.y);
                }
                qr[kl] = __builtin_bit_cast(bf16x8v, wlo_); qr[kl + 2] = __builtin_bit_cast(bf16x8v, whi_);
            }
        }
        const float* gp = gates + tok * 48 + (hk * 4 + g) * 3;
        const float g0 = sigmoidf_(gp[0]), g1 = sigmoidf_(gp[1]), g2 = sigmoidf_(gp[2]);
        f32x16 acc[2], O[2], IM[2];
        float l;
        const int nv = t >= 31 ? ((t - 31) >> 4) + 1 : 0;
        const int nvw = ((tw0 + 7 - 31) >> 4) + 1;
        const int nvmax = 4 * qb + 3;
        {
            const int ncb = (nvmax + 63) >> 6;
            const unsigned long long bm = ncb >= 64 ? ~0ull : ((1ull << ncb) - 1ull);
            attn_branch<0>(lds, KCb + (size_t)bhh * 256 * 64, VCT + (size_t)bhh * 64 * 256, 256, bm, t, nv, 0ull, 0, (tw0 + 7 >= 31 ? nvw - 1 : -1), qn, O, IM, l, ovt, tid, r, h, pr);
        }
        {
            const float lt = l + __shfl_xor(l, 32), inv = lt > 0.f ? 1.f / lt : 0.f, sc = inv * g0;
#pragma unroll
            for (int i = 0; i < 16; ++i) { acc[0][i] = O[0][i] * sc; acc[1][i] = O[1][i] * sc; }
#pragma unroll
            for (int st = 0; st < 2; ++st)
#pragma unroll
                for (int i = 0; i < 16; ++i) { float v = IM[st][i] * inv; v += __shfl_xor(v, 8); v += __shfl_xor(v, 16);
                    if (r < 8) imp_s[r * 64 + 32 * st + (i & 3) + 8 * (i >> 2) + 4 * h] = v; }
        }
        WAVE_SYNC();
        {
            unsigned long long um = 0ull;
            for (int tk = 0; tk < 8; ++tk) {
                const float imp = imp_s[tk * 64 + lane];
                const bool sv = lane <= qb, forced = (lane == 0) || (lane == qb) || (lane + 1 == qb);
                const float score = sv ? (forced ? 1e9f : imp) : -1.f;
                int rank = 0;
#pragma unroll 4
                for (int i = 0; i < 64; ++i) { const float si = __uint_as_float(__builtin_amdgcn_readlane(__float_as_uint(score), i)); rank += (si > score || (si == score && i < lane)) ? 1 : 0; }
                const unsigned long long mk = __ballot((rank < 16) && (score >= 0.f));
                um |= mk;
                if (lane == 0) msk_s[wid * 8 + tk] = mk;
            }
            if (lane == 0) { atomicOr(&uni_s[0], (unsigned)um); atomicOr(&uni_s[1], (unsigned)(um >> 32)); }
        }
        __syncthreads();
        const unsigned long long selm = msk_s[wid * 8 + (r & 7)];
        const unsigned long long uni = (unsigned long long)uni_s[0] | ((unsigned long long)uni_s[1] << 32);
        attn_branch<1>(lds, KS + (size_t)bhh * S * 64, VST + (size_t)bhh * 64 * S, S, uni, t, 0, selm, 0, tw0 + 7, qr, O, IM, l, ovt, tid, r, h, pr);
        {
            const float lt = l + __shfl_xor(l, 32), sc = g1 / lt;
#pragma unroll
            for (int i = 0; i < 16; ++i) { acc[0][i] += O[0][i] * sc; acc[1][i] += O[1][i] * sc; }
        }
        {
            const int jlo = qb >= 8 ? qb - 8 : 0;
            const unsigned long long bm = (qb >= 63 ? ~0ull : ((1ull << (qb + 1)) - 1ull)) & ~((1ull << jlo) - 1ull);
            attn_branch<2>(lds, KW + (size_t)bhh * S * 64, VWT + (size_t)bhh * 64 * S, S, bm, t, 0, 0ull, tw0 - 511, tw0 + 7, qr, O, IM, l, ovt, tid, r, h, pr);
        }
        {
            const float lt = l + __shfl_xor(l, 32), sc = g2 / lt;
            bf16* op = hn + tok * D + (hk * 4 + g) * 64 + 4 * h;
#pragma unroll
            for (int dt = 0; dt < 2; ++dt)
#pragma unroll
                for (int q4 = 0; q4 < 4; ++q4) {
                    u32x2 w; w.x = pkbf(acc[dt][4 * q4] + O[dt][4 * q4] * sc, acc[dt][4 * q4 + 1] + O[dt][4 * q4 + 1] * sc);
                    w.y = pkbf(acc[dt][4 * q4 + 2] + O[dt][4 * q4 + 2] * sc, acc[dt][4 * q4 + 3] + O[dt][4 * q4 + 3] * sc);
                    *(u32x2*)(op + 32 * dt + 8 * q4) = w;
                }
        }
    }
}

struct Args { const void* in[24]; float* out; unsigned char* ws; int lo, hi; };

__host__ __device__ constexpr int mixer_inner_phases(int kind) { return kind == 0 ? 2 : (kind == 1 ? 1 : 4); }
__host__ __device__ constexpr int total_phases() { int n = 1; for (int L = 0; L < DEPTH; ++L) n += 6 + 3 + mixer_inner_phases(L % 3); return n; }

__global__ void __launch_bounds__(512, 2) mega(Args args) {
    extern __shared__ __attribute__((aligned(16))) unsigned char lds[];
    cg::grid_group grid = cg::this_grid();
    bool again = false;
    for (int ph = args.lo; ph < args.hi; ++ph) {
        int type = 0, s = 0, L = 0;
        if (ph > 0) {
            int p = ph - 1;
            for (L = 0; L < DEPTH; ++L) { const int n = 9 + mixer_inner_phases(L % 3); if (p < n) break; p -= n; }
            const int inner = mixer_inner_phases(L % 3), kind = L % 3;
            if (p < 3) { type = 1 + p; s = 2 * L; }
            else if (p == 3) type = 4;
            else if (p == 4) type = 5;
            else if (p < 5 + inner) { const int q = p - 5; type = kind == 0 ? 6 + q : (kind == 1 ? 8 : 9 + q); }
            else if (p == 5 + inner) type = 13;
            else { type = 1 + (p - 6 - inner); s = 2 * L + 1; }
        }
        int tid_ = threadIdx.x; asm volatile("" : "+v"(tid_));
        int G_ = gridDim.x, bx_ = blockIdx.x; asm volatile("" : "+s"(G_), "+s"(bx_));
        const int tid = tid_, lane = tid & 63, wid = __builtin_amdgcn_readfirstlane(tid >> 6);
        const int G = G_, bx = bx_;
        const int vcu = (G % 8 == 0) ? (bx % 8) * (G / 8) + bx / 8 : bx;
        const int gw = vcu * 8 + wid, NGW = G * 8;
        unsigned char* ws = args.ws; asm volatile("" : "+s"(ws));
        PG8_LAS unsigned char* ldsl = (PG8_LAS unsigned char*)lds;
        float* hout = args.out; asm volatile("" : "+s"(hout));
        bf16* HN = (bf16*)(ws + WS_HN);
        bf16* RB = (bf16*)(ws + WS_R);
        f32x2* tab = (f32x2*)(ws + WS_TAB);
        const int kind = L % 3, jj = L / 3;
        bf16* QN = RB + (size_t)T * 2560;
        bf16* KSb = QN + (size_t)T * 1024;
        bf16* KWb = KSb + (size_t)T * 256;
        bf16* KCH = (bf16*)(ws + WS_O32);
        bf16* VCH = KCH + (size_t)T * 256;
        float* Pk = (float*)(ws + WS_O32 + 32 * MiB);
        float* Pv = Pk + (size_t)8192 * 512;
        bf16* KC = (bf16*)(ws + WS_O32 + 64 * MiB);
        bf16* VC = (bf16*)(ws + WS_O32 + 65 * MiB);
        bf16* OVT = (bf16*)(ws + WS_BP + 65536);
        bf16* VST = (bf16*)(ws + WS_O32 + 68 * MiB);
        bf16* VWT = (bf16*)(ws + WS_O32 + 84 * MiB);
        switch (type) {
        case 0: {
            float* scr = (float*)lds + wid * (64 * 33);
            for (int mi = 0; mi < 28; ++mi) {
                const float* W; int K, N, Npad, mode = 0; bf16* WT;
                if (mi < 8)       { W = (const float*)args.in[3] + (size_t)mi * D * 2 * FF; K = D; N = 2 * FF; Npad = N; mode = 1; WT = (bf16*)(ws + WS_WGU) + (size_t)mi * 2 * FF * D; }
                else if (mi < 16) { const int i = mi - 8; W = (const float*)args.in[4] + (size_t)i * FF * D; K = FF; N = D; Npad = N; WT = (bf16*)(ws + WS_WDN) + (size_t)i * D * FF; }
                else if (mi < 18) { const int i = mi - 16; W = (const float*)args.in[6] + (size_t)i * D * 4112; K = D; N = 4112; Npad = GDN_NPAD; WT = (bf16*)(ws + WS_WGI) + (size_t)i * GDN_NPAD * D; }
                else if (mi < 20) { const int i = mi - 18; W = (const float*)args.in[11] + (size_t)i * D * D; K = D; N = D; Npad = N; WT = (bf16*)(ws + WS_WGO) + (size_t)i * D * D; }
                else if (mi == 20) { W = (const float*)args.in[12]; K = D; N = 3072; Npad = N; WT = (bf16*)(ws + WS_WSI); }
                else if (mi == 21) { W = (const float*)args.in[14]; K = D; N = D; Npad = N; WT = (bf16*)(ws + WS_WSO); }
                else if (mi == 22) { W = (const float*)args.in[15]; K = D; N = 2608; Npad = NSA_NPAD; WT = (bf16*)(ws + WS_WNI); }
                else if (mi == 23) { W = (const float*)args.in[23]; K = D; N = D; Npad = N; WT = (bf16*)(ws + WS_WNO); }
                else { const int i = mi - 24, kd = i >> 1, hf = i & 1;
                    W = (const float*)args.in[19] + (size_t)kd * 2048 * 256 + (size_t)hf * 1024 * 256; K = 1024; N = 256; Npad = 256; WT = (bf16*)(ws + WS_WC1) + (size_t)kd * 512 * 1024 + (size_t)hf * 256 * 1024; }
                xpose_matrix(W, K, N, Npad, WT, mode, scr, gw, NGW, lane);
            }
            const int* positions = (const int*)args.in[1];
            for (int idx = bx * 512 + tid; idx < T * 32; idx += G * 512) {
                const int tk = idx >> 5, i = idx & 31;
                const float inv = 1.0f / exp2f((float)(2 * i) * (13.287712379549449f / 64.f));
                const float ang = (float)positions[tk] * inv;
                const double rev = (double)ang * 0.15915494309189535;
                const float fr = (float)(rev - rint(rev));
                f32x2 v; v.x = __builtin_amdgcn_cosf(fr); v.y = __builtin_amdgcn_sinf(fr);
                tab[idx] = v;
            }
            for (int idx = bx * 512 + tid; idx < 64 * 256; idx += G * 512) {
                const int sj = idx >> 8, i = idx & 255, q = i >> 2, rem = i & 3;
                OVT[idx] = (bf16)(rem < 3 ? (q == sj ? 0x3F80 : 0) : ((q == sj || q + 1 == sj) ? 0x3F00 : 0));
            }
            if (bx < 2 && tid < 256) {
                const float* pe = (const float*)args.in[18] + (size_t)bx * 2048;
                const float* w1 = (const float*)args.in[19] + (size_t)bx * 2048 * 256 + tid;
                float acc = ((const float*)args.in[20])[bx * 256 + tid];
                for (int k = 0; k < 2048; ++k) acc += pe[k] * w1[(size_t)k * 256];
                ((float*)(ws + WS_BP))[bx * 256 + tid] = acc;
            }
        } break;
        case 1: phase_norm(s == 0 ? (const float*)args.in[0] : hout, (const float*)args.in[2] + (size_t)s * D, HN, gw, NGW, lane); break;
        case 2: {
            pg8::Gemm g{HN, (const bf16*)(ws + WS_WGU) + (size_t)s * 2 * FF * D, T, 2 * FF, D}; pg8::StaticOrder SO; SO.init(T, 2 * FF, G, bx);
            pg8::EpiSwiGLU E{RB};
            pg8::gemm_phase<pg8::EpiSwiGLU, pg8::StaticOrder, true, true>(ldsl, g, SO, E, tid); } break;
        case 3: {
            pg8::Gemm g{RB, (const bf16*)(ws + WS_WDN) + (size_t)s * D * FF, T, D, FF}; pg8::StaticOrder SO; SO.init(T, D, G, bx);
            pg8::EpiResid E{s == 0 ? (const float*)args.in[0] : hout, hout, 0.5f};
            pg8::gemm_phase<pg8::EpiResid, pg8::StaticOrder, true, true>(ldsl, g, SO, E, tid); } break;
        case 4: phase_norm(hout, (const float*)args.in[5] + (size_t)L * D, HN, gw, NGW, lane); break;
        case 5: {
            const bf16* Wt; int Np, ldc, nmain, ldt, nvalid; float* tail;
            if (kind == 0) { Wt = (const bf16*)(ws + WS_WGI) + (size_t)jj * GDN_NPAD * D; Np = GDN_NPAD; ldc = 4096; nmain = 4096; tail = (float*)(ws + WS_AB); ldt = 16; nvalid = 4112; }
            else if (kind == 1) { Wt = (const bf16*)(ws + WS_WSI); Np = 3072; ldc = 3072; nmain = 3072; tail = (float*)(ws + WS_AB); ldt = 16; nvalid = 3072; }
            else { Wt = (const bf16*)(ws + WS_WNI); Np = NSA_NPAD; ldc = 2560; nmain = 2560; tail = (float*)(ws + WS_GT); ldt = 48; nvalid = 2608; }
            pg8::Gemm g{HN, Wt, T, Np, D}; pg8::StaticOrder SO; SO.init(T, Np, G, bx);
            pg8::EpiProj E{RB, ldc, nmain, tail, ldt, nvalid};
            pg8::gemm_phase<pg8::EpiProj, pg8::StaticOrder, true, true>(ldsl, g, SO, E, tid); } break;
        case 6:
#ifndef DIS_SCAN
            phase_gdn_scan(lds, RB, (const float*)(ws + WS_AB), (const float*)args.in[7] + (size_t)jj * 4 * 3072, (const float*)args.in[8] + jj * 8, (const float*)args.in[9] + jj * 8,
                           (float*)(ws + WS_O32), bx, G, tid, wid, lane);
#endif
            break;
        case 7:
#ifndef DIS_GPOST
            phase_gdn_post((const float*)(ws + WS_O32), RB, (const float*)args.in[10] + jj * 128, HN, gw, NGW, lane);
#endif
            break;
        case 8:
#ifndef DIS_SPOST
            phase_sc_post(RB, (const float*)args.in[13], HN, vcu * 512 + tid, G * 512);
#endif
            break;
        case 9:
#ifndef DIS_NPOST
            phase_nsa_post(lds, RB, (const float*)args.in[16], (const float*)args.in[17], tab, QN, KSb, KWb, KCH, VCH, VST, VWT, gw, NGW, wid, lane);
#endif
            break;
        case 10: {
            pg8::Gemm g{KCH, (const bf16*)(ws + WS_WC1), 8192, 512, 1024}; pg8::StaticOrder SO; SO.init(8192, 512, G, bx);
            pg8::Gemm g2{VCH, (const bf16*)(ws + WS_WC1) + (size_t)512 * 1024, 8192, 512, 1024};
            pg8::EpiF32 E{Pk, 512};
            if (bx >= G / 2) { g = g2; SO.init(8192, 512, G, bx - G / 2); E.C = Pv; }
            pg8::gemm_phase<pg8::EpiF32, pg8::StaticOrder, true, true>(ldsl, g, SO, E, tid); } break;
        case 11:
#ifndef DIS_CMP2
            phase_cmp2(lds, Pk, Pv, (const float*)(ws + WS_BP), (const float*)args.in[21], (const float*)args.in[22], (const float*)args.in[17], KC, VC, gw, NGW, wid, lane);
#endif
            break;
        case 12:
#ifndef DIS_ATTN
            phase_nsa_attn(lds, QN, KSb, KWb, VST, VWT, KC, VC, OVT, (const float*)(ws + WS_GT), tab, HN, bx, G, tid, wid, lane);
#endif
            break;
        default: {
            const bf16* Wout = kind == 0 ? (const bf16*)(ws + WS_WGO) + (size_t)jj * D * D : (kind == 1 ? (const bf16*)(ws + WS_WSO) : (const bf16*)(ws + WS_WNO));
            pg8::Gemm g{HN, Wout, T, D, D}; pg8::StaticOrder SO; SO.init(T, D, G, bx);
            pg8::EpiResid E{hout, hout, 1.0f};
            pg8::gemm_phase<pg8::EpiResid, pg8::StaticOrder, true, true>(ldsl, g, SO, E, tid); } break;
        }
#ifdef REP_TYPE
        if (type == REP_TYPE && !again) { again = true; grid.sync(); --ph; continue; }
        again = false;
#endif
        if (ph + 1 < args.hi) grid.sync();
    }
}

extern "C" void kernel_launch(void* const* d_in, const int* in_sizes, int n_in, void* d_out, int out_size, void* d_ws, size_t ws_size, hipStream_t stream) {
    static int grid = 0;
    if (grid == 0) {
        if (n_in != 24 || out_size != T * D || ws_size < WS_END) { fprintf(stderr, "kernel_launch: unexpected shapes n_in %d out %d ws %zu (need %zu)\n", n_in, out_size, ws_size, (size_t)WS_END); grid = -1; return; }
        int dev = 0, cus = 0, per_cu = 0;
        hipGetDevice(&dev); hipDeviceGetAttribute(&cus, hipDeviceAttributeMultiprocessorCount, dev);
        if (hipFuncSetAttribute((const void*)mega, hipFuncAttributeMaxDynamicSharedMemorySize, LDS_BYTES) != hipSuccess) { fprintf(stderr, "kernel_launch: hipFuncSetAttribute failed\n"); grid = -1; return; }
        if (hipOccupancyMaxActiveBlocksPerMultiprocessor(&per_cu, (const void*)mega, 512, LDS_BYTES) != hipSuccess || per_cu < 1) { fprintf(stderr, "kernel_launch: occupancy query says %d\n", per_cu); per_cu = 1; }
        (void)hipGetLastError();
        grid = cus;
    }
    if (grid < 0) return;
    Args a{};
    for (int i = 0; i < 24; ++i) a.in[i] = d_in[i];
    a.out = (float*)d_out; a.ws = (unsigned char*)d_ws;
    constexpr int NPH = total_phases();
#if MK_MULTI
    for (int p = 0; p < NPH; ++p) { a.lo = p; a.hi = p + 1; hipLaunchKernelGGL(mega, dim3(grid), dim3(512), LDS_BYTES, stream, a); }
#else
    a.lo = 0; a.hi = NPH;
    void* kargs[] = {&a};
    hipError_t e = hipLaunchCooperativeKernel((const void*)mega, dim3(grid), dim3(512), kargs, LDS_BYTES, stream);
    if (e != hipSuccess) fprintf(stderr, "cooperative launch failed: %s (grid %d)\n", hipGetErrorString(e), grid);
#endif
}
```

```cpp
#include <hip/hip_runtime.h>
#include <hip/hip_cooperative_groups.h>
#include <cstdio>
#include <cstdint>
namespace cg = cooperative_groups;
namespace pg8 {
#define PG8_LAS __attribute__((address_space(3)))
typedef unsigned short bf16_t;
typedef short bf16x8 __attribute__((ext_vector_type(8)));
typedef float f32x4 __attribute__((ext_vector_type(4)));
typedef unsigned u32x4 __attribute__((ext_vector_type(4)));
constexpr int BM = 256, BK = 64, HALF = 128, HTB = HALF * BK * 2  , STAGE_BYTES = 8 * HTB, NXCD = 8, WGM = 8;

__host__ __device__ __forceinline__ int lds_byte(int r, int c) { const int st = (r >> 4) * 2 + (c >> 5), rr = r & 15, cc = c & 31, ob = rr * 64 + cc * 2; return st * 1024 + (ob ^ (((ob >> 9) & 1) << 5)); }
__host__ __device__ __forceinline__ void stage_rc(int b, int& R, int& C) { const int st = b / 1024, sb = b % 1024, swz = sb ^ (((sb >> 9) & 1) << 5); R = (st >> 1) * 16 + swz / 64; C = (st & 1) * 32 + (swz % 64) / 2; }
__host__ __device__ __forceinline__ int perm32(int rho) { const int n = rho >> 4, i = rho & 15; return 8 * (i >> 2) + 4 * n + (i & 3); }

struct Unit { int pm, pn; };
struct Gemm { const bf16_t* A; const bf16_t* Bt; int M, N, K; };

struct StaticOrder {
    int nM, nN, nwg, G, c;
    __host__ __device__ void init(int M, int N, int G_, int c_) { nM = M / BM; nN = N / BM; nwg = nM * nN; G = G_; c = c_; }
    __host__ __device__ bool next(int i, Unit& u) const {
        const long L = (long)i * G + c; if (L >= nwg) return false;
        int wgid = (int)L; { const int q = nwg / NXCD, r = nwg % NXCD, xcd = wgid % NXCD, off = wgid / NXCD; wgid = (xcd < r ? xcd * (q + 1) : r * (q + 1) + (xcd - r) * q) + off; }
        const int nig = WGM * nN, gid = wgid / nig, fm = gid * WGM, gsz = (nM - fm) < WGM ? (nM - fm) : WGM;
        u.pm = fm + ((wgid % nig) % gsz); u.pn = (wgid % nig) / gsz; return true;
    }
    __device__ __forceinline__ void a_ready(const Unit&) const {}
    __device__ __forceinline__ void done(const Unit&) const {}
};
__device__ __forceinline__ unsigned cvt_pk_bf16(float lo, float hi) { unsigned r; asm volatile("v_cvt_pk_bf16_f32 %0, %1, %2" : "=v"(r) : "v"(lo), "v"(hi)); return r; }
template <class Epi, class Sched, bool ALIGN_EPI = false, bool SP2 = false>
__device__ __forceinline__ void gemm_phase(PG8_LAS unsigned char* lds, const Gemm g, const Sched& S, const Epi& E, const int tid) {
    const int wid = __builtin_amdgcn_readfirstlane(tid >> 6), lane = tid & 63, wr = wid >> 2, wc = wid & 3, fr = lane & 15, fq = lane >> 4;
    const int K = g.K, nt = K / BK;
    unsigned voffA[2], voffB[2];
#pragma unroll
    for (int i = 0; i < 2; ++i) { int R, C; stage_rc(tid * 16 + i * 8192, R, C); const int Rb = Epi::PERM ? ((R & ~31) + perm32(R & 31)) : R;
        voffA[i] = (unsigned)(R * K + C) * 2u; voffB[i] = (unsigned)(Rb * K + C) * 2u; }
    const size_t kstep = (size_t)(BK * 2);
    const size_t hstep = (size_t)HALF * K * 2;
    const size_t tstep = 2 * hstep;
    const unsigned ldsw = (unsigned)wid * 1024u;
    const int aoff = lds_byte(wr * 64 + fr, fq * 8), boff = lds_byte(wc * 32 + fr, fq * 8);
#define PG8_SA(b, h) (((b) * 2 + (h)) * HTB)
#define PG8_SB(b, h) ((4 + (b) * 2 + (h)) * HTB)
#define PG8_STAGE(bufoff, gbase, voff) do { _Pragma("unroll") for (int _i = 0; _i < 2; ++_i) \
        __builtin_amdgcn_global_load_lds((const unsigned*)((const char*)(gbase) + (voff)[_i]), (PG8_LAS unsigned*)(lds + (bufoff) + ldsw + _i * 8192), 16, 0, 0); } while (0)
#define PG8_LDA(dst, b, h) do { _Pragma("unroll") for (int m = 0; m < 4; ++m) _Pragma("unroll") for (int k = 0; k < 2; ++k) dst[m][k] = *(const PG8_LAS bf16x8*)(lds + PG8_SA(b, h) + aoff + m * 2048 + k * 1024); } while (0)
#define PG8_LDB(dst, b, h) do { _Pragma("unroll") for (int n = 0; n < 2; ++n) _Pragma("unroll") for (int k = 0; k < 2; ++k) dst[n][k] = *(const PG8_LAS bf16x8*)(lds + PG8_SB(b, h) + boff + n * 2048 + k * 1024); } while (0)
#define PG8_MMA(ai, bj, At, Bt) do { __builtin_amdgcn_s_setprio(1); _Pragma("unroll") for (int m = 0; m < 4; ++m) _Pragma("unroll") for (int n = 0; n < 2; ++n) _Pragma("unroll") for (int k = 0; k < 2; ++k) \
        acc[ai][bj][m][n] = __builtin_amdgcn_mfma_f32_16x16x32_bf16(Bt[n][k], At[m][k], acc[ai][bj][m][n], 0, 0, 0); __builtin_amdgcn_s_setprio(0); } while (0)
#define PG8_WAIT_V(n) asm volatile("s_waitcnt vmcnt(" #n ")" ::: "memory")
#define PG8_WAIT_L(n) asm volatile("s_waitcnt lgkmcnt(" #n ")" ::: "memory")
#define PG8_BAR __builtin_amdgcn_s_barrier()
#define PG8_SCHED __builtin_amdgcn_sched_barrier(0)
    Unit cur, nxt; int ui = 0;
    if (!S.next(0, cur)) return;
    f32x4 acc[2][2][4][2];
#pragma unroll
    for (int a = 0; a < 2; ++a)
#pragma unroll
        for (int b = 0; b < 2; ++b)
#pragma unroll
            for (int m = 0; m < 4; ++m)
#pragma unroll
                for (int n = 0; n < 2; ++n) acc[a][b][m][n] = (f32x4){0.f, 0.f, 0.f, 0.f};
    bf16x8 At[4][2], B0[2][2], B1[2][2];
    const char* cA = (const char*)g.A + (size_t)cur.pm * tstep; const char* cB = (const char*)g.Bt + (size_t)cur.pn * tstep;
    S.a_ready(cur);
    if constexpr (SP2) {
        PG8_STAGE(PG8_SB(0, 0), cB, voffB); PG8_STAGE(PG8_SB(0, 1), cB + hstep, voffB); PG8_STAGE(PG8_SA(0, 0), cA, voffA); PG8_STAGE(PG8_SA(0, 1), cA + hstep, voffA);
        if (wr == 1) PG8_BAR;
        PG8_WAIT_V(2); PG8_BAR;
        PG8_STAGE(PG8_SB(1, 0), cB + kstep, voffB); PG8_STAGE(PG8_SA(1, 0), cA + kstep, voffA); PG8_STAGE(PG8_SB(1, 1), cB + hstep + kstep, voffB);
        PG8_WAIT_V(6); PG8_BAR;
    } else {
        PG8_STAGE(PG8_SB(0, 0), cB, voffB); PG8_STAGE(PG8_SA(0, 0), cA, voffA); PG8_STAGE(PG8_SB(0, 1), cB + hstep, voffB); PG8_STAGE(PG8_SA(0, 1), cA + hstep, voffA);
        if (wr == 1) PG8_BAR;
        PG8_WAIT_V(4); PG8_BAR;
        PG8_STAGE(PG8_SB(1, 0), cB + kstep, voffB); PG8_STAGE(PG8_SA(1, 0), cA + kstep, voffA); PG8_STAGE(PG8_SB(1, 1), cB + hstep + kstep, voffB);
        PG8_WAIT_V(6); PG8_BAR;
    }
    for (;;) {
        const bool has_next = S.next(ui + 1, nxt);
        const char* nA = has_next ? (const char*)g.A + (size_t)nxt.pm * tstep : cA; const char* nB = has_next ? (const char*)g.Bt + (size_t)nxt.pn * tstep : cB;
        for (int t = 0; t < nt; t += 2) {
            const bool last = (t == nt - 2);
            const char* a1 = cA + (size_t)(t + 1) * kstep;
            const char* a2 = last ? nA : cA + (size_t)(t + 2) * kstep; const char* b2 = last ? nB : cB + (size_t)(t + 2) * kstep;
            const char* a3 = a2 + kstep; const char* b3 = b2 + kstep;
            if (last && has_next) S.a_ready(nxt);
            if constexpr (SP2) {
            PG8_LDB(B0, 0, 0); PG8_LDB(B1, 0, 1); PG8_SCHED; PG8_LDA(At, 0, 0); PG8_STAGE(PG8_SA(1, 1), a1 + hstep, voffA);
            PG8_WAIT_V(8); PG8_WAIT_L(0); PG8_BAR; PG8_MMA(0, 0, At, B0); PG8_MMA(0, 1, At, B1); PG8_BAR; PG8_SCHED;
            PG8_LDA(At, 0, 1); PG8_STAGE(PG8_SB(0, 0), b2, voffB); PG8_STAGE(PG8_SB(0, 1), b2 + hstep, voffB); PG8_STAGE(PG8_SA(0, 0), a2, voffA);
            PG8_WAIT_V(8); PG8_WAIT_L(0); PG8_BAR; PG8_MMA(1, 0, At, B0); PG8_MMA(1, 1, At, B1); PG8_BAR; PG8_SCHED;
            PG8_LDB(B0, 1, 0); PG8_LDB(B1, 1, 1); PG8_SCHED; PG8_LDA(At, 1, 0); PG8_STAGE(PG8_SA(0, 1), a2 + hstep, voffA);
            PG8_WAIT_V(8); PG8_WAIT_L(0); PG8_BAR; PG8_MMA(0, 0, At, B0); PG8_MMA(0, 1, At, B1); PG8_BAR; PG8_SCHED;
            PG8_LDA(At, 1, 1); PG8_STAGE(PG8_SB(1, 0), b3, voffB); PG8_STAGE(PG8_SB(1, 1), b3 + hstep, voffB); PG8_STAGE(PG8_SA(1, 0), a3, voffA);
            PG8_WAIT_V(8); PG8_WAIT_L(0); PG8_BAR; PG8_MMA(1, 0, At, B0); PG8_MMA(1, 1, At, B1); PG8_BAR; PG8_SCHED;
            } else {
            PG8_LDB(B0, 0, 0); PG8_SCHED; PG8_LDA(At, 0, 0); PG8_STAGE(PG8_SA(1, 1), a1 + hstep, voffA);
            PG8_WAIT_L(8); PG8_BAR; PG8_WAIT_L(0); PG8_MMA(0, 0, At, B0); PG8_BAR; PG8_SCHED;
            PG8_LDB(B1, 0, 1); PG8_STAGE(PG8_SB(0, 0), b2, voffB);
            PG8_BAR; PG8_WAIT_L(0); PG8_MMA(0, 1, At, B1); PG8_BAR;
            PG8_LDA(At, 0, 1); PG8_STAGE(PG8_SA(0, 0), a2, voffA);
            PG8_BAR; PG8_WAIT_L(0); PG8_MMA(1, 0, At, B0); PG8_BAR; PG8_SCHED;
            PG8_STAGE(PG8_SB(0, 1), b2 + hstep, voffB);
            PG8_WAIT_V(6); PG8_BAR; PG8_MMA(1, 1, At, B1); PG8_BAR;
            PG8_LDB(B0, 1, 0); PG8_SCHED; PG8_LDA(At, 1, 0); PG8_STAGE(PG8_SA(0, 1), a2 + hstep, voffA);
            PG8_WAIT_L(8); PG8_BAR; PG8_WAIT_L(0); PG8_MMA(0, 0, At, B0); PG8_BAR; PG8_SCHED;
            PG8_LDB(B1, 1, 1); PG8_STAGE(PG8_SB(1, 0), b3, voffB);
            PG8_BAR; PG8_WAIT_L(0); PG8_MMA(0, 1, At, B1); PG8_BAR;
            PG8_LDA(At, 1, 1); PG8_STAGE(PG8_SA(1, 0), a3, voffA);
            PG8_BAR; PG8_WAIT_L(0); PG8_MMA(1, 0, At, B0); PG8_BAR; PG8_SCHED;
            PG8_STAGE(PG8_SB(1, 1), b3 + hstep, voffB);
            PG8_WAIT_V(6); PG8_BAR; PG8_MMA(1, 1, At, B1); PG8_BAR;
            }
        }
        if constexpr (ALIGN_EPI) { if (wr == 0) PG8_BAR; }
        if constexpr (!Epi::AFTER_DRAIN) { E(acc, cur, wr, wc, fr, fq); S.done(cur); }
        if (!has_next) break;
#pragma unroll
        for (int a = 0; a < 2; ++a)
#pragma unroll
            for (int b = 0; b < 2; ++b)
#pragma unroll
                for (int m = 0; m < 4; ++m)
#pragma unroll
                    for (int n = 0; n < 2; ++n) acc[a][b][m][n] = (f32x4){0.f, 0.f, 0.f, 0.f};
        cur = nxt; cA = nA; cB = nB; ++ui;
        if constexpr (ALIGN_EPI) { if (wr == 1) PG8_BAR; }
    }
    PG8_WAIT_V(0);
    if constexpr (!ALIGN_EPI) { if (wr == 0) PG8_BAR; }
    PG8_BAR;
    if constexpr (Epi::AFTER_DRAIN) { E.fused(acc, cur, wr, wc, fr, fq, lds, wid, lane); S.done(cur); }
#undef PG8_SA
#undef PG8_SB
#undef PG8_STAGE
#undef PG8_LDA
#undef PG8_LDB
#undef PG8_MMA
#undef PG8_WAIT_V
#undef PG8_WAIT_L
#undef PG8_BAR
#undef PG8_SCHED
}
}

typedef unsigned short bf16;
typedef float f32x4 __attribute__((ext_vector_type(4)));
typedef float f32x2 __attribute__((ext_vector_type(2)));
typedef unsigned u32x4 __attribute__((ext_vector_type(4)));
typedef unsigned u32x2 __attribute__((ext_vector_type(2)));

#ifndef MK_MULTI
#define MK_MULTI 0
#endif

constexpr int Bn = 8, S = 4096, T = Bn * S, D = 1024, FF = 2816, DEPTH = 4;
constexpr float EPS = 1e-6f;
constexpr int GDN_NPAD = 4352, NSA_NPAD = 2816;
constexpr int LDS_BYTES = 147456;
constexpr size_t MiB = 1u << 20;
constexpr size_t WS_WGU = 1 * MiB;
constexpr size_t WS_WDN = WS_WGU + 88 * MiB;
constexpr size_t WS_WGI = WS_WDN + 44 * MiB;
constexpr size_t WS_WGO = WS_WGI + 17 * MiB;
constexpr size_t WS_WSI = WS_WGO + 4 * MiB;
constexpr size_t WS_WSO = WS_WSI + 6 * MiB;
constexpr size_t WS_WNI = WS_WSO + 2 * MiB;
constexpr size_t WS_WNO = WS_WNI + 6 * MiB;
constexpr size_t WS_WC1 = WS_WNO + 2 * MiB;
constexpr size_t WS_TAB = WS_WC1 + 2 * MiB;
constexpr size_t WS_HN  = 184 * MiB;
constexpr size_t WS_R   = WS_HN + 64 * MiB;
constexpr size_t WS_O32 = WS_R + 256 * MiB;
constexpr size_t WS_SM  = WS_O32 + 128 * MiB;
constexpr size_t WS_AB  = WS_SM;
constexpr size_t WS_GT  = WS_SM + 2 * MiB;
constexpr size_t WS_BP  = WS_SM + 8 * MiB;
constexpr size_t WS_END = WS_SM + 9 * MiB;
static_assert(WS_TAB + 8 * MiB <= WS_HN, "ws map");

__device__ __forceinline__ float bf2f(unsigned v) { return __uint_as_float(v << 16); }
__device__ __forceinline__ unsigned f2bf(float f) { unsigned u = __float_as_uint(f); return (u + 0x7fffu + ((u >> 16) & 1u)) >> 16; }
__device__ __forceinline__ unsigned pk2(float lo, float hi) { return f2bf(lo) | (f2bf(hi) << 16); }
__device__ __forceinline__ float wave_sum(float v) {
#pragma unroll
    for (int o = 1; o < 64; o <<= 1) v += __shfl_xor(v, o);
    return v;
}
__device__ __forceinline__ float wave_max(float v) {
#pragma unroll
    for (int o = 1; o < 64; o <<= 1) v = fmaxf(v, __shfl_xor(v, o));
    return v;
}
__device__ __forceinline__ float row_sum16(float v) {
    v += __uint_as_float((unsigned)__builtin_amdgcn_update_dpp(0, (int)__float_as_uint(v), 0x128, 0xf, 0xf, false));
    v += __uint_as_float((unsigned)__builtin_amdgcn_update_dpp(0, (int)__float_as_uint(v), 0x124, 0xf, 0xf, false));
    v += __uint_as_float((unsigned)__builtin_amdgcn_update_dpp(0, (int)__float_as_uint(v), 0x122, 0xf, 0xf, false));
    v += __uint_as_float((unsigned)__builtin_amdgcn_update_dpp(0, (int)__float_as_uint(v), 0x121, 0xf, 0xf, false));
    return v;
}
__device__ __forceinline__ float sigmoidf_(float x) { return 1.f / (1.f + __expf(-x)); }
__device__ __forceinline__ float siluf_(float x) { return x / (1.f + __expf(-x)); }
#define WAVE_SYNC() do { asm volatile("s_waitcnt lgkmcnt(0)" ::: "memory"); __builtin_amdgcn_wave_barrier(); } while (0)

namespace pg8 {
struct EpiSwiGLU {
    static constexpr bool PERM = true, AFTER_DRAIN = false;
    bf16_t* O;
    __device__ __forceinline__ void operator()(const f32x4 (&acc)[2][2][4][2], const Unit& u, int wr, int wc, int fr, int fq) const {
        const int row0 = u.pm * BM + wr * 64 + fr, col0 = u.pn * HALF + wc * 32 + 8 * fq;
#pragma unroll
        for (int ai = 0; ai < 2; ++ai)
#pragma unroll
            for (int m = 0; m < 4; ++m) {
                bf16_t* rowp = O + (size_t)(row0 + ai * HALF + m * 16) * FF + col0;
                float v[8];
#pragma unroll
                for (int n = 0; n < 2; ++n)
#pragma unroll
                    for (int j = 0; j < 4; ++j) { const float g = acc[ai][0][m][n][j], uu = acc[ai][1][m][n][j]; v[n * 4 + j] = g * __builtin_amdgcn_rcpf(1.f + __expf(-g)) * uu; }
                u32x4 w; w.x = cvt_pk_bf16(v[0], v[1]); w.y = cvt_pk_bf16(v[2], v[3]); w.z = cvt_pk_bf16(v[4], v[5]); w.w = cvt_pk_bf16(v[6], v[7]);
                *(u32x4*)rowp = w;
            }
    }
};
struct EpiResid {
    static constexpr bool PERM = false, AFTER_DRAIN = false;
    const float* base; float* out; float scale;
    __device__ __forceinline__ void operator()(const f32x4 (&acc)[2][2][4][2], const Unit& u, int wr, int wc, int fr, int fq) const {
        const int row0 = u.pm * BM + wr * 64 + fr, col0 = u.pn * BM + wc * 32 + 4 * fq;
#pragma unroll
        for (int ai = 0; ai < 2; ++ai)
#pragma unroll
            for (int m = 0; m < 4; ++m) {
                const size_t off = (size_t)(row0 + ai * HALF + m * 16) * D + col0;
#pragma unroll
                for (int bj = 0; bj < 2; ++bj)
#pragma unroll
                    for (int n = 0; n < 2; ++n) { const f32x4 bs = *(const f32x4*)(base + off + bj * HALF + n * 16); *(f32x4*)(out + off + bj * HALF + n * 16) = bs + acc[ai][bj][m][n] * scale; }
                asm volatile("" ::: "memory");
            }
    }
};
struct EpiProj {
    static constexpr bool PERM = true, AFTER_DRAIN = false;
    bf16_t* O; int ldc; int nmain; float* tail; int ldt; int nvalid;
    __device__ __forceinline__ void operator()(const f32x4 (&acc)[2][2][4][2], const Unit& u, int wr, int wc, int fr, int fq) const {
        const int row0 = u.pm * BM + wr * 64 + fr, colt = u.pn * BM, col0 = colt + wc * 32 + 8 * fq;
        if (colt + BM <= nmain) {
#pragma unroll
            for (int ai = 0; ai < 2; ++ai)
#pragma unroll
                for (int m = 0; m < 4; ++m) {
                    bf16_t* rowp = O + (size_t)(row0 + ai * HALF + m * 16) * ldc + col0;
#pragma unroll
                    for (int bj = 0; bj < 2; ++bj) { const f32x4 v0 = acc[ai][bj][m][0], v1 = acc[ai][bj][m][1];
                        u32x4 w; w.x = cvt_pk_bf16(v0[0], v0[1]); w.y = cvt_pk_bf16(v0[2], v0[3]); w.z = cvt_pk_bf16(v1[0], v1[1]); w.w = cvt_pk_bf16(v1[2], v1[3]);
                        *(u32x4*)(rowp + bj * HALF) = w; }
                }
        } else {
#pragma unroll
            for (int ai = 0; ai < 2; ++ai)
#pragma unroll
                for (int m = 0; m < 4; ++m) {
                    const size_t row = (size_t)(row0 + ai * HALF + m * 16);
#pragma unroll
                    for (int bj = 0; bj < 2; ++bj)
#pragma unroll
                        for (int n = 0; n < 2; ++n)
#pragma unroll
                            for (int j = 0; j < 4; ++j) { const int col = col0 + bj * HALF + 4 * n + j; if (col >= nmain && col < nvalid) tail[row * ldt + (col - nmain)] = acc[ai][bj][m][n][j]; }
                }
        }
    }
};
struct EpiF32 {
    static constexpr bool PERM = false, AFTER_DRAIN = false;
    float* C; int ldc;
    __device__ __forceinline__ void operator()(const f32x4 (&acc)[2][2][4][2], const Unit& u, int wr, int wc, int fr, int fq) const {
        const int row0 = u.pm * BM + wr * 64 + fr, col0 = u.pn * BM + wc * 32 + 4 * fq;
#pragma unroll
        for (int ai = 0; ai < 2; ++ai)
#pragma unroll
            for (int m = 0; m < 4; ++m) {
                float* rowp = C + (size_t)(row0 + ai * HALF + m * 16) * ldc + col0;
#pragma unroll
                for (int bj = 0; bj < 2; ++bj)
#pragma unroll
                    for (int n = 0; n < 2; ++n) *(f32x4*)(rowp + bj * HALF + n * 16) = acc[ai][bj][m][n];
            }
    }
};
}

__device__ __forceinline__ void xpose_item(const float* W, int K, int N, bf16* WT, int rowbase, float* scr, int k0, int n0, int lane) {
    if (n0 + 32 <= N && (N & 3) == 0) {
        f32x4 v[8];
#pragma unroll
        for (int i = 0; i < 8; ++i) v[i] = *(const f32x4*)(W + (size_t)(k0 + 8 * i + (lane >> 3)) * N + n0 + 4 * (lane & 7));
#pragma unroll
        for (int i = 0; i < 8; ++i) { float* d = scr + (8 * i + (lane >> 3)) * 33 + 4 * (lane & 7); d[0] = v[i].x; d[1] = v[i].y; d[2] = v[i].z; d[3] = v[i].w; }
    } else {
#pragma unroll 8
        for (int i = 0; i < 32; ++i) { const int kk = 2 * i + (lane >> 5), n = n0 + (lane & 31); scr[kk * 33 + (lane & 31)] = n < N ? W[(size_t)(k0 + kk) * N + n] : 0.f; }
    }
    WAVE_SYNC();
    const int c = lane & 7;
#pragma unroll
    for (int j = 0; j < 4; ++j) { const int n = (lane >> 3) + 8 * j; const float* s = scr + (8 * c) * 33 + n;
        u32x4 o; o.x = pk2(s[0 * 33], s[1 * 33]); o.y = pk2(s[2 * 33], s[3 * 33]); o.z = pk2(s[4 * 33], s[5 * 33]); o.w = pk2(s[6 * 33], s[7 * 33]);
        *(u32x4*)(WT + (size_t)(rowbase + n) * K + k0 + 8 * c) = o; }
    WAVE_SYNC();
}
__device__ __forceinline__ void xpose_matrix(const float* W, int K, int N, int Npad, bf16* WT, int mode, float* scr, int gw, int NGW, int lane) {
    const int nblk = Npad / 32, nitems = (K / 64) * nblk;
    for (int it = gw; it < nitems; it += NGW) {
        const int kb = it / nblk, nb = it - kb * nblk, n0 = nb * 32;
        int rb = n0;
        if (mode == 1) rb = (n0 < FF) ? ((n0 >> 7) * 256 + (n0 & 127)) : ((((n0 - FF) >> 7) * 256) + 128 + ((n0 - FF) & 127));
        xpose_item(W, K, N, WT, rb, scr, kb * 64, n0, lane);
    }
}

__device__ __forceinline__ void phase_norm(const float* h, const float* w, bf16* out, int gw, int NGW, int lane) {
    f32x4 wv[4];
#pragma unroll
    for (int j = 0; j < 4; ++j) wv[j] = ((const f32x4*)w)[64 * j + lane];
    for (int m = gw; m < T; m += NGW) {
        const f32x4* xr = (const f32x4*)(h + (size_t)m * D) + lane;
        f32x4 v[4]; float s = 0.f;
#pragma unroll
        for (int j = 0; j < 4; ++j) { v[j] = xr[64 * j]; s += (v[j].x * v[j].x + v[j].y * v[j].y) + (v[j].z * v[j].z + v[j].w * v[j].w); }
        const float rstd = 1.f / sqrtf(wave_sum(s) * (1.f / D) + EPS);
        u32x2* o8 = (u32x2*)(out + (size_t)m * D) + lane;
#pragma unroll
        for (int j = 0; j < 4; ++j) { u32x2 o; o.x = pk2(v[j].x * rstd * wv[j].x, v[j].y * rstd * wv[j].y); o.y = pk2(v[j].z * rstd * wv[j].z, v[j].w * rstd * wv[j].w); o8[64 * j] = o; }
    }
}

__device__ __forceinline__ void phase_gdn_scan(unsigned char* lds, const bf16* proj, const float* ab, const float* convw, const float* A_log, const float* dt_bias,
                                               float* o32, int vblk, int nblk, int tid, int wid, int lane) {
    float* qs = (float*)lds;
    float* ks = qs + 64 * 128;
    float* vs = ks + 64 * 128;
    float* al = vs + 64 * 32;
    float* be = al + 64;
    float* qk = be + 64;
    float* os = qk + 64;
    bf16* raw = (bf16*)(os + 64 * 32);
    const int e = tid >> 4, dl = tid & 15;
    for (int item = vblk; item < 256; item += nblk) {
        const int bh = (item & 7) + 8 * (item >> 5), es = (item >> 3) & 3, b = bh >> 3, h = bh & 7;
        const float Ah = __expf(A_log[h]), dtb = dt_bias[h];
        const int isk = (tid >> 4) & 1, cg = tid & 15, cv = tid & 3;
        const int colqk = isk * 1024 + h * 128 + cg * 8, colv = 2048 + h * 128 + es * 32 + cv * 8;
        f32x4 wq[4][2], wv[4][2];
#pragma unroll
        for (int j = 0; j < 4; ++j) { wq[j][0] = *(const f32x4*)(convw + j * 3072 + colqk); wq[j][1] = *(const f32x4*)(convw + j * 3072 + colqk + 4);
                                      wv[j][0] = *(const f32x4*)(convw + j * 3072 + colv);  wv[j][1] = *(const f32x4*)(convw + j * 3072 + colv + 4); }
        f32x2 S2[4];
#pragma unroll
        for (int i = 0; i < 4; ++i) S2[i] = (f32x2){0.f, 0.f};
        u32x4 pre[5];
#define GDN_PREFETCH(T0) do { _Pragma("unroll") for (int k_ = 0; k_ < 5; ++k_) { const int idx_ = tid + 512 * k_; const int row_ = idx_ / 36, c_ = idx_ - row_ * 36; const int ts_ = (T0) - 3 + row_; \
            const int col_ = c_ < 16 ? h * 128 + c_ * 8 : (c_ < 32 ? 1024 + h * 128 + (c_ - 16) * 8 : 2048 + h * 128 + es * 32 + (c_ - 32) * 8); \
            pre[k_] = (u32x4){0u, 0u, 0u, 0u}; if (idx_ < 67 * 36 && ts_ >= 0) pre[k_] = *(const u32x4*)(proj + (size_t)(b * S + ts_) * 4096 + col_); } } while (0)
#define GDN_PARK() do { _Pragma("unroll") for (int k_ = 0; k_ < 5; ++k_) { const int idx_ = tid + 512 * k_; if (idx_ < 67 * 36) *(u32x4*)(raw + idx_ * 8) = pre[k_]; } } while (0)
#define GDN_CONV8(ROW0, C8, W, OUT) do { _Pragma("unroll") for (int i_ = 0; i_ < 8; ++i_) OUT[i_] = 0.f; _Pragma("unroll") for (int j_ = 0; j_ < 4; ++j_) { const u32x4 xv_ = *(const u32x4*)(raw + ((ROW0) + j_) * 288 + (C8) * 8); \
            OUT[0] += bf2f(xv_.x & 0xffffu) * W[j_][0].x; OUT[1] += bf2f(xv_.x >> 16) * W[j_][0].y; OUT[2] += bf2f(xv_.y & 0xffffu) * W[j_][0].z; OUT[3] += bf2f(xv_.y >> 16) * W[j_][0].w; \
            OUT[4] += bf2f(xv_.z & 0xffffu) * W[j_][1].x; OUT[5] += bf2f(xv_.z >> 16) * W[j_][1].y; OUT[6] += bf2f(xv_.w & 0xffffu) * W[j_][1].z; OUT[7] += bf2f(xv_.w >> 16) * W[j_][1].w; } \
            _Pragma("unroll") for (int i_ = 0; i_ < 8; ++i_) OUT[i_] = siluf_(OUT[i_]); } while (0)
#define GDN_CONVNORM(T0) do { \
            _Pragma("unroll") for (int it_ = 0; it_ < 4; ++it_) { const int tok_ = it_ * 16 + (tid >> 5); float y_[8]; GDN_CONV8(tok_, isk * 16 + cg, wq, y_); \
                float ss_ = (y_[0] * y_[0] + y_[1] * y_[1]) + (y_[2] * y_[2] + y_[3] * y_[3]) + (y_[4] * y_[4] + y_[5] * y_[5]) + (y_[6] * y_[6] + y_[7] * y_[7]); \
                ss_ = row_sum16(ss_); const float sc_ = (1.f / sqrtf(ss_ + EPS)) * (isk ? 1.f : 0.08838834764831845f); \
                float* d_ = (isk ? ks : qs) + tok_ * 128 + cg * 8; \
                _Pragma("unroll") for (int i_ = 0; i_ < 8; ++i_) y_[i_] *= sc_; \
                *(f32x4*)d_ = (f32x4){y_[0], y_[1], y_[2], y_[3]}; *(f32x4*)(d_ + 4) = (f32x4){y_[4], y_[5], y_[6], y_[7]}; \
                float dq_ = 0.f; _Pragma("unroll") for (int i_ = 0; i_ < 8; ++i_) dq_ += y_[i_] * __shfl_xor(y_[i_], 16); \
                dq_ = row_sum16(dq_); if (isk == 0 && cg == 0) qk[tok_] = dq_; } \
            if (tid < 256) { const int tok_ = tid >> 2; float y_[8]; GDN_CONV8(tok_, 32 + cv, wv, y_); float* d_ = vs + tok_ * 32 + cv * 8; \
                *(f32x4*)d_ = (f32x4){y_[0], y_[1], y_[2], y_[3]}; *(f32x4*)(d_ + 4) = (f32x4){y_[4], y_[5], y_[6], y_[7]}; } \
            if (tid < 64) { const size_t tg_ = (size_t)(b * S + (T0) + tid); const float a_ = ab[tg_ * 16 + h] + dtb, bb_ = ab[tg_ * 16 + 8 + h]; \
                const float sp_ = a_ > 20.f ? a_ : log1pf(__expf(a_)); al[tid] = __expf(-Ah * sp_); be[tid] = sigmoidf_(bb_); } } while (0)
        __syncthreads();
        GDN_PREFETCH(0); GDN_PARK();
        __syncthreads();
        GDN_CONVNORM(0);
        __syncthreads();
        for (int chunk = 0; chunk < S / 64; ++chunk) {
            const int t0 = chunk * 64;
            const bool more = chunk + 1 < S / 64;
            if (more) GDN_PREFETCH(t0 + 64);
            {
                const float* kp = ks + dl * 8; const float* qp = qs + dl * 8; const float* vp = vs + e;
                f32x4 nk0 = *(const f32x4*)kp, nk1 = *(const f32x4*)(kp + 4), nq0 = *(const f32x4*)qp, nq1 = *(const f32x4*)(qp + 4);
                float nv = vp[0], na = al[0], nb = be[0], nqk = qk[0];
                for (int t16 = 0; t16 < 4; ++t16) {
                    float ok = 0.f;
#pragma unroll 4
                    for (int i = 0; i < 16; ++i) {
                        const int tt = t16 * 16 + i, tn = (tt + 1) & 63;
                        const f32x2 K0 = {nk0.x, nk0.y}, K1 = {nk0.z, nk0.w}, K2 = {nk1.x, nk1.y}, K3 = {nk1.z, nk1.w};
                        const f32x2 Q0 = {nq0.x, nq0.y}, Q1 = {nq0.z, nq0.w}, Q2 = {nq1.x, nq1.y}, Q3 = {nq1.z, nq1.w};
                        const float v = nv, a = na, bt = nb, qkt = nqk;
                        nk0 = *(const f32x4*)(kp + tn * 128); nk1 = *(const f32x4*)(kp + tn * 128 + 4); nq0 = *(const f32x4*)(qp + tn * 128); nq1 = *(const f32x4*)(qp + tn * 128 + 4);
                        nv = vp[tn * 32]; na = al[tn]; nb = be[tn]; nqk = qk[tn];
                        f32x2 pa = K0 * S2[0], pb = K2 * S2[2], qa = Q0 * S2[0], qb = Q2 * S2[2];
                        pa = K1 * S2[1] + pa; pb = K3 * S2[3] + pb; qa = Q1 * S2[1] + qa; qb = Q3 * S2[3] + qb;
                        pa += pb; qa += qb;
                        float p = pa.x + pa.y, qS = qa.x + qa.y;
                        p = row_sum16(p); qS = row_sum16(qS);
                        const float vn = bt * (v - a * p);
                        const float o = a * qS + qkt * vn;
                        const f32x2 vn2 = {vn, vn}, a2 = {a, a};
                        S2[0] = S2[0] * a2 + K0 * vn2; S2[1] = S2[1] * a2 + K1 * vn2; S2[2] = S2[2] * a2 + K2 * vn2; S2[3] = S2[3] * a2 + K3 * vn2;
                        ok = (i == dl) ? o : ok;
                    }
                    os[(t16 * 16 + dl) * 32 + e] = ok;
                }
            }
            __syncthreads();
            { const int tok = tid >> 3, c4 = tid & 7;
              *(f32x4*)(o32 + (size_t)(b * S + t0 + tok) * D + h * 128 + es * 32 + c4 * 4) = *(const f32x4*)(os + tok * 32 + c4 * 4); }
            if (more) {
                GDN_PARK();
                __syncthreads();
                GDN_CONVNORM(t0 + 64);
            }
            __syncthreads();
        }
#undef GDN_PREFETCH
#undef GDN_PARK
#undef GDN_CONV8
#undef GDN_CONVNORM
    }
}
__device__ __forceinline__ void phase_gdn_post(const float* o32, const bf16* proj, const float* onorm, bf16* hn, int gw, int NGW, int lane) {
    const f32x4 wv = *(const f32x4*)(onorm + ((4 * lane) & 127));
    for (int m = gw; m < T; m += NGW) {
        const f32x4* xr = (const f32x4*)(o32 + (size_t)m * D) + lane;
        const u32x2* gr = (const u32x2*)(proj + (size_t)m * 4096 + 3072) + lane;
        u32x2* o8 = (u32x2*)(hn + (size_t)m * D) + lane;
#pragma unroll
        for (int j = 0; j < 4; ++j) {
            const f32x4 v = xr[64 * j]; const u32x2 g = gr[64 * j];
            float s = (v.x * v.x + v.y * v.y) + (v.z * v.z + v.w * v.w);
#pragma unroll
            for (int o = 1; o < 32; o <<= 1) s += __shfl_xor(s, o);
            const float rstd = 1.f / sqrtf(s * (1.f / 128.f) + EPS);
            u32x2 o; o.x = pk2(v.x * rstd * wv.x * siluf_(bf2f(g.x & 0xffffu)), v.y * rstd * wv.y * siluf_(bf2f(g.x >> 16)));
            o.y = pk2(v.z * rstd * wv.z * siluf_(bf2f(g.y & 0xffffu)), v.w * rstd * wv.w * siluf_(bf2f(g.y >> 16)));
            o8[64 * j] = o;
        }
    }
}
__device__ __forceinline__ void phase_sc_post(const bf16* proj, const float* cw, bf16* hn, int gtid, int NT) {
    for (int idx = gtid; idx < T * 128; idx += NT) {
        const int m = idx >> 7, c8 = (idx & 127) * 8, s = m & (S - 1);
        float y[8];
#pragma unroll
        for (int i = 0; i < 8; ++i) y[i] = 0.f;
#pragma unroll
        for (int j = 0; j < 3; ++j) {
            if (s - 2 + j >= 0) {
                const bf16* pr = proj + (size_t)(m - 2 + j) * 3072;
                const u32x4 cv = *(const u32x4*)(pr + 1024 + c8), xv = *(const u32x4*)(pr + 2048 + c8);
                const f32x4 w0 = *(const f32x4*)(cw + j * 1024 + c8), w1 = *(const f32x4*)(cw + j * 1024 + c8 + 4);
                y[0] += w0.x * bf2f(cv.x & 0xffffu) * bf2f(xv.x & 0xffffu); y[1] += w0.y * bf2f(cv.x >> 16) * bf2f(xv.x >> 16);
                y[2] += w0.z * bf2f(cv.y & 0xffffu) * bf2f(xv.y & 0xffffu); y[3] += w0.w * bf2f(cv.y >> 16) * bf2f(xv.y >> 16);
                y[4] += w1.x * bf2f(cv.z & 0xffffu) * bf2f(xv.z & 0xffffu); y[5] += w1.y * bf2f(cv.z >> 16) * bf2f(xv.z >> 16);
                y[6] += w1.z * bf2f(cv.w & 0xffffu) * bf2f(xv.w & 0xffffu); y[7] += w1.w * bf2f(cv.w >> 16) * bf2f(xv.w >> 16);
            }
        }
        const u32x4 bv = *(const u32x4*)(proj + (size_t)m * 3072 + c8);
        u32x4 o;
        o.x = pk2(y[0] * bf2f(bv.x & 0xffffu), y[1] * bf2f(bv.x >> 16)); o.y = pk2(y[2] * bf2f(bv.y & 0xffffu), y[3] * bf2f(bv.y >> 16));
        o.z = pk2(y[4] * bf2f(bv.z & 0xffffu), y[5] * bf2f(bv.z >> 16)); o.w = pk2(y[6] * bf2f(bv.w & 0xffffu), y[7] * bf2f(bv.w >> 16));
        *(u32x4*)(hn + (size_t)m * D + c8) = o;
    }
}
__device__ __forceinline__ void phase_nsa_post(unsigned char* lds, const bf16* proj, const float* qnorm, const float* knorm, const f32x2* tab,
                                               bf16* QN, bf16* KS, bf16* KW, bf16* KCH, bf16* VCH, bf16* VST, bf16* VWT, int gw, int NGW, int wid, int lane) {
    {
        bf16* tile = (bf16*)lds + wid * (64 * 66);
        for (int item = gw; item < 2 * 32 * 64; item += NGW) {
            const int st = item & 63, bh = (item >> 6) & 31, which = item >> 11, b = bh >> 2, hk = bh & 3;
            const bf16* src = proj + ((size_t)b * S + st * 64) * 2560 + (which ? 2304 : 1792) + hk * 64 + lane;
#pragma unroll 8
            for (int i = 0; i < 64; ++i) tile[i * 66 + lane] = src[(size_t)i * 2560];
            WAVE_SYNC();
            bf16* dst = (which ? VWT : VST) + (size_t)bh * 64 * S + st * 64 + lane;
#pragma unroll 8
            for (int d = 0; d < 64; ++d) dst[(size_t)d * S] = tile[lane * 66 + d];
            WAVE_SYNC();
        }
    }
    const float qw = qnorm[lane], kw1 = knorm[64 + lane], kw2 = knorm[128 + lane];
    for (int m = gw; m < T; m += NGW) {
        const int b = m >> 12, s = m & (S - 1);
        const bf16* pr = proj + (size_t)m * 2560;
        const f32x2 cs = tab[(size_t)m * 32 + (lane & 31)];
#pragma unroll 4
        for (int hh = 0; hh < 16; ++hh) {
            const float x = bf2f(pr[hh * 64 + lane]);
            const float ss = wave_sum(x * x);
            QN[((size_t)(b * 16 + hh) * S + s) * 64 + lane] = (bf16)f2bf(x * (1.f / sqrtf(ss * (1.f / 64.f) + EPS)) * qw);
        }
#pragma unroll
        for (int hk = 0; hk < 4; ++hk) {
            const size_t o = ((size_t)(b * 4 + hk) * S + s) * 64 + lane;
            { const float x = bf2f(pr[1536 + hk * 64 + lane]); const float ss = wave_sum(x * x);
              const float y = x * (1.f / sqrtf(ss * (1.f / 64.f) + EPS)) * kw1; const float yp = __shfl_xor(y, 32);
              KS[o] = (bf16)f2bf(y * cs.x + (lane < 32 ? -yp : yp) * cs.y); }
            { const float x = bf2f(pr[2048 + hk * 64 + lane]); const float ss = wave_sum(x * x);
              const float y = x * (1.f / sqrtf(ss * (1.f / 64.f) + EPS)) * kw2; const float yp = __shfl_xor(y, 32);
              KW[o] = (bf16)f2bf(y * cs.x + (lane < 32 ? -yp : yp) * cs.y); }
            KCH[o] = pr[1024 + hk * 64 + lane];
            VCH[o] = pr[1280 + hk * 64 + lane];
        }
    }
}
__device__ __forceinline__ void phase_cmp2(unsigned char* lds, const float* Pk, const float* Pv, const float* biasp, const float* w2, const float* b2, const float* knorm0,
                                           bf16* KC, bf16* VC, int gw, int NGW, int wid, int lane) {
    float* hs = (float*)lds + wid * 256;
    for (int item = gw; item < 2 * 32 * 256; item += NGW) {
        const int i = item & 255, bh = (item >> 8) & 31, kind = item >> 13;
        bf16* outp = kind ? VC + ((size_t)bh * 64 + lane) * 256 + i : KC + ((size_t)bh * 256 + i) * 64 + lane;
        if (i == 255) { *outp = 0; continue; }
        const float* P = kind ? Pv : Pk;
        const float* r0 = P + ((size_t)bh * 256 + i) * 512; const float* r1 = r0 + 512 + 256;
#pragma unroll
        for (int j = 0; j < 4; ++j) { const int n = lane + 64 * j; const float x = r0[n] + r1[n] + biasp[kind * 256 + n];
            const float uu = 0.7978845608028654f * (x + 0.044715f * x * x * x);
            const float th = 1.f - 2.f / (1.f + __expf(2.f * uu));
            hs[n] = 0.5f * x * (1.f + th); }
        WAVE_SYNC();
        float acc = b2[kind * 64 + lane];
        const float* w = w2 + (size_t)kind * 256 * 64 + lane;
#pragma unroll 8
        for (int n = 0; n < 256; ++n) acc += hs[n] * w[n * 64];
        if (kind == 0) { const float ss = wave_sum(acc * acc); acc = acc * (1.f / sqrtf(ss * (1.f / 64.f) + EPS)) * knorm0[lane]; }
        *outp = (bf16)f2bf(acc);
        WAVE_SYNC();
    }
}
#define MFMA32(a, b, c) __builtin_amdgcn_mfma_f32_32x32x16_bf16((a), (b), (c), 0, 0, 0)
typedef short bf16x8v __attribute__((ext_vector_type(8)));
typedef float f32x16 __attribute__((ext_vector_type(16)));
typedef __bf16 bf16v2 __attribute__((ext_vector_type(2)));
constexpr int KV_STRIDE = 144;
constexpr int KV_BUF = 2 * 64 * KV_STRIDE;
constexpr int ATT_IMP_OFF = 2 * KV_BUF;
constexpr int ATT_MSK_OFF = ATT_IMP_OFF + 8 * 2048;
__device__ __forceinline__ unsigned pkbf(float a, float b) { f32x2 v = {a, b}; return __builtin_bit_cast(unsigned, __builtin_convertvector(v, bf16v2)); }

template <bool IMP>
__device__ __forceinline__ void attn_tile(const unsigned char* buf, int tt, int key0, int lo, int hi, const bf16x8v (&qf)[4],
                                          f32x16 (&O)[2], f32x16 (&IM)[2], float& m, float& l, const bf16* ovt, int r, int h, int pr) {
    f32x16 sacc;
#pragma unroll
    for (int i = 0; i < 16; ++i) sacc[i] = 0.f;
    const unsigned char* kb = buf + (32 * tt + pr) * KV_STRIDE + h * 16;
#pragma unroll
    for (int ks = 0; ks < 4; ++ks) { const bf16x8v a = *(const bf16x8v*)(kb + ks * 32); sacc = MFMA32(a, qf[ks], sacc); }
    const int kb0 = key0 + 8 * h;
    float mx = -1e30f;
#pragma unroll
    for (int i = 0; i < 16; ++i) { const int key = kb0 + 16 * (i >> 3) + (i & 7); const bool ok = (key >= lo) && (key <= hi);
        const float sv = ok ? sacc[i] * 0.18033688011112042f : -1e30f; sacc[i] = sv; mx = fmaxf(mx, sv); }
    mx = fmaxf(mx, __shfl_xor(mx, 32));
    const float mnew = fmaxf(m, mx), corr = __builtin_amdgcn_exp2f(m - mnew);
    m = mnew;
    float psum = 0.f;
#pragma unroll
    for (int i = 0; i < 16; ++i) { const float p = sacc[i] > -1e29f ? __builtin_amdgcn_exp2f(sacc[i] - mnew) : 0.f; psum += p; sacc[i] = p; }
    l = l * corr + psum;
    if (__any(corr != 1.f)) {
#pragma unroll
        for (int i = 0; i < 16; ++i) { O[0][i] *= corr; O[1][i] *= corr; }
        if (IMP) {
#pragma unroll
            for (int i = 0; i < 16; ++i) { IM[0][i] *= corr; IM[1][i] *= corr; }
        }
    }
    bf16x8v pf[2];
#pragma unroll
    for (int sx = 0; sx < 2; ++sx) { u32x4 w; w.x = pkbf(sacc[8 * sx], sacc[8 * sx + 1]); w.y = pkbf(sacc[8 * sx + 2], sacc[8 * sx + 3]); w.z = pkbf(sacc[8 * sx + 4], sacc[8 * sx + 5]); w.w = pkbf(sacc[8 * sx + 6], sacc[8 * sx + 7]);
        pf[sx] = __builtin_bit_cast(bf16x8v, w); }
    const unsigned char* vb = buf + 64 * KV_STRIDE + r * KV_STRIDE + (32 * tt + 8 * h) * 2;
#pragma unroll
    for (int dt = 0; dt < 2; ++dt)
#pragma unroll
        for (int sx = 0; sx < 2; ++sx) { const bf16x8v a = *(const bf16x8v*)(vb + dt * 32 * KV_STRIDE + sx * 32); O[dt] = MFMA32(a, pf[sx], O[dt]); }
    if (IMP) {
#pragma unroll
        for (int st = 0; st < 2; ++st)
#pragma unroll
            for (int sx = 0; sx < 2; ++sx) { const bf16x8v a = *(const bf16x8v*)(ovt + (32 * st + r) * 256 + key0 + 16 * sx + 8 * h); IM[st] = MFMA32(a, pf[sx], IM[st]); }
    }
}

template <int MODE>
__device__ __forceinline__ void attn_branch(unsigned char* kvbuf, const bf16* Kg0, const bf16* VTg0, int vts, unsigned long long blkmask, int t, int nv, unsigned long long selm,
                                            int wlo, int whi, const bf16x8v (&qf)[4], f32x16 (&O)[2], f32x16 (&IM)[2], float& l, const bf16* ovt, int tid, int r, int h, int pr) {
    float m = -1e30f;
    l = 0.f;
#pragma unroll
    for (int i = 0; i < 16; ++i) { O[0][i] = 0.f; O[1][i] = 0.f; IM[0][i] = 0.f; IM[1][i] = 0.f; }
    const int srow = tid >> 3, sch = tid & 7;
    int j = __builtin_ctzll(blkmask);
    unsigned long long rest = blkmask & (blkmask - 1);
    u32x4 kr = *(const u32x4*)(Kg0 + (size_t)(64 * j + srow) * 64 + sch * 8);
    u32x4 vr = *(const u32x4*)(VTg0 + (size_t)srow * vts + 64 * j + sch * 8);
    *(u32x4*)(kvbuf + srow * KV_STRIDE + sch * 16) = kr;
    *(u32x4*)(kvbuf + 64 * KV_STRIDE + srow * KV_STRIDE + sch * 16) = vr;
    int cur = 0;
    for (;;) {
        __syncthreads();
        const bool more = rest != 0ull;
        int jn = 0;
        if (more) { jn = __builtin_ctzll(rest); rest &= rest - 1;
            kr = *(const u32x4*)(Kg0 + (size_t)(64 * jn + srow) * 64 + sch * 8);
            vr = *(const u32x4*)(VTg0 + (size_t)srow * vts + 64 * jn + sch * 8); }
        const unsigned char* buf = kvbuf + cur * KV_BUF;
        int lo, hi;
        if (MODE == 0) { lo = 0; hi = nv - 1; }
        else if (MODE == 1) { lo = 0; hi = ((selm >> j) & 1ull) ? t : -1; }
        else { lo = t - 511; hi = t; }
#pragma unroll
        for (int tt = 0; tt < 2; ++tt) {
            const int key0 = 64 * j + 32 * tt;
            if (key0 > whi || key0 + 31 < wlo) continue;
            attn_tile<MODE == 0>(buf, tt, key0, lo, hi, qf, O, IM, m, l, ovt, r, h, pr);
        }
        if (!more) break;
        *(u32x4*)(kvbuf + (cur ^ 1) * KV_BUF + srow * KV_STRIDE + sch * 16) = kr;
        *(u32x4*)(kvbuf + (cur ^ 1) * KV_BUF + 64 * KV_STRIDE + srow * KV_STRIDE + sch * 16) = vr;
        cur ^= 1; j = jn;
    }
    __syncthreads();
}

__device__ __forceinline__ void phase_nsa_attn(unsigned char* lds, const bf16* QN, const bf16* KS, const bf16* KW, const bf16* VST, const bf16* VWT, const bf16* KCb, const bf16* VCT,
                                               const bf16* ovt, const float* gates, const f32x2* tab, bf16* hn, int vblk, int nblk, int tid, int wid, int lane) {
    const int r = lane & 31, h = lane >> 5, pr = (r & ~12) | ((r & 4) << 1) | ((r & 8) >> 1);
    float* imp_s = (float*)(lds + ATT_IMP_OFF + wid * 2048);
    unsigned long long* msk_s = (unsigned long long*)(lds + ATT_MSK_OFF);
    unsigned* uni_s = (unsigned*)(lds + ATT_MSK_OFF + 512);
    for (int item = vblk; item < Bn * 4 * 64; item += nblk) {
        const int rnd = item / nblk, wv = item - rnd * nblk;
        const int bh = wv & 31, sub = wv >> 5, per = nblk >> 5;
        int qb = rnd * per + ((rnd & 1) ? (per - 1 - sub) : sub);
        if (nblk != 256) { qb = item >> 5; }
        const int bhh = (nblk != 256) ? (item & 31) : bh;
        const int b = bhh >> 2, hk = bhh & 3;
        const int t0 = qb * 64, tw0 = t0 + 8 * wid, t = tw0 + (r & 7), g = r >> 3;
        const size_t tok = (size_t)b * S + t;
        if (tid == 0) { unsigned z = 0u; asm volatile("" : "+v"(z)); uni_s[0] = z; uni_s[1] = z; }
        bf16x8v qn[4], qr[4];
        {
            const bf16* qp = QN + ((size_t)(b * 16 + hk * 4 + g) * S + t) * 64 + 8 * h;
#pragma unroll
            for (int ks = 0; ks < 4; ++ks) qn[ks] = *(const bf16x8v*)(qp + 16 * ks);
            const f32x2* cp = tab + tok * 32 + 8 * h;
#pragma unroll
            for (int kl = 0; kl < 2; ++kl) {
                u32x4 wlo_, whi_;
                const u32x4 a = __builtin_bit_cast(u32x4, qn[kl]), c = __builtin_bit_cast(u32x4, qn[kl + 2]);
#pragma unroll
                for (int jj = 0; jj < 4; ++jj) {
                    const f32x2 cs0 = cp[16 * kl + 2 * jj], cs1 = cp[16 * kl + 2 * jj + 1];
                    const float x0 = bf2f(a[jj] & 0xffffu), x1 = bf2f(a[jj] >> 16), y0 = bf2f(c[jj] & 0xffffu), y1 = bf2f(c[jj] >> 16);
                    wlo_[jj] = pkbf(x0 * cs0.x - y0 * cs0.y, x1 * cs1.x - y1 * cs1.y);
                    whi_[jj] = pkbf(y0 * cs0.x + x0 * cs0.y, y1 * cs1.x + x1 * cs1.y);
                }
                qr[kl] = __builtin_bit_cast(bf16x8v, wlo_); qr[kl + 2] = __builtin_bit_cast(bf16x8v, whi_);
            }
        }
        const float* gp = gates + tok * 48 + (hk * 4 + g) * 3;
        const float g0 = sigmoidf_(gp[0]), g1 = sigmoidf_(gp[1]), g2 = sigmoidf_(gp[2]);
        f32x16 acc[2], O[2], IM[2];
        float l;
        const int nv = t >= 31 ? ((t - 31) >> 4) + 1 : 0;
        const int nvw = ((tw0 + 7 - 31) >> 4) + 1;
        const int nvmax = 4 * qb + 3;
        {
            const int ncb = (nvmax + 63) >> 6;
            const unsigned long long bm = ncb >= 64 ? ~0ull : ((1ull << ncb) - 1ull);
            attn_branch<0>(lds, KCb + (size_t)bhh * 256 * 64, VCT + (size_t)bhh * 64 * 256, 256, bm, t, nv, 0ull, 0, (tw0 + 7 >= 31 ? nvw - 1 : -1), qn, O, IM, l, ovt, tid, r, h, pr);
        }
        {
            const float lt = l + __shfl_xor(l, 32), inv = lt > 0.f ? 1.f / lt : 0.f, sc = inv * g0;
#pragma unroll
            for (int i = 0; i < 16; ++i) { acc[0][i] = O[0][i] * sc; acc[1][i] = O[1][i] * sc; }
#pragma unroll
            for (int st = 0; st < 2; ++st)
#pragma unroll
                for (int i = 0; i < 16; ++i) { float v = IM[st][i] * inv; v += __shfl_xor(v, 8); v += __shfl_xor(v, 16);
                    if (r < 8) imp_s[r * 64 + 32 * st + (i & 3) + 8 * (i >> 2) + 4 * h] = v; }
        }
        WAVE_SYNC();
        {
            unsigned long long um = 0ull;
            for (int tk = 0; tk < 8; ++tk) {
                const float imp = imp_s[tk * 64 + lane];
                const bool sv = lane <= qb, forced = (lane == 0) || (lane == qb) || (lane + 1 == qb);
                const float score = sv ? (forced ? 1e9f : imp) : -1.f;
                int rank = 0;
#pragma unroll 4
                for (int i = 0; i < 64; ++i) { const float si = __uint_as_float(__builtin_amdgcn_readlane(__float_as_uint(score), i)); rank += (si > score || (si == score && i < lane)) ? 1 : 0; }
                const unsigned long long mk = __ballot((rank < 16) && (score >= 0.f));
                um |= mk;
                if (lane == 0) msk_s[wid * 8 + tk] = mk;
            }
            if (lane == 0) { atomicOr(&uni_s[0], (unsigned)um); atomicOr(&uni_s[1], (unsigned)(um >> 32)); }
        }
        __syncthreads();
        const unsigned long long selm = msk_s[wid * 8 + (r & 7)];
        const unsigned long long uni = (unsigned long long)uni_s[0] | ((unsigned long long)uni_s[1] << 32);
        attn_branch<1>(lds, KS + (size_t)bhh * S * 64, VST + (size_t)bhh * 64 * S, S, uni, t, 0, selm, 0, tw0 + 7, qr, O, IM, l, ovt, tid, r, h, pr);
        {
            const float lt = l + __shfl_xor(l, 32), sc = g1 / lt;
#pragma unroll
            for (int i = 0; i < 16; ++i) { acc[0][i] += O[0][i] * sc; acc[1][i] += O[1][i] * sc; }
        }
        {
            const int jlo = qb >= 8 ? qb - 8 : 0;
            const unsigned long long bm = (qb >= 63 ? ~0ull : ((1ull << (qb + 1)) - 1ull)) & ~((1ull << jlo) - 1ull);
            attn_branch<2>(lds, KW + (size_t)bhh * S * 64, VWT + (size_t)bhh * 64 * S, S, bm, t, 0, 0ull, tw0 - 511, tw0 + 7, qr, O, IM, l, ovt, tid, r, h, pr);
        }
        {
            const float lt = l + __shfl_xor(l, 32), sc = g2 / lt;
            bf16* op = hn + tok * D + (hk * 4 + g) * 64 + 4 * h;
#pragma unroll
            for (int dt = 0; dt < 2; ++dt)
#pragma unroll
                for (int q4 = 0; q4 < 4; ++q4) {
                    u32x2 w; w.x = pkbf(acc[dt][4 * q4] + O[dt][4 * q4] * sc, acc[dt][4 * q4 + 1] + O[dt][4 * q4 + 1] * sc);
                    w.y = pkbf(acc[dt][4 * q4 + 2] + O[dt][4 * q4 + 2] * sc, acc[dt][4 * q4 + 3] + O[dt][4 * q4 + 3] * sc);
                    *(u32x2*)(op + 32 * dt + 8 * q4) = w;
                }
        }
    }
}


#define LAS __attribute__((address_space(3)))
#define XB_TMO      128
#define XB_XCNT(j)  (256  + 64 * (j))
#define XB_XSUB(j)  (1280 + 64 * (j))
#define XB_XGEN(j)  (2304 + 64 * (j))
#define XB_TOP      3328
#define XB_TOPGEN   3392
#define XCD_BAR_WORDS 3456
#define XB_SPIN_CAP (1u << 18)

__device__ __forceinline__ unsigned xb_ld(unsigned* p)              { return __hip_atomic_load(p, __ATOMIC_RELAXED, __HIP_MEMORY_SCOPE_AGENT); }
__device__ __forceinline__ unsigned xb_add(unsigned* p, unsigned v) { return __hip_atomic_fetch_add(p, v, __ATOMIC_RELAXED, __HIP_MEMORY_SCOPE_AGENT); }
__device__ __forceinline__ unsigned xb_xcc_id() { return (unsigned)__builtin_amdgcn_s_getreg((3 << 11) | 20) & 0xFu; }
#define XB_SPIN(cond, bar) do { unsigned _sp = 0; while (cond) { __builtin_amdgcn_s_sleep(1); \
    if ((++_sp & 255u) == 0u) { if (xb_ld(&(bar)[XB_TMO])) break; if (_sp > XB_SPIN_CAP) { atomicAdd(&(bar)[XB_TMO], 1u); break; } } } } while (0)

struct XcdBarrier {
    unsigned* bar; unsigned x;
    volatile LAS unsigned* st;
};

__device__ __forceinline__ XcdBarrier xcd_barrier_post(unsigned* bar, volatile LAS unsigned* st) {
    XcdBarrier b; b.bar = bar; b.x = xb_xcc_id(); b.st = st;
    if (threadIdx.x == 0) (void)xb_add(&bar[XB_XCNT(b.x)], 1u);
    return b;
}
__device__ __forceinline__ void xcd_barrier_complete(unsigned* bar, unsigned x, unsigned& nloc, unsigned& nx) {
    const unsigned G = gridDim.x * gridDim.y * gridDim.z;
    unsigned sum, cnt, mine, sp = 0u;
    for (;;) {
        sum = 0u; cnt = 0u; mine = 0u;
#pragma unroll
        for (unsigned j = 0; j < 16; ++j) { const unsigned c = xb_ld(&bar[XB_XCNT(j)]); sum += c; cnt += (c > 0u) ? 1u : 0u; mine = (j == x) ? c : mine; }
        if (sum == G) break;
        __builtin_amdgcn_s_sleep(1);
        if ((++sp & 255u) == 0u) { if (xb_ld(&bar[XB_TMO])) break; if (sp > XB_SPIN_CAP) { atomicAdd(&bar[XB_TMO], 1u); break; } }
    }
    nloc = mine > 0u ? mine : 1u; nx = cnt > 0u ? cnt : 1u;
}

__device__ __forceinline__ void xcd_barrier(const XcdBarrier& b) {
    asm volatile("s_waitcnt vmcnt(0)" ::: "memory");
    __syncthreads();
    if (threadIdx.x == 0) {
        unsigned* bar = b.bar;
        __builtin_amdgcn_s_waitcnt(0);
        unsigned nloc = b.st[0], nx = b.st[1];
        if (nloc == 0u) { xcd_barrier_complete(bar, b.x, nloc, nx); b.st[0] = nloc; b.st[1] = nx; }
        const unsigned old = xb_add(&bar[XB_XSUB(b.x)], 1u);
        const unsigned gen = old / nloc;
        if (old + 1u == (gen + 1u) * nloc) {
            __builtin_amdgcn_fence(__ATOMIC_RELEASE, "agent");
            asm volatile("s_waitcnt vmcnt(0)" ::: "memory");
            const unsigned og = xb_add(&bar[XB_TOP], 1u);
            const unsigned tg = og / nx;
            if (og + 1u == (tg + 1u) * nx) xb_add(&bar[XB_TOPGEN], 1u);
            else XB_SPIN(xb_ld(&bar[XB_TOPGEN]) == tg, bar);
            __builtin_amdgcn_fence(__ATOMIC_ACQUIRE, "agent");
            xb_add(&bar[XB_XGEN(b.x)], 1u);
            asm volatile("s_waitcnt vmcnt(0)" ::: "memory");
        } else {
            XB_SPIN(xb_ld(&bar[XB_XGEN(b.x)]) == gen, bar);
            __builtin_amdgcn_fence(__ATOMIC_ACQUIRE, "agent");
            asm volatile("s_waitcnt vmcnt(0)" ::: "memory");
        }
    }
    __syncthreads();
}

struct Args { const void* in[24]; float* out; unsigned char* ws; int lo, hi; };

__host__ __device__ constexpr int mixer_inner_phases(int kind) { return kind == 0 ? 2 : (kind == 1 ? 1 : 4); }
__host__ __device__ constexpr int total_phases() { int n = 1; for (int L = 0; L < DEPTH; ++L) n += 6 + 3 + mixer_inner_phases(L % 3); return n; }

__global__ void __launch_bounds__(512, 2) mega(Args args) {
    extern __shared__ __attribute__((aligned(16))) unsigned char lds[];
    cg::grid_group grid = cg::this_grid();
    volatile LAS unsigned* bst = (volatile LAS unsigned*)((LAS unsigned char*)lds + (LDS_BYTES - 64));
    if (threadIdx.x < 2) bst[threadIdx.x] = 0u;
    __syncthreads();
    const XcdBarrier xbar = xcd_barrier_post((unsigned*)args.ws, bst);
    bool again = false;
    for (int ph = args.lo; ph < args.hi; ++ph) {
        int type = 0, s = 0, L = 0;
        if (ph > 0) {
            int p = ph - 1;
            for (L = 0; L < DEPTH; ++L) { const int n = 9 + mixer_inner_phases(L % 3); if (p < n) break; p -= n; }
            const int inner = mixer_inner_phases(L % 3), kind = L % 3;
            if (p < 3) { type = 1 + p; s = 2 * L; }
            else if (p == 3) type = 4;
            else if (p == 4) type = 5;
            else if (p < 5 + inner) { const int q = p - 5; type = kind == 0 ? 6 + q : (kind == 1 ? 8 : 9 + q); }
            else if (p == 5 + inner) type = 13;
            else { type = 1 + (p - 6 - inner); s = 2 * L + 1; }
        }
        int tid_ = threadIdx.x; asm volatile("" : "+v"(tid_));
        int G_ = gridDim.x, bx_ = blockIdx.x; asm volatile("" : "+s"(G_), "+s"(bx_));
        const int tid = tid_, lane = tid & 63, wid = __builtin_amdgcn_readfirstlane(tid >> 6);
        const int G = G_, bx = bx_;
        const int vcu = (G % 8 == 0) ? (bx % 8) * (G / 8) + bx / 8 : bx;
        const int gw = vcu * 8 + wid, NGW = G * 8;
        unsigned char* ws = args.ws; asm volatile("" : "+s"(ws));
        PG8_LAS unsigned char* ldsl = (PG8_LAS unsigned char*)lds;
        float* hout = args.out; asm volatile("" : "+s"(hout));
        bf16* HN = (bf16*)(ws + WS_HN);
        bf16* RB = (bf16*)(ws + WS_R);
        f32x2* tab = (f32x2*)(ws + WS_TAB);
        const int kind = L % 3, jj = L / 3;
        bf16* QN = RB + (size_t)T * 2560;
        bf16* KSb = QN + (size_t)T * 1024;
        bf16* KWb = KSb + (size_t)T * 256;
        bf16* KCH = (bf16*)(ws + WS_O32);
        bf16* VCH = KCH + (size_t)T * 256;
        float* Pk = (float*)(ws + WS_O32 + 32 * MiB);
        float* Pv = Pk + (size_t)8192 * 512;
        bf16* KC = (bf16*)(ws + WS_O32 + 64 * MiB);
        bf16* VC = (bf16*)(ws + WS_O32 + 65 * MiB);
        bf16* OVT = (bf16*)(ws + WS_BP + 65536);
        bf16* VST = (bf16*)(ws + WS_O32 + 68 * MiB);
        bf16* VWT = (bf16*)(ws + WS_O32 + 84 * MiB);
        switch (type) {
        case 0: {
            float* scr = (float*)lds + wid * (64 * 33);
            for (int mi = 0; mi < 28; ++mi) {
                const float* W; int K, N, Npad, mode = 0; bf16* WT;
                if (mi < 8)       { W = (const float*)args.in[3] + (size_t)mi * D * 2 * FF; K = D; N = 2 * FF; Npad = N; mode = 1; WT = (bf16*)(ws + WS_WGU) + (size_t)mi * 2 * FF * D; }
                else if (mi < 16) { const int i = mi - 8; W = (const float*)args.in[4] + (size_t)i * FF * D; K = FF; N = D; Npad = N; WT = (bf16*)(ws + WS_WDN) + (size_t)i * D * FF; }
                else if (mi < 18) { const int i = mi - 16; W = (const float*)args.in[6] + (size_t)i * D * 4112; K = D; N = 4112; Npad = GDN_NPAD; WT = (bf16*)(ws + WS_WGI) + (size_t)i * GDN_NPAD * D; }
                else if (mi < 20) { const int i = mi - 18; W = (const float*)args.in[11] + (size_t)i * D * D; K = D; N = D; Npad = N; WT = (bf16*)(ws + WS_WGO) + (size_t)i * D * D; }
                else if (mi == 20) { W = (const float*)args.in[12]; K = D; N = 3072; Npad = N; WT = (bf16*)(ws + WS_WSI); }
                else if (mi == 21) { W = (const float*)args.in[14]; K = D; N = D; Npad = N; WT = (bf16*)(ws + WS_WSO); }
                else if (mi == 22) { W = (const float*)args.in[15]; K = D; N = 2608; Npad = NSA_NPAD; WT = (bf16*)(ws + WS_WNI); }
                else if (mi == 23) { W = (const float*)args.in[23]; K = D; N = D; Npad = N; WT = (bf16*)(ws + WS_WNO); }
                else { const int i = mi - 24, kd = i >> 1, hf = i & 1;
                    W = (const float*)args.in[19] + (size_t)kd * 2048 * 256 + (size_t)hf * 1024 * 256; K = 1024; N = 256; Npad = 256; WT = (bf16*)(ws + WS_WC1) + (size_t)kd * 512 * 1024 + (size_t)hf * 256 * 1024; }
                xpose_matrix(W, K, N, Npad, WT, mode, scr, gw, NGW, lane);
            }
            const int* positions = (const int*)args.in[1];
            for (int idx = bx * 512 + tid; idx < T * 32; idx += G * 512) {
                const int tk = idx >> 5, i = idx & 31;
                const float inv = 1.0f / exp2f((float)(2 * i) * (13.287712379549449f / 64.f));
                const float ang = (float)positions[tk] * inv;
                const double rev = (double)ang * 0.15915494309189535;
                const float fr = (float)(rev - rint(rev));
                f32x2 v; v.x = __builtin_amdgcn_cosf(fr); v.y = __builtin_amdgcn_sinf(fr);
                tab[idx] = v;
            }
            for (int idx = bx * 512 + tid; idx < 64 * 256; idx += G * 512) {
                const int sj = idx >> 8, i = idx & 255, q = i >> 2, rem = i & 3;
                OVT[idx] = (bf16)(rem < 3 ? (q == sj ? 0x3F80 : 0) : ((q == sj || q + 1 == sj) ? 0x3F00 : 0));
            }
            if (bx < 2 && tid < 256) {
                const float* pe = (const float*)args.in[18] + (size_t)bx * 2048;
                const float* w1 = (const float*)args.in[19] + (size_t)bx * 2048 * 256 + tid;
                float acc = ((const float*)args.in[20])[bx * 256 + tid];
                for (int k = 0; k < 2048; ++k) acc += pe[k] * w1[(size_t)k * 256];
                ((float*)(ws + WS_BP))[bx * 256 + tid] = acc;
            }
        } break;
        case 1: phase_norm(s == 0 ? (const float*)args.in[0] : hout, (const float*)args.in[2] + (size_t)s * D, HN, gw, NGW, lane); break;
        case 2: {
            pg8::Gemm g{HN, (const bf16*)(ws + WS_WGU) + (size_t)s * 2 * FF * D, T, 2 * FF, D}; pg8::StaticOrder SO; SO.init(T, 2 * FF, G, bx);
            pg8::EpiSwiGLU E{RB};
            pg8::gemm_phase<pg8::EpiSwiGLU, pg8::StaticOrder, true, true>(ldsl, g, SO, E, tid); } break;
        case 3: {
            pg8::Gemm g{RB, (const bf16*)(ws + WS_WDN) + (size_t)s * D * FF, T, D, FF}; pg8::StaticOrder SO; SO.init(T, D, G, bx);
            pg8::EpiResid E{s == 0 ? (const float*)args.in[0] : hout, hout, 0.5f};
            pg8::gemm_phase<pg8::EpiResid, pg8::StaticOrder, true, true>(ldsl, g, SO, E, tid); } break;
        case 4: phase_norm(hout, (const float*)args.in[5] + (size_t)L * D, HN, gw, NGW, lane); break;
        case 5: {
            const bf16* Wt; int Np, ldc, nmain, ldt, nvalid; float* tail;
            if (kind == 0) { Wt = (const bf16*)(ws + WS_WGI) + (size_t)jj * GDN_NPAD * D; Np = GDN_NPAD; ldc = 4096; nmain = 4096; tail = (float*)(ws + WS_AB); ldt = 16; nvalid = 4112; }
            else if (kind == 1) { Wt = (const bf16*)(ws + WS_WSI); Np = 3072; ldc = 3072; nmain = 3072; tail = (float*)(ws + WS_AB); ldt = 16; nvalid = 3072; }
            else { Wt = (const bf16*)(ws + WS_WNI); Np = NSA_NPAD; ldc = 2560; nmain = 2560; tail = (float*)(ws + WS_GT); ldt = 48; nvalid = 2608; }
            pg8::Gemm g{HN, Wt, T, Np, D}; pg8::StaticOrder SO; SO.init(T, Np, G, bx);
            pg8::EpiProj E{RB, ldc, nmain, tail, ldt, nvalid};
            pg8::gemm_phase<pg8::EpiProj, pg8::StaticOrder, true, true>(ldsl, g, SO, E, tid); } break;
        case 6:
#ifndef DIS_SCAN
            phase_gdn_scan(lds, RB, (const float*)(ws + WS_AB), (const float*)args.in[7] + (size_t)jj * 4 * 3072, (const float*)args.in[8] + jj * 8, (const float*)args.in[9] + jj * 8,
                           (float*)(ws + WS_O32), bx, G, tid, wid, lane);
#endif
            break;
        case 7:
#ifndef DIS_GPOST
            phase_gdn_post((const float*)(ws + WS_O32), RB, (const float*)args.in[10] + jj * 128, HN, gw, NGW, lane);
#endif
            break;
        case 8:
#ifndef DIS_SPOST
            phase_sc_post(RB, (const float*)args.in[13], HN, vcu * 512 + tid, G * 512);
#endif
            break;
        case 9:
#ifndef DIS_NPOST
            phase_nsa_post(lds, RB, (const float*)args.in[16], (const float*)args.in[17], tab, QN, KSb, KWb, KCH, VCH, VST, VWT, gw, NGW, wid, lane);
#endif
            break;
        case 10: {
            pg8::Gemm g{KCH, (const bf16*)(ws + WS_WC1), 8192, 512, 1024}; pg8::StaticOrder SO; SO.init(8192, 512, G, bx);
            pg8::Gemm g2{VCH, (const bf16*)(ws + WS_WC1) + (size_t)512 * 1024, 8192, 512, 1024};
            pg8::EpiF32 E{Pk, 512};
            if (bx >= G / 2) { g = g2; SO.init(8192, 512, G, bx - G / 2); E.C = Pv; }
            pg8::gemm_phase<pg8::EpiF32, pg8::StaticOrder, true, true>(ldsl, g, SO, E, tid); } break;
        case 11:
#ifndef DIS_CMP2
            phase_cmp2(lds, Pk, Pv, (const float*)(ws + WS_BP), (const float*)args.in[21], (const float*)args.in[22], (const float*)args.in[17], KC, VC, gw, NGW, wid, lane);
#endif
            break;
        case 12:
#ifndef DIS_ATTN
            phase_nsa_attn(lds, QN, KSb, KWb, VST, VWT, KC, VC, OVT, (const float*)(ws + WS_GT), tab, HN, bx, G, tid, wid, lane);
#endif
            break;
        default: {
            const bf16* Wout = kind == 0 ? (const bf16*)(ws + WS_WGO) + (size_t)jj * D * D : (kind == 1 ? (const bf16*)(ws + WS_WSO) : (const bf16*)(ws + WS_WNO));
            pg8::Gemm g{HN, Wout, T, D, D}; pg8::StaticOrder SO; SO.init(T, D, G, bx);
            pg8::EpiResid E{hout, hout, 1.0f};
            pg8::gemm_phase<pg8::EpiResid, pg8::StaticOrder, true, true>(ldsl, g, SO, E, tid); } break;
        }
#ifdef REP_TYPE
        if (type == REP_TYPE && !again) { again = true; xcd_barrier(xbar); --ph; continue; }
        again = false;
#endif
        if (ph + 1 < args.hi) { if (ph == 0) grid.sync(); else xcd_barrier(xbar); }
    }
}

extern "C" void kernel_launch(void* const* d_in, const int* in_sizes, int n_in, void* d_out, int out_size, void* d_ws, size_t ws_size, hipStream_t stream) {
    static int grid = 0;
    if (grid == 0) {
        if (n_in != 24 || out_size != T * D || ws_size < WS_END) { fprintf(stderr, "kernel_launch: unexpected shapes n_in %d out %d ws %zu (need %zu)\n", n_in, out_size, ws_size, (size_t)WS_END); grid = -1; return; }
        int dev = 0, cus = 0, per_cu = 0;
        hipGetDevice(&dev); hipDeviceGetAttribute(&cus, hipDeviceAttributeMultiprocessorCount, dev);
        if (hipFuncSetAttribute((const void*)mega, hipFuncAttributeMaxDynamicSharedMemorySize, LDS_BYTES) != hipSuccess) { fprintf(stderr, "kernel_launch: hipFuncSetAttribute failed\n"); grid = -1; return; }
        if (hipOccupancyMaxActiveBlocksPerMultiprocessor(&per_cu, (const void*)mega, 512, LDS_BYTES) != hipSuccess || per_cu < 1) { fprintf(stderr, "kernel_launch: occupancy query says %d\n", per_cu); per_cu = 1; }
        (void)hipGetLastError();
        grid = cus;
    }
    if (grid < 0) return;
    Args a{};
    for (int i = 0; i < 24; ++i) a.in[i] = d_in[i];
    a.out = (float*)d_out; a.ws = (unsigned char*)d_ws;
    constexpr int NPH = total_phases();
#if MK_MULTI
    for (int p = 0; p < NPH; ++p) { a.lo = p; a.hi = p + 1; hipLaunchKernelGGL(mega, dim3(grid), dim3(512), LDS_BYTES, stream, a); }
#else
    a.lo = 0; a.hi = NPH;
    (void)hipMemsetAsync(d_ws, 0, 16384, stream);
    void* kargs[] = {&a};
    hipError_t e = hipLaunchCooperativeKernel((const void*)mega, dim3(grid), dim3(512), kargs, LDS_BYTES, stream);
    if (e != hipSuccess) fprintf(stderr, "cooperative launch failed: %s (grid %d)\n", hipGetErrorString(e), grid);
#endif
}
```

```cpp
#include <hip/hip_runtime.h>
#include <hip/hip_cooperative_groups.h>
#include <cstdio>
#include <cstdint>
namespace cg = cooperative_groups;
namespace pg8 {
#define PG8_LAS __attribute__((address_space(3)))
typedef unsigned short bf16_t;
typedef short bf16x8 __attribute__((ext_vector_type(8)));
typedef float f32x4 __attribute__((ext_vector_type(4)));
typedef unsigned u32x4 __attribute__((ext_vector_type(4)));
constexpr int BM = 256, BK = 64, HALF = 128, HTB = HALF * BK * 2  , STAGE_BYTES = 8 * HTB, NXCD = 8, WGM = 8;

__host__ __device__ __forceinline__ int lds_byte(int r, int c) { const int st = (r >> 4) * 2 + (c >> 5), rr = r & 15, cc = c & 31, ob = rr * 64 + cc * 2; return st * 1024 + (ob ^ (((ob >> 9) & 1) << 5)); }
__host__ __device__ __forceinline__ void stage_rc(int b, int& R, int& C) { const int st = b / 1024, sb = b % 1024, swz = sb ^ (((sb >> 9) & 1) << 5); R = (st >> 1) * 16 + swz / 64; C = (st & 1) * 32 + (swz % 64) / 2; }
__host__ __device__ __forceinline__ int perm32(int rho) { const int n = rho >> 4, i = rho & 15; return 8 * (i >> 2) + 4 * n + (i & 3); }

struct Unit { int pm, pn; };
struct Gemm { const bf16_t* A; const bf16_t* Bt; int M, N, K; };

struct StaticOrder {
    int nM, nN, nwg, G, c;
    __host__ __device__ void init(int M, int N, int G_, int c_) { nM = M / BM; nN = N / BM; nwg = nM * nN; G = G_; c = c_; }
    __host__ __device__ bool next(int i, Unit& u) const {
        const long L = (long)i * G + c; if (L >= nwg) return false;
        int wgid = (int)L; { const int q = nwg / NXCD, r = nwg % NXCD, xcd = wgid % NXCD, off = wgid / NXCD; wgid = (xcd < r ? xcd * (q + 1) : r * (q + 1) + (xcd - r) * q) + off; }
        const int nig = WGM * nN, gid = wgid / nig, fm = gid * WGM, gsz = (nM - fm) < WGM ? (nM - fm) : WGM;
        u.pm = fm + ((wgid % nig) % gsz); u.pn = (wgid % nig) / gsz; return true;
    }
    __device__ __forceinline__ void a_ready(const Unit&) const {}
    __device__ __forceinline__ void done(const Unit&) const {}
};
__device__ __forceinline__ unsigned cvt_pk_bf16(float lo, float hi) { unsigned r; asm volatile("v_cvt_pk_bf16_f32 %0, %1, %2" : "=v"(r) : "v"(lo), "v"(hi)); return r; }
template <class Epi, class Sched, bool ALIGN_EPI = false, bool SP2 = false>
__device__ __forceinline__ void gemm_phase(PG8_LAS unsigned char* lds, const Gemm g, const Sched& S, const Epi& E, const int tid) {
    const int wid = __builtin_amdgcn_readfirstlane(tid >> 6), lane = tid & 63, wr = wid >> 2, wc = wid & 3, fr = lane & 15, fq = lane >> 4;
    const int K = g.K, nt = K / BK;
    unsigned voffA[2], voffB[2];
#pragma unroll
    for (int i = 0; i < 2; ++i) { int R, C; stage_rc(tid * 16 + i * 8192, R, C); const int Rb = Epi::PERM ? ((R & ~31) + perm32(R & 31)) : R;
        voffA[i] = (unsigned)(R * K + C) * 2u; voffB[i] = (unsigned)(Rb * K + C) * 2u; }
    const size_t kstep = (size_t)(BK * 2);
    const size_t hstep = (size_t)HALF * K * 2;
    const size_t tstep = 2 * hstep;
    const unsigned ldsw = (unsigned)wid * 1024u;
    const int aoff = lds_byte(wr * 64 + fr, fq * 8), boff = lds_byte(wc * 32 + fr, fq * 8);
#define PG8_SA(b, h) (((b) * 2 + (h)) * HTB)
#define PG8_SB(b, h) ((4 + (b) * 2 + (h)) * HTB)
#define PG8_STAGE(bufoff, gbase, voff) do { _Pragma("unroll") for (int _i = 0; _i < 2; ++_i) \
        __builtin_amdgcn_global_load_lds((const unsigned*)((const char*)(gbase) + (voff)[_i]), (PG8_LAS unsigned*)(lds + (bufoff) + ldsw + _i * 8192), 16, 0, 0); } while (0)
#define PG8_LDA(dst, b, h) do { _Pragma("unroll") for (int m = 0; m < 4; ++m) _Pragma("unroll") for (int k = 0; k < 2; ++k) dst[m][k] = *(const PG8_LAS bf16x8*)(lds + PG8_SA(b, h) + aoff + m * 2048 + k * 1024); } while (0)
#define PG8_LDB(dst, b, h) do { _Pragma("unroll") for (int n = 0; n < 2; ++n) _Pragma("unroll") for (int k = 0; k < 2; ++k) dst[n][k] = *(const PG8_LAS bf16x8*)(lds + PG8_SB(b, h) + boff + n * 2048 + k * 1024); } while (0)
#define PG8_MMA(ai, bj, At, Bt) do { __builtin_amdgcn_s_setprio(1); _Pragma("unroll") for (int m = 0; m < 4; ++m) _Pragma("unroll") for (int n = 0; n < 2; ++n) _Pragma("unroll") for (int k = 0; k < 2; ++k) \
        acc[ai][bj][m][n] = __builtin_amdgcn_mfma_f32_16x16x32_bf16(Bt[n][k], At[m][k], acc[ai][bj][m][n], 0, 0, 0); __builtin_amdgcn_s_setprio(0); } while (0)
#define PG8_WAIT_V(n) asm volatile("s_waitcnt vmcnt(" #n ")" ::: "memory")
#define PG8_WAIT_L(n) asm volatile("s_waitcnt lgkmcnt(" #n ")" ::: "memory")
#define PG8_BAR __builtin_amdgcn_s_barrier()
#define PG8_SCHED __builtin_amdgcn_sched_barrier(0)
    Unit cur, nxt; int ui = 0;
    if (!S.next(0, cur)) return;
    f32x4 acc[2][2][4][2];
#pragma unroll
    for (int a = 0; a < 2; ++a)
#pragma unroll
        for (int b = 0; b < 2; ++b)
#pragma unroll
            for (int m = 0; m < 4; ++m)
#pragma unroll
                for (int n = 0; n < 2; ++n) acc[a][b][m][n] = (f32x4){0.f, 0.f, 0.f, 0.f};
    bf16x8 At[4][2], B0[2][2], B1[2][2];
    const char* cA = (const char*)g.A + (size_t)cur.pm * tstep; const char* cB = (const char*)g.Bt + (size_t)cur.pn * tstep;
    S.a_ready(cur);
    if constexpr (SP2) {
        PG8_STAGE(PG8_SB(0, 0), cB, voffB); PG8_STAGE(PG8_SB(0, 1), cB + hstep, voffB); PG8_STAGE(PG8_SA(0, 0), cA, voffA); PG8_STAGE(PG8_SA(0, 1), cA + hstep, voffA);
        if (wr == 1) PG8_BAR;
        PG8_WAIT_V(2); PG8_BAR;
        PG8_STAGE(PG8_SB(1, 0), cB + kstep, voffB); PG8_STAGE(PG8_SA(1, 0), cA + kstep, voffA); PG8_STAGE(PG8_SB(1, 1), cB + hstep + kstep, voffB);
        PG8_WAIT_V(6); PG8_BAR;
    } else {
        PG8_STAGE(PG8_SB(0, 0), cB, voffB); PG8_STAGE(PG8_SA(0, 0), cA, voffA); PG8_STAGE(PG8_SB(0, 1), cB + hstep, voffB); PG8_STAGE(PG8_SA(0, 1), cA + hstep, voffA);
        if (wr == 1) PG8_BAR;
        PG8_WAIT_V(4); PG8_BAR;
        PG8_STAGE(PG8_SB(1, 0), cB + kstep, voffB); PG8_STAGE(PG8_SA(1, 0), cA + kstep, voffA); PG8_STAGE(PG8_SB(1, 1), cB + hstep + kstep, voffB);
        PG8_WAIT_V(6); PG8_BAR;
    }
    for (;;) {
        const bool has_next = S.next(ui + 1, nxt);
        const char* nA = has_next ? (const char*)g.A + (size_t)nxt.pm * tstep : cA; const char* nB = has_next ? (const char*)g.Bt + (size_t)nxt.pn * tstep : cB;
        for (int t = 0; t < nt; t += 2) {
            const bool last = (t == nt - 2);
            const char* a1 = cA + (size_t)(t + 1) * kstep;
            const char* a2 = last ? nA : cA + (size_t)(t + 2) * kstep; const char* b2 = last ? nB : cB + (size_t)(t + 2) * kstep;
            const char* a3 = a2 + kstep; const char* b3 = b2 + kstep;
            if (last && has_next) S.a_ready(nxt);
            if constexpr (SP2) {
            PG8_LDB(B0, 0, 0); PG8_LDB(B1, 0, 1); PG8_SCHED; PG8_LDA(At, 0, 0); PG8_STAGE(PG8_SA(1, 1), a1 + hstep, voffA);
            PG8_WAIT_V(8); PG8_WAIT_L(0); PG8_BAR; PG8_MMA(0, 0, At, B0); PG8_MMA(0, 1, At, B1); PG8_BAR; PG8_SCHED;
            PG8_LDA(At, 0, 1); PG8_STAGE(PG8_SB(0, 0), b2, voffB); PG8_STAGE(PG8_SB(0, 1), b2 + hstep, voffB); PG8_STAGE(PG8_SA(0, 0), a2, voffA);
            PG8_WAIT_V(8); PG8_WAIT_L(0); PG8_BAR; PG8_MMA(1, 0, At, B0); PG8_MMA(1, 1, At, B1); PG8_BAR; PG8_SCHED;
            PG8_LDB(B0, 1, 0); PG8_LDB(B1, 1, 1); PG8_SCHED; PG8_LDA(At, 1, 0); PG8_STAGE(PG8_SA(0, 1), a2 + hstep, voffA);
            PG8_WAIT_V(8); PG8_WAIT_L(0); PG8_BAR; PG8_MMA(0, 0, At, B0); PG8_MMA(0, 1, At, B1); PG8_BAR; PG8_SCHED;
            PG8_LDA(At, 1, 1); PG8_STAGE(PG8_SB(1, 0), b3, voffB); PG8_STAGE(PG8_SB(1, 1), b3 + hstep, voffB); PG8_STAGE(PG8_SA(1, 0), a3, voffA);
            PG8_WAIT_V(8); PG8_WAIT_L(0); PG8_BAR; PG8_MMA(1, 0, At, B0); PG8_MMA(1, 1, At, B1); PG8_BAR; PG8_SCHED;
            } else {
            PG8_LDB(B0, 0, 0); PG8_SCHED; PG8_LDA(At, 0, 0); PG8_STAGE(PG8_SA(1, 1), a1 + hstep, voffA);
            PG8_WAIT_L(8); PG8_BAR; PG8_WAIT_L(0); PG8_MMA(0, 0, At, B0); PG8_BAR; PG8_SCHED;
            PG8_LDB(B1, 0, 1); PG8_STAGE(PG8_SB(0, 0), b2, voffB);
            PG8_BAR; PG8_WAIT_L(0); PG8_MMA(0, 1, At, B1); PG8_BAR;
            PG8_LDA(At, 0, 1); PG8_STAGE(PG8_SA(0, 0), a2, voffA);
            PG8_BAR; PG8_WAIT_L(0); PG8_MMA(1, 0, At, B0); PG8_BAR; PG8_SCHED;
            PG8_STAGE(PG8_SB(0, 1), b2 + hstep, voffB);
            PG8_WAIT_V(6); PG8_BAR; PG8_MMA(1, 1, At, B1); PG8_BAR;
            PG8_LDB(B0, 1, 0); PG8_SCHED; PG8_LDA(At, 1, 0); PG8_STAGE(PG8_SA(0, 1), a2 + hstep, voffA);
            PG8_WAIT_L(8); PG8_BAR; PG8_WAIT_L(0); PG8_MMA(0, 0, At, B0); PG8_BAR; PG8_SCHED;
            PG8_LDB(B1, 1, 1); PG8_STAGE(PG8_SB(1, 0), b3, voffB);
            PG8_BAR; PG8_WAIT_L(0); PG8_MMA(0, 1, At, B1); PG8_BAR;
            PG8_LDA(At, 1, 1); PG8_STAGE(PG8_SA(1, 0), a3, voffA);
            PG8_BAR; PG8_WAIT_L(0); PG8_MMA(1, 0, At, B0); PG8_BAR; PG8_SCHED;
            PG8_STAGE(PG8_SB(1, 1), b3 + hstep, voffB);
            PG8_WAIT_V(6); PG8_BAR; PG8_MMA(1, 1, At, B1); PG8_BAR;
            }
        }
        if constexpr (ALIGN_EPI) { if (wr == 0) PG8_BAR; }
        if constexpr (!Epi::AFTER_DRAIN) { E(acc, cur, wr, wc, fr, fq); S.done(cur); }
        if (!has_next) break;
#pragma unroll
        for (int a = 0; a < 2; ++a)
#pragma unroll
            for (int b = 0; b < 2; ++b)
#pragma unroll
                for (int m = 0; m < 4; ++m)
#pragma unroll
                    for (int n = 0; n < 2; ++n) acc[a][b][m][n] = (f32x4){0.f, 0.f, 0.f, 0.f};
        cur = nxt; cA = nA; cB = nB; ++ui;
        if constexpr (ALIGN_EPI) { if (wr == 1) PG8_BAR; }
    }
    PG8_WAIT_V(0);
    if constexpr (!ALIGN_EPI) { if (wr == 0) PG8_BAR; }
    PG8_BAR;
    if constexpr (Epi::AFTER_DRAIN) { E.fused(acc, cur, wr, wc, fr, fq, lds, wid, lane); S.done(cur); }
#undef PG8_SA
#undef PG8_SB
#undef PG8_STAGE
#undef PG8_LDA
#undef PG8_LDB
#undef PG8_MMA
#undef PG8_WAIT_V
#undef PG8_WAIT_L
#undef PG8_BAR
#undef PG8_SCHED
}
}

typedef unsigned short bf16;
typedef float f32x4 __attribute__((ext_vector_type(4)));
typedef float f32x2 __attribute__((ext_vector_type(2)));
typedef unsigned u32x4 __attribute__((ext_vector_type(4)));
typedef unsigned u32x2 __attribute__((ext_vector_type(2)));

#ifndef MK_MULTI
#define MK_MULTI 0
#endif

constexpr int Bn = 8, S = 4096, T = Bn * S, D = 1024, FF = 2816, DEPTH = 4;
constexpr float EPS = 1e-6f;
constexpr int GDN_NPAD = 4352, NSA_NPAD = 2816;
constexpr int LDS_BYTES = 147456;
constexpr size_t MiB = 1u << 20;
constexpr size_t WS_WGU = 1 * MiB;
constexpr size_t WS_WDN = WS_WGU + 88 * MiB;
constexpr size_t WS_WGI = WS_WDN + 44 * MiB;
constexpr size_t WS_WGO = WS_WGI + 17 * MiB;
constexpr size_t WS_WSI = WS_WGO + 4 * MiB;
constexpr size_t WS_WSO = WS_WSI + 6 * MiB;
constexpr size_t WS_WNI = WS_WSO + 2 * MiB;
constexpr size_t WS_WNO = WS_WNI + 6 * MiB;
constexpr size_t WS_WC1 = WS_WNO + 2 * MiB;
constexpr size_t WS_TAB = WS_WC1 + 2 * MiB;
constexpr size_t WS_HN  = 184 * MiB;
constexpr size_t WS_R   = WS_HN + 64 * MiB;
constexpr size_t WS_O32 = WS_R + 256 * MiB;
constexpr size_t WS_SM  = WS_O32 + 128 * MiB;
constexpr size_t WS_AB  = WS_SM;
constexpr size_t WS_GT  = WS_SM + 2 * MiB;
constexpr size_t WS_BP  = WS_SM + 8 * MiB;
constexpr size_t WS_END = WS_SM + 9 * MiB;
static_assert(WS_TAB + 8 * MiB <= WS_HN, "ws map");

__device__ __forceinline__ float bf2f(unsigned v) { return __uint_as_float(v << 16); }
__device__ __forceinline__ unsigned f2bf(float f) { unsigned u = __float_as_uint(f); return (u + 0x7fffu + ((u >> 16) & 1u)) >> 16; }
__device__ __forceinline__ unsigned pk2(float lo, float hi) { return f2bf(lo) | (f2bf(hi) << 16); }
#define MFMA32(a, b, c) __builtin_amdgcn_mfma_f32_32x32x16_bf16((a), (b), (c), 0, 0, 0)
typedef short bf16x8v __attribute__((ext_vector_type(8)));
typedef float f32x16 __attribute__((ext_vector_type(16)));
typedef __bf16 bf16v2 __attribute__((ext_vector_type(2)));
__device__ __forceinline__ unsigned pkbf(float a, float b) { f32x2 v = {a, b}; return __builtin_bit_cast(unsigned, __builtin_convertvector(v, bf16v2)); }
__device__ __forceinline__ float wave_sum(float v) {
#pragma unroll
    for (int o = 1; o < 64; o <<= 1) v += __shfl_xor(v, o);
    return v;
}
__device__ __forceinline__ float wave_max(float v) {
#pragma unroll
    for (int o = 1; o < 64; o <<= 1) v = fmaxf(v, __shfl_xor(v, o));
    return v;
}
__device__ __forceinline__ float row_sum16(float v) {
    v += __uint_as_float((unsigned)__builtin_amdgcn_update_dpp(0, (int)__float_as_uint(v), 0x128, 0xf, 0xf, false));
    v += __uint_as_float((unsigned)__builtin_amdgcn_update_dpp(0, (int)__float_as_uint(v), 0x124, 0xf, 0xf, false));
    v += __uint_as_float((unsigned)__builtin_amdgcn_update_dpp(0, (int)__float_as_uint(v), 0x122, 0xf, 0xf, false));
    v += __uint_as_float((unsigned)__builtin_amdgcn_update_dpp(0, (int)__float_as_uint(v), 0x121, 0xf, 0xf, false));
    return v;
}
__device__ __forceinline__ float sigmoidf_(float x) { return 1.f / (1.f + __expf(-x)); }
__device__ __forceinline__ float siluf_(float x) { return x / (1.f + __expf(-x)); }
#define WAVE_SYNC() do { asm volatile("s_waitcnt lgkmcnt(0)" ::: "memory"); __builtin_amdgcn_wave_barrier(); } while (0)

namespace pg8 {
struct EpiSwiGLU {
    static constexpr bool PERM = true, AFTER_DRAIN = false;
    bf16_t* O;
    __device__ __forceinline__ void operator()(const f32x4 (&acc)[2][2][4][2], const Unit& u, int wr, int wc, int fr, int fq) const {
        const int row0 = u.pm * BM + wr * 64 + fr, col0 = u.pn * HALF + wc * 32 + 8 * fq;
#pragma unroll
        for (int ai = 0; ai < 2; ++ai)
#pragma unroll
            for (int m = 0; m < 4; ++m) {
                bf16_t* rowp = O + (size_t)(row0 + ai * HALF + m * 16) * FF + col0;
                float v[8];
#pragma unroll
                for (int n = 0; n < 2; ++n)
#pragma unroll
                    for (int j = 0; j < 4; ++j) { const float g = acc[ai][0][m][n][j], uu = acc[ai][1][m][n][j]; v[n * 4 + j] = g * __builtin_amdgcn_rcpf(1.f + __expf(-g)) * uu; }
                u32x4 w; w.x = cvt_pk_bf16(v[0], v[1]); w.y = cvt_pk_bf16(v[2], v[3]); w.z = cvt_pk_bf16(v[4], v[5]); w.w = cvt_pk_bf16(v[6], v[7]);
                *(u32x4*)rowp = w;
            }
    }
};
struct EpiResid {
    static constexpr bool PERM = false, AFTER_DRAIN = false;
    const float* base; float* out; float scale;
    __device__ __forceinline__ void operator()(const f32x4 (&acc)[2][2][4][2], const Unit& u, int wr, int wc, int fr, int fq) const {
        const int row0 = u.pm * BM + wr * 64 + fr, col0 = u.pn * BM + wc * 32 + 4 * fq;
#pragma unroll
        for (int ai = 0; ai < 2; ++ai)
#pragma unroll
            for (int m = 0; m < 4; ++m) {
                const size_t off = (size_t)(row0 + ai * HALF + m * 16) * D + col0;
#pragma unroll
                for (int bj = 0; bj < 2; ++bj)
#pragma unroll
                    for (int n = 0; n < 2; ++n) { const f32x4 bs = *(const f32x4*)(base + off + bj * HALF + n * 16); *(f32x4*)(out + off + bj * HALF + n * 16) = bs + acc[ai][bj][m][n] * scale; }
                if (m & 1) asm volatile("" ::: "memory");
            }
    }
};
struct EpiProj {
    static constexpr bool PERM = true, AFTER_DRAIN = false;
    bf16_t* O; int ldc; int nmain; float* tail; int ldt; int nvalid;
    __device__ __forceinline__ void operator()(const f32x4 (&acc)[2][2][4][2], const Unit& u, int wr, int wc, int fr, int fq) const {
        const int row0 = u.pm * BM + wr * 64 + fr, colt = u.pn * BM, col0 = colt + wc * 32 + 8 * fq;
        if (colt + BM <= nmain) {
#pragma unroll
            for (int ai = 0; ai < 2; ++ai)
#pragma unroll
                for (int m = 0; m < 4; ++m) {
                    bf16_t* rowp = O + (size_t)(row0 + ai * HALF + m * 16) * ldc + col0;
#pragma unroll
                    for (int bj = 0; bj < 2; ++bj) { const f32x4 v0 = acc[ai][bj][m][0], v1 = acc[ai][bj][m][1];
                        u32x4 w; w.x = cvt_pk_bf16(v0[0], v0[1]); w.y = cvt_pk_bf16(v0[2], v0[3]); w.z = cvt_pk_bf16(v1[0], v1[1]); w.w = cvt_pk_bf16(v1[2], v1[3]);
                        *(u32x4*)(rowp + bj * HALF) = w; }
                }
        } else {
#pragma unroll
            for (int ai = 0; ai < 2; ++ai)
#pragma unroll
                for (int m = 0; m < 4; ++m) {
                    const size_t row = (size_t)(row0 + ai * HALF + m * 16);
#pragma unroll
                    for (int bj = 0; bj < 2; ++bj)
#pragma unroll
                        for (int n = 0; n < 2; ++n)
#pragma unroll
                            for (int j = 0; j < 4; ++j) { const int col = col0 + bj * HALF + 4 * n + j; if (col >= nmain && col < nvalid) tail[row * ldt + (col - nmain)] = acc[ai][bj][m][n][j]; }
                }
        }
    }
};
struct EpiF32 {
    static constexpr bool PERM = false, AFTER_DRAIN = false;
    float* C; int ldc;
    __device__ __forceinline__ void operator()(const f32x4 (&acc)[2][2][4][2], const Unit& u, int wr, int wc, int fr, int fq) const {
        const int row0 = u.pm * BM + wr * 64 + fr, col0 = u.pn * BM + wc * 32 + 4 * fq;
#pragma unroll
        for (int ai = 0; ai < 2; ++ai)
#pragma unroll
            for (int m = 0; m < 4; ++m) {
                float* rowp = C + (size_t)(row0 + ai * HALF + m * 16) * ldc + col0;
#pragma unroll
                for (int bj = 0; bj < 2; ++bj)
#pragma unroll
                    for (int n = 0; n < 2; ++n) *(f32x4*)(rowp + bj * HALF + n * 16) = acc[ai][bj][m][n];
            }
    }
};
}

__device__ __forceinline__ void xpose_item(const float* W, int K, int N, bf16* WT, int rowbase, float* scr, int k0, int n0, int lane) {
    if (n0 + 32 <= N && (N & 3) == 0) {
        f32x4 v[8];
#pragma unroll
        for (int i = 0; i < 8; ++i) v[i] = *(const f32x4*)(W + (size_t)(k0 + 8 * i + (lane >> 3)) * N + n0 + 4 * (lane & 7));
#pragma unroll
        for (int i = 0; i < 8; ++i) { float* d = scr + (8 * i + (lane >> 3)) * 33 + 4 * (lane & 7); d[0] = v[i].x; d[1] = v[i].y; d[2] = v[i].z; d[3] = v[i].w; }
    } else {
#pragma unroll 8
        for (int i = 0; i < 32; ++i) { const int kk = 2 * i + (lane >> 5), n = n0 + (lane & 31); scr[kk * 33 + (lane & 31)] = n < N ? W[(size_t)(k0 + kk) * N + n] : 0.f; }
    }
    WAVE_SYNC();
    const int c = lane & 7;
#pragma unroll
    for (int j = 0; j < 4; ++j) { const int n = (lane >> 3) + 8 * j; const float* s = scr + (8 * c) * 33 + n;
        u32x4 o; o.x = pk2(s[0 * 33], s[1 * 33]); o.y = pk2(s[2 * 33], s[3 * 33]); o.z = pk2(s[4 * 33], s[5 * 33]); o.w = pk2(s[6 * 33], s[7 * 33]);
        *(u32x4*)(WT + (size_t)(rowbase + n) * K + k0 + 8 * c) = o; }
    WAVE_SYNC();
}
__device__ __forceinline__ void xpose_matrix(const float* W, int K, int N, int Npad, bf16* WT, int mode, float* scr, int gw, int NGW, int lane) {
    const int nblk = Npad / 32, nitems = (K / 64) * nblk;
    for (int it = gw; it < nitems; it += NGW) {
        const int kb = it / nblk, nb = it - kb * nblk, n0 = nb * 32;
        int rb = n0;
        if (mode == 1) rb = (n0 < FF) ? ((n0 >> 7) * 256 + (n0 & 127)) : ((((n0 - FF) >> 7) * 256) + 128 + ((n0 - FF) & 127));
        xpose_item(W, K, N, WT, rb, scr, kb * 64, n0, lane);
    }
}

__device__ __forceinline__ void phase_norm(const float* h, const float* w, bf16* out, int gw, int NGW, int lane) {
    f32x4 wv[4];
#pragma unroll
    for (int j = 0; j < 4; ++j) wv[j] = ((const f32x4*)w)[64 * j + lane];
    for (int m = gw; m < T; m += NGW) {
        const f32x4* xr = (const f32x4*)(h + (size_t)m * D) + lane;
        f32x4 v[4]; float s = 0.f;
#pragma unroll
        for (int j = 0; j < 4; ++j) { v[j] = xr[64 * j]; s += (v[j].x * v[j].x + v[j].y * v[j].y) + (v[j].z * v[j].z + v[j].w * v[j].w); }
        const float rstd = 1.f / sqrtf(wave_sum(s) * (1.f / D) + EPS);
        u32x2* o8 = (u32x2*)(out + (size_t)m * D) + lane;
#pragma unroll
        for (int j = 0; j < 4; ++j) { u32x2 o; o.x = pk2(v[j].x * rstd * wv[j].x, v[j].y * rstd * wv[j].y); o.y = pk2(v[j].z * rstd * wv[j].z, v[j].w * rstd * wv[j].w); o8[64 * j] = o; }
    }
}

__device__ __forceinline__ void phase_gdn_scan(unsigned char* lds, const bf16* proj, const float* ab, const float* convw, const float* A_log, const float* dt_bias,
                                               float* o32, int vblk, int nblk, int tid, int wid, int lane) {
    float* qs = (float*)lds;
    float* ks = qs + 64 * 128;
    float* vs = ks + 64 * 128;
    float* al = vs + 64 * 32;
    float* be = al + 64;
    float* qk = be + 64;
    float* os = qk + 64;
    bf16* raw = (bf16*)(os + 64 * 32);
    const int e = tid >> 4, dl = tid & 15;
    for (int item = vblk; item < 256; item += nblk) {
        const int bh = (item & 7) + 8 * (item >> 5), es = (item >> 3) & 3, b = bh >> 3, h = bh & 7;
        const float Ah = __expf(A_log[h]), dtb = dt_bias[h];
        const int isk = (tid >> 4) & 1, cg = tid & 15, cv = tid & 3;
        const int colqk = isk * 1024 + h * 128 + cg * 8, colv = 2048 + h * 128 + es * 32 + cv * 8;
        f32x4 wq[4][2], wv[4][2];
#pragma unroll
        for (int j = 0; j < 4; ++j) { wq[j][0] = *(const f32x4*)(convw + j * 3072 + colqk); wq[j][1] = *(const f32x4*)(convw + j * 3072 + colqk + 4);
                                      wv[j][0] = *(const f32x4*)(convw + j * 3072 + colv);  wv[j][1] = *(const f32x4*)(convw + j * 3072 + colv + 4); }
        f32x2 S2[4];
#pragma unroll
        for (int i = 0; i < 4; ++i) S2[i] = (f32x2){0.f, 0.f};
        u32x4 pre[5];
#define GDN_PREFETCH(T0) do { _Pragma("unroll") for (int k_ = 0; k_ < 5; ++k_) { const int idx_ = tid + 512 * k_; const int row_ = idx_ / 36, c_ = idx_ - row_ * 36; const int ts_ = (T0) - 3 + row_; \
            const int col_ = c_ < 16 ? h * 128 + c_ * 8 : (c_ < 32 ? 1024 + h * 128 + (c_ - 16) * 8 : 2048 + h * 128 + es * 32 + (c_ - 32) * 8); \
            pre[k_] = (u32x4){0u, 0u, 0u, 0u}; if (idx_ < 67 * 36 && ts_ >= 0) pre[k_] = *(const u32x4*)(proj + (size_t)(b * S + ts_) * 4096 + col_); } } while (0)
#define GDN_PARK() do { _Pragma("unroll") for (int k_ = 0; k_ < 5; ++k_) { const int idx_ = tid + 512 * k_; if (idx_ < 67 * 36) *(u32x4*)(raw + idx_ * 8) = pre[k_]; } } while (0)
#define GDN_CONV8(ROW0, C8, W, OUT) do { _Pragma("unroll") for (int i_ = 0; i_ < 8; ++i_) OUT[i_] = 0.f; _Pragma("unroll") for (int j_ = 0; j_ < 4; ++j_) { const u32x4 xv_ = *(const u32x4*)(raw + ((ROW0) + j_) * 288 + (C8) * 8); \
            OUT[0] += bf2f(xv_.x & 0xffffu) * W[j_][0].x; OUT[1] += bf2f(xv_.x >> 16) * W[j_][0].y; OUT[2] += bf2f(xv_.y & 0xffffu) * W[j_][0].z; OUT[3] += bf2f(xv_.y >> 16) * W[j_][0].w; \
            OUT[4] += bf2f(xv_.z & 0xffffu) * W[j_][1].x; OUT[5] += bf2f(xv_.z >> 16) * W[j_][1].y; OUT[6] += bf2f(xv_.w & 0xffffu) * W[j_][1].z; OUT[7] += bf2f(xv_.w >> 16) * W[j_][1].w; } \
            _Pragma("unroll") for (int i_ = 0; i_ < 8; ++i_) OUT[i_] = siluf_(OUT[i_]); } while (0)
#define GDN_CONVNORM(T0) do { \
            _Pragma("unroll") for (int it_ = 0; it_ < 4; ++it_) { const int tok_ = it_ * 16 + (tid >> 5); float y_[8]; GDN_CONV8(tok_, isk * 16 + cg, wq, y_); \
                float ss_ = (y_[0] * y_[0] + y_[1] * y_[1]) + (y_[2] * y_[2] + y_[3] * y_[3]) + (y_[4] * y_[4] + y_[5] * y_[5]) + (y_[6] * y_[6] + y_[7] * y_[7]); \
                ss_ = row_sum16(ss_); const float sc_ = (1.f / sqrtf(ss_ + EPS)) * (isk ? 1.f : 0.08838834764831845f); \
                float* d_ = (isk ? ks : qs) + tok_ * 128 + cg * 8; \
                _Pragma("unroll") for (int i_ = 0; i_ < 8; ++i_) y_[i_] *= sc_; \
                *(f32x4*)d_ = (f32x4){y_[0], y_[1], y_[2], y_[3]}; *(f32x4*)(d_ + 4) = (f32x4){y_[4], y_[5], y_[6], y_[7]}; \
                float dq_ = 0.f; _Pragma("unroll") for (int i_ = 0; i_ < 8; ++i_) dq_ += y_[i_] * __shfl_xor(y_[i_], 16); \
                dq_ = row_sum16(dq_); if (isk == 0 && cg == 0) qk[tok_] = dq_; } \
            if (tid < 256) { const int tok_ = tid >> 2; float y_[8]; GDN_CONV8(tok_, 32 + cv, wv, y_); float* d_ = vs + tok_ * 32 + cv * 8; \
                *(f32x4*)d_ = (f32x4){y_[0], y_[1], y_[2], y_[3]}; *(f32x4*)(d_ + 4) = (f32x4){y_[4], y_[5], y_[6], y_[7]}; } \
            if (tid < 64) { const size_t tg_ = (size_t)(b * S + (T0) + tid); const float a_ = ab[tg_ * 16 + h] + dtb, bb_ = ab[tg_ * 16 + 8 + h]; \
                const float sp_ = a_ > 20.f ? a_ : log1pf(__expf(a_)); al[tid] = __expf(-Ah * sp_); be[tid] = sigmoidf_(bb_); } } while (0)
        __syncthreads();
        GDN_PREFETCH(0); GDN_PARK();
        __syncthreads();
        GDN_CONVNORM(0);
        __syncthreads();
        for (int chunk = 0; chunk < S / 64; ++chunk) {
            const int t0 = chunk * 64;
            const bool more = chunk + 1 < S / 64;
            if (more) GDN_PREFETCH(t0 + 64);
            {
                const float* kp = ks + dl * 8; const float* qp = qs + dl * 8; const float* vp = vs + e;
                f32x4 nk0 = *(const f32x4*)kp, nk1 = *(const f32x4*)(kp + 4), nq0 = *(const f32x4*)qp, nq1 = *(const f32x4*)(qp + 4);
                float nv = vp[0], na = al[0], nb = be[0], nqk = qk[0];
                for (int t16 = 0; t16 < 4; ++t16) {
                    float ok = 0.f;
#pragma unroll 4
                    for (int i = 0; i < 16; ++i) {
                        const int tt = t16 * 16 + i, tn = (tt + 1) & 63;
                        const f32x2 K0 = {nk0.x, nk0.y}, K1 = {nk0.z, nk0.w}, K2 = {nk1.x, nk1.y}, K3 = {nk1.z, nk1.w};
                        const f32x2 Q0 = {nq0.x, nq0.y}, Q1 = {nq0.z, nq0.w}, Q2 = {nq1.x, nq1.y}, Q3 = {nq1.z, nq1.w};
                        const float v = nv, a = na, bt = nb, qkt = nqk;
                        nk0 = *(const f32x4*)(kp + tn * 128); nk1 = *(const f32x4*)(kp + tn * 128 + 4); nq0 = *(const f32x4*)(qp + tn * 128); nq1 = *(const f32x4*)(qp + tn * 128 + 4);
                        nv = vp[tn * 32]; na = al[tn]; nb = be[tn]; nqk = qk[tn];
                        f32x2 pa = K0 * S2[0], pb = K2 * S2[2], qa = Q0 * S2[0], qb = Q2 * S2[2];
                        pa = K1 * S2[1] + pa; pb = K3 * S2[3] + pb; qa = Q1 * S2[1] + qa; qb = Q3 * S2[3] + qb;
                        pa += pb; qa += qb;
                        float p = pa.x + pa.y, qS = qa.x + qa.y;
                        p = row_sum16(p); qS = row_sum16(qS);
                        const float vn = bt * (v - a * p);
                        const float o = a * qS + qkt * vn;
                        const f32x2 vn2 = {vn, vn}, a2 = {a, a};
                        S2[0] = S2[0] * a2 + K0 * vn2; S2[1] = S2[1] * a2 + K1 * vn2; S2[2] = S2[2] * a2 + K2 * vn2; S2[3] = S2[3] * a2 + K3 * vn2;
                        ok = (i == dl) ? o : ok;
                    }
                    os[(t16 * 16 + dl) * 32 + e] = ok;
                }
            }
            __syncthreads();
            { const int tok = tid >> 3, c4 = tid & 7;
              *(f32x4*)(o32 + (size_t)(b * S + t0 + tok) * D + h * 128 + es * 32 + c4 * 4) = *(const f32x4*)(os + tok * 32 + c4 * 4); }
            if (more) {
                GDN_PARK();
                __syncthreads();
                GDN_CONVNORM(t0 + 64);
            }
            __syncthreads();
        }
#undef GDN_PREFETCH
#undef GDN_PARK
#undef GDN_CONV8
#undef GDN_CONVNORM
    }
}

constexpr size_t WS_HALO = WS_END;
constexpr size_t WS_GL = WS_END + 10 * MiB;
constexpr size_t WS_END2 = WS_GL + 1 * MiB;

__device__ __forceinline__ void phase_gdn_halo(const bf16* proj, bf16* halo, int gtid, int NT) {
    for (int idx = gtid; idx < Bn * 64 * 3 * 384; idx += NT) {
        const int c = idx % 384, r3 = (idx / 384) % 3, bn = idx / (384 * 3), n = bn & 63, b = bn >> 6;
        u32x4 v = {0u, 0u, 0u, 0u};
        if (n > 0) v = *(const u32x4*)(proj + (size_t)(b * S + 64 * n - 3 + r3) * 4096 + c * 8);
        *(u32x4*)(halo + (size_t)(bn * 3 + r3) * 3072 + c * 8) = v;
    }
}

constexpr int GP_RAW = 0, GP_QB = 51456, GP_KB = GP_QB + 17408, GP_VB = GP_KB + 17408, GP_AM = GP_VB + 16384, GP_GC = GP_AM + 17408;
__device__ __forceinline__ void phase_gdn_prep(unsigned char* lds, bf16* proj, const bf16* halo, const float* ab, const float* convw, const float* A_log, const float* dt_bias,
                                               bf16* KT, bf16* AT, float* GL, int vblk, int nblk, int tid, int wid, int lane) {
    bf16* raw = (bf16*)(lds + GP_RAW);
    unsigned char* qb = lds + GP_QB;
    unsigned char* kb = lds + GP_KB;
    bf16* vb = (bf16*)(lds + GP_VB);
    float* Am = (float*)(lds + GP_AM);
    float* gcs = (float*)(lds + GP_GC);
    float* bes = gcs + 64;
    const int r = lane & 31, hh = lane >> 5;
    for (int item = vblk; item < Bn * 8 * 64; item += nblk) {
        const int n = item & 63, h = (item >> 6) & 7, b = item >> 9;
        const size_t tok0 = (size_t)b * S + 64 * n;
        __syncthreads();
#pragma unroll
        for (int k_ = 0; k_ < 7; ++k_) {
            const int idx = tid + 512 * k_;
            if (idx < 67 * 48) {
                const int row = idx / 48, c = idx - row * 48;
                const int col = c < 16 ? h * 128 + c * 8 : (c < 32 ? 1024 + h * 128 + (c - 16) * 8 : 2048 + h * 128 + (c - 32) * 8);
                u32x4 v;
                if (row < 3) v = *(const u32x4*)(halo + (size_t)((b * 64 + n) * 3 + row) * 3072 + col);
                else v = *(const u32x4*)(proj + (tok0 + row - 3) * 4096 + col);
                *(u32x4*)(raw + row * 384 + c * 8) = v;
            }
        }
        if (tid < 64) {
            const float a = ab[(tok0 + tid) * 16 + h] + dt_bias[h], bb = ab[(tok0 + tid) * 16 + 8 + h];
            const float sp = a > 20.f ? a : log1pf(__expf(a));
            float g = -__expf(A_log[h]) * sp;
#pragma unroll
            for (int o = 1; o < 64; o <<= 1) { const float t_ = __shfl_up(g, o); if (lane >= o) g += t_; }
            const float be_ = sigmoidf_(bb);
            gcs[tid] = g; bes[tid] = be_; gcs[128 + tid] = be_; gcs[192 + tid] = be_ * __expf(g);
        }
        __syncthreads();
        {
            const int isk = (tid >> 4) & 1, cg = tid & 15;
            const int colqk = isk * 1024 + h * 128 + cg * 8, colv = 2048 + h * 128 + cg * 8;
#define GP_CONV8(ROW0, C8, COL, OUT) do { _Pragma("unroll") for (int i_ = 0; i_ < 8; ++i_) OUT[i_] = 0.f; _Pragma("unroll") for (int j_ = 0; j_ < 4; ++j_) { const u32x4 xv_ = *(const u32x4*)(raw + ((ROW0) + j_) * 384 + (C8) * 8); \
            const f32x4 w0_ = *(const f32x4*)(convw + j_ * 3072 + (COL)), w1_ = *(const f32x4*)(convw + j_ * 3072 + (COL) + 4); \
            OUT[0] += bf2f(xv_.x & 0xffffu) * w0_.x; OUT[1] += bf2f(xv_.x >> 16) * w0_.y; OUT[2] += bf2f(xv_.y & 0xffffu) * w0_.z; OUT[3] += bf2f(xv_.y >> 16) * w0_.w; \
            OUT[4] += bf2f(xv_.z & 0xffffu) * w1_.x; OUT[5] += bf2f(xv_.z >> 16) * w1_.y; OUT[6] += bf2f(xv_.w & 0xffffu) * w1_.z; OUT[7] += bf2f(xv_.w >> 16) * w1_.w; } \
            _Pragma("unroll") for (int i_ = 0; i_ < 8; ++i_) OUT[i_] = siluf_(OUT[i_]); } while (0)
#pragma unroll
            for (int it = 0; it < 4; ++it) {
                const int tk = it * 16 + (tid >> 5);
                float y[8]; GP_CONV8(tk, isk * 16 + cg, colqk, y);
                float ss = (y[0] * y[0] + y[1] * y[1]) + (y[2] * y[2] + y[3] * y[3]) + (y[4] * y[4] + y[5] * y[5]) + (y[6] * y[6] + y[7] * y[7]);
                ss = row_sum16(ss);
                const float sc = (1.f / sqrtf(ss + EPS)) * (isk ? 1.f : 0.08838834764831845f);
                u32x4 w; w.x = pkbf(y[0] * sc, y[1] * sc); w.y = pkbf(y[2] * sc, y[3] * sc); w.z = pkbf(y[4] * sc, y[5] * sc); w.w = pkbf(y[6] * sc, y[7] * sc);
                *(u32x4*)((isk ? kb : qb) + tk * 272 + cg * 16) = w;
            }
#pragma unroll
            for (int it = 0; it < 2; ++it) {
                const int tk = it * 32 + (tid >> 4);
                float y[8]; GP_CONV8(tk, 32 + cg, colv, y);
                u32x4 w; w.x = pkbf(y[0], y[1]); w.y = pkbf(y[2], y[3]); w.z = pkbf(y[4], y[5]); w.w = pkbf(y[6], y[7]);
                *(u32x4*)(vb + tk * 128 + cg * 8) = w;
            }
#undef GP_CONV8
        }
        __syncthreads();
        {
            const int prod = wid >> 2, tr = (wid >> 1) & 1, tc = wid & 1;
            f32x16 acc;
#pragma unroll
            for (int i = 0; i < 16; ++i) acc[i] = 0.f;
            if (tr >= tc) {
                const unsigned char* Ab = (prod ? qb : kb) + (32 * tr + r) * 272 + hh * 16;
                const unsigned char* Bb = kb + (32 * tc + r) * 272 + hh * 16;
#pragma unroll
                for (int ks = 0; ks < 8; ++ks) acc = MFMA32(*(const bf16x8v*)(Ab + ks * 32), *(const bf16x8v*)(Bb + ks * 32), acc);
            }
            const int j = 32 * tc + r; const float gj = gcs[j];
#pragma unroll
            for (int i_ = 0; i_ < 16; ++i_) {
                const int i = 32 * tr + (i_ & 3) + 8 * (i_ >> 2) + 4 * hh;
                const float dec = __expf(gcs[i] - gj);
                if (prod == 0) Am[i * 68 + j] = (j < i) ? bes[i] * acc[i_] * dec : 0.f;
                else AT[(size_t)item * 4096 + i * 64 + j] = (bf16)f2bf((j <= i) ? acc[i_] * dec : 0.f);
            }
        }
        __syncthreads();
        if (tid < 256) {
            const int isw = tid >> 7, d = tid & 127;
            unsigned oam = GP_AM, orsc = GP_GC + 512 + isw * 256, ocol = (isw ? GP_KB : GP_VB) + d * 2;
            asm volatile("" : "+v"(oam), "+v"(orsc), "+v"(ocol));
            const float* Am_ = (const float*)(lds + oam); const float* rsc = (const float*)(lds + orsc); const unsigned char* col = lds + ocol;
            const int cstride = isw ? 272 : 256;
            float X[64];
#pragma clang loop unroll(full)
            for (int i = 0; i < 64; ++i) X[i] = 0.f;
#pragma clang loop unroll(full)
            for (int i = 0; i < 64; ++i) {
                float acc = rsc[i] * bf2f(*(const bf16*)(col + i * cstride));
#pragma clang loop unroll(full)
                for (int j4 = 0; j4 < 16; ++j4) { if (4 * j4 < i) { const f32x4 a4 = *(const f32x4*)(Am_ + i * 68 + 4 * j4);
                    acc -= a4.x * X[4 * j4]; acc -= a4.y * X[4 * j4 + 1]; acc -= a4.z * X[4 * j4 + 2]; acc -= a4.w * X[4 * j4 + 3]; } }
                X[i] = acc;
                asm volatile("" ::: "memory");
            }
            if (isw) {
#pragma unroll
                for (int i = 0; i < 64; ++i) proj[(tok0 + i) * 4096 + 1024 + h * 128 + d] = (bf16)f2bf(X[i]);
            } else {
                bf16* up = proj + (tok0 + (d >> 1)) * 4096 + 2048 + h * 128 + (d & 1) * 64;
#pragma unroll
                for (int i8 = 0; i8 < 8; ++i8) { u32x4 w; w.x = pkbf(X[8 * i8], X[8 * i8 + 1]); w.y = pkbf(X[8 * i8 + 2], X[8 * i8 + 3]); w.z = pkbf(X[8 * i8 + 4], X[8 * i8 + 5]); w.w = pkbf(X[8 * i8 + 6], X[8 * i8 + 7]);
                    *(u32x4*)(up + 8 * i8) = w; }
            }
        } else if (tid < 384) {
            const int d = tid - 256; const float gl_ = gcs[63];
            bf16* kp = KT + (size_t)item * 8192 + d * 64;
#pragma unroll
            for (int i8 = 0; i8 < 8; ++i8) { float y[8];
#pragma unroll
                for (int i = 0; i < 8; ++i) y[i] = bf2f(*(const bf16*)(kb + (8 * i8 + i) * 272 + d * 2)) * __expf(gl_ - gcs[8 * i8 + i]);
                u32x4 w; w.x = pkbf(y[0], y[1]); w.y = pkbf(y[2], y[3]); w.z = pkbf(y[4], y[5]); w.w = pkbf(y[6], y[7]);
                *(u32x4*)(kp + 8 * i8) = w; }
            if (d == 0) GL[item] = __expf(gl_);
        } else {
            const int d = tid - 384;
#pragma unroll 8
            for (int i = 0; i < 64; ++i) proj[(tok0 + i) * 4096 + h * 128 + d] = (bf16)f2bf(bf2f(*(const bf16*)(qb + i * 272 + d * 2)) * __expf(gcs[i]));
        }
    }
}

__device__ __forceinline__ void phase_gdn_scan2(unsigned char* lds, const bf16* proj, const bf16* KT, const bf16* AT, const float* GL, bf16* o16, int vblk, int nblk, int tid, int wid, int lane) {
    unsigned char* Sl = lds;
    unsigned char* Vl = lds + 8704;
    const int r = lane & 31, hh = lane >> 5;
    for (int item = vblk; item < 256; item += nblk) {
        const int bh = (item & 7) + 8 * (item >> 5), es = (item >> 3) & 3, b = bh >> 3, h = bh & 7;
        __syncthreads();
        for (int i = tid; i < 8704 / 4; i += 512) ((unsigned*)Sl)[i] = 0u;
        f32x16 Sacc;
#pragma unroll
        for (int i = 0; i < 16; ++i) Sacc[i] = 0.f;
        const int rt = wid & 1, dt = wid & 3;
        for (int n = 0; n < 64; ++n) {
            const size_t tok0 = (size_t)b * S + 64 * n; const int itm = bh * 64 + n;
            bf16x8v A8[8]; bf16x8v A4[4]; u32x2 uu[4]; float gl = 1.f;
            if (wid < 2) {
                const bf16* wp = proj + (tok0 + 32 * rt + r) * 4096 + 1024 + h * 128 + 8 * hh;
#pragma unroll
                for (int ks = 0; ks < 8; ++ks) A8[ks] = *(const bf16x8v*)(wp + 16 * ks);
                const int c = es * 32 + r;
                const bf16* up = proj + (tok0 + (c >> 1)) * 4096 + 2048 + h * 128 + (c & 1) * 64 + 32 * rt + 4 * hh;
#pragma unroll
                for (int g = 0; g < 4; ++g) uu[g] = *(const u32x2*)(up + 8 * g);
            } else if (wid < 4) {
                const bf16* qp = proj + (tok0 + 32 * rt + r) * 4096 + h * 128 + 8 * hh;
#pragma unroll
                for (int ks = 0; ks < 8; ++ks) A8[ks] = *(const bf16x8v*)(qp + 16 * ks);
                const bf16* ap = AT + (size_t)itm * 4096 + (32 * rt + r) * 64 + 8 * hh;
#pragma unroll
                for (int sx = 0; sx < 4; ++sx) A4[sx] = *(const bf16x8v*)(ap + 16 * sx);
            } else {
                const bf16* kp = KT + (size_t)itm * 8192 + (32 * dt + r) * 64 + 8 * hh;
#pragma unroll
                for (int sx = 0; sx < 4; ++sx) A4[sx] = *(const bf16x8v*)(kp + 16 * sx);
                gl = GL[itm];
            }
            __syncthreads();
            f32x16 acc;
#pragma unroll
            for (int i = 0; i < 16; ++i) acc[i] = 0.f;
            if (wid < 4) {
#pragma unroll
                for (int ks = 0; ks < 8; ++ks) acc = MFMA32(A8[ks], *(const bf16x8v*)(Sl + r * 272 + ks * 32 + hh * 16), acc);
                if (wid < 2) {
#pragma unroll
                    for (int g = 0; g < 4; ++g) {
                        u32x2 w; w.x = pkbf(bf2f(uu[g].x & 0xffffu) - acc[4 * g], bf2f(uu[g].x >> 16) - acc[4 * g + 1]);
                        w.y = pkbf(bf2f(uu[g].y & 0xffffu) - acc[4 * g + 2], bf2f(uu[g].y >> 16) - acc[4 * g + 3]);
                        *(u32x2*)(Vl + r * 144 + (32 * rt + 8 * g + 4 * hh) * 2) = w;
                    }
                }
            }
            __syncthreads();
            if (wid >= 2 && wid < 4) {
#pragma unroll
                for (int sx = 0; sx < 4; ++sx) acc = MFMA32(A4[sx], *(const bf16x8v*)(Vl + r * 144 + sx * 32 + hh * 16), acc);
                bf16* op = o16 + (tok0 + 32 * rt + 4 * hh) * D + h * 128 + es * 32 + r;
#pragma unroll
                for (int i = 0; i < 16; ++i) op[(size_t)((i & 3) + 8 * (i >> 2)) * D] = (bf16)f2bf(acc[i]);
            } else if (wid >= 4) {
#pragma unroll
                for (int i = 0; i < 16; ++i) Sacc[i] *= gl;
#pragma unroll
                for (int sx = 0; sx < 4; ++sx) Sacc = MFMA32(A4[sx], *(const bf16x8v*)(Vl + r * 144 + sx * 32 + hh * 16), Sacc);
#pragma unroll
                for (int g = 0; g < 4; ++g) { u32x2 w; w.x = pkbf(Sacc[4 * g], Sacc[4 * g + 1]); w.y = pkbf(Sacc[4 * g + 2], Sacc[4 * g + 3]);
                    *(u32x2*)(Sl + r * 272 + (32 * dt + 8 * g + 4 * hh) * 2) = w; }
            }
        }
    }
}

__device__ __forceinline__ void phase_gdn_post(const bf16* o16, const bf16* proj, const float* onorm, bf16* hn, int gw, int NGW, int lane) {
    const f32x4 wv = *(const f32x4*)(onorm + ((4 * lane) & 127));
    for (int m = gw; m < T; m += NGW) {
        const u32x2* xr = (const u32x2*)(o16 + (size_t)m * D) + lane;
        const u32x2* gr = (const u32x2*)(proj + (size_t)m * 4096 + 3072) + lane;
        u32x2* o8 = (u32x2*)(hn + (size_t)m * D) + lane;
#pragma unroll
        for (int j = 0; j < 4; ++j) {
            const u32x2 xv = xr[64 * j]; const u32x2 g = gr[64 * j];
            const f32x4 v = {bf2f(xv.x & 0xffffu), bf2f(xv.x >> 16), bf2f(xv.y & 0xffffu), bf2f(xv.y >> 16)};
            float s = (v.x * v.x + v.y * v.y) + (v.z * v.z + v.w * v.w);
#pragma unroll
            for (int o = 1; o < 32; o <<= 1) s += __shfl_xor(s, o);
            const float rstd = 1.f / sqrtf(s * (1.f / 128.f) + EPS);
            u32x2 o; o.x = pk2(v.x * rstd * wv.x * siluf_(bf2f(g.x & 0xffffu)), v.y * rstd * wv.y * siluf_(bf2f(g.x >> 16)));
            o.y = pk2(v.z * rstd * wv.z * siluf_(bf2f(g.y & 0xffffu)), v.w * rstd * wv.w * siluf_(bf2f(g.y >> 16)));
            o8[64 * j] = o;
        }
    }
}
__device__ __forceinline__ void phase_sc_post(const bf16* proj, const float* cw, bf16* hn, int gtid, int NT) {
    for (int idx = gtid; idx < T * 128; idx += NT) {
        const int m = idx >> 7, c8 = (idx & 127) * 8, s = m & (S - 1);
        float y[8];
#pragma unroll
        for (int i = 0; i < 8; ++i) y[i] = 0.f;
#pragma unroll
        for (int j = 0; j < 3; ++j) {
            if (s - 2 + j >= 0) {
                const bf16* pr = proj + (size_t)(m - 2 + j) * 3072;
                const u32x4 cv = *(const u32x4*)(pr + 1024 + c8), xv = *(const u32x4*)(pr + 2048 + c8);
                const f32x4 w0 = *(const f32x4*)(cw + j * 1024 + c8), w1 = *(const f32x4*)(cw + j * 1024 + c8 + 4);
                y[0] += w0.x * bf2f(cv.x & 0xffffu) * bf2f(xv.x & 0xffffu); y[1] += w0.y * bf2f(cv.x >> 16) * bf2f(xv.x >> 16);
                y[2] += w0.z * bf2f(cv.y & 0xffffu) * bf2f(xv.y & 0xffffu); y[3] += w0.w * bf2f(cv.y >> 16) * bf2f(xv.y >> 16);
                y[4] += w1.x * bf2f(cv.z & 0xffffu) * bf2f(xv.z & 0xffffu); y[5] += w1.y * bf2f(cv.z >> 16) * bf2f(xv.z >> 16);
                y[6] += w1.z * bf2f(cv.w & 0xffffu) * bf2f(xv.w & 0xffffu); y[7] += w1.w * bf2f(cv.w >> 16) * bf2f(xv.w >> 16);
            }
        }
        const u32x4 bv = *(const u32x4*)(proj + (size_t)m * 3072 + c8);
        u32x4 o;
        o.x = pk2(y[0] * bf2f(bv.x & 0xffffu), y[1] * bf2f(bv.x >> 16)); o.y = pk2(y[2] * bf2f(bv.y & 0xffffu), y[3] * bf2f(bv.y >> 16));
        o.z = pk2(y[4] * bf2f(bv.z & 0xffffu), y[5] * bf2f(bv.z >> 16)); o.w = pk2(y[6] * bf2f(bv.w & 0xffffu), y[7] * bf2f(bv.w >> 16));
        *(u32x4*)(hn + (size_t)m * D + c8) = o;
    }
}
__device__ __forceinline__ void phase_nsa_post(unsigned char* lds, const bf16* proj, const float* qnorm, const float* knorm, const f32x2* tab,
                                               bf16* QN, bf16* KS, bf16* KW, bf16* KCH, bf16* VCH, bf16* VST, bf16* VWT, int gw, int NGW, int wid, int lane) {
    {
        bf16* tile = (bf16*)lds + wid * (64 * 66);
        for (int item = gw; item < 2 * 32 * 64; item += NGW) {
            const int st = item & 63, bh = (item >> 6) & 31, which = item >> 11, b = bh >> 2, hk = bh & 3;
            const bf16* src = proj + ((size_t)b * S + st * 64) * 2560 + (which ? 2304 : 1792) + hk * 64 + lane;
#pragma unroll 8
            for (int i = 0; i < 64; ++i) tile[i * 66 + lane] = src[(size_t)i * 2560];
            WAVE_SYNC();
            bf16* dst = (which ? VWT : VST) + (size_t)bh * 64 * S + st * 64 + lane;
#pragma unroll 8
            for (int d = 0; d < 64; ++d) dst[(size_t)d * S] = tile[lane * 66 + d];
            WAVE_SYNC();
        }
    }
    const float qw = qnorm[lane], kw1 = knorm[64 + lane], kw2 = knorm[128 + lane];
    for (int m = gw; m < T; m += NGW) {
        const int b = m >> 12, s = m & (S - 1);
        const bf16* pr = proj + (size_t)m * 2560;
        const f32x2 cs = tab[(size_t)m * 32 + (lane & 31)];
#pragma unroll 4
        for (int hh = 0; hh < 16; ++hh) {
            const float x = bf2f(pr[hh * 64 + lane]);
            const float ss = wave_sum(x * x);
            QN[((size_t)(b * 16 + hh) * S + s) * 64 + lane] = (bf16)f2bf(x * (1.f / sqrtf(ss * (1.f / 64.f) + EPS)) * qw);
        }
#pragma unroll
        for (int hk = 0; hk < 4; ++hk) {
            const size_t o = ((size_t)(b * 4 + hk) * S + s) * 64 + lane;
            { const float x = bf2f(pr[1536 + hk * 64 + lane]); const float ss = wave_sum(x * x);
              const float y = x * (1.f / sqrtf(ss * (1.f / 64.f) + EPS)) * kw1; const float yp = __shfl_xor(y, 32);
              KS[o] = (bf16)f2bf(y * cs.x + (lane < 32 ? -yp : yp) * cs.y); }
            { const float x = bf2f(pr[2048 + hk * 64 + lane]); const float ss = wave_sum(x * x);
              const float y = x * (1.f / sqrtf(ss * (1.f / 64.f) + EPS)) * kw2; const float yp = __shfl_xor(y, 32);
              KW[o] = (bf16)f2bf(y * cs.x + (lane < 32 ? -yp : yp) * cs.y); }
            KCH[o] = pr[1024 + hk * 64 + lane];
            VCH[o] = pr[1280 + hk * 64 + lane];
        }
    }
}
__device__ __forceinline__ void phase_cmp2(unsigned char* lds, const float* Pk, const float* Pv, const float* biasp, const float* w2, const float* b2, const float* knorm0,
                                           bf16* KC, bf16* VC, int gw, int NGW, int wid, int lane) {
    float* hs = (float*)lds + wid * 256;
    for (int item = gw; item < 2 * 32 * 256; item += NGW) {
        const int i = item & 255, bh = (item >> 8) & 31, kind = item >> 13;
        bf16* outp = kind ? VC + ((size_t)bh * 64 + lane) * 256 + i : KC + ((size_t)bh * 256 + i) * 64 + lane;
        if (i == 255) { *outp = 0; continue; }
        const float* P = kind ? Pv : Pk;
        const float* r0 = P + ((size_t)bh * 256 + i) * 512; const float* r1 = r0 + 512 + 256;
#pragma unroll
        for (int j = 0; j < 4; ++j) { const int n = lane + 64 * j; const float x = r0[n] + r1[n] + biasp[kind * 256 + n];
            const float uu = 0.7978845608028654f * (x + 0.044715f * x * x * x);
            const float th = 1.f - 2.f / (1.f + __expf(2.f * uu));
            hs[n] = 0.5f * x * (1.f + th); }
        WAVE_SYNC();
        float acc = b2[kind * 64 + lane];
        const float* w = w2 + (size_t)kind * 256 * 64 + lane;
#pragma unroll 8
        for (int n = 0; n < 256; ++n) acc += hs[n] * w[n * 64];
        if (kind == 0) { const float ss = wave_sum(acc * acc); acc = acc * (1.f / sqrtf(ss * (1.f / 64.f) + EPS)) * knorm0[lane]; }
        *outp = (bf16)f2bf(acc);
        WAVE_SYNC();
    }
}
constexpr int KV_STRIDE = 144;
constexpr int KV_BUF = 2 * 64 * KV_STRIDE;
constexpr int ATT_IMP_OFF = 2 * KV_BUF;
constexpr int ATT_MSK_OFF = ATT_IMP_OFF + 8 * 2048;

template <bool IMP>
__device__ __forceinline__ void attn_tile(const bool FAST, const unsigned char* buf, int tt, int key0, int lo, int hi, const bf16x8v (&qf)[4],
                                          f32x16 (&O)[2], f32x16 (&IM)[2], float& m, float& l, const bf16* ovt, int r, int h, int pr) {
    f32x16 sacc;
#pragma unroll
    for (int i = 0; i < 16; ++i) sacc[i] = 0.f;
    const unsigned char* kb = buf + (32 * tt + pr) * KV_STRIDE + h * 16;
#pragma unroll
    for (int ks = 0; ks < 4; ++ks) { const bf16x8v a = *(const bf16x8v*)(kb + ks * 32); sacc = MFMA32(a, qf[ks], sacc); }
    const int kb0 = key0 + 8 * h;
    float mx = -1e30f, psum = 0.f, corr;
    if (FAST) {
        const bool on = hi >= 0;
#pragma unroll
        for (int i = 0; i < 16; ++i) mx = fmaxf(mx, sacc[i]);
        mx = on ? mx * 0.18033688011112042f : -1e30f;
        mx = fmaxf(mx, __shfl_xor(mx, 32));
        const float mnew = fmaxf(m, mx);
        corr = __builtin_amdgcn_exp2f(m - mnew);
        m = mnew;
#pragma unroll
        for (int i = 0; i < 16; ++i) { const float p = __builtin_amdgcn_exp2f(sacc[i] * 0.18033688011112042f - mnew); psum += p; sacc[i] = p; }
        if (!on) {
            psum = 0.f;
#pragma unroll
            for (int i = 0; i < 16; ++i) sacc[i] = 0.f;
        }
    } else {
#pragma unroll
        for (int i = 0; i < 16; ++i) { const int key = kb0 + 16 * (i >> 3) + (i & 7); const bool ok = (key >= lo) && (key <= hi);
            const float sv = ok ? sacc[i] * 0.18033688011112042f : -1e30f; sacc[i] = sv; mx = fmaxf(mx, sv); }
        mx = fmaxf(mx, __shfl_xor(mx, 32));
        const float mnew = fmaxf(m, mx);
        corr = __builtin_amdgcn_exp2f(m - mnew);
        m = mnew;
#pragma unroll
        for (int i = 0; i < 16; ++i) { const float p = sacc[i] > -1e29f ? __builtin_amdgcn_exp2f(sacc[i] - mnew) : 0.f; psum += p; sacc[i] = p; }
    }
    l = l * corr + psum;
    if (__any(corr != 1.f)) {
#pragma unroll
        for (int i = 0; i < 16; ++i) { O[0][i] *= corr; O[1][i] *= corr; }
        if (IMP) {
#pragma unroll
            for (int i = 0; i < 16; ++i) { IM[0][i] *= corr; IM[1][i] *= corr; }
        }
    }
    bf16x8v pf[2];
#pragma unroll
    for (int sx = 0; sx < 2; ++sx) { u32x4 w; w.x = pkbf(sacc[8 * sx], sacc[8 * sx + 1]); w.y = pkbf(sacc[8 * sx + 2], sacc[8 * sx + 3]); w.z = pkbf(sacc[8 * sx + 4], sacc[8 * sx + 5]); w.w = pkbf(sacc[8 * sx + 6], sacc[8 * sx + 7]);
        pf[sx] = __builtin_bit_cast(bf16x8v, w); }
    const unsigned char* vb = buf + 64 * KV_STRIDE + r * KV_STRIDE + (32 * tt + 8 * h) * 2;
#pragma unroll
    for (int dt = 0; dt < 2; ++dt)
#pragma unroll
        for (int sx = 0; sx < 2; ++sx) { const bf16x8v a = *(const bf16x8v*)(vb + dt * 32 * KV_STRIDE + sx * 32); O[dt] = MFMA32(a, pf[sx], O[dt]); }
    if (IMP) {
#pragma unroll
        for (int st = 0; st < 2; ++st)
#pragma unroll
            for (int sx = 0; sx < 2; ++sx) { const bf16x8v a = *(const bf16x8v*)(ovt + (32 * st + r) * 256 + key0 + 16 * sx + 8 * h); IM[st] = MFMA32(a, pf[sx], IM[st]); }
    }
}

template <int MODE>
__device__ __forceinline__ void attn_branch(unsigned char* kvbuf, const bf16* Kg0, const bf16* VTg0, int vts, unsigned long long blkmask, int t, int nv, unsigned long long selm,
                                            int wlo, int whi, int flo, int fhi, const bf16x8v (&qf)[4], f32x16 (&O)[2], f32x16 (&IM)[2], float& l, const bf16* ovt, int tid, int r, int h, int pr) {
    float m = -1e30f;
    l = 0.f;
#pragma unroll
    for (int i = 0; i < 16; ++i) { O[0][i] = 0.f; O[1][i] = 0.f; IM[0][i] = 0.f; IM[1][i] = 0.f; }
    const int srow = tid >> 3, sch = tid & 7;
    int j = __builtin_ctzll(blkmask);
    unsigned long long rest = blkmask & (blkmask - 1);
    u32x4 kr = *(const u32x4*)(Kg0 + (size_t)(64 * j + srow) * 64 + sch * 8);
    u32x4 vr = *(const u32x4*)(VTg0 + (size_t)srow * vts + 64 * j + sch * 8);
    *(u32x4*)(kvbuf + srow * KV_STRIDE + sch * 16) = kr;
    *(u32x4*)(kvbuf + 64 * KV_STRIDE + srow * KV_STRIDE + sch * 16) = vr;
    int cur = 0;
    for (;;) {
        __syncthreads();
        const bool more = rest != 0ull;
        int jn = 0;
        if (more) { jn = __builtin_ctzll(rest); rest &= rest - 1;
            kr = *(const u32x4*)(Kg0 + (size_t)(64 * jn + srow) * 64 + sch * 8);
            vr = *(const u32x4*)(VTg0 + (size_t)srow * vts + 64 * jn + sch * 8); }
        const unsigned char* buf = kvbuf + cur * KV_BUF;
        int lo, hi;
        if (MODE == 0) { lo = 0; hi = nv - 1; }
        else if (MODE == 1) { lo = 0; hi = ((selm >> j) & 1ull) ? t : -1; }
        else { lo = t - 511; hi = t; }
#pragma unroll
        for (int tt = 0; tt < 2; ++tt) {
            const int key0 = 64 * j + 32 * tt;
            if (key0 > whi || key0 + 31 < wlo) continue;
            attn_tile<MODE == 0>(key0 >= flo && key0 + 31 <= fhi, buf, tt, key0, lo, hi, qf, O, IM, m, l, ovt, r, h, pr);
        }
        if (!more) break;
        *(u32x4*)(kvbuf + (cur ^ 1) * KV_BUF + srow * KV_STRIDE + sch * 16) = kr;
        *(u32x4*)(kvbuf + (cur ^ 1) * KV_BUF + 64 * KV_STRIDE + srow * KV_STRIDE + sch * 16) = vr;
        cur ^= 1; j = jn;
    }
    __syncthreads();
}

__device__ __forceinline__ void phase_nsa_attn(unsigned char* lds, const bf16* QN, const bf16* KS, const bf16* KW, const bf16* VST, const bf16* VWT, const bf16* KCb, const bf16* VCT,
                                               const bf16* ovt, const float* gates, const f32x2* tab, bf16* hn, int vblk, int nblk, int tid, int wid, int lane) {
    const int r = lane & 31, h = lane >> 5, pr = (r & ~12) | ((r & 4) << 1) | ((r & 8) >> 1);
    float* imp_s = (float*)(lds + ATT_IMP_OFF + wid * 2048);
    unsigned long long* msk_s = (unsigned long long*)(lds + ATT_MSK_OFF);
    unsigned* uni_s = (unsigned*)(lds + ATT_MSK_OFF + 512);
    for (int item = vblk; item < Bn * 4 * 64; item += nblk) {
        const int rnd = item / nblk, wv = item - rnd * nblk;
        const int bh = wv & 31, sub = wv >> 5, per = nblk >> 5;
        int qb = rnd * per + ((rnd & 1) ? (per - 1 - sub) : sub);
        if (nblk != 256) { qb = item >> 5; }
        const int bhh = (nblk != 256) ? (item & 31) : bh;
        const int b = bhh >> 2, hk = bhh & 3;
        const int t0 = qb * 64, tw0 = t0 + 8 * wid, t = tw0 + (r & 7), g = r >> 3;
        const size_t tok = (size_t)b * S + t;
        if (tid == 0) { unsigned z = 0u; asm volatile("" : "+v"(z)); uni_s[0] = z; uni_s[1] = z; }
        bf16x8v qn[4], qr[4];
        {
            const bf16* qp = QN + ((size_t)(b * 16 + hk * 4 + g) * S + t) * 64 + 8 * h;
#pragma unroll
            for (int ks = 0; ks < 4; ++ks) qn[ks] = *(const bf16x8v*)(qp + 16 * ks);
            const f32x2* cp = tab + tok * 32 + 8 * h;
#pragma unroll
            for (int kl = 0; kl < 2; ++kl) {
                u32x4 wlo_, whi_;
                const u32x4 a = __builtin_bit_cast(u32x4, qn[kl]), c = __builtin_bit_cast(u32x4, qn[kl + 2]);
#pragma unroll
                for (int jj = 0; jj < 4; ++jj) {
                    const f32x2 cs0 = cp[16 * kl + 2 * jj], cs1 = cp[16 * kl + 2 * jj + 1];
                    const float x0 = bf2f(a[jj] & 0xffffu), x1 = bf2f(a[jj] >> 16), y0 = bf2f(c[jj] & 0xffffu), y1 = bf2f(c[jj] >> 16);
                    wlo_[jj] = pkbf(x0 * cs0.x - y0 * cs0.y, x1 * cs1.x - y1 * cs1.y);
                    whi_[jj] = pkbf(y0 * cs0.x + x0 * cs0.y, y1 * cs1.x + x1 * cs1.y);
                }
                qr[kl] = __builtin_bit_cast(bf16x8v, wlo_); qr[kl + 2] = __builtin_bit_cast(bf16x8v, whi_);
            }
        }
        const float* gp = gates + tok * 48 + (hk * 4 + g) * 3;
        const float g0 = sigmoidf_(gp[0]), g1 = sigmoidf_(gp[1]), g2 = sigmoidf_(gp[2]);
        f32x16 acc[2], O[2], IM[2];
        float l;
        const int nv = t >= 31 ? ((t - 31) >> 4) + 1 : 0;
        const int nvw = ((tw0 + 7 - 31) >> 4) + 1;
        const int nvmax = 4 * qb + 3;
        {
            const int ncb = (nvmax + 63) >> 6;
            const unsigned long long bm = ncb >= 64 ? ~0ull : ((1ull << ncb) - 1ull);
            attn_branch<0>(lds, KCb + (size_t)bhh * 256 * 64, VCT + (size_t)bhh * 64 * 256, 256, bm, t, nv, 0ull, 0, (tw0 + 7 >= 31 ? nvw - 1 : -1), 0, (tw0 >= 31 ? ((tw0 - 31) >> 4) : -1), qn, O, IM, l, ovt, tid, r, h, pr);
        }
        {
            const float lt = l + __shfl_xor(l, 32), inv = lt > 0.f ? 1.f / lt : 0.f, sc = inv * g0;
#pragma unroll
            for (int i = 0; i < 16; ++i) { acc[0][i] = O[0][i] * sc; acc[1][i] = O[1][i] * sc; }
#pragma unroll
            for (int st = 0; st < 2; ++st)
#pragma unroll
                for (int i = 0; i < 16; ++i) { float v = IM[st][i] * inv; v += __shfl_xor(v, 8); v += __shfl_xor(v, 16);
                    if (r < 8) imp_s[r * 64 + 32 * st + (i & 3) + 8 * (i >> 2) + 4 * h] = v; }
        }
        WAVE_SYNC();
        {
            unsigned long long um = 0ull;
            for (int tk = 0; tk < 8; ++tk) {
                const float imp = imp_s[tk * 64 + lane];
                const bool sv = lane <= qb, forced = (lane == 0) || (lane == qb) || (lane + 1 == qb);
                const float score = sv ? (forced ? 1e9f : imp) : -1.f;
                int rank = 0;
#pragma unroll 4
                for (int i = 0; i < 64; ++i) { const float si = __uint_as_float(__builtin_amdgcn_readlane(__float_as_uint(score), i)); rank += (si > score || (si == score && i < lane)) ? 1 : 0; }
                const unsigned long long mk = __ballot((rank < 16) && (score >= 0.f));
                um |= mk;
                if (lane == 0) msk_s[wid * 8 + tk] = mk;
            }
            if (lane == 0) { atomicOr(&uni_s[0], (unsigned)um); atomicOr(&uni_s[1], (unsigned)(um >> 32)); }
        }
        __syncthreads();
        const unsigned long long selm = msk_s[wid * 8 + (r & 7)];
        const unsigned long long uni = (unsigned long long)uni_s[0] | ((unsigned long long)uni_s[1] << 32);
        attn_branch<1>(lds, KS + (size_t)bhh * S * 64, VST + (size_t)bhh * 64 * S, S, uni, t, 0, selm, 0, tw0 + 7, 0, tw0, qr, O, IM, l, ovt, tid, r, h, pr);
        {
            const float lt = l + __shfl_xor(l, 32), sc = g1 / lt;
#pragma unroll
            for (int i = 0; i < 16; ++i) { acc[0][i] += O[0][i] * sc; acc[1][i] += O[1][i] * sc; }
        }
        {
            const int jlo = qb >= 8 ? qb - 8 : 0;
            const unsigned long long bm = (qb >= 63 ? ~0ull : ((1ull << (qb + 1)) - 1ull)) & ~((1ull << jlo) - 1ull);
            attn_branch<2>(lds, KW + (size_t)bhh * S * 64, VWT + (size_t)bhh * 64 * S, S, bm, t, 0, 0ull, tw0 - 511, tw0 + 7, tw0 + 7 - 511, tw0, qr, O, IM, l, ovt, tid, r, h, pr);
        }
        {
            const float lt = l + __shfl_xor(l, 32), sc = g2 / lt;
            bf16* op = hn + tok * D + (hk * 4 + g) * 64 + 4 * h;
#pragma unroll
            for (int dt = 0; dt < 2; ++dt)
#pragma unroll
                for (int q4 = 0; q4 < 4; ++q4) {
                    u32x2 w; w.x = pkbf(acc[dt][4 * q4] + O[dt][4 * q4] * sc, acc[dt][4 * q4 + 1] + O[dt][4 * q4 + 1] * sc);
                    w.y = pkbf(acc[dt][4 * q4 + 2] + O[dt][4 * q4 + 2] * sc, acc[dt][4 * q4 + 3] + O[dt][4 * q4 + 3] * sc);
                    *(u32x2*)(op + 32 * dt + 8 * q4) = w;
                }
        }
    }
}


#define LAS __attribute__((address_space(3)))
#define XB_TMO      128
#define XB_XCNT(j)  (256  + 64 * (j))
#define XB_XSUB(j)  (1280 + 64 * (j))
#define XB_XGEN(j)  (2304 + 64 * (j))
#define XB_TOP      3328
#define XB_TOPGEN   3392
#define XCD_BAR_WORDS 3456
#define XB_SPIN_CAP (1u << 18)

__device__ __forceinline__ unsigned xb_ld(unsigned* p)              { return __hip_atomic_load(p, __ATOMIC_RELAXED, __HIP_MEMORY_SCOPE_AGENT); }
__device__ __forceinline__ unsigned xb_add(unsigned* p, unsigned v) { return __hip_atomic_fetch_add(p, v, __ATOMIC_RELAXED, __HIP_MEMORY_SCOPE_AGENT); }
__device__ __forceinline__ unsigned xb_xcc_id() { return (unsigned)__builtin_amdgcn_s_getreg((3 << 11) | 20) & 0xFu; }
#define XB_SPIN(cond, bar) do { unsigned _sp = 0; while (cond) { __builtin_amdgcn_s_sleep(1); \
    if ((++_sp & 255u) == 0u) { if (xb_ld(&(bar)[XB_TMO])) break; if (_sp > XB_SPIN_CAP) { atomicAdd(&(bar)[XB_TMO], 1u); break; } } } } while (0)

struct XcdBarrier {
    unsigned* bar; unsigned x;
    volatile LAS unsigned* st;
};

__device__ __forceinline__ XcdBarrier xcd_barrier_post(unsigned* bar, volatile LAS unsigned* st) {
    XcdBarrier b; b.bar = bar; b.x = xb_xcc_id(); b.st = st;
    if (threadIdx.x == 0) (void)xb_add(&bar[XB_XCNT(b.x)], 1u);
    return b;
}
__device__ __forceinline__ void xcd_barrier_complete(unsigned* bar, unsigned x, unsigned& nloc, unsigned& nx) {
    const unsigned G = gridDim.x * gridDim.y * gridDim.z;
    unsigned sum, cnt, mine, sp = 0u;
    for (;;) {
        sum = 0u; cnt = 0u; mine = 0u;
#pragma unroll
        for (unsigned j = 0; j < 16; ++j) { const unsigned c = xb_ld(&bar[XB_XCNT(j)]); sum += c; cnt += (c > 0u) ? 1u : 0u; mine = (j == x) ? c : mine; }
        if (sum == G) break;
        __builtin_amdgcn_s_sleep(1);
        if ((++sp & 255u) == 0u) { if (xb_ld(&bar[XB_TMO])) break; if (sp > XB_SPIN_CAP) { atomicAdd(&bar[XB_TMO], 1u); break; } }
    }
    nloc = mine > 0u ? mine : 1u; nx = cnt > 0u ? cnt : 1u;
}

__device__ __forceinline__ void xcd_barrier(const XcdBarrier& b) {
    asm volatile("s_waitcnt vmcnt(0)" ::: "memory");
    __syncthreads();
    if (threadIdx.x == 0) {
        unsigned* bar = b.bar;
        __builtin_amdgcn_s_waitcnt(0);
        unsigned nloc = b.st[0], nx = b.st[1];
        if (nloc == 0u) { xcd_barrier_complete(bar, b.x, nloc, nx); b.st[0] = nloc; b.st[1] = nx; }
        const unsigned old = xb_add(&bar[XB_XSUB(b.x)], 1u);
        const unsigned gen = old / nloc;
        if (old + 1u == (gen + 1u) * nloc) {
            __builtin_amdgcn_fence(__ATOMIC_RELEASE, "agent");
            asm volatile("s_waitcnt vmcnt(0)" ::: "memory");
            const unsigned og = xb_add(&bar[XB_TOP], 1u);
            const unsigned tg = og / nx;
            if (og + 1u == (tg + 1u) * nx) xb_add(&bar[XB_TOPGEN], 1u);
            else XB_SPIN(xb_ld(&bar[XB_TOPGEN]) == tg, bar);
            __builtin_amdgcn_fence(__ATOMIC_ACQUIRE, "agent");
            xb_add(&bar[XB_XGEN(b.x)], 1u);
            asm volatile("s_waitcnt vmcnt(0)" ::: "memory");
        } else {
            XB_SPIN(xb_ld(&bar[XB_XGEN(b.x)]) == gen, bar);
            __builtin_amdgcn_fence(__ATOMIC_ACQUIRE, "agent");
            asm volatile("s_waitcnt vmcnt(0)" ::: "memory");
        }
    }
    __syncthreads();
}

struct Args { const void* in[24]; float* out; unsigned char* ws; int lo, hi; };

__host__ __device__ constexpr int mixer_inner_phases(int kind) { return kind == 0 ? 4 : (kind == 1 ? 1 : 4); }
__host__ __device__ constexpr int total_phases() { int n = 1; for (int L = 0; L < DEPTH; ++L) n += 6 + 3 + mixer_inner_phases(L % 3); return n; }

__global__ void __launch_bounds__(512, 2) mega(Args args) {
    extern __shared__ __attribute__((aligned(16))) unsigned char lds[];
    cg::grid_group grid = cg::this_grid();
    volatile LAS unsigned* bst = (volatile LAS unsigned*)((LAS unsigned char*)lds + (LDS_BYTES - 64));
    if (threadIdx.x < 2) bst[threadIdx.x] = 0u;
    __syncthreads();
    const XcdBarrier xbar = xcd_barrier_post((unsigned*)args.ws, bst);
    bool again = false;
    for (int ph = args.lo; ph < args.hi; ++ph) {
        int type = 0, s = 0, L = 0;
        if (ph > 0) {
            int p = ph - 1;
            for (L = 0; L < DEPTH; ++L) { const int n = 9 + mixer_inner_phases(L % 3); if (p < n) break; p -= n; }
            const int inner = mixer_inner_phases(L % 3), kind = L % 3;
            if (p < 3) { type = 1 + p; s = 2 * L; }
            else if (p == 3) type = 4;
            else if (p == 4) type = 5;
            else if (p < 5 + inner) { const int q = p - 5; type = kind == 0 ? (q == 0 ? 14 : (q == 1 ? 15 : 4 + q)) : (kind == 1 ? 8 : 9 + q); }
            else if (p == 5 + inner) type = 13;
            else { type = 1 + (p - 6 - inner); s = 2 * L + 1; }
        }
        int tid_ = threadIdx.x; asm volatile("" : "+v"(tid_));
        int G_ = gridDim.x, bx_ = blockIdx.x; asm volatile("" : "+s"(G_), "+s"(bx_));
        const int tid = tid_, lane = tid & 63, wid = __builtin_amdgcn_readfirstlane(tid >> 6);
        const int G = G_, bx = bx_;
        const int vcu = (G % 8 == 0) ? (bx % 8) * (G / 8) + bx / 8 : bx;
        const int gw = vcu * 8 + wid, NGW = G * 8;
        unsigned char* ws = args.ws; asm volatile("" : "+s"(ws));
        PG8_LAS unsigned char* ldsl = (PG8_LAS unsigned char*)lds;
        float* hout = args.out; asm volatile("" : "+s"(hout));
        bf16* HN = (bf16*)(ws + WS_HN);
        bf16* RB = (bf16*)(ws + WS_R);
        f32x2* tab = (f32x2*)(ws + WS_TAB);
        const int kind = L % 3, jj = L / 3;
        bf16* QN = RB + (size_t)T * 2560;
        bf16* KSb = QN + (size_t)T * 1024;
        bf16* KWb = KSb + (size_t)T * 256;
        bf16* KCH = (bf16*)(ws + WS_O32);
        bf16* VCH = KCH + (size_t)T * 256;
        float* Pk = (float*)(ws + WS_O32 + 32 * MiB);
        float* Pv = Pk + (size_t)8192 * 512;
        bf16* KC = (bf16*)(ws + WS_O32 + 64 * MiB);
        bf16* VC = (bf16*)(ws + WS_O32 + 65 * MiB);
        bf16* OVT = (bf16*)(ws + WS_BP + 65536);
        bf16* VST = (bf16*)(ws + WS_O32 + 68 * MiB);
        bf16* VWT = (bf16*)(ws + WS_O32 + 84 * MiB);
        switch (type) {
        case 0: {
            float* scr = (float*)lds + wid * (64 * 33);
            for (int mi = 0; mi < 28; ++mi) {
                const float* W; int K, N, Npad, mode = 0; bf16* WT;
                if (mi < 8)       { W = (const float*)args.in[3] + (size_t)mi * D * 2 * FF; K = D; N = 2 * FF; Npad = N; mode = 1; WT = (bf16*)(ws + WS_WGU) + (size_t)mi * 2 * FF * D; }
                else if (mi < 16) { const int i = mi - 8; W = (const float*)args.in[4] + (size_t)i * FF * D; K = FF; N = D; Npad = N; WT = (bf16*)(ws + WS_WDN) + (size_t)i * D * FF; }
                else if (mi < 18) { const int i = mi - 16; W = (const float*)args.in[6] + (size_t)i * D * 4112; K = D; N = 4112; Npad = GDN_NPAD; WT = (bf16*)(ws + WS_WGI) + (size_t)i * GDN_NPAD * D; }
                else if (mi < 20) { const int i = mi - 18; W = (const float*)args.in[11] + (size_t)i * D * D; K = D; N = D; Npad = N; WT = (bf16*)(ws + WS_WGO) + (size_t)i * D * D; }
                else if (mi == 20) { W = (const float*)args.in[12]; K = D; N = 3072; Npad = N; WT = (bf16*)(ws + WS_WSI); }
                else if (mi == 21) { W = (const float*)args.in[14]; K = D; N = D; Npad = N; WT = (bf16*)(ws + WS_WSO); }
                else if (mi == 22) { W = (const float*)args.in[15]; K = D; N = 2608; Npad = NSA_NPAD; WT = (bf16*)(ws + WS_WNI); }
                else if (mi == 23) { W = (const float*)args.in[23]; K = D; N = D; Npad = N; WT = (bf16*)(ws + WS_WNO); }
                else { const int i = mi - 24, kd = i >> 1, hf = i & 1;
                    W = (const float*)args.in[19] + (size_t)kd * 2048 * 256 + (size_t)hf * 1024 * 256; K = 1024; N = 256; Npad = 256; WT = (bf16*)(ws + WS_WC1) + (size_t)kd * 512 * 1024 + (size_t)hf * 256 * 1024; }
                xpose_matrix(W, K, N, Npad, WT, mode, scr, gw, NGW, lane);
            }
            const int* positions = (const int*)args.in[1];
            for (int idx = bx * 512 + tid; idx < T * 32; idx += G * 512) {
                const int tk = idx >> 5, i = idx & 31;
                const float inv = 1.0f / exp2f((float)(2 * i) * (13.287712379549449f / 64.f));
                const float ang = (float)positions[tk] * inv;
                const double rev = (double)ang * 0.15915494309189535;
                const float fr = (float)(rev - rint(rev));
                f32x2 v; v.x = __builtin_amdgcn_cosf(fr); v.y = __builtin_amdgcn_sinf(fr);
                tab[idx] = v;
            }
            for (int idx = bx * 512 + tid; idx < 64 * 256; idx += G * 512) {
                const int sj = idx >> 8, i = idx & 255, q = i >> 2, rem = i & 3;
                OVT[idx] = (bf16)(rem < 3 ? (q == sj ? 0x3F80 : 0) : ((q == sj || q + 1 == sj) ? 0x3F00 : 0));
            }
            if (bx < 2 && tid < 256) {
                const float* pe = (const float*)args.in[18] + (size_t)bx * 2048;
                const float* w1 = (const float*)args.in[19] + (size_t)bx * 2048 * 256 + tid;
                float acc = ((const float*)args.in[20])[bx * 256 + tid];
                for (int k = 0; k < 2048; ++k) acc += pe[k] * w1[(size_t)k * 256];
                ((float*)(ws + WS_BP))[bx * 256 + tid] = acc;
            }
        } break;
        case 1: phase_norm(s == 0 ? (const float*)args.in[0] : hout, (const float*)args.in[2] + (size_t)s * D, HN, gw, NGW, lane); break;
        case 2: {
            pg8::Gemm g{HN, (const bf16*)(ws + WS_WGU) + (size_t)s * 2 * FF * D, T, 2 * FF, D}; pg8::StaticOrder SO; SO.init(T, 2 * FF, G, bx);
            pg8::EpiSwiGLU E{RB};
            pg8::gemm_phase<pg8::EpiSwiGLU, pg8::StaticOrder, true, true>(ldsl, g, SO, E, tid); } break;
        case 3: {
            pg8::Gemm g{RB, (const bf16*)(ws + WS_WDN) + (size_t)s * D * FF, T, D, FF}; pg8::StaticOrder SO; SO.init(T, D, G, bx);
#if defined(REP_TYPE)
            const float sc3 = (REP_TYPE == 3 && !again) ? 0.f : 0.5f;
#else
            const float sc3 = 0.5f;
#endif
            pg8::EpiResid E{s == 0 ? (const float*)args.in[0] : hout, hout, sc3};
            pg8::gemm_phase<pg8::EpiResid, pg8::StaticOrder, true, true>(ldsl, g, SO, E, tid); } break;
        case 4: phase_norm(hout, (const float*)args.in[5] + (size_t)L * D, HN, gw, NGW, lane); break;
        case 5: {
            const bf16* Wt; int Np, ldc, nmain, ldt, nvalid; float* tail;
            if (kind == 0) { Wt = (const bf16*)(ws + WS_WGI) + (size_t)jj * GDN_NPAD * D; Np = GDN_NPAD; ldc = 4096; nmain = 4096; tail = (float*)(ws + WS_AB); ldt = 16; nvalid = 4112; }
            else if (kind == 1) { Wt = (const bf16*)(ws + WS_WSI); Np = 3072; ldc = 3072; nmain = 3072; tail = (float*)(ws + WS_AB); ldt = 16; nvalid = 3072; }
            else { Wt = (const bf16*)(ws + WS_WNI); Np = NSA_NPAD; ldc = 2560; nmain = 2560; tail = (float*)(ws + WS_GT); ldt = 48; nvalid = 2608; }
            pg8::Gemm g{HN, Wt, T, Np, D}; pg8::StaticOrder SO; SO.init(T, Np, G, bx);
            pg8::EpiProj E{RB, ldc, nmain, tail, ldt, nvalid};
            pg8::gemm_phase<pg8::EpiProj, pg8::StaticOrder, true, true>(ldsl, g, SO, E, tid); } break;
        case 14: phase_gdn_halo(RB, (bf16*)(ws + WS_HALO), vcu * 512 + tid, G * 512); break;
        case 15: phase_gdn_prep(lds, RB, (const bf16*)(ws + WS_HALO), (const float*)(ws + WS_AB), (const float*)args.in[7] + (size_t)jj * 4 * 3072, (const float*)args.in[8] + jj * 8, (const float*)args.in[9] + jj * 8,
                                HN, (bf16*)(ws + WS_O32 + 64 * MiB), (float*)(ws + WS_GL), bx, G, tid, wid, lane); break;
        case 6:
#ifndef DIS_SCAN
            phase_gdn_scan2(lds, RB, HN, (const bf16*)(ws + WS_O32 + 64 * MiB), (const float*)(ws + WS_GL), (bf16*)(ws + WS_O32), bx, G, tid, wid, lane);
#endif
            break;
        case 7:
#ifndef DIS_GPOST
            phase_gdn_post((const bf16*)(ws + WS_O32), RB, (const float*)args.in[10] + jj * 128, HN, gw, NGW, lane);
#endif
            break;
        case 8:
#ifndef DIS_SPOST
            phase_sc_post(RB, (const float*)args.in[13], HN, vcu * 512 + tid, G * 512);
#endif
            break;
        case 9:
#ifndef DIS_NPOST
            phase_nsa_post(lds, RB, (const float*)args.in[16], (const float*)args.in[17], tab, QN, KSb, KWb, KCH, VCH, VST, VWT, gw, NGW, wid, lane);
#endif
            break;
        case 10: {
            pg8::Gemm g{KCH, (const bf16*)(ws + WS_WC1), 8192, 512, 1024}; pg8::StaticOrder SO; SO.init(8192, 512, G, bx);
            pg8::Gemm g2{VCH, (const bf16*)(ws + WS_WC1) + (size_t)512 * 1024, 8192, 512, 1024};
            pg8::EpiF32 E{Pk, 512};
            if (bx >= G / 2) { g = g2; SO.init(8192, 512, G, bx - G / 2); E.C = Pv; }
            pg8::gemm_phase<pg8::EpiF32, pg8::StaticOrder, true, true>(ldsl, g, SO, E, tid); } break;
        case 11:
#ifndef DIS_CMP2
            phase_cmp2(lds, Pk, Pv, (const float*)(ws + WS_BP), (const float*)args.in[21], (const float*)args.in[22], (const float*)args.in[17], KC, VC, gw, NGW, wid, lane);
#endif
            break;
        case 12:
#ifndef DIS_ATTN
            phase_nsa_attn(lds, QN, KSb, KWb, VST, VWT, KC, VC, OVT, (const float*)(ws + WS_GT), tab, HN, bx, G, tid, wid, lane);
#endif
            break;
        default: {
            const bf16* Wout = kind == 0 ? (const bf16*)(ws + WS_WGO) + (size_t)jj * D * D : (kind == 1 ? (const bf16*)(ws + WS_WSO) : (const bf16*)(ws + WS_WNO));
            pg8::Gemm g{HN, Wout, T, D, D}; pg8::StaticOrder SO; SO.init(T, D, G, bx);
#if defined(REP_TYPE)
            const float sc13 = (REP_TYPE == 13 && !again) ? 0.f : 1.f;
#else
            const float sc13 = 1.f;
#endif
            pg8::EpiResid E{hout, hout, sc13};
            pg8::gemm_phase<pg8::EpiResid, pg8::StaticOrder, true, true>(ldsl, g, SO, E, tid); } break;
        }
#ifdef REP_TYPE
        if (type == REP_TYPE && !again) { again = true; xcd_barrier(xbar); --ph; continue; }
        again = false;
#endif
        if (ph + 1 < args.hi) { if (ph == 0) grid.sync(); else xcd_barrier(xbar); }
    }
}

extern "C" void kernel_launch(void* const* d_in, const int* in_sizes, int n_in, void* d_out, int out_size, void* d_ws, size_t ws_size, hipStream_t stream) {
    static int grid = 0;
    if (grid == 0) {
        if (n_in != 24 || out_size != T * D || ws_size < WS_END2) { fprintf(stderr, "kernel_launch: unexpected shapes n_in %d out %d ws %zu (need %zu)\n", n_in, out_size, ws_size, (size_t)WS_END2); grid = -1; return; }
        int dev = 0, cus = 0, per_cu = 0;
        hipGetDevice(&dev); hipDeviceGetAttribute(&cus, hipDeviceAttributeMultiprocessorCount, dev);
        if (hipFuncSetAttribute((const void*)mega, hipFuncAttributeMaxDynamicSharedMemorySize, LDS_BYTES) != hipSuccess) { fprintf(stderr, "kernel_launch: hipFuncSetAttribute failed\n"); grid = -1; return; }
        if (hipOccupancyMaxActiveBlocksPerMultiprocessor(&per_cu, (const void*)mega, 512, LDS_BYTES) != hipSuccess || per_cu < 1) { fprintf(stderr, "kernel_launch: occupancy query says %d\n", per_cu); per_cu = 1; }
        (void)hipGetLastError();
        grid = cus;
    }
    if (grid < 0) return;
    Args a{};
    for (int i = 0; i < 24; ++i) a.in[i] = d_in[i];
    a.out = (float*)d_out; a.ws = (unsigned char*)d_ws;
    constexpr int NPH = total_phases();
#if MK_MULTI
    for (int p = 0; p < NPH; ++p) { a.lo = p; a.hi = p + 1; hipLaunchKernelGGL(mega, dim3(grid), dim3(512), LDS_BYTES, stream, a); }
#else
    a.lo = 0; a.hi = NPH;
    (void)hipMemsetAsync(d_ws, 0, 16384, stream);
    void* kargs[] = {&a};
    hipError_t e = hipLaunchCooperativeKernel((const void*)mega, dim3(grid), dim3(512), kargs, LDS_BYTES, stream);
    if (e != hipSuccess) fprintf(stderr, "cooperative launch failed: %s (grid %d)\n", hipGetErrorString(e), grid);
#endif
}
```

```cpp
#include <hip/hip_runtime.h>
#include <hip/hip_cooperative_groups.h>
#include <cstdio>
#include <cstdint>
namespace cg = cooperative_groups;
namespace pg8 {
#define PG8_LAS __attribute__((address_space(3)))
typedef unsigned short bf16_t;
typedef short bf16x8 __attribute__((ext_vector_type(8)));
typedef float f32x4 __attribute__((ext_vector_type(4)));
typedef unsigned u32x4 __attribute__((ext_vector_type(4)));
constexpr int BM = 256, BK = 64, HALF = 128, HTB = HALF * BK * 2  , STAGE_BYTES = 8 * HTB, NXCD = 8, WGM = 8;

__host__ __device__ __forceinline__ int lds_byte(int r, int c) { const int st = (r >> 4) * 2 + (c >> 5), rr = r & 15, cc = c & 31, ob = rr * 64 + cc * 2; return st * 1024 + (ob ^ (((ob >> 9) & 1) << 5)); }
__host__ __device__ __forceinline__ void stage_rc(int b, int& R, int& C) { const int st = b / 1024, sb = b % 1024, swz = sb ^ (((sb >> 9) & 1) << 5); R = (st >> 1) * 16 + swz / 64; C = (st & 1) * 32 + (swz % 64) / 2; }
__host__ __device__ __forceinline__ int perm32(int rho) { const int n = rho >> 4, i = rho & 15; return 8 * (i >> 2) + 4 * n + (i & 3); }

struct Unit { int pm, pn; };
struct Gemm { const bf16_t* A; const bf16_t* Bt; int M, N, K; };

struct StaticOrder {
    int nM, nN, nwg, G, c;
    __host__ __device__ void init(int M, int N, int G_, int c_) { nM = M / BM; nN = N / BM; nwg = nM * nN; G = G_; c = c_; }
    __host__ __device__ bool next(int i, Unit& u) const {
        const long L = (long)i * G + c; if (L >= nwg) return false;
        int wgid = (int)L; { const int q = nwg / NXCD, r = nwg % NXCD, xcd = wgid % NXCD, off = wgid / NXCD; wgid = (xcd < r ? xcd * (q + 1) : r * (q + 1) + (xcd - r) * q) + off; }
        const int nig = WGM * nN, gid = wgid / nig, fm = gid * WGM, gsz = (nM - fm) < WGM ? (nM - fm) : WGM;
        u.pm = fm + ((wgid % nig) % gsz); u.pn = (wgid % nig) / gsz; return true;
    }
    __device__ __forceinline__ void a_ready(const Unit&) const {}
    __device__ __forceinline__ void done(const Unit&) const {}
};
__device__ __forceinline__ unsigned cvt_pk_bf16(float lo, float hi) { unsigned r; asm volatile("v_cvt_pk_bf16_f32 %0, %1, %2" : "=v"(r) : "v"(lo), "v"(hi)); return r; }
template <class Epi, class Sched, bool ALIGN_EPI = false, bool SP2 = false>
__device__ __forceinline__ void gemm_phase(PG8_LAS unsigned char* lds, const Gemm g, const Sched& S, const Epi& E, const int tid) {
    const int wid = __builtin_amdgcn_readfirstlane(tid >> 6), lane = tid & 63, wr = wid >> 2, wc = wid & 3, fr = lane & 15, fq = lane >> 4;
    const int K = g.K, nt = K / BK;
    unsigned voffA[2], voffB[2];
#pragma unroll
    for (int i = 0; i < 2; ++i) { int R, C; stage_rc(tid * 16 + i * 8192, R, C); const int Rb = Epi::PERM ? ((R & ~31) + perm32(R & 31)) : R;
        voffA[i] = (unsigned)(R * K + C) * 2u; voffB[i] = (unsigned)(Rb * K + C) * 2u; }
    const size_t kstep = (size_t)(BK * 2);
    const size_t hstep = (size_t)HALF * K * 2;
    const size_t tstep = 2 * hstep;
    const unsigned ldsw = (unsigned)wid * 1024u;
    const int aoff = lds_byte(wr * 64 + fr, fq * 8), boff = lds_byte(wc * 32 + fr, fq * 8);
#define PG8_SA(b, h) (((b) * 2 + (h)) * HTB)
#define PG8_SB(b, h) ((4 + (b) * 2 + (h)) * HTB)
#define PG8_STAGE(bufoff, gbase, voff) do { _Pragma("unroll") for (int _i = 0; _i < 2; ++_i) \
        __builtin_amdgcn_global_load_lds((const unsigned*)((const char*)(gbase) + (voff)[_i]), (PG8_LAS unsigned*)(lds + (bufoff) + ldsw + _i * 8192), 16, 0, 0); } while (0)
#define PG8_LDA(dst, b, h) do { _Pragma("unroll") for (int m = 0; m < 4; ++m) _Pragma("unroll") for (int k = 0; k < 2; ++k) dst[m][k] = *(const PG8_LAS bf16x8*)(lds + PG8_SA(b, h) + aoff + m * 2048 + k * 1024); } while (0)
#define PG8_LDB(dst, b, h) do { _Pragma("unroll") for (int n = 0; n < 2; ++n) _Pragma("unroll") for (int k = 0; k < 2; ++k) dst[n][k] = *(const PG8_LAS bf16x8*)(lds + PG8_SB(b, h) + boff + n * 2048 + k * 1024); } while (0)
#define PG8_MMA(ai, bj, At, Bt) do { __builtin_amdgcn_s_setprio(1); _Pragma("unroll") for (int m = 0; m < 4; ++m) _Pragma("unroll") for (int n = 0; n < 2; ++n) _Pragma("unroll") for (int k = 0; k < 2; ++k) \
        acc[ai][bj][m][n] = __builtin_amdgcn_mfma_f32_16x16x32_bf16(Bt[n][k], At[m][k], acc[ai][bj][m][n], 0, 0, 0); __builtin_amdgcn_s_setprio(0); } while (0)
#define PG8_WAIT_V(n) asm volatile("s_waitcnt vmcnt(" #n ")" ::: "memory")
#define PG8_WAIT_L(n) asm volatile("s_waitcnt lgkmcnt(" #n ")" ::: "memory")
#define PG8_BAR __builtin_amdgcn_s_barrier()
#define PG8_SCHED __builtin_amdgcn_sched_barrier(0)
    Unit cur, nxt; int ui = 0;
    if (!S.next(0, cur)) return;
    f32x4 acc[2][2][4][2];
#pragma unroll
    for (int a = 0; a < 2; ++a)
#pragma unroll
        for (int b = 0; b < 2; ++b)
#pragma unroll
            for (int m = 0; m < 4; ++m)
#pragma unroll
                for (int n = 0; n < 2; ++n) acc[a][b][m][n] = (f32x4){0.f, 0.f, 0.f, 0.f};
    bf16x8 At[4][2], B0[2][2], B1[2][2];
    const char* cA = (const char*)g.A + (size_t)cur.pm * tstep; const char* cB = (const char*)g.Bt + (size_t)cur.pn * tstep;
    S.a_ready(cur);
    if constexpr (SP2) {
        PG8_STAGE(PG8_SB(0, 0), cB, voffB); PG8_STAGE(PG8_SB(0, 1), cB + hstep, voffB); PG8_STAGE(PG8_SA(0, 0), cA, voffA); PG8_STAGE(PG8_SA(0, 1), cA + hstep, voffA);
        if (wr == 1) PG8_BAR;
        PG8_WAIT_V(2); PG8_BAR;
        PG8_STAGE(PG8_SB(1, 0), cB + kstep, voffB); PG8_STAGE(PG8_SA(1, 0), cA + kstep, voffA); PG8_STAGE(PG8_SB(1, 1), cB + hstep + kstep, voffB);
        PG8_WAIT_V(6); PG8_BAR;
    } else {
        PG8_STAGE(PG8_SB(0, 0), cB, voffB); PG8_STAGE(PG8_SA(0, 0), cA, voffA); PG8_STAGE(PG8_SB(0, 1), cB + hstep, voffB); PG8_STAGE(PG8_SA(0, 1), cA + hstep, voffA);
        if (wr == 1) PG8_BAR;
        PG8_WAIT_V(4); PG8_BAR;
        PG8_STAGE(PG8_SB(1, 0), cB + kstep, voffB); PG8_STAGE(PG8_SA(1, 0), cA + kstep, voffA); PG8_STAGE(PG8_SB(1, 1), cB + hstep + kstep, voffB);
        PG8_WAIT_V(6); PG8_BAR;
    }
    for (;;) {
        const bool has_next = S.next(ui + 1, nxt);
        const char* nA = has_next ? (const char*)g.A + (size_t)nxt.pm * tstep : cA; const char* nB = has_next ? (const char*)g.Bt + (size_t)nxt.pn * tstep : cB;
        for (int t = 0; t < nt; t += 2) {
            const bool last = (t == nt - 2);
            const char* a1 = cA + (size_t)(t + 1) * kstep;
            const char* a2 = last ? nA : cA + (size_t)(t + 2) * kstep; const char* b2 = last ? nB : cB + (size_t)(t + 2) * kstep;
            const char* a3 = a2 + kstep; const char* b3 = b2 + kstep;
            if (last && has_next) S.a_ready(nxt);
            if constexpr (SP2) {
            PG8_LDB(B0, 0, 0); PG8_LDB(B1, 0, 1); PG8_SCHED; PG8_LDA(At, 0, 0); PG8_STAGE(PG8_SA(1, 1), a1 + hstep, voffA);
            PG8_WAIT_V(8); PG8_WAIT_L(0); PG8_BAR; PG8_MMA(0, 0, At, B0); PG8_MMA(0, 1, At, B1); PG8_BAR; PG8_SCHED;
            PG8_LDA(At, 0, 1); PG8_STAGE(PG8_SB(0, 0), b2, voffB); PG8_STAGE(PG8_SB(0, 1), b2 + hstep, voffB); PG8_STAGE(PG8_SA(0, 0), a2, voffA);
            PG8_WAIT_V(8); PG8_WAIT_L(0); PG8_BAR; PG8_MMA(1, 0, At, B0); PG8_MMA(1, 1, At, B1); PG8_BAR; PG8_SCHED;
            PG8_LDB(B0, 1, 0); PG8_LDB(B1, 1, 1); PG8_SCHED; PG8_LDA(At, 1, 0); PG8_STAGE(PG8_SA(0, 1), a2 + hstep, voffA);
            PG8_WAIT_V(8); PG8_WAIT_L(0); PG8_BAR; PG8_MMA(0, 0, At, B0); PG8_MMA(0, 1, At, B1); PG8_BAR; PG8_SCHED;
            PG8_LDA(At, 1, 1); PG8_STAGE(PG8_SB(1, 0), b3, voffB); PG8_STAGE(PG8_SB(1, 1), b3 + hstep, voffB); PG8_STAGE(PG8_SA(1, 0), a3, voffA);
            PG8_WAIT_V(8); PG8_WAIT_L(0); PG8_BAR; PG8_MMA(1, 0, At, B0); PG8_MMA(1, 1, At, B1); PG8_BAR; PG8_SCHED;
            } else {
            PG8_LDB(B0, 0, 0); PG8_SCHED; PG8_LDA(At, 0, 0); PG8_STAGE(PG8_SA(1, 1), a1 + hstep, voffA);
            PG8_WAIT_L(8); PG8_BAR; PG8_WAIT_L(0); PG8_MMA(0, 0, At, B0); PG8_BAR; PG8_SCHED;
            PG8_LDB(B1, 0, 1); PG8_STAGE(PG8_SB(0, 0), b2, voffB);
            PG8_BAR; PG8_WAIT_L(0); PG8_MMA(0, 1, At, B1); PG8_BAR;
            PG8_LDA(At, 0, 1); PG8_STAGE(PG8_SA(0, 0), a2, voffA);
            PG8_BAR; PG8_WAIT_L(0); PG8_MMA(1, 0, At, B0); PG8_BAR; PG8_SCHED;
            PG8_STAGE(PG8_SB(0, 1), b2 + hstep, voffB);
            PG8_WAIT_V(6); PG8_BAR; PG8_MMA(1, 1, At, B1); PG8_BAR;
            PG8_LDB(B0, 1, 0); PG8_SCHED; PG8_LDA(At, 1, 0); PG8_STAGE(PG8_SA(0, 1), a2 + hstep, voffA);
            PG8_WAIT_L(8); PG8_BAR; PG8_WAIT_L(0); PG8_MMA(0, 0, At, B0); PG8_BAR; PG8_SCHED;
            PG8_LDB(B1, 1, 1); PG8_STAGE(PG8_SB(1, 0), b3, voffB);
            PG8_BAR; PG8_WAIT_L(0); PG8_MMA(0, 1, At, B1); PG8_BAR;
            PG8_LDA(At, 1, 1); PG8_STAGE(PG8_SA(1, 0), a3, voffA);
            PG8_BAR; PG8_WAIT_L(0); PG8_MMA(1, 0, At, B0); PG8_BAR; PG8_SCHED;
            PG8_STAGE(PG8_SB(1, 1), b3 + hstep, voffB);
            PG8_WAIT_V(6); PG8_BAR; PG8_MMA(1, 1, At, B1); PG8_BAR;
            }
        }
        if constexpr (ALIGN_EPI) { if (wr == 0) PG8_BAR; }
        if constexpr (!Epi::AFTER_DRAIN) { E(acc, cur, wr, wc, fr, fq); S.done(cur); }
        if (!has_next) break;
#pragma unroll
        for (int a = 0; a < 2; ++a)
#pragma unroll
            for (int b = 0; b < 2; ++b)
#pragma unroll
                for (int m = 0; m < 4; ++m)
#pragma unroll
                    for (int n = 0; n < 2; ++n) acc[a][b][m][n] = (f32x4){0.f, 0.f, 0.f, 0.f};
        cur = nxt; cA = nA; cB = nB; ++ui;
        if constexpr (ALIGN_EPI) { if (wr == 1) PG8_BAR; }
    }
    PG8_WAIT_V(0);
    if constexpr (!ALIGN_EPI) { if (wr == 0) PG8_BAR; }
    PG8_BAR;
    if constexpr (Epi::AFTER_DRAIN) { E.fused(acc, cur, wr, wc, fr, fq, lds, wid, lane); S.done(cur); }
#undef PG8_SA
#undef PG8_SB
#undef PG8_STAGE
#undef PG8_LDA
#undef PG8_LDB
#undef PG8_MMA
#undef PG8_WAIT_V
#undef PG8_WAIT_L
#undef PG8_BAR
#undef PG8_SCHED
}
}

typedef unsigned short bf16;
typedef float f32x4 __attribute__((ext_vector_type(4)));
typedef float f32x2 __attribute__((ext_vector_type(2)));
typedef unsigned u32x4 __attribute__((ext_vector_type(4)));
typedef unsigned u32x2 __attribute__((ext_vector_type(2)));

#ifndef MK_MULTI
#define MK_MULTI 0
#endif

constexpr int Bn = 8, S = 4096, T = Bn * S, D = 1024, FF = 2816, DEPTH = 4;
constexpr float EPS = 1e-6f;
constexpr int GDN_NPAD = 4352, NSA_NPAD = 2816;
constexpr int LDS_BYTES = 147456;
constexpr size_t MiB = 1u << 20;
constexpr size_t WS_WGU = 1 * MiB;
constexpr size_t WS_WDN = WS_WGU + 88 * MiB;
constexpr size_t WS_WGI = WS_WDN + 44 * MiB;
constexpr size_t WS_WGO = WS_WGI + 17 * MiB;
constexpr size_t WS_WSI = WS_WGO + 4 * MiB;
constexpr size_t WS_WSO = WS_WSI + 6 * MiB;
constexpr size_t WS_WNI = WS_WSO + 2 * MiB;
constexpr size_t WS_WNO = WS_WNI + 6 * MiB;
constexpr size_t WS_WC1 = WS_WNO + 2 * MiB;
constexpr size_t WS_TAB = WS_WC1 + 2 * MiB;
constexpr size_t WS_HN  = 184 * MiB;
constexpr size_t WS_R   = WS_HN + 64 * MiB;
constexpr size_t WS_O32 = WS_R + 256 * MiB;
constexpr size_t WS_SM  = WS_O32 + 128 * MiB;
constexpr size_t WS_AB  = WS_SM;
constexpr size_t WS_GT  = WS_SM + 2 * MiB;
constexpr size_t WS_BP  = WS_SM + 8 * MiB;
constexpr size_t WS_END = WS_SM + 9 * MiB;
static_assert(WS_TAB + 8 * MiB <= WS_HN, "ws map");

__device__ __forceinline__ float bf2f(unsigned v) { return __uint_as_float(v << 16); }
__device__ __forceinline__ unsigned f2bf(float f) { unsigned u = __float_as_uint(f); return (u + 0x7fffu + ((u >> 16) & 1u)) >> 16; }
__device__ __forceinline__ unsigned pk2(float lo, float hi) { return f2bf(lo) | (f2bf(hi) << 16); }
#define MFMA32(a, b, c) __builtin_amdgcn_mfma_f32_32x32x16_bf16((a), (b), (c), 0, 0, 0)
typedef short bf16x8v __attribute__((ext_vector_type(8)));
typedef float f32x16 __attribute__((ext_vector_type(16)));
typedef __bf16 bf16v2 __attribute__((ext_vector_type(2)));
__device__ __forceinline__ unsigned pkbf(float a, float b) { f32x2 v = {a, b}; return __builtin_bit_cast(unsigned, __builtin_convertvector(v, bf16v2)); }
__device__ __forceinline__ int lane_opq() { int l = (int)__builtin_amdgcn_mbcnt_hi(~0u, __builtin_amdgcn_mbcnt_lo(~0u, 0u)); asm volatile("" : "+v"(l)); return l; }
__device__ __forceinline__ float xshfl(float v, int m) { return __int_as_float(__builtin_amdgcn_ds_bpermute((lane_opq() ^ m) << 2, __float_as_int(v))); }
__device__ __forceinline__ float xshfl_up(float v, int o) { return __int_as_float(__builtin_amdgcn_ds_bpermute((lane_opq() - o) << 2, __float_as_int(v))); }
__device__ __forceinline__ float wave_sum(float v) {
#pragma unroll
    for (int o = 1; o < 64; o <<= 1) v += xshfl(v, o);
    return v;
}
__device__ __forceinline__ float wave_max(float v) {
#pragma unroll
    for (int o = 1; o < 64; o <<= 1) v = fmaxf(v, xshfl(v, o));
    return v;
}
__device__ __forceinline__ float row_sum16(float v) {
    v += __uint_as_float((unsigned)__builtin_amdgcn_update_dpp(0, (int)__float_as_uint(v), 0x128, 0xf, 0xf, false));
    v += __uint_as_float((unsigned)__builtin_amdgcn_update_dpp(0, (int)__float_as_uint(v), 0x124, 0xf, 0xf, false));
    v += __uint_as_float((unsigned)__builtin_amdgcn_update_dpp(0, (int)__float_as_uint(v), 0x122, 0xf, 0xf, false));
    v += __uint_as_float((unsigned)__builtin_amdgcn_update_dpp(0, (int)__float_as_uint(v), 0x121, 0xf, 0xf, false));
    return v;
}
__device__ __forceinline__ float sigmoidf_(float x) { return 1.f / (1.f + __expf(-x)); }
__device__ __forceinline__ float siluf_(float x) { return x * __builtin_amdgcn_rcpf(1.f + __expf(-x)); }
#define WAVE_SYNC() do { asm volatile("s_waitcnt lgkmcnt(0)" ::: "memory"); __builtin_amdgcn_wave_barrier(); } while (0)

namespace pg8 {
struct EpiSwiGLU {
    static constexpr bool PERM = true, AFTER_DRAIN = false;
    bf16_t* O;
    __device__ __forceinline__ void operator()(const f32x4 (&acc)[2][2][4][2], const Unit& u, int wr, int wc, int fr, int fq) const {
        const int row0 = u.pm * BM + wr * 64 + fr, col0 = u.pn * HALF + wc * 32 + 8 * fq;
#pragma unroll
        for (int ai = 0; ai < 2; ++ai)
#pragma unroll
            for (int m = 0; m < 4; ++m) {
                bf16_t* rowp = O + (size_t)(row0 + ai * HALF + m * 16) * FF + col0;
                float v[8];
#pragma unroll
                for (int n = 0; n < 2; ++n)
#pragma unroll
                    for (int j = 0; j < 4; ++j) { const float g = acc[ai][0][m][n][j], uu = acc[ai][1][m][n][j]; v[n * 4 + j] = g * __builtin_amdgcn_rcpf(1.f + __expf(-g)) * uu; }
                u32x4 w; w.x = cvt_pk_bf16(v[0], v[1]); w.y = cvt_pk_bf16(v[2], v[3]); w.z = cvt_pk_bf16(v[4], v[5]); w.w = cvt_pk_bf16(v[6], v[7]);
                *(u32x4*)rowp = w;
            }
    }
};
struct EpiResid {
    static constexpr bool PERM = false, AFTER_DRAIN = false;
    const float* base; float* out; float scale;
    __device__ __forceinline__ void operator()(const f32x4 (&acc)[2][2][4][2], const Unit& u, int wr, int wc, int fr, int fq) const {
        const int row0 = u.pm * BM + wr * 64 + fr, col0 = u.pn * BM + wc * 32 + 4 * fq;
#pragma unroll
        for (int ai = 0; ai < 2; ++ai)
#pragma unroll
            for (int m = 0; m < 4; ++m) {
                const size_t off = (size_t)(row0 + ai * HALF + m * 16) * D + col0;
#pragma unroll
                for (int bj = 0; bj < 2; ++bj)
#pragma unroll
                    for (int n = 0; n < 2; ++n) { const f32x4 bs = *(const f32x4*)(base + off + bj * HALF + n * 16); *(f32x4*)(out + off + bj * HALF + n * 16) = bs + acc[ai][bj][m][n] * scale; }
                if (m & 1) asm volatile("" ::: "memory");
            }
    }
};
struct EpiProj {
    static constexpr bool PERM = true, AFTER_DRAIN = false;
    bf16_t* O; int ldc; int nmain; float* tail; int ldt; int nvalid;
    __device__ __forceinline__ void operator()(const f32x4 (&acc)[2][2][4][2], const Unit& u, int wr, int wc, int fr, int fq) const {
        const int row0 = u.pm * BM + wr * 64 + fr, colt = u.pn * BM, col0 = colt + wc * 32 + 8 * fq;
        if (colt + BM <= nmain) {
#pragma unroll
            for (int ai = 0; ai < 2; ++ai)
#pragma unroll
                for (int m = 0; m < 4; ++m) {
                    bf16_t* rowp = O + (size_t)(row0 + ai * HALF + m * 16) * ldc + col0;
#pragma unroll
                    for (int bj = 0; bj < 2; ++bj) { const f32x4 v0 = acc[ai][bj][m][0], v1 = acc[ai][bj][m][1];
                        u32x4 w; w.x = cvt_pk_bf16(v0[0], v0[1]); w.y = cvt_pk_bf16(v0[2], v0[3]); w.z = cvt_pk_bf16(v1[0], v1[1]); w.w = cvt_pk_bf16(v1[2], v1[3]);
                        *(u32x4*)(rowp + bj * HALF) = w; }
                }
        } else {
#pragma unroll
            for (int ai = 0; ai < 2; ++ai)
#pragma unroll
                for (int m = 0; m < 4; ++m) {
                    const size_t row = (size_t)(row0 + ai * HALF + m * 16);
#pragma unroll
                    for (int bj = 0; bj < 2; ++bj)
#pragma unroll
                        for (int n = 0; n < 2; ++n)
#pragma unroll
                            for (int j = 0; j < 4; ++j) { const int col = col0 + bj * HALF + 4 * n + j; if (col >= nmain && col < nvalid) tail[row * ldt + (col - nmain)] = acc[ai][bj][m][n][j]; }
                }
        }
    }
};
struct EpiF32 {
    static constexpr bool PERM = false, AFTER_DRAIN = false;
    float* C; int ldc;
    __device__ __forceinline__ void operator()(const f32x4 (&acc)[2][2][4][2], const Unit& u, int wr, int wc, int fr, int fq) const {
        const int row0 = u.pm * BM + wr * 64 + fr, col0 = u.pn * BM + wc * 32 + 4 * fq;
#pragma unroll
        for (int ai = 0; ai < 2; ++ai)
#pragma unroll
            for (int m = 0; m < 4; ++m) {
                float* rowp = C + (size_t)(row0 + ai * HALF + m * 16) * ldc + col0;
#pragma unroll
                for (int bj = 0; bj < 2; ++bj)
#pragma unroll
                    for (int n = 0; n < 2; ++n) *(f32x4*)(rowp + bj * HALF + n * 16) = acc[ai][bj][m][n];
            }
    }
};
}

__device__ __forceinline__ void xpose_item(const float* W, int K, int N, bf16* WT, int rowbase, float* scr, int k0, int n0, int lane) {
    if (n0 + 32 <= N && (N & 3) == 0) {
        f32x4 v[8];
#pragma unroll
        for (int i = 0; i < 8; ++i) v[i] = *(const f32x4*)(W + (size_t)(k0 + 8 * i + (lane >> 3)) * N + n0 + 4 * (lane & 7));
#pragma unroll
        for (int i = 0; i < 8; ++i) { float* d = scr + (8 * i + (lane >> 3)) * 33 + 4 * (lane & 7); d[0] = v[i].x; d[1] = v[i].y; d[2] = v[i].z; d[3] = v[i].w; }
    } else {
#pragma unroll 8
        for (int i = 0; i < 32; ++i) { const int kk = 2 * i + (lane >> 5), n = n0 + (lane & 31); scr[kk * 33 + (lane & 31)] = n < N ? W[(size_t)(k0 + kk) * N + n] : 0.f; }
    }
    WAVE_SYNC();
    const int c = lane & 7;
#pragma unroll
    for (int j = 0; j < 4; ++j) { const int n = (lane >> 3) + 8 * j; const float* s = scr + (8 * c) * 33 + n;
        u32x4 o; o.x = pk2(s[0 * 33], s[1 * 33]); o.y = pk2(s[2 * 33], s[3 * 33]); o.z = pk2(s[4 * 33], s[5 * 33]); o.w = pk2(s[6 * 33], s[7 * 33]);
        *(u32x4*)(WT + (size_t)(rowbase + n) * K + k0 + 8 * c) = o; }
    WAVE_SYNC();
}
__device__ __forceinline__ void xpose_matrix(const float* W, int K, int N, int Npad, bf16* WT, int mode, float* scr, int gw, int NGW, int lane) {
    const int nblk = Npad / 32, nitems = (K / 64) * nblk;
    for (int it = gw; it < nitems; it += NGW) {
        const int kb = it / nblk, nb = it - kb * nblk, n0 = nb * 32;
        int rb = n0;
        if (mode == 1) rb = (n0 < FF) ? ((n0 >> 7) * 256 + (n0 & 127)) : ((((n0 - FF) >> 7) * 256) + 128 + ((n0 - FF) & 127));
        xpose_item(W, K, N, WT, rb, scr, kb * 64, n0, lane);
    }
}

__device__ __forceinline__ void phase_norm(const float* h, const float* w, bf16* out, int gw, int NGW, int lane) {
    f32x4 wv[4];
#pragma unroll
    for (int j = 0; j < 4; ++j) wv[j] = ((const f32x4*)w)[64 * j + lane];
    for (int m = gw; m < T; m += NGW) {
        const f32x4* xr = (const f32x4*)(h + (size_t)m * D) + lane;
        f32x4 v[4]; float s = 0.f;
#pragma unroll
        for (int j = 0; j < 4; ++j) { v[j] = xr[64 * j]; s += (v[j].x * v[j].x + v[j].y * v[j].y) + (v[j].z * v[j].z + v[j].w * v[j].w); }
        const float rstd = 1.f / sqrtf(wave_sum(s) * (1.f / D) + EPS);
        u32x2* o8 = (u32x2*)(out + (size_t)m * D) + lane;
#pragma unroll
        for (int j = 0; j < 4; ++j) { u32x2 o; o.x = pk2(v[j].x * rstd * wv[j].x, v[j].y * rstd * wv[j].y); o.y = pk2(v[j].z * rstd * wv[j].z, v[j].w * rstd * wv[j].w); o8[64 * j] = o; }
    }
}

__device__ __forceinline__ void phase_gdn_scan(unsigned char* lds, const bf16* proj, const float* ab, const float* convw, const float* A_log, const float* dt_bias,
                                               float* o32, int vblk, int nblk, int tid, int wid, int lane) {
    float* qs = (float*)lds;
    float* ks = qs + 64 * 128;
    float* vs = ks + 64 * 128;
    float* al = vs + 64 * 32;
    float* be = al + 64;
    float* qk = be + 64;
    float* os = qk + 64;
    bf16* raw = (bf16*)(os + 64 * 32);
    const int e = tid >> 4, dl = tid & 15;
    for (int item = vblk; item < 256; item += nblk) {
        const int bh = (item & 7) + 8 * (item >> 5), es = (item >> 3) & 3, b = bh >> 3, h = bh & 7;
        const float Ah = __expf(A_log[h]), dtb = dt_bias[h];
        const int isk = (tid >> 4) & 1, cg = tid & 15, cv = tid & 3;
        const int colqk = isk * 1024 + h * 128 + cg * 8, colv = 2048 + h * 128 + es * 32 + cv * 8;
        f32x4 wq[4][2], wv[4][2];
#pragma unroll
        for (int j = 0; j < 4; ++j) { wq[j][0] = *(const f32x4*)(convw + j * 3072 + colqk); wq[j][1] = *(const f32x4*)(convw + j * 3072 + colqk + 4);
                                      wv[j][0] = *(const f32x4*)(convw + j * 3072 + colv);  wv[j][1] = *(const f32x4*)(convw + j * 3072 + colv + 4); }
        f32x2 S2[4];
#pragma unroll
        for (int i = 0; i < 4; ++i) S2[i] = (f32x2){0.f, 0.f};
        u32x4 pre[5];
#define GDN_PREFETCH(T0) do { _Pragma("unroll") for (int k_ = 0; k_ < 5; ++k_) { const int idx_ = tid + 512 * k_; const int row_ = idx_ / 36, c_ = idx_ - row_ * 36; const int ts_ = (T0) - 3 + row_; \
            const int col_ = c_ < 16 ? h * 128 + c_ * 8 : (c_ < 32 ? 1024 + h * 128 + (c_ - 16) * 8 : 2048 + h * 128 + es * 32 + (c_ - 32) * 8); \
            pre[k_] = (u32x4){0u, 0u, 0u, 0u}; if (idx_ < 67 * 36 && ts_ >= 0) pre[k_] = *(const u32x4*)(proj + (size_t)(b * S + ts_) * 4096 + col_); } } while (0)
#define GDN_PARK() do { _Pragma("unroll") for (int k_ = 0; k_ < 5; ++k_) { const int idx_ = tid + 512 * k_; if (idx_ < 67 * 36) *(u32x4*)(raw + idx_ * 8) = pre[k_]; } } while (0)
#define GDN_CONV8(ROW0, C8, W, OUT) do { _Pragma("unroll") for (int i_ = 0; i_ < 8; ++i_) OUT[i_] = 0.f; _Pragma("unroll") for (int j_ = 0; j_ < 4; ++j_) { const u32x4 xv_ = *(const u32x4*)(raw + ((ROW0) + j_) * 288 + (C8) * 8); \
            OUT[0] += bf2f(xv_.x & 0xffffu) * W[j_][0].x; OUT[1] += bf2f(xv_.x >> 16) * W[j_][0].y; OUT[2] += bf2f(xv_.y & 0xffffu) * W[j_][0].z; OUT[3] += bf2f(xv_.y >> 16) * W[j_][0].w; \
            OUT[4] += bf2f(xv_.z & 0xffffu) * W[j_][1].x; OUT[5] += bf2f(xv_.z >> 16) * W[j_][1].y; OUT[6] += bf2f(xv_.w & 0xffffu) * W[j_][1].z; OUT[7] += bf2f(xv_.w >> 16) * W[j_][1].w; } \
            _Pragma("unroll") for (int i_ = 0; i_ < 8; ++i_) OUT[i_] = siluf_(OUT[i_]); } while (0)
#define GDN_CONVNORM(T0) do { \
            _Pragma("unroll") for (int it_ = 0; it_ < 4; ++it_) { const int tok_ = it_ * 16 + (tid >> 5); float y_[8]; GDN_CONV8(tok_, isk * 16 + cg, wq, y_); \
                float ss_ = (y_[0] * y_[0] + y_[1] * y_[1]) + (y_[2] * y_[2] + y_[3] * y_[3]) + (y_[4] * y_[4] + y_[5] * y_[5]) + (y_[6] * y_[6] + y_[7] * y_[7]); \
                ss_ = row_sum16(ss_); const float sc_ = (1.f / sqrtf(ss_ + EPS)) * (isk ? 1.f : 0.08838834764831845f); \
                float* d_ = (isk ? ks : qs) + tok_ * 128 + cg * 8; \
                _Pragma("unroll") for (int i_ = 0; i_ < 8; ++i_) y_[i_] *= sc_; \
                *(f32x4*)d_ = (f32x4){y_[0], y_[1], y_[2], y_[3]}; *(f32x4*)(d_ + 4) = (f32x4){y_[4], y_[5], y_[6], y_[7]}; \
                float dq_ = 0.f; _Pragma("unroll") for (int i_ = 0; i_ < 8; ++i_) dq_ += y_[i_] * xshfl(y_[i_], 16); \
                dq_ = row_sum16(dq_); if (isk == 0 && cg == 0) qk[tok_] = dq_; } \
            if (tid < 256) { const int tok_ = tid >> 2; float y_[8]; GDN_CONV8(tok_, 32 + cv, wv, y_); float* d_ = vs + tok_ * 32 + cv * 8; \
                *(f32x4*)d_ = (f32x4){y_[0], y_[1], y_[2], y_[3]}; *(f32x4*)(d_ + 4) = (f32x4){y_[4], y_[5], y_[6], y_[7]}; } \
            if (tid < 64) { const size_t tg_ = (size_t)(b * S + (T0) + tid); const float a_ = ab[tg_ * 16 + h] + dtb, bb_ = ab[tg_ * 16 + 8 + h]; \
                const float sp_ = a_ > 20.f ? a_ : __logf(1.f + __expf(a_)); al[tid] = __expf(-Ah * sp_); be[tid] = sigmoidf_(bb_); } } while (0)
        __syncthreads();
        GDN_PREFETCH(0); GDN_PARK();
        __syncthreads();
        GDN_CONVNORM(0);
        __syncthreads();
        for (int chunk = 0; chunk < S / 64; ++chunk) {
            const int t0 = chunk * 64;
            const bool more = chunk + 1 < S / 64;
            if (more) GDN_PREFETCH(t0 + 64);
            {
                const float* kp = ks + dl * 8; const float* qp = qs + dl * 8; const float* vp = vs + e;
                f32x4 nk0 = *(const f32x4*)kp, nk1 = *(const f32x4*)(kp + 4), nq0 = *(const f32x4*)qp, nq1 = *(const f32x4*)(qp + 4);
                float nv = vp[0], na = al[0], nb = be[0], nqk = qk[0];
                for (int t16 = 0; t16 < 4; ++t16) {
                    float ok = 0.f;
#pragma unroll 4
                    for (int i = 0; i < 16; ++i) {
                        const int tt = t16 * 16 + i, tn = (tt + 1) & 63;
                        const f32x2 K0 = {nk0.x, nk0.y}, K1 = {nk0.z, nk0.w}, K2 = {nk1.x, nk1.y}, K3 = {nk1.z, nk1.w};
                        const f32x2 Q0 = {nq0.x, nq0.y}, Q1 = {nq0.z, nq0.w}, Q2 = {nq1.x, nq1.y}, Q3 = {nq1.z, nq1.w};
                        const float v = nv, a = na, bt = nb, qkt = nqk;
                        nk0 = *(const f32x4*)(kp + tn * 128); nk1 = *(const f32x4*)(kp + tn * 128 + 4); nq0 = *(const f32x4*)(qp + tn * 128); nq1 = *(const f32x4*)(qp + tn * 128 + 4);
                        nv = vp[tn * 32]; na = al[tn]; nb = be[tn]; nqk = qk[tn];
                        f32x2 pa = K0 * S2[0], pb = K2 * S2[2], qa = Q0 * S2[0], qb = Q2 * S2[2];
                        pa = K1 * S2[1] + pa; pb = K3 * S2[3] + pb; qa = Q1 * S2[1] + qa; qb = Q3 * S2[3] + qb;
                        pa += pb; qa += qb;
                        float p = pa.x + pa.y, qS = qa.x + qa.y;
                        p = row_sum16(p); qS = row_sum16(qS);
                        const float vn = bt * (v - a * p);
                        const float o = a * qS + qkt * vn;
                        const f32x2 vn2 = {vn, vn}, a2 = {a, a};
                        S2[0] = S2[0] * a2 + K0 * vn2; S2[1] = S2[1] * a2 + K1 * vn2; S2[2] = S2[2] * a2 + K2 * vn2; S2[3] = S2[3] * a2 + K3 * vn2;
                        ok = (i == dl) ? o : ok;
                    }
                    os[(t16 * 16 + dl) * 32 + e] = ok;
                }
            }
            __syncthreads();
            { const int tok = tid >> 3, c4 = tid & 7;
              *(f32x4*)(o32 + (size_t)(b * S + t0 + tok) * D + h * 128 + es * 32 + c4 * 4) = *(const f32x4*)(os + tok * 32 + c4 * 4); }
            if (more) {
                GDN_PARK();
                __syncthreads();
                GDN_CONVNORM(t0 + 64);
            }
            __syncthreads();
        }
#undef GDN_PREFETCH
#undef GDN_PARK
#undef GDN_CONV8
#undef GDN_CONVNORM
    }
}

constexpr size_t WS_HALO = WS_END;
constexpr size_t WS_GL = WS_END + 10 * MiB;
constexpr size_t WS_END2 = WS_GL + 1 * MiB;

__device__ __forceinline__ void phase_gdn_halo(const bf16* proj, bf16* halo, int gtid, int NT) {
    for (int idx = gtid; idx < Bn * 64 * 3 * 384; idx += NT) {
        const int c = idx % 384, r3 = (idx / 384) % 3, bn = idx / (384 * 3), n = bn & 63, b = bn >> 6;
        u32x4 v = {0u, 0u, 0u, 0u};
        if (n > 0) v = *(const u32x4*)(proj + (size_t)(b * S + 64 * n - 3 + r3) * 4096 + c * 8);
        *(u32x4*)(halo + (size_t)(bn * 3 + r3) * 3072 + c * 8) = v;
    }
}

constexpr int GP_RAW = 0, GP_QB = 51456, GP_KB = GP_QB + 17408, GP_VB = GP_KB + 17408, GP_AM = GP_VB + 16384, GP_GC = GP_AM + 17408;
__device__ __forceinline__ void phase_gdn_prep(unsigned char* lds, bf16* proj, const bf16* halo, const float* ab, const float* convw, const float* A_log, const float* dt_bias,
                                               bf16* KT, bf16* AT, float* GL, int vblk, int nblk, int tid, int wid, int lane) {
    bf16* raw = (bf16*)(lds + GP_RAW);
    unsigned char* qb = lds + GP_QB;
    unsigned char* kb = lds + GP_KB;
    bf16* vb = (bf16*)(lds + GP_VB);
    float* Am = (float*)(lds + GP_AM);
    float* gcs = (float*)(lds + GP_GC);
    float* bes = gcs + 64;
    const int r = lane & 31, hh = lane >> 5;
    for (int item = vblk; item < Bn * 8 * 64; item += nblk) {
        const int n = item & 63, h = (item >> 6) & 7, b = item >> 9;
        const size_t tok0 = (size_t)b * S + 64 * n;
        __syncthreads();
#pragma unroll
        for (int k_ = 0; k_ < 7; ++k_) {
            const int idx = tid + 512 * k_;
            if (idx < 67 * 48) {
                const int row = idx / 48, c = idx - row * 48;
                const int col = c < 16 ? h * 128 + c * 8 : (c < 32 ? 1024 + h * 128 + (c - 16) * 8 : 2048 + h * 128 + (c - 32) * 8);
                u32x4 v;
                if (row < 3) v = *(const u32x4*)(halo + (size_t)((b * 64 + n) * 3 + row) * 3072 + col);
                else v = *(const u32x4*)(proj + (tok0 + row - 3) * 4096 + col);
                *(u32x4*)(raw + row * 384 + c * 8) = v;
            }
        }
        if (tid < 64) {
            const float a = ab[(tok0 + tid) * 16 + h] + dt_bias[h], bb = ab[(tok0 + tid) * 16 + 8 + h];
            const float sp = a > 20.f ? a : __logf(1.f + __expf(a));
            float g = -__expf(A_log[h]) * sp;
#pragma unroll
            for (int o = 1; o < 64; o <<= 1) { const float t_ = xshfl_up(g, o); if (lane >= o) g += t_; }
            const float be_ = sigmoidf_(bb);
            gcs[tid] = g; bes[tid] = be_; gcs[128 + tid] = be_; gcs[192 + tid] = be_ * __expf(g);
        }
        __syncthreads();
        {
            const int isk = (tid >> 4) & 1, cg = tid & 15;
            const int colqk = isk * 1024 + h * 128 + cg * 8, colv = 2048 + h * 128 + cg * 8;
#define GP_CONV8(ROW0, C8, COL, OUT) do { _Pragma("unroll") for (int i_ = 0; i_ < 8; ++i_) OUT[i_] = 0.f; _Pragma("unroll") for (int j_ = 0; j_ < 4; ++j_) { const u32x4 xv_ = *(const u32x4*)(raw + ((ROW0) + j_) * 384 + (C8) * 8); \
            const f32x4 w0_ = *(const f32x4*)(convw + j_ * 3072 + (COL)), w1_ = *(const f32x4*)(convw + j_ * 3072 + (COL) + 4); \
            OUT[0] += bf2f(xv_.x & 0xffffu) * w0_.x; OUT[1] += bf2f(xv_.x >> 16) * w0_.y; OUT[2] += bf2f(xv_.y & 0xffffu) * w0_.z; OUT[3] += bf2f(xv_.y >> 16) * w0_.w; \
            OUT[4] += bf2f(xv_.z & 0xffffu) * w1_.x; OUT[5] += bf2f(xv_.z >> 16) * w1_.y; OUT[6] += bf2f(xv_.w & 0xffffu) * w1_.z; OUT[7] += bf2f(xv_.w >> 16) * w1_.w; } \
            _Pragma("unroll") for (int i_ = 0; i_ < 8; ++i_) OUT[i_] = siluf_(OUT[i_]); } while (0)
#pragma unroll 1
            for (int it = 0; it < 4; ++it) {
                const int tk = it * 16 + (tid >> 5);
                float y[8]; GP_CONV8(tk, isk * 16 + cg, colqk, y);
                float ss = (y[0] * y[0] + y[1] * y[1]) + (y[2] * y[2] + y[3] * y[3]) + (y[4] * y[4] + y[5] * y[5]) + (y[6] * y[6] + y[7] * y[7]);
                ss = row_sum16(ss);
                const float sc = (1.f / sqrtf(ss + EPS)) * (isk ? 1.f : 0.08838834764831845f);
                u32x4 w; w.x = pkbf(y[0] * sc, y[1] * sc); w.y = pkbf(y[2] * sc, y[3] * sc); w.z = pkbf(y[4] * sc, y[5] * sc); w.w = pkbf(y[6] * sc, y[7] * sc);
                *(u32x4*)((isk ? kb : qb) + tk * 272 + cg * 16) = w;
            }
#pragma unroll 1
            for (int it = 0; it < 2; ++it) {
                const int tk = it * 32 + (tid >> 4);
                float y[8]; GP_CONV8(tk, 32 + cg, colv, y);
                u32x4 w; w.x = pkbf(y[0], y[1]); w.y = pkbf(y[2], y[3]); w.z = pkbf(y[4], y[5]); w.w = pkbf(y[6], y[7]);
                *(u32x4*)(vb + tk * 128 + cg * 8) = w;
            }
#undef GP_CONV8
        }
        __syncthreads();
        {
            const int prod = wid >> 2, tr = (wid >> 1) & 1, tc = wid & 1;
            f32x16 acc;
#pragma unroll
            for (int i = 0; i < 16; ++i) acc[i] = 0.f;
            if (tr >= tc) {
                const unsigned char* Ab = (prod ? qb : kb) + (32 * tr + r) * 272 + hh * 16;
                const unsigned char* Bb = kb + (32 * tc + r) * 272 + hh * 16;
#pragma unroll
                for (int ks = 0; ks < 8; ++ks) acc = MFMA32(*(const bf16x8v*)(Ab + ks * 32), *(const bf16x8v*)(Bb + ks * 32), acc);
            }
            const int j = 32 * tc + r; const float gj = gcs[j];
#pragma unroll
            for (int i_ = 0; i_ < 16; ++i_) {
                const int i = 32 * tr + (i_ & 3) + 8 * (i_ >> 2) + 4 * hh;
                const float dec = __expf(gcs[i] - gj);
                if (prod == 0) Am[i * 68 + j] = (j < i) ? bes[i] * acc[i_] * dec : 0.f;
                else AT[(size_t)item * 4096 + i * 64 + j] = (bf16)f2bf((j <= i) ? acc[i_] * dec : 0.f);
            }
        }
        __syncthreads();
        int tid3 = tid; asm volatile("" : "+v"(tid3));
        if (tid3 < 256) {
            const int isw = tid3 >> 7, d = tid3 & 127;
            unsigned oam = GP_AM, orsc = GP_GC + 512 + isw * 256, ocol = (isw ? GP_KB : GP_VB) + d * 2;
            asm volatile("" : "+v"(oam), "+v"(orsc), "+v"(ocol));
            const float* Am_ = (const float*)(lds + oam); const float* rsc = (const float*)(lds + orsc); const unsigned char* col = lds + ocol;
            const int cstride = isw ? 272 : 256;
            float X[64];
#pragma clang loop unroll(full)
            for (int i = 0; i < 64; ++i) X[i] = 0.f;
#pragma clang loop unroll(full)
            for (int i = 0; i < 64; ++i) {
                f32x4 av = {0.f, 0.f, 0.f, 0.f};
#pragma clang loop unroll(full)
                for (int j4 = 0; j4 < 16; ++j4) { if (4 * j4 < i) { const f32x4 a4 = *(const f32x4*)(Am_ + i * 68 + 4 * j4);
                    const f32x4 x4 = {X[4 * j4], X[4 * j4 + 1], X[4 * j4 + 2], X[4 * j4 + 3]}; av += a4 * x4; } }
                X[i] = rsc[i] * bf2f(*(const bf16*)(col + i * cstride)) - ((av.x + av.y) + (av.z + av.w));
                asm volatile("" ::: "memory");
            }
            if (isw) {
#pragma unroll
                for (int i = 0; i < 64; ++i) proj[(tok0 + i) * 4096 + 1024 + h * 128 + d] = (bf16)f2bf(X[i]);
            } else {
                bf16* up = proj + (tok0 + (d >> 1)) * 4096 + 2048 + h * 128 + (d & 1) * 64;
#pragma unroll
                for (int i8 = 0; i8 < 8; ++i8) { u32x4 w; w.x = pkbf(X[8 * i8], X[8 * i8 + 1]); w.y = pkbf(X[8 * i8 + 2], X[8 * i8 + 3]); w.z = pkbf(X[8 * i8 + 4], X[8 * i8 + 5]); w.w = pkbf(X[8 * i8 + 6], X[8 * i8 + 7]);
                    *(u32x4*)(up + 8 * i8) = w; }
            }
        } else if (tid3 < 384) {
            const int d = tid3 - 256; const float gl_ = gcs[63];
            bf16* kp = KT + (size_t)item * 8192 + d * 64;
#pragma unroll
            for (int i8 = 0; i8 < 8; ++i8) { float y[8];
#pragma unroll
                for (int i = 0; i < 8; ++i) y[i] = bf2f(*(const bf16*)(kb + (8 * i8 + i) * 272 + d * 2)) * __expf(gl_ - gcs[8 * i8 + i]);
                u32x4 w; w.x = pkbf(y[0], y[1]); w.y = pkbf(y[2], y[3]); w.z = pkbf(y[4], y[5]); w.w = pkbf(y[6], y[7]);
                *(u32x4*)(kp + 8 * i8) = w; }
            if (d == 0) GL[item] = __expf(gl_);
        } else {
            const int d = tid3 - 384;
#pragma unroll 8
            for (int i = 0; i < 64; ++i) proj[(tok0 + i) * 4096 + h * 128 + d] = (bf16)f2bf(bf2f(*(const bf16*)(qb + i * 272 + d * 2)) * __expf(gcs[i]));
        }
    }
}

__device__ __forceinline__ void phase_gdn_scan2(unsigned char* lds, const bf16* proj, const bf16* KT, const bf16* AT, const float* GL, bf16* o16, int vblk, int nblk, int tid, int wid, int lane) {
    unsigned char* Sl = lds;
    unsigned char* Vl = lds + 8704;
    const int r = lane & 31, hh = lane >> 5;
    for (int item = vblk; item < 256; item += nblk) {
        const int bh = (item & 7) + 8 * (item >> 5), es = (item >> 3) & 3, b = bh >> 3, h = bh & 7;
        __syncthreads();
        for (int i = tid; i < 8704 / 4; i += 512) ((unsigned*)Sl)[i] = 0u;
        f32x16 Sacc;
#pragma unroll
        for (int i = 0; i < 16; ++i) Sacc[i] = 0.f;
        const int rt = wid & 1, dt = wid & 3;
        for (int n = 0; n < 64; ++n) {
            const size_t tok0 = (size_t)b * S + 64 * n; const int itm = bh * 64 + n;
            bf16x8v A8[8]; bf16x8v A4[4]; u32x2 uu[4]; float gl = 1.f;
            if (wid < 2) {
                const bf16* wp = proj + (tok0 + 32 * rt + r) * 4096 + 1024 + h * 128 + 8 * hh;
#pragma unroll
                for (int ks = 0; ks < 8; ++ks) A8[ks] = *(const bf16x8v*)(wp + 16 * ks);
                const int c = es * 32 + r;
                const bf16* up = proj + (tok0 + (c >> 1)) * 4096 + 2048 + h * 128 + (c & 1) * 64 + 32 * rt + 4 * hh;
#pragma unroll
                for (int g = 0; g < 4; ++g) uu[g] = *(const u32x2*)(up + 8 * g);
            } else if (wid < 4) {
                const bf16* qp = proj + (tok0 + 32 * rt + r) * 4096 + h * 128 + 8 * hh;
#pragma unroll
                for (int ks = 0; ks < 8; ++ks) A8[ks] = *(const bf16x8v*)(qp + 16 * ks);
                const bf16* ap = AT + (size_t)itm * 4096 + (32 * rt + r) * 64 + 8 * hh;
#pragma unroll
                for (int sx = 0; sx < 4; ++sx) A4[sx] = *(const bf16x8v*)(ap + 16 * sx);
            } else {
                const bf16* kp = KT + (size_t)itm * 8192 + (32 * dt + r) * 64 + 8 * hh;
#pragma unroll
                for (int sx = 0; sx < 4; ++sx) A4[sx] = *(const bf16x8v*)(kp + 16 * sx);
                gl = GL[itm];
            }
            __syncthreads();
            f32x16 acc;
#pragma unroll
            for (int i = 0; i < 16; ++i) acc[i] = 0.f;
            if (wid < 4) {
#pragma unroll
                for (int ks = 0; ks < 8; ++ks) acc = MFMA32(A8[ks], *(const bf16x8v*)(Sl + r * 272 + ks * 32 + hh * 16), acc);
                if (wid < 2) {
#pragma unroll
                    for (int g = 0; g < 4; ++g) {
                        u32x2 w; w.x = pkbf(bf2f(uu[g].x & 0xffffu) - acc[4 * g], bf2f(uu[g].x >> 16) - acc[4 * g + 1]);
                        w.y = pkbf(bf2f(uu[g].y & 0xffffu) - acc[4 * g + 2], bf2f(uu[g].y >> 16) - acc[4 * g + 3]);
                        *(u32x2*)(Vl + r * 144 + (32 * rt + 8 * g + 4 * hh) * 2) = w;
                    }
                }
            }
            __syncthreads();
            if (wid >= 2 && wid < 4) {
#pragma unroll
                for (int sx = 0; sx < 4; ++sx) acc = MFMA32(A4[sx], *(const bf16x8v*)(Vl + r * 144 + sx * 32 + hh * 16), acc);
                bf16* op = o16 + (tok0 + 32 * rt + 4 * hh) * D + h * 128 + es * 32 + r;
#pragma unroll
                for (int i = 0; i < 16; ++i) op[(size_t)((i & 3) + 8 * (i >> 2)) * D] = (bf16)f2bf(acc[i]);
            } else if (wid >= 4) {
#pragma unroll
                for (int i = 0; i < 16; ++i) Sacc[i] *= gl;
#pragma unroll
                for (int sx = 0; sx < 4; ++sx) Sacc = MFMA32(A4[sx], *(const bf16x8v*)(Vl + r * 144 + sx * 32 + hh * 16), Sacc);
#pragma unroll
                for (int g = 0; g < 4; ++g) { u32x2 w; w.x = pkbf(Sacc[4 * g], Sacc[4 * g + 1]); w.y = pkbf(Sacc[4 * g + 2], Sacc[4 * g + 3]);
                    *(u32x2*)(Sl + r * 272 + (32 * dt + 8 * g + 4 * hh) * 2) = w; }
            }
        }
    }
}

__device__ __forceinline__ void phase_gdn_post(const bf16* o16, const bf16* proj, const float* onorm, bf16* hn, int gw, int NGW, int lane) {
    const f32x4 wv = *(const f32x4*)(onorm + ((4 * lane) & 127));
    for (int m = gw; m < T; m += NGW) {
        const u32x2* xr = (const u32x2*)(o16 + (size_t)m * D) + lane;
        const u32x2* gr = (const u32x2*)(proj + (size_t)m * 4096 + 3072) + lane;
        u32x2* o8 = (u32x2*)(hn + (size_t)m * D) + lane;
#pragma unroll
        for (int j = 0; j < 4; ++j) {
            const u32x2 xv = xr[64 * j]; const u32x2 g = gr[64 * j];
            const f32x4 v = {bf2f(xv.x & 0xffffu), bf2f(xv.x >> 16), bf2f(xv.y & 0xffffu), bf2f(xv.y >> 16)};
            float s = (v.x * v.x + v.y * v.y) + (v.z * v.z + v.w * v.w);
#pragma unroll
            for (int o = 1; o < 32; o <<= 1) s += xshfl(s, o);
            const float rstd = 1.f / sqrtf(s * (1.f / 128.f) + EPS);
            u32x2 o; o.x = pk2(v.x * rstd * wv.x * siluf_(bf2f(g.x & 0xffffu)), v.y * rstd * wv.y * siluf_(bf2f(g.x >> 16)));
            o.y = pk2(v.z * rstd * wv.z * siluf_(bf2f(g.y & 0xffffu)), v.w * rstd * wv.w * siluf_(bf2f(g.y >> 16)));
            o8[64 * j] = o;
        }
    }
}
__device__ __forceinline__ void phase_sc_post(const bf16* proj, const float* cw, bf16* hn, int gtid, int NT) {
    for (int idx = gtid; idx < T * 128; idx += NT) {
        const int m = idx >> 7, c8 = (idx & 127) * 8, s = m & (S - 1);
        float y[8];
#pragma unroll
        for (int i = 0; i < 8; ++i) y[i] = 0.f;
#pragma unroll
        for (int j = 0; j < 3; ++j) {
            if (s - 2 + j >= 0) {
                const bf16* pr = proj + (size_t)(m - 2 + j) * 3072;
                const u32x4 cv = *(const u32x4*)(pr + 1024 + c8), xv = *(const u32x4*)(pr + 2048 + c8);
                const f32x4 w0 = *(const f32x4*)(cw + j * 1024 + c8), w1 = *(const f32x4*)(cw + j * 1024 + c8 + 4);
                y[0] += w0.x * bf2f(cv.x & 0xffffu) * bf2f(xv.x & 0xffffu); y[1] += w0.y * bf2f(cv.x >> 16) * bf2f(xv.x >> 16);
                y[2] += w0.z * bf2f(cv.y & 0xffffu) * bf2f(xv.y & 0xffffu); y[3] += w0.w * bf2f(cv.y >> 16) * bf2f(xv.y >> 16);
                y[4] += w1.x * bf2f(cv.z & 0xffffu) * bf2f(xv.z & 0xffffu); y[5] += w1.y * bf2f(cv.z >> 16) * bf2f(xv.z >> 16);
                y[6] += w1.z * bf2f(cv.w & 0xffffu) * bf2f(xv.w & 0xffffu); y[7] += w1.w * bf2f(cv.w >> 16) * bf2f(xv.w >> 16);
            }
        }
        const u32x4 bv = *(const u32x4*)(proj + (size_t)m * 3072 + c8);
        u32x4 o;
        o.x = pk2(y[0] * bf2f(bv.x & 0xffffu), y[1] * bf2f(bv.x >> 16)); o.y = pk2(y[2] * bf2f(bv.y & 0xffffu), y[3] * bf2f(bv.y >> 16));
        o.z = pk2(y[4] * bf2f(bv.z & 0xffffu), y[5] * bf2f(bv.z >> 16)); o.w = pk2(y[6] * bf2f(bv.w & 0xffffu), y[7] * bf2f(bv.w >> 16));
        *(u32x4*)(hn + (size_t)m * D + c8) = o;
    }
}
__device__ __forceinline__ void phase_nsa_post(unsigned char* lds, const bf16* proj, const float* qnorm, const float* knorm, const f32x2* tab,
                                               bf16* QN, bf16* KS, bf16* KW, bf16* KCH, bf16* VCH, bf16* VST, bf16* VWT, int gw, int NGW, int wid, int lane) {
    {
        bf16* tile = (bf16*)lds + wid * (64 * 66);
        for (int item = gw; item < 2 * 32 * 64; item += NGW) {
            const int st = item & 63, bh = (item >> 6) & 31, which = item >> 11, b = bh >> 2, hk = bh & 3;
            const bf16* src = proj + ((size_t)b * S + st * 64) * 2560 + (which ? 2304 : 1792) + hk * 64 + lane;
#pragma unroll 8
            for (int i = 0; i < 64; ++i) tile[i * 66 + lane] = src[(size_t)i * 2560];
            WAVE_SYNC();
            bf16* dst = (which ? VWT : VST) + (size_t)bh * 64 * S + st * 64 + lane;
#pragma unroll 8
            for (int d = 0; d < 64; ++d) dst[(size_t)d * S] = tile[lane * 66 + d];
            WAVE_SYNC();
        }
    }
    const float qw = qnorm[lane], kw1 = knorm[64 + lane], kw2 = knorm[128 + lane];
    for (int m = gw; m < T; m += NGW) {
        const int b = m >> 12, s = m & (S - 1);
        const bf16* pr = proj + (size_t)m * 2560;
        const f32x2 cs = tab[(size_t)m * 32 + (lane & 31)];
#pragma unroll 4
        for (int hh = 0; hh < 16; ++hh) {
            const float x = bf2f(pr[hh * 64 + lane]);
            const float ss = wave_sum(x * x);
            QN[((size_t)(b * 16 + hh) * S + s) * 64 + lane] = (bf16)f2bf(x * (1.f / sqrtf(ss * (1.f / 64.f) + EPS)) * qw);
        }
#pragma unroll
        for (int hk = 0; hk < 4; ++hk) {
            const size_t o = ((size_t)(b * 4 + hk) * S + s) * 64 + lane;
            { const float x = bf2f(pr[1536 + hk * 64 + lane]); const float ss = wave_sum(x * x);
              const float y = x * (1.f / sqrtf(ss * (1.f / 64.f) + EPS)) * kw1; const float yp = xshfl(y, 32);
              KS[o] = (bf16)f2bf(y * cs.x + (lane < 32 ? -yp : yp) * cs.y); }
            { const float x = bf2f(pr[2048 + hk * 64 + lane]); const float ss = wave_sum(x * x);
              const float y = x * (1.f / sqrtf(ss * (1.f / 64.f) + EPS)) * kw2; const float yp = xshfl(y, 32);
              KW[o] = (bf16)f2bf(y * cs.x + (lane < 32 ? -yp : yp) * cs.y); }
            KCH[o] = pr[1024 + hk * 64 + lane];
            VCH[o] = pr[1280 + hk * 64 + lane];
        }
    }
}
__device__ __forceinline__ void phase_cmp2(unsigned char* lds, const float* Pk, const float* Pv, const float* biasp, const float* w2, const float* b2, const float* knorm0,
                                           bf16* KC, bf16* VC, int gw, int NGW, int wid, int lane) {
    float* hs = (float*)lds + wid * 256;
    for (int item = gw; item < 2 * 32 * 256; item += NGW) {
        const int i = item & 255, bh = (item >> 8) & 31, kind = item >> 13;
        bf16* outp = kind ? VC + ((size_t)bh * 64 + lane) * 256 + i : KC + ((size_t)bh * 256 + i) * 64 + lane;
        if (i == 255) { *outp = 0; continue; }
        const float* P = kind ? Pv : Pk;
        const float* r0 = P + ((size_t)bh * 256 + i) * 512; const float* r1 = r0 + 512 + 256;
#pragma unroll
        for (int j = 0; j < 4; ++j) { const int n = lane + 64 * j; const float x = r0[n] + r1[n] + biasp[kind * 256 + n];
            const float uu = 0.7978845608028654f * (x + 0.044715f * x * x * x);
            const float th = 1.f - 2.f / (1.f + __expf(2.f * uu));
            hs[n] = 0.5f * x * (1.f + th); }
        WAVE_SYNC();
        float acc = b2[kind * 64 + lane];
        const float* w = w2 + (size_t)kind * 256 * 64 + lane;
#pragma unroll 8
        for (int n = 0; n < 256; ++n) acc += hs[n] * w[n * 64];
        if (kind == 0) { const float ss = wave_sum(acc * acc); acc = acc * (1.f / sqrtf(ss * (1.f / 64.f) + EPS)) * knorm0[lane]; }
        *outp = (bf16)f2bf(acc);
        WAVE_SYNC();
    }
}
constexpr int KV_STRIDE = 144;
constexpr int KV_BUF = 2 * 64 * KV_STRIDE;
constexpr int ATT_IMP_OFF = 2 * KV_BUF;
constexpr int ATT_MSK_OFF = ATT_IMP_OFF + 8 * 2048;

template <bool IMP>
__device__ __forceinline__ void attn_tile(const bool FAST, const unsigned char* buf, int tt, int key0, int lo, int hi, const bf16x8v (&qf)[4],
                                          f32x16 (&O)[2], f32x16 (&IM)[2], float& m, float& l, const bf16* ovt, int r, int h, int pr) {
    f32x16 sacc;
#pragma unroll
    for (int i = 0; i < 16; ++i) sacc[i] = 0.f;
    const unsigned char* kb = buf + (32 * tt + pr) * KV_STRIDE + h * 16;
#pragma unroll
    for (int ks = 0; ks < 4; ++ks) { const bf16x8v a = *(const bf16x8v*)(kb + ks * 32); sacc = MFMA32(a, qf[ks], sacc); }
    const int kb0 = key0 + 8 * h;
    float mx = -1e30f, psum = 0.f, corr;
    if (FAST) {
        const bool on = hi >= 0;
#pragma unroll
        for (int i = 0; i < 16; ++i) mx = fmaxf(mx, sacc[i]);
        mx = on ? mx * 0.18033688011112042f : -1e30f;
        mx = fmaxf(mx, xshfl(mx, 32));
        const float mnew = fmaxf(m, mx);
        corr = __builtin_amdgcn_exp2f(m - mnew);
        m = mnew;
#pragma unroll
        for (int i = 0; i < 16; ++i) { const float p = __builtin_amdgcn_exp2f(sacc[i] * 0.18033688011112042f - mnew); psum += p; sacc[i] = p; }
        if (!on) {
            psum = 0.f;
#pragma unroll
            for (int i = 0; i < 16; ++i) sacc[i] = 0.f;
        }
    } else {
#pragma unroll
        for (int i = 0; i < 16; ++i) { const int key = kb0 + 16 * (i >> 3) + (i & 7); const bool ok = (key >= lo) && (key <= hi);
            const float sv = ok ? sacc[i] * 0.18033688011112042f : -1e30f; sacc[i] = sv; mx = fmaxf(mx, sv); }
        mx = fmaxf(mx, xshfl(mx, 32));
        const float mnew = fmaxf(m, mx);
        corr = __builtin_amdgcn_exp2f(m - mnew);
        m = mnew;
#pragma unroll
        for (int i = 0; i < 16; ++i) { const float p = sacc[i] > -1e29f ? __builtin_amdgcn_exp2f(sacc[i] - mnew) : 0.f; psum += p; sacc[i] = p; }
    }
    l = l * corr + psum;
    if (__any(corr != 1.f)) {
#pragma unroll
        for (int i = 0; i < 16; ++i) { O[0][i] *= corr; O[1][i] *= corr; }
        if (IMP) {
#pragma unroll
            for (int i = 0; i < 16; ++i) { IM[0][i] *= corr; IM[1][i] *= corr; }
        }
    }
    bf16x8v pf[2];
#pragma unroll
    for (int sx = 0; sx < 2; ++sx) { u32x4 w; w.x = pkbf(sacc[8 * sx], sacc[8 * sx + 1]); w.y = pkbf(sacc[8 * sx + 2], sacc[8 * sx + 3]); w.z = pkbf(sacc[8 * sx + 4], sacc[8 * sx + 5]); w.w = pkbf(sacc[8 * sx + 6], sacc[8 * sx + 7]);
        pf[sx] = __builtin_bit_cast(bf16x8v, w); }
    const unsigned char* vb = buf + 64 * KV_STRIDE + r * KV_STRIDE + (32 * tt + 8 * h) * 2;
#pragma unroll
    for (int dt = 0; dt < 2; ++dt)
#pragma unroll
        for (int sx = 0; sx < 2; ++sx) { const bf16x8v a = *(const bf16x8v*)(vb + dt * 32 * KV_STRIDE + sx * 32); O[dt] = MFMA32(a, pf[sx], O[dt]); }
    if (IMP) {
#pragma unroll
        for (int st = 0; st < 2; ++st)
#pragma unroll
            for (int sx = 0; sx < 2; ++sx) { const bf16x8v a = *(const bf16x8v*)(ovt + (32 * st + r) * 256 + key0 + 16 * sx + 8 * h); IM[st] = MFMA32(a, pf[sx], IM[st]); }
    }
}

template <int MODE>
__device__ __forceinline__ void attn_branch(unsigned char* kvbuf, const bf16* Kg0, const bf16* VTg0, int vts, unsigned long long blkmask, int t, int nv, unsigned long long selm,
                                            int wlo, int whi, int flo, int fhi, const bf16x8v (&qf)[4], f32x16 (&O)[2], f32x16 (&IM)[2], float& l, const bf16* ovt, int tid, int r, int h, int pr) {
    float m = -1e30f;
    l = 0.f;
#pragma unroll
    for (int i = 0; i < 16; ++i) { O[0][i] = 0.f; O[1][i] = 0.f; IM[0][i] = 0.f; IM[1][i] = 0.f; }
    const int srow = tid >> 3, sch = tid & 7;
    int j = __builtin_ctzll(blkmask);
    unsigned long long rest = blkmask & (blkmask - 1);
    u32x4 kr = *(const u32x4*)(Kg0 + (size_t)(64 * j + srow) * 64 + sch * 8);
    u32x4 vr = *(const u32x4*)(VTg0 + (size_t)srow * vts + 64 * j + sch * 8);
    *(u32x4*)(kvbuf + srow * KV_STRIDE + sch * 16) = kr;
    *(u32x4*)(kvbuf + 64 * KV_STRIDE + srow * KV_STRIDE + sch * 16) = vr;
    int cur = 0;
    for (;;) {
        __syncthreads();
        const bool more = rest != 0ull;
        int jn = 0;
        if (more) { jn = __builtin_ctzll(rest); rest &= rest - 1;
            kr = *(const u32x4*)(Kg0 + (size_t)(64 * jn + srow) * 64 + sch * 8);
            vr = *(const u32x4*)(VTg0 + (size_t)srow * vts + 64 * jn + sch * 8); }
        const unsigned char* buf = kvbuf + cur * KV_BUF;
        int lo, hi;
        if (MODE == 0) { lo = 0; hi = nv - 1; }
        else if (MODE == 1) { lo = 0; hi = ((selm >> j) & 1ull) ? t : -1; }
        else { lo = t - 511; hi = t; }
#pragma unroll
        for (int tt = 0; tt < 2; ++tt) {
            const int key0 = 64 * j + 32 * tt;
            if (key0 > whi || key0 + 31 < wlo) continue;
            attn_tile<MODE == 0>(key0 >= flo && key0 + 31 <= fhi, buf, tt, key0, lo, hi, qf, O, IM, m, l, ovt, r, h, pr);
        }
        if (!more) break;
        *(u32x4*)(kvbuf + (cur ^ 1) * KV_BUF + srow * KV_STRIDE + sch * 16) = kr;
        *(u32x4*)(kvbuf + (cur ^ 1) * KV_BUF + 64 * KV_STRIDE + srow * KV_STRIDE + sch * 16) = vr;
        cur ^= 1; j = jn;
    }
    __syncthreads();
}

__device__ __forceinline__ void phase_nsa_attn(unsigned char* lds, const bf16* QN, const bf16* KS, const bf16* KW, const bf16* VST, const bf16* VWT, const bf16* KCb, const bf16* VCT,
                                               const bf16* ovt, const float* gates, const f32x2* tab, bf16* hn, int vblk, int nblk, int tid, int wid, int lane) {
    const int r = lane & 31, h = lane >> 5, pr = (r & ~12) | ((r & 4) << 1) | ((r & 8) >> 1);
    float* imp_s = (float*)(lds + ATT_IMP_OFF + wid * 2048);
    unsigned long long* msk_s = (unsigned long long*)(lds + ATT_MSK_OFF);
    unsigned* uni_s = (unsigned*)(lds + ATT_MSK_OFF + 512);
    for (int item = vblk; item < Bn * 4 * 64; item += nblk) {
        const int rnd = item / nblk, wv = item - rnd * nblk;
        const int bh = wv & 31, sub = wv >> 5, per = nblk >> 5;
        int qb = rnd * per + ((rnd & 1) ? (per - 1 - sub) : sub);
        if (nblk != 256) { qb = item >> 5; }
        const int bhh = (nblk != 256) ? (item & 31) : bh;
        const int b = bhh >> 2, hk = bhh & 3;
        const int t0 = qb * 64, tw0 = t0 + 8 * wid, t = tw0 + (r & 7), g = r >> 3;
        const size_t tok = (size_t)b * S + t;
        if (tid == 0) { unsigned z = 0u; asm volatile("" : "+v"(z)); uni_s[0] = z; uni_s[1] = z; }
        bf16x8v qn[4], qr[4];
        {
            const bf16* qp = QN + ((size_t)(b * 16 + hk * 4 + g) * S + t) * 64 + 8 * h;
#pragma unroll
            for (int ks = 0; ks < 4; ++ks) qn[ks] = *(const bf16x8v*)(qp + 16 * ks);
            const f32x2* cp = tab + tok * 32 + 8 * h;
#pragma unroll
            for (int kl = 0; kl < 2; ++kl) {
                u32x4 wlo_, whi_;
                const u32x4 a = __builtin_bit_cast(u32x4, qn[kl]), c = __builtin_bit_cast(u32x4, qn[kl + 2]);
#pragma unroll
                for (int jj = 0; jj < 4; ++jj) {
                    const f32x2 cs0 = cp[16 * kl + 2 * jj], cs1 = cp[16 * kl + 2 * jj + 1];
                    const float x0 = bf2f(a[jj] & 0xffffu), x1 = bf2f(a[jj] >> 16), y0 = bf2f(c[jj] & 0xffffu), y1 = bf2f(c[jj] >> 16);
                    wlo_[jj] = pkbf(x0 * cs0.x - y0 * cs0.y, x1 * cs1.x - y1 * cs1.y);
                    whi_[jj] = pkbf(y0 * cs0.x + x0 * cs0.y, y1 * cs1.x + x1 * cs1.y);
                }
                qr[kl] = __builtin_bit_cast(bf16x8v, wlo_); qr[kl + 2] = __builtin_bit_cast(bf16x8v, whi_);
            }
        }
        const float* gp = gates + tok * 48 + (hk * 4 + g) * 3;
        const float g0 = sigmoidf_(gp[0]), g1 = sigmoidf_(gp[1]), g2 = sigmoidf_(gp[2]);
        f32x16 acc[2], O[2], IM[2];
        float l;
        const int nv = t >= 31 ? ((t - 31) >> 4) + 1 : 0;
        const int nvw = ((tw0 + 7 - 31) >> 4) + 1;
        const int nvmax = 4 * qb + 3;
        {
            const int ncb = (nvmax + 63) >> 6;
            const unsigned long long bm = ncb >= 64 ? ~0ull : ((1ull << ncb) - 1ull);
            attn_branch<0>(lds, KCb + (size_t)bhh * 256 * 64, VCT + (size_t)bhh * 64 * 256, 256, bm, t, nv, 0ull, 0, (tw0 + 7 >= 31 ? nvw - 1 : -1), 0, (tw0 >= 31 ? ((tw0 - 31) >> 4) : -1), qn, O, IM, l, ovt, tid, r, h, pr);
        }
        {
            const float lt = l + xshfl(l, 32), inv = lt > 0.f ? 1.f / lt : 0.f, sc = inv * g0;
#pragma unroll
            for (int i = 0; i < 16; ++i) { acc[0][i] = O[0][i] * sc; acc[1][i] = O[1][i] * sc; }
#pragma unroll
            for (int st = 0; st < 2; ++st)
#pragma unroll
                for (int i = 0; i < 16; ++i) { float v = IM[st][i] * inv; v += xshfl(v, 8); v += xshfl(v, 16);
                    if (r < 8) imp_s[r * 64 + 32 * st + (i & 3) + 8 * (i >> 2) + 4 * h] = v; }
        }
        WAVE_SYNC();
        {
            unsigned long long um = 0ull;
            for (int tk = 0; tk < 8; ++tk) {
                const float imp = imp_s[tk * 64 + lane];
                const bool sv = lane <= qb, forced = (lane == 0) || (lane == qb) || (lane + 1 == qb);
                const float score = sv ? (forced ? 1e9f : imp) : -1.f;
                int rank = 0;
#pragma unroll 4
                for (int i = 0; i < 64; ++i) { const float si = __uint_as_float(__builtin_amdgcn_readlane(__float_as_uint(score), i)); rank += (si > score || (si == score && i < lane)) ? 1 : 0; }
                const unsigned long long mk = __ballot((rank < 16) && (score >= 0.f));
                um |= mk;
                if (lane == 0) msk_s[wid * 8 + tk] = mk;
            }
            if (lane == 0) { atomicOr(&uni_s[0], (unsigned)um); atomicOr(&uni_s[1], (unsigned)(um >> 32)); }
        }
        __syncthreads();
        const unsigned long long selm = msk_s[wid * 8 + (r & 7)];
        const unsigned long long uni = (unsigned long long)uni_s[0] | ((unsigned long long)uni_s[1] << 32);
        attn_branch<1>(lds, KS + (size_t)bhh * S * 64, VST + (size_t)bhh * 64 * S, S, uni, t, 0, selm, 0, tw0 + 7, 0, tw0, qr, O, IM, l, ovt, tid, r, h, pr);
        {
            const float lt = l + xshfl(l, 32), sc = g1 / lt;
#pragma unroll
            for (int i = 0; i < 16; ++i) { acc[0][i] += O[0][i] * sc; acc[1][i] += O[1][i] * sc; }
        }
        {
            const int jlo = qb >= 8 ? qb - 8 : 0;
            const unsigned long long bm = (qb >= 63 ? ~0ull : ((1ull << (qb + 1)) - 1ull)) & ~((1ull << jlo) - 1ull);
            attn_branch<2>(lds, KW + (size_t)bhh * S * 64, VWT + (size_t)bhh * 64 * S, S, bm, t, 0, 0ull, tw0 - 511, tw0 + 7, tw0 + 7 - 511, tw0, qr, O, IM, l, ovt, tid, r, h, pr);
        }
        {
            const float lt = l + xshfl(l, 32), sc = g2 / lt;
            bf16* op = hn + tok * D + (hk * 4 + g) * 64 + 4 * h;
#pragma unroll
            for (int dt = 0; dt < 2; ++dt)
#pragma unroll
                for (int q4 = 0; q4 < 4; ++q4) {
                    u32x2 w; w.x = pkbf(acc[dt][4 * q4] + O[dt][4 * q4] * sc, acc[dt][4 * q4 + 1] + O[dt][4 * q4 + 1] * sc);
                    w.y = pkbf(acc[dt][4 * q4 + 2] + O[dt][4 * q4 + 2] * sc, acc[dt][4 * q4 + 3] + O[dt][4 * q4 + 3] * sc);
                    *(u32x2*)(op + 32 * dt + 8 * q4) = w;
                }
        }
    }
}


#define LAS __attribute__((address_space(3)))
#define XB_TMO      128
#define XB_XCNT(j)  (256  + 64 * (j))
#define XB_XSUB(j)  (1280 + 64 * (j))
#define XB_XGEN(j)  (2304 + 64 * (j))
#define XB_TOP      3328
#define XB_TOPGEN   3392
#define XCD_BAR_WORDS 3456
#define XB_SPIN_CAP (1u << 18)

__device__ __forceinline__ unsigned xb_ld(unsigned* p)              { return __hip_atomic_load(p, __ATOMIC_RELAXED, __HIP_MEMORY_SCOPE_AGENT); }
__device__ __forceinline__ unsigned xb_add(unsigned* p, unsigned v) { return __hip_atomic_fetch_add(p, v, __ATOMIC_RELAXED, __HIP_MEMORY_SCOPE_AGENT); }
__device__ __forceinline__ unsigned xb_xcc_id() { return (unsigned)__builtin_amdgcn_s_getreg((3 << 11) | 20) & 0xFu; }
#define XB_SPIN(cond, bar) do { unsigned _sp = 0; while (cond) { __builtin_amdgcn_s_sleep(1); \
    if ((++_sp & 255u) == 0u) { if (xb_ld(&(bar)[XB_TMO])) break; if (_sp > XB_SPIN_CAP) { atomicAdd(&(bar)[XB_TMO], 1u); break; } } } } while (0)

struct XcdBarrier {
    unsigned* bar; unsigned x;
    volatile LAS unsigned* st;
};

__device__ __forceinline__ XcdBarrier xcd_barrier_post(unsigned* bar, volatile LAS unsigned* st) {
    XcdBarrier b; b.bar = bar; b.x = xb_xcc_id(); b.st = st;
    if (threadIdx.x == 0) (void)xb_add(&bar[XB_XCNT(b.x)], 1u);
    return b;
}
__device__ __forceinline__ void xcd_barrier_complete(unsigned* bar, unsigned x, unsigned& nloc, unsigned& nx) {
    const unsigned G = gridDim.x * gridDim.y * gridDim.z;
    unsigned sum, cnt, mine, sp = 0u;
    for (;;) {
        sum = 0u; cnt = 0u; mine = 0u;
#pragma unroll
        for (unsigned j = 0; j < 16; ++j) { const unsigned c = xb_ld(&bar[XB_XCNT(j)]); sum += c; cnt += (c > 0u) ? 1u : 0u; mine = (j == x) ? c : mine; }
        if (sum == G) break;
        __builtin_amdgcn_s_sleep(1);
        if ((++sp & 255u) == 0u) { if (xb_ld(&bar[XB_TMO])) break; if (sp > XB_SPIN_CAP) { atomicAdd(&bar[XB_TMO], 1u); break; } }
    }
    nloc = mine > 0u ? mine : 1u; nx = cnt > 0u ? cnt : 1u;
}

__device__ __forceinline__ void xcd_barrier(const XcdBarrier& b) {
    asm volatile("s_waitcnt vmcnt(0)" ::: "memory");
    __syncthreads();
    if (threadIdx.x == 0) {
        unsigned* bar = b.bar;
        __builtin_amdgcn_s_waitcnt(0);
        unsigned nloc = b.st[0], nx = b.st[1];
        if (nloc == 0u) { xcd_barrier_complete(bar, b.x, nloc, nx); b.st[0] = nloc; b.st[1] = nx; }
        const unsigned old = xb_add(&bar[XB_XSUB(b.x)], 1u);
        const unsigned gen = old / nloc;
        if (old + 1u == (gen + 1u) * nloc) {
            __builtin_amdgcn_fence(__ATOMIC_RELEASE, "agent");
            asm volatile("s_waitcnt vmcnt(0)" ::: "memory");
            const unsigned og = xb_add(&bar[XB_TOP], 1u);
            const unsigned tg = og / nx;
            if (og + 1u == (tg + 1u) * nx) xb_add(&bar[XB_TOPGEN], 1u);
            else XB_SPIN(xb_ld(&bar[XB_TOPGEN]) == tg, bar);
            __builtin_amdgcn_fence(__ATOMIC_ACQUIRE, "agent");
            xb_add(&bar[XB_XGEN(b.x)], 1u);
            asm volatile("s_waitcnt vmcnt(0)" ::: "memory");
        } else {
            XB_SPIN(xb_ld(&bar[XB_XGEN(b.x)]) == gen, bar);
            __builtin_amdgcn_fence(__ATOMIC_ACQUIRE, "agent");
            asm volatile("s_waitcnt vmcnt(0)" ::: "memory");
        }
    }
    __syncthreads();
}

struct Args { const void* in[24]; float* out; unsigned char* ws; int lo, hi; };

__host__ __device__ constexpr int mixer_inner_phases(int kind) { return kind == 0 ? 4 : (kind == 1 ? 1 : 4); }
__host__ __device__ constexpr int total_phases() { int n = 1; for (int L = 0; L < DEPTH; ++L) n += 6 + 3 + mixer_inner_phases(L % 3); return n; }

__global__ void __launch_bounds__(512, 2) mega(Args args) {
    extern __shared__ __attribute__((aligned(16))) unsigned char lds[];
    cg::grid_group grid = cg::this_grid();
    volatile LAS unsigned* bst = (volatile LAS unsigned*)((LAS unsigned char*)lds + (LDS_BYTES - 64));
    if (threadIdx.x < 2) bst[threadIdx.x] = 0u;
    __syncthreads();
    const XcdBarrier xbar = xcd_barrier_post((unsigned*)args.ws, bst);
    bool again = false;
    for (int ph = args.lo; ph < args.hi; ++ph) {
        int type = 0, s = 0, L = 0;
        if (ph > 0) {
            int p = ph - 1;
            for (L = 0; L < DEPTH; ++L) { const int n = 9 + mixer_inner_phases(L % 3); if (p < n) break; p -= n; }
            const int inner = mixer_inner_phases(L % 3), kind = L % 3;
            if (p < 3) { type = 1 + p; s = 2 * L; }
            else if (p == 3) type = 4;
            else if (p == 4) type = 5;
            else if (p < 5 + inner) { const int q = p - 5; type = kind == 0 ? (q == 0 ? 14 : (q == 1 ? 15 : 4 + q)) : (kind == 1 ? 8 : 9 + q); }
            else if (p == 5 + inner) type = 13;
            else { type = 1 + (p - 6 - inner); s = 2 * L + 1; }
        }
        int tid_ = threadIdx.x; asm volatile("" : "+v"(tid_));
        int G_ = gridDim.x, bx_ = blockIdx.x; asm volatile("" : "+s"(G_), "+s"(bx_));
        const int tid = tid_, lane = tid & 63, wid = __builtin_amdgcn_readfirstlane(tid >> 6);
        const int G = G_, bx = bx_;
        const int vcu = (G % 8 == 0) ? (bx % 8) * (G / 8) + bx / 8 : bx;
        const int gw = vcu * 8 + wid, NGW = G * 8;
        unsigned char* ws = args.ws; asm volatile("" : "+s"(ws));
        PG8_LAS unsigned char* ldsl = (PG8_LAS unsigned char*)lds;
        float* hout = args.out; asm volatile("" : "+s"(hout));
        bf16* HN = (bf16*)(ws + WS_HN);
        bf16* RB = (bf16*)(ws + WS_R);
        f32x2* tab = (f32x2*)(ws + WS_TAB);
        const int kind = L % 3, jj = L / 3;
        bf16* QN = RB + (size_t)T * 2560;
        bf16* KSb = QN + (size_t)T * 1024;
        bf16* KWb = KSb + (size_t)T * 256;
        bf16* KCH = (bf16*)(ws + WS_O32);
        bf16* VCH = KCH + (size_t)T * 256;
        float* Pk = (float*)(ws + WS_O32 + 32 * MiB);
        float* Pv = Pk + (size_t)8192 * 512;
        bf16* KC = (bf16*)(ws + WS_O32 + 64 * MiB);
        bf16* VC = (bf16*)(ws + WS_O32 + 65 * MiB);
        bf16* OVT = (bf16*)(ws + WS_BP + 65536);
        bf16* VST = (bf16*)(ws + WS_O32 + 68 * MiB);
        bf16* VWT = (bf16*)(ws + WS_O32 + 84 * MiB);
        switch (type) {
        case 0: {
            float* scr = (float*)lds + wid * (64 * 33);
            for (int mi = 0; mi < 28; ++mi) {
                const float* W; int K, N, Npad, mode = 0; bf16* WT;
                if (mi < 8)       { W = (const float*)args.in[3] + (size_t)mi * D * 2 * FF; K = D; N = 2 * FF; Npad = N; mode = 1; WT = (bf16*)(ws + WS_WGU) + (size_t)mi * 2 * FF * D; }
                else if (mi < 16) { const int i = mi - 8; W = (const float*)args.in[4] + (size_t)i * FF * D; K = FF; N = D; Npad = N; WT = (bf16*)(ws + WS_WDN) + (size_t)i * D * FF; }
                else if (mi < 18) { const int i = mi - 16; W = (const float*)args.in[6] + (size_t)i * D * 4112; K = D; N = 4112; Npad = GDN_NPAD; WT = (bf16*)(ws + WS_WGI) + (size_t)i * GDN_NPAD * D; }
                else if (mi < 20) { const int i = mi - 18; W = (const float*)args.in[11] + (size_t)i * D * D; K = D; N = D; Npad = N; WT = (bf16*)(ws + WS_WGO) + (size_t)i * D * D; }
                else if (mi == 20) { W = (const float*)args.in[12]; K = D; N = 3072; Npad = N; WT = (bf16*)(ws + WS_WSI); }
                else if (mi == 21) { W = (const float*)args.in[14]; K = D; N = D; Npad = N; WT = (bf16*)(ws + WS_WSO); }
                else if (mi == 22) { W = (const float*)args.in[15]; K = D; N = 2608; Npad = NSA_NPAD; WT = (bf16*)(ws + WS_WNI); }
                else if (mi == 23) { W = (const float*)args.in[23]; K = D; N = D; Npad = N; WT = (bf16*)(ws + WS_WNO); }
                else { const int i = mi - 24, kd = i >> 1, hf = i & 1;
                    W = (const float*)args.in[19] + (size_t)kd * 2048 * 256 + (size_t)hf * 1024 * 256; K = 1024; N = 256; Npad = 256; WT = (bf16*)(ws + WS_WC1) + (size_t)kd * 512 * 1024 + (size_t)hf * 256 * 1024; }
                xpose_matrix(W, K, N, Npad, WT, mode, scr, gw, NGW, lane);
            }
            const int* positions = (const int*)args.in[1];
            for (int idx = bx * 512 + tid; idx < T * 32; idx += G * 512) {
                const int tk = idx >> 5, i = idx & 31;
                const float inv = 1.0f / exp2f((float)(2 * i) * (13.287712379549449f / 64.f));
                const float ang = (float)positions[tk] * inv;
                const double rev = (double)ang * 0.15915494309189535;
                const float fr = (float)(rev - rint(rev));
                f32x2 v; v.x = __builtin_amdgcn_cosf(fr); v.y = __builtin_amdgcn_sinf(fr);
                tab[idx] = v;
            }
            for (int idx = bx * 512 + tid; idx < 64 * 256; idx += G * 512) {
                const int sj = idx >> 8, i = idx & 255, q = i >> 2, rem = i & 3;
                OVT[idx] = (bf16)(rem < 3 ? (q == sj ? 0x3F80 : 0) : ((q == sj || q + 1 == sj) ? 0x3F00 : 0));
            }
            if (bx < 2 && tid < 256) {
                const float* pe = (const float*)args.in[18] + (size_t)bx * 2048;
                const float* w1 = (const float*)args.in[19] + (size_t)bx * 2048 * 256 + tid;
                float acc = ((const float*)args.in[20])[bx * 256 + tid];
                for (int k = 0; k < 2048; ++k) acc += pe[k] * w1[(size_t)k * 256];
                ((float*)(ws + WS_BP))[bx * 256 + tid] = acc;
            }
        } break;
        case 1: phase_norm(s == 0 ? (const float*)args.in[0] : hout, (const float*)args.in[2] + (size_t)s * D, HN, gw, NGW, lane); break;
        case 2: {
            pg8::Gemm g{HN, (const bf16*)(ws + WS_WGU) + (size_t)s * 2 * FF * D, T, 2 * FF, D}; pg8::StaticOrder SO; SO.init(T, 2 * FF, G, bx);
            pg8::EpiSwiGLU E{RB};
            pg8::gemm_phase<pg8::EpiSwiGLU, pg8::StaticOrder, true, true>(ldsl, g, SO, E, tid); } break;
        case 3: {
            pg8::Gemm g{RB, (const bf16*)(ws + WS_WDN) + (size_t)s * D * FF, T, D, FF}; pg8::StaticOrder SO; SO.init(T, D, G, bx);
#if defined(REP_TYPE)
            const float sc3 = (REP_TYPE == 3 && !again) ? 0.f : 0.5f;
#else
            const float sc3 = 0.5f;
#endif
            pg8::EpiResid E{s == 0 ? (const float*)args.in[0] : hout, hout, sc3};
            pg8::gemm_phase<pg8::EpiResid, pg8::StaticOrder, true, true>(ldsl, g, SO, E, tid); } break;
        case 4: phase_norm(hout, (const float*)args.in[5] + (size_t)L * D, HN, gw, NGW, lane); break;
        case 5: {
            const bf16* Wt; int Np, ldc, nmain, ldt, nvalid; float* tail;
            if (kind == 0) { Wt = (const bf16*)(ws + WS_WGI) + (size_t)jj * GDN_NPAD * D; Np = GDN_NPAD; ldc = 4096; nmain = 4096; tail = (float*)(ws + WS_AB); ldt = 16; nvalid = 4112; }
            else if (kind == 1) { Wt = (const bf16*)(ws + WS_WSI); Np = 3072; ldc = 3072; nmain = 3072; tail = (float*)(ws + WS_AB); ldt = 16; nvalid = 3072; }
            else { Wt = (const bf16*)(ws + WS_WNI); Np = NSA_NPAD; ldc = 2560; nmain = 2560; tail = (float*)(ws + WS_GT); ldt = 48; nvalid = 2608; }
            pg8::Gemm g{HN, Wt, T, Np, D}; pg8::StaticOrder SO; SO.init(T, Np, G, bx);
            pg8::EpiProj E{RB, ldc, nmain, tail, ldt, nvalid};
            pg8::gemm_phase<pg8::EpiProj, pg8::StaticOrder, true, true>(ldsl, g, SO, E, tid); } break;
        case 14: phase_gdn_halo(RB, (bf16*)(ws + WS_HALO), vcu * 512 + tid, G * 512); break;
        case 15: phase_gdn_prep(lds, RB, (const bf16*)(ws + WS_HALO), (const float*)(ws + WS_AB), (const float*)args.in[7] + (size_t)jj * 4 * 3072, (const float*)args.in[8] + jj * 8, (const float*)args.in[9] + jj * 8,
                                HN, (bf16*)(ws + WS_O32 + 64 * MiB), (float*)(ws + WS_GL), bx, G, tid, wid, lane); break;
        case 6:
#ifndef DIS_SCAN
            phase_gdn_scan2(lds, RB, HN, (const bf16*)(ws + WS_O32 + 64 * MiB), (const float*)(ws + WS_GL), (bf16*)(ws + WS_O32), bx, G, tid, wid, lane);
#endif
            break;
        case 7:
#ifndef DIS_GPOST
            phase_gdn_post((const bf16*)(ws + WS_O32), RB, (const float*)args.in[10] + jj * 128, HN, gw, NGW, lane);
#endif
            break;
        case 8:
#ifndef DIS_SPOST
            phase_sc_post(RB, (const float*)args.in[13], HN, vcu * 512 + tid, G * 512);
#endif
            break;
        case 9:
#ifndef DIS_NPOST
            phase_nsa_post(lds, RB, (const float*)args.in[16], (const float*)args.in[17], tab, QN, KSb, KWb, KCH, VCH, VST, VWT, gw, NGW, wid, lane);
#endif
            break;
        case 10: {
            pg8::Gemm g{KCH, (const bf16*)(ws + WS_WC1), 8192, 512, 1024}; pg8::StaticOrder SO; SO.init(8192, 512, G, bx);
            pg8::Gemm g2{VCH, (const bf16*)(ws + WS_WC1) + (size_t)512 * 1024, 8192, 512, 1024};
            pg8::EpiF32 E{Pk, 512};
            if (bx >= G / 2) { g = g2; SO.init(8192, 512, G, bx - G / 2); E.C = Pv; }
            pg8::gemm_phase<pg8::EpiF32, pg8::StaticOrder, true, true>(ldsl, g, SO, E, tid); } break;
        case 11:
#ifndef DIS_CMP2
            phase_cmp2(lds, Pk, Pv, (const float*)(ws + WS_BP), (const float*)args.in[21], (const float*)args.in[22], (const float*)args.in[17], KC, VC, gw, NGW, wid, lane);
#endif
            break;
        case 12:
#ifndef DIS_ATTN
            phase_nsa_attn(lds, QN, KSb, KWb, VST, VWT, KC, VC, OVT, (const float*)(ws + WS_GT), tab, HN, bx, G, tid, wid, lane);
#endif
            break;
        default: {
            const bf16* Wout = kind == 0 ? (const bf16*)(ws + WS_WGO) + (size_t)jj * D * D : (kind == 1 ? (const bf16*)(ws + WS_WSO) : (const bf16*)(ws + WS_WNO));
            pg8::Gemm g{HN, Wout, T, D, D}; pg8::StaticOrder SO; SO.init(T, D, G, bx);
#if defined(REP_TYPE)
            const float sc13 = (REP_TYPE == 13 && !again) ? 0.f : 1.f;
#else
            const float sc13 = 1.f;
#endif
            pg8::EpiResid E{hout, hout, sc13};
            pg8::gemm_phase<pg8::EpiResid, pg8::StaticOrder, true, true>(ldsl, g, SO, E, tid); } break;
        }
#ifdef REP_TYPE
        if (type == REP_TYPE && !again) { again = true; xcd_barrier(xbar); --ph; continue; }
        again = false;
#endif
        if (ph + 1 < args.hi) { if (ph == 0) grid.sync(); else xcd_barrier(xbar); }
    }
}

extern "C" void kernel_launch(void* const* d_in, const int* in_sizes, int n_in, void* d_out, int out_size, void* d_ws, size_t ws_size, hipStream_t stream) {
    static int grid = 0;
    if (grid == 0) {
        if (n_in != 24 || out_size != T * D || ws_size < WS_END2) { fprintf(stderr, "kernel_launch: unexpected shapes n_in %d out %d ws %zu (need %zu)\n", n_in, out_size, ws_size, (size_t)WS_END2); grid = -1; return; }
        int dev = 0, cus = 0, per_cu = 0;
        hipGetDevice(&dev); hipDeviceGetAttribute(&cus, hipDeviceAttributeMultiprocessorCount, dev);
        if (hipFuncSetAttribute((const void*)mega, hipFuncAttributeMaxDynamicSharedMemorySize, LDS_BYTES) != hipSuccess) { fprintf(stderr, "kernel_launch: hipFuncSetAttribute failed\n"); grid = -1; return; }
        if (hipOccupancyMaxActiveBlocksPerMultiprocessor(&per_cu, (const void*)mega, 512, LDS_BYTES) != hipSuccess || per_cu < 1) { fprintf(stderr, "kernel_launch: occupancy query says %d\n", per_cu); per_cu = 1; }
        (void)hipGetLastError();
        grid = cus;
    }
    if (grid < 0) return;
    Args a{};
    for (int i = 0; i < 24; ++i) a.in[i] = d_in[i];
    a.out = (float*)d_out; a.ws = (unsigned char*)d_ws;
    constexpr int NPH = total_phases();
#if MK_MULTI
    for (int p = 0; p < NPH; ++p) { a.lo = p; a.hi = p + 1; hipLaunchKernelGGL(mega, dim3(grid), dim3(512), LDS_BYTES, stream, a); }
#else
    a.lo = 0; a.hi = NPH;
    (void)hipMemsetAsync(d_ws, 0, 16384, stream);
    void* kargs[] = {&a};
    hipError_t e = hipLaunchCooperativeKernel((const void*)mega, dim3(grid), dim3(512), kargs, LDS_BYTES, stream);
    if (e != hipSuccess) fprintf(stderr, "cooperative launch failed: %s (grid %d)\n", hipGetErrorString(e), grid);
#endif
}
```

```cpp
#include <hip/hip_runtime.h>
#include <hip/hip_cooperative_groups.h>
#include <cstdio>
#include <cstdint>
namespace cg = cooperative_groups;
namespace pg8 {
#define PG8_LAS __attribute__((address_space(3)))
typedef unsigned short bf16_t;
typedef short bf16x8 __attribute__((ext_vector_type(8)));
typedef float f32x4 __attribute__((ext_vector_type(4)));
typedef unsigned u32x4 __attribute__((ext_vector_type(4)));
constexpr int BM = 256, BK = 64, HALF = 128, HTB = HALF * BK * 2  , STAGE_BYTES = 8 * HTB, NXCD = 8, WGM = 8;

__host__ __device__ __forceinline__ int lds_byte(int r, int c) { const int st = (r >> 4) * 2 + (c >> 5), rr = r & 15, cc = c & 31, ob = rr * 64 + cc * 2; return st * 1024 + (ob ^ (((ob >> 9) & 1) << 5)); }
__host__ __device__ __forceinline__ void stage_rc(int b, int& R, int& C) { const int st = b / 1024, sb = b % 1024, swz = sb ^ (((sb >> 9) & 1) << 5); R = (st >> 1) * 16 + swz / 64; C = (st & 1) * 32 + (swz % 64) / 2; }
__host__ __device__ __forceinline__ int perm32(int rho) { const int n = rho >> 4, i = rho & 15; return 8 * (i >> 2) + 4 * n + (i & 3); }

struct Unit { int pm, pn, ord; };
struct Gemm { const bf16_t* A; const bf16_t* Bt; int M, N, K; };

struct StaticOrder {
    int nM, nN, nwg, G, c;
    __host__ __device__ void init(int M, int N, int G_, int c_) { nM = M / BM; nN = N / BM; nwg = nM * nN; G = G_; c = c_; }
    __host__ __device__ bool next(int i, Unit& u) const {
        const long L = (long)i * G + c; if (L >= nwg) return false;
        int wgid = (int)L; { const int q = nwg / NXCD, r = nwg % NXCD, xcd = wgid % NXCD, off = wgid / NXCD; wgid = (xcd < r ? xcd * (q + 1) : r * (q + 1) + (xcd - r) * q) + off; }
        const int nig = WGM * nN, gid = wgid / nig, fm = gid * WGM, gsz = (nM - fm) < WGM ? (nM - fm) : WGM;
        u.pm = fm + ((wgid % nig) % gsz); u.pn = (wgid % nig) / gsz; u.ord = i; return true;
    }
    __device__ __forceinline__ void a_ready(const Unit&) const {}
    __device__ __forceinline__ void done(const Unit&) const {}
};
__device__ __forceinline__ unsigned cvt_pk_bf16(float lo, float hi) { unsigned r; asm volatile("v_cvt_pk_bf16_f32 %0, %1, %2" : "=v"(r) : "v"(lo), "v"(hi)); return r; }
template <class Epi, class Sched, bool ALIGN_EPI = false, bool SP2 = false>
__device__ __forceinline__ void gemm_phase(PG8_LAS unsigned char* lds, const Gemm g, const Sched& S, const Epi& E, const int tid) {
    const int wid = __builtin_amdgcn_readfirstlane(tid >> 6), lane = tid & 63, wr = wid >> 2, wc = wid & 3, fr = lane & 15, fq = lane >> 4;
    const int K = g.K, nt = K / BK;
    unsigned voffA[2], voffB[2];
#pragma unroll
    for (int i = 0; i < 2; ++i) { int R, C; stage_rc(tid * 16 + i * 8192, R, C); const int Rb = Epi::PERM ? ((R & ~31) + perm32(R & 31)) : R;
        voffA[i] = (unsigned)(R * K + C) * 2u; voffB[i] = (unsigned)(Rb * K + C) * 2u; }
    const size_t kstep = (size_t)(BK * 2);
    const size_t hstep = (size_t)HALF * K * 2;
    const size_t tstep = 2 * hstep;
    const unsigned ldsw = (unsigned)wid * 1024u;
    const int aoff = lds_byte(wr * 64 + fr, fq * 8), boff = lds_byte(wc * 32 + fr, fq * 8);
#define PG8_SA(b, h) (((b) * 2 + (h)) * HTB)
#define PG8_SB(b, h) ((4 + (b) * 2 + (h)) * HTB)
#define PG8_STAGE(bufoff, gbase, voff) do { _Pragma("unroll") for (int _i = 0; _i < 2; ++_i) \
        __builtin_amdgcn_global_load_lds((const unsigned*)((const char*)(gbase) + (voff)[_i]), (PG8_LAS unsigned*)(lds + (bufoff) + ldsw + _i * 8192), 16, 0, 0); } while (0)
#define PG8_LDA(dst, b, h) do { _Pragma("unroll") for (int m = 0; m < 4; ++m) _Pragma("unroll") for (int k = 0; k < 2; ++k) dst[m][k] = *(const PG8_LAS bf16x8*)(lds + PG8_SA(b, h) + aoff + m * 2048 + k * 1024); } while (0)
#define PG8_LDB(dst, b, h) do { _Pragma("unroll") for (int n = 0; n < 2; ++n) _Pragma("unroll") for (int k = 0; k < 2; ++k) dst[n][k] = *(const PG8_LAS bf16x8*)(lds + PG8_SB(b, h) + boff + n * 2048 + k * 1024); } while (0)
#define PG8_MMA(ai, bj, At, Bt) do { __builtin_amdgcn_s_setprio(1); _Pragma("unroll") for (int m = 0; m < 4; ++m) _Pragma("unroll") for (int n = 0; n < 2; ++n) _Pragma("unroll") for (int k = 0; k < 2; ++k) \
        acc[ai][bj][m][n] = __builtin_amdgcn_mfma_f32_16x16x32_bf16(Bt[n][k], At[m][k], acc[ai][bj][m][n], 0, 0, 0); __builtin_amdgcn_s_setprio(0); } while (0)
#define PG8_WAIT_V(n) asm volatile("s_waitcnt vmcnt(" #n ")" ::: "memory")
#define PG8_WAIT_L(n) asm volatile("s_waitcnt lgkmcnt(" #n ")" ::: "memory")
#define PG8_BAR __builtin_amdgcn_s_barrier()
#define PG8_SCHED __builtin_amdgcn_sched_barrier(0)
    Unit cur, nxt; int ui = 0;
    if (!S.next(0, cur)) return;
    f32x4 acc[2][2][4][2];
#pragma unroll
    for (int a = 0; a < 2; ++a)
#pragma unroll
        for (int b = 0; b < 2; ++b)
#pragma unroll
            for (int m = 0; m < 4; ++m)
#pragma unroll
                for (int n = 0; n < 2; ++n) acc[a][b][m][n] = (f32x4){0.f, 0.f, 0.f, 0.f};
    bf16x8 At[4][2], B0[2][2], B1[2][2];
    const char* cA = (const char*)g.A + (size_t)cur.pm * tstep; const char* cB = (const char*)g.Bt + (size_t)cur.pn * tstep;
    S.a_ready(cur);
    if constexpr (SP2) {
        PG8_STAGE(PG8_SB(0, 0), cB, voffB); PG8_STAGE(PG8_SB(0, 1), cB + hstep, voffB); PG8_STAGE(PG8_SA(0, 0), cA, voffA); PG8_STAGE(PG8_SA(0, 1), cA + hstep, voffA);
        if (wr == 1) PG8_BAR;
        PG8_WAIT_V(2); PG8_BAR;
        PG8_STAGE(PG8_SB(1, 0), cB + kstep, voffB); PG8_STAGE(PG8_SA(1, 0), cA + kstep, voffA); PG8_STAGE(PG8_SB(1, 1), cB + hstep + kstep, voffB);
        PG8_WAIT_V(6); PG8_BAR;
    } else {
        PG8_STAGE(PG8_SB(0, 0), cB, voffB); PG8_STAGE(PG8_SA(0, 0), cA, voffA); PG8_STAGE(PG8_SB(0, 1), cB + hstep, voffB); PG8_STAGE(PG8_SA(0, 1), cA + hstep, voffA);
        if (wr == 1) PG8_BAR;
        PG8_WAIT_V(4); PG8_BAR;
        PG8_STAGE(PG8_SB(1, 0), cB + kstep, voffB); PG8_STAGE(PG8_SA(1, 0), cA + kstep, voffA); PG8_STAGE(PG8_SB(1, 1), cB + hstep + kstep, voffB);
        PG8_WAIT_V(6); PG8_BAR;
    }
    for (;;) {
        const bool has_next = S.next(ui + 1, nxt);
        const char* nA = has_next ? (const char*)g.A + (size_t)nxt.pm * tstep : cA; const char* nB = has_next ? (const char*)g.Bt + (size_t)nxt.pn * tstep : cB;
        for (int t = 0; t < nt; t += 2) {
            const bool last = (t == nt - 2);
            const char* a1 = cA + (size_t)(t + 1) * kstep;
            const char* a2 = last ? nA : cA + (size_t)(t + 2) * kstep; const char* b2 = last ? nB : cB + (size_t)(t + 2) * kstep;
            const char* a3 = a2 + kstep; const char* b3 = b2 + kstep;
            if (last && has_next) S.a_ready(nxt);
            if constexpr (SP2) {
            PG8_LDB(B0, 0, 0); PG8_LDB(B1, 0, 1); PG8_SCHED; PG8_LDA(At, 0, 0); PG8_STAGE(PG8_SA(1, 1), a1 + hstep, voffA);
            PG8_WAIT_V(8); PG8_WAIT_L(0); PG8_BAR; PG8_MMA(0, 0, At, B0); PG8_MMA(0, 1, At, B1); PG8_BAR; PG8_SCHED;
            PG8_LDA(At, 0, 1); PG8_STAGE(PG8_SB(0, 0), b2, voffB); PG8_STAGE(PG8_SB(0, 1), b2 + hstep, voffB); PG8_STAGE(PG8_SA(0, 0), a2, voffA);
            PG8_WAIT_V(8); PG8_WAIT_L(0); PG8_BAR; PG8_MMA(1, 0, At, B0); PG8_MMA(1, 1, At, B1); PG8_BAR; PG8_SCHED;
            PG8_LDB(B0, 1, 0); PG8_LDB(B1, 1, 1); PG8_SCHED; PG8_LDA(At, 1, 0); PG8_STAGE(PG8_SA(0, 1), a2 + hstep, voffA);
            PG8_WAIT_V(8); PG8_WAIT_L(0); PG8_BAR; PG8_MMA(0, 0, At, B0); PG8_MMA(0, 1, At, B1); PG8_BAR; PG8_SCHED;
            PG8_LDA(At, 1, 1); PG8_STAGE(PG8_SB(1, 0), b3, voffB); PG8_STAGE(PG8_SB(1, 1), b3 + hstep, voffB); PG8_STAGE(PG8_SA(1, 0), a3, voffA);
            PG8_WAIT_V(8); PG8_WAIT_L(0); PG8_BAR; PG8_MMA(1, 0, At, B0); PG8_MMA(1, 1, At, B1); PG8_BAR; PG8_SCHED;
            } else {
            PG8_LDB(B0, 0, 0); PG8_SCHED; PG8_LDA(At, 0, 0); PG8_STAGE(PG8_SA(1, 1), a1 + hstep, voffA);
            PG8_WAIT_L(8); PG8_BAR; PG8_WAIT_L(0); PG8_MMA(0, 0, At, B0); PG8_BAR; PG8_SCHED;
            PG8_LDB(B1, 0, 1); PG8_STAGE(PG8_SB(0, 0), b2, voffB);
            PG8_BAR; PG8_WAIT_L(0); PG8_MMA(0, 1, At, B1); PG8_BAR;
            PG8_LDA(At, 0, 1); PG8_STAGE(PG8_SA(0, 0), a2, voffA);
            PG8_BAR; PG8_WAIT_L(0); PG8_MMA(1, 0, At, B0); PG8_BAR; PG8_SCHED;
            PG8_STAGE(PG8_SB(0, 1), b2 + hstep, voffB);
            PG8_WAIT_V(6); PG8_BAR; PG8_MMA(1, 1, At, B1); PG8_BAR;
            PG8_LDB(B0, 1, 0); PG8_SCHED; PG8_LDA(At, 1, 0); PG8_STAGE(PG8_SA(0, 1), a2 + hstep, voffA);
            PG8_WAIT_L(8); PG8_BAR; PG8_WAIT_L(0); PG8_MMA(0, 0, At, B0); PG8_BAR; PG8_SCHED;
            PG8_LDB(B1, 1, 1); PG8_STAGE(PG8_SB(1, 0), b3, voffB);
            PG8_BAR; PG8_WAIT_L(0); PG8_MMA(0, 1, At, B1); PG8_BAR;
            PG8_LDA(At, 1, 1); PG8_STAGE(PG8_SA(1, 0), a3, voffA);
            PG8_BAR; PG8_WAIT_L(0); PG8_MMA(1, 0, At, B0); PG8_BAR; PG8_SCHED;
            PG8_STAGE(PG8_SB(1, 1), b3 + hstep, voffB);
            PG8_WAIT_V(6); PG8_BAR; PG8_MMA(1, 1, At, B1); PG8_BAR;
            }
        }
        if constexpr (ALIGN_EPI) { if (wr == 0) PG8_BAR; }
        if constexpr (!Epi::AFTER_DRAIN) { E(acc, cur, wr, wc, fr, fq); S.done(cur); }
        if (!has_next) break;
#pragma unroll
        for (int a = 0; a < 2; ++a)
#pragma unroll
            for (int b = 0; b < 2; ++b)
#pragma unroll
                for (int m = 0; m < 4; ++m)
#pragma unroll
                    for (int n = 0; n < 2; ++n) acc[a][b][m][n] = (f32x4){0.f, 0.f, 0.f, 0.f};
        cur = nxt; cA = nA; cB = nB; ++ui;
        if constexpr (ALIGN_EPI) { if (wr == 1) PG8_BAR; }
    }
    PG8_WAIT_V(0);
    if constexpr (!ALIGN_EPI) { if (wr == 0) PG8_BAR; }
    PG8_BAR;
    if constexpr (Epi::AFTER_DRAIN) { E.fused(acc, cur, wr, wc, fr, fq, lds, wid, lane); S.done(cur); }
#undef PG8_SA
#undef PG8_SB
#undef PG8_STAGE
#undef PG8_LDA
#undef PG8_LDB
#undef PG8_MMA
#undef PG8_WAIT_V
#undef PG8_WAIT_L
#undef PG8_BAR
#undef PG8_SCHED
}
}

typedef unsigned short bf16;
typedef float f32x4 __attribute__((ext_vector_type(4)));
typedef float f32x2 __attribute__((ext_vector_type(2)));
typedef unsigned u32x4 __attribute__((ext_vector_type(4)));
typedef unsigned u32x2 __attribute__((ext_vector_type(2)));

#ifndef MK_MULTI
#define MK_MULTI 0
#endif

constexpr int Bn = 8, S = 4096, T = Bn * S, D = 1024, FF = 2816, DEPTH = 4;
constexpr float EPS = 1e-6f;
constexpr int GDN_NPAD = 4352, NSA_NPAD = 2816;
constexpr int LDS_BYTES = 147456;
constexpr size_t MiB = 1u << 20;
constexpr size_t WS_WGU = 1 * MiB;
constexpr size_t WS_WDN = WS_WGU + 88 * MiB;
constexpr size_t WS_WGI = WS_WDN + 44 * MiB;
constexpr size_t WS_WGO = WS_WGI + 17 * MiB;
constexpr size_t WS_WSI = WS_WGO + 4 * MiB;
constexpr size_t WS_WSO = WS_WSI + 6 * MiB;
constexpr size_t WS_WNI = WS_WSO + 2 * MiB;
constexpr size_t WS_WNO = WS_WNI + 6 * MiB;
constexpr size_t WS_WC1 = WS_WNO + 2 * MiB;
constexpr size_t WS_TAB = WS_WC1 + 2 * MiB;
constexpr size_t WS_HN  = 184 * MiB;
constexpr size_t WS_R   = WS_HN + 64 * MiB;
constexpr size_t WS_O32 = WS_R + 256 * MiB;
constexpr size_t WS_SM  = WS_O32 + 128 * MiB;
constexpr size_t WS_AB  = WS_SM;
constexpr size_t WS_GT  = WS_SM + 2 * MiB;
constexpr size_t WS_BP  = WS_SM + 8 * MiB;
constexpr size_t WS_END = WS_SM + 9 * MiB;
static_assert(WS_TAB + 8 * MiB <= WS_HN, "ws map");

__device__ __forceinline__ float bf2f(unsigned v) { return __uint_as_float(v << 16); }
__device__ __forceinline__ unsigned f2bf(float f) { unsigned u = __float_as_uint(f); return (u + 0x7fffu + ((u >> 16) & 1u)) >> 16; }
__device__ __forceinline__ unsigned pk2(float lo, float hi) { return f2bf(lo) | (f2bf(hi) << 16); }
#define MFMA32(a, b, c) __builtin_amdgcn_mfma_f32_32x32x16_bf16((a), (b), (c), 0, 0, 0)
typedef short bf16x8v __attribute__((ext_vector_type(8)));
typedef float f32x16 __attribute__((ext_vector_type(16)));
typedef __bf16 bf16v2 __attribute__((ext_vector_type(2)));
__device__ __forceinline__ unsigned pkbf(float a, float b) { f32x2 v = {a, b}; return __builtin_bit_cast(unsigned, __builtin_convertvector(v, bf16v2)); }
__device__ __forceinline__ int lane_opq() { int l = (int)__builtin_amdgcn_mbcnt_hi(~0u, __builtin_amdgcn_mbcnt_lo(~0u, 0u)); asm volatile("" : "+v"(l)); return l; }
__device__ __forceinline__ float xshfl(float v, int m) { return __int_as_float(__builtin_amdgcn_ds_bpermute((lane_opq() ^ m) << 2, __float_as_int(v))); }
__device__ __forceinline__ float xshfl_up(float v, int o) { return __int_as_float(__builtin_amdgcn_ds_bpermute((lane_opq() - o) << 2, __float_as_int(v))); }
__device__ __forceinline__ float wave_sum(float v) {
#pragma unroll
    for (int o = 1; o < 64; o <<= 1) v += xshfl(v, o);
    return v;
}
__device__ __forceinline__ float wave_max(float v) {
#pragma unroll
    for (int o = 1; o < 64; o <<= 1) v = fmaxf(v, xshfl(v, o));
    return v;
}
__device__ __forceinline__ float row_sum16(float v) {
    v += __uint_as_float((unsigned)__builtin_amdgcn_update_dpp(0, (int)__float_as_uint(v), 0x128, 0xf, 0xf, false));
    v += __uint_as_float((unsigned)__builtin_amdgcn_update_dpp(0, (int)__float_as_uint(v), 0x124, 0xf, 0xf, false));
    v += __uint_as_float((unsigned)__builtin_amdgcn_update_dpp(0, (int)__float_as_uint(v), 0x122, 0xf, 0xf, false));
    v += __uint_as_float((unsigned)__builtin_amdgcn_update_dpp(0, (int)__float_as_uint(v), 0x121, 0xf, 0xf, false));
    return v;
}
__device__ __forceinline__ float sigmoidf_(float x) { return 1.f / (1.f + __expf(-x)); }
__device__ __forceinline__ float siluf_(float x) { return x * __builtin_amdgcn_rcpf(1.f + __expf(-x)); }
#define WAVE_SYNC() do { asm volatile("s_waitcnt lgkmcnt(0)" ::: "memory"); __builtin_amdgcn_wave_barrier(); } while (0)

__device__ __forceinline__ float row_rstd(const float* ssq, size_t row) {
    const f32x4* p = (const f32x4*)(ssq + row * 16); const f32x4 a = p[0], b = p[1], c = p[2], d = p[3];
    const float t = ((a.x + a.y) + (a.z + a.w)) + ((b.x + b.y) + (b.z + b.w)) + ((c.x + c.y) + (c.z + c.w)) + ((d.x + d.y) + (d.z + d.w));
    return 1.f / sqrtf(t * (1.f / D) + EPS);
}
namespace pg8 {
struct EpiSwiGLU {
    static constexpr bool PERM = true, AFTER_DRAIN = false;
    bf16_t* O; const float* ssq;
    __device__ __forceinline__ void operator()(const f32x4 (&acc)[2][2][4][2], const Unit& u, int wr, int wc, int fr, int fq) const {
        const int row0 = u.pm * BM + wr * 64 + fr, col0 = u.pn * HALF + wc * 32 + 8 * fq;
#pragma unroll
        for (int ai = 0; ai < 2; ++ai)
#pragma unroll
            for (int m = 0; m < 4; ++m) {
                bf16_t* rowp = O + (size_t)(row0 + ai * HALF + m * 16) * FF + col0;
                const float rs = ssq[u.ord * 256 + wr * 64 + fr + ai * HALF + m * 16];
                float v[8];
#pragma unroll
                for (int n = 0; n < 2; ++n)
#pragma unroll
                    for (int j = 0; j < 4; ++j) { const float g = acc[ai][0][m][n][j] * rs, uu = acc[ai][1][m][n][j] * rs; v[n * 4 + j] = g * __builtin_amdgcn_rcpf(1.f + __expf(-g)) * uu; }
                u32x4 w; w.x = cvt_pk_bf16(v[0], v[1]); w.y = cvt_pk_bf16(v[2], v[3]); w.z = cvt_pk_bf16(v[4], v[5]); w.w = cvt_pk_bf16(v[6], v[7]);
                *(u32x4*)rowp = w;
            }
    }
};
template <int SC2> struct EpiResid {
    static constexpr bool PERM = true, AFTER_DRAIN = false;
    const float* base; float* out; bf16_t* HB; float* ssq;
    __device__ __forceinline__ void operator()(const f32x4 (&acc)[2][2][4][2], const Unit& u, int wr, int wc, int fr, int fq) const {
        constexpr float scale = 0.5f * SC2;
        const int row0 = u.pm * BM + wr * 64 + fr, col0 = u.pn * BM + wc * 32 + 8 * fq;
#pragma unroll
        for (int ai = 0; ai < 2; ++ai)
#pragma unroll
            for (int m = 0; m < 4; ++m) {
                const size_t off = (size_t)(row0 + ai * HALF + m * 16) * D + col0;
                float sq = 0.f;
#pragma unroll
                for (int bj = 0; bj < 2; ++bj) {
                    const f32x4 b0 = *(const f32x4*)(base + off + bj * HALF), b1 = *(const f32x4*)(base + off + bj * HALF + 4);
                    const f32x4 o0 = b0 + acc[ai][bj][m][0] * scale, o1 = b1 + acc[ai][bj][m][1] * scale;
                    *(f32x4*)(out + off + bj * HALF) = o0; *(f32x4*)(out + off + bj * HALF + 4) = o1;
                    { u32x4 w; w.x = cvt_pk_bf16(o0[0], o0[1]); w.y = cvt_pk_bf16(o0[2], o0[3]); w.z = cvt_pk_bf16(o1[0], o1[1]); w.w = cvt_pk_bf16(o1[2], o1[3]);
                        *(u32x4*)(HB + off + bj * HALF) = w;
                        sq += ((o0[0] * o0[0] + o0[1] * o0[1]) + (o0[2] * o0[2] + o0[3] * o0[3])) + ((o1[0] * o1[0] + o1[1] * o1[1]) + (o1[2] * o1[2] + o1[3] * o1[3])); }
                }
                { sq += xshfl(sq, 16); sq += xshfl(sq, 32); if (fq == 0) ssq[(size_t)(row0 + ai * HALF + m * 16) * 16 + u.pn * 4 + wc] = sq; }
                if (m == 3) asm volatile("" ::: "memory");
            }
    }
};
struct EpiProj {
    static constexpr bool PERM = true, AFTER_DRAIN = false;
    bf16_t* O; int ldc; int nmain; float* tail; int ldt; int nvalid; const float* ssq;
    __device__ __forceinline__ void operator()(const f32x4 (&acc)[2][2][4][2], const Unit& u, int wr, int wc, int fr, int fq) const {
        const int row0 = u.pm * BM + wr * 64 + fr, colt = u.pn * BM, col0 = colt + wc * 32 + 8 * fq;
        if (colt + BM <= nmain) {
#pragma unroll
            for (int ai = 0; ai < 2; ++ai)
#pragma unroll
                for (int m = 0; m < 4; ++m) {
                    bf16_t* rowp = O + (size_t)(row0 + ai * HALF + m * 16) * ldc + col0;
                    const float rs = ssq[u.ord * 256 + wr * 64 + fr + ai * HALF + m * 16];
#pragma unroll
                    for (int bj = 0; bj < 2; ++bj) { const f32x4 v0 = acc[ai][bj][m][0] * rs, v1 = acc[ai][bj][m][1] * rs;
                        u32x4 w; w.x = cvt_pk_bf16(v0[0], v0[1]); w.y = cvt_pk_bf16(v0[2], v0[3]); w.z = cvt_pk_bf16(v1[0], v1[1]); w.w = cvt_pk_bf16(v1[2], v1[3]);
                        *(u32x4*)(rowp + bj * HALF) = w; }
                }
        } else {
#pragma unroll
            for (int ai = 0; ai < 2; ++ai)
#pragma unroll
                for (int m = 0; m < 4; ++m) {
                    const size_t row = (size_t)(row0 + ai * HALF + m * 16);
                    const float rs = ssq[u.ord * 256 + wr * 64 + fr + ai * HALF + m * 16];
#pragma unroll
                    for (int bj = 0; bj < 2; ++bj)
#pragma unroll
                        for (int n = 0; n < 2; ++n)
#pragma unroll
                            for (int j = 0; j < 4; ++j) { const int col = col0 + bj * HALF + 4 * n + j; if (col >= nmain && col < nvalid) tail[row * ldt + (col - nmain)] = acc[ai][bj][m][n][j] * rs; }
                }
        }
    }
};
struct EpiF32 {
    static constexpr bool PERM = false, AFTER_DRAIN = false;
    float* C; int ldc;
    __device__ __forceinline__ void operator()(const f32x4 (&acc)[2][2][4][2], const Unit& u, int wr, int wc, int fr, int fq) const {
        const int row0 = u.pm * BM + wr * 64 + fr, col0 = u.pn * BM + wc * 32 + 4 * fq;
#pragma unroll
        for (int ai = 0; ai < 2; ++ai)
#pragma unroll
            for (int m = 0; m < 4; ++m) {
                float* rowp = C + (size_t)(row0 + ai * HALF + m * 16) * ldc + col0;
#pragma unroll
                for (int bj = 0; bj < 2; ++bj)
#pragma unroll
                    for (int n = 0; n < 2; ++n) *(f32x4*)(rowp + bj * HALF + n * 16) = acc[ai][bj][m][n];
            }
    }
};
}

template <class Sched>
__device__ __forceinline__ void rstd_table(float* tab, const float* ssq, const Sched& SO, int tid) {
    pg8::Unit u;
    int nu = 0; while (SO.next(nu, u)) ++nu;
    for (int k0 = 0; k0 < nu * 256; k0 += 512 * 3) {
        float t3[3];
#pragma unroll
        for (int k = 0; k < 3; ++k) { const int idx = k0 + 512 * k + tid; t3[k] = 0.f; if (idx < nu * 256) { SO.next(idx >> 8, u); t3[k] = row_rstd(ssq, (size_t)u.pm * 256 + (idx & 255)); } }
#pragma unroll
        for (int k = 0; k < 3; ++k) { const int idx = k0 + 512 * k + tid; if (idx < nu * 256) tab[idx] = t3[k]; }
    }
    __syncthreads();
}
__device__ __forceinline__ void xpose_item(const float* W, const float* nw, int K, int N, bf16* WT, int rowbase, float* scr, int k0, int n0, int lane) {
    if (n0 + 32 <= N && (N & 3) == 0) {
        f32x4 v[8];
#pragma unroll
        for (int i = 0; i < 8; ++i) { v[i] = *(const f32x4*)(W + (size_t)(k0 + 8 * i + (lane >> 3)) * N + n0 + 4 * (lane & 7)); if (nw) v[i] *= nw[k0 + 8 * i + (lane >> 3)]; }
#pragma unroll
        for (int i = 0; i < 8; ++i) { float* d = scr + (8 * i + (lane >> 3)) * 33 + 4 * (lane & 7); d[0] = v[i].x; d[1] = v[i].y; d[2] = v[i].z; d[3] = v[i].w; }
    } else {
#pragma unroll 8
        for (int i = 0; i < 32; ++i) { const int kk = 2 * i + (lane >> 5), n = n0 + (lane & 31); scr[kk * 33 + (lane & 31)] = n < N ? W[(size_t)(k0 + kk) * N + n] * (nw ? nw[k0 + kk] : 1.f) : 0.f; }
    }
    WAVE_SYNC();
    const int c = lane & 7;
#pragma unroll
    for (int j = 0; j < 4; ++j) { const int n = (lane >> 3) + 8 * j; const float* s = scr + (8 * c) * 33 + n;
        u32x4 o; o.x = pk2(s[0 * 33], s[1 * 33]); o.y = pk2(s[2 * 33], s[3 * 33]); o.z = pk2(s[4 * 33], s[5 * 33]); o.w = pk2(s[6 * 33], s[7 * 33]);
        *(u32x4*)(WT + (size_t)(rowbase + n) * K + k0 + 8 * c) = o; }
    WAVE_SYNC();
}
__device__ __forceinline__ void xpose_matrix(const float* W, const float* nw, int K, int N, int Npad, bf16* WT, int mode, float* scr, int gw, int NGW, int lane) {
    const int nblk = Npad / 32, nitems = (K / 64) * nblk;
    for (int it = gw; it < nitems; it += NGW) {
        const int kb = it / nblk, nb = it - kb * nblk, n0 = nb * 32;
        int rb = n0;
        if (mode == 1) rb = (n0 < FF) ? ((n0 >> 7) * 256 + (n0 & 127)) : ((((n0 - FF) >> 7) * 256) + 128 + ((n0 - FF) & 127));
        xpose_item(W, nw, K, N, WT, rb, scr, kb * 64, n0, lane);
    }
}

__device__ __forceinline__ void phase_norm(const float* h, const float* w, bf16* out, int gw, int NGW, int lane) {
    f32x4 wv[4];
#pragma unroll
    for (int j = 0; j < 4; ++j) wv[j] = ((const f32x4*)w)[64 * j + lane];
    for (int m = gw; m < T; m += NGW) {
        const f32x4* xr = (const f32x4*)(h + (size_t)m * D) + lane;
        f32x4 v[4]; float s = 0.f;
#pragma unroll
        for (int j = 0; j < 4; ++j) { v[j] = xr[64 * j]; s += (v[j].x * v[j].x + v[j].y * v[j].y) + (v[j].z * v[j].z + v[j].w * v[j].w); }
        const float rstd = 1.f / sqrtf(wave_sum(s) * (1.f / D) + EPS);
        u32x2* o8 = (u32x2*)(out + (size_t)m * D) + lane;
#pragma unroll
        for (int j = 0; j < 4; ++j) { u32x2 o; o.x = pk2(v[j].x * rstd * wv[j].x, v[j].y * rstd * wv[j].y); o.y = pk2(v[j].z * rstd * wv[j].z, v[j].w * rstd * wv[j].w); o8[64 * j] = o; }
    }
}

__device__ __forceinline__ void phase_gdn_scan(unsigned char* lds, const bf16* proj, const float* ab, const float* convw, const float* A_log, const float* dt_bias,
                                               float* o32, int vblk, int nblk, int tid, int wid, int lane) {
    float* qs = (float*)lds;
    float* ks = qs + 64 * 128;
    float* vs = ks + 64 * 128;
    float* al = vs + 64 * 32;
    float* be = al + 64;
    float* qk = be + 64;
    float* os = qk + 64;
    bf16* raw = (bf16*)(os + 64 * 32);
    const int e = tid >> 4, dl = tid & 15;
    for (int item = vblk; item < 256; item += nblk) {
        const int bh = (item & 7) + 8 * (item >> 5), es = (item >> 3) & 3, b = bh >> 3, h = bh & 7;
        const float Ah = __expf(A_log[h]), dtb = dt_bias[h];
        const int isk = (tid >> 4) & 1, cg = tid & 15, cv = tid & 3;
        const int colqk = isk * 1024 + h * 128 + cg * 8, colv = 2048 + h * 128 + es * 32 + cv * 8;
        f32x4 wq[4][2], wv[4][2];
#pragma unroll
        for (int j = 0; j < 4; ++j) { wq[j][0] = *(const f32x4*)(convw + j * 3072 + colqk); wq[j][1] = *(const f32x4*)(convw + j * 3072 + colqk + 4);
                                      wv[j][0] = *(const f32x4*)(convw + j * 3072 + colv);  wv[j][1] = *(const f32x4*)(convw + j * 3072 + colv + 4); }
        f32x2 S2[4];
#pragma unroll
        for (int i = 0; i < 4; ++i) S2[i] = (f32x2){0.f, 0.f};
        u32x4 pre[5];
#define GDN_PREFETCH(T0) do { _Pragma("unroll") for (int k_ = 0; k_ < 5; ++k_) { const int idx_ = tid + 512 * k_; const int row_ = idx_ / 36, c_ = idx_ - row_ * 36; const int ts_ = (T0) - 3 + row_; \
            const int col_ = c_ < 16 ? h * 128 + c_ * 8 : (c_ < 32 ? 1024 + h * 128 + (c_ - 16) * 8 : 2048 + h * 128 + es * 32 + (c_ - 32) * 8); \
            pre[k_] = (u32x4){0u, 0u, 0u, 0u}; if (idx_ < 67 * 36 && ts_ >= 0) pre[k_] = *(const u32x4*)(proj + (size_t)(b * S + ts_) * 4096 + col_); } } while (0)
#define GDN_PARK() do { _Pragma("unroll") for (int k_ = 0; k_ < 5; ++k_) { const int idx_ = tid + 512 * k_; if (idx_ < 67 * 36) *(u32x4*)(raw + idx_ * 8) = pre[k_]; } } while (0)
#define GDN_CONV8(ROW0, C8, W, OUT) do { _Pragma("unroll") for (int i_ = 0; i_ < 8; ++i_) OUT[i_] = 0.f; _Pragma("unroll") for (int j_ = 0; j_ < 4; ++j_) { const u32x4 xv_ = *(const u32x4*)(raw + ((ROW0) + j_) * 288 + (C8) * 8); \
            OUT[0] += bf2f(xv_.x & 0xffffu) * W[j_][0].x; OUT[1] += bf2f(xv_.x >> 16) * W[j_][0].y; OUT[2] += bf2f(xv_.y & 0xffffu) * W[j_][0].z; OUT[3] += bf2f(xv_.y >> 16) * W[j_][0].w; \
            OUT[4] += bf2f(xv_.z & 0xffffu) * W[j_][1].x; OUT[5] += bf2f(xv_.z >> 16) * W[j_][1].y; OUT[6] += bf2f(xv_.w & 0xffffu) * W[j_][1].z; OUT[7] += bf2f(xv_.w >> 16) * W[j_][1].w; } \
            _Pragma("unroll") for (int i_ = 0; i_ < 8; ++i_) OUT[i_] = siluf_(OUT[i_]); } while (0)
#define GDN_CONVNORM(T0) do { \
            _Pragma("unroll") for (int it_ = 0; it_ < 4; ++it_) { const int tok_ = it_ * 16 + (tid >> 5); float y_[8]; GDN_CONV8(tok_, isk * 16 + cg, wq, y_); \
                float ss_ = (y_[0] * y_[0] + y_[1] * y_[1]) + (y_[2] * y_[2] + y_[3] * y_[3]) + (y_[4] * y_[4] + y_[5] * y_[5]) + (y_[6] * y_[6] + y_[7] * y_[7]); \
                ss_ = row_sum16(ss_); const float sc_ = (1.f / sqrtf(ss_ + EPS)) * (isk ? 1.f : 0.08838834764831845f); \
                float* d_ = (isk ? ks : qs) + tok_ * 128 + cg * 8; \
                _Pragma("unroll") for (int i_ = 0; i_ < 8; ++i_) y_[i_] *= sc_; \
                *(f32x4*)d_ = (f32x4){y_[0], y_[1], y_[2], y_[3]}; *(f32x4*)(d_ + 4) = (f32x4){y_[4], y_[5], y_[6], y_[7]}; \
                float dq_ = 0.f; _Pragma("unroll") for (int i_ = 0; i_ < 8; ++i_) dq_ += y_[i_] * xshfl(y_[i_], 16); \
                dq_ = row_sum16(dq_); if (isk == 0 && cg == 0) qk[tok_] = dq_; } \
            if (tid < 256) { const int tok_ = tid >> 2; float y_[8]; GDN_CONV8(tok_, 32 + cv, wv, y_); float* d_ = vs + tok_ * 32 + cv * 8; \
                *(f32x4*)d_ = (f32x4){y_[0], y_[1], y_[2], y_[3]}; *(f32x4*)(d_ + 4) = (f32x4){y_[4], y_[5], y_[6], y_[7]}; } \
            if (tid < 64) { const size_t tg_ = (size_t)(b * S + (T0) + tid); const float a_ = ab[tg_ * 16 + h] + dtb, bb_ = ab[tg_ * 16 + 8 + h]; \
                const float sp_ = a_ > 20.f ? a_ : __logf(1.f + __expf(a_)); al[tid] = __expf(-Ah * sp_); be[tid] = sigmoidf_(bb_); } } while (0)
        __syncthreads();
        GDN_PREFETCH(0); GDN_PARK();
        __syncthreads();
        GDN_CONVNORM(0);
        __syncthreads();
        for (int chunk = 0; chunk < S / 64; ++chunk) {
            const int t0 = chunk * 64;
            const bool more = chunk + 1 < S / 64;
            if (more) GDN_PREFETCH(t0 + 64);
            {
                const float* kp = ks + dl * 8; const float* qp = qs + dl * 8; const float* vp = vs + e;
                f32x4 nk0 = *(const f32x4*)kp, nk1 = *(const f32x4*)(kp + 4), nq0 = *(const f32x4*)qp, nq1 = *(const f32x4*)(qp + 4);
                float nv = vp[0], na = al[0], nb = be[0], nqk = qk[0];
                for (int t16 = 0; t16 < 4; ++t16) {
                    float ok = 0.f;
#pragma unroll 4
                    for (int i = 0; i < 16; ++i) {
                        const int tt = t16 * 16 + i, tn = (tt + 1) & 63;
                        const f32x2 K0 = {nk0.x, nk0.y}, K1 = {nk0.z, nk0.w}, K2 = {nk1.x, nk1.y}, K3 = {nk1.z, nk1.w};
                        const f32x2 Q0 = {nq0.x, nq0.y}, Q1 = {nq0.z, nq0.w}, Q2 = {nq1.x, nq1.y}, Q3 = {nq1.z, nq1.w};
                        const float v = nv, a = na, bt = nb, qkt = nqk;
                        nk0 = *(const f32x4*)(kp + tn * 128); nk1 = *(const f32x4*)(kp + tn * 128 + 4); nq0 = *(const f32x4*)(qp + tn * 128); nq1 = *(const f32x4*)(qp + tn * 128 + 4);
                        nv = vp[tn * 32]; na = al[tn]; nb = be[tn]; nqk = qk[tn];
                        f32x2 pa = K0 * S2[0], pb = K2 * S2[2], qa = Q0 * S2[0], qb = Q2 * S2[2];
                        pa = K1 * S2[1] + pa; pb = K3 * S2[3] + pb; qa = Q1 * S2[1] + qa; qb = Q3 * S2[3] + qb;
                        pa += pb; qa += qb;
                        float p = pa.x + pa.y, qS = qa.x + qa.y;
                        p = row_sum16(p); qS = row_sum16(qS);
                        const float vn = bt * (v - a * p);
                        const float o = a * qS + qkt * vn;
                        const f32x2 vn2 = {vn, vn}, a2 = {a, a};
                        S2[0] = S2[0] * a2 + K0 * vn2; S2[1] = S2[1] * a2 + K1 * vn2; S2[2] = S2[2] * a2 + K2 * vn2; S2[3] = S2[3] * a2 + K3 * vn2;
                        ok = (i == dl) ? o : ok;
                    }
                    os[(t16 * 16 + dl) * 32 + e] = ok;
                }
            }
            __syncthreads();
            { const int tok = tid >> 3, c4 = tid & 7;
              *(f32x4*)(o32 + (size_t)(b * S + t0 + tok) * D + h * 128 + es * 32 + c4 * 4) = *(const f32x4*)(os + tok * 32 + c4 * 4); }
            if (more) {
                GDN_PARK();
                __syncthreads();
                GDN_CONVNORM(t0 + 64);
            }
            __syncthreads();
        }
#undef GDN_PREFETCH
#undef GDN_PARK
#undef GDN_CONV8
#undef GDN_CONVNORM
    }
}

constexpr size_t WS_HALO = WS_END;
constexpr size_t WS_GL = WS_END + 10 * MiB;
constexpr size_t WS_SS = WS_GL + 1 * MiB;
constexpr size_t WS_END2 = WS_SS + 26 * MiB;

__device__ __forceinline__ void phase_gdn_halo(const bf16* proj, bf16* halo, int gtid, int NT) {
    for (int idx = gtid; idx < Bn * 64 * 3 * 384; idx += NT) {
        const int c = idx % 384, r3 = (idx / 384) % 3, bn = idx / (384 * 3), n = bn & 63, b = bn >> 6;
        u32x4 v = {0u, 0u, 0u, 0u};
        if (n > 0) v = *(const u32x4*)(proj + (size_t)(b * S + 64 * n - 3 + r3) * 4096 + c * 8);
        *(u32x4*)(halo + (size_t)(bn * 3 + r3) * 3072 + c * 8) = v;
    }
}

constexpr int GP_RAW = 0, GP_QB = 51456, GP_KB = GP_QB + 17408, GP_VB = GP_KB + 17408, GP_AM = GP_VB + 16384, GP_GC = GP_AM + 17408;
__device__ __forceinline__ void phase_gdn_prep(unsigned char* lds, bf16* proj, const bf16* halo, const float* ab, const float* convw, const float* A_log, const float* dt_bias,
                                               bf16* KT, bf16* AT, float* GL, int vblk, int nblk, int tid, int wid, int lane) {
    bf16* raw = (bf16*)(lds + GP_RAW);
    unsigned char* qb = lds + GP_QB;
    unsigned char* kb = lds + GP_KB;
    bf16* vb = (bf16*)(lds + GP_VB);
    float* Am = (float*)(lds + GP_AM);
    float* gcs = (float*)(lds + GP_GC);
    float* bes = gcs + 64;
    const int r = lane & 31, hh = lane >> 5;
    for (int item = vblk; item < Bn * 8 * 64; item += nblk) {
        const int n = item & 63, h = (item >> 6) & 7, b = item >> 9;
        const size_t tok0 = (size_t)b * S + 64 * n;
        __syncthreads();
#pragma unroll
        for (int k_ = 0; k_ < 7; ++k_) {
            const int idx = tid + 512 * k_;
            if (idx < 67 * 48) {
                const int row = idx / 48, c = idx - row * 48;
                const int col = c < 16 ? h * 128 + c * 8 : (c < 32 ? 1024 + h * 128 + (c - 16) * 8 : 2048 + h * 128 + (c - 32) * 8);
                u32x4 v;
                if (row < 3) v = *(const u32x4*)(halo + (size_t)((b * 64 + n) * 3 + row) * 3072 + col);
                else v = *(const u32x4*)(proj + (tok0 + row - 3) * 4096 + col);
                *(u32x4*)(raw + row * 384 + c * 8) = v;
            }
        }
        if (tid < 64) {
            const float a = ab[(tok0 + tid) * 16 + h] + dt_bias[h], bb = ab[(tok0 + tid) * 16 + 8 + h];
            const float sp = a > 20.f ? a : __logf(1.f + __expf(a));
            float g = -__expf(A_log[h]) * sp;
#pragma unroll
            for (int o = 1; o < 64; o <<= 1) { const float t_ = xshfl_up(g, o); if (lane >= o) g += t_; }
            const float be_ = sigmoidf_(bb);
            gcs[tid] = g; bes[tid] = be_; gcs[128 + tid] = be_; gcs[192 + tid] = be_ * __expf(g);
        }
        __syncthreads();
        {
            const int isk = (tid >> 4) & 1, cg = tid & 15;
            const int colqk = isk * 1024 + h * 128 + cg * 8, colv = 2048 + h * 128 + cg * 8;
#define GP_CONV8(ROW0, C8, COL, OUT) do { _Pragma("unroll") for (int i_ = 0; i_ < 8; ++i_) OUT[i_] = 0.f; _Pragma("unroll") for (int j_ = 0; j_ < 4; ++j_) { const u32x4 xv_ = *(const u32x4*)(raw + ((ROW0) + j_) * 384 + (C8) * 8); \
            const f32x4 w0_ = *(const f32x4*)(convw + j_ * 3072 + (COL)), w1_ = *(const f32x4*)(convw + j_ * 3072 + (COL) + 4); \
            OUT[0] += bf2f(xv_.x & 0xffffu) * w0_.x; OUT[1] += bf2f(xv_.x >> 16) * w0_.y; OUT[2] += bf2f(xv_.y & 0xffffu) * w0_.z; OUT[3] += bf2f(xv_.y >> 16) * w0_.w; \
            OUT[4] += bf2f(xv_.z & 0xffffu) * w1_.x; OUT[5] += bf2f(xv_.z >> 16) * w1_.y; OUT[6] += bf2f(xv_.w & 0xffffu) * w1_.z; OUT[7] += bf2f(xv_.w >> 16) * w1_.w; } \
            _Pragma("unroll") for (int i_ = 0; i_ < 8; ++i_) OUT[i_] = siluf_(OUT[i_]); } while (0)
#pragma unroll 1
            for (int it = 0; it < 4; ++it) {
                const int tk = it * 16 + (tid >> 5);
                float y[8]; GP_CONV8(tk, isk * 16 + cg, colqk, y);
                float ss = (y[0] * y[0] + y[1] * y[1]) + (y[2] * y[2] + y[3] * y[3]) + (y[4] * y[4] + y[5] * y[5]) + (y[6] * y[6] + y[7] * y[7]);
                ss = row_sum16(ss);
                const float sc = (1.f / sqrtf(ss + EPS)) * (isk ? 1.f : 0.08838834764831845f);
                u32x4 w; w.x = pkbf(y[0] * sc, y[1] * sc); w.y = pkbf(y[2] * sc, y[3] * sc); w.z = pkbf(y[4] * sc, y[5] * sc); w.w = pkbf(y[6] * sc, y[7] * sc);
                *(u32x4*)((isk ? kb : qb) + tk * 272 + cg * 16) = w;
            }
#pragma unroll 1
            for (int it = 0; it < 2; ++it) {
                const int tk = it * 32 + (tid >> 4);
                float y[8]; GP_CONV8(tk, 32 + cg, colv, y);
                u32x4 w; w.x = pkbf(y[0], y[1]); w.y = pkbf(y[2], y[3]); w.z = pkbf(y[4], y[5]); w.w = pkbf(y[6], y[7]);
                *(u32x4*)(vb + tk * 128 + cg * 8) = w;
            }
#undef GP_CONV8
        }
        __syncthreads();
        {
            const int prod = wid >> 2, tr = (wid >> 1) & 1, tc = wid & 1;
            f32x16 acc;
#pragma unroll
            for (int i = 0; i < 16; ++i) acc[i] = 0.f;
            if (tr >= tc) {
                const unsigned char* Ab = (prod ? qb : kb) + (32 * tr + r) * 272 + hh * 16;
                const unsigned char* Bb = kb + (32 * tc + r) * 272 + hh * 16;
#pragma unroll
                for (int ks = 0; ks < 8; ++ks) acc = MFMA32(*(const bf16x8v*)(Ab + ks * 32), *(const bf16x8v*)(Bb + ks * 32), acc);
            }
            const int j = 32 * tc + r; const float gj = gcs[j];
#pragma unroll
            for (int i_ = 0; i_ < 16; ++i_) {
                const int i = 32 * tr + (i_ & 3) + 8 * (i_ >> 2) + 4 * hh;
                const float dec = __expf(gcs[i] - gj);
                if (prod == 0) Am[i * 68 + j] = (j < i) ? bes[i] * acc[i_] * dec : 0.f;
                else AT[(size_t)item * 4096 + i * 64 + j] = (bf16)f2bf((j <= i) ? acc[i_] * dec : 0.f);
            }
        }
        __syncthreads();
        int tid3 = tid; asm volatile("" : "+v"(tid3));
        if (tid3 < 256) {
            const int isw = tid3 >> 7, d = tid3 & 127;
            unsigned oam = GP_AM, orsc = GP_GC + 512 + isw * 256, ocol = (isw ? GP_KB : GP_VB) + d * 2;
            asm volatile("" : "+v"(oam), "+v"(orsc), "+v"(ocol));
            const float* Am_ = (const float*)(lds + oam); const float* rsc = (const float*)(lds + orsc); const unsigned char* col = lds + ocol;
            const int cstride = isw ? 272 : 256;
            float X[64];
#pragma clang loop unroll(full)
            for (int i = 0; i < 64; ++i) X[i] = 0.f;
#pragma clang loop unroll(full)
            for (int i = 0; i < 64; ++i) {
                f32x4 av = {0.f, 0.f, 0.f, 0.f};
#pragma clang loop unroll(full)
                for (int j4 = 0; j4 < 16; ++j4) { if (4 * j4 < i) { const f32x4 a4 = *(const f32x4*)(Am_ + i * 68 + 4 * j4);
                    const f32x4 x4 = {X[4 * j4], X[4 * j4 + 1], X[4 * j4 + 2], X[4 * j4 + 3]}; av += a4 * x4; } }
                X[i] = rsc[i] * bf2f(*(const bf16*)(col + i * cstride)) - ((av.x + av.y) + (av.z + av.w));
                asm volatile("" ::: "memory");
            }
            if (isw) {
#pragma unroll
                for (int i = 0; i < 64; ++i) proj[(tok0 + i) * 4096 + 1024 + h * 128 + d] = (bf16)f2bf(X[i]);
            } else {
                bf16* up = proj + (tok0 + (d >> 1)) * 4096 + 2048 + h * 128 + (d & 1) * 64;
#pragma unroll
                for (int i8 = 0; i8 < 8; ++i8) { u32x4 w; w.x = pkbf(X[8 * i8], X[8 * i8 + 1]); w.y = pkbf(X[8 * i8 + 2], X[8 * i8 + 3]); w.z = pkbf(X[8 * i8 + 4], X[8 * i8 + 5]); w.w = pkbf(X[8 * i8 + 6], X[8 * i8 + 7]);
                    *(u32x4*)(up + 8 * i8) = w; }
            }
        } else if (tid3 < 384) {
            const int d = tid3 - 256; const float gl_ = gcs[63];
            bf16* kp = KT + (size_t)item * 8192 + d * 64;
#pragma unroll
            for (int i8 = 0; i8 < 8; ++i8) { float y[8];
#pragma unroll
                for (int i = 0; i < 8; ++i) y[i] = bf2f(*(const bf16*)(kb + (8 * i8 + i) * 272 + d * 2)) * __expf(gl_ - gcs[8 * i8 + i]);
                u32x4 w; w.x = pkbf(y[0], y[1]); w.y = pkbf(y[2], y[3]); w.z = pkbf(y[4], y[5]); w.w = pkbf(y[6], y[7]);
                *(u32x4*)(kp + 8 * i8) = w; }
            if (d == 0) GL[item] = __expf(gl_);
        } else {
            const int d = tid3 - 384;
#pragma unroll 8
            for (int i = 0; i < 64; ++i) proj[(tok0 + i) * 4096 + h * 128 + d] = (bf16)f2bf(bf2f(*(const bf16*)(qb + i * 272 + d * 2)) * __expf(gcs[i]));
        }
    }
}

__device__ __forceinline__ void phase_gdn_scan2(unsigned char* lds, const bf16* proj, const bf16* KT, const bf16* AT, const float* GL, bf16* o16, int vblk, int nblk, int tid, int wid, int lane) {
    unsigned char* Sl = lds;
    unsigned char* Vl = lds + 8704;
    const int r = lane & 31, hh = lane >> 5;
    for (int item = vblk; item < 256; item += nblk) {
        const int bh = (item & 7) + 8 * (item >> 5), es = (item >> 3) & 3, b = bh >> 3, h = bh & 7;
        __syncthreads();
        for (int i = tid; i < 8704 / 4; i += 512) ((unsigned*)Sl)[i] = 0u;
        f32x16 Sacc;
#pragma unroll
        for (int i = 0; i < 16; ++i) Sacc[i] = 0.f;
        const int rt = wid & 1, dt = wid & 3;
        for (int n = 0; n < 64; ++n) {
            const size_t tok0 = (size_t)b * S + 64 * n; const int itm = bh * 64 + n;
            bf16x8v A8[8]; bf16x8v A4[4]; u32x2 uu[4]; float gl = 1.f;
            if (wid < 2) {
                const bf16* wp = proj + (tok0 + 32 * rt + r) * 4096 + 1024 + h * 128 + 8 * hh;
#pragma unroll
                for (int ks = 0; ks < 8; ++ks) A8[ks] = *(const bf16x8v*)(wp + 16 * ks);
                const int c = es * 32 + r;
                const bf16* up = proj + (tok0 + (c >> 1)) * 4096 + 2048 + h * 128 + (c & 1) * 64 + 32 * rt + 4 * hh;
#pragma unroll
                for (int g = 0; g < 4; ++g) uu[g] = *(const u32x2*)(up + 8 * g);
            } else if (wid < 4) {
                const bf16* qp = proj + (tok0 + 32 * rt + r) * 4096 + h * 128 + 8 * hh;
#pragma unroll
                for (int ks = 0; ks < 8; ++ks) A8[ks] = *(const bf16x8v*)(qp + 16 * ks);
                const bf16* ap = AT + (size_t)itm * 4096 + (32 * rt + r) * 64 + 8 * hh;
#pragma unroll
                for (int sx = 0; sx < 4; ++sx) A4[sx] = *(const bf16x8v*)(ap + 16 * sx);
            } else {
                const bf16* kp = KT + (size_t)itm * 8192 + (32 * dt + r) * 64 + 8 * hh;
#pragma unroll
                for (int sx = 0; sx < 4; ++sx) A4[sx] = *(const bf16x8v*)(kp + 16 * sx);
                gl = GL[itm];
            }
            __syncthreads();
            f32x16 acc;
#pragma unroll
            for (int i = 0; i < 16; ++i) acc[i] = 0.f;
            if (wid < 4) {
#pragma unroll
                for (int ks = 0; ks < 8; ++ks) acc = MFMA32(A8[ks], *(const bf16x8v*)(Sl + r * 272 + ks * 32 + hh * 16), acc);
                if (wid < 2) {
#pragma unroll
                    for (int g = 0; g < 4; ++g) {
                        u32x2 w; w.x = pkbf(bf2f(uu[g].x & 0xffffu) - acc[4 * g], bf2f(uu[g].x >> 16) - acc[4 * g + 1]);
                        w.y = pkbf(bf2f(uu[g].y & 0xffffu) - acc[4 * g + 2], bf2f(uu[g].y >> 16) - acc[4 * g + 3]);
                        *(u32x2*)(Vl + r * 144 + (32 * rt + 8 * g + 4 * hh) * 2) = w;
                    }
                }
            }
            __syncthreads();
            if (wid >= 2 && wid < 4) {
#pragma unroll
                for (int sx = 0; sx < 4; ++sx) acc = MFMA32(A4[sx], *(const bf16x8v*)(Vl + r * 144 + sx * 32 + hh * 16), acc);
                bf16* op = o16 + (tok0 + 32 * rt + 4 * hh) * D + h * 128 + es * 32 + r;
#pragma unroll
                for (int i = 0; i < 16; ++i) op[(size_t)((i & 3) + 8 * (i >> 2)) * D] = (bf16)f2bf(acc[i]);
            } else if (wid >= 4) {
#pragma unroll
                for (int i = 0; i < 16; ++i) Sacc[i] *= gl;
#pragma unroll
                for (int sx = 0; sx < 4; ++sx) Sacc = MFMA32(A4[sx], *(const bf16x8v*)(Vl + r * 144 + sx * 32 + hh * 16), Sacc);
#pragma unroll
                for (int g = 0; g < 4; ++g) { u32x2 w; w.x = pkbf(Sacc[4 * g], Sacc[4 * g + 1]); w.y = pkbf(Sacc[4 * g + 2], Sacc[4 * g + 3]);
                    *(u32x2*)(Sl + r * 272 + (32 * dt + 8 * g + 4 * hh) * 2) = w; }
            }
        }
    }
}

__device__ __forceinline__ void phase_gdn_post(const bf16* o16, const bf16* proj, const float* onorm, bf16* hn, int gw, int NGW, int lane) {
    const f32x4 wv = *(const f32x4*)(onorm + ((4 * lane) & 127));
    for (int m = gw; m < T; m += NGW) {
        const u32x2* xr = (const u32x2*)(o16 + (size_t)m * D) + lane;
        const u32x2* gr = (const u32x2*)(proj + (size_t)m * 4096 + 3072) + lane;
        u32x2* o8 = (u32x2*)(hn + (size_t)m * D) + lane;
#pragma unroll
        for (int j = 0; j < 4; ++j) {
            const u32x2 xv = xr[64 * j]; const u32x2 g = gr[64 * j];
            const f32x4 v = {bf2f(xv.x & 0xffffu), bf2f(xv.x >> 16), bf2f(xv.y & 0xffffu), bf2f(xv.y >> 16)};
            float s = (v.x * v.x + v.y * v.y) + (v.z * v.z + v.w * v.w);
#pragma unroll
            for (int o = 1; o < 32; o <<= 1) s += xshfl(s, o);
            const float rstd = 1.f / sqrtf(s * (1.f / 128.f) + EPS);
            u32x2 o; o.x = pk2(v.x * rstd * wv.x * siluf_(bf2f(g.x & 0xffffu)), v.y * rstd * wv.y * siluf_(bf2f(g.x >> 16)));
            o.y = pk2(v.z * rstd * wv.z * siluf_(bf2f(g.y & 0xffffu)), v.w * rstd * wv.w * siluf_(bf2f(g.y >> 16)));
            o8[64 * j] = o;
        }
    }
}
__device__ __forceinline__ void phase_sc_post(const bf16* proj, const float* cw, bf16* hn, int gtid, int NT) {
    for (int idx = gtid; idx < T * 128; idx += NT) {
        const int m = idx >> 7, c8 = (idx & 127) * 8, s = m & (S - 1);
        float y[8];
#pragma unroll
        for (int i = 0; i < 8; ++i) y[i] = 0.f;
#pragma unroll
        for (int j = 0; j < 3; ++j) {
            if (s - 2 + j >= 0) {
                const bf16* pr = proj + (size_t)(m - 2 + j) * 3072;
                const u32x4 cv = *(const u32x4*)(pr + 1024 + c8), xv = *(const u32x4*)(pr + 2048 + c8);
                const f32x4 w0 = *(const f32x4*)(cw + j * 1024 + c8), w1 = *(const f32x4*)(cw + j * 1024 + c8 + 4);
                y[0] += w0.x * bf2f(cv.x & 0xffffu) * bf2f(xv.x & 0xffffu); y[1] += w0.y * bf2f(cv.x >> 16) * bf2f(xv.x >> 16);
                y[2] += w0.z * bf2f(cv.y & 0xffffu) * bf2f(xv.y & 0xffffu); y[3] += w0.w * bf2f(cv.y >> 16) * bf2f(xv.y >> 16);
                y[4] += w1.x * bf2f(cv.z & 0xffffu) * bf2f(xv.z & 0xffffu); y[5] += w1.y * bf2f(cv.z >> 16) * bf2f(xv.z >> 16);
                y[6] += w1.z * bf2f(cv.w & 0xffffu) * bf2f(xv.w & 0xffffu); y[7] += w1.w * bf2f(cv.w >> 16) * bf2f(xv.w >> 16);
            }
        }
        const u32x4 bv = *(const u32x4*)(proj + (size_t)m * 3072 + c8);
        u32x4 o;
        o.x = pk2(y[0] * bf2f(bv.x & 0xffffu), y[1] * bf2f(bv.x >> 16)); o.y = pk2(y[2] * bf2f(bv.y & 0xffffu), y[3] * bf2f(bv.y >> 16));
        o.z = pk2(y[4] * bf2f(bv.z & 0xffffu), y[5] * bf2f(bv.z >> 16)); o.w = pk2(y[6] * bf2f(bv.w & 0xffffu), y[7] * bf2f(bv.w >> 16));
        *(u32x4*)(hn + (size_t)m * D + c8) = o;
    }
}
__device__ __forceinline__ void phase_nsa_post(unsigned char* lds, const bf16* proj, const float* qnorm, const float* knorm, const f32x2* tab,
                                               bf16* QN, bf16* KS, bf16* KW, bf16* KCH, bf16* VCH, bf16* VST, bf16* VWT, int gw, int NGW, int wid, int lane) {
    {
        bf16* tile = (bf16*)lds + wid * (64 * 66);
        for (int item = gw; item < 2 * 32 * 64; item += NGW) {
            const int st = item & 63, bh = (item >> 6) & 31, which = item >> 11, b = bh >> 2, hk = bh & 3;
            const bf16* src = proj + ((size_t)b * S + st * 64) * 2560 + (which ? 2304 : 1792) + hk * 64 + lane;
#pragma unroll 8
            for (int i = 0; i < 64; ++i) tile[i * 66 + lane] = src[(size_t)i * 2560];
            WAVE_SYNC();
            bf16* dst = (which ? VWT : VST) + (size_t)bh * 64 * S + st * 64 + lane;
#pragma unroll 8
            for (int d = 0; d < 64; ++d) dst[(size_t)d * S] = tile[lane * 66 + d];
            WAVE_SYNC();
        }
    }
    const float qw = qnorm[lane], kw1 = knorm[64 + lane], kw2 = knorm[128 + lane];
    for (int m = gw; m < T; m += NGW) {
        const int b = m >> 12, s = m & (S - 1);
        const bf16* pr = proj + (size_t)m * 2560;
        const f32x2 cs = tab[(size_t)m * 32 + (lane & 31)];
#pragma unroll 4
        for (int hh = 0; hh < 16; ++hh) {
            const float x = bf2f(pr[hh * 64 + lane]);
            const float ss = wave_sum(x * x);
            QN[((size_t)(b * 16 + hh) * S + s) * 64 + lane] = (bf16)f2bf(x * (1.f / sqrtf(ss * (1.f / 64.f) + EPS)) * qw);
        }
#pragma unroll
        for (int hk = 0; hk < 4; ++hk) {
            const size_t o = ((size_t)(b * 4 + hk) * S + s) * 64 + lane;
            { const float x = bf2f(pr[1536 + hk * 64 + lane]); const float ss = wave_sum(x * x);
              const float y = x * (1.f / sqrtf(ss * (1.f / 64.f) + EPS)) * kw1; const float yp = xshfl(y, 32);
              KS[o] = (bf16)f2bf(y * cs.x + (lane < 32 ? -yp : yp) * cs.y); }
            { const float x = bf2f(pr[2048 + hk * 64 + lane]); const float ss = wave_sum(x * x);
              const float y = x * (1.f / sqrtf(ss * (1.f / 64.f) + EPS)) * kw2; const float yp = xshfl(y, 32);
              KW[o] = (bf16)f2bf(y * cs.x + (lane < 32 ? -yp : yp) * cs.y); }
            KCH[o] = pr[1024 + hk * 64 + lane];
            VCH[o] = pr[1280 + hk * 64 + lane];
        }
    }
}
__device__ __forceinline__ void phase_cmp2(unsigned char* lds, const float* Pk, const float* Pv, const float* biasp, const float* w2, const float* b2, const float* knorm0,
                                           bf16* KC, bf16* VC, int gw, int NGW, int wid, int lane) {
    float* hs = (float*)lds + wid * 256;
    for (int item = gw; item < 2 * 32 * 256; item += NGW) {
        const int i = item & 255, bh = (item >> 8) & 31, kind = item >> 13;
        bf16* outp = kind ? VC + ((size_t)bh * 64 + lane) * 256 + i : KC + ((size_t)bh * 256 + i) * 64 + lane;
        if (i == 255) { *outp = 0; continue; }
        const float* P = kind ? Pv : Pk;
        const float* r0 = P + ((size_t)bh * 256 + i) * 512; const float* r1 = r0 + 512 + 256;
#pragma unroll
        for (int j = 0; j < 4; ++j) { const int n = lane + 64 * j; const float x = r0[n] + r1[n] + biasp[kind * 256 + n];
            const float uu = 0.7978845608028654f * (x + 0.044715f * x * x * x);
            const float th = 1.f - 2.f / (1.f + __expf(2.f * uu));
            hs[n] = 0.5f * x * (1.f + th); }
        WAVE_SYNC();
        float acc = b2[kind * 64 + lane];
        const float* w = w2 + (size_t)kind * 256 * 64 + lane;
#pragma unroll 8
        for (int n = 0; n < 256; ++n) acc += hs[n] * w[n * 64];
        if (kind == 0) { const float ss = wave_sum(acc * acc); acc = acc * (1.f / sqrtf(ss * (1.f / 64.f) + EPS)) * knorm0[lane]; }
        *outp = (bf16)f2bf(acc);
        WAVE_SYNC();
    }
}
constexpr int KV_STRIDE = 144;
constexpr int KV_BUF = 2 * 64 * KV_STRIDE;
constexpr int ATT_IMP_OFF = 2 * KV_BUF;
constexpr int ATT_MSK_OFF = ATT_IMP_OFF + 8 * 2048;

template <bool IMP>
__device__ __forceinline__ void attn_tile(const bool FAST, const unsigned char* buf, int tt, int key0, int lo, int hi, const bf16x8v (&qf)[4],
                                          f32x16 (&O)[2], f32x16 (&IM)[2], float& m, float& l, const bf16* ovt, int r, int h, int pr) {
    f32x16 sacc;
#pragma unroll
    for (int i = 0; i < 16; ++i) sacc[i] = 0.f;
    const unsigned char* kb = buf + (32 * tt + pr) * KV_STRIDE + h * 16;
#pragma unroll
    for (int ks = 0; ks < 4; ++ks) { const bf16x8v a = *(const bf16x8v*)(kb + ks * 32); sacc = MFMA32(a, qf[ks], sacc); }
    const int kb0 = key0 + 8 * h;
    float mx = -1e30f, psum = 0.f, corr;
    if (FAST) {
        const bool on = hi >= 0;
#pragma unroll
        for (int i = 0; i < 16; ++i) mx = fmaxf(mx, sacc[i]);
        mx = on ? mx * 0.18033688011112042f : -1e30f;
        mx = fmaxf(mx, xshfl(mx, 32));
        const float mnew = fmaxf(m, mx);
        corr = __builtin_amdgcn_exp2f(m - mnew);
        m = mnew;
#pragma unroll
        for (int i = 0; i < 16; ++i) { const float p = __builtin_amdgcn_exp2f(sacc[i] * 0.18033688011112042f - mnew); psum += p; sacc[i] = p; }
        if (!on) {
            psum = 0.f;
#pragma unroll
            for (int i = 0; i < 16; ++i) sacc[i] = 0.f;
        }
    } else {
#pragma unroll
        for (int i = 0; i < 16; ++i) { const int key = kb0 + 16 * (i >> 3) + (i & 7); const bool ok = (key >= lo) && (key <= hi);
            const float sv = ok ? sacc[i] * 0.18033688011112042f : -1e30f; sacc[i] = sv; mx = fmaxf(mx, sv); }
        mx = fmaxf(mx, xshfl(mx, 32));
        const float mnew = fmaxf(m, mx);
        corr = __builtin_amdgcn_exp2f(m - mnew);
        m = mnew;
#pragma unroll
        for (int i = 0; i < 16; ++i) { const float p = sacc[i] > -1e29f ? __builtin_amdgcn_exp2f(sacc[i] - mnew) : 0.f; psum += p; sacc[i] = p; }
    }
    l = l * corr + psum;
    if (__any(corr != 1.f)) {
#pragma unroll
        for (int i = 0; i < 16; ++i) { O[0][i] *= corr; O[1][i] *= corr; }
        if (IMP) {
#pragma unroll
            for (int i = 0; i < 16; ++i) { IM[0][i] *= corr; IM[1][i] *= corr; }
        }
    }
    bf16x8v pf[2];
#pragma unroll
    for (int sx = 0; sx < 2; ++sx) { u32x4 w; w.x = pkbf(sacc[8 * sx], sacc[8 * sx + 1]); w.y = pkbf(sacc[8 * sx + 2], sacc[8 * sx + 3]); w.z = pkbf(sacc[8 * sx + 4], sacc[8 * sx + 5]); w.w = pkbf(sacc[8 * sx + 6], sacc[8 * sx + 7]);
        pf[sx] = __builtin_bit_cast(bf16x8v, w); }
    const unsigned char* vb = buf + 64 * KV_STRIDE + r * KV_STRIDE + (32 * tt + 8 * h) * 2;
#pragma unroll
    for (int dt = 0; dt < 2; ++dt)
#pragma unroll
        for (int sx = 0; sx < 2; ++sx) { const bf16x8v a = *(const bf16x8v*)(vb + dt * 32 * KV_STRIDE + sx * 32); O[dt] = MFMA32(a, pf[sx], O[dt]); }
    if (IMP) {
#pragma unroll
        for (int st = 0; st < 2; ++st)
#pragma unroll
            for (int sx = 0; sx < 2; ++sx) { const bf16x8v a = *(const bf16x8v*)(ovt + (32 * st + r) * 256 + key0 + 16 * sx + 8 * h); IM[st] = MFMA32(a, pf[sx], IM[st]); }
    }
}

template <int MODE>
__device__ __forceinline__ void attn_branch(unsigned char* kvbuf, const bf16* Kg0, const bf16* VTg0, int vts, unsigned long long blkmask, int t, int nv, unsigned long long selm,
                                            int wlo, int whi, int flo, int fhi, const bf16x8v (&qf)[4], f32x16 (&O)[2], f32x16 (&IM)[2], float& l, const bf16* ovt, int tid, int r, int h, int pr) {
    float m = -1e30f;
    l = 0.f;
#pragma unroll
    for (int i = 0; i < 16; ++i) { O[0][i] = 0.f; O[1][i] = 0.f; IM[0][i] = 0.f; IM[1][i] = 0.f; }
    const int srow = tid >> 3, sch = tid & 7;
    int j = __builtin_ctzll(blkmask);
    unsigned long long rest = blkmask & (blkmask - 1);
    u32x4 kr = *(const u32x4*)(Kg0 + (size_t)(64 * j + srow) * 64 + sch * 8);
    u32x4 vr = *(const u32x4*)(VTg0 + (size_t)srow * vts + 64 * j + sch * 8);
    *(u32x4*)(kvbuf + srow * KV_STRIDE + sch * 16) = kr;
    *(u32x4*)(kvbuf + 64 * KV_STRIDE + srow * KV_STRIDE + sch * 16) = vr;
    int cur = 0;
    for (;;) {
        __syncthreads();
        const bool more = rest != 0ull;
        int jn = 0;
        if (more) { jn = __builtin_ctzll(rest); rest &= rest - 1;
            kr = *(const u32x4*)(Kg0 + (size_t)(64 * jn + srow) * 64 + sch * 8);
            vr = *(const u32x4*)(VTg0 + (size_t)srow * vts + 64 * jn + sch * 8); }
        const unsigned char* buf = kvbuf + cur * KV_BUF;
        int lo, hi;
        if (MODE == 0) { lo = 0; hi = nv - 1; }
        else if (MODE == 1) { lo = 0; hi = ((selm >> j) & 1ull) ? t : -1; }
        else { lo = t - 511; hi = t; }
#pragma unroll
        for (int tt = 0; tt < 2; ++tt) {
            const int key0 = 64 * j + 32 * tt;
            if (key0 > whi || key0 + 31 < wlo) continue;
            attn_tile<MODE == 0>(key0 >= flo && key0 + 31 <= fhi, buf, tt, key0, lo, hi, qf, O, IM, m, l, ovt, r, h, pr);
        }
        if (!more) break;
        *(u32x4*)(kvbuf + (cur ^ 1) * KV_BUF + srow * KV_STRIDE + sch * 16) = kr;
        *(u32x4*)(kvbuf + (cur ^ 1) * KV_BUF + 64 * KV_STRIDE + srow * KV_STRIDE + sch * 16) = vr;
        cur ^= 1; j = jn;
    }
    __syncthreads();
}

__device__ __forceinline__ void phase_nsa_attn(unsigned char* lds, const bf16* QN, const bf16* KS, const bf16* KW, const bf16* VST, const bf16* VWT, const bf16* KCb, const bf16* VCT,
                                               const bf16* ovt, const float* gates, const f32x2* tab, bf16* hn, int vblk, int nblk, int tid, int wid, int lane) {
    const int r = lane & 31, h = lane >> 5, pr = (r & ~12) | ((r & 4) << 1) | ((r & 8) >> 1);
    float* imp_s = (float*)(lds + ATT_IMP_OFF + wid * 2048);
    unsigned long long* msk_s = (unsigned long long*)(lds + ATT_MSK_OFF);
    unsigned* uni_s = (unsigned*)(lds + ATT_MSK_OFF + 512);
    for (int item = vblk; item < Bn * 4 * 64; item += nblk) {
        const int rnd = item / nblk, wv = item - rnd * nblk;
        const int bh = wv & 31, sub = wv >> 5, per = nblk >> 5;
        int qb = rnd * per + ((rnd & 1) ? (per - 1 - sub) : sub);
        if (nblk != 256) { qb = item >> 5; }
        const int bhh = (nblk != 256) ? (item & 31) : bh;
        const int b = bhh >> 2, hk = bhh & 3;
        const int t0 = qb * 64, tw0 = t0 + 8 * wid, t = tw0 + (r & 7), g = r >> 3;
        const size_t tok = (size_t)b * S + t;
        if (tid == 0) { unsigned z = 0u; asm volatile("" : "+v"(z)); uni_s[0] = z; uni_s[1] = z; }
        bf16x8v qn[4], qr[4];
        {
            const bf16* qp = QN + ((size_t)(b * 16 + hk * 4 + g) * S + t) * 64 + 8 * h;
#pragma unroll
            for (int ks = 0; ks < 4; ++ks) qn[ks] = *(const bf16x8v*)(qp + 16 * ks);
            const f32x2* cp = tab + tok * 32 + 8 * h;
#pragma unroll
            for (int kl = 0; kl < 2; ++kl) {
                u32x4 wlo_, whi_;
                const u32x4 a = __builtin_bit_cast(u32x4, qn[kl]), c = __builtin_bit_cast(u32x4, qn[kl + 2]);
#pragma unroll
                for (int jj = 0; jj < 4; ++jj) {
                    const f32x2 cs0 = cp[16 * kl + 2 * jj], cs1 = cp[16 * kl + 2 * jj + 1];
                    const float x0 = bf2f(a[jj] & 0xffffu), x1 = bf2f(a[jj] >> 16), y0 = bf2f(c[jj] & 0xffffu), y1 = bf2f(c[jj] >> 16);
                    wlo_[jj] = pkbf(x0 * cs0.x - y0 * cs0.y, x1 * cs1.x - y1 * cs1.y);
                    whi_[jj] = pkbf(y0 * cs0.x + x0 * cs0.y, y1 * cs1.x + x1 * cs1.y);
                }
                qr[kl] = __builtin_bit_cast(bf16x8v, wlo_); qr[kl + 2] = __builtin_bit_cast(bf16x8v, whi_);
            }
        }
        const float* gp = gates + tok * 48 + (hk * 4 + g) * 3;
        const float g0 = sigmoidf_(gp[0]), g1 = sigmoidf_(gp[1]), g2 = sigmoidf_(gp[2]);
        f32x16 acc[2], O[2], IM[2];
        float l;
        const int nv = t >= 31 ? ((t - 31) >> 4) + 1 : 0;
        const int nvw = ((tw0 + 7 - 31) >> 4) + 1;
        const int nvmax = 4 * qb + 3;
        {
            const int ncb = (nvmax + 63) >> 6;
            const unsigned long long bm = ncb >= 64 ? ~0ull : ((1ull << ncb) - 1ull);
            attn_branch<0>(lds, KCb + (size_t)bhh * 256 * 64, VCT + (size_t)bhh * 64 * 256, 256, bm, t, nv, 0ull, 0, (tw0 + 7 >= 31 ? nvw - 1 : -1), 0, (tw0 >= 31 ? ((tw0 - 31) >> 4) : -1), qn, O, IM, l, ovt, tid, r, h, pr);
        }
        {
            const float lt = l + xshfl(l, 32), inv = lt > 0.f ? 1.f / lt : 0.f, sc = inv * g0;
#pragma unroll
            for (int i = 0; i < 16; ++i) { acc[0][i] = O[0][i] * sc; acc[1][i] = O[1][i] * sc; }
#pragma unroll
            for (int st = 0; st < 2; ++st)
#pragma unroll
                for (int i = 0; i < 16; ++i) { float v = IM[st][i] * inv; v += xshfl(v, 8); v += xshfl(v, 16);
                    if (r < 8) imp_s[r * 64 + 32 * st + (i & 3) + 8 * (i >> 2) + 4 * h] = v; }
        }
        WAVE_SYNC();
        {
            unsigned long long um = 0ull;
            for (int tk = 0; tk < 8; ++tk) {
                const float imp = imp_s[tk * 64 + lane];
                const bool sv = lane <= qb, forced = (lane == 0) || (lane == qb) || (lane + 1 == qb);
                const float score = sv ? (forced ? 1e9f : imp) : -1.f;
                int rank = 0;
#pragma unroll 4
                for (int i = 0; i < 64; ++i) { const float si = __uint_as_float(__builtin_amdgcn_readlane(__float_as_uint(score), i)); rank += (si > score || (si == score && i < lane)) ? 1 : 0; }
                const unsigned long long mk = __ballot((rank < 16) && (score >= 0.f));
                um |= mk;
                if (lane == 0) msk_s[wid * 8 + tk] = mk;
            }
            if (lane == 0) { atomicOr(&uni_s[0], (unsigned)um); atomicOr(&uni_s[1], (unsigned)(um >> 32)); }
        }
        __syncthreads();
        const unsigned long long selm = msk_s[wid * 8 + (r & 7)];
        const unsigned long long uni = (unsigned long long)uni_s[0] | ((unsigned long long)uni_s[1] << 32);
        attn_branch<1>(lds, KS + (size_t)bhh * S * 64, VST + (size_t)bhh * 64 * S, S, uni, t, 0, selm, 0, tw0 + 7, 0, tw0, qr, O, IM, l, ovt, tid, r, h, pr);
        {
            const float lt = l + xshfl(l, 32), sc = g1 / lt;
#pragma unroll
            for (int i = 0; i < 16; ++i) { acc[0][i] += O[0][i] * sc; acc[1][i] += O[1][i] * sc; }
        }
        {
            const int jlo = qb >= 8 ? qb - 8 : 0;
            const unsigned long long bm = (qb >= 63 ? ~0ull : ((1ull << (qb + 1)) - 1ull)) & ~((1ull << jlo) - 1ull);
            attn_branch<2>(lds, KW + (size_t)bhh * S * 64, VWT + (size_t)bhh * 64 * S, S, bm, t, 0, 0ull, tw0 - 511, tw0 + 7, tw0 + 7 - 511, tw0, qr, O, IM, l, ovt, tid, r, h, pr);
        }
        {
            const float lt = l + xshfl(l, 32), sc = g2 / lt;
            bf16* op = hn + tok * D + (hk * 4 + g) * 64 + 4 * h;
#pragma unroll
            for (int dt = 0; dt < 2; ++dt)
#pragma unroll
                for (int q4 = 0; q4 < 4; ++q4) {
                    u32x2 w; w.x = pkbf(acc[dt][4 * q4] + O[dt][4 * q4] * sc, acc[dt][4 * q4 + 1] + O[dt][4 * q4 + 1] * sc);
                    w.y = pkbf(acc[dt][4 * q4 + 2] + O[dt][4 * q4 + 2] * sc, acc[dt][4 * q4 + 3] + O[dt][4 * q4 + 3] * sc);
                    *(u32x2*)(op + 32 * dt + 8 * q4) = w;
                }
        }
    }
}


#define LAS __attribute__((address_space(3)))
#define XB_TMO      128
#define XB_XCNT(j)  (256  + 64 * (j))
#define XB_XSUB(j)  (1280 + 64 * (j))
#define XB_XGEN(j)  (2304 + 64 * (j))
#define XB_TOP      3328
#define XB_TOPGEN   3392
#define XCD_BAR_WORDS 3456
#define XB_SPIN_CAP (1u << 18)

__device__ __forceinline__ unsigned xb_ld(unsigned* p)              { return __hip_atomic_load(p, __ATOMIC_RELAXED, __HIP_MEMORY_SCOPE_AGENT); }
__device__ __forceinline__ unsigned xb_add(unsigned* p, unsigned v) { return __hip_atomic_fetch_add(p, v, __ATOMIC_RELAXED, __HIP_MEMORY_SCOPE_AGENT); }
__device__ __forceinline__ unsigned xb_xcc_id() { return (unsigned)__builtin_amdgcn_s_getreg((3 << 11) | 20) & 0xFu; }
#define XB_SPIN(cond, bar) do { unsigned _sp = 0; while (cond) { __builtin_amdgcn_s_sleep(1); \
    if ((++_sp & 255u) == 0u) { if (xb_ld(&(bar)[XB_TMO])) break; if (_sp > XB_SPIN_CAP) { atomicAdd(&(bar)[XB_TMO], 1u); break; } } } } while (0)

struct XcdBarrier {
    unsigned* bar; unsigned x;
    volatile LAS unsigned* st;
};

__device__ __forceinline__ XcdBarrier xcd_barrier_post(unsigned* bar, volatile LAS unsigned* st) {
    XcdBarrier b; b.bar = bar; b.x = xb_xcc_id(); b.st = st;
    if (threadIdx.x == 0) (void)xb_add(&bar[XB_XCNT(b.x)], 1u);
    return b;
}
__device__ __forceinline__ void xcd_barrier_complete(unsigned* bar, unsigned x, unsigned& nloc, unsigned& nx) {
    const unsigned G = gridDim.x * gridDim.y * gridDim.z;
    unsigned sum, cnt, mine, sp = 0u;
    for (;;) {
        sum = 0u; cnt = 0u; mine = 0u;
#pragma unroll
        for (unsigned j = 0; j < 16; ++j) { const unsigned c = xb_ld(&bar[XB_XCNT(j)]); sum += c; cnt += (c > 0u) ? 1u : 0u; mine = (j == x) ? c : mine; }
        if (sum == G) break;
        __builtin_amdgcn_s_sleep(1);
        if ((++sp & 255u) == 0u) { if (xb_ld(&bar[XB_TMO])) break; if (sp > XB_SPIN_CAP) { atomicAdd(&bar[XB_TMO], 1u); break; } }
    }
    nloc = mine > 0u ? mine : 1u; nx = cnt > 0u ? cnt : 1u;
}

__device__ __forceinline__ void xcd_barrier(const XcdBarrier& b) {
    asm volatile("s_waitcnt vmcnt(0)" ::: "memory");
    __syncthreads();
    if (threadIdx.x == 0) {
        unsigned* bar = b.bar;
        __builtin_amdgcn_s_waitcnt(0);
        unsigned nloc = b.st[0], nx = b.st[1];
        if (nloc == 0u) { xcd_barrier_complete(bar, b.x, nloc, nx); b.st[0] = nloc; b.st[1] = nx; }
        const unsigned old = xb_add(&bar[XB_XSUB(b.x)], 1u);
        const unsigned gen = old / nloc;
        if (old + 1u == (gen + 1u) * nloc) {
            __builtin_amdgcn_fence(__ATOMIC_RELEASE, "agent");
            asm volatile("s_waitcnt vmcnt(0)" ::: "memory");
            const unsigned og = xb_add(&bar[XB_TOP], 1u);
            const unsigned tg = og / nx;
            if (og + 1u == (tg + 1u) * nx) xb_add(&bar[XB_TOPGEN], 1u);
            else XB_SPIN(xb_ld(&bar[XB_TOPGEN]) == tg, bar);
            __builtin_amdgcn_fence(__ATOMIC_ACQUIRE, "agent");
            xb_add(&bar[XB_XGEN(b.x)], 1u);
            asm volatile("s_waitcnt vmcnt(0)" ::: "memory");
        } else {
            XB_SPIN(xb_ld(&bar[XB_XGEN(b.x)]) == gen, bar);
            __builtin_amdgcn_fence(__ATOMIC_ACQUIRE, "agent");
            asm volatile("s_waitcnt vmcnt(0)" ::: "memory");
        }
    }
    __syncthreads();
}

struct Args { const void* in[24]; float* out; unsigned char* ws; int lo, hi; };

__host__ __device__ constexpr int mixer_inner_phases(int kind) { return kind == 0 ? 4 : (kind == 1 ? 1 : 4); }
__host__ __device__ constexpr int total_phases() { int n = 1; for (int L = 0; L < DEPTH; ++L) n += 4 + 2 + mixer_inner_phases(L % 3); return n; }

__global__ void __launch_bounds__(512, 2) mega(Args args) {
    extern __shared__ __attribute__((aligned(16))) unsigned char lds[];
    cg::grid_group grid = cg::this_grid();
    volatile LAS unsigned* bst = (volatile LAS unsigned*)((LAS unsigned char*)lds + (LDS_BYTES - 64));
    if (threadIdx.x < 2) bst[threadIdx.x] = 0u;
    __syncthreads();
    const XcdBarrier xbar = xcd_barrier_post((unsigned*)args.ws, bst);
    bool again = false;
    for (int ph = args.lo; ph < args.hi; ++ph) {
        int type = 0, s = 0, L = 0;
        if (ph > 0) {
            int p = ph - 1;
            for (L = 0; L < DEPTH; ++L) { const int n = 6 + mixer_inner_phases(L % 3); if (p < n) break; p -= n; }
            const int inner = mixer_inner_phases(L % 3), kind = L % 3;
            if (p < 2) { type = 2 + p; s = 2 * L; }
            else if (p == 2) type = 5;
            else if (p < 3 + inner) { const int q = p - 3; type = kind == 0 ? (q == 0 ? 14 : (q == 1 ? 15 : 4 + q)) : (kind == 1 ? 8 : 9 + q); }
            else if (p == 3 + inner) type = 13;
            else { type = 2 + (p - 4 - inner); s = 2 * L + 1; }
        }
        int tid_ = threadIdx.x; asm volatile("" : "+v"(tid_));
        int G_ = gridDim.x, bx_ = blockIdx.x; asm volatile("" : "+s"(G_), "+s"(bx_));
        const int tid = tid_, lane = tid & 63, wid = __builtin_amdgcn_readfirstlane(tid >> 6);
        const int G = G_, bx = bx_;
        const int vcu = (G % 8 == 0) ? (bx % 8) * (G / 8) + bx / 8 : bx;
        const int gw = vcu * 8 + wid, NGW = G * 8;
        unsigned char* ws = args.ws; asm volatile("" : "+s"(ws));
        PG8_LAS unsigned char* ldsl = (PG8_LAS unsigned char*)lds;
        float* hout = args.out; asm volatile("" : "+s"(hout));
        bf16* HN = (bf16*)(ws + WS_HN);
        bf16* RB = (bf16*)(ws + WS_R);
        f32x2* tab = (f32x2*)(ws + WS_TAB);
        const int kind = L % 3, jj = L / 3;
        bf16* QN = RB + (size_t)T * 2560;
        bf16* KSb = QN + (size_t)T * 1024;
        bf16* KWb = KSb + (size_t)T * 256;
        bf16* KCH = (bf16*)(ws + WS_O32);
        bf16* VCH = KCH + (size_t)T * 256;
        float* Pk = (float*)(ws + WS_O32 + 32 * MiB);
        float* Pv = Pk + (size_t)8192 * 512;
        bf16* KC = (bf16*)(ws + WS_O32 + 64 * MiB);
        bf16* VC = (bf16*)(ws + WS_O32 + 65 * MiB);
        bf16* OVT = (bf16*)(ws + WS_BP + 65536);
        bf16* VST = (bf16*)(ws + WS_O32 + 68 * MiB);
        bf16* VWT = (bf16*)(ws + WS_O32 + 84 * MiB);
        switch (type) {
        case 0: {
            float* scr = (float*)lds + wid * (64 * 33);
            for (int mi = 0; mi < 28; ++mi) {
                const float* W; const float* nw = nullptr; int K, N, Npad, mode = 0; bf16* WT;
                if (mi < 8)       { nw = (const float*)args.in[2] + (size_t)mi * D; W = (const float*)args.in[3] + (size_t)mi * D * 2 * FF; K = D; N = 2 * FF; Npad = N; mode = 1; WT = (bf16*)(ws + WS_WGU) + (size_t)mi * 2 * FF * D; }
                else if (mi < 16) { const int i = mi - 8; W = (const float*)args.in[4] + (size_t)i * FF * D; K = FF; N = D; Npad = N; WT = (bf16*)(ws + WS_WDN) + (size_t)i * D * FF; }
                else if (mi < 18) { const int i = mi - 16; nw = (const float*)args.in[5] + (size_t)(3 * i) * D; W = (const float*)args.in[6] + (size_t)i * D * 4112; K = D; N = 4112; Npad = GDN_NPAD; WT = (bf16*)(ws + WS_WGI) + (size_t)i * GDN_NPAD * D; }
                else if (mi < 20) { const int i = mi - 18; W = (const float*)args.in[11] + (size_t)i * D * D; K = D; N = D; Npad = N; WT = (bf16*)(ws + WS_WGO) + (size_t)i * D * D; }
                else if (mi == 20) { nw = (const float*)args.in[5] + (size_t)1 * D; W = (const float*)args.in[12]; K = D; N = 3072; Npad = N; WT = (bf16*)(ws + WS_WSI); }
                else if (mi == 21) { W = (const float*)args.in[14]; K = D; N = D; Npad = N; WT = (bf16*)(ws + WS_WSO); }
                else if (mi == 22) { nw = (const float*)args.in[5] + (size_t)2 * D; W = (const float*)args.in[15]; K = D; N = 2608; Npad = NSA_NPAD; WT = (bf16*)(ws + WS_WNI); }
                else if (mi == 23) { W = (const float*)args.in[23]; K = D; N = D; Npad = N; WT = (bf16*)(ws + WS_WNO); }
                else { const int i = mi - 24, kd = i >> 1, hf = i & 1;
                    W = (const float*)args.in[19] + (size_t)kd * 2048 * 256 + (size_t)hf * 1024 * 256; K = 1024; N = 256; Npad = 256; WT = (bf16*)(ws + WS_WC1) + (size_t)kd * 512 * 1024 + (size_t)hf * 256 * 1024; }
                xpose_matrix(W, nw, K, N, Npad, WT, mode, scr, gw, NGW, lane);
            }
            {
                float* ss = (float*)(ws + WS_SS);
                const float* xin = (const float*)args.in[0];
                for (int m = gw; m < T; m += NGW) {
                    const f32x4* xr = (const f32x4*)(xin + (size_t)m * D) + lane; u32x2* o8 = (u32x2*)(HN + (size_t)m * D) + lane; float sq = 0.f;
#pragma unroll
                    for (int j = 0; j < 4; ++j) { const f32x4 v = xr[64 * j]; sq += (v.x * v.x + v.y * v.y) + (v.z * v.z + v.w * v.w); u32x2 o; o.x = pkbf(v.x, v.y); o.y = pkbf(v.z, v.w); o8[64 * j] = o; }
                    sq = wave_sum(sq); if (lane < 16) ss[(size_t)m * 16 + lane] = lane == 0 ? sq : 0.f;
                }
            }
            const int* positions = (const int*)args.in[1];
            for (int idx = bx * 512 + tid; idx < T * 32; idx += G * 512) {
                const int tk = idx >> 5, i = idx & 31;
                const float inv = 1.0f / exp2f((float)(2 * i) * (13.287712379549449f / 64.f));
                const float ang = (float)positions[tk] * inv;
                const double rev = (double)ang * 0.15915494309189535;
                const float fr = (float)(rev - rint(rev));
                f32x2 v; v.x = __builtin_amdgcn_cosf(fr); v.y = __builtin_amdgcn_sinf(fr);
                tab[idx] = v;
            }
            for (int idx = bx * 512 + tid; idx < 64 * 256; idx += G * 512) {
                const int sj = idx >> 8, i = idx & 255, q = i >> 2, rem = i & 3;
                OVT[idx] = (bf16)(rem < 3 ? (q == sj ? 0x3F80 : 0) : ((q == sj || q + 1 == sj) ? 0x3F00 : 0));
            }
            if (bx < 2 && tid < 256) {
                const float* pe = (const float*)args.in[18] + (size_t)bx * 2048;
                const float* w1 = (const float*)args.in[19] + (size_t)bx * 2048 * 256 + tid;
                float acc = ((const float*)args.in[20])[bx * 256 + tid];
                for (int k = 0; k < 2048; ++k) acc += pe[k] * w1[(size_t)k * 256];
                ((float*)(ws + WS_BP))[bx * 256 + tid] = acc;
            }
        } break;
        case 2: {
            const bf16* Ah = (s & 1) ? (const bf16*)(ws + WS_R + 192 * MiB) : HN;
            pg8::Gemm g{Ah, (const bf16*)(ws + WS_WGU) + (size_t)s * 2 * FF * D, T, 2 * FF, D}; pg8::StaticOrder SO; SO.init(T, 2 * FF, G, bx);
            float* rtab = (float*)(lds + 131072);
            rstd_table(rtab, (const float*)(ws + WS_SS) + (size_t)s * T * 16, SO, tid);
            pg8::EpiSwiGLU E{RB, rtab};
            pg8::gemm_phase<pg8::EpiSwiGLU, pg8::StaticOrder, true, true>(ldsl, g, SO, E, tid); } break;
        case 3: {
            pg8::Gemm g{RB, (const bf16*)(ws + WS_WDN) + (size_t)s * D * FF, T, D, FF}; pg8::StaticOrder SO; SO.init(T, D, G, bx);
            const int slot = (s & 1) ? (s < 7 ? s + 1 : 12) : 8 + (s >> 1);
            pg8::EpiResid<1> E{s == 0 ? (const float*)args.in[0] : hout, hout, HN, (float*)(ws + WS_SS) + (size_t)slot * T * 16};
            pg8::gemm_phase<pg8::EpiResid<1>, pg8::StaticOrder, true, true>(ldsl, g, SO, E, tid); } break;
        case 5: {
            const bf16* Wt; int Np, ldc, nmain, ldt, nvalid; float* tail;
            if (kind == 0) { Wt = (const bf16*)(ws + WS_WGI) + (size_t)jj * GDN_NPAD * D; Np = GDN_NPAD; ldc = 4096; nmain = 4096; tail = (float*)(ws + WS_AB); ldt = 16; nvalid = 4112; }
            else if (kind == 1) { Wt = (const bf16*)(ws + WS_WSI); Np = 3072; ldc = 3072; nmain = 3072; tail = (float*)(ws + WS_AB); ldt = 16; nvalid = 3072; }
            else { Wt = (const bf16*)(ws + WS_WNI); Np = NSA_NPAD; ldc = 2560; nmain = 2560; tail = (float*)(ws + WS_GT); ldt = 48; nvalid = 2608; }
            pg8::Gemm g{HN, Wt, T, Np, D}; pg8::StaticOrder SO; SO.init(T, Np, G, bx);
            float* rtab = (float*)(lds + 131072);
            rstd_table(rtab, (const float*)(ws + WS_SS) + (size_t)(8 + L) * T * 16, SO, tid);
            pg8::EpiProj E{RB, ldc, nmain, tail, ldt, nvalid, rtab};
            pg8::gemm_phase<pg8::EpiProj, pg8::StaticOrder, true, true>(ldsl, g, SO, E, tid); } break;
        case 14: phase_gdn_halo(RB, (bf16*)(ws + WS_HALO), vcu * 512 + tid, G * 512); break;
        case 15: phase_gdn_prep(lds, RB, (const bf16*)(ws + WS_HALO), (const float*)(ws + WS_AB), (const float*)args.in[7] + (size_t)jj * 4 * 3072, (const float*)args.in[8] + jj * 8, (const float*)args.in[9] + jj * 8,
                                HN, (bf16*)(ws + WS_O32 + 64 * MiB), (float*)(ws + WS_GL), bx, G, tid, wid, lane); break;
        case 6:
#ifndef DIS_SCAN
            phase_gdn_scan2(lds, RB, HN, (const bf16*)(ws + WS_O32 + 64 * MiB), (const float*)(ws + WS_GL), (bf16*)(ws + WS_O32), bx, G, tid, wid, lane);
#endif
            break;
        case 7:
#ifndef DIS_GPOST
            phase_gdn_post((const bf16*)(ws + WS_O32), RB, (const float*)args.in[10] + jj * 128, HN, gw, NGW, lane);
#endif
            break;
        case 8:
#ifndef DIS_SPOST
            phase_sc_post(RB, (const float*)args.in[13], HN, vcu * 512 + tid, G * 512);
#endif
            break;
        case 9:
#ifndef DIS_NPOST
            phase_nsa_post(lds, RB, (const float*)args.in[16], (const float*)args.in[17], tab, QN, KSb, KWb, KCH, VCH, VST, VWT, gw, NGW, wid, lane);
#endif
            break;
        case 10: {
            pg8::Gemm g{KCH, (const bf16*)(ws + WS_WC1), 8192, 512, 1024}; pg8::StaticOrder SO; SO.init(8192, 512, G, bx);
            pg8::Gemm g2{VCH, (const bf16*)(ws + WS_WC1) + (size_t)512 * 1024, 8192, 512, 1024};
            pg8::EpiF32 E{Pk, 512};
            if (bx >= G / 2) { g = g2; SO.init(8192, 512, G, bx - G / 2); E.C = Pv; }
            pg8::gemm_phase<pg8::EpiF32, pg8::StaticOrder, true, true>(ldsl, g, SO, E, tid); } break;
        case 11:
#ifndef DIS_CMP2
            phase_cmp2(lds, Pk, Pv, (const float*)(ws + WS_BP), (const float*)args.in[21], (const float*)args.in[22], (const float*)args.in[17], KC, VC, gw, NGW, wid, lane);
#endif
            break;
        case 12:
#ifndef DIS_ATTN
            phase_nsa_attn(lds, QN, KSb, KWb, VST, VWT, KC, VC, OVT, (const float*)(ws + WS_GT), tab, HN, bx, G, tid, wid, lane);
#endif
            break;
        default: {
            const bf16* Wout = kind == 0 ? (const bf16*)(ws + WS_WGO) + (size_t)jj * D * D : (kind == 1 ? (const bf16*)(ws + WS_WSO) : (const bf16*)(ws + WS_WNO));
            pg8::Gemm g{HN, Wout, T, D, D}; pg8::StaticOrder SO; SO.init(T, D, G, bx);
            pg8::EpiResid<2> E{hout, hout, (bf16*)(ws + WS_R + 192 * MiB), (float*)(ws + WS_SS) + (size_t)(2 * L + 1) * T * 16};
            pg8::gemm_phase<pg8::EpiResid<2>, pg8::StaticOrder, true, true>(ldsl, g, SO, E, tid); } break;
        }
#ifdef REP_TYPE
        if (type == REP_TYPE && !again) { again = true; xcd_barrier(xbar); --ph; continue; }
        again = false;
#endif
        if (ph + 1 < args.hi) { if (ph == 0) grid.sync(); else xcd_barrier(xbar); }
    }
}

extern "C" void kernel_launch(void* const* d_in, const int* in_sizes, int n_in, void* d_out, int out_size, void* d_ws, size_t ws_size, hipStream_t stream) {
    static int grid = 0;
    if (grid == 0) {
        if (n_in != 24 || out_size != T * D || ws_size < WS_END2) { fprintf(stderr, "kernel_launch: unexpected shapes n_in %d out %d ws %zu (need %zu)\n", n_in, out_size, ws_size, (size_t)WS_END2); grid = -1; return; }
        int dev = 0, cus = 0, per_cu = 0;
        hipGetDevice(&dev); hipDeviceGetAttribute(&cus, hipDeviceAttributeMultiprocessorCount, dev);
        if (hipFuncSetAttribute((const void*)mega, hipFuncAttributeMaxDynamicSharedMemorySize, LDS_BYTES) != hipSuccess) { fprintf(stderr, "kernel_launch: hipFuncSetAttribute failed\n"); grid = -1; return; }
        if (hipOccupancyMaxActiveBlocksPerMultiprocessor(&per_cu, (const void*)mega, 512, LDS_BYTES) != hipSuccess || per_cu < 1) { fprintf(stderr, "kernel_launch: occupancy query says %d\n", per_cu); per_cu = 1; }
        (void)hipGetLastError();
        grid = cus;
    }
    if (grid < 0) return;
    Args a{};
    for (int i = 0; i < 24; ++i) a.in[i] = d_in[i];
    a.out = (float*)d_out; a.ws = (unsigned char*)d_ws;
    constexpr int NPH = total_phases();
#if MK_MULTI
    for (int p = 0; p < NPH; ++p) { a.lo = p; a.hi = p + 1; hipLaunchKernelGGL(mega, dim3(grid), dim3(512), LDS_BYTES, stream, a); }
#else
    a.lo = 0; a.hi = NPH;
    (void)hipMemsetAsync(d_ws, 0, 16384, stream);
    void* kargs[] = {&a};
    hipError_t e = hipLaunchCooperativeKernel((const void*)mega, dim3(grid), dim3(512), kargs, LDS_BYTES, stream);
    if (e != hipSuccess) fprintf(stderr, "cooperative launch failed: %s (grid %d)\n", hipGetErrorString(e), grid);
#endif
}
```

```cpp
#include <hip/hip_runtime.h>
#include <hip/hip_cooperative_groups.h>
#include <cstdio>
#include <cstdint>
namespace cg = cooperative_groups;
namespace pg8 {
#define PG8_LAS __attribute__((address_space(3)))
typedef unsigned short bf16_t;
typedef short bf16x8 __attribute__((ext_vector_type(8)));
typedef float f32x4 __attribute__((ext_vector_type(4)));
typedef unsigned u32x4 __attribute__((ext_vector_type(4)));
constexpr int BM = 256, BK = 64, HALF = 128, HTB = HALF * BK * 2  , STAGE_BYTES = 8 * HTB, NXCD = 8, WGM = 8;

__host__ __device__ __forceinline__ int lds_byte(int r, int c) { const int st = (r >> 4) * 2 + (c >> 5), rr = r & 15, cc = c & 31, ob = rr * 64 + cc * 2; return st * 1024 + (ob ^ (((ob >> 9) & 1) << 5)); }
__host__ __device__ __forceinline__ void stage_rc(int b, int& R, int& C) { const int st = b / 1024, sb = b % 1024, swz = sb ^ (((sb >> 9) & 1) << 5); R = (st >> 1) * 16 + swz / 64; C = (st & 1) * 32 + (swz % 64) / 2; }
__host__ __device__ __forceinline__ int perm32(int rho) { const int n = rho >> 4, i = rho & 15; return 8 * (i >> 2) + 4 * n + (i & 3); }

struct Unit { int pm, pn, ord; };
struct Gemm { const bf16_t* A; const bf16_t* Bt; int M, N, K; };

struct StaticOrder {
    int nM, nN, nwg, G, c;
    __host__ __device__ void init(int M, int N, int G_, int c_) { nM = M / BM; nN = N / BM; nwg = nM * nN; G = G_; c = c_; }
    __host__ __device__ bool next(int i, Unit& u) const {
        const long L = (long)i * G + c; if (L >= nwg) return false;
        int wgid = (int)L; { const int q = nwg / NXCD, r = nwg % NXCD, xcd = wgid % NXCD, off = wgid / NXCD; wgid = (xcd < r ? xcd * (q + 1) : r * (q + 1) + (xcd - r) * q) + off; }
        const int nig = WGM * nN, gid = wgid / nig, fm = gid * WGM, gsz = (nM - fm) < WGM ? (nM - fm) : WGM;
        u.pm = fm + ((wgid % nig) % gsz); u.pn = (wgid % nig) / gsz; u.ord = i; return true;
    }
    __device__ __forceinline__ void a_ready(const Unit&) const {}
    __device__ __forceinline__ void done(const Unit&) const {}
};
__device__ __forceinline__ unsigned cvt_pk_bf16(float lo, float hi) { unsigned r; asm volatile("v_cvt_pk_bf16_f32 %0, %1, %2" : "=v"(r) : "v"(lo), "v"(hi)); return r; }
template <class Epi, class Sched, bool ALIGN_EPI = false, bool SP2 = false>
__device__ __forceinline__ void gemm_phase(PG8_LAS unsigned char* lds, const Gemm g, const Sched& S, const Epi& E, const int tid) {
    const int wid = __builtin_amdgcn_readfirstlane(tid >> 6), lane = tid & 63, wr = wid >> 2, wc = wid & 3, fr = lane & 15, fq = lane >> 4;
    const int K = g.K, nt = K / BK;
    unsigned voffA[2], voffB[2];
#pragma unroll
    for (int i = 0; i < 2; ++i) { int R, C; stage_rc(tid * 16 + i * 8192, R, C); const int Rb = Epi::PERM ? ((R & ~31) + perm32(R & 31)) : R;
        voffA[i] = (unsigned)(R * K + C) * 2u; voffB[i] = (unsigned)(Rb * K + C) * 2u; }
    const size_t kstep = (size_t)(BK * 2);
    const size_t hstep = (size_t)HALF * K * 2;
    const size_t tstep = 2 * hstep;
    const unsigned ldsw = (unsigned)wid * 1024u;
    const int aoff = lds_byte(wr * 64 + fr, fq * 8), boff = lds_byte(wc * 32 + fr, fq * 8);
#define PG8_SA(b, h) (((b) * 2 + (h)) * HTB)
#define PG8_SB(b, h) ((4 + (b) * 2 + (h)) * HTB)
#define PG8_STAGE(bufoff, gbase, voff) do { _Pragma("unroll") for (int _i = 0; _i < 2; ++_i) \
        __builtin_amdgcn_global_load_lds((const unsigned*)((const char*)(gbase) + (voff)[_i]), (PG8_LAS unsigned*)(lds + (bufoff) + ldsw + _i * 8192), 16, 0, 0); } while (0)
#define PG8_LDA(dst, b, h) do { _Pragma("unroll") for (int m = 0; m < 4; ++m) _Pragma("unroll") for (int k = 0; k < 2; ++k) dst[m][k] = *(const PG8_LAS bf16x8*)(lds + PG8_SA(b, h) + aoff + m * 2048 + k * 1024); } while (0)
#define PG8_LDB(dst, b, h) do { _Pragma("unroll") for (int n = 0; n < 2; ++n) _Pragma("unroll") for (int k = 0; k < 2; ++k) dst[n][k] = *(const PG8_LAS bf16x8*)(lds + PG8_SB(b, h) + boff + n * 2048 + k * 1024); } while (0)
#define PG8_MMA(ai, bj, At, Bt) do { __builtin_amdgcn_s_setprio(1); _Pragma("unroll") for (int m = 0; m < 4; ++m) _Pragma("unroll") for (int n = 0; n < 2; ++n) _Pragma("unroll") for (int k = 0; k < 2; ++k) \
        acc[ai][bj][m][n] = __builtin_amdgcn_mfma_f32_16x16x32_bf16(Bt[n][k], At[m][k], acc[ai][bj][m][n], 0, 0, 0); __builtin_amdgcn_s_setprio(0); } while (0)
#define PG8_WAIT_V(n) asm volatile("s_waitcnt vmcnt(" #n ")" ::: "memory")
#define PG8_WAIT_L(n) asm volatile("s_waitcnt lgkmcnt(" #n ")" ::: "memory")
#define PG8_BAR __builtin_amdgcn_s_barrier()
#define PG8_SCHED __builtin_amdgcn_sched_barrier(0)
    Unit cur, nxt; int ui = 0;
    if (!S.next(0, cur)) return;
    f32x4 acc[2][2][4][2];
#pragma unroll
    for (int a = 0; a < 2; ++a)
#pragma unroll
        for (int b = 0; b < 2; ++b)
#pragma unroll
            for (int m = 0; m < 4; ++m)
#pragma unroll
                for (int n = 0; n < 2; ++n) acc[a][b][m][n] = (f32x4){0.f, 0.f, 0.f, 0.f};
    bf16x8 At[4][2], B0[2][2], B1[2][2];
    const char* cA = (const char*)g.A + (size_t)cur.pm * tstep; const char* cB = (const char*)g.Bt + (size_t)cur.pn * tstep;
    S.a_ready(cur);
    if constexpr (SP2) {
        PG8_STAGE(PG8_SB(0, 0), cB, voffB); PG8_STAGE(PG8_SB(0, 1), cB + hstep, voffB); PG8_STAGE(PG8_SA(0, 0), cA, voffA); PG8_STAGE(PG8_SA(0, 1), cA + hstep, voffA);
        if (wr == 1) PG8_BAR;
        PG8_WAIT_V(2); PG8_BAR;
        PG8_STAGE(PG8_SB(1, 0), cB + kstep, voffB); PG8_STAGE(PG8_SA(1, 0), cA + kstep, voffA); PG8_STAGE(PG8_SB(1, 1), cB + hstep + kstep, voffB);
        PG8_WAIT_V(6); PG8_BAR;
    } else {
        PG8_STAGE(PG8_SB(0, 0), cB, voffB); PG8_STAGE(PG8_SA(0, 0), cA, voffA); PG8_STAGE(PG8_SB(0, 1), cB + hstep, voffB); PG8_STAGE(PG8_SA(0, 1), cA + hstep, voffA);
        if (wr == 1) PG8_BAR;
        PG8_WAIT_V(4); PG8_BAR;
        PG8_STAGE(PG8_SB(1, 0), cB + kstep, voffB); PG8_STAGE(PG8_SA(1, 0), cA + kstep, voffA); PG8_STAGE(PG8_SB(1, 1), cB + hstep + kstep, voffB);
        PG8_WAIT_V(6); PG8_BAR;
    }
    for (;;) {
        const bool has_next = S.next(ui + 1, nxt);
        const char* nA = has_next ? (const char*)g.A + (size_t)nxt.pm * tstep : cA; const char* nB = has_next ? (const char*)g.Bt + (size_t)nxt.pn * tstep : cB;
        for (int t = 0; t < nt; t += 2) {
            const bool last = (t == nt - 2);
            const char* a1 = cA + (size_t)(t + 1) * kstep;
            const char* a2 = last ? nA : cA + (size_t)(t + 2) * kstep; const char* b2 = last ? nB : cB + (size_t)(t + 2) * kstep;
            const char* a3 = a2 + kstep; const char* b3 = b2 + kstep;
            if (last && has_next) S.a_ready(nxt);
            if constexpr (SP2) {
            PG8_LDB(B0, 0, 0); PG8_LDB(B1, 0, 1); PG8_SCHED; PG8_LDA(At, 0, 0); PG8_STAGE(PG8_SA(1, 1), a1 + hstep, voffA);
            PG8_WAIT_V(8); PG8_WAIT_L(0); PG8_BAR; PG8_MMA(0, 0, At, B0); PG8_MMA(0, 1, At, B1); PG8_BAR; PG8_SCHED;
            PG8_LDA(At, 0, 1); PG8_STAGE(PG8_SB(0, 0), b2, voffB); PG8_STAGE(PG8_SB(0, 1), b2 + hstep, voffB); PG8_STAGE(PG8_SA(0, 0), a2, voffA);
            PG8_WAIT_V(8); PG8_WAIT_L(0); PG8_BAR; PG8_MMA(1, 0, At, B0); PG8_MMA(1, 1, At, B1); PG8_BAR; PG8_SCHED;
            PG8_LDB(B0, 1, 0); PG8_LDB(B1, 1, 1); PG8_SCHED; PG8_LDA(At, 1, 0); PG8_STAGE(PG8_SA(0, 1), a2 + hstep, voffA);
            PG8_WAIT_V(8); PG8_WAIT_L(0); PG8_BAR; PG8_MMA(0, 0, At, B0); PG8_MMA(0, 1, At, B1); PG8_BAR; PG8_SCHED;
            PG8_LDA(At, 1, 1); PG8_STAGE(PG8_SB(1, 0), b3, voffB); PG8_STAGE(PG8_SB(1, 1), b3 + hstep, voffB); PG8_STAGE(PG8_SA(1, 0), a3, voffA);
            PG8_WAIT_V(8); PG8_WAIT_L(0); PG8_BAR; PG8_MMA(1, 0, At, B0); PG8_MMA(1, 1, At, B1); PG8_BAR; PG8_SCHED;
            } else {
            PG8_LDB(B0, 0, 0); PG8_SCHED; PG8_LDA(At, 0, 0); PG8_STAGE(PG8_SA(1, 1), a1 + hstep, voffA);
            PG8_WAIT_L(8); PG8_BAR; PG8_WAIT_L(0); PG8_MMA(0, 0, At, B0); PG8_BAR; PG8_SCHED;
            PG8_LDB(B1, 0, 1); PG8_STAGE(PG8_SB(0, 0), b2, voffB);
            PG8_BAR; PG8_WAIT_L(0); PG8_MMA(0, 1, At, B1); PG8_BAR;
            PG8_LDA(At, 0, 1); PG8_STAGE(PG8_SA(0, 0), a2, voffA);
            PG8_BAR; PG8_WAIT_L(0); PG8_MMA(1, 0, At, B0); PG8_BAR; PG8_SCHED;
            PG8_STAGE(PG8_SB(0, 1), b2 + hstep, voffB);
            PG8_WAIT_V(6); PG8_BAR; PG8_MMA(1, 1, At, B1); PG8_BAR;
            PG8_LDB(B0, 1, 0); PG8_SCHED; PG8_LDA(At, 1, 0); PG8_STAGE(PG8_SA(0, 1), a2 + hstep, voffA);
            PG8_WAIT_L(8); PG8_BAR; PG8_WAIT_L(0); PG8_MMA(0, 0, At, B0); PG8_BAR; PG8_SCHED;
            PG8_LDB(B1, 1, 1); PG8_STAGE(PG8_SB(1, 0), b3, voffB);
            PG8_BAR; PG8_WAIT_L(0); PG8_MMA(0, 1, At, B1); PG8_BAR;
            PG8_LDA(At, 1, 1); PG8_STAGE(PG8_SA(1, 0), a3, voffA);
            PG8_BAR; PG8_WAIT_L(0); PG8_MMA(1, 0, At, B0); PG8_BAR; PG8_SCHED;
            PG8_STAGE(PG8_SB(1, 1), b3 + hstep, voffB);
            PG8_WAIT_V(6); PG8_BAR; PG8_MMA(1, 1, At, B1); PG8_BAR;
            }
        }
        if constexpr (ALIGN_EPI) { if (wr == 0) PG8_BAR; }
        if constexpr (!Epi::AFTER_DRAIN) { E(acc, cur, wr, wc, fr, fq); S.done(cur); }
        if (!has_next) break;
#pragma unroll
        for (int a = 0; a < 2; ++a)
#pragma unroll
            for (int b = 0; b < 2; ++b)
#pragma unroll
                for (int m = 0; m < 4; ++m)
#pragma unroll
                    for (int n = 0; n < 2; ++n) acc[a][b][m][n] = (f32x4){0.f, 0.f, 0.f, 0.f};
        cur = nxt; cA = nA; cB = nB; ++ui;
        if constexpr (ALIGN_EPI) { if (wr == 1) PG8_BAR; }
    }
    PG8_WAIT_V(0);
    if constexpr (!ALIGN_EPI) { if (wr == 0) PG8_BAR; }
    PG8_BAR;
    if constexpr (Epi::AFTER_DRAIN) { E.fused(acc, cur, wr, wc, fr, fq, lds, wid, lane); S.done(cur); }
#undef PG8_SA
#undef PG8_SB
#undef PG8_STAGE
#undef PG8_LDA
#undef PG8_LDB
#undef PG8_MMA
#undef PG8_WAIT_V
#undef PG8_WAIT_L
#undef PG8_BAR
#undef PG8_SCHED
}
}

typedef unsigned short bf16;
typedef float f32x4 __attribute__((ext_vector_type(4)));
typedef float f32x2 __attribute__((ext_vector_type(2)));
typedef unsigned u32x4 __attribute__((ext_vector_type(4)));
typedef unsigned u32x2 __attribute__((ext_vector_type(2)));

#ifndef MK_MULTI
#define MK_MULTI 0
#endif

constexpr int Bn = 8, S = 4096, T = Bn * S, D = 1024, FF = 2816, DEPTH = 4;
constexpr float EPS = 1e-6f;
constexpr int GDN_NPAD = 4352, NSA_NPAD = 2816;
constexpr int LDS_BYTES = 147456;
constexpr size_t MiB = 1u << 20;
constexpr size_t WS_WGU = 1 * MiB;
constexpr size_t WS_WDN = WS_WGU + 88 * MiB;
constexpr size_t WS_WGI = WS_WDN + 44 * MiB;
constexpr size_t WS_WGO = WS_WGI + 17 * MiB;
constexpr size_t WS_WSI = WS_WGO + 4 * MiB;
constexpr size_t WS_WSO = WS_WSI + 6 * MiB;
constexpr size_t WS_WNI = WS_WSO + 2 * MiB;
constexpr size_t WS_WNO = WS_WNI + 6 * MiB;
constexpr size_t WS_WC1 = WS_WNO + 2 * MiB;
constexpr size_t WS_TAB = WS_WC1 + 2 * MiB;
constexpr size_t WS_HN  = 184 * MiB;
constexpr size_t WS_R   = WS_HN + 64 * MiB;
constexpr size_t WS_O32 = WS_R + 256 * MiB;
constexpr size_t WS_SM  = WS_O32 + 128 * MiB;
constexpr size_t WS_AB  = WS_SM;
constexpr size_t WS_GT  = WS_SM + 2 * MiB;
constexpr size_t WS_BP  = WS_SM + 8 * MiB;
constexpr size_t WS_END = WS_SM + 9 * MiB;
static_assert(WS_TAB + 8 * MiB <= WS_HN, "ws map");

__device__ __forceinline__ float bf2f(unsigned v) { return __uint_as_float(v << 16); }
__device__ __forceinline__ unsigned f2bf(float f) { unsigned u = __float_as_uint(f); return (u + 0x7fffu + ((u >> 16) & 1u)) >> 16; }
__device__ __forceinline__ unsigned pk2(float lo, float hi) { return f2bf(lo) | (f2bf(hi) << 16); }
#define MFMA32(a, b, c) __builtin_amdgcn_mfma_f32_32x32x16_bf16((a), (b), (c), 0, 0, 0)
typedef short bf16x8v __attribute__((ext_vector_type(8)));
typedef float f32x16 __attribute__((ext_vector_type(16)));
typedef __bf16 bf16v2 __attribute__((ext_vector_type(2)));
__device__ __forceinline__ unsigned pkbf(float a, float b) { f32x2 v = {a, b}; return __builtin_bit_cast(unsigned, __builtin_convertvector(v, bf16v2)); }
__device__ __forceinline__ int lane_opq() { int l = (int)__builtin_amdgcn_mbcnt_hi(~0u, __builtin_amdgcn_mbcnt_lo(~0u, 0u)); asm volatile("" : "+v"(l)); return l; }
__device__ __forceinline__ float xshfl(float v, int m) { return __int_as_float(__builtin_amdgcn_ds_bpermute((lane_opq() ^ m) << 2, __float_as_int(v))); }
__device__ __forceinline__ float xshfl_up(float v, int o) { return __int_as_float(__builtin_amdgcn_ds_bpermute((lane_opq() - o) << 2, __float_as_int(v))); }
__device__ __forceinline__ float wave_sum(float v) {
#pragma unroll
    for (int o = 1; o < 64; o <<= 1) v += xshfl(v, o);
    return v;
}
__device__ __forceinline__ float wave_max(float v) {
#pragma unroll
    for (int o = 1; o < 64; o <<= 1) v = fmaxf(v, xshfl(v, o));
    return v;
}
__device__ __forceinline__ float row_sum16(float v) {
    v += __uint_as_float((unsigned)__builtin_amdgcn_update_dpp(0, (int)__float_as_uint(v), 0x128, 0xf, 0xf, false));
    v += __uint_as_float((unsigned)__builtin_amdgcn_update_dpp(0, (int)__float_as_uint(v), 0x124, 0xf, 0xf, false));
    v += __uint_as_float((unsigned)__builtin_amdgcn_update_dpp(0, (int)__float_as_uint(v), 0x122, 0xf, 0xf, false));
    v += __uint_as_float((unsigned)__builtin_amdgcn_update_dpp(0, (int)__float_as_uint(v), 0x121, 0xf, 0xf, false));
    return v;
}
__device__ __forceinline__ float sigmoidf_(float x) { return 1.f / (1.f + __expf(-x)); }
__device__ __forceinline__ float siluf_(float x) { return x * __builtin_amdgcn_rcpf(1.f + __expf(-x)); }
#define WAVE_SYNC() do { asm volatile("s_waitcnt lgkmcnt(0)" ::: "memory"); __builtin_amdgcn_wave_barrier(); } while (0)

__device__ __forceinline__ float row_rstd(const float* ssq, size_t row) {
    const f32x4* p = (const f32x4*)(ssq + row * 16); const f32x4 a = p[0], b = p[1], c = p[2], d = p[3];
    const float t = ((a.x + a.y) + (a.z + a.w)) + ((b.x + b.y) + (b.z + b.w)) + ((c.x + c.y) + (c.z + c.w)) + ((d.x + d.y) + (d.z + d.w));
    return 1.f / sqrtf(t * (1.f / D) + EPS);
}
namespace pg8 {
struct EpiSwiGLU {
    static constexpr bool PERM = true, AFTER_DRAIN = false;
    bf16_t* O; const float* ssq;
    __device__ __forceinline__ void operator()(const f32x4 (&acc)[2][2][4][2], const Unit& u, int wr, int wc, int fr, int fq) const {
        const int row0 = u.pm * BM + wr * 64 + fr, col0 = u.pn * HALF + wc * 32 + 8 * fq;
#pragma unroll
        for (int ai = 0; ai < 2; ++ai)
#pragma unroll
            for (int m = 0; m < 4; ++m) {
                bf16_t* rowp = O + (size_t)(row0 + ai * HALF + m * 16) * FF + col0;
                const float rs = ssq[u.ord * 256 + wr * 64 + fr + ai * HALF + m * 16];
                float v[8];
#pragma unroll
                for (int n = 0; n < 2; ++n)
#pragma unroll
                    for (int j = 0; j < 4; ++j) { const float g = acc[ai][0][m][n][j] * rs, uu = acc[ai][1][m][n][j] * rs; v[n * 4 + j] = g * __builtin_amdgcn_rcpf(1.f + __expf(-g)) * uu; }
                u32x4 w; w.x = cvt_pk_bf16(v[0], v[1]); w.y = cvt_pk_bf16(v[2], v[3]); w.z = cvt_pk_bf16(v[4], v[5]); w.w = cvt_pk_bf16(v[6], v[7]);
                *(u32x4*)rowp = w;
            }
    }
};
template <int SC2> struct EpiResid {
    static constexpr bool PERM = true, AFTER_DRAIN = false;
    const float* base; float* out; bf16_t* HB; float* ssq;
    __device__ __forceinline__ void operator()(const f32x4 (&acc)[2][2][4][2], const Unit& u, int wr, int wc, int fr, int fq) const {
        constexpr float scale = 0.5f * SC2;
        const int row0 = u.pm * BM + wr * 64 + fr, col0 = u.pn * BM + wc * 32 + 8 * fq;
#pragma unroll
        for (int ai = 0; ai < 2; ++ai)
#pragma unroll
            for (int m = 0; m < 4; ++m) {
                const size_t off = (size_t)(row0 + ai * HALF + m * 16) * D + col0;
                float sq = 0.f;
#pragma unroll
                for (int bj = 0; bj < 2; ++bj) {
                    const f32x4 b0 = *(const f32x4*)(base + off + bj * HALF), b1 = *(const f32x4*)(base + off + bj * HALF + 4);
                    const f32x4 o0 = b0 + acc[ai][bj][m][0] * scale, o1 = b1 + acc[ai][bj][m][1] * scale;
                    *(f32x4*)(out + off + bj * HALF) = o0; *(f32x4*)(out + off + bj * HALF + 4) = o1;
                    { u32x4 w; w.x = cvt_pk_bf16(o0[0], o0[1]); w.y = cvt_pk_bf16(o0[2], o0[3]); w.z = cvt_pk_bf16(o1[0], o1[1]); w.w = cvt_pk_bf16(o1[2], o1[3]);
                        *(u32x4*)(HB + off + bj * HALF) = w;
                        sq += ((o0[0] * o0[0] + o0[1] * o0[1]) + (o0[2] * o0[2] + o0[3] * o0[3])) + ((o1[0] * o1[0] + o1[1] * o1[1]) + (o1[2] * o1[2] + o1[3] * o1[3])); }
                }
                { sq += xshfl(sq, 16); sq += xshfl(sq, 32); if (fq == 0) ssq[(size_t)(row0 + ai * HALF + m * 16) * 16 + u.pn * 4 + wc] = sq; }
                if (m == 3) asm volatile("" ::: "memory");
            }
    }
};
struct EpiProj {
    static constexpr bool PERM = true, AFTER_DRAIN = false;
    bf16_t* O; int ldc; int nmain; float* tail; int ldt; int nvalid; const float* ssq;
    __device__ __forceinline__ void operator()(const f32x4 (&acc)[2][2][4][2], const Unit& u, int wr, int wc, int fr, int fq) const {
        const int row0 = u.pm * BM + wr * 64 + fr, colt = u.pn * BM, col0 = colt + wc * 32 + 8 * fq;
        if (colt + BM <= nmain) {
#pragma unroll
            for (int ai = 0; ai < 2; ++ai)
#pragma unroll
                for (int m = 0; m < 4; ++m) {
                    bf16_t* rowp = O + (size_t)(row0 + ai * HALF + m * 16) * ldc + col0;
                    const float rs = ssq[u.ord * 256 + wr * 64 + fr + ai * HALF + m * 16];
#pragma unroll
                    for (int bj = 0; bj < 2; ++bj) { const f32x4 v0 = acc[ai][bj][m][0] * rs, v1 = acc[ai][bj][m][1] * rs;
                        u32x4 w; w.x = cvt_pk_bf16(v0[0], v0[1]); w.y = cvt_pk_bf16(v0[2], v0[3]); w.z = cvt_pk_bf16(v1[0], v1[1]); w.w = cvt_pk_bf16(v1[2], v1[3]);
                        *(u32x4*)(rowp + bj * HALF) = w; }
                }
        } else {
#pragma unroll
            for (int ai = 0; ai < 2; ++ai)
#pragma unroll
                for (int m = 0; m < 4; ++m) {
                    const size_t row = (size_t)(row0 + ai * HALF + m * 16);
                    const float rs = ssq[u.ord * 256 + wr * 64 + fr + ai * HALF + m * 16];
#pragma unroll
                    for (int bj = 0; bj < 2; ++bj)
#pragma unroll
                        for (int n = 0; n < 2; ++n)
#pragma unroll
                            for (int j = 0; j < 4; ++j) { const int col = col0 + bj * HALF + 4 * n + j; if (col >= nmain && col < nvalid) tail[row * ldt + (col - nmain)] = acc[ai][bj][m][n][j] * rs; }
                }
        }
    }
};
struct EpiF32 {
    static constexpr bool PERM = false, AFTER_DRAIN = false;
    float* C; int ldc;
    __device__ __forceinline__ void operator()(const f32x4 (&acc)[2][2][4][2], const Unit& u, int wr, int wc, int fr, int fq) const {
        const int row0 = u.pm * BM + wr * 64 + fr, col0 = u.pn * BM + wc * 32 + 4 * fq;
#pragma unroll
        for (int ai = 0; ai < 2; ++ai)
#pragma unroll
            for (int m = 0; m < 4; ++m) {
                float* rowp = C + (size_t)(row0 + ai * HALF + m * 16) * ldc + col0;
#pragma unroll
                for (int bj = 0; bj < 2; ++bj)
#pragma unroll
                    for (int n = 0; n < 2; ++n) *(f32x4*)(rowp + bj * HALF + n * 16) = acc[ai][bj][m][n];
            }
    }
};
}

template <class Sched>
__device__ __forceinline__ void rstd_table(float* tab, const float* ssq, const Sched& SO, int tid) {
    pg8::Unit u;
    int nu = 0; while (SO.next(nu, u)) ++nu;
    for (int k0 = 0; k0 < nu * 256; k0 += 512 * 3) {
        float t3[3];
#pragma unroll
        for (int k = 0; k < 3; ++k) { const int idx = k0 + 512 * k + tid; t3[k] = 0.f; if (idx < nu * 256) { SO.next(idx >> 8, u); t3[k] = row_rstd(ssq, (size_t)u.pm * 256 + (idx & 255)); } }
#pragma unroll
        for (int k = 0; k < 3; ++k) { const int idx = k0 + 512 * k + tid; if (idx < nu * 256) tab[idx] = t3[k]; }
    }
    __syncthreads();
}
__device__ __forceinline__ void xpose_item(const float* W, const float* nw, int K, int N, bf16* WT, int rowbase, float* scr, int k0, int n0, int lane) {
    if (n0 + 32 <= N && (N & 3) == 0) {
        f32x4 v[8];
#pragma unroll
        for (int i = 0; i < 8; ++i) { v[i] = *(const f32x4*)(W + (size_t)(k0 + 8 * i + (lane >> 3)) * N + n0 + 4 * (lane & 7)); if (nw) v[i] *= nw[k0 + 8 * i + (lane >> 3)]; }
#pragma unroll
        for (int i = 0; i < 8; ++i) { float* d = scr + (8 * i + (lane >> 3)) * 33 + 4 * (lane & 7); d[0] = v[i].x; d[1] = v[i].y; d[2] = v[i].z; d[3] = v[i].w; }
    } else {
#pragma unroll 8
        for (int i = 0; i < 32; ++i) { const int kk = 2 * i + (lane >> 5), n = n0 + (lane & 31); scr[kk * 33 + (lane & 31)] = n < N ? W[(size_t)(k0 + kk) * N + n] * (nw ? nw[k0 + kk] : 1.f) : 0.f; }
    }
    WAVE_SYNC();
    const int c = lane & 7;
#pragma unroll
    for (int j = 0; j < 4; ++j) { const int n = (lane >> 3) + 8 * j; const float* s = scr + (8 * c) * 33 + n;
        u32x4 o; o.x = pk2(s[0 * 33], s[1 * 33]); o.y = pk2(s[2 * 33], s[3 * 33]); o.z = pk2(s[4 * 33], s[5 * 33]); o.w = pk2(s[6 * 33], s[7 * 33]);
        *(u32x4*)(WT + (size_t)(rowbase + n) * K + k0 + 8 * c) = o; }
    WAVE_SYNC();
}
__device__ __forceinline__ void xpose_matrix(const float* W, const float* nw, int K, int N, int Npad, bf16* WT, int mode, float* scr, int gw, int NGW, int lane) {
    const int nblk = Npad / 32, nitems = (K / 64) * nblk;
    for (int it = gw; it < nitems; it += NGW) {
        const int kb = it / nblk, nb = it - kb * nblk, n0 = nb * 32;
        int rb = n0;
        if (mode == 1) rb = (n0 < FF) ? ((n0 >> 7) * 256 + (n0 & 127)) : ((((n0 - FF) >> 7) * 256) + 128 + ((n0 - FF) & 127));
        xpose_item(W, nw, K, N, WT, rb, scr, kb * 64, n0, lane);
    }
}

__device__ __forceinline__ void phase_norm(const float* h, const float* w, bf16* out, int gw, int NGW, int lane) {
    f32x4 wv[4];
#pragma unroll
    for (int j = 0; j < 4; ++j) wv[j] = ((const f32x4*)w)[64 * j + lane];
    for (int m = gw; m < T; m += NGW) {
        const f32x4* xr = (const f32x4*)(h + (size_t)m * D) + lane;
        f32x4 v[4]; float s = 0.f;
#pragma unroll
        for (int j = 0; j < 4; ++j) { v[j] = xr[64 * j]; s += (v[j].x * v[j].x + v[j].y * v[j].y) + (v[j].z * v[j].z + v[j].w * v[j].w); }
        const float rstd = 1.f / sqrtf(wave_sum(s) * (1.f / D) + EPS);
        u32x2* o8 = (u32x2*)(out + (size_t)m * D) + lane;
#pragma unroll
        for (int j = 0; j < 4; ++j) { u32x2 o; o.x = pk2(v[j].x * rstd * wv[j].x, v[j].y * rstd * wv[j].y); o.y = pk2(v[j].z * rstd * wv[j].z, v[j].w * rstd * wv[j].w); o8[64 * j] = o; }
    }
}

__device__ __forceinline__ void phase_gdn_scan(unsigned char* lds, const bf16* proj, const float* ab, const float* convw, const float* A_log, const float* dt_bias,
                                               float* o32, int vblk, int nblk, int tid, int wid, int lane) {
    float* qs = (float*)lds;
    float* ks = qs + 64 * 128;
    float* vs = ks + 64 * 128;
    float* al = vs + 64 * 32;
    float* be = al + 64;
    float* qk = be + 64;
    float* os = qk + 64;
    bf16* raw = (bf16*)(os + 64 * 32);
    const int e = tid >> 4, dl = tid & 15;
    for (int item = vblk; item < 256; item += nblk) {
        const int bh = (item & 7) + 8 * (item >> 5), es = (item >> 3) & 3, b = bh >> 3, h = bh & 7;
        const float Ah = __expf(A_log[h]), dtb = dt_bias[h];
        const int isk = (tid >> 4) & 1, cg = tid & 15, cv = tid & 3;
        const int colqk = isk * 1024 + h * 128 + cg * 8, colv = 2048 + h * 128 + es * 32 + cv * 8;
        f32x4 wq[4][2], wv[4][2];
#pragma unroll
        for (int j = 0; j < 4; ++j) { wq[j][0] = *(const f32x4*)(convw + j * 3072 + colqk); wq[j][1] = *(const f32x4*)(convw + j * 3072 + colqk + 4);
                                      wv[j][0] = *(const f32x4*)(convw + j * 3072 + colv);  wv[j][1] = *(const f32x4*)(convw + j * 3072 + colv + 4); }
        f32x2 S2[4];
#pragma unroll
        for (int i = 0; i < 4; ++i) S2[i] = (f32x2){0.f, 0.f};
        u32x4 pre[5];
#define GDN_PREFETCH(T0) do { _Pragma("unroll") for (int k_ = 0; k_ < 5; ++k_) { const int idx_ = tid + 512 * k_; const int row_ = idx_ / 36, c_ = idx_ - row_ * 36; const int ts_ = (T0) - 3 + row_; \
            const int col_ = c_ < 16 ? h * 128 + c_ * 8 : (c_ < 32 ? 1024 + h * 128 + (c_ - 16) * 8 : 2048 + h * 128 + es * 32 + (c_ - 32) * 8); \
            pre[k_] = (u32x4){0u, 0u, 0u, 0u}; if (idx_ < 67 * 36 && ts_ >= 0) pre[k_] = *(const u32x4*)(proj + (size_t)(b * S + ts_) * 4096 + col_); } } while (0)
#define GDN_PARK() do { _Pragma("unroll") for (int k_ = 0; k_ < 5; ++k_) { const int idx_ = tid + 512 * k_; if (idx_ < 67 * 36) *(u32x4*)(raw + idx_ * 8) = pre[k_]; } } while (0)
#define GDN_CONV8(ROW0, C8, W, OUT) do { _Pragma("unroll") for (int i_ = 0; i_ < 8; ++i_) OUT[i_] = 0.f; _Pragma("unroll") for (int j_ = 0; j_ < 4; ++j_) { const u32x4 xv_ = *(const u32x4*)(raw + ((ROW0) + j_) * 288 + (C8) * 8); \
            OUT[0] += bf2f(xv_.x & 0xffffu) * W[j_][0].x; OUT[1] += bf2f(xv_.x >> 16) * W[j_][0].y; OUT[2] += bf2f(xv_.y & 0xffffu) * W[j_][0].z; OUT[3] += bf2f(xv_.y >> 16) * W[j_][0].w; \
            OUT[4] += bf2f(xv_.z & 0xffffu) * W[j_][1].x; OUT[5] += bf2f(xv_.z >> 16) * W[j_][1].y; OUT[6] += bf2f(xv_.w & 0xffffu) * W[j_][1].z; OUT[7] += bf2f(xv_.w >> 16) * W[j_][1].w; } \
            _Pragma("unroll") for (int i_ = 0; i_ < 8; ++i_) OUT[i_] = siluf_(OUT[i_]); } while (0)
#define GDN_CONVNORM(T0) do { \
            _Pragma("unroll") for (int it_ = 0; it_ < 4; ++it_) { const int tok_ = it_ * 16 + (tid >> 5); float y_[8]; GDN_CONV8(tok_, isk * 16 + cg, wq, y_); \
                float ss_ = (y_[0] * y_[0] + y_[1] * y_[1]) + (y_[2] * y_[2] + y_[3] * y_[3]) + (y_[4] * y_[4] + y_[5] * y_[5]) + (y_[6] * y_[6] + y_[7] * y_[7]); \
                ss_ = row_sum16(ss_); const float sc_ = (1.f / sqrtf(ss_ + EPS)) * (isk ? 1.f : 0.08838834764831845f); \
                float* d_ = (isk ? ks : qs) + tok_ * 128 + cg * 8; \
                _Pragma("unroll") for (int i_ = 0; i_ < 8; ++i_) y_[i_] *= sc_; \
                *(f32x4*)d_ = (f32x4){y_[0], y_[1], y_[2], y_[3]}; *(f32x4*)(d_ + 4) = (f32x4){y_[4], y_[5], y_[6], y_[7]}; \
                float dq_ = 0.f; _Pragma("unroll") for (int i_ = 0; i_ < 8; ++i_) dq_ += y_[i_] * xshfl(y_[i_], 16); \
                dq_ = row_sum16(dq_); if (isk == 0 && cg == 0) qk[tok_] = dq_; } \
            if (tid < 256) { const int tok_ = tid >> 2; float y_[8]; GDN_CONV8(tok_, 32 + cv, wv, y_); float* d_ = vs + tok_ * 32 + cv * 8; \
                *(f32x4*)d_ = (f32x4){y_[0], y_[1], y_[2], y_[3]}; *(f32x4*)(d_ + 4) = (f32x4){y_[4], y_[5], y_[6], y_[7]}; } \
            if (tid < 64) { const size_t tg_ = (size_t)(b * S + (T0) + tid); const float a_ = ab[tg_ * 16 + h] + dtb, bb_ = ab[tg_ * 16 + 8 + h]; \
                const float sp_ = a_ > 20.f ? a_ : __logf(1.f + __expf(a_)); al[tid] = __expf(-Ah * sp_); be[tid] = sigmoidf_(bb_); } } while (0)
        __syncthreads();
        GDN_PREFETCH(0); GDN_PARK();
        __syncthreads();
        GDN_CONVNORM(0);
        __syncthreads();
        for (int chunk = 0; chunk < S / 64; ++chunk) {
            const int t0 = chunk * 64;
            const bool more = chunk + 1 < S / 64;
            if (more) GDN_PREFETCH(t0 + 64);
            {
                const float* kp = ks + dl * 8; const float* qp = qs + dl * 8; const float* vp = vs + e;
                f32x4 nk0 = *(const f32x4*)kp, nk1 = *(const f32x4*)(kp + 4), nq0 = *(const f32x4*)qp, nq1 = *(const f32x4*)(qp + 4);
                float nv = vp[0], na = al[0], nb = be[0], nqk = qk[0];
                for (int t16 = 0; t16 < 4; ++t16) {
                    float ok = 0.f;
#pragma unroll 4
                    for (int i = 0; i < 16; ++i) {
                        const int tt = t16 * 16 + i, tn = (tt + 1) & 63;
                        const f32x2 K0 = {nk0.x, nk0.y}, K1 = {nk0.z, nk0.w}, K2 = {nk1.x, nk1.y}, K3 = {nk1.z, nk1.w};
                        const f32x2 Q0 = {nq0.x, nq0.y}, Q1 = {nq0.z, nq0.w}, Q2 = {nq1.x, nq1.y}, Q3 = {nq1.z, nq1.w};
                        const float v = nv, a = na, bt = nb, qkt = nqk;
                        nk0 = *(const f32x4*)(kp + tn * 128); nk1 = *(const f32x4*)(kp + tn * 128 + 4); nq0 = *(const f32x4*)(qp + tn * 128); nq1 = *(const f32x4*)(qp + tn * 128 + 4);
                        nv = vp[tn * 32]; na = al[tn]; nb = be[tn]; nqk = qk[tn];
                        f32x2 pa = K0 * S2[0], pb = K2 * S2[2], qa = Q0 * S2[0], qb = Q2 * S2[2];
                        pa = K1 * S2[1] + pa; pb = K3 * S2[3] + pb; qa = Q1 * S2[1] + qa; qb = Q3 * S2[3] + qb;
                        pa += pb; qa += qb;
                        float p = pa.x + pa.y, qS = qa.x + qa.y;
                        p = row_sum16(p); qS = row_sum16(qS);
                        const float vn = bt * (v - a * p);
                        const float o = a * qS + qkt * vn;
                        const f32x2 vn2 = {vn, vn}, a2 = {a, a};
                        S2[0] = S2[0] * a2 + K0 * vn2; S2[1] = S2[1] * a2 + K1 * vn2; S2[2] = S2[2] * a2 + K2 * vn2; S2[3] = S2[3] * a2 + K3 * vn2;
                        ok = (i == dl) ? o : ok;
                    }
                    os[(t16 * 16 + dl) * 32 + e] = ok;
                }
            }
            __syncthreads();
            { const int tok = tid >> 3, c4 = tid & 7;
              *(f32x4*)(o32 + (size_t)(b * S + t0 + tok) * D + h * 128 + es * 32 + c4 * 4) = *(const f32x4*)(os + tok * 32 + c4 * 4); }
            if (more) {
                GDN_PARK();
                __syncthreads();
                GDN_CONVNORM(t0 + 64);
            }
            __syncthreads();
        }
#undef GDN_PREFETCH
#undef GDN_PARK
#undef GDN_CONV8
#undef GDN_CONVNORM
    }
}

constexpr size_t WS_HALO = WS_END;
constexpr size_t WS_GL = WS_END + 10 * MiB;
constexpr size_t WS_SS = WS_GL + 1 * MiB;
constexpr size_t WS_END2 = WS_SS + 26 * MiB;

__device__ __forceinline__ void phase_gdn_halo(const bf16* proj, bf16* halo, int gtid, int NT) {
    for (int idx = gtid; idx < Bn * 64 * 3 * 384; idx += NT) {
        const int c = idx % 384, r3 = (idx / 384) % 3, bn = idx / (384 * 3), n = bn & 63, b = bn >> 6;
        u32x4 v = {0u, 0u, 0u, 0u};
        if (n > 0) v = *(const u32x4*)(proj + (size_t)(b * S + 64 * n - 3 + r3) * 4096 + c * 8);
        *(u32x4*)(halo + (size_t)(bn * 3 + r3) * 3072 + c * 8) = v;
    }
}

constexpr int GP_RAW = 0, GP_QB = 51456, GP_KB = GP_QB + 17408, GP_VB = GP_KB + 17408, GP_AM = GP_VB + 16384, GP_GC = GP_AM + 17408;
__device__ __forceinline__ void phase_gdn_prep(unsigned char* lds, bf16* proj, const bf16* halo, const float* ab, const float* convw, const float* A_log, const float* dt_bias,
                                               bf16* KT, bf16* AT, float* GL, int vblk, int nblk, int tid, int wid, int lane) {
    bf16* raw = (bf16*)(lds + GP_RAW);
    unsigned char* qb = lds + GP_QB;
    unsigned char* kb = lds + GP_KB;
    bf16* vb = (bf16*)(lds + GP_VB);
    float* Am = (float*)(lds + GP_AM);
    float* gcs = (float*)(lds + GP_GC);
    float* bes = gcs + 64;
    const int r = lane & 31, hh = lane >> 5;
    for (int item = vblk; item < Bn * 8 * 64; item += nblk) {
        const int n = item & 63, h = (item >> 6) & 7, b = item >> 9;
        const size_t tok0 = (size_t)b * S + 64 * n;
        __syncthreads();
#pragma unroll
        for (int k_ = 0; k_ < 7; ++k_) {
            const int idx = tid + 512 * k_;
            if (idx < 67 * 48) {
                const int row = idx / 48, c = idx - row * 48;
                const int col = c < 16 ? h * 128 + c * 8 : (c < 32 ? 1024 + h * 128 + (c - 16) * 8 : 2048 + h * 128 + (c - 32) * 8);
                u32x4 v;
                if (row < 3) v = *(const u32x4*)(halo + (size_t)((b * 64 + n) * 3 + row) * 3072 + col);
                else v = *(const u32x4*)(proj + (tok0 + row - 3) * 4096 + col);
                *(u32x4*)(raw + row * 384 + c * 8) = v;
            }
        }
        if (tid < 64) {
            const float a = ab[(tok0 + tid) * 16 + h] + dt_bias[h], bb = ab[(tok0 + tid) * 16 + 8 + h];
            const float sp = a > 20.f ? a : __logf(1.f + __expf(a));
            float g = -__expf(A_log[h]) * sp;
#pragma unroll
            for (int o = 1; o < 64; o <<= 1) { const float t_ = xshfl_up(g, o); if (lane >= o) g += t_; }
            const float be_ = sigmoidf_(bb);
            gcs[tid] = g; bes[tid] = be_; gcs[128 + tid] = be_; gcs[192 + tid] = be_ * __expf(g);
        }
        __syncthreads();
        {
            const int isk = (tid >> 4) & 1, cg = tid & 15;
            const int colqk = isk * 1024 + h * 128 + cg * 8, colv = 2048 + h * 128 + cg * 8;
#define GP_CONV8(ROW0, C8, COL, OUT) do { _Pragma("unroll") for (int i_ = 0; i_ < 8; ++i_) OUT[i_] = 0.f; _Pragma("unroll") for (int j_ = 0; j_ < 4; ++j_) { const u32x4 xv_ = *(const u32x4*)(raw + ((ROW0) + j_) * 384 + (C8) * 8); \
            const f32x4 w0_ = *(const f32x4*)(convw + j_ * 3072 + (COL)), w1_ = *(const f32x4*)(convw + j_ * 3072 + (COL) + 4); \
            OUT[0] += bf2f(xv_.x & 0xffffu) * w0_.x; OUT[1] += bf2f(xv_.x >> 16) * w0_.y; OUT[2] += bf2f(xv_.y & 0xffffu) * w0_.z; OUT[3] += bf2f(xv_.y >> 16) * w0_.w; \
            OUT[4] += bf2f(xv_.z & 0xffffu) * w1_.x; OUT[5] += bf2f(xv_.z >> 16) * w1_.y; OUT[6] += bf2f(xv_.w & 0xffffu) * w1_.z; OUT[7] += bf2f(xv_.w >> 16) * w1_.w; } \
            _Pragma("unroll") for (int i_ = 0; i_ < 8; ++i_) OUT[i_] = siluf_(OUT[i_]); } while (0)
#pragma unroll 1
            for (int it = 0; it < 4; ++it) {
                const int tk = it * 16 + (tid >> 5);
                float y[8]; GP_CONV8(tk, isk * 16 + cg, colqk, y);
                float ss = (y[0] * y[0] + y[1] * y[1]) + (y[2] * y[2] + y[3] * y[3]) + (y[4] * y[4] + y[5] * y[5]) + (y[6] * y[6] + y[7] * y[7]);
                ss = row_sum16(ss);
                const float sc = (1.f / sqrtf(ss + EPS)) * (isk ? 1.f : 0.08838834764831845f);
                u32x4 w; w.x = pkbf(y[0] * sc, y[1] * sc); w.y = pkbf(y[2] * sc, y[3] * sc); w.z = pkbf(y[4] * sc, y[5] * sc); w.w = pkbf(y[6] * sc, y[7] * sc);
                *(u32x4*)((isk ? kb : qb) + tk * 272 + cg * 16) = w;
            }
#pragma unroll 1
            for (int it = 0; it < 2; ++it) {
                const int tk = it * 32 + (tid >> 4);
                float y[8]; GP_CONV8(tk, 32 + cg, colv, y);
                u32x4 w; w.x = pkbf(y[0], y[1]); w.y = pkbf(y[2], y[3]); w.z = pkbf(y[4], y[5]); w.w = pkbf(y[6], y[7]);
                *(u32x4*)(vb + tk * 128 + cg * 8) = w;
            }
#undef GP_CONV8
        }
        __syncthreads();
        {
            const int prod = wid >> 2, tr = (wid >> 1) & 1, tc = wid & 1;
            f32x16 acc;
#pragma unroll
            for (int i = 0; i < 16; ++i) acc[i] = 0.f;
            if (tr >= tc) {
                const unsigned char* Ab = (prod ? qb : kb) + (32 * tr + r) * 272 + hh * 16;
                const unsigned char* Bb = kb + (32 * tc + r) * 272 + hh * 16;
#pragma unroll
                for (int ks = 0; ks < 8; ++ks) acc = MFMA32(*(const bf16x8v*)(Ab + ks * 32), *(const bf16x8v*)(Bb + ks * 32), acc);
            }
            const int j = 32 * tc + r; const float gj = gcs[j];
#pragma unroll
            for (int i_ = 0; i_ < 16; ++i_) {
                const int i = 32 * tr + (i_ & 3) + 8 * (i_ >> 2) + 4 * hh;
                const float dec = __expf(gcs[i] - gj);
                if (prod == 0) Am[i * 68 + j] = (j < i) ? bes[i] * acc[i_] * dec : 0.f;
                else AT[(size_t)item * 4096 + i * 64 + j] = (bf16)f2bf((j <= i) ? acc[i_] * dec : 0.f);
            }
        }
        __syncthreads();
        int tid3 = tid; asm volatile("" : "+v"(tid3));
        if (tid3 < 256) {
            const int isw = tid3 >> 7, d = tid3 & 127;
            unsigned oam = GP_AM, orsc = GP_GC + 512 + isw * 256, ocol = (isw ? GP_KB : GP_VB) + d * 2;
            asm volatile("" : "+v"(oam), "+v"(orsc), "+v"(ocol));
            const float* Am_ = (const float*)(lds + oam); const float* rsc = (const float*)(lds + orsc); const unsigned char* col = lds + ocol;
            const int cstride = isw ? 272 : 256;
            float X[64];
#pragma clang loop unroll(full)
            for (int i = 0; i < 64; ++i) X[i] = 0.f;
#pragma clang loop unroll(full)
            for (int i = 0; i < 64; ++i) {
                f32x4 av = {0.f, 0.f, 0.f, 0.f};
#pragma clang loop unroll(full)
                for (int j4 = 0; j4 < 16; ++j4) { if (4 * j4 < i) { const f32x4 a4 = *(const f32x4*)(Am_ + i * 68 + 4 * j4);
                    const f32x4 x4 = {X[4 * j4], X[4 * j4 + 1], X[4 * j4 + 2], X[4 * j4 + 3]}; av += a4 * x4; } }
                X[i] = rsc[i] * bf2f(*(const bf16*)(col + i * cstride)) - ((av.x + av.y) + (av.z + av.w));
                asm volatile("" ::: "memory");
            }
            if (isw) {
#pragma unroll
                for (int i = 0; i < 64; ++i) proj[(tok0 + i) * 4096 + 1024 + h * 128 + d] = (bf16)f2bf(X[i]);
            } else {
                bf16* up = proj + (tok0 + (d >> 1)) * 4096 + 2048 + h * 128 + (d & 1) * 64;
#pragma unroll
                for (int i8 = 0; i8 < 8; ++i8) { u32x4 w; w.x = pkbf(X[8 * i8], X[8 * i8 + 1]); w.y = pkbf(X[8 * i8 + 2], X[8 * i8 + 3]); w.z = pkbf(X[8 * i8 + 4], X[8 * i8 + 5]); w.w = pkbf(X[8 * i8 + 6], X[8 * i8 + 7]);
                    *(u32x4*)(up + 8 * i8) = w; }
            }
        } else if (tid3 < 384) {
            const int d = tid3 - 256; const float gl_ = gcs[63];
            bf16* kp = KT + (size_t)item * 8192 + d * 64;
#pragma unroll
            for (int i8 = 0; i8 < 8; ++i8) { float y[8];
#pragma unroll
                for (int i = 0; i < 8; ++i) y[i] = bf2f(*(const bf16*)(kb + (8 * i8 + i) * 272 + d * 2)) * __expf(gl_ - gcs[8 * i8 + i]);
                u32x4 w; w.x = pkbf(y[0], y[1]); w.y = pkbf(y[2], y[3]); w.z = pkbf(y[4], y[5]); w.w = pkbf(y[6], y[7]);
                *(u32x4*)(kp + 8 * i8) = w; }
            if (d == 0) GL[item] = __expf(gl_);
        } else {
            const int d = tid3 - 384;
#pragma unroll 8
            for (int i = 0; i < 64; ++i) proj[(tok0 + i) * 4096 + h * 128 + d] = (bf16)f2bf(bf2f(*(const bf16*)(qb + i * 272 + d * 2)) * __expf(gcs[i]));
        }
    }
}

__device__ __forceinline__ void phase_gdn_scan2(unsigned char* lds, const bf16* proj, const bf16* KT, const bf16* AT, const float* GL, bf16* o16, int vblk, int nblk, int tid, int wid, int lane) {
    unsigned char* Sl = lds;
    unsigned char* Vl = lds + 8704;
    const int r = lane & 31, hh = lane >> 5;
    for (int item = vblk; item < 256; item += nblk) {
        const int bh = (item & 7) + 8 * (item >> 5), es = (item >> 3) & 3, b = bh >> 3, h = bh & 7;
        __syncthreads();
        for (int i = tid; i < 8704 / 4; i += 512) ((unsigned*)Sl)[i] = 0u;
        f32x16 Sacc;
#pragma unroll
        for (int i = 0; i < 16; ++i) Sacc[i] = 0.f;
        const int rt = wid & 1, dt = wid & 3;
        for (int n = 0; n < 64; ++n) {
            const size_t tok0 = (size_t)b * S + 64 * n; const int itm = bh * 64 + n;
            bf16x8v A8[8]; bf16x8v A4[4]; u32x2 uu[4]; float gl = 1.f;
            if (wid < 2) {
                const bf16* wp = proj + (tok0 + 32 * rt + r) * 4096 + 1024 + h * 128 + 8 * hh;
#pragma unroll
                for (int ks = 0; ks < 8; ++ks) A8[ks] = *(const bf16x8v*)(wp + 16 * ks);
                const int c = es * 32 + r;
                const bf16* up = proj + (tok0 + (c >> 1)) * 4096 + 2048 + h * 128 + (c & 1) * 64 + 32 * rt + 4 * hh;
#pragma unroll
                for (int g = 0; g < 4; ++g) uu[g] = *(const u32x2*)(up + 8 * g);
            } else if (wid < 4) {
                const bf16* qp = proj + (tok0 + 32 * rt + r) * 4096 + h * 128 + 8 * hh;
#pragma unroll
                for (int ks = 0; ks < 8; ++ks) A8[ks] = *(const bf16x8v*)(qp + 16 * ks);
                const bf16* ap = AT + (size_t)itm * 4096 + (32 * rt + r) * 64 + 8 * hh;
#pragma unroll
                for (int sx = 0; sx < 4; ++sx) A4[sx] = *(const bf16x8v*)(ap + 16 * sx);
            } else {
                const bf16* kp = KT + (size_t)itm * 8192 + (32 * dt + r) * 64 + 8 * hh;
#pragma unroll
                for (int sx = 0; sx < 4; ++sx) A4[sx] = *(const bf16x8v*)(kp + 16 * sx);
                gl = GL[itm];
            }
            __syncthreads();
            f32x16 acc;
#pragma unroll
            for (int i = 0; i < 16; ++i) acc[i] = 0.f;
            if (wid < 4) {
#pragma unroll
                for (int ks = 0; ks < 8; ++ks) acc = MFMA32(A8[ks], *(const bf16x8v*)(Sl + r * 272 + ks * 32 + hh * 16), acc);
                if (wid < 2) {
#pragma unroll
                    for (int g = 0; g < 4; ++g) {
                        u32x2 w; w.x = pkbf(bf2f(uu[g].x & 0xffffu) - acc[4 * g], bf2f(uu[g].x >> 16) - acc[4 * g + 1]);
                        w.y = pkbf(bf2f(uu[g].y & 0xffffu) - acc[4 * g + 2], bf2f(uu[g].y >> 16) - acc[4 * g + 3]);
                        *(u32x2*)(Vl + r * 144 + (32 * rt + 8 * g + 4 * hh) * 2) = w;
                    }
                }
            }
            __syncthreads();
            if (wid >= 2 && wid < 4) {
#pragma unroll
                for (int sx = 0; sx < 4; ++sx) acc = MFMA32(A4[sx], *(const bf16x8v*)(Vl + r * 144 + sx * 32 + hh * 16), acc);
                bf16* op = o16 + (tok0 + 32 * rt + 4 * hh) * D + h * 128 + es * 32 + r;
#pragma unroll
                for (int i = 0; i < 16; ++i) op[(size_t)((i & 3) + 8 * (i >> 2)) * D] = (bf16)f2bf(acc[i]);
            } else if (wid >= 4) {
#pragma unroll
                for (int i = 0; i < 16; ++i) Sacc[i] *= gl;
#pragma unroll
                for (int sx = 0; sx < 4; ++sx) Sacc = MFMA32(A4[sx], *(const bf16x8v*)(Vl + r * 144 + sx * 32 + hh * 16), Sacc);
#pragma unroll
                for (int g = 0; g < 4; ++g) { u32x2 w; w.x = pkbf(Sacc[4 * g], Sacc[4 * g + 1]); w.y = pkbf(Sacc[4 * g + 2], Sacc[4 * g + 3]);
                    *(u32x2*)(Sl + r * 272 + (32 * dt + 8 * g + 4 * hh) * 2) = w; }
            }
        }
    }
}

__device__ __forceinline__ void phase_gdn_post(const bf16* o16, const bf16* proj, const float* onorm, bf16* hn, int gw, int NGW, int lane) {
    const f32x4 wv = *(const f32x4*)(onorm + ((4 * lane) & 127));
    for (int m = gw; m < T; m += NGW) {
        const u32x2* xr = (const u32x2*)(o16 + (size_t)m * D) + lane;
        const u32x2* gr = (const u32x2*)(proj + (size_t)m * 4096 + 3072) + lane;
        u32x2* o8 = (u32x2*)(hn + (size_t)m * D) + lane;
#pragma unroll
        for (int j = 0; j < 4; ++j) {
            const u32x2 xv = xr[64 * j]; const u32x2 g = gr[64 * j];
            const f32x4 v = {bf2f(xv.x & 0xffffu), bf2f(xv.x >> 16), bf2f(xv.y & 0xffffu), bf2f(xv.y >> 16)};
            float s = (v.x * v.x + v.y * v.y) + (v.z * v.z + v.w * v.w);
#pragma unroll
            for (int o = 1; o < 32; o <<= 1) s += xshfl(s, o);
            const float rstd = 1.f / sqrtf(s * (1.f / 128.f) + EPS);
            u32x2 o; o.x = pk2(v.x * rstd * wv.x * siluf_(bf2f(g.x & 0xffffu)), v.y * rstd * wv.y * siluf_(bf2f(g.x >> 16)));
            o.y = pk2(v.z * rstd * wv.z * siluf_(bf2f(g.y & 0xffffu)), v.w * rstd * wv.w * siluf_(bf2f(g.y >> 16)));
            o8[64 * j] = o;
        }
    }
}
__device__ __forceinline__ void phase_sc_post(const bf16* proj, const float* cw, bf16* hn, int gtid, int NT) {
    for (int idx = gtid; idx < T * 128; idx += NT) {
        const int m = idx >> 7, c8 = (idx & 127) * 8, s = m & (S - 1);
        float y[8];
#pragma unroll
        for (int i = 0; i < 8; ++i) y[i] = 0.f;
#pragma unroll
        for (int j = 0; j < 3; ++j) {
            if (s - 2 + j >= 0) {
                const bf16* pr = proj + (size_t)(m - 2 + j) * 3072;
                const u32x4 cv = *(const u32x4*)(pr + 1024 + c8), xv = *(const u32x4*)(pr + 2048 + c8);
                const f32x4 w0 = *(const f32x4*)(cw + j * 1024 + c8), w1 = *(const f32x4*)(cw + j * 1024 + c8 + 4);
                y[0] += w0.x * bf2f(cv.x & 0xffffu) * bf2f(xv.x & 0xffffu); y[1] += w0.y * bf2f(cv.x >> 16) * bf2f(xv.x >> 16);
                y[2] += w0.z * bf2f(cv.y & 0xffffu) * bf2f(xv.y & 0xffffu); y[3] += w0.w * bf2f(cv.y >> 16) * bf2f(xv.y >> 16);
                y[4] += w1.x * bf2f(cv.z & 0xffffu) * bf2f(xv.z & 0xffffu); y[5] += w1.y * bf2f(cv.z >> 16) * bf2f(xv.z >> 16);
                y[6] += w1.z * bf2f(cv.w & 0xffffu) * bf2f(xv.w & 0xffffu); y[7] += w1.w * bf2f(cv.w >> 16) * bf2f(xv.w >> 16);
            }
        }
        const u32x4 bv = *(const u32x4*)(proj + (size_t)m * 3072 + c8);
        u32x4 o;
        o.x = pk2(y[0] * bf2f(bv.x & 0xffffu), y[1] * bf2f(bv.x >> 16)); o.y = pk2(y[2] * bf2f(bv.y & 0xffffu), y[3] * bf2f(bv.y >> 16));
        o.z = pk2(y[4] * bf2f(bv.z & 0xffffu), y[5] * bf2f(bv.z >> 16)); o.w = pk2(y[6] * bf2f(bv.w & 0xffffu), y[7] * bf2f(bv.w >> 16));
        *(u32x4*)(hn + (size_t)m * D + c8) = o;
    }
}
__device__ __forceinline__ void phase_nsa_post(unsigned char* lds, const bf16* proj, const float* qnorm, const float* knorm, const f32x2* tab,
                                               bf16* QN, bf16* KS, bf16* KW, bf16* KCH, bf16* VCH, bf16* VST, bf16* VWT, int gw, int NGW, int wid, int lane) {
    {
        bf16* tile = (bf16*)lds + wid * (64 * 66);
        for (int item = gw; item < 2 * 32 * 64; item += NGW) {
            const int st = item & 63, bh = (item >> 6) & 31, which = item >> 11, b = bh >> 2, hk = bh & 3;
            const bf16* src = proj + ((size_t)b * S + st * 64) * 2560 + (which ? 2304 : 1792) + hk * 64 + lane;
#pragma unroll 8
            for (int i = 0; i < 64; ++i) tile[i * 66 + lane] = src[(size_t)i * 2560];
            WAVE_SYNC();
            bf16* dst = (which ? VWT : VST) + (size_t)bh * 64 * S + st * 64 + lane;
#pragma unroll 8
            for (int d = 0; d < 64; ++d) dst[(size_t)d * S] = tile[lane * 66 + d];
            WAVE_SYNC();
        }
    }
    const int l8 = lane & 7, hsel = lane >> 3, lo32 = lane < 32;
    float qw8[8], kw8[8];
#pragma unroll
    for (int j = 0; j < 8; ++j) { qw8[j] = qnorm[8 * l8 + j]; kw8[j] = knorm[(lo32 ? 64 : 128) + 8 * l8 + j]; }
#define NP_UNPACK(V, X) do { X[0] = bf2f(V.x & 0xffffu); X[1] = bf2f(V.x >> 16); X[2] = bf2f(V.y & 0xffffu); X[3] = bf2f(V.y >> 16); X[4] = bf2f(V.z & 0xffffu); X[5] = bf2f(V.z >> 16); X[6] = bf2f(V.w & 0xffffu); X[7] = bf2f(V.w >> 16); } while (0)
#define NP_RSTD8(X, R) do { float ss_ = (X[0] * X[0] + X[1] * X[1]) + (X[2] * X[2] + X[3] * X[3]) + (X[4] * X[4] + X[5] * X[5]) + (X[6] * X[6] + X[7] * X[7]); \
        ss_ += xshfl(ss_, 1); ss_ += xshfl(ss_, 2); ss_ += xshfl(ss_, 4); R = 1.f / sqrtf(ss_ * (1.f / 64.f) + EPS); } while (0)
    for (int m = gw; m < T; m += NGW) {
        const int b = m >> 12, s = m & (S - 1);
        const bf16* pr = proj + (size_t)m * 2560;
        const u32x4 vq0 = *(const u32x4*)(pr + lane * 8), vq1 = *(const u32x4*)(pr + 512 + lane * 8);
        const u32x4 vk = *(const u32x4*)(pr + (lo32 ? 1536 + lane * 8 : 2048 + (lane - 32) * 8));
        const u32x4 vc = *(const u32x4*)(pr + (lo32 ? 1024 + lane * 8 : 1280 + (lane - 32) * 8));
        const f32x4* cp = (const f32x4*)(tab + (size_t)m * 32 + 8 * (l8 & 3));
        const f32x4 c0 = cp[0], c1 = cp[1], c2 = cp[2], c3 = cp[3];
        {
            float x[8], r; NP_UNPACK(vq0, x); NP_RSTD8(x, r);
            u32x4 w; w.x = pkbf(x[0] * r * qw8[0], x[1] * r * qw8[1]); w.y = pkbf(x[2] * r * qw8[2], x[3] * r * qw8[3]); w.z = pkbf(x[4] * r * qw8[4], x[5] * r * qw8[5]); w.w = pkbf(x[6] * r * qw8[6], x[7] * r * qw8[7]);
            *(u32x4*)(QN + ((size_t)(b * 16 + hsel) * S + s) * 64 + 8 * l8) = w;
        }
        {
            float x[8], r; NP_UNPACK(vq1, x); NP_RSTD8(x, r);
            u32x4 w; w.x = pkbf(x[0] * r * qw8[0], x[1] * r * qw8[1]); w.y = pkbf(x[2] * r * qw8[2], x[3] * r * qw8[3]); w.z = pkbf(x[4] * r * qw8[4], x[5] * r * qw8[5]); w.w = pkbf(x[6] * r * qw8[6], x[7] * r * qw8[7]);
            *(u32x4*)(QN + ((size_t)(b * 16 + 8 + hsel) * S + s) * 64 + 8 * l8) = w;
        }
        const size_t okv = ((size_t)(b * 4 + (hsel & 3)) * S + s) * 64 + 8 * l8;
        {
            float x[8], r, y[8]; NP_UNPACK(vk, x); NP_RSTD8(x, r);
            const float cs[16] = {c0.x, c0.y, c0.z, c0.w, c1.x, c1.y, c1.z, c1.w, c2.x, c2.y, c2.z, c2.w, c3.x, c3.y, c3.z, c3.w};
#pragma unroll
            for (int j = 0; j < 8; ++j) { const float yv = x[j] * r * kw8[j]; const float yp = xshfl(yv, 4); y[j] = yv * cs[2 * j] + (l8 < 4 ? -yp : yp) * cs[2 * j + 1]; }
            u32x4 w; w.x = pkbf(y[0], y[1]); w.y = pkbf(y[2], y[3]); w.z = pkbf(y[4], y[5]); w.w = pkbf(y[6], y[7]);
            *(u32x4*)((lo32 ? KS : KW) + okv) = w;
        }
        *(u32x4*)((lo32 ? KCH : VCH) + okv) = vc;
    }
#undef NP_UNPACK
#undef NP_RSTD8
}
__device__ __forceinline__ void phase_cmp2(unsigned char* lds, const float* Pk, const float* Pv, const float* biasp, const float* w2, const float* b2, const float* knorm0,
                                           bf16* KC, bf16* VC, int gw, int NGW, int wid, int lane) {
    float* hs = (float*)lds + wid * 256;
    for (int item = gw; item < 2 * 32 * 256; item += NGW) {
        const int i = item & 255, bh = (item >> 8) & 31, kind = item >> 13;
        bf16* outp = kind ? VC + ((size_t)bh * 64 + lane) * 256 + i : KC + ((size_t)bh * 256 + i) * 64 + lane;
        if (i == 255) { *outp = 0; continue; }
        const float* P = kind ? Pv : Pk;
        const float* r0 = P + ((size_t)bh * 256 + i) * 512; const float* r1 = r0 + 512 + 256;
#pragma unroll
        for (int j = 0; j < 4; ++j) { const int n = lane + 64 * j; const float x = r0[n] + r1[n] + biasp[kind * 256 + n];
            const float uu = 0.7978845608028654f * (x + 0.044715f * x * x * x);
            const float th = 1.f - 2.f / (1.f + __expf(2.f * uu));
            hs[n] = 0.5f * x * (1.f + th); }
        WAVE_SYNC();
        float acc = b2[kind * 64 + lane];
        const float* w = w2 + (size_t)kind * 256 * 64 + lane;
#pragma unroll 8
        for (int n = 0; n < 256; ++n) acc += hs[n] * w[n * 64];
        if (kind == 0) { const float ss = wave_sum(acc * acc); acc = acc * (1.f / sqrtf(ss * (1.f / 64.f) + EPS)) * knorm0[lane]; }
        *outp = (bf16)f2bf(acc);
        WAVE_SYNC();
    }
}
constexpr int KV_STRIDE = 144;
constexpr int KV_BUF = 2 * 64 * KV_STRIDE;
constexpr int ATT_IMP_OFF = 2 * KV_BUF;
constexpr int ATT_MSK_OFF = ATT_IMP_OFF + 8 * 2048;

template <bool IMP>
__device__ __forceinline__ void attn_tile(const bool FAST, const unsigned char* buf, int tt, int key0, int lo, int hi, const bf16x8v (&qf)[4],
                                          f32x16 (&O)[2], f32x16 (&IM)[2], float& m, float& l, const bf16* ovt, int r, int h, int pr) {
    f32x16 sacc;
#pragma unroll
    for (int i = 0; i < 16; ++i) sacc[i] = 0.f;
    const unsigned char* kb = buf + (32 * tt + pr) * KV_STRIDE + h * 16;
#pragma unroll
    for (int ks = 0; ks < 4; ++ks) { const bf16x8v a = *(const bf16x8v*)(kb + ks * 32); sacc = MFMA32(a, qf[ks], sacc); }
    const int kb0 = key0 + 8 * h;
    float mx = -1e30f, psum = 0.f, corr;
    if (FAST) {
        const bool on = hi >= 0;
#pragma unroll
        for (int i = 0; i < 16; ++i) mx = fmaxf(mx, sacc[i]);
        mx = on ? mx * 0.18033688011112042f : -1e30f;
        mx = fmaxf(mx, xshfl(mx, 32));
        const float mnew = fmaxf(m, mx);
        corr = __builtin_amdgcn_exp2f(m - mnew);
        m = mnew;
#pragma unroll
        for (int i = 0; i < 16; ++i) { const float p = __builtin_amdgcn_exp2f(sacc[i] * 0.18033688011112042f - mnew); psum += p; sacc[i] = p; }
        if (!on) {
            psum = 0.f;
#pragma unroll
            for (int i = 0; i < 16; ++i) sacc[i] = 0.f;
        }
    } else {
#pragma unroll
        for (int i = 0; i < 16; ++i) { const int key = kb0 + 16 * (i >> 3) + (i & 7); const bool ok = (key >= lo) && (key <= hi);
            const float sv = ok ? sacc[i] * 0.18033688011112042f : -1e30f; sacc[i] = sv; mx = fmaxf(mx, sv); }
        mx = fmaxf(mx, xshfl(mx, 32));
        const float mnew = fmaxf(m, mx);
        corr = __builtin_amdgcn_exp2f(m - mnew);
        m = mnew;
#pragma unroll
        for (int i = 0; i < 16; ++i) { const float p = sacc[i] > -1e29f ? __builtin_amdgcn_exp2f(sacc[i] - mnew) : 0.f; psum += p; sacc[i] = p; }
    }
    l = l * corr + psum;
    if (__any(corr != 1.f)) {
#pragma unroll
        for (int i = 0; i < 16; ++i) { O[0][i] *= corr; O[1][i] *= corr; }
        if (IMP) {
#pragma unroll
            for (int i = 0; i < 16; ++i) { IM[0][i] *= corr; IM[1][i] *= corr; }
        }
    }
    bf16x8v pf[2];
#pragma unroll
    for (int sx = 0; sx < 2; ++sx) { u32x4 w; w.x = pkbf(sacc[8 * sx], sacc[8 * sx + 1]); w.y = pkbf(sacc[8 * sx + 2], sacc[8 * sx + 3]); w.z = pkbf(sacc[8 * sx + 4], sacc[8 * sx + 5]); w.w = pkbf(sacc[8 * sx + 6], sacc[8 * sx + 7]);
        pf[sx] = __builtin_bit_cast(bf16x8v, w); }
    const unsigned char* vb = buf + 64 * KV_STRIDE + r * KV_STRIDE + (32 * tt + 8 * h) * 2;
#pragma unroll
    for (int dt = 0; dt < 2; ++dt)
#pragma unroll
        for (int sx = 0; sx < 2; ++sx) { const bf16x8v a = *(const bf16x8v*)(vb + dt * 32 * KV_STRIDE + sx * 32); O[dt] = MFMA32(a, pf[sx], O[dt]); }
    if (IMP) {
#pragma unroll
        for (int st = 0; st < 2; ++st)
#pragma unroll
            for (int sx = 0; sx < 2; ++sx) { const bf16x8v a = *(const bf16x8v*)(ovt + (32 * st + r) * 256 + key0 + 16 * sx + 8 * h); IM[st] = MFMA32(a, pf[sx], IM[st]); }
    }
}

template <int MODE>
__device__ __forceinline__ void attn_branch(unsigned char* kvbuf, const bf16* Kg0, const bf16* VTg0, int vts, unsigned long long blkmask, int t, int nv, unsigned long long selm,
                                            int wlo, int whi, int flo, int fhi, const bf16x8v (&qf)[4], f32x16 (&O)[2], f32x16 (&IM)[2], float& l, const bf16* ovt, int tid, int r, int h, int pr) {
    float m = -1e30f;
    l = 0.f;
#pragma unroll
    for (int i = 0; i < 16; ++i) { O[0][i] = 0.f; O[1][i] = 0.f; IM[0][i] = 0.f; IM[1][i] = 0.f; }
    const int srow = tid >> 3, sch = tid & 7;
    int j = __builtin_ctzll(blkmask);
    unsigned long long rest = blkmask & (blkmask - 1);
    u32x4 kr = *(const u32x4*)(Kg0 + (size_t)(64 * j + srow) * 64 + sch * 8);
    u32x4 vr = *(const u32x4*)(VTg0 + (size_t)srow * vts + 64 * j + sch * 8);
    *(u32x4*)(kvbuf + srow * KV_STRIDE + sch * 16) = kr;
    *(u32x4*)(kvbuf + 64 * KV_STRIDE + srow * KV_STRIDE + sch * 16) = vr;
    int cur = 0;
    for (;;) {
        __syncthreads();
        const bool more = rest != 0ull;
        int jn = 0;
        if (more) { jn = __builtin_ctzll(rest); rest &= rest - 1;
            kr = *(const u32x4*)(Kg0 + (size_t)(64 * jn + srow) * 64 + sch * 8);
            vr = *(const u32x4*)(VTg0 + (size_t)srow * vts + 64 * jn + sch * 8); }
        const unsigned char* buf = kvbuf + cur * KV_BUF;
        int lo, hi;
        if (MODE == 0) { lo = 0; hi = nv - 1; }
        else if (MODE == 1) { lo = 0; hi = ((selm >> j) & 1ull) ? t : -1; }
        else { lo = t - 511; hi = t; }
        const bool wave_on = (MODE != 1) || __any(hi >= 0);
#pragma unroll
        for (int tt = 0; tt < 2; ++tt) {
            const int key0 = 64 * j + 32 * tt;
            if (!wave_on || key0 > whi || key0 + 31 < wlo) continue;
            attn_tile<MODE == 0>(key0 >= flo && key0 + 31 <= fhi, buf, tt, key0, lo, hi, qf, O, IM, m, l, ovt, r, h, pr);
        }
        if (!more) break;
        *(u32x4*)(kvbuf + (cur ^ 1) * KV_BUF + srow * KV_STRIDE + sch * 16) = kr;
        *(u32x4*)(kvbuf + (cur ^ 1) * KV_BUF + 64 * KV_STRIDE + srow * KV_STRIDE + sch * 16) = vr;
        cur ^= 1; j = jn;
    }
    __syncthreads();
}

__device__ __forceinline__ void phase_nsa_attn(unsigned char* lds, const bf16* QN, const bf16* KS, const bf16* KW, const bf16* VST, const bf16* VWT, const bf16* KCb, const bf16* VCT,
                                               const bf16* ovt, const float* gates, const f32x2* tab, bf16* hn, int vblk, int nblk, int tid, int wid, int lane) {
    const int r = lane & 31, h = lane >> 5, pr = (r & ~12) | ((r & 4) << 1) | ((r & 8) >> 1);
    float* imp_s = (float*)(lds + ATT_IMP_OFF + wid * 2048);
    unsigned long long* msk_s = (unsigned long long*)(lds + ATT_MSK_OFF);
    unsigned* uni_s = (unsigned*)(lds + ATT_MSK_OFF + 512);
    for (int item = vblk; item < Bn * 4 * 64; item += nblk) {
        const int rnd = item / nblk, wv = item - rnd * nblk;
        const int bh = wv & 31, sub = wv >> 5, per = nblk >> 5;
        int qb = rnd * per + ((rnd & 1) ? (per - 1 - sub) : sub);
        if (nblk != 256) { qb = item >> 5; }
        const int bhh = (nblk != 256) ? (item & 31) : bh;
        const int b = bhh >> 2, hk = bhh & 3;
        const int t0 = qb * 64, tw0 = t0 + 8 * wid, t = tw0 + (r & 7), g = r >> 3;
        const size_t tok = (size_t)b * S + t;
        if (tid == 0) { unsigned z = 0u; asm volatile("" : "+v"(z)); uni_s[0] = z; uni_s[1] = z; }
        bf16x8v qn[4], qr[4];
        {
            const bf16* qp = QN + ((size_t)(b * 16 + hk * 4 + g) * S + t) * 64 + 8 * h;
#pragma unroll
            for (int ks = 0; ks < 4; ++ks) qn[ks] = *(const bf16x8v*)(qp + 16 * ks);
            const f32x2* cp = tab + tok * 32 + 8 * h;
#pragma unroll
            for (int kl = 0; kl < 2; ++kl) {
                u32x4 wlo_, whi_;
                const u32x4 a = __builtin_bit_cast(u32x4, qn[kl]), c = __builtin_bit_cast(u32x4, qn[kl + 2]);
#pragma unroll
                for (int jj = 0; jj < 4; ++jj) {
                    const f32x2 cs0 = cp[16 * kl + 2 * jj], cs1 = cp[16 * kl + 2 * jj + 1];
                    const float x0 = bf2f(a[jj] & 0xffffu), x1 = bf2f(a[jj] >> 16), y0 = bf2f(c[jj] & 0xffffu), y1 = bf2f(c[jj] >> 16);
                    wlo_[jj] = pkbf(x0 * cs0.x - y0 * cs0.y, x1 * cs1.x - y1 * cs1.y);
                    whi_[jj] = pkbf(y0 * cs0.x + x0 * cs0.y, y1 * cs1.x + x1 * cs1.y);
                }
                qr[kl] = __builtin_bit_cast(bf16x8v, wlo_); qr[kl + 2] = __builtin_bit_cast(bf16x8v, whi_);
            }
        }
        const float* gp = gates + tok * 48 + (hk * 4 + g) * 3;
        const float g0 = sigmoidf_(gp[0]), g1 = sigmoidf_(gp[1]), g2 = sigmoidf_(gp[2]);
        f32x16 acc[2], O[2], IM[2];
        float l;
        const int nv = t >= 31 ? ((t - 31) >> 4) + 1 : 0;
        const int nvw = ((tw0 + 7 - 31) >> 4) + 1;
        const int nvmax = 4 * qb + 3;
        {
            const int ncb = (nvmax + 63) >> 6;
            const unsigned long long bm = ncb >= 64 ? ~0ull : ((1ull << ncb) - 1ull);
            attn_branch<0>(lds, KCb + (size_t)bhh * 256 * 64, VCT + (size_t)bhh * 64 * 256, 256, bm, t, nv, 0ull, 0, (tw0 + 7 >= 31 ? nvw - 1 : -1), 0, (tw0 >= 31 ? ((tw0 - 31) >> 4) : -1), qn, O, IM, l, ovt, tid, r, h, pr);
        }
        {
            const float lt = l + xshfl(l, 32), inv = lt > 0.f ? 1.f / lt : 0.f, sc = inv * g0;
#pragma unroll
            for (int i = 0; i < 16; ++i) { acc[0][i] = O[0][i] * sc; acc[1][i] = O[1][i] * sc; }
#pragma unroll
            for (int st = 0; st < 2; ++st)
#pragma unroll
                for (int i = 0; i < 16; ++i) { float v = IM[st][i] * inv; v += xshfl(v, 8); v += xshfl(v, 16);
                    if (r < 8) imp_s[r * 64 + 32 * st + (i & 3) + 8 * (i >> 2) + 4 * h] = v; }
        }
        WAVE_SYNC();
        {
            unsigned long long um = 0ull;
            for (int tk = 0; tk < 8; ++tk) {
                const float imp = imp_s[tk * 64 + lane];
                const bool sv = lane <= qb, forced = (lane == 0) || (lane == qb) || (lane + 1 == qb);
                const float score = sv ? (forced ? 1e9f : imp) : -1.f;
                int rank = 0;
#pragma unroll 4
                for (int i = 0; i < 64; ++i) { const float si = __uint_as_float(__builtin_amdgcn_readlane(__float_as_uint(score), i)); rank += (si > score || (si == score && i < lane)) ? 1 : 0; }
                const unsigned long long mk = __ballot((rank < 16) && (score >= 0.f));
                um |= mk;
                if (lane == 0) msk_s[wid * 8 + tk] = mk;
            }
            if (lane == 0) { atomicOr(&uni_s[0], (unsigned)um); atomicOr(&uni_s[1], (unsigned)(um >> 32)); }
        }
        __syncthreads();
        const unsigned long long selm = msk_s[wid * 8 + (r & 7)];
        const unsigned long long uni = (unsigned long long)uni_s[0] | ((unsigned long long)uni_s[1] << 32);
        attn_branch<1>(lds, KS + (size_t)bhh * S * 64, VST + (size_t)bhh * 64 * S, S, uni, t, 0, selm, 0, tw0 + 7, 0, tw0, qr, O, IM, l, ovt, tid, r, h, pr);
        {
            const float lt = l + xshfl(l, 32), sc = g1 / lt;
#pragma unroll
            for (int i = 0; i < 16; ++i) { acc[0][i] += O[0][i] * sc; acc[1][i] += O[1][i] * sc; }
        }
        {
            const int jlo = qb >= 8 ? qb - 8 : 0;
            const unsigned long long bm = (qb >= 63 ? ~0ull : ((1ull << (qb + 1)) - 1ull)) & ~((1ull << jlo) - 1ull);
            attn_branch<2>(lds, KW + (size_t)bhh * S * 64, VWT + (size_t)bhh * 64 * S, S, bm, t, 0, 0ull, tw0 - 511, tw0 + 7, tw0 + 7 - 511, tw0, qr, O, IM, l, ovt, tid, r, h, pr);
        }
        {
            const float lt = l + xshfl(l, 32), sc = g2 / lt;
            bf16* op = hn + tok * D + (hk * 4 + g) * 64 + 4 * h;
#pragma unroll
            for (int dt = 0; dt < 2; ++dt)
#pragma unroll
                for (int q4 = 0; q4 < 4; ++q4) {
                    u32x2 w; w.x = pkbf(acc[dt][4 * q4] + O[dt][4 * q4] * sc, acc[dt][4 * q4 + 1] + O[dt][4 * q4 + 1] * sc);
                    w.y = pkbf(acc[dt][4 * q4 + 2] + O[dt][4 * q4 + 2] * sc, acc[dt][4 * q4 + 3] + O[dt][4 * q4 + 3] * sc);
                    *(u32x2*)(op + 32 * dt + 8 * q4) = w;
                }
        }
    }
}


#define LAS __attribute__((address_space(3)))
#define XB_TMO      128
#define XB_XCNT(j)  (256  + 64 * (j))
#define XB_XSUB(j)  (1280 + 64 * (j))
#define XB_XGEN(j)  (2304 + 64 * (j))
#define XB_TOP      3328
#define XB_TOPGEN   3392
#define XCD_BAR_WORDS 3456
#define XB_SPIN_CAP (1u << 18)

__device__ __forceinline__ unsigned xb_ld(unsigned* p)              { return __hip_atomic_load(p, __ATOMIC_RELAXED, __HIP_MEMORY_SCOPE_AGENT); }
__device__ __forceinline__ unsigned xb_add(unsigned* p, unsigned v) { return __hip_atomic_fetch_add(p, v, __ATOMIC_RELAXED, __HIP_MEMORY_SCOPE_AGENT); }
__device__ __forceinline__ unsigned xb_xcc_id() { return (unsigned)__builtin_amdgcn_s_getreg((3 << 11) | 20) & 0xFu; }
#define XB_SPIN(cond, bar) do { unsigned _sp = 0; while (cond) { __builtin_amdgcn_s_sleep(1); \
    if ((++_sp & 255u) == 0u) { if (xb_ld(&(bar)[XB_TMO])) break; if (_sp > XB_SPIN_CAP) { atomicAdd(&(bar)[XB_TMO], 1u); break; } } } } while (0)

struct XcdBarrier {
    unsigned* bar; unsigned x;
    volatile LAS unsigned* st;
};

__device__ __forceinline__ XcdBarrier xcd_barrier_post(unsigned* bar, volatile LAS unsigned* st) {
    XcdBarrier b; b.bar = bar; b.x = xb_xcc_id(); b.st = st;
    if (threadIdx.x == 0) (void)xb_add(&bar[XB_XCNT(b.x)], 1u);
    return b;
}
__device__ __forceinline__ void xcd_barrier_complete(unsigned* bar, unsigned x, unsigned& nloc, unsigned& nx) {
    const unsigned G = gridDim.x * gridDim.y * gridDim.z;
    unsigned sum, cnt, mine, sp = 0u;
    for (;;) {
        sum = 0u; cnt = 0u; mine = 0u;
#pragma unroll
        for (unsigned j = 0; j < 16; ++j) { const unsigned c = xb_ld(&bar[XB_XCNT(j)]); sum += c; cnt += (c > 0u) ? 1u : 0u; mine = (j == x) ? c : mine; }
        if (sum == G) break;
        __builtin_amdgcn_s_sleep(1);
        if ((++sp & 255u) == 0u) { if (xb_ld(&bar[XB_TMO])) break; if (sp > XB_SPIN_CAP) { atomicAdd(&bar[XB_TMO], 1u); break; } }
    }
    nloc = mine > 0u ? mine : 1u; nx = cnt > 0u ? cnt : 1u;
}

__device__ __forceinline__ void xcd_barrier(const XcdBarrier& b) {
    asm volatile("s_waitcnt vmcnt(0)" ::: "memory");
    __syncthreads();
    if (threadIdx.x == 0) {
        unsigned* bar = b.bar;
        __builtin_amdgcn_s_waitcnt(0);
        unsigned nloc = b.st[0], nx = b.st[1];
        if (nloc == 0u) { xcd_barrier_complete(bar, b.x, nloc, nx); b.st[0] = nloc; b.st[1] = nx; }
        const unsigned old = xb_add(&bar[XB_XSUB(b.x)], 1u);
        const unsigned gen = old / nloc;
        if (old + 1u == (gen + 1u) * nloc) {
            __builtin_amdgcn_fence(__ATOMIC_RELEASE, "agent");
            asm volatile("s_waitcnt vmcnt(0)" ::: "memory");
            const unsigned og = xb_add(&bar[XB_TOP], 1u);
            const unsigned tg = og / nx;
            if (og + 1u == (tg + 1u) * nx) xb_add(&bar[XB_TOPGEN], 1u);
            else XB_SPIN(xb_ld(&bar[XB_TOPGEN]) == tg, bar);
            __builtin_amdgcn_fence(__ATOMIC_ACQUIRE, "agent");
            xb_add(&bar[XB_XGEN(b.x)], 1u);
            asm volatile("s_waitcnt vmcnt(0)" ::: "memory");
        } else {
            XB_SPIN(xb_ld(&bar[XB_XGEN(b.x)]) == gen, bar);
            __builtin_amdgcn_fence(__ATOMIC_ACQUIRE, "agent");
            asm volatile("s_waitcnt vmcnt(0)" ::: "memory");
        }
    }
    __syncthreads();
}

struct Args { const void* in[24]; float* out; unsigned char* ws; int lo, hi; };

__host__ __device__ constexpr int mixer_inner_phases(int kind) { return kind == 0 ? 4 : (kind == 1 ? 1 : 4); }
__host__ __device__ constexpr int total_phases() { int n = 1; for (int L = 0; L < DEPTH; ++L) n += 4 + 2 + mixer_inner_phases(L % 3); return n; }

__global__ void __launch_bounds__(512, 2) mega(Args args) {
    extern __shared__ __attribute__((aligned(16))) unsigned char lds[];
    cg::grid_group grid = cg::this_grid();
    volatile LAS unsigned* bst = (volatile LAS unsigned*)((LAS unsigned char*)lds + (LDS_BYTES - 64));
    if (threadIdx.x < 2) bst[threadIdx.x] = 0u;
    __syncthreads();
    const XcdBarrier xbar = xcd_barrier_post((unsigned*)args.ws, bst);
    bool again = false;
    for (int ph = args.lo; ph < args.hi; ++ph) {
        int type = 0, s = 0, L = 0;
        if (ph > 0) {
            int p = ph - 1;
            for (L = 0; L < DEPTH; ++L) { const int n = 6 + mixer_inner_phases(L % 3); if (p < n) break; p -= n; }
            const int inner = mixer_inner_phases(L % 3), kind = L % 3;
            if (p < 2) { type = 2 + p; s = 2 * L; }
            else if (p == 2) type = 5;
            else if (p < 3 + inner) { const int q = p - 3; type = kind == 0 ? (q == 0 ? 14 : (q == 1 ? 15 : 4 + q)) : (kind == 1 ? 8 : 9 + q); }
            else if (p == 3 + inner) type = 13;
            else { type = 2 + (p - 4 - inner); s = 2 * L + 1; }
        }
        int tid_ = threadIdx.x; asm volatile("" : "+v"(tid_));
        int G_ = gridDim.x, bx_ = blockIdx.x; asm volatile("" : "+s"(G_), "+s"(bx_));
        const int tid = tid_, lane = tid & 63, wid = __builtin_amdgcn_readfirstlane(tid >> 6);
        const int G = G_, bx = bx_;
        const int vcu = (G % 8 == 0) ? (bx % 8) * (G / 8) + bx / 8 : bx;
        const int gw = vcu * 8 + wid, NGW = G * 8;
        unsigned char* ws = args.ws; asm volatile("" : "+s"(ws));
        PG8_LAS unsigned char* ldsl = (PG8_LAS unsigned char*)lds;
        float* hout = args.out; asm volatile("" : "+s"(hout));
        bf16* HN = (bf16*)(ws + WS_HN);
        bf16* RB = (bf16*)(ws + WS_R);
        f32x2* tab = (f32x2*)(ws + WS_TAB);
        const int kind = L % 3, jj = L / 3;
        bf16* QN = RB + (size_t)T * 2560;
        bf16* KSb = QN + (size_t)T * 1024;
        bf16* KWb = KSb + (size_t)T * 256;
        bf16* KCH = (bf16*)(ws + WS_O32);
        bf16* VCH = KCH + (size_t)T * 256;
        float* Pk = (float*)(ws + WS_O32 + 32 * MiB);
        float* Pv = Pk + (size_t)8192 * 512;
        bf16* KC = (bf16*)(ws + WS_O32 + 64 * MiB);
        bf16* VC = (bf16*)(ws + WS_O32 + 65 * MiB);
        bf16* OVT = (bf16*)(ws + WS_BP + 65536);
        bf16* VST = (bf16*)(ws + WS_O32 + 68 * MiB);
        bf16* VWT = (bf16*)(ws + WS_O32 + 84 * MiB);
        switch (type) {
        case 0: {
            float* scr = (float*)lds + wid * (64 * 33);
            for (int mi = 0; mi < 28; ++mi) {
                const float* W; const float* nw = nullptr; int K, N, Npad, mode = 0; bf16* WT;
                if (mi < 8)       { nw = (const float*)args.in[2] + (size_t)mi * D; W = (const float*)args.in[3] + (size_t)mi * D * 2 * FF; K = D; N = 2 * FF; Npad = N; mode = 1; WT = (bf16*)(ws + WS_WGU) + (size_t)mi * 2 * FF * D; }
                else if (mi < 16) { const int i = mi - 8; W = (const float*)args.in[4] + (size_t)i * FF * D; K = FF; N = D; Npad = N; WT = (bf16*)(ws + WS_WDN) + (size_t)i * D * FF; }
                else if (mi < 18) { const int i = mi - 16; nw = (const float*)args.in[5] + (size_t)(3 * i) * D; W = (const float*)args.in[6] + (size_t)i * D * 4112; K = D; N = 4112; Npad = GDN_NPAD; WT = (bf16*)(ws + WS_WGI) + (size_t)i * GDN_NPAD * D; }
                else if (mi < 20) { const int i = mi - 18; W = (const float*)args.in[11] + (size_t)i * D * D; K = D; N = D; Npad = N; WT = (bf16*)(ws + WS_WGO) + (size_t)i * D * D; }
                else if (mi == 20) { nw = (const float*)args.in[5] + (size_t)1 * D; W = (const float*)args.in[12]; K = D; N = 3072; Npad = N; WT = (bf16*)(ws + WS_WSI); }
                else if (mi == 21) { W = (const float*)args.in[14]; K = D; N = D; Npad = N; WT = (bf16*)(ws + WS_WSO); }
                else if (mi == 22) { nw = (const float*)args.in[5] + (size_t)2 * D; W = (const float*)args.in[15]; K = D; N = 2608; Npad = NSA_NPAD; WT = (bf16*)(ws + WS_WNI); }
                else if (mi == 23) { W = (const float*)args.in[23]; K = D; N = D; Npad = N; WT = (bf16*)(ws + WS_WNO); }
                else { const int i = mi - 24, kd = i >> 1, hf = i & 1;
                    W = (const float*)args.in[19] + (size_t)kd * 2048 * 256 + (size_t)hf * 1024 * 256; K = 1024; N = 256; Npad = 256; WT = (bf16*)(ws + WS_WC1) + (size_t)kd * 512 * 1024 + (size_t)hf * 256 * 1024; }
                xpose_matrix(W, nw, K, N, Npad, WT, mode, scr, gw, NGW, lane);
            }
            {
                float* ss = (float*)(ws + WS_SS);
                const float* xin = (const float*)args.in[0];
                for (int m = gw; m < T; m += NGW) {
                    const f32x4* xr = (const f32x4*)(xin + (size_t)m * D) + lane; u32x2* o8 = (u32x2*)(HN + (size_t)m * D) + lane; float sq = 0.f;
#pragma unroll
                    for (int j = 0; j < 4; ++j) { const f32x4 v = xr[64 * j]; sq += (v.x * v.x + v.y * v.y) + (v.z * v.z + v.w * v.w); u32x2 o; o.x = pkbf(v.x, v.y); o.y = pkbf(v.z, v.w); o8[64 * j] = o; }
                    sq = wave_sum(sq); if (lane < 16) ss[(size_t)m * 16 + lane] = lane == 0 ? sq : 0.f;
                }
            }
            const int* positions = (const int*)args.in[1];
            for (int idx = bx * 512 + tid; idx < T * 32; idx += G * 512) {
                const int tk = idx >> 5, i = idx & 31;
                const float inv = 1.0f / exp2f((float)(2 * i) * (13.287712379549449f / 64.f));
                const float ang = (float)positions[tk] * inv;
                const double rev = (double)ang * 0.15915494309189535;
                const float fr = (float)(rev - rint(rev));
                f32x2 v; v.x = __builtin_amdgcn_cosf(fr); v.y = __builtin_amdgcn_sinf(fr);
                tab[idx] = v;
            }
            for (int idx = bx * 512 + tid; idx < 64 * 256; idx += G * 512) {
                const int sj = idx >> 8, i = idx & 255, q = i >> 2, rem = i & 3;
                OVT[idx] = (bf16)(rem < 3 ? (q == sj ? 0x3F80 : 0) : ((q == sj || q + 1 == sj) ? 0x3F00 : 0));
            }
            if (bx < 2 && tid < 256) {
                const float* pe = (const float*)args.in[18] + (size_t)bx * 2048;
                const float* w1 = (const float*)args.in[19] + (size_t)bx * 2048 * 256 + tid;
                float acc = ((const float*)args.in[20])[bx * 256 + tid];
                for (int k = 0; k < 2048; ++k) acc += pe[k] * w1[(size_t)k * 256];
                ((float*)(ws + WS_BP))[bx * 256 + tid] = acc;
            }
        } break;
        case 2: {
            const bf16* Ah = (s & 1) ? (const bf16*)(ws + WS_R + 192 * MiB) : HN;
            pg8::Gemm g{Ah, (const bf16*)(ws + WS_WGU) + (size_t)s * 2 * FF * D, T, 2 * FF, D}; pg8::StaticOrder SO; SO.init(T, 2 * FF, G, bx);
            float* rtab = (float*)(lds + 131072);
            rstd_table(rtab, (const float*)(ws + WS_SS) + (size_t)s * T * 16, SO, tid);
            pg8::EpiSwiGLU E{RB, rtab};
            pg8::gemm_phase<pg8::EpiSwiGLU, pg8::StaticOrder, true, true>(ldsl, g, SO, E, tid); } break;
        case 3: {
            pg8::Gemm g{RB, (const bf16*)(ws + WS_WDN) + (size_t)s * D * FF, T, D, FF}; pg8::StaticOrder SO; SO.init(T, D, G, bx);
            const int slot = (s & 1) ? (s < 7 ? s + 1 : 12) : 8 + (s >> 1);
            pg8::EpiResid<1> E{s == 0 ? (const float*)args.in[0] : hout, hout, HN, (float*)(ws + WS_SS) + (size_t)slot * T * 16};
            pg8::gemm_phase<pg8::EpiResid<1>, pg8::StaticOrder, true, true>(ldsl, g, SO, E, tid); } break;
        case 5: {
            const bf16* Wt; int Np, ldc, nmain, ldt, nvalid; float* tail;
            if (kind == 0) { Wt = (const bf16*)(ws + WS_WGI) + (size_t)jj * GDN_NPAD * D; Np = GDN_NPAD; ldc = 4096; nmain = 4096; tail = (float*)(ws + WS_AB); ldt = 16; nvalid = 4112; }
            else if (kind == 1) { Wt = (const bf16*)(ws + WS_WSI); Np = 3072; ldc = 3072; nmain = 3072; tail = (float*)(ws + WS_AB); ldt = 16; nvalid = 3072; }
            else { Wt = (const bf16*)(ws + WS_WNI); Np = NSA_NPAD; ldc = 2560; nmain = 2560; tail = (float*)(ws + WS_GT); ldt = 48; nvalid = 2608; }
            pg8::Gemm g{HN, Wt, T, Np, D}; pg8::StaticOrder SO; SO.init(T, Np, G, bx);
            float* rtab = (float*)(lds + 131072);
            rstd_table(rtab, (const float*)(ws + WS_SS) + (size_t)(8 + L) * T * 16, SO, tid);
            pg8::EpiProj E{RB, ldc, nmain, tail, ldt, nvalid, rtab};
            pg8::gemm_phase<pg8::EpiProj, pg8::StaticOrder, true, true>(ldsl, g, SO, E, tid); } break;
        case 14: phase_gdn_halo(RB, (bf16*)(ws + WS_HALO), vcu * 512 + tid, G * 512); break;
        case 15: phase_gdn_prep(lds, RB, (const bf16*)(ws + WS_HALO), (const float*)(ws + WS_AB), (const float*)args.in[7] + (size_t)jj * 4 * 3072, (const float*)args.in[8] + jj * 8, (const float*)args.in[9] + jj * 8,
                                HN, (bf16*)(ws + WS_O32 + 64 * MiB), (float*)(ws + WS_GL), bx, G, tid, wid, lane); break;
        case 6:
#ifndef DIS_SCAN
            phase_gdn_scan2(lds, RB, HN, (const bf16*)(ws + WS_O32 + 64 * MiB), (const float*)(ws + WS_GL), (bf16*)(ws + WS_O32), bx, G, tid, wid, lane);
#endif
            break;
        case 7:
#ifndef DIS_GPOST
            phase_gdn_post((const bf16*)(ws + WS_O32), RB, (const float*)args.in[10] + jj * 128, HN, gw, NGW, lane);
#endif
            break;
        case 8:
#ifndef DIS_SPOST
            phase_sc_post(RB, (const float*)args.in[13], HN, vcu * 512 + tid, G * 512);
#endif
            break;
        case 9:
#ifndef DIS_NPOST
            phase_nsa_post(lds, RB, (const float*)args.in[16], (const float*)args.in[17], tab, QN, KSb, KWb, KCH, VCH, VST, VWT, gw, NGW, wid, lane);
#endif
            break;
        case 10: {
            pg8::Gemm g{KCH, (const bf16*)(ws + WS_WC1), 8192, 512, 1024}; pg8::StaticOrder SO; SO.init(8192, 512, G, bx);
            pg8::Gemm g2{VCH, (const bf16*)(ws + WS_WC1) + (size_t)512 * 1024, 8192, 512, 1024};
            pg8::EpiF32 E{Pk, 512};
            if (bx >= G / 2) { g = g2; SO.init(8192, 512, G, bx - G / 2); E.C = Pv; }
            pg8::gemm_phase<pg8::EpiF32, pg8::StaticOrder, true, true>(ldsl, g, SO, E, tid); } break;
        case 11:
#ifndef DIS_CMP2
            phase_cmp2(lds, Pk, Pv, (const float*)(ws + WS_BP), (const float*)args.in[21], (const float*)args.in[22], (const float*)args.in[17], KC, VC, gw, NGW, wid, lane);
#endif
            break;
        case 12:
#ifndef DIS_ATTN
            phase_nsa_attn(lds, QN, KSb, KWb, VST, VWT, KC, VC, OVT, (const float*)(ws + WS_GT), tab, HN, bx, G, tid, wid, lane);
#endif
            break;
        default: {
            const bf16* Wout = kind == 0 ? (const bf16*)(ws + WS_WGO) + (size_t)jj * D * D : (kind == 1 ? (const bf16*)(ws + WS_WSO) : (const bf16*)(ws + WS_WNO));
            pg8::Gemm g{HN, Wout, T, D, D}; pg8::StaticOrder SO; SO.init(T, D, G, bx);
            pg8::EpiResid<2> E{hout, hout, (bf16*)(ws + WS_R + 192 * MiB), (float*)(ws + WS_SS) + (size_t)(2 * L + 1) * T * 16};
            pg8::gemm_phase<pg8::EpiResid<2>, pg8::StaticOrder, true, true>(ldsl, g, SO, E, tid); } break;
        }
#ifdef REP_TYPE
        if (type == REP_TYPE && !again) { again = true; xcd_barrier(xbar); --ph; continue; }
        again = false;
#endif
        if (ph + 1 < args.hi) { if (ph == 0) grid.sync(); else xcd_barrier(xbar); }
    }
}

extern "C" void kernel_launch(void* const* d_in, const int* in_sizes, int n_in, void* d_out, int out_size, void* d_ws, size_t ws_size, hipStream_t stream) {
    static int grid = 0;
    if (grid == 0) {
        if (n_in != 24 || out_size != T * D || ws_size < WS_END2) { fprintf(stderr, "kernel_launch: unexpected shapes n_in %d out %d ws %zu (need %zu)\n", n_in, out_size, ws_size, (size_t)WS_END2); grid = -1; return; }
        int dev = 0, cus = 0, per_cu = 0;
        hipGetDevice(&dev); hipDeviceGetAttribute(&cus, hipDeviceAttributeMultiprocessorCount, dev);
        if (hipFuncSetAttribute((const void*)mega, hipFuncAttributeMaxDynamicSharedMemorySize, LDS_BYTES) != hipSuccess) { fprintf(stderr, "kernel_launch: hipFuncSetAttribute failed\n"); grid = -1; return; }
        if (hipOccupancyMaxActiveBlocksPerMultiprocessor(&per_cu, (const void*)mega, 512, LDS_BYTES) != hipSuccess || per_cu < 1) { fprintf(stderr, "kernel_launch: occupancy query says %d\n", per_cu); per_cu = 1; }
        (void)hipGetLastError();
        grid = cus;
    }
    if (grid < 0) return;
    Args a{};
    for (int i = 0; i < 24; ++i) a.in[i] = d_in[i];
    a.out = (float*)d_out; a.ws = (unsigned char*)d_ws;
    constexpr int NPH = total_phases();
#if MK_MULTI
    for (int p = 0; p < NPH; ++p) { a.lo = p; a.hi = p + 1; hipLaunchKernelGGL(mega, dim3(grid), dim3(512), LDS_BYTES, stream, a); }
#else
    a.lo = 0; a.hi = NPH;
    (void)hipMemsetAsync(d_ws, 0, 16384, stream);
    void* kargs[] = {&a};
    hipError_t e = hipLaunchCooperativeKernel((const void*)mega, dim3(grid), dim3(512), kargs, LDS_BYTES, stream);
    if (e != hipSuccess) fprintf(stderr, "cooperative launch failed: %s (grid %d)\n", hipGetErrorString(e), grid);
#endif
}
```

```cpp
#include <hip/hip_runtime.h>
#include <hip/hip_cooperative_groups.h>
#include <cstdio>
#include <cstdint>
namespace cg = cooperative_groups;
namespace pg8 {
#define PG8_LAS __attribute__((address_space(3)))
typedef unsigned short bf16_t;
typedef short bf16x8 __attribute__((ext_vector_type(8)));
typedef float f32x4 __attribute__((ext_vector_type(4)));
typedef unsigned u32x4 __attribute__((ext_vector_type(4)));
constexpr int BM = 256, BK = 64, HALF = 128, HTB = HALF * BK * 2  , STAGE_BYTES = 8 * HTB, NXCD = 8, WGM = 8;

__host__ __device__ __forceinline__ int lds_byte(int r, int c) { const int st = (r >> 4) * 2 + (c >> 5), rr = r & 15, cc = c & 31, ob = rr * 64 + cc * 2; return st * 1024 + (ob ^ (((ob >> 9) & 1) << 5)); }
__host__ __device__ __forceinline__ void stage_rc(int b, int& R, int& C) { const int st = b / 1024, sb = b % 1024, swz = sb ^ (((sb >> 9) & 1) << 5); R = (st >> 1) * 16 + swz / 64; C = (st & 1) * 32 + (swz % 64) / 2; }
__host__ __device__ __forceinline__ int perm32(int rho) { const int n = rho >> 4, i = rho & 15; return 8 * (i >> 2) + 4 * n + (i & 3); }

struct Unit { int pm, pn, ord; };
struct Gemm { const bf16_t* A; const bf16_t* Bt; int M, N, K; };

struct StaticOrder {
    int nM, nN, nwg, G, c;
    __host__ __device__ void init(int M, int N, int G_, int c_) { nM = M / BM; nN = N / BM; nwg = nM * nN; G = G_; c = c_; }
    __host__ __device__ bool next(int i, Unit& u) const {
        const long L = (long)i * G + c; if (L >= nwg) return false;
        int wgid = (int)L; { const int q = nwg / NXCD, r = nwg % NXCD, xcd = wgid % NXCD, off = wgid / NXCD; wgid = (xcd < r ? xcd * (q + 1) : r * (q + 1) + (xcd - r) * q) + off; }
        const int nig = WGM * nN, gid = wgid / nig, fm = gid * WGM, gsz = (nM - fm) < WGM ? (nM - fm) : WGM;
        u.pm = fm + ((wgid % nig) % gsz); u.pn = (wgid % nig) / gsz; u.ord = i; return true;
    }
    __device__ __forceinline__ void a_ready(const Unit&) const {}
    __device__ __forceinline__ void done(const Unit&) const {}
};
__device__ __forceinline__ unsigned cvt_pk_bf16(float lo, float hi) { unsigned r; asm volatile("v_cvt_pk_bf16_f32 %0, %1, %2" : "=v"(r) : "v"(lo), "v"(hi)); return r; }
template <class Epi, class Sched, bool ALIGN_EPI = false, bool SP2 = false>
__device__ __forceinline__ void gemm_phase(PG8_LAS unsigned char* lds, const Gemm g, const Sched& S, const Epi& E, const int tid) {
    const int wid = __builtin_amdgcn_readfirstlane(tid >> 6), lane = tid & 63, wr = wid >> 2, wc = wid & 3, fr = lane & 15, fq = lane >> 4;
    const int K = g.K, nt = K / BK;
    unsigned voffA[2], voffB[2];
#pragma unroll
    for (int i = 0; i < 2; ++i) { int R, C; stage_rc(tid * 16 + i * 8192, R, C); const int Rb = Epi::PERM ? ((R & ~31) + perm32(R & 31)) : R;
        voffA[i] = (unsigned)(R * K + C) * 2u; voffB[i] = (unsigned)(Rb * K + C) * 2u; }
    const size_t kstep = (size_t)(BK * 2);
    const size_t hstep = (size_t)HALF * K * 2;
    const size_t tstep = 2 * hstep;
    const unsigned ldsw = (unsigned)wid * 1024u;
    const int aoff = lds_byte(wr * 64 + fr, fq * 8), boff = lds_byte(wc * 32 + fr, fq * 8);
#define PG8_SA(b, h) (((b) * 2 + (h)) * HTB)
#define PG8_SB(b, h) ((4 + (b) * 2 + (h)) * HTB)
#define PG8_STAGE(bufoff, gbase, voff) do { _Pragma("unroll") for (int _i = 0; _i < 2; ++_i) \
        __builtin_amdgcn_global_load_lds((const unsigned*)((const char*)(gbase) + (voff)[_i]), (PG8_LAS unsigned*)(lds + (bufoff) + ldsw + _i * 8192), 16, 0, 0); } while (0)
#define PG8_LDA(dst, b, h) do { _Pragma("unroll") for (int m = 0; m < 4; ++m) _Pragma("unroll") for (int k = 0; k < 2; ++k) dst[m][k] = *(const PG8_LAS bf16x8*)(lds + PG8_SA(b, h) + aoff + m * 2048 + k * 1024); } while (0)
#define PG8_LDB(dst, b, h) do { _Pragma("unroll") for (int n = 0; n < 2; ++n) _Pragma("unroll") for (int k = 0; k < 2; ++k) dst[n][k] = *(const PG8_LAS bf16x8*)(lds + PG8_SB(b, h) + boff + n * 2048 + k * 1024); } while (0)
#define PG8_MMA(ai, bj, At, Bt) do { __builtin_amdgcn_s_setprio(1); _Pragma("unroll") for (int m = 0; m < 4; ++m) _Pragma("unroll") for (int n = 0; n < 2; ++n) _Pragma("unroll") for (int k = 0; k < 2; ++k) \
        acc[ai][bj][m][n] = __builtin_amdgcn_mfma_f32_16x16x32_bf16(Bt[n][k], At[m][k], acc[ai][bj][m][n], 0, 0, 0); __builtin_amdgcn_s_setprio(0); } while (0)
#define PG8_WAIT_V(n) asm volatile("s_waitcnt vmcnt(" #n ")" ::: "memory")
#define PG8_WAIT_L(n) asm volatile("s_waitcnt lgkmcnt(" #n ")" ::: "memory")
#define PG8_BAR __builtin_amdgcn_s_barrier()
#define PG8_SCHED __builtin_amdgcn_sched_barrier(0)
    Unit cur, nxt; int ui = 0;
    if (!S.next(0, cur)) return;
    f32x4 acc[2][2][4][2];
#pragma unroll
    for (int a = 0; a < 2; ++a)
#pragma unroll
        for (int b = 0; b < 2; ++b)
#pragma unroll
            for (int m = 0; m < 4; ++m)
#pragma unroll
                for (int n = 0; n < 2; ++n) acc[a][b][m][n] = (f32x4){0.f, 0.f, 0.f, 0.f};
    bf16x8 At[4][2], B0[2][2], B1[2][2];
    const char* cA = (const char*)g.A + (size_t)cur.pm * tstep; const char* cB = (const char*)g.Bt + (size_t)cur.pn * tstep;
    S.a_ready(cur);
    if constexpr (SP2) {
        PG8_STAGE(PG8_SB(0, 0), cB, voffB); PG8_STAGE(PG8_SB(0, 1), cB + hstep, voffB); PG8_STAGE(PG8_SA(0, 0), cA, voffA); PG8_STAGE(PG8_SA(0, 1), cA + hstep, voffA);
        if (wr == 1) PG8_BAR;
        PG8_WAIT_V(2); PG8_BAR;
        PG8_STAGE(PG8_SB(1, 0), cB + kstep, voffB); PG8_STAGE(PG8_SA(1, 0), cA + kstep, voffA); PG8_STAGE(PG8_SB(1, 1), cB + hstep + kstep, voffB);
        PG8_WAIT_V(6); PG8_BAR;
    } else {
        PG8_STAGE(PG8_SB(0, 0), cB, voffB); PG8_STAGE(PG8_SA(0, 0), cA, voffA); PG8_STAGE(PG8_SB(0, 1), cB + hstep, voffB); PG8_STAGE(PG8_SA(0, 1), cA + hstep, voffA);
        if (wr == 1) PG8_BAR;
        PG8_WAIT_V(4); PG8_BAR;
        PG8_STAGE(PG8_SB(1, 0), cB + kstep, voffB); PG8_STAGE(PG8_SA(1, 0), cA + kstep, voffA); PG8_STAGE(PG8_SB(1, 1), cB + hstep + kstep, voffB);
        PG8_WAIT_V(6); PG8_BAR;
    }
    for (;;) {
        const bool has_next = S.next(ui + 1, nxt);
        const char* nA = has_next ? (const char*)g.A + (size_t)nxt.pm * tstep : cA; const char* nB = has_next ? (const char*)g.Bt + (size_t)nxt.pn * tstep : cB;
        for (int t = 0; t < nt; t += 2) {
            const bool last = (t == nt - 2);
            const char* a1 = cA + (size_t)(t + 1) * kstep;
            const char* a2 = last ? nA : cA + (size_t)(t + 2) * kstep; const char* b2 = last ? nB : cB + (size_t)(t + 2) * kstep;
            const char* a3 = a2 + kstep; const char* b3 = b2 + kstep;
            if (last && has_next) S.a_ready(nxt);
            if constexpr (SP2) {
            PG8_LDB(B0, 0, 0); PG8_LDB(B1, 0, 1); PG8_SCHED; PG8_LDA(At, 0, 0); PG8_STAGE(PG8_SA(1, 1), a1 + hstep, voffA);
            PG8_WAIT_V(8); PG8_WAIT_L(0); PG8_BAR; PG8_MMA(0, 0, At, B0); PG8_MMA(0, 1, At, B1); PG8_BAR; PG8_SCHED;
            PG8_LDA(At, 0, 1); PG8_STAGE(PG8_SB(0, 0), b2, voffB); PG8_STAGE(PG8_SB(0, 1), b2 + hstep, voffB); PG8_STAGE(PG8_SA(0, 0), a2, voffA);
            PG8_WAIT_V(8); PG8_WAIT_L(0); PG8_BAR; PG8_MMA(1, 0, At, B0); PG8_MMA(1, 1, At, B1); PG8_BAR; PG8_SCHED;
            PG8_LDB(B0, 1, 0); PG8_LDB(B1, 1, 1); PG8_SCHED; PG8_LDA(At, 1, 0); PG8_STAGE(PG8_SA(0, 1), a2 + hstep, voffA);
            PG8_WAIT_V(8); PG8_WAIT_L(0); PG8_BAR; PG8_MMA(0, 0, At, B0); PG8_MMA(0, 1, At, B1); PG8_BAR; PG8_SCHED;
            PG8_LDA(At, 1, 1); PG8_STAGE(PG8_SB(1, 0), b3, voffB); PG8_STAGE(PG8_SB(1, 1), b3 + hstep, voffB); PG8_STAGE(PG8_SA(1, 0), a3, voffA);
            PG8_WAIT_V(8); PG8_WAIT_L(0); PG8_BAR; PG8_MMA(1, 0, At, B0); PG8_MMA(1, 1, At, B1); PG8_BAR; PG8_SCHED;
            } else {
            PG8_LDB(B0, 0, 0); PG8_SCHED; PG8_LDA(At, 0, 0); PG8_STAGE(PG8_SA(1, 1), a1 + hstep, voffA);
            PG8_WAIT_L(8); PG8_BAR; PG8_WAIT_L(0); PG8_MMA(0, 0, At, B0); PG8_BAR; PG8_SCHED;
            PG8_LDB(B1, 0, 1); PG8_STAGE(PG8_SB(0, 0), b2, voffB);
            PG8_BAR; PG8_WAIT_L(0); PG8_MMA(0, 1, At, B1); PG8_BAR;
            PG8_LDA(At, 0, 1); PG8_STAGE(PG8_SA(0, 0), a2, voffA);
            PG8_BAR; PG8_WAIT_L(0); PG8_MMA(1, 0, At, B0); PG8_BAR; PG8_SCHED;
            PG8_STAGE(PG8_SB(0, 1), b2 + hstep, voffB);
            PG8_WAIT_V(6); PG8_BAR; PG8_MMA(1, 1, At, B1); PG8_BAR;
            PG8_LDB(B0, 1, 0); PG8_SCHED; PG8_LDA(At, 1, 0); PG8_STAGE(PG8_SA(0, 1), a2 + hstep, voffA);
            PG8_WAIT_L(8); PG8_BAR; PG8_WAIT_L(0); PG8_MMA(0, 0, At, B0); PG8_BAR; PG8_SCHED;
            PG8_LDB(B1, 1, 1); PG8_STAGE(PG8_SB(1, 0), b3, voffB);
            PG8_BAR; PG8_WAIT_L(0); PG8_MMA(0, 1, At, B1); PG8_BAR;
            PG8_LDA(At, 1, 1); PG8_STAGE(PG8_SA(1, 0), a3, voffA);
            PG8_BAR; PG8_WAIT_L(0); PG8_MMA(1, 0, At, B0); PG8_BAR; PG8_SCHED;
            PG8_STAGE(PG8_SB(1, 1), b3 + hstep, voffB);
            PG8_WAIT_V(6); PG8_BAR; PG8_MMA(1, 1, At, B1); PG8_BAR;
            }
        }
        if constexpr (ALIGN_EPI) { if (wr == 0) PG8_BAR; }
        if constexpr (!Epi::AFTER_DRAIN) { E(acc, cur, wr, wc, fr, fq); S.done(cur); }
        if (!has_next) break;
#pragma unroll
        for (int a = 0; a < 2; ++a)
#pragma unroll
            for (int b = 0; b < 2; ++b)
#pragma unroll
                for (int m = 0; m < 4; ++m)
#pragma unroll
                    for (int n = 0; n < 2; ++n) acc[a][b][m][n] = (f32x4){0.f, 0.f, 0.f, 0.f};
        cur = nxt; cA = nA; cB = nB; ++ui;
        if constexpr (ALIGN_EPI) { if (wr == 1) PG8_BAR; }
    }
    PG8_WAIT_V(0);
    if constexpr (!ALIGN_EPI) { if (wr == 0) PG8_BAR; }
    PG8_BAR;
    if constexpr (Epi::AFTER_DRAIN) { E.fused(acc, cur, wr, wc, fr, fq, lds, wid, lane); S.done(cur); }
#undef PG8_SA
#undef PG8_SB
#undef PG8_STAGE
#undef PG8_LDA
#undef PG8_LDB
#undef PG8_MMA
#undef PG8_WAIT_V
#undef PG8_WAIT_L
#undef PG8_BAR
#undef PG8_SCHED
}
}

typedef unsigned short bf16;
typedef float f32x4 __attribute__((ext_vector_type(4)));
typedef float f32x2 __attribute__((ext_vector_type(2)));
typedef unsigned u32x4 __attribute__((ext_vector_type(4)));
typedef unsigned u32x2 __attribute__((ext_vector_type(2)));

#ifndef MK_MULTI
#define MK_MULTI 0
#endif

constexpr int Bn = 8, S = 4096, T = Bn * S, D = 1024, FF = 2816, DEPTH = 4;
constexpr float EPS = 1e-6f;
constexpr int GDN_NPAD = 4352, NSA_NPAD = 2816;
constexpr int LDS_BYTES = 147456;
constexpr size_t MiB = 1u << 20;
constexpr size_t WS_WGU = 1 * MiB;
constexpr size_t WS_WDN = WS_WGU + 88 * MiB;
constexpr size_t WS_WGI = WS_WDN + 44 * MiB;
constexpr size_t WS_WGO = WS_WGI + 17 * MiB;
constexpr size_t WS_WSI = WS_WGO + 4 * MiB;
constexpr size_t WS_WSO = WS_WSI + 6 * MiB;
constexpr size_t WS_WNI = WS_WSO + 2 * MiB;
constexpr size_t WS_WNO = WS_WNI + 6 * MiB;
constexpr size_t WS_WC1 = WS_WNO + 2 * MiB;
constexpr size_t WS_TAB = WS_WC1 + 2 * MiB;
constexpr size_t WS_HN  = 184 * MiB;
constexpr size_t WS_R   = WS_HN + 64 * MiB;
constexpr size_t WS_O32 = WS_R + 256 * MiB;
constexpr size_t WS_SM  = WS_O32 + 128 * MiB;
constexpr size_t WS_AB  = WS_SM;
constexpr size_t WS_GT  = WS_SM + 2 * MiB;
constexpr size_t WS_BP  = WS_SM + 8 * MiB;
constexpr size_t WS_END = WS_SM + 9 * MiB;
static_assert(WS_TAB + 8 * MiB <= WS_HN, "ws map");

__device__ __forceinline__ float bf2f(unsigned v) { return __uint_as_float(v << 16); }
__device__ __forceinline__ unsigned f2bf(float f) { unsigned u = __float_as_uint(f); return (u + 0x7fffu + ((u >> 16) & 1u)) >> 16; }
__device__ __forceinline__ unsigned pk2(float lo, float hi) { return f2bf(lo) | (f2bf(hi) << 16); }
#define MFMA32(a, b, c) __builtin_amdgcn_mfma_f32_32x32x16_bf16((a), (b), (c), 0, 0, 0)
typedef short bf16x8v __attribute__((ext_vector_type(8)));
typedef float f32x16 __attribute__((ext_vector_type(16)));
typedef __bf16 bf16v2 __attribute__((ext_vector_type(2)));
__device__ __forceinline__ unsigned pkbf(float a, float b) { f32x2 v = {a, b}; return __builtin_bit_cast(unsigned, __builtin_convertvector(v, bf16v2)); }
__device__ __forceinline__ int lane_opq() { int l = (int)__builtin_amdgcn_mbcnt_hi(~0u, __builtin_amdgcn_mbcnt_lo(~0u, 0u)); asm volatile("" : "+v"(l)); return l; }
__device__ __forceinline__ float xshfl(float v, int m) { return __int_as_float(__builtin_amdgcn_ds_bpermute((lane_opq() ^ m) << 2, __float_as_int(v))); }
__device__ __forceinline__ float xshfl_up(float v, int o) { return __int_as_float(__builtin_amdgcn_ds_bpermute((lane_opq() - o) << 2, __float_as_int(v))); }
__device__ __forceinline__ float wave_sum(float v) {
#pragma unroll
    for (int o = 1; o < 64; o <<= 1) v += xshfl(v, o);
    return v;
}
__device__ __forceinline__ float wave_max(float v) {
#pragma unroll
    for (int o = 1; o < 64; o <<= 1) v = fmaxf(v, xshfl(v, o));
    return v;
}
__device__ __forceinline__ float row_sum16(float v) {
    v += __uint_as_float((unsigned)__builtin_amdgcn_update_dpp(0, (int)__float_as_uint(v), 0x128, 0xf, 0xf, false));
    v += __uint_as_float((unsigned)__builtin_amdgcn_update_dpp(0, (int)__float_as_uint(v), 0x124, 0xf, 0xf, false));
    v += __uint_as_float((unsigned)__builtin_amdgcn_update_dpp(0, (int)__float_as_uint(v), 0x122, 0xf, 0xf, false));
    v += __uint_as_float((unsigned)__builtin_amdgcn_update_dpp(0, (int)__float_as_uint(v), 0x121, 0xf, 0xf, false));
    return v;
}
__device__ __forceinline__ float sigmoidf_(float x) { return 1.f / (1.f + __expf(-x)); }
__device__ __forceinline__ float siluf_(float x) { return x * __builtin_amdgcn_rcpf(1.f + __expf(-x)); }
#define WAVE_SYNC() do { asm volatile("s_waitcnt lgkmcnt(0)" ::: "memory"); __builtin_amdgcn_wave_barrier(); } while (0)

__device__ __forceinline__ float row_rstd(const float* ssq, size_t row) {
    const f32x4* p = (const f32x4*)(ssq + row * 16); const f32x4 a = p[0], b = p[1], c = p[2], d = p[3];
    const float t = ((a.x + a.y) + (a.z + a.w)) + ((b.x + b.y) + (b.z + b.w)) + ((c.x + c.y) + (c.z + c.w)) + ((d.x + d.y) + (d.z + d.w));
    return 1.f / sqrtf(t * (1.f / D) + EPS);
}
namespace pg8 {
struct EpiSwiGLU {
    static constexpr bool PERM = true, AFTER_DRAIN = false;
    bf16_t* O; const float* ssq;
    __device__ __forceinline__ void operator()(const f32x4 (&acc)[2][2][4][2], const Unit& u, int wr, int wc, int fr, int fq) const {
        const int row0 = u.pm * BM + wr * 64 + fr, col0 = u.pn * HALF + wc * 32 + 8 * fq;
#pragma unroll
        for (int ai = 0; ai < 2; ++ai)
#pragma unroll
            for (int m = 0; m < 4; ++m) {
                bf16_t* rowp = O + (size_t)(row0 + ai * HALF + m * 16) * FF + col0;
                const float rs = ssq[u.ord * 256 + wr * 64 + fr + ai * HALF + m * 16];
                float v[8];
#pragma unroll
                for (int n = 0; n < 2; ++n)
#pragma unroll
                    for (int j = 0; j < 4; ++j) { const float g = acc[ai][0][m][n][j] * rs, uu = acc[ai][1][m][n][j] * rs; v[n * 4 + j] = g * __builtin_amdgcn_rcpf(1.f + __expf(-g)) * uu; }
                u32x4 w; w.x = cvt_pk_bf16(v[0], v[1]); w.y = cvt_pk_bf16(v[2], v[3]); w.z = cvt_pk_bf16(v[4], v[5]); w.w = cvt_pk_bf16(v[6], v[7]);
                *(u32x4*)rowp = w;
            }
    }
};
template <int SC2> struct EpiResid {
    static constexpr bool PERM = true, AFTER_DRAIN = false;
    const float* base; float* out; bf16_t* HB; float* ssq;
    __device__ __forceinline__ void operator()(const f32x4 (&acc)[2][2][4][2], const Unit& u, int wr, int wc, int fr, int fq) const {
        constexpr float scale = 0.5f * SC2;
        const int row0 = u.pm * BM + wr * 64 + fr, col0 = u.pn * BM + wc * 32 + 8 * fq;
#pragma unroll
        for (int ai = 0; ai < 2; ++ai)
#pragma unroll
            for (int m = 0; m < 4; ++m) {
                const size_t off = (size_t)(row0 + ai * HALF + m * 16) * D + col0;
                float sq = 0.f;
#pragma unroll
                for (int bj = 0; bj < 2; ++bj) {
                    const f32x4 b0 = *(const f32x4*)(base + off + bj * HALF), b1 = *(const f32x4*)(base + off + bj * HALF + 4);
                    const f32x4 o0 = b0 + acc[ai][bj][m][0] * scale, o1 = b1 + acc[ai][bj][m][1] * scale;
                    *(f32x4*)(out + off + bj * HALF) = o0; *(f32x4*)(out + off + bj * HALF + 4) = o1;
                    { u32x4 w; w.x = cvt_pk_bf16(o0[0], o0[1]); w.y = cvt_pk_bf16(o0[2], o0[3]); w.z = cvt_pk_bf16(o1[0], o1[1]); w.w = cvt_pk_bf16(o1[2], o1[3]);
                        *(u32x4*)(HB + off + bj * HALF) = w;
                        sq += ((o0[0] * o0[0] + o0[1] * o0[1]) + (o0[2] * o0[2] + o0[3] * o0[3])) + ((o1[0] * o1[0] + o1[1] * o1[1]) + (o1[2] * o1[2] + o1[3] * o1[3])); }
                }
                { sq += xshfl(sq, 16); sq += xshfl(sq, 32); if (fq == 0) ssq[(size_t)(row0 + ai * HALF + m * 16) * 16 + u.pn * 4 + wc] = sq; }
                if (m == 3) asm volatile("" ::: "memory");
            }
    }
};
struct EpiProj {
    static constexpr bool PERM = true, AFTER_DRAIN = false;
    bf16_t* O; int ldc; int nmain; float* tail; int ldt; int nvalid; const float* ssq;
    __device__ __forceinline__ void operator()(const f32x4 (&acc)[2][2][4][2], const Unit& u, int wr, int wc, int fr, int fq) const {
        const int row0 = u.pm * BM + wr * 64 + fr, colt = u.pn * BM, col0 = colt + wc * 32 + 8 * fq;
        if (colt + BM <= nmain) {
#pragma unroll
            for (int ai = 0; ai < 2; ++ai)
#pragma unroll
                for (int m = 0; m < 4; ++m) {
                    bf16_t* rowp = O + (size_t)(row0 + ai * HALF + m * 16) * ldc + col0;
                    const float rs = ssq[u.ord * 256 + wr * 64 + fr + ai * HALF + m * 16];
#pragma unroll
                    for (int bj = 0; bj < 2; ++bj) { const f32x4 v0 = acc[ai][bj][m][0] * rs, v1 = acc[ai][bj][m][1] * rs;
                        u32x4 w; w.x = cvt_pk_bf16(v0[0], v0[1]); w.y = cvt_pk_bf16(v0[2], v0[3]); w.z = cvt_pk_bf16(v1[0], v1[1]); w.w = cvt_pk_bf16(v1[2], v1[3]);
                        *(u32x4*)(rowp + bj * HALF) = w; }
                }
        } else {
#pragma unroll
            for (int ai = 0; ai < 2; ++ai)
#pragma unroll
                for (int m = 0; m < 4; ++m) {
                    const size_t row = (size_t)(row0 + ai * HALF + m * 16);
                    const float rs = ssq[u.ord * 256 + wr * 64 + fr + ai * HALF + m * 16];
#pragma unroll
                    for (int bj = 0; bj < 2; ++bj)
#pragma unroll
                        for (int n = 0; n < 2; ++n)
#pragma unroll
                            for (int j = 0; j < 4; ++j) { const int col = col0 + bj * HALF + 4 * n + j; if (col >= nmain && col < nvalid) tail[row * ldt + (col - nmain)] = acc[ai][bj][m][n][j] * rs; }
                }
        }
    }
};
struct EpiF32 {
    static constexpr bool PERM = false, AFTER_DRAIN = false;
    float* C; int ldc;
    __device__ __forceinline__ void operator()(const f32x4 (&acc)[2][2][4][2], const Unit& u, int wr, int wc, int fr, int fq) const {
        const int row0 = u.pm * BM + wr * 64 + fr, col0 = u.pn * BM + wc * 32 + 4 * fq;
#pragma unroll
        for (int ai = 0; ai < 2; ++ai)
#pragma unroll
            for (int m = 0; m < 4; ++m) {
                float* rowp = C + (size_t)(row0 + ai * HALF + m * 16) * ldc + col0;
#pragma unroll
                for (int bj = 0; bj < 2; ++bj)
#pragma unroll
                    for (int n = 0; n < 2; ++n) *(f32x4*)(rowp + bj * HALF + n * 16) = acc[ai][bj][m][n];
            }
    }
};
}

template <class Sched>
__device__ __forceinline__ void rstd_table(float* tab, const float* ssq, const Sched& SO, int tid) {
    pg8::Unit u;
    int nu = 0; while (SO.next(nu, u)) ++nu;
    for (int k0 = 0; k0 < nu * 256; k0 += 512 * 3) {
        float t3[3];
#pragma unroll
        for (int k = 0; k < 3; ++k) { const int idx = k0 + 512 * k + tid; t3[k] = 0.f; if (idx < nu * 256) { SO.next(idx >> 8, u); t3[k] = row_rstd(ssq, (size_t)u.pm * 256 + (idx & 255)); } }
#pragma unroll
        for (int k = 0; k < 3; ++k) { const int idx = k0 + 512 * k + tid; if (idx < nu * 256) tab[idx] = t3[k]; }
    }
    __syncthreads();
}
__device__ __forceinline__ void xpose_item(const float* W, const float* nw, int K, int N, bf16* WT, int rowbase, float* scr, int k0, int n0, int lane) {
    if (n0 + 32 <= N && (N & 3) == 0) {
        f32x4 v[8];
#pragma unroll
        for (int i = 0; i < 8; ++i) { v[i] = *(const f32x4*)(W + (size_t)(k0 + 8 * i + (lane >> 3)) * N + n0 + 4 * (lane & 7)); if (nw) v[i] *= nw[k0 + 8 * i + (lane >> 3)]; }
#pragma unroll
        for (int i = 0; i < 8; ++i) { float* d = scr + (8 * i + (lane >> 3)) * 33 + 4 * (lane & 7); d[0] = v[i].x; d[1] = v[i].y; d[2] = v[i].z; d[3] = v[i].w; }
    } else {
#pragma unroll 8
        for (int i = 0; i < 32; ++i) { const int kk = 2 * i + (lane >> 5), n = n0 + (lane & 31); scr[kk * 33 + (lane & 31)] = n < N ? W[(size_t)(k0 + kk) * N + n] * (nw ? nw[k0 + kk] : 1.f) : 0.f; }
    }
    WAVE_SYNC();
    const int c = lane & 7;
#pragma unroll
    for (int j = 0; j < 4; ++j) { const int n = (lane >> 3) + 8 * j; const float* s = scr + (8 * c) * 33 + n;
        u32x4 o; o.x = pk2(s[0 * 33], s[1 * 33]); o.y = pk2(s[2 * 33], s[3 * 33]); o.z = pk2(s[4 * 33], s[5 * 33]); o.w = pk2(s[6 * 33], s[7 * 33]);
        *(u32x4*)(WT + (size_t)(rowbase + n) * K + k0 + 8 * c) = o; }
    WAVE_SYNC();
}
__device__ __forceinline__ void xpose_matrix(const float* W, const float* nw, int K, int N, int Npad, bf16* WT, int mode, float* scr, int gw, int NGW, int lane) {
    const int nblk = Npad / 32, nitems = (K / 64) * nblk;
    for (int it = gw; it < nitems; it += NGW) {
        const int kb = it / nblk, nb = it - kb * nblk, n0 = nb * 32;
        int rb = n0;
        if (mode == 1) rb = (n0 < FF) ? ((n0 >> 7) * 256 + (n0 & 127)) : ((((n0 - FF) >> 7) * 256) + 128 + ((n0 - FF) & 127));
        xpose_item(W, nw, K, N, WT, rb, scr, kb * 64, n0, lane);
    }
}

__device__ __forceinline__ void phase_norm(const float* h, const float* w, bf16* out, int gw, int NGW, int lane) {
    f32x4 wv[4];
#pragma unroll
    for (int j = 0; j < 4; ++j) wv[j] = ((const f32x4*)w)[64 * j + lane];
    for (int m = gw; m < T; m += NGW) {
        const f32x4* xr = (const f32x4*)(h + (size_t)m * D) + lane;
        f32x4 v[4]; float s = 0.f;
#pragma unroll
        for (int j = 0; j < 4; ++j) { v[j] = xr[64 * j]; s += (v[j].x * v[j].x + v[j].y * v[j].y) + (v[j].z * v[j].z + v[j].w * v[j].w); }
        const float rstd = 1.f / sqrtf(wave_sum(s) * (1.f / D) + EPS);
        u32x2* o8 = (u32x2*)(out + (size_t)m * D) + lane;
#pragma unroll
        for (int j = 0; j < 4; ++j) { u32x2 o; o.x = pk2(v[j].x * rstd * wv[j].x, v[j].y * rstd * wv[j].y); o.y = pk2(v[j].z * rstd * wv[j].z, v[j].w * rstd * wv[j].w); o8[64 * j] = o; }
    }
}

__device__ __forceinline__ void phase_gdn_scan(unsigned char* lds, const bf16* proj, const float* ab, const float* convw, const float* A_log, const float* dt_bias,
                                               float* o32, int vblk, int nblk, int tid, int wid, int lane) {
    float* qs = (float*)lds;
    float* ks = qs + 64 * 128;
    float* vs = ks + 64 * 128;
    float* al = vs + 64 * 32;
    float* be = al + 64;
    float* qk = be + 64;
    float* os = qk + 64;
    bf16* raw = (bf16*)(os + 64 * 32);
    const int e = tid >> 4, dl = tid & 15;
    for (int item = vblk; item < 256; item += nblk) {
        const int bh = (item & 7) + 8 * (item >> 5), es = (item >> 3) & 3, b = bh >> 3, h = bh & 7;
        const float Ah = __expf(A_log[h]), dtb = dt_bias[h];
        const int isk = (tid >> 4) & 1, cg = tid & 15, cv = tid & 3;
        const int colqk = isk * 1024 + h * 128 + cg * 8, colv = 2048 + h * 128 + es * 32 + cv * 8;
        f32x4 wq[4][2], wv[4][2];
#pragma unroll
        for (int j = 0; j < 4; ++j) { wq[j][0] = *(const f32x4*)(convw + j * 3072 + colqk); wq[j][1] = *(const f32x4*)(convw + j * 3072 + colqk + 4);
                                      wv[j][0] = *(const f32x4*)(convw + j * 3072 + colv);  wv[j][1] = *(const f32x4*)(convw + j * 3072 + colv + 4); }
        f32x2 S2[4];
#pragma unroll
        for (int i = 0; i < 4; ++i) S2[i] = (f32x2){0.f, 0.f};
        u32x4 pre[5];
#define GDN_PREFETCH(T0) do { _Pragma("unroll") for (int k_ = 0; k_ < 5; ++k_) { const int idx_ = tid + 512 * k_; const int row_ = idx_ / 36, c_ = idx_ - row_ * 36; const int ts_ = (T0) - 3 + row_; \
            const int col_ = c_ < 16 ? h * 128 + c_ * 8 : (c_ < 32 ? 1024 + h * 128 + (c_ - 16) * 8 : 2048 + h * 128 + es * 32 + (c_ - 32) * 8); \
            pre[k_] = (u32x4){0u, 0u, 0u, 0u}; if (idx_ < 67 * 36 && ts_ >= 0) pre[k_] = *(const u32x4*)(proj + (size_t)(b * S + ts_) * 4096 + col_); } } while (0)
#define GDN_PARK() do { _Pragma("unroll") for (int k_ = 0; k_ < 5; ++k_) { const int idx_ = tid + 512 * k_; if (idx_ < 67 * 36) *(u32x4*)(raw + idx_ * 8) = pre[k_]; } } while (0)
#define GDN_CONV8(ROW0, C8, W, OUT) do { _Pragma("unroll") for (int i_ = 0; i_ < 8; ++i_) OUT[i_] = 0.f; _Pragma("unroll") for (int j_ = 0; j_ < 4; ++j_) { const u32x4 xv_ = *(const u32x4*)(raw + ((ROW0) + j_) * 288 + (C8) * 8); \
            OUT[0] += bf2f(xv_.x & 0xffffu) * W[j_][0].x; OUT[1] += bf2f(xv_.x >> 16) * W[j_][0].y; OUT[2] += bf2f(xv_.y & 0xffffu) * W[j_][0].z; OUT[3] += bf2f(xv_.y >> 16) * W[j_][0].w; \
            OUT[4] += bf2f(xv_.z & 0xffffu) * W[j_][1].x; OUT[5] += bf2f(xv_.z >> 16) * W[j_][1].y; OUT[6] += bf2f(xv_.w & 0xffffu) * W[j_][1].z; OUT[7] += bf2f(xv_.w >> 16) * W[j_][1].w; } \
            _Pragma("unroll") for (int i_ = 0; i_ < 8; ++i_) OUT[i_] = siluf_(OUT[i_]); } while (0)
#define GDN_CONVNORM(T0) do { \
            _Pragma("unroll") for (int it_ = 0; it_ < 4; ++it_) { const int tok_ = it_ * 16 + (tid >> 5); float y_[8]; GDN_CONV8(tok_, isk * 16 + cg, wq, y_); \
                float ss_ = (y_[0] * y_[0] + y_[1] * y_[1]) + (y_[2] * y_[2] + y_[3] * y_[3]) + (y_[4] * y_[4] + y_[5] * y_[5]) + (y_[6] * y_[6] + y_[7] * y_[7]); \
                ss_ = row_sum16(ss_); const float sc_ = (1.f / sqrtf(ss_ + EPS)) * (isk ? 1.f : 0.08838834764831845f); \
                float* d_ = (isk ? ks : qs) + tok_ * 128 + cg * 8; \
                _Pragma("unroll") for (int i_ = 0; i_ < 8; ++i_) y_[i_] *= sc_; \
                *(f32x4*)d_ = (f32x4){y_[0], y_[1], y_[2], y_[3]}; *(f32x4*)(d_ + 4) = (f32x4){y_[4], y_[5], y_[6], y_[7]}; \
                float dq_ = 0.f; _Pragma("unroll") for (int i_ = 0; i_ < 8; ++i_) dq_ += y_[i_] * xshfl(y_[i_], 16); \
                dq_ = row_sum16(dq_); if (isk == 0 && cg == 0) qk[tok_] = dq_; } \
            if (tid < 256) { const int tok_ = tid >> 2; float y_[8]; GDN_CONV8(tok_, 32 + cv, wv, y_); float* d_ = vs + tok_ * 32 + cv * 8; \
                *(f32x4*)d_ = (f32x4){y_[0], y_[1], y_[2], y_[3]}; *(f32x4*)(d_ + 4) = (f32x4){y_[4], y_[5], y_[6], y_[7]}; } \
            if (tid < 64) { const size_t tg_ = (size_t)(b * S + (T0) + tid); const float a_ = ab[tg_ * 16 + h] + dtb, bb_ = ab[tg_ * 16 + 8 + h]; \
                const float sp_ = a_ > 20.f ? a_ : __logf(1.f + __expf(a_)); al[tid] = __expf(-Ah * sp_); be[tid] = sigmoidf_(bb_); } } while (0)
        __syncthreads();
        GDN_PREFETCH(0); GDN_PARK();
        __syncthreads();
        GDN_CONVNORM(0);
        __syncthreads();
        for (int chunk = 0; chunk < S / 64; ++chunk) {
            const int t0 = chunk * 64;
            const bool more = chunk + 1 < S / 64;
            if (more) GDN_PREFETCH(t0 + 64);
            {
                const float* kp = ks + dl * 8; const float* qp = qs + dl * 8; const float* vp = vs + e;
                f32x4 nk0 = *(const f32x4*)kp, nk1 = *(const f32x4*)(kp + 4), nq0 = *(const f32x4*)qp, nq1 = *(const f32x4*)(qp + 4);
                float nv = vp[0], na = al[0], nb = be[0], nqk = qk[0];
                for (int t16 = 0; t16 < 4; ++t16) {
                    float ok = 0.f;
#pragma unroll 4
                    for (int i = 0; i < 16; ++i) {
                        const int tt = t16 * 16 + i, tn = (tt + 1) & 63;
                        const f32x2 K0 = {nk0.x, nk0.y}, K1 = {nk0.z, nk0.w}, K2 = {nk1.x, nk1.y}, K3 = {nk1.z, nk1.w};
                        const f32x2 Q0 = {nq0.x, nq0.y}, Q1 = {nq0.z, nq0.w}, Q2 = {nq1.x, nq1.y}, Q3 = {nq1.z, nq1.w};
                        const float v = nv, a = na, bt = nb, qkt = nqk;
                        nk0 = *(const f32x4*)(kp + tn * 128); nk1 = *(const f32x4*)(kp + tn * 128 + 4); nq0 = *(const f32x4*)(qp + tn * 128); nq1 = *(const f32x4*)(qp + tn * 128 + 4);
                        nv = vp[tn * 32]; na = al[tn]; nb = be[tn]; nqk = qk[tn];
                        f32x2 pa = K0 * S2[0], pb = K2 * S2[2], qa = Q0 * S2[0], qb = Q2 * S2[2];
                        pa = K1 * S2[1] + pa; pb = K3 * S2[3] + pb; qa = Q1 * S2[1] + qa; qb = Q3 * S2[3] + qb;
                        pa += pb; qa += qb;
                        float p = pa.x + pa.y, qS = qa.x + qa.y;
                        p = row_sum16(p); qS = row_sum16(qS);
                        const float vn = bt * (v - a * p);
                        const float o = a * qS + qkt * vn;
                        const f32x2 vn2 = {vn, vn}, a2 = {a, a};
                        S2[0] = S2[0] * a2 + K0 * vn2; S2[1] = S2[1] * a2 + K1 * vn2; S2[2] = S2[2] * a2 + K2 * vn2; S2[3] = S2[3] * a2 + K3 * vn2;
                        ok = (i == dl) ? o : ok;
                    }
                    os[(t16 * 16 + dl) * 32 + e] = ok;
                }
            }
            __syncthreads();
            { const int tok = tid >> 3, c4 = tid & 7;
              *(f32x4*)(o32 + (size_t)(b * S + t0 + tok) * D + h * 128 + es * 32 + c4 * 4) = *(const f32x4*)(os + tok * 32 + c4 * 4); }
            if (more) {
                GDN_PARK();
                __syncthreads();
                GDN_CONVNORM(t0 + 64);
            }
            __syncthreads();
        }
#undef GDN_PREFETCH
#undef GDN_PARK
#undef GDN_CONV8
#undef GDN_CONVNORM
    }
}

constexpr size_t WS_HALO = WS_END;
constexpr size_t WS_GL = WS_END + 10 * MiB;
constexpr size_t WS_SS = WS_GL + 1 * MiB;
constexpr size_t WS_END2 = WS_SS + 26 * MiB;

__device__ __forceinline__ void phase_gdn_halo(const bf16* proj, bf16* halo, int gtid, int NT) {
    for (int idx = gtid; idx < Bn * 64 * 3 * 384; idx += NT) {
        const int c = idx % 384, r3 = (idx / 384) % 3, bn = idx / (384 * 3), n = bn & 63, b = bn >> 6;
        u32x4 v = {0u, 0u, 0u, 0u};
        if (n > 0) v = *(const u32x4*)(proj + (size_t)(b * S + 64 * n - 3 + r3) * 4096 + c * 8);
        *(u32x4*)(halo + (size_t)(bn * 3 + r3) * 3072 + c * 8) = v;
    }
}

constexpr int GP_RAW = 0, GP_QB = 51456, GP_KB = GP_QB + 17408, GP_VB = GP_KB + 17408, GP_AM = GP_VB + 16384, GP_GC = GP_AM + 17408;
__device__ __forceinline__ void phase_gdn_prep(unsigned char* lds, bf16* proj, const bf16* halo, const float* ab, const float* convw, const float* A_log, const float* dt_bias,
                                               bf16* KT, bf16* AT, float* GL, int vblk, int nblk, int tid, int wid, int lane) {
    bf16* raw = (bf16*)(lds + GP_RAW);
    unsigned char* qb = lds + GP_QB;
    unsigned char* kb = lds + GP_KB;
    bf16* vb = (bf16*)(lds + GP_VB);
    float* Am = (float*)(lds + GP_AM);
    float* gcs = (float*)(lds + GP_GC);
    float* bes = gcs + 64;
    const int r = lane & 31, hh = lane >> 5;
    for (int item = vblk; item < Bn * 8 * 64; item += nblk) {
        const int n = item & 63, h = (item >> 6) & 7, b = item >> 9;
        const size_t tok0 = (size_t)b * S + 64 * n;
        __syncthreads();
#pragma unroll
        for (int k_ = 0; k_ < 7; ++k_) {
            const int idx = tid + 512 * k_;
            if (idx < 67 * 48) {
                const int row = idx / 48, c = idx - row * 48;
                const int col = c < 16 ? h * 128 + c * 8 : (c < 32 ? 1024 + h * 128 + (c - 16) * 8 : 2048 + h * 128 + (c - 32) * 8);
                u32x4 v;
                if (row < 3) v = *(const u32x4*)(halo + (size_t)((b * 64 + n) * 3 + row) * 3072 + col);
                else v = *(const u32x4*)(proj + (tok0 + row - 3) * 4096 + col);
                *(u32x4*)(raw + row * 384 + c * 8) = v;
            }
        }
        if (tid < 64) {
            const float a = ab[(tok0 + tid) * 16 + h] + dt_bias[h], bb = ab[(tok0 + tid) * 16 + 8 + h];
            const float sp = a > 20.f ? a : __logf(1.f + __expf(a));
            float g = -__expf(A_log[h]) * sp;
#pragma unroll
            for (int o = 1; o < 64; o <<= 1) { const float t_ = xshfl_up(g, o); if (lane >= o) g += t_; }
            const float be_ = sigmoidf_(bb);
            gcs[tid] = g; bes[tid] = be_; gcs[128 + tid] = be_; gcs[192 + tid] = be_ * __expf(g);
        }
        __syncthreads();
        {
            const int isk = (tid >> 4) & 1, cg = tid & 15;
            const int colqk = isk * 1024 + h * 128 + cg * 8, colv = 2048 + h * 128 + cg * 8;
#define GP_CONV8(ROW0, C8, COL, OUT) do { _Pragma("unroll") for (int i_ = 0; i_ < 8; ++i_) OUT[i_] = 0.f; _Pragma("unroll") for (int j_ = 0; j_ < 4; ++j_) { const u32x4 xv_ = *(const u32x4*)(raw + ((ROW0) + j_) * 384 + (C8) * 8); \
            const f32x4 w0_ = *(const f32x4*)(convw + j_ * 3072 + (COL)), w1_ = *(const f32x4*)(convw + j_ * 3072 + (COL) + 4); \
            OUT[0] += bf2f(xv_.x & 0xffffu) * w0_.x; OUT[1] += bf2f(xv_.x >> 16) * w0_.y; OUT[2] += bf2f(xv_.y & 0xffffu) * w0_.z; OUT[3] += bf2f(xv_.y >> 16) * w0_.w; \
            OUT[4] += bf2f(xv_.z & 0xffffu) * w1_.x; OUT[5] += bf2f(xv_.z >> 16) * w1_.y; OUT[6] += bf2f(xv_.w & 0xffffu) * w1_.z; OUT[7] += bf2f(xv_.w >> 16) * w1_.w; } \
            _Pragma("unroll") for (int i_ = 0; i_ < 8; ++i_) OUT[i_] = siluf_(OUT[i_]); } while (0)
#pragma unroll 1
            for (int it = 0; it < 4; ++it) {
                const int tk = it * 16 + (tid >> 5);
                float y[8]; GP_CONV8(tk, isk * 16 + cg, colqk, y);
                float ss = (y[0] * y[0] + y[1] * y[1]) + (y[2] * y[2] + y[3] * y[3]) + (y[4] * y[4] + y[5] * y[5]) + (y[6] * y[6] + y[7] * y[7]);
                ss = row_sum16(ss);
                const float sc = (1.f / sqrtf(ss + EPS)) * (isk ? 1.f : 0.08838834764831845f);
                u32x4 w; w.x = pkbf(y[0] * sc, y[1] * sc); w.y = pkbf(y[2] * sc, y[3] * sc); w.z = pkbf(y[4] * sc, y[5] * sc); w.w = pkbf(y[6] * sc, y[7] * sc);
                *(u32x4*)((isk ? kb : qb) + tk * 272 + cg * 16) = w;
            }
#pragma unroll 1
            for (int it = 0; it < 2; ++it) {
                const int tk = it * 32 + (tid >> 4);
                float y[8]; GP_CONV8(tk, 32 + cg, colv, y);
                u32x4 w; w.x = pkbf(y[0], y[1]); w.y = pkbf(y[2], y[3]); w.z = pkbf(y[4], y[5]); w.w = pkbf(y[6], y[7]);
                *(u32x4*)(vb + tk * 128 + cg * 8) = w;
            }
#undef GP_CONV8
        }
        __syncthreads();
        {
            const int prod = wid >> 2, tr = (wid >> 1) & 1, tc = wid & 1;
            f32x16 acc;
#pragma unroll
            for (int i = 0; i < 16; ++i) acc[i] = 0.f;
            if (tr >= tc) {
                const unsigned char* Ab = (prod ? qb : kb) + (32 * tr + r) * 272 + hh * 16;
                const unsigned char* Bb = kb + (32 * tc + r) * 272 + hh * 16;
#pragma unroll
                for (int ks = 0; ks < 8; ++ks) acc = MFMA32(*(const bf16x8v*)(Ab + ks * 32), *(const bf16x8v*)(Bb + ks * 32), acc);
            }
            const int j = 32 * tc + r; const float gj = gcs[j];
#pragma unroll
            for (int i_ = 0; i_ < 16; ++i_) {
                const int i = 32 * tr + (i_ & 3) + 8 * (i_ >> 2) + 4 * hh;
                const float dec = __expf(gcs[i] - gj);
                if (prod == 0) Am[i * 68 + j] = (j < i) ? bes[i] * acc[i_] * dec : 0.f;
                else AT[(size_t)item * 4096 + i * 64 + j] = (bf16)f2bf((j <= i) ? acc[i_] * dec : 0.f);
            }
        }
        __syncthreads();
        int tid3 = tid; asm volatile("" : "+v"(tid3));
        if (tid3 < 256) {
            const int isw = tid3 >> 7, d = tid3 & 127;
            unsigned oam = GP_AM, orsc = GP_GC + 512 + isw * 256, ocol = (isw ? GP_KB : GP_VB) + d * 2;
            asm volatile("" : "+v"(oam), "+v"(orsc), "+v"(ocol));
            const float* Am_ = (const float*)(lds + oam); const float* rsc = (const float*)(lds + orsc); const unsigned char* col = lds + ocol;
            const int cstride = isw ? 272 : 256;
            float X[64];
#pragma clang loop unroll(full)
            for (int i = 0; i < 64; ++i) X[i] = 0.f;
#pragma clang loop unroll(full)
            for (int i = 0; i < 64; ++i) {
                f32x4 av = {0.f, 0.f, 0.f, 0.f};
#pragma clang loop unroll(full)
                for (int j4 = 0; j4 < 16; ++j4) { if (4 * j4 < i) { const f32x4 a4 = *(const f32x4*)(Am_ + i * 68 + 4 * j4);
                    const f32x4 x4 = {X[4 * j4], X[4 * j4 + 1], X[4 * j4 + 2], X[4 * j4 + 3]}; av += a4 * x4; } }
                X[i] = rsc[i] * bf2f(*(const bf16*)(col + i * cstride)) - ((av.x + av.y) + (av.z + av.w));
                asm volatile("" ::: "memory");
            }
            if (isw) {
#pragma unroll
                for (int i = 0; i < 64; ++i) raw[i * 128 + d] = (bf16)f2bf(X[i]);
            } else {
                bf16* up = proj + (tok0 + (d >> 1)) * 4096 + 2048 + h * 128 + (d & 1) * 64;
#pragma unroll
                for (int i8 = 0; i8 < 8; ++i8) { u32x4 w; w.x = pkbf(X[8 * i8], X[8 * i8 + 1]); w.y = pkbf(X[8 * i8 + 2], X[8 * i8 + 3]); w.z = pkbf(X[8 * i8 + 4], X[8 * i8 + 5]); w.w = pkbf(X[8 * i8 + 6], X[8 * i8 + 7]);
                    *(u32x4*)(up + 8 * i8) = w; }
            }
        } else {
            if (tid3 < 384) {
                const int d = tid3 - 256; const float gl_ = gcs[63];
                bf16* kp = KT + (size_t)item * 8192 + d * 64;
#pragma unroll
                for (int i8 = 0; i8 < 8; ++i8) { float y[8];
#pragma unroll
                    for (int i = 0; i < 8; ++i) y[i] = bf2f(*(const bf16*)(kb + (8 * i8 + i) * 272 + d * 2)) * __expf(gl_ - gcs[8 * i8 + i]);
                    u32x4 w; w.x = pkbf(y[0], y[1]); w.y = pkbf(y[2], y[3]); w.z = pkbf(y[4], y[5]); w.w = pkbf(y[6], y[7]);
                    *(u32x4*)(kp + 8 * i8) = w; }
                if (d == 0) GL[item] = __expf(gl_);
            }
#pragma unroll
            for (int k = 0; k < 4; ++k) {
                const int pc = (tid3 - 256) + 256 * k, i = pc >> 4, c8 = pc & 15;
                const u32x4 v = *(const u32x4*)(qb + i * 272 + c8 * 16); const float eg = __expf(gcs[i]);
                u32x4 w; w.x = pkbf(bf2f(v.x & 0xffffu) * eg, bf2f(v.x >> 16) * eg); w.y = pkbf(bf2f(v.y & 0xffffu) * eg, bf2f(v.y >> 16) * eg);
                w.z = pkbf(bf2f(v.z & 0xffffu) * eg, bf2f(v.z >> 16) * eg); w.w = pkbf(bf2f(v.w & 0xffffu) * eg, bf2f(v.w >> 16) * eg);
                *(u32x4*)(proj + (tok0 + i) * 4096 + h * 128 + c8 * 8) = w;
            }
        }
        __syncthreads();
#pragma unroll
        for (int k = 0; k < 2; ++k) { const int pc = tid + 512 * k, i = pc >> 4, c8 = pc & 15;
            *(u32x4*)(proj + (tok0 + i) * 4096 + 1024 + h * 128 + c8 * 8) = *(const u32x4*)(raw + i * 128 + c8 * 8); }
    }
}

__device__ __forceinline__ void phase_gdn_scan2(unsigned char* lds, const bf16* proj, const bf16* KT, const bf16* AT, const float* GL, bf16* o16, int vblk, int nblk, int tid, int wid, int lane) {
    unsigned char* Sl = lds;
    unsigned char* Vl = lds + 8704;
    const int r = lane & 31, hh = lane >> 5;
    for (int item = vblk; item < 256; item += nblk) {
        const int bh = (item & 7) + 8 * (item >> 5), es = (item >> 3) & 3, b = bh >> 3, h = bh & 7;
        __syncthreads();
        for (int i = tid; i < 8704 / 4; i += 512) ((unsigned*)Sl)[i] = 0u;
        f32x16 Sacc;
#pragma unroll
        for (int i = 0; i < 16; ++i) Sacc[i] = 0.f;
        const int rt = wid & 1, dt = wid & 3;
        for (int n = 0; n < 64; ++n) {
            const size_t tok0 = (size_t)b * S + 64 * n; const int itm = bh * 64 + n;
            bf16x8v A8[8]; bf16x8v A4[4]; u32x2 uu[4]; float gl = 1.f;
            if (wid < 2) {
                const bf16* wp = proj + (tok0 + 32 * rt + r) * 4096 + 1024 + h * 128 + 8 * hh;
#pragma unroll
                for (int ks = 0; ks < 8; ++ks) A8[ks] = *(const bf16x8v*)(wp + 16 * ks);
                const int c = es * 32 + r;
                const bf16* up = proj + (tok0 + (c >> 1)) * 4096 + 2048 + h * 128 + (c & 1) * 64 + 32 * rt + 4 * hh;
#pragma unroll
                for (int g = 0; g < 4; ++g) uu[g] = *(const u32x2*)(up + 8 * g);
            } else if (wid < 4) {
                const bf16* qp = proj + (tok0 + 32 * rt + r) * 4096 + h * 128 + 8 * hh;
#pragma unroll
                for (int ks = 0; ks < 8; ++ks) A8[ks] = *(const bf16x8v*)(qp + 16 * ks);
                const bf16* ap = AT + (size_t)itm * 4096 + (32 * rt + r) * 64 + 8 * hh;
#pragma unroll
                for (int sx = 0; sx < 4; ++sx) A4[sx] = *(const bf16x8v*)(ap + 16 * sx);
            } else {
                const bf16* kp = KT + (size_t)itm * 8192 + (32 * dt + r) * 64 + 8 * hh;
#pragma unroll
                for (int sx = 0; sx < 4; ++sx) A4[sx] = *(const bf16x8v*)(kp + 16 * sx);
                gl = GL[itm];
            }
            __syncthreads();
            f32x16 acc;
#pragma unroll
            for (int i = 0; i < 16; ++i) acc[i] = 0.f;
            if (wid < 4) {
#pragma unroll
                for (int ks = 0; ks < 8; ++ks) acc = MFMA32(A8[ks], *(const bf16x8v*)(Sl + r * 272 + ks * 32 + hh * 16), acc);
                if (wid < 2) {
#pragma unroll
                    for (int g = 0; g < 4; ++g) {
                        u32x2 w; w.x = pkbf(bf2f(uu[g].x & 0xffffu) - acc[4 * g], bf2f(uu[g].x >> 16) - acc[4 * g + 1]);
                        w.y = pkbf(bf2f(uu[g].y & 0xffffu) - acc[4 * g + 2], bf2f(uu[g].y >> 16) - acc[4 * g + 3]);
                        *(u32x2*)(Vl + r * 144 + (32 * rt + 8 * g + 4 * hh) * 2) = w;
                    }
                }
            }
            __syncthreads();
            if (wid >= 2 && wid < 4) {
#pragma unroll
                for (int sx = 0; sx < 4; ++sx) acc = MFMA32(A4[sx], *(const bf16x8v*)(Vl + r * 144 + sx * 32 + hh * 16), acc);
                bf16* op = o16 + (tok0 + 32 * rt + 4 * hh) * D + h * 128 + es * 32 + r;
#pragma unroll
                for (int i = 0; i < 16; ++i) op[(size_t)((i & 3) + 8 * (i >> 2)) * D] = (bf16)f2bf(acc[i]);
            } else if (wid >= 4) {
#pragma unroll
                for (int i = 0; i < 16; ++i) Sacc[i] *= gl;
#pragma unroll
                for (int sx = 0; sx < 4; ++sx) Sacc = MFMA32(A4[sx], *(const bf16x8v*)(Vl + r * 144 + sx * 32 + hh * 16), Sacc);
#pragma unroll
                for (int g = 0; g < 4; ++g) { u32x2 w; w.x = pkbf(Sacc[4 * g], Sacc[4 * g + 1]); w.y = pkbf(Sacc[4 * g + 2], Sacc[4 * g + 3]);
                    *(u32x2*)(Sl + r * 272 + (32 * dt + 8 * g + 4 * hh) * 2) = w; }
            }
        }
    }
}

__device__ __forceinline__ void phase_gdn_post(const bf16* o16, const bf16* proj, const float* onorm, bf16* hn, int gw, int NGW, int lane) {
    const f32x4 wv = *(const f32x4*)(onorm + ((4 * lane) & 127));
    for (int m = gw; m < T; m += NGW) {
        const u32x2* xr = (const u32x2*)(o16 + (size_t)m * D) + lane;
        const u32x2* gr = (const u32x2*)(proj + (size_t)m * 4096 + 3072) + lane;
        u32x2* o8 = (u32x2*)(hn + (size_t)m * D) + lane;
#pragma unroll
        for (int j = 0; j < 4; ++j) {
            const u32x2 xv = xr[64 * j]; const u32x2 g = gr[64 * j];
            const f32x4 v = {bf2f(xv.x & 0xffffu), bf2f(xv.x >> 16), bf2f(xv.y & 0xffffu), bf2f(xv.y >> 16)};
            float s = (v.x * v.x + v.y * v.y) + (v.z * v.z + v.w * v.w);
#pragma unroll
            for (int o = 1; o < 32; o <<= 1) s += xshfl(s, o);
            const float rstd = 1.f / sqrtf(s * (1.f / 128.f) + EPS);
            u32x2 o; o.x = pk2(v.x * rstd * wv.x * siluf_(bf2f(g.x & 0xffffu)), v.y * rstd * wv.y * siluf_(bf2f(g.x >> 16)));
            o.y = pk2(v.z * rstd * wv.z * siluf_(bf2f(g.y & 0xffffu)), v.w * rstd * wv.w * siluf_(bf2f(g.y >> 16)));
            o8[64 * j] = o;
        }
    }
}
__device__ __forceinline__ void phase_sc_post(const bf16* proj, const float* cw, bf16* hn, int gtid, int NT) {
    for (int idx = gtid; idx < T * 128; idx += NT) {
        const int m = idx >> 7, c8 = (idx & 127) * 8, s = m & (S - 1);
        float y[8];
#pragma unroll
        for (int i = 0; i < 8; ++i) y[i] = 0.f;
#pragma unroll
        for (int j = 0; j < 3; ++j) {
            if (s - 2 + j >= 0) {
                const bf16* pr = proj + (size_t)(m - 2 + j) * 3072;
                const u32x4 cv = *(const u32x4*)(pr + 1024 + c8), xv = *(const u32x4*)(pr + 2048 + c8);
                const f32x4 w0 = *(const f32x4*)(cw + j * 1024 + c8), w1 = *(const f32x4*)(cw + j * 1024 + c8 + 4);
                y[0] += w0.x * bf2f(cv.x & 0xffffu) * bf2f(xv.x & 0xffffu); y[1] += w0.y * bf2f(cv.x >> 16) * bf2f(xv.x >> 16);
                y[2] += w0.z * bf2f(cv.y & 0xffffu) * bf2f(xv.y & 0xffffu); y[3] += w0.w * bf2f(cv.y >> 16) * bf2f(xv.y >> 16);
                y[4] += w1.x * bf2f(cv.z & 0xffffu) * bf2f(xv.z & 0xffffu); y[5] += w1.y * bf2f(cv.z >> 16) * bf2f(xv.z >> 16);
                y[6] += w1.z * bf2f(cv.w & 0xffffu) * bf2f(xv.w & 0xffffu); y[7] += w1.w * bf2f(cv.w >> 16) * bf2f(xv.w >> 16);
            }
        }
        const u32x4 bv = *(const u32x4*)(proj + (size_t)m * 3072 + c8);
        u32x4 o;
        o.x = pk2(y[0] * bf2f(bv.x & 0xffffu), y[1] * bf2f(bv.x >> 16)); o.y = pk2(y[2] * bf2f(bv.y & 0xffffu), y[3] * bf2f(bv.y >> 16));
        o.z = pk2(y[4] * bf2f(bv.z & 0xffffu), y[5] * bf2f(bv.z >> 16)); o.w = pk2(y[6] * bf2f(bv.w & 0xffffu), y[7] * bf2f(bv.w >> 16));
        *(u32x4*)(hn + (size_t)m * D + c8) = o;
    }
}
__device__ __forceinline__ void phase_nsa_post(unsigned char* lds, const bf16* proj, const float* qnorm, const float* knorm, const f32x2* tab,
                                               bf16* QN, bf16* KS, bf16* KW, bf16* KCH, bf16* VCH, bf16* VST, bf16* VWT, int gw, int NGW, int wid, int lane) {
    {
        bf16* tile = (bf16*)lds + wid * (64 * 72);
        const int c8 = lane & 7, r8 = lane >> 3;
        for (int item = gw; item < 2 * 32 * 64; item += NGW) {
            const int st = item & 63, bh = (item >> 6) & 31, which = item >> 11, b = bh >> 2, hk = bh & 3;
            const bf16* src = proj + ((size_t)b * S + st * 64 + r8) * 2560 + (which ? 2304 : 1792) + hk * 64 + c8 * 8;
            u32x4 v[8];
#pragma unroll
            for (int i = 0; i < 8; ++i) v[i] = *(const u32x4*)(src + (size_t)(8 * i) * 2560);
#pragma unroll
            for (int i = 0; i < 8; ++i) *(u32x4*)(tile + (8 * i + r8) * 72 + c8 * 8) = v[i];
            WAVE_SYNC();
            bf16* dst = (which ? VWT : VST) + (size_t)bh * 64 * S + st * 64 + c8 * 8;
#pragma unroll
            for (int i = 0; i < 8; ++i) {
                const bf16* tp = tile + (8 * c8) * 72 + 8 * i + r8;
                u32x4 w; w.x = (unsigned)tp[0] | ((unsigned)tp[72] << 16); w.y = (unsigned)tp[144] | ((unsigned)tp[216] << 16);
                w.z = (unsigned)tp[288] | ((unsigned)tp[360] << 16); w.w = (unsigned)tp[432] | ((unsigned)tp[504] << 16);
                *(u32x4*)(dst + (size_t)(8 * i + r8) * S) = w;
            }
            WAVE_SYNC();
        }
    }
    const int l8 = lane & 7, hsel = lane >> 3, lo32 = lane < 32;
    float qw8[8], kw8[8];
#pragma unroll
    for (int j = 0; j < 8; ++j) { qw8[j] = qnorm[8 * l8 + j]; kw8[j] = knorm[(lo32 ? 64 : 128) + 8 * l8 + j]; }
#define NP_UNPACK(V, X) do { X[0] = bf2f(V.x & 0xffffu); X[1] = bf2f(V.x >> 16); X[2] = bf2f(V.y & 0xffffu); X[3] = bf2f(V.y >> 16); X[4] = bf2f(V.z & 0xffffu); X[5] = bf2f(V.z >> 16); X[6] = bf2f(V.w & 0xffffu); X[7] = bf2f(V.w >> 16); } while (0)
#define NP_RSTD8(X, R) do { float ss_ = (X[0] * X[0] + X[1] * X[1]) + (X[2] * X[2] + X[3] * X[3]) + (X[4] * X[4] + X[5] * X[5]) + (X[6] * X[6] + X[7] * X[7]); \
        ss_ += xshfl(ss_, 1); ss_ += xshfl(ss_, 2); ss_ += xshfl(ss_, 4); R = 1.f / sqrtf(ss_ * (1.f / 64.f) + EPS); } while (0)
    for (int m = gw; m < T; m += NGW) {
        const int b = m >> 12, s = m & (S - 1);
        const bf16* pr = proj + (size_t)m * 2560;
        const u32x4 vq0 = *(const u32x4*)(pr + lane * 8), vq1 = *(const u32x4*)(pr + 512 + lane * 8);
        const u32x4 vk = *(const u32x4*)(pr + (lo32 ? 1536 + lane * 8 : 2048 + (lane - 32) * 8));
        const u32x4 vc = *(const u32x4*)(pr + (lo32 ? 1024 + lane * 8 : 1280 + (lane - 32) * 8));
        const f32x4* cp = (const f32x4*)(tab + (size_t)m * 32 + 8 * (l8 & 3));
        const f32x4 c0 = cp[0], c1 = cp[1], c2 = cp[2], c3 = cp[3];
        {
            float x[8], r; NP_UNPACK(vq0, x); NP_RSTD8(x, r);
            u32x4 w; w.x = pkbf(x[0] * r * qw8[0], x[1] * r * qw8[1]); w.y = pkbf(x[2] * r * qw8[2], x[3] * r * qw8[3]); w.z = pkbf(x[4] * r * qw8[4], x[5] * r * qw8[5]); w.w = pkbf(x[6] * r * qw8[6], x[7] * r * qw8[7]);
            *(u32x4*)(QN + ((size_t)(b * 16 + hsel) * S + s) * 64 + 8 * l8) = w;
        }
        {
            float x[8], r; NP_UNPACK(vq1, x); NP_RSTD8(x, r);
            u32x4 w; w.x = pkbf(x[0] * r * qw8[0], x[1] * r * qw8[1]); w.y = pkbf(x[2] * r * qw8[2], x[3] * r * qw8[3]); w.z = pkbf(x[4] * r * qw8[4], x[5] * r * qw8[5]); w.w = pkbf(x[6] * r * qw8[6], x[7] * r * qw8[7]);
            *(u32x4*)(QN + ((size_t)(b * 16 + 8 + hsel) * S + s) * 64 + 8 * l8) = w;
        }
        const size_t okv = ((size_t)(b * 4 + (hsel & 3)) * S + s) * 64 + 8 * l8;
        {
            float x[8], r, y[8]; NP_UNPACK(vk, x); NP_RSTD8(x, r);
            const float cs[16] = {c0.x, c0.y, c0.z, c0.w, c1.x, c1.y, c1.z, c1.w, c2.x, c2.y, c2.z, c2.w, c3.x, c3.y, c3.z, c3.w};
#pragma unroll
            for (int j = 0; j < 8; ++j) { const float yv = x[j] * r * kw8[j]; const float yp = xshfl(yv, 4); y[j] = yv * cs[2 * j] + (l8 < 4 ? -yp : yp) * cs[2 * j + 1]; }
            u32x4 w; w.x = pkbf(y[0], y[1]); w.y = pkbf(y[2], y[3]); w.z = pkbf(y[4], y[5]); w.w = pkbf(y[6], y[7]);
            *(u32x4*)((lo32 ? KS : KW) + okv) = w;
        }
        *(u32x4*)((lo32 ? KCH : VCH) + okv) = vc;
    }
#undef NP_UNPACK
#undef NP_RSTD8
}
__device__ __forceinline__ void phase_cmp2(unsigned char* lds, const float* Pk, const float* Pv, const float* biasp, const float* w2, const float* b2, const float* knorm0,
                                           bf16* KC, bf16* VC, int gw, int NGW, int wid, int lane, int tid) {
    float* hs = (float*)lds + wid * 256;
    float* w2l = (float*)(lds + 8192);
    for (int kind = 0; kind < 2; ++kind) {
        __syncthreads();
        for (int idx = tid; idx < 256 * 64 / 4; idx += 512) ((f32x4*)w2l)[idx] = ((const f32x4*)(w2 + (size_t)kind * 256 * 64))[idx];
        __syncthreads();
        const float* P = kind ? Pv : Pk;
        for (int it = gw; it < 32 * 256; it += NGW) {
            const int i = it & 255, bh = it >> 8;
            bf16* outp = kind ? VC + ((size_t)bh * 64 + lane) * 256 + i : KC + ((size_t)bh * 256 + i) * 64 + lane;
            if (i == 255) { *outp = 0; continue; }
            const float* r0 = P + ((size_t)bh * 256 + i) * 512; const float* r1 = r0 + 512 + 256;
#pragma unroll
            for (int j = 0; j < 4; ++j) { const int n = lane + 64 * j; const float x = r0[n] + r1[n] + biasp[kind * 256 + n];
                const float uu = 0.7978845608028654f * (x + 0.044715f * x * x * x);
                const float th = 1.f - 2.f / (1.f + __expf(2.f * uu));
                hs[n] = 0.5f * x * (1.f + th); }
            WAVE_SYNC();
            float a0 = b2[kind * 64 + lane], a1 = 0.f, a2 = 0.f, a3 = 0.f;
#pragma unroll 4
            for (int n = 0; n < 256; n += 4) { const f32x4 hv = *(const f32x4*)(hs + n);
                a0 += hv.x * w2l[n * 64 + lane]; a1 += hv.y * w2l[(n + 1) * 64 + lane]; a2 += hv.z * w2l[(n + 2) * 64 + lane]; a3 += hv.w * w2l[(n + 3) * 64 + lane]; }
            float acc = (a0 + a1) + (a2 + a3);
            if (kind == 0) { const float ss = wave_sum(acc * acc); acc = acc * (1.f / sqrtf(ss * (1.f / 64.f) + EPS)) * knorm0[lane]; }
            *outp = (bf16)f2bf(acc);
            WAVE_SYNC();
        }
    }
}
constexpr int KV_STRIDE = 144;
constexpr int KV_BUF = 2 * 64 * KV_STRIDE;
constexpr int ATT_IMP_OFF = 2 * KV_BUF;
constexpr int ATT_MSK_OFF = ATT_IMP_OFF + 8 * 2048;

template <bool IMP>
__device__ __forceinline__ void attn_tile(const bool FAST, const unsigned char* buf, int tt, int key0, int lo, int hi, const bf16x8v (&qf)[4],
                                          f32x16 (&O)[2], f32x16 (&IM)[2], float& m, float& l, const bf16* ovt, int r, int h, int pr) {
    f32x16 sacc;
#pragma unroll
    for (int i = 0; i < 16; ++i) sacc[i] = 0.f;
    const unsigned char* kb = buf + (32 * tt + pr) * KV_STRIDE + h * 16;
#pragma unroll
    for (int ks = 0; ks < 4; ++ks) { const bf16x8v a = *(const bf16x8v*)(kb + ks * 32); sacc = MFMA32(a, qf[ks], sacc); }
    const int kb0 = key0 + 8 * h;
    float mx = -1e30f, psum = 0.f, corr;
    if (FAST) {
        const bool on = hi >= 0;
#pragma unroll
        for (int i = 0; i < 16; ++i) mx = fmaxf(mx, sacc[i]);
        mx = on ? mx * 0.18033688011112042f : -1e30f;
        mx = fmaxf(mx, xshfl(mx, 32));
        const float mnew = fmaxf(m, mx);
        corr = __builtin_amdgcn_exp2f(m - mnew);
        m = mnew;
#pragma unroll
        for (int i = 0; i < 16; ++i) { const float p = __builtin_amdgcn_exp2f(sacc[i] * 0.18033688011112042f - mnew); psum += p; sacc[i] = p; }
        if (!on) {
            psum = 0.f;
#pragma unroll
            for (int i = 0; i < 16; ++i) sacc[i] = 0.f;
        }
    } else {
#pragma unroll
        for (int i = 0; i < 16; ++i) { const int key = kb0 + 16 * (i >> 3) + (i & 7); const bool ok = (key >= lo) && (key <= hi);
            const float sv = ok ? sacc[i] * 0.18033688011112042f : -1e30f; sacc[i] = sv; mx = fmaxf(mx, sv); }
        mx = fmaxf(mx, xshfl(mx, 32));
        const float mnew = fmaxf(m, mx);
        corr = __builtin_amdgcn_exp2f(m - mnew);
        m = mnew;
#pragma unroll
        for (int i = 0; i < 16; ++i) { const float p = sacc[i] > -1e29f ? __builtin_amdgcn_exp2f(sacc[i] - mnew) : 0.f; psum += p; sacc[i] = p; }
    }
    l = l * corr + psum;
    if (__any(corr != 1.f)) {
#pragma unroll
        for (int i = 0; i < 16; ++i) { O[0][i] *= corr; O[1][i] *= corr; }
        if (IMP) {
#pragma unroll
            for (int i = 0; i < 16; ++i) { IM[0][i] *= corr; IM[1][i] *= corr; }
        }
    }
    bf16x8v pf[2];
#pragma unroll
    for (int sx = 0; sx < 2; ++sx) { u32x4 w; w.x = pkbf(sacc[8 * sx], sacc[8 * sx + 1]); w.y = pkbf(sacc[8 * sx + 2], sacc[8 * sx + 3]); w.z = pkbf(sacc[8 * sx + 4], sacc[8 * sx + 5]); w.w = pkbf(sacc[8 * sx + 6], sacc[8 * sx + 7]);
        pf[sx] = __builtin_bit_cast(bf16x8v, w); }
    const unsigned char* vb = buf + 64 * KV_STRIDE + r * KV_STRIDE + (32 * tt + 8 * h) * 2;
#pragma unroll
    for (int dt = 0; dt < 2; ++dt)
#pragma unroll
        for (int sx = 0; sx < 2; ++sx) { const bf16x8v a = *(const bf16x8v*)(vb + dt * 32 * KV_STRIDE + sx * 32); O[dt] = MFMA32(a, pf[sx], O[dt]); }
    if (IMP) {
#pragma unroll
        for (int st = 0; st < 2; ++st)
#pragma unroll
            for (int sx = 0; sx < 2; ++sx) { const bf16x8v a = *(const bf16x8v*)(ovt + (32 * st + r) * 256 + key0 + 16 * sx + 8 * h); IM[st] = MFMA32(a, pf[sx], IM[st]); }
    }
}

template <int MODE>
__device__ __forceinline__ void attn_branch(unsigned char* kvbuf, const bf16* Kg0, const bf16* VTg0, int vts, unsigned long long blkmask, int t, int nv, unsigned long long selm,
                                            int wlo, int whi, int flo, int fhi, const bf16x8v (&qf)[4], f32x16 (&O)[2], f32x16 (&IM)[2], float& l, const bf16* ovt, int tid, int r, int h, int pr) {
    float m = -1e30f;
    l = 0.f;
#pragma unroll
    for (int i = 0; i < 16; ++i) { O[0][i] = 0.f; O[1][i] = 0.f; IM[0][i] = 0.f; IM[1][i] = 0.f; }
    const int srow = tid >> 3, sch = tid & 7;
    int j = __builtin_ctzll(blkmask);
    unsigned long long rest = blkmask & (blkmask - 1);
    u32x4 kr = *(const u32x4*)(Kg0 + (size_t)(64 * j + srow) * 64 + sch * 8);
    u32x4 vr = *(const u32x4*)(VTg0 + (size_t)srow * vts + 64 * j + sch * 8);
    *(u32x4*)(kvbuf + srow * KV_STRIDE + sch * 16) = kr;
    *(u32x4*)(kvbuf + 64 * KV_STRIDE + srow * KV_STRIDE + sch * 16) = vr;
    int cur = 0;
    for (;;) {
        __syncthreads();
        const bool more = rest != 0ull;
        int jn = 0;
        if (more) { jn = __builtin_ctzll(rest); rest &= rest - 1;
            kr = *(const u32x4*)(Kg0 + (size_t)(64 * jn + srow) * 64 + sch * 8);
            vr = *(const u32x4*)(VTg0 + (size_t)srow * vts + 64 * jn + sch * 8); }
        const unsigned char* buf = kvbuf + cur * KV_BUF;
        int lo, hi;
        if (MODE == 0) { lo = 0; hi = nv - 1; }
        else if (MODE == 1) { lo = 0; hi = ((selm >> j) & 1ull) ? t : -1; }
        else { lo = t - 511; hi = t; }
        const bool wave_on = (MODE != 1) || __any(hi >= 0);
#pragma unroll
        for (int tt = 0; tt < 2; ++tt) {
            const int key0 = 64 * j + 32 * tt;
            if (!wave_on || key0 > whi || key0 + 31 < wlo) continue;
            attn_tile<MODE == 0>(key0 >= flo && key0 + 31 <= fhi, buf, tt, key0, lo, hi, qf, O, IM, m, l, ovt, r, h, pr);
        }
        if (!more) break;
        *(u32x4*)(kvbuf + (cur ^ 1) * KV_BUF + srow * KV_STRIDE + sch * 16) = kr;
        *(u32x4*)(kvbuf + (cur ^ 1) * KV_BUF + 64 * KV_STRIDE + srow * KV_STRIDE + sch * 16) = vr;
        cur ^= 1; j = jn;
    }
    __syncthreads();
}

__device__ __forceinline__ void phase_nsa_attn(unsigned char* lds, const bf16* QN, const bf16* KS, const bf16* KW, const bf16* VST, const bf16* VWT, const bf16* KCb, const bf16* VCT,
                                               const bf16* ovt, const float* gates, const f32x2* tab, bf16* hn, int vblk, int nblk, int tid, int wid, int lane) {
    const int r = lane & 31, h = lane >> 5, pr = (r & ~12) | ((r & 4) << 1) | ((r & 8) >> 1);
    float* imp_s = (float*)(lds + ATT_IMP_OFF + wid * 2048);
    unsigned long long* msk_s = (unsigned long long*)(lds + ATT_MSK_OFF);
    unsigned* uni_s = (unsigned*)(lds + ATT_MSK_OFF + 512);
    for (int item = vblk; item < Bn * 4 * 64; item += nblk) {
        const int rnd = item / nblk, wv = item - rnd * nblk;
        const int bh = wv & 31, sub = wv >> 5, per = nblk >> 5;
        int qb = rnd * per + ((rnd & 1) ? (per - 1 - sub) : sub);
        if (nblk != 256) { qb = item >> 5; }
        const int bhh = (nblk != 256) ? (item & 31) : bh;
        const int b = bhh >> 2, hk = bhh & 3;
        const int t0 = qb * 64, tw0 = t0 + 8 * wid, t = tw0 + (r & 7), g = r >> 3;
        const size_t tok = (size_t)b * S + t;
        if (tid == 0) { unsigned z = 0u; asm volatile("" : "+v"(z)); uni_s[0] = z; uni_s[1] = z; }
        bf16x8v qn[4], qr[4];
        {
            const bf16* qp = QN + ((size_t)(b * 16 + hk * 4 + g) * S + t) * 64 + 8 * h;
#pragma unroll
            for (int ks = 0; ks < 4; ++ks) qn[ks] = *(const bf16x8v*)(qp + 16 * ks);
            const f32x2* cp = tab + tok * 32 + 8 * h;
#pragma unroll
            for (int kl = 0; kl < 2; ++kl) {
                u32x4 wlo_, whi_;
                const u32x4 a = __builtin_bit_cast(u32x4, qn[kl]), c = __builtin_bit_cast(u32x4, qn[kl + 2]);
#pragma unroll
                for (int jj = 0; jj < 4; ++jj) {
                    const f32x2 cs0 = cp[16 * kl + 2 * jj], cs1 = cp[16 * kl + 2 * jj + 1];
                    const float x0 = bf2f(a[jj] & 0xffffu), x1 = bf2f(a[jj] >> 16), y0 = bf2f(c[jj] & 0xffffu), y1 = bf2f(c[jj] >> 16);
                    wlo_[jj] = pkbf(x0 * cs0.x - y0 * cs0.y, x1 * cs1.x - y1 * cs1.y);
                    whi_[jj] = pkbf(y0 * cs0.x + x0 * cs0.y, y1 * cs1.x + x1 * cs1.y);
                }
                qr[kl] = __builtin_bit_cast(bf16x8v, wlo_); qr[kl + 2] = __builtin_bit_cast(bf16x8v, whi_);
            }
        }
        const float* gp = gates + tok * 48 + (hk * 4 + g) * 3;
        const float g0 = sigmoidf_(gp[0]), g1 = sigmoidf_(gp[1]), g2 = sigmoidf_(gp[2]);
        f32x16 acc[2], O[2], IM[2];
        float l;
        const int nv = t >= 31 ? ((t - 31) >> 4) + 1 : 0;
        const int nvw = ((tw0 + 7 - 31) >> 4) + 1;
        const int nvmax = 4 * qb + 3;
        {
            const int ncb = (nvmax + 63) >> 6;
            const unsigned long long bm = ncb >= 64 ? ~0ull : ((1ull << ncb) - 1ull);
            attn_branch<0>(lds, KCb + (size_t)bhh * 256 * 64, VCT + (size_t)bhh * 64 * 256, 256, bm, t, nv, 0ull, 0, (tw0 + 7 >= 31 ? nvw - 1 : -1), 0, (tw0 >= 31 ? ((tw0 - 31) >> 4) : -1), qn, O, IM, l, ovt, tid, r, h, pr);
        }
        {
            const float lt = l + xshfl(l, 32), inv = lt > 0.f ? 1.f / lt : 0.f, sc = inv * g0;
#pragma unroll
            for (int i = 0; i < 16; ++i) { acc[0][i] = O[0][i] * sc; acc[1][i] = O[1][i] * sc; }
#pragma unroll
            for (int st = 0; st < 2; ++st)
#pragma unroll
                for (int i = 0; i < 16; ++i) { float v = IM[st][i] * inv; v += xshfl(v, 8); v += xshfl(v, 16);
                    if (r < 8) imp_s[r * 64 + 32 * st + (i & 3) + 8 * (i >> 2) + 4 * h] = v; }
        }
        WAVE_SYNC();
        {
            unsigned long long um = 0ull;
            for (int tk = 0; tk < 8; ++tk) {
                const float imp = imp_s[tk * 64 + lane];
                const bool sv = lane <= qb, forced = (lane == 0) || (lane == qb) || (lane + 1 == qb);
                const float score = sv ? (forced ? 1e9f : imp) : -1.f;
                int rank = 0;
#pragma unroll 4
                for (int i = 0; i < 64; ++i) { const float si = __uint_as_float(__builtin_amdgcn_readlane(__float_as_uint(score), i)); rank += (si > score || (si == score && i < lane)) ? 1 : 0; }
                const unsigned long long mk = __ballot((rank < 16) && (score >= 0.f));
                um |= mk;
                if (lane == 0) msk_s[wid * 8 + tk] = mk;
            }
            if (lane == 0) { atomicOr(&uni_s[0], (unsigned)um); atomicOr(&uni_s[1], (unsigned)(um >> 32)); }
        }
        __syncthreads();
        const unsigned long long selm = msk_s[wid * 8 + (r & 7)];
        const unsigned long long uni = (unsigned long long)uni_s[0] | ((unsigned long long)uni_s[1] << 32);
        attn_branch<1>(lds, KS + (size_t)bhh * S * 64, VST + (size_t)bhh * 64 * S, S, uni, t, 0, selm, 0, tw0 + 7, 0, tw0, qr, O, IM, l, ovt, tid, r, h, pr);
        {
            const float lt = l + xshfl(l, 32), sc = g1 / lt;
#pragma unroll
            for (int i = 0; i < 16; ++i) { acc[0][i] += O[0][i] * sc; acc[1][i] += O[1][i] * sc; }
        }
        {
            const int jlo = qb >= 8 ? qb - 8 : 0;
            const unsigned long long bm = (qb >= 63 ? ~0ull : ((1ull << (qb + 1)) - 1ull)) & ~((1ull << jlo) - 1ull);
            attn_branch<2>(lds, KW + (size_t)bhh * S * 64, VWT + (size_t)bhh * 64 * S, S, bm, t, 0, 0ull, tw0 - 511, tw0 + 7, tw0 + 7 - 511, tw0, qr, O, IM, l, ovt, tid, r, h, pr);
        }
        {
            const float lt = l + xshfl(l, 32), sc = g2 / lt;
            bf16* op = hn + tok * D + (hk * 4 + g) * 64 + 4 * h;
#pragma unroll
            for (int dt = 0; dt < 2; ++dt)
#pragma unroll
                for (int q4 = 0; q4 < 4; ++q4) {
                    u32x2 w; w.x = pkbf(acc[dt][4 * q4] + O[dt][4 * q4] * sc, acc[dt][4 * q4 + 1] + O[dt][4 * q4 + 1] * sc);
                    w.y = pkbf(acc[dt][4 * q4 + 2] + O[dt][4 * q4 + 2] * sc, acc[dt][4 * q4 + 3] + O[dt][4 * q4 + 3] * sc);
                    *(u32x2*)(op + 32 * dt + 8 * q4) = w;
                }
        }
    }
}


#define LAS __attribute__((address_space(3)))
#define XB_TMO      128
#define XB_XCNT(j)  (256  + 64 * (j))
#define XB_XSUB(j)  (1280 + 64 * (j))
#define XB_XGEN(j)  (2304 + 64 * (j))
#define XB_TOP      3328
#define XB_TOPGEN   3392
#define XCD_BAR_WORDS 3456
#define XB_SPIN_CAP (1u << 18)

__device__ __forceinline__ unsigned xb_ld(unsigned* p)              { return __hip_atomic_load(p, __ATOMIC_RELAXED, __HIP_MEMORY_SCOPE_AGENT); }
__device__ __forceinline__ unsigned xb_add(unsigned* p, unsigned v) { return __hip_atomic_fetch_add(p, v, __ATOMIC_RELAXED, __HIP_MEMORY_SCOPE_AGENT); }
__device__ __forceinline__ unsigned xb_xcc_id() { return (unsigned)__builtin_amdgcn_s_getreg((3 << 11) | 20) & 0xFu; }
#define XB_SPIN(cond, bar) do { unsigned _sp = 0; while (cond) { __builtin_amdgcn_s_sleep(1); \
    if ((++_sp & 255u) == 0u) { if (xb_ld(&(bar)[XB_TMO])) break; if (_sp > XB_SPIN_CAP) { atomicAdd(&(bar)[XB_TMO], 1u); break; } } } } while (0)

struct XcdBarrier {
    unsigned* bar; unsigned x;
    volatile LAS unsigned* st;
};

__device__ __forceinline__ XcdBarrier xcd_barrier_post(unsigned* bar, volatile LAS unsigned* st) {
    XcdBarrier b; b.bar = bar; b.x = xb_xcc_id(); b.st = st;
    if (threadIdx.x == 0) (void)xb_add(&bar[XB_XCNT(b.x)], 1u);
    return b;
}
__device__ __forceinline__ void xcd_barrier_complete(unsigned* bar, unsigned x, unsigned& nloc, unsigned& nx) {
    const unsigned G = gridDim.x * gridDim.y * gridDim.z;
    unsigned sum, cnt, mine, sp = 0u;
    for (;;) {
        sum = 0u; cnt = 0u; mine = 0u;
#pragma unroll
        for (unsigned j = 0; j < 16; ++j) { const unsigned c = xb_ld(&bar[XB_XCNT(j)]); sum += c; cnt += (c > 0u) ? 1u : 0u; mine = (j == x) ? c : mine; }
        if (sum == G) break;
        __builtin_amdgcn_s_sleep(1);
        if ((++sp & 255u) == 0u) { if (xb_ld(&bar[XB_TMO])) break; if (sp > XB_SPIN_CAP) { atomicAdd(&bar[XB_TMO], 1u); break; } }
    }
    nloc = mine > 0u ? mine : 1u; nx = cnt > 0u ? cnt : 1u;
}

__device__ __forceinline__ void xcd_barrier(const XcdBarrier& b) {
    asm volatile("s_waitcnt vmcnt(0)" ::: "memory");
    __syncthreads();
    if (threadIdx.x == 0) {
        unsigned* bar = b.bar;
        __builtin_amdgcn_s_waitcnt(0);
        unsigned nloc = b.st[0], nx = b.st[1];
        if (nloc == 0u) { xcd_barrier_complete(bar, b.x, nloc, nx); b.st[0] = nloc; b.st[1] = nx; }
        const unsigned old = xb_add(&bar[XB_XSUB(b.x)], 1u);
        const unsigned gen = old / nloc;
        if (old + 1u == (gen + 1u) * nloc) {
            __builtin_amdgcn_fence(__ATOMIC_RELEASE, "agent");
            asm volatile("s_waitcnt vmcnt(0)" ::: "memory");
            const unsigned og = xb_add(&bar[XB_TOP], 1u);
            const unsigned tg = og / nx;
            if (og + 1u == (tg + 1u) * nx) xb_add(&bar[XB_TOPGEN], 1u);
            else XB_SPIN(xb_ld(&bar[XB_TOPGEN]) == tg, bar);
            __builtin_amdgcn_fence(__ATOMIC_ACQUIRE, "agent");
            xb_add(&bar[XB_XGEN(b.x)], 1u);
            asm volatile("s_waitcnt vmcnt(0)" ::: "memory");
        } else {
            XB_SPIN(xb_ld(&bar[XB_XGEN(b.x)]) == gen, bar);
            __builtin_amdgcn_fence(__ATOMIC_ACQUIRE, "agent");
            asm volatile("s_waitcnt vmcnt(0)" ::: "memory");
        }
    }
    __syncthreads();
}

struct Args { const void* in[24]; float* out; unsigned char* ws; int lo, hi; };

__host__ __device__ constexpr int mixer_inner_phases(int kind) { return kind == 0 ? 4 : (kind == 1 ? 1 : 4); }
__host__ __device__ constexpr int total_phases() { int n = 1; for (int L = 0; L < DEPTH; ++L) n += 4 + 2 + mixer_inner_phases(L % 3); return n; }

__global__ void __launch_bounds__(512, 2) mega(Args args) {
    extern __shared__ __attribute__((aligned(16))) unsigned char lds[];
    cg::grid_group grid = cg::this_grid();
    volatile LAS unsigned* bst = (volatile LAS unsigned*)((LAS unsigned char*)lds + (LDS_BYTES - 64));
    if (threadIdx.x < 2) bst[threadIdx.x] = 0u;
    __syncthreads();
    const XcdBarrier xbar = xcd_barrier_post((unsigned*)args.ws, bst);
    bool again = false;
    for (int ph = args.lo; ph < args.hi; ++ph) {
        int type = 0, s = 0, L = 0;
        if (ph > 0) {
            int p = ph - 1;
            for (L = 0; L < DEPTH; ++L) { const int n = 6 + mixer_inner_phases(L % 3); if (p < n) break; p -= n; }
            const int inner = mixer_inner_phases(L % 3), kind = L % 3;
            if (p < 2) { type = 2 + p; s = 2 * L; }
            else if (p == 2) type = 5;
            else if (p < 3 + inner) { const int q = p - 3; type = kind == 0 ? (q == 0 ? 14 : (q == 1 ? 15 : 4 + q)) : (kind == 1 ? 8 : 9 + q); }
            else if (p == 3 + inner) type = 13;
            else { type = 2 + (p - 4 - inner); s = 2 * L + 1; }
        }
        int tid_ = threadIdx.x; asm volatile("" : "+v"(tid_));
        int G_ = gridDim.x, bx_ = blockIdx.x; asm volatile("" : "+s"(G_), "+s"(bx_));
        const int tid = tid_, lane = tid & 63, wid = __builtin_amdgcn_readfirstlane(tid >> 6);
        const int G = G_, bx = bx_;
        const int vcu = (G % 8 == 0) ? (bx % 8) * (G / 8) + bx / 8 : bx;
        const int gw = vcu * 8 + wid, NGW = G * 8;
        unsigned char* ws = args.ws; asm volatile("" : "+s"(ws));
        PG8_LAS unsigned char* ldsl = (PG8_LAS unsigned char*)lds;
        float* hout = args.out; asm volatile("" : "+s"(hout));
        bf16* HN = (bf16*)(ws + WS_HN);
        bf16* RB = (bf16*)(ws + WS_R);
        f32x2* tab = (f32x2*)(ws + WS_TAB);
        const int kind = L % 3, jj = L / 3;
        bf16* QN = RB + (size_t)T * 2560;
        bf16* KSb = QN + (size_t)T * 1024;
        bf16* KWb = KSb + (size_t)T * 256;
        bf16* KCH = (bf16*)(ws + WS_O32);
        bf16* VCH = KCH + (size_t)T * 256;
        float* Pk = (float*)(ws + WS_O32 + 32 * MiB);
        float* Pv = Pk + (size_t)8192 * 512;
        bf16* KC = (bf16*)(ws + WS_O32 + 64 * MiB);
        bf16* VC = (bf16*)(ws + WS_O32 + 65 * MiB);
        bf16* OVT = (bf16*)(ws + WS_BP + 65536);
        bf16* VST = (bf16*)(ws + WS_O32 + 68 * MiB);
        bf16* VWT = (bf16*)(ws + WS_O32 + 84 * MiB);
        switch (type) {
        case 0: {
            float* scr = (float*)lds + wid * (64 * 33);
            for (int mi = 0; mi < 28; ++mi) {
                const float* W; const float* nw = nullptr; int K, N, Npad, mode = 0; bf16* WT;
                if (mi < 8)       { nw = (const float*)args.in[2] + (size_t)mi * D; W = (const float*)args.in[3] + (size_t)mi * D * 2 * FF; K = D; N = 2 * FF; Npad = N; mode = 1; WT = (bf16*)(ws + WS_WGU) + (size_t)mi * 2 * FF * D; }
                else if (mi < 16) { const int i = mi - 8; W = (const float*)args.in[4] + (size_t)i * FF * D; K = FF; N = D; Npad = N; WT = (bf16*)(ws + WS_WDN) + (size_t)i * D * FF; }
                else if (mi < 18) { const int i = mi - 16; nw = (const float*)args.in[5] + (size_t)(3 * i) * D; W = (const float*)args.in[6] + (size_t)i * D * 4112; K = D; N = 4112; Npad = GDN_NPAD; WT = (bf16*)(ws + WS_WGI) + (size_t)i * GDN_NPAD * D; }
                else if (mi < 20) { const int i = mi - 18; W = (const float*)args.in[11] + (size_t)i * D * D; K = D; N = D; Npad = N; WT = (bf16*)(ws + WS_WGO) + (size_t)i * D * D; }
                else if (mi == 20) { nw = (const float*)args.in[5] + (size_t)1 * D; W = (const float*)args.in[12]; K = D; N = 3072; Npad = N; WT = (bf16*)(ws + WS_WSI); }
                else if (mi == 21) { W = (const float*)args.in[14]; K = D; N = D; Npad = N; WT = (bf16*)(ws + WS_WSO); }
                else if (mi == 22) { nw = (const float*)args.in[5] + (size_t)2 * D; W = (const float*)args.in[15]; K = D; N = 2608; Npad = NSA_NPAD; WT = (bf16*)(ws + WS_WNI); }
                else if (mi == 23) { W = (const float*)args.in[23]; K = D; N = D; Npad = N; WT = (bf16*)(ws + WS_WNO); }
                else { const int i = mi - 24, kd = i >> 1, hf = i & 1;
                    W = (const float*)args.in[19] + (size_t)kd * 2048 * 256 + (size_t)hf * 1024 * 256; K = 1024; N = 256; Npad = 256; WT = (bf16*)(ws + WS_WC1) + (size_t)kd * 512 * 1024 + (size_t)hf * 256 * 1024; }
                xpose_matrix(W, nw, K, N, Npad, WT, mode, scr, gw, NGW, lane);
            }
            {
                float* ss = (float*)(ws + WS_SS);
                const float* xin = (const float*)args.in[0];
                for (int m = gw; m < T; m += NGW) {
                    const f32x4* xr = (const f32x4*)(xin + (size_t)m * D) + lane; u32x2* o8 = (u32x2*)(HN + (size_t)m * D) + lane; float sq = 0.f;
#pragma unroll
                    for (int j = 0; j < 4; ++j) { const f32x4 v = xr[64 * j]; sq += (v.x * v.x + v.y * v.y) + (v.z * v.z + v.w * v.w); u32x2 o; o.x = pkbf(v.x, v.y); o.y = pkbf(v.z, v.w); o8[64 * j] = o; }
                    sq = wave_sum(sq); if (lane < 16) ss[(size_t)m * 16 + lane] = lane == 0 ? sq : 0.f;
                }
            }
            const int* positions = (const int*)args.in[1];
            for (int idx = bx * 512 + tid; idx < T * 32; idx += G * 512) {
                const int tk = idx >> 5, i = idx & 31;
                const float inv = 1.0f / exp2f((float)(2 * i) * (13.287712379549449f / 64.f));
                const float ang = (float)positions[tk] * inv;
                const double rev = (double)ang * 0.15915494309189535;
                const float fr = (float)(rev - rint(rev));
                f32x2 v; v.x = __builtin_amdgcn_cosf(fr); v.y = __builtin_amdgcn_sinf(fr);
                tab[idx] = v;
            }
            for (int idx = bx * 512 + tid; idx < 64 * 256; idx += G * 512) {
                const int sj = idx >> 8, i = idx & 255, q = i >> 2, rem = i & 3;
                OVT[idx] = (bf16)(rem < 3 ? (q == sj ? 0x3F80 : 0) : ((q == sj || q + 1 == sj) ? 0x3F00 : 0));
            }
            if (bx < 2 && tid < 256) {
                const float* pe = (const float*)args.in[18] + (size_t)bx * 2048;
                const float* w1 = (const float*)args.in[19] + (size_t)bx * 2048 * 256 + tid;
                float acc = ((const float*)args.in[20])[bx * 256 + tid];
                for (int k = 0; k < 2048; ++k) acc += pe[k] * w1[(size_t)k * 256];
                ((float*)(ws + WS_BP))[bx * 256 + tid] = acc;
            }
        } break;
        case 2: {
            const bf16* Ah = (s & 1) ? (const bf16*)(ws + WS_R + 192 * MiB) : HN;
            pg8::Gemm g{Ah, (const bf16*)(ws + WS_WGU) + (size_t)s * 2 * FF * D, T, 2 * FF, D}; pg8::StaticOrder SO; SO.init(T, 2 * FF, G, bx);
            float* rtab = (float*)(lds + 131072);
            rstd_table(rtab, (const float*)(ws + WS_SS) + (size_t)s * T * 16, SO, tid);
            pg8::EpiSwiGLU E{RB, rtab};
            pg8::gemm_phase<pg8::EpiSwiGLU, pg8::StaticOrder, true, true>(ldsl, g, SO, E, tid); } break;
        case 3: {
            pg8::Gemm g{RB, (const bf16*)(ws + WS_WDN) + (size_t)s * D * FF, T, D, FF}; pg8::StaticOrder SO; SO.init(T, D, G, bx);
            const int slot = (s & 1) ? (s < 7 ? s + 1 : 12) : 8 + (s >> 1);
            pg8::EpiResid<1> E{s == 0 ? (const float*)args.in[0] : hout, hout, HN, (float*)(ws + WS_SS) + (size_t)slot * T * 16};
            pg8::gemm_phase<pg8::EpiResid<1>, pg8::StaticOrder, true, true>(ldsl, g, SO, E, tid); } break;
        case 5: {
            const bf16* Wt; int Np, ldc, nmain, ldt, nvalid; float* tail;
            if (kind == 0) { Wt = (const bf16*)(ws + WS_WGI) + (size_t)jj * GDN_NPAD * D; Np = GDN_NPAD; ldc = 4096; nmain = 4096; tail = (float*)(ws + WS_AB); ldt = 16; nvalid = 4112; }
            else if (kind == 1) { Wt = (const bf16*)(ws + WS_WSI); Np = 3072; ldc = 3072; nmain = 3072; tail = (float*)(ws + WS_AB); ldt = 16; nvalid = 3072; }
            else { Wt = (const bf16*)(ws + WS_WNI); Np = NSA_NPAD; ldc = 2560; nmain = 2560; tail = (float*)(ws + WS_GT); ldt = 48; nvalid = 2608; }
            pg8::Gemm g{HN, Wt, T, Np, D}; pg8::StaticOrder SO; SO.init(T, Np, G, bx);
            float* rtab = (float*)(lds + 131072);
            rstd_table(rtab, (const float*)(ws + WS_SS) + (size_t)(8 + L) * T * 16, SO, tid);
            pg8::EpiProj E{RB, ldc, nmain, tail, ldt, nvalid, rtab};
            pg8::gemm_phase<pg8::EpiProj, pg8::StaticOrder, true, true>(ldsl, g, SO, E, tid); } break;
        case 14: phase_gdn_halo(RB, (bf16*)(ws + WS_HALO), vcu * 512 + tid, G * 512); break;
        case 15: phase_gdn_prep(lds, RB, (const bf16*)(ws + WS_HALO), (const float*)(ws + WS_AB), (const float*)args.in[7] + (size_t)jj * 4 * 3072, (const float*)args.in[8] + jj * 8, (const float*)args.in[9] + jj * 8,
                                HN, (bf16*)(ws + WS_O32 + 64 * MiB), (float*)(ws + WS_GL), bx, G, tid, wid, lane); break;
        case 6:
#ifndef DIS_SCAN
            phase_gdn_scan2(lds, RB, HN, (const bf16*)(ws + WS_O32 + 64 * MiB), (const float*)(ws + WS_GL), (bf16*)(ws + WS_O32), bx, G, tid, wid, lane);
#endif
            break;
        case 7:
#ifndef DIS_GPOST
            phase_gdn_post((const bf16*)(ws + WS_O32), RB, (const float*)args.in[10] + jj * 128, HN, gw, NGW, lane);
#endif
            break;
        case 8:
#ifndef DIS_SPOST
            phase_sc_post(RB, (const float*)args.in[13], HN, vcu * 512 + tid, G * 512);
#endif
            break;
        case 9:
#ifndef DIS_NPOST
            phase_nsa_post(lds, RB, (const float*)args.in[16], (const float*)args.in[17], tab, QN, KSb, KWb, KCH, VCH, VST, VWT, gw, NGW, wid, lane);
#endif
            break;
        case 10: {
            pg8::Gemm g{KCH, (const bf16*)(ws + WS_WC1), 8192, 512, 1024}; pg8::StaticOrder SO; SO.init(8192, 512, G, bx);
            pg8::Gemm g2{VCH, (const bf16*)(ws + WS_WC1) + (size_t)512 * 1024, 8192, 512, 1024};
            pg8::EpiF32 E{Pk, 512};
            if (bx >= G / 2) { g = g2; SO.init(8192, 512, G, bx - G / 2); E.C = Pv; }
            pg8::gemm_phase<pg8::EpiF32, pg8::StaticOrder, true, true>(ldsl, g, SO, E, tid); } break;
        case 11:
#ifndef DIS_CMP2
            phase_cmp2(lds, Pk, Pv, (const float*)(ws + WS_BP), (const float*)args.in[21], (const float*)args.in[22], (const float*)args.in[17], KC, VC, gw, NGW, wid, lane, tid);
#endif
            break;
        case 12:
#ifndef DIS_ATTN
            phase_nsa_attn(lds, QN, KSb, KWb, VST, VWT, KC, VC, OVT, (const float*)(ws + WS_GT), tab, HN, bx, G, tid, wid, lane);
#endif
            break;
        default: {
            const bf16* Wout = kind == 0 ? (const bf16*)(ws + WS_WGO) + (size_t)jj * D * D : (kind == 1 ? (const bf16*)(ws + WS_WSO) : (const bf16*)(ws + WS_WNO));
            pg8::Gemm g{HN, Wout, T, D, D}; pg8::StaticOrder SO; SO.init(T, D, G, bx);
            pg8::EpiResid<2> E{hout, hout, (bf16*)(ws + WS_R + 192 * MiB), (float*)(ws + WS_SS) + (size_t)(2 * L + 1) * T * 16};
            pg8::gemm_phase<pg8::EpiResid<2>, pg8::StaticOrder, true, true>(ldsl, g, SO, E, tid); } break;
        }
#ifdef REP_TYPE
        if (type == REP_TYPE && !again) { again = true; xcd_barrier(xbar); --ph; continue; }
        again = false;
#endif
        if (ph + 1 < args.hi) { if (ph == 0) grid.sync(); else xcd_barrier(xbar); }
    }
}

extern "C" void kernel_launch(void* const* d_in, const int* in_sizes, int n_in, void* d_out, int out_size, void* d_ws, size_t ws_size, hipStream_t stream) {
    static int grid = 0;
    if (grid == 0) {
        if (n_in != 24 || out_size != T * D || ws_size < WS_END2) { fprintf(stderr, "kernel_launch: unexpected shapes n_in %d out %d ws %zu (need %zu)\n", n_in, out_size, ws_size, (size_t)WS_END2); grid = -1; return; }
        int dev = 0, cus = 0, per_cu = 0;
        hipGetDevice(&dev); hipDeviceGetAttribute(&cus, hipDeviceAttributeMultiprocessorCount, dev);
        if (hipFuncSetAttribute((const void*)mega, hipFuncAttributeMaxDynamicSharedMemorySize, LDS_BYTES) != hipSuccess) { fprintf(stderr, "kernel_launch: hipFuncSetAttribute failed\n"); grid = -1; return; }
        if (hipOccupancyMaxActiveBlocksPerMultiprocessor(&per_cu, (const void*)mega, 512, LDS_BYTES) != hipSuccess || per_cu < 1) { fprintf(stderr, "kernel_launch: occupancy query says %d\n", per_cu); per_cu = 1; }
        (void)hipGetLastError();
        grid = cus;
    }
    if (grid < 0) return;
    Args a{};
    for (int i = 0; i < 24; ++i) a.in[i] = d_in[i];
    a.out = (float*)d_out; a.ws = (unsigned char*)d_ws;
    constexpr int NPH = total_phases();
#if MK_MULTI
    for (int p = 0; p < NPH; ++p) { a.lo = p; a.hi = p + 1; hipLaunchKernelGGL(mega, dim3(grid), dim3(512), LDS_BYTES, stream, a); }
#else
    a.lo = 0; a.hi = NPH;
    (void)hipMemsetAsync(d_ws, 0, 16384, stream);
    void* kargs[] = {&a};
    hipError_t e = hipLaunchCooperativeKernel((const void*)mega, dim3(grid), dim3(512), kargs, LDS_BYTES, stream);
    if (e != hipSuccess) fprintf(stderr, "cooperative launch failed: %s (grid %d)\n", hipGetErrorString(e), grid);
#endif
}
```

```cpp
#include <hip/hip_runtime.h>
#include <hip/hip_cooperative_groups.h>
#include <cstdio>
#include <cstdint>
namespace cg = cooperative_groups;
namespace pg8 {
#define PG8_LAS __attribute__((address_space(3)))
typedef unsigned short bf16_t;
typedef short bf16x8 __attribute__((ext_vector_type(8)));
typedef float f32x4 __attribute__((ext_vector_type(4)));
typedef unsigned u32x4 __attribute__((ext_vector_type(4)));
constexpr int BM = 256, BK = 64, HALF = 128, HTB = HALF * BK * 2  , STAGE_BYTES = 8 * HTB, NXCD = 8, WGM = 8;

__host__ __device__ __forceinline__ int lds_byte(int r, int c) { const int st = (r >> 4) * 2 + (c >> 5), rr = r & 15, cc = c & 31, ob = rr * 64 + cc * 2; return st * 1024 + (ob ^ (((ob >> 9) & 1) << 5)); }
__host__ __device__ __forceinline__ void stage_rc(int b, int& R, int& C) { const int st = b / 1024, sb = b % 1024, swz = sb ^ (((sb >> 9) & 1) << 5); R = (st >> 1) * 16 + swz / 64; C = (st & 1) * 32 + (swz % 64) / 2; }
__host__ __device__ __forceinline__ int perm32(int rho) { const int n = rho >> 4, i = rho & 15; return 8 * (i >> 2) + 4 * n + (i & 3); }

struct Unit { int pm, pn, ord; };
struct Gemm { const bf16_t* A; const bf16_t* Bt; int M, N, K; };

struct StaticOrder {
    int nM, nN, nwg, G, c;
    __host__ __device__ void init(int M, int N, int G_, int c_) { nM = M / BM; nN = N / BM; nwg = nM * nN; G = G_; c = c_; }
    __host__ __device__ bool next(int i, Unit& u) const {
        const long L = (long)i * G + c; if (L >= nwg) return false;
        int wgid = (int)L; { const int q = nwg / NXCD, r = nwg % NXCD, xcd = wgid % NXCD, off = wgid / NXCD; wgid = (xcd < r ? xcd * (q + 1) : r * (q + 1) + (xcd - r) * q) + off; }
        const int nig = WGM * nN, gid = wgid / nig, fm = gid * WGM, gsz = (nM - fm) < WGM ? (nM - fm) : WGM;
        u.pm = fm + ((wgid % nig) % gsz); u.pn = (wgid % nig) / gsz; u.ord = i; return true;
    }
    __device__ __forceinline__ void a_ready(const Unit&) const {}
    __device__ __forceinline__ void done(const Unit&) const {}
};
__device__ __forceinline__ unsigned cvt_pk_bf16(float lo, float hi) { unsigned r; asm volatile("v_cvt_pk_bf16_f32 %0, %1, %2" : "=v"(r) : "v"(lo), "v"(hi)); return r; }
template <class Epi, class Sched, bool ALIGN_EPI = false, bool SP2 = false>
__device__ __forceinline__ void gemm_phase(PG8_LAS unsigned char* lds, const Gemm g, const Sched& S, const Epi& E, const int tid) {
    const int wid = __builtin_amdgcn_readfirstlane(tid >> 6), lane = tid & 63, wr = wid >> 2, wc = wid & 3, fr = lane & 15, fq = lane >> 4;
    const int K = g.K, nt = K / BK;
    unsigned voffA[2], voffB[2];
#pragma unroll
    for (int i = 0; i < 2; ++i) { int R, C; stage_rc(tid * 16 + i * 8192, R, C); const int Rb = Epi::PERM ? ((R & ~31) + perm32(R & 31)) : R;
        voffA[i] = (unsigned)(R * K + C) * 2u; voffB[i] = (unsigned)(Rb * K + C) * 2u; }
    const size_t kstep = (size_t)(BK * 2);
    const size_t hstep = (size_t)HALF * K * 2;
    const size_t tstep = 2 * hstep;
    const unsigned ldsw = (unsigned)wid * 1024u;
    const int aoff = lds_byte(wr * 64 + fr, fq * 8), boff = lds_byte(wc * 32 + fr, fq * 8);
#define PG8_SA(b, h) (((b) * 2 + (h)) * HTB)
#define PG8_SB(b, h) ((4 + (b) * 2 + (h)) * HTB)
#define PG8_STAGE(bufoff, gbase, voff) do { _Pragma("unroll") for (int _i = 0; _i < 2; ++_i) \
        __builtin_amdgcn_global_load_lds((const unsigned*)((const char*)(gbase) + (voff)[_i]), (PG8_LAS unsigned*)(lds + (bufoff) + ldsw + _i * 8192), 16, 0, 0); } while (0)
#define PG8_LDA(dst, b, h) do { _Pragma("unroll") for (int m = 0; m < 4; ++m) _Pragma("unroll") for (int k = 0; k < 2; ++k) dst[m][k] = *(const PG8_LAS bf16x8*)(lds + PG8_SA(b, h) + aoff + m * 2048 + k * 1024); } while (0)
#define PG8_LDB(dst, b, h) do { _Pragma("unroll") for (int n = 0; n < 2; ++n) _Pragma("unroll") for (int k = 0; k < 2; ++k) dst[n][k] = *(const PG8_LAS bf16x8*)(lds + PG8_SB(b, h) + boff + n * 2048 + k * 1024); } while (0)
#define PG8_MMA(ai, bj, At, Bt) do { __builtin_amdgcn_s_setprio(1); _Pragma("unroll") for (int m = 0; m < 4; ++m) _Pragma("unroll") for (int n = 0; n < 2; ++n) _Pragma("unroll") for (int k = 0; k < 2; ++k) \
        acc[ai][bj][m][n] = __builtin_amdgcn_mfma_f32_16x16x32_bf16(Bt[n][k], At[m][k], acc[ai][bj][m][n], 0, 0, 0); __builtin_amdgcn_s_setprio(0); } while (0)
#define PG8_WAIT_V(n) asm volatile("s_waitcnt vmcnt(" #n ")" ::: "memory")
#define PG8_WAIT_L(n) asm volatile("s_waitcnt lgkmcnt(" #n ")" ::: "memory")
#define PG8_BAR __builtin_amdgcn_s_barrier()
#define PG8_SCHED __builtin_amdgcn_sched_barrier(0)
    Unit cur, nxt; int ui = 0;
    if (!S.next(0, cur)) return;
    f32x4 acc[2][2][4][2];
#pragma unroll
    for (int a = 0; a < 2; ++a)
#pragma unroll
        for (int b = 0; b < 2; ++b)
#pragma unroll
            for (int m = 0; m < 4; ++m)
#pragma unroll
                for (int n = 0; n < 2; ++n) acc[a][b][m][n] = (f32x4){0.f, 0.f, 0.f, 0.f};
    bf16x8 At[4][2], B0[2][2], B1[2][2];
    const char* cA = (const char*)g.A + (size_t)cur.pm * tstep; const char* cB = (const char*)g.Bt + (size_t)cur.pn * tstep;
    S.a_ready(cur);
    if constexpr (SP2) {
        PG8_STAGE(PG8_SB(0, 0), cB, voffB); PG8_STAGE(PG8_SB(0, 1), cB + hstep, voffB); PG8_STAGE(PG8_SA(0, 0), cA, voffA); PG8_STAGE(PG8_SA(0, 1), cA + hstep, voffA);
        if (wr == 1) PG8_BAR;
        PG8_WAIT_V(2); PG8_BAR;
        PG8_STAGE(PG8_SB(1, 0), cB + kstep, voffB); PG8_STAGE(PG8_SA(1, 0), cA + kstep, voffA); PG8_STAGE(PG8_SB(1, 1), cB + hstep + kstep, voffB);
        PG8_WAIT_V(6); PG8_BAR;
    } else {
        PG8_STAGE(PG8_SB(0, 0), cB, voffB); PG8_STAGE(PG8_SA(0, 0), cA, voffA); PG8_STAGE(PG8_SB(0, 1), cB + hstep, voffB); PG8_STAGE(PG8_SA(0, 1), cA + hstep, voffA);
        if (wr == 1) PG8_BAR;
        PG8_WAIT_V(4); PG8_BAR;
        PG8_STAGE(PG8_SB(1, 0), cB + kstep, voffB); PG8_STAGE(PG8_SA(1, 0), cA + kstep, voffA); PG8_STAGE(PG8_SB(1, 1), cB + hstep + kstep, voffB);
        PG8_WAIT_V(6); PG8_BAR;
    }
    for (;;) {
        const bool has_next = S.next(ui + 1, nxt);
        const char* nA = has_next ? (const char*)g.A + (size_t)nxt.pm * tstep : cA; const char* nB = has_next ? (const char*)g.Bt + (size_t)nxt.pn * tstep : cB;
        for (int t = 0; t < nt; t += 2) {
            const bool last = (t == nt - 2);
            const char* a1 = cA + (size_t)(t + 1) * kstep;
            const char* a2 = last ? nA : cA + (size_t)(t + 2) * kstep; const char* b2 = last ? nB : cB + (size_t)(t + 2) * kstep;
            const char* a3 = a2 + kstep; const char* b3 = b2 + kstep;
            if (last && has_next) S.a_ready(nxt);
            if constexpr (SP2) {
            PG8_LDB(B0, 0, 0); PG8_LDB(B1, 0, 1); PG8_SCHED; PG8_LDA(At, 0, 0); PG8_STAGE(PG8_SA(1, 1), a1 + hstep, voffA);
            PG8_WAIT_V(8); PG8_WAIT_L(0); PG8_BAR; PG8_MMA(0, 0, At, B0); PG8_MMA(0, 1, At, B1); PG8_BAR; PG8_SCHED;
            PG8_LDA(At, 0, 1); PG8_STAGE(PG8_SB(0, 0), b2, voffB); PG8_STAGE(PG8_SB(0, 1), b2 + hstep, voffB); PG8_STAGE(PG8_SA(0, 0), a2, voffA);
            PG8_WAIT_V(8); PG8_WAIT_L(0); PG8_BAR; PG8_MMA(1, 0, At, B0); PG8_MMA(1, 1, At, B1); PG8_BAR; PG8_SCHED;
            PG8_LDB(B0, 1, 0); PG8_LDB(B1, 1, 1); PG8_SCHED; PG8_LDA(At, 1, 0); PG8_STAGE(PG8_SA(0, 1), a2 + hstep, voffA);
            PG8_WAIT_V(8); PG8_WAIT_L(0); PG8_BAR; PG8_MMA(0, 0, At, B0); PG8_MMA(0, 1, At, B1); PG8_BAR; PG8_SCHED;
            PG8_LDA(At, 1, 1); PG8_STAGE(PG8_SB(1, 0), b3, voffB); PG8_STAGE(PG8_SB(1, 1), b3 + hstep, voffB); PG8_STAGE(PG8_SA(1, 0), a3, voffA);
            PG8_WAIT_V(8); PG8_WAIT_L(0); PG8_BAR; PG8_MMA(1, 0, At, B0); PG8_MMA(1, 1, At, B1); PG8_BAR; PG8_SCHED;
            } else {
            PG8_LDB(B0, 0, 0); PG8_SCHED; PG8_LDA(At, 0, 0); PG8_STAGE(PG8_SA(1, 1), a1 + hstep, voffA);
            PG8_WAIT_L(8); PG8_BAR; PG8_WAIT_L(0); PG8_MMA(0, 0, At, B0); PG8_BAR; PG8_SCHED;
            PG8_LDB(B1, 0, 1); PG8_STAGE(PG8_SB(0, 0), b2, voffB);
            PG8_BAR; PG8_WAIT_L(0); PG8_MMA(0, 1, At, B1); PG8_BAR;
            PG8_LDA(At, 0, 1); PG8_STAGE(PG8_SA(0, 0), a2, voffA);
            PG8_BAR; PG8_WAIT_L(0); PG8_MMA(1, 0, At, B0); PG8_BAR; PG8_SCHED;
            PG8_STAGE(PG8_SB(0, 1), b2 + hstep, voffB);
            PG8_WAIT_V(6); PG8_BAR; PG8_MMA(1, 1, At, B1); PG8_BAR;
            PG8_LDB(B0, 1, 0); PG8_SCHED; PG8_LDA(At, 1, 0); PG8_STAGE(PG8_SA(0, 1), a2 + hstep, voffA);
            PG8_WAIT_L(8); PG8_BAR; PG8_WAIT_L(0); PG8_MMA(0, 0, At, B0); PG8_BAR; PG8_SCHED;
            PG8_LDB(B1, 1, 1); PG8_STAGE(PG8_SB(1, 0), b3, voffB);
            PG8_BAR; PG8_WAIT_L(0); PG8_MMA(0, 1, At, B1); PG8_BAR;
            PG8_LDA(At, 1, 1); PG8_STAGE(PG8_SA(1, 0), a3, voffA);
            PG8_BAR; PG8_WAIT_L(0); PG8_MMA(1, 0, At, B0); PG8_BAR; PG8_SCHED;
            PG8_STAGE(PG8_SB(1, 1), b3 + hstep, voffB);
            PG8_WAIT_V(6); PG8_BAR; PG8_MMA(1, 1, At, B1); PG8_BAR;
            }
        }
        if constexpr (ALIGN_EPI) { if (wr == 0) PG8_BAR; }
        if constexpr (!Epi::AFTER_DRAIN) { E(acc, cur, wr, wc, fr, fq); S.done(cur); }
        if (!has_next) break;
#pragma unroll
        for (int a = 0; a < 2; ++a)
#pragma unroll
            for (int b = 0; b < 2; ++b)
#pragma unroll
                for (int m = 0; m < 4; ++m)
#pragma unroll
                    for (int n = 0; n < 2; ++n) acc[a][b][m][n] = (f32x4){0.f, 0.f, 0.f, 0.f};
        cur = nxt; cA = nA; cB = nB; ++ui;
        if constexpr (ALIGN_EPI) { if (wr == 1) PG8_BAR; }
    }
    PG8_WAIT_V(0);
    if constexpr (!ALIGN_EPI) { if (wr == 0) PG8_BAR; }
    PG8_BAR;
    if constexpr (Epi::AFTER_DRAIN) { E.fused(acc, cur, wr, wc, fr, fq, lds, wid, lane); S.done(cur); }
#undef PG8_SA
#undef PG8_SB
#undef PG8_STAGE
#undef PG8_LDA
#undef PG8_LDB
#undef PG8_MMA
#undef PG8_WAIT_V
#undef PG8_WAIT_L
#undef PG8_BAR
#undef PG8_SCHED
}
}

typedef unsigned short bf16;
typedef float f32x4 __attribute__((ext_vector_type(4)));
typedef float f32x2 __attribute__((ext_vector_type(2)));
typedef unsigned u32x4 __attribute__((ext_vector_type(4)));
typedef unsigned u32x2 __attribute__((ext_vector_type(2)));

#ifndef MK_MULTI
#define MK_MULTI 0
#endif

constexpr int Bn = 8, S = 4096, T = Bn * S, D = 1024, FF = 2816, DEPTH = 4;
constexpr float EPS = 1e-6f;
constexpr int GDN_NPAD = 4352, NSA_NPAD = 2816;
constexpr int LDS_BYTES = 147456;
constexpr size_t MiB = 1u << 20;
constexpr size_t WS_WGU = 1 * MiB;
constexpr size_t WS_WDN = WS_WGU + 88 * MiB;
constexpr size_t WS_WGI = WS_WDN + 44 * MiB;
constexpr size_t WS_WGO = WS_WGI + 17 * MiB;
constexpr size_t WS_WSI = WS_WGO + 4 * MiB;
constexpr size_t WS_WSO = WS_WSI + 6 * MiB;
constexpr size_t WS_WNI = WS_WSO + 2 * MiB;
constexpr size_t WS_WNO = WS_WNI + 6 * MiB;
constexpr size_t WS_WC1 = WS_WNO + 2 * MiB;
constexpr size_t WS_TAB = WS_WC1 + 2 * MiB;
constexpr size_t WS_HN  = 184 * MiB;
constexpr size_t WS_R   = WS_HN + 64 * MiB;
constexpr size_t WS_O32 = WS_R + 256 * MiB;
constexpr size_t WS_SM  = WS_O32 + 128 * MiB;
constexpr size_t WS_AB  = WS_SM;
constexpr size_t WS_GT  = WS_SM + 2 * MiB;
constexpr size_t WS_BP  = WS_SM + 8 * MiB;
constexpr size_t WS_END = WS_SM + 9 * MiB;
static_assert(WS_TAB + 8 * MiB <= WS_HN, "ws map");

__device__ __forceinline__ float bf2f(unsigned v) { return __uint_as_float(v << 16); }
__device__ __forceinline__ unsigned f2bf(float f) { unsigned u = __float_as_uint(f); return (u + 0x7fffu + ((u >> 16) & 1u)) >> 16; }
__device__ __forceinline__ unsigned pk2(float lo, float hi) { return f2bf(lo) | (f2bf(hi) << 16); }
#define MFMA32(a, b, c) __builtin_amdgcn_mfma_f32_32x32x16_bf16((a), (b), (c), 0, 0, 0)
typedef short bf16x8v __attribute__((ext_vector_type(8)));
typedef float f32x16 __attribute__((ext_vector_type(16)));
typedef __bf16 bf16v2 __attribute__((ext_vector_type(2)));
__device__ __forceinline__ unsigned pkbf(float a, float b) { f32x2 v = {a, b}; return __builtin_bit_cast(unsigned, __builtin_convertvector(v, bf16v2)); }
__device__ __forceinline__ int lane_opq() { int l = (int)__builtin_amdgcn_mbcnt_hi(~0u, __builtin_amdgcn_mbcnt_lo(~0u, 0u)); asm volatile("" : "+v"(l)); return l; }
__device__ __forceinline__ float xshfl(float v, int m) { return __int_as_float(__builtin_amdgcn_ds_bpermute((lane_opq() ^ m) << 2, __float_as_int(v))); }
__device__ __forceinline__ float xshfl_up(float v, int o) { return __int_as_float(__builtin_amdgcn_ds_bpermute((lane_opq() - o) << 2, __float_as_int(v))); }
__device__ __forceinline__ float wave_sum(float v) {
#pragma unroll
    for (int o = 1; o < 64; o <<= 1) v += xshfl(v, o);
    return v;
}
__device__ __forceinline__ float wave_max(float v) {
#pragma unroll
    for (int o = 1; o < 64; o <<= 1) v = fmaxf(v, xshfl(v, o));
    return v;
}
__device__ __forceinline__ float row_sum16(float v) {
    v += __uint_as_float((unsigned)__builtin_amdgcn_update_dpp(0, (int)__float_as_uint(v), 0x128, 0xf, 0xf, false));
    v += __uint_as_float((unsigned)__builtin_amdgcn_update_dpp(0, (int)__float_as_uint(v), 0x124, 0xf, 0xf, false));
    v += __uint_as_float((unsigned)__builtin_amdgcn_update_dpp(0, (int)__float_as_uint(v), 0x122, 0xf, 0xf, false));
    v += __uint_as_float((unsigned)__builtin_amdgcn_update_dpp(0, (int)__float_as_uint(v), 0x121, 0xf, 0xf, false));
    return v;
}
__device__ __forceinline__ float sigmoidf_(float x) { return 1.f / (1.f + __expf(-x)); }
__device__ __forceinline__ float siluf_(float x) { return x * __builtin_amdgcn_rcpf(1.f + __expf(-x)); }
#define WAVE_SYNC() do { asm volatile("s_waitcnt lgkmcnt(0)" ::: "memory"); __builtin_amdgcn_wave_barrier(); } while (0)

__device__ __forceinline__ float row_rstd(const float* ssq, size_t row) {
    const f32x4* p = (const f32x4*)(ssq + row * 16); const f32x4 a = p[0], b = p[1], c = p[2], d = p[3];
    const float t = ((a.x + a.y) + (a.z + a.w)) + ((b.x + b.y) + (b.z + b.w)) + ((c.x + c.y) + (c.z + c.w)) + ((d.x + d.y) + (d.z + d.w));
    return 1.f / sqrtf(t * (1.f / D) + EPS);
}
namespace pg8 {
struct EpiSwiGLU {
    static constexpr bool PERM = true, AFTER_DRAIN = false;
    bf16_t* O; const float* ssq;
    __device__ __forceinline__ void operator()(const f32x4 (&acc)[2][2][4][2], const Unit& u, int wr, int wc, int fr, int fq) const {
        const int row0 = u.pm * BM + wr * 64 + fr, col0 = u.pn * HALF + wc * 32 + 8 * fq;
#pragma unroll
        for (int ai = 0; ai < 2; ++ai)
#pragma unroll
            for (int m = 0; m < 4; ++m) {
                bf16_t* rowp = O + (size_t)(row0 + ai * HALF + m * 16) * FF + col0;
                const float rs = ssq[u.ord * 256 + wr * 64 + fr + ai * HALF + m * 16];
                float v[8];
#pragma unroll
                for (int n = 0; n < 2; ++n)
#pragma unroll
                    for (int j = 0; j < 4; ++j) { const float g = acc[ai][0][m][n][j] * rs, uu = acc[ai][1][m][n][j] * rs; v[n * 4 + j] = g * __builtin_amdgcn_rcpf(1.f + __expf(-g)) * uu; }
                u32x4 w; w.x = cvt_pk_bf16(v[0], v[1]); w.y = cvt_pk_bf16(v[2], v[3]); w.z = cvt_pk_bf16(v[4], v[5]); w.w = cvt_pk_bf16(v[6], v[7]);
                *(u32x4*)rowp = w;
            }
    }
};
template <int SC2> struct EpiResid {
    static constexpr bool PERM = true, AFTER_DRAIN = false;
    const float* base; float* out; bf16_t* HB; float* ssq;
    __device__ __forceinline__ void operator()(const f32x4 (&acc)[2][2][4][2], const Unit& u, int wr, int wc, int fr, int fq) const {
        constexpr float scale = 0.5f * SC2;
        const int row0 = u.pm * BM + wr * 64 + fr, col0 = u.pn * BM + wc * 32 + 8 * fq;
#pragma unroll
        for (int ai = 0; ai < 2; ++ai)
#pragma unroll
            for (int m = 0; m < 4; ++m) {
                const size_t off = (size_t)(row0 + ai * HALF + m * 16) * D + col0;
                float sq = 0.f;
#pragma unroll
                for (int bj = 0; bj < 2; ++bj) {
                    const f32x4 b0 = *(const f32x4*)(base + off + bj * HALF), b1 = *(const f32x4*)(base + off + bj * HALF + 4);
                    const f32x4 o0 = b0 + acc[ai][bj][m][0] * scale, o1 = b1 + acc[ai][bj][m][1] * scale;
                    *(f32x4*)(out + off + bj * HALF) = o0; *(f32x4*)(out + off + bj * HALF + 4) = o1;
                    { u32x4 w; w.x = cvt_pk_bf16(o0[0], o0[1]); w.y = cvt_pk_bf16(o0[2], o0[3]); w.z = cvt_pk_bf16(o1[0], o1[1]); w.w = cvt_pk_bf16(o1[2], o1[3]);
                        *(u32x4*)(HB + off + bj * HALF) = w;
                        sq += ((o0[0] * o0[0] + o0[1] * o0[1]) + (o0[2] * o0[2] + o0[3] * o0[3])) + ((o1[0] * o1[0] + o1[1] * o1[1]) + (o1[2] * o1[2] + o1[3] * o1[3])); }
                }
                { sq += xshfl(sq, 16); sq += xshfl(sq, 32); if (fq == 0) ssq[(size_t)(row0 + ai * HALF + m * 16) * 16 + u.pn * 4 + wc] = sq; }
                if (m == 3) asm volatile("" ::: "memory");
            }
    }
};
struct EpiProj {
    static constexpr bool PERM = true, AFTER_DRAIN = false;
    bf16_t* O; int ldc; int nmain; float* tail; int ldt; int nvalid; const float* ssq;
    __device__ __forceinline__ void operator()(const f32x4 (&acc)[2][2][4][2], const Unit& u, int wr, int wc, int fr, int fq) const {
        const int row0 = u.pm * BM + wr * 64 + fr, colt = u.pn * BM, col0 = colt + wc * 32 + 8 * fq;
        if (colt + BM <= nmain) {
#pragma unroll
            for (int ai = 0; ai < 2; ++ai)
#pragma unroll
                for (int m = 0; m < 4; ++m) {
                    bf16_t* rowp = O + (size_t)(row0 + ai * HALF + m * 16) * ldc + col0;
                    const float rs = ssq[u.ord * 256 + wr * 64 + fr + ai * HALF + m * 16];
#pragma unroll
                    for (int bj = 0; bj < 2; ++bj) { const f32x4 v0 = acc[ai][bj][m][0] * rs, v1 = acc[ai][bj][m][1] * rs;
                        u32x4 w; w.x = cvt_pk_bf16(v0[0], v0[1]); w.y = cvt_pk_bf16(v0[2], v0[3]); w.z = cvt_pk_bf16(v1[0], v1[1]); w.w = cvt_pk_bf16(v1[2], v1[3]);
                        *(u32x4*)(rowp + bj * HALF) = w; }
                }
        } else {
#pragma unroll
            for (int ai = 0; ai < 2; ++ai)
#pragma unroll
                for (int m = 0; m < 4; ++m) {
                    const size_t row = (size_t)(row0 + ai * HALF + m * 16);
                    const float rs = ssq[u.ord * 256 + wr * 64 + fr + ai * HALF + m * 16];
#pragma unroll
                    for (int bj = 0; bj < 2; ++bj)
#pragma unroll
                        for (int n = 0; n < 2; ++n)
#pragma unroll
                            for (int j = 0; j < 4; ++j) { const int col = col0 + bj * HALF + 4 * n + j; if (col >= nmain && col < nvalid) tail[row * ldt + (col - nmain)] = acc[ai][bj][m][n][j] * rs; }
                }
        }
    }
};
struct EpiF32 {
    static constexpr bool PERM = false, AFTER_DRAIN = false;
    float* C; int ldc;
    __device__ __forceinline__ void operator()(const f32x4 (&acc)[2][2][4][2], const Unit& u, int wr, int wc, int fr, int fq) const {
        const int row0 = u.pm * BM + wr * 64 + fr, col0 = u.pn * BM + wc * 32 + 4 * fq;
#pragma unroll
        for (int ai = 0; ai < 2; ++ai)
#pragma unroll
            for (int m = 0; m < 4; ++m) {
                float* rowp = C + (size_t)(row0 + ai * HALF + m * 16) * ldc + col0;
#pragma unroll
                for (int bj = 0; bj < 2; ++bj)
#pragma unroll
                    for (int n = 0; n < 2; ++n) *(f32x4*)(rowp + bj * HALF + n * 16) = acc[ai][bj][m][n];
            }
    }
};
}

template <class Sched>
__device__ __forceinline__ void rstd_table(float* tab, const float* ssq, const Sched& SO, int tid) {
    pg8::Unit u;
    int nu = 0; while (SO.next(nu, u)) ++nu;
    for (int k0 = 0; k0 < nu * 256; k0 += 512 * 3) {
        float t3[3];
#pragma unroll
        for (int k = 0; k < 3; ++k) { const int idx = k0 + 512 * k + tid; t3[k] = 0.f; if (idx < nu * 256) { SO.next(idx >> 8, u); t3[k] = row_rstd(ssq, (size_t)u.pm * 256 + (idx & 255)); } }
#pragma unroll
        for (int k = 0; k < 3; ++k) { const int idx = k0 + 512 * k + tid; if (idx < nu * 256) tab[idx] = t3[k]; }
    }
    __syncthreads();
}
__device__ __forceinline__ void xpose_item(const float* W, const float* nw, int K, int N, bf16* WT, int rowbase, float* scr, int k0, int n0, int lane) {
    if (n0 + 32 <= N && (N & 3) == 0) {
        f32x4 v[8];
#pragma unroll
        for (int i = 0; i < 8; ++i) { v[i] = *(const f32x4*)(W + (size_t)(k0 + 8 * i + (lane >> 3)) * N + n0 + 4 * (lane & 7)); if (nw) v[i] *= nw[k0 + 8 * i + (lane >> 3)]; }
#pragma unroll
        for (int i = 0; i < 8; ++i) { float* d = scr + (8 * i + (lane >> 3)) * 33 + 4 * (lane & 7); d[0] = v[i].x; d[1] = v[i].y; d[2] = v[i].z; d[3] = v[i].w; }
    } else {
#pragma unroll 8
        for (int i = 0; i < 32; ++i) { const int kk = 2 * i + (lane >> 5), n = n0 + (lane & 31); scr[kk * 33 + (lane & 31)] = n < N ? W[(size_t)(k0 + kk) * N + n] * (nw ? nw[k0 + kk] : 1.f) : 0.f; }
    }
    WAVE_SYNC();
    const int c = lane & 7;
#pragma unroll
    for (int j = 0; j < 4; ++j) { const int n = (lane >> 3) + 8 * j; const float* s = scr + (8 * c) * 33 + n;
        u32x4 o; o.x = pk2(s[0 * 33], s[1 * 33]); o.y = pk2(s[2 * 33], s[3 * 33]); o.z = pk2(s[4 * 33], s[5 * 33]); o.w = pk2(s[6 * 33], s[7 * 33]);
        *(u32x4*)(WT + (size_t)(rowbase + n) * K + k0 + 8 * c) = o; }
    WAVE_SYNC();
}
__device__ __forceinline__ void xpose_matrix(const float* W, const float* nw, int K, int N, int Npad, bf16* WT, int mode, float* scr, int gw, int NGW, int lane) {
    const int nblk = Npad / 32, nitems = (K / 64) * nblk;
    for (int it = gw; it < nitems; it += NGW) {
        const int kb = it / nblk, nb = it - kb * nblk, n0 = nb * 32;
        int rb = n0;
        if (mode == 1) rb = (n0 < FF) ? ((n0 >> 7) * 256 + (n0 & 127)) : ((((n0 - FF) >> 7) * 256) + 128 + ((n0 - FF) & 127));
        xpose_item(W, nw, K, N, WT, rb, scr, kb * 64, n0, lane);
    }
}

__device__ __forceinline__ void phase_norm(const float* h, const float* w, bf16* out, int gw, int NGW, int lane) {
    f32x4 wv[4];
#pragma unroll
    for (int j = 0; j < 4; ++j) wv[j] = ((const f32x4*)w)[64 * j + lane];
    for (int m = gw; m < T; m += NGW) {
        const f32x4* xr = (const f32x4*)(h + (size_t)m * D) + lane;
        f32x4 v[4]; float s = 0.f;
#pragma unroll
        for (int j = 0; j < 4; ++j) { v[j] = xr[64 * j]; s += (v[j].x * v[j].x + v[j].y * v[j].y) + (v[j].z * v[j].z + v[j].w * v[j].w); }
        const float rstd = 1.f / sqrtf(wave_sum(s) * (1.f / D) + EPS);
        u32x2* o8 = (u32x2*)(out + (size_t)m * D) + lane;
#pragma unroll
        for (int j = 0; j < 4; ++j) { u32x2 o; o.x = pk2(v[j].x * rstd * wv[j].x, v[j].y * rstd * wv[j].y); o.y = pk2(v[j].z * rstd * wv[j].z, v[j].w * rstd * wv[j].w); o8[64 * j] = o; }
    }
}

__device__ __forceinline__ void phase_gdn_scan(unsigned char* lds, const bf16* proj, const float* ab, const float* convw, const float* A_log, const float* dt_bias,
                                               float* o32, int vblk, int nblk, int tid, int wid, int lane) {
    float* qs = (float*)lds;
    float* ks = qs + 64 * 128;
    float* vs = ks + 64 * 128;
    float* al = vs + 64 * 32;
    float* be = al + 64;
    float* qk = be + 64;
    float* os = qk + 64;
    bf16* raw = (bf16*)(os + 64 * 32);
    const int e = tid >> 4, dl = tid & 15;
    for (int item = vblk; item < 256; item += nblk) {
        const int bh = (item & 7) + 8 * (item >> 5), es = (item >> 3) & 3, b = bh >> 3, h = bh & 7;
        const float Ah = __expf(A_log[h]), dtb = dt_bias[h];
        const int isk = (tid >> 4) & 1, cg = tid & 15, cv = tid & 3;
        const int colqk = isk * 1024 + h * 128 + cg * 8, colv = 2048 + h * 128 + es * 32 + cv * 8;
        f32x4 wq[4][2], wv[4][2];
#pragma unroll
        for (int j = 0; j < 4; ++j) { wq[j][0] = *(const f32x4*)(convw + j * 3072 + colqk); wq[j][1] = *(const f32x4*)(convw + j * 3072 + colqk + 4);
                                      wv[j][0] = *(const f32x4*)(convw + j * 3072 + colv);  wv[j][1] = *(const f32x4*)(convw + j * 3072 + colv + 4); }
        f32x2 S2[4];
#pragma unroll
        for (int i = 0; i < 4; ++i) S2[i] = (f32x2){0.f, 0.f};
        u32x4 pre[5];
#define GDN_PREFETCH(T0) do { _Pragma("unroll") for (int k_ = 0; k_ < 5; ++k_) { const int idx_ = tid + 512 * k_; const int row_ = idx_ / 36, c_ = idx_ - row_ * 36; const int ts_ = (T0) - 3 + row_; \
            const int col_ = c_ < 16 ? h * 128 + c_ * 8 : (c_ < 32 ? 1024 + h * 128 + (c_ - 16) * 8 : 2048 + h * 128 + es * 32 + (c_ - 32) * 8); \
            pre[k_] = (u32x4){0u, 0u, 0u, 0u}; if (idx_ < 67 * 36 && ts_ >= 0) pre[k_] = *(const u32x4*)(proj + (size_t)(b * S + ts_) * 4096 + col_); } } while (0)
#define GDN_PARK() do { _Pragma("unroll") for (int k_ = 0; k_ < 5; ++k_) { const int idx_ = tid + 512 * k_; if (idx_ < 67 * 36) *(u32x4*)(raw + idx_ * 8) = pre[k_]; } } while (0)
#define GDN_CONV8(ROW0, C8, W, OUT) do { _Pragma("unroll") for (int i_ = 0; i_ < 8; ++i_) OUT[i_] = 0.f; _Pragma("unroll") for (int j_ = 0; j_ < 4; ++j_) { const u32x4 xv_ = *(const u32x4*)(raw + ((ROW0) + j_) * 288 + (C8) * 8); \
            OUT[0] += bf2f(xv_.x & 0xffffu) * W[j_][0].x; OUT[1] += bf2f(xv_.x >> 16) * W[j_][0].y; OUT[2] += bf2f(xv_.y & 0xffffu) * W[j_][0].z; OUT[3] += bf2f(xv_.y >> 16) * W[j_][0].w; \
            OUT[4] += bf2f(xv_.z & 0xffffu) * W[j_][1].x; OUT[5] += bf2f(xv_.z >> 16) * W[j_][1].y; OUT[6] += bf2f(xv_.w & 0xffffu) * W[j_][1].z; OUT[7] += bf2f(xv_.w >> 16) * W[j_][1].w; } \
            _Pragma("unroll") for (int i_ = 0; i_ < 8; ++i_) OUT[i_] = siluf_(OUT[i_]); } while (0)
#define GDN_CONVNORM(T0) do { \
            _Pragma("unroll") for (int it_ = 0; it_ < 4; ++it_) { const int tok_ = it_ * 16 + (tid >> 5); float y_[8]; GDN_CONV8(tok_, isk * 16 + cg, wq, y_); \
                float ss_ = (y_[0] * y_[0] + y_[1] * y_[1]) + (y_[2] * y_[2] + y_[3] * y_[3]) + (y_[4] * y_[4] + y_[5] * y_[5]) + (y_[6] * y_[6] + y_[7] * y_[7]); \
                ss_ = row_sum16(ss_); const float sc_ = (1.f / sqrtf(ss_ + EPS)) * (isk ? 1.f : 0.08838834764831845f); \
                float* d_ = (isk ? ks : qs) + tok_ * 128 + cg * 8; \
                _Pragma("unroll") for (int i_ = 0; i_ < 8; ++i_) y_[i_] *= sc_; \
                *(f32x4*)d_ = (f32x4){y_[0], y_[1], y_[2], y_[3]}; *(f32x4*)(d_ + 4) = (f32x4){y_[4], y_[5], y_[6], y_[7]}; \
                float dq_ = 0.f; _Pragma("unroll") for (int i_ = 0; i_ < 8; ++i_) dq_ += y_[i_] * xshfl(y_[i_], 16); \
                dq_ = row_sum16(dq_); if (isk == 0 && cg == 0) qk[tok_] = dq_; } \
            if (tid < 256) { const int tok_ = tid >> 2; float y_[8]; GDN_CONV8(tok_, 32 + cv, wv, y_); float* d_ = vs + tok_ * 32 + cv * 8; \
                *(f32x4*)d_ = (f32x4){y_[0], y_[1], y_[2], y_[3]}; *(f32x4*)(d_ + 4) = (f32x4){y_[4], y_[5], y_[6], y_[7]}; } \
            if (tid < 64) { const size_t tg_ = (size_t)(b * S + (T0) + tid); const float a_ = ab[tg_ * 16 + h] + dtb, bb_ = ab[tg_ * 16 + 8 + h]; \
                const float sp_ = a_ > 20.f ? a_ : __logf(1.f + __expf(a_)); al[tid] = __expf(-Ah * sp_); be[tid] = sigmoidf_(bb_); } } while (0)
        __syncthreads();
        GDN_PREFETCH(0); GDN_PARK();
        __syncthreads();
        GDN_CONVNORM(0);
        __syncthreads();
        for (int chunk = 0; chunk < S / 64; ++chunk) {
            const int t0 = chunk * 64;
            const bool more = chunk + 1 < S / 64;
            if (more) GDN_PREFETCH(t0 + 64);
            {
                const float* kp = ks + dl * 8; const float* qp = qs + dl * 8; const float* vp = vs + e;
                f32x4 nk0 = *(const f32x4*)kp, nk1 = *(const f32x4*)(kp + 4), nq0 = *(const f32x4*)qp, nq1 = *(const f32x4*)(qp + 4);
                float nv = vp[0], na = al[0], nb = be[0], nqk = qk[0];
                for (int t16 = 0; t16 < 4; ++t16) {
                    float ok = 0.f;
#pragma unroll 4
                    for (int i = 0; i < 16; ++i) {
                        const int tt = t16 * 16 + i, tn = (tt + 1) & 63;
                        const f32x2 K0 = {nk0.x, nk0.y}, K1 = {nk0.z, nk0.w}, K2 = {nk1.x, nk1.y}, K3 = {nk1.z, nk1.w};
                        const f32x2 Q0 = {nq0.x, nq0.y}, Q1 = {nq0.z, nq0.w}, Q2 = {nq1.x, nq1.y}, Q3 = {nq1.z, nq1.w};
                        const float v = nv, a = na, bt = nb, qkt = nqk;
                        nk0 = *(const f32x4*)(kp + tn * 128); nk1 = *(const f32x4*)(kp + tn * 128 + 4); nq0 = *(const f32x4*)(qp + tn * 128); nq1 = *(const f32x4*)(qp + tn * 128 + 4);
                        nv = vp[tn * 32]; na = al[tn]; nb = be[tn]; nqk = qk[tn];
                        f32x2 pa = K0 * S2[0], pb = K2 * S2[2], qa = Q0 * S2[0], qb = Q2 * S2[2];
                        pa = K1 * S2[1] + pa; pb = K3 * S2[3] + pb; qa = Q1 * S2[1] + qa; qb = Q3 * S2[3] + qb;
                        pa += pb; qa += qb;
                        float p = pa.x + pa.y, qS = qa.x + qa.y;
                        p = row_sum16(p); qS = row_sum16(qS);
                        const float vn = bt * (v - a * p);
                        const float o = a * qS + qkt * vn;
                        const f32x2 vn2 = {vn, vn}, a2 = {a, a};
                        S2[0] = S2[0] * a2 + K0 * vn2; S2[1] = S2[1] * a2 + K1 * vn2; S2[2] = S2[2] * a2 + K2 * vn2; S2[3] = S2[3] * a2 + K3 * vn2;
                        ok = (i == dl) ? o : ok;
                    }
                    os[(t16 * 16 + dl) * 32 + e] = ok;
                }
            }
            __syncthreads();
            { const int tok = tid >> 3, c4 = tid & 7;
              *(f32x4*)(o32 + (size_t)(b * S + t0 + tok) * D + h * 128 + es * 32 + c4 * 4) = *(const f32x4*)(os + tok * 32 + c4 * 4); }
            if (more) {
                GDN_PARK();
                __syncthreads();
                GDN_CONVNORM(t0 + 64);
            }
            __syncthreads();
        }
#undef GDN_PREFETCH
#undef GDN_PARK
#undef GDN_CONV8
#undef GDN_CONVNORM
    }
}

constexpr size_t WS_HALO = WS_END;
constexpr size_t WS_GL = WS_END + 10 * MiB;
constexpr size_t WS_SS = WS_GL + 1 * MiB;
constexpr size_t WS_END2 = WS_SS + 26 * MiB;

__device__ __forceinline__ void phase_gdn_halo(const bf16* proj, bf16* halo, int gtid, int NT) {
    for (int idx = gtid; idx < Bn * 64 * 3 * 384; idx += NT) {
        const int c = idx % 384, r3 = (idx / 384) % 3, bn = idx / (384 * 3), n = bn & 63, b = bn >> 6;
        u32x4 v = {0u, 0u, 0u, 0u};
        if (n > 0) v = *(const u32x4*)(proj + (size_t)(b * S + 64 * n - 3 + r3) * 4096 + c * 8);
        *(u32x4*)(halo + (size_t)(bn * 3 + r3) * 3072 + c * 8) = v;
    }
}

constexpr int GP_RAW = 0, GP_QB = 51456, GP_KB = GP_QB + 17408, GP_VB = GP_KB + 17408, GP_AM = GP_VB + 16384, GP_GC = GP_AM + 17408, GP_W = GP_GC + 1024;
__device__ __forceinline__ void phase_gdn_prep(unsigned char* lds, bf16* proj, const bf16* halo, const float* ab, const float* convw, const float* A_log, const float* dt_bias,
                                               bf16* KT, bf16* AT, float* GL, int vblk, int nblk, int tid, int wid, int lane) {
    bf16* raw = (bf16*)(lds + GP_RAW);
    bf16* wimg = (bf16*)(lds + GP_W);
    unsigned char* qb = lds + GP_QB;
    unsigned char* kb = lds + GP_KB;
    bf16* vb = (bf16*)(lds + GP_VB);
    float* Am = (float*)(lds + GP_AM);
    float* gcs = (float*)(lds + GP_GC);
    float* bes = gcs + 64;
    const int r = lane & 31, hh = lane >> 5;
    for (int item = vblk; item < Bn * 8 * 64; item += nblk) {
        const int n = item & 63, h = (item >> 6) & 7, b = item >> 9;
        const size_t tok0 = (size_t)b * S + 64 * n;
        __syncthreads();
#define GP_RAWLOAD(ITEM, T0, NT) do { const int n_ = (ITEM) & 63, h_ = ((ITEM) >> 6) & 7, b_ = (ITEM) >> 9; const size_t tk0_ = (size_t)b_ * S + 64 * n_; \
        for (int idx = (T0); idx < 67 * 48; idx += (NT)) { const int row = idx / 48, c = idx - row * 48; \
            const int col = c < 16 ? h_ * 128 + c * 8 : (c < 32 ? 1024 + h_ * 128 + (c - 16) * 8 : 2048 + h_ * 128 + (c - 32) * 8); \
            u32x4 v; if (row < 3) v = *(const u32x4*)(halo + (size_t)((b_ * 64 + n_) * 3 + row) * 3072 + col); else v = *(const u32x4*)(proj + (tk0_ + row - 3) * 4096 + col); \
            *(u32x4*)(raw + row * 384 + c * 8) = v; } } while (0)
        if (item == vblk) GP_RAWLOAD(item, tid, 512);
        if (tid < 64) {
            const float a = ab[(tok0 + tid) * 16 + h] + dt_bias[h], bb = ab[(tok0 + tid) * 16 + 8 + h];
            const float sp = a > 20.f ? a : __logf(1.f + __expf(a));
            float g = -__expf(A_log[h]) * sp;
#pragma unroll
            for (int o = 1; o < 64; o <<= 1) { const float t_ = xshfl_up(g, o); if (lane >= o) g += t_; }
            const float be_ = sigmoidf_(bb);
            gcs[tid] = g; bes[tid] = be_; gcs[128 + tid] = be_; gcs[192 + tid] = be_ * __expf(g);
        }
        __syncthreads();
        {
            const int isk = (tid >> 4) & 1, cg = tid & 15;
            const int colqk = isk * 1024 + h * 128 + cg * 8, colv = 2048 + h * 128 + cg * 8;
#define GP_CONV8(ROW0, C8, COL, OUT) do { _Pragma("unroll") for (int i_ = 0; i_ < 8; ++i_) OUT[i_] = 0.f; _Pragma("unroll") for (int j_ = 0; j_ < 4; ++j_) { const u32x4 xv_ = *(const u32x4*)(raw + ((ROW0) + j_) * 384 + (C8) * 8); \
            const f32x4 w0_ = *(const f32x4*)(convw + j_ * 3072 + (COL)), w1_ = *(const f32x4*)(convw + j_ * 3072 + (COL) + 4); \
            OUT[0] += bf2f(xv_.x & 0xffffu) * w0_.x; OUT[1] += bf2f(xv_.x >> 16) * w0_.y; OUT[2] += bf2f(xv_.y & 0xffffu) * w0_.z; OUT[3] += bf2f(xv_.y >> 16) * w0_.w; \
            OUT[4] += bf2f(xv_.z & 0xffffu) * w1_.x; OUT[5] += bf2f(xv_.z >> 16) * w1_.y; OUT[6] += bf2f(xv_.w & 0xffffu) * w1_.z; OUT[7] += bf2f(xv_.w >> 16) * w1_.w; } \
            _Pragma("unroll") for (int i_ = 0; i_ < 8; ++i_) OUT[i_] = siluf_(OUT[i_]); } while (0)
#pragma unroll 1
            for (int it = 0; it < 4; ++it) {
                const int tk = it * 16 + (tid >> 5);
                float y[8]; GP_CONV8(tk, isk * 16 + cg, colqk, y);
                float ss = (y[0] * y[0] + y[1] * y[1]) + (y[2] * y[2] + y[3] * y[3]) + (y[4] * y[4] + y[5] * y[5]) + (y[6] * y[6] + y[7] * y[7]);
                ss = row_sum16(ss);
                const float sc = (1.f / sqrtf(ss + EPS)) * (isk ? 1.f : 0.08838834764831845f);
                u32x4 w; w.x = pkbf(y[0] * sc, y[1] * sc); w.y = pkbf(y[2] * sc, y[3] * sc); w.z = pkbf(y[4] * sc, y[5] * sc); w.w = pkbf(y[6] * sc, y[7] * sc);
                *(u32x4*)((isk ? kb : qb) + tk * 272 + cg * 16) = w;
            }
#pragma unroll 1
            for (int it = 0; it < 2; ++it) {
                const int tk = it * 32 + (tid >> 4);
                float y[8]; GP_CONV8(tk, 32 + cg, colv, y);
                u32x4 w; w.x = pkbf(y[0], y[1]); w.y = pkbf(y[2], y[3]); w.z = pkbf(y[4], y[5]); w.w = pkbf(y[6], y[7]);
                *(u32x4*)(vb + tk * 128 + cg * 8) = w;
            }
#undef GP_CONV8
        }
        __syncthreads();
        {
            const int prod = wid >> 2, tr = (wid >> 1) & 1, tc = wid & 1;
            f32x16 acc;
#pragma unroll
            for (int i = 0; i < 16; ++i) acc[i] = 0.f;
            if (tr >= tc) {
                const unsigned char* Ab = (prod ? qb : kb) + (32 * tr + r) * 272 + hh * 16;
                const unsigned char* Bb = kb + (32 * tc + r) * 272 + hh * 16;
#pragma unroll
                for (int ks = 0; ks < 8; ++ks) acc = MFMA32(*(const bf16x8v*)(Ab + ks * 32), *(const bf16x8v*)(Bb + ks * 32), acc);
            }
            const int j = 32 * tc + r; const float gj = gcs[j];
#pragma unroll
            for (int i_ = 0; i_ < 16; ++i_) {
                const int i = 32 * tr + (i_ & 3) + 8 * (i_ >> 2) + 4 * hh;
                const float dec = __expf(gcs[i] - gj);
                if (prod == 0) Am[i * 68 + j] = (j < i) ? bes[i] * acc[i_] * dec : 0.f;
                else AT[(size_t)item * 4096 + i * 64 + j] = (bf16)f2bf((j <= i) ? acc[i_] * dec : 0.f);
            }
        }
        __syncthreads();
        int tid3 = tid; asm volatile("" : "+v"(tid3));
        if (tid3 < 256) {
            const int isw = tid3 >> 7, d = tid3 & 127;
            unsigned oam = GP_AM, orsc = GP_GC + 512 + isw * 256, ocol = (isw ? GP_KB : GP_VB) + d * 2;
            asm volatile("" : "+v"(oam), "+v"(orsc), "+v"(ocol));
            const float* Am_ = (const float*)(lds + oam); const float* rsc = (const float*)(lds + orsc); const unsigned char* col = lds + ocol;
            const int cstride = isw ? 272 : 256;
            float X[64];
#pragma clang loop unroll(full)
            for (int i = 0; i < 64; ++i) X[i] = 0.f;
#pragma clang loop unroll(full)
            for (int i = 0; i < 64; ++i) {
                f32x4 av = {0.f, 0.f, 0.f, 0.f};
#pragma clang loop unroll(full)
                for (int j4 = 0; j4 < 16; ++j4) { if (4 * j4 < i) { const f32x4 a4 = *(const f32x4*)(Am_ + i * 68 + 4 * j4);
                    const f32x4 x4 = {X[4 * j4], X[4 * j4 + 1], X[4 * j4 + 2], X[4 * j4 + 3]}; av += a4 * x4; } }
                X[i] = rsc[i] * bf2f(*(const bf16*)(col + i * cstride)) - ((av.x + av.y) + (av.z + av.w));
                asm volatile("" ::: "memory");
            }
            if (isw) {
#pragma unroll
                for (int i = 0; i < 64; ++i) wimg[i * 128 + d] = (bf16)f2bf(X[i]);
            } else {
                bf16* up = proj + (tok0 + (d >> 1)) * 4096 + 2048 + h * 128 + (d & 1) * 64;
#pragma unroll
                for (int i8 = 0; i8 < 8; ++i8) { u32x4 w; w.x = pkbf(X[8 * i8], X[8 * i8 + 1]); w.y = pkbf(X[8 * i8 + 2], X[8 * i8 + 3]); w.z = pkbf(X[8 * i8 + 4], X[8 * i8 + 5]); w.w = pkbf(X[8 * i8 + 6], X[8 * i8 + 7]);
                    *(u32x4*)(up + 8 * i8) = w; }
            }
        } else {
            if (tid3 < 384) {
                const int d = tid3 - 256; const float gl_ = gcs[63];
                bf16* kp = KT + (size_t)item * 8192 + d * 64;
#pragma unroll
                for (int i8 = 0; i8 < 8; ++i8) { float y[8];
#pragma unroll
                    for (int i = 0; i < 8; ++i) y[i] = bf2f(*(const bf16*)(kb + (8 * i8 + i) * 272 + d * 2)) * __expf(gl_ - gcs[8 * i8 + i]);
                    u32x4 w; w.x = pkbf(y[0], y[1]); w.y = pkbf(y[2], y[3]); w.z = pkbf(y[4], y[5]); w.w = pkbf(y[6], y[7]);
                    *(u32x4*)(kp + 8 * i8) = w; }
                if (d == 0) GL[item] = __expf(gl_);
            }
#pragma unroll
            for (int k = 0; k < 4; ++k) {
                const int pc = (tid3 - 256) + 256 * k, i = pc >> 4, c8 = pc & 15;
                const u32x4 v = *(const u32x4*)(qb + i * 272 + c8 * 16); const float eg = __expf(gcs[i]);
                u32x4 w; w.x = pkbf(bf2f(v.x & 0xffffu) * eg, bf2f(v.x >> 16) * eg); w.y = pkbf(bf2f(v.y & 0xffffu) * eg, bf2f(v.y >> 16) * eg);
                w.z = pkbf(bf2f(v.z & 0xffffu) * eg, bf2f(v.z >> 16) * eg); w.w = pkbf(bf2f(v.w & 0xffffu) * eg, bf2f(v.w >> 16) * eg);
                *(u32x4*)(proj + (tok0 + i) * 4096 + h * 128 + c8 * 8) = w;
            }
            if (item + nblk < Bn * 8 * 64) GP_RAWLOAD(item + nblk, tid3 - 256, 256);
        }
        __syncthreads();
#pragma unroll
        for (int k = 0; k < 2; ++k) { const int pc = tid + 512 * k, i = pc >> 4, c8 = pc & 15;
            *(u32x4*)(proj + (tok0 + i) * 4096 + 1024 + h * 128 + c8 * 8) = *(const u32x4*)(wimg + i * 128 + c8 * 8); }
    }
}

#undef GP_RAWLOAD
__device__ __forceinline__ void phase_gdn_scan2(unsigned char* lds, const bf16* proj, const bf16* KT, const bf16* AT, const float* GL, bf16* o16, int vblk, int nblk, int tid, int wid, int lane) {
    unsigned char* Sl = lds;
    unsigned char* Vl = lds + 8704;
    const int r = lane & 31, hh = lane >> 5;
    for (int item = vblk; item < 256; item += nblk) {
        const int bh = (item & 7) + 8 * (item >> 5), es = (item >> 3) & 3, b = bh >> 3, h = bh & 7;
        __syncthreads();
        for (int i = tid; i < 8704 / 4; i += 512) ((unsigned*)Sl)[i] = 0u;
        f32x16 Sacc;
#pragma unroll
        for (int i = 0; i < 16; ++i) Sacc[i] = 0.f;
        const int rt = wid & 1, dt = wid & 3;
        for (int n = 0; n < 64; ++n) {
            const size_t tok0 = (size_t)b * S + 64 * n; const int itm = bh * 64 + n;
            bf16x8v A8[8]; bf16x8v A4[4]; u32x2 uu[4]; float gl = 1.f;
            if (wid < 2) {
                const bf16* wp = proj + (tok0 + 32 * rt + r) * 4096 + 1024 + h * 128 + 8 * hh;
#pragma unroll
                for (int ks = 0; ks < 8; ++ks) A8[ks] = *(const bf16x8v*)(wp + 16 * ks);
                const int c = es * 32 + r;
                const bf16* up = proj + (tok0 + (c >> 1)) * 4096 + 2048 + h * 128 + (c & 1) * 64 + 32 * rt + 4 * hh;
#pragma unroll
                for (int g = 0; g < 4; ++g) uu[g] = *(const u32x2*)(up + 8 * g);
            } else if (wid < 4) {
                const bf16* qp = proj + (tok0 + 32 * rt + r) * 4096 + h * 128 + 8 * hh;
#pragma unroll
                for (int ks = 0; ks < 8; ++ks) A8[ks] = *(const bf16x8v*)(qp + 16 * ks);
                const bf16* ap = AT + (size_t)itm * 4096 + (32 * rt + r) * 64 + 8 * hh;
#pragma unroll
                for (int sx = 0; sx < 4; ++sx) A4[sx] = *(const bf16x8v*)(ap + 16 * sx);
            } else {
                const bf16* kp = KT + (size_t)itm * 8192 + (32 * dt + r) * 64 + 8 * hh;
#pragma unroll
                for (int sx = 0; sx < 4; ++sx) A4[sx] = *(const bf16x8v*)(kp + 16 * sx);
                gl = GL[itm];
            }
            __syncthreads();
            f32x16 acc;
#pragma unroll
            for (int i = 0; i < 16; ++i) acc[i] = 0.f;
            if (wid < 4) {
#pragma unroll
                for (int ks = 0; ks < 8; ++ks) acc = MFMA32(A8[ks], *(const bf16x8v*)(Sl + r * 272 + ks * 32 + hh * 16), acc);
                if (wid < 2) {
#pragma unroll
                    for (int g = 0; g < 4; ++g) {
                        u32x2 w; w.x = pkbf(bf2f(uu[g].x & 0xffffu) - acc[4 * g], bf2f(uu[g].x >> 16) - acc[4 * g + 1]);
                        w.y = pkbf(bf2f(uu[g].y & 0xffffu) - acc[4 * g + 2], bf2f(uu[g].y >> 16) - acc[4 * g + 3]);
                        *(u32x2*)(Vl + r * 144 + (32 * rt + 8 * g + 4 * hh) * 2) = w;
                    }
                }
            }
            __syncthreads();
            if (wid >= 2 && wid < 4) {
#pragma unroll
                for (int sx = 0; sx < 4; ++sx) acc = MFMA32(A4[sx], *(const bf16x8v*)(Vl + r * 144 + sx * 32 + hh * 16), acc);
                bf16* op = o16 + (tok0 + 32 * rt + 4 * hh) * D + h * 128 + es * 32 + r;
#pragma unroll
                for (int i = 0; i < 16; ++i) op[(size_t)((i & 3) + 8 * (i >> 2)) * D] = (bf16)f2bf(acc[i]);
            } else if (wid >= 4) {
#pragma unroll
                for (int i = 0; i < 16; ++i) Sacc[i] *= gl;
#pragma unroll
                for (int sx = 0; sx < 4; ++sx) Sacc = MFMA32(A4[sx], *(const bf16x8v*)(Vl + r * 144 + sx * 32 + hh * 16), Sacc);
#pragma unroll
                for (int g = 0; g < 4; ++g) { u32x2 w; w.x = pkbf(Sacc[4 * g], Sacc[4 * g + 1]); w.y = pkbf(Sacc[4 * g + 2], Sacc[4 * g + 3]);
                    *(u32x2*)(Sl + r * 272 + (32 * dt + 8 * g + 4 * hh) * 2) = w; }
            }
        }
    }
}

__device__ __forceinline__ void phase_gdn_post(const bf16* o16, const bf16* proj, const float* onorm, bf16* hn, int gw, int NGW, int lane) {
    const int l16 = lane & 15;
    float wv[8];
#pragma unroll
    for (int j = 0; j < 8; ++j) wv[j] = onorm[8 * l16 + j];
    for (int m = 2 * gw; m < T; m += 2 * NGW) {
        u32x4 xo[2][2], gg[2][2];
#pragma unroll
        for (int tk = 0; tk < 2; ++tk)
#pragma unroll
            for (int pt = 0; pt < 2; ++pt) { xo[tk][pt] = *(const u32x4*)(o16 + (size_t)(m + tk) * D + pt * 512 + lane * 8); gg[tk][pt] = *(const u32x4*)(proj + (size_t)(m + tk) * 4096 + 3072 + pt * 512 + lane * 8); }
#pragma unroll
        for (int tk = 0; tk < 2; ++tk)
#pragma unroll
            for (int pt = 0; pt < 2; ++pt) {
                const u32x4 xv = xo[tk][pt], gv = gg[tk][pt];
                float v[8] = {bf2f(xv.x & 0xffffu), bf2f(xv.x >> 16), bf2f(xv.y & 0xffffu), bf2f(xv.y >> 16), bf2f(xv.z & 0xffffu), bf2f(xv.z >> 16), bf2f(xv.w & 0xffffu), bf2f(xv.w >> 16)};
                const float g[8] = {bf2f(gv.x & 0xffffu), bf2f(gv.x >> 16), bf2f(gv.y & 0xffffu), bf2f(gv.y >> 16), bf2f(gv.z & 0xffffu), bf2f(gv.z >> 16), bf2f(gv.w & 0xffffu), bf2f(gv.w >> 16)};
                float sq = ((v[0] * v[0] + v[1] * v[1]) + (v[2] * v[2] + v[3] * v[3])) + ((v[4] * v[4] + v[5] * v[5]) + (v[6] * v[6] + v[7] * v[7]));
                sq = row_sum16(sq);
                const float rstd = 1.f / sqrtf(sq * (1.f / 128.f) + EPS);
#pragma unroll
                for (int j = 0; j < 8; ++j) v[j] = v[j] * rstd * wv[j] * siluf_(g[j]);
                u32x4 w; w.x = pkbf(v[0], v[1]); w.y = pkbf(v[2], v[3]); w.z = pkbf(v[4], v[5]); w.w = pkbf(v[6], v[7]);
                *(u32x4*)(hn + (size_t)(m + tk) * D + pt * 512 + lane * 8) = w;
            }
    }
}
__device__ __forceinline__ void phase_sc_post(const bf16* proj, const float* cw, bf16* hn, int gtid, int NT) {
    const int c8 = (gtid & 127) * 8;
    f32x4 w0[3], w1[3];
#pragma unroll
    for (int j = 0; j < 3; ++j) { w0[j] = *(const f32x4*)(cw + j * 1024 + c8); w1[j] = *(const f32x4*)(cw + j * 1024 + c8 + 4); }
    for (int idx = gtid; idx < T * 128; idx += 2 * NT) {
        u32x4 cv[2][3], xv[2][3], bv[2];
#pragma unroll
        for (int q = 0; q < 2; ++q) {
            const int id = idx + q * NT, m = id >> 7, s = m & (S - 1);
#pragma unroll
            for (int j = 0; j < 3; ++j) { cv[q][j] = (u32x4){0u, 0u, 0u, 0u}; xv[q][j] = (u32x4){0u, 0u, 0u, 0u};
                if (id < T * 128 && s - 2 + j >= 0) { const bf16* pr = proj + (size_t)(m - 2 + j) * 3072; cv[q][j] = *(const u32x4*)(pr + 1024 + c8); xv[q][j] = *(const u32x4*)(pr + 2048 + c8); } }
            bv[q] = (u32x4){0u, 0u, 0u, 0u};
            if (id < T * 128) bv[q] = *(const u32x4*)(proj + (size_t)m * 3072 + c8);
        }
#pragma unroll
        for (int q = 0; q < 2; ++q) {
            const int id = idx + q * NT, m = id >> 7;
            if (id >= T * 128) break;
            float y[8];
#pragma unroll
            for (int i = 0; i < 8; ++i) y[i] = 0.f;
#pragma unroll
            for (int j = 0; j < 3; ++j) {
                const u32x4 c = cv[q][j], x = xv[q][j];
                y[0] += w0[j].x * bf2f(c.x & 0xffffu) * bf2f(x.x & 0xffffu); y[1] += w0[j].y * bf2f(c.x >> 16) * bf2f(x.x >> 16);
                y[2] += w0[j].z * bf2f(c.y & 0xffffu) * bf2f(x.y & 0xffffu); y[3] += w0[j].w * bf2f(c.y >> 16) * bf2f(x.y >> 16);
                y[4] += w1[j].x * bf2f(c.z & 0xffffu) * bf2f(x.z & 0xffffu); y[5] += w1[j].y * bf2f(c.z >> 16) * bf2f(x.z >> 16);
                y[6] += w1[j].z * bf2f(c.w & 0xffffu) * bf2f(x.w & 0xffffu); y[7] += w1[j].w * bf2f(c.w >> 16) * bf2f(x.w >> 16);
            }
            const u32x4 b = bv[q];
            u32x4 o;
            o.x = pkbf(y[0] * bf2f(b.x & 0xffffu), y[1] * bf2f(b.x >> 16)); o.y = pkbf(y[2] * bf2f(b.y & 0xffffu), y[3] * bf2f(b.y >> 16));
            o.z = pkbf(y[4] * bf2f(b.z & 0xffffu), y[5] * bf2f(b.z >> 16)); o.w = pkbf(y[6] * bf2f(b.w & 0xffffu), y[7] * bf2f(b.w >> 16));
            *(u32x4*)(hn + (size_t)m * D + c8) = o;
        }
    }
}
__device__ __forceinline__ void phase_nsa_post(unsigned char* lds, const bf16* proj, const float* qnorm, const float* knorm, const f32x2* tab,
                                               bf16* QN, bf16* KS, bf16* KW, bf16* KCH, bf16* VCH, bf16* VST, bf16* VWT, int gw, int NGW, int wid, int lane) {
    {
        bf16* tile = (bf16*)lds + wid * (64 * 72);
        const int c8 = lane & 7, r8 = lane >> 3;
        for (int item = gw; item < 2 * 32 * 64; item += NGW) {
            const int st = item & 63, bh = (item >> 6) & 31, which = item >> 11, b = bh >> 2, hk = bh & 3;
            const bf16* src = proj + ((size_t)b * S + st * 64 + r8) * 2560 + (which ? 2304 : 1792) + hk * 64 + c8 * 8;
            u32x4 v[8];
#pragma unroll
            for (int i = 0; i < 8; ++i) v[i] = *(const u32x4*)(src + (size_t)(8 * i) * 2560);
#pragma unroll
            for (int i = 0; i < 8; ++i) *(u32x4*)(tile + (8 * i + r8) * 72 + c8 * 8) = v[i];
            WAVE_SYNC();
            bf16* dst = (which ? VWT : VST) + (size_t)bh * 64 * S + st * 64 + c8 * 8;
#pragma unroll
            for (int i = 0; i < 8; ++i) {
                const bf16* tp = tile + (8 * c8) * 72 + 8 * i + r8;
                u32x4 w; w.x = (unsigned)tp[0] | ((unsigned)tp[72] << 16); w.y = (unsigned)tp[144] | ((unsigned)tp[216] << 16);
                w.z = (unsigned)tp[288] | ((unsigned)tp[360] << 16); w.w = (unsigned)tp[432] | ((unsigned)tp[504] << 16);
                *(u32x4*)(dst + (size_t)(8 * i + r8) * S) = w;
            }
            WAVE_SYNC();
        }
    }
    const int l8 = lane & 7, hsel = lane >> 3, lo32 = lane < 32;
    float qw8[8], kw8[8];
#pragma unroll
    for (int j = 0; j < 8; ++j) { qw8[j] = qnorm[8 * l8 + j]; kw8[j] = knorm[(lo32 ? 64 : 128) + 8 * l8 + j]; }
#define NP_UNPACK(V, X) do { X[0] = bf2f(V.x & 0xffffu); X[1] = bf2f(V.x >> 16); X[2] = bf2f(V.y & 0xffffu); X[3] = bf2f(V.y >> 16); X[4] = bf2f(V.z & 0xffffu); X[5] = bf2f(V.z >> 16); X[6] = bf2f(V.w & 0xffffu); X[7] = bf2f(V.w >> 16); } while (0)
#define NP_RSTD8(X, R) do { float ss_ = (X[0] * X[0] + X[1] * X[1]) + (X[2] * X[2] + X[3] * X[3]) + (X[4] * X[4] + X[5] * X[5]) + (X[6] * X[6] + X[7] * X[7]); \
        ss_ += xshfl(ss_, 1); ss_ += xshfl(ss_, 2); ss_ += xshfl(ss_, 4); R = 1.f / sqrtf(ss_ * (1.f / 64.f) + EPS); } while (0)
    for (int m = gw; m < T; m += NGW) {
        const int b = m >> 12, s = m & (S - 1);
        const bf16* pr = proj + (size_t)m * 2560;
        const u32x4 vq0 = *(const u32x4*)(pr + lane * 8), vq1 = *(const u32x4*)(pr + 512 + lane * 8);
        const u32x4 vk = *(const u32x4*)(pr + (lo32 ? 1536 + lane * 8 : 2048 + (lane - 32) * 8));
        const u32x4 vc = *(const u32x4*)(pr + (lo32 ? 1024 + lane * 8 : 1280 + (lane - 32) * 8));
        const f32x4* cp = (const f32x4*)(tab + (size_t)m * 32 + 8 * (l8 & 3));
        const f32x4 c0 = cp[0], c1 = cp[1], c2 = cp[2], c3 = cp[3];
        {
            float x[8], r; NP_UNPACK(vq0, x); NP_RSTD8(x, r);
            u32x4 w; w.x = pkbf(x[0] * r * qw8[0], x[1] * r * qw8[1]); w.y = pkbf(x[2] * r * qw8[2], x[3] * r * qw8[3]); w.z = pkbf(x[4] * r * qw8[4], x[5] * r * qw8[5]); w.w = pkbf(x[6] * r * qw8[6], x[7] * r * qw8[7]);
            *(u32x4*)(QN + ((size_t)(b * 16 + hsel) * S + s) * 64 + 8 * l8) = w;
        }
        {
            float x[8], r; NP_UNPACK(vq1, x); NP_RSTD8(x, r);
            u32x4 w; w.x = pkbf(x[0] * r * qw8[0], x[1] * r * qw8[1]); w.y = pkbf(x[2] * r * qw8[2], x[3] * r * qw8[3]); w.z = pkbf(x[4] * r * qw8[4], x[5] * r * qw8[5]); w.w = pkbf(x[6] * r * qw8[6], x[7] * r * qw8[7]);
            *(u32x4*)(QN + ((size_t)(b * 16 + 8 + hsel) * S + s) * 64 + 8 * l8) = w;
        }
        const size_t okv = ((size_t)(b * 4 + (hsel & 3)) * S + s) * 64 + 8 * l8;
        {
            float x[8], r, y[8]; NP_UNPACK(vk, x); NP_RSTD8(x, r);
            const float cs[16] = {c0.x, c0.y, c0.z, c0.w, c1.x, c1.y, c1.z, c1.w, c2.x, c2.y, c2.z, c2.w, c3.x, c3.y, c3.z, c3.w};
#pragma unroll
            for (int j = 0; j < 8; ++j) { const float yv = x[j] * r * kw8[j]; const float yp = xshfl(yv, 4); y[j] = yv * cs[2 * j] + (l8 < 4 ? -yp : yp) * cs[2 * j + 1]; }
            u32x4 w; w.x = pkbf(y[0], y[1]); w.y = pkbf(y[2], y[3]); w.z = pkbf(y[4], y[5]); w.w = pkbf(y[6], y[7]);
            *(u32x4*)((lo32 ? KS : KW) + okv) = w;
        }
        *(u32x4*)((lo32 ? KCH : VCH) + okv) = vc;
    }
#undef NP_UNPACK
#undef NP_RSTD8
}
__device__ __forceinline__ void phase_cmp2(unsigned char* lds, const float* Pk, const float* Pv, const float* biasp, const float* w2, const float* b2, const float* knorm0,
                                           bf16* KC, bf16* VC, int gw, int NGW, int wid, int lane, int tid) {
    float* hs = (float*)lds + wid * 256;
    float* w2l = (float*)(lds + 8192);
    for (int kind = 0; kind < 2; ++kind) {
        __syncthreads();
        for (int idx = tid; idx < 256 * 64 / 4; idx += 512) ((f32x4*)w2l)[idx] = ((const f32x4*)(w2 + (size_t)kind * 256 * 64))[idx];
        __syncthreads();
        const float* P = kind ? Pv : Pk;
        for (int it = gw; it < 32 * 256; it += NGW) {
            const int i = it & 255, bh = it >> 8;
            bf16* outp = kind ? VC + ((size_t)bh * 64 + lane) * 256 + i : KC + ((size_t)bh * 256 + i) * 64 + lane;
            if (i == 255) { *outp = 0; continue; }
            const float* r0 = P + ((size_t)bh * 256 + i) * 512; const float* r1 = r0 + 512 + 256;
#pragma unroll
            for (int j = 0; j < 4; ++j) { const int n = lane + 64 * j; const float x = r0[n] + r1[n] + biasp[kind * 256 + n];
                const float uu = 0.7978845608028654f * (x + 0.044715f * x * x * x);
                const float th = 1.f - 2.f / (1.f + __expf(2.f * uu));
                hs[n] = 0.5f * x * (1.f + th); }
            WAVE_SYNC();
            float a0 = b2[kind * 64 + lane], a1 = 0.f, a2 = 0.f, a3 = 0.f;
#pragma unroll 4
            for (int n = 0; n < 256; n += 4) { const f32x4 hv = *(const f32x4*)(hs + n);
                a0 += hv.x * w2l[n * 64 + lane]; a1 += hv.y * w2l[(n + 1) * 64 + lane]; a2 += hv.z * w2l[(n + 2) * 64 + lane]; a3 += hv.w * w2l[(n + 3) * 64 + lane]; }
            float acc = (a0 + a1) + (a2 + a3);
            if (kind == 0) { const float ss = wave_sum(acc * acc); acc = acc * (1.f / sqrtf(ss * (1.f / 64.f) + EPS)) * knorm0[lane]; }
            *outp = (bf16)f2bf(acc);
            WAVE_SYNC();
        }
    }
}
constexpr int KV_STRIDE = 144;
constexpr int KV_BUF = 2 * 64 * KV_STRIDE;
constexpr int ATT_IMP_OFF = 2 * KV_BUF;
constexpr int ATT_MSK_OFF = ATT_IMP_OFF + 8 * 2048;

template <bool IMP>
__device__ __forceinline__ void attn_tile(const bool FAST, const unsigned char* buf, int tt, int key0, int lo, int hi, const bf16x8v (&qf)[4],
                                          f32x16 (&O)[2], f32x16 (&IM)[2], float& m, float& l, const bf16* ovt, int r, int h, int pr) {
    f32x16 sacc;
#pragma unroll
    for (int i = 0; i < 16; ++i) sacc[i] = 0.f;
    const unsigned char* kb = buf + (32 * tt + pr) * KV_STRIDE + h * 16;
#pragma unroll
    for (int ks = 0; ks < 4; ++ks) { const bf16x8v a = *(const bf16x8v*)(kb + ks * 32); sacc = MFMA32(a, qf[ks], sacc); }
    const int kb0 = key0 + 8 * h;
    float mx = -1e30f, psum = 0.f, corr;
    if (FAST) {
        const bool on = hi >= 0;
#pragma unroll
        for (int i = 0; i < 16; ++i) mx = fmaxf(mx, sacc[i]);
        mx = on ? mx * 0.18033688011112042f : -1e30f;
        mx = fmaxf(mx, xshfl(mx, 32));
        const float mnew = fmaxf(m, mx);
        corr = __builtin_amdgcn_exp2f(m - mnew);
        m = mnew;
#pragma unroll
        for (int i = 0; i < 16; ++i) { const float p = __builtin_amdgcn_exp2f(sacc[i] * 0.18033688011112042f - mnew); psum += p; sacc[i] = p; }
        if (!on) {
            psum = 0.f;
#pragma unroll
            for (int i = 0; i < 16; ++i) sacc[i] = 0.f;
        }
    } else {
#pragma unroll
        for (int i = 0; i < 16; ++i) { const int key = kb0 + 16 * (i >> 3) + (i & 7); const bool ok = (key >= lo) && (key <= hi);
            const float sv = ok ? sacc[i] * 0.18033688011112042f : -1e30f; sacc[i] = sv; mx = fmaxf(mx, sv); }
        mx = fmaxf(mx, xshfl(mx, 32));
        const float mnew = fmaxf(m, mx);
        corr = __builtin_amdgcn_exp2f(m - mnew);
        m = mnew;
#pragma unroll
        for (int i = 0; i < 16; ++i) { const float p = sacc[i] > -1e29f ? __builtin_amdgcn_exp2f(sacc[i] - mnew) : 0.f; psum += p; sacc[i] = p; }
    }
    l = l * corr + psum;
    if (__any(corr != 1.f)) {
#pragma unroll
        for (int i = 0; i < 16; ++i) { O[0][i] *= corr; O[1][i] *= corr; }
        if (IMP) {
#pragma unroll
            for (int i = 0; i < 16; ++i) { IM[0][i] *= corr; IM[1][i] *= corr; }
        }
    }
    bf16x8v pf[2];
#pragma unroll
    for (int sx = 0; sx < 2; ++sx) { u32x4 w; w.x = pkbf(sacc[8 * sx], sacc[8 * sx + 1]); w.y = pkbf(sacc[8 * sx + 2], sacc[8 * sx + 3]); w.z = pkbf(sacc[8 * sx + 4], sacc[8 * sx + 5]); w.w = pkbf(sacc[8 * sx + 6], sacc[8 * sx + 7]);
        pf[sx] = __builtin_bit_cast(bf16x8v, w); }
    const unsigned char* vb = buf + 64 * KV_STRIDE + r * KV_STRIDE + (32 * tt + 8 * h) * 2;
#pragma unroll
    for (int dt = 0; dt < 2; ++dt)
#pragma unroll
        for (int sx = 0; sx < 2; ++sx) { const bf16x8v a = *(const bf16x8v*)(vb + dt * 32 * KV_STRIDE + sx * 32); O[dt] = MFMA32(a, pf[sx], O[dt]); }
    if (IMP) {
#pragma unroll
        for (int st = 0; st < 2; ++st)
#pragma unroll
            for (int sx = 0; sx < 2; ++sx) { const bf16x8v a = *(const bf16x8v*)(ovt + (32 * st + r) * 256 + key0 + 16 * sx + 8 * h); IM[st] = MFMA32(a, pf[sx], IM[st]); }
    }
}

template <int MODE>
__device__ __forceinline__ void attn_branch(unsigned char* kvbuf, const bf16* Kg0, const bf16* VTg0, int vts, unsigned long long blkmask, int t, int nv, unsigned long long selm,
                                            int wlo, int whi, int flo, int fhi, const bf16x8v (&qf)[4], f32x16 (&O)[2], f32x16 (&IM)[2], float& l, const bf16* ovt, int tid, int r, int h, int pr) {
    float m = -1e30f;
    l = 0.f;
#pragma unroll
    for (int i = 0; i < 16; ++i) { O[0][i] = 0.f; O[1][i] = 0.f; IM[0][i] = 0.f; IM[1][i] = 0.f; }
    const int srow = tid >> 3, sch = tid & 7;
    int j = __builtin_ctzll(blkmask);
    unsigned long long rest = blkmask & (blkmask - 1);
    u32x4 kr = *(const u32x4*)(Kg0 + (size_t)(64 * j + srow) * 64 + sch * 8);
    u32x4 vr = *(const u32x4*)(VTg0 + (size_t)srow * vts + 64 * j + sch * 8);
    *(u32x4*)(kvbuf + srow * KV_STRIDE + sch * 16) = kr;
    *(u32x4*)(kvbuf + 64 * KV_STRIDE + srow * KV_STRIDE + sch * 16) = vr;
    int cur = 0;
    for (;;) {
        __syncthreads();
        const bool more = rest != 0ull;
        int jn = 0;
        if (more) { jn = __builtin_ctzll(rest); rest &= rest - 1;
            kr = *(const u32x4*)(Kg0 + (size_t)(64 * jn + srow) * 64 + sch * 8);
            vr = *(const u32x4*)(VTg0 + (size_t)srow * vts + 64 * jn + sch * 8); }
        const unsigned char* buf = kvbuf + cur * KV_BUF;
        int lo, hi;
        if (MODE == 0) { lo = 0; hi = nv - 1; }
        else if (MODE == 1) { lo = 0; hi = ((selm >> j) & 1ull) ? t : -1; }
        else { lo = t - 511; hi = t; }
        const bool wave_on = (MODE != 1) || __any(hi >= 0);
#pragma unroll
        for (int tt = 0; tt < 2; ++tt) {
            const int key0 = 64 * j + 32 * tt;
            if (!wave_on || key0 > whi || key0 + 31 < wlo) continue;
            attn_tile<MODE == 0>(key0 >= flo && key0 + 31 <= fhi, buf, tt, key0, lo, hi, qf, O, IM, m, l, ovt, r, h, pr);
        }
        if (!more) break;
        *(u32x4*)(kvbuf + (cur ^ 1) * KV_BUF + srow * KV_STRIDE + sch * 16) = kr;
        *(u32x4*)(kvbuf + (cur ^ 1) * KV_BUF + 64 * KV_STRIDE + srow * KV_STRIDE + sch * 16) = vr;
        cur ^= 1; j = jn;
    }
    __syncthreads();
}

__device__ __forceinline__ void phase_nsa_attn(unsigned char* lds, const bf16* QN, const bf16* KS, const bf16* KW, const bf16* VST, const bf16* VWT, const bf16* KCb, const bf16* VCT,
                                               const bf16* ovt, const float* gates, const f32x2* tab, bf16* hn, int vblk, int nblk, int tid, int wid, int lane) {
    const int r = lane & 31, h = lane >> 5, pr = (r & ~12) | ((r & 4) << 1) | ((r & 8) >> 1);
    float* imp_s = (float*)(lds + ATT_IMP_OFF + wid * 2048);
    unsigned long long* msk_s = (unsigned long long*)(lds + ATT_MSK_OFF);
    unsigned* uni_s = (unsigned*)(lds + ATT_MSK_OFF + 512);
    for (int item = vblk; item < Bn * 4 * 64; item += nblk) {
        const int rnd = item / nblk, wv = item - rnd * nblk;
        const int bh = wv & 31, sub = wv >> 5, per = nblk >> 5;
        int qb = rnd * per + ((rnd & 1) ? (per - 1 - sub) : sub);
        if (nblk != 256) { qb = item >> 5; }
        const int bhh = (nblk != 256) ? (item & 31) : bh;
        const int b = bhh >> 2, hk = bhh & 3;
        const int t0 = qb * 64, tw0 = t0 + 8 * wid, t = tw0 + (r & 7), g = r >> 3;
        const size_t tok = (size_t)b * S + t;
        if (tid == 0) { unsigned z = 0u; asm volatile("" : "+v"(z)); uni_s[0] = z; uni_s[1] = z; }
        bf16x8v qn[4], qr[4];
        {
            const bf16* qp = QN + ((size_t)(b * 16 + hk * 4 + g) * S + t) * 64 + 8 * h;
#pragma unroll
            for (int ks = 0; ks < 4; ++ks) qn[ks] = *(const bf16x8v*)(qp + 16 * ks);
            const f32x2* cp = tab + tok * 32 + 8 * h;
#pragma unroll
            for (int kl = 0; kl < 2; ++kl) {
                u32x4 wlo_, whi_;
                const u32x4 a = __builtin_bit_cast(u32x4, qn[kl]), c = __builtin_bit_cast(u32x4, qn[kl + 2]);
#pragma unroll
                for (int jj = 0; jj < 4; ++jj) {
                    const f32x2 cs0 = cp[16 * kl + 2 * jj], cs1 = cp[16 * kl + 2 * jj + 1];
                    const float x0 = bf2f(a[jj] & 0xffffu), x1 = bf2f(a[jj] >> 16), y0 = bf2f(c[jj] & 0xffffu), y1 = bf2f(c[jj] >> 16);
                    wlo_[jj] = pkbf(x0 * cs0.x - y0 * cs0.y, x1 * cs1.x - y1 * cs1.y);
                    whi_[jj] = pkbf(y0 * cs0.x + x0 * cs0.y, y1 * cs1.x + x1 * cs1.y);
                }
                qr[kl] = __builtin_bit_cast(bf16x8v, wlo_); qr[kl + 2] = __builtin_bit_cast(bf16x8v, whi_);
            }
        }
        const float* gp = gates + tok * 48 + (hk * 4 + g) * 3;
        const float g0 = sigmoidf_(gp[0]), g1 = sigmoidf_(gp[1]), g2 = sigmoidf_(gp[2]);
        f32x16 acc[2], O[2], IM[2];
        float l;
        const int nv = t >= 31 ? ((t - 31) >> 4) + 1 : 0;
        const int nvw = ((tw0 + 7 - 31) >> 4) + 1;
        const int nvmax = 4 * qb + 3;
        {
            const int ncb = (nvmax + 63) >> 6;
            const unsigned long long bm = ncb >= 64 ? ~0ull : ((1ull << ncb) - 1ull);
            attn_branch<0>(lds, KCb + (size_t)bhh * 256 * 64, VCT + (size_t)bhh * 64 * 256, 256, bm, t, nv, 0ull, 0, (tw0 + 7 >= 31 ? nvw - 1 : -1), 0, (tw0 >= 31 ? ((tw0 - 31) >> 4) : -1), qn, O, IM, l, ovt, tid, r, h, pr);
        }
        {
            const float lt = l + xshfl(l, 32), inv = lt > 0.f ? 1.f / lt : 0.f, sc = inv * g0;
#pragma unroll
            for (int i = 0; i < 16; ++i) { acc[0][i] = O[0][i] * sc; acc[1][i] = O[1][i] * sc; }
#pragma unroll
            for (int st = 0; st < 2; ++st)
#pragma unroll
                for (int i = 0; i < 16; ++i) { float v = IM[st][i] * inv; v += xshfl(v, 8); v += xshfl(v, 16);
                    if (r < 8) imp_s[r * 64 + 32 * st + (i & 3) + 8 * (i >> 2) + 4 * h] = v; }
        }
        WAVE_SYNC();
        {
            unsigned long long um = 0ull;
            for (int tk = 0; tk < 8; ++tk) {
                const float imp = imp_s[tk * 64 + lane];
                const bool sv = lane <= qb, forced = (lane == 0) || (lane == qb) || (lane + 1 == qb);
                const float score = sv ? (forced ? 1e9f : imp) : -1.f;
                int rank = 0;
#pragma unroll 4
                for (int i = 0; i < 64; ++i) { const float si = __uint_as_float(__builtin_amdgcn_readlane(__float_as_uint(score), i)); rank += (si > score || (si == score && i < lane)) ? 1 : 0; }
                const unsigned long long mk = __ballot((rank < 16) && (score >= 0.f));
                um |= mk;
                if (lane == 0) msk_s[wid * 8 + tk] = mk;
            }
            if (lane == 0) { atomicOr(&uni_s[0], (unsigned)um); atomicOr(&uni_s[1], (unsigned)(um >> 32)); }
        }
        __syncthreads();
        const unsigned long long selm = msk_s[wid * 8 + (r & 7)];
        const unsigned long long uni = (unsigned long long)uni_s[0] | ((unsigned long long)uni_s[1] << 32);
        attn_branch<1>(lds, KS + (size_t)bhh * S * 64, VST + (size_t)bhh * 64 * S, S, uni, t, 0, selm, 0, tw0 + 7, 0, tw0, qr, O, IM, l, ovt, tid, r, h, pr);
        {
            const float lt = l + xshfl(l, 32), sc = g1 / lt;
#pragma unroll
            for (int i = 0; i < 16; ++i) { acc[0][i] += O[0][i] * sc; acc[1][i] += O[1][i] * sc; }
        }
        {
            const int jlo = qb >= 8 ? qb - 8 : 0;
            const unsigned long long bm = (qb >= 63 ? ~0ull : ((1ull << (qb + 1)) - 1ull)) & ~((1ull << jlo) - 1ull);
            attn_branch<2>(lds, KW + (size_t)bhh * S * 64, VWT + (size_t)bhh * 64 * S, S, bm, t, 0, 0ull, tw0 - 511, tw0 + 7, tw0 + 7 - 511, tw0, qr, O, IM, l, ovt, tid, r, h, pr);
        }
        {
            const float lt = l + xshfl(l, 32), sc = g2 / lt;
            bf16* op = hn + tok * D + (hk * 4 + g) * 64 + 4 * h;
#pragma unroll
            for (int dt = 0; dt < 2; ++dt)
#pragma unroll
                for (int q4 = 0; q4 < 4; ++q4) {
                    u32x2 w; w.x = pkbf(acc[dt][4 * q4] + O[dt][4 * q4] * sc, acc[dt][4 * q4 + 1] + O[dt][4 * q4 + 1] * sc);
                    w.y = pkbf(acc[dt][4 * q4 + 2] + O[dt][4 * q4 + 2] * sc, acc[dt][4 * q4 + 3] + O[dt][4 * q4 + 3] * sc);
                    *(u32x2*)(op + 32 * dt + 8 * q4) = w;
                }
        }
    }
}


#define LAS __attribute__((address_space(3)))
#define XB_TMO      128
#define XB_XCNT(j)  (256  + 64 * (j))
#define XB_XSUB(j)  (1280 + 64 * (j))
#define XB_XGEN(j)  (2304 + 64 * (j))
#define XB_TOP      3328
#define XB_TOPGEN   3392
#define XCD_BAR_WORDS 3456
#define XB_SPIN_CAP (1u << 18)

__device__ __forceinline__ unsigned xb_ld(unsigned* p)              { return __hip_atomic_load(p, __ATOMIC_RELAXED, __HIP_MEMORY_SCOPE_AGENT); }
__device__ __forceinline__ unsigned xb_add(unsigned* p, unsigned v) { return __hip_atomic_fetch_add(p, v, __ATOMIC_RELAXED, __HIP_MEMORY_SCOPE_AGENT); }
__device__ __forceinline__ unsigned xb_xcc_id() { return (unsigned)__builtin_amdgcn_s_getreg((3 << 11) | 20) & 0xFu; }
#define XB_SPIN(cond, bar) do { unsigned _sp = 0; while (cond) { __builtin_amdgcn_s_sleep(1); \
    if ((++_sp & 255u) == 0u) { if (xb_ld(&(bar)[XB_TMO])) break; if (_sp > XB_SPIN_CAP) { atomicAdd(&(bar)[XB_TMO], 1u); break; } } } } while (0)

struct XcdBarrier {
    unsigned* bar; unsigned x;
    volatile LAS unsigned* st;
};

__device__ __forceinline__ XcdBarrier xcd_barrier_post(unsigned* bar, volatile LAS unsigned* st) {
    XcdBarrier b; b.bar = bar; b.x = xb_xcc_id(); b.st = st;
    if (threadIdx.x == 0) (void)xb_add(&bar[XB_XCNT(b.x)], 1u);
    return b;
}
__device__ __forceinline__ void xcd_barrier_complete(unsigned* bar, unsigned x, unsigned& nloc, unsigned& nx) {
    const unsigned G = gridDim.x * gridDim.y * gridDim.z;
    unsigned sum, cnt, mine, sp = 0u;
    for (;;) {
        sum = 0u; cnt = 0u; mine = 0u;
#pragma unroll
        for (unsigned j = 0; j < 16; ++j) { const unsigned c = xb_ld(&bar[XB_XCNT(j)]); sum += c; cnt += (c > 0u) ? 1u : 0u; mine = (j == x) ? c : mine; }
        if (sum == G) break;
        __builtin_amdgcn_s_sleep(1);
        if ((++sp & 255u) == 0u) { if (xb_ld(&bar[XB_TMO])) break; if (sp > XB_SPIN_CAP) { atomicAdd(&bar[XB_TMO], 1u); break; } }
    }
    nloc = mine > 0u ? mine : 1u; nx = cnt > 0u ? cnt : 1u;
}

__device__ __forceinline__ void xcd_barrier(const XcdBarrier& b) {
    asm volatile("s_waitcnt vmcnt(0)" ::: "memory");
    __syncthreads();
    if (threadIdx.x == 0) {
        unsigned* bar = b.bar;
        __builtin_amdgcn_s_waitcnt(0);
        unsigned nloc = b.st[0], nx = b.st[1];
        if (nloc == 0u) { xcd_barrier_complete(bar, b.x, nloc, nx); b.st[0] = nloc; b.st[1] = nx; }
        const unsigned old = xb_add(&bar[XB_XSUB(b.x)], 1u);
        const unsigned gen = old / nloc;
        if (old + 1u == (gen + 1u) * nloc) {
            __builtin_amdgcn_fence(__ATOMIC_RELEASE, "agent");
            asm volatile("s_waitcnt vmcnt(0)" ::: "memory");
            const unsigned og = xb_add(&bar[XB_TOP], 1u);
            const unsigned tg = og / nx;
            if (og + 1u == (tg + 1u) * nx) xb_add(&bar[XB_TOPGEN], 1u);
            else XB_SPIN(xb_ld(&bar[XB_TOPGEN]) == tg, bar);
            __builtin_amdgcn_fence(__ATOMIC_ACQUIRE, "agent");
            xb_add(&bar[XB_XGEN(b.x)], 1u);
            asm volatile("s_waitcnt vmcnt(0)" ::: "memory");
        } else {
            XB_SPIN(xb_ld(&bar[XB_XGEN(b.x)]) == gen, bar);
            __builtin_amdgcn_fence(__ATOMIC_ACQUIRE, "agent");
            asm volatile("s_waitcnt vmcnt(0)" ::: "memory");
        }
    }
    __syncthreads();
}

struct Args { const void* in[24]; float* out; unsigned char* ws; int lo, hi; };

__host__ __device__ constexpr int mixer_inner_phases(int kind) { return kind == 0 ? 4 : (kind == 1 ? 1 : 4); }
__host__ __device__ constexpr int total_phases() { int n = 1; for (int L = 0; L < DEPTH; ++L) n += 4 + 2 + mixer_inner_phases(L % 3); return n; }

__global__ void __launch_bounds__(512, 2) mega(Args args) {
    extern __shared__ __attribute__((aligned(16))) unsigned char lds[];
    cg::grid_group grid = cg::this_grid();
    volatile LAS unsigned* bst = (volatile LAS unsigned*)((LAS unsigned char*)lds + (LDS_BYTES - 64));
    if (threadIdx.x < 2) bst[threadIdx.x] = 0u;
    __syncthreads();
    const XcdBarrier xbar = xcd_barrier_post((unsigned*)args.ws, bst);
    bool again = false;
    for (int ph = args.lo; ph < args.hi; ++ph) {
        int type = 0, s = 0, L = 0;
        if (ph > 0) {
            int p = ph - 1;
            for (L = 0; L < DEPTH; ++L) { const int n = 6 + mixer_inner_phases(L % 3); if (p < n) break; p -= n; }
            const int inner = mixer_inner_phases(L % 3), kind = L % 3;
            if (p < 2) { type = 2 + p; s = 2 * L; }
            else if (p == 2) type = 5;
            else if (p < 3 + inner) { const int q = p - 3; type = kind == 0 ? (q == 0 ? 14 : (q == 1 ? 15 : 4 + q)) : (kind == 1 ? 8 : 9 + q); }
            else if (p == 3 + inner) type = 13;
            else { type = 2 + (p - 4 - inner); s = 2 * L + 1; }
        }
        int tid_ = threadIdx.x; asm volatile("" : "+v"(tid_));
        int G_ = gridDim.x, bx_ = blockIdx.x; asm volatile("" : "+s"(G_), "+s"(bx_));
        const int tid = tid_, lane = tid & 63, wid = __builtin_amdgcn_readfirstlane(tid >> 6);
        const int G = G_, bx = bx_;
        const int vcu = (G % 8 == 0) ? (bx % 8) * (G / 8) + bx / 8 : bx;
        const int gw = vcu * 8 + wid, NGW = G * 8;
        unsigned char* ws = args.ws; asm volatile("" : "+s"(ws));
        PG8_LAS unsigned char* ldsl = (PG8_LAS unsigned char*)lds;
        float* hout = args.out; asm volatile("" : "+s"(hout));
        bf16* HN = (bf16*)(ws + WS_HN);
        bf16* RB = (bf16*)(ws + WS_R);
        f32x2* tab = (f32x2*)(ws + WS_TAB);
        const int kind = L % 3, jj = L / 3;
        bf16* QN = RB + (size_t)T * 2560;
        bf16* KSb = QN + (size_t)T * 1024;
        bf16* KWb = KSb + (size_t)T * 256;
        bf16* KCH = (bf16*)(ws + WS_O32);
        bf16* VCH = KCH + (size_t)T * 256;
        float* Pk = (float*)(ws + WS_O32 + 32 * MiB);
        float* Pv = Pk + (size_t)8192 * 512;
        bf16* KC = (bf16*)(ws + WS_O32 + 64 * MiB);
        bf16* VC = (bf16*)(ws + WS_O32 + 65 * MiB);
        bf16* OVT = (bf16*)(ws + WS_BP + 65536);
        bf16* VST = (bf16*)(ws + WS_O32 + 68 * MiB);
        bf16* VWT = (bf16*)(ws + WS_O32 + 84 * MiB);
        switch (type) {
        case 0: {
            float* scr = (float*)lds + wid * (64 * 33);
            for (int mi = 0; mi < 28; ++mi) {
                const float* W; const float* nw = nullptr; int K, N, Npad, mode = 0; bf16* WT;
                if (mi < 8)       { nw = (const float*)args.in[2] + (size_t)mi * D; W = (const float*)args.in[3] + (size_t)mi * D * 2 * FF; K = D; N = 2 * FF; Npad = N; mode = 1; WT = (bf16*)(ws + WS_WGU) + (size_t)mi * 2 * FF * D; }
                else if (mi < 16) { const int i = mi - 8; W = (const float*)args.in[4] + (size_t)i * FF * D; K = FF; N = D; Npad = N; WT = (bf16*)(ws + WS_WDN) + (size_t)i * D * FF; }
                else if (mi < 18) { const int i = mi - 16; nw = (const float*)args.in[5] + (size_t)(3 * i) * D; W = (const float*)args.in[6] + (size_t)i * D * 4112; K = D; N = 4112; Npad = GDN_NPAD; WT = (bf16*)(ws + WS_WGI) + (size_t)i * GDN_NPAD * D; }
                else if (mi < 20) { const int i = mi - 18; W = (const float*)args.in[11] + (size_t)i * D * D; K = D; N = D; Npad = N; WT = (bf16*)(ws + WS_WGO) + (size_t)i * D * D; }
                else if (mi == 20) { nw = (const float*)args.in[5] + (size_t)1 * D; W = (const float*)args.in[12]; K = D; N = 3072; Npad = N; WT = (bf16*)(ws + WS_WSI); }
                else if (mi == 21) { W = (const float*)args.in[14]; K = D; N = D; Npad = N; WT = (bf16*)(ws + WS_WSO); }
                else if (mi == 22) { nw = (const float*)args.in[5] + (size_t)2 * D; W = (const float*)args.in[15]; K = D; N = 2608; Npad = NSA_NPAD; WT = (bf16*)(ws + WS_WNI); }
                else if (mi == 23) { W = (const float*)args.in[23]; K = D; N = D; Npad = N; WT = (bf16*)(ws + WS_WNO); }
                else { const int i = mi - 24, kd = i >> 1, hf = i & 1;
                    W = (const float*)args.in[19] + (size_t)kd * 2048 * 256 + (size_t)hf * 1024 * 256; K = 1024; N = 256; Npad = 256; WT = (bf16*)(ws + WS_WC1) + (size_t)kd * 512 * 1024 + (size_t)hf * 256 * 1024; }
                xpose_matrix(W, nw, K, N, Npad, WT, mode, scr, gw, NGW, lane);
            }
            {
                float* ss = (float*)(ws + WS_SS);
                const float* xin = (const float*)args.in[0];
                for (int m = gw; m < T; m += NGW) {
                    const f32x4* xr = (const f32x4*)(xin + (size_t)m * D) + lane; u32x2* o8 = (u32x2*)(HN + (size_t)m * D) + lane; float sq = 0.f;
#pragma unroll
                    for (int j = 0; j < 4; ++j) { const f32x4 v = xr[64 * j]; sq += (v.x * v.x + v.y * v.y) + (v.z * v.z + v.w * v.w); u32x2 o; o.x = pkbf(v.x, v.y); o.y = pkbf(v.z, v.w); o8[64 * j] = o; }
                    sq = wave_sum(sq); if (lane < 16) ss[(size_t)m * 16 + lane] = lane == 0 ? sq : 0.f;
                }
            }
            const int* positions = (const int*)args.in[1];
            for (int idx = bx * 512 + tid; idx < T * 32; idx += G * 512) {
                const int tk = idx >> 5, i = idx & 31;
                const float inv = 1.0f / exp2f((float)(2 * i) * (13.287712379549449f / 64.f));
                const float ang = (float)positions[tk] * inv;
                const double rev = (double)ang * 0.15915494309189535;
                const float fr = (float)(rev - rint(rev));
                f32x2 v; v.x = __builtin_amdgcn_cosf(fr); v.y = __builtin_amdgcn_sinf(fr);
                tab[idx] = v;
            }
            for (int idx = bx * 512 + tid; idx < 64 * 256; idx += G * 512) {
                const int sj = idx >> 8, i = idx & 255, q = i >> 2, rem = i & 3;
                OVT[idx] = (bf16)(rem < 3 ? (q == sj ? 0x3F80 : 0) : ((q == sj || q + 1 == sj) ? 0x3F00 : 0));
            }
            if (bx < 2 && tid < 256) {
                const float* pe = (const float*)args.in[18] + (size_t)bx * 2048;
                const float* w1 = (const float*)args.in[19] + (size_t)bx * 2048 * 256 + tid;
                float acc = ((const float*)args.in[20])[bx * 256 + tid];
                for (int k = 0; k < 2048; ++k) acc += pe[k] * w1[(size_t)k * 256];
                ((float*)(ws + WS_BP))[bx * 256 + tid] = acc;
            }
        } break;
        case 2: {
            const bf16* Ah = (s & 1) ? (const bf16*)(ws + WS_R + 192 * MiB) : HN;
            pg8::Gemm g{Ah, (const bf16*)(ws + WS_WGU) + (size_t)s * 2 * FF * D, T, 2 * FF, D}; pg8::StaticOrder SO; SO.init(T, 2 * FF, G, bx);
            float* rtab = (float*)(lds + 131072);
            rstd_table(rtab, (const float*)(ws + WS_SS) + (size_t)s * T * 16, SO, tid);
            pg8::EpiSwiGLU E{RB, rtab};
            pg8::gemm_phase<pg8::EpiSwiGLU, pg8::StaticOrder, true, true>(ldsl, g, SO, E, tid); } break;
        case 3: {
            pg8::Gemm g{RB, (const bf16*)(ws + WS_WDN) + (size_t)s * D * FF, T, D, FF}; pg8::StaticOrder SO; SO.init(T, D, G, bx);
            const int slot = (s & 1) ? (s < 7 ? s + 1 : 12) : 8 + (s >> 1);
            pg8::EpiResid<1> E{s == 0 ? (const float*)args.in[0] : hout, hout, HN, (float*)(ws + WS_SS) + (size_t)slot * T * 16};
            pg8::gemm_phase<pg8::EpiResid<1>, pg8::StaticOrder, true, true>(ldsl, g, SO, E, tid); } break;
        case 5: {
            const bf16* Wt; int Np, ldc, nmain, ldt, nvalid; float* tail;
            if (kind == 0) { Wt = (const bf16*)(ws + WS_WGI) + (size_t)jj * GDN_NPAD * D; Np = GDN_NPAD; ldc = 4096; nmain = 4096; tail = (float*)(ws + WS_AB); ldt = 16; nvalid = 4112; }
            else if (kind == 1) { Wt = (const bf16*)(ws + WS_WSI); Np = 3072; ldc = 3072; nmain = 3072; tail = (float*)(ws + WS_AB); ldt = 16; nvalid = 3072; }
            else { Wt = (const bf16*)(ws + WS_WNI); Np = NSA_NPAD; ldc = 2560; nmain = 2560; tail = (float*)(ws + WS_GT); ldt = 48; nvalid = 2608; }
            pg8::Gemm g{HN, Wt, T, Np, D}; pg8::StaticOrder SO; SO.init(T, Np, G, bx);
            float* rtab = (float*)(lds + 131072);
            rstd_table(rtab, (const float*)(ws + WS_SS) + (size_t)(8 + L) * T * 16, SO, tid);
            pg8::EpiProj E{RB, ldc, nmain, tail, ldt, nvalid, rtab};
            pg8::gemm_phase<pg8::EpiProj, pg8::StaticOrder, true, true>(ldsl, g, SO, E, tid); } break;
        case 14: phase_gdn_halo(RB, (bf16*)(ws + WS_HALO), vcu * 512 + tid, G * 512); break;
        case 15: phase_gdn_prep(lds, RB, (const bf16*)(ws + WS_HALO), (const float*)(ws + WS_AB), (const float*)args.in[7] + (size_t)jj * 4 * 3072, (const float*)args.in[8] + jj * 8, (const float*)args.in[9] + jj * 8,
                                HN, (bf16*)(ws + WS_O32 + 64 * MiB), (float*)(ws + WS_GL), bx, G, tid, wid, lane); break;
        case 6:
#ifndef DIS_SCAN
            phase_gdn_scan2(lds, RB, HN, (const bf16*)(ws + WS_O32 + 64 * MiB), (const float*)(ws + WS_GL), (bf16*)(ws + WS_O32), bx, G, tid, wid, lane);
#endif
            break;
        case 7:
#ifndef DIS_GPOST
            phase_gdn_post((const bf16*)(ws + WS_O32), RB, (const float*)args.in[10] + jj * 128, HN, gw, NGW, lane);
#endif
            break;
        case 8:
#ifndef DIS_SPOST
            phase_sc_post(RB, (const float*)args.in[13], HN, vcu * 512 + tid, G * 512);
#endif
            break;
        case 9:
#ifndef DIS_NPOST
            phase_nsa_post(lds, RB, (const float*)args.in[16], (const float*)args.in[17], tab, QN, KSb, KWb, KCH, VCH, VST, VWT, gw, NGW, wid, lane);
#endif
            break;
        case 10: {
            pg8::Gemm g{KCH, (const bf16*)(ws + WS_WC1), 8192, 512, 1024}; pg8::StaticOrder SO; SO.init(8192, 512, G, bx);
            pg8::Gemm g2{VCH, (const bf16*)(ws + WS_WC1) + (size_t)512 * 1024, 8192, 512, 1024};
            pg8::EpiF32 E{Pk, 512};
            if (bx >= G / 2) { g = g2; SO.init(8192, 512, G, bx - G / 2); E.C = Pv; }
            pg8::gemm_phase<pg8::EpiF32, pg8::StaticOrder, true, true>(ldsl, g, SO, E, tid); } break;
        case 11:
#ifndef DIS_CMP2
            phase_cmp2(lds, Pk, Pv, (const float*)(ws + WS_BP), (const float*)args.in[21], (const float*)args.in[22], (const float*)args.in[17], KC, VC, gw, NGW, wid, lane, tid);
#endif
            break;
        case 12:
#ifndef DIS_ATTN
            phase_nsa_attn(lds, QN, KSb, KWb, VST, VWT, KC, VC, OVT, (const float*)(ws + WS_GT), tab, HN, bx, G, tid, wid, lane);
#endif
            break;
        default: {
            const bf16* Wout = kind == 0 ? (const bf16*)(ws + WS_WGO) + (size_t)jj * D * D : (kind == 1 ? (const bf16*)(ws + WS_WSO) : (const bf16*)(ws + WS_WNO));
            pg8::Gemm g{HN, Wout, T, D, D}; pg8::StaticOrder SO; SO.init(T, D, G, bx);
            pg8::EpiResid<2> E{hout, hout, (bf16*)(ws + WS_R + 192 * MiB), (float*)(ws + WS_SS) + (size_t)(2 * L + 1) * T * 16};
            pg8::gemm_phase<pg8::EpiResid<2>, pg8::StaticOrder, true, true>(ldsl, g, SO, E, tid); } break;
        }
#ifdef REP_TYPE
        if (type == REP_TYPE && !again) { again = true; xcd_barrier(xbar); --ph; continue; }
        again = false;
#endif
        if (ph + 1 < args.hi) { if (ph == 0) grid.sync(); else xcd_barrier(xbar); }
    }
}

extern "C" void kernel_launch(void* const* d_in, const int* in_sizes, int n_in, void* d_out, int out_size, void* d_ws, size_t ws_size, hipStream_t stream) {
    static int grid = 0;
    if (grid == 0) {
        if (n_in != 24 || out_size != T * D || ws_size < WS_END2) { fprintf(stderr, "kernel_launch: unexpected shapes n_in %d out %d ws %zu (need %zu)\n", n_in, out_size, ws_size, (size_t)WS_END2); grid = -1; return; }
        int dev = 0, cus = 0, per_cu = 0;
        hipGetDevice(&dev); hipDeviceGetAttribute(&cus, hipDeviceAttributeMultiprocessorCount, dev);
        if (hipFuncSetAttribute((const void*)mega, hipFuncAttributeMaxDynamicSharedMemorySize, LDS_BYTES) != hipSuccess) { fprintf(stderr, "kernel_launch: hipFuncSetAttribute failed\n"); grid = -1; return; }
        if (hipOccupancyMaxActiveBlocksPerMultiprocessor(&per_cu, (const void*)mega, 512, LDS_BYTES) != hipSuccess || per_cu < 1) { fprintf(stderr, "kernel_launch: occupancy query says %d\n", per_cu); per_cu = 1; }
        (void)hipGetLastError();
        grid = cus;
    }
    if (grid < 0) return;
    Args a{};
    for (int i = 0; i < 24; ++i) a.in[i] = d_in[i];
    a.out = (float*)d_out; a.ws = (unsigned char*)d_ws;
    constexpr int NPH = total_phases();
#if MK_MULTI
    for (int p = 0; p < NPH; ++p) { a.lo = p; a.hi = p + 1; hipLaunchKernelGGL(mega, dim3(grid), dim3(512), LDS_BYTES, stream, a); }
#else
    a.lo = 0; a.hi = NPH;
    (void)hipMemsetAsync(d_ws, 0, 16384, stream);
    void* kargs[] = {&a};
    hipError_t e = hipLaunchCooperativeKernel((const void*)mega, dim3(grid), dim3(512), kargs, LDS_BYTES, stream);
    if (e != hipSuccess) fprintf(stderr, "cooperative launch failed: %s (grid %d)\n", hipGetErrorString(e), grid);
#endif
}
```

```cpp
#include <hip/hip_runtime.h>
#include <hip/hip_cooperative_groups.h>
#include <cstdio>
#include <cstdint>
namespace cg = cooperative_groups;
namespace pg8 {
#define PG8_LAS __attribute__((address_space(3)))
typedef unsigned short bf16_t;
typedef short bf16x8 __attribute__((ext_vector_type(8)));
typedef float f32x4 __attribute__((ext_vector_type(4)));
typedef unsigned u32x4 __attribute__((ext_vector_type(4)));
constexpr int BM = 256, BK = 64, HALF = 128, HTB = HALF * BK * 2  , STAGE_BYTES = 8 * HTB, NXCD = 8, WGM = 8;

__host__ __device__ __forceinline__ int lds_byte(int r, int c) { const int st = (r >> 4) * 2 + (c >> 5), rr = r & 15, cc = c & 31, ob = rr * 64 + cc * 2; return st * 1024 + (ob ^ (((ob >> 9) & 1) << 5)); }
__host__ __device__ __forceinline__ void stage_rc(int b, int& R, int& C) { const int st = b / 1024, sb = b % 1024, swz = sb ^ (((sb >> 9) & 1) << 5); R = (st >> 1) * 16 + swz / 64; C = (st & 1) * 32 + (swz % 64) / 2; }
__host__ __device__ __forceinline__ int perm32(int rho) { const int n = rho >> 4, i = rho & 15; return 8 * (i >> 2) + 4 * n + (i & 3); }

struct Unit { int pm, pn, ord; };
struct Gemm { const bf16_t* A; const bf16_t* Bt; int M, N, K; };

struct StaticOrder {
    int nM, nN, nwg, G, c;
    __host__ __device__ void init(int M, int N, int G_, int c_) { nM = M / BM; nN = N / BM; nwg = nM * nN; G = G_; c = c_; }
    __host__ __device__ bool next(int i, Unit& u) const {
        const long L = (long)i * G + c; if (L >= nwg) return false;
        int wgid = (int)L; { const int q = nwg / NXCD, r = nwg % NXCD, xcd = wgid % NXCD, off = wgid / NXCD; wgid = (xcd < r ? xcd * (q + 1) : r * (q + 1) + (xcd - r) * q) + off; }
        const int nig = WGM * nN, gid = wgid / nig, fm = gid * WGM, gsz = (nM - fm) < WGM ? (nM - fm) : WGM;
        u.pm = fm + ((wgid % nig) % gsz); u.pn = (wgid % nig) / gsz; u.ord = i; return true;
    }
    __device__ __forceinline__ void a_ready(const Unit&) const {}
    __device__ __forceinline__ void done(const Unit&) const {}
};
__device__ __forceinline__ unsigned cvt_pk_bf16(float lo, float hi) { unsigned r; asm volatile("v_cvt_pk_bf16_f32 %0, %1, %2" : "=v"(r) : "v"(lo), "v"(hi)); return r; }
template <class Epi, class Sched, bool ALIGN_EPI = false, bool SP2 = false>
__device__ __forceinline__ void gemm_phase(PG8_LAS unsigned char* lds, const Gemm g, const Sched& S, const Epi& E, const int tid) {
    const int wid = __builtin_amdgcn_readfirstlane(tid >> 6), lane = tid & 63, wr = wid >> 2, wc = wid & 3, fr = lane & 15, fq = lane >> 4;
    const int K = g.K, nt = K / BK;
    unsigned voffA[2], voffB[2];
#pragma unroll
    for (int i = 0; i < 2; ++i) { int R, C; stage_rc(tid * 16 + i * 8192, R, C); const int Rb = Epi::PERM ? ((R & ~31) + perm32(R & 31)) : R;
        voffA[i] = (unsigned)(R * K + C) * 2u; voffB[i] = (unsigned)(Rb * K + C) * 2u; }
    const size_t kstep = (size_t)(BK * 2);
    const size_t hstep = (size_t)HALF * K * 2;
    const size_t tstep = 2 * hstep;
    const unsigned ldsw = (unsigned)wid * 1024u;
    const int aoff = lds_byte(wr * 64 + fr, fq * 8), boff = lds_byte(wc * 32 + fr, fq * 8);
#define PG8_SA(b, h) (((b) * 2 + (h)) * HTB)
#define PG8_SB(b, h) ((4 + (b) * 2 + (h)) * HTB)
#define PG8_STAGE(bufoff, gbase, voff) do { _Pragma("unroll") for (int _i = 0; _i < 2; ++_i) \
        __builtin_amdgcn_global_load_lds((const unsigned*)((const char*)(gbase) + (voff)[_i]), (PG8_LAS unsigned*)(lds + (bufoff) + ldsw + _i * 8192), 16, 0, 0); } while (0)
#define PG8_LDA(dst, b, h) do { _Pragma("unroll") for (int m = 0; m < 4; ++m) _Pragma("unroll") for (int k = 0; k < 2; ++k) dst[m][k] = *(const PG8_LAS bf16x8*)(lds + PG8_SA(b, h) + aoff + m * 2048 + k * 1024); } while (0)
#define PG8_LDB(dst, b, h) do { _Pragma("unroll") for (int n = 0; n < 2; ++n) _Pragma("unroll") for (int k = 0; k < 2; ++k) dst[n][k] = *(const PG8_LAS bf16x8*)(lds + PG8_SB(b, h) + boff + n * 2048 + k * 1024); } while (0)
#define PG8_MMA(ai, bj, At, Bt) do { __builtin_amdgcn_s_setprio(1); _Pragma("unroll") for (int m = 0; m < 4; ++m) _Pragma("unroll") for (int n = 0; n < 2; ++n) _Pragma("unroll") for (int k = 0; k < 2; ++k) \
        acc[ai][bj][m][n] = __builtin_amdgcn_mfma_f32_16x16x32_bf16(Bt[n][k], At[m][k], acc[ai][bj][m][n], 0, 0, 0); __builtin_amdgcn_s_setprio(0); } while (0)
#define PG8_WAIT_V(n) asm volatile("s_waitcnt vmcnt(" #n ")" ::: "memory")
#define PG8_WAIT_L(n) asm volatile("s_waitcnt lgkmcnt(" #n ")" ::: "memory")
#define PG8_BAR __builtin_amdgcn_s_barrier()
#define PG8_SCHED __builtin_amdgcn_sched_barrier(0)
    Unit cur, nxt; int ui = 0;
    if (!S.next(0, cur)) return;
    f32x4 acc[2][2][4][2];
#pragma unroll
    for (int a = 0; a < 2; ++a)
#pragma unroll
        for (int b = 0; b < 2; ++b)
#pragma unroll
            for (int m = 0; m < 4; ++m)
#pragma unroll
                for (int n = 0; n < 2; ++n) acc[a][b][m][n] = (f32x4){0.f, 0.f, 0.f, 0.f};
    bf16x8 At[4][2], B0[2][2], B1[2][2];
    const char* cA = (const char*)g.A + (size_t)cur.pm * tstep; const char* cB = (const char*)g.Bt + (size_t)cur.pn * tstep;
    S.a_ready(cur);
    if constexpr (SP2) {
        PG8_STAGE(PG8_SB(0, 0), cB, voffB); PG8_STAGE(PG8_SB(0, 1), cB + hstep, voffB); PG8_STAGE(PG8_SA(0, 0), cA, voffA); PG8_STAGE(PG8_SA(0, 1), cA + hstep, voffA);
        if (wr == 1) PG8_BAR;
        PG8_WAIT_V(2); PG8_BAR;
        PG8_STAGE(PG8_SB(1, 0), cB + kstep, voffB); PG8_STAGE(PG8_SA(1, 0), cA + kstep, voffA); PG8_STAGE(PG8_SB(1, 1), cB + hstep + kstep, voffB);
        PG8_WAIT_V(6); PG8_BAR;
    } else {
        PG8_STAGE(PG8_SB(0, 0), cB, voffB); PG8_STAGE(PG8_SA(0, 0), cA, voffA); PG8_STAGE(PG8_SB(0, 1), cB + hstep, voffB); PG8_STAGE(PG8_SA(0, 1), cA + hstep, voffA);
        if (wr == 1) PG8_BAR;
        PG8_WAIT_V(4); PG8_BAR;
        PG8_STAGE(PG8_SB(1, 0), cB + kstep, voffB); PG8_STAGE(PG8_SA(1, 0), cA + kstep, voffA); PG8_STAGE(PG8_SB(1, 1), cB + hstep + kstep, voffB);
        PG8_WAIT_V(6); PG8_BAR;
    }
    for (;;) {
        const bool has_next = S.next(ui + 1, nxt);
        const char* nA = has_next ? (const char*)g.A + (size_t)nxt.pm * tstep : cA; const char* nB = has_next ? (const char*)g.Bt + (size_t)nxt.pn * tstep : cB;
        for (int t = 0; t < nt; t += 2) {
            const bool last = (t == nt - 2);
            const char* a1 = cA + (size_t)(t + 1) * kstep;
            const char* a2 = last ? nA : cA + (size_t)(t + 2) * kstep; const char* b2 = last ? nB : cB + (size_t)(t + 2) * kstep;
            const char* a3 = a2 + kstep; const char* b3 = b2 + kstep;
            if (last && has_next) S.a_ready(nxt);
            if constexpr (SP2) {
            PG8_LDB(B0, 0, 0); PG8_LDB(B1, 0, 1); PG8_SCHED; PG8_LDA(At, 0, 0); PG8_STAGE(PG8_SA(1, 1), a1 + hstep, voffA);
            PG8_WAIT_V(8); PG8_WAIT_L(0); PG8_BAR; PG8_MMA(0, 0, At, B0); PG8_MMA(0, 1, At, B1); PG8_BAR; PG8_SCHED;
            PG8_LDA(At, 0, 1); PG8_STAGE(PG8_SB(0, 0), b2, voffB); PG8_STAGE(PG8_SB(0, 1), b2 + hstep, voffB); PG8_STAGE(PG8_SA(0, 0), a2, voffA);
            PG8_WAIT_V(8); PG8_WAIT_L(0); PG8_BAR; PG8_MMA(1, 0, At, B0); PG8_MMA(1, 1, At, B1); PG8_BAR; PG8_SCHED;
            PG8_LDB(B0, 1, 0); PG8_LDB(B1, 1, 1); PG8_SCHED; PG8_LDA(At, 1, 0); PG8_STAGE(PG8_SA(0, 1), a2 + hstep, voffA);
            PG8_WAIT_V(8); PG8_WAIT_L(0); PG8_BAR; PG8_MMA(0, 0, At, B0); PG8_MMA(0, 1, At, B1); PG8_BAR; PG8_SCHED;
            PG8_LDA(At, 1, 1); PG8_STAGE(PG8_SB(1, 0), b3, voffB); PG8_STAGE(PG8_SB(1, 1), b3 + hstep, voffB); PG8_STAGE(PG8_SA(1, 0), a3, voffA);
            PG8_WAIT_V(8); PG8_WAIT_L(0); PG8_BAR; PG8_MMA(1, 0, At, B0); PG8_MMA(1, 1, At, B1); PG8_BAR; PG8_SCHED;
            } else {
            PG8_LDB(B0, 0, 0); PG8_SCHED; PG8_LDA(At, 0, 0); PG8_STAGE(PG8_SA(1, 1), a1 + hstep, voffA);
            PG8_WAIT_L(8); PG8_BAR; PG8_WAIT_L(0); PG8_MMA(0, 0, At, B0); PG8_BAR; PG8_SCHED;
            PG8_LDB(B1, 0, 1); PG8_STAGE(PG8_SB(0, 0), b2, voffB);
            PG8_BAR; PG8_WAIT_L(0); PG8_MMA(0, 1, At, B1); PG8_BAR;
            PG8_LDA(At, 0, 1); PG8_STAGE(PG8_SA(0, 0), a2, voffA);
            PG8_BAR; PG8_WAIT_L(0); PG8_MMA(1, 0, At, B0); PG8_BAR; PG8_SCHED;
            PG8_STAGE(PG8_SB(0, 1), b2 + hstep, voffB);
            PG8_WAIT_V(6); PG8_BAR; PG8_MMA(1, 1, At, B1); PG8_BAR;
            PG8_LDB(B0, 1, 0); PG8_SCHED; PG8_LDA(At, 1, 0); PG8_STAGE(PG8_SA(0, 1), a2 + hstep, voffA);
            PG8_WAIT_L(8); PG8_BAR; PG8_WAIT_L(0); PG8_MMA(0, 0, At, B0); PG8_BAR; PG8_SCHED;
            PG8_LDB(B1, 1, 1); PG8_STAGE(PG8_SB(1, 0), b3, voffB);
            PG8_BAR; PG8_WAIT_L(0); PG8_MMA(0, 1, At, B1); PG8_BAR;
            PG8_LDA(At, 1, 1); PG8_STAGE(PG8_SA(1, 0), a3, voffA);
            PG8_BAR; PG8_WAIT_L(0); PG8_MMA(1, 0, At, B0); PG8_BAR; PG8_SCHED;
            PG8_STAGE(PG8_SB(1, 1), b3 + hstep, voffB);
            PG8_WAIT_V(6); PG8_BAR; PG8_MMA(1, 1, At, B1); PG8_BAR;
            }
        }
        if constexpr (ALIGN_EPI) { if (wr == 0) PG8_BAR; }
        if constexpr (!Epi::AFTER_DRAIN) { E(acc, cur, wr, wc, fr, fq); S.done(cur); }
        if (!has_next) break;
#pragma unroll
        for (int a = 0; a < 2; ++a)
#pragma unroll
            for (int b = 0; b < 2; ++b)
#pragma unroll
                for (int m = 0; m < 4; ++m)
#pragma unroll
                    for (int n = 0; n < 2; ++n) acc[a][b][m][n] = (f32x4){0.f, 0.f, 0.f, 0.f};
        cur = nxt; cA = nA; cB = nB; ++ui;
        if constexpr (ALIGN_EPI) { if (wr == 1) PG8_BAR; }
    }
    PG8_WAIT_V(0);
    if constexpr (!ALIGN_EPI) { if (wr == 0) PG8_BAR; }
    PG8_BAR;
    if constexpr (Epi::AFTER_DRAIN) { E.fused(acc, cur, wr, wc, fr, fq, lds, wid, lane); S.done(cur); }
#undef PG8_SA
#undef PG8_SB
#undef PG8_STAGE
#undef PG8_LDA
#undef PG8_LDB
#undef PG8_MMA
#undef PG8_WAIT_V
#undef PG8_WAIT_L
#undef PG8_BAR
#undef PG8_SCHED
}
}

typedef unsigned short bf16;
typedef float f32x4 __attribute__((ext_vector_type(4)));
typedef float f32x2 __attribute__((ext_vector_type(2)));
typedef unsigned u32x4 __attribute__((ext_vector_type(4)));
typedef unsigned u32x2 __attribute__((ext_vector_type(2)));

#ifndef MK_MULTI
#define MK_MULTI 0
#endif

constexpr int Bn = 8, S = 4096, T = Bn * S, D = 1024, FF = 2816, DEPTH = 4;
constexpr float EPS = 1e-6f;
constexpr int GDN_NPAD = 4352, NSA_NPAD = 2816;
constexpr int LDS_BYTES = 147456;
constexpr size_t MiB = 1u << 20;
constexpr size_t WS_WGU = 1 * MiB;
constexpr size_t WS_WDN = WS_WGU + 88 * MiB;
constexpr size_t WS_WGI = WS_WDN + 44 * MiB;
constexpr size_t WS_WGO = WS_WGI + 17 * MiB;
constexpr size_t WS_WSI = WS_WGO + 4 * MiB;
constexpr size_t WS_WSO = WS_WSI + 6 * MiB;
constexpr size_t WS_WNI = WS_WSO + 2 * MiB;
constexpr size_t WS_WNO = WS_WNI + 6 * MiB;
constexpr size_t WS_WC1 = WS_WNO + 2 * MiB;
constexpr size_t WS_TAB = WS_WC1 + 2 * MiB;
constexpr size_t WS_HN  = 184 * MiB;
constexpr size_t WS_R   = WS_HN + 64 * MiB;
constexpr size_t WS_O32 = WS_R + 256 * MiB;
constexpr size_t WS_SM  = WS_O32 + 128 * MiB;
constexpr size_t WS_AB  = WS_SM;
constexpr size_t WS_GT  = WS_SM + 2 * MiB;
constexpr size_t WS_BP  = WS_SM + 8 * MiB;
constexpr size_t WS_END = WS_SM + 9 * MiB;
static_assert(WS_TAB + 8 * MiB <= WS_HN, "ws map");

__device__ __forceinline__ float bf2f(unsigned v) { return __uint_as_float(v << 16); }
__device__ __forceinline__ unsigned f2bf(float f) { unsigned u = __float_as_uint(f); return (u + 0x7fffu + ((u >> 16) & 1u)) >> 16; }
__device__ __forceinline__ unsigned pk2(float lo, float hi) { return f2bf(lo) | (f2bf(hi) << 16); }
#define MFMA32(a, b, c) __builtin_amdgcn_mfma_f32_32x32x16_bf16((a), (b), (c), 0, 0, 0)
typedef short bf16x8v __attribute__((ext_vector_type(8)));
typedef float f32x16 __attribute__((ext_vector_type(16)));
typedef __bf16 bf16v2 __attribute__((ext_vector_type(2)));
__device__ __forceinline__ unsigned pkbf(float a, float b) { f32x2 v = {a, b}; return __builtin_bit_cast(unsigned, __builtin_convertvector(v, bf16v2)); }
__device__ __forceinline__ int lane_opq() { int l = (int)__builtin_amdgcn_mbcnt_hi(~0u, __builtin_amdgcn_mbcnt_lo(~0u, 0u)); asm volatile("" : "+v"(l)); return l; }
__device__ __forceinline__ float xshfl(float v, int m) { return __int_as_float(__builtin_amdgcn_ds_bpermute((lane_opq() ^ m) << 2, __float_as_int(v))); }
__device__ __forceinline__ float xshfl_up(float v, int o) { return __int_as_float(__builtin_amdgcn_ds_bpermute((lane_opq() - o) << 2, __float_as_int(v))); }
__device__ __forceinline__ float wave_sum(float v) {
#pragma unroll
    for (int o = 1; o < 64; o <<= 1) v += xshfl(v, o);
    return v;
}
__device__ __forceinline__ float wave_max(float v) {
#pragma unroll
    for (int o = 1; o < 64; o <<= 1) v = fmaxf(v, xshfl(v, o));
    return v;
}
__device__ __forceinline__ float row_sum16(float v) {
    v += __uint_as_float((unsigned)__builtin_amdgcn_update_dpp(0, (int)__float_as_uint(v), 0x128, 0xf, 0xf, false));
    v += __uint_as_float((unsigned)__builtin_amdgcn_update_dpp(0, (int)__float_as_uint(v), 0x124, 0xf, 0xf, false));
    v += __uint_as_float((unsigned)__builtin_amdgcn_update_dpp(0, (int)__float_as_uint(v), 0x122, 0xf, 0xf, false));
    v += __uint_as_float((unsigned)__builtin_amdgcn_update_dpp(0, (int)__float_as_uint(v), 0x121, 0xf, 0xf, false));
    return v;
}
__device__ __forceinline__ float sigmoidf_(float x) { return 1.f / (1.f + __expf(-x)); }
__device__ __forceinline__ float siluf_(float x) { return x * __builtin_amdgcn_rcpf(1.f + __expf(-x)); }
#define LDS_BAR() do { asm volatile("s_waitcnt lgkmcnt(0)" ::: "memory"); __builtin_amdgcn_s_barrier(); asm volatile("" ::: "memory"); } while (0)
#define WAVE_SYNC() do { asm volatile("s_waitcnt lgkmcnt(0)" ::: "memory"); __builtin_amdgcn_wave_barrier(); } while (0)

__device__ __forceinline__ float row_rstd(const float* ssq, size_t row) {
    const f32x4* p = (const f32x4*)(ssq + row * 16); const f32x4 a = p[0], b = p[1], c = p[2], d = p[3];
    const float t = ((a.x + a.y) + (a.z + a.w)) + ((b.x + b.y) + (b.z + b.w)) + ((c.x + c.y) + (c.z + c.w)) + ((d.x + d.y) + (d.z + d.w));
    return 1.f / sqrtf(t * (1.f / D) + EPS);
}
namespace pg8 {
struct EpiSwiGLU {
    static constexpr bool PERM = true, AFTER_DRAIN = false;
    bf16_t* O; const float* ssq;
    __device__ __forceinline__ void operator()(const f32x4 (&acc)[2][2][4][2], const Unit& u, int wr, int wc, int fr, int fq) const {
        const int row0 = u.pm * BM + wr * 64 + fr, col0 = u.pn * HALF + wc * 32 + 8 * fq;
#pragma unroll
        for (int ai = 0; ai < 2; ++ai)
#pragma unroll
            for (int m = 0; m < 4; ++m) {
                bf16_t* rowp = O + (size_t)(row0 + ai * HALF + m * 16) * FF + col0;
                const float rs = ssq[u.ord * 256 + wr * 64 + fr + ai * HALF + m * 16];
                float v[8];
#pragma unroll
                for (int n = 0; n < 2; ++n)
#pragma unroll
                    for (int j = 0; j < 4; ++j) { const float g = acc[ai][0][m][n][j] * rs, uu = acc[ai][1][m][n][j] * rs; v[n * 4 + j] = g * __builtin_amdgcn_rcpf(1.f + __expf(-g)) * uu; }
                u32x4 w; w.x = cvt_pk_bf16(v[0], v[1]); w.y = cvt_pk_bf16(v[2], v[3]); w.z = cvt_pk_bf16(v[4], v[5]); w.w = cvt_pk_bf16(v[6], v[7]);
                *(u32x4*)rowp = w;
            }
    }
};
template <int SC2> struct EpiResid {
    static constexpr bool PERM = true, AFTER_DRAIN = false;
    const float* base; float* out; bf16_t* HB; float* ssq;
    __device__ __forceinline__ void operator()(const f32x4 (&acc)[2][2][4][2], const Unit& u, int wr, int wc, int fr, int fq) const {
        constexpr float scale = 0.5f * SC2;
        const int row0 = u.pm * BM + wr * 64 + fr, col0 = u.pn * BM + wc * 32 + 8 * fq;
#pragma unroll
        for (int ai = 0; ai < 2; ++ai)
#pragma unroll
            for (int m = 0; m < 4; ++m) {
                const size_t off = (size_t)(row0 + ai * HALF + m * 16) * D + col0;
                float sq = 0.f;
#pragma unroll
                for (int bj = 0; bj < 2; ++bj) {
                    const f32x4 b0 = *(const f32x4*)(base + off + bj * HALF), b1 = *(const f32x4*)(base + off + bj * HALF + 4);
                    const f32x4 o0 = b0 + acc[ai][bj][m][0] * scale, o1 = b1 + acc[ai][bj][m][1] * scale;
                    *(f32x4*)(out + off + bj * HALF) = o0; *(f32x4*)(out + off + bj * HALF + 4) = o1;
                    { u32x4 w; w.x = cvt_pk_bf16(o0[0], o0[1]); w.y = cvt_pk_bf16(o0[2], o0[3]); w.z = cvt_pk_bf16(o1[0], o1[1]); w.w = cvt_pk_bf16(o1[2], o1[3]);
                        *(u32x4*)(HB + off + bj * HALF) = w;
                        sq += ((o0[0] * o0[0] + o0[1] * o0[1]) + (o0[2] * o0[2] + o0[3] * o0[3])) + ((o1[0] * o1[0] + o1[1] * o1[1]) + (o1[2] * o1[2] + o1[3] * o1[3])); }
                }
                { sq += xshfl(sq, 16); sq += xshfl(sq, 32); if (fq == 0) ssq[(size_t)(row0 + ai * HALF + m * 16) * 16 + u.pn * 4 + wc] = sq; }
                if (m == 3) asm volatile("" ::: "memory");
            }
    }
};
struct EpiProj {
    static constexpr bool PERM = true, AFTER_DRAIN = false;
    bf16_t* O; int ldc; int nmain; float* tail; int ldt; int nvalid; const float* ssq;
    __device__ __forceinline__ void operator()(const f32x4 (&acc)[2][2][4][2], const Unit& u, int wr, int wc, int fr, int fq) const {
        const int row0 = u.pm * BM + wr * 64 + fr, colt = u.pn * BM, col0 = colt + wc * 32 + 8 * fq;
        if (colt + BM <= nmain) {
#pragma unroll
            for (int ai = 0; ai < 2; ++ai)
#pragma unroll
                for (int m = 0; m < 4; ++m) {
                    bf16_t* rowp = O + (size_t)(row0 + ai * HALF + m * 16) * ldc + col0;
                    const float rs = ssq[u.ord * 256 + wr * 64 + fr + ai * HALF + m * 16];
#pragma unroll
                    for (int bj = 0; bj < 2; ++bj) { const f32x4 v0 = acc[ai][bj][m][0] * rs, v1 = acc[ai][bj][m][1] * rs;
                        u32x4 w; w.x = cvt_pk_bf16(v0[0], v0[1]); w.y = cvt_pk_bf16(v0[2], v0[3]); w.z = cvt_pk_bf16(v1[0], v1[1]); w.w = cvt_pk_bf16(v1[2], v1[3]);
                        *(u32x4*)(rowp + bj * HALF) = w; }
                }
        } else {
#pragma unroll
            for (int ai = 0; ai < 2; ++ai)
#pragma unroll
                for (int m = 0; m < 4; ++m) {
                    const size_t row = (size_t)(row0 + ai * HALF + m * 16);
                    const float rs = ssq[u.ord * 256 + wr * 64 + fr + ai * HALF + m * 16];
#pragma unroll
                    for (int bj = 0; bj < 2; ++bj)
#pragma unroll
                        for (int n = 0; n < 2; ++n)
#pragma unroll
                            for (int j = 0; j < 4; ++j) { const int col = col0 + bj * HALF + 4 * n + j; if (col >= nmain && col < nvalid) tail[row * ldt + (col - nmain)] = acc[ai][bj][m][n][j] * rs; }
                }
        }
    }
};
struct EpiF32 {
    static constexpr bool PERM = false, AFTER_DRAIN = false;
    float* C; int ldc;
    __device__ __forceinline__ void operator()(const f32x4 (&acc)[2][2][4][2], const Unit& u, int wr, int wc, int fr, int fq) const {
        const int row0 = u.pm * BM + wr * 64 + fr, col0 = u.pn * BM + wc * 32 + 4 * fq;
#pragma unroll
        for (int ai = 0; ai < 2; ++ai)
#pragma unroll
            for (int m = 0; m < 4; ++m) {
                float* rowp = C + (size_t)(row0 + ai * HALF + m * 16) * ldc + col0;
#pragma unroll
                for (int bj = 0; bj < 2; ++bj)
#pragma unroll
                    for (int n = 0; n < 2; ++n) *(f32x4*)(rowp + bj * HALF + n * 16) = acc[ai][bj][m][n];
            }
    }
};
}

template <class Sched>
__device__ __forceinline__ void rstd_table(float* tab, const float* ssq, const Sched& SO, int tid) {
    pg8::Unit u;
    int nu = 0; while (SO.next(nu, u)) ++nu;
    for (int k0 = 0; k0 < nu * 256; k0 += 512 * 3) {
        float t3[3];
#pragma unroll
        for (int k = 0; k < 3; ++k) { const int idx = k0 + 512 * k + tid; t3[k] = 0.f; if (idx < nu * 256) { SO.next(idx >> 8, u); t3[k] = row_rstd(ssq, (size_t)u.pm * 256 + (idx & 255)); } }
#pragma unroll
        for (int k = 0; k < 3; ++k) { const int idx = k0 + 512 * k + tid; if (idx < nu * 256) tab[idx] = t3[k]; }
    }
    __syncthreads();
}
__device__ __forceinline__ void xpose_item(const float* W, const float* nw, int K, int N, bf16* WT, int rowbase, float* scr, int k0, int n0, int lane) {
    if (n0 + 32 <= N && (N & 3) == 0) {
        f32x4 v[8];
#pragma unroll
        for (int i = 0; i < 8; ++i) { v[i] = *(const f32x4*)(W + (size_t)(k0 + 8 * i + (lane >> 3)) * N + n0 + 4 * (lane & 7)); if (nw) v[i] *= nw[k0 + 8 * i + (lane >> 3)]; }
#pragma unroll
        for (int i = 0; i < 8; ++i) { float* d = scr + (8 * i + (lane >> 3)) * 33 + 4 * (lane & 7); d[0] = v[i].x; d[1] = v[i].y; d[2] = v[i].z; d[3] = v[i].w; }
    } else {
#pragma unroll 8
        for (int i = 0; i < 32; ++i) { const int kk = 2 * i + (lane >> 5), n = n0 + (lane & 31); scr[kk * 33 + (lane & 31)] = n < N ? W[(size_t)(k0 + kk) * N + n] * (nw ? nw[k0 + kk] : 1.f) : 0.f; }
    }
    WAVE_SYNC();
    const int c = lane & 7;
#pragma unroll
    for (int j = 0; j < 4; ++j) { const int n = (lane >> 3) + 8 * j; const float* s = scr + (8 * c) * 33 + n;
        u32x4 o; o.x = pk2(s[0 * 33], s[1 * 33]); o.y = pk2(s[2 * 33], s[3 * 33]); o.z = pk2(s[4 * 33], s[5 * 33]); o.w = pk2(s[6 * 33], s[7 * 33]);
        *(u32x4*)(WT + (size_t)(rowbase + n) * K + k0 + 8 * c) = o; }
    WAVE_SYNC();
}
__device__ __forceinline__ void xpose_matrix(const float* W, const float* nw, int K, int N, int Npad, bf16* WT, int mode, float* scr, int gw, int NGW, int lane) {
    const int nblk = Npad / 32, nitems = (K / 64) * nblk;
    for (int it = gw; it < nitems; it += NGW) {
        const int kb = it / nblk, nb = it - kb * nblk, n0 = nb * 32;
        int rb = n0;
        if (mode == 1) rb = (n0 < FF) ? ((n0 >> 7) * 256 + (n0 & 127)) : ((((n0 - FF) >> 7) * 256) + 128 + ((n0 - FF) & 127));
        xpose_item(W, nw, K, N, WT, rb, scr, kb * 64, n0, lane);
    }
}

__device__ __forceinline__ void phase_norm(const float* h, const float* w, bf16* out, int gw, int NGW, int lane) {
    f32x4 wv[4];
#pragma unroll
    for (int j = 0; j < 4; ++j) wv[j] = ((const f32x4*)w)[64 * j + lane];
    for (int m = gw; m < T; m += NGW) {
        const f32x4* xr = (const f32x4*)(h + (size_t)m * D) + lane;
        f32x4 v[4]; float s = 0.f;
#pragma unroll
        for (int j = 0; j < 4; ++j) { v[j] = xr[64 * j]; s += (v[j].x * v[j].x + v[j].y * v[j].y) + (v[j].z * v[j].z + v[j].w * v[j].w); }
        const float rstd = 1.f / sqrtf(wave_sum(s) * (1.f / D) + EPS);
        u32x2* o8 = (u32x2*)(out + (size_t)m * D) + lane;
#pragma unroll
        for (int j = 0; j < 4; ++j) { u32x2 o; o.x = pk2(v[j].x * rstd * wv[j].x, v[j].y * rstd * wv[j].y); o.y = pk2(v[j].z * rstd * wv[j].z, v[j].w * rstd * wv[j].w); o8[64 * j] = o; }
    }
}

__device__ __forceinline__ void phase_gdn_scan(unsigned char* lds, const bf16* proj, const float* ab, const float* convw, const float* A_log, const float* dt_bias,
                                               float* o32, int vblk, int nblk, int tid, int wid, int lane) {
    float* qs = (float*)lds;
    float* ks = qs + 64 * 128;
    float* vs = ks + 64 * 128;
    float* al = vs + 64 * 32;
    float* be = al + 64;
    float* qk = be + 64;
    float* os = qk + 64;
    bf16* raw = (bf16*)(os + 64 * 32);
    const int e = tid >> 4, dl = tid & 15;
    for (int item = vblk; item < 256; item += nblk) {
        const int bh = (item & 7) + 8 * (item >> 5), es = (item >> 3) & 3, b = bh >> 3, h = bh & 7;
        const float Ah = __expf(A_log[h]), dtb = dt_bias[h];
        const int isk = (tid >> 4) & 1, cg = tid & 15, cv = tid & 3;
        const int colqk = isk * 1024 + h * 128 + cg * 8, colv = 2048 + h * 128 + es * 32 + cv * 8;
        f32x4 wq[4][2], wv[4][2];
#pragma unroll
        for (int j = 0; j < 4; ++j) { wq[j][0] = *(const f32x4*)(convw + j * 3072 + colqk); wq[j][1] = *(const f32x4*)(convw + j * 3072 + colqk + 4);
                                      wv[j][0] = *(const f32x4*)(convw + j * 3072 + colv);  wv[j][1] = *(const f32x4*)(convw + j * 3072 + colv + 4); }
        f32x2 S2[4];
#pragma unroll
        for (int i = 0; i < 4; ++i) S2[i] = (f32x2){0.f, 0.f};
        u32x4 pre[5];
#define GDN_PREFETCH(T0) do { _Pragma("unroll") for (int k_ = 0; k_ < 5; ++k_) { const int idx_ = tid + 512 * k_; const int row_ = idx_ / 36, c_ = idx_ - row_ * 36; const int ts_ = (T0) - 3 + row_; \
            const int col_ = c_ < 16 ? h * 128 + c_ * 8 : (c_ < 32 ? 1024 + h * 128 + (c_ - 16) * 8 : 2048 + h * 128 + es * 32 + (c_ - 32) * 8); \
            pre[k_] = (u32x4){0u, 0u, 0u, 0u}; if (idx_ < 67 * 36 && ts_ >= 0) pre[k_] = *(const u32x4*)(proj + (size_t)(b * S + ts_) * 4096 + col_); } } while (0)
#define GDN_PARK() do { _Pragma("unroll") for (int k_ = 0; k_ < 5; ++k_) { const int idx_ = tid + 512 * k_; if (idx_ < 67 * 36) *(u32x4*)(raw + idx_ * 8) = pre[k_]; } } while (0)
#define GDN_CONV8(ROW0, C8, W, OUT) do { _Pragma("unroll") for (int i_ = 0; i_ < 8; ++i_) OUT[i_] = 0.f; _Pragma("unroll") for (int j_ = 0; j_ < 4; ++j_) { const u32x4 xv_ = *(const u32x4*)(raw + ((ROW0) + j_) * 288 + (C8) * 8); \
            OUT[0] += bf2f(xv_.x & 0xffffu) * W[j_][0].x; OUT[1] += bf2f(xv_.x >> 16) * W[j_][0].y; OUT[2] += bf2f(xv_.y & 0xffffu) * W[j_][0].z; OUT[3] += bf2f(xv_.y >> 16) * W[j_][0].w; \
            OUT[4] += bf2f(xv_.z & 0xffffu) * W[j_][1].x; OUT[5] += bf2f(xv_.z >> 16) * W[j_][1].y; OUT[6] += bf2f(xv_.w & 0xffffu) * W[j_][1].z; OUT[7] += bf2f(xv_.w >> 16) * W[j_][1].w; } \
            _Pragma("unroll") for (int i_ = 0; i_ < 8; ++i_) OUT[i_] = siluf_(OUT[i_]); } while (0)
#define GDN_CONVNORM(T0) do { \
            _Pragma("unroll") for (int it_ = 0; it_ < 4; ++it_) { const int tok_ = it_ * 16 + (tid >> 5); float y_[8]; GDN_CONV8(tok_, isk * 16 + cg, wq, y_); \
                float ss_ = (y_[0] * y_[0] + y_[1] * y_[1]) + (y_[2] * y_[2] + y_[3] * y_[3]) + (y_[4] * y_[4] + y_[5] * y_[5]) + (y_[6] * y_[6] + y_[7] * y_[7]); \
                ss_ = row_sum16(ss_); const float sc_ = (1.f / sqrtf(ss_ + EPS)) * (isk ? 1.f : 0.08838834764831845f); \
                float* d_ = (isk ? ks : qs) + tok_ * 128 + cg * 8; \
                _Pragma("unroll") for (int i_ = 0; i_ < 8; ++i_) y_[i_] *= sc_; \
                *(f32x4*)d_ = (f32x4){y_[0], y_[1], y_[2], y_[3]}; *(f32x4*)(d_ + 4) = (f32x4){y_[4], y_[5], y_[6], y_[7]}; \
                float dq_ = 0.f; _Pragma("unroll") for (int i_ = 0; i_ < 8; ++i_) dq_ += y_[i_] * xshfl(y_[i_], 16); \
                dq_ = row_sum16(dq_); if (isk == 0 && cg == 0) qk[tok_] = dq_; } \
            if (tid < 256) { const int tok_ = tid >> 2; float y_[8]; GDN_CONV8(tok_, 32 + cv, wv, y_); float* d_ = vs + tok_ * 32 + cv * 8; \
                *(f32x4*)d_ = (f32x4){y_[0], y_[1], y_[2], y_[3]}; *(f32x4*)(d_ + 4) = (f32x4){y_[4], y_[5], y_[6], y_[7]}; } \
            if (tid < 64) { const size_t tg_ = (size_t)(b * S + (T0) + tid); const float a_ = ab[tg_ * 16 + h] + dtb, bb_ = ab[tg_ * 16 + 8 + h]; \
                const float sp_ = a_ > 20.f ? a_ : __logf(1.f + __expf(a_)); al[tid] = __expf(-Ah * sp_); be[tid] = sigmoidf_(bb_); } } while (0)
        __syncthreads();
        GDN_PREFETCH(0); GDN_PARK();
        __syncthreads();
        GDN_CONVNORM(0);
        __syncthreads();
        for (int chunk = 0; chunk < S / 64; ++chunk) {
            const int t0 = chunk * 64;
            const bool more = chunk + 1 < S / 64;
            if (more) GDN_PREFETCH(t0 + 64);
            {
                const float* kp = ks + dl * 8; const float* qp = qs + dl * 8; const float* vp = vs + e;
                f32x4 nk0 = *(const f32x4*)kp, nk1 = *(const f32x4*)(kp + 4), nq0 = *(const f32x4*)qp, nq1 = *(const f32x4*)(qp + 4);
                float nv = vp[0], na = al[0], nb = be[0], nqk = qk[0];
                for (int t16 = 0; t16 < 4; ++t16) {
                    float ok = 0.f;
#pragma unroll 4
                    for (int i = 0; i < 16; ++i) {
                        const int tt = t16 * 16 + i, tn = (tt + 1) & 63;
                        const f32x2 K0 = {nk0.x, nk0.y}, K1 = {nk0.z, nk0.w}, K2 = {nk1.x, nk1.y}, K3 = {nk1.z, nk1.w};
                        const f32x2 Q0 = {nq0.x, nq0.y}, Q1 = {nq0.z, nq0.w}, Q2 = {nq1.x, nq1.y}, Q3 = {nq1.z, nq1.w};
                        const float v = nv, a = na, bt = nb, qkt = nqk;
                        nk0 = *(const f32x4*)(kp + tn * 128); nk1 = *(const f32x4*)(kp + tn * 128 + 4); nq0 = *(const f32x4*)(qp + tn * 128); nq1 = *(const f32x4*)(qp + tn * 128 + 4);
                        nv = vp[tn * 32]; na = al[tn]; nb = be[tn]; nqk = qk[tn];
                        f32x2 pa = K0 * S2[0], pb = K2 * S2[2], qa = Q0 * S2[0], qb = Q2 * S2[2];
                        pa = K1 * S2[1] + pa; pb = K3 * S2[3] + pb; qa = Q1 * S2[1] + qa; qb = Q3 * S2[3] + qb;
                        pa += pb; qa += qb;
                        float p = pa.x + pa.y, qS = qa.x + qa.y;
                        p = row_sum16(p); qS = row_sum16(qS);
                        const float vn = bt * (v - a * p);
                        const float o = a * qS + qkt * vn;
                        const f32x2 vn2 = {vn, vn}, a2 = {a, a};
                        S2[0] = S2[0] * a2 + K0 * vn2; S2[1] = S2[1] * a2 + K1 * vn2; S2[2] = S2[2] * a2 + K2 * vn2; S2[3] = S2[3] * a2 + K3 * vn2;
                        ok = (i == dl) ? o : ok;
                    }
                    os[(t16 * 16 + dl) * 32 + e] = ok;
                }
            }
            __syncthreads();
            { const int tok = tid >> 3, c4 = tid & 7;
              *(f32x4*)(o32 + (size_t)(b * S + t0 + tok) * D + h * 128 + es * 32 + c4 * 4) = *(const f32x4*)(os + tok * 32 + c4 * 4); }
            if (more) {
                GDN_PARK();
                __syncthreads();
                GDN_CONVNORM(t0 + 64);
            }
            __syncthreads();
        }
#undef GDN_PREFETCH
#undef GDN_PARK
#undef GDN_CONV8
#undef GDN_CONVNORM
    }
}

constexpr size_t WS_HALO = WS_END;
constexpr size_t WS_GL = WS_END + 10 * MiB;
constexpr size_t WS_SS = WS_GL + 1 * MiB;
constexpr size_t WS_END2 = WS_SS + 26 * MiB;

__device__ __forceinline__ void phase_gdn_halo(const bf16* proj, bf16* halo, int gtid, int NT) {
    for (int idx = gtid; idx < Bn * 64 * 3 * 384; idx += NT) {
        const int c = idx % 384, r3 = (idx / 384) % 3, bn = idx / (384 * 3), n = bn & 63, b = bn >> 6;
        u32x4 v = {0u, 0u, 0u, 0u};
        if (n > 0) v = *(const u32x4*)(proj + (size_t)(b * S + 64 * n - 3 + r3) * 4096 + c * 8);
        *(u32x4*)(halo + (size_t)(bn * 3 + r3) * 3072 + c * 8) = v;
    }
}

constexpr int GP_RAW = 0, GP_QB = 51456, GP_KB = GP_QB + 17408, GP_VB = GP_KB + 17408, GP_AM = GP_VB + 16384, GP_GC = GP_AM + 17408, GP_W = GP_GC + 1024;
__device__ __forceinline__ void phase_gdn_prep(unsigned char* lds, bf16* proj, const bf16* halo, const float* ab, const float* convw, const float* A_log, const float* dt_bias,
                                               bf16* KT, bf16* AT, float* GL, int vblk, int nblk, int tid, int wid, int lane) {
    bf16* raw = (bf16*)(lds + GP_RAW);
    bf16* wimg = (bf16*)(lds + GP_W);
    unsigned char* qb = lds + GP_QB;
    unsigned char* kb = lds + GP_KB;
    bf16* vb = (bf16*)(lds + GP_VB);
    float* Am = (float*)(lds + GP_AM);
    float* gcs = (float*)(lds + GP_GC);
    float* bes = gcs + 64;
    const int r = lane & 31, hh = lane >> 5;
    for (int item = vblk; item < Bn * 8 * 64; item += nblk) {
        const int n = item & 63, h = (item >> 6) & 7, b = item >> 9;
        const size_t tok0 = (size_t)b * S + 64 * n;
        LDS_BAR();
#define GP_RAWLOAD(ITEM, T0, NT) do { const int n_ = (ITEM) & 63, h_ = ((ITEM) >> 6) & 7, b_ = (ITEM) >> 9; const size_t tk0_ = (size_t)b_ * S + 64 * n_; \
        for (int idx = (T0); idx < 67 * 48; idx += (NT)) { const int row = idx / 48, c = idx - row * 48; \
            const int col = c < 16 ? h_ * 128 + c * 8 : (c < 32 ? 1024 + h_ * 128 + (c - 16) * 8 : 2048 + h_ * 128 + (c - 32) * 8); \
            u32x4 v; if (row < 3) v = *(const u32x4*)(halo + (size_t)((b_ * 64 + n_) * 3 + row) * 3072 + col); else v = *(const u32x4*)(proj + (tk0_ + row - 3) * 4096 + col); \
            *(u32x4*)(raw + row * 384 + c * 8) = v; } } while (0)
        if (item == vblk) GP_RAWLOAD(item, tid, 512);
        if (tid < 64) {
            const float a = ab[(tok0 + tid) * 16 + h] + dt_bias[h], bb = ab[(tok0 + tid) * 16 + 8 + h];
            const float sp = a > 20.f ? a : __logf(1.f + __expf(a));
            float g = -__expf(A_log[h]) * sp;
#pragma unroll
            for (int o = 1; o < 64; o <<= 1) { const float t_ = xshfl_up(g, o); if (lane >= o) g += t_; }
            const float be_ = sigmoidf_(bb);
            gcs[tid] = g; bes[tid] = be_; gcs[128 + tid] = be_; gcs[192 + tid] = be_ * __expf(g);
        }
        LDS_BAR();
        {
            const int isk = (tid >> 4) & 1, cg = tid & 15;
            const int colqk = isk * 1024 + h * 128 + cg * 8, colv = 2048 + h * 128 + cg * 8;
#define GP_CONV8(ROW0, C8, COL, OUT) do { _Pragma("unroll") for (int i_ = 0; i_ < 8; ++i_) OUT[i_] = 0.f; _Pragma("unroll") for (int j_ = 0; j_ < 4; ++j_) { const u32x4 xv_ = *(const u32x4*)(raw + ((ROW0) + j_) * 384 + (C8) * 8); \
            const f32x4 w0_ = *(const f32x4*)(convw + j_ * 3072 + (COL)), w1_ = *(const f32x4*)(convw + j_ * 3072 + (COL) + 4); \
            OUT[0] += bf2f(xv_.x & 0xffffu) * w0_.x; OUT[1] += bf2f(xv_.x >> 16) * w0_.y; OUT[2] += bf2f(xv_.y & 0xffffu) * w0_.z; OUT[3] += bf2f(xv_.y >> 16) * w0_.w; \
            OUT[4] += bf2f(xv_.z & 0xffffu) * w1_.x; OUT[5] += bf2f(xv_.z >> 16) * w1_.y; OUT[6] += bf2f(xv_.w & 0xffffu) * w1_.z; OUT[7] += bf2f(xv_.w >> 16) * w1_.w; } \
            _Pragma("unroll") for (int i_ = 0; i_ < 8; ++i_) OUT[i_] = siluf_(OUT[i_]); } while (0)
#pragma unroll 1
            for (int it = 0; it < 4; ++it) {
                const int tk = it * 16 + (tid >> 5);
                float y[8]; GP_CONV8(tk, isk * 16 + cg, colqk, y);
                float ss = (y[0] * y[0] + y[1] * y[1]) + (y[2] * y[2] + y[3] * y[3]) + (y[4] * y[4] + y[5] * y[5]) + (y[6] * y[6] + y[7] * y[7]);
                ss = row_sum16(ss);
                const float sc = (1.f / sqrtf(ss + EPS)) * (isk ? 1.f : 0.08838834764831845f);
                u32x4 w; w.x = pkbf(y[0] * sc, y[1] * sc); w.y = pkbf(y[2] * sc, y[3] * sc); w.z = pkbf(y[4] * sc, y[5] * sc); w.w = pkbf(y[6] * sc, y[7] * sc);
                *(u32x4*)((isk ? kb : qb) + tk * 272 + cg * 16) = w;
            }
#pragma unroll 1
            for (int it = 0; it < 2; ++it) {
                const int tk = it * 32 + (tid >> 4);
                float y[8]; GP_CONV8(tk, 32 + cg, colv, y);
                u32x4 w; w.x = pkbf(y[0], y[1]); w.y = pkbf(y[2], y[3]); w.z = pkbf(y[4], y[5]); w.w = pkbf(y[6], y[7]);
                *(u32x4*)(vb + tk * 128 + cg * 8) = w;
            }
#undef GP_CONV8
        }
        LDS_BAR();
        {
            const int prod = wid >> 2, tr = (wid >> 1) & 1, tc = wid & 1;
            f32x16 acc;
#pragma unroll
            for (int i = 0; i < 16; ++i) acc[i] = 0.f;
            if (tr >= tc) {
                const unsigned char* Ab = (prod ? qb : kb) + (32 * tr + r) * 272 + hh * 16;
                const unsigned char* Bb = kb + (32 * tc + r) * 272 + hh * 16;
#pragma unroll
                for (int ks = 0; ks < 8; ++ks) acc = MFMA32(*(const bf16x8v*)(Ab + ks * 32), *(const bf16x8v*)(Bb + ks * 32), acc);
            }
            const int j = 32 * tc + r; const float gj = gcs[j];
#pragma unroll
            for (int i_ = 0; i_ < 16; ++i_) {
                const int i = 32 * tr + (i_ & 3) + 8 * (i_ >> 2) + 4 * hh;
                const float dec = __expf(gcs[i] - gj);
                if (prod == 0) Am[i * 68 + j] = (j < i) ? bes[i] * acc[i_] * dec : 0.f;
                else AT[(size_t)item * 4096 + i * 64 + j] = (bf16)f2bf((j <= i) ? acc[i_] * dec : 0.f);
            }
        }
        LDS_BAR();
        int tid3 = tid; asm volatile("" : "+v"(tid3));
        if (tid3 < 256) {
            const int isw = tid3 >> 7, d = tid3 & 127;
            unsigned oam = GP_AM, orsc = GP_GC + 512 + isw * 256, ocol = (isw ? GP_KB : GP_VB) + d * 2;
            asm volatile("" : "+v"(oam), "+v"(orsc), "+v"(ocol));
            const float* Am_ = (const float*)(lds + oam); const float* rsc = (const float*)(lds + orsc); const unsigned char* col = lds + ocol;
            const int cstride = isw ? 272 : 256;
            float X[64];
#pragma clang loop unroll(full)
            for (int i = 0; i < 64; ++i) X[i] = 0.f;
#pragma clang loop unroll(full)
            for (int i = 0; i < 64; ++i) {
                f32x4 av = {0.f, 0.f, 0.f, 0.f};
#pragma clang loop unroll(full)
                for (int j4 = 0; j4 < 16; ++j4) { if (4 * j4 < i) { const f32x4 a4 = *(const f32x4*)(Am_ + i * 68 + 4 * j4);
                    const f32x4 x4 = {X[4 * j4], X[4 * j4 + 1], X[4 * j4 + 2], X[4 * j4 + 3]}; av += a4 * x4; } }
                X[i] = rsc[i] * bf2f(*(const bf16*)(col + i * cstride)) - ((av.x + av.y) + (av.z + av.w));
                asm volatile("" ::: "memory");
            }
            if (isw) {
#pragma unroll
                for (int i = 0; i < 64; ++i) wimg[i * 128 + d] = (bf16)f2bf(X[i]);
            } else {
                bf16* up = proj + (tok0 + (d >> 1)) * 4096 + 2048 + h * 128 + (d & 1) * 64;
#pragma unroll
                for (int i8 = 0; i8 < 8; ++i8) { u32x4 w; w.x = pkbf(X[8 * i8], X[8 * i8 + 1]); w.y = pkbf(X[8 * i8 + 2], X[8 * i8 + 3]); w.z = pkbf(X[8 * i8 + 4], X[8 * i8 + 5]); w.w = pkbf(X[8 * i8 + 6], X[8 * i8 + 7]);
                    *(u32x4*)(up + 8 * i8) = w; }
            }
        } else {
            if (tid3 < 384) {
                const int d = tid3 - 256; const float gl_ = gcs[63];
                bf16* kp = KT + (size_t)item * 8192 + d * 64;
#pragma unroll
                for (int i8 = 0; i8 < 8; ++i8) { float y[8];
#pragma unroll
                    for (int i = 0; i < 8; ++i) y[i] = bf2f(*(const bf16*)(kb + (8 * i8 + i) * 272 + d * 2)) * __expf(gl_ - gcs[8 * i8 + i]);
                    u32x4 w; w.x = pkbf(y[0], y[1]); w.y = pkbf(y[2], y[3]); w.z = pkbf(y[4], y[5]); w.w = pkbf(y[6], y[7]);
                    *(u32x4*)(kp + 8 * i8) = w; }
                if (d == 0) GL[item] = __expf(gl_);
            }
#pragma unroll
            for (int k = 0; k < 4; ++k) {
                const int pc = (tid3 - 256) + 256 * k, i = pc >> 4, c8 = pc & 15;
                const u32x4 v = *(const u32x4*)(qb + i * 272 + c8 * 16); const float eg = __expf(gcs[i]);
                u32x4 w; w.x = pkbf(bf2f(v.x & 0xffffu) * eg, bf2f(v.x >> 16) * eg); w.y = pkbf(bf2f(v.y & 0xffffu) * eg, bf2f(v.y >> 16) * eg);
                w.z = pkbf(bf2f(v.z & 0xffffu) * eg, bf2f(v.z >> 16) * eg); w.w = pkbf(bf2f(v.w & 0xffffu) * eg, bf2f(v.w >> 16) * eg);
                *(u32x4*)(proj + (tok0 + i) * 4096 + h * 128 + c8 * 8) = w;
            }
            if (item + nblk < Bn * 8 * 64) GP_RAWLOAD(item + nblk, tid3 - 256, 256);
        }
        LDS_BAR();
#pragma unroll
        for (int k = 0; k < 2; ++k) { const int pc = tid + 512 * k, i = pc >> 4, c8 = pc & 15;
            *(u32x4*)(proj + (tok0 + i) * 4096 + 1024 + h * 128 + c8 * 8) = *(const u32x4*)(wimg + i * 128 + c8 * 8); }
    }
}

#undef GP_RAWLOAD
__device__ __forceinline__ void phase_gdn_scan2(unsigned char* lds, const bf16* proj, const bf16* KT, const bf16* AT, const float* GL, bf16* o16, int vblk, int nblk, int tid, int wid, int lane) {
    unsigned char* Sl = lds;
    unsigned char* Vl = lds + 8704;
    const int r = lane & 31, hh = lane >> 5;
    for (int item = vblk; item < 256; item += nblk) {
        const int bh = (item & 7) + 8 * (item >> 5), es = (item >> 3) & 3, b = bh >> 3, h = bh & 7;
        __syncthreads();
        for (int i = tid; i < 8704 / 4; i += 512) ((unsigned*)Sl)[i] = 0u;
        f32x16 Sacc;
#pragma unroll
        for (int i = 0; i < 16; ++i) Sacc[i] = 0.f;
        const int rt = wid & 1, dt = wid & 3;
        bf16x8v A8n[8]; bf16x8v A4n[4]; u32x2 uun[4]; float gln = 1.f;
#define GS_LOAD(N) do { const size_t tk_ = (size_t)b * S + 64 * (N); const int it_ = bh * 64 + (N); \
            if (wid < 2) { const bf16* wp_ = proj + (tk_ + 32 * rt + r) * 4096 + 1024 + h * 128 + 8 * hh; \
                _Pragma("unroll") for (int ks = 0; ks < 8; ++ks) A8n[ks] = *(const bf16x8v*)(wp_ + 16 * ks); \
                const int c_ = es * 32 + r; const bf16* up_ = proj + (tk_ + (c_ >> 1)) * 4096 + 2048 + h * 128 + (c_ & 1) * 64 + 32 * rt + 4 * hh; \
                _Pragma("unroll") for (int g = 0; g < 4; ++g) uun[g] = *(const u32x2*)(up_ + 8 * g); } \
            else if (wid < 4) { const bf16* qp_ = proj + (tk_ + 32 * rt + r) * 4096 + h * 128 + 8 * hh; \
                _Pragma("unroll") for (int ks = 0; ks < 8; ++ks) A8n[ks] = *(const bf16x8v*)(qp_ + 16 * ks); \
                const bf16* ap_ = AT + (size_t)it_ * 4096 + (32 * rt + r) * 64 + 8 * hh; \
                _Pragma("unroll") for (int sx = 0; sx < 4; ++sx) A4n[sx] = *(const bf16x8v*)(ap_ + 16 * sx); } \
            else { const bf16* kp_ = KT + (size_t)it_ * 8192 + (32 * dt + r) * 64 + 8 * hh; \
                _Pragma("unroll") for (int sx = 0; sx < 4; ++sx) A4n[sx] = *(const bf16x8v*)(kp_ + 16 * sx); \
                gln = GL[it_]; } } while (0)
        GS_LOAD(0);
        for (int n = 0; n < 64; ++n) {
            const size_t tok0 = (size_t)b * S + 64 * n;
            bf16x8v A8[8]; bf16x8v A4[4]; u32x2 uu[4]; const float gl = gln;
#pragma unroll
            for (int ks = 0; ks < 8; ++ks) A8[ks] = A8n[ks];
#pragma unroll
            for (int sx = 0; sx < 4; ++sx) { A4[sx] = A4n[sx]; uu[sx] = uun[sx]; }
            if (n + 1 < 64) GS_LOAD(n + 1);
            LDS_BAR();
            f32x16 acc;
#pragma unroll
            for (int i = 0; i < 16; ++i) acc[i] = 0.f;
            if (wid < 4) {
#pragma unroll
                for (int ks = 0; ks < 8; ++ks) acc = MFMA32(A8[ks], *(const bf16x8v*)(Sl + r * 272 + ks * 32 + hh * 16), acc);
                if (wid < 2) {
#pragma unroll
                    for (int g = 0; g < 4; ++g) {
                        u32x2 w; w.x = pkbf(bf2f(uu[g].x & 0xffffu) - acc[4 * g], bf2f(uu[g].x >> 16) - acc[4 * g + 1]);
                        w.y = pkbf(bf2f(uu[g].y & 0xffffu) - acc[4 * g + 2], bf2f(uu[g].y >> 16) - acc[4 * g + 3]);
                        *(u32x2*)(Vl + r * 144 + (32 * rt + 8 * g + 4 * hh) * 2) = w;
                    }
                }
            }
            LDS_BAR();
            if (wid >= 2 && wid < 4) {
#pragma unroll
                for (int sx = 0; sx < 4; ++sx) acc = MFMA32(A4[sx], *(const bf16x8v*)(Vl + r * 144 + sx * 32 + hh * 16), acc);
                unsigned char* Ol = lds + 13312 + (wid - 2) * 2560;
#pragma unroll
                for (int i = 0; i < 16; ++i) *(bf16*)(Ol + ((i & 3) + 8 * (i >> 2) + 4 * hh) * 80 + r * 2) = (bf16)f2bf(acc[i]);
                WAVE_SYNC();
#pragma unroll
                for (int k = 0; k < 2; ++k) { const int pc = lane + 64 * k, trow = pc >> 2, c4 = pc & 3;
                    *(u32x4*)(o16 + (tok0 + 32 * rt + trow) * D + h * 128 + es * 32 + c4 * 8) = *(const u32x4*)(Ol + trow * 80 + c4 * 16); }
                WAVE_SYNC();
            } else if (wid >= 4) {
#pragma unroll
                for (int i = 0; i < 16; ++i) Sacc[i] *= gl;
#pragma unroll
                for (int sx = 0; sx < 4; ++sx) Sacc = MFMA32(A4[sx], *(const bf16x8v*)(Vl + r * 144 + sx * 32 + hh * 16), Sacc);
#pragma unroll
                for (int g = 0; g < 4; ++g) { u32x2 w; w.x = pkbf(Sacc[4 * g], Sacc[4 * g + 1]); w.y = pkbf(Sacc[4 * g + 2], Sacc[4 * g + 3]);
                    *(u32x2*)(Sl + r * 272 + (32 * dt + 8 * g + 4 * hh) * 2) = w; }
            }
        }
    }
}

#undef GS_LOAD
__device__ __forceinline__ void phase_gdn_post(const bf16* o16, const bf16* proj, const float* onorm, bf16* hn, int gw, int NGW, int lane) {
    const int l16 = lane & 15;
    float wv[8];
#pragma unroll
    for (int j = 0; j < 8; ++j) wv[j] = onorm[8 * l16 + j];
    for (int m = 2 * gw; m < T; m += 2 * NGW) {
        u32x4 xo[2][2], gg[2][2];
#pragma unroll
        for (int tk = 0; tk < 2; ++tk)
#pragma unroll
            for (int pt = 0; pt < 2; ++pt) { xo[tk][pt] = *(const u32x4*)(o16 + (size_t)(m + tk) * D + pt * 512 + lane * 8); gg[tk][pt] = *(const u32x4*)(proj + (size_t)(m + tk) * 4096 + 3072 + pt * 512 + lane * 8); }
#pragma unroll
        for (int tk = 0; tk < 2; ++tk)
#pragma unroll
            for (int pt = 0; pt < 2; ++pt) {
                const u32x4 xv = xo[tk][pt], gv = gg[tk][pt];
                float v[8] = {bf2f(xv.x & 0xffffu), bf2f(xv.x >> 16), bf2f(xv.y & 0xffffu), bf2f(xv.y >> 16), bf2f(xv.z & 0xffffu), bf2f(xv.z >> 16), bf2f(xv.w & 0xffffu), bf2f(xv.w >> 16)};
                const float g[8] = {bf2f(gv.x & 0xffffu), bf2f(gv.x >> 16), bf2f(gv.y & 0xffffu), bf2f(gv.y >> 16), bf2f(gv.z & 0xffffu), bf2f(gv.z >> 16), bf2f(gv.w & 0xffffu), bf2f(gv.w >> 16)};
                float sq = ((v[0] * v[0] + v[1] * v[1]) + (v[2] * v[2] + v[3] * v[3])) + ((v[4] * v[4] + v[5] * v[5]) + (v[6] * v[6] + v[7] * v[7]));
                sq = row_sum16(sq);
                const float rstd = 1.f / sqrtf(sq * (1.f / 128.f) + EPS);
#pragma unroll
                for (int j = 0; j < 8; ++j) v[j] = v[j] * rstd * wv[j] * siluf_(g[j]);
                u32x4 w; w.x = pkbf(v[0], v[1]); w.y = pkbf(v[2], v[3]); w.z = pkbf(v[4], v[5]); w.w = pkbf(v[6], v[7]);
                *(u32x4*)(hn + (size_t)(m + tk) * D + pt * 512 + lane * 8) = w;
            }
    }
}
__device__ __forceinline__ void phase_sc_post(const bf16* proj, const float* cw, bf16* hn, int gtid, int NT) {
    const int c8 = (gtid & 127) * 8;
    f32x4 w0[3], w1[3];
#pragma unroll
    for (int j = 0; j < 3; ++j) { w0[j] = *(const f32x4*)(cw + j * 1024 + c8); w1[j] = *(const f32x4*)(cw + j * 1024 + c8 + 4); }
    for (int idx = gtid; idx < T * 128; idx += 2 * NT) {
        u32x4 cv[2][3], xv[2][3], bv[2];
#pragma unroll
        for (int q = 0; q < 2; ++q) {
            const int id = idx + q * NT, m = id >> 7, s = m & (S - 1);
#pragma unroll
            for (int j = 0; j < 3; ++j) { cv[q][j] = (u32x4){0u, 0u, 0u, 0u}; xv[q][j] = (u32x4){0u, 0u, 0u, 0u};
                if (id < T * 128 && s - 2 + j >= 0) { const bf16* pr = proj + (size_t)(m - 2 + j) * 3072; cv[q][j] = *(const u32x4*)(pr + 1024 + c8); xv[q][j] = *(const u32x4*)(pr + 2048 + c8); } }
            bv[q] = (u32x4){0u, 0u, 0u, 0u};
            if (id < T * 128) bv[q] = *(const u32x4*)(proj + (size_t)m * 3072 + c8);
        }
#pragma unroll
        for (int q = 0; q < 2; ++q) {
            const int id = idx + q * NT, m = id >> 7;
            if (id >= T * 128) break;
            float y[8];
#pragma unroll
            for (int i = 0; i < 8; ++i) y[i] = 0.f;
#pragma unroll
            for (int j = 0; j < 3; ++j) {
                const u32x4 c = cv[q][j], x = xv[q][j];
                y[0] += w0[j].x * bf2f(c.x & 0xffffu) * bf2f(x.x & 0xffffu); y[1] += w0[j].y * bf2f(c.x >> 16) * bf2f(x.x >> 16);
                y[2] += w0[j].z * bf2f(c.y & 0xffffu) * bf2f(x.y & 0xffffu); y[3] += w0[j].w * bf2f(c.y >> 16) * bf2f(x.y >> 16);
                y[4] += w1[j].x * bf2f(c.z & 0xffffu) * bf2f(x.z & 0xffffu); y[5] += w1[j].y * bf2f(c.z >> 16) * bf2f(x.z >> 16);
                y[6] += w1[j].z * bf2f(c.w & 0xffffu) * bf2f(x.w & 0xffffu); y[7] += w1[j].w * bf2f(c.w >> 16) * bf2f(x.w >> 16);
            }
            const u32x4 b = bv[q];
            u32x4 o;
            o.x = pkbf(y[0] * bf2f(b.x & 0xffffu), y[1] * bf2f(b.x >> 16)); o.y = pkbf(y[2] * bf2f(b.y & 0xffffu), y[3] * bf2f(b.y >> 16));
            o.z = pkbf(y[4] * bf2f(b.z & 0xffffu), y[5] * bf2f(b.z >> 16)); o.w = pkbf(y[6] * bf2f(b.w & 0xffffu), y[7] * bf2f(b.w >> 16));
            *(u32x4*)(hn + (size_t)m * D + c8) = o;
        }
    }
}
__device__ __forceinline__ void phase_nsa_post(unsigned char* lds, const bf16* proj, const float* qnorm, const float* knorm, const f32x2* tab,
                                               bf16* QN, bf16* KS, bf16* KW, bf16* KCH, bf16* VCH, bf16* VST, bf16* VWT, int gw, int NGW, int wid, int lane) {
    {
        bf16* tile = (bf16*)lds + wid * (64 * 72);
        const int c8 = lane & 7, r8 = lane >> 3;
        for (int item = gw; item < 2 * 32 * 64; item += NGW) {
            const int st = item & 63, bh = (item >> 6) & 31, which = item >> 11, b = bh >> 2, hk = bh & 3;
            const bf16* src = proj + ((size_t)b * S + st * 64 + r8) * 2560 + (which ? 2304 : 1792) + hk * 64 + c8 * 8;
            u32x4 v[8];
#pragma unroll
            for (int i = 0; i < 8; ++i) v[i] = *(const u32x4*)(src + (size_t)(8 * i) * 2560);
#pragma unroll
            for (int i = 0; i < 8; ++i) *(u32x4*)(tile + (8 * i + r8) * 72 + c8 * 8) = v[i];
            WAVE_SYNC();
            bf16* dst = (which ? VWT : VST) + (size_t)bh * 64 * S + st * 64 + c8 * 8;
#pragma unroll
            for (int i = 0; i < 8; ++i) {
                const bf16* tp = tile + (8 * c8) * 72 + 8 * i + r8;
                u32x4 w; w.x = (unsigned)tp[0] | ((unsigned)tp[72] << 16); w.y = (unsigned)tp[144] | ((unsigned)tp[216] << 16);
                w.z = (unsigned)tp[288] | ((unsigned)tp[360] << 16); w.w = (unsigned)tp[432] | ((unsigned)tp[504] << 16);
                *(u32x4*)(dst + (size_t)(8 * i + r8) * S) = w;
            }
            WAVE_SYNC();
        }
    }
    const int l8 = lane & 7, hsel = lane >> 3, lo32 = lane < 32;
    float qw8[8], kw8[8];
#pragma unroll
    for (int j = 0; j < 8; ++j) { qw8[j] = qnorm[8 * l8 + j]; kw8[j] = knorm[(lo32 ? 64 : 128) + 8 * l8 + j]; }
#define NP_UNPACK(V, X) do { X[0] = bf2f(V.x & 0xffffu); X[1] = bf2f(V.x >> 16); X[2] = bf2f(V.y & 0xffffu); X[3] = bf2f(V.y >> 16); X[4] = bf2f(V.z & 0xffffu); X[5] = bf2f(V.z >> 16); X[6] = bf2f(V.w & 0xffffu); X[7] = bf2f(V.w >> 16); } while (0)
#define NP_RSTD8(X, R) do { float ss_ = (X[0] * X[0] + X[1] * X[1]) + (X[2] * X[2] + X[3] * X[3]) + (X[4] * X[4] + X[5] * X[5]) + (X[6] * X[6] + X[7] * X[7]); \
        ss_ += xshfl(ss_, 1); ss_ += xshfl(ss_, 2); ss_ += xshfl(ss_, 4); R = 1.f / sqrtf(ss_ * (1.f / 64.f) + EPS); } while (0)
    for (int m = gw; m < T; m += NGW) {
        const int b = m >> 12, s = m & (S - 1);
        const bf16* pr = proj + (size_t)m * 2560;
        const u32x4 vq0 = *(const u32x4*)(pr + lane * 8), vq1 = *(const u32x4*)(pr + 512 + lane * 8);
        const u32x4 vk = *(const u32x4*)(pr + (lo32 ? 1536 + lane * 8 : 2048 + (lane - 32) * 8));
        const u32x4 vc = *(const u32x4*)(pr + (lo32 ? 1024 + lane * 8 : 1280 + (lane - 32) * 8));
        const f32x4* cp = (const f32x4*)(tab + (size_t)m * 32 + 8 * (l8 & 3));
        const f32x4 c0 = cp[0], c1 = cp[1], c2 = cp[2], c3 = cp[3];
        {
            float x[8], r; NP_UNPACK(vq0, x); NP_RSTD8(x, r);
            u32x4 w; w.x = pkbf(x[0] * r * qw8[0], x[1] * r * qw8[1]); w.y = pkbf(x[2] * r * qw8[2], x[3] * r * qw8[3]); w.z = pkbf(x[4] * r * qw8[4], x[5] * r * qw8[5]); w.w = pkbf(x[6] * r * qw8[6], x[7] * r * qw8[7]);
            *(u32x4*)(QN + ((size_t)(b * 16 + hsel) * S + s) * 64 + 8 * l8) = w;
        }
        {
            float x[8], r; NP_UNPACK(vq1, x); NP_RSTD8(x, r);
            u32x4 w; w.x = pkbf(x[0] * r * qw8[0], x[1] * r * qw8[1]); w.y = pkbf(x[2] * r * qw8[2], x[3] * r * qw8[3]); w.z = pkbf(x[4] * r * qw8[4], x[5] * r * qw8[5]); w.w = pkbf(x[6] * r * qw8[6], x[7] * r * qw8[7]);
            *(u32x4*)(QN + ((size_t)(b * 16 + 8 + hsel) * S + s) * 64 + 8 * l8) = w;
        }
        const size_t okv = ((size_t)(b * 4 + (hsel & 3)) * S + s) * 64 + 8 * l8;
        {
            float x[8], r, y[8]; NP_UNPACK(vk, x); NP_RSTD8(x, r);
            const float cs[16] = {c0.x, c0.y, c0.z, c0.w, c1.x, c1.y, c1.z, c1.w, c2.x, c2.y, c2.z, c2.w, c3.x, c3.y, c3.z, c3.w};
#pragma unroll
            for (int j = 0; j < 8; ++j) { const float yv = x[j] * r * kw8[j]; const float yp = xshfl(yv, 4); y[j] = yv * cs[2 * j] + (l8 < 4 ? -yp : yp) * cs[2 * j + 1]; }
            u32x4 w; w.x = pkbf(y[0], y[1]); w.y = pkbf(y[2], y[3]); w.z = pkbf(y[4], y[5]); w.w = pkbf(y[6], y[7]);
            *(u32x4*)((lo32 ? KS : KW) + okv) = w;
        }
        *(u32x4*)((lo32 ? KCH : VCH) + okv) = vc;
    }
#undef NP_UNPACK
#undef NP_RSTD8
}
__device__ __forceinline__ void phase_cmp2(unsigned char* lds, const float* Pk, const float* Pv, const float* biasp, const float* w2, const float* b2, const float* knorm0,
                                           bf16* KC, bf16* VC, int gw, int NGW, int wid, int lane, int tid) {
    float* hs = (float*)lds + wid * 256;
    float* w2l = (float*)(lds + 8192);
    for (int kind = 0; kind < 2; ++kind) {
        __syncthreads();
        for (int idx = tid; idx < 256 * 64 / 4; idx += 512) ((f32x4*)w2l)[idx] = ((const f32x4*)(w2 + (size_t)kind * 256 * 64))[idx];
        __syncthreads();
        const float* P = kind ? Pv : Pk;
        for (int it = gw; it < 32 * 256; it += NGW) {
            const int i = it & 255, bh = it >> 8;
            bf16* outp = kind ? VC + ((size_t)bh * 64 + lane) * 256 + i : KC + ((size_t)bh * 256 + i) * 64 + lane;
            if (i == 255) { *outp = 0; continue; }
            const float* r0 = P + ((size_t)bh * 256 + i) * 512; const float* r1 = r0 + 512 + 256;
#pragma unroll
            for (int j = 0; j < 4; ++j) { const int n = lane + 64 * j; const float x = r0[n] + r1[n] + biasp[kind * 256 + n];
                const float uu = 0.7978845608028654f * (x + 0.044715f * x * x * x);
                const float th = 1.f - 2.f / (1.f + __expf(2.f * uu));
                hs[n] = 0.5f * x * (1.f + th); }
            WAVE_SYNC();
            float a0 = b2[kind * 64 + lane], a1 = 0.f, a2 = 0.f, a3 = 0.f;
#pragma unroll 4
            for (int n = 0; n < 256; n += 4) { const f32x4 hv = *(const f32x4*)(hs + n);
                a0 += hv.x * w2l[n * 64 + lane]; a1 += hv.y * w2l[(n + 1) * 64 + lane]; a2 += hv.z * w2l[(n + 2) * 64 + lane]; a3 += hv.w * w2l[(n + 3) * 64 + lane]; }
            float acc = (a0 + a1) + (a2 + a3);
            if (kind == 0) { const float ss = wave_sum(acc * acc); acc = acc * (1.f / sqrtf(ss * (1.f / 64.f) + EPS)) * knorm0[lane]; }
            *outp = (bf16)f2bf(acc);
            WAVE_SYNC();
        }
    }
}
constexpr int KV_STRIDE = 144;
constexpr int KV_BUF = 2 * 64 * KV_STRIDE;
constexpr int ATT_IMP_OFF = 2 * KV_BUF;
constexpr int ATT_MSK_OFF = ATT_IMP_OFF + 8 * 2048;

template <bool IMP>
__device__ __forceinline__ void attn_tile(const bool FAST, const unsigned char* buf, int tt, int key0, int lo, int hi, const bf16x8v (&qf)[4],
                                          f32x16 (&O)[2], f32x16 (&IM)[2], float& m, float& l, const bf16* ovt, int r, int h, int pr) {
    f32x16 sacc;
#pragma unroll
    for (int i = 0; i < 16; ++i) sacc[i] = 0.f;
    const unsigned char* kb = buf + (32 * tt + pr) * KV_STRIDE + h * 16;
#pragma unroll
    for (int ks = 0; ks < 4; ++ks) { const bf16x8v a = *(const bf16x8v*)(kb + ks * 32); sacc = MFMA32(a, qf[ks], sacc); }
    const int kb0 = key0 + 8 * h;
    float mx = -1e30f, psum = 0.f, corr;
    if (FAST) {
        const bool on = hi >= 0;
#pragma unroll
        for (int i = 0; i < 16; ++i) mx = fmaxf(mx, sacc[i]);
        mx = on ? mx * 0.18033688011112042f : -1e30f;
        mx = fmaxf(mx, xshfl(mx, 32));
        const float mnew = fmaxf(m, mx);
        corr = __builtin_amdgcn_exp2f(m - mnew);
        m = mnew;
#pragma unroll
        for (int i = 0; i < 16; ++i) { const float p = __builtin_amdgcn_exp2f(sacc[i] * 0.18033688011112042f - mnew); psum += p; sacc[i] = p; }
        if (!on) {
            psum = 0.f;
#pragma unroll
            for (int i = 0; i < 16; ++i) sacc[i] = 0.f;
        }
    } else {
#pragma unroll
        for (int i = 0; i < 16; ++i) { const int key = kb0 + 16 * (i >> 3) + (i & 7); const bool ok = (key >= lo) && (key <= hi);
            const float sv = ok ? sacc[i] * 0.18033688011112042f : -1e30f; sacc[i] = sv; mx = fmaxf(mx, sv); }
        mx = fmaxf(mx, xshfl(mx, 32));
        const float mnew = fmaxf(m, mx);
        corr = __builtin_amdgcn_exp2f(m - mnew);
        m = mnew;
#pragma unroll
        for (int i = 0; i < 16; ++i) { const float p = sacc[i] > -1e29f ? __builtin_amdgcn_exp2f(sacc[i] - mnew) : 0.f; psum += p; sacc[i] = p; }
    }
    l = l * corr + psum;
    if (__any(corr != 1.f)) {
#pragma unroll
        for (int i = 0; i < 16; ++i) { O[0][i] *= corr; O[1][i] *= corr; }
        if (IMP) {
#pragma unroll
            for (int i = 0; i < 16; ++i) { IM[0][i] *= corr; IM[1][i] *= corr; }
        }
    }
    bf16x8v pf[2];
#pragma unroll
    for (int sx = 0; sx < 2; ++sx) { u32x4 w; w.x = pkbf(sacc[8 * sx], sacc[8 * sx + 1]); w.y = pkbf(sacc[8 * sx + 2], sacc[8 * sx + 3]); w.z = pkbf(sacc[8 * sx + 4], sacc[8 * sx + 5]); w.w = pkbf(sacc[8 * sx + 6], sacc[8 * sx + 7]);
        pf[sx] = __builtin_bit_cast(bf16x8v, w); }
    const unsigned char* vb = buf + 64 * KV_STRIDE + r * KV_STRIDE + (32 * tt + 8 * h) * 2;
#pragma unroll
    for (int dt = 0; dt < 2; ++dt)
#pragma unroll
        for (int sx = 0; sx < 2; ++sx) { const bf16x8v a = *(const bf16x8v*)(vb + dt * 32 * KV_STRIDE + sx * 32); O[dt] = MFMA32(a, pf[sx], O[dt]); }
    if (IMP) {
#pragma unroll
        for (int st = 0; st < 2; ++st)
#pragma unroll
            for (int sx = 0; sx < 2; ++sx) { const bf16x8v a = *(const bf16x8v*)(ovt + (32 * st + r) * 256 + key0 + 16 * sx + 8 * h); IM[st] = MFMA32(a, pf[sx], IM[st]); }
    }
}

template <int MODE>
__device__ __forceinline__ void attn_branch(unsigned char* kvbuf, const bf16* Kg0, const bf16* VTg0, int vts, unsigned long long blkmask, int t, int nv, unsigned long long selm,
                                            int wlo, int whi, int flo, int fhi, const bf16x8v (&qf)[4], f32x16 (&O)[2], f32x16 (&IM)[2], float& l, const bf16* ovt, int tid, int r, int h, int pr) {
    float m = -1e30f;
    l = 0.f;
#pragma unroll
    for (int i = 0; i < 16; ++i) { O[0][i] = 0.f; O[1][i] = 0.f; IM[0][i] = 0.f; IM[1][i] = 0.f; }
    const int srow = tid >> 3, sch = tid & 7;
    int j = __builtin_ctzll(blkmask);
    unsigned long long rest = blkmask & (blkmask - 1);
    u32x4 kr = *(const u32x4*)(Kg0 + (size_t)(64 * j + srow) * 64 + sch * 8);
    u32x4 vr = *(const u32x4*)(VTg0 + (size_t)srow * vts + 64 * j + sch * 8);
    *(u32x4*)(kvbuf + srow * KV_STRIDE + sch * 16) = kr;
    *(u32x4*)(kvbuf + 64 * KV_STRIDE + srow * KV_STRIDE + sch * 16) = vr;
    int cur = 0;
    for (;;) {
        __syncthreads();
        const bool more = rest != 0ull;
        int jn = 0;
        if (more) { jn = __builtin_ctzll(rest); rest &= rest - 1;
            kr = *(const u32x4*)(Kg0 + (size_t)(64 * jn + srow) * 64 + sch * 8);
            vr = *(const u32x4*)(VTg0 + (size_t)srow * vts + 64 * jn + sch * 8); }
        const unsigned char* buf = kvbuf + cur * KV_BUF;
        int lo, hi;
        if (MODE == 0) { lo = 0; hi = nv - 1; }
        else if (MODE == 1) { lo = 0; hi = ((selm >> j) & 1ull) ? t : -1; }
        else { lo = t - 511; hi = t; }
        const bool wave_on = (MODE != 1) || __any(hi >= 0);
#pragma unroll
        for (int tt = 0; tt < 2; ++tt) {
            const int key0 = 64 * j + 32 * tt;
            if (!wave_on || key0 > whi || key0 + 31 < wlo) continue;
            attn_tile<MODE == 0>(key0 >= flo && key0 + 31 <= fhi, buf, tt, key0, lo, hi, qf, O, IM, m, l, ovt, r, h, pr);
        }
        if (!more) break;
        *(u32x4*)(kvbuf + (cur ^ 1) * KV_BUF + srow * KV_STRIDE + sch * 16) = kr;
        *(u32x4*)(kvbuf + (cur ^ 1) * KV_BUF + 64 * KV_STRIDE + srow * KV_STRIDE + sch * 16) = vr;
        cur ^= 1; j = jn;
    }
    __syncthreads();
}

__device__ __forceinline__ void phase_nsa_attn(unsigned char* lds, const bf16* QN, const bf16* KS, const bf16* KW, const bf16* VST, const bf16* VWT, const bf16* KCb, const bf16* VCT,
                                               const bf16* ovt, const float* gates, const f32x2* tab, bf16* hn, int vblk, int nblk, int tid, int wid, int lane) {
    const int r = lane & 31, h = lane >> 5, pr = (r & ~12) | ((r & 4) << 1) | ((r & 8) >> 1);
    float* imp_s = (float*)(lds + ATT_IMP_OFF + wid * 2048);
    unsigned long long* msk_s = (unsigned long long*)(lds + ATT_MSK_OFF);
    unsigned* uni_s = (unsigned*)(lds + ATT_MSK_OFF + 512);
    for (int item = vblk; item < Bn * 4 * 64; item += nblk) {
        const int rnd = item / nblk, wv = item - rnd * nblk;
        const int bh = wv & 31, sub = wv >> 5, per = nblk >> 5;
        int qb = rnd * per + ((rnd & 1) ? (per - 1 - sub) : sub);
        if (nblk != 256) { qb = item >> 5; }
        const int bhh = (nblk != 256) ? (item & 31) : bh;
        const int b = bhh >> 2, hk = bhh & 3;
        const int t0 = qb * 64, tw0 = t0 + 8 * wid, t = tw0 + (r & 7), g = r >> 3;
        const size_t tok = (size_t)b * S + t;
        if (tid == 0) { unsigned z = 0u; asm volatile("" : "+v"(z)); uni_s[0] = z; uni_s[1] = z; }
        bf16x8v qn[4], qr[4];
        {
            const bf16* qp = QN + ((size_t)(b * 16 + hk * 4 + g) * S + t) * 64 + 8 * h;
#pragma unroll
            for (int ks = 0; ks < 4; ++ks) qn[ks] = *(const bf16x8v*)(qp + 16 * ks);
            const f32x2* cp = tab + tok * 32 + 8 * h;
#pragma unroll
            for (int kl = 0; kl < 2; ++kl) {
                u32x4 wlo_, whi_;
                const u32x4 a = __builtin_bit_cast(u32x4, qn[kl]), c = __builtin_bit_cast(u32x4, qn[kl + 2]);
#pragma unroll
                for (int jj = 0; jj < 4; ++jj) {
                    const f32x2 cs0 = cp[16 * kl + 2 * jj], cs1 = cp[16 * kl + 2 * jj + 1];
                    const float x0 = bf2f(a[jj] & 0xffffu), x1 = bf2f(a[jj] >> 16), y0 = bf2f(c[jj] & 0xffffu), y1 = bf2f(c[jj] >> 16);
                    wlo_[jj] = pkbf(x0 * cs0.x - y0 * cs0.y, x1 * cs1.x - y1 * cs1.y);
                    whi_[jj] = pkbf(y0 * cs0.x + x0 * cs0.y, y1 * cs1.x + x1 * cs1.y);
                }
                qr[kl] = __builtin_bit_cast(bf16x8v, wlo_); qr[kl + 2] = __builtin_bit_cast(bf16x8v, whi_);
            }
        }
        const float* gp = gates + tok * 48 + (hk * 4 + g) * 3;
        const float g0 = sigmoidf_(gp[0]), g1 = sigmoidf_(gp[1]), g2 = sigmoidf_(gp[2]);
        f32x16 acc[2], O[2], IM[2];
        float l;
        const int nv = t >= 31 ? ((t - 31) >> 4) + 1 : 0;
        const int nvw = ((tw0 + 7 - 31) >> 4) + 1;
        const int nvmax = 4 * qb + 3;
        {
            const int ncb = (nvmax + 63) >> 6;
            const unsigned long long bm = ncb >= 64 ? ~0ull : ((1ull << ncb) - 1ull);
            attn_branch<0>(lds, KCb + (size_t)bhh * 256 * 64, VCT + (size_t)bhh * 64 * 256, 256, bm, t, nv, 0ull, 0, (tw0 + 7 >= 31 ? nvw - 1 : -1), 0, (tw0 >= 31 ? ((tw0 - 31) >> 4) : -1), qn, O, IM, l, ovt, tid, r, h, pr);
        }
        {
            const float lt = l + xshfl(l, 32), inv = lt > 0.f ? 1.f / lt : 0.f, sc = inv * g0;
#pragma unroll
            for (int i = 0; i < 16; ++i) { acc[0][i] = O[0][i] * sc; acc[1][i] = O[1][i] * sc; }
#pragma unroll
            for (int st = 0; st < 2; ++st)
#pragma unroll
                for (int i = 0; i < 16; ++i) { float v = IM[st][i] * inv; v += xshfl(v, 8); v += xshfl(v, 16);
                    if (r < 8) imp_s[r * 64 + 32 * st + (i & 3) + 8 * (i >> 2) + 4 * h] = v; }
        }
        WAVE_SYNC();
        {
            unsigned long long um = 0ull;
            for (int tk = 0; tk < 8; ++tk) {
                const float imp = imp_s[tk * 64 + lane];
                const bool sv = lane <= qb, forced = (lane == 0) || (lane == qb) || (lane + 1 == qb);
                const float score = sv ? (forced ? 1e9f : imp) : -1.f;
                int rank = 0;
#pragma unroll 4
                for (int i = 0; i < 64; ++i) { const float si = __uint_as_float(__builtin_amdgcn_readlane(__float_as_uint(score), i)); rank += (si > score || (si == score && i < lane)) ? 1 : 0; }
                const unsigned long long mk = __ballot((rank < 16) && (score >= 0.f));
                um |= mk;
                if (lane == 0) msk_s[wid * 8 + tk] = mk;
            }
            if (lane == 0) { atomicOr(&uni_s[0], (unsigned)um); atomicOr(&uni_s[1], (unsigned)(um >> 32)); }
        }
        __syncthreads();
        const unsigned long long selm = msk_s[wid * 8 + (r & 7)];
        const unsigned long long uni = (unsigned long long)uni_s[0] | ((unsigned long long)uni_s[1] << 32);
        attn_branch<1>(lds, KS + (size_t)bhh * S * 64, VST + (size_t)bhh * 64 * S, S, uni, t, 0, selm, 0, tw0 + 7, 0, tw0, qr, O, IM, l, ovt, tid, r, h, pr);
        {
            const float lt = l + xshfl(l, 32), sc = g1 / lt;
#pragma unroll
            for (int i = 0; i < 16; ++i) { acc[0][i] += O[0][i] * sc; acc[1][i] += O[1][i] * sc; }
        }
        {
            const int jlo = qb >= 8 ? qb - 8 : 0;
            const unsigned long long bm = (qb >= 63 ? ~0ull : ((1ull << (qb + 1)) - 1ull)) & ~((1ull << jlo) - 1ull);
            attn_branch<2>(lds, KW + (size_t)bhh * S * 64, VWT + (size_t)bhh * 64 * S, S, bm, t, 0, 0ull, tw0 - 511, tw0 + 7, tw0 + 7 - 511, tw0, qr, O, IM, l, ovt, tid, r, h, pr);
        }
        {
            const float lt = l + xshfl(l, 32), sc = g2 / lt;
            bf16* op = hn + tok * D + (hk * 4 + g) * 64 + 4 * h;
#pragma unroll
            for (int dt = 0; dt < 2; ++dt)
#pragma unroll
                for (int q4 = 0; q4 < 4; ++q4) {
                    u32x2 w; w.x = pkbf(acc[dt][4 * q4] + O[dt][4 * q4] * sc, acc[dt][4 * q4 + 1] + O[dt][4 * q4 + 1] * sc);
                    w.y = pkbf(acc[dt][4 * q4 + 2] + O[dt][4 * q4 + 2] * sc, acc[dt][4 * q4 + 3] + O[dt][4 * q4 + 3] * sc);
                    *(u32x2*)(op + 32 * dt + 8 * q4) = w;
                }
        }
    }
}


#define LAS __attribute__((address_space(3)))
#define XB_TMO      128
#define XB_XCNT(j)  (256  + 64 * (j))
#define XB_XSUB(j)  (1280 + 64 * (j))
#define XB_XGEN(j)  (2304 + 64 * (j))
#define XB_TOP      3328
#define XB_TOPGEN   3392
#define XCD_BAR_WORDS 3456
#define XB_SPIN_CAP (1u << 18)

__device__ __forceinline__ unsigned xb_ld(unsigned* p)              { return __hip_atomic_load(p, __ATOMIC_RELAXED, __HIP_MEMORY_SCOPE_AGENT); }
__device__ __forceinline__ unsigned xb_add(unsigned* p, unsigned v) { return __hip_atomic_fetch_add(p, v, __ATOMIC_RELAXED, __HIP_MEMORY_SCOPE_AGENT); }
__device__ __forceinline__ unsigned xb_xcc_id() { return (unsigned)__builtin_amdgcn_s_getreg((3 << 11) | 20) & 0xFu; }
#define XB_SPIN(cond, bar) do { unsigned _sp = 0; while (cond) { __builtin_amdgcn_s_sleep(1); \
    if ((++_sp & 255u) == 0u) { if (xb_ld(&(bar)[XB_TMO])) break; if (_sp > XB_SPIN_CAP) { atomicAdd(&(bar)[XB_TMO], 1u); break; } } } } while (0)

struct XcdBarrier {
    unsigned* bar; unsigned x;
    volatile LAS unsigned* st;
};

__device__ __forceinline__ XcdBarrier xcd_barrier_post(unsigned* bar, volatile LAS unsigned* st) {
    XcdBarrier b; b.bar = bar; b.x = xb_xcc_id(); b.st = st;
    if (threadIdx.x == 0) (void)xb_add(&bar[XB_XCNT(b.x)], 1u);
    return b;
}
__device__ __forceinline__ void xcd_barrier_complete(unsigned* bar, unsigned x, unsigned& nloc, unsigned& nx) {
    const unsigned G = gridDim.x * gridDim.y * gridDim.z;
    unsigned sum, cnt, mine, sp = 0u;
    for (;;) {
        sum = 0u; cnt = 0u; mine = 0u;
#pragma unroll
        for (unsigned j = 0; j < 16; ++j) { const unsigned c = xb_ld(&bar[XB_XCNT(j)]); sum += c; cnt += (c > 0u) ? 1u : 0u; mine = (j == x) ? c : mine; }
        if (sum == G) break;
        __builtin_amdgcn_s_sleep(1);
        if ((++sp & 255u) == 0u) { if (xb_ld(&bar[XB_TMO])) break; if (sp > XB_SPIN_CAP) { atomicAdd(&bar[XB_TMO], 1u); break; } }
    }
    nloc = mine > 0u ? mine : 1u; nx = cnt > 0u ? cnt : 1u;
}

__device__ __forceinline__ void xcd_barrier(const XcdBarrier& b) {
    asm volatile("s_waitcnt vmcnt(0)" ::: "memory");
    __syncthreads();
    if (threadIdx.x == 0) {
        unsigned* bar = b.bar;
        __builtin_amdgcn_s_waitcnt(0);
        unsigned nloc = b.st[0], nx = b.st[1];
        if (nloc == 0u) { xcd_barrier_complete(bar, b.x, nloc, nx); b.st[0] = nloc; b.st[1] = nx; }
        const unsigned old = xb_add(&bar[XB_XSUB(b.x)], 1u);
        const unsigned gen = old / nloc;
        if (old + 1u == (gen + 1u) * nloc) {
            __builtin_amdgcn_fence(__ATOMIC_RELEASE, "agent");
            asm volatile("s_waitcnt vmcnt(0)" ::: "memory");
            const unsigned og = xb_add(&bar[XB_TOP], 1u);
            const unsigned tg = og / nx;
            if (og + 1u == (tg + 1u) * nx) xb_add(&bar[XB_TOPGEN], 1u);
            else XB_SPIN(xb_ld(&bar[XB_TOPGEN]) == tg, bar);
            __builtin_amdgcn_fence(__ATOMIC_ACQUIRE, "agent");
            xb_add(&bar[XB_XGEN(b.x)], 1u);
            asm volatile("s_waitcnt vmcnt(0)" ::: "memory");
        } else {
            XB_SPIN(xb_ld(&bar[XB_XGEN(b.x)]) == gen, bar);
            __builtin_amdgcn_fence(__ATOMIC_ACQUIRE, "agent");
            asm volatile("s_waitcnt vmcnt(0)" ::: "memory");
        }
    }
    __syncthreads();
}

struct Args { const void* in[24]; float* out; unsigned char* ws; int lo, hi; };

__host__ __device__ constexpr int mixer_inner_phases(int kind) { return kind == 0 ? 4 : (kind == 1 ? 1 : 4); }
__host__ __device__ constexpr int total_phases() { int n = 1; for (int L = 0; L < DEPTH; ++L) n += 4 + 2 + mixer_inner_phases(L % 3); return n; }

__global__ void __launch_bounds__(512, 2) mega(Args args) {
    extern __shared__ __attribute__((aligned(16))) unsigned char lds[];
    cg::grid_group grid = cg::this_grid();
    volatile LAS unsigned* bst = (volatile LAS unsigned*)((LAS unsigned char*)lds + (LDS_BYTES - 64));
    if (threadIdx.x < 2) bst[threadIdx.x] = 0u;
    __syncthreads();
    const XcdBarrier xbar = xcd_barrier_post((unsigned*)args.ws, bst);
    bool again = false;
    for (int ph = args.lo; ph < args.hi; ++ph) {
        int type = 0, s = 0, L = 0;
        if (ph > 0) {
            int p = ph - 1;
            for (L = 0; L < DEPTH; ++L) { const int n = 6 + mixer_inner_phases(L % 3); if (p < n) break; p -= n; }
            const int inner = mixer_inner_phases(L % 3), kind = L % 3;
            if (p < 2) { type = 2 + p; s = 2 * L; }
            else if (p == 2) type = 5;
            else if (p < 3 + inner) { const int q = p - 3; type = kind == 0 ? (q == 0 ? 14 : (q == 1 ? 15 : 4 + q)) : (kind == 1 ? 8 : 9 + q); }
            else if (p == 3 + inner) type = 13;
            else { type = 2 + (p - 4 - inner); s = 2 * L + 1; }
        }
        int tid_ = threadIdx.x; asm volatile("" : "+v"(tid_));
        int G_ = gridDim.x, bx_ = blockIdx.x; asm volatile("" : "+s"(G_), "+s"(bx_));
        const int tid = tid_, lane = tid & 63, wid = __builtin_amdgcn_readfirstlane(tid >> 6);
        const int G = G_, bx = bx_;
        const int vcu = (G % 8 == 0) ? (bx % 8) * (G / 8) + bx / 8 : bx;
        const int gw = vcu * 8 + wid, NGW = G * 8;
        unsigned char* ws = args.ws; asm volatile("" : "+s"(ws));
        PG8_LAS unsigned char* ldsl = (PG8_LAS unsigned char*)lds;
        float* hout = args.out; asm volatile("" : "+s"(hout));
        bf16* HN = (bf16*)(ws + WS_HN);
        bf16* RB = (bf16*)(ws + WS_R);
        f32x2* tab = (f32x2*)(ws + WS_TAB);
        const int kind = L % 3, jj = L / 3;
        bf16* QN = RB + (size_t)T * 2560;
        bf16* KSb = QN + (size_t)T * 1024;
        bf16* KWb = KSb + (size_t)T * 256;
        bf16* KCH = (bf16*)(ws + WS_O32);
        bf16* VCH = KCH + (size_t)T * 256;
        float* Pk = (float*)(ws + WS_O32 + 32 * MiB);
        float* Pv = Pk + (size_t)8192 * 512;
        bf16* KC = (bf16*)(ws + WS_O32 + 64 * MiB);
        bf16* VC = (bf16*)(ws + WS_O32 + 65 * MiB);
        bf16* OVT = (bf16*)(ws + WS_BP + 65536);
        bf16* VST = (bf16*)(ws + WS_O32 + 68 * MiB);
        bf16* VWT = (bf16*)(ws + WS_O32 + 84 * MiB);
        switch (type) {
        case 0: {
            float* scr = (float*)lds + wid * (64 * 33);
            for (int mi = 0; mi < 28; ++mi) {
                const float* W; const float* nw = nullptr; int K, N, Npad, mode = 0; bf16* WT;
                if (mi < 8)       { nw = (const float*)args.in[2] + (size_t)mi * D; W = (const float*)args.in[3] + (size_t)mi * D * 2 * FF; K = D; N = 2 * FF; Npad = N; mode = 1; WT = (bf16*)(ws + WS_WGU) + (size_t)mi * 2 * FF * D; }
                else if (mi < 16) { const int i = mi - 8; W = (const float*)args.in[4] + (size_t)i * FF * D; K = FF; N = D; Npad = N; WT = (bf16*)(ws + WS_WDN) + (size_t)i * D * FF; }
                else if (mi < 18) { const int i = mi - 16; nw = (const float*)args.in[5] + (size_t)(3 * i) * D; W = (const float*)args.in[6] + (size_t)i * D * 4112; K = D; N = 4112; Npad = GDN_NPAD; WT = (bf16*)(ws + WS_WGI) + (size_t)i * GDN_NPAD * D; }
                else if (mi < 20) { const int i = mi - 18; W = (const float*)args.in[11] + (size_t)i * D * D; K = D; N = D; Npad = N; WT = (bf16*)(ws + WS_WGO) + (size_t)i * D * D; }
                else if (mi == 20) { nw = (const float*)args.in[5] + (size_t)1 * D; W = (const float*)args.in[12]; K = D; N = 3072; Npad = N; WT = (bf16*)(ws + WS_WSI); }
                else if (mi == 21) { W = (const float*)args.in[14]; K = D; N = D; Npad = N; WT = (bf16*)(ws + WS_WSO); }
                else if (mi == 22) { nw = (const float*)args.in[5] + (size_t)2 * D; W = (const float*)args.in[15]; K = D; N = 2608; Npad = NSA_NPAD; WT = (bf16*)(ws + WS_WNI); }
                else if (mi == 23) { W = (const float*)args.in[23]; K = D; N = D; Npad = N; WT = (bf16*)(ws + WS_WNO); }
                else { const int i = mi - 24, kd = i >> 1, hf = i & 1;
                    W = (const float*)args.in[19] + (size_t)kd * 2048 * 256 + (size_t)hf * 1024 * 256; K = 1024; N = 256; Npad = 256; WT = (bf16*)(ws + WS_WC1) + (size_t)kd * 512 * 1024 + (size_t)hf * 256 * 1024; }
                xpose_matrix(W, nw, K, N, Npad, WT, mode, scr, gw, NGW, lane);
            }
            {
                float* ss = (float*)(ws + WS_SS);
                const float* xin = (const float*)args.in[0];
                for (int m = gw; m < T; m += NGW) {
                    const f32x4* xr = (const f32x4*)(xin + (size_t)m * D) + lane; u32x2* o8 = (u32x2*)(HN + (size_t)m * D) + lane; float sq = 0.f;
#pragma unroll
                    for (int j = 0; j < 4; ++j) { const f32x4 v = xr[64 * j]; sq += (v.x * v.x + v.y * v.y) + (v.z * v.z + v.w * v.w); u32x2 o; o.x = pkbf(v.x, v.y); o.y = pkbf(v.z, v.w); o8[64 * j] = o; }
                    sq = wave_sum(sq); if (lane < 16) ss[(size_t)m * 16 + lane] = lane == 0 ? sq : 0.f;
                }
            }
            const int* positions = (const int*)args.in[1];
            for (int idx = bx * 512 + tid; idx < T * 32; idx += G * 512) {
                const int tk = idx >> 5, i = idx & 31;
                const float inv = 1.0f / exp2f((float)(2 * i) * (13.287712379549449f / 64.f));
                const float ang = (float)positions[tk] * inv;
                const double rev = (double)ang * 0.15915494309189535;
                const float fr = (float)(rev - rint(rev));
                f32x2 v; v.x = __builtin_amdgcn_cosf(fr); v.y = __builtin_amdgcn_sinf(fr);
                tab[idx] = v;
            }
            for (int idx = bx * 512 + tid; idx < 64 * 256; idx += G * 512) {
                const int sj = idx >> 8, i = idx & 255, q = i >> 2, rem = i & 3;
                OVT[idx] = (bf16)(rem < 3 ? (q == sj ? 0x3F80 : 0) : ((q == sj || q + 1 == sj) ? 0x3F00 : 0));
            }
            if (bx < 2 && tid < 256) {
                const float* pe = (const float*)args.in[18] + (size_t)bx * 2048;
                const float* w1 = (const float*)args.in[19] + (size_t)bx * 2048 * 256 + tid;
                float acc = ((const float*)args.in[20])[bx * 256 + tid];
                for (int k = 0; k < 2048; ++k) acc += pe[k] * w1[(size_t)k * 256];
                ((float*)(ws + WS_BP))[bx * 256 + tid] = acc;
            }
        } break;
        case 2: {
            const bf16* Ah = (s & 1) ? (const bf16*)(ws + WS_R + 192 * MiB) : HN;
            pg8::Gemm g{Ah, (const bf16*)(ws + WS_WGU) + (size_t)s * 2 * FF * D, T, 2 * FF, D}; pg8::StaticOrder SO; SO.init(T, 2 * FF, G, bx);
            float* rtab = (float*)(lds + 131072);
            rstd_table(rtab, (const float*)(ws + WS_SS) + (size_t)s * T * 16, SO, tid);
            pg8::EpiSwiGLU E{RB, rtab};
            pg8::gemm_phase<pg8::EpiSwiGLU, pg8::StaticOrder, true, true>(ldsl, g, SO, E, tid); } break;
        case 3: {
            pg8::Gemm g{RB, (const bf16*)(ws + WS_WDN) + (size_t)s * D * FF, T, D, FF}; pg8::StaticOrder SO; SO.init(T, D, G, bx);
            const int slot = (s & 1) ? (s < 7 ? s + 1 : 12) : 8 + (s >> 1);
            pg8::EpiResid<1> E{s == 0 ? (const float*)args.in[0] : hout, hout, HN, (float*)(ws + WS_SS) + (size_t)slot * T * 16};
            pg8::gemm_phase<pg8::EpiResid<1>, pg8::StaticOrder, true, true>(ldsl, g, SO, E, tid); } break;
        case 5: {
            const bf16* Wt; int Np, ldc, nmain, ldt, nvalid; float* tail;
            if (kind == 0) { Wt = (const bf16*)(ws + WS_WGI) + (size_t)jj * GDN_NPAD * D; Np = GDN_NPAD; ldc = 4096; nmain = 4096; tail = (float*)(ws + WS_AB); ldt = 16; nvalid = 4112; }
            else if (kind == 1) { Wt = (const bf16*)(ws + WS_WSI); Np = 3072; ldc = 3072; nmain = 3072; tail = (float*)(ws + WS_AB); ldt = 16; nvalid = 3072; }
            else { Wt = (const bf16*)(ws + WS_WNI); Np = NSA_NPAD; ldc = 2560; nmain = 2560; tail = (float*)(ws + WS_GT); ldt = 48; nvalid = 2608; }
            pg8::Gemm g{HN, Wt, T, Np, D}; pg8::StaticOrder SO; SO.init(T, Np, G, bx);
            float* rtab = (float*)(lds + 131072);
            rstd_table(rtab, (const float*)(ws + WS_SS) + (size_t)(8 + L) * T * 16, SO, tid);
            pg8::EpiProj E{RB, ldc, nmain, tail, ldt, nvalid, rtab};
            pg8::gemm_phase<pg8::EpiProj, pg8::StaticOrder, true, true>(ldsl, g, SO, E, tid); } break;
        case 14: phase_gdn_halo(RB, (bf16*)(ws + WS_HALO), vcu * 512 + tid, G * 512); break;
        case 15: phase_gdn_prep(lds, RB, (const bf16*)(ws + WS_HALO), (const float*)(ws + WS_AB), (const float*)args.in[7] + (size_t)jj * 4 * 3072, (const float*)args.in[8] + jj * 8, (const float*)args.in[9] + jj * 8,
                                HN, (bf16*)(ws + WS_O32 + 64 * MiB), (float*)(ws + WS_GL), bx, G, tid, wid, lane); break;
        case 6:
#ifndef DIS_SCAN
            phase_gdn_scan2(lds, RB, HN, (const bf16*)(ws + WS_O32 + 64 * MiB), (const float*)(ws + WS_GL), (bf16*)(ws + WS_O32), bx, G, tid, wid, lane);
#endif
            break;
        case 7:
#ifndef DIS_GPOST
            phase_gdn_post((const bf16*)(ws + WS_O32), RB, (const float*)args.in[10] + jj * 128, HN, gw, NGW, lane);
#endif
            break;
        case 8:
#ifndef DIS_SPOST
            phase_sc_post(RB, (const float*)args.in[13], HN, vcu * 512 + tid, G * 512);
#endif
            break;
        case 9:
#ifndef DIS_NPOST
            phase_nsa_post(lds, RB, (const float*)args.in[16], (const float*)args.in[17], tab, QN, KSb, KWb, KCH, VCH, VST, VWT, gw, NGW, wid, lane);
#endif
            break;
        case 10: {
            pg8::Gemm g{KCH, (const bf16*)(ws + WS_WC1), 8192, 512, 1024}; pg8::StaticOrder SO; SO.init(8192, 512, G, bx);
            pg8::Gemm g2{VCH, (const bf16*)(ws + WS_WC1) + (size_t)512 * 1024, 8192, 512, 1024};
            pg8::EpiF32 E{Pk, 512};
            if (bx >= G / 2) { g = g2; SO.init(8192, 512, G, bx - G / 2); E.C = Pv; }
            pg8::gemm_phase<pg8::EpiF32, pg8::StaticOrder, true, true>(ldsl, g, SO, E, tid); } break;
        case 11:
#ifndef DIS_CMP2
            phase_cmp2(lds, Pk, Pv, (const float*)(ws + WS_BP), (const float*)args.in[21], (const float*)args.in[22], (const float*)args.in[17], KC, VC, gw, NGW, wid, lane, tid);
#endif
            break;
        case 12:
#ifndef DIS_ATTN
            phase_nsa_attn(lds, QN, KSb, KWb, VST, VWT, KC, VC, OVT, (const float*)(ws + WS_GT), tab, HN, bx, G, tid, wid, lane);
#endif
            break;
        default: {
            const bf16* Wout = kind == 0 ? (const bf16*)(ws + WS_WGO) + (size_t)jj * D * D : (kind == 1 ? (const bf16*)(ws + WS_WSO) : (const bf16*)(ws + WS_WNO));
            pg8::Gemm g{HN, Wout, T, D, D}; pg8::StaticOrder SO; SO.init(T, D, G, bx);
            pg8::EpiResid<2> E{hout, hout, (bf16*)(ws + WS_R + 192 * MiB), (float*)(ws + WS_SS) + (size_t)(2 * L + 1) * T * 16};
            pg8::gemm_phase<pg8::EpiResid<2>, pg8::StaticOrder, true, true>(ldsl, g, SO, E, tid); } break;
        }
#ifdef REP_TYPE
        if (type == REP_TYPE && !again) { again = true; xcd_barrier(xbar); --ph; continue; }
        again = false;
#endif
        if (ph + 1 < args.hi) { if (ph == 0) grid.sync(); else xcd_barrier(xbar); }
    }
}

extern "C" void kernel_launch(void* const* d_in, const int* in_sizes, int n_in, void* d_out, int out_size, void* d_ws, size_t ws_size, hipStream_t stream) {
    static int grid = 0;
    if (grid == 0) {
        if (n_in != 24 || out_size != T * D || ws_size < WS_END2) { fprintf(stderr, "kernel_launch: unexpected shapes n_in %d out %d ws %zu (need %zu)\n", n_in, out_size, ws_size, (size_t)WS_END2); grid = -1; return; }
        int dev = 0, cus = 0, per_cu = 0;
        hipGetDevice(&dev); hipDeviceGetAttribute(&cus, hipDeviceAttributeMultiprocessorCount, dev);
        if (hipFuncSetAttribute((const void*)mega, hipFuncAttributeMaxDynamicSharedMemorySize, LDS_BYTES) != hipSuccess) { fprintf(stderr, "kernel_launch: hipFuncSetAttribute failed\n"); grid = -1; return; }
        if (hipOccupancyMaxActiveBlocksPerMultiprocessor(&per_cu, (const void*)mega, 512, LDS_BYTES) != hipSuccess || per_cu < 1) { fprintf(stderr, "kernel_launch: occupancy query says %d\n", per_cu); per_cu = 1; }
        (void)hipGetLastError();
        grid = cus;
    }
    if (grid < 0) return;
    Args a{};
    for (int i = 0; i < 24; ++i) a.in[i] = d_in[i];
    a.out = (float*)d_out; a.ws = (unsigned char*)d_ws;
    constexpr int NPH = total_phases();
#if MK_MULTI
    for (int p = 0; p < NPH; ++p) { a.lo = p; a.hi = p + 1; hipLaunchKernelGGL(mega, dim3(grid), dim3(512), LDS_BYTES, stream, a); }
#else
    a.lo = 0; a.hi = NPH;
    (void)hipMemsetAsync(d_ws, 0, 16384, stream);
    void* kargs[] = {&a};
    hipError_t e = hipLaunchCooperativeKernel((const void*)mega, dim3(grid), dim3(512), kargs, LDS_BYTES, stream);
    if (e != hipSuccess) fprintf(stderr, "cooperative launch failed: %s (grid %d)\n", hipGetErrorString(e), grid);
#endif
}
```

```cpp
#include <hip/hip_runtime.h>
#include <hip/hip_cooperative_groups.h>
#include <cstdio>
#include <cstdint>
namespace cg = cooperative_groups;
namespace pg8 {
#define PG8_LAS __attribute__((address_space(3)))
typedef unsigned short bf16_t;
typedef short bf16x8 __attribute__((ext_vector_type(8)));
typedef float f32x4 __attribute__((ext_vector_type(4)));
typedef unsigned u32x4 __attribute__((ext_vector_type(4)));
constexpr int BM = 256, BK = 64, HALF = 128, HTB = HALF * BK * 2  , STAGE_BYTES = 8 * HTB, NXCD = 8, WGM = 8;

__host__ __device__ __forceinline__ int lds_byte(int r, int c) { const int st = (r >> 4) * 2 + (c >> 5), rr = r & 15, cc = c & 31, ob = rr * 64 + cc * 2; return st * 1024 + (ob ^ (((ob >> 9) & 1) << 5)); }
__host__ __device__ __forceinline__ void stage_rc(int b, int& R, int& C) { const int st = b / 1024, sb = b % 1024, swz = sb ^ (((sb >> 9) & 1) << 5); R = (st >> 1) * 16 + swz / 64; C = (st & 1) * 32 + (swz % 64) / 2; }
__host__ __device__ __forceinline__ int perm32(int rho) { const int n = rho >> 4, i = rho & 15; return 8 * (i >> 2) + 4 * n + (i & 3); }

struct Unit { int pm, pn, ord; };
struct Gemm { const bf16_t* A; const bf16_t* Bt; int M, N, K; };

struct StaticOrder {
    int nM, nN, nwg, G, c;
    __host__ __device__ void init(int M, int N, int G_, int c_) { nM = M / BM; nN = N / BM; nwg = nM * nN; G = G_; c = c_; }
    __host__ __device__ bool next(int i, Unit& u) const {
        const long L = (long)i * G + c; if (L >= nwg) return false;
        int wgid = (int)L; { const int q = nwg / NXCD, r = nwg % NXCD, xcd = wgid % NXCD, off = wgid / NXCD; wgid = (xcd < r ? xcd * (q + 1) : r * (q + 1) + (xcd - r) * q) + off; }
        const int nig = WGM * nN, gid = wgid / nig, fm = gid * WGM, gsz = (nM - fm) < WGM ? (nM - fm) : WGM;
        u.pm = fm + ((wgid % nig) % gsz); u.pn = (wgid % nig) / gsz; u.ord = i; return true;
    }
    __device__ __forceinline__ void a_ready(const Unit&) const {}
    __device__ __forceinline__ void done(const Unit&) const {}
};
__device__ __forceinline__ unsigned cvt_pk_bf16(float lo, float hi) { unsigned r; asm volatile("v_cvt_pk_bf16_f32 %0, %1, %2" : "=v"(r) : "v"(lo), "v"(hi)); return r; }
template <class Epi, class Sched, bool ALIGN_EPI = false, bool SP2 = false>
__device__ __forceinline__ void gemm_phase(PG8_LAS unsigned char* lds, const Gemm g, const Sched& S, const Epi& E, const int tid) {
    const int wid = __builtin_amdgcn_readfirstlane(tid >> 6), lane = tid & 63, wr = wid >> 2, wc = wid & 3, fr = lane & 15, fq = lane >> 4;
    const int K = g.K, nt = K / BK;
    unsigned voffA[2], voffB[2];
#pragma unroll
    for (int i = 0; i < 2; ++i) { int R, C; stage_rc(tid * 16 + i * 8192, R, C); const int Rb = Epi::PERM ? ((R & ~31) + perm32(R & 31)) : R;
        voffA[i] = (unsigned)(R * K + C) * 2u; voffB[i] = (unsigned)(Rb * K + C) * 2u; }
    const size_t kstep = (size_t)(BK * 2);
    const size_t hstep = (size_t)HALF * K * 2;
    const size_t tstep = 2 * hstep;
    const unsigned ldsw = (unsigned)wid * 1024u;
    const int aoff = lds_byte(wr * 64 + fr, fq * 8), boff = lds_byte(wc * 32 + fr, fq * 8);
#define PG8_SA(b, h) (((b) * 2 + (h)) * HTB)
#define PG8_SB(b, h) ((4 + (b) * 2 + (h)) * HTB)
#define PG8_STAGE(bufoff, gbase, voff) do { _Pragma("unroll") for (int _i = 0; _i < 2; ++_i) \
        __builtin_amdgcn_global_load_lds((const unsigned*)((const char*)(gbase) + (voff)[_i]), (PG8_LAS unsigned*)(lds + (bufoff) + ldsw + _i * 8192), 16, 0, 0); } while (0)
#define PG8_LDA(dst, b, h) do { _Pragma("unroll") for (int m = 0; m < 4; ++m) _Pragma("unroll") for (int k = 0; k < 2; ++k) dst[m][k] = *(const PG8_LAS bf16x8*)(lds + PG8_SA(b, h) + aoff + m * 2048 + k * 1024); } while (0)
#define PG8_LDB(dst, b, h) do { _Pragma("unroll") for (int n = 0; n < 2; ++n) _Pragma("unroll") for (int k = 0; k < 2; ++k) dst[n][k] = *(const PG8_LAS bf16x8*)(lds + PG8_SB(b, h) + boff + n * 2048 + k * 1024); } while (0)
#define PG8_MMA(ai, bj, At, Bt) do { __builtin_amdgcn_s_setprio(1); _Pragma("unroll") for (int m = 0; m < 4; ++m) _Pragma("unroll") for (int n = 0; n < 2; ++n) _Pragma("unroll") for (int k = 0; k < 2; ++k) \
        acc[ai][bj][m][n] = __builtin_amdgcn_mfma_f32_16x16x32_bf16(Bt[n][k], At[m][k], acc[ai][bj][m][n], 0, 0, 0); __builtin_amdgcn_s_setprio(0); } while (0)
#define PG8_WAIT_V(n) asm volatile("s_waitcnt vmcnt(" #n ")" ::: "memory")
#define PG8_WAIT_L(n) asm volatile("s_waitcnt lgkmcnt(" #n ")" ::: "memory")
#define PG8_BAR __builtin_amdgcn_s_barrier()
#define PG8_SCHED __builtin_amdgcn_sched_barrier(0)
    Unit cur, nxt; int ui = 0;
    if (!S.next(0, cur)) return;
    f32x4 acc[2][2][4][2];
#pragma unroll
    for (int a = 0; a < 2; ++a)
#pragma unroll
        for (int b = 0; b < 2; ++b)
#pragma unroll
            for (int m = 0; m < 4; ++m)
#pragma unroll
                for (int n = 0; n < 2; ++n) acc[a][b][m][n] = (f32x4){0.f, 0.f, 0.f, 0.f};
    bf16x8 At[4][2], B0[2][2], B1[2][2];
    const char* cA = (const char*)g.A + (size_t)cur.pm * tstep; const char* cB = (const char*)g.Bt + (size_t)cur.pn * tstep;
    S.a_ready(cur);
    if constexpr (SP2) {
        PG8_STAGE(PG8_SB(0, 0), cB, voffB); PG8_STAGE(PG8_SB(0, 1), cB + hstep, voffB); PG8_STAGE(PG8_SA(0, 0), cA, voffA); PG8_STAGE(PG8_SA(0, 1), cA + hstep, voffA);
        if (wr == 1) PG8_BAR;
        PG8_WAIT_V(2); PG8_BAR;
        PG8_STAGE(PG8_SB(1, 0), cB + kstep, voffB); PG8_STAGE(PG8_SA(1, 0), cA + kstep, voffA); PG8_STAGE(PG8_SB(1, 1), cB + hstep + kstep, voffB);
        PG8_WAIT_V(6); PG8_BAR;
    } else {
        PG8_STAGE(PG8_SB(0, 0), cB, voffB); PG8_STAGE(PG8_SA(0, 0), cA, voffA); PG8_STAGE(PG8_SB(0, 1), cB + hstep, voffB); PG8_STAGE(PG8_SA(0, 1), cA + hstep, voffA);
        if (wr == 1) PG8_BAR;
        PG8_WAIT_V(4); PG8_BAR;
        PG8_STAGE(PG8_SB(1, 0), cB + kstep, voffB); PG8_STAGE(PG8_SA(1, 0), cA + kstep, voffA); PG8_STAGE(PG8_SB(1, 1), cB + hstep + kstep, voffB);
        PG8_WAIT_V(6); PG8_BAR;
    }
    for (;;) {
        const bool has_next = S.next(ui + 1, nxt);
        const char* nA = has_next ? (const char*)g.A + (size_t)nxt.pm * tstep : cA; const char* nB = has_next ? (const char*)g.Bt + (size_t)nxt.pn * tstep : cB;
        for (int t = 0; t < nt; t += 2) {
            const bool last = (t == nt - 2);
            const char* a1 = cA + (size_t)(t + 1) * kstep;
            const char* a2 = last ? nA : cA + (size_t)(t + 2) * kstep; const char* b2 = last ? nB : cB + (size_t)(t + 2) * kstep;
            const char* a3 = a2 + kstep; const char* b3 = b2 + kstep;
            if (last && has_next) S.a_ready(nxt);
            if constexpr (SP2) {
            PG8_LDB(B0, 0, 0); PG8_LDB(B1, 0, 1); PG8_SCHED; PG8_LDA(At, 0, 0); PG8_STAGE(PG8_SA(1, 1), a1 + hstep, voffA);
            PG8_WAIT_V(8); PG8_WAIT_L(0); PG8_BAR; PG8_MMA(0, 0, At, B0); PG8_MMA(0, 1, At, B1); PG8_BAR; PG8_SCHED;
            PG8_LDA(At, 0, 1); PG8_STAGE(PG8_SB(0, 0), b2, voffB); PG8_STAGE(PG8_SB(0, 1), b2 + hstep, voffB); PG8_STAGE(PG8_SA(0, 0), a2, voffA);
            PG8_WAIT_V(8); PG8_WAIT_L(0); PG8_BAR; PG8_MMA(1, 0, At, B0); PG8_MMA(1, 1, At, B1); PG8_BAR; PG8_SCHED;
            PG8_LDB(B0, 1, 0); PG8_LDB(B1, 1, 1); PG8_SCHED; PG8_LDA(At, 1, 0); PG8_STAGE(PG8_SA(0, 1), a2 + hstep, voffA);
            PG8_WAIT_V(8); PG8_WAIT_L(0); PG8_BAR; PG8_MMA(0, 0, At, B0); PG8_MMA(0, 1, At, B1); PG8_BAR; PG8_SCHED;
            PG8_LDA(At, 1, 1); PG8_STAGE(PG8_SB(1, 0), b3, voffB); PG8_STAGE(PG8_SB(1, 1), b3 + hstep, voffB); PG8_STAGE(PG8_SA(1, 0), a3, voffA);
            PG8_WAIT_V(8); PG8_WAIT_L(0); PG8_BAR; PG8_MMA(1, 0, At, B0); PG8_MMA(1, 1, At, B1); PG8_BAR; PG8_SCHED;
            } else {
            PG8_LDB(B0, 0, 0); PG8_SCHED; PG8_LDA(At, 0, 0); PG8_STAGE(PG8_SA(1, 1), a1 + hstep, voffA);
            PG8_WAIT_L(8); PG8_BAR; PG8_WAIT_L(0); PG8_MMA(0, 0, At, B0); PG8_BAR; PG8_SCHED;
            PG8_LDB(B1, 0, 1); PG8_STAGE(PG8_SB(0, 0), b2, voffB);
            PG8_BAR; PG8_WAIT_L(0); PG8_MMA(0, 1, At, B1); PG8_BAR;
            PG8_LDA(At, 0, 1); PG8_STAGE(PG8_SA(0, 0), a2, voffA);
            PG8_BAR; PG8_WAIT_L(0); PG8_MMA(1, 0, At, B0); PG8_BAR; PG8_SCHED;
            PG8_STAGE(PG8_SB(0, 1), b2 + hstep, voffB);
            PG8_WAIT_V(6); PG8_BAR; PG8_MMA(1, 1, At, B1); PG8_BAR;
            PG8_LDB(B0, 1, 0); PG8_SCHED; PG8_LDA(At, 1, 0); PG8_STAGE(PG8_SA(0, 1), a2 + hstep, voffA);
            PG8_WAIT_L(8); PG8_BAR; PG8_WAIT_L(0); PG8_MMA(0, 0, At, B0); PG8_BAR; PG8_SCHED;
            PG8_LDB(B1, 1, 1); PG8_STAGE(PG8_SB(1, 0), b3, voffB);
            PG8_BAR; PG8_WAIT_L(0); PG8_MMA(0, 1, At, B1); PG8_BAR;
            PG8_LDA(At, 1, 1); PG8_STAGE(PG8_SA(1, 0), a3, voffA);
            PG8_BAR; PG8_WAIT_L(0); PG8_MMA(1, 0, At, B0); PG8_BAR; PG8_SCHED;
            PG8_STAGE(PG8_SB(1, 1), b3 + hstep, voffB);
            PG8_WAIT_V(6); PG8_BAR; PG8_MMA(1, 1, At, B1); PG8_BAR;
            }
        }
        if constexpr (ALIGN_EPI) { if (wr == 0) PG8_BAR; }
        if constexpr (!Epi::AFTER_DRAIN) { E(acc, cur, wr, wc, fr, fq); S.done(cur); }
        if (!has_next) break;
#pragma unroll
        for (int a = 0; a < 2; ++a)
#pragma unroll
            for (int b = 0; b < 2; ++b)
#pragma unroll
                for (int m = 0; m < 4; ++m)
#pragma unroll
                    for (int n = 0; n < 2; ++n) acc[a][b][m][n] = (f32x4){0.f, 0.f, 0.f, 0.f};
        cur = nxt; cA = nA; cB = nB; ++ui;
        if constexpr (ALIGN_EPI) { if (wr == 1) PG8_BAR; }
    }
    PG8_WAIT_V(0);
    if constexpr (!ALIGN_EPI) { if (wr == 0) PG8_BAR; }
    PG8_BAR;
    if constexpr (Epi::AFTER_DRAIN) { E.fused(acc, cur, wr, wc, fr, fq, lds, wid, lane); S.done(cur); }
#undef PG8_SA
#undef PG8_SB
#undef PG8_STAGE
#undef PG8_LDA
#undef PG8_LDB
#undef PG8_MMA
#undef PG8_WAIT_V
#undef PG8_WAIT_L
#undef PG8_BAR
#undef PG8_SCHED
}
}

typedef unsigned short bf16;
typedef float f32x4 __attribute__((ext_vector_type(4)));
typedef float f32x2 __attribute__((ext_vector_type(2)));
typedef unsigned u32x4 __attribute__((ext_vector_type(4)));
typedef unsigned u32x2 __attribute__((ext_vector_type(2)));

#ifndef MK_MULTI
#define MK_MULTI 0
#endif

constexpr int Bn = 8, S = 4096, T = Bn * S, D = 1024, FF = 2816, DEPTH = 4;
constexpr float EPS = 1e-6f;
constexpr int GDN_NPAD = 4352, NSA_NPAD = 2816;
constexpr int LDS_BYTES = 147456;
constexpr size_t MiB = 1u << 20;
constexpr size_t WS_WGU = 1 * MiB;
constexpr size_t WS_WDN = WS_WGU + 88 * MiB;
constexpr size_t WS_WGI = WS_WDN + 44 * MiB;
constexpr size_t WS_WGO = WS_WGI + 17 * MiB;
constexpr size_t WS_WSI = WS_WGO + 4 * MiB;
constexpr size_t WS_WSO = WS_WSI + 6 * MiB;
constexpr size_t WS_WNI = WS_WSO + 2 * MiB;
constexpr size_t WS_WNO = WS_WNI + 6 * MiB;
constexpr size_t WS_WC1 = WS_WNO + 2 * MiB;
constexpr size_t WS_TAB = WS_WC1 + 2 * MiB;
constexpr size_t WS_HN  = 184 * MiB;
constexpr size_t WS_R   = WS_HN + 64 * MiB;
constexpr size_t WS_O32 = WS_R + 256 * MiB;
constexpr size_t WS_SM  = WS_O32 + 128 * MiB;
constexpr size_t WS_AB  = WS_SM;
constexpr size_t WS_GT  = WS_SM + 2 * MiB;
constexpr size_t WS_BP  = WS_SM + 8 * MiB;
constexpr size_t WS_END = WS_SM + 9 * MiB;
static_assert(WS_TAB + 8 * MiB <= WS_HN, "ws map");

__device__ __forceinline__ float bf2f(unsigned v) { return __uint_as_float(v << 16); }
__device__ __forceinline__ unsigned f2bf(float f) { unsigned u = __float_as_uint(f); return (u + 0x7fffu + ((u >> 16) & 1u)) >> 16; }
__device__ __forceinline__ unsigned pk2(float lo, float hi) { return f2bf(lo) | (f2bf(hi) << 16); }
#define MFMA32(a, b, c) __builtin_amdgcn_mfma_f32_32x32x16_bf16((a), (b), (c), 0, 0, 0)
typedef short bf16x8v __attribute__((ext_vector_type(8)));
typedef float f32x16 __attribute__((ext_vector_type(16)));
typedef __bf16 bf16v2 __attribute__((ext_vector_type(2)));
__device__ __forceinline__ unsigned pkbf(float a, float b) { f32x2 v = {a, b}; return __builtin_bit_cast(unsigned, __builtin_convertvector(v, bf16v2)); }
__device__ __forceinline__ int lane_opq() { int l = (int)__builtin_amdgcn_mbcnt_hi(~0u, __builtin_amdgcn_mbcnt_lo(~0u, 0u)); asm volatile("" : "+v"(l)); return l; }
__device__ __forceinline__ float xshfl(float v, int m) { return __int_as_float(__builtin_amdgcn_ds_bpermute((lane_opq() ^ m) << 2, __float_as_int(v))); }
__device__ __forceinline__ float xshfl_up(float v, int o) { return __int_as_float(__builtin_amdgcn_ds_bpermute((lane_opq() - o) << 2, __float_as_int(v))); }
__device__ __forceinline__ float wave_sum(float v) {
#pragma unroll
    for (int o = 1; o < 64; o <<= 1) v += xshfl(v, o);
    return v;
}
__device__ __forceinline__ float wave_max(float v) {
#pragma unroll
    for (int o = 1; o < 64; o <<= 1) v = fmaxf(v, xshfl(v, o));
    return v;
}
__device__ __forceinline__ float row_sum16(float v) {
    v += __uint_as_float((unsigned)__builtin_amdgcn_update_dpp(0, (int)__float_as_uint(v), 0x128, 0xf, 0xf, false));
    v += __uint_as_float((unsigned)__builtin_amdgcn_update_dpp(0, (int)__float_as_uint(v), 0x124, 0xf, 0xf, false));
    v += __uint_as_float((unsigned)__builtin_amdgcn_update_dpp(0, (int)__float_as_uint(v), 0x122, 0xf, 0xf, false));
    v += __uint_as_float((unsigned)__builtin_amdgcn_update_dpp(0, (int)__float_as_uint(v), 0x121, 0xf, 0xf, false));
    return v;
}
__device__ __forceinline__ float sigmoidf_(float x) { return 1.f / (1.f + __expf(-x)); }
__device__ __forceinline__ float siluf_(float x) { return x * __builtin_amdgcn_rcpf(1.f + __expf(-x)); }
#define LDS_BAR() do { asm volatile("s_waitcnt lgkmcnt(0)" ::: "memory"); __builtin_amdgcn_s_barrier(); asm volatile("" ::: "memory"); } while (0)
#define WAVE_SYNC() do { asm volatile("s_waitcnt lgkmcnt(0)" ::: "memory"); __builtin_amdgcn_wave_barrier(); } while (0)

__device__ __forceinline__ float row_rstd(const float* ssq, size_t row) {
    const f32x4* p = (const f32x4*)(ssq + row * 16); const f32x4 a = p[0], b = p[1], c = p[2], d = p[3];
    const float t = ((a.x + a.y) + (a.z + a.w)) + ((b.x + b.y) + (b.z + b.w)) + ((c.x + c.y) + (c.z + c.w)) + ((d.x + d.y) + (d.z + d.w));
    return 1.f / sqrtf(t * (1.f / D) + EPS);
}
namespace pg8 {
struct EpiSwiGLU {
    static constexpr bool PERM = true, AFTER_DRAIN = false;
    bf16_t* O; const float* ssq;
    __device__ __forceinline__ void operator()(const f32x4 (&acc)[2][2][4][2], const Unit& u, int wr, int wc, int fr, int fq) const {
        const int row0 = u.pm * BM + wr * 64 + fr, col0 = u.pn * HALF + wc * 32 + 8 * fq;
#pragma unroll
        for (int ai = 0; ai < 2; ++ai)
#pragma unroll
            for (int m = 0; m < 4; ++m) {
                bf16_t* rowp = O + (size_t)(row0 + ai * HALF + m * 16) * FF + col0;
                const float rs = ssq[u.ord * 256 + wr * 64 + fr + ai * HALF + m * 16];
                float v[8];
#pragma unroll
                for (int n = 0; n < 2; ++n)
#pragma unroll
                    for (int j = 0; j < 4; ++j) { const float g = acc[ai][0][m][n][j] * rs, uu = acc[ai][1][m][n][j] * rs; v[n * 4 + j] = g * __builtin_amdgcn_rcpf(1.f + __expf(-g)) * uu; }
                u32x4 w; w.x = cvt_pk_bf16(v[0], v[1]); w.y = cvt_pk_bf16(v[2], v[3]); w.z = cvt_pk_bf16(v[4], v[5]); w.w = cvt_pk_bf16(v[6], v[7]);
                *(u32x4*)rowp = w;
            }
    }
};
template <int SC2> struct EpiResid {
    static constexpr bool PERM = true, AFTER_DRAIN = false;
    const float* base; float* out; bf16_t* HB; float* ssq;
    __device__ __forceinline__ void operator()(const f32x4 (&acc)[2][2][4][2], const Unit& u, int wr, int wc, int fr, int fq) const {
        constexpr float scale = 0.5f * SC2;
        const int row0 = u.pm * BM + wr * 64 + fr, col0 = u.pn * BM + wc * 32 + 8 * fq;
#pragma unroll
        for (int ai = 0; ai < 2; ++ai)
#pragma unroll
            for (int m = 0; m < 4; ++m) {
                const size_t off = (size_t)(row0 + ai * HALF + m * 16) * D + col0;
                float sq = 0.f;
#pragma unroll
                for (int bj = 0; bj < 2; ++bj) {
                    const f32x4 b0 = *(const f32x4*)(base + off + bj * HALF), b1 = *(const f32x4*)(base + off + bj * HALF + 4);
                    const f32x4 o0 = b0 + acc[ai][bj][m][0] * scale, o1 = b1 + acc[ai][bj][m][1] * scale;
                    *(f32x4*)(out + off + bj * HALF) = o0; *(f32x4*)(out + off + bj * HALF + 4) = o1;
                    { u32x4 w; w.x = cvt_pk_bf16(o0[0], o0[1]); w.y = cvt_pk_bf16(o0[2], o0[3]); w.z = cvt_pk_bf16(o1[0], o1[1]); w.w = cvt_pk_bf16(o1[2], o1[3]);
                        *(u32x4*)(HB + off + bj * HALF) = w;
                        sq += ((o0[0] * o0[0] + o0[1] * o0[1]) + (o0[2] * o0[2] + o0[3] * o0[3])) + ((o1[0] * o1[0] + o1[1] * o1[1]) + (o1[2] * o1[2] + o1[3] * o1[3])); }
                }
                { sq += xshfl(sq, 16); sq += xshfl(sq, 32); if (fq == 0) ssq[(size_t)(row0 + ai * HALF + m * 16) * 16 + u.pn * 4 + wc] = sq; }
                if (m == 3) asm volatile("" ::: "memory");
            }
    }
};
struct EpiProj {
    static constexpr bool PERM = true, AFTER_DRAIN = false;
    bf16_t* O; int ldc; int nmain; float* tail; int ldt; int nvalid; const float* ssq;
    __device__ __forceinline__ void operator()(const f32x4 (&acc)[2][2][4][2], const Unit& u, int wr, int wc, int fr, int fq) const {
        const int row0 = u.pm * BM + wr * 64 + fr, colt = u.pn * BM, col0 = colt + wc * 32 + 8 * fq;
        if (colt + BM <= nmain) {
#pragma unroll
            for (int ai = 0; ai < 2; ++ai)
#pragma unroll
                for (int m = 0; m < 4; ++m) {
                    bf16_t* rowp = O + (size_t)(row0 + ai * HALF + m * 16) * ldc + col0;
                    const float rs = ssq[u.ord * 256 + wr * 64 + fr + ai * HALF + m * 16];
#pragma unroll
                    for (int bj = 0; bj < 2; ++bj) { const f32x4 v0 = acc[ai][bj][m][0] * rs, v1 = acc[ai][bj][m][1] * rs;
                        u32x4 w; w.x = cvt_pk_bf16(v0[0], v0[1]); w.y = cvt_pk_bf16(v0[2], v0[3]); w.z = cvt_pk_bf16(v1[0], v1[1]); w.w = cvt_pk_bf16(v1[2], v1[3]);
                        *(u32x4*)(rowp + bj * HALF) = w; }
                }
        } else {
#pragma unroll
            for (int ai = 0; ai < 2; ++ai)
#pragma unroll
                for (int m = 0; m < 4; ++m) {
                    const size_t row = (size_t)(row0 + ai * HALF + m * 16);
                    const float rs = ssq[u.ord * 256 + wr * 64 + fr + ai * HALF + m * 16];
#pragma unroll
                    for (int bj = 0; bj < 2; ++bj)
#pragma unroll
                        for (int n = 0; n < 2; ++n)
#pragma unroll
                            for (int j = 0; j < 4; ++j) { const int col = col0 + bj * HALF + 4 * n + j; if (col >= nmain && col < nvalid) tail[row * ldt + (col - nmain)] = acc[ai][bj][m][n][j] * rs; }
                }
        }
    }
};
struct EpiF32 {
    static constexpr bool PERM = false, AFTER_DRAIN = false;
    float* C; int ldc;
    __device__ __forceinline__ void operator()(const f32x4 (&acc)[2][2][4][2], const Unit& u, int wr, int wc, int fr, int fq) const {
        const int row0 = u.pm * BM + wr * 64 + fr, col0 = u.pn * BM + wc * 32 + 4 * fq;
#pragma unroll
        for (int ai = 0; ai < 2; ++ai)
#pragma unroll
            for (int m = 0; m < 4; ++m) {
                float* rowp = C + (size_t)(row0 + ai * HALF + m * 16) * ldc + col0;
#pragma unroll
                for (int bj = 0; bj < 2; ++bj)
#pragma unroll
                    for (int n = 0; n < 2; ++n) *(f32x4*)(rowp + bj * HALF + n * 16) = acc[ai][bj][m][n];
            }
    }
};
}

template <class Sched>
__device__ __forceinline__ void rstd_table(float* tab, const float* ssq, const Sched& SO, int tid) {
    pg8::Unit u;
    int nu = 0; while (SO.next(nu, u)) ++nu;
    for (int k0 = 0; k0 < nu * 256; k0 += 512 * 3) {
        float t3[3];
#pragma unroll
        for (int k = 0; k < 3; ++k) { const int idx = k0 + 512 * k + tid; t3[k] = 0.f; if (idx < nu * 256) { SO.next(idx >> 8, u); t3[k] = row_rstd(ssq, (size_t)u.pm * 256 + (idx & 255)); } }
#pragma unroll
        for (int k = 0; k < 3; ++k) { const int idx = k0 + 512 * k + tid; if (idx < nu * 256) tab[idx] = t3[k]; }
    }
    __syncthreads();
}
__device__ __forceinline__ void xpose_item(const float* W, const float* nw, int K, int N, bf16* WT, int rowbase, float* scr, int k0, int n0, int lane) {
    if (n0 + 32 <= N && (N & 3) == 0) {
        f32x4 v[8];
#pragma unroll
        for (int i = 0; i < 8; ++i) { v[i] = *(const f32x4*)(W + (size_t)(k0 + 8 * i + (lane >> 3)) * N + n0 + 4 * (lane & 7)); if (nw) v[i] *= nw[k0 + 8 * i + (lane >> 3)]; }
#pragma unroll
        for (int i = 0; i < 8; ++i) { float* d = scr + (8 * i + (lane >> 3)) * 33 + 4 * (lane & 7); d[0] = v[i].x; d[1] = v[i].y; d[2] = v[i].z; d[3] = v[i].w; }
    } else {
#pragma unroll 8
        for (int i = 0; i < 32; ++i) { const int kk = 2 * i + (lane >> 5), n = n0 + (lane & 31); scr[kk * 33 + (lane & 31)] = n < N ? W[(size_t)(k0 + kk) * N + n] * (nw ? nw[k0 + kk] : 1.f) : 0.f; }
    }
    WAVE_SYNC();
    const int c = lane & 7;
#pragma unroll
    for (int j = 0; j < 4; ++j) { const int n = (lane >> 3) + 8 * j; const float* s = scr + (8 * c) * 33 + n;
        u32x4 o; o.x = pk2(s[0 * 33], s[1 * 33]); o.y = pk2(s[2 * 33], s[3 * 33]); o.z = pk2(s[4 * 33], s[5 * 33]); o.w = pk2(s[6 * 33], s[7 * 33]);
        *(u32x4*)(WT + (size_t)(rowbase + n) * K + k0 + 8 * c) = o; }
    WAVE_SYNC();
}
__device__ __forceinline__ void xpose_matrix(const float* W, const float* nw, int K, int N, int Npad, bf16* WT, int mode, float* scr, int gw, int NGW, int lane) {
    const int nblk = Npad / 32, nitems = (K / 64) * nblk;
    for (int it = gw; it < nitems; it += NGW) {
        const int kb = it / nblk, nb = it - kb * nblk, n0 = nb * 32;
        int rb = n0;
        if (mode == 1) rb = (n0 < FF) ? ((n0 >> 7) * 256 + (n0 & 127)) : ((((n0 - FF) >> 7) * 256) + 128 + ((n0 - FF) & 127));
        xpose_item(W, nw, K, N, WT, rb, scr, kb * 64, n0, lane);
    }
}

__device__ __forceinline__ void phase_norm(const float* h, const float* w, bf16* out, int gw, int NGW, int lane) {
    f32x4 wv[4];
#pragma unroll
    for (int j = 0; j < 4; ++j) wv[j] = ((const f32x4*)w)[64 * j + lane];
    for (int m = gw; m < T; m += NGW) {
        const f32x4* xr = (const f32x4*)(h + (size_t)m * D) + lane;
        f32x4 v[4]; float s = 0.f;
#pragma unroll
        for (int j = 0; j < 4; ++j) { v[j] = xr[64 * j]; s += (v[j].x * v[j].x + v[j].y * v[j].y) + (v[j].z * v[j].z + v[j].w * v[j].w); }
        const float rstd = 1.f / sqrtf(wave_sum(s) * (1.f / D) + EPS);
        u32x2* o8 = (u32x2*)(out + (size_t)m * D) + lane;
#pragma unroll
        for (int j = 0; j < 4; ++j) { u32x2 o; o.x = pk2(v[j].x * rstd * wv[j].x, v[j].y * rstd * wv[j].y); o.y = pk2(v[j].z * rstd * wv[j].z, v[j].w * rstd * wv[j].w); o8[64 * j] = o; }
    }
}

__device__ __forceinline__ void phase_gdn_scan(unsigned char* lds, const bf16* proj, const float* ab, const float* convw, const float* A_log, const float* dt_bias,
                                               float* o32, int vblk, int nblk, int tid, int wid, int lane) {
    float* qs = (float*)lds;
    float* ks = qs + 64 * 128;
    float* vs = ks + 64 * 128;
    float* al = vs + 64 * 32;
    float* be = al + 64;
    float* qk = be + 64;
    float* os = qk + 64;
    bf16* raw = (bf16*)(os + 64 * 32);
    const int e = tid >> 4, dl = tid & 15;
    for (int item = vblk; item < 256; item += nblk) {
        const int bh = (item & 7) + 8 * (item >> 5), es = (item >> 3) & 3, b = bh >> 3, h = bh & 7;
        const float Ah = __expf(A_log[h]), dtb = dt_bias[h];
        const int isk = (tid >> 4) & 1, cg = tid & 15, cv = tid & 3;
        const int colqk = isk * 1024 + h * 128 + cg * 8, colv = 2048 + h * 128 + es * 32 + cv * 8;
        f32x4 wq[4][2], wv[4][2];
#pragma unroll
        for (int j = 0; j < 4; ++j) { wq[j][0] = *(const f32x4*)(convw + j * 3072 + colqk); wq[j][1] = *(const f32x4*)(convw + j * 3072 + colqk + 4);
                                      wv[j][0] = *(const f32x4*)(convw + j * 3072 + colv);  wv[j][1] = *(const f32x4*)(convw + j * 3072 + colv + 4); }
        f32x2 S2[4];
#pragma unroll
        for (int i = 0; i < 4; ++i) S2[i] = (f32x2){0.f, 0.f};
        u32x4 pre[5];
#define GDN_PREFETCH(T0) do { _Pragma("unroll") for (int k_ = 0; k_ < 5; ++k_) { const int idx_ = tid + 512 * k_; const int row_ = idx_ / 36, c_ = idx_ - row_ * 36; const int ts_ = (T0) - 3 + row_; \
            const int col_ = c_ < 16 ? h * 128 + c_ * 8 : (c_ < 32 ? 1024 + h * 128 + (c_ - 16) * 8 : 2048 + h * 128 + es * 32 + (c_ - 32) * 8); \
            pre[k_] = (u32x4){0u, 0u, 0u, 0u}; if (idx_ < 67 * 36 && ts_ >= 0) pre[k_] = *(const u32x4*)(proj + (size_t)(b * S + ts_) * 4096 + col_); } } while (0)
#define GDN_PARK() do { _Pragma("unroll") for (int k_ = 0; k_ < 5; ++k_) { const int idx_ = tid + 512 * k_; if (idx_ < 67 * 36) *(u32x4*)(raw + idx_ * 8) = pre[k_]; } } while (0)
#define GDN_CONV8(ROW0, C8, W, OUT) do { _Pragma("unroll") for (int i_ = 0; i_ < 8; ++i_) OUT[i_] = 0.f; _Pragma("unroll") for (int j_ = 0; j_ < 4; ++j_) { const u32x4 xv_ = *(const u32x4*)(raw + ((ROW0) + j_) * 288 + (C8) * 8); \
            OUT[0] += bf2f(xv_.x & 0xffffu) * W[j_][0].x; OUT[1] += bf2f(xv_.x >> 16) * W[j_][0].y; OUT[2] += bf2f(xv_.y & 0xffffu) * W[j_][0].z; OUT[3] += bf2f(xv_.y >> 16) * W[j_][0].w; \
            OUT[4] += bf2f(xv_.z & 0xffffu) * W[j_][1].x; OUT[5] += bf2f(xv_.z >> 16) * W[j_][1].y; OUT[6] += bf2f(xv_.w & 0xffffu) * W[j_][1].z; OUT[7] += bf2f(xv_.w >> 16) * W[j_][1].w; } \
            _Pragma("unroll") for (int i_ = 0; i_ < 8; ++i_) OUT[i_] = siluf_(OUT[i_]); } while (0)
#define GDN_CONVNORM(T0) do { \
            _Pragma("unroll") for (int it_ = 0; it_ < 4; ++it_) { const int tok_ = it_ * 16 + (tid >> 5); float y_[8]; GDN_CONV8(tok_, isk * 16 + cg, wq, y_); \
                float ss_ = (y_[0] * y_[0] + y_[1] * y_[1]) + (y_[2] * y_[2] + y_[3] * y_[3]) + (y_[4] * y_[4] + y_[5] * y_[5]) + (y_[6] * y_[6] + y_[7] * y_[7]); \
                ss_ = row_sum16(ss_); const float sc_ = (1.f / sqrtf(ss_ + EPS)) * (isk ? 1.f : 0.08838834764831845f); \
                float* d_ = (isk ? ks : qs) + tok_ * 128 + cg * 8; \
                _Pragma("unroll") for (int i_ = 0; i_ < 8; ++i_) y_[i_] *= sc_; \
                *(f32x4*)d_ = (f32x4){y_[0], y_[1], y_[2], y_[3]}; *(f32x4*)(d_ + 4) = (f32x4){y_[4], y_[5], y_[6], y_[7]}; \
                float dq_ = 0.f; _Pragma("unroll") for (int i_ = 0; i_ < 8; ++i_) dq_ += y_[i_] * xshfl(y_[i_], 16); \
                dq_ = row_sum16(dq_); if (isk == 0 && cg == 0) qk[tok_] = dq_; } \
            if (tid < 256) { const int tok_ = tid >> 2; float y_[8]; GDN_CONV8(tok_, 32 + cv, wv, y_); float* d_ = vs + tok_ * 32 + cv * 8; \
                *(f32x4*)d_ = (f32x4){y_[0], y_[1], y_[2], y_[3]}; *(f32x4*)(d_ + 4) = (f32x4){y_[4], y_[5], y_[6], y_[7]}; } \
            if (tid < 64) { const size_t tg_ = (size_t)(b * S + (T0) + tid); const float a_ = ab[tg_ * 16 + h] + dtb, bb_ = ab[tg_ * 16 + 8 + h]; \
                const float sp_ = a_ > 20.f ? a_ : __logf(1.f + __expf(a_)); al[tid] = __expf(-Ah * sp_); be[tid] = sigmoidf_(bb_); } } while (0)
        __syncthreads();
        GDN_PREFETCH(0); GDN_PARK();
        __syncthreads();
        GDN_CONVNORM(0);
        __syncthreads();
        for (int chunk = 0; chunk < S / 64; ++chunk) {
            const int t0 = chunk * 64;
            const bool more = chunk + 1 < S / 64;
            if (more) GDN_PREFETCH(t0 + 64);
            {
                const float* kp = ks + dl * 8; const float* qp = qs + dl * 8; const float* vp = vs + e;
                f32x4 nk0 = *(const f32x4*)kp, nk1 = *(const f32x4*)(kp + 4), nq0 = *(const f32x4*)qp, nq1 = *(const f32x4*)(qp + 4);
                float nv = vp[0], na = al[0], nb = be[0], nqk = qk[0];
                for (int t16 = 0; t16 < 4; ++t16) {
                    float ok = 0.f;
#pragma unroll 4
                    for (int i = 0; i < 16; ++i) {
                        const int tt = t16 * 16 + i, tn = (tt + 1) & 63;
                        const f32x2 K0 = {nk0.x, nk0.y}, K1 = {nk0.z, nk0.w}, K2 = {nk1.x, nk1.y}, K3 = {nk1.z, nk1.w};
                        const f32x2 Q0 = {nq0.x, nq0.y}, Q1 = {nq0.z, nq0.w}, Q2 = {nq1.x, nq1.y}, Q3 = {nq1.z, nq1.w};
                        const float v = nv, a = na, bt = nb, qkt = nqk;
                        nk0 = *(const f32x4*)(kp + tn * 128); nk1 = *(const f32x4*)(kp + tn * 128 + 4); nq0 = *(const f32x4*)(qp + tn * 128); nq1 = *(const f32x4*)(qp + tn * 128 + 4);
                        nv = vp[tn * 32]; na = al[tn]; nb = be[tn]; nqk = qk[tn];
                        f32x2 pa = K0 * S2[0], pb = K2 * S2[2], qa = Q0 * S2[0], qb = Q2 * S2[2];
                        pa = K1 * S2[1] + pa; pb = K3 * S2[3] + pb; qa = Q1 * S2[1] + qa; qb = Q3 * S2[3] + qb;
                        pa += pb; qa += qb;
                        float p = pa.x + pa.y, qS = qa.x + qa.y;
                        p = row_sum16(p); qS = row_sum16(qS);
                        const float vn = bt * (v - a * p);
                        const float o = a * qS + qkt * vn;
                        const f32x2 vn2 = {vn, vn}, a2 = {a, a};
                        S2[0] = S2[0] * a2 + K0 * vn2; S2[1] = S2[1] * a2 + K1 * vn2; S2[2] = S2[2] * a2 + K2 * vn2; S2[3] = S2[3] * a2 + K3 * vn2;
                        ok = (i == dl) ? o : ok;
                    }
                    os[(t16 * 16 + dl) * 32 + e] = ok;
                }
            }
            __syncthreads();
            { const int tok = tid >> 3, c4 = tid & 7;
              *(f32x4*)(o32 + (size_t)(b * S + t0 + tok) * D + h * 128 + es * 32 + c4 * 4) = *(const f32x4*)(os + tok * 32 + c4 * 4); }
            if (more) {
                GDN_PARK();
                __syncthreads();
                GDN_CONVNORM(t0 + 64);
            }
            __syncthreads();
        }
#undef GDN_PREFETCH
#undef GDN_PARK
#undef GDN_CONV8
#undef GDN_CONVNORM
    }
}

constexpr size_t WS_HALO = WS_END;
constexpr size_t WS_GL = WS_END + 10 * MiB;
constexpr size_t WS_SS = WS_GL + 1 * MiB;
constexpr size_t WS_END2 = WS_SS + 26 * MiB;

__device__ __forceinline__ void phase_gdn_halo(const bf16* proj, bf16* halo, int gtid, int NT) {
    for (int idx = gtid; idx < Bn * 64 * 3 * 384; idx += NT) {
        const int c = idx % 384, r3 = (idx / 384) % 3, bn = idx / (384 * 3), n = bn & 63, b = bn >> 6;
        u32x4 v = {0u, 0u, 0u, 0u};
        if (n > 0) v = *(const u32x4*)(proj + (size_t)(b * S + 64 * n - 3 + r3) * 4096 + c * 8);
        *(u32x4*)(halo + (size_t)(bn * 3 + r3) * 3072 + c * 8) = v;
    }
}

constexpr int GP_RAW = 0, GP_QB = 51456, GP_KB = GP_QB + 17408, GP_VB = GP_KB + 17408, GP_AM = GP_VB + 16384, GP_GC = GP_AM + 17408, GP_W = GP_GC + 1024;
__device__ __forceinline__ void phase_gdn_prep(unsigned char* lds, bf16* proj, const bf16* halo, const float* ab, const float* convw, const float* A_log, const float* dt_bias,
                                               bf16* KT, bf16* AT, float* GL, int vblk, int nblk, int tid, int wid, int lane) {
    bf16* raw = (bf16*)(lds + GP_RAW);
    bf16* wimg = (bf16*)(lds + GP_W);
    unsigned char* qb = lds + GP_QB;
    unsigned char* kb = lds + GP_KB;
    bf16* vb = (bf16*)(lds + GP_VB);
    float* Am = (float*)(lds + GP_AM);
    float* gcs = (float*)(lds + GP_GC);
    float* bes = gcs + 64;
    const int r = lane & 31, hh = lane >> 5;
    for (int item = vblk; item < Bn * 8 * 64; item += nblk) {
        const int n = item & 63, h = (item >> 6) & 7, b = item >> 9;
        const size_t tok0 = (size_t)b * S + 64 * n;
        LDS_BAR();
#define GP_RAWLOAD(ITEM, T0, NT) do { const int n_ = (ITEM) & 63, h_ = ((ITEM) >> 6) & 7, b_ = (ITEM) >> 9; const size_t tk0_ = (size_t)b_ * S + 64 * n_; \
        for (int idx = (T0); idx < 67 * 48; idx += (NT)) { const int row = idx / 48, c = idx - row * 48; \
            const int col = c < 16 ? h_ * 128 + c * 8 : (c < 32 ? 1024 + h_ * 128 + (c - 16) * 8 : 2048 + h_ * 128 + (c - 32) * 8); \
            u32x4 v; if (row < 3) v = *(const u32x4*)(halo + (size_t)((b_ * 64 + n_) * 3 + row) * 3072 + col); else v = *(const u32x4*)(proj + (tk0_ + row - 3) * 4096 + col); \
            *(u32x4*)(raw + row * 384 + c * 8) = v; } } while (0)
        if (item == vblk) GP_RAWLOAD(item, tid, 512);
        if (tid < 64) {
            const float a = ab[(tok0 + tid) * 16 + h] + dt_bias[h], bb = ab[(tok0 + tid) * 16 + 8 + h];
            const float sp = a > 20.f ? a : __logf(1.f + __expf(a));
            float g = -__expf(A_log[h]) * sp;
#pragma unroll
            for (int o = 1; o < 64; o <<= 1) { const float t_ = xshfl_up(g, o); if (lane >= o) g += t_; }
            const float be_ = sigmoidf_(bb);
            gcs[tid] = g; bes[tid] = be_; gcs[128 + tid] = be_; gcs[192 + tid] = be_ * __expf(g);
        }
        LDS_BAR();
        {
            const int isk = (tid >> 4) & 1, cg = tid & 15;
            const int colqk = isk * 1024 + h * 128 + cg * 8, colv = 2048 + h * 128 + cg * 8;
#define GP_CONV8(ROW0, C8, COL, OUT) do { _Pragma("unroll") for (int i_ = 0; i_ < 8; ++i_) OUT[i_] = 0.f; _Pragma("unroll") for (int j_ = 0; j_ < 4; ++j_) { const u32x4 xv_ = *(const u32x4*)(raw + ((ROW0) + j_) * 384 + (C8) * 8); \
            const f32x4 w0_ = *(const f32x4*)(convw + j_ * 3072 + (COL)), w1_ = *(const f32x4*)(convw + j_ * 3072 + (COL) + 4); \
            OUT[0] += bf2f(xv_.x & 0xffffu) * w0_.x; OUT[1] += bf2f(xv_.x >> 16) * w0_.y; OUT[2] += bf2f(xv_.y & 0xffffu) * w0_.z; OUT[3] += bf2f(xv_.y >> 16) * w0_.w; \
            OUT[4] += bf2f(xv_.z & 0xffffu) * w1_.x; OUT[5] += bf2f(xv_.z >> 16) * w1_.y; OUT[6] += bf2f(xv_.w & 0xffffu) * w1_.z; OUT[7] += bf2f(xv_.w >> 16) * w1_.w; } \
            _Pragma("unroll") for (int i_ = 0; i_ < 8; ++i_) OUT[i_] = siluf_(OUT[i_]); } while (0)
#pragma unroll 1
            for (int it = 0; it < 4; ++it) {
                const int tk = it * 16 + (tid >> 5);
                float y[8]; GP_CONV8(tk, isk * 16 + cg, colqk, y);
                float ss = (y[0] * y[0] + y[1] * y[1]) + (y[2] * y[2] + y[3] * y[3]) + (y[4] * y[4] + y[5] * y[5]) + (y[6] * y[6] + y[7] * y[7]);
                ss = row_sum16(ss);
                const float sc = (1.f / sqrtf(ss + EPS)) * (isk ? 1.f : 0.08838834764831845f);
                u32x4 w; w.x = pkbf(y[0] * sc, y[1] * sc); w.y = pkbf(y[2] * sc, y[3] * sc); w.z = pkbf(y[4] * sc, y[5] * sc); w.w = pkbf(y[6] * sc, y[7] * sc);
                *(u32x4*)((isk ? kb : qb) + tk * 272 + cg * 16) = w;
            }
#pragma unroll 1
            for (int it = 0; it < 2; ++it) {
                const int tk = it * 32 + (tid >> 4);
                float y[8]; GP_CONV8(tk, 32 + cg, colv, y);
                u32x4 w; w.x = pkbf(y[0], y[1]); w.y = pkbf(y[2], y[3]); w.z = pkbf(y[4], y[5]); w.w = pkbf(y[6], y[7]);
                *(u32x4*)(vb + tk * 128 + cg * 8) = w;
            }
#undef GP_CONV8
        }
        LDS_BAR();
        {
            const int prod = wid >> 2, tr = (wid >> 1) & 1, tc = wid & 1;
            f32x16 acc;
#pragma unroll
            for (int i = 0; i < 16; ++i) acc[i] = 0.f;
            if (tr >= tc) {
                const unsigned char* Ab = (prod ? qb : kb) + (32 * tr + r) * 272 + hh * 16;
                const unsigned char* Bb = kb + (32 * tc + r) * 272 + hh * 16;
#pragma unroll
                for (int ks = 0; ks < 8; ++ks) acc = MFMA32(*(const bf16x8v*)(Ab + ks * 32), *(const bf16x8v*)(Bb + ks * 32), acc);
            }
            const int j = 32 * tc + r; const float gj = gcs[j];
#pragma unroll
            for (int i_ = 0; i_ < 16; ++i_) {
                const int i = 32 * tr + (i_ & 3) + 8 * (i_ >> 2) + 4 * hh;
                const float dec = __expf(gcs[i] - gj);
                if (prod == 0) Am[i * 68 + j] = (j < i) ? bes[i] * acc[i_] * dec : 0.f;
                else AT[(size_t)item * 4096 + i * 64 + j] = (bf16)f2bf((j <= i) ? acc[i_] * dec : 0.f);
            }
        }
        LDS_BAR();
        int tid3 = tid; asm volatile("" : "+v"(tid3));
        if (tid3 < 256) {
            const int isw = tid3 >> 7, d = tid3 & 127;
            unsigned oam = GP_AM, orsc = GP_GC + 512 + isw * 256, ocol = (isw ? GP_KB : GP_VB) + d * 2;
            asm volatile("" : "+v"(oam), "+v"(orsc), "+v"(ocol));
            const float* Am_ = (const float*)(lds + oam); const float* rsc = (const float*)(lds + orsc); const unsigned char* col = lds + ocol;
            const int cstride = isw ? 272 : 256;
            float X[64];
#pragma clang loop unroll(full)
            for (int i = 0; i < 64; ++i) X[i] = 0.f;
#pragma clang loop unroll(full)
            for (int i = 0; i < 64; ++i) {
                f32x4 av = {0.f, 0.f, 0.f, 0.f};
#pragma clang loop unroll(full)
                for (int j4 = 0; j4 < 16; ++j4) { if (4 * j4 < i) { const f32x4 a4 = *(const f32x4*)(Am_ + i * 68 + 4 * j4);
                    const f32x4 x4 = {X[4 * j4], X[4 * j4 + 1], X[4 * j4 + 2], X[4 * j4 + 3]}; av += a4 * x4; } }
                X[i] = rsc[i] * bf2f(*(const bf16*)(col + i * cstride)) - ((av.x + av.y) + (av.z + av.w));
                asm volatile("" ::: "memory");
            }
            if (isw) {
#pragma unroll
                for (int i = 0; i < 64; ++i) wimg[i * 128 + d] = (bf16)f2bf(X[i]);
            } else {
                bf16* up = proj + (tok0 + (d >> 1)) * 4096 + 2048 + h * 128 + (d & 1) * 64;
#pragma unroll
                for (int i8 = 0; i8 < 8; ++i8) { u32x4 w; w.x = pkbf(X[8 * i8], X[8 * i8 + 1]); w.y = pkbf(X[8 * i8 + 2], X[8 * i8 + 3]); w.z = pkbf(X[8 * i8 + 4], X[8 * i8 + 5]); w.w = pkbf(X[8 * i8 + 6], X[8 * i8 + 7]);
                    *(u32x4*)(up + 8 * i8) = w; }
            }
        } else {
            if (tid3 < 384) {
                const int d = tid3 - 256; const float gl_ = gcs[63];
                bf16* kp = KT + (size_t)item * 8192 + d * 64;
#pragma unroll
                for (int i8 = 0; i8 < 8; ++i8) { float y[8];
#pragma unroll
                    for (int i = 0; i < 8; ++i) y[i] = bf2f(*(const bf16*)(kb + (8 * i8 + i) * 272 + d * 2)) * __expf(gl_ - gcs[8 * i8 + i]);
                    u32x4 w; w.x = pkbf(y[0], y[1]); w.y = pkbf(y[2], y[3]); w.z = pkbf(y[4], y[5]); w.w = pkbf(y[6], y[7]);
                    *(u32x4*)(kp + 8 * i8) = w; }
                if (d == 0) GL[item] = __expf(gl_);
            }
#pragma unroll
            for (int k = 0; k < 4; ++k) {
                const int pc = (tid3 - 256) + 256 * k, i = pc >> 4, c8 = pc & 15;
                const u32x4 v = *(const u32x4*)(qb + i * 272 + c8 * 16); const float eg = __expf(gcs[i]);
                u32x4 w; w.x = pkbf(bf2f(v.x & 0xffffu) * eg, bf2f(v.x >> 16) * eg); w.y = pkbf(bf2f(v.y & 0xffffu) * eg, bf2f(v.y >> 16) * eg);
                w.z = pkbf(bf2f(v.z & 0xffffu) * eg, bf2f(v.z >> 16) * eg); w.w = pkbf(bf2f(v.w & 0xffffu) * eg, bf2f(v.w >> 16) * eg);
                *(u32x4*)(proj + (tok0 + i) * 4096 + h * 128 + c8 * 8) = w;
            }
            if (item + nblk < Bn * 8 * 64) GP_RAWLOAD(item + nblk, tid3 - 256, 256);
        }
        LDS_BAR();
#pragma unroll
        for (int k = 0; k < 2; ++k) { const int pc = tid + 512 * k, i = pc >> 4, c8 = pc & 15;
            *(u32x4*)(proj + (tok0 + i) * 4096 + 1024 + h * 128 + c8 * 8) = *(const u32x4*)(wimg + i * 128 + c8 * 8); }
    }
}

#undef GP_RAWLOAD
__device__ __forceinline__ void phase_gdn_scan2(unsigned char* lds, const bf16* proj, const bf16* KT, const bf16* AT, const float* GL, bf16* o16, int vblk, int nblk, int tid, int wid, int lane) {
    unsigned char* Sl = lds;
    unsigned char* Vl = lds + 8704;
    const int r = lane & 31, hh = lane >> 5;
    for (int item = vblk; item < 256; item += nblk) {
        const int bh = (item & 7) + 8 * (item >> 5), es = (item >> 3) & 3, b = bh >> 3, h = bh & 7;
        __syncthreads();
        for (int i = tid; i < 8704 / 4; i += 512) ((unsigned*)Sl)[i] = 0u;
        f32x16 Sacc;
#pragma unroll
        for (int i = 0; i < 16; ++i) Sacc[i] = 0.f;
        const int rt = wid & 1, dt = wid & 3;
        bf16x8v A8n[8]; bf16x8v A4n[4]; u32x2 uun[4]; float gln = 1.f;
#define GS_LOAD(N) do { const size_t tk_ = (size_t)b * S + 64 * (N); const int it_ = bh * 64 + (N); \
            if (wid < 2) { const bf16* wp_ = proj + (tk_ + 32 * rt + r) * 4096 + 1024 + h * 128 + 8 * hh; \
                _Pragma("unroll") for (int ks = 0; ks < 8; ++ks) A8n[ks] = *(const bf16x8v*)(wp_ + 16 * ks); \
                const int c_ = es * 32 + r; const bf16* up_ = proj + (tk_ + (c_ >> 1)) * 4096 + 2048 + h * 128 + (c_ & 1) * 64 + 32 * rt + 4 * hh; \
                _Pragma("unroll") for (int g = 0; g < 4; ++g) uun[g] = *(const u32x2*)(up_ + 8 * g); } \
            else if (wid < 4) { const bf16* qp_ = proj + (tk_ + 32 * rt + r) * 4096 + h * 128 + 8 * hh; \
                _Pragma("unroll") for (int ks = 0; ks < 8; ++ks) A8n[ks] = *(const bf16x8v*)(qp_ + 16 * ks); \
                const bf16* ap_ = AT + (size_t)it_ * 4096 + (32 * rt + r) * 64 + 8 * hh; \
                _Pragma("unroll") for (int sx = 0; sx < 4; ++sx) A4n[sx] = *(const bf16x8v*)(ap_ + 16 * sx); } \
            else { const bf16* kp_ = KT + (size_t)it_ * 8192 + (32 * dt + r) * 64 + 8 * hh; \
                _Pragma("unroll") for (int sx = 0; sx < 4; ++sx) A4n[sx] = *(const bf16x8v*)(kp_ + 16 * sx); \
                gln = GL[it_]; } } while (0)
        GS_LOAD(0);
        for (int n = 0; n < 64; ++n) {
            const size_t tok0 = (size_t)b * S + 64 * n;
            bf16x8v A8[8]; bf16x8v A4[4]; u32x2 uu[4]; const float gl = gln;
#pragma unroll
            for (int ks = 0; ks < 8; ++ks) A8[ks] = A8n[ks];
#pragma unroll
            for (int sx = 0; sx < 4; ++sx) { A4[sx] = A4n[sx]; uu[sx] = uun[sx]; }
            if (n + 1 < 64) GS_LOAD(n + 1);
            LDS_BAR();
            f32x16 acc;
#pragma unroll
            for (int i = 0; i < 16; ++i) acc[i] = 0.f;
            if (wid < 4) {
#pragma unroll
                for (int ks = 0; ks < 8; ++ks) acc = MFMA32(A8[ks], *(const bf16x8v*)(Sl + r * 272 + ks * 32 + hh * 16), acc);
                if (wid < 2) {
#pragma unroll
                    for (int g = 0; g < 4; ++g) {
                        u32x2 w; w.x = pkbf(bf2f(uu[g].x & 0xffffu) - acc[4 * g], bf2f(uu[g].x >> 16) - acc[4 * g + 1]);
                        w.y = pkbf(bf2f(uu[g].y & 0xffffu) - acc[4 * g + 2], bf2f(uu[g].y >> 16) - acc[4 * g + 3]);
                        *(u32x2*)(Vl + r * 144 + (32 * rt + 8 * g + 4 * hh) * 2) = w;
                    }
                }
            }
            LDS_BAR();
            if (wid >= 2 && wid < 4) {
#pragma unroll
                for (int sx = 0; sx < 4; ++sx) acc = MFMA32(A4[sx], *(const bf16x8v*)(Vl + r * 144 + sx * 32 + hh * 16), acc);
                unsigned char* Ol = lds + 13312 + (wid - 2) * 2560;
#pragma unroll
                for (int i = 0; i < 16; ++i) *(bf16*)(Ol + ((i & 3) + 8 * (i >> 2) + 4 * hh) * 80 + r * 2) = (bf16)f2bf(acc[i]);
                WAVE_SYNC();
#pragma unroll
                for (int k = 0; k < 2; ++k) { const int pc = lane + 64 * k, trow = pc >> 2, c4 = pc & 3;
                    *(u32x4*)(o16 + (tok0 + 32 * rt + trow) * D + h * 128 + es * 32 + c4 * 8) = *(const u32x4*)(Ol + trow * 80 + c4 * 16); }
                WAVE_SYNC();
            } else if (wid >= 4) {
#pragma unroll
                for (int i = 0; i < 16; ++i) Sacc[i] *= gl;
#pragma unroll
                for (int sx = 0; sx < 4; ++sx) Sacc = MFMA32(A4[sx], *(const bf16x8v*)(Vl + r * 144 + sx * 32 + hh * 16), Sacc);
#pragma unroll
                for (int g = 0; g < 4; ++g) { u32x2 w; w.x = pkbf(Sacc[4 * g], Sacc[4 * g + 1]); w.y = pkbf(Sacc[4 * g + 2], Sacc[4 * g + 3]);
                    *(u32x2*)(Sl + r * 272 + (32 * dt + 8 * g + 4 * hh) * 2) = w; }
            }
        }
    }
}

#undef GS_LOAD
__device__ __forceinline__ void phase_gdn_post(const bf16* o16, const bf16* proj, const float* onorm, bf16* hn, int gw, int NGW, int lane) {
    const int l16 = lane & 15;
    float wv[8];
#pragma unroll
    for (int j = 0; j < 8; ++j) wv[j] = onorm[8 * l16 + j];
    for (int m = 2 * gw; m < T; m += 2 * NGW) {
        u32x4 xo[2][2], gg[2][2];
#pragma unroll
        for (int tk = 0; tk < 2; ++tk)
#pragma unroll
            for (int pt = 0; pt < 2; ++pt) { xo[tk][pt] = *(const u32x4*)(o16 + (size_t)(m + tk) * D + pt * 512 + lane * 8); gg[tk][pt] = *(const u32x4*)(proj + (size_t)(m + tk) * 4096 + 3072 + pt * 512 + lane * 8); }
#pragma unroll
        for (int tk = 0; tk < 2; ++tk)
#pragma unroll
            for (int pt = 0; pt < 2; ++pt) {
                const u32x4 xv = xo[tk][pt], gv = gg[tk][pt];
                float v[8] = {bf2f(xv.x & 0xffffu), bf2f(xv.x >> 16), bf2f(xv.y & 0xffffu), bf2f(xv.y >> 16), bf2f(xv.z & 0xffffu), bf2f(xv.z >> 16), bf2f(xv.w & 0xffffu), bf2f(xv.w >> 16)};
                const float g[8] = {bf2f(gv.x & 0xffffu), bf2f(gv.x >> 16), bf2f(gv.y & 0xffffu), bf2f(gv.y >> 16), bf2f(gv.z & 0xffffu), bf2f(gv.z >> 16), bf2f(gv.w & 0xffffu), bf2f(gv.w >> 16)};
                float sq = ((v[0] * v[0] + v[1] * v[1]) + (v[2] * v[2] + v[3] * v[3])) + ((v[4] * v[4] + v[5] * v[5]) + (v[6] * v[6] + v[7] * v[7]));
                sq = row_sum16(sq);
                const float rstd = 1.f / sqrtf(sq * (1.f / 128.f) + EPS);
#pragma unroll
                for (int j = 0; j < 8; ++j) v[j] = v[j] * rstd * wv[j] * siluf_(g[j]);
                u32x4 w; w.x = pkbf(v[0], v[1]); w.y = pkbf(v[2], v[3]); w.z = pkbf(v[4], v[5]); w.w = pkbf(v[6], v[7]);
                *(u32x4*)(hn + (size_t)(m + tk) * D + pt * 512 + lane * 8) = w;
            }
    }
}
__device__ __forceinline__ void phase_sc_post(const bf16* proj, const float* cw, bf16* hn, int gtid, int NT) {
    const int c8 = (gtid & 127) * 8;
    f32x4 w0[3], w1[3];
#pragma unroll
    for (int j = 0; j < 3; ++j) { w0[j] = *(const f32x4*)(cw + j * 1024 + c8); w1[j] = *(const f32x4*)(cw + j * 1024 + c8 + 4); }
    for (int idx = gtid; idx < T * 128; idx += 2 * NT) {
        u32x4 cv[2][3], xv[2][3], bv[2];
#pragma unroll
        for (int q = 0; q < 2; ++q) {
            const int id = idx + q * NT, m = id >> 7, s = m & (S - 1);
#pragma unroll
            for (int j = 0; j < 3; ++j) { cv[q][j] = (u32x4){0u, 0u, 0u, 0u}; xv[q][j] = (u32x4){0u, 0u, 0u, 0u};
                if (id < T * 128 && s - 2 + j >= 0) { const bf16* pr = proj + (size_t)(m - 2 + j) * 3072; cv[q][j] = *(const u32x4*)(pr + 1024 + c8); xv[q][j] = *(const u32x4*)(pr + 2048 + c8); } }
            bv[q] = (u32x4){0u, 0u, 0u, 0u};
            if (id < T * 128) bv[q] = *(const u32x4*)(proj + (size_t)m * 3072 + c8);
        }
#pragma unroll
        for (int q = 0; q < 2; ++q) {
            const int id = idx + q * NT, m = id >> 7;
            if (id >= T * 128) break;
            float y[8];
#pragma unroll
            for (int i = 0; i < 8; ++i) y[i] = 0.f;
#pragma unroll
            for (int j = 0; j < 3; ++j) {
                const u32x4 c = cv[q][j], x = xv[q][j];
                y[0] += w0[j].x * bf2f(c.x & 0xffffu) * bf2f(x.x & 0xffffu); y[1] += w0[j].y * bf2f(c.x >> 16) * bf2f(x.x >> 16);
                y[2] += w0[j].z * bf2f(c.y & 0xffffu) * bf2f(x.y & 0xffffu); y[3] += w0[j].w * bf2f(c.y >> 16) * bf2f(x.y >> 16);
                y[4] += w1[j].x * bf2f(c.z & 0xffffu) * bf2f(x.z & 0xffffu); y[5] += w1[j].y * bf2f(c.z >> 16) * bf2f(x.z >> 16);
                y[6] += w1[j].z * bf2f(c.w & 0xffffu) * bf2f(x.w & 0xffffu); y[7] += w1[j].w * bf2f(c.w >> 16) * bf2f(x.w >> 16);
            }
            const u32x4 b = bv[q];
            u32x4 o;
            o.x = pkbf(y[0] * bf2f(b.x & 0xffffu), y[1] * bf2f(b.x >> 16)); o.y = pkbf(y[2] * bf2f(b.y & 0xffffu), y[3] * bf2f(b.y >> 16));
            o.z = pkbf(y[4] * bf2f(b.z & 0xffffu), y[5] * bf2f(b.z >> 16)); o.w = pkbf(y[6] * bf2f(b.w & 0xffffu), y[7] * bf2f(b.w >> 16));
            *(u32x4*)(hn + (size_t)m * D + c8) = o;
        }
    }
}
__device__ __forceinline__ void phase_nsa_post(unsigned char* lds, const bf16* proj, const float* qnorm, const float* knorm, const f32x2* tab,
                                               bf16* QN, bf16* KS, bf16* KW, bf16* KCH, bf16* VCH, bf16* VST, bf16* VWT, int gw, int NGW, int wid, int lane) {
    {
        bf16* tile = (bf16*)lds + wid * (64 * 72);
        const int c8 = lane & 7, r8 = lane >> 3;
        for (int item = gw; item < 2 * 32 * 64; item += NGW) {
            const int st = item & 63, bh = (item >> 6) & 31, which = item >> 11, b = bh >> 2, hk = bh & 3;
            const bf16* src = proj + ((size_t)b * S + st * 64 + r8) * 2560 + (which ? 2304 : 1792) + hk * 64 + c8 * 8;
            u32x4 v[8];
#pragma unroll
            for (int i = 0; i < 8; ++i) v[i] = *(const u32x4*)(src + (size_t)(8 * i) * 2560);
#pragma unroll
            for (int i = 0; i < 8; ++i) *(u32x4*)(tile + (8 * i + r8) * 72 + c8 * 8) = v[i];
            WAVE_SYNC();
            bf16* dst = (which ? VWT : VST) + (size_t)bh * 64 * S + st * 64 + c8 * 8;
#pragma unroll
            for (int i = 0; i < 8; ++i) {
                const bf16* tp = tile + (8 * c8) * 72 + 8 * i + r8;
                u32x4 w; w.x = (unsigned)tp[0] | ((unsigned)tp[72] << 16); w.y = (unsigned)tp[144] | ((unsigned)tp[216] << 16);
                w.z = (unsigned)tp[288] | ((unsigned)tp[360] << 16); w.w = (unsigned)tp[432] | ((unsigned)tp[504] << 16);
                *(u32x4*)(dst + (size_t)(8 * i + r8) * S) = w;
            }
            WAVE_SYNC();
        }
    }
    const int l8 = lane & 7, hsel = lane >> 3, lo32 = lane < 32;
    float qw8[8], kw8[8];
#pragma unroll
    for (int j = 0; j < 8; ++j) { qw8[j] = qnorm[8 * l8 + j]; kw8[j] = knorm[(lo32 ? 64 : 128) + 8 * l8 + j]; }
#define NP_UNPACK(V, X) do { X[0] = bf2f(V.x & 0xffffu); X[1] = bf2f(V.x >> 16); X[2] = bf2f(V.y & 0xffffu); X[3] = bf2f(V.y >> 16); X[4] = bf2f(V.z & 0xffffu); X[5] = bf2f(V.z >> 16); X[6] = bf2f(V.w & 0xffffu); X[7] = bf2f(V.w >> 16); } while (0)
#define NP_RSTD8(X, R) do { float ss_ = (X[0] * X[0] + X[1] * X[1]) + (X[2] * X[2] + X[3] * X[3]) + (X[4] * X[4] + X[5] * X[5]) + (X[6] * X[6] + X[7] * X[7]); \
        ss_ += xshfl(ss_, 1); ss_ += xshfl(ss_, 2); ss_ += xshfl(ss_, 4); R = 1.f / sqrtf(ss_ * (1.f / 64.f) + EPS); } while (0)
    for (int m = gw; m < T; m += NGW) {
        const int b = m >> 12, s = m & (S - 1);
        const bf16* pr = proj + (size_t)m * 2560;
        const u32x4 vq0 = *(const u32x4*)(pr + lane * 8), vq1 = *(const u32x4*)(pr + 512 + lane * 8);
        const u32x4 vk = *(const u32x4*)(pr + (lo32 ? 1536 + lane * 8 : 2048 + (lane - 32) * 8));
        const u32x4 vc = *(const u32x4*)(pr + (lo32 ? 1024 + lane * 8 : 1280 + (lane - 32) * 8));
        const f32x4* cp = (const f32x4*)(tab + (size_t)m * 32 + 8 * (l8 & 3));
        const f32x4 c0 = cp[0], c1 = cp[1], c2 = cp[2], c3 = cp[3];
        {
            float x[8], r; NP_UNPACK(vq0, x); NP_RSTD8(x, r);
            u32x4 w; w.x = pkbf(x[0] * r * qw8[0], x[1] * r * qw8[1]); w.y = pkbf(x[2] * r * qw8[2], x[3] * r * qw8[3]); w.z = pkbf(x[4] * r * qw8[4], x[5] * r * qw8[5]); w.w = pkbf(x[6] * r * qw8[6], x[7] * r * qw8[7]);
            *(u32x4*)(QN + ((size_t)(b * 16 + hsel) * S + s) * 64 + 8 * l8) = w;
        }
        {
            float x[8], r; NP_UNPACK(vq1, x); NP_RSTD8(x, r);
            u32x4 w; w.x = pkbf(x[0] * r * qw8[0], x[1] * r * qw8[1]); w.y = pkbf(x[2] * r * qw8[2], x[3] * r * qw8[3]); w.z = pkbf(x[4] * r * qw8[4], x[5] * r * qw8[5]); w.w = pkbf(x[6] * r * qw8[6], x[7] * r * qw8[7]);
            *(u32x4*)(QN + ((size_t)(b * 16 + 8 + hsel) * S + s) * 64 + 8 * l8) = w;
        }
        const size_t okv = ((size_t)(b * 4 + (hsel & 3)) * S + s) * 64 + 8 * l8;
        {
            float x[8], r, y[8]; NP_UNPACK(vk, x); NP_RSTD8(x, r);
            const float cs[16] = {c0.x, c0.y, c0.z, c0.w, c1.x, c1.y, c1.z, c1.w, c2.x, c2.y, c2.z, c2.w, c3.x, c3.y, c3.z, c3.w};
#pragma unroll
            for (int j = 0; j < 8; ++j) { const float yv = x[j] * r * kw8[j]; const float yp = xshfl(yv, 4); y[j] = yv * cs[2 * j] + (l8 < 4 ? -yp : yp) * cs[2 * j + 1]; }
            u32x4 w; w.x = pkbf(y[0], y[1]); w.y = pkbf(y[2], y[3]); w.z = pkbf(y[4], y[5]); w.w = pkbf(y[6], y[7]);
            *(u32x4*)((lo32 ? KS : KW) + okv) = w;
        }
        *(u32x4*)((lo32 ? KCH : VCH) + okv) = vc;
    }
#undef NP_UNPACK
#undef NP_RSTD8
}
__device__ __forceinline__ void phase_cmp2(unsigned char* lds, const float* Pk, const float* Pv, const float* biasp, const float* w2, const float* b2, const float* knorm0,
                                           bf16* KC, bf16* VC, int gw, int NGW, int wid, int lane, int tid) {
    float* hs = (float*)lds + wid * 256;
    float* w2l = (float*)(lds + 8192);
    for (int kind = 0; kind < 2; ++kind) {
        __syncthreads();
        for (int idx = tid; idx < 256 * 64 / 4; idx += 512) ((f32x4*)w2l)[idx] = ((const f32x4*)(w2 + (size_t)kind * 256 * 64))[idx];
        __syncthreads();
        const float* P = kind ? Pv : Pk;
        for (int it = gw; it < 32 * 256; it += NGW) {
            const int i = it & 255, bh = it >> 8;
            bf16* outp = kind ? VC + ((size_t)bh * 64 + lane) * 256 + i : KC + ((size_t)bh * 256 + i) * 64 + lane;
            if (i == 255) { *outp = 0; continue; }
            const float* r0 = P + ((size_t)bh * 256 + i) * 512; const float* r1 = r0 + 512 + 256;
#pragma unroll
            for (int j = 0; j < 4; ++j) { const int n = lane + 64 * j; const float x = r0[n] + r1[n] + biasp[kind * 256 + n];
                const float uu = 0.7978845608028654f * (x + 0.044715f * x * x * x);
                const float th = 1.f - 2.f / (1.f + __expf(2.f * uu));
                hs[n] = 0.5f * x * (1.f + th); }
            WAVE_SYNC();
            float a0 = b2[kind * 64 + lane], a1 = 0.f, a2 = 0.f, a3 = 0.f;
#pragma unroll 4
            for (int n = 0; n < 256; n += 4) { const f32x4 hv = *(const f32x4*)(hs + n);
                a0 += hv.x * w2l[n * 64 + lane]; a1 += hv.y * w2l[(n + 1) * 64 + lane]; a2 += hv.z * w2l[(n + 2) * 64 + lane]; a3 += hv.w * w2l[(n + 3) * 64 + lane]; }
            float acc = (a0 + a1) + (a2 + a3);
            if (kind == 0) { const float ss = wave_sum(acc * acc); acc = acc * (1.f / sqrtf(ss * (1.f / 64.f) + EPS)) * knorm0[lane]; }
            *outp = (bf16)f2bf(acc);
            WAVE_SYNC();
        }
    }
}
constexpr int KV_STRIDE = 144;
constexpr int KV_BUF = 2 * 64 * KV_STRIDE;
constexpr int ATT_IMP_OFF = 2 * KV_BUF;
constexpr int ATT_MSK_OFF = ATT_IMP_OFF + 8 * 2048;

template <bool IMP>
__device__ __forceinline__ void attn_tile(const bool FAST, const unsigned char* buf, int tt, int key0, int lo, int hi, const bf16x8v (&qf)[4],
                                          f32x16 (&O)[2], f32x16 (&IM)[2], float& m, float& l, const bf16* ovt, int r, int h, int pr) {
    f32x16 sacc;
#pragma unroll
    for (int i = 0; i < 16; ++i) sacc[i] = 0.f;
    bf16x8v ov[2][2];
    if (IMP) {
#pragma unroll
        for (int st = 0; st < 2; ++st)
#pragma unroll
            for (int sx = 0; sx < 2; ++sx) ov[st][sx] = *(const bf16x8v*)(ovt + (32 * st + r) * 256 + key0 + 16 * sx + 8 * h);
    }
    const unsigned char* kb = buf + (32 * tt + pr) * KV_STRIDE + h * 16;
#pragma unroll
    for (int ks = 0; ks < 4; ++ks) { const bf16x8v a = *(const bf16x8v*)(kb + ks * 32); sacc = MFMA32(a, qf[ks], sacc); }
    const int kb0 = key0 + 8 * h;
    float mx = -1e30f, psum = 0.f, corr;
    if (FAST) {
        const bool on = hi >= 0;
#pragma unroll
        for (int i = 0; i < 16; ++i) mx = fmaxf(mx, sacc[i]);
        mx = on ? mx * 0.18033688011112042f : -1e30f;
        mx = fmaxf(mx, xshfl(mx, 32));
        const float mnew = fmaxf(m, mx);
        corr = __builtin_amdgcn_exp2f(m - mnew);
        m = mnew;
#pragma unroll
        for (int i = 0; i < 16; ++i) { const float p = __builtin_amdgcn_exp2f(sacc[i] * 0.18033688011112042f - mnew); psum += p; sacc[i] = p; }
        if (!on) {
            psum = 0.f;
#pragma unroll
            for (int i = 0; i < 16; ++i) sacc[i] = 0.f;
        }
    } else {
#pragma unroll
        for (int i = 0; i < 16; ++i) { const int key = kb0 + 16 * (i >> 3) + (i & 7); const bool ok = (key >= lo) && (key <= hi);
            const float sv = ok ? sacc[i] * 0.18033688011112042f : -1e30f; sacc[i] = sv; mx = fmaxf(mx, sv); }
        mx = fmaxf(mx, xshfl(mx, 32));
        const float mnew = fmaxf(m, mx);
        corr = __builtin_amdgcn_exp2f(m - mnew);
        m = mnew;
#pragma unroll
        for (int i = 0; i < 16; ++i) { const float p = sacc[i] > -1e29f ? __builtin_amdgcn_exp2f(sacc[i] - mnew) : 0.f; psum += p; sacc[i] = p; }
    }
    l = l * corr + psum;
    if (__any(corr != 1.f)) {
#pragma unroll
        for (int i = 0; i < 16; ++i) { O[0][i] *= corr; O[1][i] *= corr; }
        if (IMP) {
#pragma unroll
            for (int i = 0; i < 16; ++i) { IM[0][i] *= corr; IM[1][i] *= corr; }
        }
    }
    bf16x8v pf[2];
#pragma unroll
    for (int sx = 0; sx < 2; ++sx) { u32x4 w; w.x = pkbf(sacc[8 * sx], sacc[8 * sx + 1]); w.y = pkbf(sacc[8 * sx + 2], sacc[8 * sx + 3]); w.z = pkbf(sacc[8 * sx + 4], sacc[8 * sx + 5]); w.w = pkbf(sacc[8 * sx + 6], sacc[8 * sx + 7]);
        pf[sx] = __builtin_bit_cast(bf16x8v, w); }
    const unsigned char* vb = buf + 64 * KV_STRIDE + r * KV_STRIDE + (32 * tt + 8 * h) * 2;
#pragma unroll
    for (int dt = 0; dt < 2; ++dt)
#pragma unroll
        for (int sx = 0; sx < 2; ++sx) { const bf16x8v a = *(const bf16x8v*)(vb + dt * 32 * KV_STRIDE + sx * 32); O[dt] = MFMA32(a, pf[sx], O[dt]); }
    if (IMP) {
#pragma unroll
        for (int st = 0; st < 2; ++st)
#pragma unroll
            for (int sx = 0; sx < 2; ++sx) IM[st] = MFMA32(ov[st][sx], pf[sx], IM[st]);
    }
}

template <int MODE>
__device__ __forceinline__ void attn_branch(unsigned char* kvbuf, const bf16* Kg0, const bf16* VTg0, int vts, unsigned long long blkmask, int t, int nv, unsigned long long selm,
                                            int wlo, int whi, int flo, int fhi, const bf16x8v (&qf)[4], f32x16 (&O)[2], f32x16 (&IM)[2], float& l, const bf16* ovt, int tid, int r, int h, int pr) {
    float m = -1e30f;
    l = 0.f;
#pragma unroll
    for (int i = 0; i < 16; ++i) { O[0][i] = 0.f; O[1][i] = 0.f; IM[0][i] = 0.f; IM[1][i] = 0.f; }
    const int srow = tid >> 3, sch = tid & 7;
    int j = __builtin_ctzll(blkmask);
    unsigned long long rest = blkmask & (blkmask - 1);
    u32x4 kr = *(const u32x4*)(Kg0 + (size_t)(64 * j + srow) * 64 + sch * 8);
    u32x4 vr = *(const u32x4*)(VTg0 + (size_t)srow * vts + 64 * j + sch * 8);
    *(u32x4*)(kvbuf + srow * KV_STRIDE + sch * 16) = kr;
    *(u32x4*)(kvbuf + 64 * KV_STRIDE + srow * KV_STRIDE + sch * 16) = vr;
    int cur = 0;
    for (;;) {
        __syncthreads();
        const bool more = rest != 0ull;
        int jn = 0;
        if (more) { jn = __builtin_ctzll(rest); rest &= rest - 1;
            kr = *(const u32x4*)(Kg0 + (size_t)(64 * jn + srow) * 64 + sch * 8);
            vr = *(const u32x4*)(VTg0 + (size_t)srow * vts + 64 * jn + sch * 8); }
        const unsigned char* buf = kvbuf + cur * KV_BUF;
        int lo, hi;
        if (MODE == 0) { lo = 0; hi = nv - 1; }
        else if (MODE == 1) { lo = 0; hi = ((selm >> j) & 1ull) ? t : -1; }
        else { lo = t - 511; hi = t; }
        const bool wave_on = (MODE != 1) || __any(hi >= 0);
#pragma unroll
        for (int tt = 0; tt < 2; ++tt) {
            const int key0 = 64 * j + 32 * tt;
            if (!wave_on || key0 > whi || key0 + 31 < wlo) continue;
            attn_tile<MODE == 0>(key0 >= flo && key0 + 31 <= fhi, buf, tt, key0, lo, hi, qf, O, IM, m, l, ovt, r, h, pr);
        }
        if (!more) break;
        *(u32x4*)(kvbuf + (cur ^ 1) * KV_BUF + srow * KV_STRIDE + sch * 16) = kr;
        *(u32x4*)(kvbuf + (cur ^ 1) * KV_BUF + 64 * KV_STRIDE + srow * KV_STRIDE + sch * 16) = vr;
        cur ^= 1; j = jn;
    }
    __syncthreads();
}

__device__ __forceinline__ void phase_nsa_attn(unsigned char* lds, const bf16* QN, const bf16* KS, const bf16* KW, const bf16* VST, const bf16* VWT, const bf16* KCb, const bf16* VCT,
                                               const bf16* ovt, const float* gates, const f32x2* tab, bf16* hn, int vblk, int nblk, int tid, int wid, int lane) {
    const int r = lane & 31, h = lane >> 5, pr = (r & ~12) | ((r & 4) << 1) | ((r & 8) >> 1);
    float* imp_s = (float*)(lds + ATT_IMP_OFF + wid * 2048);
    unsigned long long* msk_s = (unsigned long long*)(lds + ATT_MSK_OFF);
    unsigned* uni_s = (unsigned*)(lds + ATT_MSK_OFF + 512);
    for (int item = vblk; item < Bn * 4 * 64; item += nblk) {
        const int rnd = item / nblk, wv = item - rnd * nblk;
        const int bh = wv & 31, sub = wv >> 5, per = nblk >> 5;
        int qb = rnd * per + ((rnd & 1) ? (per - 1 - sub) : sub);
        if (nblk != 256) { qb = item >> 5; }
        const int bhh = (nblk != 256) ? (item & 31) : bh;
        const int b = bhh >> 2, hk = bhh & 3;
        const int t0 = qb * 64, tw0 = t0 + 8 * wid, t = tw0 + (r & 7), g = r >> 3;
        const size_t tok = (size_t)b * S + t;
        if (tid == 0) { unsigned z = 0u; asm volatile("" : "+v"(z)); uni_s[0] = z; uni_s[1] = z; }
        bf16x8v qn[4], qr[4];
        {
            const bf16* qp = QN + ((size_t)(b * 16 + hk * 4 + g) * S + t) * 64 + 8 * h;
#pragma unroll
            for (int ks = 0; ks < 4; ++ks) qn[ks] = *(const bf16x8v*)(qp + 16 * ks);
            const f32x2* cp = tab + tok * 32 + 8 * h;
#pragma unroll
            for (int kl = 0; kl < 2; ++kl) {
                u32x4 wlo_, whi_;
                const u32x4 a = __builtin_bit_cast(u32x4, qn[kl]), c = __builtin_bit_cast(u32x4, qn[kl + 2]);
#pragma unroll
                for (int jj = 0; jj < 4; ++jj) {
                    const f32x2 cs0 = cp[16 * kl + 2 * jj], cs1 = cp[16 * kl + 2 * jj + 1];
                    const float x0 = bf2f(a[jj] & 0xffffu), x1 = bf2f(a[jj] >> 16), y0 = bf2f(c[jj] & 0xffffu), y1 = bf2f(c[jj] >> 16);
                    wlo_[jj] = pkbf(x0 * cs0.x - y0 * cs0.y, x1 * cs1.x - y1 * cs1.y);
                    whi_[jj] = pkbf(y0 * cs0.x + x0 * cs0.y, y1 * cs1.x + x1 * cs1.y);
                }
                qr[kl] = __builtin_bit_cast(bf16x8v, wlo_); qr[kl + 2] = __builtin_bit_cast(bf16x8v, whi_);
            }
        }
        const float* gp = gates + tok * 48 + (hk * 4 + g) * 3;
        const float g0 = sigmoidf_(gp[0]), g1 = sigmoidf_(gp[1]), g2 = sigmoidf_(gp[2]);
        f32x16 acc[2], O[2], IM[2];
        float l;
        const int nv = t >= 31 ? ((t - 31) >> 4) + 1 : 0;
        const int nvw = ((tw0 + 7 - 31) >> 4) + 1;
        const int nvmax = 4 * qb + 3;
        {
            const int ncb = (nvmax + 63) >> 6;
            const unsigned long long bm = ncb >= 64 ? ~0ull : ((1ull << ncb) - 1ull);
            attn_branch<0>(lds, KCb + (size_t)bhh * 256 * 64, VCT + (size_t)bhh * 64 * 256, 256, bm, t, nv, 0ull, 0, (tw0 + 7 >= 31 ? nvw - 1 : -1), 0, (tw0 >= 31 ? ((tw0 - 31) >> 4) : -1), qn, O, IM, l, ovt, tid, r, h, pr);
        }
        {
            const float lt = l + xshfl(l, 32), inv = lt > 0.f ? 1.f / lt : 0.f, sc = inv * g0;
#pragma unroll
            for (int i = 0; i < 16; ++i) { acc[0][i] = O[0][i] * sc; acc[1][i] = O[1][i] * sc; }
#pragma unroll
            for (int st = 0; st < 2; ++st)
#pragma unroll
                for (int i = 0; i < 16; ++i) { float v = IM[st][i] * inv; v += xshfl(v, 8); v += xshfl(v, 16);
                    if (r < 8) imp_s[r * 64 + 32 * st + (i & 3) + 8 * (i >> 2) + 4 * h] = v; }
        }
        WAVE_SYNC();
        {
            unsigned long long um = 0ull;
            for (int tk = 0; tk < 8; ++tk) {
                const float imp = imp_s[tk * 64 + lane];
                const bool sv = lane <= qb, forced = (lane == 0) || (lane == qb) || (lane + 1 == qb);
                const float score = sv ? (forced ? 1e9f : imp) : -1.f;
                int rank = 0;
#pragma unroll 4
                for (int i = 0; i < 64; ++i) { const float si = __uint_as_float(__builtin_amdgcn_readlane(__float_as_uint(score), i)); rank += (si > score || (si == score && i < lane)) ? 1 : 0; }
                const unsigned long long mk = __ballot((rank < 16) && (score >= 0.f));
                um |= mk;
                if (lane == 0) msk_s[wid * 8 + tk] = mk;
            }
            if (lane == 0) { atomicOr(&uni_s[0], (unsigned)um); atomicOr(&uni_s[1], (unsigned)(um >> 32)); }
        }
        __syncthreads();
        const unsigned long long selm = msk_s[wid * 8 + (r & 7)];
        const unsigned long long uni = (unsigned long long)uni_s[0] | ((unsigned long long)uni_s[1] << 32);
        attn_branch<1>(lds, KS + (size_t)bhh * S * 64, VST + (size_t)bhh * 64 * S, S, uni, t, 0, selm, 0, tw0 + 7, 0, tw0, qr, O, IM, l, ovt, tid, r, h, pr);
        {
            const float lt = l + xshfl(l, 32), sc = g1 / lt;
#pragma unroll
            for (int i = 0; i < 16; ++i) { acc[0][i] += O[0][i] * sc; acc[1][i] += O[1][i] * sc; }
        }
        {
            const int jlo = qb >= 8 ? qb - 8 : 0;
            const unsigned long long bm = (qb >= 63 ? ~0ull : ((1ull << (qb + 1)) - 1ull)) & ~((1ull << jlo) - 1ull);
            attn_branch<2>(lds, KW + (size_t)bhh * S * 64, VWT + (size_t)bhh * 64 * S, S, bm, t, 0, 0ull, tw0 - 511, tw0 + 7, tw0 + 7 - 511, tw0, qr, O, IM, l, ovt, tid, r, h, pr);
        }
        {
            const float lt = l + xshfl(l, 32), sc = g2 / lt;
            bf16* op = hn + tok * D + (hk * 4 + g) * 64 + 4 * h;
#pragma unroll
            for (int dt = 0; dt < 2; ++dt)
#pragma unroll
                for (int q4 = 0; q4 < 4; ++q4) {
                    u32x2 w; w.x = pkbf(acc[dt][4 * q4] + O[dt][4 * q4] * sc, acc[dt][4 * q4 + 1] + O[dt][4 * q4 + 1] * sc);
                    w.y = pkbf(acc[dt][4 * q4 + 2] + O[dt][4 * q4 + 2] * sc, acc[dt][4 * q4 + 3] + O[dt][4 * q4 + 3] * sc);
                    *(u32x2*)(op + 32 * dt + 8 * q4) = w;
                }
        }
    }
}


#define LAS __attribute__((address_space(3)))
#define XB_TMO      128
#define XB_XCNT(j)  (256  + 64 * (j))
#define XB_XSUB(j)  (1280 + 64 * (j))
#define XB_XGEN(j)  (2304 + 64 * (j))
#define XB_TOP      3328
#define XB_TOPGEN   3392
#define XCD_BAR_WORDS 3456
#define XB_SPIN_CAP (1u << 18)

__device__ __forceinline__ unsigned xb_ld(unsigned* p)              { return __hip_atomic_load(p, __ATOMIC_RELAXED, __HIP_MEMORY_SCOPE_AGENT); }
__device__ __forceinline__ unsigned xb_add(unsigned* p, unsigned v) { return __hip_atomic_fetch_add(p, v, __ATOMIC_RELAXED, __HIP_MEMORY_SCOPE_AGENT); }
__device__ __forceinline__ unsigned xb_xcc_id() { return (unsigned)__builtin_amdgcn_s_getreg((3 << 11) | 20) & 0xFu; }
#define XB_SPIN(cond, bar) do { unsigned _sp = 0; while (cond) { __builtin_amdgcn_s_sleep(1); \
    if ((++_sp & 255u) == 0u) { if (xb_ld(&(bar)[XB_TMO])) break; if (_sp > XB_SPIN_CAP) { atomicAdd(&(bar)[XB_TMO], 1u); break; } } } } while (0)

struct XcdBarrier {
    unsigned* bar; unsigned x;
    volatile LAS unsigned* st;
};

__device__ __forceinline__ XcdBarrier xcd_barrier_post(unsigned* bar, volatile LAS unsigned* st) {
    XcdBarrier b; b.bar = bar; b.x = xb_xcc_id(); b.st = st;
    if (threadIdx.x == 0) (void)xb_add(&bar[XB_XCNT(b.x)], 1u);
    return b;
}
__device__ __forceinline__ void xcd_barrier_complete(unsigned* bar, unsigned x, unsigned& nloc, unsigned& nx) {
    const unsigned G = gridDim.x * gridDim.y * gridDim.z;
    unsigned sum, cnt, mine, sp = 0u;
    for (;;) {
        sum = 0u; cnt = 0u; mine = 0u;
#pragma unroll
        for (unsigned j = 0; j < 16; ++j) { const unsigned c = xb_ld(&bar[XB_XCNT(j)]); sum += c; cnt += (c > 0u) ? 1u : 0u; mine = (j == x) ? c : mine; }
        if (sum == G) break;
        __builtin_amdgcn_s_sleep(1);
        if ((++sp & 255u) == 0u) { if (xb_ld(&bar[XB_TMO])) break; if (sp > XB_SPIN_CAP) { atomicAdd(&bar[XB_TMO], 1u); break; } }
    }
    nloc = mine > 0u ? mine : 1u; nx = cnt > 0u ? cnt : 1u;
}

__device__ __forceinline__ void xcd_barrier(const XcdBarrier& b) {
    asm volatile("s_waitcnt vmcnt(0)" ::: "memory");
    __syncthreads();
    if (threadIdx.x == 0) {
        unsigned* bar = b.bar;
        __builtin_amdgcn_s_waitcnt(0);
        unsigned nloc = b.st[0], nx = b.st[1];
        if (nloc == 0u) { xcd_barrier_complete(bar, b.x, nloc, nx); b.st[0] = nloc; b.st[1] = nx; }
        const unsigned old = xb_add(&bar[XB_XSUB(b.x)], 1u);
        const unsigned gen = old / nloc;
        if (old + 1u == (gen + 1u) * nloc) {
            __builtin_amdgcn_fence(__ATOMIC_RELEASE, "agent");
            asm volatile("s_waitcnt vmcnt(0)" ::: "memory");
            const unsigned og = xb_add(&bar[XB_TOP], 1u);
            const unsigned tg = og / nx;
            if (og + 1u == (tg + 1u) * nx) xb_add(&bar[XB_TOPGEN], 1u);
            else XB_SPIN(xb_ld(&bar[XB_TOPGEN]) == tg, bar);
            __builtin_amdgcn_fence(__ATOMIC_ACQUIRE, "agent");
            xb_add(&bar[XB_XGEN(b.x)], 1u);
            asm volatile("s_waitcnt vmcnt(0)" ::: "memory");
        } else {
            XB_SPIN(xb_ld(&bar[XB_XGEN(b.x)]) == gen, bar);
            __builtin_amdgcn_fence(__ATOMIC_ACQUIRE, "agent");
            asm volatile("s_waitcnt vmcnt(0)" ::: "memory");
        }
    }
    __syncthreads();
}

struct Args { const void* in[24]; float* out; unsigned char* ws; int lo, hi; };

__host__ __device__ constexpr int mixer_inner_phases(int kind) { return kind == 0 ? 4 : (kind == 1 ? 1 : 4); }
__host__ __device__ constexpr int total_phases() { int n = 1; for (int L = 0; L < DEPTH; ++L) n += 4 + 2 + mixer_inner_phases(L % 3); return n; }

__global__ void __launch_bounds__(512, 2) mega(Args args) {
    extern __shared__ __attribute__((aligned(16))) unsigned char lds[];
    cg::grid_group grid = cg::this_grid();
    volatile LAS unsigned* bst = (volatile LAS unsigned*)((LAS unsigned char*)lds + (LDS_BYTES - 64));
    if (threadIdx.x < 2) bst[threadIdx.x] = 0u;
    __syncthreads();
    const XcdBarrier xbar = xcd_barrier_post((unsigned*)args.ws, bst);
    bool again = false;
    for (int ph = args.lo; ph < args.hi; ++ph) {
        int type = 0, s = 0, L = 0;
        if (ph > 0) {
            int p = ph - 1;
            for (L = 0; L < DEPTH; ++L) { const int n = 6 + mixer_inner_phases(L % 3); if (p < n) break; p -= n; }
            const int inner = mixer_inner_phases(L % 3), kind = L % 3;
            if (p < 2) { type = 2 + p; s = 2 * L; }
            else if (p == 2) type = 5;
            else if (p < 3 + inner) { const int q = p - 3; type = kind == 0 ? (q == 0 ? 14 : (q == 1 ? 15 : 4 + q)) : (kind == 1 ? 8 : 9 + q); }
            else if (p == 3 + inner) type = 13;
            else { type = 2 + (p - 4 - inner); s = 2 * L + 1; }
        }
        int tid_ = threadIdx.x; asm volatile("" : "+v"(tid_));
        int G_ = gridDim.x, bx_ = blockIdx.x; asm volatile("" : "+s"(G_), "+s"(bx_));
        const int tid = tid_, lane = tid & 63, wid = __builtin_amdgcn_readfirstlane(tid >> 6);
        const int G = G_, bx = bx_;
        const int vcu = (G % 8 == 0) ? (bx % 8) * (G / 8) + bx / 8 : bx;
        const int gw = vcu * 8 + wid, NGW = G * 8;
        unsigned char* ws = args.ws; asm volatile("" : "+s"(ws));
        PG8_LAS unsigned char* ldsl = (PG8_LAS unsigned char*)lds;
        float* hout = args.out; asm volatile("" : "+s"(hout));
        bf16* HN = (bf16*)(ws + WS_HN);
        bf16* RB = (bf16*)(ws + WS_R);
        f32x2* tab = (f32x2*)(ws + WS_TAB);
        const int kind = L % 3, jj = L / 3;
        bf16* QN = RB + (size_t)T * 2560;
        bf16* KSb = QN + (size_t)T * 1024;
        bf16* KWb = KSb + (size_t)T * 256;
        bf16* KCH = (bf16*)(ws + WS_O32);
        bf16* VCH = KCH + (size_t)T * 256;
        float* Pk = (float*)(ws + WS_O32 + 32 * MiB);
        float* Pv = Pk + (size_t)8192 * 512;
        bf16* KC = (bf16*)(ws + WS_O32 + 64 * MiB);
        bf16* VC = (bf16*)(ws + WS_O32 + 65 * MiB);
        bf16* OVT = (bf16*)(ws + WS_BP + 65536);
        bf16* VST = (bf16*)(ws + WS_O32 + 68 * MiB);
        bf16* VWT = (bf16*)(ws + WS_O32 + 84 * MiB);
        switch (type) {
        case 0: {
            float* scr = (float*)lds + wid * (64 * 33);
            for (int mi = 0; mi < 28; ++mi) {
                const float* W; const float* nw = nullptr; int K, N, Npad, mode = 0; bf16* WT;
                if (mi < 8)       { nw = (const float*)args.in[2] + (size_t)mi * D; W = (const float*)args.in[3] + (size_t)mi * D * 2 * FF; K = D; N = 2 * FF; Npad = N; mode = 1; WT = (bf16*)(ws + WS_WGU) + (size_t)mi * 2 * FF * D; }
                else if (mi < 16) { const int i = mi - 8; W = (const float*)args.in[4] + (size_t)i * FF * D; K = FF; N = D; Npad = N; WT = (bf16*)(ws + WS_WDN) + (size_t)i * D * FF; }
                else if (mi < 18) { const int i = mi - 16; nw = (const float*)args.in[5] + (size_t)(3 * i) * D; W = (const float*)args.in[6] + (size_t)i * D * 4112; K = D; N = 4112; Npad = GDN_NPAD; WT = (bf16*)(ws + WS_WGI) + (size_t)i * GDN_NPAD * D; }
                else if (mi < 20) { const int i = mi - 18; W = (const float*)args.in[11] + (size_t)i * D * D; K = D; N = D; Npad = N; WT = (bf16*)(ws + WS_WGO) + (size_t)i * D * D; }
                else if (mi == 20) { nw = (const float*)args.in[5] + (size_t)1 * D; W = (const float*)args.in[12]; K = D; N = 3072; Npad = N; WT = (bf16*)(ws + WS_WSI); }
                else if (mi == 21) { W = (const float*)args.in[14]; K = D; N = D; Npad = N; WT = (bf16*)(ws + WS_WSO); }
                else if (mi == 22) { nw = (const float*)args.in[5] + (size_t)2 * D; W = (const float*)args.in[15]; K = D; N = 2608; Npad = NSA_NPAD; WT = (bf16*)(ws + WS_WNI); }
                else if (mi == 23) { W = (const float*)args.in[23]; K = D; N = D; Npad = N; WT = (bf16*)(ws + WS_WNO); }
                else { const int i = mi - 24, kd = i >> 1, hf = i & 1;
                    W = (const float*)args.in[19] + (size_t)kd * 2048 * 256 + (size_t)hf * 1024 * 256; K = 1024; N = 256; Npad = 256; WT = (bf16*)(ws + WS_WC1) + (size_t)kd * 512 * 1024 + (size_t)hf * 256 * 1024; }
                xpose_matrix(W, nw, K, N, Npad, WT, mode, scr, gw, NGW, lane);
            }
            {
                float* ss = (float*)(ws + WS_SS);
                const float* xin = (const float*)args.in[0];
                for (int m = gw; m < T; m += NGW) {
                    const f32x4* xr = (const f32x4*)(xin + (size_t)m * D) + lane; u32x2* o8 = (u32x2*)(HN + (size_t)m * D) + lane; float sq = 0.f;
#pragma unroll
                    for (int j = 0; j < 4; ++j) { const f32x4 v = xr[64 * j]; sq += (v.x * v.x + v.y * v.y) + (v.z * v.z + v.w * v.w); u32x2 o; o.x = pkbf(v.x, v.y); o.y = pkbf(v.z, v.w); o8[64 * j] = o; }
                    sq = wave_sum(sq); if (lane < 16) ss[(size_t)m * 16 + lane] = lane == 0 ? sq : 0.f;
                }
            }
            const int* positions = (const int*)args.in[1];
            for (int idx = bx * 512 + tid; idx < T * 32; idx += G * 512) {
                const int tk = idx >> 5, i = idx & 31;
                const float inv = 1.0f / exp2f((float)(2 * i) * (13.287712379549449f / 64.f));
                const float ang = (float)positions[tk] * inv;
                const double rev = (double)ang * 0.15915494309189535;
                const float fr = (float)(rev - rint(rev));
                f32x2 v; v.x = __builtin_amdgcn_cosf(fr); v.y = __builtin_amdgcn_sinf(fr);
                tab[idx] = v;
            }
            for (int idx = bx * 512 + tid; idx < 64 * 256; idx += G * 512) {
                const int sj = idx >> 8, i = idx & 255, q = i >> 2, rem = i & 3;
                OVT[idx] = (bf16)(rem < 3 ? (q == sj ? 0x3F80 : 0) : ((q == sj || q + 1 == sj) ? 0x3F00 : 0));
            }
            if (bx < 2 && tid < 256) {
                const float* pe = (const float*)args.in[18] + (size_t)bx * 2048;
                const float* w1 = (const float*)args.in[19] + (size_t)bx * 2048 * 256 + tid;
                float acc = ((const float*)args.in[20])[bx * 256 + tid];
                for (int k = 0; k < 2048; ++k) acc += pe[k] * w1[(size_t)k * 256];
                ((float*)(ws + WS_BP))[bx * 256 + tid] = acc;
            }
        } break;
        case 2: {
            const bf16* Ah = (s & 1) ? (const bf16*)(ws + WS_R + 192 * MiB) : HN;
            pg8::Gemm g{Ah, (const bf16*)(ws + WS_WGU) + (size_t)s * 2 * FF * D, T, 2 * FF, D}; pg8::StaticOrder SO; SO.init(T, 2 * FF, G, bx);
            float* rtab = (float*)(lds + 131072);
            rstd_table(rtab, (const float*)(ws + WS_SS) + (size_t)s * T * 16, SO, tid);
            pg8::EpiSwiGLU E{RB, rtab};
            pg8::gemm_phase<pg8::EpiSwiGLU, pg8::StaticOrder, true, true>(ldsl, g, SO, E, tid); } break;
        case 3: {
            pg8::Gemm g{RB, (const bf16*)(ws + WS_WDN) + (size_t)s * D * FF, T, D, FF}; pg8::StaticOrder SO; SO.init(T, D, G, bx);
            const int slot = (s & 1) ? (s < 7 ? s + 1 : 12) : 8 + (s >> 1);
            pg8::EpiResid<1> E{s == 0 ? (const float*)args.in[0] : hout, hout, HN, (float*)(ws + WS_SS) + (size_t)slot * T * 16};
            pg8::gemm_phase<pg8::EpiResid<1>, pg8::StaticOrder, true, true>(ldsl, g, SO, E, tid); } break;
        case 5: {
            const bf16* Wt; int Np, ldc, nmain, ldt, nvalid; float* tail;
            if (kind == 0) { Wt = (const bf16*)(ws + WS_WGI) + (size_t)jj * GDN_NPAD * D; Np = GDN_NPAD; ldc = 4096; nmain = 4096; tail = (float*)(ws + WS_AB); ldt = 16; nvalid = 4112; }
            else if (kind == 1) { Wt = (const bf16*)(ws + WS_WSI); Np = 3072; ldc = 3072; nmain = 3072; tail = (float*)(ws + WS_AB); ldt = 16; nvalid = 3072; }
            else { Wt = (const bf16*)(ws + WS_WNI); Np = NSA_NPAD; ldc = 2560; nmain = 2560; tail = (float*)(ws + WS_GT); ldt = 48; nvalid = 2608; }
            pg8::Gemm g{HN, Wt, T, Np, D}; pg8::StaticOrder SO; SO.init(T, Np, G, bx);
            float* rtab = (float*)(lds + 131072);
            rstd_table(rtab, (const float*)(ws + WS_SS) + (size_t)(8 + L) * T * 16, SO, tid);
            pg8::EpiProj E{RB, ldc, nmain, tail, ldt, nvalid, rtab};
            pg8::gemm_phase<pg8::EpiProj, pg8::StaticOrder, true, true>(ldsl, g, SO, E, tid); } break;
        case 14: phase_gdn_halo(RB, (bf16*)(ws + WS_HALO), vcu * 512 + tid, G * 512); break;
        case 15: phase_gdn_prep(lds, RB, (const bf16*)(ws + WS_HALO), (const float*)(ws + WS_AB), (const float*)args.in[7] + (size_t)jj * 4 * 3072, (const float*)args.in[8] + jj * 8, (const float*)args.in[9] + jj * 8,
                                HN, (bf16*)(ws + WS_O32 + 64 * MiB), (float*)(ws + WS_GL), bx, G, tid, wid, lane); break;
        case 6:
#ifndef DIS_SCAN
            phase_gdn_scan2(lds, RB, HN, (const bf16*)(ws + WS_O32 + 64 * MiB), (const float*)(ws + WS_GL), (bf16*)(ws + WS_O32), bx, G, tid, wid, lane);
#endif
            break;
        case 7:
#ifndef DIS_GPOST
            phase_gdn_post((const bf16*)(ws + WS_O32), RB, (const float*)args.in[10] + jj * 128, HN, gw, NGW, lane);
#endif
            break;
        case 8:
#ifndef DIS_SPOST
            phase_sc_post(RB, (const float*)args.in[13], HN, vcu * 512 + tid, G * 512);
#endif
            break;
        case 9:
#ifndef DIS_NPOST
            phase_nsa_post(lds, RB, (const float*)args.in[16], (const float*)args.in[17], tab, QN, KSb, KWb, KCH, VCH, VST, VWT, gw, NGW, wid, lane);
#endif
            break;
        case 10: {
            pg8::Gemm g{KCH, (const bf16*)(ws + WS_WC1), 8192, 512, 1024}; pg8::StaticOrder SO; SO.init(8192, 512, G, bx);
            pg8::Gemm g2{VCH, (const bf16*)(ws + WS_WC1) + (size_t)512 * 1024, 8192, 512, 1024};
            pg8::EpiF32 E{Pk, 512};
            if (bx >= G / 2) { g = g2; SO.init(8192, 512, G, bx - G / 2); E.C = Pv; }
            pg8::gemm_phase<pg8::EpiF32, pg8::StaticOrder, true, true>(ldsl, g, SO, E, tid); } break;
        case 11:
#ifndef DIS_CMP2
            phase_cmp2(lds, Pk, Pv, (const float*)(ws + WS_BP), (const float*)args.in[21], (const float*)args.in[22], (const float*)args.in[17], KC, VC, gw, NGW, wid, lane, tid);
#endif
            break;
        case 12:
#ifndef DIS_ATTN
            phase_nsa_attn(lds, QN, KSb, KWb, VST, VWT, KC, VC, OVT, (const float*)(ws + WS_GT), tab, HN, bx, G, tid, wid, lane);
#endif
            break;
        default: {
            const bf16* Wout = kind == 0 ? (const bf16*)(ws + WS_WGO) + (size_t)jj * D * D : (kind == 1 ? (const bf16*)(ws + WS_WSO) : (const bf16*)(ws + WS_WNO));
            pg8::Gemm g{HN, Wout, T, D, D}; pg8::StaticOrder SO; SO.init(T, D, G, bx);
            pg8::EpiResid<2> E{hout, hout, (bf16*)(ws + WS_R + 192 * MiB), (float*)(ws + WS_SS) + (size_t)(2 * L + 1) * T * 16};
            pg8::gemm_phase<pg8::EpiResid<2>, pg8::StaticOrder, true, true>(ldsl, g, SO, E, tid); } break;
        }
#ifdef REP_TYPE
        if (type == REP_TYPE && !again) { again = true; xcd_barrier(xbar); --ph; continue; }
        again = false;
#endif
        if (ph + 1 < args.hi) { if (ph == 0) grid.sync(); else xcd_barrier(xbar); }
    }
}

extern "C" void kernel_launch(void* const* d_in, const int* in_sizes, int n_in, void* d_out, int out_size, void* d_ws, size_t ws_size, hipStream_t stream) {
    static int grid = 0;
    if (grid == 0) {
        if (n_in != 24 || out_size != T * D || ws_size < WS_END2) { fprintf(stderr, "kernel_launch: unexpected shapes n_in %d out %d ws %zu (need %zu)\n", n_in, out_size, ws_size, (size_t)WS_END2); grid = -1; return; }
        int dev = 0, cus = 0, per_cu = 0;
        hipGetDevice(&dev); hipDeviceGetAttribute(&cus, hipDeviceAttributeMultiprocessorCount, dev);
        if (hipFuncSetAttribute((const void*)mega, hipFuncAttributeMaxDynamicSharedMemorySize, LDS_BYTES) != hipSuccess) { fprintf(stderr, "kernel_launch: hipFuncSetAttribute failed\n"); grid = -1; return; }
        if (hipOccupancyMaxActiveBlocksPerMultiprocessor(&per_cu, (const void*)mega, 512, LDS_BYTES) != hipSuccess || per_cu < 1) { fprintf(stderr, "kernel_launch: occupancy query says %d\n", per_cu); per_cu = 1; }
        (void)hipGetLastError();
        grid = cus;
    }
    if (grid < 0) return;
    Args a{};
    for (int i = 0; i < 24; ++i) a.in[i] = d_in[i];
    a.out = (float*)d_out; a.ws = (unsigned char*)d_ws;
    constexpr int NPH = total_phases();
#if MK_MULTI
    for (int p = 0; p < NPH; ++p) { a.lo = p; a.hi = p + 1; hipLaunchKernelGGL(mega, dim3(grid), dim3(512), LDS_BYTES, stream, a); }
#else
    a.lo = 0; a.hi = NPH;
    (void)hipMemsetAsync(d_ws, 0, 16384, stream);
    void* kargs[] = {&a};
    hipError_t e = hipLaunchCooperativeKernel((const void*)mega, dim3(grid), dim3(512), kargs, LDS_BYTES, stream);
    if (e != hipSuccess) fprintf(stderr, "cooperative launch failed: %s (grid %d)\n", hipGetErrorString(e), grid);
#endif
}
```

```cpp
#include <hip/hip_runtime.h>
#include <hip/hip_cooperative_groups.h>
#include <cstdio>
#include <cstdint>
namespace cg = cooperative_groups;
namespace pg8 {
#define PG8_LAS __attribute__((address_space(3)))
typedef unsigned short bf16_t;
typedef short bf16x8 __attribute__((ext_vector_type(8)));
typedef float f32x4 __attribute__((ext_vector_type(4)));
typedef unsigned u32x4 __attribute__((ext_vector_type(4)));
constexpr int BM = 256, BK = 64, HALF = 128, HTB = HALF * BK * 2  , STAGE_BYTES = 8 * HTB, NXCD = 8, WGM = 8;

__host__ __device__ __forceinline__ int lds_byte(int r, int c) { const int st = (r >> 4) * 2 + (c >> 5), rr = r & 15, cc = c & 31, ob = rr * 64 + cc * 2; return st * 1024 + (ob ^ (((ob >> 9) & 1) << 5)); }
__host__ __device__ __forceinline__ void stage_rc(int b, int& R, int& C) { const int st = b / 1024, sb = b % 1024, swz = sb ^ (((sb >> 9) & 1) << 5); R = (st >> 1) * 16 + swz / 64; C = (st & 1) * 32 + (swz % 64) / 2; }
__host__ __device__ __forceinline__ int perm32(int rho) { const int n = rho >> 4, i = rho & 15; return 8 * (i >> 2) + 4 * n + (i & 3); }

struct Unit { int pm, pn, ord; };
struct Gemm { const bf16_t* A; const bf16_t* Bt; int M, N, K; };

struct StaticOrder {
    int nM, nN, nwg, G, c;
    __host__ __device__ void init(int M, int N, int G_, int c_) { nM = M / BM; nN = N / BM; nwg = nM * nN; G = G_; c = c_; }
    __host__ __device__ bool next(int i, Unit& u) const {
        const long L = (long)i * G + c; if (L >= nwg) return false;
        int wgid = (int)L; { const int q = nwg / NXCD, r = nwg % NXCD, xcd = wgid % NXCD, off = wgid / NXCD; wgid = (xcd < r ? xcd * (q + 1) : r * (q + 1) + (xcd - r) * q) + off; }
        const int nig = WGM * nN, gid = wgid / nig, fm = gid * WGM, gsz = (nM - fm) < WGM ? (nM - fm) : WGM;
        u.pm = fm + ((wgid % nig) % gsz); u.pn = (wgid % nig) / gsz; u.ord = i; return true;
    }
    __device__ __forceinline__ void a_ready(const Unit&) const {}
    __device__ __forceinline__ void done(const Unit&) const {}
};
__device__ __forceinline__ unsigned cvt_pk_bf16(float lo, float hi) { unsigned r; asm volatile("v_cvt_pk_bf16_f32 %0, %1, %2" : "=v"(r) : "v"(lo), "v"(hi)); return r; }
template <class Epi, class Sched, bool ALIGN_EPI = false, bool SP2 = false>
__device__ __forceinline__ void gemm_phase(PG8_LAS unsigned char* lds, const Gemm g, const Sched& S, const Epi& E, const int tid) {
    const int wid = __builtin_amdgcn_readfirstlane(tid >> 6), lane = tid & 63, wr = wid >> 2, wc = wid & 3, fr = lane & 15, fq = lane >> 4;
    const int K = g.K, nt = K / BK;
    unsigned voffA[2], voffB[2];
#pragma unroll
    for (int i = 0; i < 2; ++i) { int R, C; stage_rc(tid * 16 + i * 8192, R, C); const int Rb = Epi::PERM ? ((R & ~31) + perm32(R & 31)) : R;
        voffA[i] = (unsigned)(R * K + C) * 2u; voffB[i] = (unsigned)(Rb * K + C) * 2u; }
    const size_t kstep = (size_t)(BK * 2);
    const size_t hstep = (size_t)HALF * K * 2;
    const size_t tstep = 2 * hstep;
    const unsigned ldsw = (unsigned)wid * 1024u;
    const int aoff = lds_byte(wr * 64 + fr, fq * 8), boff = lds_byte(wc * 32 + fr, fq * 8);
#define PG8_SA(b, h) (((b) * 2 + (h)) * HTB)
#define PG8_SB(b, h) ((4 + (b) * 2 + (h)) * HTB)
#define PG8_STAGE(bufoff, gbase, voff) do { _Pragma("unroll") for (int _i = 0; _i < 2; ++_i) \
        __builtin_amdgcn_global_load_lds((const unsigned*)((const char*)(gbase) + (voff)[_i]), (PG8_LAS unsigned*)(lds + (bufoff) + ldsw + _i * 8192), 16, 0, 0); } while (0)
#define PG8_LDA(dst, b, h) do { _Pragma("unroll") for (int m = 0; m < 4; ++m) _Pragma("unroll") for (int k = 0; k < 2; ++k) dst[m][k] = *(const PG8_LAS bf16x8*)(lds + PG8_SA(b, h) + aoff + m * 2048 + k * 1024); } while (0)
#define PG8_LDB(dst, b, h) do { _Pragma("unroll") for (int n = 0; n < 2; ++n) _Pragma("unroll") for (int k = 0; k < 2; ++k) dst[n][k] = *(const PG8_LAS bf16x8*)(lds + PG8_SB(b, h) + boff + n * 2048 + k * 1024); } while (0)
#define PG8_MMA(ai, bj, At, Bt) do { __builtin_amdgcn_s_setprio(1); _Pragma("unroll") for (int m = 0; m < 4; ++m) _Pragma("unroll") for (int n = 0; n < 2; ++n) _Pragma("unroll") for (int k = 0; k < 2; ++k) \
        acc[ai][bj][m][n] = __builtin_amdgcn_mfma_f32_16x16x32_bf16(Bt[n][k], At[m][k], acc[ai][bj][m][n], 0, 0, 0); __builtin_amdgcn_s_setprio(0); } while (0)
#define PG8_WAIT_V(n) asm volatile("s_waitcnt vmcnt(" #n ")" ::: "memory")
#define PG8_WAIT_L(n) asm volatile("s_waitcnt lgkmcnt(" #n ")" ::: "memory")
#define PG8_BAR __builtin_amdgcn_s_barrier()
#define PG8_SCHED __builtin_amdgcn_sched_barrier(0)
    Unit cur, nxt; int ui = 0;
    if (!S.next(0, cur)) return;
    f32x4 acc[2][2][4][2];
#pragma unroll
    for (int a = 0; a < 2; ++a)
#pragma unroll
        for (int b = 0; b < 2; ++b)
#pragma unroll
            for (int m = 0; m < 4; ++m)
#pragma unroll
                for (int n = 0; n < 2; ++n) acc[a][b][m][n] = (f32x4){0.f, 0.f, 0.f, 0.f};
    bf16x8 At[4][2], B0[2][2], B1[2][2];
    const char* cA = (const char*)g.A + (size_t)cur.pm * tstep; const char* cB = (const char*)g.Bt + (size_t)cur.pn * tstep;
    S.a_ready(cur);
    if constexpr (SP2) {
        PG8_STAGE(PG8_SB(0, 0), cB, voffB); PG8_STAGE(PG8_SB(0, 1), cB + hstep, voffB); PG8_STAGE(PG8_SA(0, 0), cA, voffA); PG8_STAGE(PG8_SA(0, 1), cA + hstep, voffA);
        if (wr == 1) PG8_BAR;
        PG8_WAIT_V(2); PG8_BAR;
        PG8_STAGE(PG8_SB(1, 0), cB + kstep, voffB); PG8_STAGE(PG8_SA(1, 0), cA + kstep, voffA); PG8_STAGE(PG8_SB(1, 1), cB + hstep + kstep, voffB);
        PG8_WAIT_V(6); PG8_BAR;
    } else {
        PG8_STAGE(PG8_SB(0, 0), cB, voffB); PG8_STAGE(PG8_SA(0, 0), cA, voffA); PG8_STAGE(PG8_SB(0, 1), cB + hstep, voffB); PG8_STAGE(PG8_SA(0, 1), cA + hstep, voffA);
        if (wr == 1) PG8_BAR;
        PG8_WAIT_V(4); PG8_BAR;
        PG8_STAGE(PG8_SB(1, 0), cB + kstep, voffB); PG8_STAGE(PG8_SA(1, 0), cA + kstep, voffA); PG8_STAGE(PG8_SB(1, 1), cB + hstep + kstep, voffB);
        PG8_WAIT_V(6); PG8_BAR;
    }
    for (;;) {
        const bool has_next = S.next(ui + 1, nxt);
        const char* nA = has_next ? (const char*)g.A + (size_t)nxt.pm * tstep : cA; const char* nB = has_next ? (const char*)g.Bt + (size_t)nxt.pn * tstep : cB;
        for (int t = 0; t < nt; t += 2) {
            const bool last = (t == nt - 2);
            const char* a1 = cA + (size_t)(t + 1) * kstep;
            const char* a2 = last ? nA : cA + (size_t)(t + 2) * kstep; const char* b2 = last ? nB : cB + (size_t)(t + 2) * kstep;
            const char* a3 = a2 + kstep; const char* b3 = b2 + kstep;
            if (last && has_next) S.a_ready(nxt);
            if constexpr (SP2) {
            PG8_LDB(B0, 0, 0); PG8_LDB(B1, 0, 1); PG8_SCHED; PG8_LDA(At, 0, 0); PG8_STAGE(PG8_SA(1, 1), a1 + hstep, voffA);
            PG8_WAIT_V(8); PG8_WAIT_L(0); PG8_BAR; PG8_MMA(0, 0, At, B0); PG8_MMA(0, 1, At, B1); PG8_BAR; PG8_SCHED;
            PG8_LDA(At, 0, 1); PG8_STAGE(PG8_SB(0, 0), b2, voffB); PG8_STAGE(PG8_SB(0, 1), b2 + hstep, voffB); PG8_STAGE(PG8_SA(0, 0), a2, voffA);
            PG8_WAIT_V(8); PG8_WAIT_L(0); PG8_BAR; PG8_MMA(1, 0, At, B0); PG8_MMA(1, 1, At, B1); PG8_BAR; PG8_SCHED;
            PG8_LDB(B0, 1, 0); PG8_LDB(B1, 1, 1); PG8_SCHED; PG8_LDA(At, 1, 0); PG8_STAGE(PG8_SA(0, 1), a2 + hstep, voffA);
            PG8_WAIT_V(8); PG8_WAIT_L(0); PG8_BAR; PG8_MMA(0, 0, At, B0); PG8_MMA(0, 1, At, B1); PG8_BAR; PG8_SCHED;
            PG8_LDA(At, 1, 1); PG8_STAGE(PG8_SB(1, 0), b3, voffB); PG8_STAGE(PG8_SB(1, 1), b3 + hstep, voffB); PG8_STAGE(PG8_SA(1, 0), a3, voffA);
            PG8_WAIT_V(8); PG8_WAIT_L(0); PG8_BAR; PG8_MMA(1, 0, At, B0); PG8_MMA(1, 1, At, B1); PG8_BAR; PG8_SCHED;
            } else {
            PG8_LDB(B0, 0, 0); PG8_SCHED; PG8_LDA(At, 0, 0); PG8_STAGE(PG8_SA(1, 1), a1 + hstep, voffA);
            PG8_WAIT_L(8); PG8_BAR; PG8_WAIT_L(0); PG8_MMA(0, 0, At, B0); PG8_BAR; PG8_SCHED;
            PG8_LDB(B1, 0, 1); PG8_STAGE(PG8_SB(0, 0), b2, voffB);
            PG8_BAR; PG8_WAIT_L(0); PG8_MMA(0, 1, At, B1); PG8_BAR;
            PG8_LDA(At, 0, 1); PG8_STAGE(PG8_SA(0, 0), a2, voffA);
            PG8_BAR; PG8_WAIT_L(0); PG8_MMA(1, 0, At, B0); PG8_BAR; PG8_SCHED;
            PG8_STAGE(PG8_SB(0, 1), b2 + hstep, voffB);
            PG8_WAIT_V(6); PG8_BAR; PG8_MMA(1, 1, At, B1); PG8_BAR;
            PG8_LDB(B0, 1, 0); PG8_SCHED; PG8_LDA(At, 1, 0); PG8_STAGE(PG8_SA(0, 1), a2 + hstep, voffA);
            PG8_WAIT_L(8); PG8_BAR; PG8_WAIT_L(0); PG8_MMA(0, 0, At, B0); PG8_BAR; PG8_SCHED;
            PG8_LDB(B1, 1, 1); PG8_STAGE(PG8_SB(1, 0), b3, voffB);
            PG8_BAR; PG8_WAIT_L(0); PG8_MMA(0, 1, At, B1); PG8_BAR;
            PG8_LDA(At, 1, 1); PG8_STAGE(PG8_SA(1, 0), a3, voffA);
            PG8_BAR; PG8_WAIT_L(0); PG8_MMA(1, 0, At, B0); PG8_BAR; PG8_SCHED;
            PG8_STAGE(PG8_SB(1, 1), b3 + hstep, voffB);
            PG8_WAIT_V(6); PG8_BAR; PG8_MMA(1, 1, At, B1); PG8_BAR;
            }
        }
        if constexpr (ALIGN_EPI) { if (wr == 0) PG8_BAR; }
        if constexpr (!Epi::AFTER_DRAIN) { E(acc, cur, wr, wc, fr, fq); S.done(cur); }
        if (!has_next) break;
#pragma unroll
        for (int a = 0; a < 2; ++a)
#pragma unroll
            for (int b = 0; b < 2; ++b)
#pragma unroll
                for (int m = 0; m < 4; ++m)
#pragma unroll
                    for (int n = 0; n < 2; ++n) acc[a][b][m][n] = (f32x4){0.f, 0.f, 0.f, 0.f};
        cur = nxt; cA = nA; cB = nB; ++ui;
        if constexpr (ALIGN_EPI) { if (wr == 1) PG8_BAR; }
    }
    PG8_WAIT_V(0);
    if constexpr (!ALIGN_EPI) { if (wr == 0) PG8_BAR; }
    PG8_BAR;
    if constexpr (Epi::AFTER_DRAIN) { E.fused(acc, cur, wr, wc, fr, fq, lds, wid, lane); S.done(cur); }
#undef PG8_SA
#undef PG8_SB
#undef PG8_STAGE
#undef PG8_LDA
#undef PG8_LDB
#undef PG8_MMA
#undef PG8_WAIT_V
#undef PG8_WAIT_L
#undef PG8_BAR
#undef PG8_SCHED
}
}

typedef unsigned short bf16;
typedef float f32x4 __attribute__((ext_vector_type(4)));
typedef float f32x2 __attribute__((ext_vector_type(2)));
typedef unsigned u32x4 __attribute__((ext_vector_type(4)));
typedef unsigned u32x2 __attribute__((ext_vector_type(2)));

#ifndef MK_MULTI
#define MK_MULTI 0
#endif

constexpr int Bn = 8, S = 4096, T = Bn * S, D = 1024, FF = 2816, DEPTH = 4;
constexpr float EPS = 1e-6f;
constexpr int GDN_NPAD = 4352, NSA_NPAD = 2816;
constexpr int LDS_BYTES = 147456;
constexpr size_t MiB = 1u << 20;
constexpr size_t WS_WGU = 1 * MiB;
constexpr size_t WS_WDN = WS_WGU + 88 * MiB;
constexpr size_t WS_WGI = WS_WDN + 44 * MiB;
constexpr size_t WS_WGO = WS_WGI + 17 * MiB;
constexpr size_t WS_WSI = WS_WGO + 4 * MiB;
constexpr size_t WS_WSO = WS_WSI + 6 * MiB;
constexpr size_t WS_WNI = WS_WSO + 2 * MiB;
constexpr size_t WS_WNO = WS_WNI + 6 * MiB;
constexpr size_t WS_WC1 = WS_WNO + 2 * MiB;
constexpr size_t WS_TAB = WS_WC1 + 2 * MiB;
constexpr size_t WS_HN  = 184 * MiB;
constexpr size_t WS_R   = WS_HN + 64 * MiB;
constexpr size_t WS_O32 = WS_R + 256 * MiB;
constexpr size_t WS_SM  = WS_O32 + 128 * MiB;
constexpr size_t WS_AB  = WS_SM;
constexpr size_t WS_GT  = WS_SM + 2 * MiB;
constexpr size_t WS_BP  = WS_SM + 8 * MiB;
constexpr size_t WS_END = WS_SM + 9 * MiB;
static_assert(WS_TAB + 8 * MiB <= WS_HN, "ws map");

__device__ __forceinline__ float bf2f(unsigned v) { return __uint_as_float(v << 16); }
__device__ __forceinline__ unsigned f2bf(float f) { unsigned u = __float_as_uint(f); return (u + 0x7fffu + ((u >> 16) & 1u)) >> 16; }
__device__ __forceinline__ unsigned pk2(float lo, float hi) { return f2bf(lo) | (f2bf(hi) << 16); }
#define MFMA32(a, b, c) __builtin_amdgcn_mfma_f32_32x32x16_bf16((a), (b), (c), 0, 0, 0)
typedef short bf16x8v __attribute__((ext_vector_type(8)));
typedef float f32x16 __attribute__((ext_vector_type(16)));
typedef __bf16 bf16v2 __attribute__((ext_vector_type(2)));
__device__ __forceinline__ unsigned pkbf(float a, float b) { f32x2 v = {a, b}; return __builtin_bit_cast(unsigned, __builtin_convertvector(v, bf16v2)); }
__device__ __forceinline__ int lane_opq() { int l = (int)__builtin_amdgcn_mbcnt_hi(~0u, __builtin_amdgcn_mbcnt_lo(~0u, 0u)); asm volatile("" : "+v"(l)); return l; }
__device__ __forceinline__ float xshfl(float v, int m) { return __int_as_float(__builtin_amdgcn_ds_bpermute((lane_opq() ^ m) << 2, __float_as_int(v))); }
__device__ __forceinline__ float xshfl_up(float v, int o) { return __int_as_float(__builtin_amdgcn_ds_bpermute((lane_opq() - o) << 2, __float_as_int(v))); }
__device__ __forceinline__ float wave_sum(float v) {
#pragma unroll
    for (int o = 1; o < 64; o <<= 1) v += xshfl(v, o);
    return v;
}
__device__ __forceinline__ float wave_max(float v) {
#pragma unroll
    for (int o = 1; o < 64; o <<= 1) v = fmaxf(v, xshfl(v, o));
    return v;
}
__device__ __forceinline__ float row_sum16(float v) {
    v += __uint_as_float((unsigned)__builtin_amdgcn_update_dpp(0, (int)__float_as_uint(v), 0x128, 0xf, 0xf, false));
    v += __uint_as_float((unsigned)__builtin_amdgcn_update_dpp(0, (int)__float_as_uint(v), 0x124, 0xf, 0xf, false));
    v += __uint_as_float((unsigned)__builtin_amdgcn_update_dpp(0, (int)__float_as_uint(v), 0x122, 0xf, 0xf, false));
    v += __uint_as_float((unsigned)__builtin_amdgcn_update_dpp(0, (int)__float_as_uint(v), 0x121, 0xf, 0xf, false));
    return v;
}
__device__ __forceinline__ float sigmoidf_(float x) { return 1.f / (1.f + __expf(-x)); }
__device__ __forceinline__ float siluf_(float x) { return x * __builtin_amdgcn_rcpf(1.f + __expf(-x)); }
#define LDS_BAR() do { asm volatile("s_waitcnt lgkmcnt(0)" ::: "memory"); __builtin_amdgcn_s_barrier(); asm volatile("" ::: "memory"); } while (0)
#define WAVE_SYNC() do { asm volatile("s_waitcnt lgkmcnt(0)" ::: "memory"); __builtin_amdgcn_wave_barrier(); } while (0)

__device__ __forceinline__ float row_rstd(const float* ssq, size_t row) {
    const f32x4* p = (const f32x4*)(ssq + row * 16); const f32x4 a = p[0], b = p[1], c = p[2], d = p[3];
    const float t = ((a.x + a.y) + (a.z + a.w)) + ((b.x + b.y) + (b.z + b.w)) + ((c.x + c.y) + (c.z + c.w)) + ((d.x + d.y) + (d.z + d.w));
    return 1.f / sqrtf(t * (1.f / D) + EPS);
}
namespace pg8 {
struct EpiSwiGLU {
    static constexpr bool PERM = true, AFTER_DRAIN = false;
    bf16_t* O; const float* ssq;
    __device__ __forceinline__ void operator()(const f32x4 (&acc)[2][2][4][2], const Unit& u, int wr, int wc, int fr, int fq) const {
        const int row0 = u.pm * BM + wr * 64 + fr, col0 = u.pn * HALF + wc * 32 + 8 * fq;
#pragma unroll
        for (int ai = 0; ai < 2; ++ai)
#pragma unroll
            for (int m = 0; m < 4; ++m) {
                bf16_t* rowp = O + (size_t)(row0 + ai * HALF + m * 16) * FF + col0;
                const float rs = ssq[u.ord * 256 + wr * 64 + fr + ai * HALF + m * 16];
                float v[8];
#pragma unroll
                for (int n = 0; n < 2; ++n)
#pragma unroll
                    for (int j = 0; j < 4; ++j) { const float g = acc[ai][0][m][n][j] * rs, uu = acc[ai][1][m][n][j] * rs; v[n * 4 + j] = g * __builtin_amdgcn_rcpf(1.f + __expf(-g)) * uu; }
                u32x4 w; w.x = cvt_pk_bf16(v[0], v[1]); w.y = cvt_pk_bf16(v[2], v[3]); w.z = cvt_pk_bf16(v[4], v[5]); w.w = cvt_pk_bf16(v[6], v[7]);
                *(u32x4*)rowp = w;
            }
    }
};
template <int SC2> struct EpiResid {
    static constexpr bool PERM = true, AFTER_DRAIN = false;
    const float* base; float* out; bf16_t* HB; float* ssq;
    __device__ __forceinline__ void operator()(const f32x4 (&acc)[2][2][4][2], const Unit& u, int wr, int wc, int fr, int fq) const {
        constexpr float scale = 0.5f * SC2;
        const int row0 = u.pm * BM + wr * 64 + fr, col0 = u.pn * BM + wc * 32 + 8 * fq;
#pragma unroll
        for (int ai = 0; ai < 2; ++ai)
#pragma unroll
            for (int m = 0; m < 4; ++m) {
                const size_t off = (size_t)(row0 + ai * HALF + m * 16) * D + col0;
                float sq = 0.f;
#pragma unroll
                for (int bj = 0; bj < 2; ++bj) {
                    const f32x4 b0 = *(const f32x4*)(base + off + bj * HALF), b1 = *(const f32x4*)(base + off + bj * HALF + 4);
                    const f32x4 o0 = b0 + acc[ai][bj][m][0] * scale, o1 = b1 + acc[ai][bj][m][1] * scale;
                    *(f32x4*)(out + off + bj * HALF) = o0; *(f32x4*)(out + off + bj * HALF + 4) = o1;
                    { u32x4 w; w.x = cvt_pk_bf16(o0[0], o0[1]); w.y = cvt_pk_bf16(o0[2], o0[3]); w.z = cvt_pk_bf16(o1[0], o1[1]); w.w = cvt_pk_bf16(o1[2], o1[3]);
                        *(u32x4*)(HB + off + bj * HALF) = w;
                        sq += ((o0[0] * o0[0] + o0[1] * o0[1]) + (o0[2] * o0[2] + o0[3] * o0[3])) + ((o1[0] * o1[0] + o1[1] * o1[1]) + (o1[2] * o1[2] + o1[3] * o1[3])); }
                }
                { sq += xshfl(sq, 16); sq += xshfl(sq, 32); if (fq == 0) ssq[(size_t)(row0 + ai * HALF + m * 16) * 16 + u.pn * 4 + wc] = sq; }
                if (m == 3) asm volatile("" ::: "memory");
            }
    }
};
struct EpiProj {
    static constexpr bool PERM = true, AFTER_DRAIN = false;
    bf16_t* O; int ldc; int nmain; float* tail; int ldt; int nvalid; const float* ssq;
    __device__ __forceinline__ void operator()(const f32x4 (&acc)[2][2][4][2], const Unit& u, int wr, int wc, int fr, int fq) const {
        const int row0 = u.pm * BM + wr * 64 + fr, colt = u.pn * BM, col0 = colt + wc * 32 + 8 * fq;
        if (colt + BM <= nmain) {
#pragma unroll
            for (int ai = 0; ai < 2; ++ai)
#pragma unroll
                for (int m = 0; m < 4; ++m) {
                    bf16_t* rowp = O + (size_t)(row0 + ai * HALF + m * 16) * ldc + col0;
                    const float rs = ssq[u.ord * 256 + wr * 64 + fr + ai * HALF + m * 16];
#pragma unroll
                    for (int bj = 0; bj < 2; ++bj) { const f32x4 v0 = acc[ai][bj][m][0] * rs, v1 = acc[ai][bj][m][1] * rs;
                        u32x4 w; w.x = cvt_pk_bf16(v0[0], v0[1]); w.y = cvt_pk_bf16(v0[2], v0[3]); w.z = cvt_pk_bf16(v1[0], v1[1]); w.w = cvt_pk_bf16(v1[2], v1[3]);
                        *(u32x4*)(rowp + bj * HALF) = w; }
                }
        } else {
#pragma unroll
            for (int ai = 0; ai < 2; ++ai)
#pragma unroll
                for (int m = 0; m < 4; ++m) {
                    const size_t row = (size_t)(row0 + ai * HALF + m * 16);
                    const float rs = ssq[u.ord * 256 + wr * 64 + fr + ai * HALF + m * 16];
#pragma unroll
                    for (int bj = 0; bj < 2; ++bj)
#pragma unroll
                        for (int n = 0; n < 2; ++n)
#pragma unroll
                            for (int j = 0; j < 4; ++j) { const int col = col0 + bj * HALF + 4 * n + j; if (col >= nmain && col < nvalid) tail[row * ldt + (col - nmain)] = acc[ai][bj][m][n][j] * rs; }
                }
        }
    }
};
struct EpiF32 {
    static constexpr bool PERM = false, AFTER_DRAIN = false;
    float* C; int ldc;
    __device__ __forceinline__ void operator()(const f32x4 (&acc)[2][2][4][2], const Unit& u, int wr, int wc, int fr, int fq) const {
        const int row0 = u.pm * BM + wr * 64 + fr, col0 = u.pn * BM + wc * 32 + 4 * fq;
#pragma unroll
        for (int ai = 0; ai < 2; ++ai)
#pragma unroll
            for (int m = 0; m < 4; ++m) {
                float* rowp = C + (size_t)(row0 + ai * HALF + m * 16) * ldc + col0;
#pragma unroll
                for (int bj = 0; bj < 2; ++bj)
#pragma unroll
                    for (int n = 0; n < 2; ++n) *(f32x4*)(rowp + bj * HALF + n * 16) = acc[ai][bj][m][n];
            }
    }
};
}

template <class Sched>
__device__ __forceinline__ void rstd_table(float* tab, const float* ssq, const Sched& SO, int tid) {
    pg8::Unit u;
    int nu = 0; while (SO.next(nu, u)) ++nu;
    for (int k0 = 0; k0 < nu * 256; k0 += 512 * 3) {
        float t3[3];
#pragma unroll
        for (int k = 0; k < 3; ++k) { const int idx = k0 + 512 * k + tid; t3[k] = 0.f; if (idx < nu * 256) { SO.next(idx >> 8, u); t3[k] = row_rstd(ssq, (size_t)u.pm * 256 + (idx & 255)); } }
#pragma unroll
        for (int k = 0; k < 3; ++k) { const int idx = k0 + 512 * k + tid; if (idx < nu * 256) tab[idx] = t3[k]; }
    }
    __syncthreads();
}
__device__ __forceinline__ void xpose_item(const float* W, const float* nw, int K, int N, bf16* WT, int rowbase, float* scr, int k0, int n0, int lane) {
    if (n0 + 32 <= N && (N & 3) == 0) {
        f32x4 v[8];
#pragma unroll
        for (int i = 0; i < 8; ++i) { v[i] = *(const f32x4*)(W + (size_t)(k0 + 8 * i + (lane >> 3)) * N + n0 + 4 * (lane & 7)); if (nw) v[i] *= nw[k0 + 8 * i + (lane >> 3)]; }
#pragma unroll
        for (int i = 0; i < 8; ++i) { float* d = scr + (8 * i + (lane >> 3)) * 33 + 4 * (lane & 7); d[0] = v[i].x; d[1] = v[i].y; d[2] = v[i].z; d[3] = v[i].w; }
    } else {
#pragma unroll 8
        for (int i = 0; i < 32; ++i) { const int kk = 2 * i + (lane >> 5), n = n0 + (lane & 31); scr[kk * 33 + (lane & 31)] = n < N ? W[(size_t)(k0 + kk) * N + n] * (nw ? nw[k0 + kk] : 1.f) : 0.f; }
    }
    WAVE_SYNC();
    const int c = lane & 7;
#pragma unroll
    for (int j = 0; j < 4; ++j) { const int n = (lane >> 3) + 8 * j; const float* s = scr + (8 * c) * 33 + n;
        u32x4 o; o.x = pk2(s[0 * 33], s[1 * 33]); o.y = pk2(s[2 * 33], s[3 * 33]); o.z = pk2(s[4 * 33], s[5 * 33]); o.w = pk2(s[6 * 33], s[7 * 33]);
        *(u32x4*)(WT + (size_t)(rowbase + n) * K + k0 + 8 * c) = o; }
    WAVE_SYNC();
}
__device__ __forceinline__ void xpose_matrix(const float* W, const float* nw, int K, int N, int Npad, bf16* WT, int mode, float* scr, int gw, int NGW, int lane) {
    const int nblk = Npad / 32, nitems = (K / 64) * nblk;
    for (int it = gw; it < nitems; it += NGW) {
        const int kb = it / nblk, nb = it - kb * nblk, n0 = nb * 32;
        int rb = n0;
        if (mode == 1) rb = (n0 < FF) ? ((n0 >> 7) * 256 + (n0 & 127)) : ((((n0 - FF) >> 7) * 256) + 128 + ((n0 - FF) & 127));
        xpose_item(W, nw, K, N, WT, rb, scr, kb * 64, n0, lane);
    }
}

__device__ __forceinline__ void phase_norm(const float* h, const float* w, bf16* out, int gw, int NGW, int lane) {
    f32x4 wv[4];
#pragma unroll
    for (int j = 0; j < 4; ++j) wv[j] = ((const f32x4*)w)[64 * j + lane];
    for (int m = gw; m < T; m += NGW) {
        const f32x4* xr = (const f32x4*)(h + (size_t)m * D) + lane;
        f32x4 v[4]; float s = 0.f;
#pragma unroll
        for (int j = 0; j < 4; ++j) { v[j] = xr[64 * j]; s += (v[j].x * v[j].x + v[j].y * v[j].y) + (v[j].z * v[j].z + v[j].w * v[j].w); }
        const float rstd = 1.f / sqrtf(wave_sum(s) * (1.f / D) + EPS);
        u32x2* o8 = (u32x2*)(out + (size_t)m * D) + lane;
#pragma unroll
        for (int j = 0; j < 4; ++j) { u32x2 o; o.x = pk2(v[j].x * rstd * wv[j].x, v[j].y * rstd * wv[j].y); o.y = pk2(v[j].z * rstd * wv[j].z, v[j].w * rstd * wv[j].w); o8[64 * j] = o; }
    }
}

__device__ __forceinline__ void phase_gdn_scan(unsigned char* lds, const bf16* proj, const float* ab, const float* convw, const float* A_log, const float* dt_bias,
                                               float* o32, int vblk, int nblk, int tid, int wid, int lane) {
    float* qs = (float*)lds;
    float* ks = qs + 64 * 128;
    float* vs = ks + 64 * 128;
    float* al = vs + 64 * 32;
    float* be = al + 64;
    float* qk = be + 64;
    float* os = qk + 64;
    bf16* raw = (bf16*)(os + 64 * 32);
    const int e = tid >> 4, dl = tid & 15;
    for (int item = vblk; item < 256; item += nblk) {
        const int bh = (item & 7) + 8 * (item >> 5), es = (item >> 3) & 3, b = bh >> 3, h = bh & 7;
        const float Ah = __expf(A_log[h]), dtb = dt_bias[h];
        const int isk = (tid >> 4) & 1, cg = tid & 15, cv = tid & 3;
        const int colqk = isk * 1024 + h * 128 + cg * 8, colv = 2048 + h * 128 + es * 32 + cv * 8;
        f32x4 wq[4][2], wv[4][2];
#pragma unroll
        for (int j = 0; j < 4; ++j) { wq[j][0] = *(const f32x4*)(convw + j * 3072 + colqk); wq[j][1] = *(const f32x4*)(convw + j * 3072 + colqk + 4);
                                      wv[j][0] = *(const f32x4*)(convw + j * 3072 + colv);  wv[j][1] = *(const f32x4*)(convw + j * 3072 + colv + 4); }
        f32x2 S2[4];
#pragma unroll
        for (int i = 0; i < 4; ++i) S2[i] = (f32x2){0.f, 0.f};
        u32x4 pre[5];
#define GDN_PREFETCH(T0) do { _Pragma("unroll") for (int k_ = 0; k_ < 5; ++k_) { const int idx_ = tid + 512 * k_; const int row_ = idx_ / 36, c_ = idx_ - row_ * 36; const int ts_ = (T0) - 3 + row_; \
            const int col_ = c_ < 16 ? h * 128 + c_ * 8 : (c_ < 32 ? 1024 + h * 128 + (c_ - 16) * 8 : 2048 + h * 128 + es * 32 + (c_ - 32) * 8); \
            pre[k_] = (u32x4){0u, 0u, 0u, 0u}; if (idx_ < 67 * 36 && ts_ >= 0) pre[k_] = *(const u32x4*)(proj + (size_t)(b * S + ts_) * 4096 + col_); } } while (0)
#define GDN_PARK() do { _Pragma("unroll") for (int k_ = 0; k_ < 5; ++k_) { const int idx_ = tid + 512 * k_; if (idx_ < 67 * 36) *(u32x4*)(raw + idx_ * 8) = pre[k_]; } } while (0)
#define GDN_CONV8(ROW0, C8, W, OUT) do { _Pragma("unroll") for (int i_ = 0; i_ < 8; ++i_) OUT[i_] = 0.f; _Pragma("unroll") for (int j_ = 0; j_ < 4; ++j_) { const u32x4 xv_ = *(const u32x4*)(raw + ((ROW0) + j_) * 288 + (C8) * 8); \
            OUT[0] += bf2f(xv_.x & 0xffffu) * W[j_][0].x; OUT[1] += bf2f(xv_.x >> 16) * W[j_][0].y; OUT[2] += bf2f(xv_.y & 0xffffu) * W[j_][0].z; OUT[3] += bf2f(xv_.y >> 16) * W[j_][0].w; \
            OUT[4] += bf2f(xv_.z & 0xffffu) * W[j_][1].x; OUT[5] += bf2f(xv_.z >> 16) * W[j_][1].y; OUT[6] += bf2f(xv_.w & 0xffffu) * W[j_][1].z; OUT[7] += bf2f(xv_.w >> 16) * W[j_][1].w; } \
            _Pragma("unroll") for (int i_ = 0; i_ < 8; ++i_) OUT[i_] = siluf_(OUT[i_]); } while (0)
#define GDN_CONVNORM(T0) do { \
            _Pragma("unroll") for (int it_ = 0; it_ < 4; ++it_) { const int tok_ = it_ * 16 + (tid >> 5); float y_[8]; GDN_CONV8(tok_, isk * 16 + cg, wq, y_); \
                float ss_ = (y_[0] * y_[0] + y_[1] * y_[1]) + (y_[2] * y_[2] + y_[3] * y_[3]) + (y_[4] * y_[4] + y_[5] * y_[5]) + (y_[6] * y_[6] + y_[7] * y_[7]); \
                ss_ = row_sum16(ss_); const float sc_ = (1.f / sqrtf(ss_ + EPS)) * (isk ? 1.f : 0.08838834764831845f); \
                float* d_ = (isk ? ks : qs) + tok_ * 128 + cg * 8; \
                _Pragma("unroll") for (int i_ = 0; i_ < 8; ++i_) y_[i_] *= sc_; \
                *(f32x4*)d_ = (f32x4){y_[0], y_[1], y_[2], y_[3]}; *(f32x4*)(d_ + 4) = (f32x4){y_[4], y_[5], y_[6], y_[7]}; \
                float dq_ = 0.f; _Pragma("unroll") for (int i_ = 0; i_ < 8; ++i_) dq_ += y_[i_] * xshfl(y_[i_], 16); \
                dq_ = row_sum16(dq_); if (isk == 0 && cg == 0) qk[tok_] = dq_; } \
            if (tid < 256) { const int tok_ = tid >> 2; float y_[8]; GDN_CONV8(tok_, 32 + cv, wv, y_); float* d_ = vs + tok_ * 32 + cv * 8; \
                *(f32x4*)d_ = (f32x4){y_[0], y_[1], y_[2], y_[3]}; *(f32x4*)(d_ + 4) = (f32x4){y_[4], y_[5], y_[6], y_[7]}; } \
            if (tid < 64) { const size_t tg_ = (size_t)(b * S + (T0) + tid); const float a_ = ab[tg_ * 16 + h] + dtb, bb_ = ab[tg_ * 16 + 8 + h]; \
                const float sp_ = a_ > 20.f ? a_ : __logf(1.f + __expf(a_)); al[tid] = __expf(-Ah * sp_); be[tid] = sigmoidf_(bb_); } } while (0)
        __syncthreads();
        GDN_PREFETCH(0); GDN_PARK();
        __syncthreads();
        GDN_CONVNORM(0);
        __syncthreads();
        for (int chunk = 0; chunk < S / 64; ++chunk) {
            const int t0 = chunk * 64;
            const bool more = chunk + 1 < S / 64;
            if (more) GDN_PREFETCH(t0 + 64);
            {
                const float* kp = ks + dl * 8; const float* qp = qs + dl * 8; const float* vp = vs + e;
                f32x4 nk0 = *(const f32x4*)kp, nk1 = *(const f32x4*)(kp + 4), nq0 = *(const f32x4*)qp, nq1 = *(const f32x4*)(qp + 4);
                float nv = vp[0], na = al[0], nb = be[0], nqk = qk[0];
                for (int t16 = 0; t16 < 4; ++t16) {
                    float ok = 0.f;
#pragma unroll 4
                    for (int i = 0; i < 16; ++i) {
                        const int tt = t16 * 16 + i, tn = (tt + 1) & 63;
                        const f32x2 K0 = {nk0.x, nk0.y}, K1 = {nk0.z, nk0.w}, K2 = {nk1.x, nk1.y}, K3 = {nk1.z, nk1.w};
                        const f32x2 Q0 = {nq0.x, nq0.y}, Q1 = {nq0.z, nq0.w}, Q2 = {nq1.x, nq1.y}, Q3 = {nq1.z, nq1.w};
                        const float v = nv, a = na, bt = nb, qkt = nqk;
                        nk0 = *(const f32x4*)(kp + tn * 128); nk1 = *(const f32x4*)(kp + tn * 128 + 4); nq0 = *(const f32x4*)(qp + tn * 128); nq1 = *(const f32x4*)(qp + tn * 128 + 4);
                        nv = vp[tn * 32]; na = al[tn]; nb = be[tn]; nqk = qk[tn];
                        f32x2 pa = K0 * S2[0], pb = K2 * S2[2], qa = Q0 * S2[0], qb = Q2 * S2[2];
                        pa = K1 * S2[1] + pa; pb = K3 * S2[3] + pb; qa = Q1 * S2[1] + qa; qb = Q3 * S2[3] + qb;
                        pa += pb; qa += qb;
                        float p = pa.x + pa.y, qS = qa.x + qa.y;
                        p = row_sum16(p); qS = row_sum16(qS);
                        const float vn = bt * (v - a * p);
                        const float o = a * qS + qkt * vn;
                        const f32x2 vn2 = {vn, vn}, a2 = {a, a};
                        S2[0] = S2[0] * a2 + K0 * vn2; S2[1] = S2[1] * a2 + K1 * vn2; S2[2] = S2[2] * a2 + K2 * vn2; S2[3] = S2[3] * a2 + K3 * vn2;
                        ok = (i == dl) ? o : ok;
                    }
                    os[(t16 * 16 + dl) * 32 + e] = ok;
                }
            }
            __syncthreads();
            { const int tok = tid >> 3, c4 = tid & 7;
              *(f32x4*)(o32 + (size_t)(b * S + t0 + tok) * D + h * 128 + es * 32 + c4 * 4) = *(const f32x4*)(os + tok * 32 + c4 * 4); }
            if (more) {
                GDN_PARK();
                __syncthreads();
                GDN_CONVNORM(t0 + 64);
            }
            __syncthreads();
        }
#undef GDN_PREFETCH
#undef GDN_PARK
#undef GDN_CONV8
#undef GDN_CONVNORM
    }
}

constexpr size_t WS_HALO = WS_END;
constexpr size_t WS_GL = WS_END + 10 * MiB;
constexpr size_t WS_SS = WS_GL + 1 * MiB;
constexpr size_t WS_END2 = WS_SS + 26 * MiB;

__device__ __forceinline__ void phase_gdn_halo(const bf16* proj, bf16* halo, int gtid, int NT) {
    for (int idx = gtid; idx < Bn * 64 * 3 * 384; idx += NT) {
        const int c = idx % 384, r3 = (idx / 384) % 3, bn = idx / (384 * 3), n = bn & 63, b = bn >> 6;
        u32x4 v = {0u, 0u, 0u, 0u};
        if (n > 0) v = *(const u32x4*)(proj + (size_t)(b * S + 64 * n - 3 + r3) * 4096 + c * 8);
        *(u32x4*)(halo + (size_t)(bn * 3 + r3) * 3072 + c * 8) = v;
    }
}

constexpr int GP_RAW = 0, GP_QB = 51456, GP_KB = GP_QB + 17408, GP_VB = GP_KB + 17408, GP_AM = GP_VB + 16384, GP_GC = GP_AM + 17408, GP_W = GP_GC + 1024;
__device__ __forceinline__ void phase_gdn_prep(unsigned char* lds, bf16* proj, const bf16* halo, const float* ab, const float* convw, const float* A_log, const float* dt_bias,
                                               bf16* KT, bf16* AT, float* GL, int vblk, int nblk, int tid, int wid, int lane) {
    bf16* raw = (bf16*)(lds + GP_RAW);
    bf16* wimg = (bf16*)(lds + GP_W);
    unsigned char* qb = lds + GP_QB;
    unsigned char* kb = lds + GP_KB;
    bf16* vb = (bf16*)(lds + GP_VB);
    float* Am = (float*)(lds + GP_AM);
    float* gcs = (float*)(lds + GP_GC);
    float* bes = gcs + 64;
    const int r = lane & 31, hh = lane >> 5;
    for (int item = vblk; item < Bn * 8 * 64; item += nblk) {
        const int n = item & 63, h = (item >> 6) & 7, b = item >> 9;
        const size_t tok0 = (size_t)b * S + 64 * n;
        LDS_BAR();
#define GP_RAWLOAD(ITEM, T0, NT) do { const int n_ = (ITEM) & 63, h_ = ((ITEM) >> 6) & 7, b_ = (ITEM) >> 9; const size_t tk0_ = (size_t)b_ * S + 64 * n_; \
        for (int idx = (T0); idx < 67 * 48; idx += (NT)) { const int row = idx / 48, c = idx - row * 48; \
            const int col = c < 16 ? h_ * 128 + c * 8 : (c < 32 ? 1024 + h_ * 128 + (c - 16) * 8 : 2048 + h_ * 128 + (c - 32) * 8); \
            u32x4 v; if (row < 3) v = *(const u32x4*)(halo + (size_t)((b_ * 64 + n_) * 3 + row) * 3072 + col); else v = *(const u32x4*)(proj + (tk0_ + row - 3) * 4096 + col); \
            *(u32x4*)(raw + row * 384 + c * 8) = v; } } while (0)
        if (item == vblk) GP_RAWLOAD(item, tid, 512);
        if (tid < 64) {
            const float a = ab[(tok0 + tid) * 16 + h] + dt_bias[h], bb = ab[(tok0 + tid) * 16 + 8 + h];
            const float sp = a > 20.f ? a : __logf(1.f + __expf(a));
            float g = -__expf(A_log[h]) * sp;
#pragma unroll
            for (int o = 1; o < 64; o <<= 1) { const float t_ = xshfl_up(g, o); if (lane >= o) g += t_; }
            const float be_ = sigmoidf_(bb);
            gcs[tid] = g; bes[tid] = be_; gcs[128 + tid] = be_; gcs[192 + tid] = be_ * __expf(g);
        }
        LDS_BAR();
        {
            const int isk = (tid >> 4) & 1, cg = tid & 15;
            const int colqk = isk * 1024 + h * 128 + cg * 8, colv = 2048 + h * 128 + cg * 8;
#define GP_CONV8(ROW0, C8, COL, OUT) do { _Pragma("unroll") for (int i_ = 0; i_ < 8; ++i_) OUT[i_] = 0.f; _Pragma("unroll") for (int j_ = 0; j_ < 4; ++j_) { const u32x4 xv_ = *(const u32x4*)(raw + ((ROW0) + j_) * 384 + (C8) * 8); \
            const f32x4 w0_ = *(const f32x4*)(convw + j_ * 3072 + (COL)), w1_ = *(const f32x4*)(convw + j_ * 3072 + (COL) + 4); \
            OUT[0] += bf2f(xv_.x & 0xffffu) * w0_.x; OUT[1] += bf2f(xv_.x >> 16) * w0_.y; OUT[2] += bf2f(xv_.y & 0xffffu) * w0_.z; OUT[3] += bf2f(xv_.y >> 16) * w0_.w; \
            OUT[4] += bf2f(xv_.z & 0xffffu) * w1_.x; OUT[5] += bf2f(xv_.z >> 16) * w1_.y; OUT[6] += bf2f(xv_.w & 0xffffu) * w1_.z; OUT[7] += bf2f(xv_.w >> 16) * w1_.w; } \
            _Pragma("unroll") for (int i_ = 0; i_ < 8; ++i_) OUT[i_] = siluf_(OUT[i_]); } while (0)
#pragma unroll 1
            for (int it = 0; it < 4; ++it) {
                const int tk = it * 16 + (tid >> 5);
                float y[8]; GP_CONV8(tk, isk * 16 + cg, colqk, y);
                float ss = (y[0] * y[0] + y[1] * y[1]) + (y[2] * y[2] + y[3] * y[3]) + (y[4] * y[4] + y[5] * y[5]) + (y[6] * y[6] + y[7] * y[7]);
                ss = row_sum16(ss);
                const float sc = (1.f / sqrtf(ss + EPS)) * (isk ? 1.f : 0.08838834764831845f);
                u32x4 w; w.x = pkbf(y[0] * sc, y[1] * sc); w.y = pkbf(y[2] * sc, y[3] * sc); w.z = pkbf(y[4] * sc, y[5] * sc); w.w = pkbf(y[6] * sc, y[7] * sc);
                *(u32x4*)((isk ? kb : qb) + tk * 272 + cg * 16) = w;
            }
#pragma unroll 1
            for (int it = 0; it < 2; ++it) {
                const int tk = it * 32 + (tid >> 4);
                float y[8]; GP_CONV8(tk, 32 + cg, colv, y);
                u32x4 w; w.x = pkbf(y[0], y[1]); w.y = pkbf(y[2], y[3]); w.z = pkbf(y[4], y[5]); w.w = pkbf(y[6], y[7]);
                *(u32x4*)(vb + tk * 128 + cg * 8) = w;
            }
#undef GP_CONV8
        }
        LDS_BAR();
        {
            const int prod = wid >> 2, tr = (wid >> 1) & 1, tc = wid & 1;
            f32x16 acc;
#pragma unroll
            for (int i = 0; i < 16; ++i) acc[i] = 0.f;
            if (tr >= tc) {
                const unsigned char* Ab = (prod ? qb : kb) + (32 * tr + r) * 272 + hh * 16;
                const unsigned char* Bb = kb + (32 * tc + r) * 272 + hh * 16;
#pragma unroll
                for (int ks = 0; ks < 8; ++ks) acc = MFMA32(*(const bf16x8v*)(Ab + ks * 32), *(const bf16x8v*)(Bb + ks * 32), acc);
            }
            const int j = 32 * tc + r; const float gj = gcs[j];
#pragma unroll
            for (int i_ = 0; i_ < 16; ++i_) {
                const int i = 32 * tr + (i_ & 3) + 8 * (i_ >> 2) + 4 * hh;
                const float dec = __expf(gcs[i] - gj);
                if (prod == 0) Am[i * 68 + j] = (j < i) ? bes[i] * acc[i_] * dec : 0.f;
                else AT[(size_t)item * 4096 + i * 64 + j] = (bf16)f2bf((j <= i) ? acc[i_] * dec : 0.f);
            }
        }
        LDS_BAR();
        int tid3 = tid; asm volatile("" : "+v"(tid3));
        if (tid3 < 256) {
            const int isw = tid3 >> 7, d = tid3 & 127;
            unsigned oam = GP_AM, orsc = GP_GC + 512 + isw * 256, ocol = (isw ? GP_KB : GP_VB) + d * 2;
            asm volatile("" : "+v"(oam), "+v"(orsc), "+v"(ocol));
            const float* Am_ = (const float*)(lds + oam); const float* rsc = (const float*)(lds + orsc); const unsigned char* col = lds + ocol;
            const int cstride = isw ? 272 : 256;
            float X[64];
#pragma clang loop unroll(full)
            for (int i = 0; i < 64; ++i) X[i] = 0.f;
#pragma clang loop unroll(full)
            for (int i = 0; i < 64; ++i) {
                f32x4 av = {0.f, 0.f, 0.f, 0.f};
#pragma clang loop unroll(full)
                for (int j4 = 0; j4 < 16; ++j4) { if (4 * j4 < i) { const f32x4 a4 = *(const f32x4*)(Am_ + i * 68 + 4 * j4);
                    const f32x4 x4 = {X[4 * j4], X[4 * j4 + 1], X[4 * j4 + 2], X[4 * j4 + 3]}; av += a4 * x4; } }
                X[i] = rsc[i] * bf2f(*(const bf16*)(col + i * cstride)) - ((av.x + av.y) + (av.z + av.w));
                asm volatile("" ::: "memory");
            }
            if (isw) {
#pragma unroll
                for (int i = 0; i < 64; ++i) wimg[i * 128 + d] = (bf16)f2bf(X[i]);
            } else {
                bf16* up = proj + (tok0 + (d >> 1)) * 4096 + 2048 + h * 128 + (d & 1) * 64;
#pragma unroll
                for (int i8 = 0; i8 < 8; ++i8) { u32x4 w; w.x = pkbf(X[8 * i8], X[8 * i8 + 1]); w.y = pkbf(X[8 * i8 + 2], X[8 * i8 + 3]); w.z = pkbf(X[8 * i8 + 4], X[8 * i8 + 5]); w.w = pkbf(X[8 * i8 + 6], X[8 * i8 + 7]);
                    *(u32x4*)(up + 8 * i8) = w; }
            }
        } else {
            if (tid3 < 384) {
                const int d = tid3 - 256; const float gl_ = gcs[63];
                bf16* kp = KT + (size_t)item * 8192 + d * 64;
#pragma unroll
                for (int i8 = 0; i8 < 8; ++i8) { float y[8];
#pragma unroll
                    for (int i = 0; i < 8; ++i) y[i] = bf2f(*(const bf16*)(kb + (8 * i8 + i) * 272 + d * 2)) * __expf(gl_ - gcs[8 * i8 + i]);
                    u32x4 w; w.x = pkbf(y[0], y[1]); w.y = pkbf(y[2], y[3]); w.z = pkbf(y[4], y[5]); w.w = pkbf(y[6], y[7]);
                    *(u32x4*)(kp + 8 * i8) = w; }
                if (d == 0) GL[item] = __expf(gl_);
            }
#pragma unroll
            for (int k = 0; k < 4; ++k) {
                const int pc = (tid3 - 256) + 256 * k, i = pc >> 4, c8 = pc & 15;
                const u32x4 v = *(const u32x4*)(qb + i * 272 + c8 * 16); const float eg = __expf(gcs[i]);
                u32x4 w; w.x = pkbf(bf2f(v.x & 0xffffu) * eg, bf2f(v.x >> 16) * eg); w.y = pkbf(bf2f(v.y & 0xffffu) * eg, bf2f(v.y >> 16) * eg);
                w.z = pkbf(bf2f(v.z & 0xffffu) * eg, bf2f(v.z >> 16) * eg); w.w = pkbf(bf2f(v.w & 0xffffu) * eg, bf2f(v.w >> 16) * eg);
                *(u32x4*)(proj + (tok0 + i) * 4096 + h * 128 + c8 * 8) = w;
            }
            if (item + nblk < Bn * 8 * 64) GP_RAWLOAD(item + nblk, tid3 - 256, 256);
        }
        LDS_BAR();
#pragma unroll
        for (int k = 0; k < 2; ++k) { const int pc = tid + 512 * k, i = pc >> 4, c8 = pc & 15;
            *(u32x4*)(proj + (tok0 + i) * 4096 + 1024 + h * 128 + c8 * 8) = *(const u32x4*)(wimg + i * 128 + c8 * 8); }
    }
}

#undef GP_RAWLOAD
__device__ __forceinline__ void phase_gdn_scan2(unsigned char* lds, const bf16* proj, const bf16* KT, const bf16* AT, const float* GL, bf16* o16, int vblk, int nblk, int tid, int wid, int lane) {
    unsigned char* Sl = lds;
    unsigned char* Vl = lds + 8704;
    const int r = lane & 31, hh = lane >> 5;
    for (int item = vblk; item < 256; item += nblk) {
        const int bh = (item & 7) + 8 * (item >> 5), es = (item >> 3) & 3, b = bh >> 3, h = bh & 7;
        __syncthreads();
        for (int i = tid; i < 8704 / 4; i += 512) ((unsigned*)Sl)[i] = 0u;
        f32x16 Sacc;
#pragma unroll
        for (int i = 0; i < 16; ++i) Sacc[i] = 0.f;
        const int rt = wid & 1, dt = wid & 3;
        bf16x8v A8n[8]; bf16x8v A4n[4]; u32x2 uun[4]; float gln = 1.f;
#define GS_LOAD(N) do { const size_t tk_ = (size_t)b * S + 64 * (N); const int it_ = bh * 64 + (N); \
            if (wid < 2) { const bf16* wp_ = proj + (tk_ + 32 * rt + r) * 4096 + 1024 + h * 128 + 8 * hh; \
                _Pragma("unroll") for (int ks = 0; ks < 8; ++ks) A8n[ks] = *(const bf16x8v*)(wp_ + 16 * ks); \
                const int c_ = es * 32 + r; const bf16* up_ = proj + (tk_ + (c_ >> 1)) * 4096 + 2048 + h * 128 + (c_ & 1) * 64 + 32 * rt + 4 * hh; \
                _Pragma("unroll") for (int g = 0; g < 4; ++g) uun[g] = *(const u32x2*)(up_ + 8 * g); } \
            else if (wid < 4) { const bf16* qp_ = proj + (tk_ + 32 * rt + r) * 4096 + h * 128 + 8 * hh; \
                _Pragma("unroll") for (int ks = 0; ks < 8; ++ks) A8n[ks] = *(const bf16x8v*)(qp_ + 16 * ks); \
                const bf16* ap_ = AT + (size_t)it_ * 4096 + (32 * rt + r) * 64 + 8 * hh; \
                _Pragma("unroll") for (int sx = 0; sx < 4; ++sx) A4n[sx] = *(const bf16x8v*)(ap_ + 16 * sx); } \
            else { const bf16* kp_ = KT + (size_t)it_ * 8192 + (32 * dt + r) * 64 + 8 * hh; \
                _Pragma("unroll") for (int sx = 0; sx < 4; ++sx) A4n[sx] = *(const bf16x8v*)(kp_ + 16 * sx); \
                gln = GL[it_]; } } while (0)
        GS_LOAD(0);
        for (int n = 0; n < 64; ++n) {
            const size_t tok0 = (size_t)b * S + 64 * n;
            bf16x8v A8[8]; bf16x8v A4[4]; u32x2 uu[4]; const float gl = gln;
#pragma unroll
            for (int ks = 0; ks < 8; ++ks) A8[ks] = A8n[ks];
#pragma unroll
            for (int sx = 0; sx < 4; ++sx) { A4[sx] = A4n[sx]; uu[sx] = uun[sx]; }
            if (n + 1 < 64) GS_LOAD(n + 1);
            LDS_BAR();
            f32x16 acc;
#pragma unroll
            for (int i = 0; i < 16; ++i) acc[i] = 0.f;
            if (wid < 4) {
#pragma unroll
                for (int ks = 0; ks < 8; ++ks) acc = MFMA32(A8[ks], *(const bf16x8v*)(Sl + r * 272 + ks * 32 + hh * 16), acc);
                if (wid < 2) {
#pragma unroll
                    for (int g = 0; g < 4; ++g) {
                        u32x2 w; w.x = pkbf(bf2f(uu[g].x & 0xffffu) - acc[4 * g], bf2f(uu[g].x >> 16) - acc[4 * g + 1]);
                        w.y = pkbf(bf2f(uu[g].y & 0xffffu) - acc[4 * g + 2], bf2f(uu[g].y >> 16) - acc[4 * g + 3]);
                        *(u32x2*)(Vl + r * 144 + (32 * rt + 8 * g + 4 * hh) * 2) = w;
                    }
                }
            }
            LDS_BAR();
            if (wid >= 2 && wid < 4) {
#pragma unroll
                for (int sx = 0; sx < 4; ++sx) acc = MFMA32(A4[sx], *(const bf16x8v*)(Vl + r * 144 + sx * 32 + hh * 16), acc);
                unsigned char* Ol = lds + 13312 + (wid - 2) * 2560;
#pragma unroll
                for (int i = 0; i < 16; ++i) *(bf16*)(Ol + ((i & 3) + 8 * (i >> 2) + 4 * hh) * 80 + r * 2) = (bf16)f2bf(acc[i]);
                WAVE_SYNC();
#pragma unroll
                for (int k = 0; k < 2; ++k) { const int pc = lane + 64 * k, trow = pc >> 2, c4 = pc & 3;
                    *(u32x4*)(o16 + (tok0 + 32 * rt + trow) * D + h * 128 + es * 32 + c4 * 8) = *(const u32x4*)(Ol + trow * 80 + c4 * 16); }
                WAVE_SYNC();
            } else if (wid >= 4) {
#pragma unroll
                for (int i = 0; i < 16; ++i) Sacc[i] *= gl;
#pragma unroll
                for (int sx = 0; sx < 4; ++sx) Sacc = MFMA32(A4[sx], *(const bf16x8v*)(Vl + r * 144 + sx * 32 + hh * 16), Sacc);
#pragma unroll
                for (int g = 0; g < 4; ++g) { u32x2 w; w.x = pkbf(Sacc[4 * g], Sacc[4 * g + 1]); w.y = pkbf(Sacc[4 * g + 2], Sacc[4 * g + 3]);
                    *(u32x2*)(Sl + r * 272 + (32 * dt + 8 * g + 4 * hh) * 2) = w; }
            }
        }
    }
}

#undef GS_LOAD
__device__ __forceinline__ void phase_gdn_post(const bf16* o16, const bf16* proj, const float* onorm, bf16* hn, int gw, int NGW, int lane) {
    const int l16 = lane & 15;
    float wv[8];
#pragma unroll
    for (int j = 0; j < 8; ++j) wv[j] = onorm[8 * l16 + j];
    for (int m = 2 * gw; m < T; m += 2 * NGW) {
        u32x4 xo[2][2], gg[2][2];
#pragma unroll
        for (int tk = 0; tk < 2; ++tk)
#pragma unroll
            for (int pt = 0; pt < 2; ++pt) { xo[tk][pt] = *(const u32x4*)(o16 + (size_t)(m + tk) * D + pt * 512 + lane * 8); gg[tk][pt] = *(const u32x4*)(proj + (size_t)(m + tk) * 4096 + 3072 + pt * 512 + lane * 8); }
#pragma unroll
        for (int tk = 0; tk < 2; ++tk)
#pragma unroll
            for (int pt = 0; pt < 2; ++pt) {
                const u32x4 xv = xo[tk][pt], gv = gg[tk][pt];
                float v[8] = {bf2f(xv.x & 0xffffu), bf2f(xv.x >> 16), bf2f(xv.y & 0xffffu), bf2f(xv.y >> 16), bf2f(xv.z & 0xffffu), bf2f(xv.z >> 16), bf2f(xv.w & 0xffffu), bf2f(xv.w >> 16)};
                const float g[8] = {bf2f(gv.x & 0xffffu), bf2f(gv.x >> 16), bf2f(gv.y & 0xffffu), bf2f(gv.y >> 16), bf2f(gv.z & 0xffffu), bf2f(gv.z >> 16), bf2f(gv.w & 0xffffu), bf2f(gv.w >> 16)};
                float sq = ((v[0] * v[0] + v[1] * v[1]) + (v[2] * v[2] + v[3] * v[3])) + ((v[4] * v[4] + v[5] * v[5]) + (v[6] * v[6] + v[7] * v[7]));
                sq = row_sum16(sq);
                const float rstd = 1.f / sqrtf(sq * (1.f / 128.f) + EPS);
#pragma unroll
                for (int j = 0; j < 8; ++j) v[j] = v[j] * rstd * wv[j] * siluf_(g[j]);
                u32x4 w; w.x = pkbf(v[0], v[1]); w.y = pkbf(v[2], v[3]); w.z = pkbf(v[4], v[5]); w.w = pkbf(v[6], v[7]);
                *(u32x4*)(hn + (size_t)(m + tk) * D + pt * 512 + lane * 8) = w;
            }
    }
}
__device__ __forceinline__ void phase_sc_post(const bf16* proj, const float* cw, bf16* hn, int gtid, int NT) {
    const int c8 = (gtid & 127) * 8;
    f32x4 w0[3], w1[3];
#pragma unroll
    for (int j = 0; j < 3; ++j) { w0[j] = *(const f32x4*)(cw + j * 1024 + c8); w1[j] = *(const f32x4*)(cw + j * 1024 + c8 + 4); }
    for (int idx = gtid; idx < T * 128; idx += 2 * NT) {
        u32x4 cv[2][3], xv[2][3], bv[2];
#pragma unroll
        for (int q = 0; q < 2; ++q) {
            const int id = idx + q * NT, m = id >> 7, s = m & (S - 1);
#pragma unroll
            for (int j = 0; j < 3; ++j) { cv[q][j] = (u32x4){0u, 0u, 0u, 0u}; xv[q][j] = (u32x4){0u, 0u, 0u, 0u};
                if (id < T * 128 && s - 2 + j >= 0) { const bf16* pr = proj + (size_t)(m - 2 + j) * 3072; cv[q][j] = *(const u32x4*)(pr + 1024 + c8); xv[q][j] = *(const u32x4*)(pr + 2048 + c8); } }
            bv[q] = (u32x4){0u, 0u, 0u, 0u};
            if (id < T * 128) bv[q] = *(const u32x4*)(proj + (size_t)m * 3072 + c8);
        }
#pragma unroll
        for (int q = 0; q < 2; ++q) {
            const int id = idx + q * NT, m = id >> 7;
            if (id >= T * 128) break;
            float y[8];
#pragma unroll
            for (int i = 0; i < 8; ++i) y[i] = 0.f;
#pragma unroll
            for (int j = 0; j < 3; ++j) {
                const u32x4 c = cv[q][j], x = xv[q][j];
                y[0] += w0[j].x * bf2f(c.x & 0xffffu) * bf2f(x.x & 0xffffu); y[1] += w0[j].y * bf2f(c.x >> 16) * bf2f(x.x >> 16);
                y[2] += w0[j].z * bf2f(c.y & 0xffffu) * bf2f(x.y & 0xffffu); y[3] += w0[j].w * bf2f(c.y >> 16) * bf2f(x.y >> 16);
                y[4] += w1[j].x * bf2f(c.z & 0xffffu) * bf2f(x.z & 0xffffu); y[5] += w1[j].y * bf2f(c.z >> 16) * bf2f(x.z >> 16);
                y[6] += w1[j].z * bf2f(c.w & 0xffffu) * bf2f(x.w & 0xffffu); y[7] += w1[j].w * bf2f(c.w >> 16) * bf2f(x.w >> 16);
            }
            const u32x4 b = bv[q];
            u32x4 o;
            o.x = pkbf(y[0] * bf2f(b.x & 0xffffu), y[1] * bf2f(b.x >> 16)); o.y = pkbf(y[2] * bf2f(b.y & 0xffffu), y[3] * bf2f(b.y >> 16));
            o.z = pkbf(y[4] * bf2f(b.z & 0xffffu), y[5] * bf2f(b.z >> 16)); o.w = pkbf(y[6] * bf2f(b.w & 0xffffu), y[7] * bf2f(b.w >> 16));
            *(u32x4*)(hn + (size_t)m * D + c8) = o;
        }
    }
}
__device__ __forceinline__ void phase_nsa_post(unsigned char* lds, const bf16* proj, const float* qnorm, const float* knorm, const f32x2* tab,
                                               bf16* QN, bf16* KS, bf16* KW, bf16* KCH, bf16* VCH, bf16* VST, bf16* VWT, int gw, int NGW, int wid, int lane) {
    {
        bf16* tile = (bf16*)lds + wid * (64 * 72);
        const int c8 = lane & 7, r8 = lane >> 3;
        for (int item = gw; item < 2 * 32 * 64; item += NGW) {
            const int st = item & 63, bh = (item >> 6) & 31, which = item >> 11, b = bh >> 2, hk = bh & 3;
            const bf16* src = proj + ((size_t)b * S + st * 64 + r8) * 2560 + (which ? 2304 : 1792) + hk * 64 + c8 * 8;
            u32x4 v[8];
#pragma unroll
            for (int i = 0; i < 8; ++i) v[i] = *(const u32x4*)(src + (size_t)(8 * i) * 2560);
#pragma unroll
            for (int i = 0; i < 8; ++i) *(u32x4*)(tile + (8 * i + r8) * 72 + c8 * 8) = v[i];
            WAVE_SYNC();
            bf16* dst = (which ? VWT : VST) + (size_t)bh * 64 * S + st * 64 + c8 * 8;
#pragma unroll
            for (int i = 0; i < 8; ++i) {
                const bf16* tp = tile + (8 * c8) * 72 + 8 * i + r8;
                u32x4 w; w.x = (unsigned)tp[0] | ((unsigned)tp[72] << 16); w.y = (unsigned)tp[144] | ((unsigned)tp[216] << 16);
                w.z = (unsigned)tp[288] | ((unsigned)tp[360] << 16); w.w = (unsigned)tp[432] | ((unsigned)tp[504] << 16);
                *(u32x4*)(dst + (size_t)(8 * i + r8) * S) = w;
            }
            WAVE_SYNC();
        }
    }
    const int l8 = lane & 7, hsel = lane >> 3, lo32 = lane < 32;
    float qw8[8], kw8[8];
#pragma unroll
    for (int j = 0; j < 8; ++j) { qw8[j] = qnorm[8 * l8 + j]; kw8[j] = knorm[(lo32 ? 64 : 128) + 8 * l8 + j]; }
#define NP_UNPACK(V, X) do { X[0] = bf2f(V.x & 0xffffu); X[1] = bf2f(V.x >> 16); X[2] = bf2f(V.y & 0xffffu); X[3] = bf2f(V.y >> 16); X[4] = bf2f(V.z & 0xffffu); X[5] = bf2f(V.z >> 16); X[6] = bf2f(V.w & 0xffffu); X[7] = bf2f(V.w >> 16); } while (0)
#define NP_RSTD8(X, R) do { float ss_ = (X[0] * X[0] + X[1] * X[1]) + (X[2] * X[2] + X[3] * X[3]) + (X[4] * X[4] + X[5] * X[5]) + (X[6] * X[6] + X[7] * X[7]); \
        ss_ += xshfl(ss_, 1); ss_ += xshfl(ss_, 2); ss_ += xshfl(ss_, 4); R = 1.f / sqrtf(ss_ * (1.f / 64.f) + EPS); } while (0)
    for (int m0 = gw; m0 < T; m0 += 2 * NGW) {
        u32x4 vq0_[2], vq1_[2], vk_[2], vc_[2]; f32x4 cc_[2][4];
#pragma unroll
        for (int q = 0; q < 2; ++q) {
            const int m = m0 + q * NGW < T ? m0 + q * NGW : m0;
            const bf16* pr = proj + (size_t)m * 2560;
            vq0_[q] = *(const u32x4*)(pr + lane * 8); vq1_[q] = *(const u32x4*)(pr + 512 + lane * 8);
            vk_[q] = *(const u32x4*)(pr + (lo32 ? 1536 + lane * 8 : 2048 + (lane - 32) * 8));
            vc_[q] = *(const u32x4*)(pr + (lo32 ? 1024 + lane * 8 : 1280 + (lane - 32) * 8));
            const f32x4* cp = (const f32x4*)(tab + (size_t)m * 32 + 8 * (l8 & 3));
            cc_[q][0] = cp[0]; cc_[q][1] = cp[1]; cc_[q][2] = cp[2]; cc_[q][3] = cp[3];
        }
#pragma unroll
        for (int q = 0; q < 2; ++q) {
        const int m = m0 + q * NGW;
        if (m >= T) break;
        const int b = m >> 12, s = m & (S - 1);
        const u32x4 vq0 = vq0_[q], vq1 = vq1_[q], vk = vk_[q], vc = vc_[q];
        const f32x4 c0 = cc_[q][0], c1 = cc_[q][1], c2 = cc_[q][2], c3 = cc_[q][3];
        {
            float x[8], r; NP_UNPACK(vq0, x); NP_RSTD8(x, r);
            u32x4 w; w.x = pkbf(x[0] * r * qw8[0], x[1] * r * qw8[1]); w.y = pkbf(x[2] * r * qw8[2], x[3] * r * qw8[3]); w.z = pkbf(x[4] * r * qw8[4], x[5] * r * qw8[5]); w.w = pkbf(x[6] * r * qw8[6], x[7] * r * qw8[7]);
            *(u32x4*)(QN + ((size_t)(b * 16 + hsel) * S + s) * 64 + 8 * l8) = w;
        }
        {
            float x[8], r; NP_UNPACK(vq1, x); NP_RSTD8(x, r);
            u32x4 w; w.x = pkbf(x[0] * r * qw8[0], x[1] * r * qw8[1]); w.y = pkbf(x[2] * r * qw8[2], x[3] * r * qw8[3]); w.z = pkbf(x[4] * r * qw8[4], x[5] * r * qw8[5]); w.w = pkbf(x[6] * r * qw8[6], x[7] * r * qw8[7]);
            *(u32x4*)(QN + ((size_t)(b * 16 + 8 + hsel) * S + s) * 64 + 8 * l8) = w;
        }
        const size_t okv = ((size_t)(b * 4 + (hsel & 3)) * S + s) * 64 + 8 * l8;
        {
            float x[8], r, y[8]; NP_UNPACK(vk, x); NP_RSTD8(x, r);
            const float cs[16] = {c0.x, c0.y, c0.z, c0.w, c1.x, c1.y, c1.z, c1.w, c2.x, c2.y, c2.z, c2.w, c3.x, c3.y, c3.z, c3.w};
#pragma unroll
            for (int j = 0; j < 8; ++j) { const float yv = x[j] * r * kw8[j]; const float yp = xshfl(yv, 4); y[j] = yv * cs[2 * j] + (l8 < 4 ? -yp : yp) * cs[2 * j + 1]; }
            u32x4 w; w.x = pkbf(y[0], y[1]); w.y = pkbf(y[2], y[3]); w.z = pkbf(y[4], y[5]); w.w = pkbf(y[6], y[7]);
            *(u32x4*)((lo32 ? KS : KW) + okv) = w;
        }
        *(u32x4*)((lo32 ? KCH : VCH) + okv) = vc;
    }
    }
#undef NP_UNPACK
#undef NP_RSTD8
}
__device__ __forceinline__ void phase_cmp2(unsigned char* lds, const float* Pk, const float* Pv, const float* biasp, const float* w2, const float* b2, const float* knorm0,
                                           bf16* KC, bf16* VC, int gw, int NGW, int wid, int lane, int tid) {
    float* hs = (float*)lds + wid * 256;
    float* w2l = (float*)(lds + 8192);
    for (int kind = 0; kind < 2; ++kind) {
        __syncthreads();
        for (int idx = tid; idx < 256 * 64 / 4; idx += 512) ((f32x4*)w2l)[idx] = ((const f32x4*)(w2 + (size_t)kind * 256 * 64))[idx];
        __syncthreads();
        const float* P = kind ? Pv : Pk;
        for (int it = gw; it < 32 * 256; it += NGW) {
            const int i = it & 255, bh = it >> 8;
            bf16* outp = kind ? VC + ((size_t)bh * 64 + lane) * 256 + i : KC + ((size_t)bh * 256 + i) * 64 + lane;
            if (i == 255) { *outp = 0; continue; }
            const float* r0 = P + ((size_t)bh * 256 + i) * 512; const float* r1 = r0 + 512 + 256;
#pragma unroll
            for (int j = 0; j < 4; ++j) { const int n = lane + 64 * j; const float x = r0[n] + r1[n] + biasp[kind * 256 + n];
                const float uu = 0.7978845608028654f * (x + 0.044715f * x * x * x);
                const float th = 1.f - 2.f / (1.f + __expf(2.f * uu));
                hs[n] = 0.5f * x * (1.f + th); }
            WAVE_SYNC();
            float a0 = b2[kind * 64 + lane], a1 = 0.f, a2 = 0.f, a3 = 0.f;
#pragma unroll 4
            for (int n = 0; n < 256; n += 4) { const f32x4 hv = *(const f32x4*)(hs + n);
                a0 += hv.x * w2l[n * 64 + lane]; a1 += hv.y * w2l[(n + 1) * 64 + lane]; a2 += hv.z * w2l[(n + 2) * 64 + lane]; a3 += hv.w * w2l[(n + 3) * 64 + lane]; }
            float acc = (a0 + a1) + (a2 + a3);
            if (kind == 0) { const float ss = wave_sum(acc * acc); acc = acc * (1.f / sqrtf(ss * (1.f / 64.f) + EPS)) * knorm0[lane]; }
            *outp = (bf16)f2bf(acc);
            WAVE_SYNC();
        }
    }
}
constexpr int KV_STRIDE = 144;
constexpr int KV_BUF = 2 * 64 * KV_STRIDE;
constexpr int ATT_IMP_OFF = 2 * KV_BUF;
constexpr int ATT_MSK_OFF = ATT_IMP_OFF + 8 * 2048;

template <bool IMP>
__device__ __forceinline__ void attn_tile(const bool FAST, const unsigned char* buf, int tt, int key0, int lo, int hi, const bf16x8v (&qf)[4],
                                          f32x16 (&O)[2], f32x16 (&IM)[2], float& m, float& l, const bf16* ovt, int r, int h, int pr) {
    f32x16 sacc;
#pragma unroll
    for (int i = 0; i < 16; ++i) sacc[i] = 0.f;
    bf16x8v ov[2][2];
    if (IMP) {
#pragma unroll
        for (int st = 0; st < 2; ++st)
#pragma unroll
            for (int sx = 0; sx < 2; ++sx) ov[st][sx] = *(const bf16x8v*)(ovt + (32 * st + r) * 256 + key0 + 16 * sx + 8 * h);
    }
    const unsigned char* kb = buf + (32 * tt + pr) * KV_STRIDE + h * 16;
#pragma unroll
    for (int ks = 0; ks < 4; ++ks) { const bf16x8v a = *(const bf16x8v*)(kb + ks * 32); sacc = MFMA32(a, qf[ks], sacc); }
    const int kb0 = key0 + 8 * h;
    float mx = -1e30f, psum = 0.f, corr;
    if (FAST) {
        const bool on = hi >= 0;
#pragma unroll
        for (int i = 0; i < 16; ++i) mx = fmaxf(mx, sacc[i]);
        mx = on ? mx * 0.18033688011112042f : -1e30f;
        mx = fmaxf(mx, xshfl(mx, 32));
        const float mnew = fmaxf(m, mx);
        corr = __builtin_amdgcn_exp2f(m - mnew);
        m = mnew;
#pragma unroll
        for (int i = 0; i < 16; ++i) { const float p = __builtin_amdgcn_exp2f(sacc[i] * 0.18033688011112042f - mnew); psum += p; sacc[i] = p; }
        if (!on) {
            psum = 0.f;
#pragma unroll
            for (int i = 0; i < 16; ++i) sacc[i] = 0.f;
        }
    } else {
#pragma unroll
        for (int i = 0; i < 16; ++i) { const int key = kb0 + 16 * (i >> 3) + (i & 7); const bool ok = (key >= lo) && (key <= hi);
            const float sv = ok ? sacc[i] * 0.18033688011112042f : -1e30f; sacc[i] = sv; mx = fmaxf(mx, sv); }
        mx = fmaxf(mx, xshfl(mx, 32));
        const float mnew = fmaxf(m, mx);
        corr = __builtin_amdgcn_exp2f(m - mnew);
        m = mnew;
#pragma unroll
        for (int i = 0; i < 16; ++i) { const float p = sacc[i] > -1e29f ? __builtin_amdgcn_exp2f(sacc[i] - mnew) : 0.f; psum += p; sacc[i] = p; }
    }
    l = l * corr + psum;
    if (__any(corr != 1.f)) {
#pragma unroll
        for (int i = 0; i < 16; ++i) { O[0][i] *= corr; O[1][i] *= corr; }
        if (IMP) {
#pragma unroll
            for (int i = 0; i < 16; ++i) { IM[0][i] *= corr; IM[1][i] *= corr; }
        }
    }
    bf16x8v pf[2];
#pragma unroll
    for (int sx = 0; sx < 2; ++sx) { u32x4 w; w.x = pkbf(sacc[8 * sx], sacc[8 * sx + 1]); w.y = pkbf(sacc[8 * sx + 2], sacc[8 * sx + 3]); w.z = pkbf(sacc[8 * sx + 4], sacc[8 * sx + 5]); w.w = pkbf(sacc[8 * sx + 6], sacc[8 * sx + 7]);
        pf[sx] = __builtin_bit_cast(bf16x8v, w); }
    const unsigned char* vb = buf + 64 * KV_STRIDE + r * KV_STRIDE + (32 * tt + 8 * h) * 2;
#pragma unroll
    for (int dt = 0; dt < 2; ++dt)
#pragma unroll
        for (int sx = 0; sx < 2; ++sx) { const bf16x8v a = *(const bf16x8v*)(vb + dt * 32 * KV_STRIDE + sx * 32); O[dt] = MFMA32(a, pf[sx], O[dt]); }
    if (IMP) {
#pragma unroll
        for (int st = 0; st < 2; ++st)
#pragma unroll
            for (int sx = 0; sx < 2; ++sx) IM[st] = MFMA32(ov[st][sx], pf[sx], IM[st]);
    }
}

template <int MODE>
__device__ __forceinline__ void attn_branch(unsigned char* kvbuf, const bf16* Kg0, const bf16* VTg0, int vts, unsigned long long blkmask, int t, int nv, unsigned long long selm,
                                            int wlo, int whi, int flo, int fhi, const bf16x8v (&qf)[4], f32x16 (&O)[2], f32x16 (&IM)[2], float& l, const bf16* ovt, int tid, int r, int h, int pr) {
    float m = -1e30f;
    l = 0.f;
#pragma unroll
    for (int i = 0; i < 16; ++i) { O[0][i] = 0.f; O[1][i] = 0.f; IM[0][i] = 0.f; IM[1][i] = 0.f; }
    const int srow = tid >> 3, sch = tid & 7;
    int j = __builtin_ctzll(blkmask);
    unsigned long long rest = blkmask & (blkmask - 1);
    u32x4 kr = *(const u32x4*)(Kg0 + (size_t)(64 * j + srow) * 64 + sch * 8);
    u32x4 vr = *(const u32x4*)(VTg0 + (size_t)srow * vts + 64 * j + sch * 8);
    *(u32x4*)(kvbuf + srow * KV_STRIDE + sch * 16) = kr;
    *(u32x4*)(kvbuf + 64 * KV_STRIDE + srow * KV_STRIDE + sch * 16) = vr;
    int cur = 0;
    for (;;) {
        LDS_BAR();
        const bool more = rest != 0ull;
        int jn = 0;
        if (more) { jn = __builtin_ctzll(rest); rest &= rest - 1;
            kr = *(const u32x4*)(Kg0 + (size_t)(64 * jn + srow) * 64 + sch * 8);
            vr = *(const u32x4*)(VTg0 + (size_t)srow * vts + 64 * jn + sch * 8); }
        const unsigned char* buf = kvbuf + cur * KV_BUF;
        int lo, hi;
        if (MODE == 0) { lo = 0; hi = nv - 1; }
        else if (MODE == 1) { lo = 0; hi = ((selm >> j) & 1ull) ? t : -1; }
        else { lo = t - 511; hi = t; }
        const bool wave_on = (MODE != 1) || __any(hi >= 0);
#pragma unroll
        for (int tt = 0; tt < 2; ++tt) {
            const int key0 = 64 * j + 32 * tt;
            if (!wave_on || key0 > whi || key0 + 31 < wlo) continue;
            attn_tile<MODE == 0>(key0 >= flo && key0 + 31 <= fhi, buf, tt, key0, lo, hi, qf, O, IM, m, l, ovt, r, h, pr);
        }
        if (!more) break;
        *(u32x4*)(kvbuf + (cur ^ 1) * KV_BUF + srow * KV_STRIDE + sch * 16) = kr;
        *(u32x4*)(kvbuf + (cur ^ 1) * KV_BUF + 64 * KV_STRIDE + srow * KV_STRIDE + sch * 16) = vr;
        cur ^= 1; j = jn;
    }
    LDS_BAR();
}

__device__ __forceinline__ void phase_nsa_attn(unsigned char* lds, const bf16* QN, const bf16* KS, const bf16* KW, const bf16* VST, const bf16* VWT, const bf16* KCb, const bf16* VCT,
                                               const bf16* ovt, const float* gates, const f32x2* tab, bf16* hn, int vblk, int nblk, int tid, int wid, int lane) {
    const int r = lane & 31, h = lane >> 5, pr = (r & ~12) | ((r & 4) << 1) | ((r & 8) >> 1);
    float* imp_s = (float*)(lds + ATT_IMP_OFF + wid * 2048);
    unsigned long long* msk_s = (unsigned long long*)(lds + ATT_MSK_OFF);
    unsigned* uni_s = (unsigned*)(lds + ATT_MSK_OFF + 512);
    for (int item = vblk; item < Bn * 4 * 64; item += nblk) {
        const int rnd = item / nblk, wv = item - rnd * nblk;
        const int bh = wv & 31, sub = wv >> 5, per = nblk >> 5;
        int qb = rnd * per + ((rnd & 1) ? (per - 1 - sub) : sub);
        if (nblk != 256) { qb = item >> 5; }
        const int bhh = (nblk != 256) ? (item & 31) : bh;
        const int b = bhh >> 2, hk = bhh & 3;
        const int t0 = qb * 64, tw0 = t0 + 8 * wid, t = tw0 + (r & 7), g = r >> 3;
        const size_t tok = (size_t)b * S + t;
        if (tid == 0) { unsigned z = 0u; asm volatile("" : "+v"(z)); uni_s[0] = z; uni_s[1] = z; }
        bf16x8v qn[4], qr[4];
        {
            const bf16* qp = QN + ((size_t)(b * 16 + hk * 4 + g) * S + t) * 64 + 8 * h;
#pragma unroll
            for (int ks = 0; ks < 4; ++ks) qn[ks] = *(const bf16x8v*)(qp + 16 * ks);
            const f32x2* cp = tab + tok * 32 + 8 * h;
#pragma unroll
            for (int kl = 0; kl < 2; ++kl) {
                u32x4 wlo_, whi_;
                const u32x4 a = __builtin_bit_cast(u32x4, qn[kl]), c = __builtin_bit_cast(u32x4, qn[kl + 2]);
#pragma unroll
                for (int jj = 0; jj < 4; ++jj) {
                    const f32x2 cs0 = cp[16 * kl + 2 * jj], cs1 = cp[16 * kl + 2 * jj + 1];
                    const float x0 = bf2f(a[jj] & 0xffffu), x1 = bf2f(a[jj] >> 16), y0 = bf2f(c[jj] & 0xffffu), y1 = bf2f(c[jj] >> 16);
                    wlo_[jj] = pkbf(x0 * cs0.x - y0 * cs0.y, x1 * cs1.x - y1 * cs1.y);
                    whi_[jj] = pkbf(y0 * cs0.x + x0 * cs0.y, y1 * cs1.x + x1 * cs1.y);
                }
                qr[kl] = __builtin_bit_cast(bf16x8v, wlo_); qr[kl + 2] = __builtin_bit_cast(bf16x8v, whi_);
            }
        }
        const float* gp = gates + tok * 48 + (hk * 4 + g) * 3;
        const float g0 = sigmoidf_(gp[0]), g1 = sigmoidf_(gp[1]), g2 = sigmoidf_(gp[2]);
        f32x16 acc[2], O[2], IM[2];
        float l;
        const int nv = t >= 31 ? ((t - 31) >> 4) + 1 : 0;
        const int nvw = ((tw0 + 7 - 31) >> 4) + 1;
        const int nvmax = 4 * qb + 3;
        {
            const int ncb = (nvmax + 63) >> 6;
            const unsigned long long bm = ncb >= 64 ? ~0ull : ((1ull << ncb) - 1ull);
            attn_branch<0>(lds, KCb + (size_t)bhh * 256 * 64, VCT + (size_t)bhh * 64 * 256, 256, bm, t, nv, 0ull, 0, (tw0 + 7 >= 31 ? nvw - 1 : -1), 0, (tw0 >= 31 ? ((tw0 - 31) >> 4) : -1), qn, O, IM, l, ovt, tid, r, h, pr);
        }
        {
            const float lt = l + xshfl(l, 32), inv = lt > 0.f ? 1.f / lt : 0.f, sc = inv * g0;
#pragma unroll
            for (int i = 0; i < 16; ++i) { acc[0][i] = O[0][i] * sc; acc[1][i] = O[1][i] * sc; }
#pragma unroll
            for (int st = 0; st < 2; ++st)
#pragma unroll
                for (int i = 0; i < 16; ++i) { float v = IM[st][i] * inv; v += xshfl(v, 8); v += xshfl(v, 16);
                    if (r < 8) imp_s[r * 64 + 32 * st + (i & 3) + 8 * (i >> 2) + 4 * h] = v; }
        }
        WAVE_SYNC();
        {
            unsigned long long um = 0ull;
            for (int tk = 0; tk < 8; ++tk) {
                const float imp = imp_s[tk * 64 + lane];
                const bool sv = lane <= qb, forced = (lane == 0) || (lane == qb) || (lane + 1 == qb);
                const float score = sv ? (forced ? 1e9f : imp) : -1.f;
                int rank = 0;
#pragma unroll 4
                for (int i = 0; i < 64; ++i) { const float si = __uint_as_float(__builtin_amdgcn_readlane(__float_as_uint(score), i)); rank += (si > score || (si == score && i < lane)) ? 1 : 0; }
                const unsigned long long mk = __ballot((rank < 16) && (score >= 0.f));
                um |= mk;
                if (lane == 0) msk_s[wid * 8 + tk] = mk;
            }
            if (lane == 0) { atomicOr(&uni_s[0], (unsigned)um); atomicOr(&uni_s[1], (unsigned)(um >> 32)); }
        }
        __syncthreads();
        const unsigned long long selm = msk_s[wid * 8 + (r & 7)];
        const unsigned long long uni = (unsigned long long)uni_s[0] | ((unsigned long long)uni_s[1] << 32);
        attn_branch<1>(lds, KS + (size_t)bhh * S * 64, VST + (size_t)bhh * 64 * S, S, uni, t, 0, selm, 0, tw0 + 7, 0, tw0, qr, O, IM, l, ovt, tid, r, h, pr);
        {
            const float lt = l + xshfl(l, 32), sc = g1 / lt;
#pragma unroll
            for (int i = 0; i < 16; ++i) { acc[0][i] += O[0][i] * sc; acc[1][i] += O[1][i] * sc; }
        }
        {
            const int jlo = qb >= 8 ? qb - 8 : 0;
            const unsigned long long bm = (qb >= 63 ? ~0ull : ((1ull << (qb + 1)) - 1ull)) & ~((1ull << jlo) - 1ull);
            attn_branch<2>(lds, KW + (size_t)bhh * S * 64, VWT + (size_t)bhh * 64 * S, S, bm, t, 0, 0ull, tw0 - 511, tw0 + 7, tw0 + 7 - 511, tw0, qr, O, IM, l, ovt, tid, r, h, pr);
        }
        {
            const float lt = l + xshfl(l, 32), sc = g2 / lt;
            bf16* op = hn + tok * D + (hk * 4 + g) * 64 + 4 * h;
#pragma unroll
            for (int dt = 0; dt < 2; ++dt)
#pragma unroll
                for (int q4 = 0; q4 < 4; ++q4) {
                    u32x2 w; w.x = pkbf(acc[dt][4 * q4] + O[dt][4 * q4] * sc, acc[dt][4 * q4 + 1] + O[dt][4 * q4 + 1] * sc);
                    w.y = pkbf(acc[dt][4 * q4 + 2] + O[dt][4 * q4 + 2] * sc, acc[dt][4 * q4 + 3] + O[dt][4 * q4 + 3] * sc);
                    *(u32x2*)(op + 32 * dt + 8 * q4) = w;
                }
        }
    }
}


#define LAS __attribute__((address_space(3)))
#define XB_TMO      128
#define XB_XCNT(j)  (256  + 64 * (j))
#define XB_XSUB(j)  (1280 + 64 * (j))
#define XB_XGEN(j)  (2304 + 64 * (j))
#define XB_TOP      3328
#define XB_TOPGEN   3392
#define XCD_BAR_WORDS 3456
#define XB_SPIN_CAP (1u << 18)

__device__ __forceinline__ unsigned xb_ld(unsigned* p)              { return __hip_atomic_load(p, __ATOMIC_RELAXED, __HIP_MEMORY_SCOPE_AGENT); }
__device__ __forceinline__ unsigned xb_add(unsigned* p, unsigned v) { return __hip_atomic_fetch_add(p, v, __ATOMIC_RELAXED, __HIP_MEMORY_SCOPE_AGENT); }
__device__ __forceinline__ unsigned xb_xcc_id() { return (unsigned)__builtin_amdgcn_s_getreg((3 << 11) | 20) & 0xFu; }
#define XB_SPIN(cond, bar) do { unsigned _sp = 0; while (cond) { __builtin_amdgcn_s_sleep(1); \
    if ((++_sp & 255u) == 0u) { if (xb_ld(&(bar)[XB_TMO])) break; if (_sp > XB_SPIN_CAP) { atomicAdd(&(bar)[XB_TMO], 1u); break; } } } } while (0)

struct XcdBarrier {
    unsigned* bar; unsigned x;
    volatile LAS unsigned* st;
};

__device__ __forceinline__ XcdBarrier xcd_barrier_post(unsigned* bar, volatile LAS unsigned* st) {
    XcdBarrier b; b.bar = bar; b.x = xb_xcc_id(); b.st = st;
    if (threadIdx.x == 0) (void)xb_add(&bar[XB_XCNT(b.x)], 1u);
    return b;
}
__device__ __forceinline__ void xcd_barrier_complete(unsigned* bar, unsigned x, unsigned& nloc, unsigned& nx) {
    const unsigned G = gridDim.x * gridDim.y * gridDim.z;
    unsigned sum, cnt, mine, sp = 0u;
    for (;;) {
        sum = 0u; cnt = 0u; mine = 0u;
#pragma unroll
        for (unsigned j = 0; j < 16; ++j) { const unsigned c = xb_ld(&bar[XB_XCNT(j)]); sum += c; cnt += (c > 0u) ? 1u : 0u; mine = (j == x) ? c : mine; }
        if (sum == G) break;
        __builtin_amdgcn_s_sleep(1);
        if ((++sp & 255u) == 0u) { if (xb_ld(&bar[XB_TMO])) break; if (sp > XB_SPIN_CAP) { atomicAdd(&bar[XB_TMO], 1u); break; } }
    }
    nloc = mine > 0u ? mine : 1u; nx = cnt > 0u ? cnt : 1u;
}

__device__ __forceinline__ void xcd_barrier(const XcdBarrier& b) {
    asm volatile("s_waitcnt vmcnt(0)" ::: "memory");
    __syncthreads();
    if (threadIdx.x == 0) {
        unsigned* bar = b.bar;
        __builtin_amdgcn_s_waitcnt(0);
        unsigned nloc = b.st[0], nx = b.st[1];
        if (nloc == 0u) { xcd_barrier_complete(bar, b.x, nloc, nx); b.st[0] = nloc; b.st[1] = nx; }
        const unsigned old = xb_add(&bar[XB_XSUB(b.x)], 1u);
        const unsigned gen = old / nloc;
        if (old + 1u == (gen + 1u) * nloc) {
            __builtin_amdgcn_fence(__ATOMIC_RELEASE, "agent");
            asm volatile("s_waitcnt vmcnt(0)" ::: "memory");
            const unsigned og = xb_add(&bar[XB_TOP], 1u);
            const unsigned tg = og / nx;
            if (og + 1u == (tg + 1u) * nx) xb_add(&bar[XB_TOPGEN], 1u);
            else XB_SPIN(xb_ld(&bar[XB_TOPGEN]) == tg, bar);
            __builtin_amdgcn_fence(__ATOMIC_ACQUIRE, "agent");
            xb_add(&bar[XB_XGEN(b.x)], 1u);
            asm volatile("s_waitcnt vmcnt(0)" ::: "memory");
        } else {
            XB_SPIN(xb_ld(&bar[XB_XGEN(b.x)]) == gen, bar);
            __builtin_amdgcn_fence(__ATOMIC_ACQUIRE, "agent");
            asm volatile("s_waitcnt vmcnt(0)" ::: "memory");
        }
    }
    __syncthreads();
}

struct Args { const void* in[24]; float* out; unsigned char* ws; int lo, hi; };

__host__ __device__ constexpr int mixer_inner_phases(int kind) { return kind == 0 ? 4 : (kind == 1 ? 1 : 4); }
__host__ __device__ constexpr int total_phases() { int n = 1; for (int L = 0; L < DEPTH; ++L) n += 4 + 2 + mixer_inner_phases(L % 3); return n; }

__global__ void __launch_bounds__(512, 2) mega(Args args) {
    extern __shared__ __attribute__((aligned(16))) unsigned char lds[];
    cg::grid_group grid = cg::this_grid();
    volatile LAS unsigned* bst = (volatile LAS unsigned*)((LAS unsigned char*)lds + (LDS_BYTES - 64));
    if (threadIdx.x < 2) bst[threadIdx.x] = 0u;
    __syncthreads();
    const XcdBarrier xbar = xcd_barrier_post((unsigned*)args.ws, bst);
    bool again = false;
    for (int ph = args.lo; ph < args.hi; ++ph) {
        int type = 0, s = 0, L = 0;
        if (ph > 0) {
            int p = ph - 1;
            for (L = 0; L < DEPTH; ++L) { const int n = 6 + mixer_inner_phases(L % 3); if (p < n) break; p -= n; }
            const int inner = mixer_inner_phases(L % 3), kind = L % 3;
            if (p < 2) { type = 2 + p; s = 2 * L; }
            else if (p == 2) type = 5;
            else if (p < 3 + inner) { const int q = p - 3; type = kind == 0 ? (q == 0 ? 14 : (q == 1 ? 15 : 4 + q)) : (kind == 1 ? 8 : 9 + q); }
            else if (p == 3 + inner) type = 13;
            else { type = 2 + (p - 4 - inner); s = 2 * L + 1; }
        }
        int tid_ = threadIdx.x; asm volatile("" : "+v"(tid_));
        int G_ = gridDim.x, bx_ = blockIdx.x; asm volatile("" : "+s"(G_), "+s"(bx_));
        const int tid = tid_, lane = tid & 63, wid = __builtin_amdgcn_readfirstlane(tid >> 6);
        const int G = G_, bx = bx_;
        const int vcu = (G % 8 == 0) ? (bx % 8) * (G / 8) + bx / 8 : bx;
        const int gw = vcu * 8 + wid, NGW = G * 8;
        unsigned char* ws = args.ws; asm volatile("" : "+s"(ws));
        PG8_LAS unsigned char* ldsl = (PG8_LAS unsigned char*)lds;
        float* hout = args.out; asm volatile("" : "+s"(hout));
        bf16* HN = (bf16*)(ws + WS_HN);
        bf16* RB = (bf16*)(ws + WS_R);
        f32x2* tab = (f32x2*)(ws + WS_TAB);
        const int kind = L % 3, jj = L / 3;
        bf16* QN = RB + (size_t)T * 2560;
        bf16* KSb = QN + (size_t)T * 1024;
        bf16* KWb = KSb + (size_t)T * 256;
        bf16* KCH = (bf16*)(ws + WS_O32);
        bf16* VCH = KCH + (size_t)T * 256;
        float* Pk = (float*)(ws + WS_O32 + 32 * MiB);
        float* Pv = Pk + (size_t)8192 * 512;
        bf16* KC = (bf16*)(ws + WS_O32 + 64 * MiB);
        bf16* VC = (bf16*)(ws + WS_O32 + 65 * MiB);
        bf16* OVT = (bf16*)(ws + WS_BP + 65536);
        bf16* VST = (bf16*)(ws + WS_O32 + 68 * MiB);
        bf16* VWT = (bf16*)(ws + WS_O32 + 84 * MiB);
        switch (type) {
        case 0: {
            float* scr = (float*)lds + wid * (64 * 33);
            for (int mi = 0; mi < 28; ++mi) {
                const float* W; const float* nw = nullptr; int K, N, Npad, mode = 0; bf16* WT;
                if (mi < 8)       { nw = (const float*)args.in[2] + (size_t)mi * D; W = (const float*)args.in[3] + (size_t)mi * D * 2 * FF; K = D; N = 2 * FF; Npad = N; mode = 1; WT = (bf16*)(ws + WS_WGU) + (size_t)mi * 2 * FF * D; }
                else if (mi < 16) { const int i = mi - 8; W = (const float*)args.in[4] + (size_t)i * FF * D; K = FF; N = D; Npad = N; WT = (bf16*)(ws + WS_WDN) + (size_t)i * D * FF; }
                else if (mi < 18) { const int i = mi - 16; nw = (const float*)args.in[5] + (size_t)(3 * i) * D; W = (const float*)args.in[6] + (size_t)i * D * 4112; K = D; N = 4112; Npad = GDN_NPAD; WT = (bf16*)(ws + WS_WGI) + (size_t)i * GDN_NPAD * D; }
                else if (mi < 20) { const int i = mi - 18; W = (const float*)args.in[11] + (size_t)i * D * D; K = D; N = D; Npad = N; WT = (bf16*)(ws + WS_WGO) + (size_t)i * D * D; }
                else if (mi == 20) { nw = (const float*)args.in[5] + (size_t)1 * D; W = (const float*)args.in[12]; K = D; N = 3072; Npad = N; WT = (bf16*)(ws + WS_WSI); }
                else if (mi == 21) { W = (const float*)args.in[14]; K = D; N = D; Npad = N; WT = (bf16*)(ws + WS_WSO); }
                else if (mi == 22) { nw = (const float*)args.in[5] + (size_t)2 * D; W = (const float*)args.in[15]; K = D; N = 2608; Npad = NSA_NPAD; WT = (bf16*)(ws + WS_WNI); }
                else if (mi == 23) { W = (const float*)args.in[23]; K = D; N = D; Npad = N; WT = (bf16*)(ws + WS_WNO); }
                else { const int i = mi - 24, kd = i >> 1, hf = i & 1;
                    W = (const float*)args.in[19] + (size_t)kd * 2048 * 256 + (size_t)hf * 1024 * 256; K = 1024; N = 256; Npad = 256; WT = (bf16*)(ws + WS_WC1) + (size_t)kd * 512 * 1024 + (size_t)hf * 256 * 1024; }
                xpose_matrix(W, nw, K, N, Npad, WT, mode, scr, gw, NGW, lane);
            }
            {
                float* ss = (float*)(ws + WS_SS);
                const float* xin = (const float*)args.in[0];
                for (int m = gw; m < T; m += NGW) {
                    const f32x4* xr = (const f32x4*)(xin + (size_t)m * D) + lane; u32x2* o8 = (u32x2*)(HN + (size_t)m * D) + lane; float sq = 0.f;
#pragma unroll
                    for (int j = 0; j < 4; ++j) { const f32x4 v = xr[64 * j]; sq += (v.x * v.x + v.y * v.y) + (v.z * v.z + v.w * v.w); u32x2 o; o.x = pkbf(v.x, v.y); o.y = pkbf(v.z, v.w); o8[64 * j] = o; }
                    sq = wave_sum(sq); if (lane < 16) ss[(size_t)m * 16 + lane] = lane == 0 ? sq : 0.f;
                }
            }
            const int* positions = (const int*)args.in[1];
            for (int idx = bx * 512 + tid; idx < T * 32; idx += G * 512) {
                const int tk = idx >> 5, i = idx & 31;
                const float inv = 1.0f / exp2f((float)(2 * i) * (13.287712379549449f / 64.f));
                const float ang = (float)positions[tk] * inv;
                const double rev = (double)ang * 0.15915494309189535;
                const float fr = (float)(rev - rint(rev));
                f32x2 v; v.x = __builtin_amdgcn_cosf(fr); v.y = __builtin_amdgcn_sinf(fr);
                tab[idx] = v;
            }
            for (int idx = bx * 512 + tid; idx < 64 * 256; idx += G * 512) {
                const int sj = idx >> 8, i = idx & 255, q = i >> 2, rem = i & 3;
                OVT[idx] = (bf16)(rem < 3 ? (q == sj ? 0x3F80 : 0) : ((q == sj || q + 1 == sj) ? 0x3F00 : 0));
            }
            if (bx < 2 && tid < 256) {
                const float* pe = (const float*)args.in[18] + (size_t)bx * 2048;
                const float* w1 = (const float*)args.in[19] + (size_t)bx * 2048 * 256 + tid;
                float acc = ((const float*)args.in[20])[bx * 256 + tid];
                for (int k = 0; k < 2048; ++k) acc += pe[k] * w1[(size_t)k * 256];
                ((float*)(ws + WS_BP))[bx * 256 + tid] = acc;
            }
        } break;
        case 2: {
            const bf16* Ah = (s & 1) ? (const bf16*)(ws + WS_R + 192 * MiB) : HN;
            pg8::Gemm g{Ah, (const bf16*)(ws + WS_WGU) + (size_t)s * 2 * FF * D, T, 2 * FF, D}; pg8::StaticOrder SO; SO.init(T, 2 * FF, G, bx);
            float* rtab = (float*)(lds + 131072);
            rstd_table(rtab, (const float*)(ws + WS_SS) + (size_t)s * T * 16, SO, tid);
            pg8::EpiSwiGLU E{RB, rtab};
            pg8::gemm_phase<pg8::EpiSwiGLU, pg8::StaticOrder, true, true>(ldsl, g, SO, E, tid); } break;
        case 3: {
            pg8::Gemm g{RB, (const bf16*)(ws + WS_WDN) + (size_t)s * D * FF, T, D, FF}; pg8::StaticOrder SO; SO.init(T, D, G, bx);
            const int slot = (s & 1) ? (s < 7 ? s + 1 : 12) : 8 + (s >> 1);
            pg8::EpiResid<1> E{s == 0 ? (const float*)args.in[0] : hout, hout, HN, (float*)(ws + WS_SS) + (size_t)slot * T * 16};
            pg8::gemm_phase<pg8::EpiResid<1>, pg8::StaticOrder, true, true>(ldsl, g, SO, E, tid); } break;
        case 5: {
            const bf16* Wt; int Np, ldc, nmain, ldt, nvalid; float* tail;
            if (kind == 0) { Wt = (const bf16*)(ws + WS_WGI) + (size_t)jj * GDN_NPAD * D; Np = GDN_NPAD; ldc = 4096; nmain = 4096; tail = (float*)(ws + WS_AB); ldt = 16; nvalid = 4112; }
            else if (kind == 1) { Wt = (const bf16*)(ws + WS_WSI); Np = 3072; ldc = 3072; nmain = 3072; tail = (float*)(ws + WS_AB); ldt = 16; nvalid = 3072; }
            else { Wt = (const bf16*)(ws + WS_WNI); Np = NSA_NPAD; ldc = 2560; nmain = 2560; tail = (float*)(ws + WS_GT); ldt = 48; nvalid = 2608; }
            pg8::Gemm g{HN, Wt, T, Np, D}; pg8::StaticOrder SO; SO.init(T, Np, G, bx);
            float* rtab = (float*)(lds + 131072);
            rstd_table(rtab, (const float*)(ws + WS_SS) + (size_t)(8 + L) * T * 16, SO, tid);
            pg8::EpiProj E{RB, ldc, nmain, tail, ldt, nvalid, rtab};
            pg8::gemm_phase<pg8::EpiProj, pg8::StaticOrder, true, true>(ldsl, g, SO, E, tid); } break;
        case 14: phase_gdn_halo(RB, (bf16*)(ws + WS_HALO), vcu * 512 + tid, G * 512); break;
        case 15: phase_gdn_prep(lds, RB, (const bf16*)(ws + WS_HALO), (const float*)(ws + WS_AB), (const float*)args.in[7] + (size_t)jj * 4 * 3072, (const float*)args.in[8] + jj * 8, (const float*)args.in[9] + jj * 8,
                                HN, (bf16*)(ws + WS_O32 + 64 * MiB), (float*)(ws + WS_GL), bx, G, tid, wid, lane); break;
        case 6:
#ifndef DIS_SCAN
            phase_gdn_scan2(lds, RB, HN, (const bf16*)(ws + WS_O32 + 64 * MiB), (const float*)(ws + WS_GL), (bf16*)(ws + WS_O32), bx, G, tid, wid, lane);
#endif
            break;
        case 7:
#ifndef DIS_GPOST
            phase_gdn_post((const bf16*)(ws + WS_O32), RB, (const float*)args.in[10] + jj * 128, HN, gw, NGW, lane);
#endif
            break;
        case 8:
#ifndef DIS_SPOST
            phase_sc_post(RB, (const float*)args.in[13], HN, vcu * 512 + tid, G * 512);
#endif
            break;
        case 9:
#ifndef DIS_NPOST
            phase_nsa_post(lds, RB, (const float*)args.in[16], (const float*)args.in[17], tab, QN, KSb, KWb, KCH, VCH, VST, VWT, gw, NGW, wid, lane);
#endif
            break;
        case 10: {
            pg8::Gemm g{KCH, (const bf16*)(ws + WS_WC1), 8192, 512, 1024}; pg8::StaticOrder SO; SO.init(8192, 512, G, bx);
            pg8::Gemm g2{VCH, (const bf16*)(ws + WS_WC1) + (size_t)512 * 1024, 8192, 512, 1024};
            pg8::EpiF32 E{Pk, 512};
            if (bx >= G / 2) { g = g2; SO.init(8192, 512, G, bx - G / 2); E.C = Pv; }
            pg8::gemm_phase<pg8::EpiF32, pg8::StaticOrder, true, true>(ldsl, g, SO, E, tid); } break;
        case 11:
#ifndef DIS_CMP2
            phase_cmp2(lds, Pk, Pv, (const float*)(ws + WS_BP), (const float*)args.in[21], (const float*)args.in[22], (const float*)args.in[17], KC, VC, gw, NGW, wid, lane, tid);
#endif
            break;
        case 12:
#ifndef DIS_ATTN
            phase_nsa_attn(lds, QN, KSb, KWb, VST, VWT, KC, VC, OVT, (const float*)(ws + WS_GT), tab, HN, bx, G, tid, wid, lane);
#endif
            break;
        default: {
            const bf16* Wout = kind == 0 ? (const bf16*)(ws + WS_WGO) + (size_t)jj * D * D : (kind == 1 ? (const bf16*)(ws + WS_WSO) : (const bf16*)(ws + WS_WNO));
            pg8::Gemm g{HN, Wout, T, D, D}; pg8::StaticOrder SO; SO.init(T, D, G, bx);
            pg8::EpiResid<2> E{hout, hout, (bf16*)(ws + WS_R + 192 * MiB), (float*)(ws + WS_SS) + (size_t)(2 * L + 1) * T * 16};
            pg8::gemm_phase<pg8::EpiResid<2>, pg8::StaticOrder, true, true>(ldsl, g, SO, E, tid); } break;
        }
#ifdef REP_TYPE
        if (type == REP_TYPE && !again) { again = true; xcd_barrier(xbar); --ph; continue; }
        again = false;
#endif
        if (ph + 1 < args.hi) { if (ph == 0) grid.sync(); else xcd_barrier(xbar); }
    }
}

extern "C" void kernel_launch(void* const* d_in, const int* in_sizes, int n_in, void* d_out, int out_size, void* d_ws, size_t ws_size, hipStream_t stream) {
    static int grid = 0;
    if (grid == 0) {
        if (n_in != 24 || out_size != T * D || ws_size < WS_END2) { fprintf(stderr, "kernel_launch: unexpected shapes n_in %d out %d ws %zu (need %zu)\n", n_in, out_size, ws_size, (size_t)WS_END2); grid = -1; return; }
        int dev = 0, cus = 0, per_cu = 0;
        hipGetDevice(&dev); hipDeviceGetAttribute(&cus, hipDeviceAttributeMultiprocessorCount, dev);
        if (hipFuncSetAttribute((const void*)mega, hipFuncAttributeMaxDynamicSharedMemorySize, LDS_BYTES) != hipSuccess) { fprintf(stderr, "kernel_launch: hipFuncSetAttribute failed\n"); grid = -1; return; }
        if (hipOccupancyMaxActiveBlocksPerMultiprocessor(&per_cu, (const void*)mega, 512, LDS_BYTES) != hipSuccess || per_cu < 1) { fprintf(stderr, "kernel_launch: occupancy query says %d\n", per_cu); per_cu = 1; }
        (void)hipGetLastError();
        grid = cus;
    }
    if (grid < 0) return;
    Args a{};
    for (int i = 0; i < 24; ++i) a.in[i] = d_in[i];
    a.out = (float*)d_out; a.ws = (unsigned char*)d_ws;
    constexpr int NPH = total_phases();
#if MK_MULTI
    for (int p = 0; p < NPH; ++p) { a.lo = p; a.hi = p + 1; hipLaunchKernelGGL(mega, dim3(grid), dim3(512), LDS_BYTES, stream, a); }
#else
    a.lo = 0; a.hi = NPH;
    (void)hipMemsetAsync(d_ws, 0, 16384, stream);
    void* kargs[] = {&a};
    hipError_t e = hipLaunchCooperativeKernel((const void*)mega, dim3(grid), dim3(512), kargs, LDS_BYTES, stream);
    if (e != hipSuccess) fprintf(stderr, "cooperative launch failed: %s (grid %d)\n", hipGetErrorString(e), grid);
#endif
}
```

```cpp
#include <hip/hip_runtime.h>
#include <hip/hip_cooperative_groups.h>
#include <cstdio>
#include <cstdint>
namespace cg = cooperative_groups;
namespace pg8 {
#define PG8_LAS __attribute__((address_space(3)))
typedef unsigned short bf16_t;
typedef short bf16x8 __attribute__((ext_vector_type(8)));
typedef float f32x4 __attribute__((ext_vector_type(4)));
typedef unsigned u32x4 __attribute__((ext_vector_type(4)));
constexpr int BM = 256, BK = 64, HALF = 128, HTB = HALF * BK * 2  , STAGE_BYTES = 8 * HTB, NXCD = 8, WGM = 8;

__host__ __device__ __forceinline__ int lds_byte(int r, int c) { const int st = (r >> 4) * 2 + (c >> 5), rr = r & 15, cc = c & 31, ob = rr * 64 + cc * 2; return st * 1024 + (ob ^ (((ob >> 9) & 1) << 5)); }
__host__ __device__ __forceinline__ void stage_rc(int b, int& R, int& C) { const int st = b / 1024, sb = b % 1024, swz = sb ^ (((sb >> 9) & 1) << 5); R = (st >> 1) * 16 + swz / 64; C = (st & 1) * 32 + (swz % 64) / 2; }
__host__ __device__ __forceinline__ int perm32(int rho) { const int n = rho >> 4, i = rho & 15; return 8 * (i >> 2) + 4 * n + (i & 3); }

struct Unit { int pm, pn, ord; };
struct Gemm { const bf16_t* A; const bf16_t* Bt; int M, N, K; };

struct StaticOrder {
    int nM, nN, nwg, G, c;
    __host__ __device__ void init(int M, int N, int G_, int c_) { nM = M / BM; nN = N / BM; nwg = nM * nN; G = G_; c = c_; }
    __host__ __device__ bool next(int i, Unit& u) const {
        const long L = (long)i * G + c; if (L >= nwg) return false;
        int wgid = (int)L; { const int q = nwg / NXCD, r = nwg % NXCD, xcd = wgid % NXCD, off = wgid / NXCD; wgid = (xcd < r ? xcd * (q + 1) : r * (q + 1) + (xcd - r) * q) + off; }
        const int nig = WGM * nN, gid = wgid / nig, fm = gid * WGM, gsz = (nM - fm) < WGM ? (nM - fm) : WGM;
        u.pm = fm + ((wgid % nig) % gsz); u.pn = (wgid % nig) / gsz; u.ord = i; return true;
    }
    __device__ __forceinline__ void a_ready(const Unit&) const {}
    __device__ __forceinline__ void done(const Unit&) const {}
};
__device__ __forceinline__ unsigned cvt_pk_bf16(float lo, float hi) { unsigned r; asm volatile("v_cvt_pk_bf16_f32 %0, %1, %2" : "=v"(r) : "v"(lo), "v"(hi)); return r; }
template <class Epi, class Sched, bool ALIGN_EPI = false, bool SP2 = false>
__device__ __forceinline__ void gemm_phase(PG8_LAS unsigned char* lds, const Gemm g, const Sched& S, const Epi& E, const int tid) {
    const int wid = __builtin_amdgcn_readfirstlane(tid >> 6), lane = tid & 63, wr = wid >> 2, wc = wid & 3, fr = lane & 15, fq = lane >> 4;
    const int K = g.K, nt = K / BK;
    unsigned voffA[2], voffB[2];
#pragma unroll
    for (int i = 0; i < 2; ++i) { int R, C; stage_rc(tid * 16 + i * 8192, R, C); const int Rb = Epi::PERM ? ((R & ~31) + perm32(R & 31)) : R;
        voffA[i] = (unsigned)(R * K + C) * 2u; voffB[i] = (unsigned)(Rb * K + C) * 2u; }
    const size_t kstep = (size_t)(BK * 2);
    const size_t hstep = (size_t)HALF * K * 2;
    const size_t tstep = 2 * hstep;
    const unsigned ldsw = (unsigned)wid * 1024u;
    const int aoff = lds_byte(wr * 64 + fr, fq * 8), boff = lds_byte(wc * 32 + fr, fq * 8);
#define PG8_SA(b, h) (((b) * 2 + (h)) * HTB)
#define PG8_SB(b, h) ((4 + (b) * 2 + (h)) * HTB)
#define PG8_STAGE(bufoff, gbase, voff) do { _Pragma("unroll") for (int _i = 0; _i < 2; ++_i) \
        __builtin_amdgcn_global_load_lds((const unsigned*)((const char*)(gbase) + (voff)[_i]), (PG8_LAS unsigned*)(lds + (bufoff) + ldsw + _i * 8192), 16, 0, 0); } while (0)
#define PG8_LDA(dst, b, h) do { _Pragma("unroll") for (int m = 0; m < 4; ++m) _Pragma("unroll") for (int k = 0; k < 2; ++k) dst[m][k] = *(const PG8_LAS bf16x8*)(lds + PG8_SA(b, h) + aoff + m * 2048 + k * 1024); } while (0)
#define PG8_LDB(dst, b, h) do { _Pragma("unroll") for (int n = 0; n < 2; ++n) _Pragma("unroll") for (int k = 0; k < 2; ++k) dst[n][k] = *(const PG8_LAS bf16x8*)(lds + PG8_SB(b, h) + boff + n * 2048 + k * 1024); } while (0)
#define PG8_MMA(ai, bj, At, Bt) do { __builtin_amdgcn_s_setprio(1); _Pragma("unroll") for (int m = 0; m < 4; ++m) _Pragma("unroll") for (int n = 0; n < 2; ++n) _Pragma("unroll") for (int k = 0; k < 2; ++k) \
        acc[ai][bj][m][n] = __builtin_amdgcn_mfma_f32_16x16x32_bf16(Bt[n][k], At[m][k], acc[ai][bj][m][n], 0, 0, 0); __builtin_amdgcn_s_setprio(0); } while (0)
#define PG8_WAIT_V(n) asm volatile("s_waitcnt vmcnt(" #n ")" ::: "memory")
#define PG8_WAIT_L(n) asm volatile("s_waitcnt lgkmcnt(" #n ")" ::: "memory")
#define PG8_BAR __builtin_amdgcn_s_barrier()
#define PG8_SCHED __builtin_amdgcn_sched_barrier(0)
    Unit cur, nxt; int ui = 0;
    if (!S.next(0, cur)) return;
    f32x4 acc[2][2][4][2];
#pragma unroll
    for (int a = 0; a < 2; ++a)
#pragma unroll
        for (int b = 0; b < 2; ++b)
#pragma unroll
            for (int m = 0; m < 4; ++m)
#pragma unroll
                for (int n = 0; n < 2; ++n) acc[a][b][m][n] = (f32x4){0.f, 0.f, 0.f, 0.f};
    bf16x8 At[4][2], B0[2][2], B1[2][2];
    const char* cA = (const char*)g.A + (size_t)cur.pm * tstep; const char* cB = (const char*)g.Bt + (size_t)cur.pn * tstep;
    S.a_ready(cur);
    if constexpr (SP2) {
        PG8_STAGE(PG8_SB(0, 0), cB, voffB); PG8_STAGE(PG8_SB(0, 1), cB + hstep, voffB); PG8_STAGE(PG8_SA(0, 0), cA, voffA); PG8_STAGE(PG8_SA(0, 1), cA + hstep, voffA);
        if (wr == 1) PG8_BAR;
        PG8_WAIT_V(2); PG8_BAR;
        PG8_STAGE(PG8_SB(1, 0), cB + kstep, voffB); PG8_STAGE(PG8_SA(1, 0), cA + kstep, voffA); PG8_STAGE(PG8_SB(1, 1), cB + hstep + kstep, voffB);
        PG8_WAIT_V(6); PG8_BAR;
    } else {
        PG8_STAGE(PG8_SB(0, 0), cB, voffB); PG8_STAGE(PG8_SA(0, 0), cA, voffA); PG8_STAGE(PG8_SB(0, 1), cB + hstep, voffB); PG8_STAGE(PG8_SA(0, 1), cA + hstep, voffA);
        if (wr == 1) PG8_BAR;
        PG8_WAIT_V(4); PG8_BAR;
        PG8_STAGE(PG8_SB(1, 0), cB + kstep, voffB); PG8_STAGE(PG8_SA(1, 0), cA + kstep, voffA); PG8_STAGE(PG8_SB(1, 1), cB + hstep + kstep, voffB);
        PG8_WAIT_V(6); PG8_BAR;
    }
    for (;;) {
        const bool has_next = S.next(ui + 1, nxt);
        const char* nA = has_next ? (const char*)g.A + (size_t)nxt.pm * tstep : cA; const char* nB = has_next ? (const char*)g.Bt + (size_t)nxt.pn * tstep : cB;
        for (int t = 0; t < nt; t += 2) {
            const bool last = (t == nt - 2);
            const char* a1 = cA + (size_t)(t + 1) * kstep;
            const char* a2 = last ? nA : cA + (size_t)(t + 2) * kstep; const char* b2 = last ? nB : cB + (size_t)(t + 2) * kstep;
            const char* a3 = a2 + kstep; const char* b3 = b2 + kstep;
            if (last && has_next) S.a_ready(nxt);
            if constexpr (SP2) {
            PG8_LDB(B0, 0, 0); PG8_LDB(B1, 0, 1); PG8_SCHED; PG8_LDA(At, 0, 0); PG8_STAGE(PG8_SA(1, 1), a1 + hstep, voffA);
            PG8_WAIT_V(8); PG8_WAIT_L(0); PG8_BAR; PG8_MMA(0, 0, At, B0); PG8_MMA(0, 1, At, B1); PG8_BAR; PG8_SCHED;
            PG8_LDA(At, 0, 1); PG8_STAGE(PG8_SB(0, 0), b2, voffB); PG8_STAGE(PG8_SB(0, 1), b2 + hstep, voffB); PG8_STAGE(PG8_SA(0, 0), a2, voffA);
            PG8_WAIT_V(8); PG8_WAIT_L(0); PG8_BAR; PG8_MMA(1, 0, At, B0); PG8_MMA(1, 1, At, B1); PG8_BAR; PG8_SCHED;
            PG8_LDB(B0, 1, 0); PG8_LDB(B1, 1, 1); PG8_SCHED; PG8_LDA(At, 1, 0); PG8_STAGE(PG8_SA(0, 1), a2 + hstep, voffA);
            PG8_WAIT_V(8); PG8_WAIT_L(0); PG8_BAR; PG8_MMA(0, 0, At, B0); PG8_MMA(0, 1, At, B1); PG8_BAR; PG8_SCHED;
            PG8_LDA(At, 1, 1); PG8_STAGE(PG8_SB(1, 0), b3, voffB); PG8_STAGE(PG8_SB(1, 1), b3 + hstep, voffB); PG8_STAGE(PG8_SA(1, 0), a3, voffA);
            PG8_WAIT_V(8); PG8_WAIT_L(0); PG8_BAR; PG8_MMA(1, 0, At, B0); PG8_MMA(1, 1, At, B1); PG8_BAR; PG8_SCHED;
            } else {
            PG8_LDB(B0, 0, 0); PG8_SCHED; PG8_LDA(At, 0, 0); PG8_STAGE(PG8_SA(1, 1), a1 + hstep, voffA);
            PG8_WAIT_L(8); PG8_BAR; PG8_WAIT_L(0); PG8_MMA(0, 0, At, B0); PG8_BAR; PG8_SCHED;
            PG8_LDB(B1, 0, 1); PG8_STAGE(PG8_SB(0, 0), b2, voffB);
            PG8_BAR; PG8_WAIT_L(0); PG8_MMA(0, 1, At, B1); PG8_BAR;
            PG8_LDA(At, 0, 1); PG8_STAGE(PG8_SA(0, 0), a2, voffA);
            PG8_BAR; PG8_WAIT_L(0); PG8_MMA(1, 0, At, B0); PG8_BAR; PG8_SCHED;
            PG8_STAGE(PG8_SB(0, 1), b2 + hstep, voffB);
            PG8_WAIT_V(6); PG8_BAR; PG8_MMA(1, 1, At, B1); PG8_BAR;
            PG8_LDB(B0, 1, 0); PG8_SCHED; PG8_LDA(At, 1, 0); PG8_STAGE(PG8_SA(0, 1), a2 + hstep, voffA);
            PG8_WAIT_L(8); PG8_BAR; PG8_WAIT_L(0); PG8_MMA(0, 0, At, B0); PG8_BAR; PG8_SCHED;
            PG8_LDB(B1, 1, 1); PG8_STAGE(PG8_SB(1, 0), b3, voffB);
            PG8_BAR; PG8_WAIT_L(0); PG8_MMA(0, 1, At, B1); PG8_BAR;
            PG8_LDA(At, 1, 1); PG8_STAGE(PG8_SA(1, 0), a3, voffA);
            PG8_BAR; PG8_WAIT_L(0); PG8_MMA(1, 0, At, B0); PG8_BAR; PG8_SCHED;
            PG8_STAGE(PG8_SB(1, 1), b3 + hstep, voffB);
            PG8_WAIT_V(6); PG8_BAR; PG8_MMA(1, 1, At, B1); PG8_BAR;
            }
        }
        if constexpr (ALIGN_EPI) { if (wr == 0) PG8_BAR; }
        if constexpr (!Epi::AFTER_DRAIN) { E(acc, cur, wr, wc, fr, fq); S.done(cur); }
        if (!has_next) break;
#pragma unroll
        for (int a = 0; a < 2; ++a)
#pragma unroll
            for (int b = 0; b < 2; ++b)
#pragma unroll
                for (int m = 0; m < 4; ++m)
#pragma unroll
                    for (int n = 0; n < 2; ++n) acc[a][b][m][n] = (f32x4){0.f, 0.f, 0.f, 0.f};
        cur = nxt; cA = nA; cB = nB; ++ui;
        if constexpr (ALIGN_EPI) { if (wr == 1) PG8_BAR; }
    }
    PG8_WAIT_V(0);
    if constexpr (!ALIGN_EPI) { if (wr == 0) PG8_BAR; }
    PG8_BAR;
    if constexpr (Epi::AFTER_DRAIN) { E.fused(acc, cur, wr, wc, fr, fq, lds, wid, lane); S.done(cur); }
#undef PG8_SA
#undef PG8_SB
#undef PG8_STAGE
#undef PG8_LDA
#undef PG8_LDB
#undef PG8_MMA
#undef PG8_WAIT_V
#undef PG8_WAIT_L
#undef PG8_BAR
#undef PG8_SCHED
}
}

typedef unsigned short bf16;
typedef float f32x4 __attribute__((ext_vector_type(4)));
typedef float f32x2 __attribute__((ext_vector_type(2)));
typedef unsigned u32x4 __attribute__((ext_vector_type(4)));
typedef unsigned u32x2 __attribute__((ext_vector_type(2)));

#ifndef MK_MULTI
#define MK_MULTI 0
#endif

constexpr int Bn = 8, S = 4096, T = Bn * S, D = 1024, FF = 2816, DEPTH = 4;
constexpr float EPS = 1e-6f;
constexpr int GDN_NPAD = 4352, NSA_NPAD = 2816;
constexpr int LDS_BYTES = 147456;
constexpr size_t MiB = 1u << 20;
constexpr size_t WS_WGU = 1 * MiB;
constexpr size_t WS_WDN = WS_WGU + 88 * MiB;
constexpr size_t WS_WGI = WS_WDN + 44 * MiB;
constexpr size_t WS_WGO = WS_WGI + 17 * MiB;
constexpr size_t WS_WSI = WS_WGO + 4 * MiB;
constexpr size_t WS_WSO = WS_WSI + 6 * MiB;
constexpr size_t WS_WNI = WS_WSO + 2 * MiB;
constexpr size_t WS_WNO = WS_WNI + 6 * MiB;
constexpr size_t WS_WC1 = WS_WNO + 2 * MiB;
constexpr size_t WS_TAB = WS_WC1 + 2 * MiB;
constexpr size_t WS_HN  = 184 * MiB;
constexpr size_t WS_R   = WS_HN + 64 * MiB;
constexpr size_t WS_O32 = WS_R + 256 * MiB;
constexpr size_t WS_SM  = WS_O32 + 128 * MiB;
constexpr size_t WS_AB  = WS_SM;
constexpr size_t WS_GT  = WS_SM + 2 * MiB;
constexpr size_t WS_BP  = WS_SM + 8 * MiB;
constexpr size_t WS_END = WS_SM + 9 * MiB;
static_assert(WS_TAB + 8 * MiB <= WS_HN, "ws map");

__device__ __forceinline__ float bf2f(unsigned v) { return __uint_as_float(v << 16); }
__device__ __forceinline__ unsigned f2bf(float f) { unsigned u = __float_as_uint(f); return (u + 0x7fffu + ((u >> 16) & 1u)) >> 16; }
__device__ __forceinline__ unsigned pk2(float lo, float hi) { return f2bf(lo) | (f2bf(hi) << 16); }
#define MFMA32(a, b, c) __builtin_amdgcn_mfma_f32_32x32x16_bf16((a), (b), (c), 0, 0, 0)
typedef short bf16x8v __attribute__((ext_vector_type(8)));
typedef float f32x16 __attribute__((ext_vector_type(16)));
typedef __bf16 bf16v2 __attribute__((ext_vector_type(2)));
__device__ __forceinline__ unsigned pkbf(float a, float b) { f32x2 v = {a, b}; return __builtin_bit_cast(unsigned, __builtin_convertvector(v, bf16v2)); }
__device__ __forceinline__ int lane_opq() { int l = (int)__builtin_amdgcn_mbcnt_hi(~0u, __builtin_amdgcn_mbcnt_lo(~0u, 0u)); asm volatile("" : "+v"(l)); return l; }
__device__ __forceinline__ float xshfl(float v, int m) { return __int_as_float(__builtin_amdgcn_ds_bpermute((lane_opq() ^ m) << 2, __float_as_int(v))); }
__device__ __forceinline__ float xshfl_up(float v, int o) { return __int_as_float(__builtin_amdgcn_ds_bpermute((lane_opq() - o) << 2, __float_as_int(v))); }
__device__ __forceinline__ float wave_sum(float v) {
#pragma unroll
    for (int o = 1; o < 64; o <<= 1) v += xshfl(v, o);
    return v;
}
__device__ __forceinline__ float wave_max(float v) {
#pragma unroll
    for (int o = 1; o < 64; o <<= 1) v = fmaxf(v, xshfl(v, o));
    return v;
}
__device__ __forceinline__ float row_sum16(float v) {
    v += __uint_as_float((unsigned)__builtin_amdgcn_update_dpp(0, (int)__float_as_uint(v), 0x128, 0xf, 0xf, false));
    v += __uint_as_float((unsigned)__builtin_amdgcn_update_dpp(0, (int)__float_as_uint(v), 0x124, 0xf, 0xf, false));
    v += __uint_as_float((unsigned)__builtin_amdgcn_update_dpp(0, (int)__float_as_uint(v), 0x122, 0xf, 0xf, false));
    v += __uint_as_float((unsigned)__builtin_amdgcn_update_dpp(0, (int)__float_as_uint(v), 0x121, 0xf, 0xf, false));
    return v;
}
__device__ __forceinline__ float sigmoidf_(float x) { return 1.f / (1.f + __expf(-x)); }
__device__ __forceinline__ float siluf_(float x) { return x * __builtin_amdgcn_rcpf(1.f + __expf(-x)); }
#define LDS_BAR() do { asm volatile("s_waitcnt lgkmcnt(0)" ::: "memory"); __builtin_amdgcn_s_barrier(); asm volatile("" ::: "memory"); } while (0)
#define WAVE_SYNC() do { asm volatile("s_waitcnt lgkmcnt(0)" ::: "memory"); __builtin_amdgcn_wave_barrier(); } while (0)

__device__ __forceinline__ float row_rstd(const float* ssq, size_t row) {
    const f32x4* p = (const f32x4*)(ssq + row * 16); const f32x4 a = p[0], b = p[1], c = p[2], d = p[3];
    const float t = ((a.x + a.y) + (a.z + a.w)) + ((b.x + b.y) + (b.z + b.w)) + ((c.x + c.y) + (c.z + c.w)) + ((d.x + d.y) + (d.z + d.w));
    return 1.f / sqrtf(t * (1.f / D) + EPS);
}
namespace pg8 {
struct EpiSwiGLU {
    static constexpr bool PERM = true, AFTER_DRAIN = false;
    bf16_t* O; const float* ssq;
    __device__ __forceinline__ void operator()(const f32x4 (&acc)[2][2][4][2], const Unit& u, int wr, int wc, int fr, int fq) const {
        const int row0 = u.pm * BM + wr * 64 + fr, col0 = u.pn * HALF + wc * 32 + 8 * fq;
#pragma unroll
        for (int ai = 0; ai < 2; ++ai)
#pragma unroll
            for (int m = 0; m < 4; ++m) {
                bf16_t* rowp = O + (size_t)(row0 + ai * HALF + m * 16) * FF + col0;
                const float rs = ssq[u.ord * 256 + wr * 64 + fr + ai * HALF + m * 16];
                float v[8];
#pragma unroll
                for (int n = 0; n < 2; ++n)
#pragma unroll
                    for (int j = 0; j < 4; ++j) { const float g = acc[ai][0][m][n][j] * rs, uu = acc[ai][1][m][n][j] * rs; v[n * 4 + j] = g * __builtin_amdgcn_rcpf(1.f + __expf(-g)) * uu; }
                u32x4 w; w.x = cvt_pk_bf16(v[0], v[1]); w.y = cvt_pk_bf16(v[2], v[3]); w.z = cvt_pk_bf16(v[4], v[5]); w.w = cvt_pk_bf16(v[6], v[7]);
                *(u32x4*)rowp = w;
            }
    }
};
template <int SC2> struct EpiResid {
    static constexpr bool PERM = true, AFTER_DRAIN = false;
    const float* base; float* out; bf16_t* HB; float* ssq;
    __device__ __forceinline__ void operator()(const f32x4 (&acc)[2][2][4][2], const Unit& u, int wr, int wc, int fr, int fq) const {
        constexpr float scale = 0.5f * SC2;
        const int row0 = u.pm * BM + wr * 64 + fr, col0 = u.pn * BM + wc * 32 + 8 * fq;
#pragma unroll
        for (int ai = 0; ai < 2; ++ai)
#pragma unroll
            for (int m = 0; m < 4; ++m) {
                const size_t off = (size_t)(row0 + ai * HALF + m * 16) * D + col0;
                float sq = 0.f;
#pragma unroll
                for (int bj = 0; bj < 2; ++bj) {
                    const f32x4 b0 = *(const f32x4*)(base + off + bj * HALF), b1 = *(const f32x4*)(base + off + bj * HALF + 4);
                    const f32x4 o0 = b0 + acc[ai][bj][m][0] * scale, o1 = b1 + acc[ai][bj][m][1] * scale;
                    *(f32x4*)(out + off + bj * HALF) = o0; *(f32x4*)(out + off + bj * HALF + 4) = o1;
                    { u32x4 w; w.x = cvt_pk_bf16(o0[0], o0[1]); w.y = cvt_pk_bf16(o0[2], o0[3]); w.z = cvt_pk_bf16(o1[0], o1[1]); w.w = cvt_pk_bf16(o1[2], o1[3]);
                        *(u32x4*)(HB + off + bj * HALF) = w;
                        sq += ((o0[0] * o0[0] + o0[1] * o0[1]) + (o0[2] * o0[2] + o0[3] * o0[3])) + ((o1[0] * o1[0] + o1[1] * o1[1]) + (o1[2] * o1[2] + o1[3] * o1[3])); }
                }
                { sq += xshfl(sq, 16); sq += xshfl(sq, 32); if (fq == 0) ssq[(size_t)(row0 + ai * HALF + m * 16) * 16 + u.pn * 4 + wc] = sq; }
                if (m == 3) asm volatile("" ::: "memory");
            }
    }
};
struct EpiProj {
    static constexpr bool PERM = true, AFTER_DRAIN = false;
    bf16_t* O; int ldc; int nmain; float* tail; int ldt; int nvalid; const float* ssq;
    __device__ __forceinline__ void operator()(const f32x4 (&acc)[2][2][4][2], const Unit& u, int wr, int wc, int fr, int fq) const {
        const int row0 = u.pm * BM + wr * 64 + fr, colt = u.pn * BM, col0 = colt + wc * 32 + 8 * fq;
        if (colt + BM <= nmain) {
#pragma unroll
            for (int ai = 0; ai < 2; ++ai)
#pragma unroll
                for (int m = 0; m < 4; ++m) {
                    bf16_t* rowp = O + (size_t)(row0 + ai * HALF + m * 16) * ldc + col0;
                    const float rs = ssq[u.ord * 256 + wr * 64 + fr + ai * HALF + m * 16];
#pragma unroll
                    for (int bj = 0; bj < 2; ++bj) { const f32x4 v0 = acc[ai][bj][m][0] * rs, v1 = acc[ai][bj][m][1] * rs;
                        u32x4 w; w.x = cvt_pk_bf16(v0[0], v0[1]); w.y = cvt_pk_bf16(v0[2], v0[3]); w.z = cvt_pk_bf16(v1[0], v1[1]); w.w = cvt_pk_bf16(v1[2], v1[3]);
                        *(u32x4*)(rowp + bj * HALF) = w; }
                }
        } else {
#pragma unroll
            for (int ai = 0; ai < 2; ++ai)
#pragma unroll
                for (int m = 0; m < 4; ++m) {
                    const size_t row = (size_t)(row0 + ai * HALF + m * 16);
                    const float rs = ssq[u.ord * 256 + wr * 64 + fr + ai * HALF + m * 16];
#pragma unroll
                    for (int bj = 0; bj < 2; ++bj)
#pragma unroll
                        for (int n = 0; n < 2; ++n)
#pragma unroll
                            for (int j = 0; j < 4; ++j) { const int col = col0 + bj * HALF + 4 * n + j; if (col >= nmain && col < nvalid) tail[row * ldt + (col - nmain)] = acc[ai][bj][m][n][j] * rs; }
                }
        }
    }
};
struct EpiF32 {
    static constexpr bool PERM = false, AFTER_DRAIN = false;
    float* C; int ldc;
    __device__ __forceinline__ void operator()(const f32x4 (&acc)[2][2][4][2], const Unit& u, int wr, int wc, int fr, int fq) const {
        const int row0 = u.pm * BM + wr * 64 + fr, col0 = u.pn * BM + wc * 32 + 4 * fq;
#pragma unroll
        for (int ai = 0; ai < 2; ++ai)
#pragma unroll
            for (int m = 0; m < 4; ++m) {
                float* rowp = C + (size_t)(row0 + ai * HALF + m * 16) * ldc + col0;
#pragma unroll
                for (int bj = 0; bj < 2; ++bj)
#pragma unroll
                    for (int n = 0; n < 2; ++n) *(f32x4*)(rowp + bj * HALF + n * 16) = acc[ai][bj][m][n];
            }
    }
};
}

template <class Sched>
__device__ __forceinline__ void rstd_table(float* tab, const float* ssq, const Sched& SO, int tid) {
    pg8::Unit u;
    int nu = 0; while (SO.next(nu, u)) ++nu;
    for (int k0 = 0; k0 < nu * 256; k0 += 512 * 3) {
        float t3[3];
#pragma unroll
        for (int k = 0; k < 3; ++k) { const int idx = k0 + 512 * k + tid; t3[k] = 0.f; if (idx < nu * 256) { SO.next(idx >> 8, u); t3[k] = row_rstd(ssq, (size_t)u.pm * 256 + (idx & 255)); } }
#pragma unroll
        for (int k = 0; k < 3; ++k) { const int idx = k0 + 512 * k + tid; if (idx < nu * 256) tab[idx] = t3[k]; }
    }
    __syncthreads();
}
__device__ __forceinline__ void xpose_item(const float* W, const float* nw, int K, int N, bf16* WT, int rowbase, float* scr, int k0, int n0, int lane) {
    if (n0 + 32 <= N && (N & 3) == 0) {
        f32x4 v[8];
#pragma unroll
        for (int i = 0; i < 8; ++i) { v[i] = *(const f32x4*)(W + (size_t)(k0 + 8 * i + (lane >> 3)) * N + n0 + 4 * (lane & 7)); if (nw) v[i] *= nw[k0 + 8 * i + (lane >> 3)]; }
#pragma unroll
        for (int i = 0; i < 8; ++i) { float* d = scr + (8 * i + (lane >> 3)) * 33 + 4 * (lane & 7); d[0] = v[i].x; d[1] = v[i].y; d[2] = v[i].z; d[3] = v[i].w; }
    } else {
#pragma unroll 8
        for (int i = 0; i < 32; ++i) { const int kk = 2 * i + (lane >> 5), n = n0 + (lane & 31); scr[kk * 33 + (lane & 31)] = n < N ? W[(size_t)(k0 + kk) * N + n] * (nw ? nw[k0 + kk] : 1.f) : 0.f; }
    }
    WAVE_SYNC();
    const int c = lane & 7;
#pragma unroll
    for (int j = 0; j < 4; ++j) { const int n = (lane >> 3) + 8 * j; const float* s = scr + (8 * c) * 33 + n;
        u32x4 o; o.x = pk2(s[0 * 33], s[1 * 33]); o.y = pk2(s[2 * 33], s[3 * 33]); o.z = pk2(s[4 * 33], s[5 * 33]); o.w = pk2(s[6 * 33], s[7 * 33]);
        *(u32x4*)(WT + (size_t)(rowbase + n) * K + k0 + 8 * c) = o; }
    WAVE_SYNC();
}
__device__ __forceinline__ int xpose_rowbase(int mode, int n0) {
    return mode == 1 ? ((n0 < FF) ? ((n0 >> 7) * 256 + (n0 & 127)) : ((((n0 - FF) >> 7) * 256) + 128 + ((n0 - FF) & 127))) : n0;
}
__device__ __forceinline__ void xpose_matrix(const float* W, const float* nw, int K, int N, int Npad, bf16* WT, int mode, float* scr, int gw, int NGW, int lane) {
    const int nblk = Npad / 32, nitems = (K / 64) * nblk;
    float* scr2 = scr + 8 * 64 * 33;
    for (int it = gw; it < nitems; it += 2 * NGW) {
        const int itb = it + NGW;
        const int kbA = it / nblk, n0A = (it - kbA * nblk) * 32, kbB = itb / nblk, n0B = (itb - kbB * nblk) * 32;
        if (itb < nitems && n0A + 32 <= N && n0B + 32 <= N && (N & 3) == 0) {
            f32x4 va[8], vb[8];
#pragma unroll
            for (int i = 0; i < 8; ++i) { va[i] = *(const f32x4*)(W + (size_t)(kbA * 64 + 8 * i + (lane >> 3)) * N + n0A + 4 * (lane & 7)); vb[i] = *(const f32x4*)(W + (size_t)(kbB * 64 + 8 * i + (lane >> 3)) * N + n0B + 4 * (lane & 7)); }
            if (nw) {
#pragma unroll
                for (int i = 0; i < 8; ++i) { va[i] *= nw[kbA * 64 + 8 * i + (lane >> 3)]; vb[i] *= nw[kbB * 64 + 8 * i + (lane >> 3)]; }
            }
#pragma unroll
            for (int i = 0; i < 8; ++i) { float* d = scr + (8 * i + (lane >> 3)) * 33 + 4 * (lane & 7); d[0] = va[i].x; d[1] = va[i].y; d[2] = va[i].z; d[3] = va[i].w;
                float* e = scr2 + (8 * i + (lane >> 3)) * 33 + 4 * (lane & 7); e[0] = vb[i].x; e[1] = vb[i].y; e[2] = vb[i].z; e[3] = vb[i].w; }
            WAVE_SYNC();
            const int c = lane & 7, rbA = xpose_rowbase(mode, n0A), rbB = xpose_rowbase(mode, n0B);
#pragma unroll
            for (int j = 0; j < 4; ++j) { const int n = (lane >> 3) + 8 * j; const float* sa = scr + (8 * c) * 33 + n; const float* sb = scr2 + (8 * c) * 33 + n;
                u32x4 o; o.x = pk2(sa[0 * 33], sa[1 * 33]); o.y = pk2(sa[2 * 33], sa[3 * 33]); o.z = pk2(sa[4 * 33], sa[5 * 33]); o.w = pk2(sa[6 * 33], sa[7 * 33]);
                *(u32x4*)(WT + (size_t)(rbA + n) * K + kbA * 64 + 8 * c) = o;
                u32x4 q; q.x = pk2(sb[0 * 33], sb[1 * 33]); q.y = pk2(sb[2 * 33], sb[3 * 33]); q.z = pk2(sb[4 * 33], sb[5 * 33]); q.w = pk2(sb[6 * 33], sb[7 * 33]);
                *(u32x4*)(WT + (size_t)(rbB + n) * K + kbB * 64 + 8 * c) = q; }
            WAVE_SYNC();
        } else {
            xpose_item(W, nw, K, N, WT, xpose_rowbase(mode, n0A), scr, kbA * 64, n0A, lane);
            if (itb < nitems) xpose_item(W, nw, K, N, WT, xpose_rowbase(mode, n0B), scr, kbB * 64, n0B, lane);
        }
    }
}

__device__ __forceinline__ void phase_norm(const float* h, const float* w, bf16* out, int gw, int NGW, int lane) {
    f32x4 wv[4];
#pragma unroll
    for (int j = 0; j < 4; ++j) wv[j] = ((const f32x4*)w)[64 * j + lane];
    for (int m = gw; m < T; m += NGW) {
        const f32x4* xr = (const f32x4*)(h + (size_t)m * D) + lane;
        f32x4 v[4]; float s = 0.f;
#pragma unroll
        for (int j = 0; j < 4; ++j) { v[j] = xr[64 * j]; s += (v[j].x * v[j].x + v[j].y * v[j].y) + (v[j].z * v[j].z + v[j].w * v[j].w); }
        const float rstd = 1.f / sqrtf(wave_sum(s) * (1.f / D) + EPS);
        u32x2* o8 = (u32x2*)(out + (size_t)m * D) + lane;
#pragma unroll
        for (int j = 0; j < 4; ++j) { u32x2 o; o.x = pk2(v[j].x * rstd * wv[j].x, v[j].y * rstd * wv[j].y); o.y = pk2(v[j].z * rstd * wv[j].z, v[j].w * rstd * wv[j].w); o8[64 * j] = o; }
    }
}

__device__ __forceinline__ void phase_gdn_scan(unsigned char* lds, const bf16* proj, const float* ab, const float* convw, const float* A_log, const float* dt_bias,
                                               float* o32, int vblk, int nblk, int tid, int wid, int lane) {
    float* qs = (float*)lds;
    float* ks = qs + 64 * 128;
    float* vs = ks + 64 * 128;
    float* al = vs + 64 * 32;
    float* be = al + 64;
    float* qk = be + 64;
    float* os = qk + 64;
    bf16* raw = (bf16*)(os + 64 * 32);
    const int e = tid >> 4, dl = tid & 15;
    for (int item = vblk; item < 256; item += nblk) {
        const int bh = (item & 7) + 8 * (item >> 5), es = (item >> 3) & 3, b = bh >> 3, h = bh & 7;
        const float Ah = __expf(A_log[h]), dtb = dt_bias[h];
        const int isk = (tid >> 4) & 1, cg = tid & 15, cv = tid & 3;
        const int colqk = isk * 1024 + h * 128 + cg * 8, colv = 2048 + h * 128 + es * 32 + cv * 8;
        f32x4 wq[4][2], wv[4][2];
#pragma unroll
        for (int j = 0; j < 4; ++j) { wq[j][0] = *(const f32x4*)(convw + j * 3072 + colqk); wq[j][1] = *(const f32x4*)(convw + j * 3072 + colqk + 4);
                                      wv[j][0] = *(const f32x4*)(convw + j * 3072 + colv);  wv[j][1] = *(const f32x4*)(convw + j * 3072 + colv + 4); }
        f32x2 S2[4];
#pragma unroll
        for (int i = 0; i < 4; ++i) S2[i] = (f32x2){0.f, 0.f};
        u32x4 pre[5];
#define GDN_PREFETCH(T0) do { _Pragma("unroll") for (int k_ = 0; k_ < 5; ++k_) { const int idx_ = tid + 512 * k_; const int row_ = idx_ / 36, c_ = idx_ - row_ * 36; const int ts_ = (T0) - 3 + row_; \
            const int col_ = c_ < 16 ? h * 128 + c_ * 8 : (c_ < 32 ? 1024 + h * 128 + (c_ - 16) * 8 : 2048 + h * 128 + es * 32 + (c_ - 32) * 8); \
            pre[k_] = (u32x4){0u, 0u, 0u, 0u}; if (idx_ < 67 * 36 && ts_ >= 0) pre[k_] = *(const u32x4*)(proj + (size_t)(b * S + ts_) * 4096 + col_); } } while (0)
#define GDN_PARK() do { _Pragma("unroll") for (int k_ = 0; k_ < 5; ++k_) { const int idx_ = tid + 512 * k_; if (idx_ < 67 * 36) *(u32x4*)(raw + idx_ * 8) = pre[k_]; } } while (0)
#define GDN_CONV8(ROW0, C8, W, OUT) do { _Pragma("unroll") for (int i_ = 0; i_ < 8; ++i_) OUT[i_] = 0.f; _Pragma("unroll") for (int j_ = 0; j_ < 4; ++j_) { const u32x4 xv_ = *(const u32x4*)(raw + ((ROW0) + j_) * 288 + (C8) * 8); \
            OUT[0] += bf2f(xv_.x & 0xffffu) * W[j_][0].x; OUT[1] += bf2f(xv_.x >> 16) * W[j_][0].y; OUT[2] += bf2f(xv_.y & 0xffffu) * W[j_][0].z; OUT[3] += bf2f(xv_.y >> 16) * W[j_][0].w; \
            OUT[4] += bf2f(xv_.z & 0xffffu) * W[j_][1].x; OUT[5] += bf2f(xv_.z >> 16) * W[j_][1].y; OUT[6] += bf2f(xv_.w & 0xffffu) * W[j_][1].z; OUT[7] += bf2f(xv_.w >> 16) * W[j_][1].w; } \
            _Pragma("unroll") for (int i_ = 0; i_ < 8; ++i_) OUT[i_] = siluf_(OUT[i_]); } while (0)
#define GDN_CONVNORM(T0) do { \
            _Pragma("unroll") for (int it_ = 0; it_ < 4; ++it_) { const int tok_ = it_ * 16 + (tid >> 5); float y_[8]; GDN_CONV8(tok_, isk * 16 + cg, wq, y_); \
                float ss_ = (y_[0] * y_[0] + y_[1] * y_[1]) + (y_[2] * y_[2] + y_[3] * y_[3]) + (y_[4] * y_[4] + y_[5] * y_[5]) + (y_[6] * y_[6] + y_[7] * y_[7]); \
                ss_ = row_sum16(ss_); const float sc_ = (1.f / sqrtf(ss_ + EPS)) * (isk ? 1.f : 0.08838834764831845f); \
                float* d_ = (isk ? ks : qs) + tok_ * 128 + cg * 8; \
                _Pragma("unroll") for (int i_ = 0; i_ < 8; ++i_) y_[i_] *= sc_; \
                *(f32x4*)d_ = (f32x4){y_[0], y_[1], y_[2], y_[3]}; *(f32x4*)(d_ + 4) = (f32x4){y_[4], y_[5], y_[6], y_[7]}; \
                float dq_ = 0.f; _Pragma("unroll") for (int i_ = 0; i_ < 8; ++i_) dq_ += y_[i_] * xshfl(y_[i_], 16); \
                dq_ = row_sum16(dq_); if (isk == 0 && cg == 0) qk[tok_] = dq_; } \
            if (tid < 256) { const int tok_ = tid >> 2; float y_[8]; GDN_CONV8(tok_, 32 + cv, wv, y_); float* d_ = vs + tok_ * 32 + cv * 8; \
                *(f32x4*)d_ = (f32x4){y_[0], y_[1], y_[2], y_[3]}; *(f32x4*)(d_ + 4) = (f32x4){y_[4], y_[5], y_[6], y_[7]}; } \
            if (tid < 64) { const size_t tg_ = (size_t)(b * S + (T0) + tid); const float a_ = ab[tg_ * 16 + h] + dtb, bb_ = ab[tg_ * 16 + 8 + h]; \
                const float sp_ = a_ > 20.f ? a_ : __logf(1.f + __expf(a_)); al[tid] = __expf(-Ah * sp_); be[tid] = sigmoidf_(bb_); } } while (0)
        __syncthreads();
        GDN_PREFETCH(0); GDN_PARK();
        __syncthreads();
        GDN_CONVNORM(0);
        __syncthreads();
        for (int chunk = 0; chunk < S / 64; ++chunk) {
            const int t0 = chunk * 64;
            const bool more = chunk + 1 < S / 64;
            if (more) GDN_PREFETCH(t0 + 64);
            {
                const float* kp = ks + dl * 8; const float* qp = qs + dl * 8; const float* vp = vs + e;
                f32x4 nk0 = *(const f32x4*)kp, nk1 = *(const f32x4*)(kp + 4), nq0 = *(const f32x4*)qp, nq1 = *(const f32x4*)(qp + 4);
                float nv = vp[0], na = al[0], nb = be[0], nqk = qk[0];
                for (int t16 = 0; t16 < 4; ++t16) {
                    float ok = 0.f;
#pragma unroll 4
                    for (int i = 0; i < 16; ++i) {
                        const int tt = t16 * 16 + i, tn = (tt + 1) & 63;
                        const f32x2 K0 = {nk0.x, nk0.y}, K1 = {nk0.z, nk0.w}, K2 = {nk1.x, nk1.y}, K3 = {nk1.z, nk1.w};
                        const f32x2 Q0 = {nq0.x, nq0.y}, Q1 = {nq0.z, nq0.w}, Q2 = {nq1.x, nq1.y}, Q3 = {nq1.z, nq1.w};
                        const float v = nv, a = na, bt = nb, qkt = nqk;
                        nk0 = *(const f32x4*)(kp + tn * 128); nk1 = *(const f32x4*)(kp + tn * 128 + 4); nq0 = *(const f32x4*)(qp + tn * 128); nq1 = *(const f32x4*)(qp + tn * 128 + 4);
                        nv = vp[tn * 32]; na = al[tn]; nb = be[tn]; nqk = qk[tn];
                        f32x2 pa = K0 * S2[0], pb = K2 * S2[2], qa = Q0 * S2[0], qb = Q2 * S2[2];
                        pa = K1 * S2[1] + pa; pb = K3 * S2[3] + pb; qa = Q1 * S2[1] + qa; qb = Q3 * S2[3] + qb;
                        pa += pb; qa += qb;
                        float p = pa.x + pa.y, qS = qa.x + qa.y;
                        p = row_sum16(p); qS = row_sum16(qS);
                        const float vn = bt * (v - a * p);
                        const float o = a * qS + qkt * vn;
                        const f32x2 vn2 = {vn, vn}, a2 = {a, a};
                        S2[0] = S2[0] * a2 + K0 * vn2; S2[1] = S2[1] * a2 + K1 * vn2; S2[2] = S2[2] * a2 + K2 * vn2; S2[3] = S2[3] * a2 + K3 * vn2;
                        ok = (i == dl) ? o : ok;
                    }
                    os[(t16 * 16 + dl) * 32 + e] = ok;
                }
            }
            __syncthreads();
            { const int tok = tid >> 3, c4 = tid & 7;
              *(f32x4*)(o32 + (size_t)(b * S + t0 + tok) * D + h * 128 + es * 32 + c4 * 4) = *(const f32x4*)(os + tok * 32 + c4 * 4); }
            if (more) {
                GDN_PARK();
                __syncthreads();
                GDN_CONVNORM(t0 + 64);
            }
            __syncthreads();
        }
#undef GDN_PREFETCH
#undef GDN_PARK
#undef GDN_CONV8
#undef GDN_CONVNORM
    }
}

constexpr size_t WS_HALO = WS_END;
constexpr size_t WS_GL = WS_END + 10 * MiB;
constexpr size_t WS_SS = WS_GL + 1 * MiB;
constexpr size_t WS_END2 = WS_SS + 26 * MiB;

__device__ __forceinline__ void phase_gdn_halo(const bf16* proj, bf16* halo, int gtid, int NT) {
    for (int idx = gtid; idx < Bn * 64 * 3 * 384; idx += NT) {
        const int c = idx % 384, r3 = (idx / 384) % 3, bn = idx / (384 * 3), n = bn & 63, b = bn >> 6;
        u32x4 v = {0u, 0u, 0u, 0u};
        if (n > 0) v = *(const u32x4*)(proj + (size_t)(b * S + 64 * n - 3 + r3) * 4096 + c * 8);
        *(u32x4*)(halo + (size_t)(bn * 3 + r3) * 3072 + c * 8) = v;
    }
}

constexpr int GP_RAW = 0, GP_QB = 51456, GP_KB = GP_QB + 17408, GP_VB = GP_KB + 17408, GP_AM = GP_VB + 16384, GP_GC = GP_AM + 17408, GP_W = GP_GC + 1024;
__device__ __forceinline__ void phase_gdn_prep(unsigned char* lds, bf16* proj, const bf16* halo, const float* ab, const float* convw, const float* A_log, const float* dt_bias,
                                               bf16* KT, bf16* AT, float* GL, int vblk, int nblk, int tid, int wid, int lane) {
    bf16* raw = (bf16*)(lds + GP_RAW);
    bf16* wimg = (bf16*)(lds + GP_W);
    unsigned char* qb = lds + GP_QB;
    unsigned char* kb = lds + GP_KB;
    bf16* vb = (bf16*)(lds + GP_VB);
    float* Am = (float*)(lds + GP_AM);
    float* gcs = (float*)(lds + GP_GC);
    float* bes = gcs + 64;
    const int r = lane & 31, hh = lane >> 5;
    for (int item = vblk; item < Bn * 8 * 64; item += nblk) {
        const int n = item & 63, h = (item >> 6) & 7, b = item >> 9;
        const size_t tok0 = (size_t)b * S + 64 * n;
        LDS_BAR();
#define GP_RAWLOAD(ITEM, T0, NT) do { const int n_ = (ITEM) & 63, h_ = ((ITEM) >> 6) & 7, b_ = (ITEM) >> 9; const size_t tk0_ = (size_t)b_ * S + 64 * n_; \
        for (int idx = (T0); idx < 67 * 48; idx += (NT)) { const int row = idx / 48, c = idx - row * 48; \
            const int col = c < 16 ? h_ * 128 + c * 8 : (c < 32 ? 1024 + h_ * 128 + (c - 16) * 8 : 2048 + h_ * 128 + (c - 32) * 8); \
            u32x4 v; if (row < 3) v = *(const u32x4*)(halo + (size_t)((b_ * 64 + n_) * 3 + row) * 3072 + col); else v = *(const u32x4*)(proj + (tk0_ + row - 3) * 4096 + col); \
            *(u32x4*)(raw + row * 384 + c * 8) = v; } } while (0)
        if (item == vblk) GP_RAWLOAD(item, tid, 512);
        if (tid < 64) {
            const float a = ab[(tok0 + tid) * 16 + h] + dt_bias[h], bb = ab[(tok0 + tid) * 16 + 8 + h];
            const float sp = a > 20.f ? a : __logf(1.f + __expf(a));
            float g = -__expf(A_log[h]) * sp;
#pragma unroll
            for (int o = 1; o < 64; o <<= 1) { const float t_ = xshfl_up(g, o); if (lane >= o) g += t_; }
            const float be_ = sigmoidf_(bb);
            gcs[tid] = g; bes[tid] = be_; gcs[128 + tid] = be_; gcs[192 + tid] = be_ * __expf(g);
        }
        LDS_BAR();
        {
            const int isk = (tid >> 4) & 1, cg = tid & 15;
            const int colqk = isk * 1024 + h * 128 + cg * 8, colv = 2048 + h * 128 + cg * 8;
#define GP_CONV8(ROW0, C8, COL, OUT) do { _Pragma("unroll") for (int i_ = 0; i_ < 8; ++i_) OUT[i_] = 0.f; _Pragma("unroll") for (int j_ = 0; j_ < 4; ++j_) { const u32x4 xv_ = *(const u32x4*)(raw + ((ROW0) + j_) * 384 + (C8) * 8); \
            const f32x4 w0_ = *(const f32x4*)(convw + j_ * 3072 + (COL)), w1_ = *(const f32x4*)(convw + j_ * 3072 + (COL) + 4); \
            OUT[0] += bf2f(xv_.x & 0xffffu) * w0_.x; OUT[1] += bf2f(xv_.x >> 16) * w0_.y; OUT[2] += bf2f(xv_.y & 0xffffu) * w0_.z; OUT[3] += bf2f(xv_.y >> 16) * w0_.w; \
            OUT[4] += bf2f(xv_.z & 0xffffu) * w1_.x; OUT[5] += bf2f(xv_.z >> 16) * w1_.y; OUT[6] += bf2f(xv_.w & 0xffffu) * w1_.z; OUT[7] += bf2f(xv_.w >> 16) * w1_.w; } \
            _Pragma("unroll") for (int i_ = 0; i_ < 8; ++i_) OUT[i_] = siluf_(OUT[i_]); } while (0)
#pragma unroll 1
            for (int it = 0; it < 4; ++it) {
                const int tk = it * 16 + (tid >> 5);
                float y[8]; GP_CONV8(tk, isk * 16 + cg, colqk, y);
                float ss = (y[0] * y[0] + y[1] * y[1]) + (y[2] * y[2] + y[3] * y[3]) + (y[4] * y[4] + y[5] * y[5]) + (y[6] * y[6] + y[7] * y[7]);
                ss = row_sum16(ss);
                const float sc = (1.f / sqrtf(ss + EPS)) * (isk ? 1.f : 0.08838834764831845f);
                u32x4 w; w.x = pkbf(y[0] * sc, y[1] * sc); w.y = pkbf(y[2] * sc, y[3] * sc); w.z = pkbf(y[4] * sc, y[5] * sc); w.w = pkbf(y[6] * sc, y[7] * sc);
                *(u32x4*)((isk ? kb : qb) + tk * 272 + cg * 16) = w;
            }
#pragma unroll 1
            for (int it = 0; it < 2; ++it) {
                const int tk = it * 32 + (tid >> 4);
                float y[8]; GP_CONV8(tk, 32 + cg, colv, y);
                u32x4 w; w.x = pkbf(y[0], y[1]); w.y = pkbf(y[2], y[3]); w.z = pkbf(y[4], y[5]); w.w = pkbf(y[6], y[7]);
                *(u32x4*)(vb + tk * 128 + cg * 8) = w;
            }
#undef GP_CONV8
        }
        LDS_BAR();
        {
            const int prod = wid >> 2, tr = (wid >> 1) & 1, tc = wid & 1;
            f32x16 acc;
#pragma unroll
            for (int i = 0; i < 16; ++i) acc[i] = 0.f;
            if (tr >= tc) {
                const unsigned char* Ab = (prod ? qb : kb) + (32 * tr + r) * 272 + hh * 16;
                const unsigned char* Bb = kb + (32 * tc + r) * 272 + hh * 16;
#pragma unroll
                for (int ks = 0; ks < 8; ++ks) acc = MFMA32(*(const bf16x8v*)(Ab + ks * 32), *(const bf16x8v*)(Bb + ks * 32), acc);
            }
            const int j = 32 * tc + r; const float gj = gcs[j];
#pragma unroll
            for (int i_ = 0; i_ < 16; ++i_) {
                const int i = 32 * tr + (i_ & 3) + 8 * (i_ >> 2) + 4 * hh;
                const float dec = __expf(gcs[i] - gj);
                if (prod == 0) Am[i * 68 + j] = (j < i) ? bes[i] * acc[i_] * dec : 0.f;
                else AT[(size_t)item * 4096 + i * 64 + j] = (bf16)f2bf((j <= i) ? acc[i_] * dec : 0.f);
            }
        }
        LDS_BAR();
        int tid3 = tid; asm volatile("" : "+v"(tid3));
        if (tid3 < 256) {
            const int isw = tid3 >> 7, d = tid3 & 127;
            unsigned oam = GP_AM, orsc = GP_GC + 512 + isw * 256, ocol = (isw ? GP_KB : GP_VB) + d * 2;
            asm volatile("" : "+v"(oam), "+v"(orsc), "+v"(ocol));
            const float* Am_ = (const float*)(lds + oam); const float* rsc = (const float*)(lds + orsc); const unsigned char* col = lds + ocol;
            const int cstride = isw ? 272 : 256;
            float X[64];
#pragma clang loop unroll(full)
            for (int i = 0; i < 64; ++i) X[i] = 0.f;
#pragma clang loop unroll(full)
            for (int i = 0; i < 64; ++i) {
                f32x4 av = {0.f, 0.f, 0.f, 0.f};
#pragma clang loop unroll(full)
                for (int j4 = 0; j4 < 16; ++j4) { if (4 * j4 < i) { const f32x4 a4 = *(const f32x4*)(Am_ + i * 68 + 4 * j4);
                    const f32x4 x4 = {X[4 * j4], X[4 * j4 + 1], X[4 * j4 + 2], X[4 * j4 + 3]}; av += a4 * x4; } }
                X[i] = rsc[i] * bf2f(*(const bf16*)(col + i * cstride)) - ((av.x + av.y) + (av.z + av.w));
                asm volatile("" ::: "memory");
            }
            if (isw) {
#pragma unroll
                for (int i = 0; i < 64; ++i) wimg[i * 128 + d] = (bf16)f2bf(X[i]);
            } else {
                bf16* up = proj + (tok0 + (d >> 1)) * 4096 + 2048 + h * 128 + (d & 1) * 64;
#pragma unroll
                for (int i8 = 0; i8 < 8; ++i8) { u32x4 w; w.x = pkbf(X[8 * i8], X[8 * i8 + 1]); w.y = pkbf(X[8 * i8 + 2], X[8 * i8 + 3]); w.z = pkbf(X[8 * i8 + 4], X[8 * i8 + 5]); w.w = pkbf(X[8 * i8 + 6], X[8 * i8 + 7]);
                    *(u32x4*)(up + 8 * i8) = w; }
            }
        } else {
            if (tid3 < 384) {
                const int d = tid3 - 256; const float gl_ = gcs[63];
                bf16* kp = KT + (size_t)item * 8192 + d * 64;
#pragma unroll
                for (int i8 = 0; i8 < 8; ++i8) { float y[8];
#pragma unroll
                    for (int i = 0; i < 8; ++i) y[i] = bf2f(*(const bf16*)(kb + (8 * i8 + i) * 272 + d * 2)) * __expf(gl_ - gcs[8 * i8 + i]);
                    u32x4 w; w.x = pkbf(y[0], y[1]); w.y = pkbf(y[2], y[3]); w.z = pkbf(y[4], y[5]); w.w = pkbf(y[6], y[7]);
                    *(u32x4*)(kp + 8 * i8) = w; }
                if (d == 0) GL[item] = __expf(gl_);
            }
#pragma unroll
            for (int k = 0; k < 4; ++k) {
                const int pc = (tid3 - 256) + 256 * k, i = pc >> 4, c8 = pc & 15;
                const u32x4 v = *(const u32x4*)(qb + i * 272 + c8 * 16); const float eg = __expf(gcs[i]);
                u32x4 w; w.x = pkbf(bf2f(v.x & 0xffffu) * eg, bf2f(v.x >> 16) * eg); w.y = pkbf(bf2f(v.y & 0xffffu) * eg, bf2f(v.y >> 16) * eg);
                w.z = pkbf(bf2f(v.z & 0xffffu) * eg, bf2f(v.z >> 16) * eg); w.w = pkbf(bf2f(v.w & 0xffffu) * eg, bf2f(v.w >> 16) * eg);
                *(u32x4*)(proj + (tok0 + i) * 4096 + h * 128 + c8 * 8) = w;
            }
            if (item + nblk < Bn * 8 * 64) GP_RAWLOAD(item + nblk, tid3 - 256, 256);
        }
        LDS_BAR();
#pragma unroll
        for (int k = 0; k < 2; ++k) { const int pc = tid + 512 * k, i = pc >> 4, c8 = pc & 15;
            *(u32x4*)(proj + (tok0 + i) * 4096 + 1024 + h * 128 + c8 * 8) = *(const u32x4*)(wimg + i * 128 + c8 * 8); }
    }
}

#undef GP_RAWLOAD
__device__ __forceinline__ void phase_gdn_scan2(unsigned char* lds, const bf16* proj, const bf16* KT, const bf16* AT, const float* GL, bf16* o16, int vblk, int nblk, int tid, int wid, int lane) {
    unsigned char* Sl = lds;
    unsigned char* Vl = lds + 8704;
    const int r = lane & 31, hh = lane >> 5;
    for (int item = vblk; item < 256; item += nblk) {
        const int bh = (item & 7) + 8 * (item >> 5), es = (item >> 3) & 3, b = bh >> 3, h = bh & 7;
        __syncthreads();
        for (int i = tid; i < 8704 / 4; i += 512) ((unsigned*)Sl)[i] = 0u;
        f32x16 Sacc;
#pragma unroll
        for (int i = 0; i < 16; ++i) Sacc[i] = 0.f;
        const int rt = wid & 1, dt = wid & 3;
        bf16x8v A8n[8]; bf16x8v A4n[4]; u32x2 uun[4]; float gln = 1.f;
#define GS_LOAD(N) do { const size_t tk_ = (size_t)b * S + 64 * (N); const int it_ = bh * 64 + (N); \
            if (wid < 2) { const bf16* wp_ = proj + (tk_ + 32 * rt + r) * 4096 + 1024 + h * 128 + 8 * hh; \
                _Pragma("unroll") for (int ks = 0; ks < 8; ++ks) A8n[ks] = *(const bf16x8v*)(wp_ + 16 * ks); \
                const int c_ = es * 32 + r; const bf16* up_ = proj + (tk_ + (c_ >> 1)) * 4096 + 2048 + h * 128 + (c_ & 1) * 64 + 32 * rt + 4 * hh; \
                _Pragma("unroll") for (int g = 0; g < 4; ++g) uun[g] = *(const u32x2*)(up_ + 8 * g); } \
            else if (wid < 4) { const bf16* qp_ = proj + (tk_ + 32 * rt + r) * 4096 + h * 128 + 8 * hh; \
                _Pragma("unroll") for (int ks = 0; ks < 8; ++ks) A8n[ks] = *(const bf16x8v*)(qp_ + 16 * ks); \
                const bf16* ap_ = AT + (size_t)it_ * 4096 + (32 * rt + r) * 64 + 8 * hh; \
                _Pragma("unroll") for (int sx = 0; sx < 4; ++sx) A4n[sx] = *(const bf16x8v*)(ap_ + 16 * sx); } \
            else { const bf16* kp_ = KT + (size_t)it_ * 8192 + (32 * dt + r) * 64 + 8 * hh; \
                _Pragma("unroll") for (int sx = 0; sx < 4; ++sx) A4n[sx] = *(const bf16x8v*)(kp_ + 16 * sx); \
                gln = GL[it_]; } } while (0)
        GS_LOAD(0);
        for (int n = 0; n < 64; ++n) {
            const size_t tok0 = (size_t)b * S + 64 * n;
            bf16x8v A8[8]; bf16x8v A4[4]; u32x2 uu[4]; const float gl = gln;
#pragma unroll
            for (int ks = 0; ks < 8; ++ks) A8[ks] = A8n[ks];
#pragma unroll
            for (int sx = 0; sx < 4; ++sx) { A4[sx] = A4n[sx]; uu[sx] = uun[sx]; }
            if (n + 1 < 64) GS_LOAD(n + 1);
            LDS_BAR();
            f32x16 acc;
#pragma unroll
            for (int i = 0; i < 16; ++i) acc[i] = 0.f;
            if (wid < 4) {
#pragma unroll
                for (int ks = 0; ks < 8; ++ks) acc = MFMA32(A8[ks], *(const bf16x8v*)(Sl + r * 272 + ks * 32 + hh * 16), acc);
                if (wid < 2) {
#pragma unroll
                    for (int g = 0; g < 4; ++g) {
                        u32x2 w; w.x = pkbf(bf2f(uu[g].x & 0xffffu) - acc[4 * g], bf2f(uu[g].x >> 16) - acc[4 * g + 1]);
                        w.y = pkbf(bf2f(uu[g].y & 0xffffu) - acc[4 * g + 2], bf2f(uu[g].y >> 16) - acc[4 * g + 3]);
                        *(u32x2*)(Vl + r * 144 + (32 * rt + 8 * g + 4 * hh) * 2) = w;
                    }
                }
            }
            LDS_BAR();
            if (wid >= 2 && wid < 4) {
#pragma unroll
                for (int sx = 0; sx < 4; ++sx) acc = MFMA32(A4[sx], *(const bf16x8v*)(Vl + r * 144 + sx * 32 + hh * 16), acc);
                unsigned char* Ol = lds + 13312 + (wid - 2) * 2560;
#pragma unroll
                for (int i = 0; i < 16; ++i) *(bf16*)(Ol + ((i & 3) + 8 * (i >> 2) + 4 * hh) * 80 + r * 2) = (bf16)f2bf(acc[i]);
                WAVE_SYNC();
#pragma unroll
                for (int k = 0; k < 2; ++k) { const int pc = lane + 64 * k, trow = pc >> 2, c4 = pc & 3;
                    *(u32x4*)(o16 + (tok0 + 32 * rt + trow) * D + h * 128 + es * 32 + c4 * 8) = *(const u32x4*)(Ol + trow * 80 + c4 * 16); }
                WAVE_SYNC();
            } else if (wid >= 4) {
#pragma unroll
                for (int i = 0; i < 16; ++i) Sacc[i] *= gl;
#pragma unroll
                for (int sx = 0; sx < 4; ++sx) Sacc = MFMA32(A4[sx], *(const bf16x8v*)(Vl + r * 144 + sx * 32 + hh * 16), Sacc);
#pragma unroll
                for (int g = 0; g < 4; ++g) { u32x2 w; w.x = pkbf(Sacc[4 * g], Sacc[4 * g + 1]); w.y = pkbf(Sacc[4 * g + 2], Sacc[4 * g + 3]);
                    *(u32x2*)(Sl + r * 272 + (32 * dt + 8 * g + 4 * hh) * 2) = w; }
            }
        }
    }
}

#undef GS_LOAD
__device__ __forceinline__ void phase_gdn_post(const bf16* o16, const bf16* proj, const float* onorm, bf16* hn, int gw, int NGW, int lane) {
    const int l16 = lane & 15;
    float wv[8];
#pragma unroll
    for (int j = 0; j < 8; ++j) wv[j] = onorm[8 * l16 + j];
    for (int m = 2 * gw; m < T; m += 2 * NGW) {
        u32x4 xo[2][2], gg[2][2];
#pragma unroll
        for (int tk = 0; tk < 2; ++tk)
#pragma unroll
            for (int pt = 0; pt < 2; ++pt) { xo[tk][pt] = *(const u32x4*)(o16 + (size_t)(m + tk) * D + pt * 512 + lane * 8); gg[tk][pt] = *(const u32x4*)(proj + (size_t)(m + tk) * 4096 + 3072 + pt * 512 + lane * 8); }
#pragma unroll
        for (int tk = 0; tk < 2; ++tk)
#pragma unroll
            for (int pt = 0; pt < 2; ++pt) {
                const u32x4 xv = xo[tk][pt], gv = gg[tk][pt];
                float v[8] = {bf2f(xv.x & 0xffffu), bf2f(xv.x >> 16), bf2f(xv.y & 0xffffu), bf2f(xv.y >> 16), bf2f(xv.z & 0xffffu), bf2f(xv.z >> 16), bf2f(xv.w & 0xffffu), bf2f(xv.w >> 16)};
                const float g[8] = {bf2f(gv.x & 0xffffu), bf2f(gv.x >> 16), bf2f(gv.y & 0xffffu), bf2f(gv.y >> 16), bf2f(gv.z & 0xffffu), bf2f(gv.z >> 16), bf2f(gv.w & 0xffffu), bf2f(gv.w >> 16)};
                float sq = ((v[0] * v[0] + v[1] * v[1]) + (v[2] * v[2] + v[3] * v[3])) + ((v[4] * v[4] + v[5] * v[5]) + (v[6] * v[6] + v[7] * v[7]));
                sq = row_sum16(sq);
                const float rstd = 1.f / sqrtf(sq * (1.f / 128.f) + EPS);
#pragma unroll
                for (int j = 0; j < 8; ++j) v[j] = v[j] * rstd * wv[j] * siluf_(g[j]);
                u32x4 w; w.x = pkbf(v[0], v[1]); w.y = pkbf(v[2], v[3]); w.z = pkbf(v[4], v[5]); w.w = pkbf(v[6], v[7]);
                *(u32x4*)(hn + (size_t)(m + tk) * D + pt * 512 + lane * 8) = w;
            }
    }
}
__device__ __forceinline__ void phase_sc_post(const bf16* proj, const float* cw, bf16* hn, int gtid, int NT) {
    const int c8 = (gtid & 127) * 8;
    f32x4 w0[3], w1[3];
#pragma unroll
    for (int j = 0; j < 3; ++j) { w0[j] = *(const f32x4*)(cw + j * 1024 + c8); w1[j] = *(const f32x4*)(cw + j * 1024 + c8 + 4); }
    for (int idx = gtid; idx < T * 128; idx += 2 * NT) {
        u32x4 cv[2][3], xv[2][3], bv[2];
#pragma unroll
        for (int q = 0; q < 2; ++q) {
            const int id = idx + q * NT, m = id >> 7, s = m & (S - 1);
#pragma unroll
            for (int j = 0; j < 3; ++j) { cv[q][j] = (u32x4){0u, 0u, 0u, 0u}; xv[q][j] = (u32x4){0u, 0u, 0u, 0u};
                if (id < T * 128 && s - 2 + j >= 0) { const bf16* pr = proj + (size_t)(m - 2 + j) * 3072; cv[q][j] = *(const u32x4*)(pr + 1024 + c8); xv[q][j] = *(const u32x4*)(pr + 2048 + c8); } }
            bv[q] = (u32x4){0u, 0u, 0u, 0u};
            if (id < T * 128) bv[q] = *(const u32x4*)(proj + (size_t)m * 3072 + c8);
        }
#pragma unroll
        for (int q = 0; q < 2; ++q) {
            const int id = idx + q * NT, m = id >> 7;
            if (id >= T * 128) break;
            float y[8];
#pragma unroll
            for (int i = 0; i < 8; ++i) y[i] = 0.f;
#pragma unroll
            for (int j = 0; j < 3; ++j) {
                const u32x4 c = cv[q][j], x = xv[q][j];
                y[0] += w0[j].x * bf2f(c.x & 0xffffu) * bf2f(x.x & 0xffffu); y[1] += w0[j].y * bf2f(c.x >> 16) * bf2f(x.x >> 16);
                y[2] += w0[j].z * bf2f(c.y & 0xffffu) * bf2f(x.y & 0xffffu); y[3] += w0[j].w * bf2f(c.y >> 16) * bf2f(x.y >> 16);
                y[4] += w1[j].x * bf2f(c.z & 0xffffu) * bf2f(x.z & 0xffffu); y[5] += w1[j].y * bf2f(c.z >> 16) * bf2f(x.z >> 16);
                y[6] += w1[j].z * bf2f(c.w & 0xffffu) * bf2f(x.w & 0xffffu); y[7] += w1[j].w * bf2f(c.w >> 16) * bf2f(x.w >> 16);
            }
            const u32x4 b = bv[q];
            u32x4 o;
            o.x = pkbf(y[0] * bf2f(b.x & 0xffffu), y[1] * bf2f(b.x >> 16)); o.y = pkbf(y[2] * bf2f(b.y & 0xffffu), y[3] * bf2f(b.y >> 16));
            o.z = pkbf(y[4] * bf2f(b.z & 0xffffu), y[5] * bf2f(b.z >> 16)); o.w = pkbf(y[6] * bf2f(b.w & 0xffffu), y[7] * bf2f(b.w >> 16));
            *(u32x4*)(hn + (size_t)m * D + c8) = o;
        }
    }
}
__device__ __forceinline__ void phase_nsa_post(unsigned char* lds, const bf16* proj, const float* qnorm, const float* knorm, const f32x2* tab,
                                               bf16* QN, bf16* KS, bf16* KW, bf16* KCH, bf16* VCH, bf16* VST, bf16* VWT, int gw, int NGW, int wid, int lane) {
    {
        bf16* tile = (bf16*)lds + wid * (64 * 72);
        const int c8 = lane & 7, r8 = lane >> 3;
        for (int item = gw; item < 2 * 32 * 64; item += NGW) {
            const int st = item & 63, bh = (item >> 6) & 31, which = item >> 11, b = bh >> 2, hk = bh & 3;
            const bf16* src = proj + ((size_t)b * S + st * 64 + r8) * 2560 + (which ? 2304 : 1792) + hk * 64 + c8 * 8;
            u32x4 v[8];
#pragma unroll
            for (int i = 0; i < 8; ++i) v[i] = *(const u32x4*)(src + (size_t)(8 * i) * 2560);
#pragma unroll
            for (int i = 0; i < 8; ++i) *(u32x4*)(tile + (8 * i + r8) * 72 + c8 * 8) = v[i];
            WAVE_SYNC();
            bf16* dst = (which ? VWT : VST) + (size_t)bh * 64 * S + st * 64 + c8 * 8;
#pragma unroll
            for (int i = 0; i < 8; ++i) {
                const bf16* tp = tile + (8 * c8) * 72 + 8 * i + r8;
                u32x4 w; w.x = (unsigned)tp[0] | ((unsigned)tp[72] << 16); w.y = (unsigned)tp[144] | ((unsigned)tp[216] << 16);
                w.z = (unsigned)tp[288] | ((unsigned)tp[360] << 16); w.w = (unsigned)tp[432] | ((unsigned)tp[504] << 16);
                *(u32x4*)(dst + (size_t)(8 * i + r8) * S) = w;
            }
            WAVE_SYNC();
        }
    }
    const int l8 = lane & 7, hsel = lane >> 3, lo32 = lane < 32;
    float qw8[8], kw8[8];
#pragma unroll
    for (int j = 0; j < 8; ++j) { qw8[j] = qnorm[8 * l8 + j]; kw8[j] = knorm[(lo32 ? 64 : 128) + 8 * l8 + j]; }
#define NP_UNPACK(V, X) do { X[0] = bf2f(V.x & 0xffffu); X[1] = bf2f(V.x >> 16); X[2] = bf2f(V.y & 0xffffu); X[3] = bf2f(V.y >> 16); X[4] = bf2f(V.z & 0xffffu); X[5] = bf2f(V.z >> 16); X[6] = bf2f(V.w & 0xffffu); X[7] = bf2f(V.w >> 16); } while (0)
#define NP_RSTD8(X, R) do { float ss_ = (X[0] * X[0] + X[1] * X[1]) + (X[2] * X[2] + X[3] * X[3]) + (X[4] * X[4] + X[5] * X[5]) + (X[6] * X[6] + X[7] * X[7]); \
        ss_ += xshfl(ss_, 1); ss_ += xshfl(ss_, 2); ss_ += xshfl(ss_, 4); R = 1.f / sqrtf(ss_ * (1.f / 64.f) + EPS); } while (0)
    for (int m0 = gw; m0 < T; m0 += 2 * NGW) {
        u32x4 vq0_[2], vq1_[2], vk_[2], vc_[2]; f32x4 cc_[2][4];
#pragma unroll
        for (int q = 0; q < 2; ++q) {
            const int m = m0 + q * NGW < T ? m0 + q * NGW : m0;
            const bf16* pr = proj + (size_t)m * 2560;
            vq0_[q] = *(const u32x4*)(pr + lane * 8); vq1_[q] = *(const u32x4*)(pr + 512 + lane * 8);
            vk_[q] = *(const u32x4*)(pr + (lo32 ? 1536 + lane * 8 : 2048 + (lane - 32) * 8));
            vc_[q] = *(const u32x4*)(pr + (lo32 ? 1024 + lane * 8 : 1280 + (lane - 32) * 8));
            const f32x4* cp = (const f32x4*)(tab + (size_t)m * 32 + 8 * (l8 & 3));
            cc_[q][0] = cp[0]; cc_[q][1] = cp[1]; cc_[q][2] = cp[2]; cc_[q][3] = cp[3];
        }
#pragma unroll
        for (int q = 0; q < 2; ++q) {
        const int m = m0 + q * NGW;
        if (m >= T) break;
        const int b = m >> 12, s = m & (S - 1);
        const u32x4 vq0 = vq0_[q], vq1 = vq1_[q], vk = vk_[q], vc = vc_[q];
        const f32x4 c0 = cc_[q][0], c1 = cc_[q][1], c2 = cc_[q][2], c3 = cc_[q][3];
        {
            float x[8], r; NP_UNPACK(vq0, x); NP_RSTD8(x, r);
            u32x4 w; w.x = pkbf(x[0] * r * qw8[0], x[1] * r * qw8[1]); w.y = pkbf(x[2] * r * qw8[2], x[3] * r * qw8[3]); w.z = pkbf(x[4] * r * qw8[4], x[5] * r * qw8[5]); w.w = pkbf(x[6] * r * qw8[6], x[7] * r * qw8[7]);
            *(u32x4*)(QN + ((size_t)(b * 16 + hsel) * S + s) * 64 + 8 * l8) = w;
        }
        {
            float x[8], r; NP_UNPACK(vq1, x); NP_RSTD8(x, r);
            u32x4 w; w.x = pkbf(x[0] * r * qw8[0], x[1] * r * qw8[1]); w.y = pkbf(x[2] * r * qw8[2], x[3] * r * qw8[3]); w.z = pkbf(x[4] * r * qw8[4], x[5] * r * qw8[5]); w.w = pkbf(x[6] * r * qw8[6], x[7] * r * qw8[7]);
            *(u32x4*)(QN + ((size_t)(b * 16 + 8 + hsel) * S + s) * 64 + 8 * l8) = w;
        }
        const size_t okv = ((size_t)(b * 4 + (hsel & 3)) * S + s) * 64 + 8 * l8;
        {
            float x[8], r, y[8]; NP_UNPACK(vk, x); NP_RSTD8(x, r);
            const float cs[16] = {c0.x, c0.y, c0.z, c0.w, c1.x, c1.y, c1.z, c1.w, c2.x, c2.y, c2.z, c2.w, c3.x, c3.y, c3.z, c3.w};
#pragma unroll
            for (int j = 0; j < 8; ++j) { const float yv = x[j] * r * kw8[j]; const float yp = xshfl(yv, 4); y[j] = yv * cs[2 * j] + (l8 < 4 ? -yp : yp) * cs[2 * j + 1]; }
            u32x4 w; w.x = pkbf(y[0], y[1]); w.y = pkbf(y[2], y[3]); w.z = pkbf(y[4], y[5]); w.w = pkbf(y[6], y[7]);
            *(u32x4*)((lo32 ? KS : KW) + okv) = w;
        }
        *(u32x4*)((lo32 ? KCH : VCH) + okv) = vc;
    }
    }
#undef NP_UNPACK
#undef NP_RSTD8
}
__device__ __forceinline__ void phase_cmp2(unsigned char* lds, const float* Pk, const float* Pv, const float* biasp, const float* w2, const float* b2, const float* knorm0,
                                           bf16* KC, bf16* VC, int gw, int NGW, int wid, int lane, int tid) {
    float* hs = (float*)lds + wid * 256;
    float* w2l = (float*)(lds + 8192);
    for (int kind = 0; kind < 2; ++kind) {
        __syncthreads();
        for (int idx = tid; idx < 256 * 64 / 4; idx += 512) ((f32x4*)w2l)[idx] = ((const f32x4*)(w2 + (size_t)kind * 256 * 64))[idx];
        __syncthreads();
        const float* P = kind ? Pv : Pk;
        for (int it = gw; it < 32 * 256; it += NGW) {
            const int i = it & 255, bh = it >> 8;
            bf16* outp = kind ? VC + ((size_t)bh * 64 + lane) * 256 + i : KC + ((size_t)bh * 256 + i) * 64 + lane;
            if (i == 255) { *outp = 0; continue; }
            const float* r0 = P + ((size_t)bh * 256 + i) * 512; const float* r1 = r0 + 512 + 256;
#pragma unroll
            for (int j = 0; j < 4; ++j) { const int n = lane + 64 * j; const float x = r0[n] + r1[n] + biasp[kind * 256 + n];
                const float uu = 0.7978845608028654f * (x + 0.044715f * x * x * x);
                const float th = 1.f - 2.f / (1.f + __expf(2.f * uu));
                hs[n] = 0.5f * x * (1.f + th); }
            WAVE_SYNC();
            float a0 = b2[kind * 64 + lane], a1 = 0.f, a2 = 0.f, a3 = 0.f;
#pragma unroll 4
            for (int n = 0; n < 256; n += 4) { const f32x4 hv = *(const f32x4*)(hs + n);
                a0 += hv.x * w2l[n * 64 + lane]; a1 += hv.y * w2l[(n + 1) * 64 + lane]; a2 += hv.z * w2l[(n + 2) * 64 + lane]; a3 += hv.w * w2l[(n + 3) * 64 + lane]; }
            float acc = (a0 + a1) + (a2 + a3);
            if (kind == 0) { const float ss = wave_sum(acc * acc); acc = acc * (1.f / sqrtf(ss * (1.f / 64.f) + EPS)) * knorm0[lane]; }
            *outp = (bf16)f2bf(acc);
            WAVE_SYNC();
        }
    }
}
constexpr int KV_STRIDE = 144;
constexpr int KV_BUF = 2 * 64 * KV_STRIDE;
constexpr int ATT_IMP_OFF = 2 * KV_BUF;
constexpr int ATT_MSK_OFF = ATT_IMP_OFF + 8 * 2048;

template <bool IMP>
__device__ __forceinline__ void attn_tile(const bool FAST, const unsigned char* buf, int tt, int key0, int lo, int hi, const bf16x8v (&qf)[4],
                                          f32x16 (&O)[2], f32x16 (&IM)[2], float& m, float& l, const bf16* ovt, int r, int h, int pr) {
    f32x16 sacc;
#pragma unroll
    for (int i = 0; i < 16; ++i) sacc[i] = 0.f;
    bf16x8v ov[2][2];
    if (IMP) {
#pragma unroll
        for (int st = 0; st < 2; ++st)
#pragma unroll
            for (int sx = 0; sx < 2; ++sx) ov[st][sx] = *(const bf16x8v*)(ovt + (32 * st + r) * 256 + key0 + 16 * sx + 8 * h);
    }
    const unsigned char* kb = buf + (32 * tt + pr) * KV_STRIDE + h * 16;
#pragma unroll
    for (int ks = 0; ks < 4; ++ks) { const bf16x8v a = *(const bf16x8v*)(kb + ks * 32); sacc = MFMA32(a, qf[ks], sacc); }
    const int kb0 = key0 + 8 * h;
    float mx = -1e30f, psum = 0.f, corr;
    if (FAST) {
        const bool on = hi >= 0;
#pragma unroll
        for (int i = 0; i < 16; ++i) mx = fmaxf(mx, sacc[i]);
        mx = on ? mx * 0.18033688011112042f : -1e30f;
        mx = fmaxf(mx, xshfl(mx, 32));
        const float mnew = fmaxf(m, mx);
        corr = __builtin_amdgcn_exp2f(m - mnew);
        m = mnew;
#pragma unroll
        for (int i = 0; i < 16; ++i) { const float p = __builtin_amdgcn_exp2f(sacc[i] * 0.18033688011112042f - mnew); psum += p; sacc[i] = p; }
        if (!on) {
            psum = 0.f;
#pragma unroll
            for (int i = 0; i < 16; ++i) sacc[i] = 0.f;
        }
    } else {
#pragma unroll
        for (int i = 0; i < 16; ++i) { const int key = kb0 + 16 * (i >> 3) + (i & 7); const bool ok = (key >= lo) && (key <= hi);
            const float sv = ok ? sacc[i] * 0.18033688011112042f : -1e30f; sacc[i] = sv; mx = fmaxf(mx, sv); }
        mx = fmaxf(mx, xshfl(mx, 32));
        const float mnew = fmaxf(m, mx);
        corr = __builtin_amdgcn_exp2f(m - mnew);
        m = mnew;
#pragma unroll
        for (int i = 0; i < 16; ++i) { const float p = sacc[i] > -1e29f ? __builtin_amdgcn_exp2f(sacc[i] - mnew) : 0.f; psum += p; sacc[i] = p; }
    }
    l = l * corr + psum;
    if (__any(corr != 1.f)) {
#pragma unroll
        for (int i = 0; i < 16; ++i) { O[0][i] *= corr; O[1][i] *= corr; }
        if (IMP) {
#pragma unroll
            for (int i = 0; i < 16; ++i) { IM[0][i] *= corr; IM[1][i] *= corr; }
        }
    }
    bf16x8v pf[2];
#pragma unroll
    for (int sx = 0; sx < 2; ++sx) { u32x4 w; w.x = pkbf(sacc[8 * sx], sacc[8 * sx + 1]); w.y = pkbf(sacc[8 * sx + 2], sacc[8 * sx + 3]); w.z = pkbf(sacc[8 * sx + 4], sacc[8 * sx + 5]); w.w = pkbf(sacc[8 * sx + 6], sacc[8 * sx + 7]);
        pf[sx] = __builtin_bit_cast(bf16x8v, w); }
    const unsigned char* vb = buf + 64 * KV_STRIDE + r * KV_STRIDE + (32 * tt + 8 * h) * 2;
#pragma unroll
    for (int dt = 0; dt < 2; ++dt)
#pragma unroll
        for (int sx = 0; sx < 2; ++sx) { const bf16x8v a = *(const bf16x8v*)(vb + dt * 32 * KV_STRIDE + sx * 32); O[dt] = MFMA32(a, pf[sx], O[dt]); }
    if (IMP) {
#pragma unroll
        for (int st = 0; st < 2; ++st)
#pragma unroll
            for (int sx = 0; sx < 2; ++sx) IM[st] = MFMA32(ov[st][sx], pf[sx], IM[st]);
    }
}

template <int MODE>
__device__ __forceinline__ void attn_branch(unsigned char* kvbuf, const bf16* Kg0, const bf16* VTg0, int vts, unsigned long long blkmask, int t, int nv, unsigned long long selm,
                                            int wlo, int whi, int flo, int fhi, const bf16x8v (&qf)[4], f32x16 (&O)[2], f32x16 (&IM)[2], float& l, const bf16* ovt, int tid, int r, int h, int pr) {
    float m = -1e30f;
    l = 0.f;
#pragma unroll
    for (int i = 0; i < 16; ++i) { O[0][i] = 0.f; O[1][i] = 0.f; IM[0][i] = 0.f; IM[1][i] = 0.f; }
    const int srow = tid >> 3, sch = tid & 7;
    int j = __builtin_ctzll(blkmask);
    unsigned long long rest = blkmask & (blkmask - 1);
    u32x4 kr = *(const u32x4*)(Kg0 + (size_t)(64 * j + srow) * 64 + sch * 8);
    u32x4 vr = *(const u32x4*)(VTg0 + (size_t)srow * vts + 64 * j + sch * 8);
    *(u32x4*)(kvbuf + srow * KV_STRIDE + sch * 16) = kr;
    *(u32x4*)(kvbuf + 64 * KV_STRIDE + srow * KV_STRIDE + sch * 16) = vr;
    int cur = 0;
    for (;;) {
        LDS_BAR();
        const bool more = rest != 0ull;
        int jn = 0;
        if (more) { jn = __builtin_ctzll(rest); rest &= rest - 1;
            kr = *(const u32x4*)(Kg0 + (size_t)(64 * jn + srow) * 64 + sch * 8);
            vr = *(const u32x4*)(VTg0 + (size_t)srow * vts + 64 * jn + sch * 8); }
        const unsigned char* buf = kvbuf + cur * KV_BUF;
        int lo, hi;
        if (MODE == 0) { lo = 0; hi = nv - 1; }
        else if (MODE == 1) { lo = 0; hi = ((selm >> j) & 1ull) ? t : -1; }
        else { lo = t - 511; hi = t; }
        const bool wave_on = (MODE != 1) || __any(hi >= 0);
#pragma unroll
        for (int tt = 0; tt < 2; ++tt) {
            const int key0 = 64 * j + 32 * tt;
            if (!wave_on || key0 > whi || key0 + 31 < wlo) continue;
            attn_tile<MODE == 0>(key0 >= flo && key0 + 31 <= fhi, buf, tt, key0, lo, hi, qf, O, IM, m, l, ovt, r, h, pr);
        }
        if (!more) break;
        *(u32x4*)(kvbuf + (cur ^ 1) * KV_BUF + srow * KV_STRIDE + sch * 16) = kr;
        *(u32x4*)(kvbuf + (cur ^ 1) * KV_BUF + 64 * KV_STRIDE + srow * KV_STRIDE + sch * 16) = vr;
        cur ^= 1; j = jn;
    }
    LDS_BAR();
}

__device__ __forceinline__ void phase_nsa_attn(unsigned char* lds, const bf16* QN, const bf16* KS, const bf16* KW, const bf16* VST, const bf16* VWT, const bf16* KCb, const bf16* VCT,
                                               const bf16* ovt, const float* gates, const f32x2* tab, bf16* hn, int vblk, int nblk, int tid, int wid, int lane) {
    const int r = lane & 31, h = lane >> 5, pr = (r & ~12) | ((r & 4) << 1) | ((r & 8) >> 1);
    float* imp_s = (float*)(lds + ATT_IMP_OFF + wid * 2048);
    unsigned long long* msk_s = (unsigned long long*)(lds + ATT_MSK_OFF);
    unsigned* uni_s = (unsigned*)(lds + ATT_MSK_OFF + 512);
    for (int item = vblk; item < Bn * 4 * 64; item += nblk) {
        const int rnd = item / nblk, wv = item - rnd * nblk;
        const int bh = wv & 31, sub = wv >> 5, per = nblk >> 5;
        int qb = rnd * per + ((rnd & 1) ? (per - 1 - sub) : sub);
        if (nblk != 256) { qb = item >> 5; }
        const int bhh = (nblk != 256) ? (item & 31) : bh;
        const int b = bhh >> 2, hk = bhh & 3;
        const int t0 = qb * 64, tw0 = t0 + 8 * wid, t = tw0 + (r & 7), g = r >> 3;
        const size_t tok = (size_t)b * S + t;
        if (tid == 0) { unsigned z = 0u; asm volatile("" : "+v"(z)); uni_s[0] = z; uni_s[1] = z; }
        bf16x8v qn[4], qr[4];
        {
            const bf16* qp = QN + ((size_t)(b * 16 + hk * 4 + g) * S + t) * 64 + 8 * h;
#pragma unroll
            for (int ks = 0; ks < 4; ++ks) qn[ks] = *(const bf16x8v*)(qp + 16 * ks);
            const f32x2* cp = tab + tok * 32 + 8 * h;
#pragma unroll
            for (int kl = 0; kl < 2; ++kl) {
                u32x4 wlo_, whi_;
                const u32x4 a = __builtin_bit_cast(u32x4, qn[kl]), c = __builtin_bit_cast(u32x4, qn[kl + 2]);
#pragma unroll
                for (int jj = 0; jj < 4; ++jj) {
                    const f32x2 cs0 = cp[16 * kl + 2 * jj], cs1 = cp[16 * kl + 2 * jj + 1];
                    const float x0 = bf2f(a[jj] & 0xffffu), x1 = bf2f(a[jj] >> 16), y0 = bf2f(c[jj] & 0xffffu), y1 = bf2f(c[jj] >> 16);
                    wlo_[jj] = pkbf(x0 * cs0.x - y0 * cs0.y, x1 * cs1.x - y1 * cs1.y);
                    whi_[jj] = pkbf(y0 * cs0.x + x0 * cs0.y, y1 * cs1.x + x1 * cs1.y);
                }
                qr[kl] = __builtin_bit_cast(bf16x8v, wlo_); qr[kl + 2] = __builtin_bit_cast(bf16x8v, whi_);
            }
        }
        const float* gp = gates + tok * 48 + (hk * 4 + g) * 3;
        const float g0 = sigmoidf_(gp[0]), g1 = sigmoidf_(gp[1]), g2 = sigmoidf_(gp[2]);
        f32x16 acc[2], O[2], IM[2];
        float l;
        const int nv = t >= 31 ? ((t - 31) >> 4) + 1 : 0;
        const int nvw = ((tw0 + 7 - 31) >> 4) + 1;
        const int nvmax = 4 * qb + 3;
        {
            const int ncb = (nvmax + 63) >> 6;
            const unsigned long long bm = ncb >= 64 ? ~0ull : ((1ull << ncb) - 1ull);
            attn_branch<0>(lds, KCb + (size_t)bhh * 256 * 64, VCT + (size_t)bhh * 64 * 256, 256, bm, t, nv, 0ull, 0, (tw0 + 7 >= 31 ? nvw - 1 : -1), 0, (tw0 >= 31 ? ((tw0 - 31) >> 4) : -1), qn, O, IM, l, ovt, tid, r, h, pr);
        }
        {
            const float lt = l + xshfl(l, 32), inv = lt > 0.f ? 1.f / lt : 0.f, sc = inv * g0;
#pragma unroll
            for (int i = 0; i < 16; ++i) { acc[0][i] = O[0][i] * sc; acc[1][i] = O[1][i] * sc; }
#pragma unroll
            for (int st = 0; st < 2; ++st)
#pragma unroll
                for (int i = 0; i < 16; ++i) { float v = IM[st][i] * inv; v += xshfl(v, 8); v += xshfl(v, 16);
                    if (r < 8) imp_s[r * 64 + 32 * st + (i & 3) + 8 * (i >> 2) + 4 * h] = v; }
        }
        WAVE_SYNC();
        {
            unsigned long long um = 0ull;
            for (int tk = 0; tk < 8; ++tk) {
                const float imp = imp_s[tk * 64 + lane];
                const bool sv = lane <= qb, forced = (lane == 0) || (lane == qb) || (lane + 1 == qb);
                const float score = sv ? (forced ? 1e9f : imp) : -1.f;
                int rank = 0;
#pragma unroll 4
                for (int i = 0; i < 64; ++i) { const float si = __uint_as_float(__builtin_amdgcn_readlane(__float_as_uint(score), i)); rank += (si > score || (si == score && i < lane)) ? 1 : 0; }
                const unsigned long long mk = __ballot((rank < 16) && (score >= 0.f));
                um |= mk;
                if (lane == 0) msk_s[wid * 8 + tk] = mk;
            }
            if (lane == 0) { atomicOr(&uni_s[0], (unsigned)um); atomicOr(&uni_s[1], (unsigned)(um >> 32)); }
        }
        __syncthreads();
        const unsigned long long selm = msk_s[wid * 8 + (r & 7)];
        const unsigned long long uni = (unsigned long long)uni_s[0] | ((unsigned long long)uni_s[1] << 32);
        attn_branch<1>(lds, KS + (size_t)bhh * S * 64, VST + (size_t)bhh * 64 * S, S, uni, t, 0, selm, 0, tw0 + 7, 0, tw0, qr, O, IM, l, ovt, tid, r, h, pr);
        {
            const float lt = l + xshfl(l, 32), sc = g1 / lt;
#pragma unroll
            for (int i = 0; i < 16; ++i) { acc[0][i] += O[0][i] * sc; acc[1][i] += O[1][i] * sc; }
        }
        {
            const int jlo = qb >= 8 ? qb - 8 : 0;
            const unsigned long long bm = (qb >= 63 ? ~0ull : ((1ull << (qb + 1)) - 1ull)) & ~((1ull << jlo) - 1ull);
            attn_branch<2>(lds, KW + (size_t)bhh * S * 64, VWT + (size_t)bhh * 64 * S, S, bm, t, 0, 0ull, tw0 - 511, tw0 + 7, tw0 + 7 - 511, tw0, qr, O, IM, l, ovt, tid, r, h, pr);
        }
        {
            const float lt = l + xshfl(l, 32), sc = g2 / lt;
            bf16* op = hn + tok * D + (hk * 4 + g) * 64 + 4 * h;
#pragma unroll
            for (int dt = 0; dt < 2; ++dt)
#pragma unroll
                for (int q4 = 0; q4 < 4; ++q4) {
                    u32x2 w; w.x = pkbf(acc[dt][4 * q4] + O[dt][4 * q4] * sc, acc[dt][4 * q4 + 1] + O[dt][4 * q4 + 1] * sc);
                    w.y = pkbf(acc[dt][4 * q4 + 2] + O[dt][4 * q4 + 2] * sc, acc[dt][4 * q4 + 3] + O[dt][4 * q4 + 3] * sc);
                    *(u32x2*)(op + 32 * dt + 8 * q4) = w;
                }
        }
    }
}


#define LAS __attribute__((address_space(3)))
#define XB_TMO      128
#define XB_XCNT(j)  (256  + 64 * (j))
#define XB_XSUB(j)  (1280 + 64 * (j))
#define XB_XGEN(j)  (2304 + 64 * (j))
#define XB_TOP      3328
#define XB_TOPGEN   3392
#define XCD_BAR_WORDS 3456
#define XB_SPIN_CAP (1u << 18)

__device__ __forceinline__ unsigned xb_ld(unsigned* p)              { return __hip_atomic_load(p, __ATOMIC_RELAXED, __HIP_MEMORY_SCOPE_AGENT); }
__device__ __forceinline__ unsigned xb_add(unsigned* p, unsigned v) { return __hip_atomic_fetch_add(p, v, __ATOMIC_RELAXED, __HIP_MEMORY_SCOPE_AGENT); }
__device__ __forceinline__ unsigned xb_xcc_id() { return (unsigned)__builtin_amdgcn_s_getreg((3 << 11) | 20) & 0xFu; }
#define XB_SPIN(cond, bar) do { unsigned _sp = 0; while (cond) { __builtin_amdgcn_s_sleep(1); \
    if ((++_sp & 255u) == 0u) { if (xb_ld(&(bar)[XB_TMO])) break; if (_sp > XB_SPIN_CAP) { atomicAdd(&(bar)[XB_TMO], 1u); break; } } } } while (0)

struct XcdBarrier {
    unsigned* bar; unsigned x;
    volatile LAS unsigned* st;
};

__device__ __forceinline__ XcdBarrier xcd_barrier_post(unsigned* bar, volatile LAS unsigned* st) {
    XcdBarrier b; b.bar = bar; b.x = xb_xcc_id(); b.st = st;
    if (threadIdx.x == 0) (void)xb_add(&bar[XB_XCNT(b.x)], 1u);
    return b;
}
__device__ __forceinline__ void xcd_barrier_complete(unsigned* bar, unsigned x, unsigned& nloc, unsigned& nx) {
    const unsigned G = gridDim.x * gridDim.y * gridDim.z;
    unsigned sum, cnt, mine, sp = 0u;
    for (;;) {
        sum = 0u; cnt = 0u; mine = 0u;
#pragma unroll
        for (unsigned j = 0; j < 16; ++j) { const unsigned c = xb_ld(&bar[XB_XCNT(j)]); sum += c; cnt += (c > 0u) ? 1u : 0u; mine = (j == x) ? c : mine; }
        if (sum == G) break;
        __builtin_amdgcn_s_sleep(1);
        if ((++sp & 255u) == 0u) { if (xb_ld(&bar[XB_TMO])) break; if (sp > XB_SPIN_CAP) { atomicAdd(&bar[XB_TMO], 1u); break; } }
    }
    nloc = mine > 0u ? mine : 1u; nx = cnt > 0u ? cnt : 1u;
}

__device__ __forceinline__ void xcd_barrier(const XcdBarrier& b) {
    asm volatile("s_waitcnt vmcnt(0)" ::: "memory");
    __syncthreads();
    if (threadIdx.x == 0) {
        unsigned* bar = b.bar;
        __builtin_amdgcn_s_waitcnt(0);
        unsigned nloc = b.st[0], nx = b.st[1];
        if (nloc == 0u) { xcd_barrier_complete(bar, b.x, nloc, nx); b.st[0] = nloc; b.st[1] = nx; }
        const unsigned old = xb_add(&bar[XB_XSUB(b.x)], 1u);
        const unsigned gen = old / nloc;
        if (old + 1u == (gen + 1u) * nloc) {
            __builtin_amdgcn_fence(__ATOMIC_RELEASE, "agent");
            asm volatile("s_waitcnt vmcnt(0)" ::: "memory");
            const unsigned og = xb_add(&bar[XB_TOP], 1u);
            const unsigned tg = og / nx;
            if (og + 1u == (tg + 1u) * nx) xb_add(&bar[XB_TOPGEN], 1u);
            else XB_SPIN(xb_ld(&bar[XB_TOPGEN]) == tg, bar);
            __builtin_amdgcn_fence(__ATOMIC_ACQUIRE, "agent");
            xb_add(&bar[XB_XGEN(b.x)], 1u);
            asm volatile("s_waitcnt vmcnt(0)" ::: "memory");
        } else {
            XB_SPIN(xb_ld(&bar[XB_XGEN(b.x)]) == gen, bar);
            __builtin_amdgcn_fence(__ATOMIC_ACQUIRE, "agent");
            asm volatile("s_waitcnt vmcnt(0)" ::: "memory");
        }
    }
    __syncthreads();
}

struct Args { const void* in[24]; float* out; unsigned char* ws; int lo, hi; };

__host__ __device__ constexpr int mixer_inner_phases(int kind) { return kind == 0 ? 4 : (kind == 1 ? 1 : 4); }
__host__ __device__ constexpr int total_phases() { int n = 1; for (int L = 0; L < DEPTH; ++L) n += 4 + 2 + mixer_inner_phases(L % 3); return n; }

__global__ void __launch_bounds__(512, 2) mega(Args args) {
    extern __shared__ __attribute__((aligned(16))) unsigned char lds[];
    cg::grid_group grid = cg::this_grid();
    volatile LAS unsigned* bst = (volatile LAS unsigned*)((LAS unsigned char*)lds + (LDS_BYTES - 64));
    if (threadIdx.x < 2) bst[threadIdx.x] = 0u;
    __syncthreads();
    const XcdBarrier xbar = xcd_barrier_post((unsigned*)args.ws, bst);
    bool again = false;
    for (int ph = args.lo; ph < args.hi; ++ph) {
        int type = 0, s = 0, L = 0;
        if (ph > 0) {
            int p = ph - 1;
            for (L = 0; L < DEPTH; ++L) { const int n = 6 + mixer_inner_phases(L % 3); if (p < n) break; p -= n; }
            const int inner = mixer_inner_phases(L % 3), kind = L % 3;
            if (p < 2) { type = 2 + p; s = 2 * L; }
            else if (p == 2) type = 5;
            else if (p < 3 + inner) { const int q = p - 3; type = kind == 0 ? (q == 0 ? 14 : (q == 1 ? 15 : 4 + q)) : (kind == 1 ? 8 : 9 + q); }
            else if (p == 3 + inner) type = 13;
            else { type = 2 + (p - 4 - inner); s = 2 * L + 1; }
        }
        int tid_ = threadIdx.x; asm volatile("" : "+v"(tid_));
        int G_ = gridDim.x, bx_ = blockIdx.x; asm volatile("" : "+s"(G_), "+s"(bx_));
        const int tid = tid_, lane = tid & 63, wid = __builtin_amdgcn_readfirstlane(tid >> 6);
        const int G = G_, bx = bx_;
        const int vcu = (G % 8 == 0) ? (bx % 8) * (G / 8) + bx / 8 : bx;
        const int gw = vcu * 8 + wid, NGW = G * 8;
        unsigned char* ws = args.ws; asm volatile("" : "+s"(ws));
        PG8_LAS unsigned char* ldsl = (PG8_LAS unsigned char*)lds;
        float* hout = args.out; asm volatile("" : "+s"(hout));
        bf16* HN = (bf16*)(ws + WS_HN);
        bf16* RB = (bf16*)(ws + WS_R);
        f32x2* tab = (f32x2*)(ws + WS_TAB);
        const int kind = L % 3, jj = L / 3;
        bf16* QN = RB + (size_t)T * 2560;
        bf16* KSb = QN + (size_t)T * 1024;
        bf16* KWb = KSb + (size_t)T * 256;
        bf16* KCH = (bf16*)(ws + WS_O32);
        bf16* VCH = KCH + (size_t)T * 256;
        float* Pk = (float*)(ws + WS_O32 + 32 * MiB);
        float* Pv = Pk + (size_t)8192 * 512;
        bf16* KC = (bf16*)(ws + WS_O32 + 64 * MiB);
        bf16* VC = (bf16*)(ws + WS_O32 + 65 * MiB);
        bf16* OVT = (bf16*)(ws + WS_BP + 65536);
        bf16* VST = (bf16*)(ws + WS_O32 + 68 * MiB);
        bf16* VWT = (bf16*)(ws + WS_O32 + 84 * MiB);
        switch (type) {
        case 0: {
            float* scr = (float*)lds + wid * (64 * 33);
            for (int mi = 0; mi < 28; ++mi) {
                const float* W; const float* nw = nullptr; int K, N, Npad, mode = 0; bf16* WT;
                if (mi < 8)       { nw = (const float*)args.in[2] + (size_t)mi * D; W = (const float*)args.in[3] + (size_t)mi * D * 2 * FF; K = D; N = 2 * FF; Npad = N; mode = 1; WT = (bf16*)(ws + WS_WGU) + (size_t)mi * 2 * FF * D; }
                else if (mi < 16) { const int i = mi - 8; W = (const float*)args.in[4] + (size_t)i * FF * D; K = FF; N = D; Npad = N; WT = (bf16*)(ws + WS_WDN) + (size_t)i * D * FF; }
                else if (mi < 18) { const int i = mi - 16; nw = (const float*)args.in[5] + (size_t)(3 * i) * D; W = (const float*)args.in[6] + (size_t)i * D * 4112; K = D; N = 4112; Npad = GDN_NPAD; WT = (bf16*)(ws + WS_WGI) + (size_t)i * GDN_NPAD * D; }
                else if (mi < 20) { const int i = mi - 18; W = (const float*)args.in[11] + (size_t)i * D * D; K = D; N = D; Npad = N; WT = (bf16*)(ws + WS_WGO) + (size_t)i * D * D; }
                else if (mi == 20) { nw = (const float*)args.in[5] + (size_t)1 * D; W = (const float*)args.in[12]; K = D; N = 3072; Npad = N; WT = (bf16*)(ws + WS_WSI); }
                else if (mi == 21) { W = (const float*)args.in[14]; K = D; N = D; Npad = N; WT = (bf16*)(ws + WS_WSO); }
                else if (mi == 22) { nw = (const float*)args.in[5] + (size_t)2 * D; W = (const float*)args.in[15]; K = D; N = 2608; Npad = NSA_NPAD; WT = (bf16*)(ws + WS_WNI); }
                else if (mi == 23) { W = (const float*)args.in[23]; K = D; N = D; Npad = N; WT = (bf16*)(ws + WS_WNO); }
                else { const int i = mi - 24, kd = i >> 1, hf = i & 1;
                    W = (const float*)args.in[19] + (size_t)kd * 2048 * 256 + (size_t)hf * 1024 * 256; K = 1024; N = 256; Npad = 256; WT = (bf16*)(ws + WS_WC1) + (size_t)kd * 512 * 1024 + (size_t)hf * 256 * 1024; }
                xpose_matrix(W, nw, K, N, Npad, WT, mode, scr, gw, NGW, lane);
            }
            {
                float* ss = (float*)(ws + WS_SS);
                const float* xin = (const float*)args.in[0];
                for (int m = gw; m < T; m += NGW) {
                    const f32x4* xr = (const f32x4*)(xin + (size_t)m * D) + lane; u32x2* o8 = (u32x2*)(HN + (size_t)m * D) + lane; float sq = 0.f;
#pragma unroll
                    for (int j = 0; j < 4; ++j) { const f32x4 v = xr[64 * j]; sq += (v.x * v.x + v.y * v.y) + (v.z * v.z + v.w * v.w); u32x2 o; o.x = pkbf(v.x, v.y); o.y = pkbf(v.z, v.w); o8[64 * j] = o; }
                    sq = wave_sum(sq); if (lane < 16) ss[(size_t)m * 16 + lane] = lane == 0 ? sq : 0.f;
                }
            }
            const int* positions = (const int*)args.in[1];
            for (int idx = bx * 512 + tid; idx < T * 32; idx += G * 512) {
                const int tk = idx >> 5, i = idx & 31;
                const float inv = 1.0f / exp2f((float)(2 * i) * (13.287712379549449f / 64.f));
                const float ang = (float)positions[tk] * inv;
                const double rev = (double)ang * 0.15915494309189535;
                const float fr = (float)(rev - rint(rev));
                f32x2 v; v.x = __builtin_amdgcn_cosf(fr); v.y = __builtin_amdgcn_sinf(fr);
                tab[idx] = v;
            }
            for (int idx = bx * 512 + tid; idx < 64 * 256; idx += G * 512) {
                const int sj = idx >> 8, i = idx & 255, q = i >> 2, rem = i & 3;
                OVT[idx] = (bf16)(rem < 3 ? (q == sj ? 0x3F80 : 0) : ((q == sj || q + 1 == sj) ? 0x3F00 : 0));
            }
            if (bx < 2 && tid < 256) {
                const float* pe = (const float*)args.in[18] + (size_t)bx * 2048;
                const float* w1 = (const float*)args.in[19] + (size_t)bx * 2048 * 256 + tid;
                float acc = ((const float*)args.in[20])[bx * 256 + tid];
                for (int k = 0; k < 2048; ++k) acc += pe[k] * w1[(size_t)k * 256];
                ((float*)(ws + WS_BP))[bx * 256 + tid] = acc;
            }
        } break;
        case 2: {
            const bf16* Ah = (s & 1) ? (const bf16*)(ws + WS_R + 192 * MiB) : HN;
            pg8::Gemm g{Ah, (const bf16*)(ws + WS_WGU) + (size_t)s * 2 * FF * D, T, 2 * FF, D}; pg8::StaticOrder SO; SO.init(T, 2 * FF, G, bx);
            float* rtab = (float*)(lds + 131072);
            rstd_table(rtab, (const float*)(ws + WS_SS) + (size_t)s * T * 16, SO, tid);
            pg8::EpiSwiGLU E{RB, rtab};
            pg8::gemm_phase<pg8::EpiSwiGLU, pg8::StaticOrder, true, true>(ldsl, g, SO, E, tid); } break;
        case 3: {
            pg8::Gemm g{RB, (const bf16*)(ws + WS_WDN) + (size_t)s * D * FF, T, D, FF}; pg8::StaticOrder SO; SO.init(T, D, G, bx);
            const int slot = (s & 1) ? (s < 7 ? s + 1 : 12) : 8 + (s >> 1);
            pg8::EpiResid<1> E{s == 0 ? (const float*)args.in[0] : hout, hout, HN, (float*)(ws + WS_SS) + (size_t)slot * T * 16};
            pg8::gemm_phase<pg8::EpiResid<1>, pg8::StaticOrder, true, true>(ldsl, g, SO, E, tid); } break;
        case 5: {
            const bf16* Wt; int Np, ldc, nmain, ldt, nvalid; float* tail;
            if (kind == 0) { Wt = (const bf16*)(ws + WS_WGI) + (size_t)jj * GDN_NPAD * D; Np = GDN_NPAD; ldc = 4096; nmain = 4096; tail = (float*)(ws + WS_AB); ldt = 16; nvalid = 4112; }
            else if (kind == 1) { Wt = (const bf16*)(ws + WS_WSI); Np = 3072; ldc = 3072; nmain = 3072; tail = (float*)(ws + WS_AB); ldt = 16; nvalid = 3072; }
            else { Wt = (const bf16*)(ws + WS_WNI); Np = NSA_NPAD; ldc = 2560; nmain = 2560; tail = (float*)(ws + WS_GT); ldt = 48; nvalid = 2608; }
            pg8::Gemm g{HN, Wt, T, Np, D}; pg8::StaticOrder SO; SO.init(T, Np, G, bx);
            float* rtab = (float*)(lds + 131072);
            rstd_table(rtab, (const float*)(ws + WS_SS) + (size_t)(8 + L) * T * 16, SO, tid);
            pg8::EpiProj E{RB, ldc, nmain, tail, ldt, nvalid, rtab};
            pg8::gemm_phase<pg8::EpiProj, pg8::StaticOrder, true, true>(ldsl, g, SO, E, tid); } break;
        case 14: phase_gdn_halo(RB, (bf16*)(ws + WS_HALO), vcu * 512 + tid, G * 512); break;
        case 15: phase_gdn_prep(lds, RB, (const bf16*)(ws + WS_HALO), (const float*)(ws + WS_AB), (const float*)args.in[7] + (size_t)jj * 4 * 3072, (const float*)args.in[8] + jj * 8, (const float*)args.in[9] + jj * 8,
                                HN, (bf16*)(ws + WS_O32 + 64 * MiB), (float*)(ws + WS_GL), bx, G, tid, wid, lane); break;
        case 6:
#ifndef DIS_SCAN
            phase_gdn_scan2(lds, RB, HN, (const bf16*)(ws + WS_O32 + 64 * MiB), (const float*)(ws + WS_GL), (bf16*)(ws + WS_O32), bx, G, tid, wid, lane);
#endif
            break;
        case 7:
#ifndef DIS_GPOST
            phase_gdn_post((const bf16*)(ws + WS_O32), RB, (const float*)args.in[10] + jj * 128, HN, gw, NGW, lane);
#endif
            break;
        case 8:
#ifndef DIS_SPOST
            phase_sc_post(RB, (const float*)args.in[13], HN, vcu * 512 + tid, G * 512);
#endif
            break;
        case 9:
#ifndef DIS_NPOST
            phase_nsa_post(lds, RB, (const float*)args.in[16], (const float*)args.in[17], tab, QN, KSb, KWb, KCH, VCH, VST, VWT, gw, NGW, wid, lane);
#endif
            break;
        case 10: {
            pg8::Gemm g{KCH, (const bf16*)(ws + WS_WC1), 8192, 512, 1024}; pg8::StaticOrder SO; SO.init(8192, 512, G, bx);
            pg8::Gemm g2{VCH, (const bf16*)(ws + WS_WC1) + (size_t)512 * 1024, 8192, 512, 1024};
            pg8::EpiF32 E{Pk, 512};
            if (bx >= G / 2) { g = g2; SO.init(8192, 512, G, bx - G / 2); E.C = Pv; }
            pg8::gemm_phase<pg8::EpiF32, pg8::StaticOrder, true, true>(ldsl, g, SO, E, tid); } break;
        case 11:
#ifndef DIS_CMP2
            phase_cmp2(lds, Pk, Pv, (const float*)(ws + WS_BP), (const float*)args.in[21], (const float*)args.in[22], (const float*)args.in[17], KC, VC, gw, NGW, wid, lane, tid);
#endif
            break;
        case 12:
#ifndef DIS_ATTN
            phase_nsa_attn(lds, QN, KSb, KWb, VST, VWT, KC, VC, OVT, (const float*)(ws + WS_GT), tab, HN, bx, G, tid, wid, lane);
#endif
            break;
        default: {
            const bf16* Wout = kind == 0 ? (const bf16*)(ws + WS_WGO) + (size_t)jj * D * D : (kind == 1 ? (const bf16*)(ws + WS_WSO) : (const bf16*)(ws + WS_WNO));
            pg8::Gemm g{HN, Wout, T, D, D}; pg8::StaticOrder SO; SO.init(T, D, G, bx);
            pg8::EpiResid<2> E{hout, hout, (bf16*)(ws + WS_R + 192 * MiB), (float*)(ws + WS_SS) + (size_t)(2 * L + 1) * T * 16};
            pg8::gemm_phase<pg8::EpiResid<2>, pg8::StaticOrder, true, true>(ldsl, g, SO, E, tid); } break;
        }
#ifdef REP_TYPE
        if (type == REP_TYPE && !again) { again = true; xcd_barrier(xbar); --ph; continue; }
        again = false;
#endif
        if (ph + 1 < args.hi) { if (ph == 0) grid.sync(); else xcd_barrier(xbar); }
    }
}

extern "C" void kernel_launch(void* const* d_in, const int* in_sizes, int n_in, void* d_out, int out_size, void* d_ws, size_t ws_size, hipStream_t stream) {
    static int grid = 0;
    if (grid == 0) {
        if (n_in != 24 || out_size != T * D || ws_size < WS_END2) { fprintf(stderr, "kernel_launch: unexpected shapes n_in %d out %d ws %zu (need %zu)\n", n_in, out_size, ws_size, (size_t)WS_END2); grid = -1; return; }
        int dev = 0, cus = 0, per_cu = 0;
        hipGetDevice(&dev); hipDeviceGetAttribute(&cus, hipDeviceAttributeMultiprocessorCount, dev);
        if (hipFuncSetAttribute((const void*)mega, hipFuncAttributeMaxDynamicSharedMemorySize, LDS_BYTES) != hipSuccess) { fprintf(stderr, "kernel_launch: hipFuncSetAttribute failed\n"); grid = -1; return; }
        if (hipOccupancyMaxActiveBlocksPerMultiprocessor(&per_cu, (const void*)mega, 512, LDS_BYTES) != hipSuccess || per_cu < 1) { fprintf(stderr, "kernel_launch: occupancy query says %d\n", per_cu); per_cu = 1; }
        (void)hipGetLastError();
        grid = cus;
    }
    if (grid < 0) return;
    Args a{};
    for (int i = 0; i < 24; ++i) a.in[i] = d_in[i];
    a.out = (float*)d_out; a.ws = (unsigned char*)d_ws;
    constexpr int NPH = total_phases();
#if MK_MULTI
    for (int p = 0; p < NPH; ++p) { a.lo = p; a.hi = p + 1; hipLaunchKernelGGL(mega, dim3(grid), dim3(512), LDS_BYTES, stream, a); }
#else
    a.lo = 0; a.hi = NPH;
    (void)hipMemsetAsync(d_ws, 0, 16384, stream);
    void* kargs[] = {&a};
    hipError_t e = hipLaunchCooperativeKernel((const void*)mega, dim3(grid), dim3(512), kargs, LDS_BYTES, stream);
    if (e != hipSuccess) fprintf(stderr, "cooperative launch failed: %s (grid %d)\n", hipGetErrorString(e), grid);
#endif
}
```

```cpp
#include <hip/hip_runtime.h>
#include <hip/hip_cooperative_groups.h>
#include <cstdio>
#include <cstdint>
namespace cg = cooperative_groups;
namespace pg8 {
#define PG8_LAS __attribute__((address_space(3)))
typedef unsigned short bf16_t;
typedef short bf16x8 __attribute__((ext_vector_type(8)));
typedef float f32x4 __attribute__((ext_vector_type(4)));
typedef unsigned u32x4 __attribute__((ext_vector_type(4)));
constexpr int BM = 256, BK = 64, HALF = 128, HTB = HALF * BK * 2  , STAGE_BYTES = 8 * HTB, NXCD = 8, WGM = 8;

__host__ __device__ __forceinline__ int lds_byte(int r, int c) { const int st = (r >> 4) * 2 + (c >> 5), rr = r & 15, cc = c & 31, ob = rr * 64 + cc * 2; return st * 1024 + (ob ^ (((ob >> 9) & 1) << 5)); }
__host__ __device__ __forceinline__ void stage_rc(int b, int& R, int& C) { const int st = b / 1024, sb = b % 1024, swz = sb ^ (((sb >> 9) & 1) << 5); R = (st >> 1) * 16 + swz / 64; C = (st & 1) * 32 + (swz % 64) / 2; }
__host__ __device__ __forceinline__ int perm32(int rho) { const int n = rho >> 4, i = rho & 15; return 8 * (i >> 2) + 4 * n + (i & 3); }

struct Unit { int pm, pn, ord; };
struct Gemm { const bf16_t* A; const bf16_t* Bt; int M, N, K; };

struct StaticOrder {
    int nM, nN, nwg, G, c;
    __host__ __device__ void init(int M, int N, int G_, int c_) { nM = M / BM; nN = N / BM; nwg = nM * nN; G = G_; c = c_; }
    __host__ __device__ bool next(int i, Unit& u) const {
        const long L = (long)i * G + c; if (L >= nwg) return false;
        int wgid = (int)L; { const int q = nwg / NXCD, r = nwg % NXCD, xcd = wgid % NXCD, off = wgid / NXCD; wgid = (xcd < r ? xcd * (q + 1) : r * (q + 1) + (xcd - r) * q) + off; }
        const int nig = WGM * nN, gid = wgid / nig, fm = gid * WGM, gsz = (nM - fm) < WGM ? (nM - fm) : WGM;
        u.pm = fm + ((wgid % nig) % gsz); u.pn = (wgid % nig) / gsz; u.ord = i; return true;
    }
    __device__ __forceinline__ void a_ready(const Unit&) const {}
    __device__ __forceinline__ void done(const Unit&) const {}
};
__device__ __forceinline__ unsigned cvt_pk_bf16(float lo, float hi) { unsigned r; asm volatile("v_cvt_pk_bf16_f32 %0, %1, %2" : "=v"(r) : "v"(lo), "v"(hi)); return r; }
template <class Epi, class Sched, bool ALIGN_EPI = false, bool SP2 = false>
__device__ __forceinline__ void gemm_phase(PG8_LAS unsigned char* lds, const Gemm g, const Sched& S, const Epi& E, const int tid) {
    const int wid = __builtin_amdgcn_readfirstlane(tid >> 6), lane = tid & 63, wr = wid >> 2, wc = wid & 3, fr = lane & 15, fq = lane >> 4;
    const int K = g.K, nt = K / BK;
    unsigned voffA[2], voffB[2];
#pragma unroll
    for (int i = 0; i < 2; ++i) { int R, C; stage_rc(tid * 16 + i * 8192, R, C); const int Rb = Epi::PERM ? ((R & ~31) + perm32(R & 31)) : R;
        voffA[i] = (unsigned)(R * K + C) * 2u; voffB[i] = (unsigned)(Rb * K + C) * 2u; }
    const size_t kstep = (size_t)(BK * 2);
    const size_t hstep = (size_t)HALF * K * 2;
    const size_t tstep = 2 * hstep;
    const unsigned ldsw = (unsigned)wid * 1024u;
    const int aoff = lds_byte(wr * 64 + fr, fq * 8), boff = lds_byte(wc * 32 + fr, fq * 8);
#define PG8_SA(b, h) (((b) * 2 + (h)) * HTB)
#define PG8_SB(b, h) ((4 + (b) * 2 + (h)) * HTB)
#define PG8_STAGE(bufoff, gbase, voff) do { _Pragma("unroll") for (int _i = 0; _i < 2; ++_i) \
        __builtin_amdgcn_global_load_lds((const unsigned*)((const char*)(gbase) + (voff)[_i]), (PG8_LAS unsigned*)(lds + (bufoff) + ldsw + _i * 8192), 16, 0, 0); } while (0)
#define PG8_LDA(dst, b, h) do { _Pragma("unroll") for (int m = 0; m < 4; ++m) _Pragma("unroll") for (int k = 0; k < 2; ++k) dst[m][k] = *(const PG8_LAS bf16x8*)(lds + PG8_SA(b, h) + aoff + m * 2048 + k * 1024); } while (0)
#define PG8_LDB(dst, b, h) do { _Pragma("unroll") for (int n = 0; n < 2; ++n) _Pragma("unroll") for (int k = 0; k < 2; ++k) dst[n][k] = *(const PG8_LAS bf16x8*)(lds + PG8_SB(b, h) + boff + n * 2048 + k * 1024); } while (0)
#define PG8_MMA(ai, bj, At, Bt) do { __builtin_amdgcn_s_setprio(1); _Pragma("unroll") for (int m = 0; m < 4; ++m) _Pragma("unroll") for (int n = 0; n < 2; ++n) _Pragma("unroll") for (int k = 0; k < 2; ++k) \
        acc[ai][bj][m][n] = __builtin_amdgcn_mfma_f32_16x16x32_bf16(Bt[n][k], At[m][k], acc[ai][bj][m][n], 0, 0, 0); __builtin_amdgcn_s_setprio(0); } while (0)
#define PG8_WAIT_V(n) asm volatile("s_waitcnt vmcnt(" #n ")" ::: "memory")
#define PG8_WAIT_L(n) asm volatile("s_waitcnt lgkmcnt(" #n ")" ::: "memory")
#define PG8_BAR __builtin_amdgcn_s_barrier()
#define PG8_SCHED __builtin_amdgcn_sched_barrier(0)
    Unit cur, nxt; int ui = 0;
    if (!S.next(0, cur)) return;
    f32x4 acc[2][2][4][2];
#pragma unroll
    for (int a = 0; a < 2; ++a)
#pragma unroll
        for (int b = 0; b < 2; ++b)
#pragma unroll
            for (int m = 0; m < 4; ++m)
#pragma unroll
                for (int n = 0; n < 2; ++n) acc[a][b][m][n] = (f32x4){0.f, 0.f, 0.f, 0.f};
    bf16x8 At[4][2], B0[2][2], B1[2][2];
    const char* cA = (const char*)g.A + (size_t)cur.pm * tstep; const char* cB = (const char*)g.Bt + (size_t)cur.pn * tstep;
    S.a_ready(cur);
    if constexpr (SP2) {
        PG8_STAGE(PG8_SB(0, 0), cB, voffB); PG8_STAGE(PG8_SB(0, 1), cB + hstep, voffB); PG8_STAGE(PG8_SA(0, 0), cA, voffA); PG8_STAGE(PG8_SA(0, 1), cA + hstep, voffA);
        if (wr == 1) PG8_BAR;
        PG8_WAIT_V(2); PG8_BAR;
        PG8_STAGE(PG8_SB(1, 0), cB + kstep, voffB); PG8_STAGE(PG8_SA(1, 0), cA + kstep, voffA); PG8_STAGE(PG8_SB(1, 1), cB + hstep + kstep, voffB);
        PG8_WAIT_V(6); PG8_BAR;
    } else {
        PG8_STAGE(PG8_SB(0, 0), cB, voffB); PG8_STAGE(PG8_SA(0, 0), cA, voffA); PG8_STAGE(PG8_SB(0, 1), cB + hstep, voffB); PG8_STAGE(PG8_SA(0, 1), cA + hstep, voffA);
        if (wr == 1) PG8_BAR;
        PG8_WAIT_V(4); PG8_BAR;
        PG8_STAGE(PG8_SB(1, 0), cB + kstep, voffB); PG8_STAGE(PG8_SA(1, 0), cA + kstep, voffA); PG8_STAGE(PG8_SB(1, 1), cB + hstep + kstep, voffB);
        PG8_WAIT_V(6); PG8_BAR;
    }
    for (;;) {
        const bool has_next = S.next(ui + 1, nxt);
        const char* nA = has_next ? (const char*)g.A + (size_t)nxt.pm * tstep : cA; const char* nB = has_next ? (const char*)g.Bt + (size_t)nxt.pn * tstep : cB;
        for (int t = 0; t < nt; t += 2) {
            const bool last = (t == nt - 2);
            const char* a1 = cA + (size_t)(t + 1) * kstep;
            const char* a2 = last ? nA : cA + (size_t)(t + 2) * kstep; const char* b2 = last ? nB : cB + (size_t)(t + 2) * kstep;
            const char* a3 = a2 + kstep; const char* b3 = b2 + kstep;
            if (last && has_next) S.a_ready(nxt);
            if constexpr (SP2) {
            PG8_LDB(B0, 0, 0); PG8_LDB(B1, 0, 1); PG8_SCHED; PG8_LDA(At, 0, 0); PG8_STAGE(PG8_SA(1, 1), a1 + hstep, voffA);
            PG8_WAIT_V(8); PG8_WAIT_L(0); PG8_BAR; PG8_MMA(0, 0, At, B0); PG8_MMA(0, 1, At, B1); PG8_BAR; PG8_SCHED;
            PG8_LDA(At, 0, 1); PG8_STAGE(PG8_SB(0, 0), b2, voffB); PG8_STAGE(PG8_SB(0, 1), b2 + hstep, voffB); PG8_STAGE(PG8_SA(0, 0), a2, voffA);
            PG8_WAIT_V(8); PG8_WAIT_L(0); PG8_BAR; PG8_MMA(1, 0, At, B0); PG8_MMA(1, 1, At, B1); PG8_BAR; PG8_SCHED;
            PG8_LDB(B0, 1, 0); PG8_LDB(B1, 1, 1); PG8_SCHED; PG8_LDA(At, 1, 0); PG8_STAGE(PG8_SA(0, 1), a2 + hstep, voffA);
            PG8_WAIT_V(8); PG8_WAIT_L(0); PG8_BAR; PG8_MMA(0, 0, At, B0); PG8_MMA(0, 1, At, B1); PG8_BAR; PG8_SCHED;
            PG8_LDA(At, 1, 1); PG8_STAGE(PG8_SB(1, 0), b3, voffB); PG8_STAGE(PG8_SB(1, 1), b3 + hstep, voffB); PG8_STAGE(PG8_SA(1, 0), a3, voffA);
            PG8_WAIT_V(8); PG8_WAIT_L(0); PG8_BAR; PG8_MMA(1, 0, At, B0); PG8_MMA(1, 1, At, B1); PG8_BAR; PG8_SCHED;
            } else {
            PG8_LDB(B0, 0, 0); PG8_SCHED; PG8_LDA(At, 0, 0); PG8_STAGE(PG8_SA(1, 1), a1 + hstep, voffA);
            PG8_WAIT_L(8); PG8_BAR; PG8_WAIT_L(0); PG8_MMA(0, 0, At, B0); PG8_BAR; PG8_SCHED;
            PG8_LDB(B1, 0, 1); PG8_STAGE(PG8_SB(0, 0), b2, voffB);
            PG8_BAR; PG8_WAIT_L(0); PG8_MMA(0, 1, At, B1); PG8_BAR;
            PG8_LDA(At, 0, 1); PG8_STAGE(PG8_SA(0, 0), a2, voffA);
            PG8_BAR; PG8_WAIT_L(0); PG8_MMA(1, 0, At, B0); PG8_BAR; PG8_SCHED;
            PG8_STAGE(PG8_SB(0, 1), b2 + hstep, voffB);
            PG8_WAIT_V(6); PG8_BAR; PG8_MMA(1, 1, At, B1); PG8_BAR;
            PG8_LDB(B0, 1, 0); PG8_SCHED; PG8_LDA(At, 1, 0); PG8_STAGE(PG8_SA(0, 1), a2 + hstep, voffA);
            PG8_WAIT_L(8); PG8_BAR; PG8_WAIT_L(0); PG8_MMA(0, 0, At, B0); PG8_BAR; PG8_SCHED;
            PG8_LDB(B1, 1, 1); PG8_STAGE(PG8_SB(1, 0), b3, voffB);
            PG8_BAR; PG8_WAIT_L(0); PG8_MMA(0, 1, At, B1); PG8_BAR;
            PG8_LDA(At, 1, 1); PG8_STAGE(PG8_SA(1, 0), a3, voffA);
            PG8_BAR; PG8_WAIT_L(0); PG8_MMA(1, 0, At, B0); PG8_BAR; PG8_SCHED;
            PG8_STAGE(PG8_SB(1, 1), b3 + hstep, voffB);
            PG8_WAIT_V(6); PG8_BAR; PG8_MMA(1, 1, At, B1); PG8_BAR;
            }
        }
        if constexpr (ALIGN_EPI) { if (wr == 0) PG8_BAR; }
        if constexpr (!Epi::AFTER_DRAIN) { E(acc, cur, wr, wc, fr, fq); S.done(cur); }
        if (!has_next) break;
#pragma unroll
        for (int a = 0; a < 2; ++a)
#pragma unroll
            for (int b = 0; b < 2; ++b)
#pragma unroll
                for (int m = 0; m < 4; ++m)
#pragma unroll
                    for (int n = 0; n < 2; ++n) acc[a][b][m][n] = (f32x4){0.f, 0.f, 0.f, 0.f};
        cur = nxt; cA = nA; cB = nB; ++ui;
        if constexpr (ALIGN_EPI) { if (wr == 1) PG8_BAR; }
    }
    PG8_WAIT_V(0);
    if constexpr (!ALIGN_EPI) { if (wr == 0) PG8_BAR; }
    PG8_BAR;
    if constexpr (Epi::AFTER_DRAIN) { E.fused(acc, cur, wr, wc, fr, fq, lds, wid, lane); S.done(cur); }
#undef PG8_SA
#undef PG8_SB
#undef PG8_STAGE
#undef PG8_LDA
#undef PG8_LDB
#undef PG8_MMA
#undef PG8_WAIT_V
#undef PG8_WAIT_L
#undef PG8_BAR
#undef PG8_SCHED
}
}

typedef unsigned short bf16;
typedef float f32x4 __attribute__((ext_vector_type(4)));
typedef float f32x2 __attribute__((ext_vector_type(2)));
typedef unsigned u32x4 __attribute__((ext_vector_type(4)));
typedef unsigned u32x2 __attribute__((ext_vector_type(2)));

#ifndef MK_MULTI
#define MK_MULTI 0
#endif

constexpr int Bn = 8, S = 4096, T = Bn * S, D = 1024, FF = 2816, DEPTH = 4;
constexpr float EPS = 1e-6f;
constexpr int GDN_NPAD = 4352, NSA_NPAD = 2816;
constexpr int LDS_BYTES = 147456;
constexpr size_t MiB = 1u << 20;
constexpr size_t WS_WGU = 1 * MiB;
constexpr size_t WS_WDN = WS_WGU + 88 * MiB;
constexpr size_t WS_WGI = WS_WDN + 44 * MiB;
constexpr size_t WS_WGO = WS_WGI + 17 * MiB;
constexpr size_t WS_WSI = WS_WGO + 4 * MiB;
constexpr size_t WS_WSO = WS_WSI + 6 * MiB;
constexpr size_t WS_WNI = WS_WSO + 2 * MiB;
constexpr size_t WS_WNO = WS_WNI + 6 * MiB;
constexpr size_t WS_WC1 = WS_WNO + 2 * MiB;
constexpr size_t WS_TAB = WS_WC1 + 2 * MiB;
constexpr size_t WS_HN  = 184 * MiB;
constexpr size_t WS_R   = WS_HN + 64 * MiB;
constexpr size_t WS_O32 = WS_R + 256 * MiB;
constexpr size_t WS_SM  = WS_O32 + 128 * MiB;
constexpr size_t WS_AB  = WS_SM;
constexpr size_t WS_GT  = WS_SM + 2 * MiB;
constexpr size_t WS_BP  = WS_SM + 8 * MiB;
constexpr size_t WS_END = WS_SM + 9 * MiB;
static_assert(WS_TAB + 8 * MiB <= WS_HN, "ws map");

__device__ __forceinline__ float bf2f(unsigned v) { return __uint_as_float(v << 16); }
__device__ __forceinline__ unsigned f2bf(float f) { unsigned u = __float_as_uint(f); return (u + 0x7fffu + ((u >> 16) & 1u)) >> 16; }
__device__ __forceinline__ unsigned pk2(float lo, float hi) { return f2bf(lo) | (f2bf(hi) << 16); }
#define MFMA32(a, b, c) __builtin_amdgcn_mfma_f32_32x32x16_bf16((a), (b), (c), 0, 0, 0)
typedef short bf16x8v __attribute__((ext_vector_type(8)));
typedef float f32x16 __attribute__((ext_vector_type(16)));
typedef __bf16 bf16v2 __attribute__((ext_vector_type(2)));
__device__ __forceinline__ unsigned pkbf(float a, float b) { f32x2 v = {a, b}; return __builtin_bit_cast(unsigned, __builtin_convertvector(v, bf16v2)); }
__device__ __forceinline__ int lane_opq() { int l = (int)__builtin_amdgcn_mbcnt_hi(~0u, __builtin_amdgcn_mbcnt_lo(~0u, 0u)); asm volatile("" : "+v"(l)); return l; }
__device__ __forceinline__ float xshfl(float v, int m) { return __int_as_float(__builtin_amdgcn_ds_bpermute((lane_opq() ^ m) << 2, __float_as_int(v))); }
__device__ __forceinline__ float xshfl_up(float v, int o) { return __int_as_float(__builtin_amdgcn_ds_bpermute((lane_opq() - o) << 2, __float_as_int(v))); }
__device__ __forceinline__ float wave_sum(float v) {
#pragma unroll
    for (int o = 1; o < 64; o <<= 1) v += xshfl(v, o);
    return v;
}
__device__ __forceinline__ float wave_max(float v) {
#pragma unroll
    for (int o = 1; o < 64; o <<= 1) v = fmaxf(v, xshfl(v, o));
    return v;
}
__device__ __forceinline__ float row_sum16(float v) {
    v += __uint_as_float((unsigned)__builtin_amdgcn_update_dpp(0, (int)__float_as_uint(v), 0x128, 0xf, 0xf, false));
    v += __uint_as_float((unsigned)__builtin_amdgcn_update_dpp(0, (int)__float_as_uint(v), 0x124, 0xf, 0xf, false));
    v += __uint_as_float((unsigned)__builtin_amdgcn_update_dpp(0, (int)__float_as_uint(v), 0x122, 0xf, 0xf, false));
    v += __uint_as_float((unsigned)__builtin_amdgcn_update_dpp(0, (int)__float_as_uint(v), 0x121, 0xf, 0xf, false));
    return v;
}
__device__ __forceinline__ float sigmoidf_(float x) { return 1.f / (1.f + __expf(-x)); }
__device__ __forceinline__ float siluf_(float x) { return x * __builtin_amdgcn_rcpf(1.f + __expf(-x)); }
#define LDS_BAR() do { asm volatile("s_waitcnt lgkmcnt(0)" ::: "memory"); __builtin_amdgcn_s_barrier(); asm volatile("" ::: "memory"); } while (0)
#define WAVE_SYNC() do { asm volatile("s_waitcnt lgkmcnt(0)" ::: "memory"); __builtin_amdgcn_wave_barrier(); } while (0)

__device__ __forceinline__ float row_rstd(const float* ssq, size_t row) {
    const f32x4* p = (const f32x4*)(ssq + row * 16); const f32x4 a = p[0], b = p[1], c = p[2], d = p[3];
    const float t = ((a.x + a.y) + (a.z + a.w)) + ((b.x + b.y) + (b.z + b.w)) + ((c.x + c.y) + (c.z + c.w)) + ((d.x + d.y) + (d.z + d.w));
    return 1.f / sqrtf(t * (1.f / D) + EPS);
}
namespace pg8 {
struct EpiSwiGLU {
    static constexpr bool PERM = true, AFTER_DRAIN = false;
    bf16_t* O; const float* ssq;
    __device__ __forceinline__ void operator()(const f32x4 (&acc)[2][2][4][2], const Unit& u, int wr, int wc, int fr, int fq) const {
        const int row0 = u.pm * BM + wr * 64 + fr, col0 = u.pn * HALF + wc * 32 + 8 * fq;
#pragma unroll
        for (int ai = 0; ai < 2; ++ai)
#pragma unroll
            for (int m = 0; m < 4; ++m) {
                bf16_t* rowp = O + (size_t)(row0 + ai * HALF + m * 16) * FF + col0;
                const float rs = ssq[u.ord * 256 + wr * 64 + fr + ai * HALF + m * 16];
                const f32x2 rs2 = {rs, rs}, nl2 = {-1.4426950408889634f, -1.4426950408889634f}, one2 = {1.f, 1.f};
                unsigned wv[4];
#pragma unroll
                for (int n = 0; n < 2; ++n)
#pragma unroll
                    for (int hf = 0; hf < 2; ++hf) {
                        const f32x2 g = (f32x2){acc[ai][0][m][n][2 * hf], acc[ai][0][m][n][2 * hf + 1]} * rs2;
                        const f32x2 uu = (f32x2){acc[ai][1][m][n][2 * hf], acc[ai][1][m][n][2 * hf + 1]} * rs2;
                        const f32x2 t = g * nl2;
                        f32x2 e; e.x = __builtin_amdgcn_exp2f(t.x); e.y = __builtin_amdgcn_exp2f(t.y);
                        const f32x2 d = e + one2;
                        f32x2 rc; rc.x = __builtin_amdgcn_rcpf(d.x); rc.y = __builtin_amdgcn_rcpf(d.y);
                        const f32x2 v = (g * rc) * uu;
                        wv[2 * n + hf] = cvt_pk_bf16(v.x, v.y);
                    }
                u32x4 w; w.x = wv[0]; w.y = wv[1]; w.z = wv[2]; w.w = wv[3];
                *(u32x4*)rowp = w;
            }
    }
};
template <int SC2> struct EpiResid {
    static constexpr bool PERM = true, AFTER_DRAIN = false;
    const float* base; float* out; bf16_t* HB; float* ssq;
    __device__ __forceinline__ void operator()(const f32x4 (&acc)[2][2][4][2], const Unit& u, int wr, int wc, int fr, int fq) const {
        constexpr float scale = 0.5f * SC2;
        const int row0 = u.pm * BM + wr * 64 + fr, col0 = u.pn * BM + wc * 32 + 8 * fq;
#pragma unroll
        for (int ai = 0; ai < 2; ++ai)
#pragma unroll
            for (int m = 0; m < 4; ++m) {
                const size_t off = (size_t)(row0 + ai * HALF + m * 16) * D + col0;
                float sq = 0.f;
#pragma unroll
                for (int bj = 0; bj < 2; ++bj) {
                    const f32x4 b0 = *(const f32x4*)(base + off + bj * HALF), b1 = *(const f32x4*)(base + off + bj * HALF + 4);
                    const f32x4 o0 = b0 + acc[ai][bj][m][0] * scale, o1 = b1 + acc[ai][bj][m][1] * scale;
                    *(f32x4*)(out + off + bj * HALF) = o0; *(f32x4*)(out + off + bj * HALF + 4) = o1;
                    { u32x4 w; w.x = cvt_pk_bf16(o0[0], o0[1]); w.y = cvt_pk_bf16(o0[2], o0[3]); w.z = cvt_pk_bf16(o1[0], o1[1]); w.w = cvt_pk_bf16(o1[2], o1[3]);
                        *(u32x4*)(HB + off + bj * HALF) = w;
                        sq += ((o0[0] * o0[0] + o0[1] * o0[1]) + (o0[2] * o0[2] + o0[3] * o0[3])) + ((o1[0] * o1[0] + o1[1] * o1[1]) + (o1[2] * o1[2] + o1[3] * o1[3])); }
                }
                { sq += xshfl(sq, 16); sq += xshfl(sq, 32); if (fq == 0) ssq[(size_t)(row0 + ai * HALF + m * 16) * 16 + u.pn * 4 + wc] = sq; }
                if (m == 3) asm volatile("" ::: "memory");
            }
    }
};
struct EpiProj {
    static constexpr bool PERM = true, AFTER_DRAIN = false;
    bf16_t* O; int ldc; int nmain; float* tail; int ldt; int nvalid; const float* ssq; bf16_t* halo; int halo_on;
    __device__ __forceinline__ void operator()(const f32x4 (&acc)[2][2][4][2], const Unit& u, int wr, int wc, int fr, int fq) const {
        const int row0 = u.pm * BM + wr * 64 + fr, colt = u.pn * BM, col0 = colt + wc * 32 + 8 * fq;
        if (colt + BM <= nmain) {
#pragma unroll
            for (int ai = 0; ai < 2; ++ai)
#pragma unroll
                for (int m = 0; m < 4; ++m) {
                    bf16_t* rowp = O + (size_t)(row0 + ai * HALF + m * 16) * ldc + col0;
                    const float rs = ssq[u.ord * 256 + wr * 64 + fr + ai * HALF + m * 16];
#pragma unroll
                    for (int bj = 0; bj < 2; ++bj) { const f32x4 v0 = acc[ai][bj][m][0] * rs, v1 = acc[ai][bj][m][1] * rs;
                        u32x4 w; w.x = cvt_pk_bf16(v0[0], v0[1]); w.y = cvt_pk_bf16(v0[2], v0[3]); w.z = cvt_pk_bf16(v1[0], v1[1]); w.w = cvt_pk_bf16(v1[2], v1[3]);
                        *(u32x4*)(rowp + bj * HALF) = w;
                        if (halo_on && m == 3 && fr >= 13 && u.pn < 12) {
                            const int row = row0 + ai * HALF + m * 16, n1 = ((row & (S - 1)) >> 6) + 1;
                            if (n1 < 64) *(u32x4*)(halo + (size_t)(((row >> 12) * 64 + n1) * 3 + (fr - 13)) * 3072 + col0 + bj * HALF) = w;
                        } }
                }
        } else {
#pragma unroll
            for (int ai = 0; ai < 2; ++ai)
#pragma unroll
                for (int m = 0; m < 4; ++m) {
                    const size_t row = (size_t)(row0 + ai * HALF + m * 16);
                    const float rs = ssq[u.ord * 256 + wr * 64 + fr + ai * HALF + m * 16];
#pragma unroll
                    for (int bj = 0; bj < 2; ++bj)
#pragma unroll
                        for (int n = 0; n < 2; ++n)
#pragma unroll
                            for (int j = 0; j < 4; ++j) { const int col = col0 + bj * HALF + 4 * n + j; if (col >= nmain && col < nvalid) tail[row * ldt + (col - nmain)] = acc[ai][bj][m][n][j] * rs; }
                }
        }
    }
};
struct EpiF32 {
    static constexpr bool PERM = false, AFTER_DRAIN = false;
    float* C; int ldc;
    __device__ __forceinline__ void operator()(const f32x4 (&acc)[2][2][4][2], const Unit& u, int wr, int wc, int fr, int fq) const {
        const int row0 = u.pm * BM + wr * 64 + fr, col0 = u.pn * BM + wc * 32 + 4 * fq;
#pragma unroll
        for (int ai = 0; ai < 2; ++ai)
#pragma unroll
            for (int m = 0; m < 4; ++m) {
                float* rowp = C + (size_t)(row0 + ai * HALF + m * 16) * ldc + col0;
#pragma unroll
                for (int bj = 0; bj < 2; ++bj)
#pragma unroll
                    for (int n = 0; n < 2; ++n) *(f32x4*)(rowp + bj * HALF + n * 16) = acc[ai][bj][m][n];
            }
    }
};
}

template <class Sched>
__device__ __forceinline__ void rstd_table(float* tab, const float* ssq, const Sched& SO, int tid) {
    pg8::Unit u;
    int nu = 0; while (SO.next(nu, u)) ++nu;
    for (int k0 = 0; k0 < nu * 256; k0 += 512 * 3) {
        float t3[3];
#pragma unroll
        for (int k = 0; k < 3; ++k) { const int idx = k0 + 512 * k + tid; t3[k] = 0.f; if (idx < nu * 256) { SO.next(idx >> 8, u); t3[k] = row_rstd(ssq, (size_t)u.pm * 256 + (idx & 255)); } }
#pragma unroll
        for (int k = 0; k < 3; ++k) { const int idx = k0 + 512 * k + tid; if (idx < nu * 256) tab[idx] = t3[k]; }
    }
    __syncthreads();
}
__device__ __forceinline__ void xpose_item(const float* W, const float* nw, int K, int N, bf16* WT, int rowbase, float* scr, int k0, int n0, int lane) {
    if (n0 + 32 <= N && (N & 3) == 0) {
        f32x4 v[8];
#pragma unroll
        for (int i = 0; i < 8; ++i) { v[i] = *(const f32x4*)(W + (size_t)(k0 + 8 * i + (lane >> 3)) * N + n0 + 4 * (lane & 7)); if (nw) v[i] *= nw[k0 + 8 * i + (lane >> 3)]; }
#pragma unroll
        for (int i = 0; i < 8; ++i) { float* d = scr + (8 * i + (lane >> 3)) * 33 + 4 * (lane & 7); d[0] = v[i].x; d[1] = v[i].y; d[2] = v[i].z; d[3] = v[i].w; }
    } else {
#pragma unroll 8
        for (int i = 0; i < 32; ++i) { const int kk = 2 * i + (lane >> 5), n = n0 + (lane & 31); scr[kk * 33 + (lane & 31)] = n < N ? W[(size_t)(k0 + kk) * N + n] * (nw ? nw[k0 + kk] : 1.f) : 0.f; }
    }
    WAVE_SYNC();
    const int c = lane & 7;
#pragma unroll
    for (int j = 0; j < 4; ++j) { const int n = (lane >> 3) + 8 * j; const float* s = scr + (8 * c) * 33 + n;
        u32x4 o; o.x = pk2(s[0 * 33], s[1 * 33]); o.y = pk2(s[2 * 33], s[3 * 33]); o.z = pk2(s[4 * 33], s[5 * 33]); o.w = pk2(s[6 * 33], s[7 * 33]);
        *(u32x4*)(WT + (size_t)(rowbase + n) * K + k0 + 8 * c) = o; }
    WAVE_SYNC();
}
__device__ __forceinline__ int xpose_rowbase(int mode, int n0) {
    return mode == 1 ? ((n0 < FF) ? ((n0 >> 7) * 256 + (n0 & 127)) : ((((n0 - FF) >> 7) * 256) + 128 + ((n0 - FF) & 127))) : n0;
}
__device__ __forceinline__ void xpose_matrix(const float* W, const float* nw, int K, int N, int Npad, bf16* WT, int mode, float* scr, int gw, int NGW, int lane) {
    const int nblk = Npad / 32, nitems = (K / 64) * nblk;
    float* scr2 = scr + 8 * 64 * 33;
    for (int it = gw; it < nitems; it += 2 * NGW) {
        const int itb = it + NGW;
        const int kbA = it / nblk, n0A = (it - kbA * nblk) * 32, kbB = itb / nblk, n0B = (itb - kbB * nblk) * 32;
        if (itb < nitems && n0A + 32 <= N && n0B + 32 <= N && (N & 3) == 0) {
            f32x4 va[8], vb[8];
#pragma unroll
            for (int i = 0; i < 8; ++i) { va[i] = *(const f32x4*)(W + (size_t)(kbA * 64 + 8 * i + (lane >> 3)) * N + n0A + 4 * (lane & 7)); vb[i] = *(const f32x4*)(W + (size_t)(kbB * 64 + 8 * i + (lane >> 3)) * N + n0B + 4 * (lane & 7)); }
            if (nw) {
#pragma unroll
                for (int i = 0; i < 8; ++i) { va[i] *= nw[kbA * 64 + 8 * i + (lane >> 3)]; vb[i] *= nw[kbB * 64 + 8 * i + (lane >> 3)]; }
            }
#pragma unroll
            for (int i = 0; i < 8; ++i) { float* d = scr + (8 * i + (lane >> 3)) * 33 + 4 * (lane & 7); d[0] = va[i].x; d[1] = va[i].y; d[2] = va[i].z; d[3] = va[i].w;
                float* e = scr2 + (8 * i + (lane >> 3)) * 33 + 4 * (lane & 7); e[0] = vb[i].x; e[1] = vb[i].y; e[2] = vb[i].z; e[3] = vb[i].w; }
            WAVE_SYNC();
            const int c = lane & 7, rbA = xpose_rowbase(mode, n0A), rbB = xpose_rowbase(mode, n0B);
#pragma unroll
            for (int j = 0; j < 4; ++j) { const int n = (lane >> 3) + 8 * j; const float* sa = scr + (8 * c) * 33 + n; const float* sb = scr2 + (8 * c) * 33 + n;
                u32x4 o; o.x = pk2(sa[0 * 33], sa[1 * 33]); o.y = pk2(sa[2 * 33], sa[3 * 33]); o.z = pk2(sa[4 * 33], sa[5 * 33]); o.w = pk2(sa[6 * 33], sa[7 * 33]);
                *(u32x4*)(WT + (size_t)(rbA + n) * K + kbA * 64 + 8 * c) = o;
                u32x4 q; q.x = pk2(sb[0 * 33], sb[1 * 33]); q.y = pk2(sb[2 * 33], sb[3 * 33]); q.z = pk2(sb[4 * 33], sb[5 * 33]); q.w = pk2(sb[6 * 33], sb[7 * 33]);
                *(u32x4*)(WT + (size_t)(rbB + n) * K + kbB * 64 + 8 * c) = q; }
            WAVE_SYNC();
        } else {
            xpose_item(W, nw, K, N, WT, xpose_rowbase(mode, n0A), scr, kbA * 64, n0A, lane);
            if (itb < nitems) xpose_item(W, nw, K, N, WT, xpose_rowbase(mode, n0B), scr, kbB * 64, n0B, lane);
        }
    }
}

__device__ __forceinline__ void phase_norm(const float* h, const float* w, bf16* out, int gw, int NGW, int lane) {
    f32x4 wv[4];
#pragma unroll
    for (int j = 0; j < 4; ++j) wv[j] = ((const f32x4*)w)[64 * j + lane];
    for (int m = gw; m < T; m += NGW) {
        const f32x4* xr = (const f32x4*)(h + (size_t)m * D) + lane;
        f32x4 v[4]; float s = 0.f;
#pragma unroll
        for (int j = 0; j < 4; ++j) { v[j] = xr[64 * j]; s += (v[j].x * v[j].x + v[j].y * v[j].y) + (v[j].z * v[j].z + v[j].w * v[j].w); }
        const float rstd = 1.f / sqrtf(wave_sum(s) * (1.f / D) + EPS);
        u32x2* o8 = (u32x2*)(out + (size_t)m * D) + lane;
#pragma unroll
        for (int j = 0; j < 4; ++j) { u32x2 o; o.x = pk2(v[j].x * rstd * wv[j].x, v[j].y * rstd * wv[j].y); o.y = pk2(v[j].z * rstd * wv[j].z, v[j].w * rstd * wv[j].w); o8[64 * j] = o; }
    }
}

__device__ __forceinline__ void phase_gdn_scan(unsigned char* lds, const bf16* proj, const float* ab, const float* convw, const float* A_log, const float* dt_bias,
                                               float* o32, int vblk, int nblk, int tid, int wid, int lane) {
    float* qs = (float*)lds;
    float* ks = qs + 64 * 128;
    float* vs = ks + 64 * 128;
    float* al = vs + 64 * 32;
    float* be = al + 64;
    float* qk = be + 64;
    float* os = qk + 64;
    bf16* raw = (bf16*)(os + 64 * 32);
    const int e = tid >> 4, dl = tid & 15;
    for (int item = vblk; item < 256; item += nblk) {
        const int bh = (item & 7) + 8 * (item >> 5), es = (item >> 3) & 3, b = bh >> 3, h = bh & 7;
        const float Ah = __expf(A_log[h]), dtb = dt_bias[h];
        const int isk = (tid >> 4) & 1, cg = tid & 15, cv = tid & 3;
        const int colqk = isk * 1024 + h * 128 + cg * 8, colv = 2048 + h * 128 + es * 32 + cv * 8;
        f32x4 wq[4][2], wv[4][2];
#pragma unroll
        for (int j = 0; j < 4; ++j) { wq[j][0] = *(const f32x4*)(convw + j * 3072 + colqk); wq[j][1] = *(const f32x4*)(convw + j * 3072 + colqk + 4);
                                      wv[j][0] = *(const f32x4*)(convw + j * 3072 + colv);  wv[j][1] = *(const f32x4*)(convw + j * 3072 + colv + 4); }
        f32x2 S2[4];
#pragma unroll
        for (int i = 0; i < 4; ++i) S2[i] = (f32x2){0.f, 0.f};
        u32x4 pre[5];
#define GDN_PREFETCH(T0) do { _Pragma("unroll") for (int k_ = 0; k_ < 5; ++k_) { const int idx_ = tid + 512 * k_; const int row_ = idx_ / 36, c_ = idx_ - row_ * 36; const int ts_ = (T0) - 3 + row_; \
            const int col_ = c_ < 16 ? h * 128 + c_ * 8 : (c_ < 32 ? 1024 + h * 128 + (c_ - 16) * 8 : 2048 + h * 128 + es * 32 + (c_ - 32) * 8); \
            pre[k_] = (u32x4){0u, 0u, 0u, 0u}; if (idx_ < 67 * 36 && ts_ >= 0) pre[k_] = *(const u32x4*)(proj + (size_t)(b * S + ts_) * 4096 + col_); } } while (0)
#define GDN_PARK() do { _Pragma("unroll") for (int k_ = 0; k_ < 5; ++k_) { const int idx_ = tid + 512 * k_; if (idx_ < 67 * 36) *(u32x4*)(raw + idx_ * 8) = pre[k_]; } } while (0)
#define GDN_CONV8(ROW0, C8, W, OUT) do { _Pragma("unroll") for (int i_ = 0; i_ < 8; ++i_) OUT[i_] = 0.f; _Pragma("unroll") for (int j_ = 0; j_ < 4; ++j_) { const u32x4 xv_ = *(const u32x4*)(raw + ((ROW0) + j_) * 288 + (C8) * 8); \
            OUT[0] += bf2f(xv_.x & 0xffffu) * W[j_][0].x; OUT[1] += bf2f(xv_.x >> 16) * W[j_][0].y; OUT[2] += bf2f(xv_.y & 0xffffu) * W[j_][0].z; OUT[3] += bf2f(xv_.y >> 16) * W[j_][0].w; \
            OUT[4] += bf2f(xv_.z & 0xffffu) * W[j_][1].x; OUT[5] += bf2f(xv_.z >> 16) * W[j_][1].y; OUT[6] += bf2f(xv_.w & 0xffffu) * W[j_][1].z; OUT[7] += bf2f(xv_.w >> 16) * W[j_][1].w; } \
            _Pragma("unroll") for (int i_ = 0; i_ < 8; ++i_) OUT[i_] = siluf_(OUT[i_]); } while (0)
#define GDN_CONVNORM(T0) do { \
            _Pragma("unroll") for (int it_ = 0; it_ < 4; ++it_) { const int tok_ = it_ * 16 + (tid >> 5); float y_[8]; GDN_CONV8(tok_, isk * 16 + cg, wq, y_); \
                float ss_ = (y_[0] * y_[0] + y_[1] * y_[1]) + (y_[2] * y_[2] + y_[3] * y_[3]) + (y_[4] * y_[4] + y_[5] * y_[5]) + (y_[6] * y_[6] + y_[7] * y_[7]); \
                ss_ = row_sum16(ss_); const float sc_ = (1.f / sqrtf(ss_ + EPS)) * (isk ? 1.f : 0.08838834764831845f); \
                float* d_ = (isk ? ks : qs) + tok_ * 128 + cg * 8; \
                _Pragma("unroll") for (int i_ = 0; i_ < 8; ++i_) y_[i_] *= sc_; \
                *(f32x4*)d_ = (f32x4){y_[0], y_[1], y_[2], y_[3]}; *(f32x4*)(d_ + 4) = (f32x4){y_[4], y_[5], y_[6], y_[7]}; \
                float dq_ = 0.f; _Pragma("unroll") for (int i_ = 0; i_ < 8; ++i_) dq_ += y_[i_] * xshfl(y_[i_], 16); \
                dq_ = row_sum16(dq_); if (isk == 0 && cg == 0) qk[tok_] = dq_; } \
            if (tid < 256) { const int tok_ = tid >> 2; float y_[8]; GDN_CONV8(tok_, 32 + cv, wv, y_); float* d_ = vs + tok_ * 32 + cv * 8; \
                *(f32x4*)d_ = (f32x4){y_[0], y_[1], y_[2], y_[3]}; *(f32x4*)(d_ + 4) = (f32x4){y_[4], y_[5], y_[6], y_[7]}; } \
            if (tid < 64) { const size_t tg_ = (size_t)(b * S + (T0) + tid); const float a_ = ab[tg_ * 16 + h] + dtb, bb_ = ab[tg_ * 16 + 8 + h]; \
                const float sp_ = a_ > 20.f ? a_ : __logf(1.f + __expf(a_)); al[tid] = __expf(-Ah * sp_); be[tid] = sigmoidf_(bb_); } } while (0)
        __syncthreads();
        GDN_PREFETCH(0); GDN_PARK();
        __syncthreads();
        GDN_CONVNORM(0);
        __syncthreads();
        for (int chunk = 0; chunk < S / 64; ++chunk) {
            const int t0 = chunk * 64;
            const bool more = chunk + 1 < S / 64;
            if (more) GDN_PREFETCH(t0 + 64);
            {
                const float* kp = ks + dl * 8; const float* qp = qs + dl * 8; const float* vp = vs + e;
                f32x4 nk0 = *(const f32x4*)kp, nk1 = *(const f32x4*)(kp + 4), nq0 = *(const f32x4*)qp, nq1 = *(const f32x4*)(qp + 4);
                float nv = vp[0], na = al[0], nb = be[0], nqk = qk[0];
                for (int t16 = 0; t16 < 4; ++t16) {
                    float ok = 0.f;
#pragma unroll 4
                    for (int i = 0; i < 16; ++i) {
                        const int tt = t16 * 16 + i, tn = (tt + 1) & 63;
                        const f32x2 K0 = {nk0.x, nk0.y}, K1 = {nk0.z, nk0.w}, K2 = {nk1.x, nk1.y}, K3 = {nk1.z, nk1.w};
                        const f32x2 Q0 = {nq0.x, nq0.y}, Q1 = {nq0.z, nq0.w}, Q2 = {nq1.x, nq1.y}, Q3 = {nq1.z, nq1.w};
                        const float v = nv, a = na, bt = nb, qkt = nqk;
                        nk0 = *(const f32x4*)(kp + tn * 128); nk1 = *(const f32x4*)(kp + tn * 128 + 4); nq0 = *(const f32x4*)(qp + tn * 128); nq1 = *(const f32x4*)(qp + tn * 128 + 4);
                        nv = vp[tn * 32]; na = al[tn]; nb = be[tn]; nqk = qk[tn];
                        f32x2 pa = K0 * S2[0], pb = K2 * S2[2], qa = Q0 * S2[0], qb = Q2 * S2[2];
                        pa = K1 * S2[1] + pa; pb = K3 * S2[3] + pb; qa = Q1 * S2[1] + qa; qb = Q3 * S2[3] + qb;
                        pa += pb; qa += qb;
                        float p = pa.x + pa.y, qS = qa.x + qa.y;
                        p = row_sum16(p); qS = row_sum16(qS);
                        const float vn = bt * (v - a * p);
                        const float o = a * qS + qkt * vn;
                        const f32x2 vn2 = {vn, vn}, a2 = {a, a};
                        S2[0] = S2[0] * a2 + K0 * vn2; S2[1] = S2[1] * a2 + K1 * vn2; S2[2] = S2[2] * a2 + K2 * vn2; S2[3] = S2[3] * a2 + K3 * vn2;
                        ok = (i == dl) ? o : ok;
                    }
                    os[(t16 * 16 + dl) * 32 + e] = ok;
                }
            }
            __syncthreads();
            { const int tok = tid >> 3, c4 = tid & 7;
              *(f32x4*)(o32 + (size_t)(b * S + t0 + tok) * D + h * 128 + es * 32 + c4 * 4) = *(const f32x4*)(os + tok * 32 + c4 * 4); }
            if (more) {
                GDN_PARK();
                __syncthreads();
                GDN_CONVNORM(t0 + 64);
            }
            __syncthreads();
        }
#undef GDN_PREFETCH
#undef GDN_PARK
#undef GDN_CONV8
#undef GDN_CONVNORM
    }
}

constexpr size_t WS_HALO = WS_END;
constexpr size_t WS_GL = WS_END + 10 * MiB;
constexpr size_t WS_SS = WS_GL + 1 * MiB;
constexpr size_t WS_END2 = WS_SS + 26 * MiB;

__device__ __forceinline__ void phase_gdn_halo(const bf16* proj, bf16* halo, int gtid, int NT) {
    for (int idx = gtid; idx < Bn * 64 * 3 * 384; idx += NT) {
        const int c = idx % 384, r3 = (idx / 384) % 3, bn = idx / (384 * 3), n = bn & 63, b = bn >> 6;
        u32x4 v = {0u, 0u, 0u, 0u};
        if (n > 0) v = *(const u32x4*)(proj + (size_t)(b * S + 64 * n - 3 + r3) * 4096 + c * 8);
        *(u32x4*)(halo + (size_t)(bn * 3 + r3) * 3072 + c * 8) = v;
    }
}

constexpr int GP_RAW = 0, GP_QB = 51456, GP_KB = GP_QB + 17408, GP_VB = GP_KB + 17408, GP_AM = GP_VB + 16384, GP_GC = GP_AM + 17408, GP_W = GP_GC + 1024;
__device__ __forceinline__ void phase_gdn_prep(unsigned char* lds, bf16* proj, const bf16* halo, const float* ab, const float* convw, const float* A_log, const float* dt_bias,
                                               bf16* KT, bf16* AT, float* GL, int vblk, int nblk, int tid, int wid, int lane) {
    bf16* raw = (bf16*)(lds + GP_RAW);
    bf16* wimg = (bf16*)(lds + GP_W);
    unsigned char* qb = lds + GP_QB;
    unsigned char* kb = lds + GP_KB;
    bf16* vb = (bf16*)(lds + GP_VB);
    float* Am = (float*)(lds + GP_AM);
    float* gcs = (float*)(lds + GP_GC);
    float* bes = gcs + 64;
    const int r = lane & 31, hh = lane >> 5;
    for (int item = vblk; item < Bn * 8 * 64; item += nblk) {
        const int n = item & 63, h = (item >> 6) & 7, b = item >> 9;
        const size_t tok0 = (size_t)b * S + 64 * n;
        LDS_BAR();
#define GP_RAWLOAD(ITEM, T0, NT) do { const int n_ = (ITEM) & 63, h_ = ((ITEM) >> 6) & 7, b_ = (ITEM) >> 9; const size_t tk0_ = (size_t)b_ * S + 64 * n_; \
        for (int idx = (T0); idx < 67 * 48; idx += (NT)) { const int row = idx / 48, c = idx - row * 48; \
            const int col = c < 16 ? h_ * 128 + c * 8 : (c < 32 ? 1024 + h_ * 128 + (c - 16) * 8 : 2048 + h_ * 128 + (c - 32) * 8); \
            u32x4 v = {0u, 0u, 0u, 0u}; if (row < 3) { if (n_ > 0) v = *(const u32x4*)(halo + (size_t)((b_ * 64 + n_) * 3 + row) * 3072 + col); } else v = *(const u32x4*)(proj + (tk0_ + row - 3) * 4096 + col); \
            *(u32x4*)(raw + row * 384 + c * 8) = v; } } while (0)
        if (item == vblk) GP_RAWLOAD(item, tid, 512);
        if (tid < 64) {
            const float a = ab[(tok0 + tid) * 16 + h] + dt_bias[h], bb = ab[(tok0 + tid) * 16 + 8 + h];
            const float sp = a > 20.f ? a : __logf(1.f + __expf(a));
            float g = -__expf(A_log[h]) * sp;
#pragma unroll
            for (int o = 1; o < 64; o <<= 1) { const float t_ = xshfl_up(g, o); if (lane >= o) g += t_; }
            const float be_ = sigmoidf_(bb);
            gcs[tid] = g; bes[tid] = be_; gcs[128 + tid] = be_; gcs[192 + tid] = be_ * __expf(g);
        }
        LDS_BAR();
        {
            const int isk = (tid >> 4) & 1, cg = tid & 15;
            const int colqk = isk * 1024 + h * 128 + cg * 8, colv = 2048 + h * 128 + cg * 8;
#define GP_WLOAD(COL, W) do { _Pragma("unroll") for (int j_ = 0; j_ < 4; ++j_) { W[j_][0] = *(const f32x4*)(convw + j_ * 3072 + (COL)); W[j_][1] = *(const f32x4*)(convw + j_ * 3072 + (COL) + 4); } } while (0)
#define GP_CONV8(ROW0, C8, W, OUT) do { f32x2 a_[4] = {{0.f, 0.f}, {0.f, 0.f}, {0.f, 0.f}, {0.f, 0.f}}; \
            _Pragma("unroll") for (int j_ = 0; j_ < 4; ++j_) { const u32x4 xv_ = *(const u32x4*)(raw + ((ROW0) + j_) * 384 + (C8) * 8); const f32x4 w0_ = W[j_][0], w1_ = W[j_][1]; \
                a_[0] += (f32x2){bf2f(xv_.x & 0xffffu), bf2f(xv_.x >> 16)} * (f32x2){w0_.x, w0_.y}; a_[1] += (f32x2){bf2f(xv_.y & 0xffffu), bf2f(xv_.y >> 16)} * (f32x2){w0_.z, w0_.w}; \
                a_[2] += (f32x2){bf2f(xv_.z & 0xffffu), bf2f(xv_.z >> 16)} * (f32x2){w1_.x, w1_.y}; a_[3] += (f32x2){bf2f(xv_.w & 0xffffu), bf2f(xv_.w >> 16)} * (f32x2){w1_.z, w1_.w}; } \
            _Pragma("unroll") for (int p_ = 0; p_ < 4; ++p_) { const f32x2 t_ = a_[p_] * (f32x2){-1.4426950408889634f, -1.4426950408889634f}; \
                f32x2 e_; e_.x = __builtin_amdgcn_exp2f(t_.x); e_.y = __builtin_amdgcn_exp2f(t_.y); e_ += (f32x2){1.f, 1.f}; \
                f32x2 r_; r_.x = __builtin_amdgcn_rcpf(e_.x); r_.y = __builtin_amdgcn_rcpf(e_.y); const f32x2 y_ = a_[p_] * r_; OUT[2 * p_] = y_.x; OUT[2 * p_ + 1] = y_.y; } } while (0)
            f32x4 wc_[4][2];
            GP_WLOAD(colqk, wc_);
#pragma unroll 1
            for (int it = 0; it < 4; ++it) {
                const int tk = it * 16 + (tid >> 5);
                float y[8]; GP_CONV8(tk, isk * 16 + cg, wc_, y);
                float ss = (y[0] * y[0] + y[1] * y[1]) + (y[2] * y[2] + y[3] * y[3]) + (y[4] * y[4] + y[5] * y[5]) + (y[6] * y[6] + y[7] * y[7]);
                ss = row_sum16(ss);
                const float sc = (1.f / sqrtf(ss + EPS)) * (isk ? 1.f : 0.08838834764831845f);
                u32x4 w; w.x = pkbf(y[0] * sc, y[1] * sc); w.y = pkbf(y[2] * sc, y[3] * sc); w.z = pkbf(y[4] * sc, y[5] * sc); w.w = pkbf(y[6] * sc, y[7] * sc);
                *(u32x4*)((isk ? kb : qb) + tk * 272 + cg * 16) = w;
            }
            GP_WLOAD(colv, wc_);
#pragma unroll 1
            for (int it = 0; it < 2; ++it) {
                const int tk = it * 32 + (tid >> 4);
                float y[8]; GP_CONV8(tk, 32 + cg, wc_, y);
                u32x4 w; w.x = pkbf(y[0], y[1]); w.y = pkbf(y[2], y[3]); w.z = pkbf(y[4], y[5]); w.w = pkbf(y[6], y[7]);
                *(u32x4*)(vb + tk * 128 + cg * 8) = w;
            }
#undef GP_CONV8
#undef GP_WLOAD
        }
        LDS_BAR();
        {
            const int prod = wid >> 2, tr = (wid >> 1) & 1, tc = wid & 1;
            f32x16 acc;
#pragma unroll
            for (int i = 0; i < 16; ++i) acc[i] = 0.f;
            if (tr >= tc) {
                const unsigned char* Ab = (prod ? qb : kb) + (32 * tr + r) * 272 + hh * 16;
                const unsigned char* Bb = kb + (32 * tc + r) * 272 + hh * 16;
#pragma unroll
                for (int ks = 0; ks < 8; ++ks) acc = MFMA32(*(const bf16x8v*)(Ab + ks * 32), *(const bf16x8v*)(Bb + ks * 32), acc);
            }
            const int j = 32 * tc + r; const float gj = gcs[j];
#pragma unroll
            for (int i_ = 0; i_ < 16; ++i_) {
                const int i = 32 * tr + (i_ & 3) + 8 * (i_ >> 2) + 4 * hh;
                const float dec = __expf(gcs[i] - gj);
                if (prod == 0) Am[i * 68 + j] = (j < i) ? bes[i] * acc[i_] * dec : 0.f;
                else AT[(size_t)item * 4096 + i * 64 + j] = (bf16)f2bf((j <= i) ? acc[i_] * dec : 0.f);
            }
        }
        LDS_BAR();
        int tid3 = tid; asm volatile("" : "+v"(tid3));
        if (tid3 < 256) {
            const int isw = tid3 >> 7, d = tid3 & 127;
            unsigned oam = GP_AM, orsc = GP_GC + 512 + isw * 256, ocol = (isw ? GP_KB : GP_VB) + d * 2;
            asm volatile("" : "+v"(oam), "+v"(orsc), "+v"(ocol));
            const float* Am_ = (const float*)(lds + oam); const float* rsc = (const float*)(lds + orsc); const unsigned char* col = lds + ocol;
            const int cstride = isw ? 272 : 256;
            float X[64];
#pragma clang loop unroll(full)
            for (int i = 0; i < 64; ++i) X[i] = 0.f;
#pragma clang loop unroll(full)
            for (int i = 0; i < 64; ++i) {
                f32x4 av = {0.f, 0.f, 0.f, 0.f};
#pragma clang loop unroll(full)
                for (int j4 = 0; j4 < 16; ++j4) { if (4 * j4 < i) { const f32x4 a4 = *(const f32x4*)(Am_ + i * 68 + 4 * j4);
                    const f32x4 x4 = {X[4 * j4], X[4 * j4 + 1], X[4 * j4 + 2], X[4 * j4 + 3]}; av += a4 * x4; } }
                X[i] = rsc[i] * bf2f(*(const bf16*)(col + i * cstride)) - ((av.x + av.y) + (av.z + av.w));
                asm volatile("" ::: "memory");
            }
            if (isw) {
#pragma unroll
                for (int i = 0; i < 64; ++i) wimg[i * 128 + d] = (bf16)f2bf(X[i]);
            } else {
                bf16* up = proj + (tok0 + (d >> 1)) * 4096 + 2048 + h * 128 + (d & 1) * 64;
#pragma unroll
                for (int i8 = 0; i8 < 8; ++i8) { u32x4 w; w.x = pkbf(X[8 * i8], X[8 * i8 + 1]); w.y = pkbf(X[8 * i8 + 2], X[8 * i8 + 3]); w.z = pkbf(X[8 * i8 + 4], X[8 * i8 + 5]); w.w = pkbf(X[8 * i8 + 6], X[8 * i8 + 7]);
                    *(u32x4*)(up + 8 * i8) = w; }
            }
        } else {
            if (tid3 < 384) {
                const int d = tid3 - 256; const float gl_ = gcs[63];
                bf16* kp = KT + (size_t)item * 8192 + d * 64;
#pragma unroll
                for (int i8 = 0; i8 < 8; ++i8) { float y[8];
#pragma unroll
                    for (int i = 0; i < 8; ++i) y[i] = bf2f(*(const bf16*)(kb + (8 * i8 + i) * 272 + d * 2)) * __expf(gl_ - gcs[8 * i8 + i]);
                    u32x4 w; w.x = pkbf(y[0], y[1]); w.y = pkbf(y[2], y[3]); w.z = pkbf(y[4], y[5]); w.w = pkbf(y[6], y[7]);
                    *(u32x4*)(kp + 8 * i8) = w; }
                if (d == 0) GL[item] = __expf(gl_);
            }
#pragma unroll
            for (int k = 0; k < 4; ++k) {
                const int pc = (tid3 - 256) + 256 * k, i = pc >> 4, c8 = pc & 15;
                const u32x4 v = *(const u32x4*)(qb + i * 272 + c8 * 16); const float eg = __expf(gcs[i]);
                u32x4 w; w.x = pkbf(bf2f(v.x & 0xffffu) * eg, bf2f(v.x >> 16) * eg); w.y = pkbf(bf2f(v.y & 0xffffu) * eg, bf2f(v.y >> 16) * eg);
                w.z = pkbf(bf2f(v.z & 0xffffu) * eg, bf2f(v.z >> 16) * eg); w.w = pkbf(bf2f(v.w & 0xffffu) * eg, bf2f(v.w >> 16) * eg);
                *(u32x4*)(proj + (tok0 + i) * 4096 + h * 128 + c8 * 8) = w;
            }
            if (item + nblk < Bn * 8 * 64) GP_RAWLOAD(item + nblk, tid3 - 256, 256);
        }
        LDS_BAR();
#pragma unroll
        for (int k = 0; k < 2; ++k) { const int pc = tid + 512 * k, i = pc >> 4, c8 = pc & 15;
            *(u32x4*)(proj + (tok0 + i) * 4096 + 1024 + h * 128 + c8 * 8) = *(const u32x4*)(wimg + i * 128 + c8 * 8); }
    }
}

#undef GP_RAWLOAD
__device__ __forceinline__ void phase_gdn_scan2(unsigned char* lds, const bf16* proj, const bf16* KT, const bf16* AT, const float* GL, bf16* o16, int vblk, int nblk, int tid, int wid, int lane) {
    unsigned char* Sl = lds;
    unsigned char* Vl = lds + 8704;
    const int r = lane & 31, hh = lane >> 5;
    for (int item = vblk; item < 256; item += nblk) {
        const int bh = (item & 7) + 8 * (item >> 5), es = (item >> 3) & 3, b = bh >> 3, h = bh & 7;
        __syncthreads();
        for (int i = tid; i < 8704 / 4; i += 512) ((unsigned*)Sl)[i] = 0u;
        f32x16 Sacc;
#pragma unroll
        for (int i = 0; i < 16; ++i) Sacc[i] = 0.f;
        const int rt = wid & 1, dt = wid & 3;
        bf16x8v A8n[8]; bf16x8v A4n[4]; u32x2 uun[4]; float gln = 1.f;
#define GS_LOAD(N) do { const size_t tk_ = (size_t)b * S + 64 * (N); const int it_ = bh * 64 + (N); \
            if (wid < 2) { const bf16* wp_ = proj + (tk_ + 32 * rt + r) * 4096 + 1024 + h * 128 + 8 * hh; \
                _Pragma("unroll") for (int ks = 0; ks < 8; ++ks) A8n[ks] = *(const bf16x8v*)(wp_ + 16 * ks); \
                const int c_ = es * 32 + r; const bf16* up_ = proj + (tk_ + (c_ >> 1)) * 4096 + 2048 + h * 128 + (c_ & 1) * 64 + 32 * rt + 4 * hh; \
                _Pragma("unroll") for (int g = 0; g < 4; ++g) uun[g] = *(const u32x2*)(up_ + 8 * g); } \
            else if (wid < 4) { const bf16* qp_ = proj + (tk_ + 32 * rt + r) * 4096 + h * 128 + 8 * hh; \
                _Pragma("unroll") for (int ks = 0; ks < 8; ++ks) A8n[ks] = *(const bf16x8v*)(qp_ + 16 * ks); \
                const bf16* ap_ = AT + (size_t)it_ * 4096 + (32 * rt + r) * 64 + 8 * hh; \
                _Pragma("unroll") for (int sx = 0; sx < 4; ++sx) A4n[sx] = *(const bf16x8v*)(ap_ + 16 * sx); } \
            else { const bf16* kp_ = KT + (size_t)it_ * 8192 + (32 * dt + r) * 64 + 8 * hh; \
                _Pragma("unroll") for (int sx = 0; sx < 4; ++sx) A4n[sx] = *(const bf16x8v*)(kp_ + 16 * sx); \
                gln = GL[it_]; } } while (0)
        GS_LOAD(0);
        for (int n = 0; n < 64; ++n) {
            const size_t tok0 = (size_t)b * S + 64 * n;
            bf16x8v A8[8]; bf16x8v A4[4]; u32x2 uu[4]; const float gl = gln;
#pragma unroll
            for (int ks = 0; ks < 8; ++ks) A8[ks] = A8n[ks];
#pragma unroll
            for (int sx = 0; sx < 4; ++sx) { A4[sx] = A4n[sx]; uu[sx] = uun[sx]; }
            if (n + 1 < 64) GS_LOAD(n + 1);
            LDS_BAR();
            f32x16 acc;
#pragma unroll
            for (int i = 0; i < 16; ++i) acc[i] = 0.f;
            if (wid < 4) {
#pragma unroll
                for (int ks = 0; ks < 8; ++ks) acc = MFMA32(A8[ks], *(const bf16x8v*)(Sl + r * 272 + ks * 32 + hh * 16), acc);
                if (wid < 2) {
#pragma unroll
                    for (int g = 0; g < 4; ++g) {
                        u32x2 w; w.x = pkbf(bf2f(uu[g].x & 0xffffu) - acc[4 * g], bf2f(uu[g].x >> 16) - acc[4 * g + 1]);
                        w.y = pkbf(bf2f(uu[g].y & 0xffffu) - acc[4 * g + 2], bf2f(uu[g].y >> 16) - acc[4 * g + 3]);
                        *(u32x2*)(Vl + r * 144 + (32 * rt + 8 * g + 4 * hh) * 2) = w;
                    }
                }
            }
            LDS_BAR();
            if (wid >= 2 && wid < 4) {
#pragma unroll
                for (int sx = 0; sx < 4; ++sx) acc = MFMA32(A4[sx], *(const bf16x8v*)(Vl + r * 144 + sx * 32 + hh * 16), acc);
                unsigned char* Ol = lds + 13312 + (wid - 2) * 2560;
#pragma unroll
                for (int i = 0; i < 16; ++i) *(bf16*)(Ol + ((i & 3) + 8 * (i >> 2) + 4 * hh) * 80 + r * 2) = (bf16)f2bf(acc[i]);
                WAVE_SYNC();
#pragma unroll
                for (int k = 0; k < 2; ++k) { const int pc = lane + 64 * k, trow = pc >> 2, c4 = pc & 3;
                    *(u32x4*)(o16 + (tok0 + 32 * rt + trow) * D + h * 128 + es * 32 + c4 * 8) = *(const u32x4*)(Ol + trow * 80 + c4 * 16); }
                WAVE_SYNC();
            } else if (wid >= 4) {
#pragma unroll
                for (int i = 0; i < 16; ++i) Sacc[i] *= gl;
#pragma unroll
                for (int sx = 0; sx < 4; ++sx) Sacc = MFMA32(A4[sx], *(const bf16x8v*)(Vl + r * 144 + sx * 32 + hh * 16), Sacc);
#pragma unroll
                for (int g = 0; g < 4; ++g) { u32x2 w; w.x = pkbf(Sacc[4 * g], Sacc[4 * g + 1]); w.y = pkbf(Sacc[4 * g + 2], Sacc[4 * g + 3]);
                    *(u32x2*)(Sl + r * 272 + (32 * dt + 8 * g + 4 * hh) * 2) = w; }
            }
        }
    }
}

#undef GS_LOAD
__device__ __forceinline__ void phase_gdn_post(const bf16* o16, const bf16* proj, const float* onorm, bf16* hn, int gw, int NGW, int lane) {
    const int l16 = lane & 15;
    float wv[8];
#pragma unroll
    for (int j = 0; j < 8; ++j) wv[j] = onorm[8 * l16 + j];
    for (int m = 2 * gw; m < T; m += 2 * NGW) {
        u32x4 xo[2][2], gg[2][2];
#pragma unroll
        for (int tk = 0; tk < 2; ++tk)
#pragma unroll
            for (int pt = 0; pt < 2; ++pt) { xo[tk][pt] = *(const u32x4*)(o16 + (size_t)(m + tk) * D + pt * 512 + lane * 8); gg[tk][pt] = *(const u32x4*)(proj + (size_t)(m + tk) * 4096 + 3072 + pt * 512 + lane * 8); }
#pragma unroll
        for (int tk = 0; tk < 2; ++tk)
#pragma unroll
            for (int pt = 0; pt < 2; ++pt) {
                const u32x4 xv = xo[tk][pt], gv = gg[tk][pt];
                float v[8] = {bf2f(xv.x & 0xffffu), bf2f(xv.x >> 16), bf2f(xv.y & 0xffffu), bf2f(xv.y >> 16), bf2f(xv.z & 0xffffu), bf2f(xv.z >> 16), bf2f(xv.w & 0xffffu), bf2f(xv.w >> 16)};
                const float g[8] = {bf2f(gv.x & 0xffffu), bf2f(gv.x >> 16), bf2f(gv.y & 0xffffu), bf2f(gv.y >> 16), bf2f(gv.z & 0xffffu), bf2f(gv.z >> 16), bf2f(gv.w & 0xffffu), bf2f(gv.w >> 16)};
                float sq = ((v[0] * v[0] + v[1] * v[1]) + (v[2] * v[2] + v[3] * v[3])) + ((v[4] * v[4] + v[5] * v[5]) + (v[6] * v[6] + v[7] * v[7]));
                sq = row_sum16(sq);
                const float rstd = 1.f / sqrtf(sq * (1.f / 128.f) + EPS);
#pragma unroll
                for (int j = 0; j < 8; ++j) v[j] = v[j] * rstd * wv[j] * siluf_(g[j]);
                u32x4 w; w.x = pkbf(v[0], v[1]); w.y = pkbf(v[2], v[3]); w.z = pkbf(v[4], v[5]); w.w = pkbf(v[6], v[7]);
                *(u32x4*)(hn + (size_t)(m + tk) * D + pt * 512 + lane * 8) = w;
            }
    }
}
__device__ __forceinline__ void phase_sc_post(const bf16* proj, const float* cw, bf16* hn, int gtid, int NT) {
    const int c8 = (gtid & 127) * 8;
    f32x4 w0[3], w1[3];
#pragma unroll
    for (int j = 0; j < 3; ++j) { w0[j] = *(const f32x4*)(cw + j * 1024 + c8); w1[j] = *(const f32x4*)(cw + j * 1024 + c8 + 4); }
    for (int idx = gtid; idx < T * 128; idx += 2 * NT) {
        u32x4 cv[2][3], xv[2][3], bv[2];
#pragma unroll
        for (int q = 0; q < 2; ++q) {
            const int id = idx + q * NT, m = id >> 7, s = m & (S - 1);
#pragma unroll
            for (int j = 0; j < 3; ++j) { cv[q][j] = (u32x4){0u, 0u, 0u, 0u}; xv[q][j] = (u32x4){0u, 0u, 0u, 0u};
                if (id < T * 128 && s - 2 + j >= 0) { const bf16* pr = proj + (size_t)(m - 2 + j) * 3072; cv[q][j] = *(const u32x4*)(pr + 1024 + c8); xv[q][j] = *(const u32x4*)(pr + 2048 + c8); } }
            bv[q] = (u32x4){0u, 0u, 0u, 0u};
            if (id < T * 128) bv[q] = *(const u32x4*)(proj + (size_t)m * 3072 + c8);
        }
#pragma unroll
        for (int q = 0; q < 2; ++q) {
            const int id = idx + q * NT, m = id >> 7;
            if (id >= T * 128) break;
            float y[8];
#pragma unroll
            for (int i = 0; i < 8; ++i) y[i] = 0.f;
#pragma unroll
            for (int j = 0; j < 3; ++j) {
                const u32x4 c = cv[q][j], x = xv[q][j];
                y[0] += w0[j].x * bf2f(c.x & 0xffffu) * bf2f(x.x & 0xffffu); y[1] += w0[j].y * bf2f(c.x >> 16) * bf2f(x.x >> 16);
                y[2] += w0[j].z * bf2f(c.y & 0xffffu) * bf2f(x.y & 0xffffu); y[3] += w0[j].w * bf2f(c.y >> 16) * bf2f(x.y >> 16);
                y[4] += w1[j].x * bf2f(c.z & 0xffffu) * bf2f(x.z & 0xffffu); y[5] += w1[j].y * bf2f(c.z >> 16) * bf2f(x.z >> 16);
                y[6] += w1[j].z * bf2f(c.w & 0xffffu) * bf2f(x.w & 0xffffu); y[7] += w1[j].w * bf2f(c.w >> 16) * bf2f(x.w >> 16);
            }
            const u32x4 b = bv[q];
            u32x4 o;
            o.x = pkbf(y[0] * bf2f(b.x & 0xffffu), y[1] * bf2f(b.x >> 16)); o.y = pkbf(y[2] * bf2f(b.y & 0xffffu), y[3] * bf2f(b.y >> 16));
            o.z = pkbf(y[4] * bf2f(b.z & 0xffffu), y[5] * bf2f(b.z >> 16)); o.w = pkbf(y[6] * bf2f(b.w & 0xffffu), y[7] * bf2f(b.w >> 16));
            *(u32x4*)(hn + (size_t)m * D + c8) = o;
        }
    }
}
__device__ __forceinline__ void phase_nsa_post(unsigned char* lds, const bf16* proj, const float* qnorm, const float* knorm, const f32x2* tab,
                                               bf16* QN, bf16* KS, bf16* KW, bf16* KCH, bf16* VCH, bf16* VST, bf16* VWT, int gw, int NGW, int wid, int lane) {
    {
        bf16* tile = (bf16*)lds + wid * (64 * 72);
        const int c8 = lane & 7, r8 = lane >> 3;
        for (int item = gw; item < 2 * 32 * 64; item += NGW) {
            const int st = item & 63, bh = (item >> 6) & 31, which = item >> 11, b = bh >> 2, hk = bh & 3;
            const bf16* src = proj + ((size_t)b * S + st * 64 + r8) * 2560 + (which ? 2304 : 1792) + hk * 64 + c8 * 8;
            u32x4 v[8];
#pragma unroll
            for (int i = 0; i < 8; ++i) v[i] = *(const u32x4*)(src + (size_t)(8 * i) * 2560);
#pragma unroll
            for (int i = 0; i < 8; ++i) *(u32x4*)(tile + (8 * i + r8) * 72 + c8 * 8) = v[i];
            WAVE_SYNC();
            bf16* dst = (which ? VWT : VST) + (size_t)bh * 64 * S + st * 64 + c8 * 8;
#pragma unroll
            for (int i = 0; i < 8; ++i) {
                const bf16* tp = tile + (8 * c8) * 72 + 8 * i + r8;
                u32x4 w; w.x = (unsigned)tp[0] | ((unsigned)tp[72] << 16); w.y = (unsigned)tp[144] | ((unsigned)tp[216] << 16);
                w.z = (unsigned)tp[288] | ((unsigned)tp[360] << 16); w.w = (unsigned)tp[432] | ((unsigned)tp[504] << 16);
                *(u32x4*)(dst + (size_t)(8 * i + r8) * S) = w;
            }
            WAVE_SYNC();
        }
    }
    const int l8 = lane & 7, hsel = lane >> 3, lo32 = lane < 32;
    float qw8[8], kw8[8];
#pragma unroll
    for (int j = 0; j < 8; ++j) { qw8[j] = qnorm[8 * l8 + j]; kw8[j] = knorm[(lo32 ? 64 : 128) + 8 * l8 + j]; }
#define NP_UNPACK(V, X) do { X[0] = bf2f(V.x & 0xffffu); X[1] = bf2f(V.x >> 16); X[2] = bf2f(V.y & 0xffffu); X[3] = bf2f(V.y >> 16); X[4] = bf2f(V.z & 0xffffu); X[5] = bf2f(V.z >> 16); X[6] = bf2f(V.w & 0xffffu); X[7] = bf2f(V.w >> 16); } while (0)
#define NP_RSTD8(X, R) do { float ss_ = (X[0] * X[0] + X[1] * X[1]) + (X[2] * X[2] + X[3] * X[3]) + (X[4] * X[4] + X[5] * X[5]) + (X[6] * X[6] + X[7] * X[7]); \
        ss_ += xshfl(ss_, 1); ss_ += xshfl(ss_, 2); ss_ += xshfl(ss_, 4); R = 1.f / sqrtf(ss_ * (1.f / 64.f) + EPS); } while (0)
    for (int m0 = gw; m0 < T; m0 += 2 * NGW) {
        u32x4 vq0_[2], vq1_[2], vk_[2], vc_[2]; f32x4 cc_[2][4];
#pragma unroll
        for (int q = 0; q < 2; ++q) {
            const int m = m0 + q * NGW < T ? m0 + q * NGW : m0;
            const bf16* pr = proj + (size_t)m * 2560;
            vq0_[q] = *(const u32x4*)(pr + lane * 8); vq1_[q] = *(const u32x4*)(pr + 512 + lane * 8);
            vk_[q] = *(const u32x4*)(pr + (lo32 ? 1536 + lane * 8 : 2048 + (lane - 32) * 8));
            vc_[q] = *(const u32x4*)(pr + (lo32 ? 1024 + lane * 8 : 1280 + (lane - 32) * 8));
            const f32x4* cp = (const f32x4*)(tab + (size_t)m * 32 + 8 * (l8 & 3));
            cc_[q][0] = cp[0]; cc_[q][1] = cp[1]; cc_[q][2] = cp[2]; cc_[q][3] = cp[3];
        }
#pragma unroll
        for (int q = 0; q < 2; ++q) {
        const int m = m0 + q * NGW;
        if (m >= T) break;
        const int b = m >> 12, s = m & (S - 1);
        const u32x4 vq0 = vq0_[q], vq1 = vq1_[q], vk = vk_[q], vc = vc_[q];
        const f32x4 c0 = cc_[q][0], c1 = cc_[q][1], c2 = cc_[q][2], c3 = cc_[q][3];
        {
            float x[8], r; NP_UNPACK(vq0, x); NP_RSTD8(x, r);
            u32x4 w; w.x = pkbf(x[0] * r * qw8[0], x[1] * r * qw8[1]); w.y = pkbf(x[2] * r * qw8[2], x[3] * r * qw8[3]); w.z = pkbf(x[4] * r * qw8[4], x[5] * r * qw8[5]); w.w = pkbf(x[6] * r * qw8[6], x[7] * r * qw8[7]);
            *(u32x4*)(QN + ((size_t)(b * 16 + hsel) * S + s) * 64 + 8 * l8) = w;
        }
        {
            float x[8], r; NP_UNPACK(vq1, x); NP_RSTD8(x, r);
            u32x4 w; w.x = pkbf(x[0] * r * qw8[0], x[1] * r * qw8[1]); w.y = pkbf(x[2] * r * qw8[2], x[3] * r * qw8[3]); w.z = pkbf(x[4] * r * qw8[4], x[5] * r * qw8[5]); w.w = pkbf(x[6] * r * qw8[6], x[7] * r * qw8[7]);
            *(u32x4*)(QN + ((size_t)(b * 16 + 8 + hsel) * S + s) * 64 + 8 * l8) = w;
        }
        const size_t okv = ((size_t)(b * 4 + (hsel & 3)) * S + s) * 64 + 8 * l8;
        {
            float x[8], r, y[8]; NP_UNPACK(vk, x); NP_RSTD8(x, r);
            const float cs[16] = {c0.x, c0.y, c0.z, c0.w, c1.x, c1.y, c1.z, c1.w, c2.x, c2.y, c2.z, c2.w, c3.x, c3.y, c3.z, c3.w};
#pragma unroll
            for (int j = 0; j < 8; ++j) { const float yv = x[j] * r * kw8[j]; const float yp = xshfl(yv, 4); y[j] = yv * cs[2 * j] + (l8 < 4 ? -yp : yp) * cs[2 * j + 1]; }
            u32x4 w; w.x = pkbf(y[0], y[1]); w.y = pkbf(y[2], y[3]); w.z = pkbf(y[4], y[5]); w.w = pkbf(y[6], y[7]);
            *(u32x4*)((lo32 ? KS : KW) + okv) = w;
        }
        *(u32x4*)((lo32 ? KCH : VCH) + okv) = vc;
    }
    }
#undef NP_UNPACK
#undef NP_RSTD8
}
__device__ __forceinline__ void phase_cmp2(unsigned char* lds, const float* Pk, const float* Pv, const float* biasp, const float* w2, const float* b2, const float* knorm0,
                                           bf16* KC, bf16* VC, int gw, int NGW, int wid, int lane, int tid) {
    float* hs = (float*)lds + wid * 256;
    float* w2l = (float*)(lds + 8192);
    for (int kind = 0; kind < 2; ++kind) {
        __syncthreads();
        for (int idx = tid; idx < 256 * 64 / 4; idx += 512) ((f32x4*)w2l)[idx] = ((const f32x4*)(w2 + (size_t)kind * 256 * 64))[idx];
        __syncthreads();
        const float* P = kind ? Pv : Pk;
        for (int it = gw; it < 32 * 256; it += NGW) {
            const int i = it & 255, bh = it >> 8;
            bf16* outp = kind ? VC + ((size_t)bh * 64 + lane) * 256 + i : KC + ((size_t)bh * 256 + i) * 64 + lane;
            if (i == 255) { *outp = 0; continue; }
            const float* r0 = P + ((size_t)bh * 256 + i) * 512; const float* r1 = r0 + 512 + 256;
#pragma unroll
            for (int j = 0; j < 4; ++j) { const int n = lane + 64 * j; const float x = r0[n] + r1[n] + biasp[kind * 256 + n];
                const float uu = 0.7978845608028654f * (x + 0.044715f * x * x * x);
                const float th = 1.f - 2.f / (1.f + __expf(2.f * uu));
                hs[n] = 0.5f * x * (1.f + th); }
            WAVE_SYNC();
            float a0 = b2[kind * 64 + lane], a1 = 0.f, a2 = 0.f, a3 = 0.f;
#pragma unroll 4
            for (int n = 0; n < 256; n += 4) { const f32x4 hv = *(const f32x4*)(hs + n);
                a0 += hv.x * w2l[n * 64 + lane]; a1 += hv.y * w2l[(n + 1) * 64 + lane]; a2 += hv.z * w2l[(n + 2) * 64 + lane]; a3 += hv.w * w2l[(n + 3) * 64 + lane]; }
            float acc = (a0 + a1) + (a2 + a3);
            if (kind == 0) { const float ss = wave_sum(acc * acc); acc = acc * (1.f / sqrtf(ss * (1.f / 64.f) + EPS)) * knorm0[lane]; }
            *outp = (bf16)f2bf(acc);
            WAVE_SYNC();
        }
    }
}
constexpr int KV_STRIDE = 144;
constexpr int KV_BUF = 2 * 64 * KV_STRIDE;
constexpr int ATT_IMP_OFF = 2 * KV_BUF;
constexpr int ATT_MSK_OFF = ATT_IMP_OFF + 8 * 2048;

template <bool IMP>
__device__ __forceinline__ void attn_tile(const bool FAST, const unsigned char* buf, int tt, int key0, int lo, int hi, const bf16x8v (&qf)[4],
                                          f32x16 (&O)[2], f32x16 (&IM)[2], float& m, float& l, const bf16* ovt, int r, int h, int pr) {
    f32x16 sacc;
#pragma unroll
    for (int i = 0; i < 16; ++i) sacc[i] = 0.f;
    bf16x8v ov[2][2];
    if (IMP) {
#pragma unroll
        for (int st = 0; st < 2; ++st)
#pragma unroll
            for (int sx = 0; sx < 2; ++sx) ov[st][sx] = *(const bf16x8v*)(ovt + (32 * st + r) * 256 + key0 + 16 * sx + 8 * h);
    }
    const unsigned char* kb = buf + (32 * tt + pr) * KV_STRIDE + h * 16;
#pragma unroll
    for (int ks = 0; ks < 4; ++ks) { const bf16x8v a = *(const bf16x8v*)(kb + ks * 32); sacc = MFMA32(a, qf[ks], sacc); }
    const int kb0 = key0 + 8 * h;
    float mx = -1e30f, psum = 0.f, corr;
    if (FAST) {
        const bool on = hi >= 0;
#pragma unroll
        for (int i = 0; i < 16; ++i) mx = fmaxf(mx, sacc[i]);
        mx = on ? mx * 0.18033688011112042f : -1e30f;
        mx = fmaxf(mx, xshfl(mx, 32));
        const float mnew = fmaxf(m, mx);
        corr = __builtin_amdgcn_exp2f(m - mnew);
        m = mnew;
#pragma unroll
        for (int i = 0; i < 16; ++i) { const float p = __builtin_amdgcn_exp2f(sacc[i] * 0.18033688011112042f - mnew); psum += p; sacc[i] = p; }
        if (!on) {
            psum = 0.f;
#pragma unroll
            for (int i = 0; i < 16; ++i) sacc[i] = 0.f;
        }
    } else {
#pragma unroll
        for (int i = 0; i < 16; ++i) { const int key = kb0 + 16 * (i >> 3) + (i & 7); const bool ok = (key >= lo) && (key <= hi);
            const float sv = ok ? sacc[i] * 0.18033688011112042f : -1e30f; sacc[i] = sv; mx = fmaxf(mx, sv); }
        mx = fmaxf(mx, xshfl(mx, 32));
        const float mnew = fmaxf(m, mx);
        corr = __builtin_amdgcn_exp2f(m - mnew);
        m = mnew;
#pragma unroll
        for (int i = 0; i < 16; ++i) { const float p = sacc[i] > -1e29f ? __builtin_amdgcn_exp2f(sacc[i] - mnew) : 0.f; psum += p; sacc[i] = p; }
    }
    l = l * corr + psum;
    if (__any(corr != 1.f)) {
#pragma unroll
        for (int i = 0; i < 16; ++i) { O[0][i] *= corr; O[1][i] *= corr; }
        if (IMP) {
#pragma unroll
            for (int i = 0; i < 16; ++i) { IM[0][i] *= corr; IM[1][i] *= corr; }
        }
    }
    bf16x8v pf[2];
#pragma unroll
    for (int sx = 0; sx < 2; ++sx) { u32x4 w; w.x = pkbf(sacc[8 * sx], sacc[8 * sx + 1]); w.y = pkbf(sacc[8 * sx + 2], sacc[8 * sx + 3]); w.z = pkbf(sacc[8 * sx + 4], sacc[8 * sx + 5]); w.w = pkbf(sacc[8 * sx + 6], sacc[8 * sx + 7]);
        pf[sx] = __builtin_bit_cast(bf16x8v, w); }
    const unsigned char* vb = buf + 64 * KV_STRIDE + r * KV_STRIDE + (32 * tt + 8 * h) * 2;
#pragma unroll
    for (int dt = 0; dt < 2; ++dt)
#pragma unroll
        for (int sx = 0; sx < 2; ++sx) { const bf16x8v a = *(const bf16x8v*)(vb + dt * 32 * KV_STRIDE + sx * 32); O[dt] = MFMA32(a, pf[sx], O[dt]); }
    if (IMP) {
#pragma unroll
        for (int st = 0; st < 2; ++st)
#pragma unroll
            for (int sx = 0; sx < 2; ++sx) IM[st] = MFMA32(ov[st][sx], pf[sx], IM[st]);
    }
}

template <int MODE>
__device__ __forceinline__ void attn_branch(unsigned char* kvbuf, const bf16* Kg0, const bf16* VTg0, int vts, unsigned long long blkmask, int t, int nv, unsigned long long selm,
                                            int wlo, int whi, int flo, int fhi, const bf16x8v (&qf)[4], f32x16 (&O)[2], f32x16 (&IM)[2], float& l, const bf16* ovt, int tid, int r, int h, int pr) {
    float m = -1e30f;
    l = 0.f;
#pragma unroll
    for (int i = 0; i < 16; ++i) { O[0][i] = 0.f; O[1][i] = 0.f; IM[0][i] = 0.f; IM[1][i] = 0.f; }
    const int srow = tid >> 3, sch = tid & 7;
    int j = __builtin_ctzll(blkmask);
    unsigned long long rest = blkmask & (blkmask - 1);
    u32x4 kr = *(const u32x4*)(Kg0 + (size_t)(64 * j + srow) * 64 + sch * 8);
    u32x4 vr = *(const u32x4*)(VTg0 + (size_t)srow * vts + 64 * j + sch * 8);
    *(u32x4*)(kvbuf + srow * KV_STRIDE + sch * 16) = kr;
    *(u32x4*)(kvbuf + 64 * KV_STRIDE + srow * KV_STRIDE + sch * 16) = vr;
    int cur = 0;
    for (;;) {
        LDS_BAR();
        const bool more = rest != 0ull;
        int jn = 0;
        if (more) { jn = __builtin_ctzll(rest); rest &= rest - 1;
            kr = *(const u32x4*)(Kg0 + (size_t)(64 * jn + srow) * 64 + sch * 8);
            vr = *(const u32x4*)(VTg0 + (size_t)srow * vts + 64 * jn + sch * 8); }
        const unsigned char* buf = kvbuf + cur * KV_BUF;
        int lo, hi;
        if (MODE == 0) { lo = 0; hi = nv - 1; }
        else if (MODE == 1) { lo = 0; hi = ((selm >> j) & 1ull) ? t : -1; }
        else { lo = t - 511; hi = t; }
        const bool wave_on = (MODE != 1) || __any(hi >= 0);
#pragma unroll
        for (int tt = 0; tt < 2; ++tt) {
            const int key0 = 64 * j + 32 * tt;
            if (!wave_on || key0 > whi || key0 + 31 < wlo) continue;
            attn_tile<MODE == 0>(key0 >= flo && key0 + 31 <= fhi, buf, tt, key0, lo, hi, qf, O, IM, m, l, ovt, r, h, pr);
        }
        if (!more) break;
        *(u32x4*)(kvbuf + (cur ^ 1) * KV_BUF + srow * KV_STRIDE + sch * 16) = kr;
        *(u32x4*)(kvbuf + (cur ^ 1) * KV_BUF + 64 * KV_STRIDE + srow * KV_STRIDE + sch * 16) = vr;
        cur ^= 1; j = jn;
    }
    LDS_BAR();
}

__device__ __forceinline__ void phase_nsa_attn(unsigned char* lds, const bf16* QN, const bf16* KS, const bf16* KW, const bf16* VST, const bf16* VWT, const bf16* KCb, const bf16* VCT,
                                               const bf16* ovt, const float* gates, const f32x2* tab, bf16* hn, int vblk, int nblk, int tid, int wid, int lane) {
    const int r = lane & 31, h = lane >> 5, pr = (r & ~12) | ((r & 4) << 1) | ((r & 8) >> 1);
    float* imp_s = (float*)(lds + ATT_IMP_OFF + wid * 2048);
    unsigned long long* msk_s = (unsigned long long*)(lds + ATT_MSK_OFF);
    unsigned* uni_s = (unsigned*)(lds + ATT_MSK_OFF + 512);
    for (int item = vblk; item < Bn * 4 * 64; item += nblk) {
        const int rnd = item / nblk, wv = item - rnd * nblk;
        const int bh = wv & 31, sub = wv >> 5, per = nblk >> 5;
        int qb = rnd * per + ((rnd & 1) ? (per - 1 - sub) : sub);
        if (nblk != 256) { qb = item >> 5; }
        const int bhh = (nblk != 256) ? (item & 31) : bh;
        const int b = bhh >> 2, hk = bhh & 3;
        const int t0 = qb * 64, tw0 = t0 + 8 * wid, t = tw0 + (r & 7), g = r >> 3;
        const size_t tok = (size_t)b * S + t;
        if (tid == 0) { unsigned z = 0u; asm volatile("" : "+v"(z)); uni_s[0] = z; uni_s[1] = z; }
        bf16x8v qn[4], qr[4];
        {
            const bf16* qp = QN + ((size_t)(b * 16 + hk * 4 + g) * S + t) * 64 + 8 * h;
#pragma unroll
            for (int ks = 0; ks < 4; ++ks) qn[ks] = *(const bf16x8v*)(qp + 16 * ks);
            const f32x2* cp = tab + tok * 32 + 8 * h;
#pragma unroll
            for (int kl = 0; kl < 2; ++kl) {
                u32x4 wlo_, whi_;
                const u32x4 a = __builtin_bit_cast(u32x4, qn[kl]), c = __builtin_bit_cast(u32x4, qn[kl + 2]);
#pragma unroll
                for (int jj = 0; jj < 4; ++jj) {
                    const f32x2 cs0 = cp[16 * kl + 2 * jj], cs1 = cp[16 * kl + 2 * jj + 1];
                    const float x0 = bf2f(a[jj] & 0xffffu), x1 = bf2f(a[jj] >> 16), y0 = bf2f(c[jj] & 0xffffu), y1 = bf2f(c[jj] >> 16);
                    wlo_[jj] = pkbf(x0 * cs0.x - y0 * cs0.y, x1 * cs1.x - y1 * cs1.y);
                    whi_[jj] = pkbf(y0 * cs0.x + x0 * cs0.y, y1 * cs1.x + x1 * cs1.y);
                }
                qr[kl] = __builtin_bit_cast(bf16x8v, wlo_); qr[kl + 2] = __builtin_bit_cast(bf16x8v, whi_);
            }
        }
        const float* gp = gates + tok * 48 + (hk * 4 + g) * 3;
        const float g0 = sigmoidf_(gp[0]), g1 = sigmoidf_(gp[1]), g2 = sigmoidf_(gp[2]);
        f32x16 acc[2], O[2], IM[2];
        float l;
        const int nv = t >= 31 ? ((t - 31) >> 4) + 1 : 0;
        const int nvw = ((tw0 + 7 - 31) >> 4) + 1;
        const int nvmax = 4 * qb + 3;
        {
            const int ncb = (nvmax + 63) >> 6;
            const unsigned long long bm = ncb >= 64 ? ~0ull : ((1ull << ncb) - 1ull);
            attn_branch<0>(lds, KCb + (size_t)bhh * 256 * 64, VCT + (size_t)bhh * 64 * 256, 256, bm, t, nv, 0ull, 0, (tw0 + 7 >= 31 ? nvw - 1 : -1), 0, (tw0 >= 31 ? ((tw0 - 31) >> 4) : -1), qn, O, IM, l, ovt, tid, r, h, pr);
        }
        {
            const float lt = l + xshfl(l, 32), inv = lt > 0.f ? 1.f / lt : 0.f, sc = inv * g0;
#pragma unroll
            for (int i = 0; i < 16; ++i) { acc[0][i] = O[0][i] * sc; acc[1][i] = O[1][i] * sc; }
#pragma unroll
            for (int st = 0; st < 2; ++st)
#pragma unroll
                for (int i = 0; i < 16; ++i) { float v = IM[st][i] * inv; v += xshfl(v, 8); v += xshfl(v, 16);
                    if (r < 8) imp_s[r * 64 + 32 * st + (i & 3) + 8 * (i >> 2) + 4 * h] = v; }
        }
        WAVE_SYNC();
        {
            unsigned long long um = 0ull;
            for (int tk = 0; tk < 8; ++tk) {
                const float imp = imp_s[tk * 64 + lane];
                const bool sv = lane <= qb, forced = (lane == 0) || (lane == qb) || (lane + 1 == qb);
                const float score = sv ? (forced ? 1e9f : imp) : -1.f;
                int rank = 0;
#pragma unroll 4
                for (int i = 0; i < 64; ++i) { const float si = __uint_as_float(__builtin_amdgcn_readlane(__float_as_uint(score), i)); rank += (si > score || (si == score && i < lane)) ? 1 : 0; }
                const unsigned long long mk = __ballot((rank < 16) && (score >= 0.f));
                um |= mk;
                if (lane == 0) msk_s[wid * 8 + tk] = mk;
            }
            if (lane == 0) { atomicOr(&uni_s[0], (unsigned)um); atomicOr(&uni_s[1], (unsigned)(um >> 32)); }
        }
        __syncthreads();
        const unsigned long long selm = msk_s[wid * 8 + (r & 7)];
        const unsigned long long uni = (unsigned long long)uni_s[0] | ((unsigned long long)uni_s[1] << 32);
        attn_branch<1>(lds, KS + (size_t)bhh * S * 64, VST + (size_t)bhh * 64 * S, S, uni, t, 0, selm, 0, tw0 + 7, 0, tw0, qr, O, IM, l, ovt, tid, r, h, pr);
        {
            const float lt = l + xshfl(l, 32), sc = g1 / lt;
#pragma unroll
            for (int i = 0; i < 16; ++i) { acc[0][i] += O[0][i] * sc; acc[1][i] += O[1][i] * sc; }
        }
        {
            const int jlo = qb >= 8 ? qb - 8 : 0;
            const unsigned long long bm = (qb >= 63 ? ~0ull : ((1ull << (qb + 1)) - 1ull)) & ~((1ull << jlo) - 1ull);
            attn_branch<2>(lds, KW + (size_t)bhh * S * 64, VWT + (size_t)bhh * 64 * S, S, bm, t, 0, 0ull, tw0 - 511, tw0 + 7, tw0 + 7 - 511, tw0, qr, O, IM, l, ovt, tid, r, h, pr);
        }
        {
            const float lt = l + xshfl(l, 32), sc = g2 / lt;
            bf16* op = hn + tok * D + (hk * 4 + g) * 64 + 4 * h;
#pragma unroll
            for (int dt = 0; dt < 2; ++dt)
#pragma unroll
                for (int q4 = 0; q4 < 4; ++q4) {
                    u32x2 w; w.x = pkbf(acc[dt][4 * q4] + O[dt][4 * q4] * sc, acc[dt][4 * q4 + 1] + O[dt][4 * q4 + 1] * sc);
                    w.y = pkbf(acc[dt][4 * q4 + 2] + O[dt][4 * q4 + 2] * sc, acc[dt][4 * q4 + 3] + O[dt][4 * q4 + 3] * sc);
                    *(u32x2*)(op + 32 * dt + 8 * q4) = w;
                }
        }
    }
}


#define LAS __attribute__((address_space(3)))
#define XB_TMO      128
#define XB_XCNT(j)  (256  + 64 * (j))
#define XB_XSUB(j)  (1280 + 64 * (j))
#define XB_XGEN(j)  (2304 + 64 * (j))
#define XB_TOP      3328
#define XB_TOPGEN   3392
#define XCD_BAR_WORDS 3456
#define XB_SPIN_CAP (1u << 18)

__device__ __forceinline__ unsigned xb_ld(unsigned* p)              { return __hip_atomic_load(p, __ATOMIC_RELAXED, __HIP_MEMORY_SCOPE_AGENT); }
__device__ __forceinline__ unsigned xb_add(unsigned* p, unsigned v) { return __hip_atomic_fetch_add(p, v, __ATOMIC_RELAXED, __HIP_MEMORY_SCOPE_AGENT); }
__device__ __forceinline__ unsigned xb_xcc_id() { return (unsigned)__builtin_amdgcn_s_getreg((3 << 11) | 20) & 0xFu; }
#define XB_SPIN(cond, bar) do { unsigned _sp = 0; while (cond) { __builtin_amdgcn_s_sleep(1); \
    if ((++_sp & 255u) == 0u) { if (xb_ld(&(bar)[XB_TMO])) break; if (_sp > XB_SPIN_CAP) { atomicAdd(&(bar)[XB_TMO], 1u); break; } } } } while (0)

struct XcdBarrier {
    unsigned* bar; unsigned x;
    volatile LAS unsigned* st;
};

__device__ __forceinline__ XcdBarrier xcd_barrier_post(unsigned* bar, volatile LAS unsigned* st) {
    XcdBarrier b; b.bar = bar; b.x = xb_xcc_id(); b.st = st;
    if (threadIdx.x == 0) (void)xb_add(&bar[XB_XCNT(b.x)], 1u);
    return b;
}
__device__ __forceinline__ void xcd_barrier_complete(unsigned* bar, unsigned x, unsigned& nloc, unsigned& nx) {
    const unsigned G = gridDim.x * gridDim.y * gridDim.z;
    unsigned sum, cnt, mine, sp = 0u;
    for (;;) {
        sum = 0u; cnt = 0u; mine = 0u;
#pragma unroll
        for (unsigned j = 0; j < 16; ++j) { const unsigned c = xb_ld(&bar[XB_XCNT(j)]); sum += c; cnt += (c > 0u) ? 1u : 0u; mine = (j == x) ? c : mine; }
        if (sum == G) break;
        __builtin_amdgcn_s_sleep(1);
        if ((++sp & 255u) == 0u) { if (xb_ld(&bar[XB_TMO])) break; if (sp > XB_SPIN_CAP) { atomicAdd(&bar[XB_TMO], 1u); break; } }
    }
    nloc = mine > 0u ? mine : 1u; nx = cnt > 0u ? cnt : 1u;
}

__device__ __forceinline__ void xcd_barrier(const XcdBarrier& b) {
    asm volatile("s_waitcnt vmcnt(0)" ::: "memory");
    __syncthreads();
    if (threadIdx.x == 0) {
        unsigned* bar = b.bar;
        __builtin_amdgcn_s_waitcnt(0);
        unsigned nloc = b.st[0], nx = b.st[1];
        if (nloc == 0u) { xcd_barrier_complete(bar, b.x, nloc, nx); b.st[0] = nloc; b.st[1] = nx; }
        const unsigned old = xb_add(&bar[XB_XSUB(b.x)], 1u);
        const unsigned gen = old / nloc;
        if (old + 1u == (gen + 1u) * nloc) {
            __builtin_amdgcn_fence(__ATOMIC_RELEASE, "agent");
            asm volatile("s_waitcnt vmcnt(0)" ::: "memory");
            const unsigned og = xb_add(&bar[XB_TOP], 1u);
            const unsigned tg = og / nx;
            if (og + 1u == (tg + 1u) * nx) xb_add(&bar[XB_TOPGEN], 1u);
            else XB_SPIN(xb_ld(&bar[XB_TOPGEN]) == tg, bar);
            __builtin_amdgcn_fence(__ATOMIC_ACQUIRE, "agent");
            xb_add(&bar[XB_XGEN(b.x)], 1u);
            asm volatile("s_waitcnt vmcnt(0)" ::: "memory");
        } else {
            XB_SPIN(xb_ld(&bar[XB_XGEN(b.x)]) == gen, bar);
            __builtin_amdgcn_fence(__ATOMIC_ACQUIRE, "agent");
            asm volatile("s_waitcnt vmcnt(0)" ::: "memory");
        }
    }
    __syncthreads();
}

struct Args { const void* in[24]; float* out; unsigned char* ws; int lo, hi; };

__host__ __device__ constexpr int mixer_inner_phases(int kind) { return kind == 0 ? 3 : (kind == 1 ? 1 : 4); }
__host__ __device__ constexpr int total_phases() { int n = 1; for (int L = 0; L < DEPTH; ++L) n += 4 + 2 + mixer_inner_phases(L % 3); return n; }

__global__ void __launch_bounds__(512, 2) mega(Args args) {
    extern __shared__ __attribute__((aligned(16))) unsigned char lds[];
    cg::grid_group grid = cg::this_grid();
    volatile LAS unsigned* bst = (volatile LAS unsigned*)((LAS unsigned char*)lds + (LDS_BYTES - 64));
    if (threadIdx.x < 2) bst[threadIdx.x] = 0u;
    __syncthreads();
    const XcdBarrier xbar = xcd_barrier_post((unsigned*)args.ws, bst);
    bool again = false;
    for (int ph = args.lo; ph < args.hi; ++ph) {
        int type = 0, s = 0, L = 0;
        if (ph > 0) {
            int p = ph - 1;
            for (L = 0; L < DEPTH; ++L) { const int n = 6 + mixer_inner_phases(L % 3); if (p < n) break; p -= n; }
            const int inner = mixer_inner_phases(L % 3), kind = L % 3;
            if (p < 2) { type = 2 + p; s = 2 * L; }
            else if (p == 2) type = 5;
            else if (p < 3 + inner) { const int q = p - 3; type = kind == 0 ? (q == 0 ? 15 : 5 + q) : (kind == 1 ? 8 : 9 + q); }
            else if (p == 3 + inner) type = 13;
            else { type = 2 + (p - 4 - inner); s = 2 * L + 1; }
        }
        int tid_ = threadIdx.x; asm volatile("" : "+v"(tid_));
        int G_ = gridDim.x, bx_ = blockIdx.x; asm volatile("" : "+s"(G_), "+s"(bx_));
        const int tid = tid_, lane = tid & 63, wid = __builtin_amdgcn_readfirstlane(tid >> 6);
        const int G = G_, bx = bx_;
        const int vcu = (G % 8 == 0) ? (bx % 8) * (G / 8) + bx / 8 : bx;
        const int gw = vcu * 8 + wid, NGW = G * 8;
        unsigned char* ws = args.ws; asm volatile("" : "+s"(ws));
        PG8_LAS unsigned char* ldsl = (PG8_LAS unsigned char*)lds;
        float* hout = args.out; asm volatile("" : "+s"(hout));
        bf16* HN = (bf16*)(ws + WS_HN);
        bf16* RB = (bf16*)(ws + WS_R);
        f32x2* tab = (f32x2*)(ws + WS_TAB);
        const int kind = L % 3, jj = L / 3;
        bf16* QN = RB + (size_t)T * 2560;
        bf16* KSb = QN + (size_t)T * 1024;
        bf16* KWb = KSb + (size_t)T * 256;
        bf16* KCH = (bf16*)(ws + WS_O32);
        bf16* VCH = KCH + (size_t)T * 256;
        float* Pk = (float*)(ws + WS_O32 + 32 * MiB);
        float* Pv = Pk + (size_t)8192 * 512;
        bf16* KC = (bf16*)(ws + WS_O32 + 64 * MiB);
        bf16* VC = (bf16*)(ws + WS_O32 + 65 * MiB);
        bf16* OVT = (bf16*)(ws + WS_BP + 65536);
        bf16* VST = (bf16*)(ws + WS_O32 + 68 * MiB);
        bf16* VWT = (bf16*)(ws + WS_O32 + 84 * MiB);
        switch (type) {
        case 0: {
            float* scr = (float*)lds + wid * (64 * 33);
            for (int mi = 0; mi < 28; ++mi) {
                const float* W; const float* nw = nullptr; int K, N, Npad, mode = 0; bf16* WT;
                if (mi < 8)       { nw = (const float*)args.in[2] + (size_t)mi * D; W = (const float*)args.in[3] + (size_t)mi * D * 2 * FF; K = D; N = 2 * FF; Npad = N; mode = 1; WT = (bf16*)(ws + WS_WGU) + (size_t)mi * 2 * FF * D; }
                else if (mi < 16) { const int i = mi - 8; W = (const float*)args.in[4] + (size_t)i * FF * D; K = FF; N = D; Npad = N; WT = (bf16*)(ws + WS_WDN) + (size_t)i * D * FF; }
                else if (mi < 18) { const int i = mi - 16; nw = (const float*)args.in[5] + (size_t)(3 * i) * D; W = (const float*)args.in[6] + (size_t)i * D * 4112; K = D; N = 4112; Npad = GDN_NPAD; WT = (bf16*)(ws + WS_WGI) + (size_t)i * GDN_NPAD * D; }
                else if (mi < 20) { const int i = mi - 18; W = (const float*)args.in[11] + (size_t)i * D * D; K = D; N = D; Npad = N; WT = (bf16*)(ws + WS_WGO) + (size_t)i * D * D; }
                else if (mi == 20) { nw = (const float*)args.in[5] + (size_t)1 * D; W = (const float*)args.in[12]; K = D; N = 3072; Npad = N; WT = (bf16*)(ws + WS_WSI); }
                else if (mi == 21) { W = (const float*)args.in[14]; K = D; N = D; Npad = N; WT = (bf16*)(ws + WS_WSO); }
                else if (mi == 22) { nw = (const float*)args.in[5] + (size_t)2 * D; W = (const float*)args.in[15]; K = D; N = 2608; Npad = NSA_NPAD; WT = (bf16*)(ws + WS_WNI); }
                else if (mi == 23) { W = (const float*)args.in[23]; K = D; N = D; Npad = N; WT = (bf16*)(ws + WS_WNO); }
                else { const int i = mi - 24, kd = i >> 1, hf = i & 1;
                    W = (const float*)args.in[19] + (size_t)kd * 2048 * 256 + (size_t)hf * 1024 * 256; K = 1024; N = 256; Npad = 256; WT = (bf16*)(ws + WS_WC1) + (size_t)kd * 512 * 1024 + (size_t)hf * 256 * 1024; }
                xpose_matrix(W, nw, K, N, Npad, WT, mode, scr, gw, NGW, lane);
            }
            {
                float* ss = (float*)(ws + WS_SS);
                const float* xin = (const float*)args.in[0];
                for (int m = gw; m < T; m += NGW) {
                    const f32x4* xr = (const f32x4*)(xin + (size_t)m * D) + lane; u32x2* o8 = (u32x2*)(HN + (size_t)m * D) + lane; float sq = 0.f;
#pragma unroll
                    for (int j = 0; j < 4; ++j) { const f32x4 v = xr[64 * j]; sq += (v.x * v.x + v.y * v.y) + (v.z * v.z + v.w * v.w); u32x2 o; o.x = pkbf(v.x, v.y); o.y = pkbf(v.z, v.w); o8[64 * j] = o; }
                    sq = wave_sum(sq); if (lane < 16) ss[(size_t)m * 16 + lane] = lane == 0 ? sq : 0.f;
                }
            }
            const int* positions = (const int*)args.in[1];
            for (int idx = bx * 512 + tid; idx < T * 32; idx += G * 512) {
                const int tk = idx >> 5, i = idx & 31;
                const float inv = 1.0f / exp2f((float)(2 * i) * (13.287712379549449f / 64.f));
                const float ang = (float)positions[tk] * inv;
                const double rev = (double)ang * 0.15915494309189535;
                const float fr = (float)(rev - rint(rev));
                f32x2 v; v.x = __builtin_amdgcn_cosf(fr); v.y = __builtin_amdgcn_sinf(fr);
                tab[idx] = v;
            }
            for (int idx = bx * 512 + tid; idx < 64 * 256; idx += G * 512) {
                const int sj = idx >> 8, i = idx & 255, q = i >> 2, rem = i & 3;
                OVT[idx] = (bf16)(rem < 3 ? (q == sj ? 0x3F80 : 0) : ((q == sj || q + 1 == sj) ? 0x3F00 : 0));
            }
            if (bx < 2 && tid < 256) {
                const float* pe = (const float*)args.in[18] + (size_t)bx * 2048;
                const float* w1 = (const float*)args.in[19] + (size_t)bx * 2048 * 256 + tid;
                float acc = ((const float*)args.in[20])[bx * 256 + tid];
                for (int k = 0; k < 2048; ++k) acc += pe[k] * w1[(size_t)k * 256];
                ((float*)(ws + WS_BP))[bx * 256 + tid] = acc;
            }
        } break;
        case 2: {
            const bf16* Ah = (s & 1) ? (const bf16*)(ws + WS_R + 192 * MiB) : HN;
            pg8::Gemm g{Ah, (const bf16*)(ws + WS_WGU) + (size_t)s * 2 * FF * D, T, 2 * FF, D}; pg8::StaticOrder SO; SO.init(T, 2 * FF, G, bx);
            float* rtab = (float*)(lds + 131072);
            rstd_table(rtab, (const float*)(ws + WS_SS) + (size_t)s * T * 16, SO, tid);
            pg8::EpiSwiGLU E{RB, rtab};
            pg8::gemm_phase<pg8::EpiSwiGLU, pg8::StaticOrder, true, true>(ldsl, g, SO, E, tid); } break;
        case 3: {
            pg8::Gemm g{RB, (const bf16*)(ws + WS_WDN) + (size_t)s * D * FF, T, D, FF}; pg8::StaticOrder SO; SO.init(T, D, G, bx);
            const int slot = (s & 1) ? (s < 7 ? s + 1 : 12) : 8 + (s >> 1);
            pg8::EpiResid<1> E{s == 0 ? (const float*)args.in[0] : hout, hout, HN, (float*)(ws + WS_SS) + (size_t)slot * T * 16};
            pg8::gemm_phase<pg8::EpiResid<1>, pg8::StaticOrder, true, true>(ldsl, g, SO, E, tid); } break;
        case 5: {
            const bf16* Wt; int Np, ldc, nmain, ldt, nvalid; float* tail;
            if (kind == 0) { Wt = (const bf16*)(ws + WS_WGI) + (size_t)jj * GDN_NPAD * D; Np = GDN_NPAD; ldc = 4096; nmain = 4096; tail = (float*)(ws + WS_AB); ldt = 16; nvalid = 4112; }
            else if (kind == 1) { Wt = (const bf16*)(ws + WS_WSI); Np = 3072; ldc = 3072; nmain = 3072; tail = (float*)(ws + WS_AB); ldt = 16; nvalid = 3072; }
            else { Wt = (const bf16*)(ws + WS_WNI); Np = NSA_NPAD; ldc = 2560; nmain = 2560; tail = (float*)(ws + WS_GT); ldt = 48; nvalid = 2608; }
            pg8::Gemm g{HN, Wt, T, Np, D}; pg8::StaticOrder SO; SO.init(T, Np, G, bx);
            float* rtab = (float*)(lds + 131072);
            rstd_table(rtab, (const float*)(ws + WS_SS) + (size_t)(8 + L) * T * 16, SO, tid);
            pg8::EpiProj E{RB, ldc, nmain, tail, ldt, nvalid, rtab, (bf16*)(ws + WS_HALO), kind == 0 ? 1 : 0};
            pg8::gemm_phase<pg8::EpiProj, pg8::StaticOrder, true, true>(ldsl, g, SO, E, tid); } break;
        case 14: phase_gdn_halo(RB, (bf16*)(ws + WS_HALO), vcu * 512 + tid, G * 512); break;
        case 15: phase_gdn_prep(lds, RB, (const bf16*)(ws + WS_HALO), (const float*)(ws + WS_AB), (const float*)args.in[7] + (size_t)jj * 4 * 3072, (const float*)args.in[8] + jj * 8, (const float*)args.in[9] + jj * 8,
                                HN, (bf16*)(ws + WS_O32 + 64 * MiB), (float*)(ws + WS_GL), bx, G, tid, wid, lane); break;
        case 6:
#ifndef DIS_SCAN
            phase_gdn_scan2(lds, RB, HN, (const bf16*)(ws + WS_O32 + 64 * MiB), (const float*)(ws + WS_GL), (bf16*)(ws + WS_O32), bx, G, tid, wid, lane);
#endif
            break;
        case 7:
#ifndef DIS_GPOST
            phase_gdn_post((const bf16*)(ws + WS_O32), RB, (const float*)args.in[10] + jj * 128, HN, gw, NGW, lane);
#endif
            break;
        case 8:
#ifndef DIS_SPOST
            phase_sc_post(RB, (const float*)args.in[13], HN, vcu * 512 + tid, G * 512);
#endif
            break;
        case 9:
#ifndef DIS_NPOST
            phase_nsa_post(lds, RB, (const float*)args.in[16], (const float*)args.in[17], tab, QN, KSb, KWb, KCH, VCH, VST, VWT, gw, NGW, wid, lane);
#endif
            break;
        case 10: {
            pg8::Gemm g{KCH, (const bf16*)(ws + WS_WC1), 8192, 512, 1024}; pg8::StaticOrder SO; SO.init(8192, 512, G, bx);
            pg8::Gemm g2{VCH, (const bf16*)(ws + WS_WC1) + (size_t)512 * 1024, 8192, 512, 1024};
            pg8::EpiF32 E{Pk, 512};
            if (bx >= G / 2) { g = g2; SO.init(8192, 512, G, bx - G / 2); E.C = Pv; }
            pg8::gemm_phase<pg8::EpiF32, pg8::StaticOrder, true, true>(ldsl, g, SO, E, tid); } break;
        case 11:
#ifndef DIS_CMP2
            phase_cmp2(lds, Pk, Pv, (const float*)(ws + WS_BP), (const float*)args.in[21], (const float*)args.in[22], (const float*)args.in[17], KC, VC, gw, NGW, wid, lane, tid);
#endif
            break;
        case 12:
#ifndef DIS_ATTN
            phase_nsa_attn(lds, QN, KSb, KWb, VST, VWT, KC, VC, OVT, (const float*)(ws + WS_GT), tab, HN, bx, G, tid, wid, lane);
#endif
            break;
        default: {
            const bf16* Wout = kind == 0 ? (const bf16*)(ws + WS_WGO) + (size_t)jj * D * D : (kind == 1 ? (const bf16*)(ws + WS_WSO) : (const bf16*)(ws + WS_WNO));
            pg8::Gemm g{HN, Wout, T, D, D}; pg8::StaticOrder SO; SO.init(T, D, G, bx);
            pg8::EpiResid<2> E{hout, hout, (bf16*)(ws + WS_R + 192 * MiB), (float*)(ws + WS_SS) + (size_t)(2 * L + 1) * T * 16};
            pg8::gemm_phase<pg8::EpiResid<2>, pg8::StaticOrder, true, true>(ldsl, g, SO, E, tid); } break;
        }
#ifdef REP_TYPE
        if (type == REP_TYPE && !again) { again = true; xcd_barrier(xbar); --ph; continue; }
        again = false;
#endif
        if (ph + 1 < args.hi) { if (args.hi < 0) grid.sync(); else xcd_barrier(xbar); }
    }
}

extern "C" void kernel_launch(void* const* d_in, const int* in_sizes, int n_in, void* d_out, int out_size, void* d_ws, size_t ws_size, hipStream_t stream) {
    static int grid = 0;
    if (grid == 0) {
        if (n_in != 24 || out_size != T * D || ws_size < WS_END2) { fprintf(stderr, "kernel_launch: unexpected shapes n_in %d out %d ws %zu (need %zu)\n", n_in, out_size, ws_size, (size_t)WS_END2); grid = -1; return; }
        int dev = 0, cus = 0, per_cu = 0;
        hipGetDevice(&dev); hipDeviceGetAttribute(&cus, hipDeviceAttributeMultiprocessorCount, dev);
        if (hipFuncSetAttribute((const void*)mega, hipFuncAttributeMaxDynamicSharedMemorySize, LDS_BYTES) != hipSuccess) { fprintf(stderr, "kernel_launch: hipFuncSetAttribute failed\n"); grid = -1; return; }
        if (hipOccupancyMaxActiveBlocksPerMultiprocessor(&per_cu, (const void*)mega, 512, LDS_BYTES) != hipSuccess || per_cu < 1) { fprintf(stderr, "kernel_launch: occupancy query says %d\n", per_cu); per_cu = 1; }
        (void)hipGetLastError();
        grid = cus;
    }
    if (grid < 0) return;
    Args a{};
    for (int i = 0; i < 24; ++i) a.in[i] = d_in[i];
    a.out = (float*)d_out; a.ws = (unsigned char*)d_ws;
    constexpr int NPH = total_phases();
#if MK_MULTI
    for (int p = 0; p < NPH; ++p) { a.lo = p; a.hi = p + 1; hipLaunchKernelGGL(mega, dim3(grid), dim3(512), LDS_BYTES, stream, a); }
#else
    a.lo = 0; a.hi = NPH;
    (void)hipMemsetAsync(d_ws, 0, 16384, stream);
    void* kargs[] = {&a};
    hipError_t e = hipLaunchCooperativeKernel((const void*)mega, dim3(grid), dim3(512), kargs, LDS_BYTES, stream);
    if (e != hipSuccess) fprintf(stderr, "cooperative launch failed: %s (grid %d)\n", hipGetErrorString(e), grid);
#endif
}
```

```cpp
#include <hip/hip_runtime.h>
#include <hip/hip_cooperative_groups.h>
#include <cstdio>
#include <cstdint>
namespace cg = cooperative_groups;
namespace pg8 {
#define PG8_LAS __attribute__((address_space(3)))
typedef unsigned short bf16_t;
typedef short bf16x8 __attribute__((ext_vector_type(8)));
typedef float f32x4 __attribute__((ext_vector_type(4)));
typedef unsigned u32x4 __attribute__((ext_vector_type(4)));
constexpr int BM = 256, BK = 64, HALF = 128, HTB = HALF * BK * 2  , STAGE_BYTES = 8 * HTB, NXCD = 8, WGM = 8;

__host__ __device__ __forceinline__ int lds_byte(int r, int c) { const int st = (r >> 4) * 2 + (c >> 5), rr = r & 15, cc = c & 31, ob = rr * 64 + cc * 2; return st * 1024 + (ob ^ (((ob >> 9) & 1) << 5)); }
__host__ __device__ __forceinline__ void stage_rc(int b, int& R, int& C) { const int st = b / 1024, sb = b % 1024, swz = sb ^ (((sb >> 9) & 1) << 5); R = (st >> 1) * 16 + swz / 64; C = (st & 1) * 32 + (swz % 64) / 2; }
__host__ __device__ __forceinline__ int perm32(int rho) { const int n = rho >> 4, i = rho & 15; return 8 * (i >> 2) + 4 * n + (i & 3); }

struct Unit { int pm, pn, ord; };
struct Gemm { const bf16_t* A; const bf16_t* Bt; int M, N, K; };

struct StaticOrder {
    int nM, nN, nwg, G, c;
    __host__ __device__ void init(int M, int N, int G_, int c_) { nM = M / BM; nN = N / BM; nwg = nM * nN; G = G_; c = c_; }
    __host__ __device__ bool next(int i, Unit& u) const {
        const long L = (long)i * G + c; if (L >= nwg) return false;
        int wgid = (int)L; { const int q = nwg / NXCD, r = nwg % NXCD, xcd = wgid % NXCD, off = wgid / NXCD; wgid = (xcd < r ? xcd * (q + 1) : r * (q + 1) + (xcd - r) * q) + off; }
        const int nig = WGM * nN, gid = wgid / nig, fm = gid * WGM, gsz = (nM - fm) < WGM ? (nM - fm) : WGM;
        u.pm = fm + ((wgid % nig) % gsz); u.pn = (wgid % nig) / gsz; u.ord = i; return true;
    }
    __device__ __forceinline__ void a_ready(const Unit&) const {}
    __device__ __forceinline__ void done(const Unit&) const {}
};
__device__ __forceinline__ unsigned cvt_pk_bf16(float lo, float hi) { unsigned r; asm volatile("v_cvt_pk_bf16_f32 %0, %1, %2" : "=v"(r) : "v"(lo), "v"(hi)); return r; }
template <class Epi, class Sched, bool ALIGN_EPI = false, bool SP2 = false>
__device__ __forceinline__ void gemm_phase(PG8_LAS unsigned char* lds, const Gemm g, const Sched& S, const Epi& E, const int tid) {
    const int wid = __builtin_amdgcn_readfirstlane(tid >> 6), lane = tid & 63, wr = wid >> 2, wc = wid & 3, fr = lane & 15, fq = lane >> 4;
    const int K = g.K, nt = K / BK;
    unsigned voffA[2], voffB[2];
#pragma unroll
    for (int i = 0; i < 2; ++i) { int R, C; stage_rc(tid * 16 + i * 8192, R, C); const int Rb = Epi::PERM ? ((R & ~31) + perm32(R & 31)) : R;
        voffA[i] = (unsigned)(R * K + C) * 2u; voffB[i] = (unsigned)(Rb * K + C) * 2u; }
    const size_t kstep = (size_t)(BK * 2);
    const size_t hstep = (size_t)HALF * K * 2;
    const size_t tstep = 2 * hstep;
    const unsigned ldsw = (unsigned)wid * 1024u;
    const int aoff = lds_byte(wr * 64 + fr, fq * 8), boff = lds_byte(wc * 32 + fr, fq * 8);
#define PG8_SA(b, h) (((b) * 2 + (h)) * HTB)
#define PG8_SB(b, h) ((4 + (b) * 2 + (h)) * HTB)
#define PG8_STAGE(bufoff, gbase, voff) do { _Pragma("unroll") for (int _i = 0; _i < 2; ++_i) \
        __builtin_amdgcn_global_load_lds((const unsigned*)((const char*)(gbase) + (voff)[_i]), (PG8_LAS unsigned*)(lds + (bufoff) + ldsw + _i * 8192), 16, 0, 0); } while (0)
#define PG8_LDA(dst, b, h) do { _Pragma("unroll") for (int m = 0; m < 4; ++m) _Pragma("unroll") for (int k = 0; k < 2; ++k) dst[m][k] = *(const PG8_LAS bf16x8*)(lds + PG8_SA(b, h) + aoff + m * 2048 + k * 1024); } while (0)
#define PG8_LDB(dst, b, h) do { _Pragma("unroll") for (int n = 0; n < 2; ++n) _Pragma("unroll") for (int k = 0; k < 2; ++k) dst[n][k] = *(const PG8_LAS bf16x8*)(lds + PG8_SB(b, h) + boff + n * 2048 + k * 1024); } while (0)
#define PG8_MMA(ai, bj, At, Bt) do { __builtin_amdgcn_s_setprio(1); _Pragma("unroll") for (int m = 0; m < 4; ++m) _Pragma("unroll") for (int n = 0; n < 2; ++n) _Pragma("unroll") for (int k = 0; k < 2; ++k) \
        acc[ai][bj][m][n] = __builtin_amdgcn_mfma_f32_16x16x32_bf16(Bt[n][k], At[m][k], acc[ai][bj][m][n], 0, 0, 0); __builtin_amdgcn_s_setprio(0); } while (0)
#define PG8_WAIT_V(n) asm volatile("s_waitcnt vmcnt(" #n ")" ::: "memory")
#define PG8_WAIT_L(n) asm volatile("s_waitcnt lgkmcnt(" #n ")" ::: "memory")
#define PG8_BAR __builtin_amdgcn_s_barrier()
#define PG8_SCHED __builtin_amdgcn_sched_barrier(0)
    Unit cur, nxt; int ui = 0;
    if (!S.next(0, cur)) return;
    f32x4 acc[2][2][4][2];
#pragma unroll
    for (int a = 0; a < 2; ++a)
#pragma unroll
        for (int b = 0; b < 2; ++b)
#pragma unroll
            for (int m = 0; m < 4; ++m)
#pragma unroll
                for (int n = 0; n < 2; ++n) acc[a][b][m][n] = (f32x4){0.f, 0.f, 0.f, 0.f};
    bf16x8 At[4][2], B0[2][2], B1[2][2];
    const char* cA = (const char*)g.A + (size_t)cur.pm * tstep; const char* cB = (const char*)g.Bt + (size_t)cur.pn * tstep;
    S.a_ready(cur);
    if constexpr (SP2) {
        PG8_STAGE(PG8_SB(0, 0), cB, voffB); PG8_STAGE(PG8_SB(0, 1), cB + hstep, voffB); PG8_STAGE(PG8_SA(0, 0), cA, voffA); PG8_STAGE(PG8_SA(0, 1), cA + hstep, voffA);
        if (wr == 1) PG8_BAR;
        PG8_WAIT_V(2); PG8_BAR;
        PG8_STAGE(PG8_SB(1, 0), cB + kstep, voffB); PG8_STAGE(PG8_SA(1, 0), cA + kstep, voffA); PG8_STAGE(PG8_SB(1, 1), cB + hstep + kstep, voffB);
        PG8_WAIT_V(6); PG8_BAR;
    } else {
        PG8_STAGE(PG8_SB(0, 0), cB, voffB); PG8_STAGE(PG8_SA(0, 0), cA, voffA); PG8_STAGE(PG8_SB(0, 1), cB + hstep, voffB); PG8_STAGE(PG8_SA(0, 1), cA + hstep, voffA);
        if (wr == 1) PG8_BAR;
        PG8_WAIT_V(4); PG8_BAR;
        PG8_STAGE(PG8_SB(1, 0), cB + kstep, voffB); PG8_STAGE(PG8_SA(1, 0), cA + kstep, voffA); PG8_STAGE(PG8_SB(1, 1), cB + hstep + kstep, voffB);
        PG8_WAIT_V(6); PG8_BAR;
    }
    for (;;) {
        const bool has_next = S.next(ui + 1, nxt);
        const char* nA = has_next ? (const char*)g.A + (size_t)nxt.pm * tstep : cA; const char* nB = has_next ? (const char*)g.Bt + (size_t)nxt.pn * tstep : cB;
        for (int t = 0; t < nt; t += 2) {
            const bool last = (t == nt - 2);
            const char* a1 = cA + (size_t)(t + 1) * kstep;
            const char* a2 = last ? nA : cA + (size_t)(t + 2) * kstep; const char* b2 = last ? nB : cB + (size_t)(t + 2) * kstep;
            const char* a3 = a2 + kstep; const char* b3 = b2 + kstep;
            if (last && has_next) S.a_ready(nxt);
            if constexpr (SP2) {
            PG8_LDB(B0, 0, 0); PG8_LDB(B1, 0, 1); PG8_SCHED; PG8_LDA(At, 0, 0); PG8_STAGE(PG8_SA(1, 1), a1 + hstep, voffA);
            PG8_WAIT_V(8); PG8_WAIT_L(0); PG8_BAR; PG8_MMA(0, 0, At, B0); PG8_MMA(0, 1, At, B1); PG8_BAR; PG8_SCHED;
            PG8_LDA(At, 0, 1); PG8_STAGE(PG8_SB(0, 0), b2, voffB); PG8_STAGE(PG8_SB(0, 1), b2 + hstep, voffB); PG8_STAGE(PG8_SA(0, 0), a2, voffA);
            PG8_WAIT_V(8); PG8_WAIT_L(0); PG8_BAR; PG8_MMA(1, 0, At, B0); PG8_MMA(1, 1, At, B1); PG8_BAR; PG8_SCHED;
            PG8_LDB(B0, 1, 0); PG8_LDB(B1, 1, 1); PG8_SCHED; PG8_LDA(At, 1, 0); PG8_STAGE(PG8_SA(0, 1), a2 + hstep, voffA);
            PG8_WAIT_V(8); PG8_WAIT_L(0); PG8_BAR; PG8_MMA(0, 0, At, B0); PG8_MMA(0, 1, At, B1); PG8_BAR; PG8_SCHED;
            PG8_LDA(At, 1, 1); PG8_STAGE(PG8_SB(1, 0), b3, voffB); PG8_STAGE(PG8_SB(1, 1), b3 + hstep, voffB); PG8_STAGE(PG8_SA(1, 0), a3, voffA);
            PG8_WAIT_V(8); PG8_WAIT_L(0); PG8_BAR; PG8_MMA(1, 0, At, B0); PG8_MMA(1, 1, At, B1); PG8_BAR; PG8_SCHED;
            } else {
            PG8_LDB(B0, 0, 0); PG8_SCHED; PG8_LDA(At, 0, 0); PG8_STAGE(PG8_SA(1, 1), a1 + hstep, voffA);
            PG8_WAIT_L(8); PG8_BAR; PG8_WAIT_L(0); PG8_MMA(0, 0, At, B0); PG8_BAR; PG8_SCHED;
            PG8_LDB(B1, 0, 1); PG8_STAGE(PG8_SB(0, 0), b2, voffB);
            PG8_BAR; PG8_WAIT_L(0); PG8_MMA(0, 1, At, B1); PG8_BAR;
            PG8_LDA(At, 0, 1); PG8_STAGE(PG8_SA(0, 0), a2, voffA);
            PG8_BAR; PG8_WAIT_L(0); PG8_MMA(1, 0, At, B0); PG8_BAR; PG8_SCHED;
            PG8_STAGE(PG8_SB(0, 1), b2 + hstep, voffB);
            PG8_WAIT_V(6); PG8_BAR; PG8_MMA(1, 1, At, B1); PG8_BAR;
            PG8_LDB(B0, 1, 0); PG8_SCHED; PG8_LDA(At, 1, 0); PG8_STAGE(PG8_SA(0, 1), a2 + hstep, voffA);
            PG8_WAIT_L(8); PG8_BAR; PG8_WAIT_L(0); PG8_MMA(0, 0, At, B0); PG8_BAR; PG8_SCHED;
            PG8_LDB(B1, 1, 1); PG8_STAGE(PG8_SB(1, 0), b3, voffB);
            PG8_BAR; PG8_WAIT_L(0); PG8_MMA(0, 1, At, B1); PG8_BAR;
            PG8_LDA(At, 1, 1); PG8_STAGE(PG8_SA(1, 0), a3, voffA);
            PG8_BAR; PG8_WAIT_L(0); PG8_MMA(1, 0, At, B0); PG8_BAR; PG8_SCHED;
            PG8_STAGE(PG8_SB(1, 1), b3 + hstep, voffB);
            PG8_WAIT_V(6); PG8_BAR; PG8_MMA(1, 1, At, B1); PG8_BAR;
            }
        }
        if constexpr (ALIGN_EPI) { if (wr == 0) PG8_BAR; }
        if constexpr (!Epi::AFTER_DRAIN) { E(acc, cur, wr, wc, fr, fq); S.done(cur); }
        if (!has_next) break;
#pragma unroll
        for (int a = 0; a < 2; ++a)
#pragma unroll
            for (int b = 0; b < 2; ++b)
#pragma unroll
                for (int m = 0; m < 4; ++m)
#pragma unroll
                    for (int n = 0; n < 2; ++n) acc[a][b][m][n] = (f32x4){0.f, 0.f, 0.f, 0.f};
        cur = nxt; cA = nA; cB = nB; ++ui;
        if constexpr (ALIGN_EPI) { if (wr == 1) PG8_BAR; }
    }
    PG8_WAIT_V(0);
    if constexpr (!ALIGN_EPI) { if (wr == 0) PG8_BAR; }
    PG8_BAR;
    if constexpr (Epi::AFTER_DRAIN) { E.fused(acc, cur, wr, wc, fr, fq, lds, wid, lane); S.done(cur); }
#undef PG8_SA
#undef PG8_SB
#undef PG8_STAGE
#undef PG8_LDA
#undef PG8_LDB
#undef PG8_MMA
#undef PG8_WAIT_V
#undef PG8_WAIT_L
#undef PG8_BAR
#undef PG8_SCHED
}
}

typedef unsigned short bf16;
typedef float f32x4 __attribute__((ext_vector_type(4)));
typedef float f32x2 __attribute__((ext_vector_type(2)));
typedef unsigned u32x4 __attribute__((ext_vector_type(4)));
typedef unsigned u32x2 __attribute__((ext_vector_type(2)));

#ifndef MK_MULTI
#define MK_MULTI 0
#endif

constexpr int Bn = 8, S = 4096, T = Bn * S, D = 1024, FF = 2816, DEPTH = 4;
constexpr float EPS = 1e-6f;
constexpr int GDN_NPAD = 4352, NSA_NPAD = 2816;
constexpr int LDS_BYTES = 147456;
constexpr size_t MiB = 1u << 20;
constexpr size_t WS_WGU = 1 * MiB;
constexpr size_t WS_WDN = WS_WGU + 88 * MiB;
constexpr size_t WS_WGI = WS_WDN + 44 * MiB;
constexpr size_t WS_WGO = WS_WGI + 17 * MiB;
constexpr size_t WS_WSI = WS_WGO + 4 * MiB;
constexpr size_t WS_WSO = WS_WSI + 6 * MiB;
constexpr size_t WS_WNI = WS_WSO + 2 * MiB;
constexpr size_t WS_WNO = WS_WNI + 6 * MiB;
constexpr size_t WS_WC1 = WS_WNO + 2 * MiB;
constexpr size_t WS_TAB = WS_WC1 + 2 * MiB;
constexpr size_t WS_HN  = 184 * MiB;
constexpr size_t WS_R   = WS_HN + 64 * MiB;
constexpr size_t WS_O32 = WS_R + 256 * MiB;
constexpr size_t WS_SM  = WS_O32 + 128 * MiB;
constexpr size_t WS_AB  = WS_SM;
constexpr size_t WS_GT  = WS_SM + 2 * MiB;
constexpr size_t WS_BP  = WS_SM + 8 * MiB;
constexpr size_t WS_END = WS_SM + 9 * MiB;
static_assert(WS_TAB + 8 * MiB <= WS_HN, "ws map");

__device__ __forceinline__ float bf2f(unsigned v) { return __uint_as_float(v << 16); }
__device__ __forceinline__ unsigned f2bf(float f) { unsigned u = __float_as_uint(f); return (u + 0x7fffu + ((u >> 16) & 1u)) >> 16; }
__device__ __forceinline__ unsigned pk2(float lo, float hi) { return f2bf(lo) | (f2bf(hi) << 16); }
#define MFMA32(a, b, c) __builtin_amdgcn_mfma_f32_32x32x16_bf16((a), (b), (c), 0, 0, 0)
typedef short bf16x8v __attribute__((ext_vector_type(8)));
typedef float f32x16 __attribute__((ext_vector_type(16)));
typedef __bf16 bf16v2 __attribute__((ext_vector_type(2)));
__device__ __forceinline__ unsigned pkbf(float a, float b) { f32x2 v = {a, b}; return __builtin_bit_cast(unsigned, __builtin_convertvector(v, bf16v2)); }
__device__ __forceinline__ int lane_opq() { int l = (int)__builtin_amdgcn_mbcnt_hi(~0u, __builtin_amdgcn_mbcnt_lo(~0u, 0u)); asm volatile("" : "+v"(l)); return l; }
__device__ __forceinline__ float xshfl(float v, int m) { return __int_as_float(__builtin_amdgcn_ds_bpermute((lane_opq() ^ m) << 2, __float_as_int(v))); }
__device__ __forceinline__ float xshfl_up(float v, int o) { return __int_as_float(__builtin_amdgcn_ds_bpermute((lane_opq() - o) << 2, __float_as_int(v))); }
__device__ __forceinline__ float wave_sum(float v) {
#pragma unroll
    for (int o = 1; o < 64; o <<= 1) v += xshfl(v, o);
    return v;
}
__device__ __forceinline__ float wave_max(float v) {
#pragma unroll
    for (int o = 1; o < 64; o <<= 1) v = fmaxf(v, xshfl(v, o));
    return v;
}
__device__ __forceinline__ float row_sum16(float v) {
    v += __uint_as_float((unsigned)__builtin_amdgcn_update_dpp(0, (int)__float_as_uint(v), 0x128, 0xf, 0xf, false));
    v += __uint_as_float((unsigned)__builtin_amdgcn_update_dpp(0, (int)__float_as_uint(v), 0x124, 0xf, 0xf, false));
    v += __uint_as_float((unsigned)__builtin_amdgcn_update_dpp(0, (int)__float_as_uint(v), 0x122, 0xf, 0xf, false));
    v += __uint_as_float((unsigned)__builtin_amdgcn_update_dpp(0, (int)__float_as_uint(v), 0x121, 0xf, 0xf, false));
    return v;
}
__device__ __forceinline__ float sigmoidf_(float x) { return 1.f / (1.f + __expf(-x)); }
__device__ __forceinline__ float siluf_(float x) { return x * __builtin_amdgcn_rcpf(1.f + __expf(-x)); }
#define LDS_BAR() do { asm volatile("s_waitcnt lgkmcnt(0)" ::: "memory"); __builtin_amdgcn_s_barrier(); asm volatile("" ::: "memory"); } while (0)
#define WAVE_SYNC() do { asm volatile("s_waitcnt lgkmcnt(0)" ::: "memory"); __builtin_amdgcn_wave_barrier(); } while (0)

__device__ __forceinline__ float row_rstd(const float* ssq, size_t row) {
    const f32x4* p = (const f32x4*)(ssq + row * 16); const f32x4 a = p[0], b = p[1], c = p[2], d = p[3];
    const float t = ((a.x + a.y) + (a.z + a.w)) + ((b.x + b.y) + (b.z + b.w)) + ((c.x + c.y) + (c.z + c.w)) + ((d.x + d.y) + (d.z + d.w));
    return 1.f / sqrtf(t * (1.f / D) + EPS);
}
namespace pg8 {
struct EpiSwiGLU {
    static constexpr bool PERM = true, AFTER_DRAIN = false;
    bf16_t* O; const float* ssq;
    __device__ __forceinline__ void operator()(const f32x4 (&acc)[2][2][4][2], const Unit& u, int wr, int wc, int fr, int fq) const {
        const int row0 = u.pm * BM + wr * 64 + fr, col0 = u.pn * HALF + wc * 32 + 8 * fq;
#pragma unroll
        for (int ai = 0; ai < 2; ++ai)
#pragma unroll
            for (int m = 0; m < 4; ++m) {
                bf16_t* rowp = O + (size_t)(row0 + ai * HALF + m * 16) * FF + col0;
                const float rs = ssq[u.ord * 256 + wr * 64 + fr + ai * HALF + m * 16];
                const f32x2 rs2 = {rs, rs}, nl2 = {-1.4426950408889634f, -1.4426950408889634f}, one2 = {1.f, 1.f};
                unsigned wv[4];
#pragma unroll
                for (int n = 0; n < 2; ++n)
#pragma unroll
                    for (int hf = 0; hf < 2; ++hf) {
                        const f32x2 g = (f32x2){acc[ai][0][m][n][2 * hf], acc[ai][0][m][n][2 * hf + 1]} * rs2;
                        const f32x2 uu = (f32x2){acc[ai][1][m][n][2 * hf], acc[ai][1][m][n][2 * hf + 1]} * rs2;
                        const f32x2 t = g * nl2;
                        f32x2 e; e.x = __builtin_amdgcn_exp2f(t.x); e.y = __builtin_amdgcn_exp2f(t.y);
                        const f32x2 d = e + one2;
                        f32x2 rc; rc.x = __builtin_amdgcn_rcpf(d.x); rc.y = __builtin_amdgcn_rcpf(d.y);
                        const f32x2 v = (g * rc) * uu;
                        wv[2 * n + hf] = cvt_pk_bf16(v.x, v.y);
                    }
                u32x4 w; w.x = wv[0]; w.y = wv[1]; w.z = wv[2]; w.w = wv[3];
                *(u32x4*)rowp = w;
            }
    }
};
template <int SC2> struct EpiResid {
    static constexpr bool PERM = true, AFTER_DRAIN = false;
    const float* base; float* out; bf16_t* HB; float* ssq;
    __device__ __forceinline__ void operator()(const f32x4 (&acc)[2][2][4][2], const Unit& u, int wr, int wc, int fr, int fq) const {
        constexpr float scale = 0.5f * SC2;
        const int row0 = u.pm * BM + wr * 64 + fr, col0 = u.pn * BM + wc * 32 + 8 * fq;
#pragma unroll
        for (int ai = 0; ai < 2; ++ai)
#pragma unroll
            for (int m = 0; m < 4; ++m) {
                const size_t off = (size_t)(row0 + ai * HALF + m * 16) * D + col0;
                float sq = 0.f;
#pragma unroll
                for (int bj = 0; bj < 2; ++bj) {
                    const f32x4 b0 = *(const f32x4*)(base + off + bj * HALF), b1 = *(const f32x4*)(base + off + bj * HALF + 4);
                    const f32x4 o0 = b0 + acc[ai][bj][m][0] * scale, o1 = b1 + acc[ai][bj][m][1] * scale;
                    *(f32x4*)(out + off + bj * HALF) = o0; *(f32x4*)(out + off + bj * HALF + 4) = o1;
                    { u32x4 w; w.x = cvt_pk_bf16(o0[0], o0[1]); w.y = cvt_pk_bf16(o0[2], o0[3]); w.z = cvt_pk_bf16(o1[0], o1[1]); w.w = cvt_pk_bf16(o1[2], o1[3]);
                        *(u32x4*)(HB + off + bj * HALF) = w;
                        sq += ((o0[0] * o0[0] + o0[1] * o0[1]) + (o0[2] * o0[2] + o0[3] * o0[3])) + ((o1[0] * o1[0] + o1[1] * o1[1]) + (o1[2] * o1[2] + o1[3] * o1[3])); }
                }
                { sq += xshfl(sq, 16); sq += xshfl(sq, 32); if (fq == 0) ssq[(size_t)(row0 + ai * HALF + m * 16) * 16 + u.pn * 4 + wc] = sq; }
                if (m == 3) asm volatile("" ::: "memory");
            }
    }
};
struct EpiProj {
    static constexpr bool PERM = true, AFTER_DRAIN = false;
    bf16_t* O; int ldc; int nmain; float* tail; int ldt; int nvalid; const float* ssq; bf16_t* halo; int halo_on;
    __device__ __forceinline__ void operator()(const f32x4 (&acc)[2][2][4][2], const Unit& u, int wr, int wc, int fr, int fq) const {
        const int row0 = u.pm * BM + wr * 64 + fr, colt = u.pn * BM, col0 = colt + wc * 32 + 8 * fq;
        if (colt + BM <= nmain) {
#pragma unroll
            for (int ai = 0; ai < 2; ++ai)
#pragma unroll
                for (int m = 0; m < 4; ++m) {
                    bf16_t* rowp = O + (size_t)(row0 + ai * HALF + m * 16) * ldc + col0;
                    const float rs = ssq[u.ord * 256 + wr * 64 + fr + ai * HALF + m * 16];
#pragma unroll
                    for (int bj = 0; bj < 2; ++bj) { const f32x4 v0 = acc[ai][bj][m][0] * rs, v1 = acc[ai][bj][m][1] * rs;
                        u32x4 w; w.x = cvt_pk_bf16(v0[0], v0[1]); w.y = cvt_pk_bf16(v0[2], v0[3]); w.z = cvt_pk_bf16(v1[0], v1[1]); w.w = cvt_pk_bf16(v1[2], v1[3]);
                        *(u32x4*)(rowp + bj * HALF) = w;
                        if (halo_on && m == 3 && fr >= 13 && u.pn < 12) {
                            const int row = row0 + ai * HALF + m * 16, n1 = ((row & (S - 1)) >> 6) + 1;
                            if (n1 < 64) *(u32x4*)(halo + (size_t)(((row >> 12) * 64 + n1) * 3 + (fr - 13)) * 3072 + col0 + bj * HALF) = w;
                        } }
                }
        } else {
#pragma unroll
            for (int ai = 0; ai < 2; ++ai)
#pragma unroll
                for (int m = 0; m < 4; ++m) {
                    const size_t row = (size_t)(row0 + ai * HALF + m * 16);
                    const float rs = ssq[u.ord * 256 + wr * 64 + fr + ai * HALF + m * 16];
#pragma unroll
                    for (int bj = 0; bj < 2; ++bj)
#pragma unroll
                        for (int n = 0; n < 2; ++n)
#pragma unroll
                            for (int j = 0; j < 4; ++j) { const int col = col0 + bj * HALF + 4 * n + j; if (col >= nmain && col < nvalid) tail[row * ldt + (col - nmain)] = acc[ai][bj][m][n][j] * rs; }
                }
        }
    }
};
struct EpiF32 {
    static constexpr bool PERM = false, AFTER_DRAIN = false;
    float* C; int ldc;
    __device__ __forceinline__ void operator()(const f32x4 (&acc)[2][2][4][2], const Unit& u, int wr, int wc, int fr, int fq) const {
        const int row0 = u.pm * BM + wr * 64 + fr, col0 = u.pn * BM + wc * 32 + 4 * fq;
#pragma unroll
        for (int ai = 0; ai < 2; ++ai)
#pragma unroll
            for (int m = 0; m < 4; ++m) {
                float* rowp = C + (size_t)(row0 + ai * HALF + m * 16) * ldc + col0;
#pragma unroll
                for (int bj = 0; bj < 2; ++bj)
#pragma unroll
                    for (int n = 0; n < 2; ++n) *(f32x4*)(rowp + bj * HALF + n * 16) = acc[ai][bj][m][n];
            }
    }
};
}

template <class Sched>
__device__ __forceinline__ void rstd_table(float* tab, const float* ssq, const Sched& SO, int tid) {
    pg8::Unit u;
    int nu = 0; while (SO.next(nu, u)) ++nu;
    for (int k0 = 0; k0 < nu * 256; k0 += 512 * 3) {
        float t3[3];
#pragma unroll
        for (int k = 0; k < 3; ++k) { const int idx = k0 + 512 * k + tid; t3[k] = 0.f; if (idx < nu * 256) { SO.next(idx >> 8, u); t3[k] = row_rstd(ssq, (size_t)u.pm * 256 + (idx & 255)); } }
#pragma unroll
        for (int k = 0; k < 3; ++k) { const int idx = k0 + 512 * k + tid; if (idx < nu * 256) tab[idx] = t3[k]; }
    }
    __syncthreads();
}
__device__ __forceinline__ void xpose_item(const float* W, const float* nw, int K, int N, bf16* WT, int rowbase, float* scr, int k0, int n0, int lane) {
    if (n0 + 32 <= N && (N & 3) == 0) {
        f32x4 v[8];
#pragma unroll
        for (int i = 0; i < 8; ++i) { v[i] = *(const f32x4*)(W + (size_t)(k0 + 8 * i + (lane >> 3)) * N + n0 + 4 * (lane & 7)); if (nw) v[i] *= nw[k0 + 8 * i + (lane >> 3)]; }
#pragma unroll
        for (int i = 0; i < 8; ++i) { float* d = scr + (8 * i + (lane >> 3)) * 33 + 4 * (lane & 7); d[0] = v[i].x; d[1] = v[i].y; d[2] = v[i].z; d[3] = v[i].w; }
    } else {
#pragma unroll 8
        for (int i = 0; i < 32; ++i) { const int kk = 2 * i + (lane >> 5), n = n0 + (lane & 31); scr[kk * 33 + (lane & 31)] = n < N ? W[(size_t)(k0 + kk) * N + n] * (nw ? nw[k0 + kk] : 1.f) : 0.f; }
    }
    WAVE_SYNC();
    const int c = lane & 7;
#pragma unroll
    for (int j = 0; j < 4; ++j) { const int n = (lane >> 3) + 8 * j; const float* s = scr + (8 * c) * 33 + n;
        u32x4 o; o.x = pk2(s[0 * 33], s[1 * 33]); o.y = pk2(s[2 * 33], s[3 * 33]); o.z = pk2(s[4 * 33], s[5 * 33]); o.w = pk2(s[6 * 33], s[7 * 33]);
        *(u32x4*)(WT + (size_t)(rowbase + n) * K + k0 + 8 * c) = o; }
    WAVE_SYNC();
}
__device__ __forceinline__ int xpose_rowbase(int mode, int n0) {
    return mode == 1 ? ((n0 < FF) ? ((n0 >> 7) * 256 + (n0 & 127)) : ((((n0 - FF) >> 7) * 256) + 128 + ((n0 - FF) & 127))) : n0;
}
__device__ __forceinline__ void xpose_matrix(const float* W, const float* nw, int K, int N, int Npad, bf16* WT, int mode, float* scr, int gw, int NGW, int lane) {
    const int nblk = Npad / 32, nitems = (K / 64) * nblk;
    float* scr2 = scr + 8 * 64 * 33;
    for (int it = gw; it < nitems; it += 2 * NGW) {
        const int itb = it + NGW;
        const int kbA = it / nblk, n0A = (it - kbA * nblk) * 32, kbB = itb / nblk, n0B = (itb - kbB * nblk) * 32;
        if (itb < nitems && n0A + 32 <= N && n0B + 32 <= N && (N & 3) == 0) {
            f32x4 va[8], vb[8];
#pragma unroll
            for (int i = 0; i < 8; ++i) { va[i] = *(const f32x4*)(W + (size_t)(kbA * 64 + 8 * i + (lane >> 3)) * N + n0A + 4 * (lane & 7)); vb[i] = *(const f32x4*)(W + (size_t)(kbB * 64 + 8 * i + (lane >> 3)) * N + n0B + 4 * (lane & 7)); }
            if (nw) {
#pragma unroll
                for (int i = 0; i < 8; ++i) { va[i] *= nw[kbA * 64 + 8 * i + (lane >> 3)]; vb[i] *= nw[kbB * 64 + 8 * i + (lane >> 3)]; }
            }
#pragma unroll
            for (int i = 0; i < 8; ++i) { float* d = scr + (8 * i + (lane >> 3)) * 33 + 4 * (lane & 7); d[0] = va[i].x; d[1] = va[i].y; d[2] = va[i].z; d[3] = va[i].w;
                float* e = scr2 + (8 * i + (lane >> 3)) * 33 + 4 * (lane & 7); e[0] = vb[i].x; e[1] = vb[i].y; e[2] = vb[i].z; e[3] = vb[i].w; }
            WAVE_SYNC();
            const int c = lane & 7, rbA = xpose_rowbase(mode, n0A), rbB = xpose_rowbase(mode, n0B);
#pragma unroll
            for (int j = 0; j < 4; ++j) { const int n = (lane >> 3) + 8 * j; const float* sa = scr + (8 * c) * 33 + n; const float* sb = scr2 + (8 * c) * 33 + n;
                u32x4 o; o.x = pk2(sa[0 * 33], sa[1 * 33]); o.y = pk2(sa[2 * 33], sa[3 * 33]); o.z = pk2(sa[4 * 33], sa[5 * 33]); o.w = pk2(sa[6 * 33], sa[7 * 33]);
                *(u32x4*)(WT + (size_t)(rbA + n) * K + kbA * 64 + 8 * c) = o;
                u32x4 q; q.x = pk2(sb[0 * 33], sb[1 * 33]); q.y = pk2(sb[2 * 33], sb[3 * 33]); q.z = pk2(sb[4 * 33], sb[5 * 33]); q.w = pk2(sb[6 * 33], sb[7 * 33]);
                *(u32x4*)(WT + (size_t)(rbB + n) * K + kbB * 64 + 8 * c) = q; }
            WAVE_SYNC();
        } else {
            xpose_item(W, nw, K, N, WT, xpose_rowbase(mode, n0A), scr, kbA * 64, n0A, lane);
            if (itb < nitems) xpose_item(W, nw, K, N, WT, xpose_rowbase(mode, n0B), scr, kbB * 64, n0B, lane);
        }
    }
}

__device__ __forceinline__ void phase_norm(const float* h, const float* w, bf16* out, int gw, int NGW, int lane) {
    f32x4 wv[4];
#pragma unroll
    for (int j = 0; j < 4; ++j) wv[j] = ((const f32x4*)w)[64 * j + lane];
    for (int m = gw; m < T; m += NGW) {
        const f32x4* xr = (const f32x4*)(h + (size_t)m * D) + lane;
        f32x4 v[4]; float s = 0.f;
#pragma unroll
        for (int j = 0; j < 4; ++j) { v[j] = xr[64 * j]; s += (v[j].x * v[j].x + v[j].y * v[j].y) + (v[j].z * v[j].z + v[j].w * v[j].w); }
        const float rstd = 1.f / sqrtf(wave_sum(s) * (1.f / D) + EPS);
        u32x2* o8 = (u32x2*)(out + (size_t)m * D) + lane;
#pragma unroll
        for (int j = 0; j < 4; ++j) { u32x2 o; o.x = pk2(v[j].x * rstd * wv[j].x, v[j].y * rstd * wv[j].y); o.y = pk2(v[j].z * rstd * wv[j].z, v[j].w * rstd * wv[j].w); o8[64 * j] = o; }
    }
}

__device__ __forceinline__ void phase_gdn_scan(unsigned char* lds, const bf16* proj, const float* ab, const float* convw, const float* A_log, const float* dt_bias,
                                               float* o32, int vblk, int nblk, int tid, int wid, int lane) {
    float* qs = (float*)lds;
    float* ks = qs + 64 * 128;
    float* vs = ks + 64 * 128;
    float* al = vs + 64 * 32;
    float* be = al + 64;
    float* qk = be + 64;
    float* os = qk + 64;
    bf16* raw = (bf16*)(os + 64 * 32);
    const int e = tid >> 4, dl = tid & 15;
    for (int item = vblk; item < 256; item += nblk) {
        const int bh = (item & 7) + 8 * (item >> 5), es = (item >> 3) & 3, b = bh >> 3, h = bh & 7;
        const float Ah = __expf(A_log[h]), dtb = dt_bias[h];
        const int isk = (tid >> 4) & 1, cg = tid & 15, cv = tid & 3;
        const int colqk = isk * 1024 + h * 128 + cg * 8, colv = 2048 + h * 128 + es * 32 + cv * 8;
        f32x4 wq[4][2], wv[4][2];
#pragma unroll
        for (int j = 0; j < 4; ++j) { wq[j][0] = *(const f32x4*)(convw + j * 3072 + colqk); wq[j][1] = *(const f32x4*)(convw + j * 3072 + colqk + 4);
                                      wv[j][0] = *(const f32x4*)(convw + j * 3072 + colv);  wv[j][1] = *(const f32x4*)(convw + j * 3072 + colv + 4); }
        f32x2 S2[4];
#pragma unroll
        for (int i = 0; i < 4; ++i) S2[i] = (f32x2){0.f, 0.f};
        u32x4 pre[5];
#define GDN_PREFETCH(T0) do { _Pragma("unroll") for (int k_ = 0; k_ < 5; ++k_) { const int idx_ = tid + 512 * k_; const int row_ = idx_ / 36, c_ = idx_ - row_ * 36; const int ts_ = (T0) - 3 + row_; \
            const int col_ = c_ < 16 ? h * 128 + c_ * 8 : (c_ < 32 ? 1024 + h * 128 + (c_ - 16) * 8 : 2048 + h * 128 + es * 32 + (c_ - 32) * 8); \
            pre[k_] = (u32x4){0u, 0u, 0u, 0u}; if (idx_ < 67 * 36 && ts_ >= 0) pre[k_] = *(const u32x4*)(proj + (size_t)(b * S + ts_) * 4096 + col_); } } while (0)
#define GDN_PARK() do { _Pragma("unroll") for (int k_ = 0; k_ < 5; ++k_) { const int idx_ = tid + 512 * k_; if (idx_ < 67 * 36) *(u32x4*)(raw + idx_ * 8) = pre[k_]; } } while (0)
#define GDN_CONV8(ROW0, C8, W, OUT) do { _Pragma("unroll") for (int i_ = 0; i_ < 8; ++i_) OUT[i_] = 0.f; _Pragma("unroll") for (int j_ = 0; j_ < 4; ++j_) { const u32x4 xv_ = *(const u32x4*)(raw + ((ROW0) + j_) * 288 + (C8) * 8); \
            OUT[0] += bf2f(xv_.x & 0xffffu) * W[j_][0].x; OUT[1] += bf2f(xv_.x >> 16) * W[j_][0].y; OUT[2] += bf2f(xv_.y & 0xffffu) * W[j_][0].z; OUT[3] += bf2f(xv_.y >> 16) * W[j_][0].w; \
            OUT[4] += bf2f(xv_.z & 0xffffu) * W[j_][1].x; OUT[5] += bf2f(xv_.z >> 16) * W[j_][1].y; OUT[6] += bf2f(xv_.w & 0xffffu) * W[j_][1].z; OUT[7] += bf2f(xv_.w >> 16) * W[j_][1].w; } \
            _Pragma("unroll") for (int i_ = 0; i_ < 8; ++i_) OUT[i_] = siluf_(OUT[i_]); } while (0)
#define GDN_CONVNORM(T0) do { \
            _Pragma("unroll") for (int it_ = 0; it_ < 4; ++it_) { const int tok_ = it_ * 16 + (tid >> 5); float y_[8]; GDN_CONV8(tok_, isk * 16 + cg, wq, y_); \
                float ss_ = (y_[0] * y_[0] + y_[1] * y_[1]) + (y_[2] * y_[2] + y_[3] * y_[3]) + (y_[4] * y_[4] + y_[5] * y_[5]) + (y_[6] * y_[6] + y_[7] * y_[7]); \
                ss_ = row_sum16(ss_); const float sc_ = (1.f / sqrtf(ss_ + EPS)) * (isk ? 1.f : 0.08838834764831845f); \
                float* d_ = (isk ? ks : qs) + tok_ * 128 + cg * 8; \
                _Pragma("unroll") for (int i_ = 0; i_ < 8; ++i_) y_[i_] *= sc_; \
                *(f32x4*)d_ = (f32x4){y_[0], y_[1], y_[2], y_[3]}; *(f32x4*)(d_ + 4) = (f32x4){y_[4], y_[5], y_[6], y_[7]}; \
                float dq_ = 0.f; _Pragma("unroll") for (int i_ = 0; i_ < 8; ++i_) dq_ += y_[i_] * xshfl(y_[i_], 16); \
                dq_ = row_sum16(dq_); if (isk == 0 && cg == 0) qk[tok_] = dq_; } \
            if (tid < 256) { const int tok_ = tid >> 2; float y_[8]; GDN_CONV8(tok_, 32 + cv, wv, y_); float* d_ = vs + tok_ * 32 + cv * 8; \
                *(f32x4*)d_ = (f32x4){y_[0], y_[1], y_[2], y_[3]}; *(f32x4*)(d_ + 4) = (f32x4){y_[4], y_[5], y_[6], y_[7]}; } \
            if (tid < 64) { const size_t tg_ = (size_t)(b * S + (T0) + tid); const float a_ = ab[tg_ * 16 + h] + dtb, bb_ = ab[tg_ * 16 + 8 + h]; \
                const float sp_ = a_ > 20.f ? a_ : __logf(1.f + __expf(a_)); al[tid] = __expf(-Ah * sp_); be[tid] = sigmoidf_(bb_); } } while (0)
        __syncthreads();
        GDN_PREFETCH(0); GDN_PARK();
        __syncthreads();
        GDN_CONVNORM(0);
        __syncthreads();
        for (int chunk = 0; chunk < S / 64; ++chunk) {
            const int t0 = chunk * 64;
            const bool more = chunk + 1 < S / 64;
            if (more) GDN_PREFETCH(t0 + 64);
            {
                const float* kp = ks + dl * 8; const float* qp = qs + dl * 8; const float* vp = vs + e;
                f32x4 nk0 = *(const f32x4*)kp, nk1 = *(const f32x4*)(kp + 4), nq0 = *(const f32x4*)qp, nq1 = *(const f32x4*)(qp + 4);
                float nv = vp[0], na = al[0], nb = be[0], nqk = qk[0];
                for (int t16 = 0; t16 < 4; ++t16) {
                    float ok = 0.f;
#pragma unroll 4
                    for (int i = 0; i < 16; ++i) {
                        const int tt = t16 * 16 + i, tn = (tt + 1) & 63;
                        const f32x2 K0 = {nk0.x, nk0.y}, K1 = {nk0.z, nk0.w}, K2 = {nk1.x, nk1.y}, K3 = {nk1.z, nk1.w};
                        const f32x2 Q0 = {nq0.x, nq0.y}, Q1 = {nq0.z, nq0.w}, Q2 = {nq1.x, nq1.y}, Q3 = {nq1.z, nq1.w};
                        const float v = nv, a = na, bt = nb, qkt = nqk;
                        nk0 = *(const f32x4*)(kp + tn * 128); nk1 = *(const f32x4*)(kp + tn * 128 + 4); nq0 = *(const f32x4*)(qp + tn * 128); nq1 = *(const f32x4*)(qp + tn * 128 + 4);
                        nv = vp[tn * 32]; na = al[tn]; nb = be[tn]; nqk = qk[tn];
                        f32x2 pa = K0 * S2[0], pb = K2 * S2[2], qa = Q0 * S2[0], qb = Q2 * S2[2];
                        pa = K1 * S2[1] + pa; pb = K3 * S2[3] + pb; qa = Q1 * S2[1] + qa; qb = Q3 * S2[3] + qb;
                        pa += pb; qa += qb;
                        float p = pa.x + pa.y, qS = qa.x + qa.y;
                        p = row_sum16(p); qS = row_sum16(qS);
                        const float vn = bt * (v - a * p);
                        const float o = a * qS + qkt * vn;
                        const f32x2 vn2 = {vn, vn}, a2 = {a, a};
                        S2[0] = S2[0] * a2 + K0 * vn2; S2[1] = S2[1] * a2 + K1 * vn2; S2[2] = S2[2] * a2 + K2 * vn2; S2[3] = S2[3] * a2 + K3 * vn2;
                        ok = (i == dl) ? o : ok;
                    }
                    os[(t16 * 16 + dl) * 32 + e] = ok;
                }
            }
            __syncthreads();
            { const int tok = tid >> 3, c4 = tid & 7;
              *(f32x4*)(o32 + (size_t)(b * S + t0 + tok) * D + h * 128 + es * 32 + c4 * 4) = *(const f32x4*)(os + tok * 32 + c4 * 4); }
            if (more) {
                GDN_PARK();
                __syncthreads();
                GDN_CONVNORM(t0 + 64);
            }
            __syncthreads();
        }
#undef GDN_PREFETCH
#undef GDN_PARK
#undef GDN_CONV8
#undef GDN_CONVNORM
    }
}

constexpr size_t WS_HALO = WS_END;
constexpr size_t WS_GL = WS_END + 10 * MiB;
constexpr size_t WS_SS = WS_GL + 1 * MiB;
constexpr size_t WS_END2 = WS_SS + 26 * MiB;

__device__ __forceinline__ void phase_gdn_halo(const bf16* proj, bf16* halo, int gtid, int NT) {
    for (int idx = gtid; idx < Bn * 64 * 3 * 384; idx += NT) {
        const int c = idx % 384, r3 = (idx / 384) % 3, bn = idx / (384 * 3), n = bn & 63, b = bn >> 6;
        u32x4 v = {0u, 0u, 0u, 0u};
        if (n > 0) v = *(const u32x4*)(proj + (size_t)(b * S + 64 * n - 3 + r3) * 4096 + c * 8);
        *(u32x4*)(halo + (size_t)(bn * 3 + r3) * 3072 + c * 8) = v;
    }
}

constexpr int GP_RAW = 0, GP_QB = 51456, GP_KB = GP_QB + 17408, GP_VB = GP_KB + 17408, GP_AM = GP_VB + 16384, GP_GC = GP_AM + 17408, GP_W = GP_GC + 1024;
__device__ __forceinline__ void phase_gdn_prep(unsigned char* lds, bf16* proj, const bf16* halo, const float* ab, const float* convw, const float* A_log, const float* dt_bias,
                                               bf16* KT, bf16* AT, float* GL, int vblk, int nblk, int tid, int wid, int lane) {
    bf16* raw = (bf16*)(lds + GP_RAW);
    bf16* wimg = (bf16*)(lds + GP_W);
    unsigned char* qb = lds + GP_QB;
    unsigned char* kb = lds + GP_KB;
    bf16* vb = (bf16*)(lds + GP_VB);
    float* Am = (float*)(lds + GP_AM);
    float* gcs = (float*)(lds + GP_GC);
    float* bes = gcs + 64;
    const int r = lane & 31, hh = lane >> 5;
    for (int item = vblk; item < Bn * 8 * 64; item += nblk) {
        const int n = item & 63, h = (item >> 6) & 7, b = item >> 9;
        const size_t tok0 = (size_t)b * S + 64 * n;
        LDS_BAR();
#define GP_RAWLOAD(ITEM, T0, NT) do { const int n_ = (ITEM) & 63, h_ = ((ITEM) >> 6) & 7, b_ = (ITEM) >> 9; const size_t tk0_ = (size_t)b_ * S + 64 * n_; \
        for (int idx = (T0); idx < 67 * 48; idx += (NT)) { const int row = idx / 48, c = idx - row * 48; \
            const int col = c < 16 ? h_ * 128 + c * 8 : (c < 32 ? 1024 + h_ * 128 + (c - 16) * 8 : 2048 + h_ * 128 + (c - 32) * 8); \
            u32x4 v = {0u, 0u, 0u, 0u}; if (row < 3) { if (n_ > 0) v = *(const u32x4*)(halo + (size_t)((b_ * 64 + n_) * 3 + row) * 3072 + col); } else v = *(const u32x4*)(proj + (tk0_ + row - 3) * 4096 + col); \
            *(u32x4*)(raw + row * 384 + c * 8) = v; } } while (0)
        if (item == vblk) GP_RAWLOAD(item, tid, 512);
        if (tid < 64) {
            const float a = ab[(tok0 + tid) * 16 + h] + dt_bias[h], bb = ab[(tok0 + tid) * 16 + 8 + h];
            const float sp = a > 20.f ? a : __logf(1.f + __expf(a));
            float g = -__expf(A_log[h]) * sp;
#pragma unroll
            for (int o = 1; o < 64; o <<= 1) { const float t_ = xshfl_up(g, o); if (lane >= o) g += t_; }
            const float be_ = sigmoidf_(bb);
            gcs[tid] = g; bes[tid] = be_; gcs[128 + tid] = be_; gcs[192 + tid] = be_ * __expf(g);
        }
        LDS_BAR();
        {
            const int isk = (tid >> 4) & 1, cg = tid & 15;
            const int colqk = isk * 1024 + h * 128 + cg * 8, colv = 2048 + h * 128 + cg * 8;
#define GP_WLOAD(COL, W) do { _Pragma("unroll") for (int j_ = 0; j_ < 4; ++j_) { W[j_][0] = *(const f32x4*)(convw + j_ * 3072 + (COL)); W[j_][1] = *(const f32x4*)(convw + j_ * 3072 + (COL) + 4); } } while (0)
#define GP_CONV8(ROW0, C8, W, OUT) do { _Pragma("unroll") for (int i_ = 0; i_ < 8; ++i_) OUT[i_] = 0.f; _Pragma("unroll") for (int j_ = 0; j_ < 4; ++j_) { const u32x4 xv_ = *(const u32x4*)(raw + ((ROW0) + j_) * 384 + (C8) * 8); \
            const f32x4 w0_ = W[j_][0], w1_ = W[j_][1]; \
            OUT[0] += bf2f(xv_.x & 0xffffu) * w0_.x; OUT[1] += bf2f(xv_.x >> 16) * w0_.y; OUT[2] += bf2f(xv_.y & 0xffffu) * w0_.z; OUT[3] += bf2f(xv_.y >> 16) * w0_.w; \
            OUT[4] += bf2f(xv_.z & 0xffffu) * w1_.x; OUT[5] += bf2f(xv_.z >> 16) * w1_.y; OUT[6] += bf2f(xv_.w & 0xffffu) * w1_.z; OUT[7] += bf2f(xv_.w >> 16) * w1_.w; } \
            _Pragma("unroll") for (int i_ = 0; i_ < 8; ++i_) OUT[i_] = siluf_(OUT[i_]); } while (0)
            f32x4 wc_[4][2];
            GP_WLOAD(colqk, wc_);
#pragma unroll 1
            for (int it = 0; it < 4; ++it) {
                const int tk = it * 16 + (tid >> 5);
                float y[8]; GP_CONV8(tk, isk * 16 + cg, wc_, y);
                float ss = (y[0] * y[0] + y[1] * y[1]) + (y[2] * y[2] + y[3] * y[3]) + (y[4] * y[4] + y[5] * y[5]) + (y[6] * y[6] + y[7] * y[7]);
                ss = row_sum16(ss);
                const float sc = (1.f / sqrtf(ss + EPS)) * (isk ? 1.f : 0.08838834764831845f);
                u32x4 w; w.x = pkbf(y[0] * sc, y[1] * sc); w.y = pkbf(y[2] * sc, y[3] * sc); w.z = pkbf(y[4] * sc, y[5] * sc); w.w = pkbf(y[6] * sc, y[7] * sc);
                *(u32x4*)((isk ? kb : qb) + tk * 272 + cg * 16) = w;
            }
            GP_WLOAD(colv, wc_);
#pragma unroll 1
            for (int it = 0; it < 2; ++it) {
                const int tk = it * 32 + (tid >> 4);
                float y[8]; GP_CONV8(tk, 32 + cg, wc_, y);
                u32x4 w; w.x = pkbf(y[0], y[1]); w.y = pkbf(y[2], y[3]); w.z = pkbf(y[4], y[5]); w.w = pkbf(y[6], y[7]);
                *(u32x4*)(vb + tk * 128 + cg * 8) = w;
            }
#undef GP_CONV8
#undef GP_WLOAD
        }
        LDS_BAR();
        {
            const int prod = wid >> 2, tr = (wid >> 1) & 1, tc = wid & 1;
            f32x16 acc;
#pragma unroll
            for (int i = 0; i < 16; ++i) acc[i] = 0.f;
            if (tr >= tc) {
                const unsigned char* Ab = (prod ? qb : kb) + (32 * tr + r) * 272 + hh * 16;
                const unsigned char* Bb = kb + (32 * tc + r) * 272 + hh * 16;
#pragma unroll
                for (int ks = 0; ks < 8; ++ks) acc = MFMA32(*(const bf16x8v*)(Ab + ks * 32), *(const bf16x8v*)(Bb + ks * 32), acc);
            }
            const int j = 32 * tc + r; const float gj = gcs[j];
#pragma unroll
            for (int i_ = 0; i_ < 16; ++i_) {
                const int i = 32 * tr + (i_ & 3) + 8 * (i_ >> 2) + 4 * hh;
                const float dec = __expf(gcs[i] - gj);
                if (prod == 0) Am[i * 68 + j] = (j < i) ? bes[i] * acc[i_] * dec : 0.f;
                else AT[(size_t)item * 4096 + i * 64 + j] = (bf16)f2bf((j <= i) ? acc[i_] * dec : 0.f);
            }
        }
        LDS_BAR();
        int tid3 = tid; asm volatile("" : "+v"(tid3));
        if (tid3 < 256) {
            const int isw = tid3 >> 7, d = tid3 & 127;
            unsigned oam = GP_AM, orsc = GP_GC + 512 + isw * 256, ocol = (isw ? GP_KB : GP_VB) + d * 2;
            asm volatile("" : "+v"(oam), "+v"(orsc), "+v"(ocol));
            const float* Am_ = (const float*)(lds + oam); const float* rsc = (const float*)(lds + orsc); const unsigned char* col = lds + ocol;
            const int cstride = isw ? 272 : 256;
            float X[64];
#pragma clang loop unroll(full)
            for (int i = 0; i < 64; ++i) X[i] = 0.f;
#pragma clang loop unroll(full)
            for (int i = 0; i < 64; ++i) {
                f32x4 av = {0.f, 0.f, 0.f, 0.f};
#pragma clang loop unroll(full)
                for (int j4 = 0; j4 < 16; ++j4) { if (4 * j4 < i) { const f32x4 a4 = *(const f32x4*)(Am_ + i * 68 + 4 * j4);
                    const f32x4 x4 = {X[4 * j4], X[4 * j4 + 1], X[4 * j4 + 2], X[4 * j4 + 3]}; av += a4 * x4; } }
                X[i] = rsc[i] * bf2f(*(const bf16*)(col + i * cstride)) - ((av.x + av.y) + (av.z + av.w));
                asm volatile("" ::: "memory");
            }
            if (isw) {
#pragma unroll
                for (int i = 0; i < 64; ++i) wimg[i * 128 + d] = (bf16)f2bf(X[i]);
            } else {
                bf16* up = proj + (tok0 + (d >> 1)) * 4096 + 2048 + h * 128 + (d & 1) * 64;
#pragma unroll
                for (int i8 = 0; i8 < 8; ++i8) { u32x4 w; w.x = pkbf(X[8 * i8], X[8 * i8 + 1]); w.y = pkbf(X[8 * i8 + 2], X[8 * i8 + 3]); w.z = pkbf(X[8 * i8 + 4], X[8 * i8 + 5]); w.w = pkbf(X[8 * i8 + 6], X[8 * i8 + 7]);
                    *(u32x4*)(up + 8 * i8) = w; }
            }
        } else {
            if (tid3 < 384) {
                const int d = tid3 - 256; const float gl_ = gcs[63];
                bf16* kp = KT + (size_t)item * 8192 + d * 64;
#pragma unroll
                for (int i8 = 0; i8 < 8; ++i8) { float y[8];
#pragma unroll
                    for (int i = 0; i < 8; ++i) y[i] = bf2f(*(const bf16*)(kb + (8 * i8 + i) * 272 + d * 2)) * __expf(gl_ - gcs[8 * i8 + i]);
                    u32x4 w; w.x = pkbf(y[0], y[1]); w.y = pkbf(y[2], y[3]); w.z = pkbf(y[4], y[5]); w.w = pkbf(y[6], y[7]);
                    *(u32x4*)(kp + 8 * i8) = w; }
                if (d == 0) GL[item] = __expf(gl_);
            }
#pragma unroll
            for (int k = 0; k < 4; ++k) {
                const int pc = (tid3 - 256) + 256 * k, i = pc >> 4, c8 = pc & 15;
                const u32x4 v = *(const u32x4*)(qb + i * 272 + c8 * 16); const float eg = __expf(gcs[i]);
                u32x4 w; w.x = pkbf(bf2f(v.x & 0xffffu) * eg, bf2f(v.x >> 16) * eg); w.y = pkbf(bf2f(v.y & 0xffffu) * eg, bf2f(v.y >> 16) * eg);
                w.z = pkbf(bf2f(v.z & 0xffffu) * eg, bf2f(v.z >> 16) * eg); w.w = pkbf(bf2f(v.w & 0xffffu) * eg, bf2f(v.w >> 16) * eg);
                *(u32x4*)(proj + (tok0 + i) * 4096 + h * 128 + c8 * 8) = w;
            }
            if (item + nblk < Bn * 8 * 64) GP_RAWLOAD(item + nblk, tid3 - 256, 256);
        }
        LDS_BAR();
#pragma unroll
        for (int k = 0; k < 2; ++k) { const int pc = tid + 512 * k, i = pc >> 4, c8 = pc & 15;
            *(u32x4*)(proj + (tok0 + i) * 4096 + 1024 + h * 128 + c8 * 8) = *(const u32x4*)(wimg + i * 128 + c8 * 8); }
    }
}

#undef GP_RAWLOAD
__device__ __forceinline__ void phase_gdn_scan2(unsigned char* lds, const bf16* proj, const bf16* KT, const bf16* AT, const float* GL, bf16* o16, int vblk, int nblk, int tid, int wid, int lane) {
    unsigned char* Sl = lds;
    unsigned char* Vl = lds + 8704;
    const int r = lane & 31, hh = lane >> 5;
    for (int item = vblk; item < 256; item += nblk) {
        const int bh = (item & 7) + 8 * (item >> 5), es = (item >> 3) & 3, b = bh >> 3, h = bh & 7;
        __syncthreads();
        for (int i = tid; i < 8704 / 4; i += 512) ((unsigned*)Sl)[i] = 0u;
        f32x16 Sacc;
#pragma unroll
        for (int i = 0; i < 16; ++i) Sacc[i] = 0.f;
        const int rt = wid & 1, dt = wid & 3;
        bf16x8v A8n[8]; bf16x8v A4n[4]; u32x2 uun[4]; float gln = 1.f;
#define GS_LOAD(N) do { const size_t tk_ = (size_t)b * S + 64 * (N); const int it_ = bh * 64 + (N); \
            if (wid < 2) { const bf16* wp_ = proj + (tk_ + 32 * rt + r) * 4096 + 1024 + h * 128 + 8 * hh; \
                _Pragma("unroll") for (int ks = 0; ks < 8; ++ks) A8n[ks] = *(const bf16x8v*)(wp_ + 16 * ks); \
                const int c_ = es * 32 + r; const bf16* up_ = proj + (tk_ + (c_ >> 1)) * 4096 + 2048 + h * 128 + (c_ & 1) * 64 + 32 * rt + 4 * hh; \
                _Pragma("unroll") for (int g = 0; g < 4; ++g) uun[g] = *(const u32x2*)(up_ + 8 * g); } \
            else if (wid < 4) { const bf16* qp_ = proj + (tk_ + 32 * rt + r) * 4096 + h * 128 + 8 * hh; \
                _Pragma("unroll") for (int ks = 0; ks < 8; ++ks) A8n[ks] = *(const bf16x8v*)(qp_ + 16 * ks); \
                const bf16* ap_ = AT + (size_t)it_ * 4096 + (32 * rt + r) * 64 + 8 * hh; \
                _Pragma("unroll") for (int sx = 0; sx < 4; ++sx) A4n[sx] = *(const bf16x8v*)(ap_ + 16 * sx); } \
            else { const bf16* kp_ = KT + (size_t)it_ * 8192 + (32 * dt + r) * 64 + 8 * hh; \
                _Pragma("unroll") for (int sx = 0; sx < 4; ++sx) A4n[sx] = *(const bf16x8v*)(kp_ + 16 * sx); \
                gln = GL[it_]; } } while (0)
        GS_LOAD(0);
        for (int n = 0; n < 64; ++n) {
            const size_t tok0 = (size_t)b * S + 64 * n;
            bf16x8v A8[8]; bf16x8v A4[4]; u32x2 uu[4]; const float gl = gln;
#pragma unroll
            for (int ks = 0; ks < 8; ++ks) A8[ks] = A8n[ks];
#pragma unroll
            for (int sx = 0; sx < 4; ++sx) { A4[sx] = A4n[sx]; uu[sx] = uun[sx]; }
            if (n + 1 < 64) GS_LOAD(n + 1);
            LDS_BAR();
            f32x16 acc;
#pragma unroll
            for (int i = 0; i < 16; ++i) acc[i] = 0.f;
            if (wid < 4) {
#pragma unroll
                for (int ks = 0; ks < 8; ++ks) acc = MFMA32(A8[ks], *(const bf16x8v*)(Sl + r * 272 + ks * 32 + hh * 16), acc);
                if (wid < 2) {
#pragma unroll
                    for (int g = 0; g < 4; ++g) {
                        u32x2 w; w.x = pkbf(bf2f(uu[g].x & 0xffffu) - acc[4 * g], bf2f(uu[g].x >> 16) - acc[4 * g + 1]);
                        w.y = pkbf(bf2f(uu[g].y & 0xffffu) - acc[4 * g + 2], bf2f(uu[g].y >> 16) - acc[4 * g + 3]);
                        *(u32x2*)(Vl + r * 144 + (32 * rt + 8 * g + 4 * hh) * 2) = w;
                    }
                }
            }
            LDS_BAR();
            if (wid >= 2 && wid < 4) {
#pragma unroll
                for (int sx = 0; sx < 4; ++sx) acc = MFMA32(A4[sx], *(const bf16x8v*)(Vl + r * 144 + sx * 32 + hh * 16), acc);
                unsigned char* Ol = lds + 13312 + (wid - 2) * 2560;
#pragma unroll
                for (int i = 0; i < 16; ++i) *(bf16*)(Ol + ((i & 3) + 8 * (i >> 2) + 4 * hh) * 80 + r * 2) = (bf16)f2bf(acc[i]);
                WAVE_SYNC();
#pragma unroll
                for (int k = 0; k < 2; ++k) { const int pc = lane + 64 * k, trow = pc >> 2, c4 = pc & 3;
                    *(u32x4*)(o16 + (tok0 + 32 * rt + trow) * D + h * 128 + es * 32 + c4 * 8) = *(const u32x4*)(Ol + trow * 80 + c4 * 16); }
                WAVE_SYNC();
            } else if (wid >= 4) {
#pragma unroll
                for (int i = 0; i < 16; ++i) Sacc[i] *= gl;
#pragma unroll
                for (int sx = 0; sx < 4; ++sx) Sacc = MFMA32(A4[sx], *(const bf16x8v*)(Vl + r * 144 + sx * 32 + hh * 16), Sacc);
#pragma unroll
                for (int g = 0; g < 4; ++g) { u32x2 w; w.x = pkbf(Sacc[4 * g], Sacc[4 * g + 1]); w.y = pkbf(Sacc[4 * g + 2], Sacc[4 * g + 3]);
                    *(u32x2*)(Sl + r * 272 + (32 * dt + 8 * g + 4 * hh) * 2) = w; }
            }
        }
    }
}

#undef GS_LOAD
__device__ __forceinline__ void phase_gdn_post(const bf16* o16, const bf16* proj, const float* onorm, bf16* hn, int gw, int NGW, int lane) {
    const int l16 = lane & 15;
    float wv[8];
#pragma unroll
    for (int j = 0; j < 8; ++j) wv[j] = onorm[8 * l16 + j];
    for (int m = 2 * gw; m < T; m += 2 * NGW) {
        u32x4 xo[2][2], gg[2][2];
#pragma unroll
        for (int tk = 0; tk < 2; ++tk)
#pragma unroll
            for (int pt = 0; pt < 2; ++pt) { xo[tk][pt] = *(const u32x4*)(o16 + (size_t)(m + tk) * D + pt * 512 + lane * 8); gg[tk][pt] = *(const u32x4*)(proj + (size_t)(m + tk) * 4096 + 3072 + pt * 512 + lane * 8); }
#pragma unroll
        for (int tk = 0; tk < 2; ++tk)
#pragma unroll
            for (int pt = 0; pt < 2; ++pt) {
                const u32x4 xv = xo[tk][pt], gv = gg[tk][pt];
                float v[8] = {bf2f(xv.x & 0xffffu), bf2f(xv.x >> 16), bf2f(xv.y & 0xffffu), bf2f(xv.y >> 16), bf2f(xv.z & 0xffffu), bf2f(xv.z >> 16), bf2f(xv.w & 0xffffu), bf2f(xv.w >> 16)};
                const float g[8] = {bf2f(gv.x & 0xffffu), bf2f(gv.x >> 16), bf2f(gv.y & 0xffffu), bf2f(gv.y >> 16), bf2f(gv.z & 0xffffu), bf2f(gv.z >> 16), bf2f(gv.w & 0xffffu), bf2f(gv.w >> 16)};
                float sq = ((v[0] * v[0] + v[1] * v[1]) + (v[2] * v[2] + v[3] * v[3])) + ((v[4] * v[4] + v[5] * v[5]) + (v[6] * v[6] + v[7] * v[7]));
                sq = row_sum16(sq);
                const float rstd = 1.f / sqrtf(sq * (1.f / 128.f) + EPS);
#pragma unroll
                for (int j = 0; j < 8; ++j) v[j] = v[j] * rstd * wv[j] * siluf_(g[j]);
                u32x4 w; w.x = pkbf(v[0], v[1]); w.y = pkbf(v[2], v[3]); w.z = pkbf(v[4], v[5]); w.w = pkbf(v[6], v[7]);
                *(u32x4*)(hn + (size_t)(m + tk) * D + pt * 512 + lane * 8) = w;
            }
    }
}
__device__ __forceinline__ void phase_sc_post(const bf16* proj, const float* cw, bf16* hn, int gtid, int NT) {
    const int c8 = (gtid & 127) * 8;
    f32x4 w0[3], w1[3];
#pragma unroll
    for (int j = 0; j < 3; ++j) { w0[j] = *(const f32x4*)(cw + j * 1024 + c8); w1[j] = *(const f32x4*)(cw + j * 1024 + c8 + 4); }
    for (int idx = gtid; idx < T * 128; idx += 2 * NT) {
        u32x4 cv[2][3], xv[2][3], bv[2];
#pragma unroll
        for (int q = 0; q < 2; ++q) {
            const int id = idx + q * NT, m = id >> 7, s = m & (S - 1);
#pragma unroll
            for (int j = 0; j < 3; ++j) { cv[q][j] = (u32x4){0u, 0u, 0u, 0u}; xv[q][j] = (u32x4){0u, 0u, 0u, 0u};
                if (id < T * 128 && s - 2 + j >= 0) { const bf16* pr = proj + (size_t)(m - 2 + j) * 3072; cv[q][j] = *(const u32x4*)(pr + 1024 + c8); xv[q][j] = *(const u32x4*)(pr + 2048 + c8); } }
            bv[q] = (u32x4){0u, 0u, 0u, 0u};
            if (id < T * 128) bv[q] = *(const u32x4*)(proj + (size_t)m * 3072 + c8);
        }
#pragma unroll
        for (int q = 0; q < 2; ++q) {
            const int id = idx + q * NT, m = id >> 7;
            if (id >= T * 128) break;
            float y[8];
#pragma unroll
            for (int i = 0; i < 8; ++i) y[i] = 0.f;
#pragma unroll
            for (int j = 0; j < 3; ++j) {
                const u32x4 c = cv[q][j], x = xv[q][j];
                y[0] += w0[j].x * bf2f(c.x & 0xffffu) * bf2f(x.x & 0xffffu); y[1] += w0[j].y * bf2f(c.x >> 16) * bf2f(x.x >> 16);
                y[2] += w0[j].z * bf2f(c.y & 0xffffu) * bf2f(x.y & 0xffffu); y[3] += w0[j].w * bf2f(c.y >> 16) * bf2f(x.y >> 16);
                y[4] += w1[j].x * bf2f(c.z & 0xffffu) * bf2f(x.z & 0xffffu); y[5] += w1[j].y * bf2f(c.z >> 16) * bf2f(x.z >> 16);
                y[6] += w1[j].z * bf2f(c.w & 0xffffu) * bf2f(x.w & 0xffffu); y[7] += w1[j].w * bf2f(c.w >> 16) * bf2f(x.w >> 16);
            }
            const u32x4 b = bv[q];
            u32x4 o;
            o.x = pkbf(y[0] * bf2f(b.x & 0xffffu), y[1] * bf2f(b.x >> 16)); o.y = pkbf(y[2] * bf2f(b.y & 0xffffu), y[3] * bf2f(b.y >> 16));
            o.z = pkbf(y[4] * bf2f(b.z & 0xffffu), y[5] * bf2f(b.z >> 16)); o.w = pkbf(y[6] * bf2f(b.w & 0xffffu), y[7] * bf2f(b.w >> 16));
            *(u32x4*)(hn + (size_t)m * D + c8) = o;
        }
    }
}
__device__ __forceinline__ void phase_nsa_post(unsigned char* lds, const bf16* proj, const float* qnorm, const float* knorm, const f32x2* tab,
                                               bf16* QN, bf16* KS, bf16* KW, bf16* KCH, bf16* VCH, bf16* VST, bf16* VWT, int gw, int NGW, int wid, int lane) {
    {
        bf16* tile = (bf16*)lds + wid * (64 * 72);
        const int c8 = lane & 7, r8 = lane >> 3;
        for (int item = gw; item < 2 * 32 * 64; item += NGW) {
            const int st = item & 63, bh = (item >> 6) & 31, which = item >> 11, b = bh >> 2, hk = bh & 3;
            const bf16* src = proj + ((size_t)b * S + st * 64 + r8) * 2560 + (which ? 2304 : 1792) + hk * 64 + c8 * 8;
            u32x4 v[8];
#pragma unroll
            for (int i = 0; i < 8; ++i) v[i] = *(const u32x4*)(src + (size_t)(8 * i) * 2560);
#pragma unroll
            for (int i = 0; i < 8; ++i) *(u32x4*)(tile + (8 * i + r8) * 72 + c8 * 8) = v[i];
            WAVE_SYNC();
            bf16* dst = (which ? VWT : VST) + (size_t)bh * 64 * S + st * 64 + c8 * 8;
#pragma unroll
            for (int i = 0; i < 8; ++i) {
                const bf16* tp = tile + (8 * c8) * 72 + 8 * i + r8;
                u32x4 w; w.x = (unsigned)tp[0] | ((unsigned)tp[72] << 16); w.y = (unsigned)tp[144] | ((unsigned)tp[216] << 16);
                w.z = (unsigned)tp[288] | ((unsigned)tp[360] << 16); w.w = (unsigned)tp[432] | ((unsigned)tp[504] << 16);
                *(u32x4*)(dst + (size_t)(8 * i + r8) * S) = w;
            }
            WAVE_SYNC();
        }
    }
    const int l8 = lane & 7, hsel = lane >> 3, lo32 = lane < 32;
    float qw8[8], kw8[8];
#pragma unroll
    for (int j = 0; j < 8; ++j) { qw8[j] = qnorm[8 * l8 + j]; kw8[j] = knorm[(lo32 ? 64 : 128) + 8 * l8 + j]; }
#define NP_UNPACK(V, X) do { X[0] = bf2f(V.x & 0xffffu); X[1] = bf2f(V.x >> 16); X[2] = bf2f(V.y & 0xffffu); X[3] = bf2f(V.y >> 16); X[4] = bf2f(V.z & 0xffffu); X[5] = bf2f(V.z >> 16); X[6] = bf2f(V.w & 0xffffu); X[7] = bf2f(V.w >> 16); } while (0)
#define NP_RSTD8(X, R) do { float ss_ = (X[0] * X[0] + X[1] * X[1]) + (X[2] * X[2] + X[3] * X[3]) + (X[4] * X[4] + X[5] * X[5]) + (X[6] * X[6] + X[7] * X[7]); \
        ss_ += xshfl(ss_, 1); ss_ += xshfl(ss_, 2); ss_ += xshfl(ss_, 4); R = 1.f / sqrtf(ss_ * (1.f / 64.f) + EPS); } while (0)
    for (int m0 = gw; m0 < T; m0 += 2 * NGW) {
        u32x4 vq0_[2], vq1_[2], vk_[2], vc_[2]; f32x4 cc_[2][4];
#pragma unroll
        for (int q = 0; q < 2; ++q) {
            const int m = m0 + q * NGW < T ? m0 + q * NGW : m0;
            const bf16* pr = proj + (size_t)m * 2560;
            vq0_[q] = *(const u32x4*)(pr + lane * 8); vq1_[q] = *(const u32x4*)(pr + 512 + lane * 8);
            vk_[q] = *(const u32x4*)(pr + (lo32 ? 1536 + lane * 8 : 2048 + (lane - 32) * 8));
            vc_[q] = *(const u32x4*)(pr + (lo32 ? 1024 + lane * 8 : 1280 + (lane - 32) * 8));
            const f32x4* cp = (const f32x4*)(tab + (size_t)m * 32 + 8 * (l8 & 3));
            cc_[q][0] = cp[0]; cc_[q][1] = cp[1]; cc_[q][2] = cp[2]; cc_[q][3] = cp[3];
        }
#pragma unroll
        for (int q = 0; q < 2; ++q) {
        const int m = m0 + q * NGW;
        if (m >= T) break;
        const int b = m >> 12, s = m & (S - 1);
        const u32x4 vq0 = vq0_[q], vq1 = vq1_[q], vk = vk_[q], vc = vc_[q];
        const f32x4 c0 = cc_[q][0], c1 = cc_[q][1], c2 = cc_[q][2], c3 = cc_[q][3];
        {
            float x[8], r; NP_UNPACK(vq0, x); NP_RSTD8(x, r);
            u32x4 w; w.x = pkbf(x[0] * r * qw8[0], x[1] * r * qw8[1]); w.y = pkbf(x[2] * r * qw8[2], x[3] * r * qw8[3]); w.z = pkbf(x[4] * r * qw8[4], x[5] * r * qw8[5]); w.w = pkbf(x[6] * r * qw8[6], x[7] * r * qw8[7]);
            *(u32x4*)(QN + ((size_t)(b * 16 + hsel) * S + s) * 64 + 8 * l8) = w;
        }
        {
            float x[8], r; NP_UNPACK(vq1, x); NP_RSTD8(x, r);
            u32x4 w; w.x = pkbf(x[0] * r * qw8[0], x[1] * r * qw8[1]); w.y = pkbf(x[2] * r * qw8[2], x[3] * r * qw8[3]); w.z = pkbf(x[4] * r * qw8[4], x[5] * r * qw8[5]); w.w = pkbf(x[6] * r * qw8[6], x[7] * r * qw8[7]);
            *(u32x4*)(QN + ((size_t)(b * 16 + 8 + hsel) * S + s) * 64 + 8 * l8) = w;
        }
        const size_t okv = ((size_t)(b * 4 + (hsel & 3)) * S + s) * 64 + 8 * l8;
        {
            float x[8], r, y[8]; NP_UNPACK(vk, x); NP_RSTD8(x, r);
            const float cs[16] = {c0.x, c0.y, c0.z, c0.w, c1.x, c1.y, c1.z, c1.w, c2.x, c2.y, c2.z, c2.w, c3.x, c3.y, c3.z, c3.w};
#pragma unroll
            for (int j = 0; j < 8; ++j) { const float yv = x[j] * r * kw8[j]; const float yp = xshfl(yv, 4); y[j] = yv * cs[2 * j] + (l8 < 4 ? -yp : yp) * cs[2 * j + 1]; }
            u32x4 w; w.x = pkbf(y[0], y[1]); w.y = pkbf(y[2], y[3]); w.z = pkbf(y[4], y[5]); w.w = pkbf(y[6], y[7]);
            *(u32x4*)((lo32 ? KS : KW) + okv) = w;
        }
        *(u32x4*)((lo32 ? KCH : VCH) + okv) = vc;
    }
    }
#undef NP_UNPACK
#undef NP_RSTD8
}
__device__ __forceinline__ void phase_cmp2(unsigned char* lds, const float* Pk, const float* Pv, const float* biasp, const float* w2, const float* b2, const float* knorm0,
                                           bf16* KC, bf16* VC, int gw, int NGW, int wid, int lane, int tid) {
    float* hs = (float*)lds + wid * 256;
    float* w2l = (float*)(lds + 8192);
    for (int kind = 0; kind < 2; ++kind) {
        __syncthreads();
        for (int idx = tid; idx < 256 * 64 / 4; idx += 512) ((f32x4*)w2l)[idx] = ((const f32x4*)(w2 + (size_t)kind * 256 * 64))[idx];
        __syncthreads();
        const float* P = kind ? Pv : Pk;
        for (int it = gw; it < 32 * 256; it += NGW) {
            const int i = it & 255, bh = it >> 8;
            bf16* outp = kind ? VC + ((size_t)bh * 64 + lane) * 256 + i : KC + ((size_t)bh * 256 + i) * 64 + lane;
            if (i == 255) { *outp = 0; continue; }
            const float* r0 = P + ((size_t)bh * 256 + i) * 512; const float* r1 = r0 + 512 + 256;
#pragma unroll
            for (int j = 0; j < 4; ++j) { const int n = lane + 64 * j; const float x = r0[n] + r1[n] + biasp[kind * 256 + n];
                const float uu = 0.7978845608028654f * (x + 0.044715f * x * x * x);
                const float th = 1.f - 2.f / (1.f + __expf(2.f * uu));
                hs[n] = 0.5f * x * (1.f + th); }
            WAVE_SYNC();
            float a0 = b2[kind * 64 + lane], a1 = 0.f, a2 = 0.f, a3 = 0.f;
#pragma unroll 4
            for (int n = 0; n < 256; n += 4) { const f32x4 hv = *(const f32x4*)(hs + n);
                a0 += hv.x * w2l[n * 64 + lane]; a1 += hv.y * w2l[(n + 1) * 64 + lane]; a2 += hv.z * w2l[(n + 2) * 64 + lane]; a3 += hv.w * w2l[(n + 3) * 64 + lane]; }
            float acc = (a0 + a1) + (a2 + a3);
            if (kind == 0) { const float ss = wave_sum(acc * acc); acc = acc * (1.f / sqrtf(ss * (1.f / 64.f) + EPS)) * knorm0[lane]; }
            *outp = (bf16)f2bf(acc);
            WAVE_SYNC();
        }
    }
}
constexpr int KV_STRIDE = 144;
constexpr int KV_BUF = 2 * 64 * KV_STRIDE;
constexpr int ATT_IMP_OFF = 2 * KV_BUF;
constexpr int ATT_MSK_OFF = ATT_IMP_OFF + 8 * 2048;

template <bool IMP>
__device__ __forceinline__ void attn_tile(const bool FAST, const unsigned char* buf, int tt, int key0, int lo, int hi, const bf16x8v (&qf)[4],
                                          f32x16 (&O)[2], f32x16 (&IM)[2], float& m, float& l, const bf16* ovt, int r, int h, int pr) {
    f32x16 sacc;
#pragma unroll
    for (int i = 0; i < 16; ++i) sacc[i] = 0.f;
    bf16x8v ov[2][2];
    if (IMP) {
#pragma unroll
        for (int st = 0; st < 2; ++st)
#pragma unroll
            for (int sx = 0; sx < 2; ++sx) ov[st][sx] = *(const bf16x8v*)(ovt + (32 * st + r) * 256 + key0 + 16 * sx + 8 * h);
    }
    const unsigned char* kb = buf + (32 * tt + pr) * KV_STRIDE + h * 16;
#pragma unroll
    for (int ks = 0; ks < 4; ++ks) { const bf16x8v a = *(const bf16x8v*)(kb + ks * 32); sacc = MFMA32(a, qf[ks], sacc); }
    const int kb0 = key0 + 8 * h;
    float mx = -1e30f, psum = 0.f, corr;
    if (FAST) {
        const bool on = hi >= 0;
#pragma unroll
        for (int i = 0; i < 16; ++i) mx = fmaxf(mx, sacc[i]);
        mx = on ? mx * 0.18033688011112042f : -1e30f;
        mx = fmaxf(mx, xshfl(mx, 32));
        const float mnew = fmaxf(m, mx);
        corr = __builtin_amdgcn_exp2f(m - mnew);
        m = mnew;
#pragma unroll
        for (int i = 0; i < 16; ++i) { const float p = __builtin_amdgcn_exp2f(sacc[i] * 0.18033688011112042f - mnew); psum += p; sacc[i] = p; }
        if (!on) {
            psum = 0.f;
#pragma unroll
            for (int i = 0; i < 16; ++i) sacc[i] = 0.f;
        }
    } else {
#pragma unroll
        for (int i = 0; i < 16; ++i) { const int key = kb0 + 16 * (i >> 3) + (i & 7); const bool ok = (key >= lo) && (key <= hi);
            const float sv = ok ? sacc[i] * 0.18033688011112042f : -1e30f; sacc[i] = sv; mx = fmaxf(mx, sv); }
        mx = fmaxf(mx, xshfl(mx, 32));
        const float mnew = fmaxf(m, mx);
        corr = __builtin_amdgcn_exp2f(m - mnew);
        m = mnew;
#pragma unroll
        for (int i = 0; i < 16; ++i) { const float p = sacc[i] > -1e29f ? __builtin_amdgcn_exp2f(sacc[i] - mnew) : 0.f; psum += p; sacc[i] = p; }
    }
    l = l * corr + psum;
    if (__any(corr != 1.f)) {
#pragma unroll
        for (int i = 0; i < 16; ++i) { O[0][i] *= corr; O[1][i] *= corr; }
        if (IMP) {
#pragma unroll
            for (int i = 0; i < 16; ++i) { IM[0][i] *= corr; IM[1][i] *= corr; }
        }
    }
    bf16x8v pf[2];
#pragma unroll
    for (int sx = 0; sx < 2; ++sx) { u32x4 w; w.x = pkbf(sacc[8 * sx], sacc[8 * sx + 1]); w.y = pkbf(sacc[8 * sx + 2], sacc[8 * sx + 3]); w.z = pkbf(sacc[8 * sx + 4], sacc[8 * sx + 5]); w.w = pkbf(sacc[8 * sx + 6], sacc[8 * sx + 7]);
        pf[sx] = __builtin_bit_cast(bf16x8v, w); }
    const unsigned char* vb = buf + 64 * KV_STRIDE + r * KV_STRIDE + (32 * tt + 8 * h) * 2;
#pragma unroll
    for (int dt = 0; dt < 2; ++dt)
#pragma unroll
        for (int sx = 0; sx < 2; ++sx) { const bf16x8v a = *(const bf16x8v*)(vb + dt * 32 * KV_STRIDE + sx * 32); O[dt] = MFMA32(a, pf[sx], O[dt]); }
    if (IMP) {
#pragma unroll
        for (int st = 0; st < 2; ++st)
#pragma unroll
            for (int sx = 0; sx < 2; ++sx) IM[st] = MFMA32(ov[st][sx], pf[sx], IM[st]);
    }
}

template <int MODE>
__device__ __forceinline__ void attn_branch(unsigned char* kvbuf, const bf16* Kg0, const bf16* VTg0, int vts, unsigned long long blkmask, int t, int nv, unsigned long long selm,
                                            int wlo, int whi, int flo, int fhi, const bf16x8v (&qf)[4], f32x16 (&O)[2], f32x16 (&IM)[2], float& l, const bf16* ovt, int tid, int r, int h, int pr) {
    float m = -1e30f;
    l = 0.f;
#pragma unroll
    for (int i = 0; i < 16; ++i) { O[0][i] = 0.f; O[1][i] = 0.f; IM[0][i] = 0.f; IM[1][i] = 0.f; }
    const int srow = tid >> 3, sch = tid & 7;
    int j = __builtin_ctzll(blkmask);
    unsigned long long rest = blkmask & (blkmask - 1);
    u32x4 kr = *(const u32x4*)(Kg0 + (size_t)(64 * j + srow) * 64 + sch * 8);
    u32x4 vr = *(const u32x4*)(VTg0 + (size_t)srow * vts + 64 * j + sch * 8);
    *(u32x4*)(kvbuf + srow * KV_STRIDE + sch * 16) = kr;
    *(u32x4*)(kvbuf + 64 * KV_STRIDE + srow * KV_STRIDE + sch * 16) = vr;
    int cur = 0;
    for (;;) {
        LDS_BAR();
        const bool more = rest != 0ull;
        int jn = 0;
        if (more) { jn = __builtin_ctzll(rest); rest &= rest - 1;
            kr = *(const u32x4*)(Kg0 + (size_t)(64 * jn + srow) * 64 + sch * 8);
            vr = *(const u32x4*)(VTg0 + (size_t)srow * vts + 64 * jn + sch * 8); }
        const unsigned char* buf = kvbuf + cur * KV_BUF;
        int lo, hi;
        if (MODE == 0) { lo = 0; hi = nv - 1; }
        else if (MODE == 1) { lo = 0; hi = ((selm >> j) & 1ull) ? t : -1; }
        else { lo = t - 511; hi = t; }
        const bool wave_on = (MODE != 1) || __any(hi >= 0);
#pragma unroll
        for (int tt = 0; tt < 2; ++tt) {
            const int key0 = 64 * j + 32 * tt;
            if (!wave_on || key0 > whi || key0 + 31 < wlo) continue;
            attn_tile<MODE == 0>(key0 >= flo && key0 + 31 <= fhi, buf, tt, key0, lo, hi, qf, O, IM, m, l, ovt, r, h, pr);
        }
        if (!more) break;
        *(u32x4*)(kvbuf + (cur ^ 1) * KV_BUF + srow * KV_STRIDE + sch * 16) = kr;
        *(u32x4*)(kvbuf + (cur ^ 1) * KV_BUF + 64 * KV_STRIDE + srow * KV_STRIDE + sch * 16) = vr;
        cur ^= 1; j = jn;
    }
    LDS_BAR();
}

__device__ __forceinline__ void phase_nsa_attn(unsigned char* lds, const bf16* QN, const bf16* KS, const bf16* KW, const bf16* VST, const bf16* VWT, const bf16* KCb, const bf16* VCT,
                                               const bf16* ovt, const float* gates, const f32x2* tab, bf16* hn, int vblk, int nblk, int tid, int wid, int lane) {
    const int r = lane & 31, h = lane >> 5, pr = (r & ~12) | ((r & 4) << 1) | ((r & 8) >> 1);
    float* imp_s = (float*)(lds + ATT_IMP_OFF + wid * 2048);
    unsigned long long* msk_s = (unsigned long long*)(lds + ATT_MSK_OFF);
    unsigned* uni_s = (unsigned*)(lds + ATT_MSK_OFF + 512);
    for (int item = vblk; item < Bn * 4 * 64; item += nblk) {
        const int rnd = item / nblk, wv = item - rnd * nblk;
        const int bh = wv & 31, sub = wv >> 5, per = nblk >> 5;
        int qb = rnd * per + ((rnd & 1) ? (per - 1 - sub) : sub);
        if (nblk != 256) { qb = item >> 5; }
        const int bhh = (nblk != 256) ? (item & 31) : bh;
        const int b = bhh >> 2, hk = bhh & 3;
        const int t0 = qb * 64, tw0 = t0 + 8 * wid, t = tw0 + (r & 7), g = r >> 3;
        const size_t tok = (size_t)b * S + t;
        if (tid == 0) { unsigned z = 0u; asm volatile("" : "+v"(z)); uni_s[0] = z; uni_s[1] = z; }
        bf16x8v qn[4], qr[4];
        {
            const bf16* qp = QN + ((size_t)(b * 16 + hk * 4 + g) * S + t) * 64 + 8 * h;
#pragma unroll
            for (int ks = 0; ks < 4; ++ks) qn[ks] = *(const bf16x8v*)(qp + 16 * ks);
            const f32x2* cp = tab + tok * 32 + 8 * h;
#pragma unroll
            for (int kl = 0; kl < 2; ++kl) {
                u32x4 wlo_, whi_;
                const u32x4 a = __builtin_bit_cast(u32x4, qn[kl]), c = __builtin_bit_cast(u32x4, qn[kl + 2]);
#pragma unroll
                for (int jj = 0; jj < 4; ++jj) {
                    const f32x2 cs0 = cp[16 * kl + 2 * jj], cs1 = cp[16 * kl + 2 * jj + 1];
                    const float x0 = bf2f(a[jj] & 0xffffu), x1 = bf2f(a[jj] >> 16), y0 = bf2f(c[jj] & 0xffffu), y1 = bf2f(c[jj] >> 16);
                    wlo_[jj] = pkbf(x0 * cs0.x - y0 * cs0.y, x1 * cs1.x - y1 * cs1.y);
                    whi_[jj] = pkbf(y0 * cs0.x + x0 * cs0.y, y1 * cs1.x + x1 * cs1.y);
                }
                qr[kl] = __builtin_bit_cast(bf16x8v, wlo_); qr[kl + 2] = __builtin_bit_cast(bf16x8v, whi_);
            }
        }
        const float* gp = gates + tok * 48 + (hk * 4 + g) * 3;
        const float g0 = sigmoidf_(gp[0]), g1 = sigmoidf_(gp[1]), g2 = sigmoidf_(gp[2]);
        f32x16 acc[2], O[2], IM[2];
        float l;
        const int nv = t >= 31 ? ((t - 31) >> 4) + 1 : 0;
        const int nvw = ((tw0 + 7 - 31) >> 4) + 1;
        const int nvmax = 4 * qb + 3;
        {
            const int ncb = (nvmax + 63) >> 6;
            const unsigned long long bm = ncb >= 64 ? ~0ull : ((1ull << ncb) - 1ull);
            attn_branch<0>(lds, KCb + (size_t)bhh * 256 * 64, VCT + (size_t)bhh * 64 * 256, 256, bm, t, nv, 0ull, 0, (tw0 + 7 >= 31 ? nvw - 1 : -1), 0, (tw0 >= 31 ? ((tw0 - 31) >> 4) : -1), qn, O, IM, l, ovt, tid, r, h, pr);
        }
        {
            const float lt = l + xshfl(l, 32), inv = lt > 0.f ? 1.f / lt : 0.f, sc = inv * g0;
#pragma unroll
            for (int i = 0; i < 16; ++i) { acc[0][i] = O[0][i] * sc; acc[1][i] = O[1][i] * sc; }
#pragma unroll
            for (int st = 0; st < 2; ++st)
#pragma unroll
                for (int i = 0; i < 16; ++i) { float v = IM[st][i] * inv; v += xshfl(v, 8); v += xshfl(v, 16);
                    if (r < 8) imp_s[r * 64 + 32 * st + (i & 3) + 8 * (i >> 2) + 4 * h] = v; }
        }
        WAVE_SYNC();
        {
            unsigned long long um = 0ull;
            for (int tk = 0; tk < 8; ++tk) {
                const float imp = imp_s[tk * 64 + lane];
                const bool sv = lane <= qb, forced = (lane == 0) || (lane == qb) || (lane + 1 == qb);
                const float score = sv ? (forced ? 1e9f : imp) : -1.f;
                int rank = 0;
#pragma unroll 4
                for (int i = 0; i < 64; ++i) { const float si = __uint_as_float(__builtin_amdgcn_readlane(__float_as_uint(score), i)); rank += (si > score || (si == score && i < lane)) ? 1 : 0; }
                const unsigned long long mk = __ballot((rank < 16) && (score >= 0.f));
                um |= mk;
                if (lane == 0) msk_s[wid * 8 + tk] = mk;
            }
            if (lane == 0) { atomicOr(&uni_s[0], (unsigned)um); atomicOr(&uni_s[1], (unsigned)(um >> 32)); }
        }
        __syncthreads();
        const unsigned long long selm = msk_s[wid * 8 + (r & 7)];
        const unsigned long long uni = (unsigned long long)uni_s[0] | ((unsigned long long)uni_s[1] << 32);
        attn_branch<1>(lds, KS + (size_t)bhh * S * 64, VST + (size_t)bhh * 64 * S, S, uni, t, 0, selm, 0, tw0 + 7, 0, tw0, qr, O, IM, l, ovt, tid, r, h, pr);
        {
            const float lt = l + xshfl(l, 32), sc = g1 / lt;
#pragma unroll
            for (int i = 0; i < 16; ++i) { acc[0][i] += O[0][i] * sc; acc[1][i] += O[1][i] * sc; }
        }
        {
            const int jlo = qb >= 8 ? qb - 8 : 0;
            const unsigned long long bm = (qb >= 63 ? ~0ull : ((1ull << (qb + 1)) - 1ull)) & ~((1ull << jlo) - 1ull);
            attn_branch<2>(lds, KW + (size_t)bhh * S * 64, VWT + (size_t)bhh * 64 * S, S, bm, t, 0, 0ull, tw0 - 511, tw0 + 7, tw0 + 7 - 511, tw0, qr, O, IM, l, ovt, tid, r, h, pr);
        }
        {
            const float lt = l + xshfl(l, 32), sc = g2 / lt;
            bf16* op = hn + tok * D + (hk * 4 + g) * 64 + 4 * h;
#pragma unroll
            for (int dt = 0; dt < 2; ++dt)
#pragma unroll
                for (int q4 = 0; q4 < 4; ++q4) {
                    u32x2 w; w.x = pkbf(acc[dt][4 * q4] + O[dt][4 * q4] * sc, acc[dt][4 * q4 + 1] + O[dt][4 * q4 + 1] * sc);
                    w.y = pkbf(acc[dt][4 * q4 + 2] + O[dt][4 * q4 + 2] * sc, acc[dt][4 * q4 + 3] + O[dt][4 * q4 + 3] * sc);
                    *(u32x2*)(op + 32 * dt + 8 * q4) = w;
                }
        }
    }
}


#define LAS __attribute__((address_space(3)))
#define XB_TMO      128
#define XB_XCNT(j)  (256  + 64 * (j))
#define XB_XSUB(j)  (1280 + 64 * (j))
#define XB_XGEN(j)  (2304 + 64 * (j))
#define XB_TOP      3328
#define XB_TOPGEN   3392
#define XCD_BAR_WORDS 3456
#define XB_SPIN_CAP (1u << 18)

__device__ __forceinline__ unsigned xb_ld(unsigned* p)              { return __hip_atomic_load(p, __ATOMIC_RELAXED, __HIP_MEMORY_SCOPE_AGENT); }
__device__ __forceinline__ unsigned xb_add(unsigned* p, unsigned v) { return __hip_atomic_fetch_add(p, v, __ATOMIC_RELAXED, __HIP_MEMORY_SCOPE_AGENT); }
__device__ __forceinline__ unsigned xb_xcc_id() { return (unsigned)__builtin_amdgcn_s_getreg((3 << 11) | 20) & 0xFu; }
#define XB_SPIN(cond, bar) do { unsigned _sp = 0; while (cond) { __builtin_amdgcn_s_sleep(1); \
    if ((++_sp & 255u) == 0u) { if (xb_ld(&(bar)[XB_TMO])) break; if (_sp > XB_SPIN_CAP) { atomicAdd(&(bar)[XB_TMO], 1u); break; } } } } while (0)

struct XcdBarrier {
    unsigned* bar; unsigned x;
    volatile LAS unsigned* st;
};

__device__ __forceinline__ XcdBarrier xcd_barrier_post(unsigned* bar, volatile LAS unsigned* st) {
    XcdBarrier b; b.bar = bar; b.x = xb_xcc_id(); b.st = st;
    if (threadIdx.x == 0) (void)xb_add(&bar[XB_XCNT(b.x)], 1u);
    return b;
}
__device__ __forceinline__ void xcd_barrier_complete(unsigned* bar, unsigned x, unsigned& nloc, unsigned& nx) {
    const unsigned G = gridDim.x * gridDim.y * gridDim.z;
    unsigned sum, cnt, mine, sp = 0u;
    for (;;) {
        sum = 0u; cnt = 0u; mine = 0u;
#pragma unroll
        for (unsigned j = 0; j < 16; ++j) { const unsigned c = xb_ld(&bar[XB_XCNT(j)]); sum += c; cnt += (c > 0u) ? 1u : 0u; mine = (j == x) ? c : mine; }
        if (sum == G) break;
        __builtin_amdgcn_s_sleep(1);
        if ((++sp & 255u) == 0u) { if (xb_ld(&bar[XB_TMO])) break; if (sp > XB_SPIN_CAP) { atomicAdd(&bar[XB_TMO], 1u); break; } }
    }
    nloc = mine > 0u ? mine : 1u; nx = cnt > 0u ? cnt : 1u;
}

__device__ __forceinline__ void xcd_barrier(const XcdBarrier& b) {
    asm volatile("s_waitcnt vmcnt(0)" ::: "memory");
    __syncthreads();
    if (threadIdx.x == 0) {
        unsigned* bar = b.bar;
        __builtin_amdgcn_s_waitcnt(0);
        unsigned nloc = b.st[0], nx = b.st[1];
        if (nloc == 0u) { xcd_barrier_complete(bar, b.x, nloc, nx); b.st[0] = nloc; b.st[1] = nx; }
        const unsigned old = xb_add(&bar[XB_XSUB(b.x)], 1u);
        const unsigned gen = old / nloc;
        if (old + 1u == (gen + 1u) * nloc) {
            __builtin_amdgcn_fence(__ATOMIC_RELEASE, "agent");
            asm volatile("s_waitcnt vmcnt(0)" ::: "memory");
            const unsigned og = xb_add(&bar[XB_TOP], 1u);
            const unsigned tg = og / nx;
            if (og + 1u == (tg + 1u) * nx) xb_add(&bar[XB_TOPGEN], 1u);
            else XB_SPIN(xb_ld(&bar[XB_TOPGEN]) == tg, bar);
            __builtin_amdgcn_fence(__ATOMIC_ACQUIRE, "agent");
            xb_add(&bar[XB_XGEN(b.x)], 1u);
            asm volatile("s_waitcnt vmcnt(0)" ::: "memory");
        } else {
            XB_SPIN(xb_ld(&bar[XB_XGEN(b.x)]) == gen, bar);
            __builtin_amdgcn_fence(__ATOMIC_ACQUIRE, "agent");
            asm volatile("s_waitcnt vmcnt(0)" ::: "memory");
        }
    }
    __syncthreads();
}

struct Args { const void* in[24]; float* out; unsigned char* ws; int lo, hi; };

__host__ __device__ constexpr int mixer_inner_phases(int kind) { return kind == 0 ? 3 : (kind == 1 ? 1 : 4); }
__host__ __device__ constexpr int total_phases() { int n = 1; for (int L = 0; L < DEPTH; ++L) n += 4 + 2 + mixer_inner_phases(L % 3); return n; }

__global__ void __launch_bounds__(512, 2) mega(Args args) {
    extern __shared__ __attribute__((aligned(16))) unsigned char lds[];
    cg::grid_group grid = cg::this_grid();
    volatile LAS unsigned* bst = (volatile LAS unsigned*)((LAS unsigned char*)lds + (LDS_BYTES - 64));
    if (threadIdx.x < 2) bst[threadIdx.x] = 0u;
    __syncthreads();
    const XcdBarrier xbar = xcd_barrier_post((unsigned*)args.ws, bst);
    bool again = false;
    for (int ph = args.lo; ph < args.hi; ++ph) {
        int type = 0, s = 0, L = 0;
        if (ph > 0) {
            int p = ph - 1;
            for (L = 0; L < DEPTH; ++L) { const int n = 6 + mixer_inner_phases(L % 3); if (p < n) break; p -= n; }
            const int inner = mixer_inner_phases(L % 3), kind = L % 3;
            if (p < 2) { type = 2 + p; s = 2 * L; }
            else if (p == 2) type = 5;
            else if (p < 3 + inner) { const int q = p - 3; type = kind == 0 ? (q == 0 ? 15 : 5 + q) : (kind == 1 ? 8 : 9 + q); }
            else if (p == 3 + inner) type = 13;
            else { type = 2 + (p - 4 - inner); s = 2 * L + 1; }
        }
        int tid_ = threadIdx.x; asm volatile("" : "+v"(tid_));
        int G_ = gridDim.x, bx_ = blockIdx.x; asm volatile("" : "+s"(G_), "+s"(bx_));
        const int tid = tid_, lane = tid & 63, wid = __builtin_amdgcn_readfirstlane(tid >> 6);
        const int G = G_, bx = bx_;
        const int vcu = (G % 8 == 0) ? (bx % 8) * (G / 8) + bx / 8 : bx;
        const int gw = vcu * 8 + wid, NGW = G * 8;
        unsigned char* ws = args.ws; asm volatile("" : "+s"(ws));
        PG8_LAS unsigned char* ldsl = (PG8_LAS unsigned char*)lds;
        float* hout = args.out; asm volatile("" : "+s"(hout));
        bf16* HN = (bf16*)(ws + WS_HN);
        bf16* RB = (bf16*)(ws + WS_R);
        f32x2* tab = (f32x2*)(ws + WS_TAB);
        const int kind = L % 3, jj = L / 3;
        bf16* QN = RB + (size_t)T * 2560;
        bf16* KSb = QN + (size_t)T * 1024;
        bf16* KWb = KSb + (size_t)T * 256;
        bf16* KCH = (bf16*)(ws + WS_O32);
        bf16* VCH = KCH + (size_t)T * 256;
        float* Pk = (float*)(ws + WS_O32 + 32 * MiB);
        float* Pv = Pk + (size_t)8192 * 512;
        bf16* KC = (bf16*)(ws + WS_O32 + 64 * MiB);
        bf16* VC = (bf16*)(ws + WS_O32 + 65 * MiB);
        bf16* OVT = (bf16*)(ws + WS_BP + 65536);
        bf16* VST = (bf16*)(ws + WS_O32 + 68 * MiB);
        bf16* VWT = (bf16*)(ws + WS_O32 + 84 * MiB);
        switch (type) {
        case 0: {
            float* scr = (float*)lds + wid * (64 * 33);
            for (int mi = 0; mi < 28; ++mi) {
                const float* W; const float* nw = nullptr; int K, N, Npad, mode = 0; bf16* WT;
                if (mi < 8)       { nw = (const float*)args.in[2] + (size_t)mi * D; W = (const float*)args.in[3] + (size_t)mi * D * 2 * FF; K = D; N = 2 * FF; Npad = N; mode = 1; WT = (bf16*)(ws + WS_WGU) + (size_t)mi * 2 * FF * D; }
                else if (mi < 16) { const int i = mi - 8; W = (const float*)args.in[4] + (size_t)i * FF * D; K = FF; N = D; Npad = N; WT = (bf16*)(ws + WS_WDN) + (size_t)i * D * FF; }
                else if (mi < 18) { const int i = mi - 16; nw = (const float*)args.in[5] + (size_t)(3 * i) * D; W = (const float*)args.in[6] + (size_t)i * D * 4112; K = D; N = 4112; Npad = GDN_NPAD; WT = (bf16*)(ws + WS_WGI) + (size_t)i * GDN_NPAD * D; }
                else if (mi < 20) { const int i = mi - 18; W = (const float*)args.in[11] + (size_t)i * D * D; K = D; N = D; Npad = N; WT = (bf16*)(ws + WS_WGO) + (size_t)i * D * D; }
                else if (mi == 20) { nw = (const float*)args.in[5] + (size_t)1 * D; W = (const float*)args.in[12]; K = D; N = 3072; Npad = N; WT = (bf16*)(ws + WS_WSI); }
                else if (mi == 21) { W = (const float*)args.in[14]; K = D; N = D; Npad = N; WT = (bf16*)(ws + WS_WSO); }
                else if (mi == 22) { nw = (const float*)args.in[5] + (size_t)2 * D; W = (const float*)args.in[15]; K = D; N = 2608; Npad = NSA_NPAD; WT = (bf16*)(ws + WS_WNI); }
                else if (mi == 23) { W = (const float*)args.in[23]; K = D; N = D; Npad = N; WT = (bf16*)(ws + WS_WNO); }
                else { const int i = mi - 24, kd = i >> 1, hf = i & 1;
                    W = (const float*)args.in[19] + (size_t)kd * 2048 * 256 + (size_t)hf * 1024 * 256; K = 1024; N = 256; Npad = 256; WT = (bf16*)(ws + WS_WC1) + (size_t)kd * 512 * 1024 + (size_t)hf * 256 * 1024; }
                xpose_matrix(W, nw, K, N, Npad, WT, mode, scr, gw, NGW, lane);
            }
            {
                float* ss = (float*)(ws + WS_SS);
                const float* xin = (const float*)args.in[0];
                for (int m0 = gw; m0 < T; m0 += 4 * NGW) {
                    f32x4 v[4][4];
#pragma unroll
                    for (int q = 0; q < 4; ++q) { const int m = m0 + q * NGW < T ? m0 + q * NGW : m0; const f32x4* xr = (const f32x4*)(xin + (size_t)m * D) + lane;
#pragma unroll
                        for (int j = 0; j < 4; ++j) v[q][j] = xr[64 * j]; }
#pragma unroll
                    for (int q = 0; q < 4; ++q) {
                        const int m = m0 + q * NGW;
                        if (m >= T) break;
                        u32x2* o8 = (u32x2*)(HN + (size_t)m * D) + lane; float sq = 0.f;
#pragma unroll
                        for (int j = 0; j < 4; ++j) { const f32x4 x = v[q][j]; sq += (x.x * x.x + x.y * x.y) + (x.z * x.z + x.w * x.w); u32x2 o; o.x = pkbf(x.x, x.y); o.y = pkbf(x.z, x.w); o8[64 * j] = o; }
                        sq = wave_sum(sq); if (lane < 16) ss[(size_t)m * 16 + lane] = lane == 0 ? sq : 0.f;
                    }
                }
            }
            const int* positions = (const int*)args.in[1];
            for (int idx = bx * 512 + tid; idx < T * 32; idx += G * 512) {
                const int tk = idx >> 5, i = idx & 31;
                const float inv = 1.0f / exp2f((float)(2 * i) * (13.287712379549449f / 64.f));
                const float ang = (float)positions[tk] * inv;
                const double rev = (double)ang * 0.15915494309189535;
                const float fr = (float)(rev - rint(rev));
                f32x2 v; v.x = __builtin_amdgcn_cosf(fr); v.y = __builtin_amdgcn_sinf(fr);
                tab[idx] = v;
            }
            for (int idx = bx * 512 + tid; idx < 64 * 256; idx += G * 512) {
                const int sj = idx >> 8, i = idx & 255, q = i >> 2, rem = i & 3;
                OVT[idx] = (bf16)(rem < 3 ? (q == sj ? 0x3F80 : 0) : ((q == sj || q + 1 == sj) ? 0x3F00 : 0));
            }
            if (bx < 2 && tid < 256) {
                const float* pe = (const float*)args.in[18] + (size_t)bx * 2048;
                const float* w1 = (const float*)args.in[19] + (size_t)bx * 2048 * 256 + tid;
                float acc = ((const float*)args.in[20])[bx * 256 + tid];
                for (int k = 0; k < 2048; ++k) acc += pe[k] * w1[(size_t)k * 256];
                ((float*)(ws + WS_BP))[bx * 256 + tid] = acc;
            }
        } break;
        case 2: {
            const bf16* Ah = (s & 1) ? (const bf16*)(ws + WS_R + 192 * MiB) : HN;
            pg8::Gemm g{Ah, (const bf16*)(ws + WS_WGU) + (size_t)s * 2 * FF * D, T, 2 * FF, D}; pg8::StaticOrder SO; SO.init(T, 2 * FF, G, bx);
            float* rtab = (float*)(lds + 131072);
            rstd_table(rtab, (const float*)(ws + WS_SS) + (size_t)s * T * 16, SO, tid);
            pg8::EpiSwiGLU E{RB, rtab};
            pg8::gemm_phase<pg8::EpiSwiGLU, pg8::StaticOrder, true, true>(ldsl, g, SO, E, tid); } break;
        case 3: {
            pg8::Gemm g{RB, (const bf16*)(ws + WS_WDN) + (size_t)s * D * FF, T, D, FF}; pg8::StaticOrder SO; SO.init(T, D, G, bx);
            const int slot = (s & 1) ? (s < 7 ? s + 1 : 12) : 8 + (s >> 1);
            pg8::EpiResid<1> E{s == 0 ? (const float*)args.in[0] : hout, hout, HN, (float*)(ws + WS_SS) + (size_t)slot * T * 16};
            pg8::gemm_phase<pg8::EpiResid<1>, pg8::StaticOrder, true, true>(ldsl, g, SO, E, tid); } break;
        case 5: {
            const bf16* Wt; int Np, ldc, nmain, ldt, nvalid; float* tail;
            if (kind == 0) { Wt = (const bf16*)(ws + WS_WGI) + (size_t)jj * GDN_NPAD * D; Np = GDN_NPAD; ldc = 4096; nmain = 4096; tail = (float*)(ws + WS_AB); ldt = 16; nvalid = 4112; }
            else if (kind == 1) { Wt = (const bf16*)(ws + WS_WSI); Np = 3072; ldc = 3072; nmain = 3072; tail = (float*)(ws + WS_AB); ldt = 16; nvalid = 3072; }
            else { Wt = (const bf16*)(ws + WS_WNI); Np = NSA_NPAD; ldc = 2560; nmain = 2560; tail = (float*)(ws + WS_GT); ldt = 48; nvalid = 2608; }
            pg8::Gemm g{HN, Wt, T, Np, D}; pg8::StaticOrder SO; SO.init(T, Np, G, bx);
            float* rtab = (float*)(lds + 131072);
            rstd_table(rtab, (const float*)(ws + WS_SS) + (size_t)(8 + L) * T * 16, SO, tid);
            pg8::EpiProj E{RB, ldc, nmain, tail, ldt, nvalid, rtab, (bf16*)(ws + WS_HALO), kind == 0 ? 1 : 0};
            pg8::gemm_phase<pg8::EpiProj, pg8::StaticOrder, true, true>(ldsl, g, SO, E, tid); } break;
        case 14: phase_gdn_halo(RB, (bf16*)(ws + WS_HALO), vcu * 512 + tid, G * 512); break;
        case 15: phase_gdn_prep(lds, RB, (const bf16*)(ws + WS_HALO), (const float*)(ws + WS_AB), (const float*)args.in[7] + (size_t)jj * 4 * 3072, (const float*)args.in[8] + jj * 8, (const float*)args.in[9] + jj * 8,
                                HN, (bf16*)(ws + WS_O32 + 64 * MiB), (float*)(ws + WS_GL), bx, G, tid, wid, lane); break;
        case 6:
#ifndef DIS_SCAN
            phase_gdn_scan2(lds, RB, HN, (const bf16*)(ws + WS_O32 + 64 * MiB), (const float*)(ws + WS_GL), (bf16*)(ws + WS_O32), bx, G, tid, wid, lane);
#endif
            break;
        case 7:
#ifndef DIS_GPOST
            phase_gdn_post((const bf16*)(ws + WS_O32), RB, (const float*)args.in[10] + jj * 128, HN, gw, NGW, lane);
#endif
            break;
        case 8:
#ifndef DIS_SPOST
            phase_sc_post(RB, (const float*)args.in[13], HN, vcu * 512 + tid, G * 512);
#endif
            break;
        case 9:
#ifndef DIS_NPOST
            phase_nsa_post(lds, RB, (const float*)args.in[16], (const float*)args.in[17], tab, QN, KSb, KWb, KCH, VCH, VST, VWT, gw, NGW, wid, lane);
#endif
            break;
        case 10: {
            pg8::Gemm g{KCH, (const bf16*)(ws + WS_WC1), 8192, 512, 1024}; pg8::StaticOrder SO; SO.init(8192, 512, G, bx);
            pg8::Gemm g2{VCH, (const bf16*)(ws + WS_WC1) + (size_t)512 * 1024, 8192, 512, 1024};
            pg8::EpiF32 E{Pk, 512};
            if (bx >= G / 2) { g = g2; SO.init(8192, 512, G, bx - G / 2); E.C = Pv; }
            pg8::gemm_phase<pg8::EpiF32, pg8::StaticOrder, true, true>(ldsl, g, SO, E, tid); } break;
        case 11:
#ifndef DIS_CMP2
            phase_cmp2(lds, Pk, Pv, (const float*)(ws + WS_BP), (const float*)args.in[21], (const float*)args.in[22], (const float*)args.in[17], KC, VC, gw, NGW, wid, lane, tid);
#endif
            break;
        case 12:
#ifndef DIS_ATTN
            phase_nsa_attn(lds, QN, KSb, KWb, VST, VWT, KC, VC, OVT, (const float*)(ws + WS_GT), tab, HN, bx, G, tid, wid, lane);
#endif
            break;
        default: {
            const bf16* Wout = kind == 0 ? (const bf16*)(ws + WS_WGO) + (size_t)jj * D * D : (kind == 1 ? (const bf16*)(ws + WS_WSO) : (const bf16*)(ws + WS_WNO));
            pg8::Gemm g{HN, Wout, T, D, D}; pg8::StaticOrder SO; SO.init(T, D, G, bx);
            pg8::EpiResid<2> E{hout, hout, (bf16*)(ws + WS_R + 192 * MiB), (float*)(ws + WS_SS) + (size_t)(2 * L + 1) * T * 16};
            pg8::gemm_phase<pg8::EpiResid<2>, pg8::StaticOrder, true, true>(ldsl, g, SO, E, tid); } break;
        }
#ifdef REP_TYPE
        if (type == REP_TYPE && !again) { again = true; xcd_barrier(xbar); --ph; continue; }
        again = false;
#endif
        if (ph + 1 < args.hi) { if (args.hi < 0) grid.sync(); else xcd_barrier(xbar); }
    }
}

extern "C" void kernel_launch(void* const* d_in, const int* in_sizes, int n_in, void* d_out, int out_size, void* d_ws, size_t ws_size, hipStream_t stream) {
    static int grid = 0;
    if (grid == 0) {
        if (n_in != 24 || out_size != T * D || ws_size < WS_END2) { fprintf(stderr, "kernel_launch: unexpected shapes n_in %d out %d ws %zu (need %zu)\n", n_in, out_size, ws_size, (size_t)WS_END2); grid = -1; return; }
        int dev = 0, cus = 0, per_cu = 0;
        hipGetDevice(&dev); hipDeviceGetAttribute(&cus, hipDeviceAttributeMultiprocessorCount, dev);
        if (hipFuncSetAttribute((const void*)mega, hipFuncAttributeMaxDynamicSharedMemorySize, LDS_BYTES) != hipSuccess) { fprintf(stderr, "kernel_launch: hipFuncSetAttribute failed\n"); grid = -1; return; }
        if (hipOccupancyMaxActiveBlocksPerMultiprocessor(&per_cu, (const void*)mega, 512, LDS_BYTES) != hipSuccess || per_cu < 1) { fprintf(stderr, "kernel_launch: occupancy query says %d\n", per_cu); per_cu = 1; }
        (void)hipGetLastError();
        grid = cus;
    }
    if (grid < 0) return;
    Args a{};
    for (int i = 0; i < 24; ++i) a.in[i] = d_in[i];
    a.out = (float*)d_out; a.ws = (unsigned char*)d_ws;
    constexpr int NPH = total_phases();
#if MK_MULTI
    for (int p = 0; p < NPH; ++p) { a.lo = p; a.hi = p + 1; hipLaunchKernelGGL(mega, dim3(grid), dim3(512), LDS_BYTES, stream, a); }
#else
    a.lo = 0; a.hi = NPH;
    (void)hipMemsetAsync(d_ws, 0, 16384, stream);
    void* kargs[] = {&a};
    hipError_t e = hipLaunchCooperativeKernel((const void*)mega, dim3(grid), dim3(512), kargs, LDS_BYTES, stream);
    if (e != hipSuccess) fprintf(stderr, "cooperative launch failed: %s (grid %d)\n", hipGetErrorString(e), grid);
#endif
}
```

```cpp
#include <hip/hip_runtime.h>
#include <hip/hip_cooperative_groups.h>
#include <cstdio>
#include <cstdint>
namespace cg = cooperative_groups;
namespace pg8 {
#define PG8_LAS __attribute__((address_space(3)))
typedef unsigned short bf16_t;
typedef short bf16x8 __attribute__((ext_vector_type(8)));
typedef float f32x4 __attribute__((ext_vector_type(4)));
typedef unsigned u32x4 __attribute__((ext_vector_type(4)));
constexpr int BM = 256, BK = 64, HALF = 128, HTB = HALF * BK * 2  , STAGE_BYTES = 8 * HTB, NXCD = 8, WGM = 8;

__host__ __device__ __forceinline__ int lds_byte(int r, int c) { const int st = (r >> 4) * 2 + (c >> 5), rr = r & 15, cc = c & 31, ob = rr * 64 + cc * 2; return st * 1024 + (ob ^ (((ob >> 9) & 1) << 5)); }
__host__ __device__ __forceinline__ void stage_rc(int b, int& R, int& C) { const int st = b / 1024, sb = b % 1024, swz = sb ^ (((sb >> 9) & 1) << 5); R = (st >> 1) * 16 + swz / 64; C = (st & 1) * 32 + (swz % 64) / 2; }
__host__ __device__ __forceinline__ int perm32(int rho) { const int n = rho >> 4, i = rho & 15; return 8 * (i >> 2) + 4 * n + (i & 3); }

struct Unit { int pm, pn, ord; };
struct Gemm { const bf16_t* A; const bf16_t* Bt; int M, N, K; };

struct StaticOrder {
    int nM, nN, nwg, G, c;
    __host__ __device__ void init(int M, int N, int G_, int c_) { nM = M / BM; nN = N / BM; nwg = nM * nN; G = G_; c = c_; }
    __host__ __device__ bool next(int i, Unit& u) const {
        const long L = (long)i * G + c; if (L >= nwg) return false;
        int wgid = (int)L; { const int q = nwg / NXCD, r = nwg % NXCD, xcd = wgid % NXCD, off = wgid / NXCD; wgid = (xcd < r ? xcd * (q + 1) : r * (q + 1) + (xcd - r) * q) + off; }
        const int nig = WGM * nN, gid = wgid / nig, fm = gid * WGM, gsz = (nM - fm) < WGM ? (nM - fm) : WGM;
        u.pm = fm + ((wgid % nig) % gsz); u.pn = (wgid % nig) / gsz; u.ord = i; return true;
    }
    __device__ __forceinline__ void a_ready(const Unit&) const {}
    __device__ __forceinline__ void done(const Unit&) const {}
};
__device__ __forceinline__ unsigned cvt_pk_bf16(float lo, float hi) { unsigned r; asm volatile("v_cvt_pk_bf16_f32 %0, %1, %2" : "=v"(r) : "v"(lo), "v"(hi)); return r; }
template <class Epi, class Sched, bool ALIGN_EPI = false, bool SP2 = false>
__device__ __forceinline__ void gemm_phase(PG8_LAS unsigned char* lds, const Gemm g, const Sched& S, const Epi& E, const int tid) {
    const int wid = __builtin_amdgcn_readfirstlane(tid >> 6), lane = tid & 63, wr = wid >> 2, wc = wid & 3, fr = lane & 15, fq = lane >> 4;
    const int K = g.K, nt = K / BK;
    unsigned voffA[2], voffB[2];
#pragma unroll
    for (int i = 0; i < 2; ++i) { int R, C; stage_rc(tid * 16 + i * 8192, R, C); const int Rb = Epi::PERM ? ((R & ~31) + perm32(R & 31)) : R;
        voffA[i] = (unsigned)(R * K + C) * 2u; voffB[i] = (unsigned)(Rb * K + C) * 2u; }
    const size_t kstep = (size_t)(BK * 2);
    const size_t hstep = (size_t)HALF * K * 2;
    const size_t tstep = 2 * hstep;
    const unsigned ldsw = (unsigned)wid * 1024u;
    const int aoff = lds_byte(wr * 64 + fr, fq * 8), boff = lds_byte(wc * 32 + fr, fq * 8);
#define PG8_SA(b, h) (((b) * 2 + (h)) * HTB)
#define PG8_SB(b, h) ((4 + (b) * 2 + (h)) * HTB)
#define PG8_STAGE(bufoff, gbase, voff) do { _Pragma("unroll") for (int _i = 0; _i < 2; ++_i) \
        __builtin_amdgcn_global_load_lds((const unsigned*)((const char*)(gbase) + (voff)[_i]), (PG8_LAS unsigned*)(lds + (bufoff) + ldsw + _i * 8192), 16, 0, 0); } while (0)
#define PG8_LDA(dst, b, h) do { _Pragma("unroll") for (int m = 0; m < 4; ++m) _Pragma("unroll") for (int k = 0; k < 2; ++k) dst[m][k] = *(const PG8_LAS bf16x8*)(lds + PG8_SA(b, h) + aoff + m * 2048 + k * 1024); } while (0)
#define PG8_LDB(dst, b, h) do { _Pragma("unroll") for (int n = 0; n < 2; ++n) _Pragma("unroll") for (int k = 0; k < 2; ++k) dst[n][k] = *(const PG8_LAS bf16x8*)(lds + PG8_SB(b, h) + boff + n * 2048 + k * 1024); } while (0)
#define PG8_MMA(ai, bj, At, Bt) do { __builtin_amdgcn_s_setprio(1); _Pragma("unroll") for (int m = 0; m < 4; ++m) _Pragma("unroll") for (int n = 0; n < 2; ++n) _Pragma("unroll") for (int k = 0; k < 2; ++k) \
        acc[ai][bj][m][n] = __builtin_amdgcn_mfma_f32_16x16x32_bf16(Bt[n][k], At[m][k], acc[ai][bj][m][n], 0, 0, 0); __builtin_amdgcn_s_setprio(0); } while (0)
#define PG8_WAIT_V(n) asm volatile("s_waitcnt vmcnt(" #n ")" ::: "memory")
#define PG8_WAIT_L(n) asm volatile("s_waitcnt lgkmcnt(" #n ")" ::: "memory")
#define PG8_BAR __builtin_amdgcn_s_barrier()
#define PG8_SCHED __builtin_amdgcn_sched_barrier(0)
    Unit cur, nxt; int ui = 0;
    if (!S.next(0, cur)) return;
    f32x4 acc[2][2][4][2];
#pragma unroll
    for (int a = 0; a < 2; ++a)
#pragma unroll
        for (int b = 0; b < 2; ++b)
#pragma unroll
            for (int m = 0; m < 4; ++m)
#pragma unroll
                for (int n = 0; n < 2; ++n) acc[a][b][m][n] = (f32x4){0.f, 0.f, 0.f, 0.f};
    bf16x8 At[4][2], B0[2][2], B1[2][2];
    const char* cA = (const char*)g.A + (size_t)cur.pm * tstep; const char* cB = (const char*)g.Bt + (size_t)cur.pn * tstep;
    S.a_ready(cur);
    if constexpr (SP2) {
        PG8_STAGE(PG8_SB(0, 0), cB, voffB); PG8_STAGE(PG8_SB(0, 1), cB + hstep, voffB); PG8_STAGE(PG8_SA(0, 0), cA, voffA); PG8_STAGE(PG8_SA(0, 1), cA + hstep, voffA);
        if (wr == 1) PG8_BAR;
        PG8_WAIT_V(2); PG8_BAR;
        PG8_STAGE(PG8_SB(1, 0), cB + kstep, voffB); PG8_STAGE(PG8_SA(1, 0), cA + kstep, voffA); PG8_STAGE(PG8_SB(1, 1), cB + hstep + kstep, voffB);
        PG8_WAIT_V(6); PG8_BAR;
    } else {
        PG8_STAGE(PG8_SB(0, 0), cB, voffB); PG8_STAGE(PG8_SA(0, 0), cA, voffA); PG8_STAGE(PG8_SB(0, 1), cB + hstep, voffB); PG8_STAGE(PG8_SA(0, 1), cA + hstep, voffA);
        if (wr == 1) PG8_BAR;
        PG8_WAIT_V(4); PG8_BAR;
        PG8_STAGE(PG8_SB(1, 0), cB + kstep, voffB); PG8_STAGE(PG8_SA(1, 0), cA + kstep, voffA); PG8_STAGE(PG8_SB(1, 1), cB + hstep + kstep, voffB);
        PG8_WAIT_V(6); PG8_BAR;
    }
    for (;;) {
        const bool has_next = S.next(ui + 1, nxt);
        const char* nA = has_next ? (const char*)g.A + (size_t)nxt.pm * tstep : cA; const char* nB = has_next ? (const char*)g.Bt + (size_t)nxt.pn * tstep : cB;
        for (int t = 0; t < nt; t += 2) {
            const bool last = (t == nt - 2);
            const char* a1 = cA + (size_t)(t + 1) * kstep;
            const char* a2 = last ? nA : cA + (size_t)(t + 2) * kstep; const char* b2 = last ? nB : cB + (size_t)(t + 2) * kstep;
            const char* a3 = a2 + kstep; const char* b3 = b2 + kstep;
            if (last && has_next) S.a_ready(nxt);
            if constexpr (SP2) {
            PG8_LDB(B0, 0, 0); PG8_LDB(B1, 0, 1); PG8_SCHED; PG8_LDA(At, 0, 0); PG8_STAGE(PG8_SA(1, 1), a1 + hstep, voffA);
            PG8_WAIT_V(8); PG8_WAIT_L(0); PG8_BAR; PG8_MMA(0, 0, At, B0); PG8_MMA(0, 1, At, B1); PG8_BAR; PG8_SCHED;
            PG8_LDA(At, 0, 1); PG8_STAGE(PG8_SB(0, 0), b2, voffB); PG8_STAGE(PG8_SB(0, 1), b2 + hstep, voffB); PG8_STAGE(PG8_SA(0, 0), a2, voffA);
            PG8_WAIT_V(8); PG8_WAIT_L(0); PG8_BAR; PG8_MMA(1, 0, At, B0); PG8_MMA(1, 1, At, B1); PG8_BAR; PG8_SCHED;
            PG8_LDB(B0, 1, 0); PG8_LDB(B1, 1, 1); PG8_SCHED; PG8_LDA(At, 1, 0); PG8_STAGE(PG8_SA(0, 1), a2 + hstep, voffA);
            PG8_WAIT_V(8); PG8_WAIT_L(0); PG8_BAR; PG8_MMA(0, 0, At, B0); PG8_MMA(0, 1, At, B1); PG8_BAR; PG8_SCHED;
            PG8_LDA(At, 1, 1); PG8_STAGE(PG8_SB(1, 0), b3, voffB); PG8_STAGE(PG8_SB(1, 1), b3 + hstep, voffB); PG8_STAGE(PG8_SA(1, 0), a3, voffA);
            PG8_WAIT_V(8); PG8_WAIT_L(0); PG8_BAR; PG8_MMA(1, 0, At, B0); PG8_MMA(1, 1, At, B1); PG8_BAR; PG8_SCHED;
            } else {
            PG8_LDB(B0, 0, 0); PG8_SCHED; PG8_LDA(At, 0, 0); PG8_STAGE(PG8_SA(1, 1), a1 + hstep, voffA);
            PG8_WAIT_L(8); PG8_BAR; PG8_WAIT_L(0); PG8_MMA(0, 0, At, B0); PG8_BAR; PG8_SCHED;
            PG8_LDB(B1, 0, 1); PG8_STAGE(PG8_SB(0, 0), b2, voffB);
            PG8_BAR; PG8_WAIT_L(0); PG8_MMA(0, 1, At, B1); PG8_BAR;
            PG8_LDA(At, 0, 1); PG8_STAGE(PG8_SA(0, 0), a2, voffA);
            PG8_BAR; PG8_WAIT_L(0); PG8_MMA(1, 0, At, B0); PG8_BAR; PG8_SCHED;
            PG8_STAGE(PG8_SB(0, 1), b2 + hstep, voffB);
            PG8_WAIT_V(6); PG8_BAR; PG8_MMA(1, 1, At, B1); PG8_BAR;
            PG8_LDB(B0, 1, 0); PG8_SCHED; PG8_LDA(At, 1, 0); PG8_STAGE(PG8_SA(0, 1), a2 + hstep, voffA);
            PG8_WAIT_L(8); PG8_BAR; PG8_WAIT_L(0); PG8_MMA(0, 0, At, B0); PG8_BAR; PG8_SCHED;
            PG8_LDB(B1, 1, 1); PG8_STAGE(PG8_SB(1, 0), b3, voffB);
            PG8_BAR; PG8_WAIT_L(0); PG8_MMA(0, 1, At, B1); PG8_BAR;
            PG8_LDA(At, 1, 1); PG8_STAGE(PG8_SA(1, 0), a3, voffA);
            PG8_BAR; PG8_WAIT_L(0); PG8_MMA(1, 0, At, B0); PG8_BAR; PG8_SCHED;
            PG8_STAGE(PG8_SB(1, 1), b3 + hstep, voffB);
            PG8_WAIT_V(6); PG8_BAR; PG8_MMA(1, 1, At, B1); PG8_BAR;
            }
        }
        if constexpr (ALIGN_EPI) { if (wr == 0) PG8_BAR; }
        if constexpr (!Epi::AFTER_DRAIN) { E(acc, cur, wr, wc, fr, fq); S.done(cur); }
        if (!has_next) break;
#pragma unroll
        for (int a = 0; a < 2; ++a)
#pragma unroll
            for (int b = 0; b < 2; ++b)
#pragma unroll
                for (int m = 0; m < 4; ++m)
#pragma unroll
                    for (int n = 0; n < 2; ++n) acc[a][b][m][n] = (f32x4){0.f, 0.f, 0.f, 0.f};
        cur = nxt; cA = nA; cB = nB; ++ui;
        if constexpr (ALIGN_EPI) { if (wr == 1) PG8_BAR; }
    }
    PG8_WAIT_V(0);
    if constexpr (!ALIGN_EPI) { if (wr == 0) PG8_BAR; }
    PG8_BAR;
    if constexpr (Epi::AFTER_DRAIN) { E.fused(acc, cur, wr, wc, fr, fq, lds, wid, lane); S.done(cur); }
#undef PG8_SA
#undef PG8_SB
#undef PG8_STAGE
#undef PG8_LDA
#undef PG8_LDB
#undef PG8_MMA
#undef PG8_WAIT_V
#undef PG8_WAIT_L
#undef PG8_BAR
#undef PG8_SCHED
}
}

typedef unsigned short bf16;
typedef float f32x4 __attribute__((ext_vector_type(4)));
typedef float f32x2 __attribute__((ext_vector_type(2)));
typedef unsigned u32x4 __attribute__((ext_vector_type(4)));
typedef unsigned u32x2 __attribute__((ext_vector_type(2)));

#ifndef MK_MULTI
#define MK_MULTI 0
#endif

constexpr int Bn = 8, S = 4096, T = Bn * S, D = 1024, FF = 2816, DEPTH = 4;
constexpr float EPS = 1e-6f;
constexpr int GDN_NPAD = 4352, NSA_NPAD = 2816;
constexpr int LDS_BYTES = 147456;
constexpr size_t MiB = 1u << 20;
constexpr size_t WS_WGU = 1 * MiB;
constexpr size_t WS_WDN = WS_WGU + 88 * MiB;
constexpr size_t WS_WGI = WS_WDN + 44 * MiB;
constexpr size_t WS_WGO = WS_WGI + 17 * MiB;
constexpr size_t WS_WSI = WS_WGO + 4 * MiB;
constexpr size_t WS_WSO = WS_WSI + 6 * MiB;
constexpr size_t WS_WNI = WS_WSO + 2 * MiB;
constexpr size_t WS_WNO = WS_WNI + 6 * MiB;
constexpr size_t WS_WC1 = WS_WNO + 2 * MiB;
constexpr size_t WS_TAB = WS_WC1 + 2 * MiB;
constexpr size_t WS_HN  = 184 * MiB;
constexpr size_t WS_R   = WS_HN + 64 * MiB;
constexpr size_t WS_O32 = WS_R + 256 * MiB;
constexpr size_t WS_SM  = WS_O32 + 128 * MiB;
constexpr size_t WS_AB  = WS_SM;
constexpr size_t WS_GT  = WS_SM + 2 * MiB;
constexpr size_t WS_BP  = WS_SM + 8 * MiB;
constexpr size_t WS_END = WS_SM + 9 * MiB;
static_assert(WS_TAB + 8 * MiB <= WS_HN, "ws map");

__device__ __forceinline__ float bf2f(unsigned v) { return __uint_as_float(v << 16); }
__device__ __forceinline__ unsigned f2bf(float f) { unsigned u = __float_as_uint(f); return (u + 0x7fffu + ((u >> 16) & 1u)) >> 16; }
__device__ __forceinline__ unsigned pk2(float lo, float hi) { return f2bf(lo) | (f2bf(hi) << 16); }
#define MFMA32(a, b, c) __builtin_amdgcn_mfma_f32_32x32x16_bf16((a), (b), (c), 0, 0, 0)
typedef short bf16x8v __attribute__((ext_vector_type(8)));
typedef float f32x16 __attribute__((ext_vector_type(16)));
typedef __bf16 bf16v2 __attribute__((ext_vector_type(2)));
__device__ __forceinline__ unsigned pkbf(float a, float b) { f32x2 v = {a, b}; return __builtin_bit_cast(unsigned, __builtin_convertvector(v, bf16v2)); }
__device__ __forceinline__ int lane_opq() { int l = (int)__builtin_amdgcn_mbcnt_hi(~0u, __builtin_amdgcn_mbcnt_lo(~0u, 0u)); asm volatile("" : "+v"(l)); return l; }
__device__ __forceinline__ float xshfl(float v, int m) { return __int_as_float(__builtin_amdgcn_ds_bpermute((lane_opq() ^ m) << 2, __float_as_int(v))); }
__device__ __forceinline__ float xshfl_up(float v, int o) { return __int_as_float(__builtin_amdgcn_ds_bpermute((lane_opq() - o) << 2, __float_as_int(v))); }
__device__ __forceinline__ float wave_sum(float v) {
#pragma unroll
    for (int o = 1; o < 64; o <<= 1) v += xshfl(v, o);
    return v;
}
__device__ __forceinline__ float wave_max(float v) {
#pragma unroll
    for (int o = 1; o < 64; o <<= 1) v = fmaxf(v, xshfl(v, o));
    return v;
}
__device__ __forceinline__ float row_sum16(float v) {
    v += __uint_as_float((unsigned)__builtin_amdgcn_update_dpp(0, (int)__float_as_uint(v), 0x128, 0xf, 0xf, false));
    v += __uint_as_float((unsigned)__builtin_amdgcn_update_dpp(0, (int)__float_as_uint(v), 0x124, 0xf, 0xf, false));
    v += __uint_as_float((unsigned)__builtin_amdgcn_update_dpp(0, (int)__float_as_uint(v), 0x122, 0xf, 0xf, false));
    v += __uint_as_float((unsigned)__builtin_amdgcn_update_dpp(0, (int)__float_as_uint(v), 0x121, 0xf, 0xf, false));
    return v;
}
__device__ __forceinline__ float sigmoidf_(float x) { return 1.f / (1.f + __expf(-x)); }
__device__ __forceinline__ float siluf_(float x) { return x * __builtin_amdgcn_rcpf(1.f + __expf(-x)); }
#define LDS_BAR() do { asm volatile("s_waitcnt lgkmcnt(0)" ::: "memory"); __builtin_amdgcn_s_barrier(); asm volatile("" ::: "memory"); } while (0)
#define WAVE_SYNC() do { asm volatile("s_waitcnt lgkmcnt(0)" ::: "memory"); __builtin_amdgcn_wave_barrier(); } while (0)

__device__ __forceinline__ float row_rstd(const float* ssq, size_t row) {
    const f32x4* p = (const f32x4*)(ssq + row * 16); const f32x4 a = p[0], b = p[1], c = p[2], d = p[3];
    const float t = ((a.x + a.y) + (a.z + a.w)) + ((b.x + b.y) + (b.z + b.w)) + ((c.x + c.y) + (c.z + c.w)) + ((d.x + d.y) + (d.z + d.w));
    return 1.f / sqrtf(t * (1.f / D) + EPS);
}
namespace pg8 {
struct EpiSwiGLU {
    static constexpr bool PERM = true, AFTER_DRAIN = false;
    bf16_t* O; const float* ssq;
    __device__ __forceinline__ void operator()(const f32x4 (&acc)[2][2][4][2], const Unit& u, int wr, int wc, int fr, int fq) const {
        const int row0 = u.pm * BM + wr * 64 + fr, col0 = u.pn * HALF + wc * 32 + 8 * fq;
#pragma unroll
        for (int ai = 0; ai < 2; ++ai)
#pragma unroll
            for (int m = 0; m < 4; ++m) {
                bf16_t* rowp = O + (size_t)(row0 + ai * HALF + m * 16) * FF + col0;
                const float rs = ssq[u.ord * 256 + wr * 64 + fr + ai * HALF + m * 16];
                const f32x2 rs2 = {rs, rs}, nl2 = {-1.4426950408889634f, -1.4426950408889634f}, one2 = {1.f, 1.f};
                unsigned wv[4];
#pragma unroll
                for (int n = 0; n < 2; ++n)
#pragma unroll
                    for (int hf = 0; hf < 2; ++hf) {
                        const f32x2 g = (f32x2){acc[ai][0][m][n][2 * hf], acc[ai][0][m][n][2 * hf + 1]} * rs2;
                        const f32x2 uu = (f32x2){acc[ai][1][m][n][2 * hf], acc[ai][1][m][n][2 * hf + 1]} * rs2;
                        const f32x2 t = g * nl2;
                        f32x2 e; e.x = __builtin_amdgcn_exp2f(t.x); e.y = __builtin_amdgcn_exp2f(t.y);
                        const f32x2 d = e + one2;
                        f32x2 rc; rc.x = __builtin_amdgcn_rcpf(d.x); rc.y = __builtin_amdgcn_rcpf(d.y);
                        const f32x2 v = (g * rc) * uu;
                        wv[2 * n + hf] = cvt_pk_bf16(v.x, v.y);
                    }
                u32x4 w; w.x = wv[0]; w.y = wv[1]; w.z = wv[2]; w.w = wv[3];
                *(u32x4*)rowp = w;
            }
    }
};
template <int SC2> struct EpiResid {
    static constexpr bool PERM = true, AFTER_DRAIN = false;
    const float* base; float* out; bf16_t* HB; float* ssq;
    __device__ __forceinline__ void operator()(const f32x4 (&acc)[2][2][4][2], const Unit& u, int wr, int wc, int fr, int fq) const {
        constexpr float scale = 0.5f * SC2;
        const int row0 = u.pm * BM + wr * 64 + fr, col0 = u.pn * BM + wc * 32 + 8 * fq;
#pragma unroll
        for (int ai = 0; ai < 2; ++ai)
#pragma unroll
            for (int m = 0; m < 4; ++m) {
                const size_t off = (size_t)(row0 + ai * HALF + m * 16) * D + col0;
                float sq = 0.f;
#pragma unroll
                for (int bj = 0; bj < 2; ++bj) {
                    const f32x4 b0 = *(const f32x4*)(base + off + bj * HALF), b1 = *(const f32x4*)(base + off + bj * HALF + 4);
                    const f32x4 o0 = b0 + acc[ai][bj][m][0] * scale, o1 = b1 + acc[ai][bj][m][1] * scale;
                    *(f32x4*)(out + off + bj * HALF) = o0; *(f32x4*)(out + off + bj * HALF + 4) = o1;
                    { u32x4 w; w.x = cvt_pk_bf16(o0[0], o0[1]); w.y = cvt_pk_bf16(o0[2], o0[3]); w.z = cvt_pk_bf16(o1[0], o1[1]); w.w = cvt_pk_bf16(o1[2], o1[3]);
                        *(u32x4*)(HB + off + bj * HALF) = w;
                        sq += ((o0[0] * o0[0] + o0[1] * o0[1]) + (o0[2] * o0[2] + o0[3] * o0[3])) + ((o1[0] * o1[0] + o1[1] * o1[1]) + (o1[2] * o1[2] + o1[3] * o1[3])); }
                }
                { sq += xshfl(sq, 16); sq += xshfl(sq, 32); if (fq == 0) ssq[(size_t)(row0 + ai * HALF + m * 16) * 16 + u.pn * 4 + wc] = sq; }
                if (m == 3) asm volatile("" ::: "memory");
            }
    }
};
struct EpiProj {
    static constexpr bool PERM = true, AFTER_DRAIN = false;
    bf16_t* O; int ldc; int nmain; float* tail; int ldt; int nvalid; const float* ssq; bf16_t* halo; int halo_on;
    __device__ __forceinline__ void operator()(const f32x4 (&acc)[2][2][4][2], const Unit& u, int wr, int wc, int fr, int fq) const {
        const int row0 = u.pm * BM + wr * 64 + fr, colt = u.pn * BM, col0 = colt + wc * 32 + 8 * fq;
        if (colt + BM <= nmain) {
#pragma unroll
            for (int ai = 0; ai < 2; ++ai)
#pragma unroll
                for (int m = 0; m < 4; ++m) {
                    bf16_t* rowp = O + (size_t)(row0 + ai * HALF + m * 16) * ldc + col0;
                    const float rs = ssq[u.ord * 256 + wr * 64 + fr + ai * HALF + m * 16];
#pragma unroll
                    for (int bj = 0; bj < 2; ++bj) { const f32x4 v0 = acc[ai][bj][m][0] * rs, v1 = acc[ai][bj][m][1] * rs;
                        u32x4 w; w.x = cvt_pk_bf16(v0[0], v0[1]); w.y = cvt_pk_bf16(v0[2], v0[3]); w.z = cvt_pk_bf16(v1[0], v1[1]); w.w = cvt_pk_bf16(v1[2], v1[3]);
                        *(u32x4*)(rowp + bj * HALF) = w;
                        if (halo_on && m == 3 && fr >= 13 && u.pn < 12) {
                            const int row = row0 + ai * HALF + m * 16, n1 = ((row & (S - 1)) >> 6) + 1;
                            if (n1 < 64) *(u32x4*)(halo + (size_t)(((row >> 12) * 64 + n1) * 3 + (fr - 13)) * 3072 + col0 + bj * HALF) = w;
                        } }
                }
        } else {
#pragma unroll
            for (int ai = 0; ai < 2; ++ai)
#pragma unroll
                for (int m = 0; m < 4; ++m) {
                    const size_t row = (size_t)(row0 + ai * HALF + m * 16);
                    const float rs = ssq[u.ord * 256 + wr * 64 + fr + ai * HALF + m * 16];
#pragma unroll
                    for (int bj = 0; bj < 2; ++bj)
#pragma unroll
                        for (int n = 0; n < 2; ++n)
#pragma unroll
                            for (int j = 0; j < 4; ++j) { const int col = col0 + bj * HALF + 4 * n + j; if (col >= nmain && col < nvalid) tail[row * ldt + (col - nmain)] = acc[ai][bj][m][n][j] * rs; }
                }
        }
    }
};
struct EpiF32 {
    static constexpr bool PERM = false, AFTER_DRAIN = false;
    float* C; int ldc;
    __device__ __forceinline__ void operator()(const f32x4 (&acc)[2][2][4][2], const Unit& u, int wr, int wc, int fr, int fq) const {
        const int row0 = u.pm * BM + wr * 64 + fr, col0 = u.pn * BM + wc * 32 + 4 * fq;
#pragma unroll
        for (int ai = 0; ai < 2; ++ai)
#pragma unroll
            for (int m = 0; m < 4; ++m) {
                float* rowp = C + (size_t)(row0 + ai * HALF + m * 16) * ldc + col0;
#pragma unroll
                for (int bj = 0; bj < 2; ++bj)
#pragma unroll
                    for (int n = 0; n < 2; ++n) *(f32x4*)(rowp + bj * HALF + n * 16) = acc[ai][bj][m][n];
            }
    }
};
}

template <class Sched>
__device__ __forceinline__ void rstd_table(float* tab, const float* ssq, const Sched& SO, int tid) {
    pg8::Unit u;
    int nu = 0; while (SO.next(nu, u)) ++nu;
    for (int k0 = 0; k0 < nu * 256; k0 += 512 * 3) {
        float t3[3];
#pragma unroll
        for (int k = 0; k < 3; ++k) { const int idx = k0 + 512 * k + tid; t3[k] = 0.f; if (idx < nu * 256) { SO.next(idx >> 8, u); t3[k] = row_rstd(ssq, (size_t)u.pm * 256 + (idx & 255)); } }
#pragma unroll
        for (int k = 0; k < 3; ++k) { const int idx = k0 + 512 * k + tid; if (idx < nu * 256) tab[idx] = t3[k]; }
    }
    __syncthreads();
}
__device__ __forceinline__ void xpose_item(const float* W, const float* nw, int K, int N, bf16* WT, int rowbase, float* scr, int k0, int n0, int lane) {
    if (n0 + 32 <= N && (N & 3) == 0) {
        f32x4 v[8];
#pragma unroll
        for (int i = 0; i < 8; ++i) { v[i] = *(const f32x4*)(W + (size_t)(k0 + 8 * i + (lane >> 3)) * N + n0 + 4 * (lane & 7)); if (nw) v[i] *= nw[k0 + 8 * i + (lane >> 3)]; }
#pragma unroll
        for (int i = 0; i < 8; ++i) { float* d = scr + (8 * i + (lane >> 3)) * 33 + 4 * (lane & 7); d[0] = v[i].x; d[1] = v[i].y; d[2] = v[i].z; d[3] = v[i].w; }
    } else {
#pragma unroll 8
        for (int i = 0; i < 32; ++i) { const int kk = 2 * i + (lane >> 5), n = n0 + (lane & 31); scr[kk * 33 + (lane & 31)] = n < N ? W[(size_t)(k0 + kk) * N + n] * (nw ? nw[k0 + kk] : 1.f) : 0.f; }
    }
    WAVE_SYNC();
    const int c = lane & 7;
#pragma unroll
    for (int j = 0; j < 4; ++j) { const int n = (lane >> 3) + 8 * j; const float* s = scr + (8 * c) * 33 + n;
        u32x4 o; o.x = pk2(s[0 * 33], s[1 * 33]); o.y = pk2(s[2 * 33], s[3 * 33]); o.z = pk2(s[4 * 33], s[5 * 33]); o.w = pk2(s[6 * 33], s[7 * 33]);
        *(u32x4*)(WT + (size_t)(rowbase + n) * K + k0 + 8 * c) = o; }
    WAVE_SYNC();
}
__device__ __forceinline__ int xpose_rowbase(int mode, int n0) {
    return mode == 1 ? ((n0 < FF) ? ((n0 >> 7) * 256 + (n0 & 127)) : ((((n0 - FF) >> 7) * 256) + 128 + ((n0 - FF) & 127))) : n0;
}
__device__ __forceinline__ void xpose_matrix(const float* W, const float* nw, int K, int N, int Npad, bf16* WT, int mode, float* scr, int gw, int NGW, int lane) {
    const int nblk = Npad / 32, nitems = (K / 64) * nblk;
    float* scr2 = scr + 8 * 64 * 33;
    for (int it = gw; it < nitems; it += 2 * NGW) {
        const int itb = it + NGW;
        const int kbA = it / nblk, n0A = (it - kbA * nblk) * 32, kbB = itb / nblk, n0B = (itb - kbB * nblk) * 32;
        if (itb < nitems && n0A + 32 <= N && n0B + 32 <= N && (N & 3) == 0) {
            f32x4 va[8], vb[8];
#pragma unroll
            for (int i = 0; i < 8; ++i) { va[i] = *(const f32x4*)(W + (size_t)(kbA * 64 + 8 * i + (lane >> 3)) * N + n0A + 4 * (lane & 7)); vb[i] = *(const f32x4*)(W + (size_t)(kbB * 64 + 8 * i + (lane >> 3)) * N + n0B + 4 * (lane & 7)); }
            if (nw) {
#pragma unroll
                for (int i = 0; i < 8; ++i) { va[i] *= nw[kbA * 64 + 8 * i + (lane >> 3)]; vb[i] *= nw[kbB * 64 + 8 * i + (lane >> 3)]; }
            }
#pragma unroll
            for (int i = 0; i < 8; ++i) { float* d = scr + (8 * i + (lane >> 3)) * 33 + 4 * (lane & 7); d[0] = va[i].x; d[1] = va[i].y; d[2] = va[i].z; d[3] = va[i].w;
                float* e = scr2 + (8 * i + (lane >> 3)) * 33 + 4 * (lane & 7); e[0] = vb[i].x; e[1] = vb[i].y; e[2] = vb[i].z; e[3] = vb[i].w; }
            WAVE_SYNC();
            const int c = lane & 7, rbA = xpose_rowbase(mode, n0A), rbB = xpose_rowbase(mode, n0B);
#pragma unroll
            for (int j = 0; j < 4; ++j) { const int n = (lane >> 3) + 8 * j; const float* sa = scr + (8 * c) * 33 + n; const float* sb = scr2 + (8 * c) * 33 + n;
                u32x4 o; o.x = pk2(sa[0 * 33], sa[1 * 33]); o.y = pk2(sa[2 * 33], sa[3 * 33]); o.z = pk2(sa[4 * 33], sa[5 * 33]); o.w = pk2(sa[6 * 33], sa[7 * 33]);
                *(u32x4*)(WT + (size_t)(rbA + n) * K + kbA * 64 + 8 * c) = o;
                u32x4 q; q.x = pk2(sb[0 * 33], sb[1 * 33]); q.y = pk2(sb[2 * 33], sb[3 * 33]); q.z = pk2(sb[4 * 33], sb[5 * 33]); q.w = pk2(sb[6 * 33], sb[7 * 33]);
                *(u32x4*)(WT + (size_t)(rbB + n) * K + kbB * 64 + 8 * c) = q; }
            WAVE_SYNC();
        } else {
            xpose_item(W, nw, K, N, WT, xpose_rowbase(mode, n0A), scr, kbA * 64, n0A, lane);
            if (itb < nitems) xpose_item(W, nw, K, N, WT, xpose_rowbase(mode, n0B), scr, kbB * 64, n0B, lane);
        }
    }
}

__device__ __forceinline__ void phase_norm(const float* h, const float* w, bf16* out, int gw, int NGW, int lane) {
    f32x4 wv[4];
#pragma unroll
    for (int j = 0; j < 4; ++j) wv[j] = ((const f32x4*)w)[64 * j + lane];
    for (int m = gw; m < T; m += NGW) {
        const f32x4* xr = (const f32x4*)(h + (size_t)m * D) + lane;
        f32x4 v[4]; float s = 0.f;
#pragma unroll
        for (int j = 0; j < 4; ++j) { v[j] = xr[64 * j]; s += (v[j].x * v[j].x + v[j].y * v[j].y) + (v[j].z * v[j].z + v[j].w * v[j].w); }
        const float rstd = 1.f / sqrtf(wave_sum(s) * (1.f / D) + EPS);
        u32x2* o8 = (u32x2*)(out + (size_t)m * D) + lane;
#pragma unroll
        for (int j = 0; j < 4; ++j) { u32x2 o; o.x = pk2(v[j].x * rstd * wv[j].x, v[j].y * rstd * wv[j].y); o.y = pk2(v[j].z * rstd * wv[j].z, v[j].w * rstd * wv[j].w); o8[64 * j] = o; }
    }
}

__device__ __forceinline__ void phase_gdn_scan(unsigned char* lds, const bf16* proj, const float* ab, const float* convw, const float* A_log, const float* dt_bias,
                                               float* o32, int vblk, int nblk, int tid, int wid, int lane) {
    float* qs = (float*)lds;
    float* ks = qs + 64 * 128;
    float* vs = ks + 64 * 128;
    float* al = vs + 64 * 32;
    float* be = al + 64;
    float* qk = be + 64;
    float* os = qk + 64;
    bf16* raw = (bf16*)(os + 64 * 32);
    const int e = tid >> 4, dl = tid & 15;
    for (int item = vblk; item < 256; item += nblk) {
        const int bh = (item & 7) + 8 * (item >> 5), es = (item >> 3) & 3, b = bh >> 3, h = bh & 7;
        const float Ah = __expf(A_log[h]), dtb = dt_bias[h];
        const int isk = (tid >> 4) & 1, cg = tid & 15, cv = tid & 3;
        const int colqk = isk * 1024 + h * 128 + cg * 8, colv = 2048 + h * 128 + es * 32 + cv * 8;
        f32x4 wq[4][2], wv[4][2];
#pragma unroll
        for (int j = 0; j < 4; ++j) { wq[j][0] = *(const f32x4*)(convw + j * 3072 + colqk); wq[j][1] = *(const f32x4*)(convw + j * 3072 + colqk + 4);
                                      wv[j][0] = *(const f32x4*)(convw + j * 3072 + colv);  wv[j][1] = *(const f32x4*)(convw + j * 3072 + colv + 4); }
        f32x2 S2[4];
#pragma unroll
        for (int i = 0; i < 4; ++i) S2[i] = (f32x2){0.f, 0.f};
        u32x4 pre[5];
#define GDN_PREFETCH(T0) do { _Pragma("unroll") for (int k_ = 0; k_ < 5; ++k_) { const int idx_ = tid + 512 * k_; const int row_ = idx_ / 36, c_ = idx_ - row_ * 36; const int ts_ = (T0) - 3 + row_; \
            const int col_ = c_ < 16 ? h * 128 + c_ * 8 : (c_ < 32 ? 1024 + h * 128 + (c_ - 16) * 8 : 2048 + h * 128 + es * 32 + (c_ - 32) * 8); \
            pre[k_] = (u32x4){0u, 0u, 0u, 0u}; if (idx_ < 67 * 36 && ts_ >= 0) pre[k_] = *(const u32x4*)(proj + (size_t)(b * S + ts_) * 4096 + col_); } } while (0)
#define GDN_PARK() do { _Pragma("unroll") for (int k_ = 0; k_ < 5; ++k_) { const int idx_ = tid + 512 * k_; if (idx_ < 67 * 36) *(u32x4*)(raw + idx_ * 8) = pre[k_]; } } while (0)
#define GDN_CONV8(ROW0, C8, W, OUT) do { _Pragma("unroll") for (int i_ = 0; i_ < 8; ++i_) OUT[i_] = 0.f; _Pragma("unroll") for (int j_ = 0; j_ < 4; ++j_) { const u32x4 xv_ = *(const u32x4*)(raw + ((ROW0) + j_) * 288 + (C8) * 8); \
            OUT[0] += bf2f(xv_.x & 0xffffu) * W[j_][0].x; OUT[1] += bf2f(xv_.x >> 16) * W[j_][0].y; OUT[2] += bf2f(xv_.y & 0xffffu) * W[j_][0].z; OUT[3] += bf2f(xv_.y >> 16) * W[j_][0].w; \
            OUT[4] += bf2f(xv_.z & 0xffffu) * W[j_][1].x; OUT[5] += bf2f(xv_.z >> 16) * W[j_][1].y; OUT[6] += bf2f(xv_.w & 0xffffu) * W[j_][1].z; OUT[7] += bf2f(xv_.w >> 16) * W[j_][1].w; } \
            _Pragma("unroll") for (int i_ = 0; i_ < 8; ++i_) OUT[i_] = siluf_(OUT[i_]); } while (0)
#define GDN_CONVNORM(T0) do { \
            _Pragma("unroll") for (int it_ = 0; it_ < 4; ++it_) { const int tok_ = it_ * 16 + (tid >> 5); float y_[8]; GDN_CONV8(tok_, isk * 16 + cg, wq, y_); \
                float ss_ = (y_[0] * y_[0] + y_[1] * y_[1]) + (y_[2] * y_[2] + y_[3] * y_[3]) + (y_[4] * y_[4] + y_[5] * y_[5]) + (y_[6] * y_[6] + y_[7] * y_[7]); \
                ss_ = row_sum16(ss_); const float sc_ = (1.f / sqrtf(ss_ + EPS)) * (isk ? 1.f : 0.08838834764831845f); \
                float* d_ = (isk ? ks : qs) + tok_ * 128 + cg * 8; \
                _Pragma("unroll") for (int i_ = 0; i_ < 8; ++i_) y_[i_] *= sc_; \
                *(f32x4*)d_ = (f32x4){y_[0], y_[1], y_[2], y_[3]}; *(f32x4*)(d_ + 4) = (f32x4){y_[4], y_[5], y_[6], y_[7]}; \
                float dq_ = 0.f; _Pragma("unroll") for (int i_ = 0; i_ < 8; ++i_) dq_ += y_[i_] * xshfl(y_[i_], 16); \
                dq_ = row_sum16(dq_); if (isk == 0 && cg == 0) qk[tok_] = dq_; } \
            if (tid < 256) { const int tok_ = tid >> 2; float y_[8]; GDN_CONV8(tok_, 32 + cv, wv, y_); float* d_ = vs + tok_ * 32 + cv * 8; \
                *(f32x4*)d_ = (f32x4){y_[0], y_[1], y_[2], y_[3]}; *(f32x4*)(d_ + 4) = (f32x4){y_[4], y_[5], y_[6], y_[7]}; } \
            if (tid < 64) { const size_t tg_ = (size_t)(b * S + (T0) + tid); const float a_ = ab[tg_ * 16 + h] + dtb, bb_ = ab[tg_ * 16 + 8 + h]; \
                const float sp_ = a_ > 20.f ? a_ : __logf(1.f + __expf(a_)); al[tid] = __expf(-Ah * sp_); be[tid] = sigmoidf_(bb_); } } while (0)
        __syncthreads();
        GDN_PREFETCH(0); GDN_PARK();
        __syncthreads();
        GDN_CONVNORM(0);
        __syncthreads();
        for (int chunk = 0; chunk < S / 64; ++chunk) {
            const int t0 = chunk * 64;
            const bool more = chunk + 1 < S / 64;
            if (more) GDN_PREFETCH(t0 + 64);
            {
                const float* kp = ks + dl * 8; const float* qp = qs + dl * 8; const float* vp = vs + e;
                f32x4 nk0 = *(const f32x4*)kp, nk1 = *(const f32x4*)(kp + 4), nq0 = *(const f32x4*)qp, nq1 = *(const f32x4*)(qp + 4);
                float nv = vp[0], na = al[0], nb = be[0], nqk = qk[0];
                for (int t16 = 0; t16 < 4; ++t16) {
                    float ok = 0.f;
#pragma unroll 4
                    for (int i = 0; i < 16; ++i) {
                        const int tt = t16 * 16 + i, tn = (tt + 1) & 63;
                        const f32x2 K0 = {nk0.x, nk0.y}, K1 = {nk0.z, nk0.w}, K2 = {nk1.x, nk1.y}, K3 = {nk1.z, nk1.w};
                        const f32x2 Q0 = {nq0.x, nq0.y}, Q1 = {nq0.z, nq0.w}, Q2 = {nq1.x, nq1.y}, Q3 = {nq1.z, nq1.w};
                        const float v = nv, a = na, bt = nb, qkt = nqk;
                        nk0 = *(const f32x4*)(kp + tn * 128); nk1 = *(const f32x4*)(kp + tn * 128 + 4); nq0 = *(const f32x4*)(qp + tn * 128); nq1 = *(const f32x4*)(qp + tn * 128 + 4);
                        nv = vp[tn * 32]; na = al[tn]; nb = be[tn]; nqk = qk[tn];
                        f32x2 pa = K0 * S2[0], pb = K2 * S2[2], qa = Q0 * S2[0], qb = Q2 * S2[2];
                        pa = K1 * S2[1] + pa; pb = K3 * S2[3] + pb; qa = Q1 * S2[1] + qa; qb = Q3 * S2[3] + qb;
                        pa += pb; qa += qb;
                        float p = pa.x + pa.y, qS = qa.x + qa.y;
                        p = row_sum16(p); qS = row_sum16(qS);
                        const float vn = bt * (v - a * p);
                        const float o = a * qS + qkt * vn;
                        const f32x2 vn2 = {vn, vn}, a2 = {a, a};
                        S2[0] = S2[0] * a2 + K0 * vn2; S2[1] = S2[1] * a2 + K1 * vn2; S2[2] = S2[2] * a2 + K2 * vn2; S2[3] = S2[3] * a2 + K3 * vn2;
                        ok = (i == dl) ? o : ok;
                    }
                    os[(t16 * 16 + dl) * 32 + e] = ok;
                }
            }
            __syncthreads();
            { const int tok = tid >> 3, c4 = tid & 7;
              *(f32x4*)(o32 + (size_t)(b * S + t0 + tok) * D + h * 128 + es * 32 + c4 * 4) = *(const f32x4*)(os + tok * 32 + c4 * 4); }
            if (more) {
                GDN_PARK();
                __syncthreads();
                GDN_CONVNORM(t0 + 64);
            }
            __syncthreads();
        }
#undef GDN_PREFETCH
#undef GDN_PARK
#undef GDN_CONV8
#undef GDN_CONVNORM
    }
}

constexpr size_t WS_HALO = WS_END;
constexpr size_t WS_GL = WS_END + 10 * MiB;
constexpr size_t WS_SS = WS_GL + 1 * MiB;
constexpr size_t WS_END2 = WS_SS + 26 * MiB;

__device__ __forceinline__ void phase_gdn_halo(const bf16* proj, bf16* halo, int gtid, int NT) {
    for (int idx = gtid; idx < Bn * 64 * 3 * 384; idx += NT) {
        const int c = idx % 384, r3 = (idx / 384) % 3, bn = idx / (384 * 3), n = bn & 63, b = bn >> 6;
        u32x4 v = {0u, 0u, 0u, 0u};
        if (n > 0) v = *(const u32x4*)(proj + (size_t)(b * S + 64 * n - 3 + r3) * 4096 + c * 8);
        *(u32x4*)(halo + (size_t)(bn * 3 + r3) * 3072 + c * 8) = v;
    }
}

constexpr int GP_RAW = 0, GP_QB = 51456, GP_KB = GP_QB + 17408, GP_VB = GP_KB + 17408, GP_AM = GP_VB + 16384, GP_GC = GP_AM + 17408, GP_W = GP_GC + 1024;
__device__ __forceinline__ void phase_gdn_prep(unsigned char* lds, bf16* proj, const bf16* halo, const float* ab, const float* convw, const float* A_log, const float* dt_bias,
                                               bf16* KT, bf16* AT, float* GL, int vblk, int nblk, int tid, int wid, int lane) {
    bf16* raw = (bf16*)(lds + GP_RAW);
    bf16* wimg = (bf16*)(lds + GP_W);
    unsigned char* qb = lds + GP_QB;
    unsigned char* kb = lds + GP_KB;
    bf16* vb = (bf16*)(lds + GP_VB);
    float* Am = (float*)(lds + GP_AM);
    float* gcs = (float*)(lds + GP_GC);
    float* bes = gcs + 64;
    const int r = lane & 31, hh = lane >> 5;
    for (int item = vblk; item < Bn * 8 * 64; item += nblk) {
        const int n = item & 63, h = (item >> 6) & 7, b = item >> 9;
        const size_t tok0 = (size_t)b * S + 64 * n;
        LDS_BAR();
#define GP_RAWLOAD(ITEM, T0, NT) do { const int n_ = (ITEM) & 63, h_ = ((ITEM) >> 6) & 7, b_ = (ITEM) >> 9; const size_t tk0_ = (size_t)b_ * S + 64 * n_; \
        for (int idx = (T0); idx < 67 * 48; idx += (NT)) { const int row = idx / 48, c = idx - row * 48; \
            const int col = c < 16 ? h_ * 128 + c * 8 : (c < 32 ? 1024 + h_ * 128 + (c - 16) * 8 : 2048 + h_ * 128 + (c - 32) * 8); \
            u32x4 v = {0u, 0u, 0u, 0u}; if (row < 3) { if (n_ > 0) v = *(const u32x4*)(halo + (size_t)((b_ * 64 + n_) * 3 + row) * 3072 + col); } else v = *(const u32x4*)(proj + (tk0_ + row - 3) * 4096 + col); \
            *(u32x4*)(raw + row * 384 + c * 8) = v; } } while (0)
        if (item == vblk) GP_RAWLOAD(item, tid, 512);
        if (tid < 64) {
            const float a = ab[(tok0 + tid) * 16 + h] + dt_bias[h], bb = ab[(tok0 + tid) * 16 + 8 + h];
            const float sp = a > 20.f ? a : __logf(1.f + __expf(a));
            float g = -__expf(A_log[h]) * sp;
#pragma unroll
            for (int o = 1; o < 64; o <<= 1) { const float t_ = xshfl_up(g, o); if (lane >= o) g += t_; }
            const float be_ = sigmoidf_(bb);
            gcs[tid] = g; bes[tid] = be_; gcs[128 + tid] = be_; gcs[192 + tid] = be_ * __expf(g);
        }
        LDS_BAR();
        {
            const int isk = (tid >> 4) & 1, cg = tid & 15;
            const int colqk = isk * 1024 + h * 128 + cg * 8, colv = 2048 + h * 128 + cg * 8;
#define GP_WLOAD(COL, W) do { _Pragma("unroll") for (int j_ = 0; j_ < 4; ++j_) { W[j_][0] = *(const f32x4*)(convw + j_ * 3072 + (COL)); W[j_][1] = *(const f32x4*)(convw + j_ * 3072 + (COL) + 4); } } while (0)
#define GP_CONV8(ROW0, C8, W, OUT) do { _Pragma("unroll") for (int i_ = 0; i_ < 8; ++i_) OUT[i_] = 0.f; _Pragma("unroll") for (int j_ = 0; j_ < 4; ++j_) { const u32x4 xv_ = *(const u32x4*)(raw + ((ROW0) + j_) * 384 + (C8) * 8); \
            const f32x4 w0_ = W[j_][0], w1_ = W[j_][1]; \
            OUT[0] += bf2f(xv_.x & 0xffffu) * w0_.x; OUT[1] += bf2f(xv_.x >> 16) * w0_.y; OUT[2] += bf2f(xv_.y & 0xffffu) * w0_.z; OUT[3] += bf2f(xv_.y >> 16) * w0_.w; \
            OUT[4] += bf2f(xv_.z & 0xffffu) * w1_.x; OUT[5] += bf2f(xv_.z >> 16) * w1_.y; OUT[6] += bf2f(xv_.w & 0xffffu) * w1_.z; OUT[7] += bf2f(xv_.w >> 16) * w1_.w; } \
            _Pragma("unroll") for (int i_ = 0; i_ < 8; ++i_) OUT[i_] = siluf_(OUT[i_]); } while (0)
            f32x4 wc_[4][2];
            GP_WLOAD(colqk, wc_);
#pragma unroll 1
            for (int it = 0; it < 4; ++it) {
                const int tk = it * 16 + (tid >> 5);
                float y[8]; GP_CONV8(tk, isk * 16 + cg, wc_, y);
                float ss = (y[0] * y[0] + y[1] * y[1]) + (y[2] * y[2] + y[3] * y[3]) + (y[4] * y[4] + y[5] * y[5]) + (y[6] * y[6] + y[7] * y[7]);
                ss = row_sum16(ss);
                const float sc = (1.f / sqrtf(ss + EPS)) * (isk ? 1.f : 0.08838834764831845f);
                u32x4 w; w.x = pkbf(y[0] * sc, y[1] * sc); w.y = pkbf(y[2] * sc, y[3] * sc); w.z = pkbf(y[4] * sc, y[5] * sc); w.w = pkbf(y[6] * sc, y[7] * sc);
                *(u32x4*)((isk ? kb : qb) + tk * 272 + cg * 16) = w;
            }
            GP_WLOAD(colv, wc_);
#pragma unroll 1
            for (int it = 0; it < 2; ++it) {
                const int tk = it * 32 + (tid >> 4);
                float y[8]; GP_CONV8(tk, 32 + cg, wc_, y);
                u32x4 w; w.x = pkbf(y[0], y[1]); w.y = pkbf(y[2], y[3]); w.z = pkbf(y[4], y[5]); w.w = pkbf(y[6], y[7]);
                *(u32x4*)(vb + tk * 128 + cg * 8) = w;
            }
#undef GP_CONV8
#undef GP_WLOAD
        }
        LDS_BAR();
        {
            const int prod = wid >> 2, tr = (wid >> 1) & 1, tc = wid & 1;
            f32x16 acc;
#pragma unroll
            for (int i = 0; i < 16; ++i) acc[i] = 0.f;
            if (tr >= tc) {
                const unsigned char* Ab = (prod ? qb : kb) + (32 * tr + r) * 272 + hh * 16;
                const unsigned char* Bb = kb + (32 * tc + r) * 272 + hh * 16;
#pragma unroll
                for (int ks = 0; ks < 8; ++ks) acc = MFMA32(*(const bf16x8v*)(Ab + ks * 32), *(const bf16x8v*)(Bb + ks * 32), acc);
            }
            const int j = 32 * tc + r; const float gj = gcs[j];
#pragma unroll
            for (int i_ = 0; i_ < 16; ++i_) {
                const int i = 32 * tr + (i_ & 3) + 8 * (i_ >> 2) + 4 * hh;
                const float dec = __expf(gcs[i] - gj);
                if (prod == 0) Am[i * 68 + j] = (j < i) ? bes[i] * acc[i_] * dec : 0.f;
                else AT[(size_t)item * 4096 + i * 64 + j] = (bf16)f2bf((j <= i) ? acc[i_] * dec : 0.f);
            }
        }
        LDS_BAR();
        int tid3 = tid; asm volatile("" : "+v"(tid3));
        if (tid3 < 256) {
            const int isw = tid3 >> 7, d = tid3 & 127;
            unsigned oam = GP_AM, orsc = GP_GC + 512 + isw * 256, ocol = (isw ? GP_KB : GP_VB) + d * 2;
            asm volatile("" : "+v"(oam), "+v"(orsc), "+v"(ocol));
            const float* Am_ = (const float*)(lds + oam); const float* rsc = (const float*)(lds + orsc); const unsigned char* col = lds + ocol;
            const int cstride = isw ? 272 : 256;
            float X[64];
#pragma clang loop unroll(full)
            for (int i = 0; i < 64; ++i) X[i] = 0.f;
#pragma clang loop unroll(full)
            for (int i = 0; i < 64; ++i) {
                f32x4 av = {0.f, 0.f, 0.f, 0.f};
#pragma clang loop unroll(full)
                for (int j4 = 0; j4 < 16; ++j4) { if (4 * j4 < i) { const f32x4 a4 = *(const f32x4*)(Am_ + i * 68 + 4 * j4);
                    const f32x4 x4 = {X[4 * j4], X[4 * j4 + 1], X[4 * j4 + 2], X[4 * j4 + 3]}; av += a4 * x4; } }
                X[i] = rsc[i] * bf2f(*(const bf16*)(col + i * cstride)) - ((av.x + av.y) + (av.z + av.w));
                asm volatile("" ::: "memory");
            }
            if (isw) {
#pragma unroll
                for (int i = 0; i < 64; ++i) wimg[i * 128 + d] = (bf16)f2bf(X[i]);
            } else {
                bf16* up = proj + (tok0 + (d >> 1)) * 4096 + 2048 + h * 128 + (d & 1) * 64;
#pragma unroll
                for (int i8 = 0; i8 < 8; ++i8) { u32x4 w; w.x = pkbf(X[8 * i8], X[8 * i8 + 1]); w.y = pkbf(X[8 * i8 + 2], X[8 * i8 + 3]); w.z = pkbf(X[8 * i8 + 4], X[8 * i8 + 5]); w.w = pkbf(X[8 * i8 + 6], X[8 * i8 + 7]);
                    *(u32x4*)(up + 8 * i8) = w; }
            }
        } else {
            if (tid3 < 384) {
                const int d = tid3 - 256; const float gl_ = gcs[63];
                bf16* kp = KT + (size_t)item * 8192 + d * 64;
#pragma unroll
                for (int i8 = 0; i8 < 8; ++i8) { float y[8];
#pragma unroll
                    for (int i = 0; i < 8; ++i) y[i] = bf2f(*(const bf16*)(kb + (8 * i8 + i) * 272 + d * 2)) * __expf(gl_ - gcs[8 * i8 + i]);
                    u32x4 w; w.x = pkbf(y[0], y[1]); w.y = pkbf(y[2], y[3]); w.z = pkbf(y[4], y[5]); w.w = pkbf(y[6], y[7]);
                    *(u32x4*)(kp + 8 * i8) = w; }
                if (d == 0) GL[item] = __expf(gl_);
            }
#pragma unroll
            for (int k = 0; k < 4; ++k) {
                const int pc = (tid3 - 256) + 256 * k, i = pc >> 4, c8 = pc & 15;
                const u32x4 v = *(const u32x4*)(qb + i * 272 + c8 * 16); const float eg = __expf(gcs[i]);
                u32x4 w; w.x = pkbf(bf2f(v.x & 0xffffu) * eg, bf2f(v.x >> 16) * eg); w.y = pkbf(bf2f(v.y & 0xffffu) * eg, bf2f(v.y >> 16) * eg);
                w.z = pkbf(bf2f(v.z & 0xffffu) * eg, bf2f(v.z >> 16) * eg); w.w = pkbf(bf2f(v.w & 0xffffu) * eg, bf2f(v.w >> 16) * eg);
                *(u32x4*)(proj + (tok0 + i) * 4096 + h * 128 + c8 * 8) = w;
            }
            if (item + nblk < Bn * 8 * 64) GP_RAWLOAD(item + nblk, tid3 - 256, 256);
        }
        LDS_BAR();
#pragma unroll
        for (int k = 0; k < 2; ++k) { const int pc = tid + 512 * k, i = pc >> 4, c8 = pc & 15;
            *(u32x4*)(proj + (tok0 + i) * 4096 + 1024 + h * 128 + c8 * 8) = *(const u32x4*)(wimg + i * 128 + c8 * 8); }
    }
}

#undef GP_RAWLOAD
__device__ __forceinline__ void phase_gdn_scan2(unsigned char* lds, const bf16* proj, const bf16* KT, const bf16* AT, const float* GL, bf16* o16, int vblk, int nblk, int tid, int wid, int lane) {
    unsigned char* Sl = lds;
    unsigned char* Vl = lds + 8704;
    const int r = lane & 31, hh = lane >> 5;
    for (int item = vblk; item < 256; item += nblk) {
        const int bh = (item & 7) + 8 * (item >> 5), es = (item >> 3) & 3, b = bh >> 3, h = bh & 7;
        __syncthreads();
        for (int i = tid; i < 8704 / 4; i += 512) ((unsigned*)Sl)[i] = 0u;
        f32x16 Sacc;
#pragma unroll
        for (int i = 0; i < 16; ++i) Sacc[i] = 0.f;
        const int rt = wid & 1, dt = wid & 3;
        bf16x8v A8n[8]; bf16x8v A4n[4]; u32x2 uun[4]; float gln = 1.f;
#define GS_LOAD(N) do { const size_t tk_ = (size_t)b * S + 64 * (N); const int it_ = bh * 64 + (N); \
            if (wid < 2) { const bf16* wp_ = proj + (tk_ + 32 * rt + r) * 4096 + 1024 + h * 128 + 8 * hh; \
                _Pragma("unroll") for (int ks = 0; ks < 8; ++ks) A8n[ks] = *(const bf16x8v*)(wp_ + 16 * ks); \
                const int c_ = es * 32 + r; const bf16* up_ = proj + (tk_ + (c_ >> 1)) * 4096 + 2048 + h * 128 + (c_ & 1) * 64 + 32 * rt + 4 * hh; \
                _Pragma("unroll") for (int g = 0; g < 4; ++g) uun[g] = *(const u32x2*)(up_ + 8 * g); } \
            else if (wid < 4) { const bf16* qp_ = proj + (tk_ + 32 * rt + r) * 4096 + h * 128 + 8 * hh; \
                _Pragma("unroll") for (int ks = 0; ks < 8; ++ks) A8n[ks] = *(const bf16x8v*)(qp_ + 16 * ks); \
                const bf16* ap_ = AT + (size_t)it_ * 4096 + (32 * rt + r) * 64 + 8 * hh; \
                _Pragma("unroll") for (int sx = 0; sx < 4; ++sx) A4n[sx] = *(const bf16x8v*)(ap_ + 16 * sx); } \
            else { const bf16* kp_ = KT + (size_t)it_ * 8192 + (32 * dt + r) * 64 + 8 * hh; \
                _Pragma("unroll") for (int sx = 0; sx < 4; ++sx) A4n[sx] = *(const bf16x8v*)(kp_ + 16 * sx); \
                gln = GL[it_]; } } while (0)
        GS_LOAD(0);
        for (int n = 0; n < 64; ++n) {
            const size_t tok0 = (size_t)b * S + 64 * n;
            bf16x8v A8[8]; bf16x8v A4[4]; u32x2 uu[4]; const float gl = gln;
#pragma unroll
            for (int ks = 0; ks < 8; ++ks) A8[ks] = A8n[ks];
#pragma unroll
            for (int sx = 0; sx < 4; ++sx) { A4[sx] = A4n[sx]; uu[sx] = uun[sx]; }
            if (n + 1 < 64) GS_LOAD(n + 1);
            LDS_BAR();
            f32x16 acc;
#pragma unroll
            for (int i = 0; i < 16; ++i) acc[i] = 0.f;
            if (wid < 4) {
#pragma unroll
                for (int ks = 0; ks < 8; ++ks) acc = MFMA32(A8[ks], *(const bf16x8v*)(Sl + r * 272 + ks * 32 + hh * 16), acc);
                if (wid < 2) {
#pragma unroll
                    for (int g = 0; g < 4; ++g) {
                        u32x2 w; w.x = pkbf(bf2f(uu[g].x & 0xffffu) - acc[4 * g], bf2f(uu[g].x >> 16) - acc[4 * g + 1]);
                        w.y = pkbf(bf2f(uu[g].y & 0xffffu) - acc[4 * g + 2], bf2f(uu[g].y >> 16) - acc[4 * g + 3]);
                        *(u32x2*)(Vl + r * 144 + (32 * rt + 8 * g + 4 * hh) * 2) = w;
                    }
                }
            }
            LDS_BAR();
            if (wid >= 2 && wid < 4) {
#pragma unroll
                for (int sx = 0; sx < 4; ++sx) acc = MFMA32(A4[sx], *(const bf16x8v*)(Vl + r * 144 + sx * 32 + hh * 16), acc);
                unsigned char* Ol = lds + 13312 + (wid - 2) * 2560;
#pragma unroll
                for (int i = 0; i < 16; ++i) *(bf16*)(Ol + ((i & 3) + 8 * (i >> 2) + 4 * hh) * 80 + r * 2) = (bf16)f2bf(acc[i]);
                WAVE_SYNC();
#pragma unroll
                for (int k = 0; k < 2; ++k) { const int pc = lane + 64 * k, trow = pc >> 2, c4 = pc & 3;
                    *(u32x4*)(o16 + (tok0 + 32 * rt + trow) * D + h * 128 + es * 32 + c4 * 8) = *(const u32x4*)(Ol + trow * 80 + c4 * 16); }
                WAVE_SYNC();
            } else if (wid >= 4) {
#pragma unroll
                for (int i = 0; i < 16; ++i) Sacc[i] *= gl;
#pragma unroll
                for (int sx = 0; sx < 4; ++sx) Sacc = MFMA32(A4[sx], *(const bf16x8v*)(Vl + r * 144 + sx * 32 + hh * 16), Sacc);
#pragma unroll
                for (int g = 0; g < 4; ++g) { u32x2 w; w.x = pkbf(Sacc[4 * g], Sacc[4 * g + 1]); w.y = pkbf(Sacc[4 * g + 2], Sacc[4 * g + 3]);
                    *(u32x2*)(Sl + r * 272 + (32 * dt + 8 * g + 4 * hh) * 2) = w; }
            }
        }
    }
}

#undef GS_LOAD
__device__ __forceinline__ void phase_gdn_post(const bf16* o16, const bf16* proj, const float* onorm, bf16* hn, int gw, int NGW, int lane) {
    const int l16 = lane & 15;
    float wv[8];
#pragma unroll
    for (int j = 0; j < 8; ++j) wv[j] = onorm[8 * l16 + j];
    for (int m = 2 * gw; m < T; m += 2 * NGW) {
        u32x4 xo[2][2], gg[2][2];
#pragma unroll
        for (int tk = 0; tk < 2; ++tk)
#pragma unroll
            for (int pt = 0; pt < 2; ++pt) { xo[tk][pt] = *(const u32x4*)(o16 + (size_t)(m + tk) * D + pt * 512 + lane * 8); gg[tk][pt] = *(const u32x4*)(proj + (size_t)(m + tk) * 4096 + 3072 + pt * 512 + lane * 8); }
#pragma unroll
        for (int tk = 0; tk < 2; ++tk)
#pragma unroll
            for (int pt = 0; pt < 2; ++pt) {
                const u32x4 xv = xo[tk][pt], gv = gg[tk][pt];
                float v[8] = {bf2f(xv.x & 0xffffu), bf2f(xv.x >> 16), bf2f(xv.y & 0xffffu), bf2f(xv.y >> 16), bf2f(xv.z & 0xffffu), bf2f(xv.z >> 16), bf2f(xv.w & 0xffffu), bf2f(xv.w >> 16)};
                const float g[8] = {bf2f(gv.x & 0xffffu), bf2f(gv.x >> 16), bf2f(gv.y & 0xffffu), bf2f(gv.y >> 16), bf2f(gv.z & 0xffffu), bf2f(gv.z >> 16), bf2f(gv.w & 0xffffu), bf2f(gv.w >> 16)};
                float sq = ((v[0] * v[0] + v[1] * v[1]) + (v[2] * v[2] + v[3] * v[3])) + ((v[4] * v[4] + v[5] * v[5]) + (v[6] * v[6] + v[7] * v[7]));
                sq = row_sum16(sq);
                const float rstd = 1.f / sqrtf(sq * (1.f / 128.f) + EPS);
#pragma unroll
                for (int j = 0; j < 8; ++j) v[j] = v[j] * rstd * wv[j] * siluf_(g[j]);
                u32x4 w; w.x = pkbf(v[0], v[1]); w.y = pkbf(v[2], v[3]); w.z = pkbf(v[4], v[5]); w.w = pkbf(v[6], v[7]);
                *(u32x4*)(hn + (size_t)(m + tk) * D + pt * 512 + lane * 8) = w;
            }
    }
}
__device__ __forceinline__ void phase_sc_post(const bf16* proj, const float* cw, bf16* hn, int gtid, int NT) {
    const int c8 = (gtid & 127) * 8;
    f32x4 w0[3], w1[3];
#pragma unroll
    for (int j = 0; j < 3; ++j) { w0[j] = *(const f32x4*)(cw + j * 1024 + c8); w1[j] = *(const f32x4*)(cw + j * 1024 + c8 + 4); }
    for (int idx = gtid; idx < T * 128; idx += 2 * NT) {
        u32x4 cv[2][3], xv[2][3], bv[2];
#pragma unroll
        for (int q = 0; q < 2; ++q) {
            const int id = idx + q * NT, m = id >> 7, s = m & (S - 1);
#pragma unroll
            for (int j = 0; j < 3; ++j) { cv[q][j] = (u32x4){0u, 0u, 0u, 0u}; xv[q][j] = (u32x4){0u, 0u, 0u, 0u};
                if (id < T * 128 && s - 2 + j >= 0) { const bf16* pr = proj + (size_t)(m - 2 + j) * 3072; cv[q][j] = *(const u32x4*)(pr + 1024 + c8); xv[q][j] = *(const u32x4*)(pr + 2048 + c8); } }
            bv[q] = (u32x4){0u, 0u, 0u, 0u};
            if (id < T * 128) bv[q] = *(const u32x4*)(proj + (size_t)m * 3072 + c8);
        }
#pragma unroll
        for (int q = 0; q < 2; ++q) {
            const int id = idx + q * NT, m = id >> 7;
            if (id >= T * 128) break;
            float y[8];
#pragma unroll
            for (int i = 0; i < 8; ++i) y[i] = 0.f;
#pragma unroll
            for (int j = 0; j < 3; ++j) {
                const u32x4 c = cv[q][j], x = xv[q][j];
                y[0] += w0[j].x * bf2f(c.x & 0xffffu) * bf2f(x.x & 0xffffu); y[1] += w0[j].y * bf2f(c.x >> 16) * bf2f(x.x >> 16);
                y[2] += w0[j].z * bf2f(c.y & 0xffffu) * bf2f(x.y & 0xffffu); y[3] += w0[j].w * bf2f(c.y >> 16) * bf2f(x.y >> 16);
                y[4] += w1[j].x * bf2f(c.z & 0xffffu) * bf2f(x.z & 0xffffu); y[5] += w1[j].y * bf2f(c.z >> 16) * bf2f(x.z >> 16);
                y[6] += w1[j].z * bf2f(c.w & 0xffffu) * bf2f(x.w & 0xffffu); y[7] += w1[j].w * bf2f(c.w >> 16) * bf2f(x.w >> 16);
            }
            const u32x4 b = bv[q];
            u32x4 o;
            o.x = pkbf(y[0] * bf2f(b.x & 0xffffu), y[1] * bf2f(b.x >> 16)); o.y = pkbf(y[2] * bf2f(b.y & 0xffffu), y[3] * bf2f(b.y >> 16));
            o.z = pkbf(y[4] * bf2f(b.z & 0xffffu), y[5] * bf2f(b.z >> 16)); o.w = pkbf(y[6] * bf2f(b.w & 0xffffu), y[7] * bf2f(b.w >> 16));
            *(u32x4*)(hn + (size_t)m * D + c8) = o;
        }
    }
}
__device__ __forceinline__ void phase_nsa_post(unsigned char* lds, const bf16* proj, const float* qnorm, const float* knorm, const f32x2* tab,
                                               bf16* QN, bf16* KS, bf16* KW, bf16* KCH, bf16* VCH, bf16* VST, bf16* VWT, int gw, int NGW, int wid, int lane) {
    {
        bf16* tile = (bf16*)lds + wid * (64 * 72);
        const int c8 = lane & 7, r8 = lane >> 3;
        for (int item = gw; item < 2 * 32 * 64; item += NGW) {
            const int st = item & 63, bh = (item >> 6) & 31, which = item >> 11, b = bh >> 2, hk = bh & 3;
            const bf16* src = proj + ((size_t)b * S + st * 64 + r8) * 2560 + (which ? 2304 : 1792) + hk * 64 + c8 * 8;
            u32x4 v[8];
#pragma unroll
            for (int i = 0; i < 8; ++i) v[i] = *(const u32x4*)(src + (size_t)(8 * i) * 2560);
#pragma unroll
            for (int i = 0; i < 8; ++i) *(u32x4*)(tile + (8 * i + r8) * 72 + c8 * 8) = v[i];
            WAVE_SYNC();
            bf16* dst = (which ? VWT : VST) + (size_t)bh * 64 * S + st * 64 + c8 * 8;
#pragma unroll
            for (int i = 0; i < 8; ++i) {
                const bf16* tp = tile + (8 * c8) * 72 + 8 * i + r8;
                u32x4 w; w.x = (unsigned)tp[0] | ((unsigned)tp[72] << 16); w.y = (unsigned)tp[144] | ((unsigned)tp[216] << 16);
                w.z = (unsigned)tp[288] | ((unsigned)tp[360] << 16); w.w = (unsigned)tp[432] | ((unsigned)tp[504] << 16);
                *(u32x4*)(dst + (size_t)(8 * i + r8) * S) = w;
            }
            WAVE_SYNC();
        }
    }
    const int l8 = lane & 7, hsel = lane >> 3, lo32 = lane < 32;
    float qw8[8], kw8[8];
#pragma unroll
    for (int j = 0; j < 8; ++j) { qw8[j] = qnorm[8 * l8 + j]; kw8[j] = knorm[(lo32 ? 64 : 128) + 8 * l8 + j]; }
#define NP_UNPACK(V, X) do { X[0] = bf2f(V.x & 0xffffu); X[1] = bf2f(V.x >> 16); X[2] = bf2f(V.y & 0xffffu); X[3] = bf2f(V.y >> 16); X[4] = bf2f(V.z & 0xffffu); X[5] = bf2f(V.z >> 16); X[6] = bf2f(V.w & 0xffffu); X[7] = bf2f(V.w >> 16); } while (0)
#define NP_RSTD8(X, R) do { float ss_ = (X[0] * X[0] + X[1] * X[1]) + (X[2] * X[2] + X[3] * X[3]) + (X[4] * X[4] + X[5] * X[5]) + (X[6] * X[6] + X[7] * X[7]); \
        ss_ += xshfl(ss_, 1); ss_ += xshfl(ss_, 2); ss_ += xshfl(ss_, 4); R = 1.f / sqrtf(ss_ * (1.f / 64.f) + EPS); } while (0)
    for (int m0 = gw; m0 < T; m0 += 2 * NGW) {
        u32x4 vq0_[2], vq1_[2], vk_[2], vc_[2]; f32x4 cc_[2][4];
#pragma unroll
        for (int q = 0; q < 2; ++q) {
            const int m = m0 + q * NGW < T ? m0 + q * NGW : m0;
            const bf16* pr = proj + (size_t)m * 2560;
            vq0_[q] = *(const u32x4*)(pr + lane * 8); vq1_[q] = *(const u32x4*)(pr + 512 + lane * 8);
            vk_[q] = *(const u32x4*)(pr + (lo32 ? 1536 + lane * 8 : 2048 + (lane - 32) * 8));
            vc_[q] = *(const u32x4*)(pr + (lo32 ? 1024 + lane * 8 : 1280 + (lane - 32) * 8));
            const f32x4* cp = (const f32x4*)(tab + (size_t)m * 32 + 8 * (l8 & 3));
            cc_[q][0] = cp[0]; cc_[q][1] = cp[1]; cc_[q][2] = cp[2]; cc_[q][3] = cp[3];
        }
#pragma unroll
        for (int q = 0; q < 2; ++q) {
        const int m = m0 + q * NGW;
        if (m >= T) break;
        const int b = m >> 12, s = m & (S - 1);
        const u32x4 vq0 = vq0_[q], vq1 = vq1_[q], vk = vk_[q], vc = vc_[q];
        const f32x4 c0 = cc_[q][0], c1 = cc_[q][1], c2 = cc_[q][2], c3 = cc_[q][3];
        {
            float x[8], r; NP_UNPACK(vq0, x); NP_RSTD8(x, r);
            u32x4 w; w.x = pkbf(x[0] * r * qw8[0], x[1] * r * qw8[1]); w.y = pkbf(x[2] * r * qw8[2], x[3] * r * qw8[3]); w.z = pkbf(x[4] * r * qw8[4], x[5] * r * qw8[5]); w.w = pkbf(x[6] * r * qw8[6], x[7] * r * qw8[7]);
            *(u32x4*)(QN + ((size_t)(b * 16 + hsel) * S + s) * 64 + 8 * l8) = w;
        }
        {
            float x[8], r; NP_UNPACK(vq1, x); NP_RSTD8(x, r);
            u32x4 w; w.x = pkbf(x[0] * r * qw8[0], x[1] * r * qw8[1]); w.y = pkbf(x[2] * r * qw8[2], x[3] * r * qw8[3]); w.z = pkbf(x[4] * r * qw8[4], x[5] * r * qw8[5]); w.w = pkbf(x[6] * r * qw8[6], x[7] * r * qw8[7]);
            *(u32x4*)(QN + ((size_t)(b * 16 + 8 + hsel) * S + s) * 64 + 8 * l8) = w;
        }
        const size_t okv = ((size_t)(b * 4 + (hsel & 3)) * S + s) * 64 + 8 * l8;
        {
            float x[8], r, y[8]; NP_UNPACK(vk, x); NP_RSTD8(x, r);
            const float cs[16] = {c0.x, c0.y, c0.z, c0.w, c1.x, c1.y, c1.z, c1.w, c2.x, c2.y, c2.z, c2.w, c3.x, c3.y, c3.z, c3.w};
#pragma unroll
            for (int j = 0; j < 8; ++j) { const float yv = x[j] * r * kw8[j]; const float yp = xshfl(yv, 4); y[j] = yv * cs[2 * j] + (l8 < 4 ? -yp : yp) * cs[2 * j + 1]; }
            u32x4 w; w.x = pkbf(y[0], y[1]); w.y = pkbf(y[2], y[3]); w.z = pkbf(y[4], y[5]); w.w = pkbf(y[6], y[7]);
            *(u32x4*)((lo32 ? KS : KW) + okv) = w;
        }
        *(u32x4*)((lo32 ? KCH : VCH) + okv) = vc;
    }
    }
#undef NP_UNPACK
#undef NP_RSTD8
}
__device__ __forceinline__ void phase_cmp2(unsigned char* lds, const float* Pk, const float* Pv, const float* biasp, const float* w2, const float* b2, const float* knorm0,
                                           bf16* KC, bf16* VC, int gw, int NGW, int wid, int lane, int tid) {
    float* hs = (float*)lds + wid * 256;
    float* w2l = (float*)(lds + 8192);
    for (int kind = 0; kind < 2; ++kind) {
        __syncthreads();
        for (int idx = tid; idx < 256 * 64 / 4; idx += 512) ((f32x4*)w2l)[idx] = ((const f32x4*)(w2 + (size_t)kind * 256 * 64))[idx];
        __syncthreads();
        const float* P = kind ? Pv : Pk;
        for (int it = gw; it < 32 * 256; it += NGW) {
            const int i = it & 255, bh = it >> 8;
            bf16* outp = kind ? VC + ((size_t)bh * 64 + lane) * 256 + i : KC + ((size_t)bh * 256 + i) * 64 + lane;
            if (i == 255) { *outp = 0; continue; }
            const float* r0 = P + ((size_t)bh * 256 + i) * 512; const float* r1 = r0 + 512 + 256;
#pragma unroll
            for (int j = 0; j < 4; ++j) { const int n = lane + 64 * j; const float x = r0[n] + r1[n] + biasp[kind * 256 + n];
                const float uu = 0.7978845608028654f * (x + 0.044715f * x * x * x);
                const float th = 1.f - 2.f / (1.f + __expf(2.f * uu));
                hs[n] = 0.5f * x * (1.f + th); }
            WAVE_SYNC();
            float a0 = b2[kind * 64 + lane], a1 = 0.f, a2 = 0.f, a3 = 0.f;
#pragma unroll 4
            for (int n = 0; n < 256; n += 4) { const f32x4 hv = *(const f32x4*)(hs + n);
                a0 += hv.x * w2l[n * 64 + lane]; a1 += hv.y * w2l[(n + 1) * 64 + lane]; a2 += hv.z * w2l[(n + 2) * 64 + lane]; a3 += hv.w * w2l[(n + 3) * 64 + lane]; }
            float acc = (a0 + a1) + (a2 + a3);
            if (kind == 0) { const float ss = wave_sum(acc * acc); acc = acc * (1.f / sqrtf(ss * (1.f / 64.f) + EPS)) * knorm0[lane]; }
            *outp = (bf16)f2bf(acc);
            WAVE_SYNC();
        }
    }
}
constexpr int KV_STRIDE = 144;
constexpr int KV_BUF = 2 * 64 * KV_STRIDE;
constexpr int ATT_IMP_OFF = 2 * KV_BUF;
constexpr int ATT_MSK_OFF = ATT_IMP_OFF + 8 * 2048;

template <bool IMP>
__device__ __forceinline__ void attn_tile(const bool FAST, const unsigned char* buf, int tt, int key0, int lo, int hi, const bf16x8v (&qf)[4],
                                          f32x16 (&O)[2], f32x16 (&IM)[2], float& m, float& l, const bf16* ovt, int r, int h, int pr) {
    f32x16 sacc;
#pragma unroll
    for (int i = 0; i < 16; ++i) sacc[i] = 0.f;
    bf16x8v ov[2][2];
    if (IMP) {
#pragma unroll
        for (int st = 0; st < 2; ++st)
#pragma unroll
            for (int sx = 0; sx < 2; ++sx) ov[st][sx] = *(const bf16x8v*)(ovt + (32 * st + r) * 256 + key0 + 16 * sx + 8 * h);
    }
    const unsigned char* kb = buf + (32 * tt + pr) * KV_STRIDE + h * 16;
#pragma unroll
    for (int ks = 0; ks < 4; ++ks) { const bf16x8v a = *(const bf16x8v*)(kb + ks * 32); sacc = MFMA32(a, qf[ks], sacc); }
    const int kb0 = key0 + 8 * h;
    float mx = -1e30f, psum = 0.f, corr;
    if (FAST) {
        const bool on = hi >= 0;
#pragma unroll
        for (int i = 0; i < 16; ++i) mx = fmaxf(mx, sacc[i]);
        mx = on ? mx * 0.18033688011112042f : -1e30f;
        mx = fmaxf(mx, xshfl(mx, 32));
        const float mnew = fmaxf(m, mx);
        corr = __builtin_amdgcn_exp2f(m - mnew);
        m = mnew;
#pragma unroll
        for (int i = 0; i < 16; ++i) { const float p = __builtin_amdgcn_exp2f(sacc[i] * 0.18033688011112042f - mnew); psum += p; sacc[i] = p; }
        if (!on) {
            psum = 0.f;
#pragma unroll
            for (int i = 0; i < 16; ++i) sacc[i] = 0.f;
        }
    } else {
#pragma unroll
        for (int i = 0; i < 16; ++i) { const int key = kb0 + 16 * (i >> 3) + (i & 7); const bool ok = (key >= lo) && (key <= hi);
            const float sv = ok ? sacc[i] * 0.18033688011112042f : -1e30f; sacc[i] = sv; mx = fmaxf(mx, sv); }
        mx = fmaxf(mx, xshfl(mx, 32));
        const float mnew = fmaxf(m, mx);
        corr = __builtin_amdgcn_exp2f(m - mnew);
        m = mnew;
#pragma unroll
        for (int i = 0; i < 16; ++i) { const float p = sacc[i] > -1e29f ? __builtin_amdgcn_exp2f(sacc[i] - mnew) : 0.f; psum += p; sacc[i] = p; }
    }
    l = l * corr + psum;
    if (__any(corr != 1.f)) {
#pragma unroll
        for (int i = 0; i < 16; ++i) { O[0][i] *= corr; O[1][i] *= corr; }
        if (IMP) {
#pragma unroll
            for (int i = 0; i < 16; ++i) { IM[0][i] *= corr; IM[1][i] *= corr; }
        }
    }
    bf16x8v pf[2];
#pragma unroll
    for (int sx = 0; sx < 2; ++sx) { u32x4 w; w.x = pkbf(sacc[8 * sx], sacc[8 * sx + 1]); w.y = pkbf(sacc[8 * sx + 2], sacc[8 * sx + 3]); w.z = pkbf(sacc[8 * sx + 4], sacc[8 * sx + 5]); w.w = pkbf(sacc[8 * sx + 6], sacc[8 * sx + 7]);
        pf[sx] = __builtin_bit_cast(bf16x8v, w); }
    const unsigned char* vb = buf + 64 * KV_STRIDE + r * KV_STRIDE + (32 * tt + 8 * h) * 2;
#pragma unroll
    for (int dt = 0; dt < 2; ++dt)
#pragma unroll
        for (int sx = 0; sx < 2; ++sx) { const bf16x8v a = *(const bf16x8v*)(vb + dt * 32 * KV_STRIDE + sx * 32); O[dt] = MFMA32(a, pf[sx], O[dt]); }
    if (IMP) {
#pragma unroll
        for (int st = 0; st < 2; ++st)
#pragma unroll
            for (int sx = 0; sx < 2; ++sx) IM[st] = MFMA32(ov[st][sx], pf[sx], IM[st]);
    }
}

template <int MODE>
__device__ __forceinline__ void attn_branch(unsigned char* kvbuf, const bf16* Kg0, const bf16* VTg0, int vts, unsigned long long blkmask, int t, int nv, unsigned long long selm,
                                            int wlo, int whi, int flo, int fhi, const bf16x8v (&qf)[4], f32x16 (&O)[2], f32x16 (&IM)[2], float& l, const bf16* ovt, int tid, int r, int h, int pr) {
    float m = -1e30f;
    l = 0.f;
#pragma unroll
    for (int i = 0; i < 16; ++i) { O[0][i] = 0.f; O[1][i] = 0.f; IM[0][i] = 0.f; IM[1][i] = 0.f; }
    const int srow = tid >> 3, sch = tid & 7;
    int j = __builtin_ctzll(blkmask);
    unsigned long long rest = blkmask & (blkmask - 1);
    u32x4 kr = *(const u32x4*)(Kg0 + (size_t)(64 * j + srow) * 64 + sch * 8);
    u32x4 vr = *(const u32x4*)(VTg0 + (size_t)srow * vts + 64 * j + sch * 8);
    *(u32x4*)(kvbuf + srow * KV_STRIDE + sch * 16) = kr;
    *(u32x4*)(kvbuf + 64 * KV_STRIDE + srow * KV_STRIDE + sch * 16) = vr;
    int cur = 0;
    for (;;) {
        LDS_BAR();
        const bool more = rest != 0ull;
        int jn = 0;
        if (more) { jn = __builtin_ctzll(rest); rest &= rest - 1;
            kr = *(const u32x4*)(Kg0 + (size_t)(64 * jn + srow) * 64 + sch * 8);
            vr = *(const u32x4*)(VTg0 + (size_t)srow * vts + 64 * jn + sch * 8); }
        const unsigned char* buf = kvbuf + cur * KV_BUF;
        int lo, hi;
        if (MODE == 0) { lo = 0; hi = nv - 1; }
        else if (MODE == 1) { lo = 0; hi = ((selm >> j) & 1ull) ? t : -1; }
        else { lo = t - 511; hi = t; }
        const bool wave_on = (MODE != 1) || __any(hi >= 0);
#pragma unroll
        for (int tt = 0; tt < 2; ++tt) {
            const int key0 = 64 * j + 32 * tt;
            if (!wave_on || key0 > whi || key0 + 31 < wlo) continue;
            attn_tile<MODE == 0>(key0 >= flo && key0 + 31 <= fhi, buf, tt, key0, lo, hi, qf, O, IM, m, l, ovt, r, h, pr);
        }
        if (!more) break;
        *(u32x4*)(kvbuf + (cur ^ 1) * KV_BUF + srow * KV_STRIDE + sch * 16) = kr;
        *(u32x4*)(kvbuf + (cur ^ 1) * KV_BUF + 64 * KV_STRIDE + srow * KV_STRIDE + sch * 16) = vr;
        cur ^= 1; j = jn;
    }
    LDS_BAR();
}

__device__ __forceinline__ void phase_nsa_attn(unsigned char* lds, const bf16* QN, const bf16* KS, const bf16* KW, const bf16* VST, const bf16* VWT, const bf16* KCb, const bf16* VCT,
                                               const bf16* ovt, const float* gates, const f32x2* tab, bf16* hn, int vblk, int nblk, int tid, int wid, int lane) {
    const int r = lane & 31, h = lane >> 5, pr = (r & ~12) | ((r & 4) << 1) | ((r & 8) >> 1);
    float* imp_s = (float*)(lds + ATT_IMP_OFF + wid * 2048);
    unsigned long long* msk_s = (unsigned long long*)(lds + ATT_MSK_OFF);
    unsigned* uni_s = (unsigned*)(lds + ATT_MSK_OFF + 512);
    for (int item = vblk; item < Bn * 4 * 64; item += nblk) {
        const int rnd = item / nblk, wv = item - rnd * nblk;
        const int bh = wv & 31, sub = wv >> 5, per = nblk >> 5;
        int qb = rnd * per + ((rnd & 1) ? (per - 1 - sub) : sub);
        if (nblk != 256) { qb = item >> 5; }
        const int bhh = (nblk != 256) ? (item & 31) : bh;
        const int b = bhh >> 2, hk = bhh & 3;
        const int t0 = qb * 64, tw0 = t0 + 8 * wid, t = tw0 + (r & 7), g = r >> 3;
        const size_t tok = (size_t)b * S + t;
        if (tid == 0) { unsigned z = 0u; asm volatile("" : "+v"(z)); uni_s[0] = z; uni_s[1] = z; }
        bf16x8v qn[4], qr[4];
        {
            const bf16* qp = QN + ((size_t)(b * 16 + hk * 4 + g) * S + t) * 64 + 8 * h;
#pragma unroll
            for (int ks = 0; ks < 4; ++ks) qn[ks] = *(const bf16x8v*)(qp + 16 * ks);
            const f32x2* cp = tab + tok * 32 + 8 * h;
#pragma unroll
            for (int kl = 0; kl < 2; ++kl) {
                u32x4 wlo_, whi_;
                const u32x4 a = __builtin_bit_cast(u32x4, qn[kl]), c = __builtin_bit_cast(u32x4, qn[kl + 2]);
#pragma unroll
                for (int jj = 0; jj < 4; ++jj) {
                    const f32x2 cs0 = cp[16 * kl + 2 * jj], cs1 = cp[16 * kl + 2 * jj + 1];
                    const float x0 = bf2f(a[jj] & 0xffffu), x1 = bf2f(a[jj] >> 16), y0 = bf2f(c[jj] & 0xffffu), y1 = bf2f(c[jj] >> 16);
                    wlo_[jj] = pkbf(x0 * cs0.x - y0 * cs0.y, x1 * cs1.x - y1 * cs1.y);
                    whi_[jj] = pkbf(y0 * cs0.x + x0 * cs0.y, y1 * cs1.x + x1 * cs1.y);
                }
                qr[kl] = __builtin_bit_cast(bf16x8v, wlo_); qr[kl + 2] = __builtin_bit_cast(bf16x8v, whi_);
            }
        }
        const float* gp = gates + tok * 48 + (hk * 4 + g) * 3;
        const float g0 = sigmoidf_(gp[0]), g1 = sigmoidf_(gp[1]), g2 = sigmoidf_(gp[2]);
        f32x16 acc[2], O[2], IM[2];
        float l;
        const int nv = t >= 31 ? ((t - 31) >> 4) + 1 : 0;
        const int nvw = ((tw0 + 7 - 31) >> 4) + 1;
        const int nvmax = 4 * qb + 3;
        {
            const int ncb = (nvmax + 63) >> 6;
            const unsigned long long bm = ncb >= 64 ? ~0ull : ((1ull << ncb) - 1ull);
            attn_branch<0>(lds, KCb + (size_t)bhh * 256 * 64, VCT + (size_t)bhh * 64 * 256, 256, bm, t, nv, 0ull, 0, (tw0 + 7 >= 31 ? nvw - 1 : -1), 0, (tw0 >= 31 ? ((tw0 - 31) >> 4) : -1), qn, O, IM, l, ovt, tid, r, h, pr);
        }
        {
            const float lt = l + xshfl(l, 32), inv = lt > 0.f ? 1.f / lt : 0.f, sc = inv * g0;
#pragma unroll
            for (int i = 0; i < 16; ++i) { acc[0][i] = O[0][i] * sc; acc[1][i] = O[1][i] * sc; }
#pragma unroll
            for (int st = 0; st < 2; ++st)
#pragma unroll
                for (int i = 0; i < 16; ++i) { float v = IM[st][i] * inv; v += xshfl(v, 8); v += xshfl(v, 16);
                    if (r < 8) imp_s[r * 64 + 32 * st + (i & 3) + 8 * (i >> 2) + 4 * h] = v; }
        }
        WAVE_SYNC();
        {
            unsigned long long um = 0ull;
            for (int tk = 0; tk < 8; ++tk) {
                const float imp = imp_s[tk * 64 + lane];
                const bool sv = lane <= qb, forced = (lane == 0) || (lane == qb) || (lane + 1 == qb);
                const float score = sv ? (forced ? 1e9f : imp) : -1.f;
                int rank = 0;
#pragma unroll 4
                for (int i = 0; i < 64; ++i) { const float si = __uint_as_float(__builtin_amdgcn_readlane(__float_as_uint(score), i)); rank += (si > score || (si == score && i < lane)) ? 1 : 0; }
                const unsigned long long mk = __ballot((rank < 16) && (score >= 0.f));
                um |= mk;
                if (lane == 0) msk_s[wid * 8 + tk] = mk;
            }
            if (lane == 0) { atomicOr(&uni_s[0], (unsigned)um); atomicOr(&uni_s[1], (unsigned)(um >> 32)); }
        }
        __syncthreads();
        const unsigned long long selm = msk_s[wid * 8 + (r & 7)];
        const unsigned long long uni = (unsigned long long)uni_s[0] | ((unsigned long long)uni_s[1] << 32);
        attn_branch<1>(lds, KS + (size_t)bhh * S * 64, VST + (size_t)bhh * 64 * S, S, uni, t, 0, selm, 0, tw0 + 7, 0, tw0, qr, O, IM, l, ovt, tid, r, h, pr);
        {
            const float lt = l + xshfl(l, 32), sc = g1 / lt;
#pragma unroll
            for (int i = 0; i < 16; ++i) { acc[0][i] += O[0][i] * sc; acc[1][i] += O[1][i] * sc; }
        }
        {
            const int jlo = qb >= 8 ? qb - 8 : 0;
            const unsigned long long bm = (qb >= 63 ? ~0ull : ((1ull << (qb + 1)) - 1ull)) & ~((1ull << jlo) - 1ull);
            attn_branch<2>(lds, KW + (size_t)bhh * S * 64, VWT + (size_t)bhh * 64 * S, S, bm, t, 0, 0ull, tw0 - 511, tw0 + 7, tw0 + 7 - 511, tw0, qr, O, IM, l, ovt, tid, r, h, pr);
        }
        {
            const float lt = l + xshfl(l, 32), sc = g2 / lt;
            bf16* op = hn + tok * D + (hk * 4 + g) * 64 + 4 * h;
#pragma unroll
            for (int dt = 0; dt < 2; ++dt)
#pragma unroll
                for (int q4 = 0; q4 < 4; ++q4) {
                    u32x2 w; w.x = pkbf(acc[dt][4 * q4] + O[dt][4 * q4] * sc, acc[dt][4 * q4 + 1] + O[dt][4 * q4 + 1] * sc);
                    w.y = pkbf(acc[dt][4 * q4 + 2] + O[dt][4 * q4 + 2] * sc, acc[dt][4 * q4 + 3] + O[dt][4 * q4 + 3] * sc);
                    *(u32x2*)(op + 32 * dt + 8 * q4) = w;
                }
        }
    }
}


#define LAS __attribute__((address_space(3)))
#define XB_TMO      128
#define XB_XCNT(j)  (256  + 64 * (j))
#define XB_XSUB(j)  (1280 + 64 * (j))
#define XB_XGEN(j)  (2304 + 64 * (j))
#define XB_TOP      3328
#define XB_TOPGEN   3392
#define XCD_BAR_WORDS 3456
#define XB_SPIN_CAP (1u << 18)

__device__ __forceinline__ unsigned xb_ld(unsigned* p)              { return __hip_atomic_load(p, __ATOMIC_RELAXED, __HIP_MEMORY_SCOPE_AGENT); }
__device__ __forceinline__ unsigned xb_add(unsigned* p, unsigned v) { return __hip_atomic_fetch_add(p, v, __ATOMIC_RELAXED, __HIP_MEMORY_SCOPE_AGENT); }
__device__ __forceinline__ unsigned xb_xcc_id() { return (unsigned)__builtin_amdgcn_s_getreg((3 << 11) | 20) & 0xFu; }
#define XB_SPIN(cond, bar) do { unsigned _sp = 0; while (cond) { __builtin_amdgcn_s_sleep(0); \
    if ((++_sp & 255u) == 0u) { if (xb_ld(&(bar)[XB_TMO])) break; if (_sp > XB_SPIN_CAP) { atomicAdd(&(bar)[XB_TMO], 1u); break; } } } } while (0)

struct XcdBarrier {
    unsigned* bar; unsigned x;
    volatile LAS unsigned* st;
};

__device__ __forceinline__ XcdBarrier xcd_barrier_post(unsigned* bar, volatile LAS unsigned* st) {
    XcdBarrier b; b.bar = bar; b.x = xb_xcc_id(); b.st = st;
    if (threadIdx.x == 0) (void)xb_add(&bar[XB_XCNT(b.x)], 1u);
    return b;
}
__device__ __forceinline__ void xcd_barrier_complete(unsigned* bar, unsigned x, unsigned& nloc, unsigned& nx) {
    const unsigned G = gridDim.x * gridDim.y * gridDim.z;
    unsigned sum, cnt, mine, sp = 0u;
    for (;;) {
        sum = 0u; cnt = 0u; mine = 0u;
#pragma unroll
        for (unsigned j = 0; j < 16; ++j) { const unsigned c = xb_ld(&bar[XB_XCNT(j)]); sum += c; cnt += (c > 0u) ? 1u : 0u; mine = (j == x) ? c : mine; }
        if (sum == G) break;
        __builtin_amdgcn_s_sleep(0);
        if ((++sp & 255u) == 0u) { if (xb_ld(&bar[XB_TMO])) break; if (sp > XB_SPIN_CAP) { atomicAdd(&bar[XB_TMO], 1u); break; } }
    }
    nloc = mine > 0u ? mine : 1u; nx = cnt > 0u ? cnt : 1u;
}

__device__ __forceinline__ void xcd_barrier(const XcdBarrier& b) {
    asm volatile("s_waitcnt vmcnt(0)" ::: "memory");
    __syncthreads();
    if (threadIdx.x == 0) {
        unsigned* bar = b.bar;
        __builtin_amdgcn_s_waitcnt(0);
        unsigned nloc = b.st[0], nx = b.st[1];
        if (nloc == 0u) { xcd_barrier_complete(bar, b.x, nloc, nx); b.st[0] = nloc; b.st[1] = nx; }
        const unsigned old = xb_add(&bar[XB_XSUB(b.x)], 1u);
        const unsigned gen = old / nloc;
        if (old + 1u == (gen + 1u) * nloc) {
            __builtin_amdgcn_fence(__ATOMIC_RELEASE, "agent");
            asm volatile("s_waitcnt vmcnt(0)" ::: "memory");
            const unsigned og = xb_add(&bar[XB_TOP], 1u);
            const unsigned tg = og / nx;
            if (og + 1u == (tg + 1u) * nx) xb_add(&bar[XB_TOPGEN], 1u);
            else XB_SPIN(xb_ld(&bar[XB_TOPGEN]) == tg, bar);
            __builtin_amdgcn_fence(__ATOMIC_ACQUIRE, "agent");
            xb_add(&bar[XB_XGEN(b.x)], 1u);
            asm volatile("s_waitcnt vmcnt(0)" ::: "memory");
        } else {
            XB_SPIN(xb_ld(&bar[XB_XGEN(b.x)]) == gen, bar);
            __builtin_amdgcn_fence(__ATOMIC_ACQUIRE, "agent");
            asm volatile("s_waitcnt vmcnt(0)" ::: "memory");
        }
    }
    __syncthreads();
}

struct Args { const void* in[24]; float* out; unsigned char* ws; int lo, hi; };

__host__ __device__ constexpr int mixer_inner_phases(int kind) { return kind == 0 ? 3 : (kind == 1 ? 1 : 4); }
__host__ __device__ constexpr int total_phases() { int n = 1; for (int L = 0; L < DEPTH; ++L) n += 4 + 2 + mixer_inner_phases(L % 3); return n; }

__global__ void __launch_bounds__(512, 2) mega(Args args) {
    extern __shared__ __attribute__((aligned(16))) unsigned char lds[];
    cg::grid_group grid = cg::this_grid();
    volatile LAS unsigned* bst = (volatile LAS unsigned*)((LAS unsigned char*)lds + (LDS_BYTES - 64));
    if (threadIdx.x < 2) bst[threadIdx.x] = 0u;
    __syncthreads();
    const XcdBarrier xbar = xcd_barrier_post((unsigned*)args.ws, bst);
    bool again = false;
    for (int ph = args.lo; ph < args.hi; ++ph) {
        int type = 0, s = 0, L = 0;
        if (ph > 0) {
            int p = ph - 1;
            for (L = 0; L < DEPTH; ++L) { const int n = 6 + mixer_inner_phases(L % 3); if (p < n) break; p -= n; }
            const int inner = mixer_inner_phases(L % 3), kind = L % 3;
            if (p < 2) { type = 2 + p; s = 2 * L; }
            else if (p == 2) type = 5;
            else if (p < 3 + inner) { const int q = p - 3; type = kind == 0 ? (q == 0 ? 15 : 5 + q) : (kind == 1 ? 8 : 9 + q); }
            else if (p == 3 + inner) type = 13;
            else { type = 2 + (p - 4 - inner); s = 2 * L + 1; }
        }
        int tid_ = threadIdx.x; asm volatile("" : "+v"(tid_));
        int G_ = gridDim.x, bx_ = blockIdx.x; asm volatile("" : "+s"(G_), "+s"(bx_));
        const int tid = tid_, lane = tid & 63, wid = __builtin_amdgcn_readfirstlane(tid >> 6);
        const int G = G_, bx = bx_;
        const int vcu = (G % 8 == 0) ? (bx % 8) * (G / 8) + bx / 8 : bx;
        const int gw = vcu * 8 + wid, NGW = G * 8;
        unsigned char* ws = args.ws; asm volatile("" : "+s"(ws));
        PG8_LAS unsigned char* ldsl = (PG8_LAS unsigned char*)lds;
        float* hout = args.out; asm volatile("" : "+s"(hout));
        bf16* HN = (bf16*)(ws + WS_HN);
        bf16* RB = (bf16*)(ws + WS_R);
        f32x2* tab = (f32x2*)(ws + WS_TAB);
        const int kind = L % 3, jj = L / 3;
        bf16* QN = RB + (size_t)T * 2560;
        bf16* KSb = QN + (size_t)T * 1024;
        bf16* KWb = KSb + (size_t)T * 256;
        bf16* KCH = (bf16*)(ws + WS_O32);
        bf16* VCH = KCH + (size_t)T * 256;
        float* Pk = (float*)(ws + WS_O32 + 32 * MiB);
        float* Pv = Pk + (size_t)8192 * 512;
        bf16* KC = (bf16*)(ws + WS_O32 + 64 * MiB);
        bf16* VC = (bf16*)(ws + WS_O32 + 65 * MiB);
        bf16* OVT = (bf16*)(ws + WS_BP + 65536);
        bf16* VST = (bf16*)(ws + WS_O32 + 68 * MiB);
        bf16* VWT = (bf16*)(ws + WS_O32 + 84 * MiB);
        switch (type) {
        case 0: {
            float* scr = (float*)lds + wid * (64 * 33);
            for (int mi = 0; mi < 28; ++mi) {
                const float* W; const float* nw = nullptr; int K, N, Npad, mode = 0; bf16* WT;
                if (mi < 8)       { nw = (const float*)args.in[2] + (size_t)mi * D; W = (const float*)args.in[3] + (size_t)mi * D * 2 * FF; K = D; N = 2 * FF; Npad = N; mode = 1; WT = (bf16*)(ws + WS_WGU) + (size_t)mi * 2 * FF * D; }
                else if (mi < 16) { const int i = mi - 8; W = (const float*)args.in[4] + (size_t)i * FF * D; K = FF; N = D; Npad = N; WT = (bf16*)(ws + WS_WDN) + (size_t)i * D * FF; }
                else if (mi < 18) { const int i = mi - 16; nw = (const float*)args.in[5] + (size_t)(3 * i) * D; W = (const float*)args.in[6] + (size_t)i * D * 4112; K = D; N = 4112; Npad = GDN_NPAD; WT = (bf16*)(ws + WS_WGI) + (size_t)i * GDN_NPAD * D; }
                else if (mi < 20) { const int i = mi - 18; W = (const float*)args.in[11] + (size_t)i * D * D; K = D; N = D; Npad = N; WT = (bf16*)(ws + WS_WGO) + (size_t)i * D * D; }
                else if (mi == 20) { nw = (const float*)args.in[5] + (size_t)1 * D; W = (const float*)args.in[12]; K = D; N = 3072; Npad = N; WT = (bf16*)(ws + WS_WSI); }
                else if (mi == 21) { W = (const float*)args.in[14]; K = D; N = D; Npad = N; WT = (bf16*)(ws + WS_WSO); }
                else if (mi == 22) { nw = (const float*)args.in[5] + (size_t)2 * D; W = (const float*)args.in[15]; K = D; N = 2608; Npad = NSA_NPAD; WT = (bf16*)(ws + WS_WNI); }
                else if (mi == 23) { W = (const float*)args.in[23]; K = D; N = D; Npad = N; WT = (bf16*)(ws + WS_WNO); }
                else { const int i = mi - 24, kd = i >> 1, hf = i & 1;
                    W = (const float*)args.in[19] + (size_t)kd * 2048 * 256 + (size_t)hf * 1024 * 256; K = 1024; N = 256; Npad = 256; WT = (bf16*)(ws + WS_WC1) + (size_t)kd * 512 * 1024 + (size_t)hf * 256 * 1024; }
                xpose_matrix(W, nw, K, N, Npad, WT, mode, scr, gw, NGW, lane);
            }
            {
                float* ss = (float*)(ws + WS_SS);
                const float* xin = (const float*)args.in[0];
                for (int m0 = gw; m0 < T; m0 += 4 * NGW) {
                    f32x4 v[4][4];
#pragma unroll
                    for (int q = 0; q < 4; ++q) { const int m = m0 + q * NGW < T ? m0 + q * NGW : m0; const f32x4* xr = (const f32x4*)(xin + (size_t)m * D) + lane;
#pragma unroll
                        for (int j = 0; j < 4; ++j) v[q][j] = xr[64 * j]; }
#pragma unroll
                    for (int q = 0; q < 4; ++q) {
                        const int m = m0 + q * NGW;
                        if (m >= T) break;
                        u32x2* o8 = (u32x2*)(HN + (size_t)m * D) + lane; float sq = 0.f;
#pragma unroll
                        for (int j = 0; j < 4; ++j) { const f32x4 x = v[q][j]; sq += (x.x * x.x + x.y * x.y) + (x.z * x.z + x.w * x.w); u32x2 o; o.x = pkbf(x.x, x.y); o.y = pkbf(x.z, x.w); o8[64 * j] = o; }
                        sq = wave_sum(sq); if (lane < 16) ss[(size_t)m * 16 + lane] = lane == 0 ? sq : 0.f;
                    }
                }
            }
            const int* positions = (const int*)args.in[1];
            for (int idx = bx * 512 + tid; idx < T * 32; idx += G * 512) {
                const int tk = idx >> 5, i = idx & 31;
                const float inv = 1.0f / exp2f((float)(2 * i) * (13.287712379549449f / 64.f));
                const float ang = (float)positions[tk] * inv;
                const double rev = (double)ang * 0.15915494309189535;
                const float fr = (float)(rev - rint(rev));
                f32x2 v; v.x = __builtin_amdgcn_cosf(fr); v.y = __builtin_amdgcn_sinf(fr);
                tab[idx] = v;
            }
            for (int idx = bx * 512 + tid; idx < 64 * 256; idx += G * 512) {
                const int sj = idx >> 8, i = idx & 255, q = i >> 2, rem = i & 3;
                OVT[idx] = (bf16)(rem < 3 ? (q == sj ? 0x3F80 : 0) : ((q == sj || q + 1 == sj) ? 0x3F00 : 0));
            }
            if (bx < 2 && tid < 256) {
                const float* pe = (const float*)args.in[18] + (size_t)bx * 2048;
                const float* w1 = (const float*)args.in[19] + (size_t)bx * 2048 * 256 + tid;
                float acc = ((const float*)args.in[20])[bx * 256 + tid];
                for (int k = 0; k < 2048; ++k) acc += pe[k] * w1[(size_t)k * 256];
                ((float*)(ws + WS_BP))[bx * 256 + tid] = acc;
            }
        } break;
        case 2: {
            const bf16* Ah = (s & 1) ? (const bf16*)(ws + WS_R + 192 * MiB) : HN;
            pg8::Gemm g{Ah, (const bf16*)(ws + WS_WGU) + (size_t)s * 2 * FF * D, T, 2 * FF, D}; pg8::StaticOrder SO; SO.init(T, 2 * FF, G, bx);
            float* rtab = (float*)(lds + 131072);
            rstd_table(rtab, (const float*)(ws + WS_SS) + (size_t)s * T * 16, SO, tid);
            pg8::EpiSwiGLU E{RB, rtab};
            pg8::gemm_phase<pg8::EpiSwiGLU, pg8::StaticOrder, true, true>(ldsl, g, SO, E, tid); } break;
        case 3: {
            pg8::Gemm g{RB, (const bf16*)(ws + WS_WDN) + (size_t)s * D * FF, T, D, FF}; pg8::StaticOrder SO; SO.init(T, D, G, bx);
            const int slot = (s & 1) ? (s < 7 ? s + 1 : 12) : 8 + (s >> 1);
            pg8::EpiResid<1> E{s == 0 ? (const float*)args.in[0] : hout, hout, HN, (float*)(ws + WS_SS) + (size_t)slot * T * 16};
            pg8::gemm_phase<pg8::EpiResid<1>, pg8::StaticOrder, true, true>(ldsl, g, SO, E, tid); } break;
        case 5: {
            const bf16* Wt; int Np, ldc, nmain, ldt, nvalid; float* tail;
            if (kind == 0) { Wt = (const bf16*)(ws + WS_WGI) + (size_t)jj * GDN_NPAD * D; Np = GDN_NPAD; ldc = 4096; nmain = 4096; tail = (float*)(ws + WS_AB); ldt = 16; nvalid = 4112; }
            else if (kind == 1) { Wt = (const bf16*)(ws + WS_WSI); Np = 3072; ldc = 3072; nmain = 3072; tail = (float*)(ws + WS_AB); ldt = 16; nvalid = 3072; }
            else { Wt = (const bf16*)(ws + WS_WNI); Np = NSA_NPAD; ldc = 2560; nmain = 2560; tail = (float*)(ws + WS_GT); ldt = 48; nvalid = 2608; }
            pg8::Gemm g{HN, Wt, T, Np, D}; pg8::StaticOrder SO; SO.init(T, Np, G, bx);
            float* rtab = (float*)(lds + 131072);
            rstd_table(rtab, (const float*)(ws + WS_SS) + (size_t)(8 + L) * T * 16, SO, tid);
            pg8::EpiProj E{RB, ldc, nmain, tail, ldt, nvalid, rtab, (bf16*)(ws + WS_HALO), kind == 0 ? 1 : 0};
            pg8::gemm_phase<pg8::EpiProj, pg8::StaticOrder, true, true>(ldsl, g, SO, E, tid); } break;
        case 14: phase_gdn_halo(RB, (bf16*)(ws + WS_HALO), vcu * 512 + tid, G * 512); break;
        case 15: phase_gdn_prep(lds, RB, (const bf16*)(ws + WS_HALO), (const float*)(ws + WS_AB), (const float*)args.in[7] + (size_t)jj * 4 * 3072, (const float*)args.in[8] + jj * 8, (const float*)args.in[9] + jj * 8,
                                HN, (bf16*)(ws + WS_O32 + 64 * MiB), (float*)(ws + WS_GL), bx, G, tid, wid, lane); break;
        case 6:
#ifndef DIS_SCAN
            phase_gdn_scan2(lds, RB, HN, (const bf16*)(ws + WS_O32 + 64 * MiB), (const float*)(ws + WS_GL), (bf16*)(ws + WS_O32), bx, G, tid, wid, lane);
#endif
            break;
        case 7:
#ifndef DIS_GPOST
            phase_gdn_post((const bf16*)(ws + WS_O32), RB, (const float*)args.in[10] + jj * 128, HN, gw, NGW, lane);
#endif
            break;
        case 8:
#ifndef DIS_SPOST
            phase_sc_post(RB, (const float*)args.in[13], HN, vcu * 512 + tid, G * 512);
#endif
            break;
        case 9:
#ifndef DIS_NPOST
            phase_nsa_post(lds, RB, (const float*)args.in[16], (const float*)args.in[17], tab, QN, KSb, KWb, KCH, VCH, VST, VWT, gw, NGW, wid, lane);
#endif
            break;
        case 10: {
            pg8::Gemm g{KCH, (const bf16*)(ws + WS_WC1), 8192, 512, 1024}; pg8::StaticOrder SO; SO.init(8192, 512, G, bx);
            pg8::Gemm g2{VCH, (const bf16*)(ws + WS_WC1) + (size_t)512 * 1024, 8192, 512, 1024};
            pg8::EpiF32 E{Pk, 512};
            if (bx >= G / 2) { g = g2; SO.init(8192, 512, G, bx - G / 2); E.C = Pv; }
            pg8::gemm_phase<pg8::EpiF32, pg8::StaticOrder, true, true>(ldsl, g, SO, E, tid); } break;
        case 11:
#ifndef DIS_CMP2
            phase_cmp2(lds, Pk, Pv, (const float*)(ws + WS_BP), (const float*)args.in[21], (const float*)args.in[22], (const float*)args.in[17], KC, VC, gw, NGW, wid, lane, tid);
#endif
            break;
        case 12:
#ifndef DIS_ATTN
            phase_nsa_attn(lds, QN, KSb, KWb, VST, VWT, KC, VC, OVT, (const float*)(ws + WS_GT), tab, HN, bx, G, tid, wid, lane);
#endif
            break;
        default: {
            const bf16* Wout = kind == 0 ? (const bf16*)(ws + WS_WGO) + (size_t)jj * D * D : (kind == 1 ? (const bf16*)(ws + WS_WSO) : (const bf16*)(ws + WS_WNO));
            pg8::Gemm g{HN, Wout, T, D, D}; pg8::StaticOrder SO; SO.init(T, D, G, bx);
            pg8::EpiResid<2> E{hout, hout, (bf16*)(ws + WS_R + 192 * MiB), (float*)(ws + WS_SS) + (size_t)(2 * L + 1) * T * 16};
            pg8::gemm_phase<pg8::EpiResid<2>, pg8::StaticOrder, true, true>(ldsl, g, SO, E, tid); } break;
        }
#ifdef REP_TYPE
        if (type == REP_TYPE && !again) { again = true; xcd_barrier(xbar); --ph; continue; }
        again = false;
#endif
        if (ph + 1 < args.hi) { if (args.hi < 0) grid.sync(); else xcd_barrier(xbar); }
    }
}

extern "C" void kernel_launch(void* const* d_in, const int* in_sizes, int n_in, void* d_out, int out_size, void* d_ws, size_t ws_size, hipStream_t stream) {
    static int grid = 0;
    if (grid == 0) {
        if (n_in != 24 || out_size != T * D || ws_size < WS_END2) { fprintf(stderr, "kernel_launch: unexpected shapes n_in %d out %d ws %zu (need %zu)\n", n_in, out_size, ws_size, (size_t)WS_END2); grid = -1; return; }
        int dev = 0, cus = 0, per_cu = 0;
        hipGetDevice(&dev); hipDeviceGetAttribute(&cus, hipDeviceAttributeMultiprocessorCount, dev);
        if (hipFuncSetAttribute((const void*)mega, hipFuncAttributeMaxDynamicSharedMemorySize, LDS_BYTES) != hipSuccess) { fprintf(stderr, "kernel_launch: hipFuncSetAttribute failed\n"); grid = -1; return; }
        if (hipOccupancyMaxActiveBlocksPerMultiprocessor(&per_cu, (const void*)mega, 512, LDS_BYTES) != hipSuccess || per_cu < 1) { fprintf(stderr, "kernel_launch: occupancy query says %d\n", per_cu); per_cu = 1; }
        (void)hipGetLastError();
        grid = cus;
    }
    if (grid < 0) return;
    Args a{};
    for (int i = 0; i < 24; ++i) a.in[i] = d_in[i];
    a.out = (float*)d_out; a.ws = (unsigned char*)d_ws;
    constexpr int NPH = total_phases();
#if MK_MULTI
    for (int p = 0; p < NPH; ++p) { a.lo = p; a.hi = p + 1; hipLaunchKernelGGL(mega, dim3(grid), dim3(512), LDS_BYTES, stream, a); }
#else
    a.lo = 0; a.hi = NPH;
    (void)hipMemsetAsync(d_ws, 0, 16384, stream);
    void* kargs[] = {&a};
    hipError_t e = hipLaunchCooperativeKernel((const void*)mega, dim3(grid), dim3(512), kargs, LDS_BYTES, stream);
    if (e != hipSuccess) fprintf(stderr, "cooperative launch failed: %s (grid %d)\n", hipGetErrorString(e), grid);
#endif
}
```
